# Optimizing an MI355X kernel written in HIP

```python
import math
import jax, jax.numpy as jnp
from jax import lax
import numpy as np

D_MODEL = 2048
BATCH = 4
SEQ = 2048
DEPTH = 2
DEC_BATCH = 128
DEC_SEQ = 4
PAST_LEN = 16384
PAGE_SIZE = 128

N_EVEN = (DEPTH + 1) // 2
N_ODD = DEPTH // 2
PLE_DIM = 256
D_FF = 4 * D_MODEL
CONV_W = 4
CHUNK = 64
LN_EPS = 1e-5
RMS_EPS = 1e-6
DN_ALPHA = (2 * DEPTH) ** 0.25
DN_BETA = (8 * DEPTH) ** -0.25

A_HEADS = D_MODEL // 256
A_DK = 128
A_DV = 128
A_QK = A_HEADS * A_DK
A_V = A_HEADS * A_DV
LRU_W = D_MODEL // 2
B_BLOCKS = 8
B_BW = LRU_W // B_BLOCKS
LRU_C = 8.0
CONV_CH = 2 * A_QK + A_V + LRU_W
PROJ_E = CONV_CH + A_V + LRU_W + 2 * A_HEADS
MIX_E = A_V + LRU_W
C_HEADS = D_MODEL // 256
C_DK = 128
C_DV = 256
C_QK = C_HEADS * C_DK
C_V = C_HEADS * C_DV
PROJ_O = 2 * C_QK + 2 * C_V + 2 * C_HEADS

kernel_name = "deltanet_rglru_mlstm_hybrid_step"

F32 = jnp.float32


def layer_norm(x, g, b):
    xf = x.astype(F32)
    mu = jnp.mean(xf, -1, keepdims=True)
    var = jnp.mean(jnp.square(xf - mu), -1, keepdims=True)
    return ((xf - mu) * lax.rsqrt(var + LN_EPS) * g.astype(F32) + b.astype(F32)).astype(x.dtype)


def rms_norm(x, w):
    xf = x.astype(F32)
    return xf * lax.rsqrt(jnp.mean(xf * xf, -1, keepdims=True) + RMS_EPS) * w.astype(F32)


def l2_normalize(x):
    xf = x.astype(F32)
    return xf * lax.rsqrt(jnp.sum(xf * xf, -1, keepdims=True) + 1e-6)


def causal_conv(u, buf, w, b):
    T = u.shape[1]
    full = jnp.concatenate([buf.astype(u.dtype), u], axis=1)
    out = sum(full[:, j:j + T] * w[j] for j in range(CONV_W)) + b
    return out, full[:, T:]


def to_chunks(x, L):
    B, T, H = x.shape[:3]
    x = x.reshape((B, T // L, L, H) + x.shape[3:])
    return jnp.moveaxis(x, (1, 3), (0, 2))


def from_chunks(x):
    x = jnp.moveaxis(x, (0, 2), (1, 3))
    B, NC, L, H = x.shape[:4]
    return x.reshape((B, NC * L, H) + x.shape[4:])


def gated_delta_rule(q, k, v, g, beta, s0, L):
    qc, kc, vc = (to_chunks(t.astype(F32), L) for t in (q, k, v))
    gc = jnp.cumsum(to_chunks(g.astype(F32), L), axis=-1)
    bc = to_chunks(beta.astype(F32), L)
    idx = jnp.arange(L)
    tril = idx[:, None] >= idx[None, :]
    decay = jnp.exp(jnp.where(tril, gc[..., :, None] - gc[..., None, :], -jnp.inf))
    kb = kc * bc[..., None]
    m_strict = jnp.where(idx[:, None] > idx[None, :],
                         jnp.einsum('nbhid,nbhjd->nbhij', kb, kc) * decay, 0.0)
    eye = jnp.eye(L, dtype=F32)
    t_inv = lax.linalg.triangular_solve(eye + m_strict, jnp.broadcast_to(eye, m_strict.shape),
                                        left_side=True, lower=True)
    u = jnp.einsum('nbhij,nbhjd->nbhid', t_inv, vc * bc[..., None])
    w = jnp.einsum('nbhij,nbhjd->nbhid', t_inv, kb * jnp.exp(gc)[..., None])
    qk = jnp.einsum('nbhid,nbhjd->nbhij', qc, kc) * decay

    def step(s, xs):
        q_i, k_i, u_i, w_i, qk_i, g_i = xs
        v_new = u_i - jnp.einsum('bhik,bhkv->bhiv', w_i, s)
        o = (jnp.einsum('bhik,bhkv->bhiv', q_i * jnp.exp(g_i)[..., None], s)
             + jnp.einsum('bhij,bhjv->bhiv', qk_i, v_new))
        g_last = g_i[..., -1:]
        s = (s * jnp.exp(g_last)[..., None]
             + jnp.einsum('bhik,bhiv->bhkv', k_i * jnp.exp(g_last - g_i)[..., None], v_new))
        return s, o

    s_fin, o = lax.scan(step, s0.astype(F32), (qc, kc, u, w, qk, gc))
    return from_chunks(o), s_fin


def rg_lru(x, r_pre, i_pre, lam, h0):
    log_a = -LRU_C * jax.nn.sigmoid(r_pre.astype(F32)) * jax.nn.softplus(-lam.astype(F32))
    a = jnp.exp(log_a)
    bx = jnp.sqrt(-jnp.expm1(2.0 * log_a)) * jax.nn.sigmoid(i_pre.astype(F32)) * x.astype(F32)
    bx = bx.at[:, 0].add(a[:, 0] * h0.astype(F32))

    def combine(left, right):
        a1, b1 = left
        a2, b2 = right
        return a1 * a2, a2 * b1 + b2

    _, h = lax.associative_scan(combine, (a, bx), axis=1)
    return h, h[:, -1]


def mlstm_chunked(q, k, v, ig, fg, c0, n0, m0, L):
    qc, kc, vc = (to_chunks(t.astype(F32), L) for t in (q, k, v))
    igc = to_chunks(ig.astype(F32), L)
    bcum = jnp.cumsum(jax.nn.log_sigmoid(to_chunks(fg.astype(F32), L)), axis=-1)
    idx = jnp.arange(L)
    tril = idx[:, None] >= idx[None, :]
    d_intra = jnp.where(tril, bcum[..., :, None] - bcum[..., None, :] + igc[..., None, :], -jnp.inf)
    g_end = bcum[..., -1:] - bcum + igc
    qk = jnp.einsum('nbhtk,nbhsk->nbhts', qc, kc)

    def step(carry, xs):
        c, n, m = carry
        q_i, k_i, v_i, b_i, d_i, ge_i, qk_i = xs
        inter = b_i + m[..., None]
        m_t = jnp.maximum(inter, jnp.max(d_i, -1))
        e = jnp.exp(inter - m_t)
        s = qk_i * jnp.exp(d_i - m_t[..., None])
        num = (e[..., None] * jnp.einsum('bhtk,bhvk->bhtv', q_i, c)
               + jnp.einsum('bhts,bhsv->bhtv', s, v_i))
        den = e * jnp.einsum('bhtk,bhk->bht', q_i, n) + jnp.sum(s, -1)
        h = num / jnp.maximum(jnp.abs(den), jnp.exp(-m_t))[..., None]
        b_last = b_i[..., -1]
        m_new = jnp.maximum(b_last + m, jnp.max(ge_i, -1))
        sc = jnp.exp(b_last + m - m_new)
        w_s = jnp.exp(ge_i - m_new[..., None])
        c = sc[..., None, None] * c + jnp.einsum('bhs,bhsv,bhsk->bhvk', w_s, v_i, k_i)
        n = sc[..., None] * n + jnp.einsum('bhs,bhsk->bhk', w_s, k_i)
        return (c, n, m_new), h

    (c, n, m), h = lax.scan(step, (c0.astype(F32), n0.astype(F32), m0.astype(F32)),
                            (qc, kc, vc, bcum, d_intra, g_end, qk))
    return from_chunks(h), c, n, m


def delta_lru_mixer(x, conv_buf, s_delta, h_lru, w_in, w_conv, b_conv, a_log, dt_bias, norm_w,
                    w_r, b_r, w_i, b_i, lam, w_out, L):
    B, T, _ = x.shape
    proj = x @ w_in
    s1 = CONV_CH
    s2 = s1 + A_V
    s3 = s2 + LRU_W
    s4 = s3 + A_HEADS
    conv_in, z, gate, a_pre, b_pre = jnp.split(proj, [s1, s2, s3, s4], axis=-1)
    conv_out, conv_new = causal_conv(conv_in, conv_buf, w_conv, b_conv)
    q, k, v, xr = jnp.split(conv_out, [A_QK, 2 * A_QK, 2 * A_QK + A_V], axis=-1)
    q = l2_normalize(jax.nn.silu(q).reshape(B, T, A_HEADS, A_DK)) * (A_DK ** -0.5)
    k = l2_normalize(jax.nn.silu(k).reshape(B, T, A_HEADS, A_DK))
    v = jax.nn.silu(v).reshape(B, T, A_HEADS, A_DV)
    g = -jnp.exp(a_log.astype(F32)) * jax.nn.softplus(a_pre.astype(F32) + dt_bias.astype(F32))
    beta = jax.nn.sigmoid(b_pre.astype(F32))
    o, s_new = gated_delta_rule(q, k, v, g, beta, s_delta, L)
    y_a = (rms_norm(o, norm_w) * jax.nn.silu(z.reshape(B, T, A_HEADS, A_DV).astype(F32))).reshape(B, T, A_V)
    xb = xr.reshape(B, T, B_BLOCKS, B_BW)
    r_pre = jnp.einsum('btnc,ncd->btnd', xb, w_r).reshape(B, T, LRU_W) + b_r
    i_pre = jnp.einsum('btnc,ncd->btnd', xb, w_i).reshape(B, T, LRU_W) + b_i
    h, h_last = rg_lru(xr, r_pre, i_pre, lam, h_lru)
    y_b = h * jax.nn.gelu(gate.astype(F32))
    y = jnp.concatenate([y_a, y_b], axis=-1).astype(x.dtype) @ w_out
    return y, conv_new, s_new, h_last


def mlstm_mixer(x, c0, n0, m0, w_in, b_ig, b_fg, norm_w, w_out, L):
    B, T, _ = x.shape
    proj = x @ w_in
    cuts = [C_QK, 2 * C_QK, 2 * C_QK + C_V, 2 * C_QK + 2 * C_V, 2 * C_QK + 2 * C_V + C_HEADS]
    q, k, v, o_pre, ig, fg = jnp.split(proj, cuts, axis=-1)
    q = q.reshape(B, T, C_HEADS, C_DK)
    k = k.reshape(B, T, C_HEADS, C_DK) * (C_DK ** -0.5)
    v = v.reshape(B, T, C_HEADS, C_DV)
    ig = ig.astype(F32) + b_ig.astype(F32)
    fg = fg.astype(F32) + b_fg.astype(F32)
    h, c, n, m = mlstm_chunked(q, k, v, ig, fg, c0, n0, m0, L)
    y = rms_norm(h, norm_w.reshape(C_HEADS, C_DV)) * jax.nn.sigmoid(o_pre.reshape(B, T, C_HEADS, C_DV).astype(F32))
    y = y.reshape(B, T, C_V).astype(x.dtype) @ w_out
    return y, c, n, m


def run_trunk(x, p, conv, delta, lru, mc, mn, mm, W):
    T = x.shape[1]
    L = math.gcd(T, CHUNK)
    conv_o, delta_o, lru_o, mc_o, mn_o, mm_o = [], [], [], [], [], []
    for layer in range(DEPTH):
        j = layer // 2
        if layer % 2 == 0:
            mix, cb, sd, hl = delta_lru_mixer(
                x, conv[j], delta[j], lru[j], W['w_in_e'][j], W['w_conv_e'][j], W['b_conv_e'][j],
                W['a_log_e'][j], W['dt_bias_e'][j], W['delta_norm_e'][j], W['lru_wr_e'][j],
                W['lru_br_e'][j], W['lru_wi_e'][j], W['lru_bi_e'][j], W['lru_lambda_e'][j],
                W['w_out_e'][j], L)
            conv_o.append(cb)
            delta_o.append(sd)
            lru_o.append(hl)
        else:
            mix, c, n, m = mlstm_mixer(
                x, mc[j], mn[j], mm[j], W['w_in_o'][j], W['b_ig_o'][j], W['b_fg_o'][j],
                W['mlstm_norm_o'][j], W['w_out_o'][j], L)
            mc_o.append(c)
            mn_o.append(n)
            mm_o.append(m)
        h = layer_norm(DN_ALPHA * x + mix.astype(x.dtype), W['ln1_g'][layer], W['ln1_b'][layer])
        ff = jnp.square(jax.nn.relu(h @ W['w_up'][layer])) @ W['w_down'][layer]
        h = layer_norm(DN_ALPHA * h + ff, W['ln2_g'][layer], W['ln2_b'][layer])
        gate = jax.nn.sigmoid((h @ W['w_ple_gate'][layer]).astype(F32))
        x = (h.astype(F32) + gate * (p[layer] @ W['w_ple'][layer]).astype(F32)).astype(x.dtype)
    return (x, jnp.stack(conv_o), jnp.stack(delta_o), jnp.stack(lru_o),
            jnp.stack(mc_o), jnp.stack(mn_o), jnp.stack(mm_o))


def setup_inputs(seed: int = 0) -> dict:
    key = jax.random.key(seed)
    ks = iter(jax.random.split(key, 48))

    def nrm(shape, scale):
        return jax.random.normal(next(ks), shape, F32) * scale

    def unif(shape, lo, hi):
        return jax.random.uniform(next(ks), shape, F32, lo, hi)

    d = {}
    d['x_prompt'] = nrm((BATCH, SEQ, D_MODEL), 1.0)
    d['x_sample'] = nrm((DEC_BATCH, DEC_SEQ, D_MODEL), 1.0)
    d['p_prompt'] = nrm((DEPTH, BATCH, SEQ, PLE_DIM), 1.0)
    d['p_sample'] = nrm((DEPTH, DEC_BATCH, DEC_SEQ, PLE_DIM), 1.0)
    d['state_conv'] = nrm((N_EVEN, DEC_BATCH, CONV_W - 1, CONV_CH), 1.0)
    d['state_delta'] = nrm((N_EVEN, DEC_BATCH, A_HEADS, A_DK, A_DV), 0.3)
    d['state_lru'] = nrm((N_EVEN, DEC_BATCH, LRU_W), 0.5)
    d['state_mlstm_c'] = nrm((N_ODD, DEC_BATCH, C_HEADS, C_DV, C_DK), 0.3)
    d['state_mlstm_n'] = nrm((N_ODD, DEC_BATCH, C_HEADS, C_DK), 0.3)
    d['state_mlstm_m'] = unif((N_ODD, DEC_BATCH, C_HEADS), 0.0, 2.0)
    d['w_in_e'] = nrm((N_EVEN, D_MODEL, PROJ_E), D_MODEL ** -0.5)
    d['w_conv_e'] = nrm((N_EVEN, CONV_W, CONV_CH), CONV_W ** -0.5)
    d['b_conv_e'] = nrm((N_EVEN, CONV_CH), 0.01)
    d['a_log_e'] = jnp.log(unif((N_EVEN, A_HEADS), 1.0, 16.0))
    dt = jnp.exp(unif((N_EVEN, A_HEADS), math.log(1e-3), math.log(1e-1)))
    d['dt_bias_e'] = dt + jnp.log(-jnp.expm1(-dt))
    d['delta_norm_e'] = 1.0 + nrm((N_EVEN, A_DV), 0.02)
    d['lru_wr_e'] = nrm((N_EVEN, B_BLOCKS, B_BW, B_BW), B_BW ** -0.5)
    d['lru_br_e'] = nrm((N_EVEN, LRU_W), 0.01)
    d['lru_wi_e'] = nrm((N_EVEN, B_BLOCKS, B_BW, B_BW), B_BW ** -0.5)
    d['lru_bi_e'] = nrm((N_EVEN, LRU_W), 0.01)
    u = unif((N_EVEN, LRU_W), 0.9, 0.999) ** (1.0 / LRU_C)
    d['lru_lambda_e'] = jnp.log(u) - jnp.log1p(-u)
    d['w_out_e'] = nrm((N_EVEN, MIX_E, D_MODEL), MIX_E ** -0.5 * DN_BETA)
    d['w_in_o'] = nrm((N_ODD, D_MODEL, PROJ_O), D_MODEL ** -0.5)
    d['b_ig_o'] = nrm((N_ODD, C_HEADS), 0.1)
    d['b_fg_o'] = jnp.linspace(3.0, 6.0, C_HEADS, dtype=F32)[None, :] + nrm((N_ODD, C_HEADS), 0.1)
    d['mlstm_norm_o'] = 1.0 + nrm((N_ODD, C_V), 0.02)
    d['w_out_o'] = nrm((N_ODD, C_V, D_MODEL), C_V ** -0.5 * DN_BETA)
    d['ln1_g'] = 1.0 + nrm((DEPTH, D_MODEL), 0.02)
    d['ln1_b'] = nrm((DEPTH, D_MODEL), 0.02)
    d['ln2_g'] = 1.0 + nrm((DEPTH, D_MODEL), 0.02)
    d['ln2_b'] = nrm((DEPTH, D_MODEL), 0.02)
    d['w_up'] = nrm((DEPTH, D_MODEL, D_FF), D_MODEL ** -0.5)
    d['w_down'] = nrm((DEPTH, D_FF, D_MODEL), D_FF ** -0.5 * DN_BETA)
    d['w_ple'] = nrm((DEPTH, PLE_DIM, D_MODEL), PLE_DIM ** -0.5 * 0.5)
    d['w_ple_gate'] = nrm((DEPTH, D_MODEL, D_MODEL), D_MODEL ** -0.5)
    return d


def reference(x_prompt, x_sample, p_prompt, p_sample, state_conv, state_delta, state_lru,
              state_mlstm_c, state_mlstm_n, state_mlstm_m, w_in_e, w_conv_e, b_conv_e, a_log_e,
              dt_bias_e, delta_norm_e, lru_wr_e, lru_br_e, lru_wi_e, lru_bi_e, lru_lambda_e, w_out_e,
              w_in_o, b_ig_o, b_fg_o, mlstm_norm_o, w_out_o, ln1_g, ln1_b, ln2_g, ln2_b, w_up, w_down,
              w_ple, w_ple_gate):
    W = dict(w_in_e=w_in_e, w_conv_e=w_conv_e, b_conv_e=b_conv_e, a_log_e=a_log_e,
             dt_bias_e=dt_bias_e, delta_norm_e=delta_norm_e, lru_wr_e=lru_wr_e, lru_br_e=lru_br_e,
             lru_wi_e=lru_wi_e, lru_bi_e=lru_bi_e, lru_lambda_e=lru_lambda_e, w_out_e=w_out_e,
             w_in_o=w_in_o, b_ig_o=b_ig_o, b_fg_o=b_fg_o, mlstm_norm_o=mlstm_norm_o, w_out_o=w_out_o,
             ln1_g=ln1_g, ln1_b=ln1_b, ln2_g=ln2_g, ln2_b=ln2_b, w_up=w_up, w_down=w_down,
             w_ple=w_ple, w_ple_gate=w_ple_gate)
    bp = x_prompt.shape[0]
    z_conv = jnp.zeros((N_EVEN, bp, CONV_W - 1, CONV_CH), x_prompt.dtype)
    z_delta = jnp.zeros((N_EVEN, bp, A_HEADS, A_DK, A_DV), F32)
    z_lru = jnp.zeros((N_EVEN, bp, LRU_W), F32)
    z_c = jnp.zeros((N_ODD, bp, C_HEADS, C_DV, C_DK), F32)
    z_n = jnp.zeros((N_ODD, bp, C_HEADS, C_DK), F32)
    z_m = jnp.zeros((N_ODD, bp, C_HEADS), F32)
    y_prompt, conv_p, delta_p, lru_p, mc_p, mn_p, mm_p = run_trunk(
        x_prompt, p_prompt, z_conv, z_delta, z_lru, z_c, z_n, z_m, W)
    y_sample, conv_s, delta_s, lru_s, mc_s, mn_s, mm_s = run_trunk(
        x_sample, p_sample, state_conv, state_delta, state_lru,
        state_mlstm_c, state_mlstm_n, state_mlstm_m, W)
    return (y_prompt, y_sample, conv_p, delta_p, lru_p, mc_p, mn_p, mm_p,
            conv_s, delta_s, lru_s, mc_s, mn_s, mm_s)
```

```cpp
#include <hip/hip_runtime.h>
#include <hip/hip_cooperative_groups.h>
#include <cstdio>
#include <cstdint>
namespace cg = cooperative_groups;

#ifndef MK_N_LAUNCHES
#define MK_N_LAUNCHES 0
#endif

namespace pg8 {
#define PG8_LAS __attribute__((address_space(3)))
typedef unsigned short bf16_t;
typedef short bf16x8 __attribute__((ext_vector_type(8)));
typedef float f32x4 __attribute__((ext_vector_type(4)));
typedef unsigned u32x4 __attribute__((ext_vector_type(4)));
constexpr int BM = 256, BK = 64, HALF = 128, HTB = HALF * BK * 2, STAGE_BYTES = 8 * HTB, NXCD = 8, WGM = 8;

__host__ __device__ __forceinline__ int lds_byte(int r, int c) { const int st = (r >> 4) * 2 + (c >> 5), rr = r & 15, cc = c & 31, ob = rr * 64 + cc * 2; return st * 1024 + (ob ^ (((ob >> 9) & 1) << 5)); }
__host__ __device__ __forceinline__ void stage_rc(int b, int& R, int& C) { const int st = b / 1024, sb = b % 1024, swz = sb ^ (((sb >> 9) & 1) << 5); R = (st >> 1) * 16 + swz / 64; C = (st & 1) * 32 + (swz % 64) / 2; }
__host__ __device__ __forceinline__ int perm32(int rho) { const int n = rho >> 4, i = rho & 15; return 8 * (i >> 2) + 4 * n + (i & 3); }

struct Unit { int pm, pn; };
struct Gemm { const bf16_t* A; const bf16_t* Bt; int M, N, K; };

struct StaticOrder {
    int nM, nN, nwg, G, c;
    __host__ __device__ void init(int M, int N, int G_, int c_) { nM = M / BM; nN = N / BM; nwg = nM * nN; G = G_; c = c_; }
    __host__ __device__ bool next(int i, Unit& u) const {
        const long L = (long)i * G + c; if (L >= nwg) return false;
        int wgid = (int)L; { const int q = nwg / NXCD, r = nwg % NXCD, xcd = wgid % NXCD, off = wgid / NXCD; wgid = (xcd < r ? xcd * (q + 1) : r * (q + 1) + (xcd - r) * q) + off; }
        const int nig = WGM * nN, gid = wgid / nig, fm = gid * WGM, gsz = (nM - fm) < WGM ? (nM - fm) : WGM;
        u.pm = fm + ((wgid % nig) % gsz); u.pn = (wgid % nig) / gsz; return true;
    }
    __device__ __forceinline__ void a_ready(const Unit&) const {}
    __device__ __forceinline__ void done(const Unit&) const {}
};

__device__ __forceinline__ unsigned cvt_pk_bf16(float lo, float hi) { unsigned r; asm volatile("v_cvt_pk_bf16_f32 %0, %1, %2" : "=v"(r) : "v"(lo), "v"(hi)); return r; }

struct EpiF32 {
    static constexpr bool PERM = false, AFTER_DRAIN = false;
    float* C; int ldc;
    __device__ __forceinline__ void operator()(const f32x4 (&acc)[2][2][4][2], const Unit& u, int wr, int wc, int fr, int fq) const {
        const int row0 = u.pm * BM + wr * 64 + fr, col0 = u.pn * BM + wc * 32 + 4 * fq;
#pragma unroll
        for (int ai = 0; ai < 2; ++ai)
#pragma unroll
            for (int m = 0; m < 4; ++m) { float* rowp = C + (size_t)(row0 + ai * HALF + m * 16) * ldc + col0;
#pragma unroll
                for (int bj = 0; bj < 2; ++bj)
#pragma unroll
                    for (int n = 0; n < 2; ++n) *(f32x4*)(rowp + bj * HALF + n * 16) = acc[ai][bj][m][n]; }
    }
};
template <int ACT> struct EpiBf16 {
    static constexpr bool PERM = true, AFTER_DRAIN = false;
    bf16_t* O; int ldc; float* gates; int gate_pn;
    __device__ __forceinline__ void operator()(const f32x4 (&acc)[2][2][4][2], const Unit& u, int wr, int wc, int fr, int fq) const {
        const int row0 = u.pm * BM + wr * 64 + fr; const int col0 = u.pn * BM + wc * 32 + 8 * fq;
        const bool gt = (gates != nullptr) && (u.pn == gate_pn) && (wc == 0) && (fq < 2);
#pragma unroll
        for (int ai = 0; ai < 2; ++ai)
#pragma unroll
            for (int m = 0; m < 4; ++m) { const int row = row0 + ai * HALF + m * 16; bf16_t* rowp = O + (size_t)row * ldc + col0;
#pragma unroll
                for (int bj = 0; bj < 2; ++bj) { f32x4 v0 = acc[ai][bj][m][0], v1 = acc[ai][bj][m][1];
                    if (ACT == 1) {
#pragma unroll
                        for (int j = 0; j < 4; ++j) { const float a = fmaxf(v0[j], 0.f), b = fmaxf(v1[j], 0.f); v0[j] = a * a; v1[j] = b * b; } }
                    u32x4 w; w.x = cvt_pk_bf16(v0[0], v0[1]); w.y = cvt_pk_bf16(v0[2], v0[3]); w.z = cvt_pk_bf16(v1[0], v1[1]); w.w = cvt_pk_bf16(v1[2], v1[3]);
                    *(u32x4*)(rowp + bj * HALF) = w; }
                if (gt) { float* gp = gates + (size_t)row * 16 + 8 * fq; *(f32x4*)gp = acc[ai][0][m][0]; *(f32x4*)(gp + 4) = acc[ai][0][m][1]; } }
    }
};

template <class Epi, class Sched, bool ALIGN_EPI = false, bool SP2 = false>
__device__ __forceinline__ void gemm_phase(PG8_LAS unsigned char* lds, const Gemm g, const Sched& S, const Epi& E, const int tid) {
    const int wid = __builtin_amdgcn_readfirstlane(tid >> 6), lane = tid & 63, wr = wid >> 2, wc = wid & 3, fr = lane & 15, fq = lane >> 4;
    const int K = g.K, nt = K / BK;
    unsigned voffA[2], voffB[2];
#pragma unroll
    for (int i = 0; i < 2; ++i) { int R, C; stage_rc(tid * 16 + i * 8192, R, C); const int Rb = Epi::PERM ? ((R & ~31) + perm32(R & 31)) : R;
        voffA[i] = (unsigned)(R * K + C) * 2u; voffB[i] = (unsigned)(Rb * K + C) * 2u; }
    const size_t kstep = (size_t)(BK * 2);
    const size_t hstep = (size_t)HALF * K * 2;
    const size_t tstep = 2 * hstep;
    const unsigned ldsw = (unsigned)wid * 1024u;
    const int aoff = lds_byte(wr * 64 + fr, fq * 8), boff = lds_byte(wc * 32 + fr, fq * 8);
#define PG8_SA(b, h) (((b) * 2 + (h)) * HTB)
#define PG8_SB(b, h) ((4 + (b) * 2 + (h)) * HTB)
#define PG8_STAGE(bufoff, gbase, voff) do { _Pragma("unroll") for (int _i = 0; _i < 2; ++_i) \
        __builtin_amdgcn_global_load_lds((const unsigned*)((const char*)(gbase) + (voff)[_i]), (PG8_LAS unsigned*)(lds + (bufoff) + ldsw + _i * 8192), 16, 0, 0); } while (0)
#define PG8_LDA(dst, b, h) do { _Pragma("unroll") for (int m = 0; m < 4; ++m) _Pragma("unroll") for (int k = 0; k < 2; ++k) dst[m][k] = *(const PG8_LAS bf16x8*)(lds + PG8_SA(b, h) + aoff + m * 2048 + k * 1024); } while (0)
#define PG8_LDB(dst, b, h) do { _Pragma("unroll") for (int n = 0; n < 2; ++n) _Pragma("unroll") for (int k = 0; k < 2; ++k) dst[n][k] = *(const PG8_LAS bf16x8*)(lds + PG8_SB(b, h) + boff + n * 2048 + k * 1024); } while (0)
#define PG8_MMA(ai, bj, At, Bt) do { __builtin_amdgcn_s_setprio(1); _Pragma("unroll") for (int m = 0; m < 4; ++m) _Pragma("unroll") for (int n = 0; n < 2; ++n) _Pragma("unroll") for (int k = 0; k < 2; ++k) \
        acc[ai][bj][m][n] = __builtin_amdgcn_mfma_f32_16x16x32_bf16(Bt[n][k], At[m][k], acc[ai][bj][m][n], 0, 0, 0); __builtin_amdgcn_s_setprio(0); } while (0)
#define PG8_WAIT_V(n) asm volatile("s_waitcnt vmcnt(" #n ")" ::: "memory")
#define PG8_WAIT_L(n) asm volatile("s_waitcnt lgkmcnt(" #n ")" ::: "memory")
#define PG8_BAR __builtin_amdgcn_s_barrier()
#define PG8_SCHED __builtin_amdgcn_sched_barrier(0)
    Unit cur, nxt; int ui = 0;
    if (!S.next(0, cur)) return;
    f32x4 acc[2][2][4][2];
#pragma unroll
    for (int a = 0; a < 2; ++a)
#pragma unroll
        for (int b = 0; b < 2; ++b)
#pragma unroll
            for (int m = 0; m < 4; ++m)
#pragma unroll
                for (int n = 0; n < 2; ++n) acc[a][b][m][n] = (f32x4){0.f, 0.f, 0.f, 0.f};
    bf16x8 At[4][2], B0[2][2], B1[2][2];
    const char* cA = (const char*)g.A + (size_t)cur.pm * tstep; const char* cB = (const char*)g.Bt + (size_t)cur.pn * tstep;
    S.a_ready(cur);
    if constexpr (SP2) {
        PG8_STAGE(PG8_SB(0, 0), cB, voffB); PG8_STAGE(PG8_SB(0, 1), cB + hstep, voffB); PG8_STAGE(PG8_SA(0, 0), cA, voffA); PG8_STAGE(PG8_SA(0, 1), cA + hstep, voffA);
        if (wr == 1) PG8_BAR;
        PG8_WAIT_V(2); PG8_BAR;
        PG8_STAGE(PG8_SB(1, 0), cB + kstep, voffB); PG8_STAGE(PG8_SA(1, 0), cA + kstep, voffA); PG8_STAGE(PG8_SB(1, 1), cB + hstep + kstep, voffB);
        PG8_WAIT_V(6); PG8_BAR;
    } else {
        PG8_STAGE(PG8_SB(0, 0), cB, voffB); PG8_STAGE(PG8_SA(0, 0), cA, voffA); PG8_STAGE(PG8_SB(0, 1), cB + hstep, voffB); PG8_STAGE(PG8_SA(0, 1), cA + hstep, voffA);
        if (wr == 1) PG8_BAR;
        PG8_WAIT_V(4); PG8_BAR;
        PG8_STAGE(PG8_SB(1, 0), cB + kstep, voffB); PG8_STAGE(PG8_SA(1, 0), cA + kstep, voffA); PG8_STAGE(PG8_SB(1, 1), cB + hstep + kstep, voffB);
        PG8_WAIT_V(6); PG8_BAR;
    }
    for (;;) {
        const bool has_next = S.next(ui + 1, nxt);
        const char* nA = has_next ? (const char*)g.A + (size_t)nxt.pm * tstep : cA; const char* nB = has_next ? (const char*)g.Bt + (size_t)nxt.pn * tstep : cB;
        for (int t = 0; t < nt; t += 2) {
            const bool last = (t == nt - 2);
            const char* a1 = cA + (size_t)(t + 1) * kstep;
            const char* a2 = last ? nA : cA + (size_t)(t + 2) * kstep; const char* b2 = last ? nB : cB + (size_t)(t + 2) * kstep;
            const char* a3 = a2 + kstep; const char* b3 = b2 + kstep;
            if (last && has_next) S.a_ready(nxt);
            if constexpr (SP2) {
            PG8_LDB(B0, 0, 0); PG8_LDB(B1, 0, 1); PG8_SCHED; PG8_LDA(At, 0, 0); PG8_STAGE(PG8_SA(1, 1), a1 + hstep, voffA);
            PG8_WAIT_V(8); PG8_WAIT_L(0); PG8_BAR; PG8_MMA(0, 0, At, B0); PG8_MMA(0, 1, At, B1); PG8_BAR; PG8_SCHED;
            PG8_LDA(At, 0, 1); PG8_STAGE(PG8_SB(0, 0), b2, voffB); PG8_STAGE(PG8_SB(0, 1), b2 + hstep, voffB); PG8_STAGE(PG8_SA(0, 0), a2, voffA);
            PG8_WAIT_V(8); PG8_WAIT_L(0); PG8_BAR; PG8_MMA(1, 0, At, B0); PG8_MMA(1, 1, At, B1); PG8_BAR; PG8_SCHED;
            PG8_LDB(B0, 1, 0); PG8_LDB(B1, 1, 1); PG8_SCHED; PG8_LDA(At, 1, 0); PG8_STAGE(PG8_SA(0, 1), a2 + hstep, voffA);
            PG8_WAIT_V(8); PG8_WAIT_L(0); PG8_BAR; PG8_MMA(0, 0, At, B0); PG8_MMA(0, 1, At, B1); PG8_BAR; PG8_SCHED;
            PG8_LDA(At, 1, 1); PG8_STAGE(PG8_SB(1, 0), b3, voffB); PG8_STAGE(PG8_SB(1, 1), b3 + hstep, voffB); PG8_STAGE(PG8_SA(1, 0), a3, voffA);
            PG8_WAIT_V(8); PG8_WAIT_L(0); PG8_BAR; PG8_MMA(1, 0, At, B0); PG8_MMA(1, 1, At, B1); PG8_BAR; PG8_SCHED;
            } else {
            PG8_LDB(B0, 0, 0); PG8_SCHED; PG8_LDA(At, 0, 0); PG8_STAGE(PG8_SA(1, 1), a1 + hstep, voffA);
            PG8_WAIT_L(8); PG8_BAR; PG8_WAIT_L(0); PG8_MMA(0, 0, At, B0); PG8_BAR; PG8_SCHED;
            PG8_LDB(B1, 0, 1); PG8_STAGE(PG8_SB(0, 0), b2, voffB);
            PG8_BAR; PG8_WAIT_L(0); PG8_MMA(0, 1, At, B1); PG8_BAR;
            PG8_LDA(At, 0, 1); PG8_STAGE(PG8_SA(0, 0), a2, voffA);
            PG8_BAR; PG8_WAIT_L(0); PG8_MMA(1, 0, At, B0); PG8_BAR; PG8_SCHED;
            PG8_STAGE(PG8_SB(0, 1), b2 + hstep, voffB);
            PG8_WAIT_V(6); PG8_BAR; PG8_MMA(1, 1, At, B1); PG8_BAR;
            PG8_LDB(B0, 1, 0); PG8_SCHED; PG8_LDA(At, 1, 0); PG8_STAGE(PG8_SA(0, 1), a2 + hstep, voffA);
            PG8_WAIT_L(8); PG8_BAR; PG8_WAIT_L(0); PG8_MMA(0, 0, At, B0); PG8_BAR; PG8_SCHED;
            PG8_LDB(B1, 1, 1); PG8_STAGE(PG8_SB(1, 0), b3, voffB);
            PG8_BAR; PG8_WAIT_L(0); PG8_MMA(0, 1, At, B1); PG8_BAR;
            PG8_LDA(At, 1, 1); PG8_STAGE(PG8_SA(1, 0), a3, voffA);
            PG8_BAR; PG8_WAIT_L(0); PG8_MMA(1, 0, At, B0); PG8_BAR; PG8_SCHED;
            PG8_STAGE(PG8_SB(1, 1), b3 + hstep, voffB);
            PG8_WAIT_V(6); PG8_BAR; PG8_MMA(1, 1, At, B1); PG8_BAR;
            }
        }
        if constexpr (ALIGN_EPI) { if (wr == 0) PG8_BAR; }
        E(acc, cur, wr, wc, fr, fq); S.done(cur);
        if (!has_next) break;
#pragma unroll
        for (int a = 0; a < 2; ++a)
#pragma unroll
            for (int b = 0; b < 2; ++b)
#pragma unroll
                for (int m = 0; m < 4; ++m)
#pragma unroll
                    for (int n = 0; n < 2; ++n) acc[a][b][m][n] = (f32x4){0.f, 0.f, 0.f, 0.f};
        cur = nxt; cA = nA; cB = nB; ++ui;
        if constexpr (ALIGN_EPI) { if (wr == 1) PG8_BAR; }
    }
    PG8_WAIT_V(0);
    if constexpr (!ALIGN_EPI) { if (wr == 0) PG8_BAR; }
    PG8_BAR;
#undef PG8_SA
#undef PG8_SB
#undef PG8_STAGE
#undef PG8_LDA
#undef PG8_LDB
#undef PG8_MMA
#undef PG8_WAIT_V
#undef PG8_WAIT_L
#undef PG8_BAR
#undef PG8_SCHED
}
}

constexpr int NWAVES = 8, NTHR = 512;
constexpr int D = 2048, FF = 8192, PLE = 256;
constexpr int TP = 2048, BP = 4, TS = 4, BS = 128;
constexpr int MP = BP * TP, MS = BS * TS, M = MP + MS;
constexpr int NPROJ = 6160, NPROJ_PAD = 6400;
constexpr int NH = 8;
constexpr float LN_EPS = 1e-5f, RMS_EPS = 1e-6f;
constexpr float DN_ALPHA = 1.41421356237f;

constexpr size_t MiB = 1u << 20;
constexpr size_t WS_CTL = 0;
constexpr size_t WS_WINE = 1 * MiB;
constexpr size_t WS_WOUTE = WS_WINE + 25 * MiB;
constexpr size_t WS_WINO = WS_WOUTE + 8 * MiB;
constexpr size_t WS_WOUTO = WS_WINO + 25 * MiB;
constexpr size_t WS_WUP = WS_WOUTO + 8 * MiB;
constexpr size_t WS_WDOWN = WS_WUP + 64 * MiB;
constexpr size_t WS_WPLE = WS_WDOWN + 64 * MiB;
constexpr size_t WS_WGATE = WS_WPLE + 2 * MiB;
constexpr size_t WS_XB = WS_WGATE + 16 * MiB;
constexpr size_t WS_MIX = WS_XB + 34 * MiB;
constexpr size_t WS_H = WS_MIX + 34 * MiB;
constexpr size_t WS_H2 = WS_H + 34 * MiB;
constexpr size_t WS_PW = WS_H2 + 34 * MiB;
constexpr size_t WS_PB = WS_PW + 34 * MiB;
constexpr size_t WS_GATES = WS_PB + 9 * MiB;
constexpr size_t WS_PROJ = WS_GATES + 1 * MiB;
constexpr size_t WS_PART0 = WS_PROJ + 136 * MiB;
constexpr size_t WS_PART1 = WS_PART0 + 68 * MiB;
constexpr size_t WS_END = WS_PART1 + 68 * MiB;

constexpr size_t O_Y = 0;
constexpr size_t O_CONVP = (size_t)M * D;
constexpr size_t O_DELTAP = O_CONVP + (size_t)BP * 3 * 4096;
constexpr size_t O_LRUP = O_DELTAP + (size_t)BP * 8 * 128 * 128;
constexpr size_t O_MCP = O_LRUP + (size_t)BP * 1024;
constexpr size_t O_MNP = O_MCP + (size_t)BP * 8 * 256 * 128;
constexpr size_t O_MMP = O_MNP + (size_t)BP * 8 * 128;
constexpr size_t O_CONVS = O_MMP + (size_t)BP * 8;
constexpr size_t O_DELTAS = O_CONVS + (size_t)BS * 3 * 4096;
constexpr size_t O_LRUS = O_DELTAS + (size_t)BS * 8 * 128 * 128;
constexpr size_t O_MCS = O_LRUS + (size_t)BS * 1024;
constexpr size_t O_MNS = O_MCS + (size_t)BS * 8 * 256 * 128;
constexpr size_t O_MMS = O_MNS + (size_t)BS * 8 * 128;
constexpr size_t O_END = O_MMS + (size_t)BS * 8;

constexpr int LDS_BYTES = 147456;
constexpr int LDS_CTL_OFF = 131072;

#define LAS __attribute__((address_space(3)))
typedef unsigned short bf16;
typedef unsigned v4u __attribute__((ext_vector_type(4)));
typedef unsigned v2u __attribute__((ext_vector_type(2)));
typedef float f32x4 __attribute__((ext_vector_type(4)));
#define LDS_WAIT() asm volatile("s_waitcnt lgkmcnt(0)" ::: "memory")
__device__ __forceinline__ unsigned f2bf(float f) { unsigned u = __builtin_bit_cast(unsigned, f); return (u + 0x7fffu + ((u >> 16) & 1u)) >> 16; }
__device__ __forceinline__ unsigned pk2(float lo, float hi) { return f2bf(lo) | (f2bf(hi) << 16); }
__device__ __forceinline__ float bf2f(unsigned short b) { return __builtin_bit_cast(float, ((unsigned)b) << 16); }
__device__ __forceinline__ float bflo(unsigned w) { return __builtin_bit_cast(float, w << 16); }
__device__ __forceinline__ float bfhi(unsigned w) { return __builtin_bit_cast(float, w & 0xffff0000u); }
__device__ __forceinline__ float sigm(float x) { return 1.f / (1.f + expf(-x)); }
__device__ __forceinline__ float siluf(float x) { return x * sigm(x); }
__device__ __forceinline__ float softplusf(float x) { return fmaxf(x, 0.f) + log1pf(expf(-fabsf(x))); }
__device__ __forceinline__ float logsigf(float x) { return -softplusf(-x); }
__device__ __forceinline__ float gelu_tanh(float x) { const float u = 0.7978845608028654f * (x + 0.044715f * x * x * x); return 0.5f * x * (1.f + tanhf(u)); }
__device__ __forceinline__ float wave_sum(float v) {
#pragma unroll
    for (int o = 1; o < 64; o <<= 1) v += __shfl_xor(v, o);
    return v;
}

#define XB_TMO      128
#define XB_XCNT(j)  (256  + 64 * (j))
#define XB_XSUB(j)  (1280 + 64 * (j))
#define XB_XGEN(j)  (2304 + 64 * (j))
#define XB_TOP      3328
#define XB_TOPGEN   3392
#define XCD_BAR_WORDS 3456
#define XB_SPIN_CAP (1u << 22)
__device__ __forceinline__ unsigned xb_ld(unsigned* p)              { return __hip_atomic_load(p, __ATOMIC_RELAXED, __HIP_MEMORY_SCOPE_AGENT); }
__device__ __forceinline__ unsigned xb_add(unsigned* p, unsigned v) { return __hip_atomic_fetch_add(p, v, __ATOMIC_RELAXED, __HIP_MEMORY_SCOPE_AGENT); }
__device__ __forceinline__ unsigned xb_xcc_id() { return (unsigned)__builtin_amdgcn_s_getreg((3 << 11) | 20) & 0xFu; }
#define XB_SPIN(cond, bar) do { unsigned _sp = 0; while (cond) { __builtin_amdgcn_s_sleep(1); \
    if ((++_sp & 255u) == 0u) { if (xb_ld(&(bar)[XB_TMO])) break; if (_sp > XB_SPIN_CAP) { atomicAdd(&(bar)[XB_TMO], 1u); break; } } } } while (0)
struct XcdBarrier { unsigned* bar; unsigned x; volatile LAS unsigned* st; };
__device__ __forceinline__ XcdBarrier xcd_barrier_post(unsigned* bar, volatile LAS unsigned* st) {
    XcdBarrier b; b.bar = bar; b.x = xb_xcc_id(); b.st = st;
    if (threadIdx.x == 0) (void)xb_add(&bar[XB_XCNT(b.x)], 1u);
    return b;
}
__device__ __forceinline__ void xcd_barrier_complete(unsigned* bar, unsigned x, unsigned& nloc, unsigned& nx) {
    const unsigned G = gridDim.x * gridDim.y * gridDim.z;
    unsigned sum, cnt, mine, sp = 0u;
    for (;;) {
        sum = 0u; cnt = 0u; mine = 0u;
#pragma unroll
        for (unsigned j = 0; j < 16; ++j) { const unsigned c = xb_ld(&bar[XB_XCNT(j)]); sum += c; cnt += (c > 0u) ? 1u : 0u; mine = (j == x) ? c : mine; }
        if (sum == G) break;
        __builtin_amdgcn_s_sleep(1);
        if ((++sp & 255u) == 0u) { if (xb_ld(&bar[XB_TMO])) break; if (sp > XB_SPIN_CAP) { atomicAdd(&bar[XB_TMO], 1u); break; } }
    }
    nloc = mine > 0u ? mine : 1u; nx = cnt > 0u ? cnt : 1u;
}
__device__ __forceinline__ void xcd_barrier(const XcdBarrier& b) {
    asm volatile("s_waitcnt vmcnt(0)" ::: "memory");
    __syncthreads();
    if (threadIdx.x == 0) {
        unsigned* bar = b.bar;
        __builtin_amdgcn_s_waitcnt(0);
        unsigned nloc = b.st[0], nx = b.st[1];
        if (nloc == 0u) { xcd_barrier_complete(bar, b.x, nloc, nx); b.st[0] = nloc; b.st[1] = nx; }
        const unsigned old = xb_add(&bar[XB_XSUB(b.x)], 1u);
        const unsigned gen = old / nloc;
        if (old + 1u == (gen + 1u) * nloc) {
            __builtin_amdgcn_fence(__ATOMIC_RELEASE, "agent");
            asm volatile("s_waitcnt vmcnt(0)" ::: "memory");
            const unsigned og = xb_add(&bar[XB_TOP], 1u);
            const unsigned tg = og / nx;
            if (og + 1u == (tg + 1u) * nx) xb_add(&bar[XB_TOPGEN], 1u);
            else XB_SPIN(xb_ld(&bar[XB_TOPGEN]) == tg, bar);
            __builtin_amdgcn_fence(__ATOMIC_ACQUIRE, "agent");
            xb_add(&bar[XB_XGEN(b.x)], 1u);
            asm volatile("s_waitcnt vmcnt(0)" ::: "memory");
        } else {
            XB_SPIN(xb_ld(&bar[XB_XGEN(b.x)]) == gen, bar);
            __builtin_amdgcn_fence(__ATOMIC_ACQUIRE, "agent");
            asm volatile("s_waitcnt vmcnt(0)" ::: "memory");
        }
    }
    __syncthreads();
}

struct Args { const float* in[35]; float* out; unsigned char* ws; int ph_lo, ph_hi; };
typedef const __attribute__((address_space(4))) Args* ArgsP;
enum { I_XP = 0, I_XS, I_PP, I_PS, I_SCONV, I_SDELTA, I_SLRU, I_SMC, I_SMN, I_SMM, I_WINE, I_WCONV, I_BCONV, I_ALOG, I_DTB, I_DNORM, I_LWR, I_LBR, I_LWI, I_LBI, I_LLAM, I_WOUTE,
       I_WINO, I_BIG, I_BFG, I_MNORM, I_WOUTO, I_LN1G, I_LN1B, I_LN2G, I_LN2B, I_WUP, I_WDOWN, I_WPLE, I_WGATE };

__device__ __forceinline__ void p0_transpose_item(const float* W, int K, int N, int Npad, bf16* WT, LAS float* scr, int item, int lane) {
    const int nblk = Npad / 32, kb = item / nblk, nb = item % nblk, k0 = 64 * kb, n0 = 32 * nb;
    const int nn = n0 + (lane & 31); const bool ok = nn < N;
#pragma unroll 8
    for (int i = 0; i < 32; ++i) { const int kk = 2 * i + (lane >> 5); scr[kk * 33 + (lane & 31)] = ok ? W[(size_t)(k0 + kk) * N + nn] : 0.f; }
    LDS_WAIT(); asm volatile("" ::: "memory");
    const int c = lane & 7;
#pragma unroll
    for (int j = 0; j < 4; ++j) { const int n = (lane >> 3) + 8 * j; const LAS float* s = scr + (8 * c) * 33 + n;
        v4u o; o.x = pk2(s[0 * 33], s[1 * 33]); o.y = pk2(s[2 * 33], s[3 * 33]); o.z = pk2(s[4 * 33], s[5 * 33]); o.w = pk2(s[6 * 33], s[7 * 33]);
        *(v4u*)(WT + (size_t)(n0 + n) * K + k0 + 8 * c) = o; }
    LDS_WAIT(); asm volatile("" ::: "memory");
}
__device__ __forceinline__ void row_to_bf16(const float* src, bf16* dst, int n, int lane) {
    for (int j = 0; j < n / 256; ++j) { const f32x4 v = *(const f32x4*)(src + j * 256 + lane * 4); v2u o; o.x = pk2(v.x, v.y); o.y = pk2(v.z, v.w); *(v2u*)(dst + j * 256 + lane * 4) = o; }
}

__device__ __forceinline__ void phase_convert(ArgsP a, LAS unsigned char* lds, int gw, int NGW, int wave, int lane) {
    unsigned char* ws = a->ws;
    LAS float* scr = (LAS float*)(lds + wave * 16384);
    constexpr int I_IN = (D / 64) * (NPROJ_PAD / 32), I_SQ = (D / 64) * (D / 32), I_UP = (D / 64) * (FF / 32), I_DN = (FF / 64) * (D / 32), I_PL = (PLE / 64) * (D / 32);
    constexpr int NITEMS = 2 * I_IN + 2 * I_SQ + 2 * I_UP + 2 * I_DN + 2 * I_PL + 2 * I_SQ;
    for (int it = gw; it < NITEMS; it += NGW) {
        int r = it;
        if (r < I_IN) { p0_transpose_item(a->in[I_WINE], D, NPROJ, NPROJ_PAD, (bf16*)(ws + WS_WINE), scr, r, lane); continue; } r -= I_IN;
        if (r < I_IN) { p0_transpose_item(a->in[I_WINO], D, NPROJ, NPROJ_PAD, (bf16*)(ws + WS_WINO), scr, r, lane); continue; } r -= I_IN;
        if (r < I_SQ) { p0_transpose_item(a->in[I_WOUTE], D, D, D, (bf16*)(ws + WS_WOUTE), scr, r, lane); continue; } r -= I_SQ;
        if (r < I_SQ) { p0_transpose_item(a->in[I_WOUTO], D, D, D, (bf16*)(ws + WS_WOUTO), scr, r, lane); continue; } r -= I_SQ;
        if (r < 2 * I_UP) { const int l = r / I_UP; p0_transpose_item(a->in[I_WUP] + (size_t)l * D * FF, D, FF, FF, (bf16*)(ws + WS_WUP) + (size_t)l * D * FF, scr, r % I_UP, lane); continue; } r -= 2 * I_UP;
        if (r < 2 * I_DN) { const int l = r / I_DN; p0_transpose_item(a->in[I_WDOWN] + (size_t)l * D * FF, FF, D, D, (bf16*)(ws + WS_WDOWN) + (size_t)l * D * FF, scr, r % I_DN, lane); continue; } r -= 2 * I_DN;
        if (r < 2 * I_PL) { const int l = r / I_PL; p0_transpose_item(a->in[I_WPLE] + (size_t)l * PLE * D, PLE, D, D, (bf16*)(ws + WS_WPLE) + (size_t)l * PLE * D, scr, r % I_PL, lane); continue; } r -= 2 * I_PL;
        { const int l = r / I_SQ; p0_transpose_item(a->in[I_WGATE] + (size_t)l * D * D, D, D, D, (bf16*)(ws + WS_WGATE) + (size_t)l * D * D, scr, r % I_SQ, lane); }
    }
    bf16* xb = (bf16*)(ws + WS_XB);
    for (int m = gw; m < M; m += NGW) {
        const float* src = m < MP ? a->in[I_XP] + (size_t)m * D : a->in[I_XS] + (size_t)(m - MP) * D;
        row_to_bf16(src, xb + (size_t)m * D, D, lane);
    }
    bf16* pb = (bf16*)(ws + WS_PB);
    for (int r = gw; r < 2 * M; r += NGW) {
        const int l = r / M, m = r % M;
        const float* src = m < MP ? a->in[I_PP] + ((size_t)l * MP + m) * PLE : a->in[I_PS] + ((size_t)l * MS + (m - MP)) * PLE;
        row_to_bf16(src, pb + (size_t)r * PLE, PLE, lane);
    }
}

__device__ __forceinline__ float conv_in(const bf16* proj, int row0, int tq, int ch, const float* cstate) {
    if (tq >= 0) return bf2f(proj[(size_t)(row0 + tq) * NPROJ_PAD + ch]);
    return cstate ? cstate[(3 + tq) * 4096 + ch] : 0.f;
}
__device__ __forceinline__ float conv4(const bf16* proj, int row0, int t, int ch, const float* cstate, const float* wconv, const float* bconv) {
    float acc = bconv[ch];
#pragma unroll
    for (int j = 0; j < 4; ++j) acc += wconv[j * 4096 + ch] * conv_in(proj, row0, t - 3 + j, ch, cstate);
    return acc;
}

__device__ __forceinline__ void delta_rec_item(ArgsP a, LAS unsigned char* lds, int row0, int T, int h, const float* cstate, const float* S0, float* Sout, const int tid) {
    const int lane = tid & 63, wave = tid >> 6, c = tid & 127, r = tid >> 7;
    const bf16* proj = (const bf16*)(a->ws + WS_PROJ); const float* gates = (const float*)(a->ws + WS_GATES); bf16* mix = (bf16*)(a->ws + WS_MIX);
    const float* wconv = a->in[I_WCONV]; const float* bconv = a->in[I_BCONV];
    LAS float* act = (LAS float*)lds;
    LAS float* nrm = act + 4 * 384;
    LAS float* gb = nrm + 8;
    LAS float* red = gb + 8;
    LAS float* red2 = red + 512;
    LAS float* obuf = red2 + 512;
    float s[32];
#pragma unroll
    for (int i = 0; i < 32; ++i) s[i] = S0 ? S0[(size_t)(32 * r + i) * 128 + c] : 0.f;
    const float aexp = expf(a->in[I_ALOG][h]), dtb = a->in[I_DTB][h];
#pragma unroll 1
    for (int t0 = 0; t0 < T; t0 += 4) {
#pragma unroll
        for (int j = 0; j < 3; ++j) { const int idx = tid + 512 * j, tok = idx / 384, chl = idx % 384, part = chl >> 7, i = chl & 127;
            const int ch = part * 1024 + h * 128 + i;
            act[tok * 384 + chl] = siluf(conv4(proj, row0, t0 + tok, ch, cstate, wconv, bconv)); }
        __syncthreads();
        { const int tok = wave >> 1, part = wave & 1; const float x0 = act[tok * 384 + part * 128 + lane], x1 = act[tok * 384 + part * 128 + 64 + lane];
          const float ss = wave_sum(x0 * x0 + x1 * x1); if (lane == 0) nrm[tok * 2 + part] = rsqrtf(ss + 1e-6f) * (part == 0 ? 0.08838834764831845f : 1.f); }
        if (tid < 4) { const int row = row0 + t0 + tid; const float g = -aexp * softplusf(gates[(size_t)row * 16 + h] + dtb); gb[tid * 2] = expf(g); gb[tid * 2 + 1] = sigm(gates[(size_t)row * 16 + 8 + h]); }
        __syncthreads();
#pragma unroll 1
        for (int tok = 0; tok < 4; ++tok) {
            const float eg = gb[tok * 2], beta = gb[tok * 2 + 1], nq = nrm[tok * 2], nk = nrm[tok * 2 + 1];
            const LAS float* qv = act + tok * 384 + 32 * r; const LAS float* kv = qv + 128;
            float ks = 0.f;
#pragma unroll
            for (int i = 0; i < 32; ++i) ks += kv[i] * s[i];
            red[r * 128 + c] = ks * nk;
            __syncthreads();
            const float kS = red[c] + red[128 + c] + red[256 + c] + red[384 + c];
            const float vnew = beta * (act[tok * 384 + 256 + c] - eg * kS);
            float os = 0.f;
#pragma unroll
            for (int i = 0; i < 32; ++i) { s[i] = eg * s[i] + (kv[i] * nk) * vnew; os += qv[i] * s[i]; }
            red2[r * 128 + c] = os * nq;
            __syncthreads();
            if (r == 0) obuf[tok * 128 + c] = red2[c] + red2[128 + c] + red2[256 + c] + red2[384 + c];
        }
        __syncthreads();
        if (wave < 4) { const int tok = wave, row = row0 + t0 + tok; const float o0 = obuf[tok * 128 + lane], o1 = obuf[tok * 128 + 64 + lane];
            const float rstd = rsqrtf(wave_sum(o0 * o0 + o1 * o1) * (1.f / 128.f) + RMS_EPS);
            const float* nw = a->in[I_DNORM];
            const float z0 = bf2f(proj[(size_t)row * NPROJ_PAD + 4096 + h * 128 + lane]), z1 = bf2f(proj[(size_t)row * NPROJ_PAD + 4096 + h * 128 + 64 + lane]);
            mix[(size_t)row * D + h * 128 + lane] = (bf16)f2bf(o0 * rstd * nw[lane] * siluf(z0));
            mix[(size_t)row * D + h * 128 + 64 + lane] = (bf16)f2bf(o1 * rstd * nw[64 + lane] * siluf(z1)); }
        __syncthreads();
    }
#pragma unroll
    for (int i = 0; i < 32; ++i) Sout[(size_t)(32 * r + i) * 128 + c] = s[i];
}

__device__ __forceinline__ void lru_rec_item(ArgsP a, LAS unsigned char* lds, int row0, int T, int n, const float* cstate, const float* h0, float* hout, const int tid) {
    const int d = tid & 127, part = tid >> 7;
    const bf16* proj = (const bf16*)(a->ws + WS_PROJ); bf16* mix = (bf16*)(a->ws + WS_MIX);
    const float* wconv = a->in[I_WCONV]; const float* bconv = a->in[I_BCONV];
    const float* wr = a->in[I_LWR] + (size_t)n * 16384; const float* wi = a->in[I_LWI] + (size_t)n * 16384;
    LAS float* xr = (LAS float*)lds;
    LAS float* red = xr + 512;
    const int chn = n * 128 + d;
    float hst = h0 ? h0[chn] : 0.f;
    const float br = a->in[I_LBR][chn], bi = a->in[I_LBI][chn], spl = softplusf(-a->in[I_LLAM][chn]);
#pragma unroll 1
    for (int t0 = 0; t0 < T; t0 += 4) {
        { const int tok = tid >> 7; xr[tok * 128 + d] = conv4(proj, row0, t0 + tok, 3072 + chn, cstate, wconv, bconv); }
        __syncthreads();
        float ar[4] = {0.f, 0.f, 0.f, 0.f}, ai[4] = {0.f, 0.f, 0.f, 0.f};
#pragma unroll 4
        for (int cc = 0; cc < 32; ++cc) { const int c = part * 32 + cc; const float w1 = wr[c * 128 + d], w2 = wi[c * 128 + d];
#pragma unroll
        for (int tok = 0; tok < 4; ++tok) { const float x = xr[tok * 128 + c]; ar[tok] += x * w1; ai[tok] += x * w2; } }
#pragma unroll
        for (int tok = 0; tok < 4; ++tok) { red[((tok * 2 + 0) * 4 + part) * 128 + d] = ar[tok]; red[((tok * 2 + 1) * 4 + part) * 128 + d] = ai[tok]; }
        __syncthreads();
        if (part == 0) {
    #pragma unroll 1
        for (int tok = 0; tok < 4; ++tok) {
                const int row = row0 + t0 + tok;
                float rp = br, ip = bi;
#pragma unroll
                for (int p = 0; p < 4; ++p) { rp += red[((tok * 2 + 0) * 4 + p) * 128 + d]; ip += red[((tok * 2 + 1) * 4 + p) * 128 + d]; }
                const float log_a = -8.f * sigm(rp) * spl;
                const float av = expf(log_a);
                const float bx = sqrtf(-expm1f(2.f * log_a)) * sigm(ip) * xr[tok * 128 + d];
                hst = av * hst + bx;
                const float gate = bf2f(proj[(size_t)row * NPROJ_PAD + 5120 + chn]);
                mix[(size_t)row * D + 1024 + chn] = (bf16)f2bf(hst * gelu_tanh(gate));
            }
        }
        __syncthreads();
    }
    if (part == 0) hout[chn] = hst;
}

__device__ __forceinline__ void mlstm_rec_item(ArgsP a, LAS unsigned char* lds, int row0, int T, int h, const float* C0, const float* n0, const float* m0, float* Cout, float* nout, float* mout, const int tid) {
    const int lane = tid & 63, wave = tid >> 6, v = tid & 255, kh = tid >> 8;
    const bf16* proj = (const bf16*)(a->ws + WS_PROJ); const float* gates = (const float*)(a->ws + WS_GATES); bf16* mix = (bf16*)(a->ws + WS_MIX);
    LAS float* qs = (LAS float*)lds;
    LAS float* ks = qs + 512;
    LAS float* vs = ks + 512;
    LAS float* gs = vs + 1024;
    LAS float* red = gs + 8;
    LAS float* dred = red + 1024;
    LAS float* hbuf = dred + 4;
    float cst[64];
#pragma unroll
    for (int i = 0; i < 64; ++i) cst[i] = C0 ? C0[(size_t)v * 128 + 64 * kh + i] : 0.f;
    float nst = (tid < 128) ? (n0 ? n0[tid] : 0.f) : 0.f;
    float mst = m0 ? m0[0] : 0.f;
    const float big = a->in[I_BIG][h], bfg = a->in[I_BFG][h];
#pragma unroll 1
    for (int t0 = 0; t0 < T; t0 += 4) {
#pragma unroll
        for (int j = 0; j < 4; ++j) { const int tok = j, row = row0 + t0 + tok; const bf16* pr = proj + (size_t)row * NPROJ_PAD;
            float val;
            if (tid < 128) val = bf2f(pr[h * 128 + tid]); else if (tid < 256) val = bf2f(pr[1024 + h * 128 + (tid - 128)]) * 0.08838834764831845f; else val = bf2f(pr[2048 + h * 256 + (tid - 256)]);
            if (tid < 128) qs[tok * 128 + tid] = val; else if (tid < 256) ks[tok * 128 + tid - 128] = val; else vs[tok * 256 + tid - 256] = val; }
        if (tid < 4) { const int row = row0 + t0 + tid; gs[tid * 2] = gates[(size_t)row * 16 + h] + big; gs[tid * 2 + 1] = gates[(size_t)row * 16 + 8 + h] + bfg; }
        __syncthreads();
#pragma unroll 1
        for (int tok = 0; tok < 4; ++tok) {
            const int par = tok & 1;
            const float ig = gs[tok * 2], lf = logsigf(gs[tok * 2 + 1]);
            const float mnew = fmaxf(lf + mst, ig), fp = expf(lf + mst - mnew), ip = expf(ig - mnew); mst = mnew;
            const float vv = vs[tok * 256 + v] * ip;
            const LAS float* kv = ks + tok * 128 + 64 * kh; const LAS float* qv = qs + tok * 128 + 64 * kh;
            float num = 0.f;
#pragma unroll
            for (int i = 0; i < 64; ++i) { cst[i] = fp * cst[i] + vv * kv[i]; num += cst[i] * qv[i]; }
            red[(par * 2 + kh) * 256 + v] = num;
            if (tid < 128) { nst = fp * nst + ip * ks[tok * 128 + tid]; const float dp = wave_sum(nst * qs[tok * 128 + tid]); if (lane == 0) dred[par * 2 + wave] = dp; }
            __syncthreads();
            if (kh == 0) { const float nm = red[(par * 2) * 256 + v] + red[(par * 2 + 1) * 256 + v]; const float den = dred[par * 2] + dred[par * 2 + 1];
                hbuf[tok * 256 + v] = nm / fmaxf(fabsf(den), expf(-mnew)); }
        }
        __syncthreads();
        if (wave < 4) { const int tok = wave, row = row0 + t0 + tok; float hv[4]; float ss = 0.f;
#pragma unroll
            for (int j = 0; j < 4; ++j) { hv[j] = hbuf[tok * 256 + j * 64 + lane]; ss += hv[j] * hv[j]; }
            const float rstd = rsqrtf(wave_sum(ss) * (1.f / 256.f) + RMS_EPS);
            const float* nw = a->in[I_MNORM] + h * 256;
#pragma unroll
            for (int j = 0; j < 4; ++j) { const int vi = j * 64 + lane; const float op = bf2f(proj[(size_t)row * NPROJ_PAD + 4096 + h * 256 + vi]);
                mix[(size_t)row * D + h * 256 + vi] = (bf16)f2bf(hv[j] * rstd * nw[vi] * sigm(op)); } }
        __syncthreads();
    }
#pragma unroll
    for (int i = 0; i < 64; ++i) Cout[(size_t)v * 128 + 64 * kh + i] = cst[i];
    if (tid < 128) nout[tid] = nst;
    if (tid == 0) mout[0] = mst;
}

__device__ __forceinline__ void phase_mixer_even(ArgsP a, LAS unsigned char* lds, int vcu, int G, const int tid) {
    const int NIT = 64 + 2048;
#pragma unroll 1
    for (int it = vcu; it < NIT; it += G) {
        int kind, row0, T, hn; const float* cst; const float* st0; float* sto;
        if (it < 32) { const int b = it >> 3; hn = it & 7; kind = 0; row0 = b * TP; T = TP; cst = nullptr; st0 = nullptr; sto = a->out + O_DELTAP + (size_t)it * 16384; }
        else if (it < 64) { const int j = it - 32, b = j >> 3; hn = j & 7; kind = 1; row0 = b * TP; T = TP; cst = nullptr; st0 = nullptr; sto = a->out + O_LRUP + (size_t)b * 1024; }
        else if (it < 64 + 1024) { const int j = it - 64, b = j >> 3; hn = j & 7; kind = 0; row0 = MP + b * TS; T = TS; cst = a->in[I_SCONV] + (size_t)b * 3 * 4096; st0 = a->in[I_SDELTA] + (size_t)j * 16384; sto = a->out + O_DELTAS + (size_t)j * 16384; }
        else { const int j = it - 64 - 1024, b = j >> 3; hn = j & 7; kind = 1; row0 = MP + b * TS; T = TS; cst = a->in[I_SCONV] + (size_t)b * 3 * 4096; st0 = a->in[I_SLRU] + (size_t)b * 1024; sto = a->out + O_LRUS + (size_t)b * 1024; }
        if (kind == 0) delta_rec_item(a, lds, row0, T, hn, cst, st0, sto, tid);
        else lru_rec_item(a, lds, row0, T, hn, cst, st0, sto, tid);
    }
    const bf16* proj = (const bf16*)(a->ws + WS_PROJ);
    const int nconv = (BP + BS) * 3 * 4096;
    for (int i = vcu * NTHR + tid; i < nconv; i += G * NTHR) {
        const int ch = i & 4095, rj = i >> 12, j = rj % 3, b = rj / 3;
        if (b < BP) a->out[O_CONVP + (size_t)(b * 3 + j) * 4096 + ch] = bf2f(proj[(size_t)(b * TP + TP - 3 + j) * NPROJ_PAD + ch]);
        else { const int bs = b - BP; a->out[O_CONVS + (size_t)(bs * 3 + j) * 4096 + ch] = bf2f(proj[(size_t)(MP + bs * TS + 1 + j) * NPROJ_PAD + ch]); }
    }
}
__device__ __forceinline__ void phase_mixer_odd(ArgsP a, LAS unsigned char* lds, int vcu, int G, const int tid) {
    const int NIT = 32 + 1024;
#pragma unroll 1
    for (int it = vcu; it < NIT; it += G) {
        int row0, T, h; const float* c0; const float* n0; const float* m0; float* co; float* no; float* mo;
        if (it < 32) { const int b = it >> 3; h = it & 7; row0 = b * TP; T = TP; c0 = nullptr; n0 = nullptr; m0 = nullptr; co = a->out + O_MCP + (size_t)it * 32768; no = a->out + O_MNP + (size_t)it * 128; mo = a->out + O_MMP + it; }
        else { const int j = it - 32, b = j >> 3; h = j & 7; row0 = MP + b * TS; T = TS; c0 = a->in[I_SMC] + (size_t)j * 32768; n0 = a->in[I_SMN] + (size_t)j * 128; m0 = a->in[I_SMM] + j;
               co = a->out + O_MCS + (size_t)j * 32768; no = a->out + O_MNS + (size_t)j * 128; mo = a->out + O_MMS + j; }
        mlstm_rec_item(a, lds, row0, T, h, c0, n0, m0, co, no, mo, tid);
    }
}

__device__ __forceinline__ void phase_ln(const float* p0, const float* p1, const bf16* resid, const float* g, const float* bta, bf16* dst, int gw, int NGW, int lane) {
    for (int m = gw; m < M; m += NGW) {
        float v[32]; float s = 0.f;
#pragma unroll
        for (int j = 0; j < 8; ++j) { const size_t off = (size_t)m * D + j * 256 + lane * 4; f32x4 x = *(const f32x4*)(p0 + off); if (p1) { const f32x4 y = *(const f32x4*)(p1 + off); x = x + y; }
            const v2u rr = *(const v2u*)(resid + off);
            v[4 * j + 0] = x.x + DN_ALPHA * bflo(rr.x); v[4 * j + 1] = x.y + DN_ALPHA * bfhi(rr.x); v[4 * j + 2] = x.z + DN_ALPHA * bflo(rr.y); v[4 * j + 3] = x.w + DN_ALPHA * bfhi(rr.y);
            s += (v[4 * j] + v[4 * j + 1]) + (v[4 * j + 2] + v[4 * j + 3]); }
        const float mean = wave_sum(s) * (1.f / D); float s2 = 0.f;
#pragma unroll
        for (int i = 0; i < 32; ++i) { v[i] -= mean; s2 += v[i] * v[i]; }
        const float rstd = rsqrtf(wave_sum(s2) * (1.f / D) + LN_EPS);
#pragma unroll
        for (int j = 0; j < 8; ++j) { const int col = j * 256 + lane * 4; const f32x4 gg = *(const f32x4*)(g + col), bb = *(const f32x4*)(bta + col);
            v2u o; o.x = pk2(v[4 * j] * rstd * gg.x + bb.x, v[4 * j + 1] * rstd * gg.y + bb.y); o.y = pk2(v[4 * j + 2] * rstd * gg.z + bb.z, v[4 * j + 3] * rstd * gg.w + bb.w);
            *(v2u*)(dst + (size_t)m * D + col) = o; }
    }
}
__device__ __forceinline__ void phase_combine(const float* p0, const float* p1, const bf16* h2, const bf16* pw, bf16* xb, float* outf, int gw, int NGW, int lane) {
    for (int m = gw; m < M; m += NGW) {
#pragma unroll
        for (int j = 0; j < 8; ++j) { const size_t off = (size_t)m * D + j * 256 + lane * 4; f32x4 x = *(const f32x4*)(p0 + off); if (p1) { const f32x4 y = *(const f32x4*)(p1 + off); x = x + y; }
            const v2u hh = *(const v2u*)(h2 + off), pp = *(const v2u*)(pw + off);
            f32x4 o; o.x = bflo(hh.x) + sigm(x.x) * bflo(pp.x); o.y = bfhi(hh.x) + sigm(x.y) * bfhi(pp.x); o.z = bflo(hh.y) + sigm(x.z) * bflo(pp.y); o.w = bfhi(hh.y) + sigm(x.w) * bfhi(pp.y);
            v2u ob; ob.x = pk2(o.x, o.y); ob.y = pk2(o.z, o.w); *(v2u*)(xb + off) = ob;
            if (outf) *(f32x4*)(outf + off) = o; }
    }
}

constexpr int N_PHASES = 19;
enum { GK_F32 = 0, GK_BF16 = 1, GK_SQRELU = 2 };
__global__ void __launch_bounds__(NTHR, 2) mk_fwd(Args a_in) {
    extern __shared__ __attribute__((aligned(16))) unsigned char lds_raw[];
    LAS unsigned char* lds = (LAS unsigned char*)lds_raw;
    ArgsP kp = (ArgsP)__builtin_amdgcn_kernarg_segment_ptr();
    const int lo = a_in.ph_lo, hi = a_in.ph_hi;
#if MK_N_LAUNCHES == 1
    volatile LAS unsigned* xst = (volatile LAS unsigned*)(lds + LDS_CTL_OFF);
    if (threadIdx.x < 2) xst[threadIdx.x] = 0u;
    __syncthreads();
    XcdBarrier bar = xcd_barrier_post((unsigned*)(a_in.ws + WS_CTL) + 4096, xst);
#endif
#pragma unroll 1
    for (int p = lo; p < hi; ++p) {
        int tid = threadIdx.x; asm volatile("" : "+v"(tid));
        int bx = blockIdx.x; asm volatile("" : "+s"(bx));
        int G = gridDim.x; asm volatile("" : "+s"(G));
        ArgsP a = kp; asm volatile("" : "+s"(a));
        const int lane = tid & 63, wave = __builtin_amdgcn_readfirstlane(tid >> 6);
        const int vcu = (G % 8 == 0) ? (bx % 8) * (G / 8) + bx / 8 : bx;
        const int gw = vcu * NWAVES + wave, NGW = G * NWAVES;
        unsigned char* ws = a->ws;
        if (p == 0) {
#ifndef SKIP_CONV
 phase_convert(a, lds, gw, NGW, wave, lane);
#endif
 }
        else {
            const int L = (p - 1) / 9, q = (p - 1) % 9;
            bf16* xb = (bf16*)(ws + WS_XB); bf16* mixb = (bf16*)(ws + WS_MIX); bf16* hb = (bf16*)(ws + WS_H); bf16* h2b = (bf16*)(ws + WS_H2); bf16* pwb = (bf16*)(ws + WS_PW);
            bf16* projb = (bf16*)(ws + WS_PROJ); bf16* upb = (bf16*)(ws + WS_PROJ);
            float* part0 = (float*)(ws + WS_PART0); float* gatesb = (float*)(ws + WS_GATES);
            if (q == 1) {
#ifndef SKIP_MIX
 if (L == 0) phase_mixer_even(a, lds, vcu, G, tid); else phase_mixer_odd(a, lds, vcu, G, tid);
#endif
 }

#ifndef SKIP_LN
 else if (q == 3) phase_ln(part0, nullptr, xb, a->in[I_LN1G] + L * D, a->in[I_LN1B] + L * D, hb, gw, NGW, lane);
            else if (q == 6) phase_ln(part0, nullptr, hb, a->in[I_LN2G] + L * D, a->in[I_LN2B] + L * D, h2b, gw, NGW, lane);
            else if (q == 8) phase_combine(part0, nullptr, h2b, pwb, xb, L == 1 ? a->out + O_Y : nullptr, gw, NGW, lane);
#endif

            else {
                for (int sub = 0; sub < (q == 7 ? 2 : 1); ++sub) {
                    const bf16* A; const bf16* Bt; int N, K, kind; void* out; float* gp = nullptr; int corder = bx;
                    if (q == 0) { A = xb; Bt = (const bf16*)(ws + (L == 0 ? WS_WINE : WS_WINO)); N = NPROJ_PAD; K = D; kind = GK_BF16; out = projb; gp = gatesb; }
                    else if (q == 2) { A = mixb; Bt = (const bf16*)(ws + (L == 0 ? WS_WOUTE : WS_WOUTO)); N = D; K = D; kind = GK_F32; out = part0; }
                    else if (q == 4) { A = hb; Bt = (const bf16*)(ws + WS_WUP) + (size_t)L * D * FF; N = FF; K = D; kind = GK_SQRELU; out = upb; }
                    else if (q == 5) { A = upb; Bt = (const bf16*)(ws + WS_WDOWN) + (size_t)L * D * FF; N = D; K = FF; kind = GK_F32; out = part0; }
                    else if (sub == 0) { A = h2b; Bt = (const bf16*)(ws + WS_WGATE) + (size_t)L * D * D; N = D; K = D; kind = GK_F32; out = part0; }
                    else { A = (const bf16*)(ws + WS_PB) + (size_t)L * M * PLE; Bt = (const bf16*)(ws + WS_WPLE) + (size_t)L * PLE * D; N = D; K = PLE; kind = GK_BF16; out = pwb; corder = (bx + 128) % G; }
                    pg8::Gemm g{A, Bt, M, N, K}; pg8::StaticOrder S; S.init(M, N, G, corder);
                    if (kind == GK_F32) { pg8::EpiF32 E{(float*)out, N}; pg8::gemm_phase<pg8::EpiF32, pg8::StaticOrder, true, true>(lds, g, S, E, tid); }
                    else if (kind == GK_BF16) { pg8::EpiBf16<0> E{(bf16*)out, N, gp, 24}; pg8::gemm_phase<pg8::EpiBf16<0>, pg8::StaticOrder, true, true>(lds, g, S, E, tid); }
                    else { pg8::EpiBf16<1> E{(bf16*)out, N, nullptr, -1}; pg8::gemm_phase<pg8::EpiBf16<1>, pg8::StaticOrder, true, true>(lds, g, S, E, tid); }
                }
            }
        }
#if MK_N_LAUNCHES == 1
        if (p + 1 < hi) { if (p == lo) cg::this_grid().sync(); else xcd_barrier(bar); }
#endif
    }
}

extern "C" void kernel_launch(void* const* d_in, const int* in_sizes, int n_in, void* d_out, int out_size, void* d_ws, size_t ws_size, hipStream_t stream) {
    static int grid = 0;
    if (grid == 0) {
        if (n_in != 35 || (size_t)out_size != O_END || ws_size < WS_END) { fprintf(stderr, "kernel_launch: unexpected shapes: n_in %d out %d (want %zu) ws %zu (want %zu)\n", n_in, out_size, (size_t)O_END, ws_size, (size_t)WS_END); grid = -1; return; }
        int dev = 0, cus = 0, per_cu = 0;
        hipGetDevice(&dev); hipDeviceGetAttribute(&cus, hipDeviceAttributeMultiprocessorCount, dev);
        if (hipFuncSetAttribute((const void*)mk_fwd, hipFuncAttributeMaxDynamicSharedMemorySize, LDS_BYTES) != hipSuccess) { fprintf(stderr, "kernel_launch: hipFuncSetAttribute failed\n"); grid = -1; return; }
        if (hipOccupancyMaxActiveBlocksPerMultiprocessor(&per_cu, (const void*)mk_fwd, NTHR, LDS_BYTES) != hipSuccess || per_cu < 1) { fprintf(stderr, "kernel_launch: occupancy query says %d\n", per_cu); per_cu = 1; }
        (void)hipGetLastError();
        grid = cus * 1;
    }
    if (grid < 0) return;
    Args a{};
    for (int i = 0; i < 35; ++i) a.in[i] = (const float*)d_in[i];
    a.out = (float*)d_out; a.ws = (unsigned char*)d_ws;
#if MK_N_LAUNCHES == 1
    hipMemsetAsync((char*)d_ws + WS_CTL, 0, 1 * MiB, stream);
    a.ph_lo = 0; a.ph_hi = N_PHASES;
    void* args[] = {&a};
    hipError_t e = hipLaunchCooperativeKernel((const void*)mk_fwd, dim3(grid), dim3(NTHR), args, LDS_BYTES, stream);
    if (e != hipSuccess) fprintf(stderr, "cooperative launch failed: %s (grid %d)\n", hipGetErrorString(e), grid);
#else
    for (int p = 0; p < N_PHASES; ++p) {
        a.ph_lo = p; a.ph_hi = p + 1;
        hipLaunchKernelGGL(mk_fwd, dim3(grid), dim3(NTHR), LDS_BYTES, stream, a);
    }
#endif
}
```

```cpp
#include <hip/hip_runtime.h>
#include <hip/hip_cooperative_groups.h>
#include <cstdio>
#include <cstdint>
namespace cg = cooperative_groups;

#ifndef MK_N_LAUNCHES
#define MK_N_LAUNCHES 1
#endif

namespace pg8 {
#define PG8_LAS __attribute__((address_space(3)))
typedef unsigned short bf16_t;
typedef short bf16x8 __attribute__((ext_vector_type(8)));
typedef float f32x4 __attribute__((ext_vector_type(4)));
typedef unsigned u32x4 __attribute__((ext_vector_type(4)));
constexpr int BM = 256, BK = 64, HALF = 128, HTB = HALF * BK * 2, STAGE_BYTES = 8 * HTB, NXCD = 8, WGM = 8;

__host__ __device__ __forceinline__ int lds_byte(int r, int c) { const int st = (r >> 4) * 2 + (c >> 5), rr = r & 15, cc = c & 31, ob = rr * 64 + cc * 2; return st * 1024 + (ob ^ (((ob >> 9) & 1) << 5)); }
__host__ __device__ __forceinline__ void stage_rc(int b, int& R, int& C) { const int st = b / 1024, sb = b % 1024, swz = sb ^ (((sb >> 9) & 1) << 5); R = (st >> 1) * 16 + swz / 64; C = (st & 1) * 32 + (swz % 64) / 2; }
__host__ __device__ __forceinline__ int perm32(int rho) { const int n = rho >> 4, i = rho & 15; return 8 * (i >> 2) + 4 * n + (i & 3); }

struct Unit { int pm, pn; };
struct Gemm { const bf16_t* A; const bf16_t* Bt; int M, N, K; };

struct StaticOrder {
    int nM, nN, nwg, G, c;
    __host__ __device__ void init(int M, int N, int G_, int c_) { nM = M / BM; nN = N / BM; nwg = nM * nN; G = G_; c = c_; }
    __host__ __device__ bool next(int i, Unit& u) const {
        const long L = (long)i * G + c; if (L >= nwg) return false;
        int wgid = (int)L; { const int q = nwg / NXCD, r = nwg % NXCD, xcd = wgid % NXCD, off = wgid / NXCD; wgid = (xcd < r ? xcd * (q + 1) : r * (q + 1) + (xcd - r) * q) + off; }
        const int nig = WGM * nN, gid = wgid / nig, fm = gid * WGM, gsz = (nM - fm) < WGM ? (nM - fm) : WGM;
        u.pm = fm + ((wgid % nig) % gsz); u.pn = (wgid % nig) / gsz; return true;
    }
    __device__ __forceinline__ void a_ready(const Unit&) const {}
    __device__ __forceinline__ void done(const Unit&) const {}
};

__device__ __forceinline__ unsigned cvt_pk_bf16(float lo, float hi) { unsigned r; asm volatile("v_cvt_pk_bf16_f32 %0, %1, %2" : "=v"(r) : "v"(lo), "v"(hi)); return r; }

struct EpiF32 {
    static constexpr bool PERM = false, AFTER_DRAIN = false;
    float* C; int ldc;
    __device__ __forceinline__ void operator()(const f32x4 (&acc)[2][2][4][2], const Unit& u, int wr, int wc, int fr, int fq) const {
        const int row0 = u.pm * BM + wr * 64 + fr, col0 = u.pn * BM + wc * 32 + 4 * fq;
#pragma unroll
        for (int ai = 0; ai < 2; ++ai)
#pragma unroll
            for (int m = 0; m < 4; ++m) { float* rowp = C + (size_t)(row0 + ai * HALF + m * 16) * ldc + col0;
#pragma unroll
                for (int bj = 0; bj < 2; ++bj)
#pragma unroll
                    for (int n = 0; n < 2; ++n) *(f32x4*)(rowp + bj * HALF + n * 16) = acc[ai][bj][m][n]; }
    }
};
template <int ACT> struct EpiBf16 {
    static constexpr bool PERM = true, AFTER_DRAIN = false;
    bf16_t* O; int ldc; float* gates; int gate_pn;
    __device__ __forceinline__ void operator()(const f32x4 (&acc)[2][2][4][2], const Unit& u, int wr, int wc, int fr, int fq) const {
        const int row0 = u.pm * BM + wr * 64 + fr; const int col0 = u.pn * BM + wc * 32 + 8 * fq;
        const bool gt = (gates != nullptr) && (u.pn == gate_pn) && (wc == 0) && (fq < 2);
#pragma unroll
        for (int ai = 0; ai < 2; ++ai)
#pragma unroll
            for (int m = 0; m < 4; ++m) { const int row = row0 + ai * HALF + m * 16; bf16_t* rowp = O + (size_t)row * ldc + col0;
#pragma unroll
                for (int bj = 0; bj < 2; ++bj) { f32x4 v0 = acc[ai][bj][m][0], v1 = acc[ai][bj][m][1];
                    if (ACT == 1) {
#pragma unroll
                        for (int j = 0; j < 4; ++j) { const float a = fmaxf(v0[j], 0.f), b = fmaxf(v1[j], 0.f); v0[j] = a * a; v1[j] = b * b; } }
                    u32x4 w; w.x = cvt_pk_bf16(v0[0], v0[1]); w.y = cvt_pk_bf16(v0[2], v0[3]); w.z = cvt_pk_bf16(v1[0], v1[1]); w.w = cvt_pk_bf16(v1[2], v1[3]);
                    *(u32x4*)(rowp + bj * HALF) = w; }
                if (gt) { float* gp = gates + (size_t)row * 16 + 8 * fq; *(f32x4*)gp = acc[ai][0][m][0]; *(f32x4*)(gp + 4) = acc[ai][0][m][1]; } }
    }
};

template <class Epi, class Sched, bool ALIGN_EPI = false, bool SP2 = false>
__device__ __forceinline__ void gemm_phase(PG8_LAS unsigned char* lds, const Gemm g, const Sched& S, const Epi& E, const int tid) {
    const int wid = __builtin_amdgcn_readfirstlane(tid >> 6), lane = tid & 63, wr = wid >> 2, wc = wid & 3, fr = lane & 15, fq = lane >> 4;
    const int K = g.K, nt = K / BK;
    unsigned voffA[2], voffB[2];
#pragma unroll
    for (int i = 0; i < 2; ++i) { int R, C; stage_rc(tid * 16 + i * 8192, R, C); const int Rb = Epi::PERM ? ((R & ~31) + perm32(R & 31)) : R;
        voffA[i] = (unsigned)(R * K + C) * 2u; voffB[i] = (unsigned)(Rb * K + C) * 2u; }
    const size_t kstep = (size_t)(BK * 2);
    const size_t hstep = (size_t)HALF * K * 2;
    const size_t tstep = 2 * hstep;
    const unsigned ldsw = (unsigned)wid * 1024u;
    const int aoff = lds_byte(wr * 64 + fr, fq * 8), boff = lds_byte(wc * 32 + fr, fq * 8);
#define PG8_SA(b, h) (((b) * 2 + (h)) * HTB)
#define PG8_SB(b, h) ((4 + (b) * 2 + (h)) * HTB)
#define PG8_STAGE(bufoff, gbase, voff) do { _Pragma("unroll") for (int _i = 0; _i < 2; ++_i) \
        __builtin_amdgcn_global_load_lds((const unsigned*)((const char*)(gbase) + (voff)[_i]), (PG8_LAS unsigned*)(lds + (bufoff) + ldsw + _i * 8192), 16, 0, 0); } while (0)
#define PG8_LDA(dst, b, h) do { _Pragma("unroll") for (int m = 0; m < 4; ++m) _Pragma("unroll") for (int k = 0; k < 2; ++k) dst[m][k] = *(const PG8_LAS bf16x8*)(lds + PG8_SA(b, h) + aoff + m * 2048 + k * 1024); } while (0)
#define PG8_LDB(dst, b, h) do { _Pragma("unroll") for (int n = 0; n < 2; ++n) _Pragma("unroll") for (int k = 0; k < 2; ++k) dst[n][k] = *(const PG8_LAS bf16x8*)(lds + PG8_SB(b, h) + boff + n * 2048 + k * 1024); } while (0)
#define PG8_MMA(ai, bj, At, Bt) do { __builtin_amdgcn_s_setprio(1); _Pragma("unroll") for (int m = 0; m < 4; ++m) _Pragma("unroll") for (int n = 0; n < 2; ++n) _Pragma("unroll") for (int k = 0; k < 2; ++k) \
        acc[ai][bj][m][n] = __builtin_amdgcn_mfma_f32_16x16x32_bf16(Bt[n][k], At[m][k], acc[ai][bj][m][n], 0, 0, 0); __builtin_amdgcn_s_setprio(0); } while (0)
#define PG8_WAIT_V(n) asm volatile("s_waitcnt vmcnt(" #n ")" ::: "memory")
#define PG8_WAIT_L(n) asm volatile("s_waitcnt lgkmcnt(" #n ")" ::: "memory")
#define PG8_BAR __builtin_amdgcn_s_barrier()
#define PG8_SCHED __builtin_amdgcn_sched_barrier(0)
    Unit cur, nxt; int ui = 0;
    if (!S.next(0, cur)) return;
    f32x4 acc[2][2][4][2];
#pragma unroll
    for (int a = 0; a < 2; ++a)
#pragma unroll
        for (int b = 0; b < 2; ++b)
#pragma unroll
            for (int m = 0; m < 4; ++m)
#pragma unroll
                for (int n = 0; n < 2; ++n) acc[a][b][m][n] = (f32x4){0.f, 0.f, 0.f, 0.f};
    bf16x8 At[4][2], B0[2][2], B1[2][2];
    const char* cA = (const char*)g.A + (size_t)cur.pm * tstep; const char* cB = (const char*)g.Bt + (size_t)cur.pn * tstep;
    S.a_ready(cur);
    if constexpr (SP2) {
        PG8_STAGE(PG8_SB(0, 0), cB, voffB); PG8_STAGE(PG8_SB(0, 1), cB + hstep, voffB); PG8_STAGE(PG8_SA(0, 0), cA, voffA); PG8_STAGE(PG8_SA(0, 1), cA + hstep, voffA);
        if (wr == 1) PG8_BAR;
        PG8_WAIT_V(2); PG8_BAR;
        PG8_STAGE(PG8_SB(1, 0), cB + kstep, voffB); PG8_STAGE(PG8_SA(1, 0), cA + kstep, voffA); PG8_STAGE(PG8_SB(1, 1), cB + hstep + kstep, voffB);
        PG8_WAIT_V(6); PG8_BAR;
    } else {
        PG8_STAGE(PG8_SB(0, 0), cB, voffB); PG8_STAGE(PG8_SA(0, 0), cA, voffA); PG8_STAGE(PG8_SB(0, 1), cB + hstep, voffB); PG8_STAGE(PG8_SA(0, 1), cA + hstep, voffA);
        if (wr == 1) PG8_BAR;
        PG8_WAIT_V(4); PG8_BAR;
        PG8_STAGE(PG8_SB(1, 0), cB + kstep, voffB); PG8_STAGE(PG8_SA(1, 0), cA + kstep, voffA); PG8_STAGE(PG8_SB(1, 1), cB + hstep + kstep, voffB);
        PG8_WAIT_V(6); PG8_BAR;
    }
    for (;;) {
        const bool has_next = S.next(ui + 1, nxt);
        const char* nA = has_next ? (const char*)g.A + (size_t)nxt.pm * tstep : cA; const char* nB = has_next ? (const char*)g.Bt + (size_t)nxt.pn * tstep : cB;
        for (int t = 0; t < nt; t += 2) {
            const bool last = (t == nt - 2);
            const char* a1 = cA + (size_t)(t + 1) * kstep;
            const char* a2 = last ? nA : cA + (size_t)(t + 2) * kstep; const char* b2 = last ? nB : cB + (size_t)(t + 2) * kstep;
            const char* a3 = a2 + kstep; const char* b3 = b2 + kstep;
            if (last && has_next) S.a_ready(nxt);
            if constexpr (SP2) {
            PG8_LDB(B0, 0, 0); PG8_LDB(B1, 0, 1); PG8_SCHED; PG8_LDA(At, 0, 0); PG8_STAGE(PG8_SA(1, 1), a1 + hstep, voffA);
            PG8_WAIT_V(8); PG8_WAIT_L(0); PG8_BAR; PG8_MMA(0, 0, At, B0); PG8_MMA(0, 1, At, B1); PG8_BAR; PG8_SCHED;
            PG8_LDA(At, 0, 1); PG8_STAGE(PG8_SB(0, 0), b2, voffB); PG8_STAGE(PG8_SB(0, 1), b2 + hstep, voffB); PG8_STAGE(PG8_SA(0, 0), a2, voffA);
            PG8_WAIT_V(8); PG8_WAIT_L(0); PG8_BAR; PG8_MMA(1, 0, At, B0); PG8_MMA(1, 1, At, B1); PG8_BAR; PG8_SCHED;
            PG8_LDB(B0, 1, 0); PG8_LDB(B1, 1, 1); PG8_SCHED; PG8_LDA(At, 1, 0); PG8_STAGE(PG8_SA(0, 1), a2 + hstep, voffA);
            PG8_WAIT_V(8); PG8_WAIT_L(0); PG8_BAR; PG8_MMA(0, 0, At, B0); PG8_MMA(0, 1, At, B1); PG8_BAR; PG8_SCHED;
            PG8_LDA(At, 1, 1); PG8_STAGE(PG8_SB(1, 0), b3, voffB); PG8_STAGE(PG8_SB(1, 1), b3 + hstep, voffB); PG8_STAGE(PG8_SA(1, 0), a3, voffA);
            PG8_WAIT_V(8); PG8_WAIT_L(0); PG8_BAR; PG8_MMA(1, 0, At, B0); PG8_MMA(1, 1, At, B1); PG8_BAR; PG8_SCHED;
            } else {
            PG8_LDB(B0, 0, 0); PG8_SCHED; PG8_LDA(At, 0, 0); PG8_STAGE(PG8_SA(1, 1), a1 + hstep, voffA);
            PG8_WAIT_L(8); PG8_BAR; PG8_WAIT_L(0); PG8_MMA(0, 0, At, B0); PG8_BAR; PG8_SCHED;
            PG8_LDB(B1, 0, 1); PG8_STAGE(PG8_SB(0, 0), b2, voffB);
            PG8_BAR; PG8_WAIT_L(0); PG8_MMA(0, 1, At, B1); PG8_BAR;
            PG8_LDA(At, 0, 1); PG8_STAGE(PG8_SA(0, 0), a2, voffA);
            PG8_BAR; PG8_WAIT_L(0); PG8_MMA(1, 0, At, B0); PG8_BAR; PG8_SCHED;
            PG8_STAGE(PG8_SB(0, 1), b2 + hstep, voffB);
            PG8_WAIT_V(6); PG8_BAR; PG8_MMA(1, 1, At, B1); PG8_BAR;
            PG8_LDB(B0, 1, 0); PG8_SCHED; PG8_LDA(At, 1, 0); PG8_STAGE(PG8_SA(0, 1), a2 + hstep, voffA);
            PG8_WAIT_L(8); PG8_BAR; PG8_WAIT_L(0); PG8_MMA(0, 0, At, B0); PG8_BAR; PG8_SCHED;
            PG8_LDB(B1, 1, 1); PG8_STAGE(PG8_SB(1, 0), b3, voffB);
            PG8_BAR; PG8_WAIT_L(0); PG8_MMA(0, 1, At, B1); PG8_BAR;
            PG8_LDA(At, 1, 1); PG8_STAGE(PG8_SA(1, 0), a3, voffA);
            PG8_BAR; PG8_WAIT_L(0); PG8_MMA(1, 0, At, B0); PG8_BAR; PG8_SCHED;
            PG8_STAGE(PG8_SB(1, 1), b3 + hstep, voffB);
            PG8_WAIT_V(6); PG8_BAR; PG8_MMA(1, 1, At, B1); PG8_BAR;
            }
        }
        if constexpr (ALIGN_EPI) { if (wr == 0) PG8_BAR; }
        E(acc, cur, wr, wc, fr, fq); S.done(cur);
        if (!has_next) break;
#pragma unroll
        for (int a = 0; a < 2; ++a)
#pragma unroll
            for (int b = 0; b < 2; ++b)
#pragma unroll
                for (int m = 0; m < 4; ++m)
#pragma unroll
                    for (int n = 0; n < 2; ++n) acc[a][b][m][n] = (f32x4){0.f, 0.f, 0.f, 0.f};
        cur = nxt; cA = nA; cB = nB; ++ui;
        if constexpr (ALIGN_EPI) { if (wr == 1) PG8_BAR; }
    }
    PG8_WAIT_V(0);
    if constexpr (!ALIGN_EPI) { if (wr == 0) PG8_BAR; }
    PG8_BAR;
#undef PG8_SA
#undef PG8_SB
#undef PG8_STAGE
#undef PG8_LDA
#undef PG8_LDB
#undef PG8_MMA
#undef PG8_WAIT_V
#undef PG8_WAIT_L
#undef PG8_BAR
#undef PG8_SCHED
}
}

constexpr int NWAVES = 8, NTHR = 512;
constexpr int D = 2048, FF = 8192, PLE = 256;
constexpr int TP = 2048, BP = 4, TS = 4, BS = 128;
constexpr int MP = BP * TP, MS = BS * TS, M = MP + MS;
constexpr int NPROJ = 6160, NPROJ_PAD = 6400;
constexpr int NH = 8;
constexpr float LN_EPS = 1e-5f, RMS_EPS = 1e-6f;
constexpr float DN_ALPHA = 1.41421356237f;

constexpr size_t MiB = 1u << 20;
constexpr size_t WS_CTL = 0;
constexpr size_t WS_WINE = 1 * MiB;
constexpr size_t WS_WOUTE = WS_WINE + 25 * MiB;
constexpr size_t WS_WINO = WS_WOUTE + 8 * MiB;
constexpr size_t WS_WOUTO = WS_WINO + 25 * MiB;
constexpr size_t WS_WUP = WS_WOUTO + 8 * MiB;
constexpr size_t WS_WDOWN = WS_WUP + 64 * MiB;
constexpr size_t WS_WPLE = WS_WDOWN + 64 * MiB;
constexpr size_t WS_WGATE = WS_WPLE + 2 * MiB;
constexpr size_t WS_XB = WS_WGATE + 16 * MiB;
constexpr size_t WS_MIX = WS_XB + 34 * MiB;
constexpr size_t WS_H = WS_MIX + 34 * MiB;
constexpr size_t WS_H2 = WS_H + 34 * MiB;
constexpr size_t WS_PW = WS_H2 + 34 * MiB;
constexpr size_t WS_PB = WS_PW + 34 * MiB;
constexpr size_t WS_GATES = WS_PB + 9 * MiB;
constexpr size_t WS_PROJ = WS_GATES + 1 * MiB;
constexpr size_t WS_PART0 = WS_PROJ + 136 * MiB;
constexpr size_t WS_PART1 = WS_PART0 + 68 * MiB;
constexpr size_t WS_END = WS_PART1 + 68 * MiB;

constexpr size_t O_Y = 0;
constexpr size_t O_CONVP = (size_t)M * D;
constexpr size_t O_DELTAP = O_CONVP + (size_t)BP * 3 * 4096;
constexpr size_t O_LRUP = O_DELTAP + (size_t)BP * 8 * 128 * 128;
constexpr size_t O_MCP = O_LRUP + (size_t)BP * 1024;
constexpr size_t O_MNP = O_MCP + (size_t)BP * 8 * 256 * 128;
constexpr size_t O_MMP = O_MNP + (size_t)BP * 8 * 128;
constexpr size_t O_CONVS = O_MMP + (size_t)BP * 8;
constexpr size_t O_DELTAS = O_CONVS + (size_t)BS * 3 * 4096;
constexpr size_t O_LRUS = O_DELTAS + (size_t)BS * 8 * 128 * 128;
constexpr size_t O_MCS = O_LRUS + (size_t)BS * 1024;
constexpr size_t O_MNS = O_MCS + (size_t)BS * 8 * 256 * 128;
constexpr size_t O_MMS = O_MNS + (size_t)BS * 8 * 128;
constexpr size_t O_END = O_MMS + (size_t)BS * 8;

constexpr int LDS_BYTES = 147456;
constexpr int LDS_CTL_OFF = 131072;

#define LAS __attribute__((address_space(3)))
typedef unsigned short bf16;
typedef unsigned v4u __attribute__((ext_vector_type(4)));
typedef unsigned v2u __attribute__((ext_vector_type(2)));
typedef float f32x4 __attribute__((ext_vector_type(4)));
#define LDS_WAIT() asm volatile("s_waitcnt lgkmcnt(0)" ::: "memory")
__device__ __forceinline__ unsigned f2bf(float f) { unsigned u = __builtin_bit_cast(unsigned, f); return (u + 0x7fffu + ((u >> 16) & 1u)) >> 16; }
__device__ __forceinline__ unsigned pk2(float lo, float hi) { return f2bf(lo) | (f2bf(hi) << 16); }
__device__ __forceinline__ float bf2f(unsigned short b) { return __builtin_bit_cast(float, ((unsigned)b) << 16); }
__device__ __forceinline__ float bflo(unsigned w) { return __builtin_bit_cast(float, w << 16); }
__device__ __forceinline__ float bfhi(unsigned w) { return __builtin_bit_cast(float, w & 0xffff0000u); }
__device__ __forceinline__ float sigm(float x) { return 1.f / (1.f + expf(-x)); }
__device__ __forceinline__ float siluf(float x) { return x * sigm(x); }
__device__ __forceinline__ float softplusf(float x) { return fmaxf(x, 0.f) + log1pf(expf(-fabsf(x))); }
__device__ __forceinline__ float logsigf(float x) { return -softplusf(-x); }
__device__ __forceinline__ float gelu_tanh(float x) { const float u = 0.7978845608028654f * (x + 0.044715f * x * x * x); return 0.5f * x * (1.f + tanhf(u)); }
__device__ __forceinline__ float wave_sum(float v) {
#pragma unroll
    for (int o = 1; o < 64; o <<= 1) v += __shfl_xor(v, o);
    return v;
}

#define XB_TMO      128
#define XB_XCNT(j)  (256  + 64 * (j))
#define XB_XSUB(j)  (1280 + 64 * (j))
#define XB_XGEN(j)  (2304 + 64 * (j))
#define XB_TOP      3328
#define XB_TOPGEN   3392
#define XCD_BAR_WORDS 3456
#define XB_SPIN_CAP (1u << 22)
__device__ __forceinline__ unsigned xb_ld(unsigned* p)              { return __hip_atomic_load(p, __ATOMIC_RELAXED, __HIP_MEMORY_SCOPE_AGENT); }
__device__ __forceinline__ unsigned xb_add(unsigned* p, unsigned v) { return __hip_atomic_fetch_add(p, v, __ATOMIC_RELAXED, __HIP_MEMORY_SCOPE_AGENT); }
__device__ __forceinline__ unsigned xb_xcc_id() { return (unsigned)__builtin_amdgcn_s_getreg((3 << 11) | 20) & 0xFu; }
#define XB_SPIN(cond, bar) do { unsigned _sp = 0; while (cond) { __builtin_amdgcn_s_sleep(1); \
    if ((++_sp & 255u) == 0u) { if (xb_ld(&(bar)[XB_TMO])) break; if (_sp > XB_SPIN_CAP) { atomicAdd(&(bar)[XB_TMO], 1u); break; } } } } while (0)
struct XcdBarrier { unsigned* bar; unsigned x; volatile LAS unsigned* st; };
__device__ __forceinline__ XcdBarrier xcd_barrier_post(unsigned* bar, volatile LAS unsigned* st) {
    XcdBarrier b; b.bar = bar; b.x = xb_xcc_id(); b.st = st;
    if (threadIdx.x == 0) (void)xb_add(&bar[XB_XCNT(b.x)], 1u);
    return b;
}
__device__ __forceinline__ void xcd_barrier_complete(unsigned* bar, unsigned x, unsigned& nloc, unsigned& nx) {
    const unsigned G = gridDim.x * gridDim.y * gridDim.z;
    unsigned sum, cnt, mine, sp = 0u;
    for (;;) {
        sum = 0u; cnt = 0u; mine = 0u;
#pragma unroll
        for (unsigned j = 0; j < 16; ++j) { const unsigned c = xb_ld(&bar[XB_XCNT(j)]); sum += c; cnt += (c > 0u) ? 1u : 0u; mine = (j == x) ? c : mine; }
        if (sum == G) break;
        __builtin_amdgcn_s_sleep(1);
        if ((++sp & 255u) == 0u) { if (xb_ld(&bar[XB_TMO])) break; if (sp > XB_SPIN_CAP) { atomicAdd(&bar[XB_TMO], 1u); break; } }
    }
    nloc = mine > 0u ? mine : 1u; nx = cnt > 0u ? cnt : 1u;
}
__device__ __forceinline__ void xcd_barrier(const XcdBarrier& b) {
    asm volatile("s_waitcnt vmcnt(0)" ::: "memory");
    __syncthreads();
    if (threadIdx.x == 0) {
        unsigned* bar = b.bar;
        __builtin_amdgcn_s_waitcnt(0);
        unsigned nloc = b.st[0], nx = b.st[1];
        if (nloc == 0u) { xcd_barrier_complete(bar, b.x, nloc, nx); b.st[0] = nloc; b.st[1] = nx; }
        const unsigned old = xb_add(&bar[XB_XSUB(b.x)], 1u);
        const unsigned gen = old / nloc;
        if (old + 1u == (gen + 1u) * nloc) {
            __builtin_amdgcn_fence(__ATOMIC_RELEASE, "agent");
            asm volatile("s_waitcnt vmcnt(0)" ::: "memory");
            const unsigned og = xb_add(&bar[XB_TOP], 1u);
            const unsigned tg = og / nx;
            if (og + 1u == (tg + 1u) * nx) xb_add(&bar[XB_TOPGEN], 1u);
            else XB_SPIN(xb_ld(&bar[XB_TOPGEN]) == tg, bar);
            __builtin_amdgcn_fence(__ATOMIC_ACQUIRE, "agent");
            xb_add(&bar[XB_XGEN(b.x)], 1u);
            asm volatile("s_waitcnt vmcnt(0)" ::: "memory");
        } else {
            XB_SPIN(xb_ld(&bar[XB_XGEN(b.x)]) == gen, bar);
            __builtin_amdgcn_fence(__ATOMIC_ACQUIRE, "agent");
            asm volatile("s_waitcnt vmcnt(0)" ::: "memory");
        }
    }
    __syncthreads();
}

struct Args { const float* in[35]; float* out; unsigned char* ws; int ph_lo, ph_hi; };
typedef const __attribute__((address_space(4))) Args* ArgsP;
enum { I_XP = 0, I_XS, I_PP, I_PS, I_SCONV, I_SDELTA, I_SLRU, I_SMC, I_SMN, I_SMM, I_WINE, I_WCONV, I_BCONV, I_ALOG, I_DTB, I_DNORM, I_LWR, I_LBR, I_LWI, I_LBI, I_LLAM, I_WOUTE,
       I_WINO, I_BIG, I_BFG, I_MNORM, I_WOUTO, I_LN1G, I_LN1B, I_LN2G, I_LN2B, I_WUP, I_WDOWN, I_WPLE, I_WGATE };

__device__ __forceinline__ void p0_transpose_item(const float* W, int K, int N, int Npad, bf16* WT, LAS float* scr, int item, int lane) {
    const int nblk = Npad / 32, kb = item / nblk, nb = item % nblk, k0 = 64 * kb, n0 = 32 * nb;
    const int nn = n0 + (lane & 31); const bool ok = nn < N;
#pragma unroll 8
    for (int i = 0; i < 32; ++i) { const int kk = 2 * i + (lane >> 5); scr[kk * 33 + (lane & 31)] = ok ? W[(size_t)(k0 + kk) * N + nn] : 0.f; }
    LDS_WAIT(); asm volatile("" ::: "memory");
    const int c = lane & 7;
#pragma unroll
    for (int j = 0; j < 4; ++j) { const int n = (lane >> 3) + 8 * j; const LAS float* s = scr + (8 * c) * 33 + n;
        v4u o; o.x = pk2(s[0 * 33], s[1 * 33]); o.y = pk2(s[2 * 33], s[3 * 33]); o.z = pk2(s[4 * 33], s[5 * 33]); o.w = pk2(s[6 * 33], s[7 * 33]);
        *(v4u*)(WT + (size_t)(n0 + n) * K + k0 + 8 * c) = o; }
    LDS_WAIT(); asm volatile("" ::: "memory");
}
__device__ __forceinline__ void row_to_bf16(const float* src, bf16* dst, int n, int lane) {
    for (int j = 0; j < n / 256; ++j) { const f32x4 v = *(const f32x4*)(src + j * 256 + lane * 4); v2u o; o.x = pk2(v.x, v.y); o.y = pk2(v.z, v.w); *(v2u*)(dst + j * 256 + lane * 4) = o; }
}

__device__ __forceinline__ void phase_convert(ArgsP a, LAS unsigned char* lds, int gw, int NGW, int wave, int lane) {
    unsigned char* ws = a->ws;
    LAS float* scr = (LAS float*)(lds + wave * 16384);
    constexpr int I_IN = (D / 64) * (NPROJ_PAD / 32), I_SQ = (D / 64) * (D / 32), I_UP = (D / 64) * (FF / 32), I_DN = (FF / 64) * (D / 32), I_PL = (PLE / 64) * (D / 32);
    constexpr int NITEMS = 2 * I_IN + 2 * I_SQ + 2 * I_UP + 2 * I_DN + 2 * I_PL + 2 * I_SQ;
    for (int it = gw; it < NITEMS; it += NGW) {
        int r = it;
        if (r < I_IN) { p0_transpose_item(a->in[I_WINE], D, NPROJ, NPROJ_PAD, (bf16*)(ws + WS_WINE), scr, r, lane); continue; } r -= I_IN;
        if (r < I_IN) { p0_transpose_item(a->in[I_WINO], D, NPROJ, NPROJ_PAD, (bf16*)(ws + WS_WINO), scr, r, lane); continue; } r -= I_IN;
        if (r < I_SQ) { p0_transpose_item(a->in[I_WOUTE], D, D, D, (bf16*)(ws + WS_WOUTE), scr, r, lane); continue; } r -= I_SQ;
        if (r < I_SQ) { p0_transpose_item(a->in[I_WOUTO], D, D, D, (bf16*)(ws + WS_WOUTO), scr, r, lane); continue; } r -= I_SQ;
        if (r < 2 * I_UP) { const int l = r / I_UP; p0_transpose_item(a->in[I_WUP] + (size_t)l * D * FF, D, FF, FF, (bf16*)(ws + WS_WUP) + (size_t)l * D * FF, scr, r % I_UP, lane); continue; } r -= 2 * I_UP;
        if (r < 2 * I_DN) { const int l = r / I_DN; p0_transpose_item(a->in[I_WDOWN] + (size_t)l * D * FF, FF, D, D, (bf16*)(ws + WS_WDOWN) + (size_t)l * D * FF, scr, r % I_DN, lane); continue; } r -= 2 * I_DN;
        if (r < 2 * I_PL) { const int l = r / I_PL; p0_transpose_item(a->in[I_WPLE] + (size_t)l * PLE * D, PLE, D, D, (bf16*)(ws + WS_WPLE) + (size_t)l * PLE * D, scr, r % I_PL, lane); continue; } r -= 2 * I_PL;
        { const int l = r / I_SQ; p0_transpose_item(a->in[I_WGATE] + (size_t)l * D * D, D, D, D, (bf16*)(ws + WS_WGATE) + (size_t)l * D * D, scr, r % I_SQ, lane); }
    }
    bf16* xb = (bf16*)(ws + WS_XB);
    for (int m = gw; m < M; m += NGW) {
        const float* src = m < MP ? a->in[I_XP] + (size_t)m * D : a->in[I_XS] + (size_t)(m - MP) * D;
        row_to_bf16(src, xb + (size_t)m * D, D, lane);
    }
    bf16* pb = (bf16*)(ws + WS_PB);
    for (int r = gw; r < 2 * M; r += NGW) {
        const int l = r / M, m = r % M;
        const float* src = m < MP ? a->in[I_PP] + ((size_t)l * MP + m) * PLE : a->in[I_PS] + ((size_t)l * MS + (m - MP)) * PLE;
        row_to_bf16(src, pb + (size_t)r * PLE, PLE, lane);
    }
}

__device__ __forceinline__ float conv_in(const bf16* proj, int row0, int tq, int ch, const float* cstate) {
    if (tq >= 0) return bf2f(proj[(size_t)(row0 + tq) * NPROJ_PAD + ch]);
    return cstate ? cstate[(3 + tq) * 4096 + ch] : 0.f;
}
__device__ __forceinline__ float conv4(const bf16* proj, int row0, int t, int ch, const float* cstate, const float* wconv, const float* bconv) {
    float acc = bconv[ch];
#pragma unroll
    for (int j = 0; j < 4; ++j) acc += wconv[j * 4096 + ch] * conv_in(proj, row0, t - 3 + j, ch, cstate);
    return acc;
}

__device__ __forceinline__ void delta_rec_item(ArgsP a, LAS unsigned char* lds, int row0, int T, int h, const float* cstate, const float* S0, float* Sout, const int tid) {
    const int lane = tid & 63, wave = tid >> 6, c = tid & 127, r = tid >> 7;
    const bf16* proj = (const bf16*)(a->ws + WS_PROJ); const float* gates = (const float*)(a->ws + WS_GATES); bf16* mix = (bf16*)(a->ws + WS_MIX);
    const float* wconv = a->in[I_WCONV]; const float* bconv = a->in[I_BCONV];
    LAS float* act = (LAS float*)lds;
    LAS float* nrm = act + 4 * 384;
    LAS float* gb = nrm + 8;
    LAS float* red = gb + 8;
    LAS float* red2 = red + 512;
    LAS float* obuf = red2 + 512;
    float s[32];
#pragma unroll
    for (int i = 0; i < 32; ++i) s[i] = S0 ? S0[(size_t)(32 * r + i) * 128 + c] : 0.f;
    const float aexp = expf(a->in[I_ALOG][h]), dtb = a->in[I_DTB][h];
#pragma unroll 1
    for (int t0 = 0; t0 < T; t0 += 4) {
#pragma unroll
        for (int j = 0; j < 3; ++j) { const int idx = tid + 512 * j, tok = idx / 384, chl = idx % 384, part = chl >> 7, i = chl & 127;
            const int ch = part * 1024 + h * 128 + i;
            act[tok * 384 + chl] = siluf(conv4(proj, row0, t0 + tok, ch, cstate, wconv, bconv)); }
        __syncthreads();
        { const int tok = wave >> 1, part = wave & 1; const float x0 = act[tok * 384 + part * 128 + lane], x1 = act[tok * 384 + part * 128 + 64 + lane];
          const float ss = wave_sum(x0 * x0 + x1 * x1); if (lane == 0) nrm[tok * 2 + part] = rsqrtf(ss + 1e-6f) * (part == 0 ? 0.08838834764831845f : 1.f); }
        if (tid < 4) { const int row = row0 + t0 + tid; const float g = -aexp * softplusf(gates[(size_t)row * 16 + h] + dtb); gb[tid * 2] = expf(g); gb[tid * 2 + 1] = sigm(gates[(size_t)row * 16 + 8 + h]); }
        __syncthreads();
#pragma unroll 1
        for (int tok = 0; tok < 4; ++tok) {
            const float eg = gb[tok * 2], beta = gb[tok * 2 + 1], nq = nrm[tok * 2], nk = nrm[tok * 2 + 1];
            const LAS float* qv = act + tok * 384 + 32 * r; const LAS float* kv = qv + 128;
            float ks = 0.f;
#pragma unroll
            for (int i = 0; i < 32; ++i) ks += kv[i] * s[i];
            red[r * 128 + c] = ks * nk;
            __syncthreads();
            const float kS = red[c] + red[128 + c] + red[256 + c] + red[384 + c];
            const float vnew = beta * (act[tok * 384 + 256 + c] - eg * kS);
            float os = 0.f;
#pragma unroll
            for (int i = 0; i < 32; ++i) { s[i] = eg * s[i] + (kv[i] * nk) * vnew; os += qv[i] * s[i]; }
            red2[r * 128 + c] = os * nq;
            __syncthreads();
            if (r == 0) obuf[tok * 128 + c] = red2[c] + red2[128 + c] + red2[256 + c] + red2[384 + c];
        }
        __syncthreads();
        if (wave < 4) { const int tok = wave, row = row0 + t0 + tok; const float o0 = obuf[tok * 128 + lane], o1 = obuf[tok * 128 + 64 + lane];
            const float rstd = rsqrtf(wave_sum(o0 * o0 + o1 * o1) * (1.f / 128.f) + RMS_EPS);
            const float* nw = a->in[I_DNORM];
            const float z0 = bf2f(proj[(size_t)row * NPROJ_PAD + 4096 + h * 128 + lane]), z1 = bf2f(proj[(size_t)row * NPROJ_PAD + 4096 + h * 128 + 64 + lane]);
            mix[(size_t)row * D + h * 128 + lane] = (bf16)f2bf(o0 * rstd * nw[lane] * siluf(z0));
            mix[(size_t)row * D + h * 128 + 64 + lane] = (bf16)f2bf(o1 * rstd * nw[64 + lane] * siluf(z1)); }
        __syncthreads();
    }
#pragma unroll
    for (int i = 0; i < 32; ++i) Sout[(size_t)(32 * r + i) * 128 + c] = s[i];
}

__device__ __forceinline__ void lru_rec_item(ArgsP a, LAS unsigned char* lds, int row0, int T, int n, const float* cstate, const float* h0, float* hout, const int tid) {
    const int d = tid & 127, part = tid >> 7;
    const bf16* proj = (const bf16*)(a->ws + WS_PROJ); bf16* mix = (bf16*)(a->ws + WS_MIX);
    const float* wconv = a->in[I_WCONV]; const float* bconv = a->in[I_BCONV];
    const float* wr = a->in[I_LWR] + (size_t)n * 16384; const float* wi = a->in[I_LWI] + (size_t)n * 16384;
    LAS float* xr = (LAS float*)lds;
    LAS float* red = xr + 512;
    const int chn = n * 128 + d;
    float hst = h0 ? h0[chn] : 0.f;
    const float br = a->in[I_LBR][chn], bi = a->in[I_LBI][chn], spl = softplusf(-a->in[I_LLAM][chn]);
#pragma unroll 1
    for (int t0 = 0; t0 < T; t0 += 4) {
        { const int tok = tid >> 7; xr[tok * 128 + d] = conv4(proj, row0, t0 + tok, 3072 + chn, cstate, wconv, bconv); }
        __syncthreads();
        float ar[4] = {0.f, 0.f, 0.f, 0.f}, ai[4] = {0.f, 0.f, 0.f, 0.f};
#pragma unroll 4
        for (int cc = 0; cc < 32; ++cc) { const int c = part * 32 + cc; const float w1 = wr[c * 128 + d], w2 = wi[c * 128 + d];
#pragma unroll
        for (int tok = 0; tok < 4; ++tok) { const float x = xr[tok * 128 + c]; ar[tok] += x * w1; ai[tok] += x * w2; } }
#pragma unroll
        for (int tok = 0; tok < 4; ++tok) { red[((tok * 2 + 0) * 4 + part) * 128 + d] = ar[tok]; red[((tok * 2 + 1) * 4 + part) * 128 + d] = ai[tok]; }
        __syncthreads();
        if (part == 0) {
    #pragma unroll 1
        for (int tok = 0; tok < 4; ++tok) {
                const int row = row0 + t0 + tok;
                float rp = br, ip = bi;
#pragma unroll
                for (int p = 0; p < 4; ++p) { rp += red[((tok * 2 + 0) * 4 + p) * 128 + d]; ip += red[((tok * 2 + 1) * 4 + p) * 128 + d]; }
                const float log_a = -8.f * sigm(rp) * spl;
                const float av = expf(log_a);
                const float bx = sqrtf(-expm1f(2.f * log_a)) * sigm(ip) * xr[tok * 128 + d];
                hst = av * hst + bx;
                const float gate = bf2f(proj[(size_t)row * NPROJ_PAD + 5120 + chn]);
                mix[(size_t)row * D + 1024 + chn] = (bf16)f2bf(hst * gelu_tanh(gate));
            }
        }
        __syncthreads();
    }
    if (part == 0) hout[chn] = hst;
}

__device__ __forceinline__ void mlstm_rec_item(ArgsP a, LAS unsigned char* lds, int row0, int T, int h, const float* C0, const float* n0, const float* m0, float* Cout, float* nout, float* mout, const int tid) {
    const int lane = tid & 63, wave = tid >> 6, v = tid & 255, kh = tid >> 8;
    const bf16* proj = (const bf16*)(a->ws + WS_PROJ); const float* gates = (const float*)(a->ws + WS_GATES); bf16* mix = (bf16*)(a->ws + WS_MIX);
    LAS float* qs = (LAS float*)lds;
    LAS float* ks = qs + 512;
    LAS float* vs = ks + 512;
    LAS float* gs = vs + 1024;
    LAS float* red = gs + 8;
    LAS float* dred = red + 1024;
    LAS float* hbuf = dred + 4;
    float cst[64];
#pragma unroll
    for (int i = 0; i < 64; ++i) cst[i] = C0 ? C0[(size_t)v * 128 + 64 * kh + i] : 0.f;
    float nst = (tid < 128) ? (n0 ? n0[tid] : 0.f) : 0.f;
    float mst = m0 ? m0[0] : 0.f;
    const float big = a->in[I_BIG][h], bfg = a->in[I_BFG][h];
#pragma unroll 1
    for (int t0 = 0; t0 < T; t0 += 4) {
#pragma unroll
        for (int j = 0; j < 4; ++j) { const int tok = j, row = row0 + t0 + tok; const bf16* pr = proj + (size_t)row * NPROJ_PAD;
            float val;
            if (tid < 128) val = bf2f(pr[h * 128 + tid]); else if (tid < 256) val = bf2f(pr[1024 + h * 128 + (tid - 128)]) * 0.08838834764831845f; else val = bf2f(pr[2048 + h * 256 + (tid - 256)]);
            if (tid < 128) qs[tok * 128 + tid] = val; else if (tid < 256) ks[tok * 128 + tid - 128] = val; else vs[tok * 256 + tid - 256] = val; }
        if (tid < 4) { const int row = row0 + t0 + tid; gs[tid * 2] = gates[(size_t)row * 16 + h] + big; gs[tid * 2 + 1] = gates[(size_t)row * 16 + 8 + h] + bfg; }
        __syncthreads();
#pragma unroll 1
        for (int tok = 0; tok < 4; ++tok) {
            const int par = tok & 1;
            const float ig = gs[tok * 2], lf = logsigf(gs[tok * 2 + 1]);
            const float mnew = fmaxf(lf + mst, ig), fp = expf(lf + mst - mnew), ip = expf(ig - mnew); mst = mnew;
            const float vv = vs[tok * 256 + v] * ip;
            const LAS float* kv = ks + tok * 128 + 64 * kh; const LAS float* qv = qs + tok * 128 + 64 * kh;
            float num = 0.f;
#pragma unroll
            for (int i = 0; i < 64; ++i) { cst[i] = fp * cst[i] + vv * kv[i]; num += cst[i] * qv[i]; }
            red[(par * 2 + kh) * 256 + v] = num;
            if (tid < 128) { nst = fp * nst + ip * ks[tok * 128 + tid]; const float dp = wave_sum(nst * qs[tok * 128 + tid]); if (lane == 0) dred[par * 2 + wave] = dp; }
            __syncthreads();
            if (kh == 0) { const float nm = red[(par * 2) * 256 + v] + red[(par * 2 + 1) * 256 + v]; const float den = dred[par * 2] + dred[par * 2 + 1];
                hbuf[tok * 256 + v] = nm / fmaxf(fabsf(den), expf(-mnew)); }
        }
        __syncthreads();
        if (wave < 4) { const int tok = wave, row = row0 + t0 + tok; float hv[4]; float ss = 0.f;
#pragma unroll
            for (int j = 0; j < 4; ++j) { hv[j] = hbuf[tok * 256 + j * 64 + lane]; ss += hv[j] * hv[j]; }
            const float rstd = rsqrtf(wave_sum(ss) * (1.f / 256.f) + RMS_EPS);
            const float* nw = a->in[I_MNORM] + h * 256;
#pragma unroll
            for (int j = 0; j < 4; ++j) { const int vi = j * 64 + lane; const float op = bf2f(proj[(size_t)row * NPROJ_PAD + 4096 + h * 256 + vi]);
                mix[(size_t)row * D + h * 256 + vi] = (bf16)f2bf(hv[j] * rstd * nw[vi] * sigm(op)); } }
        __syncthreads();
    }
#pragma unroll
    for (int i = 0; i < 64; ++i) Cout[(size_t)v * 128 + 64 * kh + i] = cst[i];
    if (tid < 128) nout[tid] = nst;
    if (tid == 0) mout[0] = mst;
}

__device__ __forceinline__ void phase_mixer_even(ArgsP a, LAS unsigned char* lds, int vcu, int G, const int tid) {
    const int NIT = 64 + 2048;
#pragma unroll 1
    for (int it = vcu; it < NIT; it += G) {
        int kind, row0, T, hn; const float* cst; const float* st0; float* sto;
        if (it < 32) { const int b = it >> 3; hn = it & 7; kind = 0; row0 = b * TP; T = TP; cst = nullptr; st0 = nullptr; sto = a->out + O_DELTAP + (size_t)it * 16384; }
        else if (it < 64) { const int j = it - 32, b = j >> 3; hn = j & 7; kind = 1; row0 = b * TP; T = TP; cst = nullptr; st0 = nullptr; sto = a->out + O_LRUP + (size_t)b * 1024; }
        else if (it < 64 + 1024) { const int j = it - 64, b = j >> 3; hn = j & 7; kind = 0; row0 = MP + b * TS; T = TS; cst = a->in[I_SCONV] + (size_t)b * 3 * 4096; st0 = a->in[I_SDELTA] + (size_t)j * 16384; sto = a->out + O_DELTAS + (size_t)j * 16384; }
        else { const int j = it - 64 - 1024, b = j >> 3; hn = j & 7; kind = 1; row0 = MP + b * TS; T = TS; cst = a->in[I_SCONV] + (size_t)b * 3 * 4096; st0 = a->in[I_SLRU] + (size_t)b * 1024; sto = a->out + O_LRUS + (size_t)b * 1024; }
        if (kind == 0) delta_rec_item(a, lds, row0, T, hn, cst, st0, sto, tid);
        else lru_rec_item(a, lds, row0, T, hn, cst, st0, sto, tid);
    }
    const bf16* proj = (const bf16*)(a->ws + WS_PROJ);
    const int nconv = (BP + BS) * 3 * 4096;
    for (int i = vcu * NTHR + tid; i < nconv; i += G * NTHR) {
        const int ch = i & 4095, rj = i >> 12, j = rj % 3, b = rj / 3;
        if (b < BP) a->out[O_CONVP + (size_t)(b * 3 + j) * 4096 + ch] = bf2f(proj[(size_t)(b * TP + TP - 3 + j) * NPROJ_PAD + ch]);
        else { const int bs = b - BP; a->out[O_CONVS + (size_t)(bs * 3 + j) * 4096 + ch] = bf2f(proj[(size_t)(MP + bs * TS + 1 + j) * NPROJ_PAD + ch]); }
    }
}
__device__ __forceinline__ void phase_mixer_odd(ArgsP a, LAS unsigned char* lds, int vcu, int G, const int tid) {
    const int NIT = 32 + 1024;
#pragma unroll 1
    for (int it = vcu; it < NIT; it += G) {
        int row0, T, h; const float* c0; const float* n0; const float* m0; float* co; float* no; float* mo;
        if (it < 32) { const int b = it >> 3; h = it & 7; row0 = b * TP; T = TP; c0 = nullptr; n0 = nullptr; m0 = nullptr; co = a->out + O_MCP + (size_t)it * 32768; no = a->out + O_MNP + (size_t)it * 128; mo = a->out + O_MMP + it; }
        else { const int j = it - 32, b = j >> 3; h = j & 7; row0 = MP + b * TS; T = TS; c0 = a->in[I_SMC] + (size_t)j * 32768; n0 = a->in[I_SMN] + (size_t)j * 128; m0 = a->in[I_SMM] + j;
               co = a->out + O_MCS + (size_t)j * 32768; no = a->out + O_MNS + (size_t)j * 128; mo = a->out + O_MMS + j; }
        mlstm_rec_item(a, lds, row0, T, h, c0, n0, m0, co, no, mo, tid);
    }
}

__device__ __forceinline__ void phase_ln(const float* p0, const float* p1, const bf16* resid, const float* g, const float* bta, bf16* dst, int gw, int NGW, int lane) {
    for (int m = gw; m < M; m += NGW) {
        float v[32]; float s = 0.f;
#pragma unroll
        for (int j = 0; j < 8; ++j) { const size_t off = (size_t)m * D + j * 256 + lane * 4; f32x4 x = *(const f32x4*)(p0 + off); if (p1) { const f32x4 y = *(const f32x4*)(p1 + off); x = x + y; }
            const v2u rr = *(const v2u*)(resid + off);
            v[4 * j + 0] = x.x + DN_ALPHA * bflo(rr.x); v[4 * j + 1] = x.y + DN_ALPHA * bfhi(rr.x); v[4 * j + 2] = x.z + DN_ALPHA * bflo(rr.y); v[4 * j + 3] = x.w + DN_ALPHA * bfhi(rr.y);
            s += (v[4 * j] + v[4 * j + 1]) + (v[4 * j + 2] + v[4 * j + 3]); }
        const float mean = wave_sum(s) * (1.f / D); float s2 = 0.f;
#pragma unroll
        for (int i = 0; i < 32; ++i) { v[i] -= mean; s2 += v[i] * v[i]; }
        const float rstd = rsqrtf(wave_sum(s2) * (1.f / D) + LN_EPS);
#pragma unroll
        for (int j = 0; j < 8; ++j) { const int col = j * 256 + lane * 4; const f32x4 gg = *(const f32x4*)(g + col), bb = *(const f32x4*)(bta + col);
            v2u o; o.x = pk2(v[4 * j] * rstd * gg.x + bb.x, v[4 * j + 1] * rstd * gg.y + bb.y); o.y = pk2(v[4 * j + 2] * rstd * gg.z + bb.z, v[4 * j + 3] * rstd * gg.w + bb.w);
            *(v2u*)(dst + (size_t)m * D + col) = o; }
    }
}
__device__ __forceinline__ void phase_combine(const float* p0, const float* p1, const bf16* h2, const bf16* pw, bf16* xb, float* outf, int gw, int NGW, int lane) {
    for (int m = gw; m < M; m += NGW) {
#pragma unroll
        for (int j = 0; j < 8; ++j) { const size_t off = (size_t)m * D + j * 256 + lane * 4; f32x4 x = *(const f32x4*)(p0 + off); if (p1) { const f32x4 y = *(const f32x4*)(p1 + off); x = x + y; }
            const v2u hh = *(const v2u*)(h2 + off), pp = *(const v2u*)(pw + off);
            f32x4 o; o.x = bflo(hh.x) + sigm(x.x) * bflo(pp.x); o.y = bfhi(hh.x) + sigm(x.y) * bfhi(pp.x); o.z = bflo(hh.y) + sigm(x.z) * bflo(pp.y); o.w = bfhi(hh.y) + sigm(x.w) * bfhi(pp.y);
            v2u ob; ob.x = pk2(o.x, o.y); ob.y = pk2(o.z, o.w); *(v2u*)(xb + off) = ob;
            if (outf) *(f32x4*)(outf + off) = o; }
    }
}

constexpr int N_PHASES = 19;
enum { GK_F32 = 0, GK_BF16 = 1, GK_SQRELU = 2 };
__global__ void __launch_bounds__(NTHR, 2) mk_fwd(Args a_in) {
    extern __shared__ __attribute__((aligned(16))) unsigned char lds_raw[];
    LAS unsigned char* lds = (LAS unsigned char*)lds_raw;
    ArgsP kp = (ArgsP)__builtin_amdgcn_kernarg_segment_ptr();
    const int lo = a_in.ph_lo, hi = a_in.ph_hi;
#if MK_N_LAUNCHES == 1
    volatile LAS unsigned* xst = (volatile LAS unsigned*)(lds + LDS_CTL_OFF);
    if (threadIdx.x < 2) xst[threadIdx.x] = 0u;
    __syncthreads();
    XcdBarrier bar = xcd_barrier_post((unsigned*)(a_in.ws + WS_CTL) + 4096, xst);
#endif
#pragma unroll 1
    for (int p = lo; p < hi; ++p) {
        int tid = threadIdx.x; asm volatile("" : "+v"(tid));
        int bx = blockIdx.x; asm volatile("" : "+s"(bx));
        int G = gridDim.x; asm volatile("" : "+s"(G));
        ArgsP a = kp; asm volatile("" : "+s"(a));
        const int lane = tid & 63, wave = __builtin_amdgcn_readfirstlane(tid >> 6);
        const int vcu = (G % 8 == 0) ? (bx % 8) * (G / 8) + bx / 8 : bx;
        const int gw = vcu * NWAVES + wave, NGW = G * NWAVES;
        unsigned char* ws = a->ws;
        if (p == 0) {
#ifndef SKIP_CONV
 phase_convert(a, lds, gw, NGW, wave, lane);
#endif
 }
        else {
            const int L = (p - 1) / 9, q = (p - 1) % 9;
            bf16* xb = (bf16*)(ws + WS_XB); bf16* mixb = (bf16*)(ws + WS_MIX); bf16* hb = (bf16*)(ws + WS_H); bf16* h2b = (bf16*)(ws + WS_H2); bf16* pwb = (bf16*)(ws + WS_PW);
            bf16* projb = (bf16*)(ws + WS_PROJ); bf16* upb = (bf16*)(ws + WS_PROJ);
            float* part0 = (float*)(ws + WS_PART0); float* gatesb = (float*)(ws + WS_GATES);
            if (q == 1) {
#ifndef SKIP_MIX
 if (L == 0) phase_mixer_even(a, lds, vcu, G, tid); else phase_mixer_odd(a, lds, vcu, G, tid);
#endif
 }

#ifndef SKIP_LN
 else if (q == 3) phase_ln(part0, nullptr, xb, a->in[I_LN1G] + L * D, a->in[I_LN1B] + L * D, hb, gw, NGW, lane);
            else if (q == 6) phase_ln(part0, nullptr, hb, a->in[I_LN2G] + L * D, a->in[I_LN2B] + L * D, h2b, gw, NGW, lane);
            else if (q == 8) phase_combine(part0, nullptr, h2b, pwb, xb, L == 1 ? a->out + O_Y : nullptr, gw, NGW, lane);
#endif

            else {
                for (int sub = 0; sub < (q == 7 ? 2 : 1); ++sub) {
                    const bf16* A; const bf16* Bt; int N, K, kind; void* out; float* gp = nullptr; int corder = bx;
                    if (q == 0) { A = xb; Bt = (const bf16*)(ws + (L == 0 ? WS_WINE : WS_WINO)); N = NPROJ_PAD; K = D; kind = GK_BF16; out = projb; gp = gatesb; }
                    else if (q == 2) { A = mixb; Bt = (const bf16*)(ws + (L == 0 ? WS_WOUTE : WS_WOUTO)); N = D; K = D; kind = GK_F32; out = part0; }
                    else if (q == 4) { A = hb; Bt = (const bf16*)(ws + WS_WUP) + (size_t)L * D * FF; N = FF; K = D; kind = GK_SQRELU; out = upb; }
                    else if (q == 5) { A = upb; Bt = (const bf16*)(ws + WS_WDOWN) + (size_t)L * D * FF; N = D; K = FF; kind = GK_F32; out = part0; }
                    else if (sub == 0) { A = h2b; Bt = (const bf16*)(ws + WS_WGATE) + (size_t)L * D * D; N = D; K = D; kind = GK_F32; out = part0; }
                    else { A = (const bf16*)(ws + WS_PB) + (size_t)L * M * PLE; Bt = (const bf16*)(ws + WS_WPLE) + (size_t)L * PLE * D; N = D; K = PLE; kind = GK_BF16; out = pwb; corder = (bx + 128) % G; }
                    pg8::Gemm g{A, Bt, M, N, K}; pg8::StaticOrder S; S.init(M, N, G, corder);
                    if (kind == GK_F32) { pg8::EpiF32 E{(float*)out, N}; pg8::gemm_phase<pg8::EpiF32, pg8::StaticOrder, true, true>(lds, g, S, E, tid); }
                    else if (kind == GK_BF16) { pg8::EpiBf16<0> E{(bf16*)out, N, gp, 24}; pg8::gemm_phase<pg8::EpiBf16<0>, pg8::StaticOrder, true, true>(lds, g, S, E, tid); }
                    else { pg8::EpiBf16<1> E{(bf16*)out, N, nullptr, -1}; pg8::gemm_phase<pg8::EpiBf16<1>, pg8::StaticOrder, true, true>(lds, g, S, E, tid); }
                }
            }
        }
#if MK_N_LAUNCHES == 1
        if (p + 1 < hi) { if (p == lo) cg::this_grid().sync(); else xcd_barrier(bar); }
#endif
    }
}

extern "C" void kernel_launch(void* const* d_in, const int* in_sizes, int n_in, void* d_out, int out_size, void* d_ws, size_t ws_size, hipStream_t stream) {
    static int grid = 0;
    if (grid == 0) {
        if (n_in != 35 || (size_t)out_size != O_END || ws_size < WS_END) { fprintf(stderr, "kernel_launch: unexpected shapes: n_in %d out %d (want %zu) ws %zu (want %zu)\n", n_in, out_size, (size_t)O_END, ws_size, (size_t)WS_END); grid = -1; return; }
        int dev = 0, cus = 0, per_cu = 0;
        hipGetDevice(&dev); hipDeviceGetAttribute(&cus, hipDeviceAttributeMultiprocessorCount, dev);
        if (hipFuncSetAttribute((const void*)mk_fwd, hipFuncAttributeMaxDynamicSharedMemorySize, LDS_BYTES) != hipSuccess) { fprintf(stderr, "kernel_launch: hipFuncSetAttribute failed\n"); grid = -1; return; }
        if (hipOccupancyMaxActiveBlocksPerMultiprocessor(&per_cu, (const void*)mk_fwd, NTHR, LDS_BYTES) != hipSuccess || per_cu < 1) { fprintf(stderr, "kernel_launch: occupancy query says %d\n", per_cu); per_cu = 1; }
        (void)hipGetLastError();
        grid = cus * 1;
    }
    if (grid < 0) return;
    Args a{};
    for (int i = 0; i < 35; ++i) a.in[i] = (const float*)d_in[i];
    a.out = (float*)d_out; a.ws = (unsigned char*)d_ws;
#if MK_N_LAUNCHES == 1
    hipMemsetAsync((char*)d_ws + WS_CTL, 0, 1 * MiB, stream);
    a.ph_lo = 0; a.ph_hi = N_PHASES;
    void* args[] = {&a};
    hipError_t e = hipLaunchCooperativeKernel((const void*)mk_fwd, dim3(grid), dim3(NTHR), args, LDS_BYTES, stream);
    if (e != hipSuccess) fprintf(stderr, "cooperative launch failed: %s (grid %d)\n", hipGetErrorString(e), grid);
#else
    for (int p = 0; p < N_PHASES; ++p) {
        a.ph_lo = p; a.ph_hi = p + 1;
        hipLaunchKernelGGL(mk_fwd, dim3(grid), dim3(NTHR), LDS_BYTES, stream, a);
    }
#endif
}
```

```cpp
#include <hip/hip_runtime.h>
#include <hip/hip_cooperative_groups.h>
#include <cstdio>
#include <cstdint>
namespace cg = cooperative_groups;

#ifndef MK_N_LAUNCHES
#define MK_N_LAUNCHES 1
#endif

namespace pg8 {
#define PG8_LAS __attribute__((address_space(3)))
typedef unsigned short bf16_t;
typedef short bf16x8 __attribute__((ext_vector_type(8)));
typedef float f32x4 __attribute__((ext_vector_type(4)));
typedef unsigned u32x4 __attribute__((ext_vector_type(4)));
constexpr int BM = 256, BK = 64, HALF = 128, HTB = HALF * BK * 2, STAGE_BYTES = 8 * HTB, NXCD = 8, WGM = 8;

__host__ __device__ __forceinline__ int lds_byte(int r, int c) { const int st = (r >> 4) * 2 + (c >> 5), rr = r & 15, cc = c & 31, ob = rr * 64 + cc * 2; return st * 1024 + (ob ^ (((ob >> 9) & 1) << 5)); }
__host__ __device__ __forceinline__ void stage_rc(int b, int& R, int& C) { const int st = b / 1024, sb = b % 1024, swz = sb ^ (((sb >> 9) & 1) << 5); R = (st >> 1) * 16 + swz / 64; C = (st & 1) * 32 + (swz % 64) / 2; }
__host__ __device__ __forceinline__ int perm32(int rho) { const int n = rho >> 4, i = rho & 15; return 8 * (i >> 2) + 4 * n + (i & 3); }

struct Unit { int pm, pn; };
struct Gemm { const bf16_t* A; const bf16_t* Bt; int M, N, K; };

struct StaticOrder {
    int nM, nN, nwg, G, c;
    __host__ __device__ void init(int M, int N, int G_, int c_) { nM = M / BM; nN = N / BM; nwg = nM * nN; G = G_; c = c_; }
    __host__ __device__ bool next(int i, Unit& u) const {
        const long L = (long)i * G + c; if (L >= nwg) return false;
        int wgid = (int)L; { const int q = nwg / NXCD, r = nwg % NXCD, xcd = wgid % NXCD, off = wgid / NXCD; wgid = (xcd < r ? xcd * (q + 1) : r * (q + 1) + (xcd - r) * q) + off; }
        const int nig = WGM * nN, gid = wgid / nig, fm = gid * WGM, gsz = (nM - fm) < WGM ? (nM - fm) : WGM;
        u.pm = fm + ((wgid % nig) % gsz); u.pn = (wgid % nig) / gsz; return true;
    }
    __device__ __forceinline__ void a_ready(const Unit&) const {}
    __device__ __forceinline__ void done(const Unit&) const {}
};

__device__ __forceinline__ unsigned cvt_pk_bf16(float lo, float hi) { unsigned r; asm volatile("v_cvt_pk_bf16_f32 %0, %1, %2" : "=v"(r) : "v"(lo), "v"(hi)); return r; }

struct EpiF32 {
    static constexpr bool PERM = false, AFTER_DRAIN = false;
    float* C; int ldc;
    __device__ __forceinline__ void operator()(const f32x4 (&acc)[2][2][4][2], const Unit& u, int wr, int wc, int fr, int fq) const {
        const int row0 = u.pm * BM + wr * 64 + fr, col0 = u.pn * BM + wc * 32 + 4 * fq;
#pragma unroll
        for (int ai = 0; ai < 2; ++ai)
#pragma unroll
            for (int m = 0; m < 4; ++m) { float* rowp = C + (size_t)(row0 + ai * HALF + m * 16) * ldc + col0;
#pragma unroll
                for (int bj = 0; bj < 2; ++bj)
#pragma unroll
                    for (int n = 0; n < 2; ++n) *(f32x4*)(rowp + bj * HALF + n * 16) = acc[ai][bj][m][n]; }
    }
};
template <int ACT> struct EpiBf16 {
    static constexpr bool PERM = true, AFTER_DRAIN = false;
    bf16_t* O; int ldc; float* gates; int gate_pn;
    __device__ __forceinline__ void operator()(const f32x4 (&acc)[2][2][4][2], const Unit& u, int wr, int wc, int fr, int fq) const {
        const int row0 = u.pm * BM + wr * 64 + fr; const int col0 = u.pn * BM + wc * 32 + 8 * fq;
        const bool gt = (gates != nullptr) && (u.pn == gate_pn) && (wc == 0) && (fq < 2);
#pragma unroll
        for (int ai = 0; ai < 2; ++ai)
#pragma unroll
            for (int m = 0; m < 4; ++m) { const int row = row0 + ai * HALF + m * 16; bf16_t* rowp = O + (size_t)row * ldc + col0;
#pragma unroll
                for (int bj = 0; bj < 2; ++bj) { f32x4 v0 = acc[ai][bj][m][0], v1 = acc[ai][bj][m][1];
                    if (ACT == 1) {
#pragma unroll
                        for (int j = 0; j < 4; ++j) { const float a = fmaxf(v0[j], 0.f), b = fmaxf(v1[j], 0.f); v0[j] = a * a; v1[j] = b * b; } }
                    u32x4 w; w.x = cvt_pk_bf16(v0[0], v0[1]); w.y = cvt_pk_bf16(v0[2], v0[3]); w.z = cvt_pk_bf16(v1[0], v1[1]); w.w = cvt_pk_bf16(v1[2], v1[3]);
                    *(u32x4*)(rowp + bj * HALF) = w; }
                if (gt) { float* gp = gates + (size_t)row * 16 + 8 * fq; *(f32x4*)gp = acc[ai][0][m][0]; *(f32x4*)(gp + 4) = acc[ai][0][m][1]; } }
    }
};

template <class Epi, class Sched, bool ALIGN_EPI = false, bool SP2 = false>
__device__ __forceinline__ void gemm_phase(PG8_LAS unsigned char* lds, const Gemm g, const Sched& S, const Epi& E, const int tid) {
    const int wid = __builtin_amdgcn_readfirstlane(tid >> 6), lane = tid & 63, wr = wid >> 2, wc = wid & 3, fr = lane & 15, fq = lane >> 4;
    const int K = g.K, nt = K / BK;
    unsigned voffA[2], voffB[2];
#pragma unroll
    for (int i = 0; i < 2; ++i) { int R, C; stage_rc(tid * 16 + i * 8192, R, C); const int Rb = Epi::PERM ? ((R & ~31) + perm32(R & 31)) : R;
        voffA[i] = (unsigned)(R * K + C) * 2u; voffB[i] = (unsigned)(Rb * K + C) * 2u; }
    const size_t kstep = (size_t)(BK * 2);
    const size_t hstep = (size_t)HALF * K * 2;
    const size_t tstep = 2 * hstep;
    const unsigned ldsw = (unsigned)wid * 1024u;
    const int aoff = lds_byte(wr * 64 + fr, fq * 8), boff = lds_byte(wc * 32 + fr, fq * 8);
#define PG8_SA(b, h) (((b) * 2 + (h)) * HTB)
#define PG8_SB(b, h) ((4 + (b) * 2 + (h)) * HTB)
#define PG8_STAGE(bufoff, gbase, voff) do { _Pragma("unroll") for (int _i = 0; _i < 2; ++_i) \
        __builtin_amdgcn_global_load_lds((const unsigned*)((const char*)(gbase) + (voff)[_i]), (PG8_LAS unsigned*)(lds + (bufoff) + ldsw + _i * 8192), 16, 0, 0); } while (0)
#define PG8_LDA(dst, b, h) do { _Pragma("unroll") for (int m = 0; m < 4; ++m) _Pragma("unroll") for (int k = 0; k < 2; ++k) dst[m][k] = *(const PG8_LAS bf16x8*)(lds + PG8_SA(b, h) + aoff + m * 2048 + k * 1024); } while (0)
#define PG8_LDB(dst, b, h) do { _Pragma("unroll") for (int n = 0; n < 2; ++n) _Pragma("unroll") for (int k = 0; k < 2; ++k) dst[n][k] = *(const PG8_LAS bf16x8*)(lds + PG8_SB(b, h) + boff + n * 2048 + k * 1024); } while (0)
#define PG8_MMA(ai, bj, At, Bt) do { __builtin_amdgcn_s_setprio(1); _Pragma("unroll") for (int m = 0; m < 4; ++m) _Pragma("unroll") for (int n = 0; n < 2; ++n) _Pragma("unroll") for (int k = 0; k < 2; ++k) \
        acc[ai][bj][m][n] = __builtin_amdgcn_mfma_f32_16x16x32_bf16(Bt[n][k], At[m][k], acc[ai][bj][m][n], 0, 0, 0); __builtin_amdgcn_s_setprio(0); } while (0)
#define PG8_WAIT_V(n) asm volatile("s_waitcnt vmcnt(" #n ")" ::: "memory")
#define PG8_WAIT_L(n) asm volatile("s_waitcnt lgkmcnt(" #n ")" ::: "memory")
#define PG8_BAR __builtin_amdgcn_s_barrier()
#define PG8_SCHED __builtin_amdgcn_sched_barrier(0)
    Unit cur, nxt; int ui = 0;
    if (!S.next(0, cur)) return;
    f32x4 acc[2][2][4][2];
#pragma unroll
    for (int a = 0; a < 2; ++a)
#pragma unroll
        for (int b = 0; b < 2; ++b)
#pragma unroll
            for (int m = 0; m < 4; ++m)
#pragma unroll
                for (int n = 0; n < 2; ++n) acc[a][b][m][n] = (f32x4){0.f, 0.f, 0.f, 0.f};
    bf16x8 At[4][2], B0[2][2], B1[2][2];
    const char* cA = (const char*)g.A + (size_t)cur.pm * tstep; const char* cB = (const char*)g.Bt + (size_t)cur.pn * tstep;
    S.a_ready(cur);
    if constexpr (SP2) {
        PG8_STAGE(PG8_SB(0, 0), cB, voffB); PG8_STAGE(PG8_SB(0, 1), cB + hstep, voffB); PG8_STAGE(PG8_SA(0, 0), cA, voffA); PG8_STAGE(PG8_SA(0, 1), cA + hstep, voffA);
        if (wr == 1) PG8_BAR;
        PG8_WAIT_V(2); PG8_BAR;
        PG8_STAGE(PG8_SB(1, 0), cB + kstep, voffB); PG8_STAGE(PG8_SA(1, 0), cA + kstep, voffA); PG8_STAGE(PG8_SB(1, 1), cB + hstep + kstep, voffB);
        PG8_WAIT_V(6); PG8_BAR;
    } else {
        PG8_STAGE(PG8_SB(0, 0), cB, voffB); PG8_STAGE(PG8_SA(0, 0), cA, voffA); PG8_STAGE(PG8_SB(0, 1), cB + hstep, voffB); PG8_STAGE(PG8_SA(0, 1), cA + hstep, voffA);
        if (wr == 1) PG8_BAR;
        PG8_WAIT_V(4); PG8_BAR;
        PG8_STAGE(PG8_SB(1, 0), cB + kstep, voffB); PG8_STAGE(PG8_SA(1, 0), cA + kstep, voffA); PG8_STAGE(PG8_SB(1, 1), cB + hstep + kstep, voffB);
        PG8_WAIT_V(6); PG8_BAR;
    }
    for (;;) {
        const bool has_next = S.next(ui + 1, nxt);
        const char* nA = has_next ? (const char*)g.A + (size_t)nxt.pm * tstep : cA; const char* nB = has_next ? (const char*)g.Bt + (size_t)nxt.pn * tstep : cB;
        for (int t = 0; t < nt; t += 2) {
            const bool last = (t == nt - 2);
            const char* a1 = cA + (size_t)(t + 1) * kstep;
            const char* a2 = last ? nA : cA + (size_t)(t + 2) * kstep; const char* b2 = last ? nB : cB + (size_t)(t + 2) * kstep;
            const char* a3 = a2 + kstep; const char* b3 = b2 + kstep;
            if (last && has_next) S.a_ready(nxt);
            if constexpr (SP2) {
            PG8_LDB(B0, 0, 0); PG8_LDB(B1, 0, 1); PG8_SCHED; PG8_LDA(At, 0, 0); PG8_STAGE(PG8_SA(1, 1), a1 + hstep, voffA);
            PG8_WAIT_V(8); PG8_WAIT_L(0); PG8_BAR; PG8_MMA(0, 0, At, B0); PG8_MMA(0, 1, At, B1); PG8_BAR; PG8_SCHED;
            PG8_LDA(At, 0, 1); PG8_STAGE(PG8_SB(0, 0), b2, voffB); PG8_STAGE(PG8_SB(0, 1), b2 + hstep, voffB); PG8_STAGE(PG8_SA(0, 0), a2, voffA);
            PG8_WAIT_V(8); PG8_WAIT_L(0); PG8_BAR; PG8_MMA(1, 0, At, B0); PG8_MMA(1, 1, At, B1); PG8_BAR; PG8_SCHED;
            PG8_LDB(B0, 1, 0); PG8_LDB(B1, 1, 1); PG8_SCHED; PG8_LDA(At, 1, 0); PG8_STAGE(PG8_SA(0, 1), a2 + hstep, voffA);
            PG8_WAIT_V(8); PG8_WAIT_L(0); PG8_BAR; PG8_MMA(0, 0, At, B0); PG8_MMA(0, 1, At, B1); PG8_BAR; PG8_SCHED;
            PG8_LDA(At, 1, 1); PG8_STAGE(PG8_SB(1, 0), b3, voffB); PG8_STAGE(PG8_SB(1, 1), b3 + hstep, voffB); PG8_STAGE(PG8_SA(1, 0), a3, voffA);
            PG8_WAIT_V(8); PG8_WAIT_L(0); PG8_BAR; PG8_MMA(1, 0, At, B0); PG8_MMA(1, 1, At, B1); PG8_BAR; PG8_SCHED;
            } else {
            PG8_LDB(B0, 0, 0); PG8_SCHED; PG8_LDA(At, 0, 0); PG8_STAGE(PG8_SA(1, 1), a1 + hstep, voffA);
            PG8_WAIT_L(8); PG8_BAR; PG8_WAIT_L(0); PG8_MMA(0, 0, At, B0); PG8_BAR; PG8_SCHED;
            PG8_LDB(B1, 0, 1); PG8_STAGE(PG8_SB(0, 0), b2, voffB);
            PG8_BAR; PG8_WAIT_L(0); PG8_MMA(0, 1, At, B1); PG8_BAR;
            PG8_LDA(At, 0, 1); PG8_STAGE(PG8_SA(0, 0), a2, voffA);
            PG8_BAR; PG8_WAIT_L(0); PG8_MMA(1, 0, At, B0); PG8_BAR; PG8_SCHED;
            PG8_STAGE(PG8_SB(0, 1), b2 + hstep, voffB);
            PG8_WAIT_V(6); PG8_BAR; PG8_MMA(1, 1, At, B1); PG8_BAR;
            PG8_LDB(B0, 1, 0); PG8_SCHED; PG8_LDA(At, 1, 0); PG8_STAGE(PG8_SA(0, 1), a2 + hstep, voffA);
            PG8_WAIT_L(8); PG8_BAR; PG8_WAIT_L(0); PG8_MMA(0, 0, At, B0); PG8_BAR; PG8_SCHED;
            PG8_LDB(B1, 1, 1); PG8_STAGE(PG8_SB(1, 0), b3, voffB);
            PG8_BAR; PG8_WAIT_L(0); PG8_MMA(0, 1, At, B1); PG8_BAR;
            PG8_LDA(At, 1, 1); PG8_STAGE(PG8_SA(1, 0), a3, voffA);
            PG8_BAR; PG8_WAIT_L(0); PG8_MMA(1, 0, At, B0); PG8_BAR; PG8_SCHED;
            PG8_STAGE(PG8_SB(1, 1), b3 + hstep, voffB);
            PG8_WAIT_V(6); PG8_BAR; PG8_MMA(1, 1, At, B1); PG8_BAR;
            }
        }
        if constexpr (ALIGN_EPI) { if (wr == 0) PG8_BAR; }
        E(acc, cur, wr, wc, fr, fq); S.done(cur);
        if (!has_next) break;
#pragma unroll
        for (int a = 0; a < 2; ++a)
#pragma unroll
            for (int b = 0; b < 2; ++b)
#pragma unroll
                for (int m = 0; m < 4; ++m)
#pragma unroll
                    for (int n = 0; n < 2; ++n) acc[a][b][m][n] = (f32x4){0.f, 0.f, 0.f, 0.f};
        cur = nxt; cA = nA; cB = nB; ++ui;
        if constexpr (ALIGN_EPI) { if (wr == 1) PG8_BAR; }
    }
    PG8_WAIT_V(0);
    if constexpr (!ALIGN_EPI) { if (wr == 0) PG8_BAR; }
    PG8_BAR;
#undef PG8_SA
#undef PG8_SB
#undef PG8_STAGE
#undef PG8_LDA
#undef PG8_LDB
#undef PG8_MMA
#undef PG8_WAIT_V
#undef PG8_WAIT_L
#undef PG8_BAR
#undef PG8_SCHED
}
}

constexpr int NWAVES = 8, NTHR = 512;
constexpr int D = 2048, FF = 8192, PLE = 256;
constexpr int TP = 2048, BP = 4, TS = 4, BS = 128;
constexpr int MP = BP * TP, MS = BS * TS, M = MP + MS;
constexpr int NPROJ = 6160, NPROJ_PAD = 6400;
constexpr int NH = 8;
constexpr float LN_EPS = 1e-5f, RMS_EPS = 1e-6f;
constexpr float DN_ALPHA = 1.41421356237f;

constexpr size_t MiB = 1u << 20;
constexpr size_t WS_CTL = 0;
constexpr size_t WS_WINE = 1 * MiB;
constexpr size_t WS_WOUTE = WS_WINE + 25 * MiB;
constexpr size_t WS_WINO = WS_WOUTE + 8 * MiB;
constexpr size_t WS_WOUTO = WS_WINO + 25 * MiB;
constexpr size_t WS_WUP = WS_WOUTO + 8 * MiB;
constexpr size_t WS_WDOWN = WS_WUP + 64 * MiB;
constexpr size_t WS_WPLE = WS_WDOWN + 64 * MiB;
constexpr size_t WS_WGATE = WS_WPLE + 2 * MiB;
constexpr size_t WS_XB = WS_WGATE + 16 * MiB;
constexpr size_t WS_MIX = WS_XB + 34 * MiB;
constexpr size_t WS_H = WS_MIX + 34 * MiB;
constexpr size_t WS_H2 = WS_H + 34 * MiB;
constexpr size_t WS_PW = WS_H2 + 34 * MiB;
constexpr size_t WS_PB = WS_PW + 34 * MiB;
constexpr size_t WS_GATES = WS_PB + 9 * MiB;
constexpr size_t WS_PROJ = WS_GATES + 1 * MiB;
constexpr size_t WS_PART0 = WS_PROJ + 136 * MiB;
constexpr size_t WS_PART1 = WS_PART0 + 68 * MiB;
constexpr size_t WS_LRUW = WS_PART1 + 68 * MiB;
constexpr size_t WS_END = WS_LRUW + 1 * MiB;
constexpr size_t WS_DG = WS_PART0;
constexpr size_t WS_DB = WS_PART0 + 32 * MiB;
constexpr size_t WS_DS = WS_PART0 + 64 * MiB;
constexpr size_t WS_DQ = WS_PART0 + 96 * MiB;
constexpr size_t WS_DO = WS_PART0 + 112 * MiB;
constexpr size_t WS_DD = WS_PART0 + 128 * MiB;
constexpr size_t WS_DF = WS_PART0 + 129 * MiB;
constexpr size_t WS_LRU_HL = WS_H;
constexpr size_t WS_LRU_P = WS_H + 16 * MiB;
constexpr size_t WS_LRU_END = WS_H + 32 * MiB;

constexpr size_t O_Y = 0;
constexpr size_t O_CONVP = (size_t)M * D;
constexpr size_t O_DELTAP = O_CONVP + (size_t)BP * 3 * 4096;
constexpr size_t O_LRUP = O_DELTAP + (size_t)BP * 8 * 128 * 128;
constexpr size_t O_MCP = O_LRUP + (size_t)BP * 1024;
constexpr size_t O_MNP = O_MCP + (size_t)BP * 8 * 256 * 128;
constexpr size_t O_MMP = O_MNP + (size_t)BP * 8 * 128;
constexpr size_t O_CONVS = O_MMP + (size_t)BP * 8;
constexpr size_t O_DELTAS = O_CONVS + (size_t)BS * 3 * 4096;
constexpr size_t O_LRUS = O_DELTAS + (size_t)BS * 8 * 128 * 128;
constexpr size_t O_MCS = O_LRUS + (size_t)BS * 1024;
constexpr size_t O_MNS = O_MCS + (size_t)BS * 8 * 256 * 128;
constexpr size_t O_MMS = O_MNS + (size_t)BS * 8 * 128;
constexpr size_t O_END = O_MMS + (size_t)BS * 8;

constexpr int LDS_BYTES = 147456;
constexpr int LDS_CTL_OFF = 131072;

#define LAS __attribute__((address_space(3)))
typedef unsigned short bf16;
typedef unsigned v4u __attribute__((ext_vector_type(4)));
typedef unsigned v2u __attribute__((ext_vector_type(2)));
typedef float f32x4 __attribute__((ext_vector_type(4)));
#define LDS_WAIT() asm volatile("s_waitcnt lgkmcnt(0)" ::: "memory")
__device__ __forceinline__ unsigned f2bf(float f) { unsigned u = __builtin_bit_cast(unsigned, f); return (u + 0x7fffu + ((u >> 16) & 1u)) >> 16; }
__device__ __forceinline__ unsigned pk2(float lo, float hi) { return f2bf(lo) | (f2bf(hi) << 16); }
__device__ __forceinline__ float bf2f(unsigned short b) { return __builtin_bit_cast(float, ((unsigned)b) << 16); }
__device__ __forceinline__ float bflo(unsigned w) { return __builtin_bit_cast(float, w << 16); }
__device__ __forceinline__ float bfhi(unsigned w) { return __builtin_bit_cast(float, w & 0xffff0000u); }
__device__ __forceinline__ float sigm(float x) { return 1.f / (1.f + expf(-x)); }
__device__ __forceinline__ float siluf(float x) { return x * sigm(x); }
__device__ __forceinline__ float softplusf(float x) { return fmaxf(x, 0.f) + log1pf(expf(-fabsf(x))); }
__device__ __forceinline__ float logsigf(float x) { return -softplusf(-x); }
__device__ __forceinline__ float gelu_tanh(float x) { const float u = 0.7978845608028654f * (x + 0.044715f * x * x * x); return 0.5f * x * (1.f + tanhf(u)); }
__device__ __forceinline__ float wave_sum(float v) {
#pragma unroll
    for (int o = 1; o < 64; o <<= 1) v += __shfl_xor(v, o);
    return v;
}

#define XB_TMO      128
#define XB_XCNT(j)  (256  + 64 * (j))
#define XB_XSUB(j)  (1280 + 64 * (j))
#define XB_XGEN(j)  (2304 + 64 * (j))
#define XB_TOP      3328
#define XB_TOPGEN   3392
#define XCD_BAR_WORDS 3456
#define XB_SPIN_CAP (1u << 22)
__device__ __forceinline__ unsigned xb_ld(unsigned* p)              { return __hip_atomic_load(p, __ATOMIC_RELAXED, __HIP_MEMORY_SCOPE_AGENT); }
__device__ __forceinline__ unsigned xb_add(unsigned* p, unsigned v) { return __hip_atomic_fetch_add(p, v, __ATOMIC_RELAXED, __HIP_MEMORY_SCOPE_AGENT); }
__device__ __forceinline__ unsigned xb_xcc_id() { return (unsigned)__builtin_amdgcn_s_getreg((3 << 11) | 20) & 0xFu; }
#define XB_SPIN(cond, bar) do { unsigned _sp = 0; while (cond) { __builtin_amdgcn_s_sleep(1); \
    if ((++_sp & 255u) == 0u) { if (xb_ld(&(bar)[XB_TMO])) break; if (_sp > XB_SPIN_CAP) { atomicAdd(&(bar)[XB_TMO], 1u); break; } } } } while (0)
struct XcdBarrier { unsigned* bar; unsigned x; volatile LAS unsigned* st; };
__device__ __forceinline__ XcdBarrier xcd_barrier_post(unsigned* bar, volatile LAS unsigned* st) {
    XcdBarrier b; b.bar = bar; b.x = xb_xcc_id(); b.st = st;
    if (threadIdx.x == 0) (void)xb_add(&bar[XB_XCNT(b.x)], 1u);
    return b;
}
__device__ __forceinline__ void xcd_barrier_complete(unsigned* bar, unsigned x, unsigned& nloc, unsigned& nx) {
    const unsigned G = gridDim.x * gridDim.y * gridDim.z;
    unsigned sum, cnt, mine, sp = 0u;
    for (;;) {
        sum = 0u; cnt = 0u; mine = 0u;
#pragma unroll
        for (unsigned j = 0; j < 16; ++j) { const unsigned c = xb_ld(&bar[XB_XCNT(j)]); sum += c; cnt += (c > 0u) ? 1u : 0u; mine = (j == x) ? c : mine; }
        if (sum == G) break;
        __builtin_amdgcn_s_sleep(1);
        if ((++sp & 255u) == 0u) { if (xb_ld(&bar[XB_TMO])) break; if (sp > XB_SPIN_CAP) { atomicAdd(&bar[XB_TMO], 1u); break; } }
    }
    nloc = mine > 0u ? mine : 1u; nx = cnt > 0u ? cnt : 1u;
}
__device__ __forceinline__ void xcd_barrier(const XcdBarrier& b) {
    asm volatile("s_waitcnt vmcnt(0)" ::: "memory");
    __syncthreads();
    if (threadIdx.x == 0) {
        unsigned* bar = b.bar;
        __builtin_amdgcn_s_waitcnt(0);
        unsigned nloc = b.st[0], nx = b.st[1];
        if (nloc == 0u) { xcd_barrier_complete(bar, b.x, nloc, nx); b.st[0] = nloc; b.st[1] = nx; }
        const unsigned old = xb_add(&bar[XB_XSUB(b.x)], 1u);
        const unsigned gen = old / nloc;
        if (old + 1u == (gen + 1u) * nloc) {
            __builtin_amdgcn_fence(__ATOMIC_RELEASE, "agent");
            asm volatile("s_waitcnt vmcnt(0)" ::: "memory");
            const unsigned og = xb_add(&bar[XB_TOP], 1u);
            const unsigned tg = og / nx;
            if (og + 1u == (tg + 1u) * nx) xb_add(&bar[XB_TOPGEN], 1u);
            else XB_SPIN(xb_ld(&bar[XB_TOPGEN]) == tg, bar);
            __builtin_amdgcn_fence(__ATOMIC_ACQUIRE, "agent");
            xb_add(&bar[XB_XGEN(b.x)], 1u);
            asm volatile("s_waitcnt vmcnt(0)" ::: "memory");
        } else {
            XB_SPIN(xb_ld(&bar[XB_XGEN(b.x)]) == gen, bar);
            __builtin_amdgcn_fence(__ATOMIC_ACQUIRE, "agent");
            asm volatile("s_waitcnt vmcnt(0)" ::: "memory");
        }
    }
    __syncthreads();
}

struct Args { const float* in[35]; float* out; unsigned char* ws; int ph_lo, ph_hi; };
typedef const __attribute__((address_space(4))) Args* ArgsP;
enum { I_XP = 0, I_XS, I_PP, I_PS, I_SCONV, I_SDELTA, I_SLRU, I_SMC, I_SMN, I_SMM, I_WINE, I_WCONV, I_BCONV, I_ALOG, I_DTB, I_DNORM, I_LWR, I_LBR, I_LWI, I_LBI, I_LLAM, I_WOUTE,
       I_WINO, I_BIG, I_BFG, I_MNORM, I_WOUTO, I_LN1G, I_LN1B, I_LN2G, I_LN2B, I_WUP, I_WDOWN, I_WPLE, I_WGATE };

__device__ __forceinline__ void p0_transpose_item(const float* W, int K, int N, int Npad, bf16* WT, LAS float* scr, int item, int lane) {
    const int nblk = Npad / 32, kb = item / nblk, nb = item % nblk, k0 = 64 * kb, n0 = 32 * nb;
    const int nn = n0 + (lane & 31); const bool ok = nn < N;
#pragma unroll 8
    for (int i = 0; i < 32; ++i) { const int kk = 2 * i + (lane >> 5); scr[kk * 33 + (lane & 31)] = ok ? W[(size_t)(k0 + kk) * N + nn] : 0.f; }
    LDS_WAIT(); asm volatile("" ::: "memory");
    const int c = lane & 7;
#pragma unroll
    for (int j = 0; j < 4; ++j) { const int n = (lane >> 3) + 8 * j; const LAS float* s = scr + (8 * c) * 33 + n;
        v4u o; o.x = pk2(s[0 * 33], s[1 * 33]); o.y = pk2(s[2 * 33], s[3 * 33]); o.z = pk2(s[4 * 33], s[5 * 33]); o.w = pk2(s[6 * 33], s[7 * 33]);
        *(v4u*)(WT + (size_t)(n0 + n) * K + k0 + 8 * c) = o; }
    LDS_WAIT(); asm volatile("" ::: "memory");
}
__device__ __forceinline__ void row_to_bf16(const float* src, bf16* dst, int n, int lane) {
    for (int j = 0; j < n / 256; ++j) { const f32x4 v = *(const f32x4*)(src + j * 256 + lane * 4); v2u o; o.x = pk2(v.x, v.y); o.y = pk2(v.z, v.w); *(v2u*)(dst + j * 256 + lane * 4) = o; }
}

__device__ __forceinline__ void phase_convert(ArgsP a, LAS unsigned char* lds, int gw, int NGW, int wave, int lane) {
    unsigned char* ws = a->ws;
    LAS float* scr = (LAS float*)(lds + wave * 16384);
    constexpr int I_IN = (D / 64) * (NPROJ_PAD / 32), I_SQ = (D / 64) * (D / 32), I_UP = (D / 64) * (FF / 32), I_DN = (FF / 64) * (D / 32), I_PL = (PLE / 64) * (D / 32);
    constexpr int NITEMS = 2 * I_IN + 2 * I_SQ + 2 * I_UP + 2 * I_DN + 2 * I_PL + 2 * I_SQ + 128;
    for (int it = gw; it < NITEMS; it += NGW) {
        int r = it;
        if (r < I_IN) { p0_transpose_item(a->in[I_WINE], D, NPROJ, NPROJ_PAD, (bf16*)(ws + WS_WINE), scr, r, lane); continue; } r -= I_IN;
        if (r < I_IN) { p0_transpose_item(a->in[I_WINO], D, NPROJ, NPROJ_PAD, (bf16*)(ws + WS_WINO), scr, r, lane); continue; } r -= I_IN;
        if (r < I_SQ) { p0_transpose_item(a->in[I_WOUTE], D, D, D, (bf16*)(ws + WS_WOUTE), scr, r, lane); continue; } r -= I_SQ;
        if (r < I_SQ) { p0_transpose_item(a->in[I_WOUTO], D, D, D, (bf16*)(ws + WS_WOUTO), scr, r, lane); continue; } r -= I_SQ;
        if (r < 2 * I_UP) { const int l = r / I_UP; p0_transpose_item(a->in[I_WUP] + (size_t)l * D * FF, D, FF, FF, (bf16*)(ws + WS_WUP) + (size_t)l * D * FF, scr, r % I_UP, lane); continue; } r -= 2 * I_UP;
        if (r < 2 * I_DN) { const int l = r / I_DN; p0_transpose_item(a->in[I_WDOWN] + (size_t)l * D * FF, FF, D, D, (bf16*)(ws + WS_WDOWN) + (size_t)l * D * FF, scr, r % I_DN, lane); continue; } r -= 2 * I_DN;
        if (r < 2 * I_PL) { const int l = r / I_PL; p0_transpose_item(a->in[I_WPLE] + (size_t)l * PLE * D, PLE, D, D, (bf16*)(ws + WS_WPLE) + (size_t)l * PLE * D, scr, r % I_PL, lane); continue; } r -= 2 * I_PL;
        if (r < 2 * I_SQ) { const int l = r / I_SQ; p0_transpose_item(a->in[I_WGATE] + (size_t)l * D * D, D, D, D, (bf16*)(ws + WS_WGATE) + (size_t)l * D * D, scr, r % I_SQ, lane); continue; } r -= 2 * I_SQ;
        { const int mat = r / 64, blk = (r / 8) & 7; p0_transpose_item(a->in[mat == 0 ? I_LWR : I_LWI] + (size_t)blk * 16384, 128, 128, 128, (bf16*)(ws + WS_LRUW) + (size_t)(mat * 8 + blk) * 16384, scr, r % 8, lane); }
    }
    bf16* xb = (bf16*)(ws + WS_XB);
    for (int m = gw; m < M; m += NGW) {
        const float* src = m < MP ? a->in[I_XP] + (size_t)m * D : a->in[I_XS] + (size_t)(m - MP) * D;
        row_to_bf16(src, xb + (size_t)m * D, D, lane);
    }
    bf16* pb = (bf16*)(ws + WS_PB);
    for (int r = gw; r < 2 * M; r += NGW) {
        const int l = r / M, m = r % M;
        const float* src = m < MP ? a->in[I_PP] + ((size_t)l * MP + m) * PLE : a->in[I_PS] + ((size_t)l * MS + (m - MP)) * PLE;
        row_to_bf16(src, pb + (size_t)r * PLE, PLE, lane);
    }
}

__device__ __forceinline__ float conv_in(const bf16* proj, int row0, int tq, int ch, const float* cstate) {
    if (tq >= 0) return bf2f(proj[(size_t)(row0 + tq) * NPROJ_PAD + ch]);
    return cstate ? cstate[(3 + tq) * 4096 + ch] : 0.f;
}
__device__ __forceinline__ float conv4(const bf16* proj, int row0, int t, int ch, const float* cstate, const float* wconv, const float* bconv) {
    float acc = bconv[ch];
#pragma unroll
    for (int j = 0; j < 4; ++j) acc += wconv[j * 4096 + ch] * conv_in(proj, row0, t - 3 + j, ch, cstate);
    return acc;
}

__device__ __forceinline__ void delta_rec_item(ArgsP a, LAS unsigned char* lds, int row0, int T, int h, const float* cstate, const float* S0, float* Sout, const int tid) {
    const int lane = tid & 63, wave = tid >> 6, c = tid & 127, r = tid >> 7;
    const bf16* proj = (const bf16*)(a->ws + WS_PROJ); const float* gates = (const float*)(a->ws + WS_GATES); bf16* mix = (bf16*)(a->ws + WS_MIX);
    const float* wconv = a->in[I_WCONV]; const float* bconv = a->in[I_BCONV];
    LAS float* act = (LAS float*)lds;
    LAS float* nrm = act + 4 * 384;
    LAS float* gb = nrm + 8;
    LAS float* red = gb + 8;
    LAS float* red2 = red + 512;
    LAS float* obuf = red2 + 512;
    float s[32];
#pragma unroll
    for (int i = 0; i < 32; ++i) s[i] = S0 ? S0[(size_t)(32 * r + i) * 128 + c] : 0.f;
    const float aexp = expf(a->in[I_ALOG][h]), dtb = a->in[I_DTB][h];
#pragma unroll 1
    for (int t0 = 0; t0 < T; t0 += 4) {
#pragma unroll
        for (int j = 0; j < 3; ++j) { const int idx = tid + 512 * j, tok = idx / 384, chl = idx % 384, part = chl >> 7, i = chl & 127;
            const int ch = part * 1024 + h * 128 + i;
            act[tok * 384 + chl] = siluf(conv4(proj, row0, t0 + tok, ch, cstate, wconv, bconv)); }
        __syncthreads();
        { const int tok = wave >> 1, part = wave & 1; const float x0 = act[tok * 384 + part * 128 + lane], x1 = act[tok * 384 + part * 128 + 64 + lane];
          const float ss = wave_sum(x0 * x0 + x1 * x1); if (lane == 0) nrm[tok * 2 + part] = rsqrtf(ss + 1e-6f) * (part == 0 ? 0.08838834764831845f : 1.f); }
        if (tid < 4) { const int row = row0 + t0 + tid; const float g = -aexp * softplusf(gates[(size_t)row * 16 + h] + dtb); gb[tid * 2] = expf(g); gb[tid * 2 + 1] = sigm(gates[(size_t)row * 16 + 8 + h]); }
        __syncthreads();
#pragma unroll 1
        for (int tok = 0; tok < 4; ++tok) {
            const float eg = gb[tok * 2], beta = gb[tok * 2 + 1], nq = nrm[tok * 2], nk = nrm[tok * 2 + 1];
            const LAS float* qv = act + tok * 384 + 32 * r; const LAS float* kv = qv + 128;
            float ks = 0.f;
#pragma unroll
            for (int i = 0; i < 32; ++i) ks += kv[i] * s[i];
            red[r * 128 + c] = ks * nk;
            __syncthreads();
            const float kS = red[c] + red[128 + c] + red[256 + c] + red[384 + c];
            const float vnew = beta * (act[tok * 384 + 256 + c] - eg * kS);
            float os = 0.f;
#pragma unroll
            for (int i = 0; i < 32; ++i) { s[i] = eg * s[i] + (kv[i] * nk) * vnew; os += qv[i] * s[i]; }
            red2[r * 128 + c] = os * nq;
            __syncthreads();
            if (r == 0) obuf[tok * 128 + c] = red2[c] + red2[128 + c] + red2[256 + c] + red2[384 + c];
        }
        __syncthreads();
        if (wave < 4) { const int tok = wave, row = row0 + t0 + tok; const float o0 = obuf[tok * 128 + lane], o1 = obuf[tok * 128 + 64 + lane];
            const float rstd = rsqrtf(wave_sum(o0 * o0 + o1 * o1) * (1.f / 128.f) + RMS_EPS);
            const float* nw = a->in[I_DNORM];
            const float z0 = bf2f(proj[(size_t)row * NPROJ_PAD + 4096 + h * 128 + lane]), z1 = bf2f(proj[(size_t)row * NPROJ_PAD + 4096 + h * 128 + 64 + lane]);
            mix[(size_t)row * D + h * 128 + lane] = (bf16)f2bf(o0 * rstd * nw[lane] * siluf(z0));
            mix[(size_t)row * D + h * 128 + 64 + lane] = (bf16)f2bf(o1 * rstd * nw[64 + lane] * siluf(z1)); }
        __syncthreads();
    }
#pragma unroll
    for (int i = 0; i < 32; ++i) Sout[(size_t)(32 * r + i) * 128 + c] = s[i];
}

__device__ __forceinline__ void lru_rec_item(ArgsP a, LAS unsigned char* lds, int row0, int T, int n, const float* cstate, const float* h0, float* hout, const int tid) {
    const int d = tid & 127, part = tid >> 7;
    const bf16* proj = (const bf16*)(a->ws + WS_PROJ); bf16* mix = (bf16*)(a->ws + WS_MIX);
    const float* wconv = a->in[I_WCONV]; const float* bconv = a->in[I_BCONV];
    const float* wr = a->in[I_LWR] + (size_t)n * 16384; const float* wi = a->in[I_LWI] + (size_t)n * 16384;
    LAS float* xr = (LAS float*)lds;
    LAS float* red = xr + 512;
    const int chn = n * 128 + d;
    float hst = h0 ? h0[chn] : 0.f;
    const float br = a->in[I_LBR][chn], bi = a->in[I_LBI][chn], spl = softplusf(-a->in[I_LLAM][chn]);
#pragma unroll 1
    for (int t0 = 0; t0 < T; t0 += 4) {
        { const int tok = tid >> 7; xr[tok * 128 + d] = conv4(proj, row0, t0 + tok, 3072 + chn, cstate, wconv, bconv); }
        __syncthreads();
        float ar[4] = {0.f, 0.f, 0.f, 0.f}, ai[4] = {0.f, 0.f, 0.f, 0.f};
#pragma unroll 4
        for (int cc = 0; cc < 32; ++cc) { const int c = part * 32 + cc; const float w1 = wr[c * 128 + d], w2 = wi[c * 128 + d];
#pragma unroll
        for (int tok = 0; tok < 4; ++tok) { const float x = xr[tok * 128 + c]; ar[tok] += x * w1; ai[tok] += x * w2; } }
#pragma unroll
        for (int tok = 0; tok < 4; ++tok) { red[((tok * 2 + 0) * 4 + part) * 128 + d] = ar[tok]; red[((tok * 2 + 1) * 4 + part) * 128 + d] = ai[tok]; }
        __syncthreads();
        if (part == 0) {
    #pragma unroll 1
        for (int tok = 0; tok < 4; ++tok) {
                const int row = row0 + t0 + tok;
                float rp = br, ip = bi;
#pragma unroll
                for (int p = 0; p < 4; ++p) { rp += red[((tok * 2 + 0) * 4 + p) * 128 + d]; ip += red[((tok * 2 + 1) * 4 + p) * 128 + d]; }
                const float log_a = -8.f * sigm(rp) * spl;
                const float av = expf(log_a);
                const float bx = sqrtf(-expm1f(2.f * log_a)) * sigm(ip) * xr[tok * 128 + d];
                hst = av * hst + bx;
                const float gate = bf2f(proj[(size_t)row * NPROJ_PAD + 5120 + chn]);
                mix[(size_t)row * D + 1024 + chn] = (bf16)f2bf(hst * gelu_tanh(gate));
            }
        }
        __syncthreads();
    }
    if (part == 0) hout[chn] = hst;
}

__device__ __forceinline__ void mlstm_rec_item(ArgsP a, LAS unsigned char* lds, int row0, int T, int h, const float* C0, const float* n0, const float* m0, float* Cout, float* nout, float* mout, const int tid) {
    const int lane = tid & 63, wave = tid >> 6, v = tid & 255, kh = tid >> 8;
    const bf16* proj = (const bf16*)(a->ws + WS_PROJ); const float* gates = (const float*)(a->ws + WS_GATES); bf16* mix = (bf16*)(a->ws + WS_MIX);
    LAS float* qs = (LAS float*)lds;
    LAS float* ks = qs + 512;
    LAS float* vs = ks + 512;
    LAS float* gs = vs + 1024;
    LAS float* red = gs + 8;
    LAS float* dred = red + 1024;
    LAS float* hbuf = dred + 4;
    float cst[64];
#pragma unroll
    for (int i = 0; i < 64; ++i) cst[i] = C0 ? C0[(size_t)v * 128 + 64 * kh + i] : 0.f;
    float nst = (tid < 128) ? (n0 ? n0[tid] : 0.f) : 0.f;
    float mst = m0 ? m0[0] : 0.f;
    const float big = a->in[I_BIG][h], bfg = a->in[I_BFG][h];
#pragma unroll 1
    for (int t0 = 0; t0 < T; t0 += 4) {
#pragma unroll
        for (int j = 0; j < 4; ++j) { const int tok = j, row = row0 + t0 + tok; const bf16* pr = proj + (size_t)row * NPROJ_PAD;
            float val;
            if (tid < 128) val = bf2f(pr[h * 128 + tid]); else if (tid < 256) val = bf2f(pr[1024 + h * 128 + (tid - 128)]) * 0.08838834764831845f; else val = bf2f(pr[2048 + h * 256 + (tid - 256)]);
            if (tid < 128) qs[tok * 128 + tid] = val; else if (tid < 256) ks[tok * 128 + tid - 128] = val; else vs[tok * 256 + tid - 256] = val; }
        if (tid < 4) { const int row = row0 + t0 + tid; gs[tid * 2] = gates[(size_t)row * 16 + h] + big; gs[tid * 2 + 1] = gates[(size_t)row * 16 + 8 + h] + bfg; }
        __syncthreads();
#pragma unroll 1
        for (int tok = 0; tok < 4; ++tok) {
            const int par = tok & 1;
            const float ig = gs[tok * 2], lf = logsigf(gs[tok * 2 + 1]);
            const float mnew = fmaxf(lf + mst, ig), fp = expf(lf + mst - mnew), ip = expf(ig - mnew); mst = mnew;
            const float vv = vs[tok * 256 + v] * ip;
            const LAS float* kv = ks + tok * 128 + 64 * kh; const LAS float* qv = qs + tok * 128 + 64 * kh;
            float num = 0.f;
#pragma unroll
            for (int i = 0; i < 64; ++i) { cst[i] = fp * cst[i] + vv * kv[i]; num += cst[i] * qv[i]; }
            red[(par * 2 + kh) * 256 + v] = num;
            if (tid < 128) { nst = fp * nst + ip * ks[tok * 128 + tid]; const float dp = wave_sum(nst * qs[tok * 128 + tid]); if (lane == 0) dred[par * 2 + wave] = dp; }
            __syncthreads();
            if (kh == 0) { const float nm = red[(par * 2) * 256 + v] + red[(par * 2 + 1) * 256 + v]; const float den = dred[par * 2] + dred[par * 2 + 1];
                hbuf[tok * 256 + v] = nm / fmaxf(fabsf(den), expf(-mnew)); }
        }
        __syncthreads();
        if (wave < 4) { const int tok = wave, row = row0 + t0 + tok; float hv[4]; float ss = 0.f;
#pragma unroll
            for (int j = 0; j < 4; ++j) { hv[j] = hbuf[tok * 256 + j * 64 + lane]; ss += hv[j] * hv[j]; }
            const float rstd = rsqrtf(wave_sum(ss) * (1.f / 256.f) + RMS_EPS);
            const float* nw = a->in[I_MNORM] + h * 256;
#pragma unroll
            for (int j = 0; j < 4; ++j) { const int vi = j * 64 + lane; const float op = bf2f(proj[(size_t)row * NPROJ_PAD + 4096 + h * 256 + vi]);
                mix[(size_t)row * D + h * 256 + vi] = (bf16)f2bf(hv[j] * rstd * nw[vi] * sigm(op)); } }
        __syncthreads();
    }
#pragma unroll
    for (int i = 0; i < 64; ++i) Cout[(size_t)v * 128 + 64 * kh + i] = cst[i];
    if (tid < 128) nout[tid] = nst;
    if (tid == 0) mout[0] = mst;
}


typedef short bf16x8 __attribute__((ext_vector_type(8)));
#define MFMA32(a_, b_, c_) __builtin_amdgcn_mfma_f32_16x16x32_bf16(a_, b_, c_, 0, 0, 0)

__device__ __forceinline__ void lru_prep_item(ArgsP a, LAS unsigned char* lds, int item, const int tid) {
    const int c = item & 31, n = (item >> 5) & 7, b = item >> 8;
    const int lane = tid & 63, w = __builtin_amdgcn_readfirstlane(tid >> 6), fr = lane & 15, fq = lane >> 4;
    unsigned char* ws = a->ws;
    const bf16* proj = (const bf16*)(ws + WS_PROJ);
    LAS bf16* xa = (LAS bf16*)lds;
    LAS float* xf = (LAS float*)(lds + 17408);
    LAS float* obH = (LAS float*)(lds + 51200);
    LAS float* obP = obH + 64 * 132;
    {
        const int t = tid >> 3, sub = tid & 7, ch0 = 3072 + n * 128 + sub * 16;
        const float* wconv = a->in[I_WCONV]; const float* bconv = a->in[I_BCONV];
        float x[16];
#pragma unroll
        for (int i = 0; i < 4; ++i) { const f32x4 bb = *(const f32x4*)(bconv + ch0 + 4 * i); x[4 * i] = bb.x; x[4 * i + 1] = bb.y; x[4 * i + 2] = bb.z; x[4 * i + 3] = bb.w; }
#pragma unroll
        for (int j = 0; j < 4; ++j) { const int tt = 64 * c + t - 3 + j;
            if (tt >= 0) { const bf16* pr = proj + (size_t)(b * TP + tt) * NPROJ_PAD + ch0; const v4u u0 = *(const v4u*)pr, u1 = *(const v4u*)(pr + 8);
                const unsigned uu[8] = {u0.x, u0.y, u0.z, u0.w, u1.x, u1.y, u1.z, u1.w};
#pragma unroll
                for (int i = 0; i < 4; ++i) { const f32x4 ww = *(const f32x4*)(wconv + j * 4096 + ch0 + 4 * i);
                    x[4 * i] += ww.x * bflo(uu[2 * i]); x[4 * i + 1] += ww.y * bfhi(uu[2 * i]); x[4 * i + 2] += ww.z * bflo(uu[2 * i + 1]); x[4 * i + 3] += ww.w * bfhi(uu[2 * i + 1]); } } }
        v4u o0, o1; o0.x = pk2(x[0], x[1]); o0.y = pk2(x[2], x[3]); o0.z = pk2(x[4], x[5]); o0.w = pk2(x[6], x[7]); o1.x = pk2(x[8], x[9]); o1.y = pk2(x[10], x[11]); o1.z = pk2(x[12], x[13]); o1.w = pk2(x[14], x[15]);
        *(LAS v4u*)(xa + t * 136 + sub * 16) = o0; *(LAS v4u*)(xa + t * 136 + sub * 16 + 8) = o1;
#pragma unroll
        for (int i = 0; i < 4; ++i) *(LAS f32x4*)(xf + t * 132 + sub * 16 + 4 * i) = (f32x4){x[4 * i], x[4 * i + 1], x[4 * i + 2], x[4 * i + 3]};
    }
    __syncthreads();
    const bf16* wrT = (const bf16*)(ws + WS_LRUW) + (size_t)n * 16384; const bf16* wiT = wrT + 8 * 16384;
    bf16x8 br[4], bi[4];
#pragma unroll
    for (int ks = 0; ks < 4; ++ks) { br[ks] = *(const bf16x8*)(wrT + (16 * w + fr) * 128 + 32 * ks + 8 * fq); bi[ks] = *(const bf16x8*)(wiT + (16 * w + fr) * 128 + 32 * ks + 8 * fq); }
    f32x4 accr[4], acci[4];
#pragma unroll
    for (int tb = 0; tb < 4; ++tb) { accr[tb] = (f32x4){0.f, 0.f, 0.f, 0.f}; acci[tb] = (f32x4){0.f, 0.f, 0.f, 0.f};
#pragma unroll
        for (int ks = 0; ks < 4; ++ks) { const bf16x8 af = *(const LAS bf16x8*)(xa + (16 * tb + fr) * 136 + 32 * ks + 8 * fq); accr[tb] = MFMA32(af, br[ks], accr[tb]); acci[tb] = MFMA32(af, bi[ks], acci[tb]); } }
    const int dl = 16 * w + fr, chn = n * 128 + dl;
    const float brs = a->in[I_LBR][chn], bis = a->in[I_LBI][chn], spl = softplusf(-a->in[I_LLAM][chn]);
    float Apre = 1.f, Hpre = 0.f;
#pragma unroll
    for (int tb = 0; tb < 4; ++tb) {
        float P[4], Hh[4];
#pragma unroll
        for (int j = 0; j < 4; ++j) { const int t = 16 * tb + 4 * fq + j;
            const float log_a = -8.f * sigm(accr[tb][j] + brs) * spl; const float av = expf(log_a);
            const float bx = sqrtf(-expm1f(2.f * log_a)) * sigm(acci[tb][j] + bis) * xf[t * 132 + dl];
            if (j == 0) { P[0] = av; Hh[0] = bx; } else { P[j] = P[j - 1] * av; Hh[j] = av * Hh[j - 1] + bx; } }
        float Ai = P[3], Hi = Hh[3];
        { const float A2 = __shfl_up(Ai, 16), H2 = __shfl_up(Hi, 16); if (fq >= 1) { Hi = Ai * H2 + Hi; Ai = A2 * Ai; } }
        { const float A2 = __shfl_up(Ai, 32), H2 = __shfl_up(Hi, 32); if (fq >= 2) { Hi = Ai * H2 + Hi; Ai = A2 * Ai; } }
        float Aex = __shfl_up(Ai, 16), Hex = __shfl_up(Hi, 16); if (fq == 0) { Aex = 1.f; Hex = 0.f; }
        const float Atb = __shfl(Ai, 48 + fr), Htb = __shfl(Hi, 48 + fr);
        const float EA = Apre * Aex, EH = Aex * Hpre + Hex;
#pragma unroll
        for (int j = 0; j < 4; ++j) { const int t = 16 * tb + 4 * fq + j; obP[t * 132 + dl] = EA * P[j]; obH[t * 132 + dl] = P[j] * EH + Hh[j]; }
        Hpre = Atb * Hpre + Htb; Apre = Apre * Atb;
    }
    if (fq == 0) { float* e = (float*)(ws + WS_LRU_END) + (size_t)item * 256; e[dl] = Apre; e[128 + dl] = Hpre; }
    __syncthreads();
    {
        const int t = tid >> 3, sub = tid & 7;
        bf16* hl = (bf16*)(ws + WS_LRU_HL) + ((size_t)item * 64 + t) * 128 + sub * 16; bf16* pp = (bf16*)(ws + WS_LRU_P) + ((size_t)item * 64 + t) * 128 + sub * 16;
        const LAS float* sh = obH + t * 132 + sub * 16; const LAS float* sp = obP + t * 132 + sub * 16;
        v4u o0, o1;
        o0.x = pk2(sh[0], sh[1]); o0.y = pk2(sh[2], sh[3]); o0.z = pk2(sh[4], sh[5]); o0.w = pk2(sh[6], sh[7]); o1.x = pk2(sh[8], sh[9]); o1.y = pk2(sh[10], sh[11]); o1.z = pk2(sh[12], sh[13]); o1.w = pk2(sh[14], sh[15]);
        *(v4u*)hl = o0; *(v4u*)(hl + 8) = o1;
        o0.x = pk2(sp[0], sp[1]); o0.y = pk2(sp[2], sp[3]); o0.z = pk2(sp[4], sp[5]); o0.w = pk2(sp[6], sp[7]); o1.x = pk2(sp[8], sp[9]); o1.y = pk2(sp[10], sp[11]); o1.z = pk2(sp[12], sp[13]); o1.w = pk2(sp[14], sp[15]);
        *(v4u*)pp = o0; *(v4u*)(pp + 8) = o1;
    }
    __syncthreads();
}
__device__ __forceinline__ void lru_out_item(ArgsP a, LAS unsigned char* lds, int item, const int tid) {
    const int c = item & 31, n = (item >> 5) & 7, b = item >> 8;
    unsigned char* ws = a->ws;
    LAS float* carry = (LAS float*)lds;
    if (tid < 128) { float cr = 0.f; const float* e = (const float*)(ws + WS_LRU_END) + (size_t)(item - c) * 256;
        for (int k = 0; k < c; ++k) cr = e[k * 256 + 128 + tid] + e[k * 256 + tid] * cr;
        carry[tid] = cr; }
    __syncthreads();
    const int t = tid >> 3, sub = tid & 7, d0 = sub * 16, row = b * TP + 64 * c + t;
    const bf16* hl = (const bf16*)(ws + WS_LRU_HL) + ((size_t)item * 64 + t) * 128 + d0; const bf16* pp = (const bf16*)(ws + WS_LRU_P) + ((size_t)item * 64 + t) * 128 + d0;
    const bf16* gp = (const bf16*)(ws + WS_PROJ) + (size_t)row * NPROJ_PAD + 5120 + n * 128 + d0;
    const v4u h0 = *(const v4u*)hl, h1 = *(const v4u*)(hl + 8), p0 = *(const v4u*)pp, p1 = *(const v4u*)(pp + 8), g0 = *(const v4u*)gp, g1 = *(const v4u*)(gp + 8);
    const unsigned hu[8] = {h0.x, h0.y, h0.z, h0.w, h1.x, h1.y, h1.z, h1.w}, pu[8] = {p0.x, p0.y, p0.z, p0.w, p1.x, p1.y, p1.z, p1.w}, gu[8] = {g0.x, g0.y, g0.z, g0.w, g1.x, g1.y, g1.z, g1.w};
    float hv[16]; unsigned ou[8];
#pragma unroll
    for (int i = 0; i < 8; ++i) { hv[2 * i] = bflo(hu[i]) + bflo(pu[i]) * carry[d0 + 2 * i]; hv[2 * i + 1] = bfhi(hu[i]) + bfhi(pu[i]) * carry[d0 + 2 * i + 1];
        ou[i] = pk2(hv[2 * i] * gelu_tanh(bflo(gu[i])), hv[2 * i + 1] * gelu_tanh(bfhi(gu[i]))); }
    bf16* mp = (bf16*)(ws + WS_MIX) + (size_t)row * D + 1024 + n * 128 + d0;
    *(v4u*)mp = (v4u){ou[0], ou[1], ou[2], ou[3]}; *(v4u*)(mp + 8) = (v4u){ou[4], ou[5], ou[6], ou[7]};
    if (c == 31 && t == 63) { float* o = a->out + O_LRUP + (size_t)b * 1024 + n * 128 + d0;
#pragma unroll
        for (int i = 0; i < 4; ++i) *(f32x4*)(o + 4 * i) = (f32x4){hv[4 * i], hv[4 * i + 1], hv[4 * i + 2], hv[4 * i + 3]}; }
    __syncthreads();
}


__device__ __forceinline__ void conv16_prompt(const bf16* proj, const float* wconv, const float* bconv, int b, int tseq, int ch0, float (&x)[16]) {
#pragma unroll
    for (int i = 0; i < 4; ++i) { const f32x4 bb = *(const f32x4*)(bconv + ch0 + 4 * i); x[4 * i] = bb.x; x[4 * i + 1] = bb.y; x[4 * i + 2] = bb.z; x[4 * i + 3] = bb.w; }
#pragma unroll
    for (int j = 0; j < 4; ++j) { const int tt = tseq - 3 + j;
        if (tt >= 0) { const bf16* pr = proj + (size_t)(b * TP + tt) * NPROJ_PAD + ch0; const v4u u0 = *(const v4u*)pr, u1 = *(const v4u*)(pr + 8);
            const unsigned uu[8] = {u0.x, u0.y, u0.z, u0.w, u1.x, u1.y, u1.z, u1.w};
#pragma unroll
            for (int i = 0; i < 4; ++i) { const f32x4 ww = *(const f32x4*)(wconv + j * 4096 + ch0 + 4 * i);
                x[4 * i] += ww.x * bflo(uu[2 * i]); x[4 * i + 1] += ww.y * bfhi(uu[2 * i]); x[4 * i + 2] += ww.z * bflo(uu[2 * i + 1]); x[4 * i + 3] += ww.w * bfhi(uu[2 * i + 1]); } } }
}
__device__ __forceinline__ void st16_bf16(LAS bf16* p, const float (&x)[16]) {
    v4u o0, o1; o0.x = pk2(x[0], x[1]); o0.y = pk2(x[2], x[3]); o0.z = pk2(x[4], x[5]); o0.w = pk2(x[6], x[7]); o1.x = pk2(x[8], x[9]); o1.y = pk2(x[10], x[11]); o1.z = pk2(x[12], x[13]); o1.w = pk2(x[14], x[15]);
    *(LAS v4u*)p = o0; *(LAS v4u*)(p + 8) = o1;
}
__device__ __forceinline__ v2u pack4(const f32x4 v) { v2u o; o.x = pk2(v.x, v.y); o.y = pk2(v.z, v.w); return o; }
__device__ __forceinline__ bf16x8 zero8() { return (bf16x8){0, 0, 0, 0, 0, 0, 0, 0}; }

__device__ __forceinline__ void delta_prep_item(ArgsP a, LAS unsigned char* lds, int item, const int tid) {
    const int c = item & 31, h = (item >> 5) & 7, b = item >> 8;
    const int lane = tid & 63, w = __builtin_amdgcn_readfirstlane(tid >> 6), fr = lane & 15, fq = lane >> 4;
    unsigned char* ws = a->ws;
    const bf16* proj = (const bf16*)(ws + WS_PROJ);
    LAS bf16* Kn = (LAS bf16*)lds;
    LAS bf16* Qn = (LAS bf16*)(lds + 17408);
    LAS bf16* KdT = (LAS bf16*)(lds + 34816);
    LAS bf16* RX = (LAS bf16*)(lds + 53248);
    LAS bf16* Mm = (LAS bf16*)(lds + 90112);
    LAS bf16* QKd = (LAS bf16*)(lds + 99328);
    LAS bf16* Td = (LAS bf16*)(lds + 108544);
    LAS bf16* RT = (LAS bf16*)(lds + 111616) + w * 768;
    LAS float* gl = (LAS float*)(lds + 123904);
    LAS float* gcs = gl + 64;
    LAS float* bet = gcs + 64;
    const int t = tid >> 3, sub = tid & 7;
    {
        if (sub == 0) { const float* gt = (const float*)(ws + WS_GATES) + (size_t)(b * TP + 64 * c + t) * 16;
            gl[t] = -expf(a->in[I_ALOG][h]) * softplusf(gt[h] + a->in[I_DTB][h]); bet[t] = sigm(gt[8 + h]); }
        __syncthreads();
        if (w == 0) { float v = gl[lane];
#pragma unroll
            for (int o = 1; o < 64; o <<= 1) { const float u = __shfl_up(v, o); if (lane >= o) v += u; }
            gcs[lane] = v; }
        __syncthreads();
    }
    {
        const float* wconv = a->in[I_WCONV]; const float* bconv = a->in[I_BCONV];
        const float gc = gcs[t], glast = gcs[63], beta = bet[t];
        const float ec = expf(gc), ed = expf(glast - gc);
        float x[16], y[16];
        conv16_prompt(proj, wconv, bconv, b, 64 * c + t, 1024 + h * 128 + sub * 16, x);
        float ss = 0.f;
#pragma unroll
        for (int i = 0; i < 16; ++i) { x[i] = siluf(x[i]); ss += x[i] * x[i]; }
        ss += __shfl_xor(ss, 1); ss += __shfl_xor(ss, 2); ss += __shfl_xor(ss, 4);
        const float rk = rsqrtf(ss + 1e-6f);
#pragma unroll
        for (int i = 0; i < 16; ++i) x[i] *= rk;
        st16_bf16(Kn + t * 136 + sub * 16, x);
#pragma unroll
        for (int i = 0; i < 16; ++i) KdT[(sub * 16 + i) * 72 + t] = (bf16)f2bf(x[i] * ed);
#pragma unroll
        for (int i = 0; i < 16; ++i) y[i] = x[i] * (beta * ec);
        st16_bf16(RX + t * 264 + 128 + sub * 16, y);
        conv16_prompt(proj, wconv, bconv, b, 64 * c + t, h * 128 + sub * 16, x);
        ss = 0.f;
#pragma unroll
        for (int i = 0; i < 16; ++i) { x[i] = siluf(x[i]); ss += x[i] * x[i]; }
        ss += __shfl_xor(ss, 1); ss += __shfl_xor(ss, 2); ss += __shfl_xor(ss, 4);
        const float rq = rsqrtf(ss + 1e-6f) * 0.08838834764831845f;
#pragma unroll
        for (int i = 0; i < 16; ++i) x[i] *= rq;
        st16_bf16(Qn + t * 136 + sub * 16, x);
        conv16_prompt(proj, wconv, bconv, b, 64 * c + t, 2048 + h * 128 + sub * 16, x);
#pragma unroll
        for (int i = 0; i < 16; ++i) x[i] = siluf(x[i]) * beta;
        st16_bf16(RX + t * 264 + sub * 16, x);
    }
    __syncthreads();
    {
        const int ib = w >> 1;
#pragma unroll
        for (int jj = 0; jj < 2; ++jj) { const int jb = 2 * (w & 1) + jj;
            f32x4 ak = (f32x4){0.f, 0.f, 0.f, 0.f}, aq = (f32x4){0.f, 0.f, 0.f, 0.f};
            if (jb <= ib) {
#pragma unroll
                for (int ks = 0; ks < 4; ++ks) { const bf16x8 bfr = *(const LAS bf16x8*)(Kn + (16 * jb + fr) * 136 + 32 * ks + 8 * fq);
                    const bf16x8 afk = *(const LAS bf16x8*)(Kn + (16 * ib + fr) * 136 + 32 * ks + 8 * fq), afq = *(const LAS bf16x8*)(Qn + (16 * ib + fr) * 136 + 32 * ks + 8 * fq);
                    ak = MFMA32(afk, bfr, ak); aq = MFMA32(afq, bfr, aq); } }
            const int col = 16 * jb + fr; const float gcc = gcs[col];
#pragma unroll
            for (int j = 0; j < 4; ++j) { const int row = 16 * ib + 4 * fq + j; const float dec = (row >= col) ? expf(gcs[row] - gcc) : 0.f;
                Mm[row * 72 + col] = (bf16)f2bf(row > col ? -bet[row] * ak[j] * dec : 0.f);
                QKd[row * 72 + col] = (bf16)f2bf(aq[j] * dec); }
        }
    }
    __syncthreads();
    if (w == 0) { const int blk = lane >> 4, col = lane & 15; float xi[16];
#pragma unroll
        for (int i = 0; i < 16; ++i) { float acc = (i == col) ? 1.f : 0.f; const LAS bf16* mr = Mm + (16 * blk + i) * 72 + 16 * blk;
#pragma unroll
            for (int j = 0; j < i; ++j) acc += bf2f(mr[j]) * xi[j];
            xi[i] = acc; }
#pragma unroll
        for (int i = 0; i < 16; ++i) Td[(blk * 16 + i) * 24 + col] = (bf16)f2bf(xi[i]); }
    f32x4 rhs[2][4];
#pragma unroll
    for (int cbl = 0; cbl < 2; ++cbl)
#pragma unroll
        for (int bb = 0; bb < 4; ++bb)
#pragma unroll
            for (int j = 0; j < 4; ++j) rhs[cbl][bb][j] = bf2f(RX[(16 * bb + 4 * fq + j) * 264 + 32 * w + 16 * cbl + fr]);
    __syncthreads();
#pragma unroll
    for (int cbl = 0; cbl < 2; ++cbl) { const int cb = 2 * w + cbl;
#pragma unroll
        for (int bb = 0; bb < 4; ++bb) {
            f32x4 acc = rhs[cbl][bb];
#pragma unroll
            for (int ks = 0; ks < 2; ++ks) { if (32 * ks < 16 * bb) { const bool ok = (32 * ks + 8 * fq) < 16 * bb;
                const bf16x8 af = ok ? *(const LAS bf16x8*)(Mm + (16 * bb + fr) * 72 + 32 * ks + 8 * fq) : zero8();
                const bf16x8 bf_ = ok ? *(const LAS bf16x8*)(RX + (16 * cb + fr) * 72 + 32 * ks + 8 * fq) : zero8();
                acc = MFMA32(af, bf_, acc); } }
            *(LAS v2u*)(RT + (16 * cbl + fr) * 24 + 4 * fq) = pack4(acc);
            asm volatile("s_waitcnt lgkmcnt(0)" ::: "memory");
            const bool ok2 = fq < 2;
            const bf16x8 af2 = ok2 ? *(const LAS bf16x8*)(Td + (bb * 16 + fr) * 24 + 8 * fq) : zero8();
            const bf16x8 bf2 = ok2 ? *(const LAS bf16x8*)(RT + (16 * cbl + fr) * 24 + 8 * fq) : zero8();
            const f32x4 xb4 = MFMA32(af2, bf2, ((f32x4){0.f, 0.f, 0.f, 0.f}));
            *(LAS v2u*)(RX + (16 * cb + fr) * 72 + 16 * bb + 4 * fq) = pack4(xb4);
            asm volatile("s_waitcnt lgkmcnt(0)" ::: "memory");
        }
    }
    __syncthreads();
    {
        v4u* gout = (v4u*)(ws + WS_DG) + ((size_t)item * 8 + w) * 4 * 64 + lane;
        bf16x8 kb[2];
#pragma unroll
        for (int kt = 0; kt < 2; ++kt) kb[kt] = *(const LAS bf16x8*)(KdT + (16 * w + fr) * 72 + 32 * kt + 8 * fq);
#pragma unroll
        for (int ks = 0; ks < 4; ++ks) { f32x4 g0 = (f32x4){0.f, 0.f, 0.f, 0.f}, g1 = (f32x4){0.f, 0.f, 0.f, 0.f};
#pragma unroll
            for (int kt = 0; kt < 2; ++kt) { const bf16x8 a0 = *(const LAS bf16x8*)(RX + (128 + 32 * ks + fr) * 72 + 32 * kt + 8 * fq), a1 = *(const LAS bf16x8*)(RX + (128 + 32 * ks + 16 + fr) * 72 + 32 * kt + 8 * fq);
                g0 = MFMA32(a0, kb[kt], g0); g1 = MFMA32(a1, kb[kt], g1); }
            const v2u p0 = pack4(-g0), p1 = pack4(-g1); gout[ks * 64] = (v4u){p0.x, p0.y, p1.x, p1.y}; }
        v2u* bout = (v2u*)(ws + WS_DB) + ((size_t)item * 64 + w) * 64 + lane;
#pragma unroll
        for (int s2 = 0; s2 < 8; ++s2) { f32x4 bc = (f32x4){0.f, 0.f, 0.f, 0.f};
#pragma unroll
            for (int kt = 0; kt < 2; ++kt) { const bf16x8 ub = *(const LAS bf16x8*)(RX + (16 * s2 + fr) * 72 + 32 * kt + 8 * fq); bc = MFMA32(kb[kt], ub, bc); }
            bout[(size_t)s2 * 8 * 64] = pack4(bc); }
    }
    {
        const int tb = w >> 1, half = w & 1; const float ect = expf(gcs[16 * tb + fr]);
        bf16x8 qk[2];
#pragma unroll
        for (int kt = 0; kt < 2; ++kt) qk[kt] = *(const LAS bf16x8*)(QKd + (16 * tb + fr) * 72 + 32 * kt + 8 * fq);
        v4u* qout = (v4u*)(ws + WS_DQ) + ((size_t)item * 4 + tb) * 4 * 64 + lane;
#pragma unroll
        for (int kk = 0; kk < 2; ++kk) { const int ks = 2 * half + kk; v2u pk[2];
#pragma unroll
            for (int hf = 0; hf < 2; ++hf) { const int db = 2 * ks + hf; f32x4 acc = (f32x4){0.f, 0.f, 0.f, 0.f};
#pragma unroll
                for (int kt = 0; kt < 2; ++kt) { const bf16x8 wa = *(const LAS bf16x8*)(RX + (128 + 16 * db + fr) * 72 + 32 * kt + 8 * fq); acc = MFMA32(wa, qk[kt], acc); }
                const v2u qn4 = *(const LAS v2u*)(Qn + (16 * tb + fr) * 136 + 16 * db + 4 * fq);
                f32x4 qp; qp.x = bflo(qn4.x) * ect - acc.x; qp.y = bfhi(qn4.x) * ect - acc.y; qp.z = bflo(qn4.y) * ect - acc.z; qp.w = bfhi(qn4.y) * ect - acc.w;
                pk[hf] = pack4(qp); }
            qout[ks * 64] = (v4u){pk[0].x, pk[0].y, pk[1].x, pk[1].y}; }
        v2u* oout = (v2u*)(ws + WS_DO) + ((size_t)item * 4 + tb) * 8 * 64 + lane;
#pragma unroll
        for (int ss = 0; ss < 4; ++ss) { const int s2 = 4 * half + ss; f32x4 acc = (f32x4){0.f, 0.f, 0.f, 0.f};
#pragma unroll
            for (int kt = 0; kt < 2; ++kt) { const bf16x8 ua = *(const LAS bf16x8*)(RX + (16 * s2 + fr) * 72 + 32 * kt + 8 * fq); acc = MFMA32(ua, qk[kt], acc); }
            oout[s2 * 64] = pack4(acc); }
    }
    if (tid == 0) ((float*)(ws + WS_DD))[item] = expf(gcs[63]);
    __syncthreads();
}

__device__ __forceinline__ void delta_scan_wave(ArgsP a, int chain, int s, const int lane) {
    unsigned char* ws = a->ws;
    const int fr = lane & 15, fq = lane >> 4;
    f32x4 S[8]; bf16x8 Sb[4];
#pragma unroll
    for (int i = 0; i < 8; ++i) S[i] = (f32x4){0.f, 0.f, 0.f, 0.f};
#pragma unroll
    for (int i = 0; i < 4; ++i) Sb[i] = zero8();
    const bf16x8* gbase = (const bf16x8*)(ws + WS_DG) + (size_t)chain * 32 * 2048 + lane;
    bf16x8 G[8][4];
#pragma unroll
    for (int rb = 0; rb < 8; ++rb)
#pragma unroll
        for (int ks = 0; ks < 4; ++ks) G[rb][ks] = gbase[(rb * 4 + ks) * 64];
#pragma unroll 1
    for (int c = 0; c < 32; ++c) {
        const int item = chain * 32 + c;
        const float d = ((const float*)(ws + WS_DD))[item];
        bf16x8* sout = (bf16x8*)(ws + WS_DS) + ((size_t)item * 8 + s) * 4 * 64 + lane;
#pragma unroll
        for (int ks = 0; ks < 4; ++ks) sout[ks * 64] = Sb[ks];
        const v2u* bin = (const v2u*)(ws + WS_DB) + ((size_t)item * 8 + s) * 8 * 64 + lane;
#pragma unroll
        for (int rb = 0; rb < 8; ++rb) { const v2u bc = bin[rb * 64]; S[rb].x = d * S[rb].x + bflo(bc.x); S[rb].y = d * S[rb].y + bfhi(bc.x); S[rb].z = d * S[rb].z + bflo(bc.y); S[rb].w = d * S[rb].w + bfhi(bc.y); }
        const bf16x8* gnext = gbase + (size_t)(c + 1 < 32 ? c + 1 : c) * 2048;
#pragma unroll
        for (int rb = 0; rb < 8; ++rb) {
#pragma unroll
            for (int ks = 0; ks < 4; ++ks) S[rb] = MFMA32(G[rb][ks], Sb[ks], S[rb]);
#pragma unroll
            for (int ks = 0; ks < 4; ++ks) G[rb][ks] = gnext[(rb * 4 + ks) * 64];
        }
#pragma unroll
        for (int ks = 0; ks < 4; ++ks) { const v2u lo = pack4(S[2 * ks]), hi = pack4(S[2 * ks + 1]); const v4u u = (v4u){lo.x, lo.y, hi.x, hi.y}; Sb[ks] = __builtin_bit_cast(bf16x8, u); }
    }
    f32x4* so = (f32x4*)(ws + WS_DF) + ((size_t)(chain * 8 + s) * 8) * 64 + lane;
#pragma unroll
    for (int rb = 0; rb < 8; ++rb) so[rb * 64] = S[rb];
}

__device__ __forceinline__ void delta_out_wave(ArgsP a, int item, int tb, const int lane) {
    unsigned char* ws = a->ws;
    const int c = item & 31, h = (item >> 5) & 7, b = item >> 8, fr = lane & 15, fq = lane >> 4;
    bf16x8 qf[4];
    const bf16x8* qin = (const bf16x8*)(ws + WS_DQ) + ((size_t)item * 4 + tb) * 4 * 64 + lane;
#pragma unroll
    for (int ks = 0; ks < 4; ++ks) qf[ks] = qin[ks * 64];
    const v2u* oin = (const v2u*)(ws + WS_DO) + ((size_t)item * 4 + tb) * 8 * 64 + lane;
    const bf16x8* sin = (const bf16x8*)(ws + WS_DS) + (size_t)item * 8 * 4 * 64 + lane;
    f32x4 o[8]; float ss = 0.f;
#pragma unroll
    for (int s = 0; s < 8; ++s) { const v2u ol = oin[s * 64]; o[s] = (f32x4){bflo(ol.x), bfhi(ol.x), bflo(ol.y), bfhi(ol.y)};
#pragma unroll
        for (int ks = 0; ks < 4; ++ks) o[s] = MFMA32(sin[(s * 4 + ks) * 64], qf[ks], o[s]);
        ss += (o[s].x * o[s].x + o[s].y * o[s].y) + (o[s].z * o[s].z + o[s].w * o[s].w); }
    ss += __shfl_xor(ss, 16); ss += __shfl_xor(ss, 32);
    const float rstd = rsqrtf(ss * (1.f / 128.f) + RMS_EPS);
    const int row = b * TP + 64 * c + 16 * tb + fr;
    const bf16* zp = (const bf16*)(ws + WS_PROJ) + (size_t)row * NPROJ_PAD + 4096 + h * 128 + 4 * fq;
    bf16* mp = (bf16*)(ws + WS_MIX) + (size_t)row * D + h * 128 + 4 * fq;
    const float* nw = a->in[I_DNORM] + 4 * fq;
#pragma unroll
    for (int s = 0; s < 8; ++s) { const v2u z = *(const v2u*)(zp + 16 * s); const f32x4 n4 = *(const f32x4*)(nw + 16 * s);
        f32x4 y; y.x = o[s].x * rstd * n4.x * siluf(bflo(z.x)); y.y = o[s].y * rstd * n4.y * siluf(bfhi(z.x)); y.z = o[s].z * rstd * n4.z * siluf(bflo(z.y)); y.w = o[s].w * rstd * n4.w * siluf(bfhi(z.y));
        *(v2u*)(mp + 16 * s) = pack4(y); }
}

__device__ __forceinline__ void phase_mixer_even(ArgsP a, LAS unsigned char* lds, int vcu, int G, const int tid) {
    const int NIT = 4096;
#pragma unroll 1
    for (int it = vcu; it < NIT; it += G) {
        if (it < 1024) { delta_prep_item(a, lds, it, tid); continue; }
        if (it < 2048) { lru_prep_item(a, lds, it - 1024, tid); continue; }
        const int j = (it - 2048) & 1023, b = j >> 3, hn = j & 7; const float* cst = a->in[I_SCONV] + (size_t)b * 3 * 4096;
        if (it < 3072) delta_rec_item(a, lds, MP + b * TS, TS, hn, cst, a->in[I_SDELTA] + (size_t)j * 16384, a->out + O_DELTAS + (size_t)j * 16384, tid);
        else lru_rec_item(a, lds, MP + b * TS, TS, hn, cst, a->in[I_SLRU] + (size_t)b * 1024, a->out + O_LRUS + (size_t)b * 1024, tid);
    }
    const bf16* proj = (const bf16*)(a->ws + WS_PROJ);
    const int nconv = (BP + BS) * 3 * 4096;
    for (int i = vcu * NTHR + tid; i < nconv; i += G * NTHR) {
        const int ch = i & 4095, rj = i >> 12, j = rj % 3, b = rj / 3;
        if (b < BP) a->out[O_CONVP + (size_t)(b * 3 + j) * 4096 + ch] = bf2f(proj[(size_t)(b * TP + TP - 3 + j) * NPROJ_PAD + ch]);
        else { const int bs = b - BP; a->out[O_CONVS + (size_t)(bs * 3 + j) * 4096 + ch] = bf2f(proj[(size_t)(MP + bs * TS + 1 + j) * NPROJ_PAD + ch]); }
    }
}
__device__ __forceinline__ void phase_mixer_even_b(ArgsP a, int vcu, int G, const int tid) {
    if ((tid >> 6) == 0) { for (int it = vcu; it < 256; it += G) delta_scan_wave(a, it >> 3, it & 7, tid & 63); }
}
__device__ __forceinline__ void phase_mixer_even_c(ArgsP a, LAS unsigned char* lds, int vcu, int G, const int tid) {
    const int w = tid >> 6;
#pragma unroll 1
    for (int it = vcu; it < 512; it += G) delta_out_wave(a, 2 * it + (w >> 2), w & 3, tid & 63);
#pragma unroll 1
    for (int it = vcu; it < 1024; it += G) lru_out_item(a, lds, it, tid);
    for (int chain = vcu; chain < 32; chain += G) {
        const float* src = (const float*)(a->ws + WS_DF) + (size_t)chain * 16384; float* dst = a->out + O_DELTAP + (size_t)chain * 16384;
        for (int e = tid; e < 16384; e += NTHR) { const int dk = e >> 7, dv = e & 127;
            dst[e] = src[((((dv >> 4) * 8 + (dk >> 4)) * 64 + ((dk >> 2) & 3) * 16 + (dv & 15)) << 2) + (dk & 3)]; }
    }
}
__device__ __forceinline__ void phase_mixer_odd(ArgsP a, LAS unsigned char* lds, int vcu, int G, const int tid) {
    const int NIT = 32 + 1024;
#pragma unroll 1
    for (int it = vcu; it < NIT; it += G) {
        int row0, T, h; const float* c0; const float* n0; const float* m0; float* co; float* no; float* mo;
        if (it < 32) { const int b = it >> 3; h = it & 7; row0 = b * TP; T = TP; c0 = nullptr; n0 = nullptr; m0 = nullptr; co = a->out + O_MCP + (size_t)it * 32768; no = a->out + O_MNP + (size_t)it * 128; mo = a->out + O_MMP + it; }
        else { const int j = it - 32, b = j >> 3; h = j & 7; row0 = MP + b * TS; T = TS; c0 = a->in[I_SMC] + (size_t)j * 32768; n0 = a->in[I_SMN] + (size_t)j * 128; m0 = a->in[I_SMM] + j;
               co = a->out + O_MCS + (size_t)j * 32768; no = a->out + O_MNS + (size_t)j * 128; mo = a->out + O_MMS + j; }
        mlstm_rec_item(a, lds, row0, T, h, c0, n0, m0, co, no, mo, tid);
    }
}

__device__ __forceinline__ void phase_ln(const float* p0, const float* p1, const bf16* resid, const float* g, const float* bta, bf16* dst, int gw, int NGW, int lane) {
    for (int m = gw; m < M; m += NGW) {
        float v[32]; float s = 0.f;
#pragma unroll
        for (int j = 0; j < 8; ++j) { const size_t off = (size_t)m * D + j * 256 + lane * 4; f32x4 x = *(const f32x4*)(p0 + off); if (p1) { const f32x4 y = *(const f32x4*)(p1 + off); x = x + y; }
            const v2u rr = *(const v2u*)(resid + off);
            v[4 * j + 0] = x.x + DN_ALPHA * bflo(rr.x); v[4 * j + 1] = x.y + DN_ALPHA * bfhi(rr.x); v[4 * j + 2] = x.z + DN_ALPHA * bflo(rr.y); v[4 * j + 3] = x.w + DN_ALPHA * bfhi(rr.y);
            s += (v[4 * j] + v[4 * j + 1]) + (v[4 * j + 2] + v[4 * j + 3]); }
        const float mean = wave_sum(s) * (1.f / D); float s2 = 0.f;
#pragma unroll
        for (int i = 0; i < 32; ++i) { v[i] -= mean; s2 += v[i] * v[i]; }
        const float rstd = rsqrtf(wave_sum(s2) * (1.f / D) + LN_EPS);
#pragma unroll
        for (int j = 0; j < 8; ++j) { const int col = j * 256 + lane * 4; const f32x4 gg = *(const f32x4*)(g + col), bb = *(const f32x4*)(bta + col);
            v2u o; o.x = pk2(v[4 * j] * rstd * gg.x + bb.x, v[4 * j + 1] * rstd * gg.y + bb.y); o.y = pk2(v[4 * j + 2] * rstd * gg.z + bb.z, v[4 * j + 3] * rstd * gg.w + bb.w);
            *(v2u*)(dst + (size_t)m * D + col) = o; }
    }
}
__device__ __forceinline__ void phase_combine(const float* p0, const float* p1, const bf16* h2, const bf16* pw, bf16* xb, float* outf, int gw, int NGW, int lane) {
    for (int m = gw; m < M; m += NGW) {
#pragma unroll
        for (int j = 0; j < 8; ++j) { const size_t off = (size_t)m * D + j * 256 + lane * 4; f32x4 x = *(const f32x4*)(p0 + off); if (p1) { const f32x4 y = *(const f32x4*)(p1 + off); x = x + y; }
            const v2u hh = *(const v2u*)(h2 + off), pp = *(const v2u*)(pw + off);
            f32x4 o; o.x = bflo(hh.x) + sigm(x.x) * bflo(pp.x); o.y = bfhi(hh.x) + sigm(x.y) * bfhi(pp.x); o.z = bflo(hh.y) + sigm(x.z) * bflo(pp.y); o.w = bfhi(hh.y) + sigm(x.w) * bfhi(pp.y);
            v2u ob; ob.x = pk2(o.x, o.y); ob.y = pk2(o.z, o.w); *(v2u*)(xb + off) = ob;
            if (outf) *(f32x4*)(outf + off) = o; }
    }
}

constexpr int N_PHASES = 22;
enum { OP_INPROJ = 0, OP_MIXA, OP_MIXB, OP_MIXC, OP_OUTPROJ, OP_LN1, OP_UP, OP_DOWN, OP_LN2, OP_GATE, OP_COMBINE };
enum { GK_F32 = 0, GK_BF16 = 1, GK_SQRELU = 2 };
__global__ void __launch_bounds__(NTHR, 2) mk_fwd(Args a_in) {
    extern __shared__ __attribute__((aligned(16))) unsigned char lds_raw[];
    LAS unsigned char* lds = (LAS unsigned char*)lds_raw;
    ArgsP kp = (ArgsP)__builtin_amdgcn_kernarg_segment_ptr();
    const int lo = a_in.ph_lo, hi = a_in.ph_hi;
#if MK_N_LAUNCHES == 1
    volatile LAS unsigned* xst = (volatile LAS unsigned*)(lds + LDS_CTL_OFF);
    if (threadIdx.x < 2) xst[threadIdx.x] = 0u;
    __syncthreads();
    XcdBarrier bar = xcd_barrier_post((unsigned*)(a_in.ws + WS_CTL) + 4096, xst);
#endif
#pragma unroll 1
    for (int p = lo; p < hi; ++p) {
        int tid = threadIdx.x; asm volatile("" : "+v"(tid));
        int bx = blockIdx.x; asm volatile("" : "+s"(bx));
        int G = gridDim.x; asm volatile("" : "+s"(G));
        ArgsP a = kp; asm volatile("" : "+s"(a));
        const int lane = tid & 63, wave = __builtin_amdgcn_readfirstlane(tid >> 6);
        const int vcu = (G % 8 == 0) ? (bx % 8) * (G / 8) + bx / 8 : bx;
        const int gw = vcu * NWAVES + wave, NGW = G * NWAVES;
        unsigned char* ws = a->ws;
        if (p == 0) {
phase_convert(a, lds, gw, NGW, wave, lane); }
        else {
            const int L = p <= 11 ? 0 : 1; const int q = L == 0 ? p - 1 : (p - 12 < 3 ? p - 12 : p - 11);
            bf16* xb = (bf16*)(ws + WS_XB); bf16* mixb = (bf16*)(ws + WS_MIX); bf16* hb = (bf16*)(ws + WS_H); bf16* h2b = (bf16*)(ws + WS_H2); bf16* pwb = (bf16*)(ws + WS_PW);
            bf16* projb = (bf16*)(ws + WS_PROJ); bf16* upb = (bf16*)(ws + WS_PROJ);
            float* part0 = (float*)(ws + WS_PART0); float* gatesb = (float*)(ws + WS_GATES);
            if (q == OP_MIXA) { if (L == 0) phase_mixer_even(a, lds, vcu, G, tid); else phase_mixer_odd(a, lds, vcu, G, tid); }
            else if (q == OP_MIXB) { phase_mixer_even_b(a, vcu, G, tid); }
            else if (q == OP_MIXC) { phase_mixer_even_c(a, lds, vcu, G, tid); }

            else if (q == OP_LN1) phase_ln(part0, nullptr, xb, a->in[I_LN1G] + L * D, a->in[I_LN1B] + L * D, hb, gw, NGW, lane);
            else if (q == OP_LN2) phase_ln(part0, nullptr, hb, a->in[I_LN2G] + L * D, a->in[I_LN2B] + L * D, h2b, gw, NGW, lane);
            else if (q == OP_COMBINE) phase_combine(part0, nullptr, h2b, pwb, xb, L == 1 ? a->out + O_Y : nullptr, gw, NGW, lane);

            else {
                for (int sub = 0; sub < (q == OP_GATE ? 2 : 1); ++sub) {
                    const bf16* A; const bf16* Bt; int N, K, kind; void* out; float* gp = nullptr; int corder = bx;
                    if (q == OP_INPROJ) { A = xb; Bt = (const bf16*)(ws + (L == 0 ? WS_WINE : WS_WINO)); N = NPROJ_PAD; K = D; kind = GK_BF16; out = projb; gp = gatesb; }
                    else if (q == OP_OUTPROJ) { A = mixb; Bt = (const bf16*)(ws + (L == 0 ? WS_WOUTE : WS_WOUTO)); N = D; K = D; kind = GK_F32; out = part0; }
                    else if (q == OP_UP) { A = hb; Bt = (const bf16*)(ws + WS_WUP) + (size_t)L * D * FF; N = FF; K = D; kind = GK_SQRELU; out = upb; }
                    else if (q == OP_DOWN) { A = upb; Bt = (const bf16*)(ws + WS_WDOWN) + (size_t)L * D * FF; N = D; K = FF; kind = GK_F32; out = part0; }
                    else if (sub == 0) { A = h2b; Bt = (const bf16*)(ws + WS_WGATE) + (size_t)L * D * D; N = D; K = D; kind = GK_F32; out = part0; }
                    else { A = (const bf16*)(ws + WS_PB) + (size_t)L * M * PLE; Bt = (const bf16*)(ws + WS_WPLE) + (size_t)L * PLE * D; N = D; K = PLE; kind = GK_BF16; out = pwb; corder = (bx + 128) % G; }
                    pg8::Gemm g{A, Bt, M, N, K}; pg8::StaticOrder S; S.init(M, N, G, corder);
                    if (kind == GK_F32) { pg8::EpiF32 E{(float*)out, N}; pg8::gemm_phase<pg8::EpiF32, pg8::StaticOrder, true, true>(lds, g, S, E, tid); }
                    else if (kind == GK_BF16) { pg8::EpiBf16<0> E{(bf16*)out, N, gp, 24}; pg8::gemm_phase<pg8::EpiBf16<0>, pg8::StaticOrder, true, true>(lds, g, S, E, tid); }
                    else { pg8::EpiBf16<1> E{(bf16*)out, N, nullptr, -1}; pg8::gemm_phase<pg8::EpiBf16<1>, pg8::StaticOrder, true, true>(lds, g, S, E, tid); }
                }
            }
        }
#if MK_N_LAUNCHES == 1
        if (p + 1 < hi) { if (p == lo) cg::this_grid().sync(); else xcd_barrier(bar); }
#endif
    }
}

extern "C" void kernel_launch(void* const* d_in, const int* in_sizes, int n_in, void* d_out, int out_size, void* d_ws, size_t ws_size, hipStream_t stream) {
    static int grid = 0;
    if (grid == 0) {
        if (n_in != 35 || (size_t)out_size != O_END || ws_size < WS_END) { fprintf(stderr, "kernel_launch: unexpected shapes: n_in %d out %d (want %zu) ws %zu (want %zu)\n", n_in, out_size, (size_t)O_END, ws_size, (size_t)WS_END); grid = -1; return; }
        int dev = 0, cus = 0, per_cu = 0;
        hipGetDevice(&dev); hipDeviceGetAttribute(&cus, hipDeviceAttributeMultiprocessorCount, dev);
        if (hipFuncSetAttribute((const void*)mk_fwd, hipFuncAttributeMaxDynamicSharedMemorySize, LDS_BYTES) != hipSuccess) { fprintf(stderr, "kernel_launch: hipFuncSetAttribute failed\n"); grid = -1; return; }
        if (hipOccupancyMaxActiveBlocksPerMultiprocessor(&per_cu, (const void*)mk_fwd, NTHR, LDS_BYTES) != hipSuccess || per_cu < 1) { fprintf(stderr, "kernel_launch: occupancy query says %d\n", per_cu); per_cu = 1; }
        (void)hipGetLastError();
        grid = cus * 1;
    }
    if (grid < 0) return;
    Args a{};
    for (int i = 0; i < 35; ++i) a.in[i] = (const float*)d_in[i];
    a.out = (float*)d_out; a.ws = (unsigned char*)d_ws;
#if MK_N_LAUNCHES == 1
    hipMemsetAsync((char*)d_ws + WS_CTL, 0, 1 * MiB, stream);
    a.ph_lo = 0; a.ph_hi = N_PHASES;
    void* args[] = {&a};
    hipError_t e = hipLaunchCooperativeKernel((const void*)mk_fwd, dim3(grid), dim3(NTHR), args, LDS_BYTES, stream);
    if (e != hipSuccess) fprintf(stderr, "cooperative launch failed: %s (grid %d)\n", hipGetErrorString(e), grid);
#else
    for (int p = 0; p < N_PHASES; ++p) {
        a.ph_lo = p; a.ph_hi = p + 1;
        hipLaunchKernelGGL(mk_fwd, dim3(grid), dim3(NTHR), LDS_BYTES, stream, a);
    }
#endif
}
```

```cpp
#include <hip/hip_runtime.h>
#include <hip/hip_cooperative_groups.h>
#include <cstdio>
#include <cstdint>
namespace cg = cooperative_groups;

#ifndef MK_N_LAUNCHES
#define MK_N_LAUNCHES 1
#endif

namespace pg8 {
#define PG8_LAS __attribute__((address_space(3)))
typedef unsigned short bf16_t;
typedef short bf16x8 __attribute__((ext_vector_type(8)));
typedef float f32x4 __attribute__((ext_vector_type(4)));
typedef unsigned u32x4 __attribute__((ext_vector_type(4)));
constexpr int BM = 256, BK = 64, HALF = 128, HTB = HALF * BK * 2, STAGE_BYTES = 8 * HTB, NXCD = 8, WGM = 8;

__host__ __device__ __forceinline__ int lds_byte(int r, int c) { const int st = (r >> 4) * 2 + (c >> 5), rr = r & 15, cc = c & 31, ob = rr * 64 + cc * 2; return st * 1024 + (ob ^ (((ob >> 9) & 1) << 5)); }
__host__ __device__ __forceinline__ void stage_rc(int b, int& R, int& C) { const int st = b / 1024, sb = b % 1024, swz = sb ^ (((sb >> 9) & 1) << 5); R = (st >> 1) * 16 + swz / 64; C = (st & 1) * 32 + (swz % 64) / 2; }
__host__ __device__ __forceinline__ int perm32(int rho) { const int n = rho >> 4, i = rho & 15; return 8 * (i >> 2) + 4 * n + (i & 3); }

struct Unit { int pm, pn; };
struct Gemm { const bf16_t* A; const bf16_t* Bt; int M, N, K; };

struct StaticOrder {
    int nM, nN, nwg, G, c;
    __host__ __device__ void init(int M, int N, int G_, int c_) { nM = M / BM; nN = N / BM; nwg = nM * nN; G = G_; c = c_; }
    __host__ __device__ bool next(int i, Unit& u) const {
        const long L = (long)i * G + c; if (L >= nwg) return false;
        int wgid = (int)L; { const int q = nwg / NXCD, r = nwg % NXCD, xcd = wgid % NXCD, off = wgid / NXCD; wgid = (xcd < r ? xcd * (q + 1) : r * (q + 1) + (xcd - r) * q) + off; }
        const int nig = WGM * nN, gid = wgid / nig, fm = gid * WGM, gsz = (nM - fm) < WGM ? (nM - fm) : WGM;
        u.pm = fm + ((wgid % nig) % gsz); u.pn = (wgid % nig) / gsz; return true;
    }
    __device__ __forceinline__ void a_ready(const Unit&) const {}
    __device__ __forceinline__ void done(const Unit&) const {}
};

__device__ __forceinline__ unsigned cvt_pk_bf16(float lo, float hi) { unsigned r; asm volatile("v_cvt_pk_bf16_f32 %0, %1, %2" : "=v"(r) : "v"(lo), "v"(hi)); return r; }

struct EpiF32 {
    static constexpr bool PERM = false, AFTER_DRAIN = false;
    float* C; int ldc;
    __device__ __forceinline__ void operator()(const f32x4 (&acc)[2][2][4][2], const Unit& u, int wr, int wc, int fr, int fq) const {
        const int row0 = u.pm * BM + wr * 64 + fr, col0 = u.pn * BM + wc * 32 + 4 * fq;
#pragma unroll
        for (int ai = 0; ai < 2; ++ai)
#pragma unroll
            for (int m = 0; m < 4; ++m) { float* rowp = C + (size_t)(row0 + ai * HALF + m * 16) * ldc + col0;
#pragma unroll
                for (int bj = 0; bj < 2; ++bj)
#pragma unroll
                    for (int n = 0; n < 2; ++n) *(f32x4*)(rowp + bj * HALF + n * 16) = acc[ai][bj][m][n]; }
    }
};
template <int ACT> struct EpiBf16 {
    static constexpr bool PERM = true, AFTER_DRAIN = false;
    bf16_t* O; int ldc; float* gates; int gate_pn;
    __device__ __forceinline__ void operator()(const f32x4 (&acc)[2][2][4][2], const Unit& u, int wr, int wc, int fr, int fq) const {
        const int row0 = u.pm * BM + wr * 64 + fr; const int col0 = u.pn * BM + wc * 32 + 8 * fq;
        const bool gt = (gates != nullptr) && (u.pn == gate_pn) && (wc == 0) && (fq < 2);
#pragma unroll
        for (int ai = 0; ai < 2; ++ai)
#pragma unroll
            for (int m = 0; m < 4; ++m) { const int row = row0 + ai * HALF + m * 16; bf16_t* rowp = O + (size_t)row * ldc + col0;
#pragma unroll
                for (int bj = 0; bj < 2; ++bj) { f32x4 v0 = acc[ai][bj][m][0], v1 = acc[ai][bj][m][1];
                    if (ACT == 1) {
#pragma unroll
                        for (int j = 0; j < 4; ++j) { const float a = fmaxf(v0[j], 0.f), b = fmaxf(v1[j], 0.f); v0[j] = a * a; v1[j] = b * b; } }
                    u32x4 w; w.x = cvt_pk_bf16(v0[0], v0[1]); w.y = cvt_pk_bf16(v0[2], v0[3]); w.z = cvt_pk_bf16(v1[0], v1[1]); w.w = cvt_pk_bf16(v1[2], v1[3]);
                    *(u32x4*)(rowp + bj * HALF) = w; }
                if (gt) { float* gp = gates + (size_t)row * 16 + 8 * fq; *(f32x4*)gp = acc[ai][0][m][0]; *(f32x4*)(gp + 4) = acc[ai][0][m][1]; } }
    }
};

template <class Epi, class Sched, bool ALIGN_EPI = false, bool SP2 = false>
__device__ __forceinline__ void gemm_phase(PG8_LAS unsigned char* lds, const Gemm g, const Sched& S, const Epi& E, const int tid) {
    const int wid = __builtin_amdgcn_readfirstlane(tid >> 6), lane = tid & 63, wr = wid >> 2, wc = wid & 3, fr = lane & 15, fq = lane >> 4;
    const int K = g.K, nt = K / BK;
    unsigned voffA[2], voffB[2];
#pragma unroll
    for (int i = 0; i < 2; ++i) { int R, C; stage_rc(tid * 16 + i * 8192, R, C); const int Rb = Epi::PERM ? ((R & ~31) + perm32(R & 31)) : R;
        voffA[i] = (unsigned)(R * K + C) * 2u; voffB[i] = (unsigned)(Rb * K + C) * 2u; }
    const size_t kstep = (size_t)(BK * 2);
    const size_t hstep = (size_t)HALF * K * 2;
    const size_t tstep = 2 * hstep;
    const unsigned ldsw = (unsigned)wid * 1024u;
    const int aoff = lds_byte(wr * 64 + fr, fq * 8), boff = lds_byte(wc * 32 + fr, fq * 8);
#define PG8_SA(b, h) (((b) * 2 + (h)) * HTB)
#define PG8_SB(b, h) ((4 + (b) * 2 + (h)) * HTB)
#define PG8_STAGE(bufoff, gbase, voff) do { _Pragma("unroll") for (int _i = 0; _i < 2; ++_i) \
        __builtin_amdgcn_global_load_lds((const unsigned*)((const char*)(gbase) + (voff)[_i]), (PG8_LAS unsigned*)(lds + (bufoff) + ldsw + _i * 8192), 16, 0, 0); } while (0)
#define PG8_LDA(dst, b, h) do { _Pragma("unroll") for (int m = 0; m < 4; ++m) _Pragma("unroll") for (int k = 0; k < 2; ++k) dst[m][k] = *(const PG8_LAS bf16x8*)(lds + PG8_SA(b, h) + aoff + m * 2048 + k * 1024); } while (0)
#define PG8_LDB(dst, b, h) do { _Pragma("unroll") for (int n = 0; n < 2; ++n) _Pragma("unroll") for (int k = 0; k < 2; ++k) dst[n][k] = *(const PG8_LAS bf16x8*)(lds + PG8_SB(b, h) + boff + n * 2048 + k * 1024); } while (0)
#define PG8_MMA(ai, bj, At, Bt) do { __builtin_amdgcn_s_setprio(1); _Pragma("unroll") for (int m = 0; m < 4; ++m) _Pragma("unroll") for (int n = 0; n < 2; ++n) _Pragma("unroll") for (int k = 0; k < 2; ++k) \
        acc[ai][bj][m][n] = __builtin_amdgcn_mfma_f32_16x16x32_bf16(Bt[n][k], At[m][k], acc[ai][bj][m][n], 0, 0, 0); __builtin_amdgcn_s_setprio(0); } while (0)
#define PG8_WAIT_V(n) asm volatile("s_waitcnt vmcnt(" #n ")" ::: "memory")
#define PG8_WAIT_L(n) asm volatile("s_waitcnt lgkmcnt(" #n ")" ::: "memory")
#define PG8_BAR __builtin_amdgcn_s_barrier()
#define PG8_SCHED __builtin_amdgcn_sched_barrier(0)
    Unit cur, nxt; int ui = 0;
    if (!S.next(0, cur)) return;
    f32x4 acc[2][2][4][2];
#pragma unroll
    for (int a = 0; a < 2; ++a)
#pragma unroll
        for (int b = 0; b < 2; ++b)
#pragma unroll
            for (int m = 0; m < 4; ++m)
#pragma unroll
                for (int n = 0; n < 2; ++n) acc[a][b][m][n] = (f32x4){0.f, 0.f, 0.f, 0.f};
    bf16x8 At[4][2], B0[2][2], B1[2][2];
    const char* cA = (const char*)g.A + (size_t)cur.pm * tstep; const char* cB = (const char*)g.Bt + (size_t)cur.pn * tstep;
    S.a_ready(cur);
    if constexpr (SP2) {
        PG8_STAGE(PG8_SB(0, 0), cB, voffB); PG8_STAGE(PG8_SB(0, 1), cB + hstep, voffB); PG8_STAGE(PG8_SA(0, 0), cA, voffA); PG8_STAGE(PG8_SA(0, 1), cA + hstep, voffA);
        if (wr == 1) PG8_BAR;
        PG8_WAIT_V(2); PG8_BAR;
        PG8_STAGE(PG8_SB(1, 0), cB + kstep, voffB); PG8_STAGE(PG8_SA(1, 0), cA + kstep, voffA); PG8_STAGE(PG8_SB(1, 1), cB + hstep + kstep, voffB);
        PG8_WAIT_V(6); PG8_BAR;
    } else {
        PG8_STAGE(PG8_SB(0, 0), cB, voffB); PG8_STAGE(PG8_SA(0, 0), cA, voffA); PG8_STAGE(PG8_SB(0, 1), cB + hstep, voffB); PG8_STAGE(PG8_SA(0, 1), cA + hstep, voffA);
        if (wr == 1) PG8_BAR;
        PG8_WAIT_V(4); PG8_BAR;
        PG8_STAGE(PG8_SB(1, 0), cB + kstep, voffB); PG8_STAGE(PG8_SA(1, 0), cA + kstep, voffA); PG8_STAGE(PG8_SB(1, 1), cB + hstep + kstep, voffB);
        PG8_WAIT_V(6); PG8_BAR;
    }
    for (;;) {
        const bool has_next = S.next(ui + 1, nxt);
        const char* nA = has_next ? (const char*)g.A + (size_t)nxt.pm * tstep : cA; const char* nB = has_next ? (const char*)g.Bt + (size_t)nxt.pn * tstep : cB;
        for (int t = 0; t < nt; t += 2) {
            const bool last = (t == nt - 2);
            const char* a1 = cA + (size_t)(t + 1) * kstep;
            const char* a2 = last ? nA : cA + (size_t)(t + 2) * kstep; const char* b2 = last ? nB : cB + (size_t)(t + 2) * kstep;
            const char* a3 = a2 + kstep; const char* b3 = b2 + kstep;
            if (last && has_next) S.a_ready(nxt);
            if constexpr (SP2) {
            PG8_LDB(B0, 0, 0); PG8_LDB(B1, 0, 1); PG8_SCHED; PG8_LDA(At, 0, 0); PG8_STAGE(PG8_SA(1, 1), a1 + hstep, voffA);
            PG8_WAIT_V(8); PG8_WAIT_L(0); PG8_BAR; PG8_MMA(0, 0, At, B0); PG8_MMA(0, 1, At, B1); PG8_BAR; PG8_SCHED;
            PG8_LDA(At, 0, 1); PG8_STAGE(PG8_SB(0, 0), b2, voffB); PG8_STAGE(PG8_SB(0, 1), b2 + hstep, voffB); PG8_STAGE(PG8_SA(0, 0), a2, voffA);
            PG8_WAIT_V(8); PG8_WAIT_L(0); PG8_BAR; PG8_MMA(1, 0, At, B0); PG8_MMA(1, 1, At, B1); PG8_BAR; PG8_SCHED;
            PG8_LDB(B0, 1, 0); PG8_LDB(B1, 1, 1); PG8_SCHED; PG8_LDA(At, 1, 0); PG8_STAGE(PG8_SA(0, 1), a2 + hstep, voffA);
            PG8_WAIT_V(8); PG8_WAIT_L(0); PG8_BAR; PG8_MMA(0, 0, At, B0); PG8_MMA(0, 1, At, B1); PG8_BAR; PG8_SCHED;
            PG8_LDA(At, 1, 1); PG8_STAGE(PG8_SB(1, 0), b3, voffB); PG8_STAGE(PG8_SB(1, 1), b3 + hstep, voffB); PG8_STAGE(PG8_SA(1, 0), a3, voffA);
            PG8_WAIT_V(8); PG8_WAIT_L(0); PG8_BAR; PG8_MMA(1, 0, At, B0); PG8_MMA(1, 1, At, B1); PG8_BAR; PG8_SCHED;
            } else {
            PG8_LDB(B0, 0, 0); PG8_SCHED; PG8_LDA(At, 0, 0); PG8_STAGE(PG8_SA(1, 1), a1 + hstep, voffA);
            PG8_WAIT_L(8); PG8_BAR; PG8_WAIT_L(0); PG8_MMA(0, 0, At, B0); PG8_BAR; PG8_SCHED;
            PG8_LDB(B1, 0, 1); PG8_STAGE(PG8_SB(0, 0), b2, voffB);
            PG8_BAR; PG8_WAIT_L(0); PG8_MMA(0, 1, At, B1); PG8_BAR;
            PG8_LDA(At, 0, 1); PG8_STAGE(PG8_SA(0, 0), a2, voffA);
            PG8_BAR; PG8_WAIT_L(0); PG8_MMA(1, 0, At, B0); PG8_BAR; PG8_SCHED;
            PG8_STAGE(PG8_SB(0, 1), b2 + hstep, voffB);
            PG8_WAIT_V(6); PG8_BAR; PG8_MMA(1, 1, At, B1); PG8_BAR;
            PG8_LDB(B0, 1, 0); PG8_SCHED; PG8_LDA(At, 1, 0); PG8_STAGE(PG8_SA(0, 1), a2 + hstep, voffA);
            PG8_WAIT_L(8); PG8_BAR; PG8_WAIT_L(0); PG8_MMA(0, 0, At, B0); PG8_BAR; PG8_SCHED;
            PG8_LDB(B1, 1, 1); PG8_STAGE(PG8_SB(1, 0), b3, voffB);
            PG8_BAR; PG8_WAIT_L(0); PG8_MMA(0, 1, At, B1); PG8_BAR;
            PG8_LDA(At, 1, 1); PG8_STAGE(PG8_SA(1, 0), a3, voffA);
            PG8_BAR; PG8_WAIT_L(0); PG8_MMA(1, 0, At, B0); PG8_BAR; PG8_SCHED;
            PG8_STAGE(PG8_SB(1, 1), b3 + hstep, voffB);
            PG8_WAIT_V(6); PG8_BAR; PG8_MMA(1, 1, At, B1); PG8_BAR;
            }
        }
        if constexpr (ALIGN_EPI) { if (wr == 0) PG8_BAR; }
        E(acc, cur, wr, wc, fr, fq); S.done(cur);
        if (!has_next) break;
#pragma unroll
        for (int a = 0; a < 2; ++a)
#pragma unroll
            for (int b = 0; b < 2; ++b)
#pragma unroll
                for (int m = 0; m < 4; ++m)
#pragma unroll
                    for (int n = 0; n < 2; ++n) acc[a][b][m][n] = (f32x4){0.f, 0.f, 0.f, 0.f};
        cur = nxt; cA = nA; cB = nB; ++ui;
        if constexpr (ALIGN_EPI) { if (wr == 1) PG8_BAR; }
    }
    PG8_WAIT_V(0);
    if constexpr (!ALIGN_EPI) { if (wr == 0) PG8_BAR; }
    PG8_BAR;
#undef PG8_SA
#undef PG8_SB
#undef PG8_STAGE
#undef PG8_LDA
#undef PG8_LDB
#undef PG8_MMA
#undef PG8_WAIT_V
#undef PG8_WAIT_L
#undef PG8_BAR
#undef PG8_SCHED
}
}

constexpr int NWAVES = 8, NTHR = 512;
constexpr int D = 2048, FF = 8192, PLE = 256;
constexpr int TP = 2048, BP = 4, TS = 4, BS = 128;
constexpr int MP = BP * TP, MS = BS * TS, M = MP + MS;
constexpr int NPROJ = 6160, NPROJ_PAD = 6400;
constexpr int NH = 8;
constexpr float LN_EPS = 1e-5f, RMS_EPS = 1e-6f;
constexpr float DN_ALPHA = 1.41421356237f;

constexpr size_t MiB = 1u << 20;
constexpr size_t WS_CTL = 0;
constexpr size_t WS_WINE = 1 * MiB;
constexpr size_t WS_WOUTE = WS_WINE + 25 * MiB;
constexpr size_t WS_WINO = WS_WOUTE + 8 * MiB;
constexpr size_t WS_WOUTO = WS_WINO + 25 * MiB;
constexpr size_t WS_WUP = WS_WOUTO + 8 * MiB;
constexpr size_t WS_WDOWN = WS_WUP + 64 * MiB;
constexpr size_t WS_WPLE = WS_WDOWN + 64 * MiB;
constexpr size_t WS_WGATE = WS_WPLE + 2 * MiB;
constexpr size_t WS_XB = WS_WGATE + 16 * MiB;
constexpr size_t WS_MIX = WS_XB + 34 * MiB;
constexpr size_t WS_H = WS_MIX + 34 * MiB;
constexpr size_t WS_H2 = WS_H + 34 * MiB;
constexpr size_t WS_PW = WS_H2 + 34 * MiB;
constexpr size_t WS_PB = WS_PW + 34 * MiB;
constexpr size_t WS_GATES = WS_PB + 9 * MiB;
constexpr size_t WS_PROJ = WS_GATES + 1 * MiB;
constexpr size_t WS_PART0 = WS_PROJ + 136 * MiB;
constexpr size_t WS_PART1 = WS_PART0 + 68 * MiB;
constexpr size_t WS_LRUW = WS_PART1 + 68 * MiB;
constexpr size_t WS_END = WS_LRUW + 1 * MiB;
constexpr size_t WS_DG = WS_PART0;
constexpr size_t WS_DB = WS_PART0 + 32 * MiB;
constexpr size_t WS_DS = WS_PART0 + 64 * MiB;
constexpr size_t WS_DQ = WS_PART0 + 96 * MiB;
constexpr size_t WS_DO = WS_PART0 + 112 * MiB;
constexpr size_t WS_DD = WS_PART0 + 128 * MiB;
constexpr size_t WS_DF = WS_PART0 + 129 * MiB;
constexpr size_t WS_MC = WS_PART0;
constexpr size_t WS_MN = WS_PART0 + 64 * MiB;
constexpr size_t WS_MM = WS_PART0 + 65 * MiB;
constexpr size_t WS_LRU_HL = WS_H;
constexpr size_t WS_LRU_P = WS_H + 16 * MiB;
constexpr size_t WS_LRU_END = WS_H + 32 * MiB;

constexpr size_t O_Y = 0;
constexpr size_t O_CONVP = (size_t)M * D;
constexpr size_t O_DELTAP = O_CONVP + (size_t)BP * 3 * 4096;
constexpr size_t O_LRUP = O_DELTAP + (size_t)BP * 8 * 128 * 128;
constexpr size_t O_MCP = O_LRUP + (size_t)BP * 1024;
constexpr size_t O_MNP = O_MCP + (size_t)BP * 8 * 256 * 128;
constexpr size_t O_MMP = O_MNP + (size_t)BP * 8 * 128;
constexpr size_t O_CONVS = O_MMP + (size_t)BP * 8;
constexpr size_t O_DELTAS = O_CONVS + (size_t)BS * 3 * 4096;
constexpr size_t O_LRUS = O_DELTAS + (size_t)BS * 8 * 128 * 128;
constexpr size_t O_MCS = O_LRUS + (size_t)BS * 1024;
constexpr size_t O_MNS = O_MCS + (size_t)BS * 8 * 256 * 128;
constexpr size_t O_MMS = O_MNS + (size_t)BS * 8 * 128;
constexpr size_t O_END = O_MMS + (size_t)BS * 8;

constexpr int LDS_BYTES = 147456;
constexpr int LDS_CTL_OFF = 131072;

#define LAS __attribute__((address_space(3)))
typedef unsigned short bf16;
typedef unsigned v4u __attribute__((ext_vector_type(4)));
typedef unsigned v2u __attribute__((ext_vector_type(2)));
typedef float f32x4 __attribute__((ext_vector_type(4)));
#define LDS_WAIT() asm volatile("s_waitcnt lgkmcnt(0)" ::: "memory")
__device__ __forceinline__ unsigned f2bf(float f) { unsigned u = __builtin_bit_cast(unsigned, f); return (u + 0x7fffu + ((u >> 16) & 1u)) >> 16; }
__device__ __forceinline__ unsigned pk2(float lo, float hi) { return f2bf(lo) | (f2bf(hi) << 16); }
__device__ __forceinline__ float bf2f(unsigned short b) { return __builtin_bit_cast(float, ((unsigned)b) << 16); }
__device__ __forceinline__ float bflo(unsigned w) { return __builtin_bit_cast(float, w << 16); }
__device__ __forceinline__ float bfhi(unsigned w) { return __builtin_bit_cast(float, w & 0xffff0000u); }
__device__ __forceinline__ float sigm(float x) { return 1.f / (1.f + expf(-x)); }
__device__ __forceinline__ float siluf(float x) { return x * sigm(x); }
__device__ __forceinline__ float softplusf(float x) { return fmaxf(x, 0.f) + log1pf(expf(-fabsf(x))); }
__device__ __forceinline__ float logsigf(float x) { return -softplusf(-x); }
__device__ __forceinline__ float gelu_tanh(float x) { const float u = 0.7978845608028654f * (x + 0.044715f * x * x * x); return 0.5f * x * (1.f + tanhf(u)); }
__device__ __forceinline__ float wave_sum(float v) {
#pragma unroll
    for (int o = 1; o < 64; o <<= 1) v += __shfl_xor(v, o);
    return v;
}

#define XB_TMO      128
#define XB_XCNT(j)  (256  + 64 * (j))
#define XB_XSUB(j)  (1280 + 64 * (j))
#define XB_XGEN(j)  (2304 + 64 * (j))
#define XB_TOP      3328
#define XB_TOPGEN   3392
#define XCD_BAR_WORDS 3456
#define XB_SPIN_CAP (1u << 22)
__device__ __forceinline__ unsigned xb_ld(unsigned* p)              { return __hip_atomic_load(p, __ATOMIC_RELAXED, __HIP_MEMORY_SCOPE_AGENT); }
__device__ __forceinline__ unsigned xb_add(unsigned* p, unsigned v) { return __hip_atomic_fetch_add(p, v, __ATOMIC_RELAXED, __HIP_MEMORY_SCOPE_AGENT); }
__device__ __forceinline__ unsigned xb_xcc_id() { return (unsigned)__builtin_amdgcn_s_getreg((3 << 11) | 20) & 0xFu; }
#define XB_SPIN(cond, bar) do { unsigned _sp = 0; while (cond) { __builtin_amdgcn_s_sleep(1); \
    if ((++_sp & 255u) == 0u) { if (xb_ld(&(bar)[XB_TMO])) break; if (_sp > XB_SPIN_CAP) { atomicAdd(&(bar)[XB_TMO], 1u); break; } } } } while (0)
struct XcdBarrier { unsigned* bar; unsigned x; volatile LAS unsigned* st; };
__device__ __forceinline__ XcdBarrier xcd_barrier_post(unsigned* bar, volatile LAS unsigned* st) {
    XcdBarrier b; b.bar = bar; b.x = xb_xcc_id(); b.st = st;
    if (threadIdx.x == 0) (void)xb_add(&bar[XB_XCNT(b.x)], 1u);
    return b;
}
__device__ __forceinline__ void xcd_barrier_complete(unsigned* bar, unsigned x, unsigned& nloc, unsigned& nx) {
    const unsigned G = gridDim.x * gridDim.y * gridDim.z;
    unsigned sum, cnt, mine, sp = 0u;
    for (;;) {
        sum = 0u; cnt = 0u; mine = 0u;
#pragma unroll
        for (unsigned j = 0; j < 16; ++j) { const unsigned c = xb_ld(&bar[XB_XCNT(j)]); sum += c; cnt += (c > 0u) ? 1u : 0u; mine = (j == x) ? c : mine; }
        if (sum == G) break;
        __builtin_amdgcn_s_sleep(1);
        if ((++sp & 255u) == 0u) { if (xb_ld(&bar[XB_TMO])) break; if (sp > XB_SPIN_CAP) { atomicAdd(&bar[XB_TMO], 1u); break; } }
    }
    nloc = mine > 0u ? mine : 1u; nx = cnt > 0u ? cnt : 1u;
}
__device__ __forceinline__ void xcd_barrier(const XcdBarrier& b) {
    asm volatile("s_waitcnt vmcnt(0)" ::: "memory");
    __syncthreads();
    if (threadIdx.x == 0) {
        unsigned* bar = b.bar;
        __builtin_amdgcn_s_waitcnt(0);
        unsigned nloc = b.st[0], nx = b.st[1];
        if (nloc == 0u) { xcd_barrier_complete(bar, b.x, nloc, nx); b.st[0] = nloc; b.st[1] = nx; }
        const unsigned old = xb_add(&bar[XB_XSUB(b.x)], 1u);
        const unsigned gen = old / nloc;
        if (old + 1u == (gen + 1u) * nloc) {
            __builtin_amdgcn_fence(__ATOMIC_RELEASE, "agent");
            asm volatile("s_waitcnt vmcnt(0)" ::: "memory");
            const unsigned og = xb_add(&bar[XB_TOP], 1u);
            const unsigned tg = og / nx;
            if (og + 1u == (tg + 1u) * nx) xb_add(&bar[XB_TOPGEN], 1u);
            else XB_SPIN(xb_ld(&bar[XB_TOPGEN]) == tg, bar);
            __builtin_amdgcn_fence(__ATOMIC_ACQUIRE, "agent");
            xb_add(&bar[XB_XGEN(b.x)], 1u);
            asm volatile("s_waitcnt vmcnt(0)" ::: "memory");
        } else {
            XB_SPIN(xb_ld(&bar[XB_XGEN(b.x)]) == gen, bar);
            __builtin_amdgcn_fence(__ATOMIC_ACQUIRE, "agent");
            asm volatile("s_waitcnt vmcnt(0)" ::: "memory");
        }
    }
    __syncthreads();
}

struct Args { const float* in[35]; float* out; unsigned char* ws; int ph_lo, ph_hi; };
typedef const __attribute__((address_space(4))) Args* ArgsP;
enum { I_XP = 0, I_XS, I_PP, I_PS, I_SCONV, I_SDELTA, I_SLRU, I_SMC, I_SMN, I_SMM, I_WINE, I_WCONV, I_BCONV, I_ALOG, I_DTB, I_DNORM, I_LWR, I_LBR, I_LWI, I_LBI, I_LLAM, I_WOUTE,
       I_WINO, I_BIG, I_BFG, I_MNORM, I_WOUTO, I_LN1G, I_LN1B, I_LN2G, I_LN2B, I_WUP, I_WDOWN, I_WPLE, I_WGATE };

__device__ __forceinline__ void p0_transpose_item(const float* W, int K, int N, int Npad, bf16* WT, LAS float* scr, int item, int lane) {
    const int nblk = Npad / 32, kb = item / nblk, nb = item % nblk, k0 = 64 * kb, n0 = 32 * nb;
    const int nn = n0 + (lane & 31); const bool ok = nn < N;
#pragma unroll 8
    for (int i = 0; i < 32; ++i) { const int kk = 2 * i + (lane >> 5); scr[kk * 33 + (lane & 31)] = ok ? W[(size_t)(k0 + kk) * N + nn] : 0.f; }
    LDS_WAIT(); asm volatile("" ::: "memory");
    const int c = lane & 7;
#pragma unroll
    for (int j = 0; j < 4; ++j) { const int n = (lane >> 3) + 8 * j; const LAS float* s = scr + (8 * c) * 33 + n;
        v4u o; o.x = pk2(s[0 * 33], s[1 * 33]); o.y = pk2(s[2 * 33], s[3 * 33]); o.z = pk2(s[4 * 33], s[5 * 33]); o.w = pk2(s[6 * 33], s[7 * 33]);
        *(v4u*)(WT + (size_t)(n0 + n) * K + k0 + 8 * c) = o; }
    LDS_WAIT(); asm volatile("" ::: "memory");
}
__device__ __forceinline__ void row_to_bf16(const float* src, bf16* dst, int n, int lane) {
    for (int j = 0; j < n / 256; ++j) { const f32x4 v = *(const f32x4*)(src + j * 256 + lane * 4); v2u o; o.x = pk2(v.x, v.y); o.y = pk2(v.z, v.w); *(v2u*)(dst + j * 256 + lane * 4) = o; }
}

__device__ __forceinline__ void phase_convert(ArgsP a, LAS unsigned char* lds, int gw, int NGW, int wave, int lane) {
    unsigned char* ws = a->ws;
    LAS float* scr = (LAS float*)(lds + wave * 16384);
    constexpr int I_IN = (D / 64) * (NPROJ_PAD / 32), I_SQ = (D / 64) * (D / 32), I_UP = (D / 64) * (FF / 32), I_DN = (FF / 64) * (D / 32), I_PL = (PLE / 64) * (D / 32);
    constexpr int NITEMS = 2 * I_IN + 2 * I_SQ + 2 * I_UP + 2 * I_DN + 2 * I_PL + 2 * I_SQ + 128;
    for (int it = gw; it < NITEMS; it += NGW) {
        int r = it;
        if (r < I_IN) { p0_transpose_item(a->in[I_WINE], D, NPROJ, NPROJ_PAD, (bf16*)(ws + WS_WINE), scr, r, lane); continue; } r -= I_IN;
        if (r < I_IN) { p0_transpose_item(a->in[I_WINO], D, NPROJ, NPROJ_PAD, (bf16*)(ws + WS_WINO), scr, r, lane); continue; } r -= I_IN;
        if (r < I_SQ) { p0_transpose_item(a->in[I_WOUTE], D, D, D, (bf16*)(ws + WS_WOUTE), scr, r, lane); continue; } r -= I_SQ;
        if (r < I_SQ) { p0_transpose_item(a->in[I_WOUTO], D, D, D, (bf16*)(ws + WS_WOUTO), scr, r, lane); continue; } r -= I_SQ;
        if (r < 2 * I_UP) { const int l = r / I_UP; p0_transpose_item(a->in[I_WUP] + (size_t)l * D * FF, D, FF, FF, (bf16*)(ws + WS_WUP) + (size_t)l * D * FF, scr, r % I_UP, lane); continue; } r -= 2 * I_UP;
        if (r < 2 * I_DN) { const int l = r / I_DN; p0_transpose_item(a->in[I_WDOWN] + (size_t)l * D * FF, FF, D, D, (bf16*)(ws + WS_WDOWN) + (size_t)l * D * FF, scr, r % I_DN, lane); continue; } r -= 2 * I_DN;
        if (r < 2 * I_PL) { const int l = r / I_PL; p0_transpose_item(a->in[I_WPLE] + (size_t)l * PLE * D, PLE, D, D, (bf16*)(ws + WS_WPLE) + (size_t)l * PLE * D, scr, r % I_PL, lane); continue; } r -= 2 * I_PL;
        if (r < 2 * I_SQ) { const int l = r / I_SQ; p0_transpose_item(a->in[I_WGATE] + (size_t)l * D * D, D, D, D, (bf16*)(ws + WS_WGATE) + (size_t)l * D * D, scr, r % I_SQ, lane); continue; } r -= 2 * I_SQ;
        { const int mat = r / 64, blk = (r / 8) & 7; p0_transpose_item(a->in[mat == 0 ? I_LWR : I_LWI] + (size_t)blk * 16384, 128, 128, 128, (bf16*)(ws + WS_LRUW) + (size_t)(mat * 8 + blk) * 16384, scr, r % 8, lane); }
    }
    bf16* xb = (bf16*)(ws + WS_XB);
    for (int m = gw; m < M; m += NGW) {
        const float* src = m < MP ? a->in[I_XP] + (size_t)m * D : a->in[I_XS] + (size_t)(m - MP) * D;
        row_to_bf16(src, xb + (size_t)m * D, D, lane);
    }
    bf16* pb = (bf16*)(ws + WS_PB);
    for (int r = gw; r < 2 * M; r += NGW) {
        const int l = r / M, m = r % M;
        const float* src = m < MP ? a->in[I_PP] + ((size_t)l * MP + m) * PLE : a->in[I_PS] + ((size_t)l * MS + (m - MP)) * PLE;
        row_to_bf16(src, pb + (size_t)r * PLE, PLE, lane);
    }
}

__device__ __forceinline__ float conv_in(const bf16* proj, int row0, int tq, int ch, const float* cstate) {
    if (tq >= 0) return bf2f(proj[(size_t)(row0 + tq) * NPROJ_PAD + ch]);
    return cstate ? cstate[(3 + tq) * 4096 + ch] : 0.f;
}
__device__ __forceinline__ float conv4(const bf16* proj, int row0, int t, int ch, const float* cstate, const float* wconv, const float* bconv) {
    float acc = bconv[ch];
#pragma unroll
    for (int j = 0; j < 4; ++j) acc += wconv[j * 4096 + ch] * conv_in(proj, row0, t - 3 + j, ch, cstate);
    return acc;
}

__device__ __forceinline__ void delta_rec_item(ArgsP a, LAS unsigned char* lds, int row0, int T, int h, const float* cstate, const float* S0, float* Sout, const int tid) {
    const int lane = tid & 63, wave = tid >> 6, c = tid & 127, r = tid >> 7;
    const bf16* proj = (const bf16*)(a->ws + WS_PROJ); const float* gates = (const float*)(a->ws + WS_GATES); bf16* mix = (bf16*)(a->ws + WS_MIX);
    const float* wconv = a->in[I_WCONV]; const float* bconv = a->in[I_BCONV];
    LAS float* act = (LAS float*)lds;
    LAS float* nrm = act + 4 * 384;
    LAS float* gb = nrm + 8;
    LAS float* red = gb + 8;
    LAS float* red2 = red + 512;
    LAS float* obuf = red2 + 512;
    float s[32];
#pragma unroll
    for (int i = 0; i < 32; ++i) s[i] = S0 ? S0[(size_t)(32 * r + i) * 128 + c] : 0.f;
    const float aexp = expf(a->in[I_ALOG][h]), dtb = a->in[I_DTB][h];
#pragma unroll 1
    for (int t0 = 0; t0 < T; t0 += 4) {
#pragma unroll
        for (int j = 0; j < 3; ++j) { const int idx = tid + 512 * j, tok = idx / 384, chl = idx % 384, part = chl >> 7, i = chl & 127;
            const int ch = part * 1024 + h * 128 + i;
            act[tok * 384 + chl] = siluf(conv4(proj, row0, t0 + tok, ch, cstate, wconv, bconv)); }
        __syncthreads();
        { const int tok = wave >> 1, part = wave & 1; const float x0 = act[tok * 384 + part * 128 + lane], x1 = act[tok * 384 + part * 128 + 64 + lane];
          const float ss = wave_sum(x0 * x0 + x1 * x1); if (lane == 0) nrm[tok * 2 + part] = rsqrtf(ss + 1e-6f) * (part == 0 ? 0.08838834764831845f : 1.f); }
        if (tid < 4) { const int row = row0 + t0 + tid; const float g = -aexp * softplusf(gates[(size_t)row * 16 + h] + dtb); gb[tid * 2] = expf(g); gb[tid * 2 + 1] = sigm(gates[(size_t)row * 16 + 8 + h]); }
        __syncthreads();
#pragma unroll 1
        for (int tok = 0; tok < 4; ++tok) {
            const float eg = gb[tok * 2], beta = gb[tok * 2 + 1], nq = nrm[tok * 2], nk = nrm[tok * 2 + 1];
            const LAS float* qv = act + tok * 384 + 32 * r; const LAS float* kv = qv + 128;
            float ks = 0.f;
#pragma unroll
            for (int i = 0; i < 32; ++i) ks += kv[i] * s[i];
            red[r * 128 + c] = ks * nk;
            __syncthreads();
            const float kS = red[c] + red[128 + c] + red[256 + c] + red[384 + c];
            const float vnew = beta * (act[tok * 384 + 256 + c] - eg * kS);
            float os = 0.f;
#pragma unroll
            for (int i = 0; i < 32; ++i) { s[i] = eg * s[i] + (kv[i] * nk) * vnew; os += qv[i] * s[i]; }
            red2[r * 128 + c] = os * nq;
            __syncthreads();
            if (r == 0) obuf[tok * 128 + c] = red2[c] + red2[128 + c] + red2[256 + c] + red2[384 + c];
        }
        __syncthreads();
        if (wave < 4) { const int tok = wave, row = row0 + t0 + tok; const float o0 = obuf[tok * 128 + lane], o1 = obuf[tok * 128 + 64 + lane];
            const float rstd = rsqrtf(wave_sum(o0 * o0 + o1 * o1) * (1.f / 128.f) + RMS_EPS);
            const float* nw = a->in[I_DNORM];
            const float z0 = bf2f(proj[(size_t)row * NPROJ_PAD + 4096 + h * 128 + lane]), z1 = bf2f(proj[(size_t)row * NPROJ_PAD + 4096 + h * 128 + 64 + lane]);
            mix[(size_t)row * D + h * 128 + lane] = (bf16)f2bf(o0 * rstd * nw[lane] * siluf(z0));
            mix[(size_t)row * D + h * 128 + 64 + lane] = (bf16)f2bf(o1 * rstd * nw[64 + lane] * siluf(z1)); }
        __syncthreads();
    }
#pragma unroll
    for (int i = 0; i < 32; ++i) Sout[(size_t)(32 * r + i) * 128 + c] = s[i];
}

__device__ __forceinline__ void lru_rec_item(ArgsP a, LAS unsigned char* lds, int row0, int T, int n, const float* cstate, const float* h0, float* hout, const int tid) {
    const int d = tid & 127, part = tid >> 7;
    const bf16* proj = (const bf16*)(a->ws + WS_PROJ); bf16* mix = (bf16*)(a->ws + WS_MIX);
    const float* wconv = a->in[I_WCONV]; const float* bconv = a->in[I_BCONV];
    const float* wr = a->in[I_LWR] + (size_t)n * 16384; const float* wi = a->in[I_LWI] + (size_t)n * 16384;
    LAS float* xr = (LAS float*)lds;
    LAS float* red = xr + 512;
    const int chn = n * 128 + d;
    float hst = h0 ? h0[chn] : 0.f;
    const float br = a->in[I_LBR][chn], bi = a->in[I_LBI][chn], spl = softplusf(-a->in[I_LLAM][chn]);
#pragma unroll 1
    for (int t0 = 0; t0 < T; t0 += 4) {
        { const int tok = tid >> 7; xr[tok * 128 + d] = conv4(proj, row0, t0 + tok, 3072 + chn, cstate, wconv, bconv); }
        __syncthreads();
        float ar[4] = {0.f, 0.f, 0.f, 0.f}, ai[4] = {0.f, 0.f, 0.f, 0.f};
#pragma unroll 4
        for (int cc = 0; cc < 32; ++cc) { const int c = part * 32 + cc; const float w1 = wr[c * 128 + d], w2 = wi[c * 128 + d];
#pragma unroll
        for (int tok = 0; tok < 4; ++tok) { const float x = xr[tok * 128 + c]; ar[tok] += x * w1; ai[tok] += x * w2; } }
#pragma unroll
        for (int tok = 0; tok < 4; ++tok) { red[((tok * 2 + 0) * 4 + part) * 128 + d] = ar[tok]; red[((tok * 2 + 1) * 4 + part) * 128 + d] = ai[tok]; }
        __syncthreads();
        if (part == 0) {
    #pragma unroll 1
        for (int tok = 0; tok < 4; ++tok) {
                const int row = row0 + t0 + tok;
                float rp = br, ip = bi;
#pragma unroll
                for (int p = 0; p < 4; ++p) { rp += red[((tok * 2 + 0) * 4 + p) * 128 + d]; ip += red[((tok * 2 + 1) * 4 + p) * 128 + d]; }
                const float log_a = -8.f * sigm(rp) * spl;
                const float av = expf(log_a);
                const float bx = sqrtf(-expm1f(2.f * log_a)) * sigm(ip) * xr[tok * 128 + d];
                hst = av * hst + bx;
                const float gate = bf2f(proj[(size_t)row * NPROJ_PAD + 5120 + chn]);
                mix[(size_t)row * D + 1024 + chn] = (bf16)f2bf(hst * gelu_tanh(gate));
            }
        }
        __syncthreads();
    }
    if (part == 0) hout[chn] = hst;
}

__device__ __forceinline__ void mlstm_rec_item(ArgsP a, LAS unsigned char* lds, int row0, int T, int h, const float* C0, const float* n0, const float* m0, float* Cout, float* nout, float* mout, const int tid) {
    const int lane = tid & 63, wave = tid >> 6, v = tid & 255, kh = tid >> 8;
    const bf16* proj = (const bf16*)(a->ws + WS_PROJ); const float* gates = (const float*)(a->ws + WS_GATES); bf16* mix = (bf16*)(a->ws + WS_MIX);
    LAS float* qs = (LAS float*)lds;
    LAS float* ks = qs + 512;
    LAS float* vs = ks + 512;
    LAS float* gs = vs + 1024;
    LAS float* red = gs + 8;
    LAS float* dred = red + 1024;
    LAS float* hbuf = dred + 4;
    float cst[64];
#pragma unroll
    for (int i = 0; i < 64; ++i) cst[i] = C0 ? C0[(size_t)v * 128 + 64 * kh + i] : 0.f;
    float nst = (tid < 128) ? (n0 ? n0[tid] : 0.f) : 0.f;
    float mst = m0 ? m0[0] : 0.f;
    const float big = a->in[I_BIG][h], bfg = a->in[I_BFG][h];
#pragma unroll 1
    for (int t0 = 0; t0 < T; t0 += 4) {
#pragma unroll
        for (int j = 0; j < 4; ++j) { const int tok = j, row = row0 + t0 + tok; const bf16* pr = proj + (size_t)row * NPROJ_PAD;
            float val;
            if (tid < 128) val = bf2f(pr[h * 128 + tid]); else if (tid < 256) val = bf2f(pr[1024 + h * 128 + (tid - 128)]) * 0.08838834764831845f; else val = bf2f(pr[2048 + h * 256 + (tid - 256)]);
            if (tid < 128) qs[tok * 128 + tid] = val; else if (tid < 256) ks[tok * 128 + tid - 128] = val; else vs[tok * 256 + tid - 256] = val; }
        if (tid < 4) { const int row = row0 + t0 + tid; gs[tid * 2] = gates[(size_t)row * 16 + h] + big; gs[tid * 2 + 1] = gates[(size_t)row * 16 + 8 + h] + bfg; }
        __syncthreads();
#pragma unroll 1
        for (int tok = 0; tok < 4; ++tok) {
            const int par = tok & 1;
            const float ig = gs[tok * 2], lf = logsigf(gs[tok * 2 + 1]);
            const float mnew = fmaxf(lf + mst, ig), fp = expf(lf + mst - mnew), ip = expf(ig - mnew); mst = mnew;
            const float vv = vs[tok * 256 + v] * ip;
            const LAS float* kv = ks + tok * 128 + 64 * kh; const LAS float* qv = qs + tok * 128 + 64 * kh;
            float num = 0.f;
#pragma unroll
            for (int i = 0; i < 64; ++i) { cst[i] = fp * cst[i] + vv * kv[i]; num += cst[i] * qv[i]; }
            red[(par * 2 + kh) * 256 + v] = num;
            if (tid < 128) { nst = fp * nst + ip * ks[tok * 128 + tid]; const float dp = wave_sum(nst * qs[tok * 128 + tid]); if (lane == 0) dred[par * 2 + wave] = dp; }
            __syncthreads();
            if (kh == 0) { const float nm = red[(par * 2) * 256 + v] + red[(par * 2 + 1) * 256 + v]; const float den = dred[par * 2] + dred[par * 2 + 1];
                hbuf[tok * 256 + v] = nm / fmaxf(fabsf(den), expf(-mnew)); }
        }
        __syncthreads();
        if (wave < 4) { const int tok = wave, row = row0 + t0 + tok; float hv[4]; float ss = 0.f;
#pragma unroll
            for (int j = 0; j < 4; ++j) { hv[j] = hbuf[tok * 256 + j * 64 + lane]; ss += hv[j] * hv[j]; }
            const float rstd = rsqrtf(wave_sum(ss) * (1.f / 256.f) + RMS_EPS);
            const float* nw = a->in[I_MNORM] + h * 256;
#pragma unroll
            for (int j = 0; j < 4; ++j) { const int vi = j * 64 + lane; const float op = bf2f(proj[(size_t)row * NPROJ_PAD + 4096 + h * 256 + vi]);
                mix[(size_t)row * D + h * 256 + vi] = (bf16)f2bf(hv[j] * rstd * nw[vi] * sigm(op)); } }
        __syncthreads();
    }
#pragma unroll
    for (int i = 0; i < 64; ++i) Cout[(size_t)v * 128 + 64 * kh + i] = cst[i];
    if (tid < 128) nout[tid] = nst;
    if (tid == 0) mout[0] = mst;
}


typedef short bf16x8 __attribute__((ext_vector_type(8)));
#define MFMA32(a_, b_, c_) __builtin_amdgcn_mfma_f32_16x16x32_bf16(a_, b_, c_, 0, 0, 0)

__device__ __forceinline__ void lru_prep_item(ArgsP a, LAS unsigned char* lds, int item, const int tid) {
    const int c = item & 31, n = (item >> 5) & 7, b = item >> 8;
    const int lane = tid & 63, w = __builtin_amdgcn_readfirstlane(tid >> 6), fr = lane & 15, fq = lane >> 4;
    unsigned char* ws = a->ws;
    const bf16* proj = (const bf16*)(ws + WS_PROJ);
    LAS bf16* xa = (LAS bf16*)lds;
    LAS float* xf = (LAS float*)(lds + 17408);
    LAS float* obH = (LAS float*)(lds + 51200);
    LAS float* obP = obH + 64 * 132;
    {
        const int t = tid >> 3, sub = tid & 7, ch0 = 3072 + n * 128 + sub * 16;
        const float* wconv = a->in[I_WCONV]; const float* bconv = a->in[I_BCONV];
        float x[16];
#pragma unroll
        for (int i = 0; i < 4; ++i) { const f32x4 bb = *(const f32x4*)(bconv + ch0 + 4 * i); x[4 * i] = bb.x; x[4 * i + 1] = bb.y; x[4 * i + 2] = bb.z; x[4 * i + 3] = bb.w; }
#pragma unroll
        for (int j = 0; j < 4; ++j) { const int tt = 64 * c + t - 3 + j;
            if (tt >= 0) { const bf16* pr = proj + (size_t)(b * TP + tt) * NPROJ_PAD + ch0; const v4u u0 = *(const v4u*)pr, u1 = *(const v4u*)(pr + 8);
                const unsigned uu[8] = {u0.x, u0.y, u0.z, u0.w, u1.x, u1.y, u1.z, u1.w};
#pragma unroll
                for (int i = 0; i < 4; ++i) { const f32x4 ww = *(const f32x4*)(wconv + j * 4096 + ch0 + 4 * i);
                    x[4 * i] += ww.x * bflo(uu[2 * i]); x[4 * i + 1] += ww.y * bfhi(uu[2 * i]); x[4 * i + 2] += ww.z * bflo(uu[2 * i + 1]); x[4 * i + 3] += ww.w * bfhi(uu[2 * i + 1]); } } }
        v4u o0, o1; o0.x = pk2(x[0], x[1]); o0.y = pk2(x[2], x[3]); o0.z = pk2(x[4], x[5]); o0.w = pk2(x[6], x[7]); o1.x = pk2(x[8], x[9]); o1.y = pk2(x[10], x[11]); o1.z = pk2(x[12], x[13]); o1.w = pk2(x[14], x[15]);
        *(LAS v4u*)(xa + t * 136 + sub * 16) = o0; *(LAS v4u*)(xa + t * 136 + sub * 16 + 8) = o1;
#pragma unroll
        for (int i = 0; i < 4; ++i) *(LAS f32x4*)(xf + t * 132 + sub * 16 + 4 * i) = (f32x4){x[4 * i], x[4 * i + 1], x[4 * i + 2], x[4 * i + 3]};
    }
    __syncthreads();
    const bf16* wrT = (const bf16*)(ws + WS_LRUW) + (size_t)n * 16384; const bf16* wiT = wrT + 8 * 16384;
    bf16x8 br[4], bi[4];
#pragma unroll
    for (int ks = 0; ks < 4; ++ks) { br[ks] = *(const bf16x8*)(wrT + (16 * w + fr) * 128 + 32 * ks + 8 * fq); bi[ks] = *(const bf16x8*)(wiT + (16 * w + fr) * 128 + 32 * ks + 8 * fq); }
    f32x4 accr[4], acci[4];
#pragma unroll
    for (int tb = 0; tb < 4; ++tb) { accr[tb] = (f32x4){0.f, 0.f, 0.f, 0.f}; acci[tb] = (f32x4){0.f, 0.f, 0.f, 0.f};
#pragma unroll
        for (int ks = 0; ks < 4; ++ks) { const bf16x8 af = *(const LAS bf16x8*)(xa + (16 * tb + fr) * 136 + 32 * ks + 8 * fq); accr[tb] = MFMA32(af, br[ks], accr[tb]); acci[tb] = MFMA32(af, bi[ks], acci[tb]); } }
    const int dl = 16 * w + fr, chn = n * 128 + dl;
    const float brs = a->in[I_LBR][chn], bis = a->in[I_LBI][chn], spl = softplusf(-a->in[I_LLAM][chn]);
    float Apre = 1.f, Hpre = 0.f;
#pragma unroll
    for (int tb = 0; tb < 4; ++tb) {
        float P[4], Hh[4];
#pragma unroll
        for (int j = 0; j < 4; ++j) { const int t = 16 * tb + 4 * fq + j;
            const float log_a = -8.f * sigm(accr[tb][j] + brs) * spl; const float av = expf(log_a);
            const float bx = sqrtf(-expm1f(2.f * log_a)) * sigm(acci[tb][j] + bis) * xf[t * 132 + dl];
            if (j == 0) { P[0] = av; Hh[0] = bx; } else { P[j] = P[j - 1] * av; Hh[j] = av * Hh[j - 1] + bx; } }
        float Ai = P[3], Hi = Hh[3];
        { const float A2 = __shfl_up(Ai, 16), H2 = __shfl_up(Hi, 16); if (fq >= 1) { Hi = Ai * H2 + Hi; Ai = A2 * Ai; } }
        { const float A2 = __shfl_up(Ai, 32), H2 = __shfl_up(Hi, 32); if (fq >= 2) { Hi = Ai * H2 + Hi; Ai = A2 * Ai; } }
        float Aex = __shfl_up(Ai, 16), Hex = __shfl_up(Hi, 16); if (fq == 0) { Aex = 1.f; Hex = 0.f; }
        const float Atb = __shfl(Ai, 48 + fr), Htb = __shfl(Hi, 48 + fr);
        const float EA = Apre * Aex, EH = Aex * Hpre + Hex;
#pragma unroll
        for (int j = 0; j < 4; ++j) { const int t = 16 * tb + 4 * fq + j; obP[t * 132 + dl] = EA * P[j]; obH[t * 132 + dl] = P[j] * EH + Hh[j]; }
        Hpre = Atb * Hpre + Htb; Apre = Apre * Atb;
    }
    if (fq == 0) { float* e = (float*)(ws + WS_LRU_END) + (size_t)item * 256; e[dl] = Apre; e[128 + dl] = Hpre; }
    __syncthreads();
    {
        const int t = tid >> 3, sub = tid & 7;
        bf16* hl = (bf16*)(ws + WS_LRU_HL) + ((size_t)item * 64 + t) * 128 + sub * 16; bf16* pp = (bf16*)(ws + WS_LRU_P) + ((size_t)item * 64 + t) * 128 + sub * 16;
        const LAS float* sh = obH + t * 132 + sub * 16; const LAS float* sp = obP + t * 132 + sub * 16;
        v4u o0, o1;
        o0.x = pk2(sh[0], sh[1]); o0.y = pk2(sh[2], sh[3]); o0.z = pk2(sh[4], sh[5]); o0.w = pk2(sh[6], sh[7]); o1.x = pk2(sh[8], sh[9]); o1.y = pk2(sh[10], sh[11]); o1.z = pk2(sh[12], sh[13]); o1.w = pk2(sh[14], sh[15]);
        *(v4u*)hl = o0; *(v4u*)(hl + 8) = o1;
        o0.x = pk2(sp[0], sp[1]); o0.y = pk2(sp[2], sp[3]); o0.z = pk2(sp[4], sp[5]); o0.w = pk2(sp[6], sp[7]); o1.x = pk2(sp[8], sp[9]); o1.y = pk2(sp[10], sp[11]); o1.z = pk2(sp[12], sp[13]); o1.w = pk2(sp[14], sp[15]);
        *(v4u*)pp = o0; *(v4u*)(pp + 8) = o1;
    }
    __syncthreads();
}
__device__ __forceinline__ void lru_out_item(ArgsP a, LAS unsigned char* lds, int item, const int tid) {
    const int c = item & 31, n = (item >> 5) & 7, b = item >> 8;
    unsigned char* ws = a->ws;
    LAS float* carry = (LAS float*)lds;
    if (tid < 128) { float cr = 0.f; const float* e = (const float*)(ws + WS_LRU_END) + (size_t)(item - c) * 256;
        for (int k = 0; k < c; ++k) cr = e[k * 256 + 128 + tid] + e[k * 256 + tid] * cr;
        carry[tid] = cr; }
    __syncthreads();
    const int t = tid >> 3, sub = tid & 7, d0 = sub * 16, row = b * TP + 64 * c + t;
    const bf16* hl = (const bf16*)(ws + WS_LRU_HL) + ((size_t)item * 64 + t) * 128 + d0; const bf16* pp = (const bf16*)(ws + WS_LRU_P) + ((size_t)item * 64 + t) * 128 + d0;
    const bf16* gp = (const bf16*)(ws + WS_PROJ) + (size_t)row * NPROJ_PAD + 5120 + n * 128 + d0;
    const v4u h0 = *(const v4u*)hl, h1 = *(const v4u*)(hl + 8), p0 = *(const v4u*)pp, p1 = *(const v4u*)(pp + 8), g0 = *(const v4u*)gp, g1 = *(const v4u*)(gp + 8);
    const unsigned hu[8] = {h0.x, h0.y, h0.z, h0.w, h1.x, h1.y, h1.z, h1.w}, pu[8] = {p0.x, p0.y, p0.z, p0.w, p1.x, p1.y, p1.z, p1.w}, gu[8] = {g0.x, g0.y, g0.z, g0.w, g1.x, g1.y, g1.z, g1.w};
    float hv[16]; unsigned ou[8];
#pragma unroll
    for (int i = 0; i < 8; ++i) { hv[2 * i] = bflo(hu[i]) + bflo(pu[i]) * carry[d0 + 2 * i]; hv[2 * i + 1] = bfhi(hu[i]) + bfhi(pu[i]) * carry[d0 + 2 * i + 1];
        ou[i] = pk2(hv[2 * i] * gelu_tanh(bflo(gu[i])), hv[2 * i + 1] * gelu_tanh(bfhi(gu[i]))); }
    bf16* mp = (bf16*)(ws + WS_MIX) + (size_t)row * D + 1024 + n * 128 + d0;
    *(v4u*)mp = (v4u){ou[0], ou[1], ou[2], ou[3]}; *(v4u*)(mp + 8) = (v4u){ou[4], ou[5], ou[6], ou[7]};
    if (c == 31 && t == 63) { float* o = a->out + O_LRUP + (size_t)b * 1024 + n * 128 + d0;
#pragma unroll
        for (int i = 0; i < 4; ++i) *(f32x4*)(o + 4 * i) = (f32x4){hv[4 * i], hv[4 * i + 1], hv[4 * i + 2], hv[4 * i + 3]}; }
    __syncthreads();
}


__device__ __forceinline__ void conv16_prompt(const bf16* proj, const float* wconv, const float* bconv, int b, int tseq, int ch0, float (&x)[16]) {
#pragma unroll
    for (int i = 0; i < 4; ++i) { const f32x4 bb = *(const f32x4*)(bconv + ch0 + 4 * i); x[4 * i] = bb.x; x[4 * i + 1] = bb.y; x[4 * i + 2] = bb.z; x[4 * i + 3] = bb.w; }
#pragma unroll
    for (int j = 0; j < 4; ++j) { const int tt = tseq - 3 + j;
        if (tt >= 0) { const bf16* pr = proj + (size_t)(b * TP + tt) * NPROJ_PAD + ch0; const v4u u0 = *(const v4u*)pr, u1 = *(const v4u*)(pr + 8);
            const unsigned uu[8] = {u0.x, u0.y, u0.z, u0.w, u1.x, u1.y, u1.z, u1.w};
#pragma unroll
            for (int i = 0; i < 4; ++i) { const f32x4 ww = *(const f32x4*)(wconv + j * 4096 + ch0 + 4 * i);
                x[4 * i] += ww.x * bflo(uu[2 * i]); x[4 * i + 1] += ww.y * bfhi(uu[2 * i]); x[4 * i + 2] += ww.z * bflo(uu[2 * i + 1]); x[4 * i + 3] += ww.w * bfhi(uu[2 * i + 1]); } } }
}
__device__ __forceinline__ void st16_bf16(LAS bf16* p, const float (&x)[16]) {
    v4u o0, o1; o0.x = pk2(x[0], x[1]); o0.y = pk2(x[2], x[3]); o0.z = pk2(x[4], x[5]); o0.w = pk2(x[6], x[7]); o1.x = pk2(x[8], x[9]); o1.y = pk2(x[10], x[11]); o1.z = pk2(x[12], x[13]); o1.w = pk2(x[14], x[15]);
    *(LAS v4u*)p = o0; *(LAS v4u*)(p + 8) = o1;
}
__device__ __forceinline__ v2u pack4(const f32x4 v) { v2u o; o.x = pk2(v.x, v.y); o.y = pk2(v.z, v.w); return o; }
__device__ __forceinline__ bf16x8 zero8() { return (bf16x8){0, 0, 0, 0, 0, 0, 0, 0}; }

__device__ __forceinline__ void delta_prep_item(ArgsP a, LAS unsigned char* lds, int item, const int tid) {
    const int c = item & 31, h = (item >> 5) & 7, b = item >> 8;
    const int lane = tid & 63, w = __builtin_amdgcn_readfirstlane(tid >> 6), fr = lane & 15, fq = lane >> 4;
    unsigned char* ws = a->ws;
    const bf16* proj = (const bf16*)(ws + WS_PROJ);
    LAS bf16* Kn = (LAS bf16*)lds;
    LAS bf16* Qn = (LAS bf16*)(lds + 17408);
    LAS bf16* KdT = (LAS bf16*)(lds + 34816);
    LAS bf16* RX = (LAS bf16*)(lds + 53248);
    LAS bf16* Mm = (LAS bf16*)(lds + 90112);
    LAS bf16* QKd = (LAS bf16*)(lds + 99328);
    LAS bf16* Td = (LAS bf16*)(lds + 108544);
    LAS bf16* RT = (LAS bf16*)(lds + 111616) + w * 768;
    LAS float* gl = (LAS float*)(lds + 123904);
    LAS float* gcs = gl + 64;
    LAS float* bet = gcs + 64;
    const int t = tid >> 3, sub = tid & 7;
    {
        if (sub == 0) { const float* gt = (const float*)(ws + WS_GATES) + (size_t)(b * TP + 64 * c + t) * 16;
            gl[t] = -expf(a->in[I_ALOG][h]) * softplusf(gt[h] + a->in[I_DTB][h]); bet[t] = sigm(gt[8 + h]); }
        __syncthreads();
        if (w == 0) { float v = gl[lane];
#pragma unroll
            for (int o = 1; o < 64; o <<= 1) { const float u = __shfl_up(v, o); if (lane >= o) v += u; }
            gcs[lane] = v; }
        __syncthreads();
    }
    {
        const float* wconv = a->in[I_WCONV]; const float* bconv = a->in[I_BCONV];
        const float gc = gcs[t], glast = gcs[63], beta = bet[t];
        const float ec = expf(gc), ed = expf(glast - gc);
        float x[16], y[16];
        conv16_prompt(proj, wconv, bconv, b, 64 * c + t, 1024 + h * 128 + sub * 16, x);
        float ss = 0.f;
#pragma unroll
        for (int i = 0; i < 16; ++i) { x[i] = siluf(x[i]); ss += x[i] * x[i]; }
        ss += __shfl_xor(ss, 1); ss += __shfl_xor(ss, 2); ss += __shfl_xor(ss, 4);
        const float rk = rsqrtf(ss + 1e-6f);
#pragma unroll
        for (int i = 0; i < 16; ++i) x[i] *= rk;
        st16_bf16(Kn + t * 136 + sub * 16, x);
#pragma unroll
        for (int i = 0; i < 16; ++i) KdT[(sub * 16 + i) * 72 + t] = (bf16)f2bf(x[i] * ed);
#pragma unroll
        for (int i = 0; i < 16; ++i) y[i] = x[i] * (beta * ec);
        st16_bf16(RX + t * 264 + 128 + sub * 16, y);
        conv16_prompt(proj, wconv, bconv, b, 64 * c + t, h * 128 + sub * 16, x);
        ss = 0.f;
#pragma unroll
        for (int i = 0; i < 16; ++i) { x[i] = siluf(x[i]); ss += x[i] * x[i]; }
        ss += __shfl_xor(ss, 1); ss += __shfl_xor(ss, 2); ss += __shfl_xor(ss, 4);
        const float rq = rsqrtf(ss + 1e-6f) * 0.08838834764831845f;
#pragma unroll
        for (int i = 0; i < 16; ++i) x[i] *= rq;
        st16_bf16(Qn + t * 136 + sub * 16, x);
        conv16_prompt(proj, wconv, bconv, b, 64 * c + t, 2048 + h * 128 + sub * 16, x);
#pragma unroll
        for (int i = 0; i < 16; ++i) x[i] = siluf(x[i]) * beta;
        st16_bf16(RX + t * 264 + sub * 16, x);
    }
    __syncthreads();
    {
        const int ib = w >> 1;
#pragma unroll
        for (int jj = 0; jj < 2; ++jj) { const int jb = 2 * (w & 1) + jj;
            f32x4 ak = (f32x4){0.f, 0.f, 0.f, 0.f}, aq = (f32x4){0.f, 0.f, 0.f, 0.f};
            if (jb <= ib) {
#pragma unroll
                for (int ks = 0; ks < 4; ++ks) { const bf16x8 bfr = *(const LAS bf16x8*)(Kn + (16 * jb + fr) * 136 + 32 * ks + 8 * fq);
                    const bf16x8 afk = *(const LAS bf16x8*)(Kn + (16 * ib + fr) * 136 + 32 * ks + 8 * fq), afq = *(const LAS bf16x8*)(Qn + (16 * ib + fr) * 136 + 32 * ks + 8 * fq);
                    ak = MFMA32(afk, bfr, ak); aq = MFMA32(afq, bfr, aq); } }
            const int col = 16 * jb + fr; const float gcc = gcs[col];
#pragma unroll
            for (int j = 0; j < 4; ++j) { const int row = 16 * ib + 4 * fq + j; const float dec = (row >= col) ? expf(gcs[row] - gcc) : 0.f;
                Mm[row * 72 + col] = (bf16)f2bf(row > col ? -bet[row] * ak[j] * dec : 0.f);
                QKd[row * 72 + col] = (bf16)f2bf(aq[j] * dec); }
        }
    }
    __syncthreads();
    if (w == 0) { const int blk = lane >> 4, col = lane & 15; float xi[16];
#pragma unroll
        for (int i = 0; i < 16; ++i) { float acc = (i == col) ? 1.f : 0.f; const LAS bf16* mr = Mm + (16 * blk + i) * 72 + 16 * blk;
#pragma unroll
            for (int j = 0; j < i; ++j) acc += bf2f(mr[j]) * xi[j];
            xi[i] = acc; }
#pragma unroll
        for (int i = 0; i < 16; ++i) Td[(blk * 16 + i) * 24 + col] = (bf16)f2bf(xi[i]); }
    f32x4 rhs[2][4];
#pragma unroll
    for (int cbl = 0; cbl < 2; ++cbl)
#pragma unroll
        for (int bb = 0; bb < 4; ++bb)
#pragma unroll
            for (int j = 0; j < 4; ++j) rhs[cbl][bb][j] = bf2f(RX[(16 * bb + 4 * fq + j) * 264 + 32 * w + 16 * cbl + fr]);
    __syncthreads();
#pragma unroll
    for (int cbl = 0; cbl < 2; ++cbl) { const int cb = 2 * w + cbl;
#pragma unroll
        for (int bb = 0; bb < 4; ++bb) {
            f32x4 acc = rhs[cbl][bb];
#pragma unroll
            for (int ks = 0; ks < 2; ++ks) { if (32 * ks < 16 * bb) { const bool ok = (32 * ks + 8 * fq) < 16 * bb;
                const bf16x8 af = ok ? *(const LAS bf16x8*)(Mm + (16 * bb + fr) * 72 + 32 * ks + 8 * fq) : zero8();
                const bf16x8 bf_ = ok ? *(const LAS bf16x8*)(RX + (16 * cb + fr) * 72 + 32 * ks + 8 * fq) : zero8();
                acc = MFMA32(af, bf_, acc); } }
            *(LAS v2u*)(RT + (16 * cbl + fr) * 24 + 4 * fq) = pack4(acc);
            asm volatile("s_waitcnt lgkmcnt(0)" ::: "memory");
            const bool ok2 = fq < 2;
            const bf16x8 af2 = ok2 ? *(const LAS bf16x8*)(Td + (bb * 16 + fr) * 24 + 8 * fq) : zero8();
            const bf16x8 bf2 = ok2 ? *(const LAS bf16x8*)(RT + (16 * cbl + fr) * 24 + 8 * fq) : zero8();
            const f32x4 xb4 = MFMA32(af2, bf2, ((f32x4){0.f, 0.f, 0.f, 0.f}));
            *(LAS v2u*)(RX + (16 * cb + fr) * 72 + 16 * bb + 4 * fq) = pack4(xb4);
            asm volatile("s_waitcnt lgkmcnt(0)" ::: "memory");
        }
    }
    __syncthreads();
    {
        v4u* gout = (v4u*)(ws + WS_DG) + ((size_t)item * 8 + w) * 4 * 64 + lane;
        bf16x8 kb[2];
#pragma unroll
        for (int kt = 0; kt < 2; ++kt) kb[kt] = *(const LAS bf16x8*)(KdT + (16 * w + fr) * 72 + 32 * kt + 8 * fq);
#pragma unroll
        for (int ks = 0; ks < 4; ++ks) { f32x4 g0 = (f32x4){0.f, 0.f, 0.f, 0.f}, g1 = (f32x4){0.f, 0.f, 0.f, 0.f};
#pragma unroll
            for (int kt = 0; kt < 2; ++kt) { const bf16x8 a0 = *(const LAS bf16x8*)(RX + (128 + 32 * ks + fr) * 72 + 32 * kt + 8 * fq), a1 = *(const LAS bf16x8*)(RX + (128 + 32 * ks + 16 + fr) * 72 + 32 * kt + 8 * fq);
                g0 = MFMA32(a0, kb[kt], g0); g1 = MFMA32(a1, kb[kt], g1); }
            const v2u p0 = pack4(-g0), p1 = pack4(-g1); gout[ks * 64] = (v4u){p0.x, p0.y, p1.x, p1.y}; }
        v2u* bout = (v2u*)(ws + WS_DB) + ((size_t)item * 64 + w) * 64 + lane;
#pragma unroll
        for (int s2 = 0; s2 < 8; ++s2) { f32x4 bc = (f32x4){0.f, 0.f, 0.f, 0.f};
#pragma unroll
            for (int kt = 0; kt < 2; ++kt) { const bf16x8 ub = *(const LAS bf16x8*)(RX + (16 * s2 + fr) * 72 + 32 * kt + 8 * fq); bc = MFMA32(kb[kt], ub, bc); }
            bout[(size_t)s2 * 8 * 64] = pack4(bc); }
    }
    {
        const int tb = w >> 1, half = w & 1; const float ect = expf(gcs[16 * tb + fr]);
        bf16x8 qk[2];
#pragma unroll
        for (int kt = 0; kt < 2; ++kt) qk[kt] = *(const LAS bf16x8*)(QKd + (16 * tb + fr) * 72 + 32 * kt + 8 * fq);
        v4u* qout = (v4u*)(ws + WS_DQ) + ((size_t)item * 4 + tb) * 4 * 64 + lane;
#pragma unroll
        for (int kk = 0; kk < 2; ++kk) { const int ks = 2 * half + kk; v2u pk[2];
#pragma unroll
            for (int hf = 0; hf < 2; ++hf) { const int db = 2 * ks + hf; f32x4 acc = (f32x4){0.f, 0.f, 0.f, 0.f};
#pragma unroll
                for (int kt = 0; kt < 2; ++kt) { const bf16x8 wa = *(const LAS bf16x8*)(RX + (128 + 16 * db + fr) * 72 + 32 * kt + 8 * fq); acc = MFMA32(wa, qk[kt], acc); }
                const v2u qn4 = *(const LAS v2u*)(Qn + (16 * tb + fr) * 136 + 16 * db + 4 * fq);
                f32x4 qp; qp.x = bflo(qn4.x) * ect - acc.x; qp.y = bfhi(qn4.x) * ect - acc.y; qp.z = bflo(qn4.y) * ect - acc.z; qp.w = bfhi(qn4.y) * ect - acc.w;
                pk[hf] = pack4(qp); }
            qout[ks * 64] = (v4u){pk[0].x, pk[0].y, pk[1].x, pk[1].y}; }
        v2u* oout = (v2u*)(ws + WS_DO) + ((size_t)item * 4 + tb) * 8 * 64 + lane;
#pragma unroll
        for (int ss = 0; ss < 4; ++ss) { const int s2 = 4 * half + ss; f32x4 acc = (f32x4){0.f, 0.f, 0.f, 0.f};
#pragma unroll
            for (int kt = 0; kt < 2; ++kt) { const bf16x8 ua = *(const LAS bf16x8*)(RX + (16 * s2 + fr) * 72 + 32 * kt + 8 * fq); acc = MFMA32(ua, qk[kt], acc); }
            oout[s2 * 64] = pack4(acc); }
    }
    if (tid == 0) ((float*)(ws + WS_DD))[item] = expf(gcs[63]);
    __syncthreads();
}

__device__ __forceinline__ void delta_scan_wave(ArgsP a, int chain, int s, const int lane) {
    unsigned char* ws = a->ws;
    const int fr = lane & 15, fq = lane >> 4;
    f32x4 S[8]; bf16x8 Sb[4];
#pragma unroll
    for (int i = 0; i < 8; ++i) S[i] = (f32x4){0.f, 0.f, 0.f, 0.f};
#pragma unroll
    for (int i = 0; i < 4; ++i) Sb[i] = zero8();
    const bf16x8* gbase = (const bf16x8*)(ws + WS_DG) + (size_t)chain * 32 * 2048 + lane;
    bf16x8 G[8][4];
#pragma unroll
    for (int rb = 0; rb < 8; ++rb)
#pragma unroll
        for (int ks = 0; ks < 4; ++ks) G[rb][ks] = gbase[(rb * 4 + ks) * 64];
#pragma unroll 1
    for (int c = 0; c < 32; ++c) {
        const int item = chain * 32 + c;
        const float d = ((const float*)(ws + WS_DD))[item];
        bf16x8* sout = (bf16x8*)(ws + WS_DS) + ((size_t)item * 8 + s) * 4 * 64 + lane;
#pragma unroll
        for (int ks = 0; ks < 4; ++ks) sout[ks * 64] = Sb[ks];
        const v2u* bin = (const v2u*)(ws + WS_DB) + ((size_t)item * 8 + s) * 8 * 64 + lane;
#pragma unroll
        for (int rb = 0; rb < 8; ++rb) { const v2u bc = bin[rb * 64]; S[rb].x = d * S[rb].x + bflo(bc.x); S[rb].y = d * S[rb].y + bfhi(bc.x); S[rb].z = d * S[rb].z + bflo(bc.y); S[rb].w = d * S[rb].w + bfhi(bc.y); }
        const bf16x8* gnext = gbase + (size_t)(c + 1 < 32 ? c + 1 : c) * 2048;
#pragma unroll
        for (int rb = 0; rb < 8; ++rb) {
#pragma unroll
            for (int ks = 0; ks < 4; ++ks) S[rb] = MFMA32(G[rb][ks], Sb[ks], S[rb]);
#pragma unroll
            for (int ks = 0; ks < 4; ++ks) G[rb][ks] = gnext[(rb * 4 + ks) * 64];
        }
#pragma unroll
        for (int ks = 0; ks < 4; ++ks) { const v2u lo = pack4(S[2 * ks]), hi = pack4(S[2 * ks + 1]); const v4u u = (v4u){lo.x, lo.y, hi.x, hi.y}; Sb[ks] = __builtin_bit_cast(bf16x8, u); }
    }
    f32x4* so = (f32x4*)(ws + WS_DF) + ((size_t)(chain * 8 + s) * 8) * 64 + lane;
#pragma unroll
    for (int rb = 0; rb < 8; ++rb) so[rb * 64] = S[rb];
}

__device__ __forceinline__ void delta_out_wave(ArgsP a, int item, int tb, const int lane) {
    unsigned char* ws = a->ws;
    const int c = item & 31, h = (item >> 5) & 7, b = item >> 8, fr = lane & 15, fq = lane >> 4;
    bf16x8 qf[4];
    const bf16x8* qin = (const bf16x8*)(ws + WS_DQ) + ((size_t)item * 4 + tb) * 4 * 64 + lane;
#pragma unroll
    for (int ks = 0; ks < 4; ++ks) qf[ks] = qin[ks * 64];
    const v2u* oin = (const v2u*)(ws + WS_DO) + ((size_t)item * 4 + tb) * 8 * 64 + lane;
    const bf16x8* sin = (const bf16x8*)(ws + WS_DS) + (size_t)item * 8 * 4 * 64 + lane;
    f32x4 o[8]; float ss = 0.f;
#pragma unroll
    for (int s = 0; s < 8; ++s) { const v2u ol = oin[s * 64]; o[s] = (f32x4){bflo(ol.x), bfhi(ol.x), bflo(ol.y), bfhi(ol.y)};
#pragma unroll
        for (int ks = 0; ks < 4; ++ks) o[s] = MFMA32(sin[(s * 4 + ks) * 64], qf[ks], o[s]);
        ss += (o[s].x * o[s].x + o[s].y * o[s].y) + (o[s].z * o[s].z + o[s].w * o[s].w); }
    ss += __shfl_xor(ss, 16); ss += __shfl_xor(ss, 32);
    const float rstd = rsqrtf(ss * (1.f / 128.f) + RMS_EPS);
    const int row = b * TP + 64 * c + 16 * tb + fr;
    const bf16* zp = (const bf16*)(ws + WS_PROJ) + (size_t)row * NPROJ_PAD + 4096 + h * 128 + 4 * fq;
    bf16* mp = (bf16*)(ws + WS_MIX) + (size_t)row * D + h * 128 + 4 * fq;
    const float* nw = a->in[I_DNORM] + 4 * fq;
#pragma unroll
    for (int s = 0; s < 8; ++s) { const v2u z = *(const v2u*)(zp + 16 * s); const f32x4 n4 = *(const f32x4*)(nw + 16 * s);
        f32x4 y; y.x = o[s].x * rstd * n4.x * siluf(bflo(z.x)); y.y = o[s].y * rstd * n4.y * siluf(bfhi(z.x)); y.z = o[s].z * rstd * n4.z * siluf(bflo(z.y)); y.w = o[s].w * rstd * n4.w * siluf(bfhi(z.y));
        *(v2u*)(mp + 16 * s) = pack4(y); }
}


__device__ __forceinline__ float wave_incl_sum(float v, int lane) {
#pragma unroll
    for (int o = 1; o < 64; o <<= 1) { const float u = __shfl_up(v, o); if (lane >= o) v += u; }
    return v;
}
__device__ __forceinline__ float wave_incl_max(float v, int lane) {
#pragma unroll
    for (int o = 1; o < 64; o <<= 1) { const float u = __shfl_up(v, o); if (lane >= o) v = fmaxf(v, u); }
    return v;
}
__device__ __forceinline__ float wave_max(float v) {
#pragma unroll
    for (int o = 1; o < 64; o <<= 1) v = fmaxf(v, __shfl_xor(v, o));
    return v;
}
__device__ __forceinline__ void mlstm_scan_item(ArgsP a, LAS unsigned char* lds, int chain, int vs, const int tid) {
    const int lane = tid & 63, w = __builtin_amdgcn_readfirstlane(tid >> 6), fr = lane & 15, fq = lane >> 4;
    const int b = chain >> 3, h = chain & 7, row0 = b * TP;
    unsigned char* ws = a->ws;
    const bf16* proj = (const bf16*)(ws + WS_PROJ); const float* gates = (const float*)(ws + WS_GATES);
    LAS bf16* KT = (LAS bf16*)lds;
    LAS bf16* VT = (LAS bf16*)(lds + 36864);
    LAS float* wls = (LAS float*)(lds + 46080);
    const float big = a->in[I_BIG][h], bfg = a->in[I_BFG][h];
    const int ks0 = tid >> 4, kk8 = tid & 15;
    const int vtok = tid >> 2, vv8 = tid & 3;
    const bf16* kptr = proj + (size_t)(row0 + ks0) * NPROJ_PAD + 1024 + h * 128 + 8 * kk8;
    const bf16* vptr = proj + (size_t)(row0 + vtok) * NPROJ_PAD + 2048 + h * 256 + 32 * vs + 8 * vv8;
    const float* gptr = gates + (size_t)(row0 + lane) * 16 + h;
    f32x4 acc[2]; acc[0] = (f32x4){0.f, 0.f, 0.f, 0.f}; acc[1] = acc[0];
    float nst = 0.f, m = 0.f;
    v4u kq[2][2], vq[2]; float gi[2], gf[2];
#define ML_LOAD(set, c_) do { const size_t ro = (size_t)(c_) * 64 * NPROJ_PAD; kq[set][0] = *(const v4u*)(kptr + ro); kq[set][1] = *(const v4u*)(kptr + ro + (size_t)32 * NPROJ_PAD); \
        if (tid < 256) vq[set] = *(const v4u*)(vptr + ro); gi[set] = gptr[(size_t)(c_) * 64 * 16]; gf[set] = gptr[(size_t)(c_) * 64 * 16 + 8]; } while (0)
#define ML_STEP(set, c_) do { const int item = chain * 32 + (c_); \
        const float ig = gi[set] + big, lf = logsigf(gf[set] + bfg); \
        const float bcum = wave_incl_sum(lf, lane), blast = __shfl(bcum, 63), gend = blast - bcum + ig; \
        const float mnew = fmaxf(blast + m, wave_max(gend)), sc = expf(blast + m - mnew), wv = expf(gend - mnew) * 0.08838834764831845f; \
        LAS bf16* kt = KT + (set) * 9216; LAS bf16* vt = VT + (set) * 2304; \
        _Pragma("unroll") for (int i = 0; i < 2; ++i) { const unsigned uu[4] = {kq[set][i].x, kq[set][i].y, kq[set][i].z, kq[set][i].w}; const int tok = ks0 + 32 * i; \
            _Pragma("unroll") for (int e = 0; e < 4; ++e) { kt[(8 * kk8 + 2 * e) * 72 + tok] = (bf16)(uu[e] & 0xffffu); kt[(8 * kk8 + 2 * e + 1) * 72 + tok] = (bf16)(uu[e] >> 16); } } \
        if (tid < 256) { const float wt = __shfl(wv, 16 * w + (lane >> 2)); const unsigned uu[4] = {vq[set].x, vq[set].y, vq[set].z, vq[set].w}; \
            _Pragma("unroll") for (int e = 0; e < 4; ++e) { vt[(8 * vv8 + 2 * e) * 72 + vtok] = (bf16)f2bf(bflo(uu[e]) * wt); vt[(8 * vv8 + 2 * e + 1) * 72 + vtok] = (bf16)f2bf(bfhi(uu[e]) * wt); } } \
        if (w == 0) wls[(set) * 64 + lane] = wv; \
        if ((c_) + 2 < 32) ML_LOAD(set, (c_) + 2); \
        if (vs == 0 && tid == 0) ((float*)(ws + WS_MM))[item] = m; \
        __syncthreads(); \
        _Pragma("unroll") for (int vb = 0; vb < 2; ++vb) { *(v2u*)((bf16*)(ws + WS_MC) + ((size_t)item * 256 + 32 * vs + 16 * vb + fr) * 128 + 16 * w + 4 * fq) = pack4(acc[vb]); } \
        if (vs == 0 && tid < 128) { ((float*)(ws + WS_MN))[(size_t)item * 128 + tid] = nst; float sn = 0.f; \
            _Pragma("unroll") for (int s8 = 0; s8 < 8; ++s8) { const v4u kk = *(const LAS v4u*)(kt + tid * 72 + 8 * s8); const LAS float* wl = wls + (set) * 64 + 8 * s8; \
                sn += bflo(kk.x) * wl[0] + bfhi(kk.x) * wl[1] + bflo(kk.y) * wl[2] + bfhi(kk.y) * wl[3] + bflo(kk.z) * wl[4] + bfhi(kk.z) * wl[5] + bflo(kk.w) * wl[6] + bfhi(kk.w) * wl[7]; } \
            nst = sc * nst + sn; } \
        _Pragma("unroll") for (int vb = 0; vb < 2; ++vb) { acc[vb] = acc[vb] * sc; \
            _Pragma("unroll") for (int kt2 = 0; kt2 < 2; ++kt2) { const bf16x8 af = *(const LAS bf16x8*)(kt + (16 * w + fr) * 72 + 32 * kt2 + 8 * fq), bfv = *(const LAS bf16x8*)(vt + (16 * vb + fr) * 72 + 32 * kt2 + 8 * fq); \
                acc[vb] = MFMA32(af, bfv, acc[vb]); } } \
        m = mnew; } while (0)
    ML_LOAD(0, 0); ML_LOAD(1, 1);
#pragma unroll 1
    for (int c2 = 0; c2 < 32; c2 += 2) { ML_STEP(0, c2); ML_STEP(1, c2 + 1); }
#undef ML_LOAD
#undef ML_STEP
#pragma unroll
    for (int vb = 0; vb < 2; ++vb) *(f32x4*)(a->out + O_MCP + ((size_t)chain * 256 + 32 * vs + 16 * vb + fr) * 128 + 16 * w + 4 * fq) = acc[vb];
    if (vs == 0) { if (tid < 128) a->out[O_MNP + (size_t)chain * 128 + tid] = nst; if (tid == 0) a->out[O_MMP + chain] = m; }
    __syncthreads();
}

__device__ __forceinline__ void mlstm_out_item(ArgsP a, LAS unsigned char* lds, int item, const int tid) {
    const int c = item & 31, h = (item >> 5) & 7, b = item >> 8, row0 = b * TP + 64 * c;
    const int lane = tid & 63, w = __builtin_amdgcn_readfirstlane(tid >> 6), fr = lane & 15, fq = lane >> 4;
    unsigned char* ws = a->ws;
    const bf16* proj = (const bf16*)(ws + WS_PROJ); const float* gates = (const float*)(ws + WS_GATES);
    LAS bf16* VT = (LAS bf16*)lds;
    LAS float* ssq = (LAS float*)(lds + 36864);
    const float mc = ((const float*)(ws + WS_MM))[item];
    float av, Mt, et, em;
    { const float ig = gates[(size_t)(row0 + lane) * 16 + h] + a->in[I_BIG][h], lf = logsigf(gates[(size_t)(row0 + lane) * 16 + 8 + h] + a->in[I_BFG][h]);
      const float bcum = wave_incl_sum(lf, lane); av = ig - bcum; Mt = fmaxf(mc, wave_incl_max(av, lane)); et = expf(mc - Mt); em = expf(-(bcum + Mt)); }
#pragma unroll
    for (int i = 0; i < 4; ++i) { const int idx = tid + 512 * i, s = idx >> 5, v8 = idx & 31; const v4u u = *(const v4u*)(proj + (size_t)(row0 + s) * NPROJ_PAD + 2048 + h * 256 + 8 * v8);
        const unsigned uu[4] = {u.x, u.y, u.z, u.w};
#pragma unroll
        for (int e = 0; e < 4; ++e) { VT[(8 * v8 + 2 * e) * 72 + s] = (bf16)(uu[e] & 0xffffu); VT[(8 * v8 + 2 * e + 1) * 72 + s] = (bf16)(uu[e] >> 16); } }
    const int tb = w & 3, half = w >> 2, t = 16 * tb + fr;
    bf16x8 qf[4]; float qn = 0.f;
#pragma unroll
    for (int ks = 0; ks < 4; ++ks) { const v4u u = *(const v4u*)(proj + (size_t)(row0 + t) * NPROJ_PAD + h * 128 + 32 * ks + 8 * fq); qf[ks] = __builtin_bit_cast(bf16x8, u);
        const float* np = (const float*)(ws + WS_MN) + (size_t)item * 128 + 32 * ks + 8 * fq; const f32x4 n0 = *(const f32x4*)np, n1 = *(const f32x4*)(np + 4);
        qn += bflo(u.x) * n0.x + bfhi(u.x) * n0.y + bflo(u.y) * n0.z + bfhi(u.y) * n0.w + bflo(u.z) * n1.x + bfhi(u.z) * n1.y + bflo(u.w) * n1.z + bfhi(u.w) * n1.w; }
    qn += __shfl_xor(qn, 16); qn += __shfl_xor(qn, 32);
    const float Mtt = __shfl(Mt, t), ett = __shfl(et, t), emt = __shfl(em, t);
    v2u smp[4]; float rowsum = 0.f;
#pragma unroll
    for (int sb = 0; sb < 4; ++sb) { smp[sb] = (v2u){0u, 0u};
        if (sb <= tb) { f32x4 qk = (f32x4){0.f, 0.f, 0.f, 0.f};
#pragma unroll
            for (int ks = 0; ks < 4; ++ks) { const v4u u = *(const v4u*)(proj + (size_t)(row0 + 16 * sb + fr) * NPROJ_PAD + 1024 + h * 128 + 32 * ks + 8 * fq); qk = MFMA32(__builtin_bit_cast(bf16x8, u), qf[ks], qk); }
            f32x4 sm;
#pragma unroll
            for (int j = 0; j < 4; ++j) { const int s = 16 * sb + 4 * fq + j; const float as = __shfl(av, s); sm[j] = (s <= t) ? qk[j] * 0.08838834764831845f * expf(as - Mtt) : 0.f; rowsum += sm[j]; }
            smp[sb] = pack4(sm); } }
    rowsum += __shfl_xor(rowsum, 16); rowsum += __shfl_xor(rowsum, 32);
    const float hden = 1.f / fmaxf(fabsf(ett * qn + rowsum), emt);
    const v4u s0u = (v4u){smp[0].x, smp[0].y, smp[1].x, smp[1].y}, s1u = (v4u){smp[2].x, smp[2].y, smp[3].x, smp[3].y};
    const bf16x8 sf0 = __builtin_bit_cast(bf16x8, s0u), sf1 = __builtin_bit_cast(bf16x8, s1u);
    __syncthreads();
    f32x4 hv[8]; float ss = 0.f;
    const bf16* cs = (const bf16*)(ws + WS_MC) + (size_t)item * 256 * 128;
#pragma unroll
    for (int vb = 0; vb < 8; ++vb) { const int vrow = 128 * half + 16 * vb + fr; f32x4 acc = (f32x4){0.f, 0.f, 0.f, 0.f};
#pragma unroll
        for (int ks = 0; ks < 4; ++ks) { const v4u u = *(const v4u*)(cs + (size_t)vrow * 128 + 32 * ks + 8 * fq); acc = MFMA32(__builtin_bit_cast(bf16x8, u), qf[ks], acc); }
        acc = acc * ett;
        { const v2u a0 = *(const LAS v2u*)(VT + vrow * 72 + 4 * fq), a1 = *(const LAS v2u*)(VT + vrow * 72 + 16 + 4 * fq); const v4u au = (v4u){a0.x, a0.y, a1.x, a1.y}; acc = MFMA32(__builtin_bit_cast(bf16x8, au), sf0, acc); }
        { const v2u a0 = *(const LAS v2u*)(VT + vrow * 72 + 32 + 4 * fq), a1 = *(const LAS v2u*)(VT + vrow * 72 + 48 + 4 * fq); const v4u au = (v4u){a0.x, a0.y, a1.x, a1.y}; acc = MFMA32(__builtin_bit_cast(bf16x8, au), sf1, acc); }
        hv[vb] = acc * hden; ss += (hv[vb].x * hv[vb].x + hv[vb].y * hv[vb].y) + (hv[vb].z * hv[vb].z + hv[vb].w * hv[vb].w); }
    ss += __shfl_xor(ss, 16); ss += __shfl_xor(ss, 32);
    if (fq == 0) ssq[half * 64 + t] = ss;
    __syncthreads();
    const float rstd = rsqrtf((ssq[t] + ssq[64 + t]) * (1.f / 256.f) + RMS_EPS);
    const bf16* op = proj + (size_t)(row0 + t) * NPROJ_PAD + 4096 + h * 256 + 128 * half + 4 * fq;
    bf16* mp = (bf16*)(ws + WS_MIX) + (size_t)(row0 + t) * D + h * 256 + 128 * half + 4 * fq;
    const float* nw = a->in[I_MNORM] + h * 256 + 128 * half + 4 * fq;
#pragma unroll
    for (int vb = 0; vb < 8; ++vb) { const v2u o = *(const v2u*)(op + 16 * vb); const f32x4 n4 = *(const f32x4*)(nw + 16 * vb);
        f32x4 y; y.x = hv[vb].x * rstd * n4.x * sigm(bflo(o.x)); y.y = hv[vb].y * rstd * n4.y * sigm(bfhi(o.x)); y.z = hv[vb].z * rstd * n4.z * sigm(bflo(o.y)); y.w = hv[vb].w * rstd * n4.w * sigm(bfhi(o.y));
        *(v2u*)(mp + 16 * vb) = pack4(y); }
    __syncthreads();
}

__device__ __forceinline__ void phase_mixer_even(ArgsP a, LAS unsigned char* lds, int vcu, int G, const int tid) {
    const int NIT = 4096;
#pragma unroll 1
    for (int it = vcu; it < NIT; it += G) {
        if (it < 1024) { delta_prep_item(a, lds, it, tid); continue; }
        if (it < 2048) { lru_prep_item(a, lds, it - 1024, tid); continue; }
        const int j = (it - 2048) & 1023, b = j >> 3, hn = j & 7; const float* cst = a->in[I_SCONV] + (size_t)b * 3 * 4096;
        if (it < 3072) delta_rec_item(a, lds, MP + b * TS, TS, hn, cst, a->in[I_SDELTA] + (size_t)j * 16384, a->out + O_DELTAS + (size_t)j * 16384, tid);
        else lru_rec_item(a, lds, MP + b * TS, TS, hn, cst, a->in[I_SLRU] + (size_t)b * 1024, a->out + O_LRUS + (size_t)b * 1024, tid);
    }
    const bf16* proj = (const bf16*)(a->ws + WS_PROJ);
    const int nconv = (BP + BS) * 3 * 4096;
    for (int i = vcu * NTHR + tid; i < nconv; i += G * NTHR) {
        const int ch = i & 4095, rj = i >> 12, j = rj % 3, b = rj / 3;
        if (b < BP) a->out[O_CONVP + (size_t)(b * 3 + j) * 4096 + ch] = bf2f(proj[(size_t)(b * TP + TP - 3 + j) * NPROJ_PAD + ch]);
        else { const int bs = b - BP; a->out[O_CONVS + (size_t)(bs * 3 + j) * 4096 + ch] = bf2f(proj[(size_t)(MP + bs * TS + 1 + j) * NPROJ_PAD + ch]); }
    }
}
__device__ __forceinline__ void phase_mixer_even_b(ArgsP a, int vcu, int G, const int tid) {
    if ((tid >> 6) == 0) { for (int it = vcu; it < 256; it += G) delta_scan_wave(a, it >> 3, it & 7, tid & 63); }
}
__device__ __forceinline__ void phase_mixer_even_c(ArgsP a, LAS unsigned char* lds, int vcu, int G, const int tid) {
    const int w = tid >> 6;
#pragma unroll 1
    for (int it = vcu; it < 512; it += G) delta_out_wave(a, 2 * it + (w >> 2), w & 3, tid & 63);
#pragma unroll 1
    for (int it = vcu; it < 1024; it += G) lru_out_item(a, lds, it, tid);
    for (int chain = vcu; chain < 32; chain += G) {
        const float* src = (const float*)(a->ws + WS_DF) + (size_t)chain * 16384; float* dst = a->out + O_DELTAP + (size_t)chain * 16384;
        for (int e = tid; e < 16384; e += NTHR) { const int dk = e >> 7, dv = e & 127;
            dst[e] = src[((((dv >> 4) * 8 + (dk >> 4)) * 64 + ((dk >> 2) & 3) * 16 + (dv & 15)) << 2) + (dk & 3)]; }
    }
}
__device__ __forceinline__ void phase_mixer_odd(ArgsP a, LAS unsigned char* lds, int vcu, int G, const int tid) {
#pragma unroll 1
    for (int it = vcu; it < 256; it += G) mlstm_scan_item(a, lds, it >> 3, it & 7, tid);
#pragma unroll 1
    for (int j = vcu; j < 1024; j += G) { const int b = j >> 3, h = j & 7;
        mlstm_rec_item(a, lds, MP + b * TS, TS, h, a->in[I_SMC] + (size_t)j * 32768, a->in[I_SMN] + (size_t)j * 128, a->in[I_SMM] + j, a->out + O_MCS + (size_t)j * 32768, a->out + O_MNS + (size_t)j * 128, a->out + O_MMS + j, tid); }
}
__device__ __forceinline__ void phase_mixer_odd_b(ArgsP a, LAS unsigned char* lds, int vcu, int G, const int tid) {
#pragma unroll 1
    for (int it = vcu; it < 1024; it += G) mlstm_out_item(a, lds, it, tid);
}

__device__ __forceinline__ void phase_ln(const float* p0, const float* p1, const bf16* resid, const float* g, const float* bta, bf16* dst, int gw, int NGW, int lane) {
    for (int m = gw; m < M; m += NGW) {
        float v[32]; float s = 0.f;
#pragma unroll
        for (int j = 0; j < 8; ++j) { const size_t off = (size_t)m * D + j * 256 + lane * 4; f32x4 x = *(const f32x4*)(p0 + off); if (p1) { const f32x4 y = *(const f32x4*)(p1 + off); x = x + y; }
            const v2u rr = *(const v2u*)(resid + off);
            v[4 * j + 0] = x.x + DN_ALPHA * bflo(rr.x); v[4 * j + 1] = x.y + DN_ALPHA * bfhi(rr.x); v[4 * j + 2] = x.z + DN_ALPHA * bflo(rr.y); v[4 * j + 3] = x.w + DN_ALPHA * bfhi(rr.y);
            s += (v[4 * j] + v[4 * j + 1]) + (v[4 * j + 2] + v[4 * j + 3]); }
        const float mean = wave_sum(s) * (1.f / D); float s2 = 0.f;
#pragma unroll
        for (int i = 0; i < 32; ++i) { v[i] -= mean; s2 += v[i] * v[i]; }
        const float rstd = rsqrtf(wave_sum(s2) * (1.f / D) + LN_EPS);
#pragma unroll
        for (int j = 0; j < 8; ++j) { const int col = j * 256 + lane * 4; const f32x4 gg = *(const f32x4*)(g + col), bb = *(const f32x4*)(bta + col);
            v2u o; o.x = pk2(v[4 * j] * rstd * gg.x + bb.x, v[4 * j + 1] * rstd * gg.y + bb.y); o.y = pk2(v[4 * j + 2] * rstd * gg.z + bb.z, v[4 * j + 3] * rstd * gg.w + bb.w);
            *(v2u*)(dst + (size_t)m * D + col) = o; }
    }
}
__device__ __forceinline__ void phase_combine(const float* p0, const float* p1, const bf16* h2, const bf16* pw, bf16* xb, float* outf, int gw, int NGW, int lane) {
    for (int m = gw; m < M; m += NGW) {
#pragma unroll
        for (int j = 0; j < 8; ++j) { const size_t off = (size_t)m * D + j * 256 + lane * 4; f32x4 x = *(const f32x4*)(p0 + off); if (p1) { const f32x4 y = *(const f32x4*)(p1 + off); x = x + y; }
            const v2u hh = *(const v2u*)(h2 + off), pp = *(const v2u*)(pw + off);
            f32x4 o; o.x = bflo(hh.x) + sigm(x.x) * bflo(pp.x); o.y = bfhi(hh.x) + sigm(x.y) * bfhi(pp.x); o.z = bflo(hh.y) + sigm(x.z) * bflo(pp.y); o.w = bfhi(hh.y) + sigm(x.w) * bfhi(pp.y);
            v2u ob; ob.x = pk2(o.x, o.y); ob.y = pk2(o.z, o.w); *(v2u*)(xb + off) = ob;
            if (outf) *(f32x4*)(outf + off) = o; }
    }
}

constexpr int N_PHASES = 22;
enum { OP_INPROJ = 0, OP_MIXA, OP_MIXB, OP_MIXC, OP_OUTPROJ, OP_LN1, OP_UP, OP_DOWN, OP_LN2, OP_GATE, OP_COMBINE };
enum { GK_F32 = 0, GK_BF16 = 1, GK_SQRELU = 2 };
__global__ void __launch_bounds__(NTHR, 2) mk_fwd(Args a_in) {
    extern __shared__ __attribute__((aligned(16))) unsigned char lds_raw[];
    LAS unsigned char* lds = (LAS unsigned char*)lds_raw;
    ArgsP kp = (ArgsP)__builtin_amdgcn_kernarg_segment_ptr();
    const int lo = a_in.ph_lo, hi = a_in.ph_hi;
#if MK_N_LAUNCHES == 1
    volatile LAS unsigned* xst = (volatile LAS unsigned*)(lds + LDS_CTL_OFF);
    if (threadIdx.x < 2) xst[threadIdx.x] = 0u;
    __syncthreads();
    XcdBarrier bar = xcd_barrier_post((unsigned*)(a_in.ws + WS_CTL) + 4096, xst);
#endif
#pragma unroll 1
    for (int p = lo; p < hi; ++p) {
        int tid = threadIdx.x; asm volatile("" : "+v"(tid));
        int bx = blockIdx.x; asm volatile("" : "+s"(bx));
        int G = gridDim.x; asm volatile("" : "+s"(G));
        ArgsP a = kp; asm volatile("" : "+s"(a));
        const int lane = tid & 63, wave = __builtin_amdgcn_readfirstlane(tid >> 6);
        const int vcu = (G % 8 == 0) ? (bx % 8) * (G / 8) + bx / 8 : bx;
        const int gw = vcu * NWAVES + wave, NGW = G * NWAVES;
        unsigned char* ws = a->ws;
        if (p == 0) {
phase_convert(a, lds, gw, NGW, wave, lane); }
        else {
            const int L = p <= 11 ? 0 : 1; const int q = L == 0 ? p - 1 : (p - 12 < 3 ? p - 12 : p - 11);
            bf16* xb = (bf16*)(ws + WS_XB); bf16* mixb = (bf16*)(ws + WS_MIX); bf16* hb = (bf16*)(ws + WS_H); bf16* h2b = (bf16*)(ws + WS_H2); bf16* pwb = (bf16*)(ws + WS_PW);
            bf16* projb = (bf16*)(ws + WS_PROJ); bf16* upb = (bf16*)(ws + WS_PROJ);
            float* part0 = (float*)(ws + WS_PART0); float* gatesb = (float*)(ws + WS_GATES);
            if (q == OP_MIXA) { if (L == 0) phase_mixer_even(a, lds, vcu, G, tid); else phase_mixer_odd(a, lds, vcu, G, tid); }
            else if (q == OP_MIXB) { if (L == 0) phase_mixer_even_b(a, vcu, G, tid); else phase_mixer_odd_b(a, lds, vcu, G, tid); }
            else if (q == OP_MIXC) { phase_mixer_even_c(a, lds, vcu, G, tid); }

            else if (q == OP_LN1) phase_ln(part0, nullptr, xb, a->in[I_LN1G] + L * D, a->in[I_LN1B] + L * D, hb, gw, NGW, lane);
            else if (q == OP_LN2) phase_ln(part0, nullptr, hb, a->in[I_LN2G] + L * D, a->in[I_LN2B] + L * D, h2b, gw, NGW, lane);
            else if (q == OP_COMBINE) phase_combine(part0, nullptr, h2b, pwb, xb, L == 1 ? a->out + O_Y : nullptr, gw, NGW, lane);

            else {
                for (int sub = 0; sub < (q == OP_GATE ? 2 : 1); ++sub) {
                    const bf16* A; const bf16* Bt; int N, K, kind; void* out; float* gp = nullptr; int corder = bx;
                    if (q == OP_INPROJ) { A = xb; Bt = (const bf16*)(ws + (L == 0 ? WS_WINE : WS_WINO)); N = NPROJ_PAD; K = D; kind = GK_BF16; out = projb; gp = gatesb; }
                    else if (q == OP_OUTPROJ) { A = mixb; Bt = (const bf16*)(ws + (L == 0 ? WS_WOUTE : WS_WOUTO)); N = D; K = D; kind = GK_F32; out = part0; }
                    else if (q == OP_UP) { A = hb; Bt = (const bf16*)(ws + WS_WUP) + (size_t)L * D * FF; N = FF; K = D; kind = GK_SQRELU; out = upb; }
                    else if (q == OP_DOWN) { A = upb; Bt = (const bf16*)(ws + WS_WDOWN) + (size_t)L * D * FF; N = D; K = FF; kind = GK_F32; out = part0; }
                    else if (sub == 0) { A = h2b; Bt = (const bf16*)(ws + WS_WGATE) + (size_t)L * D * D; N = D; K = D; kind = GK_F32; out = part0; }
                    else { A = (const bf16*)(ws + WS_PB) + (size_t)L * M * PLE; Bt = (const bf16*)(ws + WS_WPLE) + (size_t)L * PLE * D; N = D; K = PLE; kind = GK_BF16; out = pwb; corder = (bx + 128) % G; }
                    pg8::Gemm g{A, Bt, M, N, K}; pg8::StaticOrder S; S.init(M, N, G, corder);
                    if (kind == GK_F32) { pg8::EpiF32 E{(float*)out, N}; pg8::gemm_phase<pg8::EpiF32, pg8::StaticOrder, true, true>(lds, g, S, E, tid); }
                    else if (kind == GK_BF16) { pg8::EpiBf16<0> E{(bf16*)out, N, gp, 24}; pg8::gemm_phase<pg8::EpiBf16<0>, pg8::StaticOrder, true, true>(lds, g, S, E, tid); }
                    else { pg8::EpiBf16<1> E{(bf16*)out, N, nullptr, -1}; pg8::gemm_phase<pg8::EpiBf16<1>, pg8::StaticOrder, true, true>(lds, g, S, E, tid); }
                }
            }
        }
#if MK_N_LAUNCHES == 1
        if (p + 1 < hi) { if (p == lo) cg::this_grid().sync(); else xcd_barrier(bar); }
#endif
    }
}

extern "C" void kernel_launch(void* const* d_in, const int* in_sizes, int n_in, void* d_out, int out_size, void* d_ws, size_t ws_size, hipStream_t stream) {
    static int grid = 0;
    if (grid == 0) {
        if (n_in != 35 || (size_t)out_size != O_END || ws_size < WS_END) { fprintf(stderr, "kernel_launch: unexpected shapes: n_in %d out %d (want %zu) ws %zu (want %zu)\n", n_in, out_size, (size_t)O_END, ws_size, (size_t)WS_END); grid = -1; return; }
        int dev = 0, cus = 0, per_cu = 0;
        hipGetDevice(&dev); hipDeviceGetAttribute(&cus, hipDeviceAttributeMultiprocessorCount, dev);
        if (hipFuncSetAttribute((const void*)mk_fwd, hipFuncAttributeMaxDynamicSharedMemorySize, LDS_BYTES) != hipSuccess) { fprintf(stderr, "kernel_launch: hipFuncSetAttribute failed\n"); grid = -1; return; }
        if (hipOccupancyMaxActiveBlocksPerMultiprocessor(&per_cu, (const void*)mk_fwd, NTHR, LDS_BYTES) != hipSuccess || per_cu < 1) { fprintf(stderr, "kernel_launch: occupancy query says %d\n", per_cu); per_cu = 1; }
        (void)hipGetLastError();
        grid = cus * 1;
    }
    if (grid < 0) return;
    Args a{};
    for (int i = 0; i < 35; ++i) a.in[i] = (const float*)d_in[i];
    a.out = (float*)d_out; a.ws = (unsigned char*)d_ws;
#if MK_N_LAUNCHES == 1
    hipMemsetAsync((char*)d_ws + WS_CTL, 0, 1 * MiB, stream);
    a.ph_lo = 0; a.ph_hi = N_PHASES;
    void* args[] = {&a};
    hipError_t e = hipLaunchCooperativeKernel((const void*)mk_fwd, dim3(grid), dim3(NTHR), args, LDS_BYTES, stream);
    if (e != hipSuccess) fprintf(stderr, "cooperative launch failed: %s (grid %d)\n", hipGetErrorString(e), grid);
#else
    for (int p = 0; p < N_PHASES; ++p) {
        a.ph_lo = p; a.ph_hi = p + 1;
        hipLaunchKernelGGL(mk_fwd, dim3(grid), dim3(NTHR), LDS_BYTES, stream, a);
    }
#endif
}
```

```cpp
#include <hip/hip_runtime.h>
#include <hip/hip_cooperative_groups.h>
#include <cstdio>
#include <cstdint>
namespace cg = cooperative_groups;

#ifndef PROBE_MASK
#define PROBE_MASK 0
#endif
#define PROBE_P (-1)
#define PROBE_SUB 0
#ifndef MK_N_LAUNCHES
#define MK_N_LAUNCHES 1
#endif

namespace pg8 {
#define PG8_LAS __attribute__((address_space(3)))
typedef unsigned short bf16_t;
typedef short bf16x8 __attribute__((ext_vector_type(8)));
typedef float f32x4 __attribute__((ext_vector_type(4)));
typedef unsigned u32x4 __attribute__((ext_vector_type(4)));
constexpr int BM = 256, BK = 64, HALF = 128, HTB = HALF * BK * 2, STAGE_BYTES = 8 * HTB, NXCD = 8, WGM = 8;

__host__ __device__ __forceinline__ int lds_byte(int r, int c) { const int st = (r >> 4) * 2 + (c >> 5), rr = r & 15, cc = c & 31, ob = rr * 64 + cc * 2; return st * 1024 + (ob ^ (((ob >> 9) & 1) << 5)); }
__host__ __device__ __forceinline__ void stage_rc(int b, int& R, int& C) { const int st = b / 1024, sb = b % 1024, swz = sb ^ (((sb >> 9) & 1) << 5); R = (st >> 1) * 16 + swz / 64; C = (st & 1) * 32 + (swz % 64) / 2; }
__host__ __device__ __forceinline__ int perm32(int rho) { const int n = rho >> 4, i = rho & 15; return 8 * (i >> 2) + 4 * n + (i & 3); }

struct Unit { int pm, pn, kt0, nkt, dst; };
struct Gemm { const bf16_t* A; const bf16_t* Bt; int M, N, K; };

struct StaticOrder {
    int nM, nN, nwg, G, c, T;
    __host__ __device__ void init(int M, int N, int K, int G_, int c_) { nM = M / BM; nN = N / BM; nwg = nM * nN; G = G_; c = c_; T = K / BK; }
    __host__ __device__ bool next(int i, Unit& u) const {
        const long L = (long)i * G + c; if (L >= nwg) return false;
        int wgid = (int)L; { const int q = nwg / NXCD, r = nwg % NXCD, xcd = wgid % NXCD, off = wgid / NXCD; wgid = (xcd < r ? xcd * (q + 1) : r * (q + 1) + (xcd - r) * q) + off; }
        const int nig = WGM * nN, gid = wgid / nig, fm = gid * WGM, gsz = (nM - fm) < WGM ? (nM - fm) : WGM;
        u.pm = fm + ((wgid % nig) % gsz); u.pn = (wgid % nig) / gsz; u.kt0 = 0; u.nkt = T; u.dst = 0; return true;
    }
    __device__ __forceinline__ void a_ready(const Unit&) const {}
    __device__ __forceinline__ void done(const Unit&) const {}
};
struct StreamK {
    int nN, T, P, ntot, c;
    __host__ __device__ void init(int M, int N, int K, int G, int c_) { nN = N / BM; T = K / BK; ntot = (M / BM) * nN * T; P = (((ntot + G - 1) / G) + 1) & ~1; c = c_; }
    __host__ __device__ bool next(int i, Unit& u) const {
        int s = c * P; const int e = (s + P < ntot) ? s + P : ntot;
        for (int k = 0; ; ++k) { if (s >= e) return false; const int tile = s / T, kt0 = s - tile * T; const int n = (T - kt0 < e - s) ? T - kt0 : e - s;
            if (k == i) { u.pm = tile / nN; u.pn = tile - u.pm * nN; u.kt0 = kt0; u.nkt = n; u.dst = kt0 ? 1 : 0; return true; }
            s += n; }
    }
    __device__ __forceinline__ void a_ready(const Unit&) const {}
    __device__ __forceinline__ void done(const Unit&) const {}
};
struct MainSplit {
    int T, c;
    __host__ __device__ void init(int K, int c_) { T = K / BK; c = c_; }
    __host__ __device__ bool next(int i, Unit& u) const {
        if (i == 0) { u.pm = c >> 3; u.pn = c & 7; u.kt0 = 0; u.nkt = T; u.dst = 0; return true; }
        if (i == 1) { const int lt = c >> 4, j = c & 15; u.pm = 32 + (lt >> 3); u.pn = lt & 7; u.nkt = T >> 4; u.kt0 = j * u.nkt; u.dst = 1 + j; return true; }
        return false;
    }
    __device__ __forceinline__ void a_ready(const Unit&) const {}
    __device__ __forceinline__ void done(const Unit&) const {}
};
__host__ __device__ __forceinline__ bool split_tile(int tile, int T, int P) { return (tile * T) / P != ((tile + 1) * T - 1) / P; }

__device__ __forceinline__ unsigned cvt_pk_bf16(float lo, float hi) { unsigned r; asm volatile("v_cvt_pk_bf16_f32 %0, %1, %2" : "=v"(r) : "v"(lo), "v"(hi)); return r; }

struct EpiF32 {
    static constexpr bool PERM = false, AFTER_DRAIN = false;
    float* C; float* C1; int ldc;
    __device__ __forceinline__ void operator()(const f32x4 (&acc)[2][2][4][2], const Unit& u, int wr, int wc, int fr, int fq) const {
        const int row0 = u.pm * BM + wr * 64 + fr, col0 = u.pn * BM + wc * 32 + 4 * fq; float* Cb = u.dst ? C1 + ((long)(u.dst - 1) * 512 - 8192) * (long)ldc : C;
#pragma unroll
        for (int ai = 0; ai < 2; ++ai)
#pragma unroll
            for (int m = 0; m < 4; ++m) { float* rowp = Cb + (size_t)(row0 + ai * HALF + m * 16) * ldc + col0;
#pragma unroll
                for (int bj = 0; bj < 2; ++bj)
#pragma unroll
                    for (int n = 0; n < 2; ++n) *(f32x4*)(rowp + bj * HALF + n * 16) = acc[ai][bj][m][n]; }
    }
};
template <int ACT> struct EpiBf16 {
    static constexpr bool PERM = true, AFTER_DRAIN = false;
    bf16_t* O; int ldc; float* gates; int gate_pn;
    __device__ __forceinline__ void operator()(const f32x4 (&acc)[2][2][4][2], const Unit& u, int wr, int wc, int fr, int fq) const {
        const int row0 = u.pm * BM + wr * 64 + fr; const int col0 = u.pn * BM + wc * 32 + 8 * fq;
        const bool gt = (gates != nullptr) && (u.pn == gate_pn) && (wc == 0) && (fq < 2);
#pragma unroll
        for (int ai = 0; ai < 2; ++ai)
#pragma unroll
            for (int m = 0; m < 4; ++m) { const int row = row0 + ai * HALF + m * 16; bf16_t* rowp = O + (size_t)row * ldc + col0;
#pragma unroll
                for (int bj = 0; bj < 2; ++bj) { f32x4 v0 = acc[ai][bj][m][0], v1 = acc[ai][bj][m][1];
                    if (ACT == 1) {
#pragma unroll
                        for (int j = 0; j < 4; ++j) { const float a = fmaxf(v0[j], 0.f), b = fmaxf(v1[j], 0.f); v0[j] = a * a; v1[j] = b * b; } }
                    u32x4 w; w.x = cvt_pk_bf16(v0[0], v0[1]); w.y = cvt_pk_bf16(v0[2], v0[3]); w.z = cvt_pk_bf16(v1[0], v1[1]); w.w = cvt_pk_bf16(v1[2], v1[3]);
                    *(u32x4*)(rowp + bj * HALF) = w; }
                if (gt) { float* gp = gates + (size_t)row * 16 + 8 * fq; *(f32x4*)gp = acc[ai][0][m][0]; *(f32x4*)(gp + 4) = acc[ai][0][m][1]; } }
    }
};

template <class Epi, class Sched, bool ALIGN_EPI = false, bool SP2 = false>
__device__ __forceinline__ void gemm_phase(PG8_LAS unsigned char* lds, const Gemm g, const Sched& S, const Epi& E, const int tid) {
    const int wid = __builtin_amdgcn_readfirstlane(tid >> 6), lane = tid & 63, wr = wid >> 2, wc = wid & 3, fr = lane & 15, fq = lane >> 4;
    const int K = g.K;
    unsigned voffA[2], voffB[2];
#pragma unroll
    for (int i = 0; i < 2; ++i) { int R, C; stage_rc(tid * 16 + i * 8192, R, C); const int Rb = Epi::PERM ? ((R & ~31) + perm32(R & 31)) : R;
        voffA[i] = (unsigned)(R * K + C) * 2u; voffB[i] = (unsigned)(Rb * K + C) * 2u; }
    const size_t kstep = (size_t)(BK * 2);
    const size_t hstep = (size_t)HALF * K * 2;
    const size_t tstep = 2 * hstep;
    const unsigned ldsw = (unsigned)wid * 1024u;
    const int aoff = lds_byte(wr * 64 + fr, fq * 8), boff = lds_byte(wc * 32 + fr, fq * 8);
#define PG8_SA(b, h) (((b) * 2 + (h)) * HTB)
#define PG8_SB(b, h) ((4 + (b) * 2 + (h)) * HTB)
#define PG8_STAGE(bufoff, gbase, voff) do { _Pragma("unroll") for (int _i = 0; _i < 2; ++_i) \
        __builtin_amdgcn_global_load_lds((const unsigned*)((const char*)(gbase) + (voff)[_i]), (PG8_LAS unsigned*)(lds + (bufoff) + ldsw + _i * 8192), 16, 0, 0); } while (0)
#define PG8_LDA(dst, b, h) do { _Pragma("unroll") for (int m = 0; m < 4; ++m) _Pragma("unroll") for (int k = 0; k < 2; ++k) dst[m][k] = *(const PG8_LAS bf16x8*)(lds + PG8_SA(b, h) + aoff + m * 2048 + k * 1024); } while (0)
#define PG8_LDB(dst, b, h) do { _Pragma("unroll") for (int n = 0; n < 2; ++n) _Pragma("unroll") for (int k = 0; k < 2; ++k) dst[n][k] = *(const PG8_LAS bf16x8*)(lds + PG8_SB(b, h) + boff + n * 2048 + k * 1024); } while (0)
#define PG8_MMA(ai, bj, At, Bt) do { __builtin_amdgcn_s_setprio(1); _Pragma("unroll") for (int m = 0; m < 4; ++m) _Pragma("unroll") for (int n = 0; n < 2; ++n) _Pragma("unroll") for (int k = 0; k < 2; ++k) \
        acc[ai][bj][m][n] = __builtin_amdgcn_mfma_f32_16x16x32_bf16(Bt[n][k], At[m][k], acc[ai][bj][m][n], 0, 0, 0); __builtin_amdgcn_s_setprio(0); } while (0)
#define PG8_WAIT_V(n) asm volatile("s_waitcnt vmcnt(" #n ")" ::: "memory")
#define PG8_WAIT_L(n) asm volatile("s_waitcnt lgkmcnt(" #n ")" ::: "memory")
#define PG8_BAR __builtin_amdgcn_s_barrier()
#define PG8_SCHED __builtin_amdgcn_sched_barrier(0)
    Unit cur, nxt; int ui = 0;
    if (!S.next(0, cur)) return;
    f32x4 acc[2][2][4][2];
#pragma unroll
    for (int a = 0; a < 2; ++a)
#pragma unroll
        for (int b = 0; b < 2; ++b)
#pragma unroll
            for (int m = 0; m < 4; ++m)
#pragma unroll
                for (int n = 0; n < 2; ++n) acc[a][b][m][n] = (f32x4){0.f, 0.f, 0.f, 0.f};
    bf16x8 At[4][2], B0[2][2], B1[2][2];
    const char* cA = (const char*)g.A + (size_t)cur.pm * tstep + (size_t)cur.kt0 * kstep; const char* cB = (const char*)g.Bt + (size_t)cur.pn * tstep + (size_t)cur.kt0 * kstep;
    S.a_ready(cur);
    if constexpr (SP2) {
        PG8_STAGE(PG8_SB(0, 0), cB, voffB); PG8_STAGE(PG8_SB(0, 1), cB + hstep, voffB); PG8_STAGE(PG8_SA(0, 0), cA, voffA); PG8_STAGE(PG8_SA(0, 1), cA + hstep, voffA);
        if (wr == 1) PG8_BAR;
        PG8_WAIT_V(2); PG8_BAR;
        PG8_STAGE(PG8_SB(1, 0), cB + kstep, voffB); PG8_STAGE(PG8_SA(1, 0), cA + kstep, voffA); PG8_STAGE(PG8_SB(1, 1), cB + hstep + kstep, voffB);
        PG8_WAIT_V(6); PG8_BAR;
    } else {
        PG8_STAGE(PG8_SB(0, 0), cB, voffB); PG8_STAGE(PG8_SA(0, 0), cA, voffA); PG8_STAGE(PG8_SB(0, 1), cB + hstep, voffB); PG8_STAGE(PG8_SA(0, 1), cA + hstep, voffA);
        if (wr == 1) PG8_BAR;
        PG8_WAIT_V(4); PG8_BAR;
        PG8_STAGE(PG8_SB(1, 0), cB + kstep, voffB); PG8_STAGE(PG8_SA(1, 0), cA + kstep, voffA); PG8_STAGE(PG8_SB(1, 1), cB + hstep + kstep, voffB);
        PG8_WAIT_V(6); PG8_BAR;
    }
    for (;;) {
        const bool has_next = S.next(ui + 1, nxt);
        const char* nA = has_next ? (const char*)g.A + (size_t)nxt.pm * tstep + (size_t)nxt.kt0 * kstep : cA; const char* nB = has_next ? (const char*)g.Bt + (size_t)nxt.pn * tstep + (size_t)nxt.kt0 * kstep : cB;
        const int nt = cur.nkt;
        for (int t = 0; t < nt; t += 2) {
            const bool last = (t == nt - 2);
            const char* a1 = cA + (size_t)(t + 1) * kstep;
            const char* a2 = last ? nA : cA + (size_t)(t + 2) * kstep; const char* b2 = last ? nB : cB + (size_t)(t + 2) * kstep;
            const char* a3 = a2 + kstep; const char* b3 = b2 + kstep;
            if (last && has_next) S.a_ready(nxt);
            if constexpr (SP2) {
            PG8_LDB(B0, 0, 0); PG8_LDB(B1, 0, 1); PG8_SCHED; PG8_LDA(At, 0, 0); PG8_STAGE(PG8_SA(1, 1), a1 + hstep, voffA);
            PG8_WAIT_V(8); PG8_WAIT_L(0); PG8_BAR; PG8_MMA(0, 0, At, B0); PG8_MMA(0, 1, At, B1); PG8_BAR; PG8_SCHED;
            PG8_LDA(At, 0, 1); PG8_STAGE(PG8_SB(0, 0), b2, voffB); PG8_STAGE(PG8_SB(0, 1), b2 + hstep, voffB); PG8_STAGE(PG8_SA(0, 0), a2, voffA);
            PG8_WAIT_V(8); PG8_WAIT_L(0); PG8_BAR; PG8_MMA(1, 0, At, B0); PG8_MMA(1, 1, At, B1); PG8_BAR; PG8_SCHED;
            PG8_LDB(B0, 1, 0); PG8_LDB(B1, 1, 1); PG8_SCHED; PG8_LDA(At, 1, 0); PG8_STAGE(PG8_SA(0, 1), a2 + hstep, voffA);
            PG8_WAIT_V(8); PG8_WAIT_L(0); PG8_BAR; PG8_MMA(0, 0, At, B0); PG8_MMA(0, 1, At, B1); PG8_BAR; PG8_SCHED;
            PG8_LDA(At, 1, 1); PG8_STAGE(PG8_SB(1, 0), b3, voffB); PG8_STAGE(PG8_SB(1, 1), b3 + hstep, voffB); PG8_STAGE(PG8_SA(1, 0), a3, voffA);
            PG8_WAIT_V(8); PG8_WAIT_L(0); PG8_BAR; PG8_MMA(1, 0, At, B0); PG8_MMA(1, 1, At, B1); PG8_BAR; PG8_SCHED;
            } else {
            PG8_LDB(B0, 0, 0); PG8_SCHED; PG8_LDA(At, 0, 0); PG8_STAGE(PG8_SA(1, 1), a1 + hstep, voffA);
            PG8_WAIT_L(8); PG8_BAR; PG8_WAIT_L(0); PG8_MMA(0, 0, At, B0); PG8_BAR; PG8_SCHED;
            PG8_LDB(B1, 0, 1); PG8_STAGE(PG8_SB(0, 0), b2, voffB);
            PG8_BAR; PG8_WAIT_L(0); PG8_MMA(0, 1, At, B1); PG8_BAR;
            PG8_LDA(At, 0, 1); PG8_STAGE(PG8_SA(0, 0), a2, voffA);
            PG8_BAR; PG8_WAIT_L(0); PG8_MMA(1, 0, At, B0); PG8_BAR; PG8_SCHED;
            PG8_STAGE(PG8_SB(0, 1), b2 + hstep, voffB);
            PG8_WAIT_V(6); PG8_BAR; PG8_MMA(1, 1, At, B1); PG8_BAR;
            PG8_LDB(B0, 1, 0); PG8_SCHED; PG8_LDA(At, 1, 0); PG8_STAGE(PG8_SA(0, 1), a2 + hstep, voffA);
            PG8_WAIT_L(8); PG8_BAR; PG8_WAIT_L(0); PG8_MMA(0, 0, At, B0); PG8_BAR; PG8_SCHED;
            PG8_LDB(B1, 1, 1); PG8_STAGE(PG8_SB(1, 0), b3, voffB);
            PG8_BAR; PG8_WAIT_L(0); PG8_MMA(0, 1, At, B1); PG8_BAR;
            PG8_LDA(At, 1, 1); PG8_STAGE(PG8_SA(1, 0), a3, voffA);
            PG8_BAR; PG8_WAIT_L(0); PG8_MMA(1, 0, At, B0); PG8_BAR; PG8_SCHED;
            PG8_STAGE(PG8_SB(1, 1), b3 + hstep, voffB);
            PG8_WAIT_V(6); PG8_BAR; PG8_MMA(1, 1, At, B1); PG8_BAR;
            }
        }
        if constexpr (ALIGN_EPI) { if (wr == 0) PG8_BAR; }
        E(acc, cur, wr, wc, fr, fq); S.done(cur);
        if (!has_next) break;
#pragma unroll
        for (int a = 0; a < 2; ++a)
#pragma unroll
            for (int b = 0; b < 2; ++b)
#pragma unroll
                for (int m = 0; m < 4; ++m)
#pragma unroll
                    for (int n = 0; n < 2; ++n) acc[a][b][m][n] = (f32x4){0.f, 0.f, 0.f, 0.f};
        cur = nxt; cA = nA; cB = nB; ++ui;
        if constexpr (ALIGN_EPI) { if (wr == 1) PG8_BAR; }
    }
    PG8_WAIT_V(0);
    if constexpr (!ALIGN_EPI) { if (wr == 0) PG8_BAR; }
    PG8_BAR;
#undef PG8_SA
#undef PG8_SB
#undef PG8_STAGE
#undef PG8_LDA
#undef PG8_LDB
#undef PG8_MMA
#undef PG8_WAIT_V
#undef PG8_WAIT_L
#undef PG8_BAR
#undef PG8_SCHED
}
}

constexpr int NWAVES = 8, NTHR = 512;
constexpr int D = 2048, FF = 8192, PLE = 256;
constexpr int TP = 2048, BP = 4, TS = 4, BS = 128;
constexpr int MP = BP * TP, MS = BS * TS, M = MP + MS;
constexpr int NPROJ = 6160, NPROJ_PAD = 6400;
constexpr int NH = 8;
constexpr float LN_EPS = 1e-5f, RMS_EPS = 1e-6f;
constexpr float DN_ALPHA = 1.41421356237f;

constexpr size_t MiB = 1u << 20;
constexpr size_t WS_CTL = 0;
constexpr size_t WS_WINE = 1 * MiB;
constexpr size_t WS_WOUTE = WS_WINE + 25 * MiB;
constexpr size_t WS_WINO = WS_WOUTE + 8 * MiB;
constexpr size_t WS_WOUTO = WS_WINO + 25 * MiB;
constexpr size_t WS_WUP = WS_WOUTO + 8 * MiB;
constexpr size_t WS_WDOWN = WS_WUP + 64 * MiB;
constexpr size_t WS_WPLE = WS_WDOWN + 64 * MiB;
constexpr size_t WS_WGATE = WS_WPLE + 2 * MiB;
constexpr size_t WS_XB = WS_WGATE + 16 * MiB;
constexpr size_t WS_MIX = WS_XB + 34 * MiB;
constexpr size_t WS_H = WS_MIX + 34 * MiB;
constexpr size_t WS_H2 = WS_H + 34 * MiB;
constexpr size_t WS_PW = WS_H2 + 34 * MiB;
constexpr size_t WS_PB = WS_PW + 34 * MiB;
constexpr size_t WS_GATES = WS_PB + 9 * MiB;
constexpr size_t WS_PROJ = WS_GATES + 1 * MiB;
constexpr size_t WS_PART0 = WS_PROJ + 136 * MiB;
constexpr size_t WS_PART1 = WS_PART0 + 68 * MiB;
constexpr size_t WS_LRUW = WS_PART1 + 68 * MiB;
constexpr size_t WS_END = WS_LRUW + 1 * MiB;
constexpr size_t WS_DG = WS_PART0;
constexpr size_t WS_DB = WS_PART0 + 32 * MiB;
constexpr size_t WS_DS = WS_PART0 + 64 * MiB;
constexpr size_t WS_DQ = WS_PART0 + 96 * MiB;
constexpr size_t WS_DO = WS_PART0 + 112 * MiB;
constexpr size_t WS_DD = WS_PART0 + 128 * MiB;
constexpr size_t WS_DF = WS_PART0 + 129 * MiB;
constexpr size_t WS_MC = WS_PART0;
constexpr size_t WS_MN = WS_PART0 + 64 * MiB;
constexpr size_t WS_MM = WS_PART0 + 65 * MiB;
constexpr size_t WS_LRU_HL = WS_H;
constexpr size_t WS_LRU_P = WS_H + 16 * MiB;
constexpr size_t WS_LRU_END = WS_H + 32 * MiB;

constexpr size_t O_Y = 0;
constexpr size_t O_CONVP = (size_t)M * D;
constexpr size_t O_DELTAP = O_CONVP + (size_t)BP * 3 * 4096;
constexpr size_t O_LRUP = O_DELTAP + (size_t)BP * 8 * 128 * 128;
constexpr size_t O_MCP = O_LRUP + (size_t)BP * 1024;
constexpr size_t O_MNP = O_MCP + (size_t)BP * 8 * 256 * 128;
constexpr size_t O_MMP = O_MNP + (size_t)BP * 8 * 128;
constexpr size_t O_CONVS = O_MMP + (size_t)BP * 8;
constexpr size_t O_DELTAS = O_CONVS + (size_t)BS * 3 * 4096;
constexpr size_t O_LRUS = O_DELTAS + (size_t)BS * 8 * 128 * 128;
constexpr size_t O_MCS = O_LRUS + (size_t)BS * 1024;
constexpr size_t O_MNS = O_MCS + (size_t)BS * 8 * 256 * 128;
constexpr size_t O_MMS = O_MNS + (size_t)BS * 8 * 128;
constexpr size_t O_END = O_MMS + (size_t)BS * 8;

constexpr int LDS_BYTES = 147456;
constexpr int LDS_CTL_OFF = 131072;

#define LAS __attribute__((address_space(3)))
typedef unsigned short bf16;
typedef unsigned v4u __attribute__((ext_vector_type(4)));
typedef unsigned v2u __attribute__((ext_vector_type(2)));
typedef float f32x4 __attribute__((ext_vector_type(4)));
#define LDS_WAIT() asm volatile("s_waitcnt lgkmcnt(0)" ::: "memory")
__device__ __forceinline__ unsigned f2bf(float f) { unsigned u = __builtin_bit_cast(unsigned, f); return (u + 0x7fffu + ((u >> 16) & 1u)) >> 16; }
__device__ __forceinline__ unsigned pk2(float lo, float hi) { return f2bf(lo) | (f2bf(hi) << 16); }
__device__ __forceinline__ float bf2f(unsigned short b) { return __builtin_bit_cast(float, ((unsigned)b) << 16); }
__device__ __forceinline__ float bflo(unsigned w) { return __builtin_bit_cast(float, w << 16); }
__device__ __forceinline__ float bfhi(unsigned w) { return __builtin_bit_cast(float, w & 0xffff0000u); }
__device__ __forceinline__ float sigm(float x) { return 1.f / (1.f + expf(-x)); }
__device__ __forceinline__ float siluf(float x) { return x * sigm(x); }
__device__ __forceinline__ float softplusf(float x) { return fmaxf(x, 0.f) + log1pf(expf(-fabsf(x))); }
__device__ __forceinline__ float logsigf(float x) { return -softplusf(-x); }
__device__ __forceinline__ float gelu_tanh(float x) { const float u = 0.7978845608028654f * (x + 0.044715f * x * x * x); return 0.5f * x * (1.f + tanhf(u)); }
__device__ __forceinline__ float wave_sum(float v) {
#pragma unroll
    for (int o = 1; o < 64; o <<= 1) v += __shfl_xor(v, o);
    return v;
}

#define XB_TMO      128
#define XB_XCNT(j)  (256  + 64 * (j))
#define XB_XSUB(j)  (1280 + 64 * (j))
#define XB_XGEN(j)  (2304 + 64 * (j))
#define XB_TOP      3328
#define XB_TOPGEN   3392
#define XCD_BAR_WORDS 3456
#define XB_SPIN_CAP (1u << 22)
__device__ __forceinline__ unsigned xb_ld(unsigned* p)              { return __hip_atomic_load(p, __ATOMIC_RELAXED, __HIP_MEMORY_SCOPE_AGENT); }
__device__ __forceinline__ unsigned xb_add(unsigned* p, unsigned v) { return __hip_atomic_fetch_add(p, v, __ATOMIC_RELAXED, __HIP_MEMORY_SCOPE_AGENT); }
__device__ __forceinline__ unsigned xb_xcc_id() { return (unsigned)__builtin_amdgcn_s_getreg((3 << 11) | 20) & 0xFu; }
#define XB_SPIN(cond, bar) do { unsigned _sp = 0; while (cond) { __builtin_amdgcn_s_sleep(1); \
    if ((++_sp & 255u) == 0u) { if (xb_ld(&(bar)[XB_TMO])) break; if (_sp > XB_SPIN_CAP) { atomicAdd(&(bar)[XB_TMO], 1u); break; } } } } while (0)
struct XcdBarrier { unsigned* bar; unsigned x; volatile LAS unsigned* st; };
__device__ __forceinline__ XcdBarrier xcd_barrier_post(unsigned* bar, volatile LAS unsigned* st) {
    XcdBarrier b; b.bar = bar; b.x = xb_xcc_id(); b.st = st;
    if (threadIdx.x == 0) (void)xb_add(&bar[XB_XCNT(b.x)], 1u);
    return b;
}
__device__ __forceinline__ void xcd_barrier_complete(unsigned* bar, unsigned x, unsigned& nloc, unsigned& nx) {
    const unsigned G = gridDim.x * gridDim.y * gridDim.z;
    unsigned sum, cnt, mine, sp = 0u;
    for (;;) {
        sum = 0u; cnt = 0u; mine = 0u;
#pragma unroll
        for (unsigned j = 0; j < 16; ++j) { const unsigned c = xb_ld(&bar[XB_XCNT(j)]); sum += c; cnt += (c > 0u) ? 1u : 0u; mine = (j == x) ? c : mine; }
        if (sum == G) break;
        __builtin_amdgcn_s_sleep(1);
        if ((++sp & 255u) == 0u) { if (xb_ld(&bar[XB_TMO])) break; if (sp > XB_SPIN_CAP) { atomicAdd(&bar[XB_TMO], 1u); break; } }
    }
    nloc = mine > 0u ? mine : 1u; nx = cnt > 0u ? cnt : 1u;
}
__device__ __forceinline__ void xcd_barrier(const XcdBarrier& b) {
    asm volatile("s_waitcnt vmcnt(0)" ::: "memory");
    __syncthreads();
    if (threadIdx.x == 0) {
        unsigned* bar = b.bar;
        __builtin_amdgcn_s_waitcnt(0);
        unsigned nloc = b.st[0], nx = b.st[1];
        if (nloc == 0u) { xcd_barrier_complete(bar, b.x, nloc, nx); b.st[0] = nloc; b.st[1] = nx; }
        const unsigned old = xb_add(&bar[XB_XSUB(b.x)], 1u);
        const unsigned gen = old / nloc;
        if (old + 1u == (gen + 1u) * nloc) {
            __builtin_amdgcn_fence(__ATOMIC_RELEASE, "agent");
            asm volatile("s_waitcnt vmcnt(0)" ::: "memory");
            const unsigned og = xb_add(&bar[XB_TOP], 1u);
            const unsigned tg = og / nx;
            if (og + 1u == (tg + 1u) * nx) xb_add(&bar[XB_TOPGEN], 1u);
            else XB_SPIN(xb_ld(&bar[XB_TOPGEN]) == tg, bar);
            __builtin_amdgcn_fence(__ATOMIC_ACQUIRE, "agent");
            xb_add(&bar[XB_XGEN(b.x)], 1u);
            asm volatile("s_waitcnt vmcnt(0)" ::: "memory");
        } else {
            XB_SPIN(xb_ld(&bar[XB_XGEN(b.x)]) == gen, bar);
            __builtin_amdgcn_fence(__ATOMIC_ACQUIRE, "agent");
            asm volatile("s_waitcnt vmcnt(0)" ::: "memory");
        }
    }
    __syncthreads();
}

struct Args { const float* in[35]; float* out; unsigned char* ws; int ph_lo, ph_hi; };
typedef const __attribute__((address_space(4))) Args* ArgsP;
enum { I_XP = 0, I_XS, I_PP, I_PS, I_SCONV, I_SDELTA, I_SLRU, I_SMC, I_SMN, I_SMM, I_WINE, I_WCONV, I_BCONV, I_ALOG, I_DTB, I_DNORM, I_LWR, I_LBR, I_LWI, I_LBI, I_LLAM, I_WOUTE,
       I_WINO, I_BIG, I_BFG, I_MNORM, I_WOUTO, I_LN1G, I_LN1B, I_LN2G, I_LN2B, I_WUP, I_WDOWN, I_WPLE, I_WGATE };

__device__ __forceinline__ void p0_transpose_item(const float* W, int K, int N, int Npad, bf16* WT, LAS float* scr, int item, int lane) {
    const int nblk = Npad / 32, kb = item / nblk, nb = item % nblk, k0 = 64 * kb, n0 = 32 * nb;
    const int r = lane >> 3, c4 = lane & 7;
    const bool ok = (n0 + 4 * c4) < N;
    f32x4 v[8];
#pragma unroll
    for (int i = 0; i < 8; ++i) v[i] = ok ? __builtin_nontemporal_load((const f32x4*)(W + (size_t)(k0 + 8 * i + r) * N + n0 + 4 * c4)) : (f32x4){0.f, 0.f, 0.f, 0.f};
#pragma unroll
    for (int i = 0; i < 8; ++i) { LAS float* d = scr + (8 * i + r) * 33 + 4 * c4; d[0] = v[i].x; d[1] = v[i].y; d[2] = v[i].z; d[3] = v[i].w; }
    LDS_WAIT(); asm volatile("" ::: "memory");
    const int c = lane & 7;
#pragma unroll
    for (int j = 0; j < 4; ++j) { const int n = (lane >> 3) + 8 * j; const LAS float* s = scr + (8 * c) * 33 + n;
        v4u o; o.x = pk2(s[0 * 33], s[1 * 33]); o.y = pk2(s[2 * 33], s[3 * 33]); o.z = pk2(s[4 * 33], s[5 * 33]); o.w = pk2(s[6 * 33], s[7 * 33]);
        *(v4u*)(WT + (size_t)(n0 + n) * K + k0 + 8 * c) = o; }
    LDS_WAIT(); asm volatile("" ::: "memory");
}
__device__ __forceinline__ void row_to_bf16(const float* src, bf16* dst, int n, int lane) {
    for (int j = 0; j < n / 256; ++j) { const f32x4 v = *(const f32x4*)(src + j * 256 + lane * 4); v2u o; o.x = pk2(v.x, v.y); o.y = pk2(v.z, v.w); *(v2u*)(dst + j * 256 + lane * 4) = o; }
}

namespace cv { constexpr int I_IN = (D / 64) * (NPROJ_PAD / 32), I_SQ = (D / 64) * (D / 32), I_UP = (D / 64) * (FF / 32), I_DN = (FF / 64) * (D / 32), I_PL = (PLE / 64) * (D / 32);
               constexpr int N_FIRST = I_IN + 128, N_REST = I_IN + 2 * I_SQ + 2 * I_UP + 2 * I_DN + 2 * I_PL + 2 * I_SQ; }
__device__ __forceinline__ void convert_first_item(ArgsP a, LAS float* scr, int r, int lane) {
    unsigned char* ws = a->ws;
    if (r < cv::I_IN) { p0_transpose_item(a->in[I_WINE], D, NPROJ, NPROJ_PAD, (bf16*)(ws + WS_WINE), scr, r, lane); return; } r -= cv::I_IN;
    { const int mat = r / 64, blk = (r / 8) & 7; p0_transpose_item(a->in[mat == 0 ? I_LWR : I_LWI] + (size_t)blk * 16384, 128, 128, 128, (bf16*)(ws + WS_LRUW) + (size_t)(mat * 8 + blk) * 16384, scr, r % 8, lane); }
}
__device__ __forceinline__ void convert_rest_item(ArgsP a, LAS float* scr, int r, int lane) {
    using namespace cv; unsigned char* ws = a->ws;
    if (r < I_SQ) { p0_transpose_item(a->in[I_WOUTE], D, D, D, (bf16*)(ws + WS_WOUTE), scr, r, lane); return; } r -= I_SQ;
    if (r < I_UP) { p0_transpose_item(a->in[I_WUP], D, FF, FF, (bf16*)(ws + WS_WUP), scr, r, lane); return; } r -= I_UP;
    if (r < I_DN) { p0_transpose_item(a->in[I_WDOWN], FF, D, D, (bf16*)(ws + WS_WDOWN), scr, r, lane); return; } r -= I_DN;
    if (r < I_PL) { p0_transpose_item(a->in[I_WPLE], PLE, D, D, (bf16*)(ws + WS_WPLE), scr, r, lane); return; } r -= I_PL;
    if (r < I_SQ) { p0_transpose_item(a->in[I_WGATE], D, D, D, (bf16*)(ws + WS_WGATE), scr, r, lane); return; } r -= I_SQ;
    if (r < I_IN) { p0_transpose_item(a->in[I_WINO], D, NPROJ, NPROJ_PAD, (bf16*)(ws + WS_WINO), scr, r, lane); return; } r -= I_IN;
    if (r < I_SQ) { p0_transpose_item(a->in[I_WOUTO], D, D, D, (bf16*)(ws + WS_WOUTO), scr, r, lane); return; } r -= I_SQ;
    if (r < I_UP) { p0_transpose_item(a->in[I_WUP] + (size_t)D * FF, D, FF, FF, (bf16*)(ws + WS_WUP) + (size_t)D * FF, scr, r, lane); return; } r -= I_UP;
    if (r < I_DN) { p0_transpose_item(a->in[I_WDOWN] + (size_t)D * FF, FF, D, D, (bf16*)(ws + WS_WDOWN) + (size_t)D * FF, scr, r, lane); return; } r -= I_DN;
    if (r < I_PL) { p0_transpose_item(a->in[I_WPLE] + (size_t)PLE * D, PLE, D, D, (bf16*)(ws + WS_WPLE) + (size_t)PLE * D, scr, r, lane); return; } r -= I_PL;
    p0_transpose_item(a->in[I_WGATE] + (size_t)D * D, D, D, D, (bf16*)(ws + WS_WGATE) + (size_t)D * D, scr, r, lane);
}
__device__ __forceinline__ void phase_convert(ArgsP a, LAS unsigned char* lds, int gw, int NGW, int wave, int lane) {
    unsigned char* ws = a->ws;
    LAS float* scr = (LAS float*)(lds + wave * 16384);
    for (int it = gw; it < cv::N_FIRST; it += NGW) convert_first_item(a, scr, it, lane);
    bf16* xb = (bf16*)(ws + WS_XB);
    for (int m = gw; m < M; m += NGW) {
        const float* src = m < MP ? a->in[I_XP] + (size_t)m * D : a->in[I_XS] + (size_t)(m - MP) * D;
        row_to_bf16(src, xb + (size_t)m * D, D, lane);
    }
    bf16* pb = (bf16*)(ws + WS_PB);
    for (int r = gw; r < 2 * M; r += NGW) {
        const int l = r / M, m = r % M;
        const float* src = m < MP ? a->in[I_PP] + ((size_t)l * MP + m) * PLE : a->in[I_PS] + ((size_t)l * MS + (m - MP)) * PLE;
        row_to_bf16(src, pb + (size_t)r * PLE, PLE, lane);
    }
}

__device__ __forceinline__ float conv_in(const bf16* proj, int row0, int tq, int ch, const float* cstate) {
    if (tq >= 0) return bf2f(proj[(size_t)(row0 + tq) * NPROJ_PAD + ch]);
    return cstate ? cstate[(3 + tq) * 4096 + ch] : 0.f;
}
__device__ __forceinline__ float conv4(const bf16* proj, int row0, int t, int ch, const float* cstate, const float* wconv, const float* bconv) {
    float acc = bconv[ch];
#pragma unroll
    for (int j = 0; j < 4; ++j) acc += wconv[j * 4096 + ch] * conv_in(proj, row0, t - 3 + j, ch, cstate);
    return acc;
}

__device__ __forceinline__ void delta_rec_item(ArgsP a, LAS unsigned char* lds, int row0, int T, int h, const float* cstate, const float* S0, float* Sout, const int tid) {
    const int lane = tid & 63, wave = tid >> 6, c = tid & 127, r = tid >> 7;
    const bf16* proj = (const bf16*)(a->ws + WS_PROJ); const float* gates = (const float*)(a->ws + WS_GATES); bf16* mix = (bf16*)(a->ws + WS_MIX);
    const float* wconv = a->in[I_WCONV]; const float* bconv = a->in[I_BCONV];
    LAS float* act = (LAS float*)lds;
    LAS float* nrm = act + 4 * 384;
    LAS float* gb = nrm + 8;
    LAS float* red = gb + 8;
    LAS float* red2 = red + 512;
    LAS float* obuf = red2 + 512;
    float s[32];
#pragma unroll
    for (int i = 0; i < 32; ++i) s[i] = S0 ? S0[(size_t)(32 * r + i) * 128 + c] : 0.f;
    const float aexp = expf(a->in[I_ALOG][h]), dtb = a->in[I_DTB][h];
#pragma unroll 1
    for (int t0 = 0; t0 < T; t0 += 4) {
#pragma unroll
        for (int j = 0; j < 3; ++j) { const int idx = tid + 512 * j, tok = idx / 384, chl = idx % 384, part = chl >> 7, i = chl & 127;
            const int ch = part * 1024 + h * 128 + i;
            act[tok * 384 + chl] = siluf(conv4(proj, row0, t0 + tok, ch, cstate, wconv, bconv)); }
        __syncthreads();
        { const int tok = wave >> 1, part = wave & 1; const float x0 = act[tok * 384 + part * 128 + lane], x1 = act[tok * 384 + part * 128 + 64 + lane];
          const float ss = wave_sum(x0 * x0 + x1 * x1); if (lane == 0) nrm[tok * 2 + part] = rsqrtf(ss + 1e-6f) * (part == 0 ? 0.08838834764831845f : 1.f); }
        if (tid < 4) { const int row = row0 + t0 + tid; const float g = -aexp * softplusf(gates[(size_t)row * 16 + h] + dtb); gb[tid * 2] = expf(g); gb[tid * 2 + 1] = sigm(gates[(size_t)row * 16 + 8 + h]); }
        __syncthreads();
#pragma unroll 1
        for (int tok = 0; tok < 4; ++tok) {
            const float eg = gb[tok * 2], beta = gb[tok * 2 + 1], nq = nrm[tok * 2], nk = nrm[tok * 2 + 1];
            const LAS float* qv = act + tok * 384 + 32 * r; const LAS float* kv = qv + 128;
            float ks = 0.f;
#pragma unroll
            for (int i = 0; i < 32; ++i) ks += kv[i] * s[i];
            red[r * 128 + c] = ks * nk;
            __syncthreads();
            const float kS = red[c] + red[128 + c] + red[256 + c] + red[384 + c];
            const float vnew = beta * (act[tok * 384 + 256 + c] - eg * kS);
            float os = 0.f;
#pragma unroll
            for (int i = 0; i < 32; ++i) { s[i] = eg * s[i] + (kv[i] * nk) * vnew; os += qv[i] * s[i]; }
            red2[r * 128 + c] = os * nq;
            __syncthreads();
            if (r == 0) obuf[tok * 128 + c] = red2[c] + red2[128 + c] + red2[256 + c] + red2[384 + c];
        }
        __syncthreads();
        if (wave < 4) { const int tok = wave, row = row0 + t0 + tok; const float o0 = obuf[tok * 128 + lane], o1 = obuf[tok * 128 + 64 + lane];
            const float rstd = rsqrtf(wave_sum(o0 * o0 + o1 * o1) * (1.f / 128.f) + RMS_EPS);
            const float* nw = a->in[I_DNORM];
            const float z0 = bf2f(proj[(size_t)row * NPROJ_PAD + 4096 + h * 128 + lane]), z1 = bf2f(proj[(size_t)row * NPROJ_PAD + 4096 + h * 128 + 64 + lane]);
            mix[(size_t)row * D + h * 128 + lane] = (bf16)f2bf(o0 * rstd * nw[lane] * siluf(z0));
            mix[(size_t)row * D + h * 128 + 64 + lane] = (bf16)f2bf(o1 * rstd * nw[64 + lane] * siluf(z1)); }
        __syncthreads();
    }
#pragma unroll
    for (int i = 0; i < 32; ++i) Sout[(size_t)(32 * r + i) * 128 + c] = s[i];
}

__device__ __forceinline__ void lru_rec_item(ArgsP a, LAS unsigned char* lds, int row0, int T, int n, const float* cstate, const float* h0, float* hout, const int tid) {
    const int d = tid & 127, part = tid >> 7;
    const bf16* proj = (const bf16*)(a->ws + WS_PROJ); bf16* mix = (bf16*)(a->ws + WS_MIX);
    const float* wconv = a->in[I_WCONV]; const float* bconv = a->in[I_BCONV];
    const float* wr = a->in[I_LWR] + (size_t)n * 16384; const float* wi = a->in[I_LWI] + (size_t)n * 16384;
    LAS float* xr = (LAS float*)lds;
    LAS float* red = xr + 512;
    const int chn = n * 128 + d;
    float hst = h0 ? h0[chn] : 0.f;
    const float br = a->in[I_LBR][chn], bi = a->in[I_LBI][chn], spl = softplusf(-a->in[I_LLAM][chn]);
#pragma unroll 1
    for (int t0 = 0; t0 < T; t0 += 4) {
        { const int tok = tid >> 7; xr[tok * 128 + d] = conv4(proj, row0, t0 + tok, 3072 + chn, cstate, wconv, bconv); }
        __syncthreads();
        float ar[4] = {0.f, 0.f, 0.f, 0.f}, ai[4] = {0.f, 0.f, 0.f, 0.f};
#pragma unroll 4
        for (int cc = 0; cc < 32; ++cc) { const int c = part * 32 + cc; const float w1 = wr[c * 128 + d], w2 = wi[c * 128 + d];
#pragma unroll
        for (int tok = 0; tok < 4; ++tok) { const float x = xr[tok * 128 + c]; ar[tok] += x * w1; ai[tok] += x * w2; } }
#pragma unroll
        for (int tok = 0; tok < 4; ++tok) { red[((tok * 2 + 0) * 4 + part) * 128 + d] = ar[tok]; red[((tok * 2 + 1) * 4 + part) * 128 + d] = ai[tok]; }
        __syncthreads();
        if (part == 0) {
    #pragma unroll 1
        for (int tok = 0; tok < 4; ++tok) {
                const int row = row0 + t0 + tok;
                float rp = br, ip = bi;
#pragma unroll
                for (int p = 0; p < 4; ++p) { rp += red[((tok * 2 + 0) * 4 + p) * 128 + d]; ip += red[((tok * 2 + 1) * 4 + p) * 128 + d]; }
                const float log_a = -8.f * sigm(rp) * spl;
                const float av = expf(log_a);
                const float bx = sqrtf(-expm1f(2.f * log_a)) * sigm(ip) * xr[tok * 128 + d];
                hst = av * hst + bx;
                const float gate = bf2f(proj[(size_t)row * NPROJ_PAD + 5120 + chn]);
                mix[(size_t)row * D + 1024 + chn] = (bf16)f2bf(hst * gelu_tanh(gate));
            }
        }
        __syncthreads();
    }
    if (part == 0) hout[chn] = hst;
}

__device__ __forceinline__ void mlstm_rec_item(ArgsP a, LAS unsigned char* lds, int row0, int T, int h, const float* C0, const float* n0, const float* m0, float* Cout, float* nout, float* mout, const int tid) {
    const int lane = tid & 63, wave = tid >> 6, v = tid & 255, kh = tid >> 8;
    const bf16* proj = (const bf16*)(a->ws + WS_PROJ); const float* gates = (const float*)(a->ws + WS_GATES); bf16* mix = (bf16*)(a->ws + WS_MIX);
    LAS float* qs = (LAS float*)lds;
    LAS float* ks = qs + 512;
    LAS float* vs = ks + 512;
    LAS float* gs = vs + 1024;
    LAS float* red = gs + 8;
    LAS float* dred = red + 1024;
    LAS float* hbuf = dred + 4;
    float cst[64];
#pragma unroll
    for (int i = 0; i < 64; ++i) cst[i] = C0 ? C0[(size_t)v * 128 + 64 * kh + i] : 0.f;
    float nst = (tid < 128) ? (n0 ? n0[tid] : 0.f) : 0.f;
    float mst = m0 ? m0[0] : 0.f;
    const float big = a->in[I_BIG][h], bfg = a->in[I_BFG][h];
#pragma unroll 1
    for (int t0 = 0; t0 < T; t0 += 4) {
#pragma unroll
        for (int j = 0; j < 4; ++j) { const int tok = j, row = row0 + t0 + tok; const bf16* pr = proj + (size_t)row * NPROJ_PAD;
            float val;
            if (tid < 128) val = bf2f(pr[h * 128 + tid]); else if (tid < 256) val = bf2f(pr[1024 + h * 128 + (tid - 128)]) * 0.08838834764831845f; else val = bf2f(pr[2048 + h * 256 + (tid - 256)]);
            if (tid < 128) qs[tok * 128 + tid] = val; else if (tid < 256) ks[tok * 128 + tid - 128] = val; else vs[tok * 256 + tid - 256] = val; }
        if (tid < 4) { const int row = row0 + t0 + tid; gs[tid * 2] = gates[(size_t)row * 16 + h] + big; gs[tid * 2 + 1] = gates[(size_t)row * 16 + 8 + h] + bfg; }
        __syncthreads();
#pragma unroll 1
        for (int tok = 0; tok < 4; ++tok) {
            const int par = tok & 1;
            const float ig = gs[tok * 2], lf = logsigf(gs[tok * 2 + 1]);
            const float mnew = fmaxf(lf + mst, ig), fp = expf(lf + mst - mnew), ip = expf(ig - mnew); mst = mnew;
            const float vv = vs[tok * 256 + v] * ip;
            const LAS float* kv = ks + tok * 128 + 64 * kh; const LAS float* qv = qs + tok * 128 + 64 * kh;
            float num = 0.f;
#pragma unroll
            for (int i = 0; i < 64; ++i) { cst[i] = fp * cst[i] + vv * kv[i]; num += cst[i] * qv[i]; }
            red[(par * 2 + kh) * 256 + v] = num;
            if (tid < 128) { nst = fp * nst + ip * ks[tok * 128 + tid]; const float dp = wave_sum(nst * qs[tok * 128 + tid]); if (lane == 0) dred[par * 2 + wave] = dp; }
            __syncthreads();
            if (kh == 0) { const float nm = red[(par * 2) * 256 + v] + red[(par * 2 + 1) * 256 + v]; const float den = dred[par * 2] + dred[par * 2 + 1];
                hbuf[tok * 256 + v] = nm / fmaxf(fabsf(den), expf(-mnew)); }
        }
        __syncthreads();
        if (wave < 4) { const int tok = wave, row = row0 + t0 + tok; float hv[4]; float ss = 0.f;
#pragma unroll
            for (int j = 0; j < 4; ++j) { hv[j] = hbuf[tok * 256 + j * 64 + lane]; ss += hv[j] * hv[j]; }
            const float rstd = rsqrtf(wave_sum(ss) * (1.f / 256.f) + RMS_EPS);
            const float* nw = a->in[I_MNORM] + h * 256;
#pragma unroll
            for (int j = 0; j < 4; ++j) { const int vi = j * 64 + lane; const float op = bf2f(proj[(size_t)row * NPROJ_PAD + 4096 + h * 256 + vi]);
                mix[(size_t)row * D + h * 256 + vi] = (bf16)f2bf(hv[j] * rstd * nw[vi] * sigm(op)); } }
        __syncthreads();
    }
#pragma unroll
    for (int i = 0; i < 64; ++i) Cout[(size_t)v * 128 + 64 * kh + i] = cst[i];
    if (tid < 128) nout[tid] = nst;
    if (tid == 0) mout[0] = mst;
}


typedef short bf16x8 __attribute__((ext_vector_type(8)));
#define MFMA32(a_, b_, c_) __builtin_amdgcn_mfma_f32_16x16x32_bf16(a_, b_, c_, 0, 0, 0)

__device__ __forceinline__ void lru_prep_item(ArgsP a, LAS unsigned char* lds, int item, const int tid) {
    const int c = item & 31, n = (item >> 5) & 7, b = item >> 8;
    const int lane = tid & 63, w = __builtin_amdgcn_readfirstlane(tid >> 6), fr = lane & 15, fq = lane >> 4;
    unsigned char* ws = a->ws;
    const bf16* proj = (const bf16*)(ws + WS_PROJ);
    LAS bf16* xa = (LAS bf16*)lds;
    LAS float* xf = (LAS float*)(lds + 17408);
    LAS float* obH = (LAS float*)(lds + 51200);
    LAS float* obP = obH + 64 * 132;
    {
        const int t = tid >> 3, sub = tid & 7, ch0 = 3072 + n * 128 + sub * 16;
        const float* wconv = a->in[I_WCONV]; const float* bconv = a->in[I_BCONV];
        float x[16];
#pragma unroll
        for (int i = 0; i < 4; ++i) { const f32x4 bb = *(const f32x4*)(bconv + ch0 + 4 * i); x[4 * i] = bb.x; x[4 * i + 1] = bb.y; x[4 * i + 2] = bb.z; x[4 * i + 3] = bb.w; }
#pragma unroll
        for (int j = 0; j < 4; ++j) { const int tt = 64 * c + t - 3 + j;
            if (tt >= 0) { const bf16* pr = proj + (size_t)(b * TP + tt) * NPROJ_PAD + ch0; const v4u u0 = *(const v4u*)pr, u1 = *(const v4u*)(pr + 8);
                const unsigned uu[8] = {u0.x, u0.y, u0.z, u0.w, u1.x, u1.y, u1.z, u1.w};
#pragma unroll
                for (int i = 0; i < 4; ++i) { const f32x4 ww = *(const f32x4*)(wconv + j * 4096 + ch0 + 4 * i);
                    x[4 * i] += ww.x * bflo(uu[2 * i]); x[4 * i + 1] += ww.y * bfhi(uu[2 * i]); x[4 * i + 2] += ww.z * bflo(uu[2 * i + 1]); x[4 * i + 3] += ww.w * bfhi(uu[2 * i + 1]); } } }
        v4u o0, o1; o0.x = pk2(x[0], x[1]); o0.y = pk2(x[2], x[3]); o0.z = pk2(x[4], x[5]); o0.w = pk2(x[6], x[7]); o1.x = pk2(x[8], x[9]); o1.y = pk2(x[10], x[11]); o1.z = pk2(x[12], x[13]); o1.w = pk2(x[14], x[15]);
        *(LAS v4u*)(xa + t * 136 + sub * 16) = o0; *(LAS v4u*)(xa + t * 136 + sub * 16 + 8) = o1;
#pragma unroll
        for (int i = 0; i < 4; ++i) *(LAS f32x4*)(xf + t * 132 + sub * 16 + 4 * i) = (f32x4){x[4 * i], x[4 * i + 1], x[4 * i + 2], x[4 * i + 3]};
    }
    __syncthreads();
    const bf16* wrT = (const bf16*)(ws + WS_LRUW) + (size_t)n * 16384; const bf16* wiT = wrT + 8 * 16384;
    bf16x8 br[4], bi[4];
#pragma unroll
    for (int ks = 0; ks < 4; ++ks) { br[ks] = *(const bf16x8*)(wrT + (16 * w + fr) * 128 + 32 * ks + 8 * fq); bi[ks] = *(const bf16x8*)(wiT + (16 * w + fr) * 128 + 32 * ks + 8 * fq); }
    f32x4 accr[4], acci[4];
#pragma unroll
    for (int tb = 0; tb < 4; ++tb) { accr[tb] = (f32x4){0.f, 0.f, 0.f, 0.f}; acci[tb] = (f32x4){0.f, 0.f, 0.f, 0.f};
#pragma unroll
        for (int ks = 0; ks < 4; ++ks) { const bf16x8 af = *(const LAS bf16x8*)(xa + (16 * tb + fr) * 136 + 32 * ks + 8 * fq); accr[tb] = MFMA32(af, br[ks], accr[tb]); acci[tb] = MFMA32(af, bi[ks], acci[tb]); } }
    const int dl = 16 * w + fr, chn = n * 128 + dl;
    const float brs = a->in[I_LBR][chn], bis = a->in[I_LBI][chn], spl = softplusf(-a->in[I_LLAM][chn]);
    float Apre = 1.f, Hpre = 0.f;
#pragma unroll
    for (int tb = 0; tb < 4; ++tb) {
        float P[4], Hh[4];
#pragma unroll
        for (int j = 0; j < 4; ++j) { const int t = 16 * tb + 4 * fq + j;
            const float log_a = -8.f * sigm(accr[tb][j] + brs) * spl; const float av = expf(log_a);
            const float bx = sqrtf(-expm1f(2.f * log_a)) * sigm(acci[tb][j] + bis) * xf[t * 132 + dl];
            if (j == 0) { P[0] = av; Hh[0] = bx; } else { P[j] = P[j - 1] * av; Hh[j] = av * Hh[j - 1] + bx; } }
        float Ai = P[3], Hi = Hh[3];
        { const float A2 = __shfl_up(Ai, 16), H2 = __shfl_up(Hi, 16); if (fq >= 1) { Hi = Ai * H2 + Hi; Ai = A2 * Ai; } }
        { const float A2 = __shfl_up(Ai, 32), H2 = __shfl_up(Hi, 32); if (fq >= 2) { Hi = Ai * H2 + Hi; Ai = A2 * Ai; } }
        float Aex = __shfl_up(Ai, 16), Hex = __shfl_up(Hi, 16); if (fq == 0) { Aex = 1.f; Hex = 0.f; }
        const float Atb = __shfl(Ai, 48 + fr), Htb = __shfl(Hi, 48 + fr);
        const float EA = Apre * Aex, EH = Aex * Hpre + Hex;
#pragma unroll
        for (int j = 0; j < 4; ++j) { const int t = 16 * tb + 4 * fq + j; obP[t * 132 + dl] = EA * P[j]; obH[t * 132 + dl] = P[j] * EH + Hh[j]; }
        Hpre = Atb * Hpre + Htb; Apre = Apre * Atb;
    }
    if (fq == 0) { float* e = (float*)(ws + WS_LRU_END) + (size_t)item * 256; e[dl] = Apre; e[128 + dl] = Hpre; }
    __syncthreads();
    {
        const int t = tid >> 3, sub = tid & 7;
        bf16* hl = (bf16*)(ws + WS_LRU_HL) + ((size_t)item * 64 + t) * 128 + sub * 16; bf16* pp = (bf16*)(ws + WS_LRU_P) + ((size_t)item * 64 + t) * 128 + sub * 16;
        const LAS float* sh = obH + t * 132 + sub * 16; const LAS float* sp = obP + t * 132 + sub * 16;
        v4u o0, o1;
        o0.x = pk2(sh[0], sh[1]); o0.y = pk2(sh[2], sh[3]); o0.z = pk2(sh[4], sh[5]); o0.w = pk2(sh[6], sh[7]); o1.x = pk2(sh[8], sh[9]); o1.y = pk2(sh[10], sh[11]); o1.z = pk2(sh[12], sh[13]); o1.w = pk2(sh[14], sh[15]);
        *(v4u*)hl = o0; *(v4u*)(hl + 8) = o1;
        o0.x = pk2(sp[0], sp[1]); o0.y = pk2(sp[2], sp[3]); o0.z = pk2(sp[4], sp[5]); o0.w = pk2(sp[6], sp[7]); o1.x = pk2(sp[8], sp[9]); o1.y = pk2(sp[10], sp[11]); o1.z = pk2(sp[12], sp[13]); o1.w = pk2(sp[14], sp[15]);
        *(v4u*)pp = o0; *(v4u*)(pp + 8) = o1;
    }
    __syncthreads();
}
__device__ __forceinline__ void lru_out_item(ArgsP a, LAS unsigned char* lds, int item, const int tid) {
    const int c = item & 31, n = (item >> 5) & 7, b = item >> 8;
    unsigned char* ws = a->ws;
    LAS float* carry = (LAS float*)lds;
    if (tid < 128) { float cr = 0.f; const float* e = (const float*)(ws + WS_LRU_END) + (size_t)(item - c) * 256;
        for (int k = 0; k < c; ++k) cr = e[k * 256 + 128 + tid] + e[k * 256 + tid] * cr;
        carry[tid] = cr; }
    __syncthreads();
    const int t = tid >> 3, sub = tid & 7, d0 = sub * 16, row = b * TP + 64 * c + t;
    const bf16* hl = (const bf16*)(ws + WS_LRU_HL) + ((size_t)item * 64 + t) * 128 + d0; const bf16* pp = (const bf16*)(ws + WS_LRU_P) + ((size_t)item * 64 + t) * 128 + d0;
    const bf16* gp = (const bf16*)(ws + WS_PROJ) + (size_t)row * NPROJ_PAD + 5120 + n * 128 + d0;
    const v4u h0 = *(const v4u*)hl, h1 = *(const v4u*)(hl + 8), p0 = *(const v4u*)pp, p1 = *(const v4u*)(pp + 8), g0 = *(const v4u*)gp, g1 = *(const v4u*)(gp + 8);
    const unsigned hu[8] = {h0.x, h0.y, h0.z, h0.w, h1.x, h1.y, h1.z, h1.w}, pu[8] = {p0.x, p0.y, p0.z, p0.w, p1.x, p1.y, p1.z, p1.w}, gu[8] = {g0.x, g0.y, g0.z, g0.w, g1.x, g1.y, g1.z, g1.w};
    float hv[16]; unsigned ou[8];
#pragma unroll
    for (int i = 0; i < 8; ++i) { hv[2 * i] = bflo(hu[i]) + bflo(pu[i]) * carry[d0 + 2 * i]; hv[2 * i + 1] = bfhi(hu[i]) + bfhi(pu[i]) * carry[d0 + 2 * i + 1];
        ou[i] = pk2(hv[2 * i] * gelu_tanh(bflo(gu[i])), hv[2 * i + 1] * gelu_tanh(bfhi(gu[i]))); }
    bf16* mp = (bf16*)(ws + WS_MIX) + (size_t)row * D + 1024 + n * 128 + d0;
    *(v4u*)mp = (v4u){ou[0], ou[1], ou[2], ou[3]}; *(v4u*)(mp + 8) = (v4u){ou[4], ou[5], ou[6], ou[7]};
    if (c == 31 && t == 63) { float* o = a->out + O_LRUP + (size_t)b * 1024 + n * 128 + d0;
#pragma unroll
        for (int i = 0; i < 4; ++i) *(f32x4*)(o + 4 * i) = (f32x4){hv[4 * i], hv[4 * i + 1], hv[4 * i + 2], hv[4 * i + 3]}; }
    __syncthreads();
}


__device__ __forceinline__ void conv16_prompt(const bf16* proj, const float* wconv, const float* bconv, int b, int tseq, int ch0, float (&x)[16]) {
#pragma unroll
    for (int i = 0; i < 4; ++i) { const f32x4 bb = *(const f32x4*)(bconv + ch0 + 4 * i); x[4 * i] = bb.x; x[4 * i + 1] = bb.y; x[4 * i + 2] = bb.z; x[4 * i + 3] = bb.w; }
#pragma unroll
    for (int j = 0; j < 4; ++j) { const int tt = tseq - 3 + j;
        if (tt >= 0) { const bf16* pr = proj + (size_t)(b * TP + tt) * NPROJ_PAD + ch0; const v4u u0 = *(const v4u*)pr, u1 = *(const v4u*)(pr + 8);
            const unsigned uu[8] = {u0.x, u0.y, u0.z, u0.w, u1.x, u1.y, u1.z, u1.w};
#pragma unroll
            for (int i = 0; i < 4; ++i) { const f32x4 ww = *(const f32x4*)(wconv + j * 4096 + ch0 + 4 * i);
                x[4 * i] += ww.x * bflo(uu[2 * i]); x[4 * i + 1] += ww.y * bfhi(uu[2 * i]); x[4 * i + 2] += ww.z * bflo(uu[2 * i + 1]); x[4 * i + 3] += ww.w * bfhi(uu[2 * i + 1]); } } }
}
__device__ __forceinline__ void st16_bf16(LAS bf16* p, const float (&x)[16]) {
    v4u o0, o1; o0.x = pk2(x[0], x[1]); o0.y = pk2(x[2], x[3]); o0.z = pk2(x[4], x[5]); o0.w = pk2(x[6], x[7]); o1.x = pk2(x[8], x[9]); o1.y = pk2(x[10], x[11]); o1.z = pk2(x[12], x[13]); o1.w = pk2(x[14], x[15]);
    *(LAS v4u*)p = o0; *(LAS v4u*)(p + 8) = o1;
}
__device__ __forceinline__ v2u pack4(const f32x4 v) { v2u o; o.x = pk2(v.x, v.y); o.y = pk2(v.z, v.w); return o; }
__device__ __forceinline__ bf16x8 zero8() { return (bf16x8){0, 0, 0, 0, 0, 0, 0, 0}; }

__device__ __forceinline__ void delta_prep_item(ArgsP a, LAS unsigned char* lds, int item, const int tid) {
    const int c = item & 31, h = (item >> 5) & 7, b = item >> 8;
    const int lane = tid & 63, w = __builtin_amdgcn_readfirstlane(tid >> 6), fr = lane & 15, fq = lane >> 4;
    unsigned char* ws = a->ws;
    const bf16* proj = (const bf16*)(ws + WS_PROJ);
    LAS bf16* Kn = (LAS bf16*)lds;
    LAS bf16* Qn = (LAS bf16*)(lds + 17408);
    LAS bf16* KdT = (LAS bf16*)(lds + 34816);
    LAS bf16* RX = (LAS bf16*)(lds + 53248);
    LAS bf16* Mm = (LAS bf16*)(lds + 90112);
    LAS bf16* QKd = (LAS bf16*)(lds + 99328);
    LAS bf16* Td = (LAS bf16*)(lds + 108544);
    LAS bf16* RT = (LAS bf16*)(lds + 111616) + w * 768;
    LAS float* gl = (LAS float*)(lds + 123904);
    LAS float* gcs = gl + 64;
    LAS float* bet = gcs + 64;
    const int t = tid >> 3, sub = tid & 7;
    {
        if (sub == 0) { const float* gt = (const float*)(ws + WS_GATES) + (size_t)(b * TP + 64 * c + t) * 16;
            gl[t] = -expf(a->in[I_ALOG][h]) * softplusf(gt[h] + a->in[I_DTB][h]); bet[t] = sigm(gt[8 + h]); }
        __syncthreads();
        if (w == 0) { float v = gl[lane];
#pragma unroll
            for (int o = 1; o < 64; o <<= 1) { const float u = __shfl_up(v, o); if (lane >= o) v += u; }
            gcs[lane] = v; }
        __syncthreads();
    }
    {
        const float* wconv = a->in[I_WCONV]; const float* bconv = a->in[I_BCONV];
        const float gc = gcs[t], glast = gcs[63], beta = bet[t];
        const float ec = expf(gc), ed = expf(glast - gc);
        float x[16], y[16];
        conv16_prompt(proj, wconv, bconv, b, 64 * c + t, 1024 + h * 128 + sub * 16, x);
        float ss = 0.f;
#pragma unroll
        for (int i = 0; i < 16; ++i) { x[i] = siluf(x[i]); ss += x[i] * x[i]; }
        ss += __shfl_xor(ss, 1); ss += __shfl_xor(ss, 2); ss += __shfl_xor(ss, 4);
        const float rk = rsqrtf(ss + 1e-6f);
#pragma unroll
        for (int i = 0; i < 16; ++i) x[i] *= rk;
        st16_bf16(Kn + t * 136 + sub * 16, x);
#pragma unroll
        for (int i = 0; i < 16; ++i) KdT[(sub * 16 + i) * 72 + t] = (bf16)f2bf(x[i] * ed);
#pragma unroll
        for (int i = 0; i < 16; ++i) y[i] = x[i] * (beta * ec);
        st16_bf16(RX + t * 264 + 128 + sub * 16, y);
        conv16_prompt(proj, wconv, bconv, b, 64 * c + t, h * 128 + sub * 16, x);
        ss = 0.f;
#pragma unroll
        for (int i = 0; i < 16; ++i) { x[i] = siluf(x[i]); ss += x[i] * x[i]; }
        ss += __shfl_xor(ss, 1); ss += __shfl_xor(ss, 2); ss += __shfl_xor(ss, 4);
        const float rq = rsqrtf(ss + 1e-6f) * 0.08838834764831845f;
#pragma unroll
        for (int i = 0; i < 16; ++i) x[i] *= rq;
        st16_bf16(Qn + t * 136 + sub * 16, x);
        conv16_prompt(proj, wconv, bconv, b, 64 * c + t, 2048 + h * 128 + sub * 16, x);
#pragma unroll
        for (int i = 0; i < 16; ++i) x[i] = siluf(x[i]) * beta;
        st16_bf16(RX + t * 264 + sub * 16, x);
    }
    __syncthreads();
    {
        const int ib = w >> 1;
#pragma unroll
        for (int jj = 0; jj < 2; ++jj) { const int jb = 2 * (w & 1) + jj;
            f32x4 ak = (f32x4){0.f, 0.f, 0.f, 0.f}, aq = (f32x4){0.f, 0.f, 0.f, 0.f};
            if (jb <= ib) {
#pragma unroll
                for (int ks = 0; ks < 4; ++ks) { const bf16x8 bfr = *(const LAS bf16x8*)(Kn + (16 * jb + fr) * 136 + 32 * ks + 8 * fq);
                    const bf16x8 afk = *(const LAS bf16x8*)(Kn + (16 * ib + fr) * 136 + 32 * ks + 8 * fq), afq = *(const LAS bf16x8*)(Qn + (16 * ib + fr) * 136 + 32 * ks + 8 * fq);
                    ak = MFMA32(afk, bfr, ak); aq = MFMA32(afq, bfr, aq); } }
            const int col = 16 * jb + fr; const float gcc = gcs[col];
#pragma unroll
            for (int j = 0; j < 4; ++j) { const int row = 16 * ib + 4 * fq + j; const float dec = (row >= col) ? expf(gcs[row] - gcc) : 0.f;
                Mm[row * 72 + col] = (bf16)f2bf(row > col ? -bet[row] * ak[j] * dec : 0.f);
                QKd[row * 72 + col] = (bf16)f2bf(aq[j] * dec); }
        }
    }
    __syncthreads();
    if (w == 0) { const int blk = lane >> 4, col = lane & 15; float xi[16];
#pragma unroll
        for (int i = 0; i < 16; ++i) { float acc = (i == col) ? 1.f : 0.f; const LAS bf16* mr = Mm + (16 * blk + i) * 72 + 16 * blk;
#pragma unroll
            for (int j = 0; j < i; ++j) acc += bf2f(mr[j]) * xi[j];
            xi[i] = acc; }
#pragma unroll
        for (int i = 0; i < 16; ++i) Td[(blk * 16 + i) * 24 + col] = (bf16)f2bf(xi[i]); }
    f32x4 rhs[2][4];
#pragma unroll
    for (int cbl = 0; cbl < 2; ++cbl)
#pragma unroll
        for (int bb = 0; bb < 4; ++bb)
#pragma unroll
            for (int j = 0; j < 4; ++j) rhs[cbl][bb][j] = bf2f(RX[(16 * bb + 4 * fq + j) * 264 + 32 * w + 16 * cbl + fr]);
    __syncthreads();
#pragma unroll
    for (int cbl = 0; cbl < 2; ++cbl) { const int cb = 2 * w + cbl;
#pragma unroll
        for (int bb = 0; bb < 4; ++bb) {
            f32x4 acc = rhs[cbl][bb];
#pragma unroll
            for (int ks = 0; ks < 2; ++ks) { if (32 * ks < 16 * bb) { const bool ok = (32 * ks + 8 * fq) < 16 * bb;
                const bf16x8 af = ok ? *(const LAS bf16x8*)(Mm + (16 * bb + fr) * 72 + 32 * ks + 8 * fq) : zero8();
                const bf16x8 bf_ = ok ? *(const LAS bf16x8*)(RX + (16 * cb + fr) * 72 + 32 * ks + 8 * fq) : zero8();
                acc = MFMA32(af, bf_, acc); } }
            *(LAS v2u*)(RT + (16 * cbl + fr) * 24 + 4 * fq) = pack4(acc);
            asm volatile("s_waitcnt lgkmcnt(0)" ::: "memory");
            const bool ok2 = fq < 2;
            const bf16x8 af2 = ok2 ? *(const LAS bf16x8*)(Td + (bb * 16 + fr) * 24 + 8 * fq) : zero8();
            const bf16x8 bf2 = ok2 ? *(const LAS bf16x8*)(RT + (16 * cbl + fr) * 24 + 8 * fq) : zero8();
            const f32x4 xb4 = MFMA32(af2, bf2, ((f32x4){0.f, 0.f, 0.f, 0.f}));
            *(LAS v2u*)(RX + (16 * cb + fr) * 72 + 16 * bb + 4 * fq) = pack4(xb4);
            asm volatile("s_waitcnt lgkmcnt(0)" ::: "memory");
        }
    }
    __syncthreads();
    {
        v4u* gout = (v4u*)(ws + WS_DG) + ((size_t)item * 8 + w) * 4 * 64 + lane;
        bf16x8 kb[2];
#pragma unroll
        for (int kt = 0; kt < 2; ++kt) kb[kt] = *(const LAS bf16x8*)(KdT + (16 * w + fr) * 72 + 32 * kt + 8 * fq);
#pragma unroll
        for (int ks = 0; ks < 4; ++ks) { f32x4 g0 = (f32x4){0.f, 0.f, 0.f, 0.f}, g1 = (f32x4){0.f, 0.f, 0.f, 0.f};
#pragma unroll
            for (int kt = 0; kt < 2; ++kt) { const bf16x8 a0 = *(const LAS bf16x8*)(RX + (128 + 32 * ks + fr) * 72 + 32 * kt + 8 * fq), a1 = *(const LAS bf16x8*)(RX + (128 + 32 * ks + 16 + fr) * 72 + 32 * kt + 8 * fq);
                g0 = MFMA32(a0, kb[kt], g0); g1 = MFMA32(a1, kb[kt], g1); }
            const v2u p0 = pack4(-g0), p1 = pack4(-g1); gout[ks * 64] = (v4u){p0.x, p0.y, p1.x, p1.y}; }
        v2u* bout = (v2u*)(ws + WS_DB) + ((size_t)item * 64 + w) * 64 + lane;
#pragma unroll
        for (int s2 = 0; s2 < 8; ++s2) { f32x4 bc = (f32x4){0.f, 0.f, 0.f, 0.f};
#pragma unroll
            for (int kt = 0; kt < 2; ++kt) { const bf16x8 ub = *(const LAS bf16x8*)(RX + (16 * s2 + fr) * 72 + 32 * kt + 8 * fq); bc = MFMA32(kb[kt], ub, bc); }
            bout[(size_t)s2 * 8 * 64] = pack4(bc); }
    }
    {
        const int tb = w >> 1, half = w & 1; const float ect = expf(gcs[16 * tb + fr]);
        bf16x8 qk[2];
#pragma unroll
        for (int kt = 0; kt < 2; ++kt) qk[kt] = *(const LAS bf16x8*)(QKd + (16 * tb + fr) * 72 + 32 * kt + 8 * fq);
        v4u* qout = (v4u*)(ws + WS_DQ) + ((size_t)item * 4 + tb) * 4 * 64 + lane;
#pragma unroll
        for (int kk = 0; kk < 2; ++kk) { const int ks = 2 * half + kk; v2u pk[2];
#pragma unroll
            for (int hf = 0; hf < 2; ++hf) { const int db = 2 * ks + hf; f32x4 acc = (f32x4){0.f, 0.f, 0.f, 0.f};
#pragma unroll
                for (int kt = 0; kt < 2; ++kt) { const bf16x8 wa = *(const LAS bf16x8*)(RX + (128 + 16 * db + fr) * 72 + 32 * kt + 8 * fq); acc = MFMA32(wa, qk[kt], acc); }
                const v2u qn4 = *(const LAS v2u*)(Qn + (16 * tb + fr) * 136 + 16 * db + 4 * fq);
                f32x4 qp; qp.x = bflo(qn4.x) * ect - acc.x; qp.y = bfhi(qn4.x) * ect - acc.y; qp.z = bflo(qn4.y) * ect - acc.z; qp.w = bfhi(qn4.y) * ect - acc.w;
                pk[hf] = pack4(qp); }
            qout[ks * 64] = (v4u){pk[0].x, pk[0].y, pk[1].x, pk[1].y}; }
        v2u* oout = (v2u*)(ws + WS_DO) + ((size_t)item * 4 + tb) * 8 * 64 + lane;
#pragma unroll
        for (int ss = 0; ss < 4; ++ss) { const int s2 = 4 * half + ss; f32x4 acc = (f32x4){0.f, 0.f, 0.f, 0.f};
#pragma unroll
            for (int kt = 0; kt < 2; ++kt) { const bf16x8 ua = *(const LAS bf16x8*)(RX + (16 * s2 + fr) * 72 + 32 * kt + 8 * fq); acc = MFMA32(ua, qk[kt], acc); }
            oout[s2 * 64] = pack4(acc); }
    }
    if (tid == 0) ((float*)(ws + WS_DD))[item] = expf(gcs[63]);
    __syncthreads();
}

__device__ __forceinline__ void delta_scan_wave(ArgsP a, int chain, int s, const int lane) {
    unsigned char* ws = a->ws;
    const int fr = lane & 15, fq = lane >> 4;
    f32x4 S[8]; bf16x8 Sb[4];
#pragma unroll
    for (int i = 0; i < 8; ++i) S[i] = (f32x4){0.f, 0.f, 0.f, 0.f};
#pragma unroll
    for (int i = 0; i < 4; ++i) Sb[i] = zero8();
    const bf16x8* gbase = (const bf16x8*)(ws + WS_DG) + (size_t)chain * 32 * 2048 + lane;
    bf16x8 G[8][4];
#pragma unroll
    for (int rb = 0; rb < 8; ++rb)
#pragma unroll
        for (int ks = 0; ks < 4; ++ks) G[rb][ks] = gbase[(rb * 4 + ks) * 64];
#pragma unroll 1
    for (int c = 0; c < 32; ++c) {
        const int item = chain * 32 + c;
        const float d = ((const float*)(ws + WS_DD))[item];
        bf16x8* sout = (bf16x8*)(ws + WS_DS) + ((size_t)item * 8 + s) * 4 * 64 + lane;
#pragma unroll
        for (int ks = 0; ks < 4; ++ks) sout[ks * 64] = Sb[ks];
        const v2u* bin = (const v2u*)(ws + WS_DB) + ((size_t)item * 8 + s) * 8 * 64 + lane;
#pragma unroll
        for (int rb = 0; rb < 8; ++rb) { const v2u bc = bin[rb * 64]; S[rb].x = d * S[rb].x + bflo(bc.x); S[rb].y = d * S[rb].y + bfhi(bc.x); S[rb].z = d * S[rb].z + bflo(bc.y); S[rb].w = d * S[rb].w + bfhi(bc.y); }
        const bf16x8* gnext = gbase + (size_t)(c + 1 < 32 ? c + 1 : c) * 2048;
#pragma unroll
        for (int rb = 0; rb < 8; ++rb) {
#pragma unroll
            for (int ks = 0; ks < 4; ++ks) S[rb] = MFMA32(G[rb][ks], Sb[ks], S[rb]);
#pragma unroll
            for (int ks = 0; ks < 4; ++ks) G[rb][ks] = gnext[(rb * 4 + ks) * 64];
        }
#pragma unroll
        for (int ks = 0; ks < 4; ++ks) { const v2u lo = pack4(S[2 * ks]), hi = pack4(S[2 * ks + 1]); const v4u u = (v4u){lo.x, lo.y, hi.x, hi.y}; Sb[ks] = __builtin_bit_cast(bf16x8, u); }
    }
    f32x4* so = (f32x4*)(ws + WS_DF) + ((size_t)(chain * 8 + s) * 8) * 64 + lane;
#pragma unroll
    for (int rb = 0; rb < 8; ++rb) so[rb * 64] = S[rb];
}

__device__ __forceinline__ void delta_out_wave(ArgsP a, int item, int tb, const int lane) {
    unsigned char* ws = a->ws;
    const int c = item & 31, h = (item >> 5) & 7, b = item >> 8, fr = lane & 15, fq = lane >> 4;
    bf16x8 qf[4];
    const bf16x8* qin = (const bf16x8*)(ws + WS_DQ) + ((size_t)item * 4 + tb) * 4 * 64 + lane;
#pragma unroll
    for (int ks = 0; ks < 4; ++ks) qf[ks] = qin[ks * 64];
    const v2u* oin = (const v2u*)(ws + WS_DO) + ((size_t)item * 4 + tb) * 8 * 64 + lane;
    const bf16x8* sin = (const bf16x8*)(ws + WS_DS) + (size_t)item * 8 * 4 * 64 + lane;
    f32x4 o[8]; float ss = 0.f;
#pragma unroll
    for (int s = 0; s < 8; ++s) { const v2u ol = oin[s * 64]; o[s] = (f32x4){bflo(ol.x), bfhi(ol.x), bflo(ol.y), bfhi(ol.y)};
#pragma unroll
        for (int ks = 0; ks < 4; ++ks) o[s] = MFMA32(sin[(s * 4 + ks) * 64], qf[ks], o[s]);
        ss += (o[s].x * o[s].x + o[s].y * o[s].y) + (o[s].z * o[s].z + o[s].w * o[s].w); }
    ss += __shfl_xor(ss, 16); ss += __shfl_xor(ss, 32);
    const float rstd = rsqrtf(ss * (1.f / 128.f) + RMS_EPS);
    const int row = b * TP + 64 * c + 16 * tb + fr;
    const bf16* zp = (const bf16*)(ws + WS_PROJ) + (size_t)row * NPROJ_PAD + 4096 + h * 128 + 4 * fq;
    bf16* mp = (bf16*)(ws + WS_MIX) + (size_t)row * D + h * 128 + 4 * fq;
    const float* nw = a->in[I_DNORM] + 4 * fq;
#pragma unroll
    for (int s = 0; s < 8; ++s) { const v2u z = *(const v2u*)(zp + 16 * s); const f32x4 n4 = *(const f32x4*)(nw + 16 * s);
        f32x4 y; y.x = o[s].x * rstd * n4.x * siluf(bflo(z.x)); y.y = o[s].y * rstd * n4.y * siluf(bfhi(z.x)); y.z = o[s].z * rstd * n4.z * siluf(bflo(z.y)); y.w = o[s].w * rstd * n4.w * siluf(bfhi(z.y));
        *(v2u*)(mp + 16 * s) = pack4(y); }
}


__device__ __forceinline__ float wave_incl_sum(float v, int lane) {
#pragma unroll
    for (int o = 1; o < 64; o <<= 1) { const float u = __shfl_up(v, o); if (lane >= o) v += u; }
    return v;
}
__device__ __forceinline__ float wave_incl_max(float v, int lane) {
#pragma unroll
    for (int o = 1; o < 64; o <<= 1) { const float u = __shfl_up(v, o); if (lane >= o) v = fmaxf(v, u); }
    return v;
}
__device__ __forceinline__ float wave_max(float v) {
#pragma unroll
    for (int o = 1; o < 64; o <<= 1) v = fmaxf(v, __shfl_xor(v, o));
    return v;
}
__device__ __forceinline__ void mlstm_scan_item(ArgsP a, LAS unsigned char* lds, int chain, int vs, const int tid) {
    const int lane = tid & 63, w = __builtin_amdgcn_readfirstlane(tid >> 6), fr = lane & 15, fq = lane >> 4;
    const int b = chain >> 3, h = chain & 7, row0 = b * TP;
    unsigned char* ws = a->ws;
    const bf16* proj = (const bf16*)(ws + WS_PROJ); const float* gates = (const float*)(ws + WS_GATES);
    LAS bf16* KT = (LAS bf16*)lds;
    LAS bf16* VT = (LAS bf16*)(lds + 36864);
    LAS float* wls = (LAS float*)(lds + 46080);
    const float big = a->in[I_BIG][h], bfg = a->in[I_BFG][h];
    const int ks0 = tid >> 4, kk8 = tid & 15;
    const int vtok = tid >> 2, vv8 = tid & 3;
    const bf16* kptr = proj + (size_t)(row0 + ks0) * NPROJ_PAD + 1024 + h * 128 + 8 * kk8;
    const bf16* vptr = proj + (size_t)(row0 + vtok) * NPROJ_PAD + 2048 + h * 256 + 32 * vs + 8 * vv8;
    const float* gptr = gates + (size_t)(row0 + lane) * 16 + h;
    f32x4 acc[2]; acc[0] = (f32x4){0.f, 0.f, 0.f, 0.f}; acc[1] = acc[0];
    float nst = 0.f, m = 0.f;
    v4u kq[2][2], vq[2]; float gi[2], gf[2];
#define ML_LOAD(set, c_) do { const size_t ro = (size_t)(c_) * 64 * NPROJ_PAD; kq[set][0] = *(const v4u*)(kptr + ro); kq[set][1] = *(const v4u*)(kptr + ro + (size_t)32 * NPROJ_PAD); \
        if (tid < 256) vq[set] = *(const v4u*)(vptr + ro); gi[set] = gptr[(size_t)(c_) * 64 * 16]; gf[set] = gptr[(size_t)(c_) * 64 * 16 + 8]; } while (0)
#define ML_STEP(set, c_) do { const int item = chain * 32 + (c_); \
        const float ig = gi[set] + big, lf = logsigf(gf[set] + bfg); \
        const float bcum = wave_incl_sum(lf, lane), blast = __shfl(bcum, 63), gend = blast - bcum + ig; \
        const float mnew = fmaxf(blast + m, wave_max(gend)), sc = expf(blast + m - mnew), wv = expf(gend - mnew) * 0.08838834764831845f; \
        LAS bf16* kt = KT + (set) * 9216; LAS bf16* vt = VT + (set) * 2304; \
        _Pragma("unroll") for (int i = 0; i < 2; ++i) { const unsigned uu[4] = {kq[set][i].x, kq[set][i].y, kq[set][i].z, kq[set][i].w}; const int tok = ks0 + 32 * i; \
            _Pragma("unroll") for (int e = 0; e < 4; ++e) { kt[(8 * kk8 + 2 * e) * 72 + tok] = (bf16)(uu[e] & 0xffffu); kt[(8 * kk8 + 2 * e + 1) * 72 + tok] = (bf16)(uu[e] >> 16); } } \
        if (tid < 256) { const float wt = __shfl(wv, 16 * w + (lane >> 2)); const unsigned uu[4] = {vq[set].x, vq[set].y, vq[set].z, vq[set].w}; \
            _Pragma("unroll") for (int e = 0; e < 4; ++e) { vt[(8 * vv8 + 2 * e) * 72 + vtok] = (bf16)f2bf(bflo(uu[e]) * wt); vt[(8 * vv8 + 2 * e + 1) * 72 + vtok] = (bf16)f2bf(bfhi(uu[e]) * wt); } } \
        if (w == 0) wls[(set) * 64 + lane] = wv; \
        if ((c_) + 2 < 32) ML_LOAD(set, (c_) + 2); \
        if (vs == 0 && tid == 0) ((float*)(ws + WS_MM))[item] = m; \
        __syncthreads(); \
        _Pragma("unroll") for (int vb = 0; vb < 2; ++vb) { *(v2u*)((bf16*)(ws + WS_MC) + ((size_t)item * 256 + 32 * vs + 16 * vb + fr) * 128 + 16 * w + 4 * fq) = pack4(acc[vb]); } \
        if (vs == 0 && tid < 128) { ((float*)(ws + WS_MN))[(size_t)item * 128 + tid] = nst; float sn = 0.f; \
            _Pragma("unroll") for (int s8 = 0; s8 < 8; ++s8) { const v4u kk = *(const LAS v4u*)(kt + tid * 72 + 8 * s8); const LAS float* wl = wls + (set) * 64 + 8 * s8; \
                sn += bflo(kk.x) * wl[0] + bfhi(kk.x) * wl[1] + bflo(kk.y) * wl[2] + bfhi(kk.y) * wl[3] + bflo(kk.z) * wl[4] + bfhi(kk.z) * wl[5] + bflo(kk.w) * wl[6] + bfhi(kk.w) * wl[7]; } \
            nst = sc * nst + sn; } \
        _Pragma("unroll") for (int vb = 0; vb < 2; ++vb) { acc[vb] = acc[vb] * sc; \
            _Pragma("unroll") for (int kt2 = 0; kt2 < 2; ++kt2) { const bf16x8 af = *(const LAS bf16x8*)(kt + (16 * w + fr) * 72 + 32 * kt2 + 8 * fq), bfv = *(const LAS bf16x8*)(vt + (16 * vb + fr) * 72 + 32 * kt2 + 8 * fq); \
                acc[vb] = MFMA32(af, bfv, acc[vb]); } } \
        m = mnew; } while (0)
    ML_LOAD(0, 0); ML_LOAD(1, 1);
#pragma unroll 1
    for (int c2 = 0; c2 < 32; c2 += 2) { ML_STEP(0, c2); ML_STEP(1, c2 + 1); }
#undef ML_LOAD
#undef ML_STEP
#pragma unroll
    for (int vb = 0; vb < 2; ++vb) *(f32x4*)(a->out + O_MCP + ((size_t)chain * 256 + 32 * vs + 16 * vb + fr) * 128 + 16 * w + 4 * fq) = acc[vb];
    if (vs == 0) { if (tid < 128) a->out[O_MNP + (size_t)chain * 128 + tid] = nst; if (tid == 0) a->out[O_MMP + chain] = m; }
    __syncthreads();
}

__device__ __forceinline__ void mlstm_out_item(ArgsP a, LAS unsigned char* lds, int item, const int tid) {
    const int c = item & 31, h = (item >> 5) & 7, b = item >> 8, row0 = b * TP + 64 * c;
    const int lane = tid & 63, w = __builtin_amdgcn_readfirstlane(tid >> 6), fr = lane & 15, fq = lane >> 4;
    unsigned char* ws = a->ws;
    const bf16* proj = (const bf16*)(ws + WS_PROJ); const float* gates = (const float*)(ws + WS_GATES);
    LAS bf16* VT = (LAS bf16*)lds;
    LAS float* ssq = (LAS float*)(lds + 36864);
    const float mc = ((const float*)(ws + WS_MM))[item];
    float av, Mt, et, em;
    { const float ig = gates[(size_t)(row0 + lane) * 16 + h] + a->in[I_BIG][h], lf = logsigf(gates[(size_t)(row0 + lane) * 16 + 8 + h] + a->in[I_BFG][h]);
      const float bcum = wave_incl_sum(lf, lane); av = ig - bcum; Mt = fmaxf(mc, wave_incl_max(av, lane)); et = expf(mc - Mt); em = expf(-(bcum + Mt)); }
#pragma unroll
    for (int i = 0; i < 4; ++i) { const int idx = tid + 512 * i, s = idx >> 5, v8 = idx & 31; const v4u u = *(const v4u*)(proj + (size_t)(row0 + s) * NPROJ_PAD + 2048 + h * 256 + 8 * v8);
        const unsigned uu[4] = {u.x, u.y, u.z, u.w};
#pragma unroll
        for (int e = 0; e < 4; ++e) { VT[(8 * v8 + 2 * e) * 72 + s] = (bf16)(uu[e] & 0xffffu); VT[(8 * v8 + 2 * e + 1) * 72 + s] = (bf16)(uu[e] >> 16); } }
    const int tb = w & 3, half = w >> 2, t = 16 * tb + fr;
    bf16x8 qf[4]; float qn = 0.f;
#pragma unroll
    for (int ks = 0; ks < 4; ++ks) { const v4u u = *(const v4u*)(proj + (size_t)(row0 + t) * NPROJ_PAD + h * 128 + 32 * ks + 8 * fq); qf[ks] = __builtin_bit_cast(bf16x8, u);
        const float* np = (const float*)(ws + WS_MN) + (size_t)item * 128 + 32 * ks + 8 * fq; const f32x4 n0 = *(const f32x4*)np, n1 = *(const f32x4*)(np + 4);
        qn += bflo(u.x) * n0.x + bfhi(u.x) * n0.y + bflo(u.y) * n0.z + bfhi(u.y) * n0.w + bflo(u.z) * n1.x + bfhi(u.z) * n1.y + bflo(u.w) * n1.z + bfhi(u.w) * n1.w; }
    qn += __shfl_xor(qn, 16); qn += __shfl_xor(qn, 32);
    const float Mtt = __shfl(Mt, t), ett = __shfl(et, t), emt = __shfl(em, t);
    v2u smp[4]; float rowsum = 0.f;
#pragma unroll
    for (int sb = 0; sb < 4; ++sb) { smp[sb] = (v2u){0u, 0u};
        if (sb <= tb) { f32x4 qk = (f32x4){0.f, 0.f, 0.f, 0.f};
#pragma unroll
            for (int ks = 0; ks < 4; ++ks) { const v4u u = *(const v4u*)(proj + (size_t)(row0 + 16 * sb + fr) * NPROJ_PAD + 1024 + h * 128 + 32 * ks + 8 * fq); qk = MFMA32(__builtin_bit_cast(bf16x8, u), qf[ks], qk); }
            f32x4 sm;
#pragma unroll
            for (int j = 0; j < 4; ++j) { const int s = 16 * sb + 4 * fq + j; const float as = __shfl(av, s); sm[j] = (s <= t) ? qk[j] * 0.08838834764831845f * expf(as - Mtt) : 0.f; rowsum += sm[j]; }
            smp[sb] = pack4(sm); } }
    rowsum += __shfl_xor(rowsum, 16); rowsum += __shfl_xor(rowsum, 32);
    const float hden = 1.f / fmaxf(fabsf(ett * qn + rowsum), emt);
    const v4u s0u = (v4u){smp[0].x, smp[0].y, smp[1].x, smp[1].y}, s1u = (v4u){smp[2].x, smp[2].y, smp[3].x, smp[3].y};
    const bf16x8 sf0 = __builtin_bit_cast(bf16x8, s0u), sf1 = __builtin_bit_cast(bf16x8, s1u);
    __syncthreads();
    f32x4 hv[8]; float ss = 0.f;
    const bf16* cs = (const bf16*)(ws + WS_MC) + (size_t)item * 256 * 128;
#pragma unroll
    for (int vb = 0; vb < 8; ++vb) { const int vrow = 128 * half + 16 * vb + fr; f32x4 acc = (f32x4){0.f, 0.f, 0.f, 0.f};
#pragma unroll
        for (int ks = 0; ks < 4; ++ks) { const v4u u = *(const v4u*)(cs + (size_t)vrow * 128 + 32 * ks + 8 * fq); acc = MFMA32(__builtin_bit_cast(bf16x8, u), qf[ks], acc); }
        acc = acc * ett;
        { const v2u a0 = *(const LAS v2u*)(VT + vrow * 72 + 4 * fq), a1 = *(const LAS v2u*)(VT + vrow * 72 + 16 + 4 * fq); const v4u au = (v4u){a0.x, a0.y, a1.x, a1.y}; acc = MFMA32(__builtin_bit_cast(bf16x8, au), sf0, acc); }
        { const v2u a0 = *(const LAS v2u*)(VT + vrow * 72 + 32 + 4 * fq), a1 = *(const LAS v2u*)(VT + vrow * 72 + 48 + 4 * fq); const v4u au = (v4u){a0.x, a0.y, a1.x, a1.y}; acc = MFMA32(__builtin_bit_cast(bf16x8, au), sf1, acc); }
        hv[vb] = acc * hden; ss += (hv[vb].x * hv[vb].x + hv[vb].y * hv[vb].y) + (hv[vb].z * hv[vb].z + hv[vb].w * hv[vb].w); }
    ss += __shfl_xor(ss, 16); ss += __shfl_xor(ss, 32);
    if (fq == 0) ssq[half * 64 + t] = ss;
    __syncthreads();
    const float rstd = rsqrtf((ssq[t] + ssq[64 + t]) * (1.f / 256.f) + RMS_EPS);
    const bf16* op = proj + (size_t)(row0 + t) * NPROJ_PAD + 4096 + h * 256 + 128 * half + 4 * fq;
    bf16* mp = (bf16*)(ws + WS_MIX) + (size_t)(row0 + t) * D + h * 256 + 128 * half + 4 * fq;
    const float* nw = a->in[I_MNORM] + h * 256 + 128 * half + 4 * fq;
#pragma unroll
    for (int vb = 0; vb < 8; ++vb) { const v2u o = *(const v2u*)(op + 16 * vb); const f32x4 n4 = *(const f32x4*)(nw + 16 * vb);
        f32x4 y; y.x = hv[vb].x * rstd * n4.x * sigm(bflo(o.x)); y.y = hv[vb].y * rstd * n4.y * sigm(bfhi(o.x)); y.z = hv[vb].z * rstd * n4.z * sigm(bflo(o.y)); y.w = hv[vb].w * rstd * n4.w * sigm(bfhi(o.y));
        *(v2u*)(mp + 16 * vb) = pack4(y); }
    __syncthreads();
}

__device__ __forceinline__ void phase_mixer_even(ArgsP a, LAS unsigned char* lds, int vcu, int G, const int tid) {
#pragma unroll 1
    for (int r = 0; r < 1 + (PROBE_SUB & 1); ++r)
#pragma unroll 1
    for (int it = vcu; it < 1024; it += G) delta_prep_item(a, lds, it, tid);
#pragma unroll 1
    for (int r = 0; r < 1 + ((PROBE_SUB >> 1) & 1); ++r)
#pragma unroll 1
    for (int it = vcu; it < 1024; it += G) lru_prep_item(a, lds, it, tid);
#pragma unroll 1
    for (int r = 0; r < 1 + ((PROBE_SUB >> 2) & 1); ++r)
#pragma unroll 1
    for (int j = vcu; j < 1024; j += G) { const int b = j >> 3, hn = j & 7; delta_rec_item(a, lds, MP + b * TS, TS, hn, a->in[I_SCONV] + (size_t)b * 3 * 4096, a->in[I_SDELTA] + (size_t)j * 16384, a->out + O_DELTAS + (size_t)j * 16384, tid); }
#pragma unroll 1
    for (int r = 0; r < 1 + ((PROBE_SUB >> 3) & 1); ++r)
#pragma unroll 1
    for (int j = vcu; j < 1024; j += G) { const int b = j >> 3, hn = j & 7; lru_rec_item(a, lds, MP + b * TS, TS, hn, a->in[I_SCONV] + (size_t)b * 3 * 4096, a->in[I_SLRU] + (size_t)b * 1024, a->out + O_LRUS + (size_t)b * 1024, tid); }
    const bf16* proj = (const bf16*)(a->ws + WS_PROJ);
    const int nconv = (BP + BS) * 3 * 4096;
    for (int i = vcu * NTHR + tid; i < nconv; i += G * NTHR) {
        const int ch = i & 4095, rj = i >> 12, j = rj % 3, b = rj / 3;
        if (b < BP) a->out[O_CONVP + (size_t)(b * 3 + j) * 4096 + ch] = bf2f(proj[(size_t)(b * TP + TP - 3 + j) * NPROJ_PAD + ch]);
        else { const int bs = b - BP; a->out[O_CONVS + (size_t)(bs * 3 + j) * 4096 + ch] = bf2f(proj[(size_t)(MP + bs * TS + 1 + j) * NPROJ_PAD + ch]); }
    }
}
__device__ __forceinline__ void phase_mixer_even_b(ArgsP a, LAS unsigned char* lds, int vcu, int G, const int tid) {
    const int w = __builtin_amdgcn_readfirstlane(tid >> 6);
    if (w == 0) { for (int it = vcu; it < 256; it += G) delta_scan_wave(a, it >> 3, it & 7, tid & 63); }
    else { LAS float* scr = (LAS float*)(lds + w * 16384);
#pragma unroll 1
        for (int it = vcu * 7 + (w - 1); it < cv::N_REST; it += G * 7) convert_rest_item(a, scr, it, tid & 63); }
}
__device__ __forceinline__ void phase_mixer_even_c(ArgsP a, LAS unsigned char* lds, int vcu, int G, const int tid) {
    const int w = tid >> 6;
#pragma unroll 1
    for (int it = vcu; it < 512; it += G) delta_out_wave(a, 2 * it + (w >> 2), w & 3, tid & 63);
#pragma unroll 1
    for (int it = vcu; it < 1024; it += G) lru_out_item(a, lds, it, tid);
    for (int chain = vcu; chain < 32; chain += G) {
        const float* src = (const float*)(a->ws + WS_DF) + (size_t)chain * 16384; float* dst = a->out + O_DELTAP + (size_t)chain * 16384;
        for (int e = tid; e < 16384; e += NTHR) { const int dk = e >> 7, dv = e & 127;
            dst[e] = src[((((dv >> 4) * 8 + (dk >> 4)) * 64 + ((dk >> 2) & 3) * 16 + (dv & 15)) << 2) + (dk & 3)]; }
    }
}
__device__ __forceinline__ void phase_mixer_odd(ArgsP a, LAS unsigned char* lds, int vcu, int G, const int tid) {
#pragma unroll 1
    for (int r = 0; r < 1 + ((PROBE_SUB >> 4) & 1); ++r)
#pragma unroll 1
    for (int it = vcu; it < 256; it += G) mlstm_scan_item(a, lds, it >> 3, it & 7, tid);
#pragma unroll 1
    for (int r = 0; r < 1 + ((PROBE_SUB >> 5) & 1); ++r)
#pragma unroll 1
    for (int j = vcu; j < 1024; j += G) { const int b = j >> 3, h = j & 7;
        mlstm_rec_item(a, lds, MP + b * TS, TS, h, a->in[I_SMC] + (size_t)j * 32768, a->in[I_SMN] + (size_t)j * 128, a->in[I_SMM] + j, a->out + O_MCS + (size_t)j * 32768, a->out + O_MNS + (size_t)j * 128, a->out + O_MMS + j, tid); }
}
__device__ __forceinline__ void phase_mixer_odd_b(ArgsP a, LAS unsigned char* lds, int vcu, int G, const int tid) {
#pragma unroll 1
    for (int it = vcu; it < 1024; it += G) mlstm_out_item(a, lds, it, tid);
}

__device__ __forceinline__ void phase_ln(const float* p0, const float* p1, int T, int P, const bf16* resid, const float* g, const float* bta, bf16* dst, int gw, int NGW, int lane) {
    for (int m = gw; m < M; m += NGW) {
        float v[32]; float s = 0.f;
#pragma unroll
        for (int j = 0; j < 8; ++j) { const size_t off = (size_t)m * D + j * 256 + lane * 4; f32x4 x;
            if (m < MP) x = *(const f32x4*)(p0 + off);
            else { const float* q1 = p1 + (size_t)(m - MP) * D + j * 256 + lane * 4; x = *(const f32x4*)q1;
#pragma unroll
                for (int ch = 1; ch < 16; ++ch) x = x + *(const f32x4*)(q1 + (size_t)ch * 512 * D); }
            const v2u rr = *(const v2u*)(resid + off);
            v[4 * j + 0] = x.x + DN_ALPHA * bflo(rr.x); v[4 * j + 1] = x.y + DN_ALPHA * bfhi(rr.x); v[4 * j + 2] = x.z + DN_ALPHA * bflo(rr.y); v[4 * j + 3] = x.w + DN_ALPHA * bfhi(rr.y);
            s += (v[4 * j] + v[4 * j + 1]) + (v[4 * j + 2] + v[4 * j + 3]); }
        const float mean = wave_sum(s) * (1.f / D); float s2 = 0.f;
#pragma unroll
        for (int i = 0; i < 32; ++i) { v[i] -= mean; s2 += v[i] * v[i]; }
        const float rstd = rsqrtf(wave_sum(s2) * (1.f / D) + LN_EPS);
#pragma unroll
        for (int j = 0; j < 8; ++j) { const int col = j * 256 + lane * 4; const f32x4 gg = *(const f32x4*)(g + col), bb = *(const f32x4*)(bta + col);
            v2u o; o.x = pk2(v[4 * j] * rstd * gg.x + bb.x, v[4 * j + 1] * rstd * gg.y + bb.y); o.y = pk2(v[4 * j + 2] * rstd * gg.z + bb.z, v[4 * j + 3] * rstd * gg.w + bb.w);
            *(v2u*)(dst + (size_t)m * D + col) = o; }
    }
}
__device__ __forceinline__ void phase_combine(const float* p0, const float* p1, int T, int P, const bf16* h2, const bf16* pw, bf16* xb, float* outf, int gw, int NGW, int lane) {
    for (int m = gw; m < M; m += NGW) {
#pragma unroll
        for (int j = 0; j < 8; ++j) { const size_t off = (size_t)m * D + j * 256 + lane * 4; f32x4 x;
            if (m < MP) x = *(const f32x4*)(p0 + off);
            else { const float* q1 = p1 + (size_t)(m - MP) * D + j * 256 + lane * 4; x = *(const f32x4*)q1;
#pragma unroll
                for (int ch = 1; ch < 16; ++ch) x = x + *(const f32x4*)(q1 + (size_t)ch * 512 * D); }
            const v2u hh = *(const v2u*)(h2 + off), pp = *(const v2u*)(pw + off);
            f32x4 o; o.x = bflo(hh.x) + sigm(x.x) * bflo(pp.x); o.y = bfhi(hh.x) + sigm(x.y) * bfhi(pp.x); o.z = bflo(hh.y) + sigm(x.z) * bflo(pp.y); o.w = bfhi(hh.y) + sigm(x.w) * bfhi(pp.y);
            v2u ob; ob.x = pk2(o.x, o.y); ob.y = pk2(o.z, o.w); *(v2u*)(xb + off) = ob;
            if (outf) *(f32x4*)(outf + off) = o; }
    }
}

constexpr int N_PHASES = 22;
enum { OP_INPROJ = 0, OP_MIXA, OP_MIXB, OP_MIXC, OP_OUTPROJ, OP_LN1, OP_UP, OP_DOWN, OP_LN2, OP_GATE, OP_COMBINE };
enum { GK_F32 = 0, GK_BF16 = 1, GK_SQRELU = 2 };
__global__ void __launch_bounds__(NTHR, 2) mk_fwd(Args a_in) {
    extern __shared__ __attribute__((aligned(16))) unsigned char lds_raw[];
    LAS unsigned char* lds = (LAS unsigned char*)lds_raw;
    ArgsP kp = (ArgsP)__builtin_amdgcn_kernarg_segment_ptr();
    const int lo = a_in.ph_lo, hi = a_in.ph_hi;
#if MK_N_LAUNCHES == 1
    volatile LAS unsigned* xst = (volatile LAS unsigned*)(lds + LDS_CTL_OFF);
    if (threadIdx.x < 2) xst[threadIdx.x] = 0u;
    __syncthreads();
    XcdBarrier bar = xcd_barrier_post((unsigned*)(a_in.ws + WS_CTL) + 4096, xst);
#endif
#pragma unroll 1
    for (int p = lo; p < hi; ++p) {
      int nrep = 1;
      if (PROBE_MASK) { const int L_ = p <= 11 ? 0 : 1; const int q_ = p == 0 ? -1 : (L_ == 0 ? p - 1 : (p - 12 < 3 ? p - 12 : p - 11));
        int grp; if (p == 0) grp = 0; else if (q_ == OP_INPROJ || q_ == OP_UP) grp = 1; else if (q_ == OP_OUTPROJ || q_ == OP_DOWN || q_ == OP_GATE) grp = 2; else if (q_ == OP_LN1 || q_ == OP_LN2 || q_ == OP_COMBINE) grp = 3; else grp = (L_ == 0) ? 4 : 5;
        if ((PROBE_MASK >> grp) & 1) nrep = 2; }
      if (p == PROBE_P) nrep = 2;
#pragma unroll 1
      for (int rep = 0; rep < nrep; ++rep) {
        int pp = p; asm volatile("" : "+s"(pp));
        int tid = threadIdx.x; asm volatile("" : "+v"(tid));
        int bx = blockIdx.x; asm volatile("" : "+s"(bx));
        int G = gridDim.x; asm volatile("" : "+s"(G));
        ArgsP a = kp; asm volatile("" : "+s"(a));
#define MK_VCU ((G % 8 == 0) ? (bx % 8) * (G / 8) + bx / 8 : bx)
#define MK_WAVE (__builtin_amdgcn_readfirstlane(tid >> 6))
#define MK_GW (MK_VCU * NWAVES + MK_WAVE)
#define MK_NGW (G * NWAVES)
#define MK_LANE (tid & 63)
        unsigned char* ws = a->ws;
        if (pp == 0) {
phase_convert(a, lds, MK_GW, MK_NGW, MK_WAVE, MK_LANE); }
        else {
            const int L = pp <= 11 ? 0 : 1; const int q = L == 0 ? pp - 1 : (pp - 12 < 3 ? pp - 12 : pp - 11);
            bf16* xb = (bf16*)(ws + WS_XB); bf16* mixb = (bf16*)(ws + WS_MIX); bf16* hb = (bf16*)(ws + WS_H); bf16* h2b = (bf16*)(ws + WS_H2); bf16* pwb = (bf16*)(ws + WS_PW);
            bf16* projb = (bf16*)(ws + WS_PROJ); bf16* upb = (bf16*)(ws + WS_PROJ);
            float* part0 = (float*)(ws + WS_PART0); float* part1 = (float*)(ws + WS_PART1); float* gatesb = (float*)(ws + WS_GATES);
            const int P32 = ((((M / 256) * 8 * 32 + G - 1) / G) + 1) & ~1, P128 = ((((M / 256) * 8 * 128 + G - 1) / G) + 1) & ~1;
            if (q == OP_MIXA) { if (L == 0) phase_mixer_even(a, lds, MK_VCU, G, tid); else phase_mixer_odd(a, lds, MK_VCU, G, tid); }
            else if (q == OP_MIXB) { if (L == 0) phase_mixer_even_b(a, lds, MK_VCU, G, tid); else phase_mixer_odd_b(a, lds, MK_VCU, G, tid); }
            else if (q == OP_MIXC) { phase_mixer_even_c(a, lds, MK_VCU, G, tid); }

            else if (q == OP_LN1) phase_ln(part0, part1, 32, P32, xb, a->in[I_LN1G] + L * D, a->in[I_LN1B] + L * D, hb, MK_GW, MK_NGW, MK_LANE);
            else if (q == OP_LN2) phase_ln(part0, part1, 128, P128, hb, a->in[I_LN2G] + L * D, a->in[I_LN2B] + L * D, h2b, MK_GW, MK_NGW, MK_LANE);
            else if (q == OP_COMBINE) phase_combine(part0, part1, 32, P32, h2b, pwb, xb, L == 1 ? a->out + O_Y : nullptr, MK_GW, MK_NGW, MK_LANE);

            else {
                for (int sub = 0; sub < (q == OP_GATE ? 2 : 1); ++sub) {
                    const bf16* A; const bf16* Bt; int N, K, kind; void* out; float* gp = nullptr; int corder = bx;
                    if (q == OP_INPROJ) { A = xb; Bt = (const bf16*)(ws + (L == 0 ? WS_WINE : WS_WINO)); N = NPROJ_PAD; K = D; kind = GK_BF16; out = projb; gp = gatesb; }
                    else if (q == OP_OUTPROJ) { A = mixb; Bt = (const bf16*)(ws + (L == 0 ? WS_WOUTE : WS_WOUTO)); N = D; K = D; kind = GK_F32; out = part0; }
                    else if (q == OP_UP) { A = hb; Bt = (const bf16*)(ws + WS_WUP) + (size_t)L * D * FF; N = FF; K = D; kind = GK_SQRELU; out = upb; }
                    else if (q == OP_DOWN) { A = upb; Bt = (const bf16*)(ws + WS_WDOWN) + (size_t)L * D * FF; N = D; K = FF; kind = GK_F32; out = part0; }
                    else if (sub == 0) { A = h2b; Bt = (const bf16*)(ws + WS_WGATE) + (size_t)L * D * D; N = D; K = D; kind = GK_F32; out = part0; }
                    else { A = (const bf16*)(ws + WS_PB) + (size_t)L * M * PLE; Bt = (const bf16*)(ws + WS_WPLE) + (size_t)L * PLE * D; N = D; K = PLE; kind = GK_BF16; out = pwb; corder = (bx + 128) % G; }
                    pg8::Gemm g{A, Bt, M, N, K};
                    if (kind == GK_F32) { pg8::MainSplit SK; SK.init(K, MK_VCU); pg8::EpiF32 E{(float*)out, part1, N}; pg8::gemm_phase<pg8::EpiF32, pg8::MainSplit, true, true>(lds, g, SK, E, tid); }
                    else if (kind == GK_BF16) { pg8::StaticOrder S; S.init(M, N, K, G, corder); pg8::EpiBf16<0> E{(bf16*)out, N, gp, 24}; pg8::gemm_phase<pg8::EpiBf16<0>, pg8::StaticOrder, true, true>(lds, g, S, E, tid); }
                    else { pg8::StaticOrder S; S.init(M, N, K, G, corder); pg8::EpiBf16<1> E{(bf16*)out, N, nullptr, -1}; pg8::gemm_phase<pg8::EpiBf16<1>, pg8::StaticOrder, true, true>(lds, g, S, E, tid); }
                }
            }
        }
#if MK_N_LAUNCHES == 1
        if (p + 1 < hi || rep + 1 < nrep) { if (p == lo && rep == 0) cg::this_grid().sync(); else xcd_barrier(bar); }
#endif
      }
    }
}

extern "C" void kernel_launch(void* const* d_in, const int* in_sizes, int n_in, void* d_out, int out_size, void* d_ws, size_t ws_size, hipStream_t stream) {
    static int grid = 0;
    if (grid == 0) {
        if (n_in != 35 || (size_t)out_size != O_END || ws_size < WS_END) { fprintf(stderr, "kernel_launch: unexpected shapes: n_in %d out %d (want %zu) ws %zu (want %zu)\n", n_in, out_size, (size_t)O_END, ws_size, (size_t)WS_END); grid = -1; return; }
        int dev = 0, cus = 0, per_cu = 0;
        hipGetDevice(&dev); hipDeviceGetAttribute(&cus, hipDeviceAttributeMultiprocessorCount, dev);
        if (hipFuncSetAttribute((const void*)mk_fwd, hipFuncAttributeMaxDynamicSharedMemorySize, LDS_BYTES) != hipSuccess) { fprintf(stderr, "kernel_launch: hipFuncSetAttribute failed\n"); grid = -1; return; }
        if (hipOccupancyMaxActiveBlocksPerMultiprocessor(&per_cu, (const void*)mk_fwd, NTHR, LDS_BYTES) != hipSuccess || per_cu < 1) { fprintf(stderr, "kernel_launch: occupancy query says %d\n", per_cu); per_cu = 1; }
        (void)hipGetLastError();
        if (cus != 256) { fprintf(stderr, "kernel_launch: built for a 256-CU device (N = 2048 GEMM schedule), got %d\n", cus); grid = -1; return; }
        grid = cus * 1;
    }
    if (grid < 0) return;
    Args a{};
    for (int i = 0; i < 35; ++i) a.in[i] = (const float*)d_in[i];
    a.out = (float*)d_out; a.ws = (unsigned char*)d_ws;
#if MK_N_LAUNCHES == 1
    hipMemsetAsync((char*)d_ws + WS_CTL, 0, 1 * MiB, stream);
    a.ph_lo = 0; a.ph_hi = N_PHASES;
    void* args[] = {&a};
    hipError_t e = hipLaunchCooperativeKernel((const void*)mk_fwd, dim3(grid), dim3(NTHR), args, LDS_BYTES, stream);
    if (e != hipSuccess) fprintf(stderr, "cooperative launch failed: %s (grid %d)\n", hipGetErrorString(e), grid);
#else
    for (int p = 0; p < N_PHASES; ++p) {
        a.ph_lo = p; a.ph_hi = p + 1;
        hipLaunchKernelGGL(mk_fwd, dim3(grid), dim3(NTHR), LDS_BYTES, stream, a);
    }
#endif
}
```

```cpp
#include <hip/hip_runtime.h>
#include <hip/hip_cooperative_groups.h>
#include <cstdio>
#include <cstdint>
namespace cg = cooperative_groups;

#ifndef PROBE_MASK
#define PROBE_MASK 0
#endif
#define PROBE_P (-1)
#define PROBE_SUB 0
#ifndef MK_N_LAUNCHES
#define MK_N_LAUNCHES 1
#endif

namespace pg8 {
#define PG8_LAS __attribute__((address_space(3)))
typedef unsigned short bf16_t;
typedef short bf16x8 __attribute__((ext_vector_type(8)));
typedef float f32x4 __attribute__((ext_vector_type(4)));
typedef unsigned u32x4 __attribute__((ext_vector_type(4)));
constexpr int BM = 256, BK = 64, HALF = 128, HTB = HALF * BK * 2, STAGE_BYTES = 8 * HTB, NXCD = 8, WGM = 8;

__host__ __device__ __forceinline__ int lds_byte(int r, int c) { const int st = (r >> 4) * 2 + (c >> 5), rr = r & 15, cc = c & 31, ob = rr * 64 + cc * 2; return st * 1024 + (ob ^ (((ob >> 9) & 1) << 5)); }
__host__ __device__ __forceinline__ void stage_rc(int b, int& R, int& C) { const int st = b / 1024, sb = b % 1024, swz = sb ^ (((sb >> 9) & 1) << 5); R = (st >> 1) * 16 + swz / 64; C = (st & 1) * 32 + (swz % 64) / 2; }
__host__ __device__ __forceinline__ int perm32(int rho) { const int n = rho >> 4, i = rho & 15; return 8 * (i >> 2) + 4 * n + (i & 3); }

struct Unit { int pm, pn, kt0, nkt, dst; };
struct Gemm { const bf16_t* A; const bf16_t* Bt; int M, N, K; };

struct StaticOrder {
    int nM, nN, nwg, G, c, T;
    __host__ __device__ void init(int M, int N, int K, int G_, int c_) { nM = M / BM; nN = N / BM; nwg = nM * nN; G = G_; c = c_; T = K / BK; }
    __host__ __device__ bool next(int i, Unit& u) const {
        const long L = (long)i * G + c; if (L >= nwg) return false;
        int wgid = (int)L; { const int q = nwg / NXCD, r = nwg % NXCD, xcd = wgid % NXCD, off = wgid / NXCD; wgid = (xcd < r ? xcd * (q + 1) : r * (q + 1) + (xcd - r) * q) + off; }
        const int nig = WGM * nN, gid = wgid / nig, fm = gid * WGM, gsz = (nM - fm) < WGM ? (nM - fm) : WGM;
        u.pm = fm + ((wgid % nig) % gsz); u.pn = (wgid % nig) / gsz; u.kt0 = 0; u.nkt = T; u.dst = 0; return true;
    }
    __device__ __forceinline__ void a_ready(const Unit&) const {}
    __device__ __forceinline__ void done(const Unit&) const {}
};
struct StreamK {
    int nN, T, P, ntot, c;
    __host__ __device__ void init(int M, int N, int K, int G, int c_) { nN = N / BM; T = K / BK; ntot = (M / BM) * nN * T; P = (((ntot + G - 1) / G) + 1) & ~1; c = c_; }
    __host__ __device__ bool next(int i, Unit& u) const {
        int s = c * P; const int e = (s + P < ntot) ? s + P : ntot;
        for (int k = 0; ; ++k) { if (s >= e) return false; const int tile = s / T, kt0 = s - tile * T; const int n = (T - kt0 < e - s) ? T - kt0 : e - s;
            if (k == i) { u.pm = tile / nN; u.pn = tile - u.pm * nN; u.kt0 = kt0; u.nkt = n; u.dst = kt0 ? 1 : 0; return true; }
            s += n; }
    }
    __device__ __forceinline__ void a_ready(const Unit&) const {}
    __device__ __forceinline__ void done(const Unit&) const {}
};
struct MainSplit {
    int T, c;
    __host__ __device__ void init(int K, int c_) { T = K / BK; c = c_; }
    __host__ __device__ bool next(int i, Unit& u) const {
        if (i == 0) { u.pm = c >> 3; u.pn = c & 7; u.kt0 = 0; u.nkt = T; u.dst = 0; return true; }
        if (i == 1) { const int lt = c >> 4, j = c & 15; u.pm = 32 + (lt >> 3); u.pn = lt & 7; u.nkt = T >> 4; u.kt0 = j * u.nkt; u.dst = 1 + j; return true; }
        return false;
    }
    __device__ __forceinline__ void a_ready(const Unit&) const {}
    __device__ __forceinline__ void done(const Unit&) const {}
};
__host__ __device__ __forceinline__ bool split_tile(int tile, int T, int P) { return (tile * T) / P != ((tile + 1) * T - 1) / P; }

__device__ __forceinline__ unsigned cvt_pk_bf16(float lo, float hi) { unsigned r; asm volatile("v_cvt_pk_bf16_f32 %0, %1, %2" : "=v"(r) : "v"(lo), "v"(hi)); return r; }

__device__ __forceinline__ float pg_bflo(unsigned w) { return __builtin_bit_cast(float, w << 16); }
__device__ __forceinline__ float pg_bfhi(unsigned w) { return __builtin_bit_cast(float, w & 0xffff0000u); }
__device__ __forceinline__ void store_chunk(const f32x4 (&acc)[2][2][4][2], const Unit& u, float* C1, int ldc, int wr, int wc, int fr, int fq) {
    const int row0 = u.pm * BM + wr * 64 + fr, col0 = u.pn * BM + wc * 32 + 8 * fq; float* Cb = C1 + ((long)(u.dst - 1) * 512 - 8192) * (long)ldc;
#pragma unroll
    for (int ai = 0; ai < 2; ++ai)
#pragma unroll
        for (int m = 0; m < 4; ++m) { float* rowp = Cb + (size_t)(row0 + ai * HALF + m * 16) * ldc + col0;
#pragma unroll
            for (int bj = 0; bj < 2; ++bj) { *(f32x4*)(rowp + bj * HALF) = acc[ai][bj][m][0]; *(f32x4*)(rowp + bj * HALF + 4) = acc[ai][bj][m][1]; } }
}
struct EpiLnStat {
    static constexpr bool PERM = true, AFTER_DRAIN = false;
    bf16_t* VB; float* ST; const bf16_t* resid; float* C1; int ldc; int mrows; float alpha;
    __device__ __forceinline__ void operator()(const f32x4 (&acc)[2][2][4][2], const Unit& u, int wr, int wc, int fr, int fq) const {
        if (u.dst) { store_chunk(acc, u, C1, ldc, wr, wc, fr, fq); return; }
        const int row0 = u.pm * BM + wr * 64 + fr, col0 = u.pn * BM + wc * 32 + 8 * fq;
#pragma unroll
        for (int ai = 0; ai < 2; ++ai)
#pragma unroll
            for (int m = 0; m < 4; ++m) { const int row = row0 + ai * HALF + m * 16; float s = 0.f, ss = 0.f;
#pragma unroll
                for (int bj = 0; bj < 2; ++bj) { const size_t off = (size_t)row * ldc + col0 + bj * HALF; const u32x4 r = *(const u32x4*)(resid + off);
                    f32x4 v0 = acc[ai][bj][m][0], v1 = acc[ai][bj][m][1];
                    v0[0] += alpha * pg_bflo(r.x); v0[1] += alpha * pg_bfhi(r.x); v0[2] += alpha * pg_bflo(r.y); v0[3] += alpha * pg_bfhi(r.y);
                    v1[0] += alpha * pg_bflo(r.z); v1[1] += alpha * pg_bfhi(r.z); v1[2] += alpha * pg_bflo(r.w); v1[3] += alpha * pg_bfhi(r.w);
                    s += ((v0[0] + v0[1]) + (v0[2] + v0[3])) + ((v1[0] + v1[1]) + (v1[2] + v1[3]));
                    ss += ((v0[0] * v0[0] + v0[1] * v0[1]) + (v0[2] * v0[2] + v0[3] * v0[3])) + ((v1[0] * v1[0] + v1[1] * v1[1]) + (v1[2] * v1[2] + v1[3] * v1[3]));
                    u32x4 w; w.x = cvt_pk_bf16(v0[0], v0[1]); w.y = cvt_pk_bf16(v0[2], v0[3]); w.z = cvt_pk_bf16(v1[0], v1[1]); w.w = cvt_pk_bf16(v1[2], v1[3]);
                    *(u32x4*)(VB + off) = w; }
                s += __shfl_xor(s, 16); s += __shfl_xor(s, 32); ss += __shfl_xor(ss, 16); ss += __shfl_xor(ss, 32);
                if (fq == 0) { float* sp = ST + (((size_t)u.pn * mrows + row) * 4 + wc) * 2; sp[0] = s; sp[1] = ss; } }
    }
};
struct EpiCombine {
    static constexpr bool PERM = true, AFTER_DRAIN = false;
    const bf16_t* h2; const bf16_t* pw; bf16_t* xb; float* outf; float* C1; int ldc;
    __device__ __forceinline__ void operator()(const f32x4 (&acc)[2][2][4][2], const Unit& u, int wr, int wc, int fr, int fq) const {
        if (u.dst) { store_chunk(acc, u, C1, ldc, wr, wc, fr, fq); return; }
        const int row0 = u.pm * BM + wr * 64 + fr, col0 = u.pn * BM + wc * 32 + 8 * fq;
#pragma unroll
        for (int ai = 0; ai < 2; ++ai)
#pragma unroll
            for (int m = 0; m < 4; ++m) { const int row = row0 + ai * HALF + m * 16;
#pragma unroll
                for (int bj = 0; bj < 2; ++bj) { const size_t off = (size_t)row * ldc + col0 + bj * HALF; const u32x4 hh = *(const u32x4*)(h2 + off), pp = *(const u32x4*)(pw + off);
                    const f32x4 a0 = acc[ai][bj][m][0], a1 = acc[ai][bj][m][1]; f32x4 o0, o1;
                    o0[0] = pg_bflo(hh.x) + pg_bflo(pp.x) / (1.f + __expf(-a0[0])); o0[1] = pg_bfhi(hh.x) + pg_bfhi(pp.x) / (1.f + __expf(-a0[1]));
                    o0[2] = pg_bflo(hh.y) + pg_bflo(pp.y) / (1.f + __expf(-a0[2])); o0[3] = pg_bfhi(hh.y) + pg_bfhi(pp.y) / (1.f + __expf(-a0[3]));
                    o1[0] = pg_bflo(hh.z) + pg_bflo(pp.z) / (1.f + __expf(-a1[0])); o1[1] = pg_bfhi(hh.z) + pg_bfhi(pp.z) / (1.f + __expf(-a1[1]));
                    o1[2] = pg_bflo(hh.w) + pg_bflo(pp.w) / (1.f + __expf(-a1[2])); o1[3] = pg_bfhi(hh.w) + pg_bfhi(pp.w) / (1.f + __expf(-a1[3]));
                    u32x4 w; w.x = cvt_pk_bf16(o0[0], o0[1]); w.y = cvt_pk_bf16(o0[2], o0[3]); w.z = cvt_pk_bf16(o1[0], o1[1]); w.w = cvt_pk_bf16(o1[2], o1[3]);
                    *(u32x4*)(xb + off) = w;
                    if (outf) { *(f32x4*)(outf + off) = o0; *(f32x4*)(outf + off + 4) = o1; } } }
    }
};
template <int ACT> struct EpiBf16 {
    static constexpr bool PERM = true, AFTER_DRAIN = false;
    bf16_t* O; int ldc; float* gates; int gate_pn;
    __device__ __forceinline__ void operator()(const f32x4 (&acc)[2][2][4][2], const Unit& u, int wr, int wc, int fr, int fq) const {
        const int row0 = u.pm * BM + wr * 64 + fr; const int col0 = u.pn * BM + wc * 32 + 8 * fq;
        const bool gt = (gates != nullptr) && (u.pn == gate_pn) && (wc == 0) && (fq < 2);
#pragma unroll
        for (int ai = 0; ai < 2; ++ai)
#pragma unroll
            for (int m = 0; m < 4; ++m) { const int row = row0 + ai * HALF + m * 16; bf16_t* rowp = O + (size_t)row * ldc + col0;
#pragma unroll
                for (int bj = 0; bj < 2; ++bj) { f32x4 v0 = acc[ai][bj][m][0], v1 = acc[ai][bj][m][1];
                    if (ACT == 1) {
#pragma unroll
                        for (int j = 0; j < 4; ++j) { const float a = fmaxf(v0[j], 0.f), b = fmaxf(v1[j], 0.f); v0[j] = a * a; v1[j] = b * b; } }
                    u32x4 w; w.x = cvt_pk_bf16(v0[0], v0[1]); w.y = cvt_pk_bf16(v0[2], v0[3]); w.z = cvt_pk_bf16(v1[0], v1[1]); w.w = cvt_pk_bf16(v1[2], v1[3]);
                    *(u32x4*)(rowp + bj * HALF) = w; }
                if (gt) { float* gp = gates + (size_t)row * 16 + 8 * fq; *(f32x4*)gp = acc[ai][0][m][0]; *(f32x4*)(gp + 4) = acc[ai][0][m][1]; } }
    }
};

template <class Epi, class Sched, bool ALIGN_EPI = false, bool SP2 = false>
__device__ __forceinline__ void gemm_phase(PG8_LAS unsigned char* lds, const Gemm g, const Sched& S, const Epi& E, const int tid) {
    const int wid = __builtin_amdgcn_readfirstlane(tid >> 6), lane = tid & 63, wr = wid >> 2, wc = wid & 3, fr = lane & 15, fq = lane >> 4;
    const int K = g.K;
    unsigned voffA[2], voffB[2];
#pragma unroll
    for (int i = 0; i < 2; ++i) { int R, C; stage_rc(tid * 16 + i * 8192, R, C); const int Rb = Epi::PERM ? ((R & ~31) + perm32(R & 31)) : R;
        voffA[i] = (unsigned)(R * K + C) * 2u; voffB[i] = (unsigned)(Rb * K + C) * 2u; }
    const size_t kstep = (size_t)(BK * 2);
    const size_t hstep = (size_t)HALF * K * 2;
    const size_t tstep = 2 * hstep;
    const unsigned ldsw = (unsigned)wid * 1024u;
    const int aoff = lds_byte(wr * 64 + fr, fq * 8), boff = lds_byte(wc * 32 + fr, fq * 8);
#define PG8_SA(b, h) (((b) * 2 + (h)) * HTB)
#define PG8_SB(b, h) ((4 + (b) * 2 + (h)) * HTB)
#define PG8_STAGE(bufoff, gbase, voff) do { _Pragma("unroll") for (int _i = 0; _i < 2; ++_i) \
        __builtin_amdgcn_global_load_lds((const unsigned*)((const char*)(gbase) + (voff)[_i]), (PG8_LAS unsigned*)(lds + (bufoff) + ldsw + _i * 8192), 16, 0, 0); } while (0)
#define PG8_LDA(dst, b, h) do { _Pragma("unroll") for (int m = 0; m < 4; ++m) _Pragma("unroll") for (int k = 0; k < 2; ++k) dst[m][k] = *(const PG8_LAS bf16x8*)(lds + PG8_SA(b, h) + aoff + m * 2048 + k * 1024); } while (0)
#define PG8_LDB(dst, b, h) do { _Pragma("unroll") for (int n = 0; n < 2; ++n) _Pragma("unroll") for (int k = 0; k < 2; ++k) dst[n][k] = *(const PG8_LAS bf16x8*)(lds + PG8_SB(b, h) + boff + n * 2048 + k * 1024); } while (0)
#define PG8_MMA(ai, bj, At, Bt) do { __builtin_amdgcn_s_setprio(1); _Pragma("unroll") for (int m = 0; m < 4; ++m) _Pragma("unroll") for (int n = 0; n < 2; ++n) _Pragma("unroll") for (int k = 0; k < 2; ++k) \
        acc[ai][bj][m][n] = __builtin_amdgcn_mfma_f32_16x16x32_bf16(Bt[n][k], At[m][k], acc[ai][bj][m][n], 0, 0, 0); __builtin_amdgcn_s_setprio(0); } while (0)
#define PG8_WAIT_V(n) asm volatile("s_waitcnt vmcnt(" #n ")" ::: "memory")
#define PG8_WAIT_L(n) asm volatile("s_waitcnt lgkmcnt(" #n ")" ::: "memory")
#define PG8_BAR __builtin_amdgcn_s_barrier()
#define PG8_SCHED __builtin_amdgcn_sched_barrier(0)
    Unit cur, nxt; int ui = 0;
    if (!S.next(0, cur)) return;
    f32x4 acc[2][2][4][2];
#pragma unroll
    for (int a = 0; a < 2; ++a)
#pragma unroll
        for (int b = 0; b < 2; ++b)
#pragma unroll
            for (int m = 0; m < 4; ++m)
#pragma unroll
                for (int n = 0; n < 2; ++n) acc[a][b][m][n] = (f32x4){0.f, 0.f, 0.f, 0.f};
    bf16x8 At[4][2], B0[2][2], B1[2][2];
    const char* cA = (const char*)g.A + (size_t)cur.pm * tstep + (size_t)cur.kt0 * kstep; const char* cB = (const char*)g.Bt + (size_t)cur.pn * tstep + (size_t)cur.kt0 * kstep;
    S.a_ready(cur);
    if constexpr (SP2) {
        PG8_STAGE(PG8_SB(0, 0), cB, voffB); PG8_STAGE(PG8_SB(0, 1), cB + hstep, voffB); PG8_STAGE(PG8_SA(0, 0), cA, voffA); PG8_STAGE(PG8_SA(0, 1), cA + hstep, voffA);
        if (wr == 1) PG8_BAR;
        PG8_WAIT_V(2); PG8_BAR;
        PG8_STAGE(PG8_SB(1, 0), cB + kstep, voffB); PG8_STAGE(PG8_SA(1, 0), cA + kstep, voffA); PG8_STAGE(PG8_SB(1, 1), cB + hstep + kstep, voffB);
        PG8_WAIT_V(6); PG8_BAR;
    } else {
        PG8_STAGE(PG8_SB(0, 0), cB, voffB); PG8_STAGE(PG8_SA(0, 0), cA, voffA); PG8_STAGE(PG8_SB(0, 1), cB + hstep, voffB); PG8_STAGE(PG8_SA(0, 1), cA + hstep, voffA);
        if (wr == 1) PG8_BAR;
        PG8_WAIT_V(4); PG8_BAR;
        PG8_STAGE(PG8_SB(1, 0), cB + kstep, voffB); PG8_STAGE(PG8_SA(1, 0), cA + kstep, voffA); PG8_STAGE(PG8_SB(1, 1), cB + hstep + kstep, voffB);
        PG8_WAIT_V(6); PG8_BAR;
    }
    for (;;) {
        const bool has_next = S.next(ui + 1, nxt);
        const char* nA = has_next ? (const char*)g.A + (size_t)nxt.pm * tstep + (size_t)nxt.kt0 * kstep : cA; const char* nB = has_next ? (const char*)g.Bt + (size_t)nxt.pn * tstep + (size_t)nxt.kt0 * kstep : cB;
        const int nt = cur.nkt;
        for (int t = 0; t < nt; t += 2) {
            const bool last = (t == nt - 2);
            const char* a1 = cA + (size_t)(t + 1) * kstep;
            const char* a2 = last ? nA : cA + (size_t)(t + 2) * kstep; const char* b2 = last ? nB : cB + (size_t)(t + 2) * kstep;
            const char* a3 = a2 + kstep; const char* b3 = b2 + kstep;
            if (last && has_next) S.a_ready(nxt);
            if constexpr (SP2) {
            PG8_LDB(B0, 0, 0); PG8_LDB(B1, 0, 1); PG8_SCHED; PG8_LDA(At, 0, 0); PG8_STAGE(PG8_SA(1, 1), a1 + hstep, voffA);
            PG8_WAIT_V(8); PG8_WAIT_L(0); PG8_BAR; PG8_MMA(0, 0, At, B0); PG8_MMA(0, 1, At, B1); PG8_BAR; PG8_SCHED;
            PG8_LDA(At, 0, 1); PG8_STAGE(PG8_SB(0, 0), b2, voffB); PG8_STAGE(PG8_SB(0, 1), b2 + hstep, voffB); PG8_STAGE(PG8_SA(0, 0), a2, voffA);
            PG8_WAIT_V(8); PG8_WAIT_L(0); PG8_BAR; PG8_MMA(1, 0, At, B0); PG8_MMA(1, 1, At, B1); PG8_BAR; PG8_SCHED;
            PG8_LDB(B0, 1, 0); PG8_LDB(B1, 1, 1); PG8_SCHED; PG8_LDA(At, 1, 0); PG8_STAGE(PG8_SA(0, 1), a2 + hstep, voffA);
            PG8_WAIT_V(8); PG8_WAIT_L(0); PG8_BAR; PG8_MMA(0, 0, At, B0); PG8_MMA(0, 1, At, B1); PG8_BAR; PG8_SCHED;
            PG8_LDA(At, 1, 1); PG8_STAGE(PG8_SB(1, 0), b3, voffB); PG8_STAGE(PG8_SB(1, 1), b3 + hstep, voffB); PG8_STAGE(PG8_SA(1, 0), a3, voffA);
            PG8_WAIT_V(8); PG8_WAIT_L(0); PG8_BAR; PG8_MMA(1, 0, At, B0); PG8_MMA(1, 1, At, B1); PG8_BAR; PG8_SCHED;
            } else {
            PG8_LDB(B0, 0, 0); PG8_SCHED; PG8_LDA(At, 0, 0); PG8_STAGE(PG8_SA(1, 1), a1 + hstep, voffA);
            PG8_WAIT_L(8); PG8_BAR; PG8_WAIT_L(0); PG8_MMA(0, 0, At, B0); PG8_BAR; PG8_SCHED;
            PG8_LDB(B1, 0, 1); PG8_STAGE(PG8_SB(0, 0), b2, voffB);
            PG8_BAR; PG8_WAIT_L(0); PG8_MMA(0, 1, At, B1); PG8_BAR;
            PG8_LDA(At, 0, 1); PG8_STAGE(PG8_SA(0, 0), a2, voffA);
            PG8_BAR; PG8_WAIT_L(0); PG8_MMA(1, 0, At, B0); PG8_BAR; PG8_SCHED;
            PG8_STAGE(PG8_SB(0, 1), b2 + hstep, voffB);
            PG8_WAIT_V(6); PG8_BAR; PG8_MMA(1, 1, At, B1); PG8_BAR;
            PG8_LDB(B0, 1, 0); PG8_SCHED; PG8_LDA(At, 1, 0); PG8_STAGE(PG8_SA(0, 1), a2 + hstep, voffA);
            PG8_WAIT_L(8); PG8_BAR; PG8_WAIT_L(0); PG8_MMA(0, 0, At, B0); PG8_BAR; PG8_SCHED;
            PG8_LDB(B1, 1, 1); PG8_STAGE(PG8_SB(1, 0), b3, voffB);
            PG8_BAR; PG8_WAIT_L(0); PG8_MMA(0, 1, At, B1); PG8_BAR;
            PG8_LDA(At, 1, 1); PG8_STAGE(PG8_SA(1, 0), a3, voffA);
            PG8_BAR; PG8_WAIT_L(0); PG8_MMA(1, 0, At, B0); PG8_BAR; PG8_SCHED;
            PG8_STAGE(PG8_SB(1, 1), b3 + hstep, voffB);
            PG8_WAIT_V(6); PG8_BAR; PG8_MMA(1, 1, At, B1); PG8_BAR;
            }
        }
        if constexpr (ALIGN_EPI) { if (wr == 0) PG8_BAR; }
        E(acc, cur, wr, wc, fr, fq); S.done(cur);
        if (!has_next) break;
#pragma unroll
        for (int a = 0; a < 2; ++a)
#pragma unroll
            for (int b = 0; b < 2; ++b)
#pragma unroll
                for (int m = 0; m < 4; ++m)
#pragma unroll
                    for (int n = 0; n < 2; ++n) acc[a][b][m][n] = (f32x4){0.f, 0.f, 0.f, 0.f};
        cur = nxt; cA = nA; cB = nB; ++ui;
        if constexpr (ALIGN_EPI) { if (wr == 1) PG8_BAR; }
    }
    PG8_WAIT_V(0);
    if constexpr (!ALIGN_EPI) { if (wr == 0) PG8_BAR; }
    PG8_BAR;
#undef PG8_SA
#undef PG8_SB
#undef PG8_STAGE
#undef PG8_LDA
#undef PG8_LDB
#undef PG8_MMA
#undef PG8_WAIT_V
#undef PG8_WAIT_L
#undef PG8_BAR
#undef PG8_SCHED
}
}

constexpr int NWAVES = 8, NTHR = 512;
constexpr int D = 2048, FF = 8192, PLE = 256;
constexpr int TP = 2048, BP = 4, TS = 4, BS = 128;
constexpr int MP = BP * TP, MS = BS * TS, M = MP + MS;
constexpr int NPROJ = 6160, NPROJ_PAD = 6400;
constexpr int NH = 8;
constexpr float LN_EPS = 1e-5f, RMS_EPS = 1e-6f;
constexpr float DN_ALPHA = 1.41421356237f;

constexpr size_t MiB = 1u << 20;
constexpr size_t WS_CTL = 0;
constexpr size_t WS_WINE = 1 * MiB;
constexpr size_t WS_WOUTE = WS_WINE + 25 * MiB;
constexpr size_t WS_WINO = WS_WOUTE + 8 * MiB;
constexpr size_t WS_WOUTO = WS_WINO + 25 * MiB;
constexpr size_t WS_WUP = WS_WOUTO + 8 * MiB;
constexpr size_t WS_WDOWN = WS_WUP + 64 * MiB;
constexpr size_t WS_WPLE = WS_WDOWN + 64 * MiB;
constexpr size_t WS_WGATE = WS_WPLE + 2 * MiB;
constexpr size_t WS_XB = WS_WGATE + 16 * MiB;
constexpr size_t WS_MIX = WS_XB + 34 * MiB;
constexpr size_t WS_H = WS_MIX + 34 * MiB;
constexpr size_t WS_H2 = WS_H + 34 * MiB;
constexpr size_t WS_PW = WS_H2 + 34 * MiB;
constexpr size_t WS_PB = WS_PW + 34 * MiB;
constexpr size_t WS_GATES = WS_PB + 9 * MiB;
constexpr size_t WS_PROJ = WS_GATES + 1 * MiB;
constexpr size_t WS_PART0 = WS_PROJ + 136 * MiB;
constexpr size_t WS_PART1 = WS_PART0 + 68 * MiB;
constexpr size_t WS_LRUW = WS_PART1 + 68 * MiB;
constexpr size_t WS_END = WS_LRUW + 1 * MiB;
constexpr size_t WS_DG = WS_PART0;
constexpr size_t WS_DB = WS_PART0 + 32 * MiB;
constexpr size_t WS_DS = WS_PART0 + 64 * MiB;
constexpr size_t WS_DQ = WS_PART0 + 96 * MiB;
constexpr size_t WS_DO = WS_PART0 + 112 * MiB;
constexpr size_t WS_DD = WS_PART0 + 128 * MiB;
constexpr size_t WS_DF = WS_PART0 + 129 * MiB;
constexpr size_t WS_MC = WS_PART0;
constexpr size_t WS_MN = WS_PART0 + 64 * MiB;
constexpr size_t WS_MM = WS_PART0 + 65 * MiB;
constexpr size_t WS_LRU_HL = WS_H;
constexpr size_t WS_LRU_P = WS_H + 16 * MiB;
constexpr size_t WS_LRU_END = WS_H + 32 * MiB;

constexpr size_t O_Y = 0;
constexpr size_t O_CONVP = (size_t)M * D;
constexpr size_t O_DELTAP = O_CONVP + (size_t)BP * 3 * 4096;
constexpr size_t O_LRUP = O_DELTAP + (size_t)BP * 8 * 128 * 128;
constexpr size_t O_MCP = O_LRUP + (size_t)BP * 1024;
constexpr size_t O_MNP = O_MCP + (size_t)BP * 8 * 256 * 128;
constexpr size_t O_MMP = O_MNP + (size_t)BP * 8 * 128;
constexpr size_t O_CONVS = O_MMP + (size_t)BP * 8;
constexpr size_t O_DELTAS = O_CONVS + (size_t)BS * 3 * 4096;
constexpr size_t O_LRUS = O_DELTAS + (size_t)BS * 8 * 128 * 128;
constexpr size_t O_MCS = O_LRUS + (size_t)BS * 1024;
constexpr size_t O_MNS = O_MCS + (size_t)BS * 8 * 256 * 128;
constexpr size_t O_MMS = O_MNS + (size_t)BS * 8 * 128;
constexpr size_t O_END = O_MMS + (size_t)BS * 8;

constexpr int LDS_BYTES = 147456;
constexpr int LDS_CTL_OFF = 131072;

#define LAS __attribute__((address_space(3)))
typedef unsigned short bf16;
typedef unsigned v4u __attribute__((ext_vector_type(4)));
typedef unsigned v2u __attribute__((ext_vector_type(2)));
typedef float f32x4 __attribute__((ext_vector_type(4)));
#define LDS_WAIT() asm volatile("s_waitcnt lgkmcnt(0)" ::: "memory")
__device__ __forceinline__ unsigned f2bf(float f) { unsigned u = __builtin_bit_cast(unsigned, f); return (u + 0x7fffu + ((u >> 16) & 1u)) >> 16; }
__device__ __forceinline__ unsigned pk2(float lo, float hi) { return f2bf(lo) | (f2bf(hi) << 16); }
__device__ __forceinline__ float bf2f(unsigned short b) { return __builtin_bit_cast(float, ((unsigned)b) << 16); }
__device__ __forceinline__ float bflo(unsigned w) { return __builtin_bit_cast(float, w << 16); }
__device__ __forceinline__ float bfhi(unsigned w) { return __builtin_bit_cast(float, w & 0xffff0000u); }
__device__ __forceinline__ float sigm(float x) { return 1.f / (1.f + expf(-x)); }
__device__ __forceinline__ float siluf(float x) { return x * sigm(x); }
__device__ __forceinline__ float softplusf(float x) { return fmaxf(x, 0.f) + log1pf(expf(-fabsf(x))); }
__device__ __forceinline__ float logsigf(float x) { return -softplusf(-x); }
__device__ __forceinline__ float gelu_tanh(float x) { const float u = 0.7978845608028654f * (x + 0.044715f * x * x * x); return 0.5f * x * (1.f + tanhf(u)); }
__device__ __forceinline__ float wave_sum(float v) {
#pragma unroll
    for (int o = 1; o < 64; o <<= 1) v += __shfl_xor(v, o);
    return v;
}

#define XB_TMO      128
#define XB_XCNT(j)  (256  + 64 * (j))
#define XB_XSUB(j)  (1280 + 64 * (j))
#define XB_XGEN(j)  (2304 + 64 * (j))
#define XB_TOP      3328
#define XB_TOPGEN   3392
#define XCD_BAR_WORDS 3456
#define XB_SPIN_CAP (1u << 22)
__device__ __forceinline__ unsigned xb_ld(unsigned* p)              { return __hip_atomic_load(p, __ATOMIC_RELAXED, __HIP_MEMORY_SCOPE_AGENT); }
__device__ __forceinline__ unsigned xb_add(unsigned* p, unsigned v) { return __hip_atomic_fetch_add(p, v, __ATOMIC_RELAXED, __HIP_MEMORY_SCOPE_AGENT); }
__device__ __forceinline__ unsigned xb_xcc_id() { return (unsigned)__builtin_amdgcn_s_getreg((3 << 11) | 20) & 0xFu; }
#define XB_SPIN(cond, bar) do { unsigned _sp = 0; while (cond) { __builtin_amdgcn_s_sleep(1); \
    if ((++_sp & 255u) == 0u) { if (xb_ld(&(bar)[XB_TMO])) break; if (_sp > XB_SPIN_CAP) { atomicAdd(&(bar)[XB_TMO], 1u); break; } } } } while (0)
struct XcdBarrier { unsigned* bar; unsigned x; volatile LAS unsigned* st; };
__device__ __forceinline__ XcdBarrier xcd_barrier_post(unsigned* bar, volatile LAS unsigned* st) {
    XcdBarrier b; b.bar = bar; b.x = xb_xcc_id(); b.st = st;
    if (threadIdx.x == 0) (void)xb_add(&bar[XB_XCNT(b.x)], 1u);
    return b;
}
__device__ __forceinline__ void xcd_barrier_complete(unsigned* bar, unsigned x, unsigned& nloc, unsigned& nx) {
    const unsigned G = gridDim.x * gridDim.y * gridDim.z;
    unsigned sum, cnt, mine, sp = 0u;
    for (;;) {
        sum = 0u; cnt = 0u; mine = 0u;
#pragma unroll
        for (unsigned j = 0; j < 16; ++j) { const unsigned c = xb_ld(&bar[XB_XCNT(j)]); sum += c; cnt += (c > 0u) ? 1u : 0u; mine = (j == x) ? c : mine; }
        if (sum == G) break;
        __builtin_amdgcn_s_sleep(1);
        if ((++sp & 255u) == 0u) { if (xb_ld(&bar[XB_TMO])) break; if (sp > XB_SPIN_CAP) { atomicAdd(&bar[XB_TMO], 1u); break; } }
    }
    nloc = mine > 0u ? mine : 1u; nx = cnt > 0u ? cnt : 1u;
}
__device__ __forceinline__ void xcd_barrier(const XcdBarrier& b) {
    asm volatile("s_waitcnt vmcnt(0)" ::: "memory");
    __syncthreads();
    if (threadIdx.x == 0) {
        unsigned* bar = b.bar;
        __builtin_amdgcn_s_waitcnt(0);
        unsigned nloc = b.st[0], nx = b.st[1];
        if (nloc == 0u) { xcd_barrier_complete(bar, b.x, nloc, nx); b.st[0] = nloc; b.st[1] = nx; }
        const unsigned old = xb_add(&bar[XB_XSUB(b.x)], 1u);
        const unsigned gen = old / nloc;
        if (old + 1u == (gen + 1u) * nloc) {
            __builtin_amdgcn_fence(__ATOMIC_RELEASE, "agent");
            asm volatile("s_waitcnt vmcnt(0)" ::: "memory");
            const unsigned og = xb_add(&bar[XB_TOP], 1u);
            const unsigned tg = og / nx;
            if (og + 1u == (tg + 1u) * nx) xb_add(&bar[XB_TOPGEN], 1u);
            else XB_SPIN(xb_ld(&bar[XB_TOPGEN]) == tg, bar);
            __builtin_amdgcn_fence(__ATOMIC_ACQUIRE, "agent");
            xb_add(&bar[XB_XGEN(b.x)], 1u);
            asm volatile("s_waitcnt vmcnt(0)" ::: "memory");
        } else {
            XB_SPIN(xb_ld(&bar[XB_XGEN(b.x)]) == gen, bar);
            __builtin_amdgcn_fence(__ATOMIC_ACQUIRE, "agent");
            asm volatile("s_waitcnt vmcnt(0)" ::: "memory");
        }
    }
    __syncthreads();
}

struct Args { const float* in[35]; float* out; unsigned char* ws; int ph_lo, ph_hi; };
typedef const __attribute__((address_space(4))) Args* ArgsP;
enum { I_XP = 0, I_XS, I_PP, I_PS, I_SCONV, I_SDELTA, I_SLRU, I_SMC, I_SMN, I_SMM, I_WINE, I_WCONV, I_BCONV, I_ALOG, I_DTB, I_DNORM, I_LWR, I_LBR, I_LWI, I_LBI, I_LLAM, I_WOUTE,
       I_WINO, I_BIG, I_BFG, I_MNORM, I_WOUTO, I_LN1G, I_LN1B, I_LN2G, I_LN2B, I_WUP, I_WDOWN, I_WPLE, I_WGATE };

__device__ __forceinline__ void p0_transpose_item(const float* W, int K, int N, int Npad, bf16* WT, LAS float* scr, int item, int lane) {
    const int nblk = Npad / 32, kb = item / nblk, nb = item % nblk, k0 = 64 * kb, n0 = 32 * nb;
    const int r = lane >> 3, c4 = lane & 7;
    const bool ok = (n0 + 4 * c4) < N;
    f32x4 v[8];
#pragma unroll
    for (int i = 0; i < 8; ++i) v[i] = ok ? __builtin_nontemporal_load((const f32x4*)(W + (size_t)(k0 + 8 * i + r) * N + n0 + 4 * c4)) : (f32x4){0.f, 0.f, 0.f, 0.f};
#pragma unroll
    for (int i = 0; i < 8; ++i) { LAS float* d = scr + (8 * i + r) * 33 + 4 * c4; d[0] = v[i].x; d[1] = v[i].y; d[2] = v[i].z; d[3] = v[i].w; }
    LDS_WAIT(); asm volatile("" ::: "memory");
    const int c = lane & 7;
#pragma unroll
    for (int j = 0; j < 4; ++j) { const int n = (lane >> 3) + 8 * j; const LAS float* s = scr + (8 * c) * 33 + n;
        v4u o; o.x = pk2(s[0 * 33], s[1 * 33]); o.y = pk2(s[2 * 33], s[3 * 33]); o.z = pk2(s[4 * 33], s[5 * 33]); o.w = pk2(s[6 * 33], s[7 * 33]);
        *(v4u*)(WT + (size_t)(n0 + n) * K + k0 + 8 * c) = o; }
    LDS_WAIT(); asm volatile("" ::: "memory");
}
__device__ __forceinline__ void row_to_bf16(const float* src, bf16* dst, int n, int lane) {
    for (int j = 0; j < n / 256; ++j) { const f32x4 v = *(const f32x4*)(src + j * 256 + lane * 4); v2u o; o.x = pk2(v.x, v.y); o.y = pk2(v.z, v.w); *(v2u*)(dst + j * 256 + lane * 4) = o; }
}

namespace cv { constexpr int I_IN = (D / 64) * (NPROJ_PAD / 32), I_SQ = (D / 64) * (D / 32), I_UP = (D / 64) * (FF / 32), I_DN = (FF / 64) * (D / 32), I_PL = (PLE / 64) * (D / 32);
               constexpr int N_FIRST = I_IN + 128, N_REST = I_IN + 2 * I_SQ + 2 * I_UP + 2 * I_DN + 2 * I_PL + 2 * I_SQ; }
__device__ __forceinline__ void convert_first_item(ArgsP a, LAS float* scr, int r, int lane) {
    unsigned char* ws = a->ws;
    if (r < cv::I_IN) { p0_transpose_item(a->in[I_WINE], D, NPROJ, NPROJ_PAD, (bf16*)(ws + WS_WINE), scr, r, lane); return; } r -= cv::I_IN;
    { const int mat = r / 64, blk = (r / 8) & 7; p0_transpose_item(a->in[mat == 0 ? I_LWR : I_LWI] + (size_t)blk * 16384, 128, 128, 128, (bf16*)(ws + WS_LRUW) + (size_t)(mat * 8 + blk) * 16384, scr, r % 8, lane); }
}
__device__ __forceinline__ void convert_rest_item(ArgsP a, LAS float* scr, int r, int lane) {
    using namespace cv; unsigned char* ws = a->ws;
    if (r < I_SQ) { p0_transpose_item(a->in[I_WOUTE], D, D, D, (bf16*)(ws + WS_WOUTE), scr, r, lane); return; } r -= I_SQ;
    if (r < I_UP) { p0_transpose_item(a->in[I_WUP], D, FF, FF, (bf16*)(ws + WS_WUP), scr, r, lane); return; } r -= I_UP;
    if (r < I_DN) { p0_transpose_item(a->in[I_WDOWN], FF, D, D, (bf16*)(ws + WS_WDOWN), scr, r, lane); return; } r -= I_DN;
    if (r < I_PL) { p0_transpose_item(a->in[I_WPLE], PLE, D, D, (bf16*)(ws + WS_WPLE), scr, r, lane); return; } r -= I_PL;
    if (r < I_SQ) { p0_transpose_item(a->in[I_WGATE], D, D, D, (bf16*)(ws + WS_WGATE), scr, r, lane); return; } r -= I_SQ;
    if (r < I_IN) { p0_transpose_item(a->in[I_WINO], D, NPROJ, NPROJ_PAD, (bf16*)(ws + WS_WINO), scr, r, lane); return; } r -= I_IN;
    if (r < I_SQ) { p0_transpose_item(a->in[I_WOUTO], D, D, D, (bf16*)(ws + WS_WOUTO), scr, r, lane); return; } r -= I_SQ;
    if (r < I_UP) { p0_transpose_item(a->in[I_WUP] + (size_t)D * FF, D, FF, FF, (bf16*)(ws + WS_WUP) + (size_t)D * FF, scr, r, lane); return; } r -= I_UP;
    if (r < I_DN) { p0_transpose_item(a->in[I_WDOWN] + (size_t)D * FF, FF, D, D, (bf16*)(ws + WS_WDOWN) + (size_t)D * FF, scr, r, lane); return; } r -= I_DN;
    if (r < I_PL) { p0_transpose_item(a->in[I_WPLE] + (size_t)PLE * D, PLE, D, D, (bf16*)(ws + WS_WPLE) + (size_t)PLE * D, scr, r, lane); return; } r -= I_PL;
    p0_transpose_item(a->in[I_WGATE] + (size_t)D * D, D, D, D, (bf16*)(ws + WS_WGATE) + (size_t)D * D, scr, r, lane);
}
__device__ __forceinline__ void phase_convert(ArgsP a, LAS unsigned char* lds, int gw, int NGW, int wave, int lane) {
    unsigned char* ws = a->ws;
    LAS float* scr = (LAS float*)(lds + wave * 16384);
    for (int it = gw; it < cv::N_FIRST; it += NGW) convert_first_item(a, scr, it, lane);
    bf16* xb = (bf16*)(ws + WS_XB);
    for (int m = gw; m < M; m += NGW) {
        const float* src = m < MP ? a->in[I_XP] + (size_t)m * D : a->in[I_XS] + (size_t)(m - MP) * D;
        row_to_bf16(src, xb + (size_t)m * D, D, lane);
    }
    bf16* pb = (bf16*)(ws + WS_PB);
    for (int r = gw; r < 2 * M; r += NGW) {
        const int l = r / M, m = r % M;
        const float* src = m < MP ? a->in[I_PP] + ((size_t)l * MP + m) * PLE : a->in[I_PS] + ((size_t)l * MS + (m - MP)) * PLE;
        row_to_bf16(src, pb + (size_t)r * PLE, PLE, lane);
    }
}

__device__ __forceinline__ float conv_in(const bf16* proj, int row0, int tq, int ch, const float* cstate) {
    if (tq >= 0) return bf2f(proj[(size_t)(row0 + tq) * NPROJ_PAD + ch]);
    return cstate ? cstate[(3 + tq) * 4096 + ch] : 0.f;
}
__device__ __forceinline__ float conv4(const bf16* proj, int row0, int t, int ch, const float* cstate, const float* wconv, const float* bconv) {
    float acc = bconv[ch];
#pragma unroll
    for (int j = 0; j < 4; ++j) acc += wconv[j * 4096 + ch] * conv_in(proj, row0, t - 3 + j, ch, cstate);
    return acc;
}

__device__ __forceinline__ void delta_rec_item(ArgsP a, LAS unsigned char* lds, int row0, int T, int h, const float* cstate, const float* S0, float* Sout, const int tid) {
    const int lane = tid & 63, wave = tid >> 6, c = tid & 127, r = tid >> 7;
    const bf16* proj = (const bf16*)(a->ws + WS_PROJ); const float* gates = (const float*)(a->ws + WS_GATES); bf16* mix = (bf16*)(a->ws + WS_MIX);
    const float* wconv = a->in[I_WCONV]; const float* bconv = a->in[I_BCONV];
    LAS float* act = (LAS float*)lds;
    LAS float* nrm = act + 4 * 384;
    LAS float* gb = nrm + 8;
    LAS float* red = gb + 8;
    LAS float* red2 = red + 512;
    LAS float* obuf = red2 + 512;
    float s[32];
#pragma unroll
    for (int i = 0; i < 32; ++i) s[i] = S0 ? S0[(size_t)(32 * r + i) * 128 + c] : 0.f;
    const float aexp = expf(a->in[I_ALOG][h]), dtb = a->in[I_DTB][h];
#pragma unroll 1
    for (int t0 = 0; t0 < T; t0 += 4) {
#pragma unroll
        for (int j = 0; j < 3; ++j) { const int idx = tid + 512 * j, tok = idx / 384, chl = idx % 384, part = chl >> 7, i = chl & 127;
            const int ch = part * 1024 + h * 128 + i;
            act[tok * 384 + chl] = siluf(conv4(proj, row0, t0 + tok, ch, cstate, wconv, bconv)); }
        __syncthreads();
        { const int tok = wave >> 1, part = wave & 1; const float x0 = act[tok * 384 + part * 128 + lane], x1 = act[tok * 384 + part * 128 + 64 + lane];
          const float ss = wave_sum(x0 * x0 + x1 * x1); if (lane == 0) nrm[tok * 2 + part] = rsqrtf(ss + 1e-6f) * (part == 0 ? 0.08838834764831845f : 1.f); }
        if (tid < 4) { const int row = row0 + t0 + tid; const float g = -aexp * softplusf(gates[(size_t)row * 16 + h] + dtb); gb[tid * 2] = expf(g); gb[tid * 2 + 1] = sigm(gates[(size_t)row * 16 + 8 + h]); }
        __syncthreads();
#pragma unroll 1
        for (int tok = 0; tok < 4; ++tok) {
            const float eg = gb[tok * 2], beta = gb[tok * 2 + 1], nq = nrm[tok * 2], nk = nrm[tok * 2 + 1];
            const LAS float* qv = act + tok * 384 + 32 * r; const LAS float* kv = qv + 128;
            float ks = 0.f;
#pragma unroll
            for (int i = 0; i < 32; ++i) ks += kv[i] * s[i];
            red[r * 128 + c] = ks * nk;
            __syncthreads();
            const float kS = red[c] + red[128 + c] + red[256 + c] + red[384 + c];
            const float vnew = beta * (act[tok * 384 + 256 + c] - eg * kS);
            float os = 0.f;
#pragma unroll
            for (int i = 0; i < 32; ++i) { s[i] = eg * s[i] + (kv[i] * nk) * vnew; os += qv[i] * s[i]; }
            red2[r * 128 + c] = os * nq;
            __syncthreads();
            if (r == 0) obuf[tok * 128 + c] = red2[c] + red2[128 + c] + red2[256 + c] + red2[384 + c];
        }
        __syncthreads();
        if (wave < 4) { const int tok = wave, row = row0 + t0 + tok; const float o0 = obuf[tok * 128 + lane], o1 = obuf[tok * 128 + 64 + lane];
            const float rstd = rsqrtf(wave_sum(o0 * o0 + o1 * o1) * (1.f / 128.f) + RMS_EPS);
            const float* nw = a->in[I_DNORM];
            const float z0 = bf2f(proj[(size_t)row * NPROJ_PAD + 4096 + h * 128 + lane]), z1 = bf2f(proj[(size_t)row * NPROJ_PAD + 4096 + h * 128 + 64 + lane]);
            mix[(size_t)row * D + h * 128 + lane] = (bf16)f2bf(o0 * rstd * nw[lane] * siluf(z0));
            mix[(size_t)row * D + h * 128 + 64 + lane] = (bf16)f2bf(o1 * rstd * nw[64 + lane] * siluf(z1)); }
        __syncthreads();
    }
#pragma unroll
    for (int i = 0; i < 32; ++i) Sout[(size_t)(32 * r + i) * 128 + c] = s[i];
}

__device__ __forceinline__ void lru_rec_item(ArgsP a, LAS unsigned char* lds, int row0, int T, int n, const float* cstate, const float* h0, float* hout, const int tid) {
    const int d = tid & 127, part = tid >> 7;
    const bf16* proj = (const bf16*)(a->ws + WS_PROJ); bf16* mix = (bf16*)(a->ws + WS_MIX);
    const float* wconv = a->in[I_WCONV]; const float* bconv = a->in[I_BCONV];
    const float* wr = a->in[I_LWR] + (size_t)n * 16384; const float* wi = a->in[I_LWI] + (size_t)n * 16384;
    LAS float* xr = (LAS float*)lds;
    LAS float* red = xr + 512;
    const int chn = n * 128 + d;
    float hst = h0 ? h0[chn] : 0.f;
    const float br = a->in[I_LBR][chn], bi = a->in[I_LBI][chn], spl = softplusf(-a->in[I_LLAM][chn]);
#pragma unroll 1
    for (int t0 = 0; t0 < T; t0 += 4) {
        { const int tok = tid >> 7; xr[tok * 128 + d] = conv4(proj, row0, t0 + tok, 3072 + chn, cstate, wconv, bconv); }
        __syncthreads();
        float ar[4] = {0.f, 0.f, 0.f, 0.f}, ai[4] = {0.f, 0.f, 0.f, 0.f};
#pragma unroll 4
        for (int cc = 0; cc < 32; ++cc) { const int c = part * 32 + cc; const float w1 = wr[c * 128 + d], w2 = wi[c * 128 + d];
#pragma unroll
        for (int tok = 0; tok < 4; ++tok) { const float x = xr[tok * 128 + c]; ar[tok] += x * w1; ai[tok] += x * w2; } }
#pragma unroll
        for (int tok = 0; tok < 4; ++tok) { red[((tok * 2 + 0) * 4 + part) * 128 + d] = ar[tok]; red[((tok * 2 + 1) * 4 + part) * 128 + d] = ai[tok]; }
        __syncthreads();
        if (part == 0) {
    #pragma unroll 1
        for (int tok = 0; tok < 4; ++tok) {
                const int row = row0 + t0 + tok;
                float rp = br, ip = bi;
#pragma unroll
                for (int p = 0; p < 4; ++p) { rp += red[((tok * 2 + 0) * 4 + p) * 128 + d]; ip += red[((tok * 2 + 1) * 4 + p) * 128 + d]; }
                const float log_a = -8.f * sigm(rp) * spl;
                const float av = expf(log_a);
                const float bx = sqrtf(-expm1f(2.f * log_a)) * sigm(ip) * xr[tok * 128 + d];
                hst = av * hst + bx;
                const float gate = bf2f(proj[(size_t)row * NPROJ_PAD + 5120 + chn]);
                mix[(size_t)row * D + 1024 + chn] = (bf16)f2bf(hst * gelu_tanh(gate));
            }
        }
        __syncthreads();
    }
    if (part == 0) hout[chn] = hst;
}

__device__ __forceinline__ void mlstm_rec_item(ArgsP a, LAS unsigned char* lds, int row0, int T, int h, const float* C0, const float* n0, const float* m0, float* Cout, float* nout, float* mout, const int tid) {
    const int lane = tid & 63, wave = tid >> 6, v = tid & 255, kh = tid >> 8;
    const bf16* proj = (const bf16*)(a->ws + WS_PROJ); const float* gates = (const float*)(a->ws + WS_GATES); bf16* mix = (bf16*)(a->ws + WS_MIX);
    LAS float* qs = (LAS float*)lds;
    LAS float* ks = qs + 512;
    LAS float* vs = ks + 512;
    LAS float* gs = vs + 1024;
    LAS float* red = gs + 8;
    LAS float* dred = red + 1024;
    LAS float* hbuf = dred + 4;
    float cst[64];
#pragma unroll
    for (int i = 0; i < 64; ++i) cst[i] = C0 ? C0[(size_t)v * 128 + 64 * kh + i] : 0.f;
    float nst = (tid < 128) ? (n0 ? n0[tid] : 0.f) : 0.f;
    float mst = m0 ? m0[0] : 0.f;
    const float big = a->in[I_BIG][h], bfg = a->in[I_BFG][h];
#pragma unroll 1
    for (int t0 = 0; t0 < T; t0 += 4) {
#pragma unroll
        for (int j = 0; j < 4; ++j) { const int tok = j, row = row0 + t0 + tok; const bf16* pr = proj + (size_t)row * NPROJ_PAD;
            float val;
            if (tid < 128) val = bf2f(pr[h * 128 + tid]); else if (tid < 256) val = bf2f(pr[1024 + h * 128 + (tid - 128)]) * 0.08838834764831845f; else val = bf2f(pr[2048 + h * 256 + (tid - 256)]);
            if (tid < 128) qs[tok * 128 + tid] = val; else if (tid < 256) ks[tok * 128 + tid - 128] = val; else vs[tok * 256 + tid - 256] = val; }
        if (tid < 4) { const int row = row0 + t0 + tid; gs[tid * 2] = gates[(size_t)row * 16 + h] + big; gs[tid * 2 + 1] = gates[(size_t)row * 16 + 8 + h] + bfg; }
        __syncthreads();
#pragma unroll 1
        for (int tok = 0; tok < 4; ++tok) {
            const int par = tok & 1;
            const float ig = gs[tok * 2], lf = logsigf(gs[tok * 2 + 1]);
            const float mnew = fmaxf(lf + mst, ig), fp = expf(lf + mst - mnew), ip = expf(ig - mnew); mst = mnew;
            const float vv = vs[tok * 256 + v] * ip;
            const LAS float* kv = ks + tok * 128 + 64 * kh; const LAS float* qv = qs + tok * 128 + 64 * kh;
            float num = 0.f;
#pragma unroll
            for (int i = 0; i < 64; ++i) { cst[i] = fp * cst[i] + vv * kv[i]; num += cst[i] * qv[i]; }
            red[(par * 2 + kh) * 256 + v] = num;
            if (tid < 128) { nst = fp * nst + ip * ks[tok * 128 + tid]; const float dp = wave_sum(nst * qs[tok * 128 + tid]); if (lane == 0) dred[par * 2 + wave] = dp; }
            __syncthreads();
            if (kh == 0) { const float nm = red[(par * 2) * 256 + v] + red[(par * 2 + 1) * 256 + v]; const float den = dred[par * 2] + dred[par * 2 + 1];
                hbuf[tok * 256 + v] = nm / fmaxf(fabsf(den), expf(-mnew)); }
        }
        __syncthreads();
        if (wave < 4) { const int tok = wave, row = row0 + t0 + tok; float hv[4]; float ss = 0.f;
#pragma unroll
            for (int j = 0; j < 4; ++j) { hv[j] = hbuf[tok * 256 + j * 64 + lane]; ss += hv[j] * hv[j]; }
            const float rstd = rsqrtf(wave_sum(ss) * (1.f / 256.f) + RMS_EPS);
            const float* nw = a->in[I_MNORM] + h * 256;
#pragma unroll
            for (int j = 0; j < 4; ++j) { const int vi = j * 64 + lane; const float op = bf2f(proj[(size_t)row * NPROJ_PAD + 4096 + h * 256 + vi]);
                mix[(size_t)row * D + h * 256 + vi] = (bf16)f2bf(hv[j] * rstd * nw[vi] * sigm(op)); } }
        __syncthreads();
    }
#pragma unroll
    for (int i = 0; i < 64; ++i) Cout[(size_t)v * 128 + 64 * kh + i] = cst[i];
    if (tid < 128) nout[tid] = nst;
    if (tid == 0) mout[0] = mst;
}


typedef short bf16x8 __attribute__((ext_vector_type(8)));
#define MFMA32(a_, b_, c_) __builtin_amdgcn_mfma_f32_16x16x32_bf16(a_, b_, c_, 0, 0, 0)

__device__ __forceinline__ void lru_prep_item(ArgsP a, LAS unsigned char* lds, int item, const int tid) {
    const int c = item & 31, n = (item >> 5) & 7, b = item >> 8;
    const int lane = tid & 63, w = __builtin_amdgcn_readfirstlane(tid >> 6), fr = lane & 15, fq = lane >> 4;
    unsigned char* ws = a->ws;
    const bf16* proj = (const bf16*)(ws + WS_PROJ);
    LAS bf16* xa = (LAS bf16*)lds;
    LAS float* xf = (LAS float*)(lds + 17408);
    LAS float* obH = (LAS float*)(lds + 51200);
    LAS float* obP = obH + 64 * 132;
    {
        const int t = tid >> 3, sub = tid & 7, ch0 = 3072 + n * 128 + sub * 16;
        const float* wconv = a->in[I_WCONV]; const float* bconv = a->in[I_BCONV];
        float x[16];
#pragma unroll
        for (int i = 0; i < 4; ++i) { const f32x4 bb = *(const f32x4*)(bconv + ch0 + 4 * i); x[4 * i] = bb.x; x[4 * i + 1] = bb.y; x[4 * i + 2] = bb.z; x[4 * i + 3] = bb.w; }
#pragma unroll
        for (int j = 0; j < 4; ++j) { const int tt = 64 * c + t - 3 + j;
            if (tt >= 0) { const bf16* pr = proj + (size_t)(b * TP + tt) * NPROJ_PAD + ch0; const v4u u0 = *(const v4u*)pr, u1 = *(const v4u*)(pr + 8);
                const unsigned uu[8] = {u0.x, u0.y, u0.z, u0.w, u1.x, u1.y, u1.z, u1.w};
#pragma unroll
                for (int i = 0; i < 4; ++i) { const f32x4 ww = *(const f32x4*)(wconv + j * 4096 + ch0 + 4 * i);
                    x[4 * i] += ww.x * bflo(uu[2 * i]); x[4 * i + 1] += ww.y * bfhi(uu[2 * i]); x[4 * i + 2] += ww.z * bflo(uu[2 * i + 1]); x[4 * i + 3] += ww.w * bfhi(uu[2 * i + 1]); } } }
        v4u o0, o1; o0.x = pk2(x[0], x[1]); o0.y = pk2(x[2], x[3]); o0.z = pk2(x[4], x[5]); o0.w = pk2(x[6], x[7]); o1.x = pk2(x[8], x[9]); o1.y = pk2(x[10], x[11]); o1.z = pk2(x[12], x[13]); o1.w = pk2(x[14], x[15]);
        *(LAS v4u*)(xa + t * 136 + sub * 16) = o0; *(LAS v4u*)(xa + t * 136 + sub * 16 + 8) = o1;
#pragma unroll
        for (int i = 0; i < 4; ++i) *(LAS f32x4*)(xf + t * 132 + sub * 16 + 4 * i) = (f32x4){x[4 * i], x[4 * i + 1], x[4 * i + 2], x[4 * i + 3]};
    }
    __syncthreads();
    const bf16* wrT = (const bf16*)(ws + WS_LRUW) + (size_t)n * 16384; const bf16* wiT = wrT + 8 * 16384;
    bf16x8 br[4], bi[4];
#pragma unroll
    for (int ks = 0; ks < 4; ++ks) { br[ks] = *(const bf16x8*)(wrT + (16 * w + fr) * 128 + 32 * ks + 8 * fq); bi[ks] = *(const bf16x8*)(wiT + (16 * w + fr) * 128 + 32 * ks + 8 * fq); }
    f32x4 accr[4], acci[4];
#pragma unroll
    for (int tb = 0; tb < 4; ++tb) { accr[tb] = (f32x4){0.f, 0.f, 0.f, 0.f}; acci[tb] = (f32x4){0.f, 0.f, 0.f, 0.f};
#pragma unroll
        for (int ks = 0; ks < 4; ++ks) { const bf16x8 af = *(const LAS bf16x8*)(xa + (16 * tb + fr) * 136 + 32 * ks + 8 * fq); accr[tb] = MFMA32(af, br[ks], accr[tb]); acci[tb] = MFMA32(af, bi[ks], acci[tb]); } }
    const int dl = 16 * w + fr, chn = n * 128 + dl;
    const float brs = a->in[I_LBR][chn], bis = a->in[I_LBI][chn], spl = softplusf(-a->in[I_LLAM][chn]);
    float Apre = 1.f, Hpre = 0.f;
#pragma unroll
    for (int tb = 0; tb < 4; ++tb) {
        float P[4], Hh[4];
#pragma unroll
        for (int j = 0; j < 4; ++j) { const int t = 16 * tb + 4 * fq + j;
            const float log_a = -8.f * sigm(accr[tb][j] + brs) * spl; const float av = expf(log_a);
            const float bx = sqrtf(-expm1f(2.f * log_a)) * sigm(acci[tb][j] + bis) * xf[t * 132 + dl];
            if (j == 0) { P[0] = av; Hh[0] = bx; } else { P[j] = P[j - 1] * av; Hh[j] = av * Hh[j - 1] + bx; } }
        float Ai = P[3], Hi = Hh[3];
        { const float A2 = __shfl_up(Ai, 16), H2 = __shfl_up(Hi, 16); if (fq >= 1) { Hi = Ai * H2 + Hi; Ai = A2 * Ai; } }
        { const float A2 = __shfl_up(Ai, 32), H2 = __shfl_up(Hi, 32); if (fq >= 2) { Hi = Ai * H2 + Hi; Ai = A2 * Ai; } }
        float Aex = __shfl_up(Ai, 16), Hex = __shfl_up(Hi, 16); if (fq == 0) { Aex = 1.f; Hex = 0.f; }
        const float Atb = __shfl(Ai, 48 + fr), Htb = __shfl(Hi, 48 + fr);
        const float EA = Apre * Aex, EH = Aex * Hpre + Hex;
#pragma unroll
        for (int j = 0; j < 4; ++j) { const int t = 16 * tb + 4 * fq + j; obP[t * 132 + dl] = EA * P[j]; obH[t * 132 + dl] = P[j] * EH + Hh[j]; }
        Hpre = Atb * Hpre + Htb; Apre = Apre * Atb;
    }
    if (fq == 0) { float* e = (float*)(ws + WS_LRU_END) + (size_t)item * 256; e[dl] = Apre; e[128 + dl] = Hpre; }
    __syncthreads();
    {
        const int t = tid >> 3, sub = tid & 7;
        bf16* hl = (bf16*)(ws + WS_LRU_HL) + ((size_t)item * 64 + t) * 128 + sub * 16; bf16* pp = (bf16*)(ws + WS_LRU_P) + ((size_t)item * 64 + t) * 128 + sub * 16;
        const LAS float* sh = obH + t * 132 + sub * 16; const LAS float* sp = obP + t * 132 + sub * 16;
        v4u o0, o1;
        o0.x = pk2(sh[0], sh[1]); o0.y = pk2(sh[2], sh[3]); o0.z = pk2(sh[4], sh[5]); o0.w = pk2(sh[6], sh[7]); o1.x = pk2(sh[8], sh[9]); o1.y = pk2(sh[10], sh[11]); o1.z = pk2(sh[12], sh[13]); o1.w = pk2(sh[14], sh[15]);
        *(v4u*)hl = o0; *(v4u*)(hl + 8) = o1;
        o0.x = pk2(sp[0], sp[1]); o0.y = pk2(sp[2], sp[3]); o0.z = pk2(sp[4], sp[5]); o0.w = pk2(sp[6], sp[7]); o1.x = pk2(sp[8], sp[9]); o1.y = pk2(sp[10], sp[11]); o1.z = pk2(sp[12], sp[13]); o1.w = pk2(sp[14], sp[15]);
        *(v4u*)pp = o0; *(v4u*)(pp + 8) = o1;
    }
    __syncthreads();
}
__device__ __forceinline__ void lru_out_item(ArgsP a, LAS unsigned char* lds, int item, const int tid) {
    const int c = item & 31, n = (item >> 5) & 7, b = item >> 8;
    unsigned char* ws = a->ws;
    LAS float* carry = (LAS float*)lds;
    if (tid < 128) { float cr = 0.f; const float* e = (const float*)(ws + WS_LRU_END) + (size_t)(item - c) * 256;
        for (int k = 0; k < c; ++k) cr = e[k * 256 + 128 + tid] + e[k * 256 + tid] * cr;
        carry[tid] = cr; }
    __syncthreads();
    const int t = tid >> 3, sub = tid & 7, d0 = sub * 16, row = b * TP + 64 * c + t;
    const bf16* hl = (const bf16*)(ws + WS_LRU_HL) + ((size_t)item * 64 + t) * 128 + d0; const bf16* pp = (const bf16*)(ws + WS_LRU_P) + ((size_t)item * 64 + t) * 128 + d0;
    const bf16* gp = (const bf16*)(ws + WS_PROJ) + (size_t)row * NPROJ_PAD + 5120 + n * 128 + d0;
    const v4u h0 = *(const v4u*)hl, h1 = *(const v4u*)(hl + 8), p0 = *(const v4u*)pp, p1 = *(const v4u*)(pp + 8), g0 = *(const v4u*)gp, g1 = *(const v4u*)(gp + 8);
    const unsigned hu[8] = {h0.x, h0.y, h0.z, h0.w, h1.x, h1.y, h1.z, h1.w}, pu[8] = {p0.x, p0.y, p0.z, p0.w, p1.x, p1.y, p1.z, p1.w}, gu[8] = {g0.x, g0.y, g0.z, g0.w, g1.x, g1.y, g1.z, g1.w};
    float hv[16]; unsigned ou[8];
#pragma unroll
    for (int i = 0; i < 8; ++i) { hv[2 * i] = bflo(hu[i]) + bflo(pu[i]) * carry[d0 + 2 * i]; hv[2 * i + 1] = bfhi(hu[i]) + bfhi(pu[i]) * carry[d0 + 2 * i + 1];
        ou[i] = pk2(hv[2 * i] * gelu_tanh(bflo(gu[i])), hv[2 * i + 1] * gelu_tanh(bfhi(gu[i]))); }
    bf16* mp = (bf16*)(ws + WS_MIX) + (size_t)row * D + 1024 + n * 128 + d0;
    *(v4u*)mp = (v4u){ou[0], ou[1], ou[2], ou[3]}; *(v4u*)(mp + 8) = (v4u){ou[4], ou[5], ou[6], ou[7]};
    if (c == 31 && t == 63) { float* o = a->out + O_LRUP + (size_t)b * 1024 + n * 128 + d0;
#pragma unroll
        for (int i = 0; i < 4; ++i) *(f32x4*)(o + 4 * i) = (f32x4){hv[4 * i], hv[4 * i + 1], hv[4 * i + 2], hv[4 * i + 3]}; }
    __syncthreads();
}


__device__ __forceinline__ void conv16_prompt(const bf16* proj, const float* wconv, const float* bconv, int b, int tseq, int ch0, float (&x)[16]) {
#pragma unroll
    for (int i = 0; i < 4; ++i) { const f32x4 bb = *(const f32x4*)(bconv + ch0 + 4 * i); x[4 * i] = bb.x; x[4 * i + 1] = bb.y; x[4 * i + 2] = bb.z; x[4 * i + 3] = bb.w; }
#pragma unroll
    for (int j = 0; j < 4; ++j) { const int tt = tseq - 3 + j;
        if (tt >= 0) { const bf16* pr = proj + (size_t)(b * TP + tt) * NPROJ_PAD + ch0; const v4u u0 = *(const v4u*)pr, u1 = *(const v4u*)(pr + 8);
            const unsigned uu[8] = {u0.x, u0.y, u0.z, u0.w, u1.x, u1.y, u1.z, u1.w};
#pragma unroll
            for (int i = 0; i < 4; ++i) { const f32x4 ww = *(const f32x4*)(wconv + j * 4096 + ch0 + 4 * i);
                x[4 * i] += ww.x * bflo(uu[2 * i]); x[4 * i + 1] += ww.y * bfhi(uu[2 * i]); x[4 * i + 2] += ww.z * bflo(uu[2 * i + 1]); x[4 * i + 3] += ww.w * bfhi(uu[2 * i + 1]); } } }
}
__device__ __forceinline__ void st16_bf16(LAS bf16* p, const float (&x)[16]) {
    v4u o0, o1; o0.x = pk2(x[0], x[1]); o0.y = pk2(x[2], x[3]); o0.z = pk2(x[4], x[5]); o0.w = pk2(x[6], x[7]); o1.x = pk2(x[8], x[9]); o1.y = pk2(x[10], x[11]); o1.z = pk2(x[12], x[13]); o1.w = pk2(x[14], x[15]);
    *(LAS v4u*)p = o0; *(LAS v4u*)(p + 8) = o1;
}
__device__ __forceinline__ v2u pack4(const f32x4 v) { v2u o; o.x = pk2(v.x, v.y); o.y = pk2(v.z, v.w); return o; }
__device__ __forceinline__ bf16x8 zero8() { return (bf16x8){0, 0, 0, 0, 0, 0, 0, 0}; }

__device__ __forceinline__ void delta_prep_item(ArgsP a, LAS unsigned char* lds, int item, const int tid) {
    const int c = item & 31, h = (item >> 5) & 7, b = item >> 8;
    const int lane = tid & 63, w = __builtin_amdgcn_readfirstlane(tid >> 6), fr = lane & 15, fq = lane >> 4;
    unsigned char* ws = a->ws;
    const bf16* proj = (const bf16*)(ws + WS_PROJ);
    LAS bf16* Kn = (LAS bf16*)lds;
    LAS bf16* Qn = (LAS bf16*)(lds + 17408);
    LAS bf16* KdT = (LAS bf16*)(lds + 34816);
    LAS bf16* RX = (LAS bf16*)(lds + 53248);
    LAS bf16* Mm = (LAS bf16*)(lds + 90112);
    LAS bf16* QKd = (LAS bf16*)(lds + 99328);
    LAS bf16* Td = (LAS bf16*)(lds + 108544);
    LAS bf16* RT = (LAS bf16*)(lds + 111616) + w * 768;
    LAS float* gl = (LAS float*)(lds + 123904);
    LAS float* gcs = gl + 64;
    LAS float* bet = gcs + 64;
    const int t = tid >> 3, sub = tid & 7;
    {
        if (sub == 0) { const float* gt = (const float*)(ws + WS_GATES) + (size_t)(b * TP + 64 * c + t) * 16;
            gl[t] = -expf(a->in[I_ALOG][h]) * softplusf(gt[h] + a->in[I_DTB][h]); bet[t] = sigm(gt[8 + h]); }
        __syncthreads();
        if (w == 0) { float v = gl[lane];
#pragma unroll
            for (int o = 1; o < 64; o <<= 1) { const float u = __shfl_up(v, o); if (lane >= o) v += u; }
            gcs[lane] = v; }
        __syncthreads();
    }
    {
        const float* wconv = a->in[I_WCONV]; const float* bconv = a->in[I_BCONV];
        const float gc = gcs[t], glast = gcs[63], beta = bet[t];
        const float ec = expf(gc), ed = expf(glast - gc);
        float x[16], y[16];
        conv16_prompt(proj, wconv, bconv, b, 64 * c + t, 1024 + h * 128 + sub * 16, x);
        float ss = 0.f;
#pragma unroll
        for (int i = 0; i < 16; ++i) { x[i] = siluf(x[i]); ss += x[i] * x[i]; }
        ss += __shfl_xor(ss, 1); ss += __shfl_xor(ss, 2); ss += __shfl_xor(ss, 4);
        const float rk = rsqrtf(ss + 1e-6f);
#pragma unroll
        for (int i = 0; i < 16; ++i) x[i] *= rk;
        st16_bf16(Kn + t * 136 + sub * 16, x);
#pragma unroll
        for (int i = 0; i < 16; ++i) KdT[(sub * 16 + i) * 72 + t] = (bf16)f2bf(x[i] * ed);
#pragma unroll
        for (int i = 0; i < 16; ++i) y[i] = x[i] * (beta * ec);
        st16_bf16(RX + t * 264 + 128 + sub * 16, y);
        conv16_prompt(proj, wconv, bconv, b, 64 * c + t, h * 128 + sub * 16, x);
        ss = 0.f;
#pragma unroll
        for (int i = 0; i < 16; ++i) { x[i] = siluf(x[i]); ss += x[i] * x[i]; }
        ss += __shfl_xor(ss, 1); ss += __shfl_xor(ss, 2); ss += __shfl_xor(ss, 4);
        const float rq = rsqrtf(ss + 1e-6f) * 0.08838834764831845f;
#pragma unroll
        for (int i = 0; i < 16; ++i) x[i] *= rq;
        st16_bf16(Qn + t * 136 + sub * 16, x);
        conv16_prompt(proj, wconv, bconv, b, 64 * c + t, 2048 + h * 128 + sub * 16, x);
#pragma unroll
        for (int i = 0; i < 16; ++i) x[i] = siluf(x[i]) * beta;
        st16_bf16(RX + t * 264 + sub * 16, x);
    }
    __syncthreads();
    {
        const int ib = w >> 1;
#pragma unroll
        for (int jj = 0; jj < 2; ++jj) { const int jb = 2 * (w & 1) + jj;
            f32x4 ak = (f32x4){0.f, 0.f, 0.f, 0.f}, aq = (f32x4){0.f, 0.f, 0.f, 0.f};
            if (jb <= ib) {
#pragma unroll
                for (int ks = 0; ks < 4; ++ks) { const bf16x8 bfr = *(const LAS bf16x8*)(Kn + (16 * jb + fr) * 136 + 32 * ks + 8 * fq);
                    const bf16x8 afk = *(const LAS bf16x8*)(Kn + (16 * ib + fr) * 136 + 32 * ks + 8 * fq), afq = *(const LAS bf16x8*)(Qn + (16 * ib + fr) * 136 + 32 * ks + 8 * fq);
                    ak = MFMA32(afk, bfr, ak); aq = MFMA32(afq, bfr, aq); } }
            const int col = 16 * jb + fr; const float gcc = gcs[col];
#pragma unroll
            for (int j = 0; j < 4; ++j) { const int row = 16 * ib + 4 * fq + j; const float dec = (row >= col) ? expf(gcs[row] - gcc) : 0.f;
                Mm[row * 72 + col] = (bf16)f2bf(row > col ? -bet[row] * ak[j] * dec : 0.f);
                QKd[row * 72 + col] = (bf16)f2bf(aq[j] * dec); }
        }
    }
    __syncthreads();
    if (w == 0) { const int blk = lane >> 4, col = lane & 15; float xi[16];
#pragma unroll
        for (int i = 0; i < 16; ++i) { float acc = (i == col) ? 1.f : 0.f; const LAS bf16* mr = Mm + (16 * blk + i) * 72 + 16 * blk;
#pragma unroll
            for (int j = 0; j < i; ++j) acc += bf2f(mr[j]) * xi[j];
            xi[i] = acc; }
#pragma unroll
        for (int i = 0; i < 16; ++i) Td[(blk * 16 + i) * 24 + col] = (bf16)f2bf(xi[i]); }
    f32x4 rhs[2][4];
#pragma unroll
    for (int cbl = 0; cbl < 2; ++cbl)
#pragma unroll
        for (int bb = 0; bb < 4; ++bb)
#pragma unroll
            for (int j = 0; j < 4; ++j) rhs[cbl][bb][j] = bf2f(RX[(16 * bb + 4 * fq + j) * 264 + 32 * w + 16 * cbl + fr]);
    __syncthreads();
#pragma unroll
    for (int cbl = 0; cbl < 2; ++cbl) { const int cb = 2 * w + cbl;
#pragma unroll
        for (int bb = 0; bb < 4; ++bb) {
            f32x4 acc = rhs[cbl][bb];
#pragma unroll
            for (int ks = 0; ks < 2; ++ks) { if (32 * ks < 16 * bb) { const bool ok = (32 * ks + 8 * fq) < 16 * bb;
                const bf16x8 af = ok ? *(const LAS bf16x8*)(Mm + (16 * bb + fr) * 72 + 32 * ks + 8 * fq) : zero8();
                const bf16x8 bf_ = ok ? *(const LAS bf16x8*)(RX + (16 * cb + fr) * 72 + 32 * ks + 8 * fq) : zero8();
                acc = MFMA32(af, bf_, acc); } }
            *(LAS v2u*)(RT + (16 * cbl + fr) * 24 + 4 * fq) = pack4(acc);
            asm volatile("s_waitcnt lgkmcnt(0)" ::: "memory");
            const bool ok2 = fq < 2;
            const bf16x8 af2 = ok2 ? *(const LAS bf16x8*)(Td + (bb * 16 + fr) * 24 + 8 * fq) : zero8();
            const bf16x8 bf2 = ok2 ? *(const LAS bf16x8*)(RT + (16 * cbl + fr) * 24 + 8 * fq) : zero8();
            const f32x4 xb4 = MFMA32(af2, bf2, ((f32x4){0.f, 0.f, 0.f, 0.f}));
            *(LAS v2u*)(RX + (16 * cb + fr) * 72 + 16 * bb + 4 * fq) = pack4(xb4);
            asm volatile("s_waitcnt lgkmcnt(0)" ::: "memory");
        }
    }
    __syncthreads();
    {
        v4u* gout = (v4u*)(ws + WS_DG) + ((size_t)item * 8 + w) * 4 * 64 + lane;
        bf16x8 kb[2];
#pragma unroll
        for (int kt = 0; kt < 2; ++kt) kb[kt] = *(const LAS bf16x8*)(KdT + (16 * w + fr) * 72 + 32 * kt + 8 * fq);
#pragma unroll
        for (int ks = 0; ks < 4; ++ks) { f32x4 g0 = (f32x4){0.f, 0.f, 0.f, 0.f}, g1 = (f32x4){0.f, 0.f, 0.f, 0.f};
#pragma unroll
            for (int kt = 0; kt < 2; ++kt) { const bf16x8 a0 = *(const LAS bf16x8*)(RX + (128 + 32 * ks + fr) * 72 + 32 * kt + 8 * fq), a1 = *(const LAS bf16x8*)(RX + (128 + 32 * ks + 16 + fr) * 72 + 32 * kt + 8 * fq);
                g0 = MFMA32(a0, kb[kt], g0); g1 = MFMA32(a1, kb[kt], g1); }
            const v2u p0 = pack4(-g0), p1 = pack4(-g1); gout[ks * 64] = (v4u){p0.x, p0.y, p1.x, p1.y}; }
        v2u* bout = (v2u*)(ws + WS_DB) + ((size_t)item * 64 + w) * 64 + lane;
#pragma unroll
        for (int s2 = 0; s2 < 8; ++s2) { f32x4 bc = (f32x4){0.f, 0.f, 0.f, 0.f};
#pragma unroll
            for (int kt = 0; kt < 2; ++kt) { const bf16x8 ub = *(const LAS bf16x8*)(RX + (16 * s2 + fr) * 72 + 32 * kt + 8 * fq); bc = MFMA32(kb[kt], ub, bc); }
            bout[(size_t)s2 * 8 * 64] = pack4(bc); }
    }
    {
        const int tb = w >> 1, half = w & 1; const float ect = expf(gcs[16 * tb + fr]);
        bf16x8 qk[2];
#pragma unroll
        for (int kt = 0; kt < 2; ++kt) qk[kt] = *(const LAS bf16x8*)(QKd + (16 * tb + fr) * 72 + 32 * kt + 8 * fq);
        v4u* qout = (v4u*)(ws + WS_DQ) + ((size_t)item * 4 + tb) * 4 * 64 + lane;
#pragma unroll
        for (int kk = 0; kk < 2; ++kk) { const int ks = 2 * half + kk; v2u pk[2];
#pragma unroll
            for (int hf = 0; hf < 2; ++hf) { const int db = 2 * ks + hf; f32x4 acc = (f32x4){0.f, 0.f, 0.f, 0.f};
#pragma unroll
                for (int kt = 0; kt < 2; ++kt) { const bf16x8 wa = *(const LAS bf16x8*)(RX + (128 + 16 * db + fr) * 72 + 32 * kt + 8 * fq); acc = MFMA32(wa, qk[kt], acc); }
                const v2u qn4 = *(const LAS v2u*)(Qn + (16 * tb + fr) * 136 + 16 * db + 4 * fq);
                f32x4 qp; qp.x = bflo(qn4.x) * ect - acc.x; qp.y = bfhi(qn4.x) * ect - acc.y; qp.z = bflo(qn4.y) * ect - acc.z; qp.w = bfhi(qn4.y) * ect - acc.w;
                pk[hf] = pack4(qp); }
            qout[ks * 64] = (v4u){pk[0].x, pk[0].y, pk[1].x, pk[1].y}; }
        v2u* oout = (v2u*)(ws + WS_DO) + ((size_t)item * 4 + tb) * 8 * 64 + lane;
#pragma unroll
        for (int ss = 0; ss < 4; ++ss) { const int s2 = 4 * half + ss; f32x4 acc = (f32x4){0.f, 0.f, 0.f, 0.f};
#pragma unroll
            for (int kt = 0; kt < 2; ++kt) { const bf16x8 ua = *(const LAS bf16x8*)(RX + (16 * s2 + fr) * 72 + 32 * kt + 8 * fq); acc = MFMA32(ua, qk[kt], acc); }
            oout[s2 * 64] = pack4(acc); }
    }
    if (tid == 0) ((float*)(ws + WS_DD))[item] = expf(gcs[63]);
    __syncthreads();
}

__device__ __forceinline__ void delta_scan_wave(ArgsP a, int chain, int s, const int lane) {
    unsigned char* ws = a->ws;
    const int fr = lane & 15, fq = lane >> 4;
    f32x4 S[8]; bf16x8 Sb[4];
#pragma unroll
    for (int i = 0; i < 8; ++i) S[i] = (f32x4){0.f, 0.f, 0.f, 0.f};
#pragma unroll
    for (int i = 0; i < 4; ++i) Sb[i] = zero8();
    const bf16x8* gbase = (const bf16x8*)(ws + WS_DG) + (size_t)chain * 32 * 2048 + lane;
    bf16x8 G[8][4];
#pragma unroll
    for (int rb = 0; rb < 8; ++rb)
#pragma unroll
        for (int ks = 0; ks < 4; ++ks) G[rb][ks] = gbase[(rb * 4 + ks) * 64];
#pragma unroll 1
    for (int c = 0; c < 32; ++c) {
        const int item = chain * 32 + c;
        const float d = ((const float*)(ws + WS_DD))[item];
        bf16x8* sout = (bf16x8*)(ws + WS_DS) + ((size_t)item * 8 + s) * 4 * 64 + lane;
#pragma unroll
        for (int ks = 0; ks < 4; ++ks) sout[ks * 64] = Sb[ks];
        const v2u* bin = (const v2u*)(ws + WS_DB) + ((size_t)item * 8 + s) * 8 * 64 + lane;
#pragma unroll
        for (int rb = 0; rb < 8; ++rb) { const v2u bc = bin[rb * 64]; S[rb].x = d * S[rb].x + bflo(bc.x); S[rb].y = d * S[rb].y + bfhi(bc.x); S[rb].z = d * S[rb].z + bflo(bc.y); S[rb].w = d * S[rb].w + bfhi(bc.y); }
        const bf16x8* gnext = gbase + (size_t)(c + 1 < 32 ? c + 1 : c) * 2048;
#pragma unroll
        for (int rb = 0; rb < 8; ++rb) {
#pragma unroll
            for (int ks = 0; ks < 4; ++ks) S[rb] = MFMA32(G[rb][ks], Sb[ks], S[rb]);
#pragma unroll
            for (int ks = 0; ks < 4; ++ks) G[rb][ks] = gnext[(rb * 4 + ks) * 64];
        }
#pragma unroll
        for (int ks = 0; ks < 4; ++ks) { const v2u lo = pack4(S[2 * ks]), hi = pack4(S[2 * ks + 1]); const v4u u = (v4u){lo.x, lo.y, hi.x, hi.y}; Sb[ks] = __builtin_bit_cast(bf16x8, u); }
    }
    f32x4* so = (f32x4*)(ws + WS_DF) + ((size_t)(chain * 8 + s) * 8) * 64 + lane;
#pragma unroll
    for (int rb = 0; rb < 8; ++rb) so[rb * 64] = S[rb];
}

__device__ __forceinline__ void delta_out_wave(ArgsP a, int item, int tb, const int lane) {
    unsigned char* ws = a->ws;
    const int c = item & 31, h = (item >> 5) & 7, b = item >> 8, fr = lane & 15, fq = lane >> 4;
    bf16x8 qf[4];
    const bf16x8* qin = (const bf16x8*)(ws + WS_DQ) + ((size_t)item * 4 + tb) * 4 * 64 + lane;
#pragma unroll
    for (int ks = 0; ks < 4; ++ks) qf[ks] = qin[ks * 64];
    const v2u* oin = (const v2u*)(ws + WS_DO) + ((size_t)item * 4 + tb) * 8 * 64 + lane;
    const bf16x8* sin = (const bf16x8*)(ws + WS_DS) + (size_t)item * 8 * 4 * 64 + lane;
    f32x4 o[8]; float ss = 0.f;
#pragma unroll
    for (int s = 0; s < 8; ++s) { const v2u ol = oin[s * 64]; o[s] = (f32x4){bflo(ol.x), bfhi(ol.x), bflo(ol.y), bfhi(ol.y)};
#pragma unroll
        for (int ks = 0; ks < 4; ++ks) o[s] = MFMA32(sin[(s * 4 + ks) * 64], qf[ks], o[s]);
        ss += (o[s].x * o[s].x + o[s].y * o[s].y) + (o[s].z * o[s].z + o[s].w * o[s].w); }
    ss += __shfl_xor(ss, 16); ss += __shfl_xor(ss, 32);
    const float rstd = rsqrtf(ss * (1.f / 128.f) + RMS_EPS);
    const int row = b * TP + 64 * c + 16 * tb + fr;
    const bf16* zp = (const bf16*)(ws + WS_PROJ) + (size_t)row * NPROJ_PAD + 4096 + h * 128 + 4 * fq;
    bf16* mp = (bf16*)(ws + WS_MIX) + (size_t)row * D + h * 128 + 4 * fq;
    const float* nw = a->in[I_DNORM] + 4 * fq;
#pragma unroll
    for (int s = 0; s < 8; ++s) { const v2u z = *(const v2u*)(zp + 16 * s); const f32x4 n4 = *(const f32x4*)(nw + 16 * s);
        f32x4 y; y.x = o[s].x * rstd * n4.x * siluf(bflo(z.x)); y.y = o[s].y * rstd * n4.y * siluf(bfhi(z.x)); y.z = o[s].z * rstd * n4.z * siluf(bflo(z.y)); y.w = o[s].w * rstd * n4.w * siluf(bfhi(z.y));
        *(v2u*)(mp + 16 * s) = pack4(y); }
}


__device__ __forceinline__ float wave_incl_sum(float v, int lane) {
#pragma unroll
    for (int o = 1; o < 64; o <<= 1) { const float u = __shfl_up(v, o); if (lane >= o) v += u; }
    return v;
}
__device__ __forceinline__ float wave_incl_max(float v, int lane) {
#pragma unroll
    for (int o = 1; o < 64; o <<= 1) { const float u = __shfl_up(v, o); if (lane >= o) v = fmaxf(v, u); }
    return v;
}
__device__ __forceinline__ float wave_max(float v) {
#pragma unroll
    for (int o = 1; o < 64; o <<= 1) v = fmaxf(v, __shfl_xor(v, o));
    return v;
}
__device__ __forceinline__ void mlstm_scan_item(ArgsP a, LAS unsigned char* lds, int chain, int vs, const int tid) {
    const int lane = tid & 63, w = __builtin_amdgcn_readfirstlane(tid >> 6), fr = lane & 15, fq = lane >> 4;
    const int b = chain >> 3, h = chain & 7, row0 = b * TP;
    unsigned char* ws = a->ws;
    const bf16* proj = (const bf16*)(ws + WS_PROJ); const float* gates = (const float*)(ws + WS_GATES);
    LAS bf16* KT = (LAS bf16*)lds;
    LAS bf16* VT = (LAS bf16*)(lds + 36864);
    LAS float* wls = (LAS float*)(lds + 46080);
    const float big = a->in[I_BIG][h], bfg = a->in[I_BFG][h];
    const int ks0 = tid >> 4, kk8 = tid & 15;
    const int vtok = tid >> 2, vv8 = tid & 3;
    const bf16* kptr = proj + (size_t)(row0 + ks0) * NPROJ_PAD + 1024 + h * 128 + 8 * kk8;
    const bf16* vptr = proj + (size_t)(row0 + vtok) * NPROJ_PAD + 2048 + h * 256 + 32 * vs + 8 * vv8;
    const float* gptr = gates + (size_t)(row0 + lane) * 16 + h;
    f32x4 acc[2]; acc[0] = (f32x4){0.f, 0.f, 0.f, 0.f}; acc[1] = acc[0];
    float nst = 0.f, m = 0.f;
    v4u kq[2][2], vq[2]; float gi[2], gf[2];
#define ML_LOAD(set, c_) do { const size_t ro = (size_t)(c_) * 64 * NPROJ_PAD; kq[set][0] = *(const v4u*)(kptr + ro); kq[set][1] = *(const v4u*)(kptr + ro + (size_t)32 * NPROJ_PAD); \
        if (tid < 256) vq[set] = *(const v4u*)(vptr + ro); gi[set] = gptr[(size_t)(c_) * 64 * 16]; gf[set] = gptr[(size_t)(c_) * 64 * 16 + 8]; } while (0)
#define ML_STEP(set, c_) do { const int item = chain * 32 + (c_); \
        const float ig = gi[set] + big, lf = logsigf(gf[set] + bfg); \
        const float bcum = wave_incl_sum(lf, lane), blast = __shfl(bcum, 63), gend = blast - bcum + ig; \
        const float mnew = fmaxf(blast + m, wave_max(gend)), sc = expf(blast + m - mnew), wv = expf(gend - mnew) * 0.08838834764831845f; \
        LAS bf16* kt = KT + (set) * 9216; LAS bf16* vt = VT + (set) * 2304; \
        _Pragma("unroll") for (int i = 0; i < 2; ++i) { const unsigned uu[4] = {kq[set][i].x, kq[set][i].y, kq[set][i].z, kq[set][i].w}; const int tok = ks0 + 32 * i; \
            _Pragma("unroll") for (int e = 0; e < 4; ++e) { kt[(8 * kk8 + 2 * e) * 72 + tok] = (bf16)(uu[e] & 0xffffu); kt[(8 * kk8 + 2 * e + 1) * 72 + tok] = (bf16)(uu[e] >> 16); } } \
        if (tid < 256) { const float wt = __shfl(wv, 16 * w + (lane >> 2)); const unsigned uu[4] = {vq[set].x, vq[set].y, vq[set].z, vq[set].w}; \
            _Pragma("unroll") for (int e = 0; e < 4; ++e) { vt[(8 * vv8 + 2 * e) * 72 + vtok] = (bf16)f2bf(bflo(uu[e]) * wt); vt[(8 * vv8 + 2 * e + 1) * 72 + vtok] = (bf16)f2bf(bfhi(uu[e]) * wt); } } \
        if (w == 0) wls[(set) * 64 + lane] = wv; \
        if ((c_) + 2 < 32) ML_LOAD(set, (c_) + 2); \
        if (vs == 0 && tid == 0) ((float*)(ws + WS_MM))[item] = m; \
        __syncthreads(); \
        _Pragma("unroll") for (int vb = 0; vb < 2; ++vb) { *(v2u*)((bf16*)(ws + WS_MC) + ((size_t)item * 256 + 32 * vs + 16 * vb + fr) * 128 + 16 * w + 4 * fq) = pack4(acc[vb]); } \
        if (vs == 0 && tid < 128) { ((float*)(ws + WS_MN))[(size_t)item * 128 + tid] = nst; float sn = 0.f; \
            _Pragma("unroll") for (int s8 = 0; s8 < 8; ++s8) { const v4u kk = *(const LAS v4u*)(kt + tid * 72 + 8 * s8); const LAS float* wl = wls + (set) * 64 + 8 * s8; \
                sn += bflo(kk.x) * wl[0] + bfhi(kk.x) * wl[1] + bflo(kk.y) * wl[2] + bfhi(kk.y) * wl[3] + bflo(kk.z) * wl[4] + bfhi(kk.z) * wl[5] + bflo(kk.w) * wl[6] + bfhi(kk.w) * wl[7]; } \
            nst = sc * nst + sn; } \
        _Pragma("unroll") for (int vb = 0; vb < 2; ++vb) { acc[vb] = acc[vb] * sc; \
            _Pragma("unroll") for (int kt2 = 0; kt2 < 2; ++kt2) { const bf16x8 af = *(const LAS bf16x8*)(kt + (16 * w + fr) * 72 + 32 * kt2 + 8 * fq), bfv = *(const LAS bf16x8*)(vt + (16 * vb + fr) * 72 + 32 * kt2 + 8 * fq); \
                acc[vb] = MFMA32(af, bfv, acc[vb]); } } \
        m = mnew; } while (0)
    ML_LOAD(0, 0); ML_LOAD(1, 1);
#pragma unroll 1
    for (int c2 = 0; c2 < 32; c2 += 2) { ML_STEP(0, c2); ML_STEP(1, c2 + 1); }
#undef ML_LOAD
#undef ML_STEP
#pragma unroll
    for (int vb = 0; vb < 2; ++vb) *(f32x4*)(a->out + O_MCP + ((size_t)chain * 256 + 32 * vs + 16 * vb + fr) * 128 + 16 * w + 4 * fq) = acc[vb];
    if (vs == 0) { if (tid < 128) a->out[O_MNP + (size_t)chain * 128 + tid] = nst; if (tid == 0) a->out[O_MMP + chain] = m; }
    __syncthreads();
}

__device__ __forceinline__ void mlstm_out_item(ArgsP a, LAS unsigned char* lds, int item, const int tid) {
    const int c = item & 31, h = (item >> 5) & 7, b = item >> 8, row0 = b * TP + 64 * c;
    const int lane = tid & 63, w = __builtin_amdgcn_readfirstlane(tid >> 6), fr = lane & 15, fq = lane >> 4;
    unsigned char* ws = a->ws;
    const bf16* proj = (const bf16*)(ws + WS_PROJ); const float* gates = (const float*)(ws + WS_GATES);
    LAS bf16* VT = (LAS bf16*)lds;
    LAS float* ssq = (LAS float*)(lds + 36864);
    const float mc = ((const float*)(ws + WS_MM))[item];
    float av, Mt, et, em;
    { const float ig = gates[(size_t)(row0 + lane) * 16 + h] + a->in[I_BIG][h], lf = logsigf(gates[(size_t)(row0 + lane) * 16 + 8 + h] + a->in[I_BFG][h]);
      const float bcum = wave_incl_sum(lf, lane); av = ig - bcum; Mt = fmaxf(mc, wave_incl_max(av, lane)); et = expf(mc - Mt); em = expf(-(bcum + Mt)); }
#pragma unroll
    for (int i = 0; i < 4; ++i) { const int idx = tid + 512 * i, s = idx >> 5, v8 = idx & 31; const v4u u = *(const v4u*)(proj + (size_t)(row0 + s) * NPROJ_PAD + 2048 + h * 256 + 8 * v8);
        const unsigned uu[4] = {u.x, u.y, u.z, u.w};
#pragma unroll
        for (int e = 0; e < 4; ++e) { VT[(8 * v8 + 2 * e) * 72 + s] = (bf16)(uu[e] & 0xffffu); VT[(8 * v8 + 2 * e + 1) * 72 + s] = (bf16)(uu[e] >> 16); } }
    const int tb = w & 3, half = w >> 2, t = 16 * tb + fr;
    bf16x8 qf[4]; float qn = 0.f;
#pragma unroll
    for (int ks = 0; ks < 4; ++ks) { const v4u u = *(const v4u*)(proj + (size_t)(row0 + t) * NPROJ_PAD + h * 128 + 32 * ks + 8 * fq); qf[ks] = __builtin_bit_cast(bf16x8, u);
        const float* np = (const float*)(ws + WS_MN) + (size_t)item * 128 + 32 * ks + 8 * fq; const f32x4 n0 = *(const f32x4*)np, n1 = *(const f32x4*)(np + 4);
        qn += bflo(u.x) * n0.x + bfhi(u.x) * n0.y + bflo(u.y) * n0.z + bfhi(u.y) * n0.w + bflo(u.z) * n1.x + bfhi(u.z) * n1.y + bflo(u.w) * n1.z + bfhi(u.w) * n1.w; }
    qn += __shfl_xor(qn, 16); qn += __shfl_xor(qn, 32);
    const float Mtt = __shfl(Mt, t), ett = __shfl(et, t), emt = __shfl(em, t);
    v2u smp[4]; float rowsum = 0.f;
#pragma unroll
    for (int sb = 0; sb < 4; ++sb) { smp[sb] = (v2u){0u, 0u};
        if (sb <= tb) { f32x4 qk = (f32x4){0.f, 0.f, 0.f, 0.f};
#pragma unroll
            for (int ks = 0; ks < 4; ++ks) { const v4u u = *(const v4u*)(proj + (size_t)(row0 + 16 * sb + fr) * NPROJ_PAD + 1024 + h * 128 + 32 * ks + 8 * fq); qk = MFMA32(__builtin_bit_cast(bf16x8, u), qf[ks], qk); }
            f32x4 sm;
#pragma unroll
            for (int j = 0; j < 4; ++j) { const int s = 16 * sb + 4 * fq + j; const float as = __shfl(av, s); sm[j] = (s <= t) ? qk[j] * 0.08838834764831845f * expf(as - Mtt) : 0.f; rowsum += sm[j]; }
            smp[sb] = pack4(sm); } }
    rowsum += __shfl_xor(rowsum, 16); rowsum += __shfl_xor(rowsum, 32);
    const float hden = 1.f / fmaxf(fabsf(ett * qn + rowsum), emt);
    const v4u s0u = (v4u){smp[0].x, smp[0].y, smp[1].x, smp[1].y}, s1u = (v4u){smp[2].x, smp[2].y, smp[3].x, smp[3].y};
    const bf16x8 sf0 = __builtin_bit_cast(bf16x8, s0u), sf1 = __builtin_bit_cast(bf16x8, s1u);
    __syncthreads();
    f32x4 hv[8]; float ss = 0.f;
    const bf16* cs = (const bf16*)(ws + WS_MC) + (size_t)item * 256 * 128;
#pragma unroll
    for (int vb = 0; vb < 8; ++vb) { const int vrow = 128 * half + 16 * vb + fr; f32x4 acc = (f32x4){0.f, 0.f, 0.f, 0.f};
#pragma unroll
        for (int ks = 0; ks < 4; ++ks) { const v4u u = *(const v4u*)(cs + (size_t)vrow * 128 + 32 * ks + 8 * fq); acc = MFMA32(__builtin_bit_cast(bf16x8, u), qf[ks], acc); }
        acc = acc * ett;
        { const v2u a0 = *(const LAS v2u*)(VT + vrow * 72 + 4 * fq), a1 = *(const LAS v2u*)(VT + vrow * 72 + 16 + 4 * fq); const v4u au = (v4u){a0.x, a0.y, a1.x, a1.y}; acc = MFMA32(__builtin_bit_cast(bf16x8, au), sf0, acc); }
        { const v2u a0 = *(const LAS v2u*)(VT + vrow * 72 + 32 + 4 * fq), a1 = *(const LAS v2u*)(VT + vrow * 72 + 48 + 4 * fq); const v4u au = (v4u){a0.x, a0.y, a1.x, a1.y}; acc = MFMA32(__builtin_bit_cast(bf16x8, au), sf1, acc); }
        hv[vb] = acc * hden; ss += (hv[vb].x * hv[vb].x + hv[vb].y * hv[vb].y) + (hv[vb].z * hv[vb].z + hv[vb].w * hv[vb].w); }
    ss += __shfl_xor(ss, 16); ss += __shfl_xor(ss, 32);
    if (fq == 0) ssq[half * 64 + t] = ss;
    __syncthreads();
    const float rstd = rsqrtf((ssq[t] + ssq[64 + t]) * (1.f / 256.f) + RMS_EPS);
    const bf16* op = proj + (size_t)(row0 + t) * NPROJ_PAD + 4096 + h * 256 + 128 * half + 4 * fq;
    bf16* mp = (bf16*)(ws + WS_MIX) + (size_t)(row0 + t) * D + h * 256 + 128 * half + 4 * fq;
    const float* nw = a->in[I_MNORM] + h * 256 + 128 * half + 4 * fq;
#pragma unroll
    for (int vb = 0; vb < 8; ++vb) { const v2u o = *(const v2u*)(op + 16 * vb); const f32x4 n4 = *(const f32x4*)(nw + 16 * vb);
        f32x4 y; y.x = hv[vb].x * rstd * n4.x * sigm(bflo(o.x)); y.y = hv[vb].y * rstd * n4.y * sigm(bfhi(o.x)); y.z = hv[vb].z * rstd * n4.z * sigm(bflo(o.y)); y.w = hv[vb].w * rstd * n4.w * sigm(bfhi(o.y));
        *(v2u*)(mp + 16 * vb) = pack4(y); }
    __syncthreads();
}

__device__ __forceinline__ void phase_mixer_even(ArgsP a, LAS unsigned char* lds, int vcu, int G, const int tid) {
#pragma unroll 1
    for (int r = 0; r < 1 + (PROBE_SUB & 1); ++r)
#pragma unroll 1
    for (int it = vcu; it < 1024; it += G) delta_prep_item(a, lds, it, tid);
#pragma unroll 1
    for (int r = 0; r < 1 + ((PROBE_SUB >> 1) & 1); ++r)
#pragma unroll 1
    for (int it = vcu; it < 1024; it += G) lru_prep_item(a, lds, it, tid);
#pragma unroll 1
    for (int r = 0; r < 1 + ((PROBE_SUB >> 2) & 1); ++r)
#pragma unroll 1
    for (int j = vcu; j < 1024; j += G) { const int b = j >> 3, hn = j & 7; delta_rec_item(a, lds, MP + b * TS, TS, hn, a->in[I_SCONV] + (size_t)b * 3 * 4096, a->in[I_SDELTA] + (size_t)j * 16384, a->out + O_DELTAS + (size_t)j * 16384, tid); }
#pragma unroll 1
    for (int r = 0; r < 1 + ((PROBE_SUB >> 3) & 1); ++r)
#pragma unroll 1
    for (int j = vcu; j < 1024; j += G) { const int b = j >> 3, hn = j & 7; lru_rec_item(a, lds, MP + b * TS, TS, hn, a->in[I_SCONV] + (size_t)b * 3 * 4096, a->in[I_SLRU] + (size_t)b * 1024, a->out + O_LRUS + (size_t)b * 1024, tid); }
    const bf16* proj = (const bf16*)(a->ws + WS_PROJ);
    const int nconv = (BP + BS) * 3 * 4096;
    for (int i = vcu * NTHR + tid; i < nconv; i += G * NTHR) {
        const int ch = i & 4095, rj = i >> 12, j = rj % 3, b = rj / 3;
        if (b < BP) a->out[O_CONVP + (size_t)(b * 3 + j) * 4096 + ch] = bf2f(proj[(size_t)(b * TP + TP - 3 + j) * NPROJ_PAD + ch]);
        else { const int bs = b - BP; a->out[O_CONVS + (size_t)(bs * 3 + j) * 4096 + ch] = bf2f(proj[(size_t)(MP + bs * TS + 1 + j) * NPROJ_PAD + ch]); }
    }
}
__device__ __forceinline__ void phase_mixer_even_b(ArgsP a, LAS unsigned char* lds, int vcu, int G, const int tid) {
    const int w = __builtin_amdgcn_readfirstlane(tid >> 6);
    if (w == 0) { for (int it = vcu; it < 256; it += G) delta_scan_wave(a, it >> 3, it & 7, tid & 63); }
    else { LAS float* scr = (LAS float*)(lds + w * 16384);
#pragma unroll 1
        for (int it = vcu * 7 + (w - 1); it < cv::N_REST; it += G * 7) convert_rest_item(a, scr, it, tid & 63); }
}
__device__ __forceinline__ void phase_mixer_even_c(ArgsP a, LAS unsigned char* lds, int vcu, int G, const int tid) {
    const int w = tid >> 6;
#pragma unroll 1
    for (int it = vcu; it < 512; it += G) delta_out_wave(a, 2 * it + (w >> 2), w & 3, tid & 63);
#pragma unroll 1
    for (int it = vcu; it < 1024; it += G) lru_out_item(a, lds, it, tid);
    for (int chain = vcu; chain < 32; chain += G) {
        const float* src = (const float*)(a->ws + WS_DF) + (size_t)chain * 16384; float* dst = a->out + O_DELTAP + (size_t)chain * 16384;
        for (int e = tid; e < 16384; e += NTHR) { const int dk = e >> 7, dv = e & 127;
            dst[e] = src[((((dv >> 4) * 8 + (dk >> 4)) * 64 + ((dk >> 2) & 3) * 16 + (dv & 15)) << 2) + (dk & 3)]; }
    }
}
__device__ __forceinline__ void phase_mixer_odd(ArgsP a, LAS unsigned char* lds, int vcu, int G, const int tid) {
#pragma unroll 1
    for (int r = 0; r < 1 + ((PROBE_SUB >> 4) & 1); ++r)
#pragma unroll 1
    for (int it = vcu; it < 256; it += G) mlstm_scan_item(a, lds, it >> 3, it & 7, tid);
#pragma unroll 1
    for (int r = 0; r < 1 + ((PROBE_SUB >> 5) & 1); ++r)
#pragma unroll 1
    for (int j = vcu; j < 1024; j += G) { const int b = j >> 3, h = j & 7;
        mlstm_rec_item(a, lds, MP + b * TS, TS, h, a->in[I_SMC] + (size_t)j * 32768, a->in[I_SMN] + (size_t)j * 128, a->in[I_SMM] + j, a->out + O_MCS + (size_t)j * 32768, a->out + O_MNS + (size_t)j * 128, a->out + O_MMS + j, tid); }
}
__device__ __forceinline__ void phase_mixer_odd_b(ArgsP a, LAS unsigned char* lds, int vcu, int G, const int tid) {
#pragma unroll 1
    for (int it = vcu; it < 1024; it += G) mlstm_out_item(a, lds, it, tid);
}

__device__ __forceinline__ void phase_ln(const bf16* VB, const float* ST, const float* p1, const bf16* resid, const float* g, const float* bta, bf16* dst, int gw, int NGW, int lane) {
    for (int m = gw; m < M; m += NGW) {
        if (m < MP) {
            float s = 0.f, ss = 0.f;
            if (lane < 32) { const float* sp = ST + (((size_t)(lane >> 2) * M + m) * 4 + (lane & 3)) * 2; s = sp[0]; ss = sp[1]; }
            s = wave_sum(s); ss = wave_sum(ss);
            const float mean = s * (1.f / D), rstd = rsqrtf(fmaxf(ss * (1.f / D) - mean * mean, 0.f) + LN_EPS);
#pragma unroll
            for (int j = 0; j < 4; ++j) { const int col = j * 512 + lane * 8; const v4u v = *(const v4u*)(VB + (size_t)m * D + col);
                const f32x4 g0 = *(const f32x4*)(g + col), g1 = *(const f32x4*)(g + col + 4), b0 = *(const f32x4*)(bta + col), b1 = *(const f32x4*)(bta + col + 4);
                v4u o; o.x = pk2((bflo(v.x) - mean) * rstd * g0.x + b0.x, (bfhi(v.x) - mean) * rstd * g0.y + b0.y); o.y = pk2((bflo(v.y) - mean) * rstd * g0.z + b0.z, (bfhi(v.y) - mean) * rstd * g0.w + b0.w);
                o.z = pk2((bflo(v.z) - mean) * rstd * g1.x + b1.x, (bfhi(v.z) - mean) * rstd * g1.y + b1.y); o.w = pk2((bflo(v.w) - mean) * rstd * g1.z + b1.z, (bfhi(v.w) - mean) * rstd * g1.w + b1.w);
                *(v4u*)(dst + (size_t)m * D + col) = o; }
        } else {
            float v[32]; float s = 0.f;
#pragma unroll
            for (int j = 0; j < 8; ++j) { const size_t off = (size_t)m * D + j * 256 + lane * 4; const float* q1 = p1 + (size_t)(m - MP) * D + j * 256 + lane * 4; f32x4 x = *(const f32x4*)q1;
#pragma unroll
                for (int ch = 1; ch < 16; ++ch) x = x + *(const f32x4*)(q1 + (size_t)ch * 512 * D);
                const v2u rr = *(const v2u*)(resid + off);
                v[4 * j + 0] = x.x + DN_ALPHA * bflo(rr.x); v[4 * j + 1] = x.y + DN_ALPHA * bfhi(rr.x); v[4 * j + 2] = x.z + DN_ALPHA * bflo(rr.y); v[4 * j + 3] = x.w + DN_ALPHA * bfhi(rr.y);
                s += (v[4 * j] + v[4 * j + 1]) + (v[4 * j + 2] + v[4 * j + 3]); }
            const float mean = wave_sum(s) * (1.f / D); float s2 = 0.f;
#pragma unroll
            for (int i = 0; i < 32; ++i) { v[i] -= mean; s2 += v[i] * v[i]; }
            const float rstd = rsqrtf(wave_sum(s2) * (1.f / D) + LN_EPS);
#pragma unroll
            for (int j = 0; j < 8; ++j) { const int col = j * 256 + lane * 4; const f32x4 gg = *(const f32x4*)(g + col), bb = *(const f32x4*)(bta + col);
                v2u o; o.x = pk2(v[4 * j] * rstd * gg.x + bb.x, v[4 * j + 1] * rstd * gg.y + bb.y); o.y = pk2(v[4 * j + 2] * rstd * gg.z + bb.z, v[4 * j + 3] * rstd * gg.w + bb.w);
                *(v2u*)(dst + (size_t)m * D + col) = o; }
        }
    }
}
__device__ __forceinline__ void phase_combine(const float* p1, const bf16* h2, const bf16* pw, bf16* xb, float* outf, int gw, int NGW, int lane) {
    for (int m = MP + gw; m < M; m += NGW) {
#pragma unroll
        for (int j = 0; j < 8; ++j) { const size_t off = (size_t)m * D + j * 256 + lane * 4; const float* q1 = p1 + (size_t)(m - MP) * D + j * 256 + lane * 4; f32x4 x = *(const f32x4*)q1;
#pragma unroll
            for (int ch = 1; ch < 16; ++ch) x = x + *(const f32x4*)(q1 + (size_t)ch * 512 * D);
            const v2u hh = *(const v2u*)(h2 + off), pp = *(const v2u*)(pw + off);
            f32x4 o; o.x = bflo(hh.x) + sigm(x.x) * bflo(pp.x); o.y = bfhi(hh.x) + sigm(x.y) * bfhi(pp.x); o.z = bflo(hh.y) + sigm(x.z) * bflo(pp.y); o.w = bfhi(hh.y) + sigm(x.w) * bfhi(pp.y);
            v2u ob; ob.x = pk2(o.x, o.y); ob.y = pk2(o.z, o.w); *(v2u*)(xb + off) = ob;
            if (outf) *(f32x4*)(outf + off) = o; }
    }
}

constexpr int N_PHASES = 22;
enum { OP_INPROJ = 0, OP_MIXA, OP_MIXB, OP_MIXC, OP_OUTPROJ, OP_LN1, OP_UP, OP_DOWN, OP_LN2, OP_GATE, OP_COMBINE };
enum { GK_LN = 0, GK_BF16 = 1, GK_SQRELU = 2, GK_COMB = 3 };
__global__ void __launch_bounds__(NTHR, 2) mk_fwd(Args a_in) {
    extern __shared__ __attribute__((aligned(16))) unsigned char lds_raw[];
    LAS unsigned char* lds = (LAS unsigned char*)lds_raw;
    ArgsP kp = (ArgsP)__builtin_amdgcn_kernarg_segment_ptr();
    const int lo = a_in.ph_lo, hi = a_in.ph_hi;
    const int wv0 = __builtin_amdgcn_readfirstlane((int)threadIdx.x >> 6);
#if MK_N_LAUNCHES == 1
    volatile LAS unsigned* xst = (volatile LAS unsigned*)(lds + LDS_CTL_OFF);
    if (threadIdx.x < 2) xst[threadIdx.x] = 0u;
    __syncthreads();
    XcdBarrier bar = xcd_barrier_post((unsigned*)(a_in.ws + WS_CTL) + 4096, xst);
#endif
#pragma unroll 1
    for (int p = lo; p < hi; ++p) {
      int nrep = 1;
      if (PROBE_MASK) { const int L_ = p <= 11 ? 0 : 1; const int q_ = p == 0 ? -1 : (L_ == 0 ? p - 1 : (p - 12 < 3 ? p - 12 : p - 11));
        int grp; if (p == 0) grp = 0; else if (q_ == OP_INPROJ || q_ == OP_UP) grp = 1; else if (q_ == OP_OUTPROJ || q_ == OP_DOWN || q_ == OP_GATE) grp = 2; else if (q_ == OP_LN1 || q_ == OP_LN2 || q_ == OP_COMBINE) grp = 3; else grp = (L_ == 0) ? 4 : 5;
        if ((PROBE_MASK >> grp) & 1) nrep = 2; }
      if (p == PROBE_P) nrep = 2;
#pragma unroll 1
      for (int rep = 0; rep < nrep; ++rep) {
        int pp = p; asm volatile("" : "+s"(pp));
        int wvs = wv0; asm volatile("" : "+s"(wvs));
        unsigned ones = ~0u; asm volatile("" : "+s"(ones));
        int tid = (wvs << 6) | (int)__builtin_amdgcn_mbcnt_hi(ones, __builtin_amdgcn_mbcnt_lo(ones, 0u)); asm volatile("" : "+v"(tid));
        int bx = blockIdx.x; asm volatile("" : "+s"(bx));
        int G = gridDim.x; asm volatile("" : "+s"(G));
        ArgsP a = kp; asm volatile("" : "+s"(a));
#define MK_VCU ((G % 8 == 0) ? (bx % 8) * (G / 8) + bx / 8 : bx)
#define MK_WAVE (__builtin_amdgcn_readfirstlane(tid >> 6))
#define MK_GW (MK_VCU * NWAVES + MK_WAVE)
#define MK_NGW (G * NWAVES)
#define MK_LANE (tid & 63)
        unsigned char* ws = a->ws;
        if (pp == 0) {
phase_convert(a, lds, MK_GW, MK_NGW, MK_WAVE, MK_LANE); }
        else {
            const int L = pp <= 11 ? 0 : 1; const int q = L == 0 ? pp - 1 : (pp - 12 < 3 ? pp - 12 : pp - 11);
            bf16* xb = (bf16*)(ws + WS_XB); bf16* mixb = (bf16*)(ws + WS_MIX); bf16* hb = (bf16*)(ws + WS_H); bf16* h2b = (bf16*)(ws + WS_H2); bf16* pwb = (bf16*)(ws + WS_PW);
            bf16* projb = (bf16*)(ws + WS_PROJ); bf16* upb = (bf16*)(ws + WS_PROJ);
            bf16* vbb = (bf16*)(ws + WS_PART0); float* stb = (float*)(ws + WS_PART0 + 34 * MiB); float* part1 = (float*)(ws + WS_PART1); float* gatesb = (float*)(ws + WS_GATES);
            if (q == OP_MIXA) { if (L == 0) phase_mixer_even(a, lds, MK_VCU, G, tid); else phase_mixer_odd(a, lds, MK_VCU, G, tid); }
            else if (q == OP_MIXB) { if (L == 0) phase_mixer_even_b(a, lds, MK_VCU, G, tid); else phase_mixer_odd_b(a, lds, MK_VCU, G, tid); }
            else if (q == OP_MIXC) { phase_mixer_even_c(a, lds, MK_VCU, G, tid); }
            else if (q == OP_LN1) phase_ln(vbb, stb, part1, xb, a->in[I_LN1G] + L * D, a->in[I_LN1B] + L * D, hb, MK_GW, MK_NGW, MK_LANE);
            else if (q == OP_LN2) phase_ln(vbb, stb, part1, hb, a->in[I_LN2G] + L * D, a->in[I_LN2B] + L * D, h2b, MK_GW, MK_NGW, MK_LANE);
            else if (q == OP_COMBINE) phase_combine(part1, h2b, pwb, xb, L == 1 ? a->out + O_Y : nullptr, MK_GW, MK_NGW, MK_LANE);
            else {
                for (int sub = 0; sub < (q == OP_OUTPROJ ? 2 : 1); ++sub) {
                    const bf16* A; const bf16* Bt; int N, K, kind; void* out = nullptr; float* gp = nullptr; const bf16* resid = nullptr; int corder = bx;
                    if (q == OP_INPROJ) { A = xb; Bt = (const bf16*)(ws + (L == 0 ? WS_WINE : WS_WINO)); N = NPROJ_PAD; K = D; kind = GK_BF16; out = projb; gp = gatesb; }
                    else if (q == OP_OUTPROJ && sub == 0) { A = mixb; Bt = (const bf16*)(ws + (L == 0 ? WS_WOUTE : WS_WOUTO)); N = D; K = D; kind = GK_LN; resid = xb; }
                    else if (q == OP_OUTPROJ) { A = (const bf16*)(ws + WS_PB) + (size_t)L * M * PLE; Bt = (const bf16*)(ws + WS_WPLE) + (size_t)L * PLE * D; N = D; K = PLE; kind = GK_BF16; out = pwb; corder = (bx + 128) % G; }
                    else if (q == OP_UP) { A = hb; Bt = (const bf16*)(ws + WS_WUP) + (size_t)L * D * FF; N = FF; K = D; kind = GK_SQRELU; out = upb; }
                    else if (q == OP_DOWN) { A = upb; Bt = (const bf16*)(ws + WS_WDOWN) + (size_t)L * D * FF; N = D; K = FF; kind = GK_LN; resid = hb; }
                    else { A = h2b; Bt = (const bf16*)(ws + WS_WGATE) + (size_t)L * D * D; N = D; K = D; kind = GK_COMB; }
                    pg8::Gemm g{A, Bt, M, N, K};
                    if (kind == GK_LN) { pg8::MainSplit SK; SK.init(K, MK_VCU); pg8::EpiLnStat E{vbb, stb, resid, part1, N, M, DN_ALPHA}; pg8::gemm_phase<pg8::EpiLnStat, pg8::MainSplit, true, true>(lds, g, SK, E, tid); }
                    else if (kind == GK_COMB) { pg8::MainSplit SK; SK.init(K, MK_VCU); pg8::EpiCombine E{h2b, pwb, xb, L == 1 ? a->out + O_Y : nullptr, part1, N}; pg8::gemm_phase<pg8::EpiCombine, pg8::MainSplit, true, true>(lds, g, SK, E, tid); }
                    else if (kind == GK_BF16) { pg8::StaticOrder S; S.init(M, N, K, G, corder); pg8::EpiBf16<0> E{(bf16*)out, N, gp, 24}; pg8::gemm_phase<pg8::EpiBf16<0>, pg8::StaticOrder, true, true>(lds, g, S, E, tid); }
                    else { pg8::StaticOrder S; S.init(M, N, K, G, corder); pg8::EpiBf16<1> E{(bf16*)out, N, nullptr, -1}; pg8::gemm_phase<pg8::EpiBf16<1>, pg8::StaticOrder, true, true>(lds, g, S, E, tid); }
                }
            }
        }
#if MK_N_LAUNCHES == 1
        if (p + 1 < hi || rep + 1 < nrep) { if (p == lo && rep == 0) cg::this_grid().sync(); else xcd_barrier(bar); }
#endif
      }
    }
}

extern "C" void kernel_launch(void* const* d_in, const int* in_sizes, int n_in, void* d_out, int out_size, void* d_ws, size_t ws_size, hipStream_t stream) {
    static int grid = 0;
    if (grid == 0) {
        if (n_in != 35 || (size_t)out_size != O_END || ws_size < WS_END) { fprintf(stderr, "kernel_launch: unexpected shapes: n_in %d out %d (want %zu) ws %zu (want %zu)\n", n_in, out_size, (size_t)O_END, ws_size, (size_t)WS_END); grid = -1; return; }
        int dev = 0, cus = 0, per_cu = 0;
        hipGetDevice(&dev); hipDeviceGetAttribute(&cus, hipDeviceAttributeMultiprocessorCount, dev);
        if (hipFuncSetAttribute((const void*)mk_fwd, hipFuncAttributeMaxDynamicSharedMemorySize, LDS_BYTES) != hipSuccess) { fprintf(stderr, "kernel_launch: hipFuncSetAttribute failed\n"); grid = -1; return; }
        if (hipOccupancyMaxActiveBlocksPerMultiprocessor(&per_cu, (const void*)mk_fwd, NTHR, LDS_BYTES) != hipSuccess || per_cu < 1) { fprintf(stderr, "kernel_launch: occupancy query says %d\n", per_cu); per_cu = 1; }
        (void)hipGetLastError();
        if (cus != 256) { fprintf(stderr, "kernel_launch: built for a 256-CU device (N = 2048 GEMM schedule), got %d\n", cus); grid = -1; return; }
        grid = cus * 1;
    }
    if (grid < 0) return;
    Args a{};
    for (int i = 0; i < 35; ++i) a.in[i] = (const float*)d_in[i];
    a.out = (float*)d_out; a.ws = (unsigned char*)d_ws;
#if MK_N_LAUNCHES == 1
    hipMemsetAsync((char*)d_ws + WS_CTL, 0, 1 * MiB, stream);
    a.ph_lo = 0; a.ph_hi = N_PHASES;
    void* args[] = {&a};
    hipError_t e = hipLaunchCooperativeKernel((const void*)mk_fwd, dim3(grid), dim3(NTHR), args, LDS_BYTES, stream);
    if (e != hipSuccess) fprintf(stderr, "cooperative launch failed: %s (grid %d)\n", hipGetErrorString(e), grid);
#else
    for (int p = 0; p < N_PHASES; ++p) {
        a.ph_lo = p; a.ph_hi = p + 1;
        hipLaunchKernelGGL(mk_fwd, dim3(grid), dim3(NTHR), LDS_BYTES, stream, a);
    }
#endif
}
```

```cpp
#include <hip/hip_runtime.h>
#include <hip/hip_cooperative_groups.h>
#include <cstdio>
#include <cstdint>
namespace cg = cooperative_groups;

#ifndef PROBE_MASK
#define PROBE_MASK 0
#endif
#define PROBE_P (-1)
#define PROBE_SUB 0
#ifndef MK_N_LAUNCHES
#define MK_N_LAUNCHES 1
#endif

namespace pg8 {
#define PG8_LAS __attribute__((address_space(3)))
typedef unsigned short bf16_t;
typedef short bf16x8 __attribute__((ext_vector_type(8)));
typedef float f32x4 __attribute__((ext_vector_type(4)));
typedef unsigned u32x4 __attribute__((ext_vector_type(4)));
constexpr int BM = 256, BK = 64, HALF = 128, HTB = HALF * BK * 2, STAGE_BYTES = 8 * HTB, NXCD = 8, WGM = 8;

__host__ __device__ __forceinline__ int lds_byte(int r, int c) { const int st = (r >> 4) * 2 + (c >> 5), rr = r & 15, cc = c & 31, ob = rr * 64 + cc * 2; return st * 1024 + (ob ^ (((ob >> 9) & 1) << 5)); }
__host__ __device__ __forceinline__ void stage_rc(int b, int& R, int& C) { const int st = b / 1024, sb = b % 1024, swz = sb ^ (((sb >> 9) & 1) << 5); R = (st >> 1) * 16 + swz / 64; C = (st & 1) * 32 + (swz % 64) / 2; }
__host__ __device__ __forceinline__ int perm32(int rho) { const int n = rho >> 4, i = rho & 15; return 8 * (i >> 2) + 4 * n + (i & 3); }

struct Unit { int pm, pn, kt0, nkt, dst; };
struct Gemm { const bf16_t* A; const bf16_t* Bt; int M, N, K; };

struct StaticOrder {
    int nM, nN, nwg, G, c, T;
    __host__ __device__ void init(int M, int N, int K, int G_, int c_) { nM = M / BM; nN = N / BM; nwg = nM * nN; G = G_; c = c_; T = K / BK; }
    __host__ __device__ bool next(int i, Unit& u) const {
        const long L = (long)i * G + c; if (L >= nwg) return false;
        int wgid = (int)L; { const int q = nwg / NXCD, r = nwg % NXCD, xcd = wgid % NXCD, off = wgid / NXCD; wgid = (xcd < r ? xcd * (q + 1) : r * (q + 1) + (xcd - r) * q) + off; }
        const int nig = WGM * nN, gid = wgid / nig, fm = gid * WGM, gsz = (nM - fm) < WGM ? (nM - fm) : WGM;
        u.pm = fm + ((wgid % nig) % gsz); u.pn = (wgid % nig) / gsz; u.kt0 = 0; u.nkt = T; u.dst = 0; return true;
    }
    __device__ __forceinline__ void a_ready(const Unit&) const {}
    __device__ __forceinline__ void done(const Unit&) const {}
};
struct StreamK {
    int nN, T, P, ntot, c;
    __host__ __device__ void init(int M, int N, int K, int G, int c_) { nN = N / BM; T = K / BK; ntot = (M / BM) * nN * T; P = (((ntot + G - 1) / G) + 1) & ~1; c = c_; }
    __host__ __device__ bool next(int i, Unit& u) const {
        int s = c * P; const int e = (s + P < ntot) ? s + P : ntot;
        for (int k = 0; ; ++k) { if (s >= e) return false; const int tile = s / T, kt0 = s - tile * T; const int n = (T - kt0 < e - s) ? T - kt0 : e - s;
            if (k == i) { u.pm = tile / nN; u.pn = tile - u.pm * nN; u.kt0 = kt0; u.nkt = n; u.dst = kt0 ? 1 : 0; return true; }
            s += n; }
    }
    __device__ __forceinline__ void a_ready(const Unit&) const {}
    __device__ __forceinline__ void done(const Unit&) const {}
};
struct MainSplit {
    int T, c;
    __host__ __device__ void init(int K, int c_) { T = K / BK; c = c_; }
    __host__ __device__ bool next(int i, Unit& u) const {
        if (i == 0) { u.pm = c >> 3; u.pn = c & 7; u.kt0 = 0; u.nkt = T; u.dst = 0; return true; }
        if (i == 1) { const int lt = c >> 4, j = c & 15; u.pm = 32 + (lt >> 3); u.pn = lt & 7; u.nkt = T >> 4; u.kt0 = j * u.nkt; u.dst = 1 + j; return true; }
        return false;
    }
    __device__ __forceinline__ void a_ready(const Unit&) const {}
    __device__ __forceinline__ void done(const Unit&) const {}
};
__host__ __device__ __forceinline__ bool split_tile(int tile, int T, int P) { return (tile * T) / P != ((tile + 1) * T - 1) / P; }

__device__ __forceinline__ unsigned cvt_pk_bf16(float lo, float hi) { unsigned r; asm volatile("v_cvt_pk_bf16_f32 %0, %1, %2" : "=v"(r) : "v"(lo), "v"(hi)); return r; }

__device__ __forceinline__ float pg_bflo(unsigned w) { return __builtin_bit_cast(float, w << 16); }
__device__ __forceinline__ float pg_bfhi(unsigned w) { return __builtin_bit_cast(float, w & 0xffff0000u); }
__device__ __forceinline__ void store_chunk(const f32x4 (&acc)[2][2][4][2], const Unit& u, float* C1, int ldc, int wr, int wc, int fr, int fq) {
    const int row0 = u.pm * BM + wr * 64 + fr, col0 = u.pn * BM + wc * 32 + 8 * fq; float* Cb = C1 + ((long)(u.dst - 1) * 512 - 8192) * (long)ldc;
#pragma unroll
    for (int ai = 0; ai < 2; ++ai)
#pragma unroll
        for (int m = 0; m < 4; ++m) { float* rowp = Cb + (size_t)(row0 + ai * HALF + m * 16) * ldc + col0;
#pragma unroll
            for (int bj = 0; bj < 2; ++bj) { *(f32x4*)(rowp + bj * HALF) = acc[ai][bj][m][0]; *(f32x4*)(rowp + bj * HALF + 4) = acc[ai][bj][m][1]; } }
}
struct EpiLnStat {
    static constexpr bool PERM = true, AFTER_DRAIN = false;
    bf16_t* VB; float* ST; const bf16_t* resid; float* C1; int ldc; int mrows; float alpha;
    __device__ __forceinline__ void operator()(const f32x4 (&acc)[2][2][4][2], const Unit& u, int wr, int wc, int fr, int fq) const {
        if (u.dst) { store_chunk(acc, u, C1, ldc, wr, wc, fr, fq); return; }
        const int row0 = u.pm * BM + wr * 64 + fr, col0 = u.pn * BM + wc * 32 + 8 * fq;
#pragma unroll
        for (int ai = 0; ai < 2; ++ai)
#pragma unroll
            for (int m = 0; m < 4; ++m) { const int row = row0 + ai * HALF + m * 16; float s = 0.f, ss = 0.f;
#pragma unroll
                for (int bj = 0; bj < 2; ++bj) { const size_t off = (size_t)row * ldc + col0 + bj * HALF; const u32x4 r = *(const u32x4*)(resid + off);
                    f32x4 v0 = acc[ai][bj][m][0], v1 = acc[ai][bj][m][1];
                    v0[0] += alpha * pg_bflo(r.x); v0[1] += alpha * pg_bfhi(r.x); v0[2] += alpha * pg_bflo(r.y); v0[3] += alpha * pg_bfhi(r.y);
                    v1[0] += alpha * pg_bflo(r.z); v1[1] += alpha * pg_bfhi(r.z); v1[2] += alpha * pg_bflo(r.w); v1[3] += alpha * pg_bfhi(r.w);
                    s += ((v0[0] + v0[1]) + (v0[2] + v0[3])) + ((v1[0] + v1[1]) + (v1[2] + v1[3]));
                    ss += ((v0[0] * v0[0] + v0[1] * v0[1]) + (v0[2] * v0[2] + v0[3] * v0[3])) + ((v1[0] * v1[0] + v1[1] * v1[1]) + (v1[2] * v1[2] + v1[3] * v1[3]));
                    u32x4 w; w.x = cvt_pk_bf16(v0[0], v0[1]); w.y = cvt_pk_bf16(v0[2], v0[3]); w.z = cvt_pk_bf16(v1[0], v1[1]); w.w = cvt_pk_bf16(v1[2], v1[3]);
                    *(u32x4*)(VB + off) = w; }
                s += __shfl_xor(s, 16); s += __shfl_xor(s, 32); ss += __shfl_xor(ss, 16); ss += __shfl_xor(ss, 32);
                if (fq == 0) { float* sp = ST + (((size_t)u.pn * mrows + row) * 4 + wc) * 2; sp[0] = s; sp[1] = ss; } }
    }
};
struct EpiCombine {
    static constexpr bool PERM = true, AFTER_DRAIN = false;
    const bf16_t* h2; const bf16_t* pw; bf16_t* xb; float* outf; float* C1; int ldc;
    __device__ __forceinline__ void operator()(const f32x4 (&acc)[2][2][4][2], const Unit& u, int wr, int wc, int fr, int fq) const {
        if (u.dst) { store_chunk(acc, u, C1, ldc, wr, wc, fr, fq); return; }
        const int row0 = u.pm * BM + wr * 64 + fr, col0 = u.pn * BM + wc * 32 + 8 * fq;
#pragma unroll
        for (int ai = 0; ai < 2; ++ai)
#pragma unroll
            for (int m = 0; m < 4; ++m) { const int row = row0 + ai * HALF + m * 16;
#pragma unroll
                for (int bj = 0; bj < 2; ++bj) { const size_t off = (size_t)row * ldc + col0 + bj * HALF; const u32x4 hh = *(const u32x4*)(h2 + off), pp = *(const u32x4*)(pw + off);
                    const f32x4 a0 = acc[ai][bj][m][0], a1 = acc[ai][bj][m][1]; f32x4 o0, o1;
                    o0[0] = pg_bflo(hh.x) + pg_bflo(pp.x) / (1.f + __expf(-a0[0])); o0[1] = pg_bfhi(hh.x) + pg_bfhi(pp.x) / (1.f + __expf(-a0[1]));
                    o0[2] = pg_bflo(hh.y) + pg_bflo(pp.y) / (1.f + __expf(-a0[2])); o0[3] = pg_bfhi(hh.y) + pg_bfhi(pp.y) / (1.f + __expf(-a0[3]));
                    o1[0] = pg_bflo(hh.z) + pg_bflo(pp.z) / (1.f + __expf(-a1[0])); o1[1] = pg_bfhi(hh.z) + pg_bfhi(pp.z) / (1.f + __expf(-a1[1]));
                    o1[2] = pg_bflo(hh.w) + pg_bflo(pp.w) / (1.f + __expf(-a1[2])); o1[3] = pg_bfhi(hh.w) + pg_bfhi(pp.w) / (1.f + __expf(-a1[3]));
                    u32x4 w; w.x = cvt_pk_bf16(o0[0], o0[1]); w.y = cvt_pk_bf16(o0[2], o0[3]); w.z = cvt_pk_bf16(o1[0], o1[1]); w.w = cvt_pk_bf16(o1[2], o1[3]);
                    *(u32x4*)(xb + off) = w;
                    if (outf) { *(f32x4*)(outf + off) = o0; *(f32x4*)(outf + off + 4) = o1; } } }
    }
};
template <int ACT> struct EpiBf16 {
    static constexpr bool PERM = true, AFTER_DRAIN = false;
    bf16_t* O; int ldc; float* gates; int gate_pn;
    __device__ __forceinline__ void operator()(const f32x4 (&acc)[2][2][4][2], const Unit& u, int wr, int wc, int fr, int fq) const {
        const int row0 = u.pm * BM + wr * 64 + fr; const int col0 = u.pn * BM + wc * 32 + 8 * fq;
        const bool gt = (gates != nullptr) && (u.pn == gate_pn) && (wc == 0) && (fq < 2);
#pragma unroll
        for (int ai = 0; ai < 2; ++ai)
#pragma unroll
            for (int m = 0; m < 4; ++m) { const int row = row0 + ai * HALF + m * 16; bf16_t* rowp = O + (size_t)row * ldc + col0;
#pragma unroll
                for (int bj = 0; bj < 2; ++bj) { f32x4 v0 = acc[ai][bj][m][0], v1 = acc[ai][bj][m][1];
                    if (ACT == 1) {
#pragma unroll
                        for (int j = 0; j < 4; ++j) { const float a = fmaxf(v0[j], 0.f), b = fmaxf(v1[j], 0.f); v0[j] = a * a; v1[j] = b * b; } }
                    u32x4 w; w.x = cvt_pk_bf16(v0[0], v0[1]); w.y = cvt_pk_bf16(v0[2], v0[3]); w.z = cvt_pk_bf16(v1[0], v1[1]); w.w = cvt_pk_bf16(v1[2], v1[3]);
                    *(u32x4*)(rowp + bj * HALF) = w; }
                if (gt) { float* gp = gates + (size_t)row * 16 + 8 * fq; *(f32x4*)gp = acc[ai][0][m][0]; *(f32x4*)(gp + 4) = acc[ai][0][m][1]; } }
    }
};

template <class Epi, class Sched, bool ALIGN_EPI = false, bool SP2 = false>
__device__ __forceinline__ void gemm_phase(PG8_LAS unsigned char* lds, const Gemm g, const Sched& S, const Epi& E, const int tid) {
    const int wid = __builtin_amdgcn_readfirstlane(tid >> 6), lane = tid & 63, wr = wid >> 2, wc = wid & 3, fr = lane & 15, fq = lane >> 4;
    const int K = g.K;
    unsigned voffA[2], voffB[2];
#pragma unroll
    for (int i = 0; i < 2; ++i) { int R, C; stage_rc(tid * 16 + i * 8192, R, C); const int Rb = Epi::PERM ? ((R & ~31) + perm32(R & 31)) : R;
        voffA[i] = (unsigned)(R * K + C) * 2u; voffB[i] = (unsigned)(Rb * K + C) * 2u; }
    const size_t kstep = (size_t)(BK * 2);
    const size_t hstep = (size_t)HALF * K * 2;
    const size_t tstep = 2 * hstep;
    const unsigned ldsw = (unsigned)wid * 1024u;
    const int aoff = lds_byte(wr * 64 + fr, fq * 8), boff = lds_byte(wc * 32 + fr, fq * 8);
#define PG8_SA(b, h) (((b) * 2 + (h)) * HTB)
#define PG8_SB(b, h) ((4 + (b) * 2 + (h)) * HTB)
#define PG8_STAGE(bufoff, gbase, voff) do { _Pragma("unroll") for (int _i = 0; _i < 2; ++_i) \
        __builtin_amdgcn_global_load_lds((const unsigned*)((const char*)(gbase) + (voff)[_i]), (PG8_LAS unsigned*)(lds + (bufoff) + ldsw + _i * 8192), 16, 0, 0); } while (0)
#define PG8_LDA(dst, b, h) do { _Pragma("unroll") for (int m = 0; m < 4; ++m) _Pragma("unroll") for (int k = 0; k < 2; ++k) dst[m][k] = *(const PG8_LAS bf16x8*)(lds + PG8_SA(b, h) + aoff + m * 2048 + k * 1024); } while (0)
#define PG8_LDB(dst, b, h) do { _Pragma("unroll") for (int n = 0; n < 2; ++n) _Pragma("unroll") for (int k = 0; k < 2; ++k) dst[n][k] = *(const PG8_LAS bf16x8*)(lds + PG8_SB(b, h) + boff + n * 2048 + k * 1024); } while (0)
#define PG8_MMA(ai, bj, At, Bt) do { __builtin_amdgcn_s_setprio(1); _Pragma("unroll") for (int m = 0; m < 4; ++m) _Pragma("unroll") for (int n = 0; n < 2; ++n) _Pragma("unroll") for (int k = 0; k < 2; ++k) \
        acc[ai][bj][m][n] = __builtin_amdgcn_mfma_f32_16x16x32_bf16(Bt[n][k], At[m][k], acc[ai][bj][m][n], 0, 0, 0); __builtin_amdgcn_s_setprio(0); } while (0)
#define PG8_WAIT_V(n) asm volatile("s_waitcnt vmcnt(" #n ")" ::: "memory")
#define PG8_WAIT_L(n) asm volatile("s_waitcnt lgkmcnt(" #n ")" ::: "memory")
#define PG8_BAR __builtin_amdgcn_s_barrier()
#define PG8_SCHED __builtin_amdgcn_sched_barrier(0)
    Unit cur, nxt; int ui = 0;
    if (!S.next(0, cur)) return;
    f32x4 acc[2][2][4][2];
#pragma unroll
    for (int a = 0; a < 2; ++a)
#pragma unroll
        for (int b = 0; b < 2; ++b)
#pragma unroll
            for (int m = 0; m < 4; ++m)
#pragma unroll
                for (int n = 0; n < 2; ++n) acc[a][b][m][n] = (f32x4){0.f, 0.f, 0.f, 0.f};
    bf16x8 At[4][2], B0[2][2], B1[2][2];
    const char* cA = (const char*)g.A + (size_t)cur.pm * tstep + (size_t)cur.kt0 * kstep; const char* cB = (const char*)g.Bt + (size_t)cur.pn * tstep + (size_t)cur.kt0 * kstep;
    S.a_ready(cur);
    if constexpr (SP2) {
        PG8_STAGE(PG8_SB(0, 0), cB, voffB); PG8_STAGE(PG8_SB(0, 1), cB + hstep, voffB); PG8_STAGE(PG8_SA(0, 0), cA, voffA); PG8_STAGE(PG8_SA(0, 1), cA + hstep, voffA);
        if (wr == 1) PG8_BAR;
        PG8_WAIT_V(2); PG8_BAR;
        PG8_STAGE(PG8_SB(1, 0), cB + kstep, voffB); PG8_STAGE(PG8_SA(1, 0), cA + kstep, voffA); PG8_STAGE(PG8_SB(1, 1), cB + hstep + kstep, voffB);
        PG8_WAIT_V(6); PG8_BAR;
    } else {
        PG8_STAGE(PG8_SB(0, 0), cB, voffB); PG8_STAGE(PG8_SA(0, 0), cA, voffA); PG8_STAGE(PG8_SB(0, 1), cB + hstep, voffB); PG8_STAGE(PG8_SA(0, 1), cA + hstep, voffA);
        if (wr == 1) PG8_BAR;
        PG8_WAIT_V(4); PG8_BAR;
        PG8_STAGE(PG8_SB(1, 0), cB + kstep, voffB); PG8_STAGE(PG8_SA(1, 0), cA + kstep, voffA); PG8_STAGE(PG8_SB(1, 1), cB + hstep + kstep, voffB);
        PG8_WAIT_V(6); PG8_BAR;
    }
    for (;;) {
        const bool has_next = S.next(ui + 1, nxt);
        const char* nA = has_next ? (const char*)g.A + (size_t)nxt.pm * tstep + (size_t)nxt.kt0 * kstep : cA; const char* nB = has_next ? (const char*)g.Bt + (size_t)nxt.pn * tstep + (size_t)nxt.kt0 * kstep : cB;
        const int nt = cur.nkt;
        for (int t = 0; t < nt; t += 2) {
            const bool last = (t == nt - 2);
            const char* a1 = cA + (size_t)(t + 1) * kstep;
            const char* a2 = last ? nA : cA + (size_t)(t + 2) * kstep; const char* b2 = last ? nB : cB + (size_t)(t + 2) * kstep;
            const char* a3 = a2 + kstep; const char* b3 = b2 + kstep;
            if (last && has_next) S.a_ready(nxt);
            if constexpr (SP2) {
            PG8_LDB(B0, 0, 0); PG8_LDB(B1, 0, 1); PG8_SCHED; PG8_LDA(At, 0, 0); PG8_STAGE(PG8_SA(1, 1), a1 + hstep, voffA);
            PG8_WAIT_V(8); PG8_WAIT_L(0); PG8_BAR; PG8_MMA(0, 0, At, B0); PG8_MMA(0, 1, At, B1); PG8_BAR; PG8_SCHED;
            PG8_LDA(At, 0, 1); PG8_STAGE(PG8_SB(0, 0), b2, voffB); PG8_STAGE(PG8_SB(0, 1), b2 + hstep, voffB); PG8_STAGE(PG8_SA(0, 0), a2, voffA);
            PG8_WAIT_V(8); PG8_WAIT_L(0); PG8_BAR; PG8_MMA(1, 0, At, B0); PG8_MMA(1, 1, At, B1); PG8_BAR; PG8_SCHED;
            PG8_LDB(B0, 1, 0); PG8_LDB(B1, 1, 1); PG8_SCHED; PG8_LDA(At, 1, 0); PG8_STAGE(PG8_SA(0, 1), a2 + hstep, voffA);
            PG8_WAIT_V(8); PG8_WAIT_L(0); PG8_BAR; PG8_MMA(0, 0, At, B0); PG8_MMA(0, 1, At, B1); PG8_BAR; PG8_SCHED;
            PG8_LDA(At, 1, 1); PG8_STAGE(PG8_SB(1, 0), b3, voffB); PG8_STAGE(PG8_SB(1, 1), b3 + hstep, voffB); PG8_STAGE(PG8_SA(1, 0), a3, voffA);
            PG8_WAIT_V(8); PG8_WAIT_L(0); PG8_BAR; PG8_MMA(1, 0, At, B0); PG8_MMA(1, 1, At, B1); PG8_BAR; PG8_SCHED;
            } else {
            PG8_LDB(B0, 0, 0); PG8_SCHED; PG8_LDA(At, 0, 0); PG8_STAGE(PG8_SA(1, 1), a1 + hstep, voffA);
            PG8_WAIT_L(8); PG8_BAR; PG8_WAIT_L(0); PG8_MMA(0, 0, At, B0); PG8_BAR; PG8_SCHED;
            PG8_LDB(B1, 0, 1); PG8_STAGE(PG8_SB(0, 0), b2, voffB);
            PG8_BAR; PG8_WAIT_L(0); PG8_MMA(0, 1, At, B1); PG8_BAR;
            PG8_LDA(At, 0, 1); PG8_STAGE(PG8_SA(0, 0), a2, voffA);
            PG8_BAR; PG8_WAIT_L(0); PG8_MMA(1, 0, At, B0); PG8_BAR; PG8_SCHED;
            PG8_STAGE(PG8_SB(0, 1), b2 + hstep, voffB);
            PG8_WAIT_V(6); PG8_BAR; PG8_MMA(1, 1, At, B1); PG8_BAR;
            PG8_LDB(B0, 1, 0); PG8_SCHED; PG8_LDA(At, 1, 0); PG8_STAGE(PG8_SA(0, 1), a2 + hstep, voffA);
            PG8_WAIT_L(8); PG8_BAR; PG8_WAIT_L(0); PG8_MMA(0, 0, At, B0); PG8_BAR; PG8_SCHED;
            PG8_LDB(B1, 1, 1); PG8_STAGE(PG8_SB(1, 0), b3, voffB);
            PG8_BAR; PG8_WAIT_L(0); PG8_MMA(0, 1, At, B1); PG8_BAR;
            PG8_LDA(At, 1, 1); PG8_STAGE(PG8_SA(1, 0), a3, voffA);
            PG8_BAR; PG8_WAIT_L(0); PG8_MMA(1, 0, At, B0); PG8_BAR; PG8_SCHED;
            PG8_STAGE(PG8_SB(1, 1), b3 + hstep, voffB);
            PG8_WAIT_V(6); PG8_BAR; PG8_MMA(1, 1, At, B1); PG8_BAR;
            }
        }
        if constexpr (ALIGN_EPI) { if (wr == 0) PG8_BAR; }
        E(acc, cur, wr, wc, fr, fq); S.done(cur);
        if (!has_next) break;
#pragma unroll
        for (int a = 0; a < 2; ++a)
#pragma unroll
            for (int b = 0; b < 2; ++b)
#pragma unroll
                for (int m = 0; m < 4; ++m)
#pragma unroll
                    for (int n = 0; n < 2; ++n) acc[a][b][m][n] = (f32x4){0.f, 0.f, 0.f, 0.f};
        cur = nxt; cA = nA; cB = nB; ++ui;
        if constexpr (ALIGN_EPI) { if (wr == 1) PG8_BAR; }
    }
    PG8_WAIT_V(0);
    if constexpr (!ALIGN_EPI) { if (wr == 0) PG8_BAR; }
    PG8_BAR;
#undef PG8_SA
#undef PG8_SB
#undef PG8_STAGE
#undef PG8_LDA
#undef PG8_LDB
#undef PG8_MMA
#undef PG8_WAIT_V
#undef PG8_WAIT_L
#undef PG8_BAR
#undef PG8_SCHED
}
}

constexpr int NWAVES = 8, NTHR = 512;
constexpr int D = 2048, FF = 8192, PLE = 256;
constexpr int TP = 2048, BP = 4, TS = 4, BS = 128;
constexpr int MP = BP * TP, MS = BS * TS, M = MP + MS;
constexpr int NPROJ = 6160, NPROJ_PAD = 6400;
constexpr int NH = 8;
constexpr float LN_EPS = 1e-5f, RMS_EPS = 1e-6f;
constexpr float DN_ALPHA = 1.41421356237f;

constexpr size_t MiB = 1u << 20;
constexpr size_t WS_CTL = 0;
constexpr size_t WS_WINE = 1 * MiB;
constexpr size_t WS_WOUTE = WS_WINE + 25 * MiB;
constexpr size_t WS_WINO = WS_WOUTE + 8 * MiB;
constexpr size_t WS_WOUTO = WS_WINO + 25 * MiB;
constexpr size_t WS_WUP = WS_WOUTO + 8 * MiB;
constexpr size_t WS_WDOWN = WS_WUP + 64 * MiB;
constexpr size_t WS_WPLE = WS_WDOWN + 64 * MiB;
constexpr size_t WS_WGATE = WS_WPLE + 2 * MiB;
constexpr size_t WS_XB = WS_WGATE + 16 * MiB;
constexpr size_t WS_MIX = WS_XB + 34 * MiB;
constexpr size_t WS_H = WS_MIX + 34 * MiB;
constexpr size_t WS_H2 = WS_H + 34 * MiB;
constexpr size_t WS_PW = WS_H2 + 34 * MiB;
constexpr size_t WS_PB = WS_PW + 34 * MiB;
constexpr size_t WS_GATES = WS_PB + 9 * MiB;
constexpr size_t WS_PROJ = WS_GATES + 1 * MiB;
constexpr size_t WS_PART0 = WS_PROJ + 136 * MiB;
constexpr size_t WS_PART1 = WS_PART0 + 68 * MiB;
constexpr size_t WS_LRUW = WS_PART1 + 68 * MiB;
constexpr size_t WS_END = WS_LRUW + 1 * MiB;
constexpr size_t WS_DG = WS_PART0;
constexpr size_t WS_DB = WS_PART0 + 32 * MiB;
constexpr size_t WS_DS = WS_PART0 + 64 * MiB;
constexpr size_t WS_DQ = WS_PART0 + 96 * MiB;
constexpr size_t WS_DO = WS_PART0 + 112 * MiB;
constexpr size_t WS_DD = WS_PART0 + 128 * MiB;
constexpr size_t WS_DF = WS_PART0 + 129 * MiB;
constexpr size_t WS_MC = WS_PART0;
constexpr size_t WS_MN = WS_PART0 + 64 * MiB;
constexpr size_t WS_MM = WS_PART0 + 65 * MiB;
constexpr size_t WS_LRU_HL = WS_H;
constexpr size_t WS_LRU_P = WS_H + 16 * MiB;
constexpr size_t WS_LRU_END = WS_H + 32 * MiB;

constexpr size_t O_Y = 0;
constexpr size_t O_CONVP = (size_t)M * D;
constexpr size_t O_DELTAP = O_CONVP + (size_t)BP * 3 * 4096;
constexpr size_t O_LRUP = O_DELTAP + (size_t)BP * 8 * 128 * 128;
constexpr size_t O_MCP = O_LRUP + (size_t)BP * 1024;
constexpr size_t O_MNP = O_MCP + (size_t)BP * 8 * 256 * 128;
constexpr size_t O_MMP = O_MNP + (size_t)BP * 8 * 128;
constexpr size_t O_CONVS = O_MMP + (size_t)BP * 8;
constexpr size_t O_DELTAS = O_CONVS + (size_t)BS * 3 * 4096;
constexpr size_t O_LRUS = O_DELTAS + (size_t)BS * 8 * 128 * 128;
constexpr size_t O_MCS = O_LRUS + (size_t)BS * 1024;
constexpr size_t O_MNS = O_MCS + (size_t)BS * 8 * 256 * 128;
constexpr size_t O_MMS = O_MNS + (size_t)BS * 8 * 128;
constexpr size_t O_END = O_MMS + (size_t)BS * 8;

constexpr int LDS_BYTES = 147456;
constexpr int LDS_CTL_OFF = 131072;

#define LAS __attribute__((address_space(3)))
typedef unsigned short bf16;
typedef unsigned v4u __attribute__((ext_vector_type(4)));
typedef unsigned v2u __attribute__((ext_vector_type(2)));
typedef float f32x4 __attribute__((ext_vector_type(4)));
#define LDS_WAIT() asm volatile("s_waitcnt lgkmcnt(0)" ::: "memory")
__device__ __forceinline__ unsigned f2bf(float f) { unsigned u = __builtin_bit_cast(unsigned, f); return (u + 0x7fffu + ((u >> 16) & 1u)) >> 16; }
__device__ __forceinline__ unsigned pk2(float lo, float hi) { return f2bf(lo) | (f2bf(hi) << 16); }
__device__ __forceinline__ float bf2f(unsigned short b) { return __builtin_bit_cast(float, ((unsigned)b) << 16); }
__device__ __forceinline__ float bflo(unsigned w) { return __builtin_bit_cast(float, w << 16); }
__device__ __forceinline__ float bfhi(unsigned w) { return __builtin_bit_cast(float, w & 0xffff0000u); }
__device__ __forceinline__ float sigm(float x) { return 1.f / (1.f + expf(-x)); }
__device__ __forceinline__ float siluf(float x) { return x * sigm(x); }
__device__ __forceinline__ float softplusf(float x) { return fmaxf(x, 0.f) + log1pf(expf(-fabsf(x))); }
__device__ __forceinline__ float logsigf(float x) { return -softplusf(-x); }
__device__ __forceinline__ float gelu_tanh(float x) { const float u = 0.7978845608028654f * (x + 0.044715f * x * x * x); return 0.5f * x * (1.f + tanhf(u)); }
__device__ __forceinline__ float wave_sum(float v) {
#pragma unroll
    for (int o = 1; o < 64; o <<= 1) v += __shfl_xor(v, o);
    return v;
}

#define XB_TMO      128
#define XB_XCNT(j)  (256  + 64 * (j))
#define XB_XSUB(j)  (1280 + 64 * (j))
#define XB_XGEN(j)  (2304 + 64 * (j))
#define XB_TOP      3328
#define XB_TOPGEN   3392
#define XCD_BAR_WORDS 3456
#define XB_SPIN_CAP (1u << 22)
__device__ __forceinline__ unsigned xb_ld(unsigned* p)              { return __hip_atomic_load(p, __ATOMIC_RELAXED, __HIP_MEMORY_SCOPE_AGENT); }
__device__ __forceinline__ unsigned xb_add(unsigned* p, unsigned v) { return __hip_atomic_fetch_add(p, v, __ATOMIC_RELAXED, __HIP_MEMORY_SCOPE_AGENT); }
__device__ __forceinline__ unsigned xb_xcc_id() { return (unsigned)__builtin_amdgcn_s_getreg((3 << 11) | 20) & 0xFu; }
#define XB_SPIN(cond, bar) do { unsigned _sp = 0; while (cond) { __builtin_amdgcn_s_sleep(1); \
    if ((++_sp & 255u) == 0u) { if (xb_ld(&(bar)[XB_TMO])) break; if (_sp > XB_SPIN_CAP) { atomicAdd(&(bar)[XB_TMO], 1u); break; } } } } while (0)
struct XcdBarrier { unsigned* bar; unsigned x; volatile LAS unsigned* st; };
__device__ __forceinline__ XcdBarrier xcd_barrier_post(unsigned* bar, volatile LAS unsigned* st) {
    XcdBarrier b; b.bar = bar; b.x = xb_xcc_id(); b.st = st;
    if (threadIdx.x == 0) (void)xb_add(&bar[XB_XCNT(b.x)], 1u);
    return b;
}
__device__ __forceinline__ void xcd_barrier_complete(unsigned* bar, unsigned x, unsigned& nloc, unsigned& nx) {
    const unsigned G = gridDim.x * gridDim.y * gridDim.z;
    unsigned sum, cnt, mine, sp = 0u;
    for (;;) {
        sum = 0u; cnt = 0u; mine = 0u;
#pragma unroll
        for (unsigned j = 0; j < 16; ++j) { const unsigned c = xb_ld(&bar[XB_XCNT(j)]); sum += c; cnt += (c > 0u) ? 1u : 0u; mine = (j == x) ? c : mine; }
        if (sum == G) break;
        __builtin_amdgcn_s_sleep(1);
        if ((++sp & 255u) == 0u) { if (xb_ld(&bar[XB_TMO])) break; if (sp > XB_SPIN_CAP) { atomicAdd(&bar[XB_TMO], 1u); break; } }
    }
    nloc = mine > 0u ? mine : 1u; nx = cnt > 0u ? cnt : 1u;
}
__device__ __forceinline__ void xcd_barrier(const XcdBarrier& b) {
    asm volatile("s_waitcnt vmcnt(0)" ::: "memory");
    __syncthreads();
    if (threadIdx.x == 0) {
        unsigned* bar = b.bar;
        __builtin_amdgcn_s_waitcnt(0);
        unsigned nloc = b.st[0], nx = b.st[1];
        if (nloc == 0u) { xcd_barrier_complete(bar, b.x, nloc, nx); b.st[0] = nloc; b.st[1] = nx; }
        const unsigned old = xb_add(&bar[XB_XSUB(b.x)], 1u);
        const unsigned gen = old / nloc;
        if (old + 1u == (gen + 1u) * nloc) {
            __builtin_amdgcn_fence(__ATOMIC_RELEASE, "agent");
            asm volatile("s_waitcnt vmcnt(0)" ::: "memory");
            const unsigned og = xb_add(&bar[XB_TOP], 1u);
            const unsigned tg = og / nx;
            if (og + 1u == (tg + 1u) * nx) xb_add(&bar[XB_TOPGEN], 1u);
            else XB_SPIN(xb_ld(&bar[XB_TOPGEN]) == tg, bar);
            __builtin_amdgcn_fence(__ATOMIC_ACQUIRE, "agent");
            xb_add(&bar[XB_XGEN(b.x)], 1u);
            asm volatile("s_waitcnt vmcnt(0)" ::: "memory");
        } else {
            XB_SPIN(xb_ld(&bar[XB_XGEN(b.x)]) == gen, bar);
            __builtin_amdgcn_fence(__ATOMIC_ACQUIRE, "agent");
            asm volatile("s_waitcnt vmcnt(0)" ::: "memory");
        }
    }
    __syncthreads();
}

struct Args { const float* in[35]; float* out; unsigned char* ws; int ph_lo, ph_hi; };
typedef const __attribute__((address_space(4))) Args* ArgsP;
enum { I_XP = 0, I_XS, I_PP, I_PS, I_SCONV, I_SDELTA, I_SLRU, I_SMC, I_SMN, I_SMM, I_WINE, I_WCONV, I_BCONV, I_ALOG, I_DTB, I_DNORM, I_LWR, I_LBR, I_LWI, I_LBI, I_LLAM, I_WOUTE,
       I_WINO, I_BIG, I_BFG, I_MNORM, I_WOUTO, I_LN1G, I_LN1B, I_LN2G, I_LN2B, I_WUP, I_WDOWN, I_WPLE, I_WGATE };

__device__ __forceinline__ void p0_transpose_item(const float* W, int K, int N, int Npad, bf16* WT, LAS float* scr, int item, int lane) {
    const int nblk = Npad / 32, kb = item / nblk, nb = item % nblk, k0 = 64 * kb, n0 = 32 * nb;
    const int r = lane >> 3, c4 = lane & 7;
    const bool ok = (n0 + 4 * c4) < N;
    f32x4 v[8];
#pragma unroll
    for (int i = 0; i < 8; ++i) v[i] = ok ? __builtin_nontemporal_load((const f32x4*)(W + (size_t)(k0 + 8 * i + r) * N + n0 + 4 * c4)) : (f32x4){0.f, 0.f, 0.f, 0.f};
#pragma unroll
    for (int i = 0; i < 8; ++i) { LAS float* d = scr + (8 * i + r) * 33 + 4 * c4; d[0] = v[i].x; d[1] = v[i].y; d[2] = v[i].z; d[3] = v[i].w; }
    LDS_WAIT(); asm volatile("" ::: "memory");
    const int c = lane & 7;
#pragma unroll
    for (int j = 0; j < 4; ++j) { const int n = (lane >> 3) + 8 * j; const LAS float* s = scr + (8 * c) * 33 + n;
        v4u o; o.x = pk2(s[0 * 33], s[1 * 33]); o.y = pk2(s[2 * 33], s[3 * 33]); o.z = pk2(s[4 * 33], s[5 * 33]); o.w = pk2(s[6 * 33], s[7 * 33]);
        *(v4u*)(WT + (size_t)(n0 + n) * K + k0 + 8 * c) = o; }
    LDS_WAIT(); asm volatile("" ::: "memory");
}
__device__ __forceinline__ void row_to_bf16(const float* src, bf16* dst, int n, int lane) {
    for (int j = 0; j < n / 256; ++j) { const f32x4 v = *(const f32x4*)(src + j * 256 + lane * 4); v2u o; o.x = pk2(v.x, v.y); o.y = pk2(v.z, v.w); *(v2u*)(dst + j * 256 + lane * 4) = o; }
}

namespace cv { constexpr int I_IN = (D / 64) * (NPROJ_PAD / 32), I_SQ = (D / 64) * (D / 32), I_UP = (D / 64) * (FF / 32), I_DN = (FF / 64) * (D / 32), I_PL = (PLE / 64) * (D / 32);
               constexpr int N_FIRST = I_IN + 128, N_REST = I_IN + 2 * I_SQ + 2 * I_UP + 2 * I_DN + 2 * I_PL + 2 * I_SQ; }
__device__ __forceinline__ void convert_first_item(ArgsP a, LAS float* scr, int r, int lane) {
    unsigned char* ws = a->ws;
    if (r < cv::I_IN) { p0_transpose_item(a->in[I_WINE], D, NPROJ, NPROJ_PAD, (bf16*)(ws + WS_WINE), scr, r, lane); return; } r -= cv::I_IN;
    { const int mat = r / 64, blk = (r / 8) & 7; p0_transpose_item(a->in[mat == 0 ? I_LWR : I_LWI] + (size_t)blk * 16384, 128, 128, 128, (bf16*)(ws + WS_LRUW) + (size_t)(mat * 8 + blk) * 16384, scr, r % 8, lane); }
}
__device__ __forceinline__ void convert_rest_item(ArgsP a, LAS float* scr, int r, int lane) {
    using namespace cv; unsigned char* ws = a->ws;
    if (r < I_SQ) { p0_transpose_item(a->in[I_WOUTE], D, D, D, (bf16*)(ws + WS_WOUTE), scr, r, lane); return; } r -= I_SQ;
    if (r < I_UP) { p0_transpose_item(a->in[I_WUP], D, FF, FF, (bf16*)(ws + WS_WUP), scr, r, lane); return; } r -= I_UP;
    if (r < I_DN) { p0_transpose_item(a->in[I_WDOWN], FF, D, D, (bf16*)(ws + WS_WDOWN), scr, r, lane); return; } r -= I_DN;
    if (r < I_PL) { p0_transpose_item(a->in[I_WPLE], PLE, D, D, (bf16*)(ws + WS_WPLE), scr, r, lane); return; } r -= I_PL;
    if (r < I_SQ) { p0_transpose_item(a->in[I_WGATE], D, D, D, (bf16*)(ws + WS_WGATE), scr, r, lane); return; } r -= I_SQ;
    if (r < I_IN) { p0_transpose_item(a->in[I_WINO], D, NPROJ, NPROJ_PAD, (bf16*)(ws + WS_WINO), scr, r, lane); return; } r -= I_IN;
    if (r < I_SQ) { p0_transpose_item(a->in[I_WOUTO], D, D, D, (bf16*)(ws + WS_WOUTO), scr, r, lane); return; } r -= I_SQ;
    if (r < I_UP) { p0_transpose_item(a->in[I_WUP] + (size_t)D * FF, D, FF, FF, (bf16*)(ws + WS_WUP) + (size_t)D * FF, scr, r, lane); return; } r -= I_UP;
    if (r < I_DN) { p0_transpose_item(a->in[I_WDOWN] + (size_t)D * FF, FF, D, D, (bf16*)(ws + WS_WDOWN) + (size_t)D * FF, scr, r, lane); return; } r -= I_DN;
    if (r < I_PL) { p0_transpose_item(a->in[I_WPLE] + (size_t)PLE * D, PLE, D, D, (bf16*)(ws + WS_WPLE) + (size_t)PLE * D, scr, r, lane); return; } r -= I_PL;
    p0_transpose_item(a->in[I_WGATE] + (size_t)D * D, D, D, D, (bf16*)(ws + WS_WGATE) + (size_t)D * D, scr, r, lane);
}
__device__ __forceinline__ void phase_convert(ArgsP a, LAS unsigned char* lds, int gw, int NGW, int wave, int lane) {
    unsigned char* ws = a->ws;
    LAS float* scr = (LAS float*)(lds + wave * 16384);
    for (int it = gw; it < cv::N_FIRST; it += NGW) convert_first_item(a, scr, it, lane);
    bf16* xb = (bf16*)(ws + WS_XB);
    for (int m = gw; m < M; m += NGW) {
        const float* src = m < MP ? a->in[I_XP] + (size_t)m * D : a->in[I_XS] + (size_t)(m - MP) * D;
        row_to_bf16(src, xb + (size_t)m * D, D, lane);
    }
    bf16* pb = (bf16*)(ws + WS_PB);
    for (int r = gw; r < 2 * M; r += NGW) {
        const int l = r / M, m = r % M;
        const float* src = m < MP ? a->in[I_PP] + ((size_t)l * MP + m) * PLE : a->in[I_PS] + ((size_t)l * MS + (m - MP)) * PLE;
        row_to_bf16(src, pb + (size_t)r * PLE, PLE, lane);
    }
}

__device__ __forceinline__ float conv_in(const bf16* proj, int row0, int tq, int ch, const float* cstate) {
    if (tq >= 0) return bf2f(proj[(size_t)(row0 + tq) * NPROJ_PAD + ch]);
    return cstate ? cstate[(3 + tq) * 4096 + ch] : 0.f;
}
__device__ __forceinline__ float conv4(const bf16* proj, int row0, int t, int ch, const float* cstate, const float* wconv, const float* bconv) {
    float acc = bconv[ch];
#pragma unroll
    for (int j = 0; j < 4; ++j) acc += wconv[j * 4096 + ch] * conv_in(proj, row0, t - 3 + j, ch, cstate);
    return acc;
}

__device__ __forceinline__ void delta_rec_item(ArgsP a, LAS unsigned char* lds, int row0, int T, int h, const float* cstate, const float* S0, float* Sout, const int tid) {
    const int lane = tid & 63, wave = tid >> 6, c = tid & 127, r = tid >> 7;
    const bf16* proj = (const bf16*)(a->ws + WS_PROJ); const float* gates = (const float*)(a->ws + WS_GATES); bf16* mix = (bf16*)(a->ws + WS_MIX);
    const float* wconv = a->in[I_WCONV]; const float* bconv = a->in[I_BCONV];
    LAS float* act = (LAS float*)lds;
    LAS float* nrm = act + 4 * 384;
    LAS float* gb = nrm + 8;
    LAS float* red = gb + 8;
    LAS float* red2 = red + 512;
    LAS float* obuf = red2 + 512;
    float s[32];
#pragma unroll
    for (int i = 0; i < 32; ++i) s[i] = S0 ? S0[(size_t)(32 * r + i) * 128 + c] : 0.f;
    const float aexp = expf(a->in[I_ALOG][h]), dtb = a->in[I_DTB][h];
#pragma unroll 1
    for (int t0 = 0; t0 < T; t0 += 4) {
#pragma unroll
        for (int j = 0; j < 3; ++j) { const int idx = tid + 512 * j, tok = idx / 384, chl = idx % 384, part = chl >> 7, i = chl & 127;
            const int ch = part * 1024 + h * 128 + i;
            act[tok * 384 + chl] = siluf(conv4(proj, row0, t0 + tok, ch, cstate, wconv, bconv)); }
        __syncthreads();
        { const int tok = wave >> 1, part = wave & 1; const float x0 = act[tok * 384 + part * 128 + lane], x1 = act[tok * 384 + part * 128 + 64 + lane];
          const float ss = wave_sum(x0 * x0 + x1 * x1); if (lane == 0) nrm[tok * 2 + part] = rsqrtf(ss + 1e-6f) * (part == 0 ? 0.08838834764831845f : 1.f); }
        if (tid < 4) { const int row = row0 + t0 + tid; const float g = -aexp * softplusf(gates[(size_t)row * 16 + h] + dtb); gb[tid * 2] = expf(g); gb[tid * 2 + 1] = sigm(gates[(size_t)row * 16 + 8 + h]); }
        __syncthreads();
#pragma unroll 1
        for (int tok = 0; tok < 4; ++tok) {
            const float eg = gb[tok * 2], beta = gb[tok * 2 + 1], nq = nrm[tok * 2], nk = nrm[tok * 2 + 1];
            const LAS float* qv = act + tok * 384 + 32 * r; const LAS float* kv = qv + 128;
            float ks = 0.f;
#pragma unroll
            for (int i = 0; i < 32; ++i) ks += kv[i] * s[i];
            red[r * 128 + c] = ks * nk;
            __syncthreads();
            const float kS = red[c] + red[128 + c] + red[256 + c] + red[384 + c];
            const float vnew = beta * (act[tok * 384 + 256 + c] - eg * kS);
            float os = 0.f;
#pragma unroll
            for (int i = 0; i < 32; ++i) { s[i] = eg * s[i] + (kv[i] * nk) * vnew; os += qv[i] * s[i]; }
            red2[r * 128 + c] = os * nq;
            __syncthreads();
            if (r == 0) obuf[tok * 128 + c] = red2[c] + red2[128 + c] + red2[256 + c] + red2[384 + c];
        }
        __syncthreads();
        if (wave < 4) { const int tok = wave, row = row0 + t0 + tok; const float o0 = obuf[tok * 128 + lane], o1 = obuf[tok * 128 + 64 + lane];
            const float rstd = rsqrtf(wave_sum(o0 * o0 + o1 * o1) * (1.f / 128.f) + RMS_EPS);
            const float* nw = a->in[I_DNORM];
            const float z0 = bf2f(proj[(size_t)row * NPROJ_PAD + 4096 + h * 128 + lane]), z1 = bf2f(proj[(size_t)row * NPROJ_PAD + 4096 + h * 128 + 64 + lane]);
            mix[(size_t)row * D + h * 128 + lane] = (bf16)f2bf(o0 * rstd * nw[lane] * siluf(z0));
            mix[(size_t)row * D + h * 128 + 64 + lane] = (bf16)f2bf(o1 * rstd * nw[64 + lane] * siluf(z1)); }
        __syncthreads();
    }
#pragma unroll
    for (int i = 0; i < 32; ++i) Sout[(size_t)(32 * r + i) * 128 + c] = s[i];
}

__device__ __forceinline__ void lru_rec_item(ArgsP a, LAS unsigned char* lds, int row0, int T, int n, const float* cstate, const float* h0, float* hout, const int tid) {
    const int d = tid & 127, part = tid >> 7;
    const bf16* proj = (const bf16*)(a->ws + WS_PROJ); bf16* mix = (bf16*)(a->ws + WS_MIX);
    const float* wconv = a->in[I_WCONV]; const float* bconv = a->in[I_BCONV];
    const float* wr = a->in[I_LWR] + (size_t)n * 16384; const float* wi = a->in[I_LWI] + (size_t)n * 16384;
    LAS float* xr = (LAS float*)lds;
    LAS float* red = xr + 512;
    const int chn = n * 128 + d;
    float hst = h0 ? h0[chn] : 0.f;
    const float br = a->in[I_LBR][chn], bi = a->in[I_LBI][chn], spl = softplusf(-a->in[I_LLAM][chn]);
#pragma unroll 1
    for (int t0 = 0; t0 < T; t0 += 4) {
        { const int tok = tid >> 7; xr[tok * 128 + d] = conv4(proj, row0, t0 + tok, 3072 + chn, cstate, wconv, bconv); }
        __syncthreads();
        float ar[4] = {0.f, 0.f, 0.f, 0.f}, ai[4] = {0.f, 0.f, 0.f, 0.f};
#pragma unroll 4
        for (int cc = 0; cc < 32; ++cc) { const int c = part * 32 + cc; const float w1 = wr[c * 128 + d], w2 = wi[c * 128 + d];
#pragma unroll
        for (int tok = 0; tok < 4; ++tok) { const float x = xr[tok * 128 + c]; ar[tok] += x * w1; ai[tok] += x * w2; } }
#pragma unroll
        for (int tok = 0; tok < 4; ++tok) { red[((tok * 2 + 0) * 4 + part) * 128 + d] = ar[tok]; red[((tok * 2 + 1) * 4 + part) * 128 + d] = ai[tok]; }
        __syncthreads();
        if (part == 0) {
    #pragma unroll 1
        for (int tok = 0; tok < 4; ++tok) {
                const int row = row0 + t0 + tok;
                float rp = br, ip = bi;
#pragma unroll
                for (int p = 0; p < 4; ++p) { rp += red[((tok * 2 + 0) * 4 + p) * 128 + d]; ip += red[((tok * 2 + 1) * 4 + p) * 128 + d]; }
                const float log_a = -8.f * sigm(rp) * spl;
                const float av = expf(log_a);
                const float bx = sqrtf(-expm1f(2.f * log_a)) * sigm(ip) * xr[tok * 128 + d];
                hst = av * hst + bx;
                const float gate = bf2f(proj[(size_t)row * NPROJ_PAD + 5120 + chn]);
                mix[(size_t)row * D + 1024 + chn] = (bf16)f2bf(hst * gelu_tanh(gate));
            }
        }
        __syncthreads();
    }
    if (part == 0) hout[chn] = hst;
}

__device__ __forceinline__ void mlstm_rec_item(ArgsP a, LAS unsigned char* lds, int row0, int T, int h, const float* C0, const float* n0, const float* m0, float* Cout, float* nout, float* mout, const int tid) {
    const int lane = tid & 63, wave = tid >> 6, v = tid & 255, kh = tid >> 8;
    const bf16* proj = (const bf16*)(a->ws + WS_PROJ); const float* gates = (const float*)(a->ws + WS_GATES); bf16* mix = (bf16*)(a->ws + WS_MIX);
    LAS float* qs = (LAS float*)lds;
    LAS float* ks = qs + 512;
    LAS float* vs = ks + 512;
    LAS float* gs = vs + 1024;
    LAS float* red = gs + 8;
    LAS float* dred = red + 1024;
    LAS float* hbuf = dred + 4;
    float cst[64];
#pragma unroll
    for (int i = 0; i < 64; ++i) cst[i] = C0 ? C0[(size_t)v * 128 + 64 * kh + i] : 0.f;
    float nst = (tid < 128) ? (n0 ? n0[tid] : 0.f) : 0.f;
    float mst = m0 ? m0[0] : 0.f;
    const float big = a->in[I_BIG][h], bfg = a->in[I_BFG][h];
#pragma unroll 1
    for (int t0 = 0; t0 < T; t0 += 4) {
#pragma unroll
        for (int j = 0; j < 4; ++j) { const int tok = j, row = row0 + t0 + tok; const bf16* pr = proj + (size_t)row * NPROJ_PAD;
            float val;
            if (tid < 128) val = bf2f(pr[h * 128 + tid]); else if (tid < 256) val = bf2f(pr[1024 + h * 128 + (tid - 128)]) * 0.08838834764831845f; else val = bf2f(pr[2048 + h * 256 + (tid - 256)]);
            if (tid < 128) qs[tok * 128 + tid] = val; else if (tid < 256) ks[tok * 128 + tid - 128] = val; else vs[tok * 256 + tid - 256] = val; }
        if (tid < 4) { const int row = row0 + t0 + tid; gs[tid * 2] = gates[(size_t)row * 16 + h] + big; gs[tid * 2 + 1] = gates[(size_t)row * 16 + 8 + h] + bfg; }
        __syncthreads();
#pragma unroll 1
        for (int tok = 0; tok < 4; ++tok) {
            const int par = tok & 1;
            const float ig = gs[tok * 2], lf = logsigf(gs[tok * 2 + 1]);
            const float mnew = fmaxf(lf + mst, ig), fp = expf(lf + mst - mnew), ip = expf(ig - mnew); mst = mnew;
            const float vv = vs[tok * 256 + v] * ip;
            const LAS float* kv = ks + tok * 128 + 64 * kh; const LAS float* qv = qs + tok * 128 + 64 * kh;
            float num = 0.f;
#pragma unroll
            for (int i = 0; i < 64; ++i) { cst[i] = fp * cst[i] + vv * kv[i]; num += cst[i] * qv[i]; }
            red[(par * 2 + kh) * 256 + v] = num;
            if (tid < 128) { nst = fp * nst + ip * ks[tok * 128 + tid]; const float dp = wave_sum(nst * qs[tok * 128 + tid]); if (lane == 0) dred[par * 2 + wave] = dp; }
            __syncthreads();
            if (kh == 0) { const float nm = red[(par * 2) * 256 + v] + red[(par * 2 + 1) * 256 + v]; const float den = dred[par * 2] + dred[par * 2 + 1];
                hbuf[tok * 256 + v] = nm / fmaxf(fabsf(den), expf(-mnew)); }
        }
        __syncthreads();
        if (wave < 4) { const int tok = wave, row = row0 + t0 + tok; float hv[4]; float ss = 0.f;
#pragma unroll
            for (int j = 0; j < 4; ++j) { hv[j] = hbuf[tok * 256 + j * 64 + lane]; ss += hv[j] * hv[j]; }
            const float rstd = rsqrtf(wave_sum(ss) * (1.f / 256.f) + RMS_EPS);
            const float* nw = a->in[I_MNORM] + h * 256;
#pragma unroll
            for (int j = 0; j < 4; ++j) { const int vi = j * 64 + lane; const float op = bf2f(proj[(size_t)row * NPROJ_PAD + 4096 + h * 256 + vi]);
                mix[(size_t)row * D + h * 256 + vi] = (bf16)f2bf(hv[j] * rstd * nw[vi] * sigm(op)); } }
        __syncthreads();
    }
#pragma unroll
    for (int i = 0; i < 64; ++i) Cout[(size_t)v * 128 + 64 * kh + i] = cst[i];
    if (tid < 128) nout[tid] = nst;
    if (tid == 0) mout[0] = mst;
}


typedef short bf16x8 __attribute__((ext_vector_type(8)));
#define MFMA32(a_, b_, c_) __builtin_amdgcn_mfma_f32_16x16x32_bf16(a_, b_, c_, 0, 0, 0)

__device__ __forceinline__ void lru_prep_item(ArgsP a, LAS unsigned char* lds, int item, const int tid) {
    const int c = item & 31, n = (item >> 5) & 7, b = item >> 8;
    const int lane = tid & 63, w = __builtin_amdgcn_readfirstlane(tid >> 6), fr = lane & 15, fq = lane >> 4;
    unsigned char* ws = a->ws;
    const bf16* proj = (const bf16*)(ws + WS_PROJ);
    LAS bf16* xa = (LAS bf16*)lds;
    LAS float* xf = (LAS float*)(lds + 17408);
    LAS float* obH = (LAS float*)(lds + 51200);
    LAS float* obP = obH + 64 * 132;
    {
        const int t = tid >> 3, sub = tid & 7, ch0 = 3072 + n * 128 + sub * 16;
        const float* wconv = a->in[I_WCONV]; const float* bconv = a->in[I_BCONV];
        float x[16];
#pragma unroll
        for (int i = 0; i < 4; ++i) { const f32x4 bb = *(const f32x4*)(bconv + ch0 + 4 * i); x[4 * i] = bb.x; x[4 * i + 1] = bb.y; x[4 * i + 2] = bb.z; x[4 * i + 3] = bb.w; }
#pragma unroll
        for (int j = 0; j < 4; ++j) { const int tt = 64 * c + t - 3 + j;
            if (tt >= 0) { const bf16* pr = proj + (size_t)(b * TP + tt) * NPROJ_PAD + ch0; const v4u u0 = *(const v4u*)pr, u1 = *(const v4u*)(pr + 8);
                const unsigned uu[8] = {u0.x, u0.y, u0.z, u0.w, u1.x, u1.y, u1.z, u1.w};
#pragma unroll
                for (int i = 0; i < 4; ++i) { const f32x4 ww = *(const f32x4*)(wconv + j * 4096 + ch0 + 4 * i);
                    x[4 * i] += ww.x * bflo(uu[2 * i]); x[4 * i + 1] += ww.y * bfhi(uu[2 * i]); x[4 * i + 2] += ww.z * bflo(uu[2 * i + 1]); x[4 * i + 3] += ww.w * bfhi(uu[2 * i + 1]); } } }
        v4u o0, o1; o0.x = pk2(x[0], x[1]); o0.y = pk2(x[2], x[3]); o0.z = pk2(x[4], x[5]); o0.w = pk2(x[6], x[7]); o1.x = pk2(x[8], x[9]); o1.y = pk2(x[10], x[11]); o1.z = pk2(x[12], x[13]); o1.w = pk2(x[14], x[15]);
        *(LAS v4u*)(xa + t * 136 + sub * 16) = o0; *(LAS v4u*)(xa + t * 136 + sub * 16 + 8) = o1;
#pragma unroll
        for (int i = 0; i < 4; ++i) *(LAS f32x4*)(xf + t * 132 + sub * 16 + 4 * i) = (f32x4){x[4 * i], x[4 * i + 1], x[4 * i + 2], x[4 * i + 3]};
    }
    __syncthreads();
    const bf16* wrT = (const bf16*)(ws + WS_LRUW) + (size_t)n * 16384; const bf16* wiT = wrT + 8 * 16384;
    bf16x8 br[4], bi[4];
#pragma unroll
    for (int ks = 0; ks < 4; ++ks) { br[ks] = *(const bf16x8*)(wrT + (16 * w + fr) * 128 + 32 * ks + 8 * fq); bi[ks] = *(const bf16x8*)(wiT + (16 * w + fr) * 128 + 32 * ks + 8 * fq); }
    f32x4 accr[4], acci[4];
#pragma unroll
    for (int tb = 0; tb < 4; ++tb) { accr[tb] = (f32x4){0.f, 0.f, 0.f, 0.f}; acci[tb] = (f32x4){0.f, 0.f, 0.f, 0.f};
#pragma unroll
        for (int ks = 0; ks < 4; ++ks) { const bf16x8 af = *(const LAS bf16x8*)(xa + (16 * tb + fr) * 136 + 32 * ks + 8 * fq); accr[tb] = MFMA32(af, br[ks], accr[tb]); acci[tb] = MFMA32(af, bi[ks], acci[tb]); } }
    const int dl = 16 * w + fr, chn = n * 128 + dl;
    const float brs = a->in[I_LBR][chn], bis = a->in[I_LBI][chn], spl = softplusf(-a->in[I_LLAM][chn]);
    float Apre = 1.f, Hpre = 0.f;
#pragma unroll
    for (int tb = 0; tb < 4; ++tb) {
        float P[4], Hh[4];
#pragma unroll
        for (int j = 0; j < 4; ++j) { const int t = 16 * tb + 4 * fq + j;
            const float log_a = -8.f * sigm(accr[tb][j] + brs) * spl; const float av = expf(log_a);
            const float bx = sqrtf(-expm1f(2.f * log_a)) * sigm(acci[tb][j] + bis) * xf[t * 132 + dl];
            if (j == 0) { P[0] = av; Hh[0] = bx; } else { P[j] = P[j - 1] * av; Hh[j] = av * Hh[j - 1] + bx; } }
        float Ai = P[3], Hi = Hh[3];
        { const float A2 = __shfl_up(Ai, 16), H2 = __shfl_up(Hi, 16); if (fq >= 1) { Hi = Ai * H2 + Hi; Ai = A2 * Ai; } }
        { const float A2 = __shfl_up(Ai, 32), H2 = __shfl_up(Hi, 32); if (fq >= 2) { Hi = Ai * H2 + Hi; Ai = A2 * Ai; } }
        float Aex = __shfl_up(Ai, 16), Hex = __shfl_up(Hi, 16); if (fq == 0) { Aex = 1.f; Hex = 0.f; }
        const float Atb = __shfl(Ai, 48 + fr), Htb = __shfl(Hi, 48 + fr);
        const float EA = Apre * Aex, EH = Aex * Hpre + Hex;
#pragma unroll
        for (int j = 0; j < 4; ++j) { const int t = 16 * tb + 4 * fq + j; obP[t * 132 + dl] = EA * P[j]; obH[t * 132 + dl] = P[j] * EH + Hh[j]; }
        Hpre = Atb * Hpre + Htb; Apre = Apre * Atb;
    }
    if (fq == 0) { float* e = (float*)(ws + WS_LRU_END) + (size_t)item * 256; e[dl] = Apre; e[128 + dl] = Hpre; }
    __syncthreads();
    {
        const int t = tid >> 3, sub = tid & 7;
        bf16* hl = (bf16*)(ws + WS_LRU_HL) + ((size_t)item * 64 + t) * 128 + sub * 16; bf16* pp = (bf16*)(ws + WS_LRU_P) + ((size_t)item * 64 + t) * 128 + sub * 16;
        const LAS float* sh = obH + t * 132 + sub * 16; const LAS float* sp = obP + t * 132 + sub * 16;
        v4u o0, o1;
        o0.x = pk2(sh[0], sh[1]); o0.y = pk2(sh[2], sh[3]); o0.z = pk2(sh[4], sh[5]); o0.w = pk2(sh[6], sh[7]); o1.x = pk2(sh[8], sh[9]); o1.y = pk2(sh[10], sh[11]); o1.z = pk2(sh[12], sh[13]); o1.w = pk2(sh[14], sh[15]);
        *(v4u*)hl = o0; *(v4u*)(hl + 8) = o1;
        o0.x = pk2(sp[0], sp[1]); o0.y = pk2(sp[2], sp[3]); o0.z = pk2(sp[4], sp[5]); o0.w = pk2(sp[6], sp[7]); o1.x = pk2(sp[8], sp[9]); o1.y = pk2(sp[10], sp[11]); o1.z = pk2(sp[12], sp[13]); o1.w = pk2(sp[14], sp[15]);
        *(v4u*)pp = o0; *(v4u*)(pp + 8) = o1;
    }
    __syncthreads();
}
__device__ __forceinline__ void lru_out_item(ArgsP a, LAS unsigned char* lds, int item, const int tid) {
    const int c = item & 31, n = (item >> 5) & 7, b = item >> 8;
    unsigned char* ws = a->ws;
    LAS float* carry = (LAS float*)lds;
    if (tid < 128) { float cr = 0.f; const float* e = (const float*)(ws + WS_LRU_END) + (size_t)(item - c) * 256;
        for (int k = 0; k < c; ++k) cr = e[k * 256 + 128 + tid] + e[k * 256 + tid] * cr;
        carry[tid] = cr; }
    __syncthreads();
    const int t = tid >> 3, sub = tid & 7, d0 = sub * 16, row = b * TP + 64 * c + t;
    const bf16* hl = (const bf16*)(ws + WS_LRU_HL) + ((size_t)item * 64 + t) * 128 + d0; const bf16* pp = (const bf16*)(ws + WS_LRU_P) + ((size_t)item * 64 + t) * 128 + d0;
    const bf16* gp = (const bf16*)(ws + WS_PROJ) + (size_t)row * NPROJ_PAD + 5120 + n * 128 + d0;
    const v4u h0 = *(const v4u*)hl, h1 = *(const v4u*)(hl + 8), p0 = *(const v4u*)pp, p1 = *(const v4u*)(pp + 8), g0 = *(const v4u*)gp, g1 = *(const v4u*)(gp + 8);
    const unsigned hu[8] = {h0.x, h0.y, h0.z, h0.w, h1.x, h1.y, h1.z, h1.w}, pu[8] = {p0.x, p0.y, p0.z, p0.w, p1.x, p1.y, p1.z, p1.w}, gu[8] = {g0.x, g0.y, g0.z, g0.w, g1.x, g1.y, g1.z, g1.w};
    float hv[16]; unsigned ou[8];
#pragma unroll
    for (int i = 0; i < 8; ++i) { hv[2 * i] = bflo(hu[i]) + bflo(pu[i]) * carry[d0 + 2 * i]; hv[2 * i + 1] = bfhi(hu[i]) + bfhi(pu[i]) * carry[d0 + 2 * i + 1];
        ou[i] = pk2(hv[2 * i] * gelu_tanh(bflo(gu[i])), hv[2 * i + 1] * gelu_tanh(bfhi(gu[i]))); }
    bf16* mp = (bf16*)(ws + WS_MIX) + (size_t)row * D + 1024 + n * 128 + d0;
    *(v4u*)mp = (v4u){ou[0], ou[1], ou[2], ou[3]}; *(v4u*)(mp + 8) = (v4u){ou[4], ou[5], ou[6], ou[7]};
    if (c == 31 && t == 63) { float* o = a->out + O_LRUP + (size_t)b * 1024 + n * 128 + d0;
#pragma unroll
        for (int i = 0; i < 4; ++i) *(f32x4*)(o + 4 * i) = (f32x4){hv[4 * i], hv[4 * i + 1], hv[4 * i + 2], hv[4 * i + 3]}; }
    __syncthreads();
}


__device__ __forceinline__ void conv16_prompt(const bf16* proj, const float* wconv, const float* bconv, int b, int tseq, int ch0, float (&x)[16]) {
#pragma unroll
    for (int i = 0; i < 4; ++i) { const f32x4 bb = *(const f32x4*)(bconv + ch0 + 4 * i); x[4 * i] = bb.x; x[4 * i + 1] = bb.y; x[4 * i + 2] = bb.z; x[4 * i + 3] = bb.w; }
#pragma unroll
    for (int j = 0; j < 4; ++j) { const int tt = tseq - 3 + j;
        if (tt >= 0) { const bf16* pr = proj + (size_t)(b * TP + tt) * NPROJ_PAD + ch0; const v4u u0 = *(const v4u*)pr, u1 = *(const v4u*)(pr + 8);
            const unsigned uu[8] = {u0.x, u0.y, u0.z, u0.w, u1.x, u1.y, u1.z, u1.w};
#pragma unroll
            for (int i = 0; i < 4; ++i) { const f32x4 ww = *(const f32x4*)(wconv + j * 4096 + ch0 + 4 * i);
                x[4 * i] += ww.x * bflo(uu[2 * i]); x[4 * i + 1] += ww.y * bfhi(uu[2 * i]); x[4 * i + 2] += ww.z * bflo(uu[2 * i + 1]); x[4 * i + 3] += ww.w * bfhi(uu[2 * i + 1]); } } }
}
__device__ __forceinline__ void st16_bf16(LAS bf16* p, const float (&x)[16]) {
    v4u o0, o1; o0.x = pk2(x[0], x[1]); o0.y = pk2(x[2], x[3]); o0.z = pk2(x[4], x[5]); o0.w = pk2(x[6], x[7]); o1.x = pk2(x[8], x[9]); o1.y = pk2(x[10], x[11]); o1.z = pk2(x[12], x[13]); o1.w = pk2(x[14], x[15]);
    *(LAS v4u*)p = o0; *(LAS v4u*)(p + 8) = o1;
}
__device__ __forceinline__ v2u pack4(const f32x4 v) { v2u o; o.x = pk2(v.x, v.y); o.y = pk2(v.z, v.w); return o; }
__device__ __forceinline__ bf16x8 zero8() { return (bf16x8){0, 0, 0, 0, 0, 0, 0, 0}; }

__device__ __forceinline__ void delta_prep_item(ArgsP a, LAS unsigned char* lds, int item, const int tid) {
    const int c = item & 31, h = (item >> 5) & 7, b = item >> 8;
    const int lane = tid & 63, w = __builtin_amdgcn_readfirstlane(tid >> 6), fr = lane & 15, fq = lane >> 4;
    unsigned char* ws = a->ws;
    const bf16* proj = (const bf16*)(ws + WS_PROJ);
    LAS bf16* Kn = (LAS bf16*)lds;
    LAS bf16* Qn = (LAS bf16*)(lds + 17408);
    LAS bf16* KdT = (LAS bf16*)(lds + 34816);
    LAS bf16* RX = (LAS bf16*)(lds + 53248);
    LAS bf16* Mm = (LAS bf16*)(lds + 90112);
    LAS bf16* QKd = (LAS bf16*)(lds + 99328);
    LAS bf16* Td = (LAS bf16*)(lds + 108544);
    LAS bf16* RT = (LAS bf16*)(lds + 111616) + w * 768;
    LAS float* gl = (LAS float*)(lds + 123904);
    LAS float* gcs = gl + 64;
    LAS float* bet = gcs + 64;
    const int t = tid >> 3, sub = tid & 7;
    {
        if (sub == 0) { const float* gt = (const float*)(ws + WS_GATES) + (size_t)(b * TP + 64 * c + t) * 16;
            gl[t] = -expf(a->in[I_ALOG][h]) * softplusf(gt[h] + a->in[I_DTB][h]); bet[t] = sigm(gt[8 + h]); }
        __syncthreads();
        if (w == 0) { float v = gl[lane];
#pragma unroll
            for (int o = 1; o < 64; o <<= 1) { const float u = __shfl_up(v, o); if (lane >= o) v += u; }
            gcs[lane] = v; }
        __syncthreads();
    }
    {
        const float* wconv = a->in[I_WCONV]; const float* bconv = a->in[I_BCONV];
        const float gc = gcs[t], glast = gcs[63], beta = bet[t];
        const float ec = expf(gc), ed = expf(glast - gc);
        float x[16], y[16];
        conv16_prompt(proj, wconv, bconv, b, 64 * c + t, 1024 + h * 128 + sub * 16, x);
        float ss = 0.f;
#pragma unroll
        for (int i = 0; i < 16; ++i) { x[i] = siluf(x[i]); ss += x[i] * x[i]; }
        ss += __shfl_xor(ss, 1); ss += __shfl_xor(ss, 2); ss += __shfl_xor(ss, 4);
        const float rk = rsqrtf(ss + 1e-6f);
#pragma unroll
        for (int i = 0; i < 16; ++i) x[i] *= rk;
        st16_bf16(Kn + t * 136 + sub * 16, x);
#pragma unroll
        for (int i = 0; i < 16; ++i) KdT[(sub * 16 + i) * 72 + t] = (bf16)f2bf(x[i] * ed);
#pragma unroll
        for (int i = 0; i < 16; ++i) y[i] = x[i] * (beta * ec);
        st16_bf16(RX + t * 264 + 128 + sub * 16, y);
        conv16_prompt(proj, wconv, bconv, b, 64 * c + t, h * 128 + sub * 16, x);
        ss = 0.f;
#pragma unroll
        for (int i = 0; i < 16; ++i) { x[i] = siluf(x[i]); ss += x[i] * x[i]; }
        ss += __shfl_xor(ss, 1); ss += __shfl_xor(ss, 2); ss += __shfl_xor(ss, 4);
        const float rq = rsqrtf(ss + 1e-6f) * 0.08838834764831845f;
#pragma unroll
        for (int i = 0; i < 16; ++i) x[i] *= rq;
        st16_bf16(Qn + t * 136 + sub * 16, x);
        conv16_prompt(proj, wconv, bconv, b, 64 * c + t, 2048 + h * 128 + sub * 16, x);
#pragma unroll
        for (int i = 0; i < 16; ++i) x[i] = siluf(x[i]) * beta;
        st16_bf16(RX + t * 264 + sub * 16, x);
    }
    __syncthreads();
    {
        const int ib = w >> 1;
#pragma unroll
        for (int jj = 0; jj < 2; ++jj) { const int jb = 2 * (w & 1) + jj;
            f32x4 ak = (f32x4){0.f, 0.f, 0.f, 0.f}, aq = (f32x4){0.f, 0.f, 0.f, 0.f};
            if (jb <= ib) {
#pragma unroll
                for (int ks = 0; ks < 4; ++ks) { const bf16x8 bfr = *(const LAS bf16x8*)(Kn + (16 * jb + fr) * 136 + 32 * ks + 8 * fq);
                    const bf16x8 afk = *(const LAS bf16x8*)(Kn + (16 * ib + fr) * 136 + 32 * ks + 8 * fq), afq = *(const LAS bf16x8*)(Qn + (16 * ib + fr) * 136 + 32 * ks + 8 * fq);
                    ak = MFMA32(afk, bfr, ak); aq = MFMA32(afq, bfr, aq); } }
            const int col = 16 * jb + fr; const float gcc = gcs[col];
#pragma unroll
            for (int j = 0; j < 4; ++j) { const int row = 16 * ib + 4 * fq + j; const float dec = (row >= col) ? expf(gcs[row] - gcc) : 0.f;
                Mm[row * 72 + col] = (bf16)f2bf(row > col ? -bet[row] * ak[j] * dec : 0.f);
                QKd[row * 72 + col] = (bf16)f2bf(aq[j] * dec); }
        }
    }
    __syncthreads();
    if (w == 0) { const int blk = lane >> 4, col = lane & 15; float xi[16];
#pragma unroll
        for (int i = 0; i < 16; ++i) { float acc = (i == col) ? 1.f : 0.f; const LAS bf16* mr = Mm + (16 * blk + i) * 72 + 16 * blk;
#pragma unroll
            for (int j = 0; j < i; ++j) acc += bf2f(mr[j]) * xi[j];
            xi[i] = acc; }
#pragma unroll
        for (int i = 0; i < 16; ++i) Td[(blk * 16 + i) * 24 + col] = (bf16)f2bf(xi[i]); }
    f32x4 rhs[2][4];
#pragma unroll
    for (int cbl = 0; cbl < 2; ++cbl)
#pragma unroll
        for (int bb = 0; bb < 4; ++bb)
#pragma unroll
            for (int j = 0; j < 4; ++j) rhs[cbl][bb][j] = bf2f(RX[(16 * bb + 4 * fq + j) * 264 + 32 * w + 16 * cbl + fr]);
    __syncthreads();
#pragma unroll
    for (int cbl = 0; cbl < 2; ++cbl) { const int cb = 2 * w + cbl;
#pragma unroll
        for (int bb = 0; bb < 4; ++bb) {
            f32x4 acc = rhs[cbl][bb];
#pragma unroll
            for (int ks = 0; ks < 2; ++ks) { if (32 * ks < 16 * bb) { const bool ok = (32 * ks + 8 * fq) < 16 * bb;
                const bf16x8 af = ok ? *(const LAS bf16x8*)(Mm + (16 * bb + fr) * 72 + 32 * ks + 8 * fq) : zero8();
                const bf16x8 bf_ = ok ? *(const LAS bf16x8*)(RX + (16 * cb + fr) * 72 + 32 * ks + 8 * fq) : zero8();
                acc = MFMA32(af, bf_, acc); } }
            *(LAS v2u*)(RT + (16 * cbl + fr) * 24 + 4 * fq) = pack4(acc);
            asm volatile("s_waitcnt lgkmcnt(0)" ::: "memory");
            const bool ok2 = fq < 2;
            const bf16x8 af2 = ok2 ? *(const LAS bf16x8*)(Td + (bb * 16 + fr) * 24 + 8 * fq) : zero8();
            const bf16x8 bf2 = ok2 ? *(const LAS bf16x8*)(RT + (16 * cbl + fr) * 24 + 8 * fq) : zero8();
            const f32x4 xb4 = MFMA32(af2, bf2, ((f32x4){0.f, 0.f, 0.f, 0.f}));
            *(LAS v2u*)(RX + (16 * cb + fr) * 72 + 16 * bb + 4 * fq) = pack4(xb4);
            asm volatile("s_waitcnt lgkmcnt(0)" ::: "memory");
        }
    }
    __syncthreads();
    {
        v4u* gout = (v4u*)(ws + WS_DG) + ((size_t)item * 8 + w) * 4 * 64 + lane;
        bf16x8 kb[2];
#pragma unroll
        for (int kt = 0; kt < 2; ++kt) kb[kt] = *(const LAS bf16x8*)(KdT + (16 * w + fr) * 72 + 32 * kt + 8 * fq);
#pragma unroll
        for (int ks = 0; ks < 4; ++ks) { f32x4 g0 = (f32x4){0.f, 0.f, 0.f, 0.f}, g1 = (f32x4){0.f, 0.f, 0.f, 0.f};
#pragma unroll
            for (int kt = 0; kt < 2; ++kt) { const bf16x8 a0 = *(const LAS bf16x8*)(RX + (128 + 32 * ks + fr) * 72 + 32 * kt + 8 * fq), a1 = *(const LAS bf16x8*)(RX + (128 + 32 * ks + 16 + fr) * 72 + 32 * kt + 8 * fq);
                g0 = MFMA32(a0, kb[kt], g0); g1 = MFMA32(a1, kb[kt], g1); }
            const v2u p0 = pack4(-g0), p1 = pack4(-g1); gout[ks * 64] = (v4u){p0.x, p0.y, p1.x, p1.y}; }
        v2u* bout = (v2u*)(ws + WS_DB) + ((size_t)item * 64 + w) * 64 + lane;
#pragma unroll
        for (int s2 = 0; s2 < 8; ++s2) { f32x4 bc = (f32x4){0.f, 0.f, 0.f, 0.f};
#pragma unroll
            for (int kt = 0; kt < 2; ++kt) { const bf16x8 ub = *(const LAS bf16x8*)(RX + (16 * s2 + fr) * 72 + 32 * kt + 8 * fq); bc = MFMA32(kb[kt], ub, bc); }
            bout[(size_t)s2 * 8 * 64] = pack4(bc); }
    }
    {
        const int tb = w >> 1, half = w & 1; const float ect = expf(gcs[16 * tb + fr]);
        bf16x8 qk[2];
#pragma unroll
        for (int kt = 0; kt < 2; ++kt) qk[kt] = *(const LAS bf16x8*)(QKd + (16 * tb + fr) * 72 + 32 * kt + 8 * fq);
        v4u* qout = (v4u*)(ws + WS_DQ) + ((size_t)item * 4 + tb) * 4 * 64 + lane;
#pragma unroll
        for (int kk = 0; kk < 2; ++kk) { const int ks = 2 * half + kk; v2u pk[2];
#pragma unroll
            for (int hf = 0; hf < 2; ++hf) { const int db = 2 * ks + hf; f32x4 acc = (f32x4){0.f, 0.f, 0.f, 0.f};
#pragma unroll
                for (int kt = 0; kt < 2; ++kt) { const bf16x8 wa = *(const LAS bf16x8*)(RX + (128 + 16 * db + fr) * 72 + 32 * kt + 8 * fq); acc = MFMA32(wa, qk[kt], acc); }
                const v2u qn4 = *(const LAS v2u*)(Qn + (16 * tb + fr) * 136 + 16 * db + 4 * fq);
                f32x4 qp; qp.x = bflo(qn4.x) * ect - acc.x; qp.y = bfhi(qn4.x) * ect - acc.y; qp.z = bflo(qn4.y) * ect - acc.z; qp.w = bfhi(qn4.y) * ect - acc.w;
                pk[hf] = pack4(qp); }
            qout[ks * 64] = (v4u){pk[0].x, pk[0].y, pk[1].x, pk[1].y}; }
        v2u* oout = (v2u*)(ws + WS_DO) + ((size_t)item * 4 + tb) * 8 * 64 + lane;
#pragma unroll
        for (int ss = 0; ss < 4; ++ss) { const int s2 = 4 * half + ss; f32x4 acc = (f32x4){0.f, 0.f, 0.f, 0.f};
#pragma unroll
            for (int kt = 0; kt < 2; ++kt) { const bf16x8 ua = *(const LAS bf16x8*)(RX + (16 * s2 + fr) * 72 + 32 * kt + 8 * fq); acc = MFMA32(ua, qk[kt], acc); }
            oout[s2 * 64] = pack4(acc); }
    }
    if (tid == 0) ((float*)(ws + WS_DD))[item] = expf(gcs[63]);
    __syncthreads();
}

__device__ __forceinline__ void delta_scan_wave(ArgsP a, int chain, int s, const int lane) {
    unsigned char* ws = a->ws;
    const int fr = lane & 15, fq = lane >> 4;
    f32x4 S[8]; bf16x8 Sb[4];
#pragma unroll
    for (int i = 0; i < 8; ++i) S[i] = (f32x4){0.f, 0.f, 0.f, 0.f};
#pragma unroll
    for (int i = 0; i < 4; ++i) Sb[i] = zero8();
    const bf16x8* gbase = (const bf16x8*)(ws + WS_DG) + (size_t)chain * 32 * 2048 + lane;
    bf16x8 G[8][4];
#pragma unroll
    for (int rb = 0; rb < 8; ++rb)
#pragma unroll
        for (int ks = 0; ks < 4; ++ks) G[rb][ks] = gbase[(rb * 4 + ks) * 64];
#pragma unroll 1
    for (int c = 0; c < 32; ++c) {
        const int item = chain * 32 + c;
        const float d = ((const float*)(ws + WS_DD))[item];
        bf16x8* sout = (bf16x8*)(ws + WS_DS) + ((size_t)item * 8 + s) * 4 * 64 + lane;
#pragma unroll
        for (int ks = 0; ks < 4; ++ks) sout[ks * 64] = Sb[ks];
        const v2u* bin = (const v2u*)(ws + WS_DB) + ((size_t)item * 8 + s) * 8 * 64 + lane;
#pragma unroll
        for (int rb = 0; rb < 8; ++rb) { const v2u bc = bin[rb * 64]; S[rb].x = d * S[rb].x + bflo(bc.x); S[rb].y = d * S[rb].y + bfhi(bc.x); S[rb].z = d * S[rb].z + bflo(bc.y); S[rb].w = d * S[rb].w + bfhi(bc.y); }
        const bf16x8* gnext = gbase + (size_t)(c + 1 < 32 ? c + 1 : c) * 2048;
#pragma unroll
        for (int rb = 0; rb < 8; ++rb) {
#pragma unroll
            for (int ks = 0; ks < 4; ++ks) S[rb] = MFMA32(G[rb][ks], Sb[ks], S[rb]);
#pragma unroll
            for (int ks = 0; ks < 4; ++ks) G[rb][ks] = gnext[(rb * 4 + ks) * 64];
        }
#pragma unroll
        for (int ks = 0; ks < 4; ++ks) { const v2u lo = pack4(S[2 * ks]), hi = pack4(S[2 * ks + 1]); const v4u u = (v4u){lo.x, lo.y, hi.x, hi.y}; Sb[ks] = __builtin_bit_cast(bf16x8, u); }
    }
    f32x4* so = (f32x4*)(ws + WS_DF) + ((size_t)(chain * 8 + s) * 8) * 64 + lane;
#pragma unroll
    for (int rb = 0; rb < 8; ++rb) so[rb * 64] = S[rb];
}

__device__ __forceinline__ void delta_out_wave(ArgsP a, int item, int tb, const int lane) {
    unsigned char* ws = a->ws;
    const int c = item & 31, h = (item >> 5) & 7, b = item >> 8, fr = lane & 15, fq = lane >> 4;
    bf16x8 qf[4];
    const bf16x8* qin = (const bf16x8*)(ws + WS_DQ) + ((size_t)item * 4 + tb) * 4 * 64 + lane;
#pragma unroll
    for (int ks = 0; ks < 4; ++ks) qf[ks] = qin[ks * 64];
    const v2u* oin = (const v2u*)(ws + WS_DO) + ((size_t)item * 4 + tb) * 8 * 64 + lane;
    const bf16x8* sin = (const bf16x8*)(ws + WS_DS) + (size_t)item * 8 * 4 * 64 + lane;
    f32x4 o[8]; float ss = 0.f;
#pragma unroll
    for (int s = 0; s < 8; ++s) { const v2u ol = oin[s * 64]; o[s] = (f32x4){bflo(ol.x), bfhi(ol.x), bflo(ol.y), bfhi(ol.y)};
#pragma unroll
        for (int ks = 0; ks < 4; ++ks) o[s] = MFMA32(sin[(s * 4 + ks) * 64], qf[ks], o[s]);
        ss += (o[s].x * o[s].x + o[s].y * o[s].y) + (o[s].z * o[s].z + o[s].w * o[s].w); }
    ss += __shfl_xor(ss, 16); ss += __shfl_xor(ss, 32);
    const float rstd = rsqrtf(ss * (1.f / 128.f) + RMS_EPS);
    const int row = b * TP + 64 * c + 16 * tb + fr;
    const bf16* zp = (const bf16*)(ws + WS_PROJ) + (size_t)row * NPROJ_PAD + 4096 + h * 128 + 4 * fq;
    bf16* mp = (bf16*)(ws + WS_MIX) + (size_t)row * D + h * 128 + 4 * fq;
    const float* nw = a->in[I_DNORM] + 4 * fq;
#pragma unroll
    for (int s = 0; s < 8; ++s) { const v2u z = *(const v2u*)(zp + 16 * s); const f32x4 n4 = *(const f32x4*)(nw + 16 * s);
        f32x4 y; y.x = o[s].x * rstd * n4.x * siluf(bflo(z.x)); y.y = o[s].y * rstd * n4.y * siluf(bfhi(z.x)); y.z = o[s].z * rstd * n4.z * siluf(bflo(z.y)); y.w = o[s].w * rstd * n4.w * siluf(bfhi(z.y));
        *(v2u*)(mp + 16 * s) = pack4(y); }
}


__device__ __forceinline__ float wave_incl_sum(float v, int lane) {
#pragma unroll
    for (int o = 1; o < 64; o <<= 1) { const float u = __shfl_up(v, o); if (lane >= o) v += u; }
    return v;
}
__device__ __forceinline__ float wave_incl_max(float v, int lane) {
#pragma unroll
    for (int o = 1; o < 64; o <<= 1) { const float u = __shfl_up(v, o); if (lane >= o) v = fmaxf(v, u); }
    return v;
}
__device__ __forceinline__ float wave_max(float v) {
#pragma unroll
    for (int o = 1; o < 64; o <<= 1) v = fmaxf(v, __shfl_xor(v, o));
    return v;
}
__device__ __forceinline__ void mlstm_scan_item(ArgsP a, LAS unsigned char* lds, int chain, int vs, const int tid) {
    const int lane = tid & 63, w = __builtin_amdgcn_readfirstlane(tid >> 6), fr = lane & 15, fq = lane >> 4;
    const int b = chain >> 3, h = chain & 7, row0 = b * TP;
    unsigned char* ws = a->ws;
    const bf16* proj = (const bf16*)(ws + WS_PROJ); const float* gates = (const float*)(ws + WS_GATES);
    LAS bf16* KT = (LAS bf16*)lds;
    LAS bf16* VT = (LAS bf16*)(lds + 36864);
    LAS float* wls = (LAS float*)(lds + 46080);
    const float big = a->in[I_BIG][h], bfg = a->in[I_BFG][h];
    const int ks0 = tid >> 4, kk8 = tid & 15;
    const int vtok = tid >> 2, vv8 = tid & 3;
    const bf16* kptr = proj + (size_t)(row0 + ks0) * NPROJ_PAD + 1024 + h * 128 + 8 * kk8;
    const bf16* vptr = proj + (size_t)(row0 + vtok) * NPROJ_PAD + 2048 + h * 256 + 32 * vs + 8 * vv8;
    const float* gptr = gates + (size_t)(row0 + lane) * 16 + h;
    f32x4 acc[2]; acc[0] = (f32x4){0.f, 0.f, 0.f, 0.f}; acc[1] = acc[0];
    float nst = 0.f, m = 0.f;
    v4u kq[2][2], vq[2]; float gi[2], gf[2];
#define ML_LOAD(set, c_) do { const size_t ro = (size_t)(c_) * 64 * NPROJ_PAD; kq[set][0] = *(const v4u*)(kptr + ro); kq[set][1] = *(const v4u*)(kptr + ro + (size_t)32 * NPROJ_PAD); \
        if (tid < 256) vq[set] = *(const v4u*)(vptr + ro); gi[set] = gptr[(size_t)(c_) * 64 * 16]; gf[set] = gptr[(size_t)(c_) * 64 * 16 + 8]; } while (0)
#define ML_STEP(set, c_) do { const int item = chain * 32 + (c_); \
        const float ig = gi[set] + big, lf = logsigf(gf[set] + bfg); \
        const float bcum = wave_incl_sum(lf, lane), blast = __shfl(bcum, 63), gend = blast - bcum + ig; \
        const float mnew = fmaxf(blast + m, wave_max(gend)), sc = expf(blast + m - mnew), wv = expf(gend - mnew) * 0.08838834764831845f; \
        LAS bf16* kt = KT + (set) * 9216; LAS bf16* vt = VT + (set) * 2304; \
        _Pragma("unroll") for (int i = 0; i < 2; ++i) { const unsigned uu[4] = {kq[set][i].x, kq[set][i].y, kq[set][i].z, kq[set][i].w}; const int tok = ks0 + 32 * i; \
            _Pragma("unroll") for (int e = 0; e < 4; ++e) { kt[(8 * kk8 + 2 * e) * 72 + tok] = (bf16)(uu[e] & 0xffffu); kt[(8 * kk8 + 2 * e + 1) * 72 + tok] = (bf16)(uu[e] >> 16); } } \
        if (tid < 256) { const float wt = __shfl(wv, 16 * w + (lane >> 2)); const unsigned uu[4] = {vq[set].x, vq[set].y, vq[set].z, vq[set].w}; \
            _Pragma("unroll") for (int e = 0; e < 4; ++e) { vt[(8 * vv8 + 2 * e) * 72 + vtok] = (bf16)f2bf(bflo(uu[e]) * wt); vt[(8 * vv8 + 2 * e + 1) * 72 + vtok] = (bf16)f2bf(bfhi(uu[e]) * wt); } } \
        if (w == 0) wls[(set) * 64 + lane] = wv; \
        if ((c_) + 2 < 32) ML_LOAD(set, (c_) + 2); \
        if (vs == 0 && tid == 0) ((float*)(ws + WS_MM))[item] = m; \
        __syncthreads(); \
        _Pragma("unroll") for (int vb = 0; vb < 2; ++vb) { *(v2u*)((bf16*)(ws + WS_MC) + ((size_t)item * 256 + 32 * vs + 16 * vb + fr) * 128 + 16 * w + 4 * fq) = pack4(acc[vb]); } \
        if (vs == 0 && tid < 128) { ((float*)(ws + WS_MN))[(size_t)item * 128 + tid] = nst; float sn = 0.f; \
            _Pragma("unroll") for (int s8 = 0; s8 < 8; ++s8) { const v4u kk = *(const LAS v4u*)(kt + tid * 72 + 8 * s8); const LAS float* wl = wls + (set) * 64 + 8 * s8; \
                sn += bflo(kk.x) * wl[0] + bfhi(kk.x) * wl[1] + bflo(kk.y) * wl[2] + bfhi(kk.y) * wl[3] + bflo(kk.z) * wl[4] + bfhi(kk.z) * wl[5] + bflo(kk.w) * wl[6] + bfhi(kk.w) * wl[7]; } \
            nst = sc * nst + sn; } \
        _Pragma("unroll") for (int vb = 0; vb < 2; ++vb) { acc[vb] = acc[vb] * sc; \
            _Pragma("unroll") for (int kt2 = 0; kt2 < 2; ++kt2) { const bf16x8 af = *(const LAS bf16x8*)(kt + (16 * w + fr) * 72 + 32 * kt2 + 8 * fq), bfv = *(const LAS bf16x8*)(vt + (16 * vb + fr) * 72 + 32 * kt2 + 8 * fq); \
                acc[vb] = MFMA32(af, bfv, acc[vb]); } } \
        m = mnew; } while (0)
    ML_LOAD(0, 0); ML_LOAD(1, 1);
#pragma unroll 1
    for (int c2 = 0; c2 < 32; c2 += 2) { ML_STEP(0, c2); ML_STEP(1, c2 + 1); }
#undef ML_LOAD
#undef ML_STEP
#pragma unroll
    for (int vb = 0; vb < 2; ++vb) *(f32x4*)(a->out + O_MCP + ((size_t)chain * 256 + 32 * vs + 16 * vb + fr) * 128 + 16 * w + 4 * fq) = acc[vb];
    if (vs == 0) { if (tid < 128) a->out[O_MNP + (size_t)chain * 128 + tid] = nst; if (tid == 0) a->out[O_MMP + chain] = m; }
    __syncthreads();
}

__device__ __forceinline__ void mlstm_out_item(ArgsP a, LAS unsigned char* lds, int item, const int tid) {
    const int c = item & 31, h = (item >> 5) & 7, b = item >> 8, row0 = b * TP + 64 * c;
    const int lane = tid & 63, w = __builtin_amdgcn_readfirstlane(tid >> 6), fr = lane & 15, fq = lane >> 4;
    unsigned char* ws = a->ws;
    const bf16* proj = (const bf16*)(ws + WS_PROJ); const float* gates = (const float*)(ws + WS_GATES);
    LAS bf16* VT = (LAS bf16*)lds;
    LAS float* ssq = (LAS float*)(lds + 36864);
    const float mc = ((const float*)(ws + WS_MM))[item];
    float av, Mt, et, em;
    { const float ig = gates[(size_t)(row0 + lane) * 16 + h] + a->in[I_BIG][h], lf = logsigf(gates[(size_t)(row0 + lane) * 16 + 8 + h] + a->in[I_BFG][h]);
      const float bcum = wave_incl_sum(lf, lane); av = ig - bcum; Mt = fmaxf(mc, wave_incl_max(av, lane)); et = expf(mc - Mt); em = expf(-(bcum + Mt)); }
#pragma unroll
    for (int i = 0; i < 4; ++i) { const int idx = tid + 512 * i, s = idx >> 5, v8 = idx & 31; const v4u u = *(const v4u*)(proj + (size_t)(row0 + s) * NPROJ_PAD + 2048 + h * 256 + 8 * v8);
        const unsigned uu[4] = {u.x, u.y, u.z, u.w};
#pragma unroll
        for (int e = 0; e < 4; ++e) { VT[(8 * v8 + 2 * e) * 72 + s] = (bf16)(uu[e] & 0xffffu); VT[(8 * v8 + 2 * e + 1) * 72 + s] = (bf16)(uu[e] >> 16); } }
    const int tb = w & 3, half = w >> 2, t = 16 * tb + fr;
    bf16x8 qf[4]; float qn = 0.f;
#pragma unroll
    for (int ks = 0; ks < 4; ++ks) { const v4u u = *(const v4u*)(proj + (size_t)(row0 + t) * NPROJ_PAD + h * 128 + 32 * ks + 8 * fq); qf[ks] = __builtin_bit_cast(bf16x8, u);
        const float* np = (const float*)(ws + WS_MN) + (size_t)item * 128 + 32 * ks + 8 * fq; const f32x4 n0 = *(const f32x4*)np, n1 = *(const f32x4*)(np + 4);
        qn += bflo(u.x) * n0.x + bfhi(u.x) * n0.y + bflo(u.y) * n0.z + bfhi(u.y) * n0.w + bflo(u.z) * n1.x + bfhi(u.z) * n1.y + bflo(u.w) * n1.z + bfhi(u.w) * n1.w; }
    qn += __shfl_xor(qn, 16); qn += __shfl_xor(qn, 32);
    const float Mtt = __shfl(Mt, t), ett = __shfl(et, t), emt = __shfl(em, t);
    v2u smp[4]; float rowsum = 0.f;
#pragma unroll
    for (int sb = 0; sb < 4; ++sb) { smp[sb] = (v2u){0u, 0u};
        if (sb <= tb) { f32x4 qk = (f32x4){0.f, 0.f, 0.f, 0.f};
#pragma unroll
            for (int ks = 0; ks < 4; ++ks) { const v4u u = *(const v4u*)(proj + (size_t)(row0 + 16 * sb + fr) * NPROJ_PAD + 1024 + h * 128 + 32 * ks + 8 * fq); qk = MFMA32(__builtin_bit_cast(bf16x8, u), qf[ks], qk); }
            f32x4 sm;
#pragma unroll
            for (int j = 0; j < 4; ++j) { const int s = 16 * sb + 4 * fq + j; const float as = __shfl(av, s); sm[j] = (s <= t) ? qk[j] * 0.08838834764831845f * expf(as - Mtt) : 0.f; rowsum += sm[j]; }
            smp[sb] = pack4(sm); } }
    rowsum += __shfl_xor(rowsum, 16); rowsum += __shfl_xor(rowsum, 32);
    const float hden = 1.f / fmaxf(fabsf(ett * qn + rowsum), emt);
    const v4u s0u = (v4u){smp[0].x, smp[0].y, smp[1].x, smp[1].y}, s1u = (v4u){smp[2].x, smp[2].y, smp[3].x, smp[3].y};
    const bf16x8 sf0 = __builtin_bit_cast(bf16x8, s0u), sf1 = __builtin_bit_cast(bf16x8, s1u);
    __syncthreads();
    f32x4 hv[8]; float ss = 0.f;
    const bf16* cs = (const bf16*)(ws + WS_MC) + (size_t)item * 256 * 128;
#pragma unroll
    for (int vb = 0; vb < 8; ++vb) { const int vrow = 128 * half + 16 * vb + fr; f32x4 acc = (f32x4){0.f, 0.f, 0.f, 0.f};
#pragma unroll
        for (int ks = 0; ks < 4; ++ks) { const v4u u = *(const v4u*)(cs + (size_t)vrow * 128 + 32 * ks + 8 * fq); acc = MFMA32(__builtin_bit_cast(bf16x8, u), qf[ks], acc); }
        acc = acc * ett;
        { const v2u a0 = *(const LAS v2u*)(VT + vrow * 72 + 4 * fq), a1 = *(const LAS v2u*)(VT + vrow * 72 + 16 + 4 * fq); const v4u au = (v4u){a0.x, a0.y, a1.x, a1.y}; acc = MFMA32(__builtin_bit_cast(bf16x8, au), sf0, acc); }
        { const v2u a0 = *(const LAS v2u*)(VT + vrow * 72 + 32 + 4 * fq), a1 = *(const LAS v2u*)(VT + vrow * 72 + 48 + 4 * fq); const v4u au = (v4u){a0.x, a0.y, a1.x, a1.y}; acc = MFMA32(__builtin_bit_cast(bf16x8, au), sf1, acc); }
        hv[vb] = acc * hden; ss += (hv[vb].x * hv[vb].x + hv[vb].y * hv[vb].y) + (hv[vb].z * hv[vb].z + hv[vb].w * hv[vb].w); }
    ss += __shfl_xor(ss, 16); ss += __shfl_xor(ss, 32);
    if (fq == 0) ssq[half * 64 + t] = ss;
    __syncthreads();
    const float rstd = rsqrtf((ssq[t] + ssq[64 + t]) * (1.f / 256.f) + RMS_EPS);
    const bf16* op = proj + (size_t)(row0 + t) * NPROJ_PAD + 4096 + h * 256 + 128 * half + 4 * fq;
    bf16* mp = (bf16*)(ws + WS_MIX) + (size_t)(row0 + t) * D + h * 256 + 128 * half + 4 * fq;
    const float* nw = a->in[I_MNORM] + h * 256 + 128 * half + 4 * fq;
#pragma unroll
    for (int vb = 0; vb < 8; ++vb) { const v2u o = *(const v2u*)(op + 16 * vb); const f32x4 n4 = *(const f32x4*)(nw + 16 * vb);
        f32x4 y; y.x = hv[vb].x * rstd * n4.x * sigm(bflo(o.x)); y.y = hv[vb].y * rstd * n4.y * sigm(bfhi(o.x)); y.z = hv[vb].z * rstd * n4.z * sigm(bflo(o.y)); y.w = hv[vb].w * rstd * n4.w * sigm(bfhi(o.y));
        *(v2u*)(mp + 16 * vb) = pack4(y); }
    __syncthreads();
}

__device__ __forceinline__ void phase_mixer_even(ArgsP a, LAS unsigned char* lds, int vcu, int G, const int tid) {
#pragma unroll 1
    for (int r = 0; r < 1 + (PROBE_SUB & 1); ++r)
#pragma unroll 1
    for (int it = vcu; it < 1024; it += G) delta_prep_item(a, lds, it, tid);
#pragma unroll 1
    for (int r = 0; r < 1 + ((PROBE_SUB >> 1) & 1); ++r)
#pragma unroll 1
    for (int it = vcu; it < 1024; it += G) lru_prep_item(a, lds, it, tid);
#pragma unroll 1
    for (int r = 0; r < 1 + ((PROBE_SUB >> 2) & 1); ++r)
#pragma unroll 1
    for (int j = vcu; j < 1024; j += G) { const int b = j >> 3, hn = j & 7; delta_rec_item(a, lds, MP + b * TS, TS, hn, a->in[I_SCONV] + (size_t)b * 3 * 4096, a->in[I_SDELTA] + (size_t)j * 16384, a->out + O_DELTAS + (size_t)j * 16384, tid); }
#pragma unroll 1
    for (int r = 0; r < 1 + ((PROBE_SUB >> 3) & 1); ++r)
#pragma unroll 1
    for (int j = vcu; j < 1024; j += G) { const int b = j >> 3, hn = j & 7; lru_rec_item(a, lds, MP + b * TS, TS, hn, a->in[I_SCONV] + (size_t)b * 3 * 4096, a->in[I_SLRU] + (size_t)b * 1024, a->out + O_LRUS + (size_t)b * 1024, tid); }
    const bf16* proj = (const bf16*)(a->ws + WS_PROJ);
    const int nconv = (BP + BS) * 3 * 4096;
    for (int i = vcu * NTHR + tid; i < nconv; i += G * NTHR) {
        const int ch = i & 4095, rj = i >> 12, j = rj % 3, b = rj / 3;
        if (b < BP) a->out[O_CONVP + (size_t)(b * 3 + j) * 4096 + ch] = bf2f(proj[(size_t)(b * TP + TP - 3 + j) * NPROJ_PAD + ch]);
        else { const int bs = b - BP; a->out[O_CONVS + (size_t)(bs * 3 + j) * 4096 + ch] = bf2f(proj[(size_t)(MP + bs * TS + 1 + j) * NPROJ_PAD + ch]); }
    }
}
__device__ __forceinline__ void phase_mixer_even_b(ArgsP a, LAS unsigned char* lds, int vcu, int G, const int tid) {
    const int w = __builtin_amdgcn_readfirstlane(tid >> 6);
    if (w == 0) { for (int it = vcu; it < 256; it += G) delta_scan_wave(a, it >> 3, it & 7, tid & 63); }
    else { LAS float* scr = (LAS float*)(lds + w * 16384);
#pragma unroll 1
        for (int it = vcu * 7 + (w - 1); it < cv::N_REST; it += G * 7) convert_rest_item(a, scr, it, tid & 63); }
}
__device__ __forceinline__ void phase_mixer_even_c(ArgsP a, LAS unsigned char* lds, int vcu, int G, const int tid) {
    const int w = tid >> 6;
#pragma unroll 1
    for (int it = vcu; it < 512; it += G) delta_out_wave(a, 2 * it + (w >> 2), w & 3, tid & 63);
#pragma unroll 1
    for (int it = vcu; it < 1024; it += G) lru_out_item(a, lds, it, tid);
    for (int chain = vcu; chain < 32; chain += G) {
        const float* src = (const float*)(a->ws + WS_DF) + (size_t)chain * 16384; float* dst = a->out + O_DELTAP + (size_t)chain * 16384;
        for (int e = tid; e < 16384; e += NTHR) { const int dk = e >> 7, dv = e & 127;
            dst[e] = src[((((dv >> 4) * 8 + (dk >> 4)) * 64 + ((dk >> 2) & 3) * 16 + (dv & 15)) << 2) + (dk & 3)]; }
    }
}
__device__ __forceinline__ void phase_mixer_odd(ArgsP a, LAS unsigned char* lds, int vcu, int G, const int tid) {
#pragma unroll 1
    for (int r = 0; r < 1 + ((PROBE_SUB >> 4) & 1); ++r)
#pragma unroll 1
    for (int it = vcu; it < 256; it += G) mlstm_scan_item(a, lds, it >> 3, it & 7, tid);
#pragma unroll 1
    for (int r = 0; r < 1 + ((PROBE_SUB >> 5) & 1); ++r)
#pragma unroll 1
    for (int j = vcu; j < 1024; j += G) { const int b = j >> 3, h = j & 7;
        mlstm_rec_item(a, lds, MP + b * TS, TS, h, a->in[I_SMC] + (size_t)j * 32768, a->in[I_SMN] + (size_t)j * 128, a->in[I_SMM] + j, a->out + O_MCS + (size_t)j * 32768, a->out + O_MNS + (size_t)j * 128, a->out + O_MMS + j, tid); }
}
__device__ __forceinline__ void phase_mixer_odd_b(ArgsP a, LAS unsigned char* lds, int vcu, int G, const int tid) {
#pragma unroll 1
    for (int it = vcu; it < 1024; it += G) mlstm_out_item(a, lds, it, tid);
}

__device__ __forceinline__ void phase_ln(const bf16* VB, const float* ST, const float* p1, const bf16* resid, const float* g, const float* bta, bf16* dst, int gw, int NGW, int lane) {
    for (int m = gw; m < M; m += NGW) {
        if (m < MP) {
            float s = 0.f, ss = 0.f;
            if (lane < 32) { const float* sp = ST + (((size_t)(lane >> 2) * M + m) * 4 + (lane & 3)) * 2; s = sp[0]; ss = sp[1]; }
            s = wave_sum(s); ss = wave_sum(ss);
            const float mean = s * (1.f / D), rstd = rsqrtf(fmaxf(ss * (1.f / D) - mean * mean, 0.f) + LN_EPS);
#pragma unroll
            for (int j = 0; j < 4; ++j) { const int col = j * 512 + lane * 8; const v4u v = *(const v4u*)(VB + (size_t)m * D + col);
                const f32x4 g0 = *(const f32x4*)(g + col), g1 = *(const f32x4*)(g + col + 4), b0 = *(const f32x4*)(bta + col), b1 = *(const f32x4*)(bta + col + 4);
                v4u o; o.x = pk2((bflo(v.x) - mean) * rstd * g0.x + b0.x, (bfhi(v.x) - mean) * rstd * g0.y + b0.y); o.y = pk2((bflo(v.y) - mean) * rstd * g0.z + b0.z, (bfhi(v.y) - mean) * rstd * g0.w + b0.w);
                o.z = pk2((bflo(v.z) - mean) * rstd * g1.x + b1.x, (bfhi(v.z) - mean) * rstd * g1.y + b1.y); o.w = pk2((bflo(v.w) - mean) * rstd * g1.z + b1.z, (bfhi(v.w) - mean) * rstd * g1.w + b1.w);
                *(v4u*)(dst + (size_t)m * D + col) = o; }
        } else {
            float v[32]; float s = 0.f;
#pragma unroll
            for (int j = 0; j < 8; ++j) { const size_t off = (size_t)m * D + j * 256 + lane * 4; const float* q1 = p1 + (size_t)(m - MP) * D + j * 256 + lane * 4; f32x4 x = *(const f32x4*)q1;
#pragma unroll
                for (int ch = 1; ch < 16; ++ch) x = x + *(const f32x4*)(q1 + (size_t)ch * 512 * D);
                const v2u rr = *(const v2u*)(resid + off);
                v[4 * j + 0] = x.x + DN_ALPHA * bflo(rr.x); v[4 * j + 1] = x.y + DN_ALPHA * bfhi(rr.x); v[4 * j + 2] = x.z + DN_ALPHA * bflo(rr.y); v[4 * j + 3] = x.w + DN_ALPHA * bfhi(rr.y);
                s += (v[4 * j] + v[4 * j + 1]) + (v[4 * j + 2] + v[4 * j + 3]); }
            const float mean = wave_sum(s) * (1.f / D); float s2 = 0.f;
#pragma unroll
            for (int i = 0; i < 32; ++i) { v[i] -= mean; s2 += v[i] * v[i]; }
            const float rstd = rsqrtf(wave_sum(s2) * (1.f / D) + LN_EPS);
#pragma unroll
            for (int j = 0; j < 8; ++j) { const int col = j * 256 + lane * 4; const f32x4 gg = *(const f32x4*)(g + col), bb = *(const f32x4*)(bta + col);
                v2u o; o.x = pk2(v[4 * j] * rstd * gg.x + bb.x, v[4 * j + 1] * rstd * gg.y + bb.y); o.y = pk2(v[4 * j + 2] * rstd * gg.z + bb.z, v[4 * j + 3] * rstd * gg.w + bb.w);
                *(v2u*)(dst + (size_t)m * D + col) = o; }
        }
    }
}
__device__ __forceinline__ void phase_combine(const float* p1, const bf16* h2, const bf16* pw, bf16* xb, float* outf, int gw, int NGW, int lane) {
    for (int m = MP + gw; m < M; m += NGW) {
#pragma unroll
        for (int j = 0; j < 8; ++j) { const size_t off = (size_t)m * D + j * 256 + lane * 4; const float* q1 = p1 + (size_t)(m - MP) * D + j * 256 + lane * 4; f32x4 x = *(const f32x4*)q1;
#pragma unroll
            for (int ch = 1; ch < 16; ++ch) x = x + *(const f32x4*)(q1 + (size_t)ch * 512 * D);
            const v2u hh = *(const v2u*)(h2 + off), pp = *(const v2u*)(pw + off);
            f32x4 o; o.x = bflo(hh.x) + sigm(x.x) * bflo(pp.x); o.y = bfhi(hh.x) + sigm(x.y) * bfhi(pp.x); o.z = bflo(hh.y) + sigm(x.z) * bflo(pp.y); o.w = bfhi(hh.y) + sigm(x.w) * bfhi(pp.y);
            v2u ob; ob.x = pk2(o.x, o.y); ob.y = pk2(o.z, o.w); *(v2u*)(xb + off) = ob;
            if (outf) *(f32x4*)(outf + off) = o; }
    }
}

constexpr int N_PHASES = 22;
enum { OP_INPROJ = 0, OP_MIXA, OP_MIXB, OP_MIXC, OP_OUTPROJ, OP_LN1, OP_UP, OP_DOWN, OP_LN2, OP_GATE, OP_COMBINE };
enum { GK_LN = 0, GK_BF16 = 1, GK_SQRELU = 2, GK_COMB = 3 };
__global__ void __launch_bounds__(NTHR, 2) mk_fwd(Args a_in) {
    extern __shared__ __attribute__((aligned(16))) unsigned char lds_raw[];
    LAS unsigned char* lds = (LAS unsigned char*)lds_raw;
    ArgsP kp = (ArgsP)__builtin_amdgcn_kernarg_segment_ptr();
    const int lo = a_in.ph_lo, hi = a_in.ph_hi;
    int wv0; { const int wtmp = (int)threadIdx.x >> 6; asm volatile("v_readfirstlane_b32 %0, %1" : "=s"(wv0) : "v"(wtmp)); }
#if MK_N_LAUNCHES == 1
    volatile LAS unsigned* xst = (volatile LAS unsigned*)(lds + LDS_CTL_OFF);
    if (threadIdx.x < 2) xst[threadIdx.x] = 0u;
    __syncthreads();
    XcdBarrier bar = xcd_barrier_post((unsigned*)(a_in.ws + WS_CTL) + 4096, xst);
#endif
    int p = lo; asm volatile("" : "+s"(p));
#pragma unroll 1
    for (; p < hi; ) {
      int nrep = 1;
      if (PROBE_MASK) { const int L_ = p <= 11 ? 0 : 1; const int q_ = p == 0 ? -1 : (L_ == 0 ? p - 1 : (p - 12 < 3 ? p - 12 : p - 11));
        int grp; if (p == 0) grp = 0; else if (q_ == OP_INPROJ || q_ == OP_UP) grp = 1; else if (q_ == OP_OUTPROJ || q_ == OP_DOWN || q_ == OP_GATE) grp = 2; else if (q_ == OP_LN1 || q_ == OP_LN2 || q_ == OP_COMBINE) grp = 3; else grp = (L_ == 0) ? 4 : 5;
        if ((PROBE_MASK >> grp) & 1) nrep = 2; }
      if (p == PROBE_P) nrep = 2;
#pragma unroll 1
      for (int rep = 0; rep < nrep; ++rep) {
        int pp = p; asm volatile("" : "+s"(pp));
        int wvs = wv0; asm volatile("" : "+s"(wvs));
        unsigned ones = ~0u; asm volatile("" : "+s"(ones));
        int tid = (wvs << 6) | (int)__builtin_amdgcn_mbcnt_hi(ones, __builtin_amdgcn_mbcnt_lo(ones, 0u)); asm volatile("" : "+v"(tid));
        int bx = blockIdx.x; asm volatile("" : "+s"(bx));
        int G = gridDim.x; asm volatile("" : "+s"(G));
        ArgsP a = kp; asm volatile("" : "+s"(a));
#define MK_VCU ((G % 8 == 0) ? (bx % 8) * (G / 8) + bx / 8 : bx)
#define MK_WAVE (__builtin_amdgcn_readfirstlane(tid >> 6))
#define MK_GW (MK_VCU * NWAVES + MK_WAVE)
#define MK_NGW (G * NWAVES)
#define MK_LANE (tid & 63)
        unsigned char* ws = a->ws;
        if (pp == 0) {
phase_convert(a, lds, MK_GW, MK_NGW, MK_WAVE, MK_LANE); }
        else {
            const int L = pp <= 11 ? 0 : 1; const int q = L == 0 ? pp - 1 : (pp - 12 < 3 ? pp - 12 : pp - 11);
            bf16* xb = (bf16*)(ws + WS_XB); bf16* mixb = (bf16*)(ws + WS_MIX); bf16* hb = (bf16*)(ws + WS_H); bf16* h2b = (bf16*)(ws + WS_H2); bf16* pwb = (bf16*)(ws + WS_PW);
            bf16* projb = (bf16*)(ws + WS_PROJ); bf16* upb = (bf16*)(ws + WS_PROJ);
            bf16* vbb = (bf16*)(ws + WS_PART0); float* stb = (float*)(ws + WS_PART0 + 34 * MiB); float* part1 = (float*)(ws + WS_PART1); float* gatesb = (float*)(ws + WS_GATES);
            if (q == OP_MIXA) { if (L == 0) phase_mixer_even(a, lds, MK_VCU, G, tid); else phase_mixer_odd(a, lds, MK_VCU, G, tid); }
            else if (q == OP_MIXB) { if (L == 0) phase_mixer_even_b(a, lds, MK_VCU, G, tid); else phase_mixer_odd_b(a, lds, MK_VCU, G, tid); }
            else if (q == OP_MIXC) { phase_mixer_even_c(a, lds, MK_VCU, G, tid); }
            else if (q == OP_LN1) phase_ln(vbb, stb, part1, xb, a->in[I_LN1G] + L * D, a->in[I_LN1B] + L * D, hb, MK_GW, MK_NGW, MK_LANE);
            else if (q == OP_LN2) phase_ln(vbb, stb, part1, hb, a->in[I_LN2G] + L * D, a->in[I_LN2B] + L * D, h2b, MK_GW, MK_NGW, MK_LANE);
            else if (q == OP_COMBINE) phase_combine(part1, h2b, pwb, xb, L == 1 ? a->out + O_Y : nullptr, MK_GW, MK_NGW, MK_LANE);
            else {
                for (int sub = 0; sub < (q == OP_OUTPROJ ? 2 : 1); ++sub) {
                    const bf16* A; const bf16* Bt; int N, K, kind; void* out = nullptr; float* gp = nullptr; const bf16* resid = nullptr; int corder = bx;
                    if (q == OP_INPROJ) { A = xb; Bt = (const bf16*)(ws + (L == 0 ? WS_WINE : WS_WINO)); N = NPROJ_PAD; K = D; kind = GK_BF16; out = projb; gp = gatesb; }
                    else if (q == OP_OUTPROJ && sub == 0) { A = mixb; Bt = (const bf16*)(ws + (L == 0 ? WS_WOUTE : WS_WOUTO)); N = D; K = D; kind = GK_LN; resid = xb; }
                    else if (q == OP_OUTPROJ) { A = (const bf16*)(ws + WS_PB) + (size_t)L * M * PLE; Bt = (const bf16*)(ws + WS_WPLE) + (size_t)L * PLE * D; N = D; K = PLE; kind = GK_BF16; out = pwb; corder = (bx + 128) % G; }
                    else if (q == OP_UP) { A = hb; Bt = (const bf16*)(ws + WS_WUP) + (size_t)L * D * FF; N = FF; K = D; kind = GK_SQRELU; out = upb; }
                    else if (q == OP_DOWN) { A = upb; Bt = (const bf16*)(ws + WS_WDOWN) + (size_t)L * D * FF; N = D; K = FF; kind = GK_LN; resid = hb; }
                    else { A = h2b; Bt = (const bf16*)(ws + WS_WGATE) + (size_t)L * D * D; N = D; K = D; kind = GK_COMB; }
                    pg8::Gemm g{A, Bt, M, N, K};
                    if (kind == GK_LN) { pg8::MainSplit SK; SK.init(K, MK_VCU); pg8::EpiLnStat E{vbb, stb, resid, part1, N, M, DN_ALPHA}; pg8::gemm_phase<pg8::EpiLnStat, pg8::MainSplit, true, true>(lds, g, SK, E, tid); }
                    else if (kind == GK_COMB) { pg8::MainSplit SK; SK.init(K, MK_VCU); pg8::EpiCombine E{h2b, pwb, xb, L == 1 ? a->out + O_Y : nullptr, part1, N}; pg8::gemm_phase<pg8::EpiCombine, pg8::MainSplit, true, true>(lds, g, SK, E, tid); }
                    else if (kind == GK_BF16) { pg8::StaticOrder S; S.init(M, N, K, G, corder); pg8::EpiBf16<0> E{(bf16*)out, N, gp, 24}; pg8::gemm_phase<pg8::EpiBf16<0>, pg8::StaticOrder, true, true>(lds, g, S, E, tid); }
                    else { pg8::StaticOrder S; S.init(M, N, K, G, corder); pg8::EpiBf16<1> E{(bf16*)out, N, nullptr, -1}; pg8::gemm_phase<pg8::EpiBf16<1>, pg8::StaticOrder, true, true>(lds, g, S, E, tid); }
                }
            }
        }
#if MK_N_LAUNCHES == 1
        if (p + 1 < hi || rep + 1 < nrep) xcd_barrier(bar);
#endif
      }
      asm volatile("s_add_i32 %0, %0, 1" : "+s"(p) : : "scc");
    }
}

extern "C" void kernel_launch(void* const* d_in, const int* in_sizes, int n_in, void* d_out, int out_size, void* d_ws, size_t ws_size, hipStream_t stream) {
    static int grid = 0;
    if (grid == 0) {
        if (n_in != 35 || (size_t)out_size != O_END || ws_size < WS_END) { fprintf(stderr, "kernel_launch: unexpected shapes: n_in %d out %d (want %zu) ws %zu (want %zu)\n", n_in, out_size, (size_t)O_END, ws_size, (size_t)WS_END); grid = -1; return; }
        int dev = 0, cus = 0, per_cu = 0;
        hipGetDevice(&dev); hipDeviceGetAttribute(&cus, hipDeviceAttributeMultiprocessorCount, dev);
        if (hipFuncSetAttribute((const void*)mk_fwd, hipFuncAttributeMaxDynamicSharedMemorySize, LDS_BYTES) != hipSuccess) { fprintf(stderr, "kernel_launch: hipFuncSetAttribute failed\n"); grid = -1; return; }
        if (hipOccupancyMaxActiveBlocksPerMultiprocessor(&per_cu, (const void*)mk_fwd, NTHR, LDS_BYTES) != hipSuccess || per_cu < 1) { fprintf(stderr, "kernel_launch: occupancy query says %d\n", per_cu); per_cu = 1; }
        (void)hipGetLastError();
        if (cus != 256) { fprintf(stderr, "kernel_launch: built for a 256-CU device (N = 2048 GEMM schedule), got %d\n", cus); grid = -1; return; }
        grid = cus * 1;
    }
    if (grid < 0) return;
    Args a{};
    for (int i = 0; i < 35; ++i) a.in[i] = (const float*)d_in[i];
    a.out = (float*)d_out; a.ws = (unsigned char*)d_ws;
#if MK_N_LAUNCHES == 1
    hipMemsetAsync((char*)d_ws + WS_CTL, 0, 1 * MiB, stream);
    a.ph_lo = 0; a.ph_hi = N_PHASES;
    hipLaunchKernelGGL(mk_fwd, dim3(grid), dim3(NTHR), LDS_BYTES, stream, a);
#else
    for (int p = 0; p < N_PHASES; ++p) {
        a.ph_lo = p; a.ph_hi = p + 1;
        hipLaunchKernelGGL(mk_fwd, dim3(grid), dim3(NTHR), LDS_BYTES, stream, a);
    }
#endif
}
```

```cpp
#include <hip/hip_runtime.h>
#include <hip/hip_cooperative_groups.h>
#include <cstdio>
#include <cstdint>
namespace cg = cooperative_groups;

#ifndef PROBE_MASK
#define PROBE_MASK 0
#endif
#define PROBE_P (-1)
#define PROBE_SUB 0
#ifndef MK_N_LAUNCHES
#define MK_N_LAUNCHES 1
#endif

namespace pg8 {
#define PG8_LAS __attribute__((address_space(3)))
typedef unsigned short bf16_t;
typedef short bf16x8 __attribute__((ext_vector_type(8)));
typedef float f32x4 __attribute__((ext_vector_type(4)));
typedef unsigned u32x4 __attribute__((ext_vector_type(4)));
constexpr int BM = 256, BK = 64, HALF = 128, HTB = HALF * BK * 2, STAGE_BYTES = 8 * HTB, NXCD = 8, WGM = 8;

__host__ __device__ __forceinline__ int lds_byte(int r, int c) { const int st = (r >> 4) * 2 + (c >> 5), rr = r & 15, cc = c & 31, ob = rr * 64 + cc * 2; return st * 1024 + (ob ^ (((ob >> 9) & 1) << 5)); }
__host__ __device__ __forceinline__ void stage_rc(int b, int& R, int& C) { const int st = b / 1024, sb = b % 1024, swz = sb ^ (((sb >> 9) & 1) << 5); R = (st >> 1) * 16 + swz / 64; C = (st & 1) * 32 + (swz % 64) / 2; }
__host__ __device__ __forceinline__ int perm32(int rho) { const int n = rho >> 4, i = rho & 15; return 8 * (i >> 2) + 4 * n + (i & 3); }

struct Unit { int pm, pn, kt0, nkt, dst; };
struct Gemm { const bf16_t* A; const bf16_t* Bt; int M, N, K; };

struct StaticOrder {
    int nM, nN, nwg, G, c, T;
    __host__ __device__ void init(int M, int N, int K, int G_, int c_) { nM = M / BM; nN = N / BM; nwg = nM * nN; G = G_; c = c_; T = K / BK; }
    __host__ __device__ bool next(int i, Unit& u) const {
        const long L = (long)i * G + c; if (L >= nwg) return false;
        int wgid = (int)L; { const int q = nwg / NXCD, r = nwg % NXCD, xcd = wgid % NXCD, off = wgid / NXCD; wgid = (xcd < r ? xcd * (q + 1) : r * (q + 1) + (xcd - r) * q) + off; }
        const int nig = WGM * nN, gid = wgid / nig, fm = gid * WGM, gsz = (nM - fm) < WGM ? (nM - fm) : WGM;
        u.pm = fm + ((wgid % nig) % gsz); u.pn = (wgid % nig) / gsz; u.kt0 = 0; u.nkt = T; u.dst = 0; return true;
    }
    __device__ __forceinline__ void a_ready(const Unit&) const {}
    __device__ __forceinline__ void done(const Unit&) const {}
};
struct StreamK {
    int nN, T, P, ntot, c;
    __host__ __device__ void init(int M, int N, int K, int G, int c_) { nN = N / BM; T = K / BK; ntot = (M / BM) * nN * T; P = (((ntot + G - 1) / G) + 1) & ~1; c = c_; }
    __host__ __device__ bool next(int i, Unit& u) const {
        int s = c * P; const int e = (s + P < ntot) ? s + P : ntot;
        for (int k = 0; ; ++k) { if (s >= e) return false; const int tile = s / T, kt0 = s - tile * T; const int n = (T - kt0 < e - s) ? T - kt0 : e - s;
            if (k == i) { u.pm = tile / nN; u.pn = tile - u.pm * nN; u.kt0 = kt0; u.nkt = n; u.dst = kt0 ? 1 : 0; return true; }
            s += n; }
    }
    __device__ __forceinline__ void a_ready(const Unit&) const {}
    __device__ __forceinline__ void done(const Unit&) const {}
};
struct MainSplit {
    int T, c;
    __host__ __device__ void init(int K, int c_) { T = K / BK; c = c_; }
    __host__ __device__ bool next(int i, Unit& u) const {
        if (i == 0) { u.pm = c >> 3; u.pn = c & 7; u.kt0 = 0; u.nkt = T; u.dst = 0; return true; }
        if (i == 1) { const int lt = c >> 4, j = c & 15; u.pm = 32 + (lt >> 3); u.pn = lt & 7; u.nkt = T >> 4; u.kt0 = j * u.nkt; u.dst = 1 + j; return true; }
        return false;
    }
    __device__ __forceinline__ void a_ready(const Unit&) const {}
    __device__ __forceinline__ void done(const Unit&) const {}
};
__host__ __device__ __forceinline__ bool split_tile(int tile, int T, int P) { return (tile * T) / P != ((tile + 1) * T - 1) / P; }

__device__ __forceinline__ unsigned cvt_pk_bf16(float lo, float hi) { unsigned r; asm volatile("v_cvt_pk_bf16_f32 %0, %1, %2" : "=v"(r) : "v"(lo), "v"(hi)); return r; }

__device__ __forceinline__ float pg_bflo(unsigned w) { return __builtin_bit_cast(float, w << 16); }
__device__ __forceinline__ float pg_bfhi(unsigned w) { return __builtin_bit_cast(float, w & 0xffff0000u); }
__device__ __forceinline__ void store_chunk(const f32x4 (&acc)[2][2][4][2], const Unit& u, float* C1, int ldc, int wr, int wc, int fr, int fq) {
    const int row0 = u.pm * BM + wr * 64 + fr, col0 = u.pn * BM + wc * 32 + 8 * fq; float* Cb = C1 + ((long)(u.dst - 1) * 512 - 8192) * (long)ldc;
#pragma unroll
    for (int ai = 0; ai < 2; ++ai)
#pragma unroll
        for (int m = 0; m < 4; ++m) { float* rowp = Cb + (size_t)(row0 + ai * HALF + m * 16) * ldc + col0;
#pragma unroll
            for (int bj = 0; bj < 2; ++bj) { *(f32x4*)(rowp + bj * HALF) = acc[ai][bj][m][0]; *(f32x4*)(rowp + bj * HALF + 4) = acc[ai][bj][m][1]; } }
}
struct EpiLnStat {
    static constexpr bool PERM = true, AFTER_DRAIN = false;
    bf16_t* VB; float* ST; const bf16_t* resid; float* C1; int ldc; int mrows; float alpha;
    __device__ __forceinline__ void operator()(const f32x4 (&acc)[2][2][4][2], const Unit& u, int wr, int wc, int fr, int fq) const {
        if (u.dst) { store_chunk(acc, u, C1, ldc, wr, wc, fr, fq); return; }
        const int row0 = u.pm * BM + wr * 64 + fr, col0 = u.pn * BM + wc * 32 + 8 * fq;
#pragma unroll
        for (int ai = 0; ai < 2; ++ai)
#pragma unroll
            for (int m = 0; m < 4; ++m) { const int row = row0 + ai * HALF + m * 16; float s = 0.f, ss = 0.f;
#pragma unroll
                for (int bj = 0; bj < 2; ++bj) { const size_t off = (size_t)row * ldc + col0 + bj * HALF; const u32x4 r = *(const u32x4*)(resid + off);
                    f32x4 v0 = acc[ai][bj][m][0], v1 = acc[ai][bj][m][1];
                    v0[0] += alpha * pg_bflo(r.x); v0[1] += alpha * pg_bfhi(r.x); v0[2] += alpha * pg_bflo(r.y); v0[3] += alpha * pg_bfhi(r.y);
                    v1[0] += alpha * pg_bflo(r.z); v1[1] += alpha * pg_bfhi(r.z); v1[2] += alpha * pg_bflo(r.w); v1[3] += alpha * pg_bfhi(r.w);
                    s += ((v0[0] + v0[1]) + (v0[2] + v0[3])) + ((v1[0] + v1[1]) + (v1[2] + v1[3]));
                    ss += ((v0[0] * v0[0] + v0[1] * v0[1]) + (v0[2] * v0[2] + v0[3] * v0[3])) + ((v1[0] * v1[0] + v1[1] * v1[1]) + (v1[2] * v1[2] + v1[3] * v1[3]));
                    u32x4 w; w.x = cvt_pk_bf16(v0[0], v0[1]); w.y = cvt_pk_bf16(v0[2], v0[3]); w.z = cvt_pk_bf16(v1[0], v1[1]); w.w = cvt_pk_bf16(v1[2], v1[3]);
                    *(u32x4*)(VB + off) = w; }
                s += __shfl_xor(s, 16); s += __shfl_xor(s, 32); ss += __shfl_xor(ss, 16); ss += __shfl_xor(ss, 32);
                if (fq == 0) { float* sp = ST + (((size_t)u.pn * mrows + row) * 4 + wc) * 2; sp[0] = s; sp[1] = ss; } }
    }
};
struct EpiCombine {
    static constexpr bool PERM = true, AFTER_DRAIN = false;
    const bf16_t* h2; const bf16_t* pw; bf16_t* xb; float* outf; float* C1; int ldc;
    __device__ __forceinline__ void operator()(const f32x4 (&acc)[2][2][4][2], const Unit& u, int wr, int wc, int fr, int fq) const {
        if (u.dst) { store_chunk(acc, u, C1, ldc, wr, wc, fr, fq); return; }
        const int row0 = u.pm * BM + wr * 64 + fr, col0 = u.pn * BM + wc * 32 + 8 * fq;
#pragma unroll
        for (int ai = 0; ai < 2; ++ai)
#pragma unroll
            for (int m = 0; m < 4; ++m) { const int row = row0 + ai * HALF + m * 16;
#pragma unroll
                for (int bj = 0; bj < 2; ++bj) { const size_t off = (size_t)row * ldc + col0 + bj * HALF; const u32x4 hh = *(const u32x4*)(h2 + off), pp = *(const u32x4*)(pw + off);
                    const f32x4 a0 = acc[ai][bj][m][0], a1 = acc[ai][bj][m][1]; f32x4 o0, o1;
                    o0[0] = pg_bflo(hh.x) + pg_bflo(pp.x) / (1.f + __expf(-a0[0])); o0[1] = pg_bfhi(hh.x) + pg_bfhi(pp.x) / (1.f + __expf(-a0[1]));
                    o0[2] = pg_bflo(hh.y) + pg_bflo(pp.y) / (1.f + __expf(-a0[2])); o0[3] = pg_bfhi(hh.y) + pg_bfhi(pp.y) / (1.f + __expf(-a0[3]));
                    o1[0] = pg_bflo(hh.z) + pg_bflo(pp.z) / (1.f + __expf(-a1[0])); o1[1] = pg_bfhi(hh.z) + pg_bfhi(pp.z) / (1.f + __expf(-a1[1]));
                    o1[2] = pg_bflo(hh.w) + pg_bflo(pp.w) / (1.f + __expf(-a1[2])); o1[3] = pg_bfhi(hh.w) + pg_bfhi(pp.w) / (1.f + __expf(-a1[3]));
                    u32x4 w; w.x = cvt_pk_bf16(o0[0], o0[1]); w.y = cvt_pk_bf16(o0[2], o0[3]); w.z = cvt_pk_bf16(o1[0], o1[1]); w.w = cvt_pk_bf16(o1[2], o1[3]);
                    *(u32x4*)(xb + off) = w;
                    if (outf) { *(f32x4*)(outf + off) = o0; *(f32x4*)(outf + off + 4) = o1; } } }
    }
};
template <int ACT> struct EpiBf16 {
    static constexpr bool PERM = true, AFTER_DRAIN = false;
    bf16_t* O; int ldc; float* gates; int gate_pn;
    __device__ __forceinline__ void operator()(const f32x4 (&acc)[2][2][4][2], const Unit& u, int wr, int wc, int fr, int fq) const {
        const int row0 = u.pm * BM + wr * 64 + fr; const int col0 = u.pn * BM + wc * 32 + 8 * fq;
        const bool gt = (gates != nullptr) && (u.pn == gate_pn) && (wc == 0) && (fq < 2);
#pragma unroll
        for (int ai = 0; ai < 2; ++ai)
#pragma unroll
            for (int m = 0; m < 4; ++m) { const int row = row0 + ai * HALF + m * 16; bf16_t* rowp = O + (size_t)row * ldc + col0;
#pragma unroll
                for (int bj = 0; bj < 2; ++bj) { f32x4 v0 = acc[ai][bj][m][0], v1 = acc[ai][bj][m][1];
                    if (ACT == 1) {
#pragma unroll
                        for (int j = 0; j < 4; ++j) { const float a = fmaxf(v0[j], 0.f), b = fmaxf(v1[j], 0.f); v0[j] = a * a; v1[j] = b * b; } }
                    u32x4 w; w.x = cvt_pk_bf16(v0[0], v0[1]); w.y = cvt_pk_bf16(v0[2], v0[3]); w.z = cvt_pk_bf16(v1[0], v1[1]); w.w = cvt_pk_bf16(v1[2], v1[3]);
                    *(u32x4*)(rowp + bj * HALF) = w; }
                if (gt) { float* gp = gates + (size_t)row * 16 + 8 * fq; *(f32x4*)gp = acc[ai][0][m][0]; *(f32x4*)(gp + 4) = acc[ai][0][m][1]; } }
    }
};

template <class Epi, class Sched, bool ALIGN_EPI = false, bool SP2 = false>
__device__ __forceinline__ void gemm_phase(PG8_LAS unsigned char* lds, const Gemm g, const Sched& S, const Epi& E, const int tid) {
    const int wid = __builtin_amdgcn_readfirstlane(tid >> 6), lane = tid & 63, wr = wid >> 2, wc = wid & 3, fr = lane & 15, fq = lane >> 4;
    const int K = g.K;
    unsigned voffA[2], voffB[2];
#pragma unroll
    for (int i = 0; i < 2; ++i) { int R, C; stage_rc(tid * 16 + i * 8192, R, C); const int Rb = Epi::PERM ? ((R & ~31) + perm32(R & 31)) : R;
        voffA[i] = (unsigned)(R * K + C) * 2u; voffB[i] = (unsigned)(Rb * K + C) * 2u; }
    const size_t kstep = (size_t)(BK * 2);
    const size_t hstep = (size_t)HALF * K * 2;
    const size_t tstep = 2 * hstep;
    const unsigned ldsw = (unsigned)wid * 1024u;
    const int aoff = lds_byte(wr * 64 + fr, fq * 8), boff = lds_byte(wc * 32 + fr, fq * 8);
#define PG8_SA(b, h) (((b) * 2 + (h)) * HTB)
#define PG8_SB(b, h) ((4 + (b) * 2 + (h)) * HTB)
#define PG8_STAGE(bufoff, gbase, voff) do { _Pragma("unroll") for (int _i = 0; _i < 2; ++_i) \
        __builtin_amdgcn_global_load_lds((const unsigned*)((const char*)(gbase) + (voff)[_i]), (PG8_LAS unsigned*)(lds + (bufoff) + ldsw + _i * 8192), 16, 0, 0); } while (0)
#define PG8_LDA(dst, b, h) do { _Pragma("unroll") for (int m = 0; m < 4; ++m) _Pragma("unroll") for (int k = 0; k < 2; ++k) dst[m][k] = *(const PG8_LAS bf16x8*)(lds + PG8_SA(b, h) + aoff + m * 2048 + k * 1024); } while (0)
#define PG8_LDB(dst, b, h) do { _Pragma("unroll") for (int n = 0; n < 2; ++n) _Pragma("unroll") for (int k = 0; k < 2; ++k) dst[n][k] = *(const PG8_LAS bf16x8*)(lds + PG8_SB(b, h) + boff + n * 2048 + k * 1024); } while (0)
#define PG8_MMA(ai, bj, At, Bt) do { __builtin_amdgcn_s_setprio(1); _Pragma("unroll") for (int m = 0; m < 4; ++m) _Pragma("unroll") for (int n = 0; n < 2; ++n) _Pragma("unroll") for (int k = 0; k < 2; ++k) \
        acc[ai][bj][m][n] = __builtin_amdgcn_mfma_f32_16x16x32_bf16(Bt[n][k], At[m][k], acc[ai][bj][m][n], 0, 0, 0); __builtin_amdgcn_s_setprio(0); } while (0)
#define PG8_WAIT_V(n) asm volatile("s_waitcnt vmcnt(" #n ")" ::: "memory")
#define PG8_WAIT_L(n) asm volatile("s_waitcnt lgkmcnt(" #n ")" ::: "memory")
#define PG8_BAR __builtin_amdgcn_s_barrier()
#define PG8_SCHED __builtin_amdgcn_sched_barrier(0)
    Unit cur, nxt; int ui = 0;
    if (!S.next(0, cur)) return;
    f32x4 acc[2][2][4][2];
#pragma unroll
    for (int a = 0; a < 2; ++a)
#pragma unroll
        for (int b = 0; b < 2; ++b)
#pragma unroll
            for (int m = 0; m < 4; ++m)
#pragma unroll
                for (int n = 0; n < 2; ++n) acc[a][b][m][n] = (f32x4){0.f, 0.f, 0.f, 0.f};
    bf16x8 At[4][2], B0[2][2], B1[2][2];
    const char* cA = (const char*)g.A + (size_t)cur.pm * tstep + (size_t)cur.kt0 * kstep; const char* cB = (const char*)g.Bt + (size_t)cur.pn * tstep + (size_t)cur.kt0 * kstep;
    S.a_ready(cur);
    if constexpr (SP2) {
        PG8_STAGE(PG8_SB(0, 0), cB, voffB); PG8_STAGE(PG8_SB(0, 1), cB + hstep, voffB); PG8_STAGE(PG8_SA(0, 0), cA, voffA); PG8_STAGE(PG8_SA(0, 1), cA + hstep, voffA);
        if (wr == 1) PG8_BAR;
        PG8_WAIT_V(2); PG8_BAR;
        PG8_STAGE(PG8_SB(1, 0), cB + kstep, voffB); PG8_STAGE(PG8_SA(1, 0), cA + kstep, voffA); PG8_STAGE(PG8_SB(1, 1), cB + hstep + kstep, voffB);
        PG8_WAIT_V(6); PG8_BAR;
    } else {
        PG8_STAGE(PG8_SB(0, 0), cB, voffB); PG8_STAGE(PG8_SA(0, 0), cA, voffA); PG8_STAGE(PG8_SB(0, 1), cB + hstep, voffB); PG8_STAGE(PG8_SA(0, 1), cA + hstep, voffA);
        if (wr == 1) PG8_BAR;
        PG8_WAIT_V(4); PG8_BAR;
        PG8_STAGE(PG8_SB(1, 0), cB + kstep, voffB); PG8_STAGE(PG8_SA(1, 0), cA + kstep, voffA); PG8_STAGE(PG8_SB(1, 1), cB + hstep + kstep, voffB);
        PG8_WAIT_V(6); PG8_BAR;
    }
    for (;;) {
        const bool has_next = S.next(ui + 1, nxt);
        const char* nA = has_next ? (const char*)g.A + (size_t)nxt.pm * tstep + (size_t)nxt.kt0 * kstep : cA; const char* nB = has_next ? (const char*)g.Bt + (size_t)nxt.pn * tstep + (size_t)nxt.kt0 * kstep : cB;
        const int nt = cur.nkt;
        for (int t = 0; t < nt; t += 2) {
            const bool last = (t == nt - 2);
            const char* a1 = cA + (size_t)(t + 1) * kstep;
            const char* a2 = last ? nA : cA + (size_t)(t + 2) * kstep; const char* b2 = last ? nB : cB + (size_t)(t + 2) * kstep;
            const char* a3 = a2 + kstep; const char* b3 = b2 + kstep;
            if (last && has_next) S.a_ready(nxt);
            if constexpr (SP2) {
            PG8_LDB(B0, 0, 0); PG8_LDB(B1, 0, 1); PG8_SCHED; PG8_LDA(At, 0, 0); PG8_STAGE(PG8_SA(1, 1), a1 + hstep, voffA);
            PG8_WAIT_V(8); PG8_WAIT_L(0); PG8_BAR; PG8_MMA(0, 0, At, B0); PG8_MMA(0, 1, At, B1); PG8_BAR; PG8_SCHED;
            PG8_LDA(At, 0, 1); PG8_STAGE(PG8_SB(0, 0), b2, voffB); PG8_STAGE(PG8_SB(0, 1), b2 + hstep, voffB); PG8_STAGE(PG8_SA(0, 0), a2, voffA);
            PG8_WAIT_V(8); PG8_WAIT_L(0); PG8_BAR; PG8_MMA(1, 0, At, B0); PG8_MMA(1, 1, At, B1); PG8_BAR; PG8_SCHED;
            PG8_LDB(B0, 1, 0); PG8_LDB(B1, 1, 1); PG8_SCHED; PG8_LDA(At, 1, 0); PG8_STAGE(PG8_SA(0, 1), a2 + hstep, voffA);
            PG8_WAIT_V(8); PG8_WAIT_L(0); PG8_BAR; PG8_MMA(0, 0, At, B0); PG8_MMA(0, 1, At, B1); PG8_BAR; PG8_SCHED;
            PG8_LDA(At, 1, 1); PG8_STAGE(PG8_SB(1, 0), b3, voffB); PG8_STAGE(PG8_SB(1, 1), b3 + hstep, voffB); PG8_STAGE(PG8_SA(1, 0), a3, voffA);
            PG8_WAIT_V(8); PG8_WAIT_L(0); PG8_BAR; PG8_MMA(1, 0, At, B0); PG8_MMA(1, 1, At, B1); PG8_BAR; PG8_SCHED;
            } else {
            PG8_LDB(B0, 0, 0); PG8_SCHED; PG8_LDA(At, 0, 0); PG8_STAGE(PG8_SA(1, 1), a1 + hstep, voffA);
            PG8_WAIT_L(8); PG8_BAR; PG8_WAIT_L(0); PG8_MMA(0, 0, At, B0); PG8_BAR; PG8_SCHED;
            PG8_LDB(B1, 0, 1); PG8_STAGE(PG8_SB(0, 0), b2, voffB);
            PG8_BAR; PG8_WAIT_L(0); PG8_MMA(0, 1, At, B1); PG8_BAR;
            PG8_LDA(At, 0, 1); PG8_STAGE(PG8_SA(0, 0), a2, voffA);
            PG8_BAR; PG8_WAIT_L(0); PG8_MMA(1, 0, At, B0); PG8_BAR; PG8_SCHED;
            PG8_STAGE(PG8_SB(0, 1), b2 + hstep, voffB);
            PG8_WAIT_V(6); PG8_BAR; PG8_MMA(1, 1, At, B1); PG8_BAR;
            PG8_LDB(B0, 1, 0); PG8_SCHED; PG8_LDA(At, 1, 0); PG8_STAGE(PG8_SA(0, 1), a2 + hstep, voffA);
            PG8_WAIT_L(8); PG8_BAR; PG8_WAIT_L(0); PG8_MMA(0, 0, At, B0); PG8_BAR; PG8_SCHED;
            PG8_LDB(B1, 1, 1); PG8_STAGE(PG8_SB(1, 0), b3, voffB);
            PG8_BAR; PG8_WAIT_L(0); PG8_MMA(0, 1, At, B1); PG8_BAR;
            PG8_LDA(At, 1, 1); PG8_STAGE(PG8_SA(1, 0), a3, voffA);
            PG8_BAR; PG8_WAIT_L(0); PG8_MMA(1, 0, At, B0); PG8_BAR; PG8_SCHED;
            PG8_STAGE(PG8_SB(1, 1), b3 + hstep, voffB);
            PG8_WAIT_V(6); PG8_BAR; PG8_MMA(1, 1, At, B1); PG8_BAR;
            }
        }
        if constexpr (ALIGN_EPI) { if (wr == 0) PG8_BAR; }
        E(acc, cur, wr, wc, fr, fq); S.done(cur);
        if (!has_next) break;
#pragma unroll
        for (int a = 0; a < 2; ++a)
#pragma unroll
            for (int b = 0; b < 2; ++b)
#pragma unroll
                for (int m = 0; m < 4; ++m)
#pragma unroll
                    for (int n = 0; n < 2; ++n) acc[a][b][m][n] = (f32x4){0.f, 0.f, 0.f, 0.f};
        cur = nxt; cA = nA; cB = nB; ++ui;
        if constexpr (ALIGN_EPI) { if (wr == 1) PG8_BAR; }
    }
    PG8_WAIT_V(0);
    if constexpr (!ALIGN_EPI) { if (wr == 0) PG8_BAR; }
    PG8_BAR;
#undef PG8_SA
#undef PG8_SB
#undef PG8_STAGE
#undef PG8_LDA
#undef PG8_LDB
#undef PG8_MMA
#undef PG8_WAIT_V
#undef PG8_WAIT_L
#undef PG8_BAR
#undef PG8_SCHED
}
}

constexpr int NWAVES = 8, NTHR = 512;
constexpr int D = 2048, FF = 8192, PLE = 256;
constexpr int TP = 2048, BP = 4, TS = 4, BS = 128;
constexpr int MP = BP * TP, MS = BS * TS, M = MP + MS;
constexpr int NPROJ = 6160, NPROJ_PAD = 6400;
constexpr int NH = 8;
constexpr float LN_EPS = 1e-5f, RMS_EPS = 1e-6f;
constexpr float DN_ALPHA = 1.41421356237f;

constexpr size_t MiB = 1u << 20;
constexpr size_t WS_CTL = 0;
constexpr size_t WS_WINE = 1 * MiB;
constexpr size_t WS_WOUTE = WS_WINE + 25 * MiB;
constexpr size_t WS_WINO = WS_WOUTE + 8 * MiB;
constexpr size_t WS_WOUTO = WS_WINO + 25 * MiB;
constexpr size_t WS_WUP = WS_WOUTO + 8 * MiB;
constexpr size_t WS_WDOWN = WS_WUP + 64 * MiB;
constexpr size_t WS_WPLE = WS_WDOWN + 64 * MiB;
constexpr size_t WS_WGATE = WS_WPLE + 2 * MiB;
constexpr size_t WS_XB = WS_WGATE + 16 * MiB;
constexpr size_t WS_MIX = WS_XB + 34 * MiB;
constexpr size_t WS_H = WS_MIX + 34 * MiB;
constexpr size_t WS_H2 = WS_H + 34 * MiB;
constexpr size_t WS_PW = WS_H2 + 34 * MiB;
constexpr size_t WS_PB = WS_PW + 34 * MiB;
constexpr size_t WS_GATES = WS_PB + 9 * MiB;
constexpr size_t WS_PROJ = WS_GATES + 1 * MiB;
constexpr size_t WS_PART0 = WS_PROJ + 136 * MiB;
constexpr size_t WS_PART1 = WS_PART0 + 68 * MiB;
constexpr size_t WS_LRUW = WS_PART1 + 68 * MiB;
constexpr size_t WS_END = WS_LRUW + 1 * MiB;
constexpr size_t WS_DG = WS_PART0;
constexpr size_t WS_DB = WS_PART0 + 32 * MiB;
constexpr size_t WS_DS = WS_PART0 + 64 * MiB;
constexpr size_t WS_DQ = WS_PART0 + 96 * MiB;
constexpr size_t WS_DO = WS_PART0 + 112 * MiB;
constexpr size_t WS_DD = WS_PART0 + 128 * MiB;
constexpr size_t WS_DF = WS_PART0 + 129 * MiB;
constexpr size_t WS_MC = WS_PART0;
constexpr size_t WS_MN = WS_PART0 + 64 * MiB;
constexpr size_t WS_MM = WS_PART0 + 65 * MiB;
constexpr size_t WS_LRU_HL = WS_H;
constexpr size_t WS_LRU_P = WS_H + 16 * MiB;
constexpr size_t WS_LRU_END = WS_H + 32 * MiB;

constexpr size_t O_Y = 0;
constexpr size_t O_CONVP = (size_t)M * D;
constexpr size_t O_DELTAP = O_CONVP + (size_t)BP * 3 * 4096;
constexpr size_t O_LRUP = O_DELTAP + (size_t)BP * 8 * 128 * 128;
constexpr size_t O_MCP = O_LRUP + (size_t)BP * 1024;
constexpr size_t O_MNP = O_MCP + (size_t)BP * 8 * 256 * 128;
constexpr size_t O_MMP = O_MNP + (size_t)BP * 8 * 128;
constexpr size_t O_CONVS = O_MMP + (size_t)BP * 8;
constexpr size_t O_DELTAS = O_CONVS + (size_t)BS * 3 * 4096;
constexpr size_t O_LRUS = O_DELTAS + (size_t)BS * 8 * 128 * 128;
constexpr size_t O_MCS = O_LRUS + (size_t)BS * 1024;
constexpr size_t O_MNS = O_MCS + (size_t)BS * 8 * 256 * 128;
constexpr size_t O_MMS = O_MNS + (size_t)BS * 8 * 128;
constexpr size_t O_END = O_MMS + (size_t)BS * 8;

constexpr int LDS_BYTES = 147456;
constexpr int LDS_CTL_OFF = 131072;

#define LAS __attribute__((address_space(3)))
typedef unsigned short bf16;
typedef unsigned v4u __attribute__((ext_vector_type(4)));
typedef unsigned v2u __attribute__((ext_vector_type(2)));
typedef float f32x4 __attribute__((ext_vector_type(4)));
#define LDS_WAIT() asm volatile("s_waitcnt lgkmcnt(0)" ::: "memory")
__device__ __forceinline__ unsigned f2bf(float f) { unsigned u = __builtin_bit_cast(unsigned, f); return (u + 0x7fffu + ((u >> 16) & 1u)) >> 16; }
__device__ __forceinline__ unsigned pk2(float lo, float hi) { return f2bf(lo) | (f2bf(hi) << 16); }
__device__ __forceinline__ float bf2f(unsigned short b) { return __builtin_bit_cast(float, ((unsigned)b) << 16); }
__device__ __forceinline__ float bflo(unsigned w) { return __builtin_bit_cast(float, w << 16); }
__device__ __forceinline__ float bfhi(unsigned w) { return __builtin_bit_cast(float, w & 0xffff0000u); }
__device__ __forceinline__ float sigm(float x) { return 1.f / (1.f + expf(-x)); }
__device__ __forceinline__ float siluf(float x) { return x * sigm(x); }
__device__ __forceinline__ float softplusf(float x) { return fmaxf(x, 0.f) + log1pf(expf(-fabsf(x))); }
__device__ __forceinline__ float logsigf(float x) { return -softplusf(-x); }
__device__ __forceinline__ float gelu_tanh(float x) { const float u = 0.7978845608028654f * (x + 0.044715f * x * x * x); return 0.5f * x * (1.f + tanhf(u)); }
__device__ __forceinline__ float wave_sum(float v) {
#pragma unroll
    for (int o = 1; o < 64; o <<= 1) v += __shfl_xor(v, o);
    return v;
}

#define XB_TMO      128
#define XB_XCNT(j)  (256  + 64 * (j))
#define XB_XSUB(j)  (1280 + 64 * (j))
#define XB_XGEN(j)  (2304 + 64 * (j))
#define XB_TOP      3328
#define XB_TOPGEN   3392
#define XCD_BAR_WORDS 3456
#define XB_SPIN_CAP (1u << 22)
__device__ __forceinline__ unsigned xb_ld(unsigned* p)              { return __hip_atomic_load(p, __ATOMIC_RELAXED, __HIP_MEMORY_SCOPE_AGENT); }
__device__ __forceinline__ unsigned xb_add(unsigned* p, unsigned v) { return __hip_atomic_fetch_add(p, v, __ATOMIC_RELAXED, __HIP_MEMORY_SCOPE_AGENT); }
__device__ __forceinline__ unsigned xb_xcc_id() { return (unsigned)__builtin_amdgcn_s_getreg((3 << 11) | 20) & 0xFu; }
#define XB_SPIN(cond, bar) do { unsigned _sp = 0; while (cond) { __builtin_amdgcn_s_sleep(1); \
    if ((++_sp & 255u) == 0u) { if (xb_ld(&(bar)[XB_TMO])) break; if (_sp > XB_SPIN_CAP) { atomicAdd(&(bar)[XB_TMO], 1u); break; } } } } while (0)
struct XcdBarrier { unsigned* bar; unsigned x; volatile LAS unsigned* st; };
__device__ __forceinline__ XcdBarrier xcd_barrier_post(unsigned* bar, volatile LAS unsigned* st) {
    XcdBarrier b; b.bar = bar; b.x = xb_xcc_id(); b.st = st;
    if (threadIdx.x == 0) (void)xb_add(&bar[XB_XCNT(b.x)], 1u);
    return b;
}
__device__ __forceinline__ void xcd_barrier_complete(unsigned* bar, unsigned x, unsigned& nloc, unsigned& nx) {
    const unsigned G = gridDim.x * gridDim.y * gridDim.z;
    unsigned sum, cnt, mine, sp = 0u;
    for (;;) {
        sum = 0u; cnt = 0u; mine = 0u;
#pragma unroll
        for (unsigned j = 0; j < 16; ++j) { const unsigned c = xb_ld(&bar[XB_XCNT(j)]); sum += c; cnt += (c > 0u) ? 1u : 0u; mine = (j == x) ? c : mine; }
        if (sum == G) break;
        __builtin_amdgcn_s_sleep(1);
        if ((++sp & 255u) == 0u) { if (xb_ld(&bar[XB_TMO])) break; if (sp > XB_SPIN_CAP) { atomicAdd(&bar[XB_TMO], 1u); break; } }
    }
    nloc = mine > 0u ? mine : 1u; nx = cnt > 0u ? cnt : 1u;
}
__device__ __forceinline__ void xcd_barrier(const XcdBarrier& b) {
    asm volatile("s_waitcnt vmcnt(0)" ::: "memory");
    __syncthreads();
    if (threadIdx.x == 0) {
        unsigned* bar = b.bar;
        __builtin_amdgcn_s_waitcnt(0);
        unsigned nloc = b.st[0], nx = b.st[1];
        if (nloc == 0u) { xcd_barrier_complete(bar, b.x, nloc, nx); b.st[0] = nloc; b.st[1] = nx; }
        const unsigned old = xb_add(&bar[XB_XSUB(b.x)], 1u);
        const unsigned gen = old / nloc;
        if (old + 1u == (gen + 1u) * nloc) {
            __builtin_amdgcn_fence(__ATOMIC_RELEASE, "agent");
            asm volatile("s_waitcnt vmcnt(0)" ::: "memory");
            const unsigned og = xb_add(&bar[XB_TOP], 1u);
            const unsigned tg = og / nx;
            if (og + 1u == (tg + 1u) * nx) xb_add(&bar[XB_TOPGEN], 1u);
            else XB_SPIN(xb_ld(&bar[XB_TOPGEN]) == tg, bar);
            __builtin_amdgcn_fence(__ATOMIC_ACQUIRE, "agent");
            xb_add(&bar[XB_XGEN(b.x)], 1u);
            asm volatile("s_waitcnt vmcnt(0)" ::: "memory");
        } else {
            XB_SPIN(xb_ld(&bar[XB_XGEN(b.x)]) == gen, bar);
            __builtin_amdgcn_fence(__ATOMIC_ACQUIRE, "agent");
            asm volatile("s_waitcnt vmcnt(0)" ::: "memory");
        }
    }
    __syncthreads();
}

struct Args { const float* in[35]; float* out; unsigned char* ws; int ph_lo, ph_hi; };
typedef const __attribute__((address_space(4))) Args* ArgsP;
enum { I_XP = 0, I_XS, I_PP, I_PS, I_SCONV, I_SDELTA, I_SLRU, I_SMC, I_SMN, I_SMM, I_WINE, I_WCONV, I_BCONV, I_ALOG, I_DTB, I_DNORM, I_LWR, I_LBR, I_LWI, I_LBI, I_LLAM, I_WOUTE,
       I_WINO, I_BIG, I_BFG, I_MNORM, I_WOUTO, I_LN1G, I_LN1B, I_LN2G, I_LN2B, I_WUP, I_WDOWN, I_WPLE, I_WGATE };

__device__ __forceinline__ void p0_transpose_item(const float* W, int K, int N, int Npad, bf16* WT, LAS float* scr, int item, int lane) {
    const int nblk = Npad / 32, kb = item / nblk, nb = item % nblk, k0 = 64 * kb, n0 = 32 * nb;
    const int r = lane >> 3, c4 = lane & 7;
    const bool ok = (n0 + 4 * c4) < N;
    f32x4 v[8];
#pragma unroll
    for (int i = 0; i < 8; ++i) v[i] = ok ? __builtin_nontemporal_load((const f32x4*)(W + (size_t)(k0 + 8 * i + r) * N + n0 + 4 * c4)) : (f32x4){0.f, 0.f, 0.f, 0.f};
#pragma unroll
    for (int i = 0; i < 8; ++i) { LAS float* d = scr + (8 * i + r) * 33 + 4 * c4; d[0] = v[i].x; d[1] = v[i].y; d[2] = v[i].z; d[3] = v[i].w; }
    LDS_WAIT(); asm volatile("" ::: "memory");
    const int c = lane & 7;
#pragma unroll
    for (int j = 0; j < 4; ++j) { const int n = (lane >> 3) + 8 * j; const LAS float* s = scr + (8 * c) * 33 + n;
        v4u o; o.x = pk2(s[0 * 33], s[1 * 33]); o.y = pk2(s[2 * 33], s[3 * 33]); o.z = pk2(s[4 * 33], s[5 * 33]); o.w = pk2(s[6 * 33], s[7 * 33]);
        *(v4u*)(WT + (size_t)(n0 + n) * K + k0 + 8 * c) = o; }
    LDS_WAIT(); asm volatile("" ::: "memory");
}
__device__ __forceinline__ void row_to_bf16(const float* src, bf16* dst, int n, int lane) {
    for (int j = 0; j < n / 256; ++j) { const f32x4 v = *(const f32x4*)(src + j * 256 + lane * 4); v2u o; o.x = pk2(v.x, v.y); o.y = pk2(v.z, v.w); *(v2u*)(dst + j * 256 + lane * 4) = o; }
}

namespace cv { constexpr int I_IN = (D / 64) * (NPROJ_PAD / 32), I_SQ = (D / 64) * (D / 32), I_UP = (D / 64) * (FF / 32), I_DN = (FF / 64) * (D / 32), I_PL = (PLE / 64) * (D / 32);
               constexpr int N_FIRST = I_IN + 128, N_REST = I_IN + 2 * I_SQ + 2 * I_UP + 2 * I_DN + 2 * I_PL + 2 * I_SQ; }
__device__ __forceinline__ void convert_first_item(ArgsP a, LAS float* scr, int r, int lane) {
    unsigned char* ws = a->ws;
    if (r < cv::I_IN) { p0_transpose_item(a->in[I_WINE], D, NPROJ, NPROJ_PAD, (bf16*)(ws + WS_WINE), scr, r, lane); return; } r -= cv::I_IN;
    { const int mat = r / 64, blk = (r / 8) & 7; p0_transpose_item(a->in[mat == 0 ? I_LWR : I_LWI] + (size_t)blk * 16384, 128, 128, 128, (bf16*)(ws + WS_LRUW) + (size_t)(mat * 8 + blk) * 16384, scr, r % 8, lane); }
}
__device__ __forceinline__ void convert_rest_item(ArgsP a, LAS float* scr, int r, int lane) {
    using namespace cv; unsigned char* ws = a->ws;
    if (r < I_SQ) { p0_transpose_item(a->in[I_WOUTE], D, D, D, (bf16*)(ws + WS_WOUTE), scr, r, lane); return; } r -= I_SQ;
    if (r < I_UP) { p0_transpose_item(a->in[I_WUP], D, FF, FF, (bf16*)(ws + WS_WUP), scr, r, lane); return; } r -= I_UP;
    if (r < I_DN) { p0_transpose_item(a->in[I_WDOWN], FF, D, D, (bf16*)(ws + WS_WDOWN), scr, r, lane); return; } r -= I_DN;
    if (r < I_PL) { p0_transpose_item(a->in[I_WPLE], PLE, D, D, (bf16*)(ws + WS_WPLE), scr, r, lane); return; } r -= I_PL;
    if (r < I_SQ) { p0_transpose_item(a->in[I_WGATE], D, D, D, (bf16*)(ws + WS_WGATE), scr, r, lane); return; } r -= I_SQ;
    if (r < I_IN) { p0_transpose_item(a->in[I_WINO], D, NPROJ, NPROJ_PAD, (bf16*)(ws + WS_WINO), scr, r, lane); return; } r -= I_IN;
    if (r < I_SQ) { p0_transpose_item(a->in[I_WOUTO], D, D, D, (bf16*)(ws + WS_WOUTO), scr, r, lane); return; } r -= I_SQ;
    if (r < I_UP) { p0_transpose_item(a->in[I_WUP] + (size_t)D * FF, D, FF, FF, (bf16*)(ws + WS_WUP) + (size_t)D * FF, scr, r, lane); return; } r -= I_UP;
    if (r < I_DN) { p0_transpose_item(a->in[I_WDOWN] + (size_t)D * FF, FF, D, D, (bf16*)(ws + WS_WDOWN) + (size_t)D * FF, scr, r, lane); return; } r -= I_DN;
    if (r < I_PL) { p0_transpose_item(a->in[I_WPLE] + (size_t)PLE * D, PLE, D, D, (bf16*)(ws + WS_WPLE) + (size_t)PLE * D, scr, r, lane); return; } r -= I_PL;
    p0_transpose_item(a->in[I_WGATE] + (size_t)D * D, D, D, D, (bf16*)(ws + WS_WGATE) + (size_t)D * D, scr, r, lane);
}
__device__ __forceinline__ void phase_convert(ArgsP a, LAS unsigned char* lds, int gw, int NGW, int wave, int lane) {
    unsigned char* ws = a->ws;
    LAS float* scr = (LAS float*)(lds + wave * 16384);
    for (int it = gw; it < cv::N_FIRST; it += NGW) convert_first_item(a, scr, it, lane);
    bf16* xb = (bf16*)(ws + WS_XB);
    for (int m = gw; m < M; m += NGW) {
        const float* src = m < MP ? a->in[I_XP] + (size_t)m * D : a->in[I_XS] + (size_t)(m - MP) * D;
        row_to_bf16(src, xb + (size_t)m * D, D, lane);
    }
    bf16* pb = (bf16*)(ws + WS_PB);
    for (int r = gw; r < 2 * M; r += NGW) {
        const int l = r / M, m = r % M;
        const float* src = m < MP ? a->in[I_PP] + ((size_t)l * MP + m) * PLE : a->in[I_PS] + ((size_t)l * MS + (m - MP)) * PLE;
        row_to_bf16(src, pb + (size_t)r * PLE, PLE, lane);
    }
}

__device__ __forceinline__ float conv_in(const bf16* proj, int row0, int tq, int ch, const float* cstate) {
    if (tq >= 0) return bf2f(proj[(size_t)(row0 + tq) * NPROJ_PAD + ch]);
    return cstate ? cstate[(3 + tq) * 4096 + ch] : 0.f;
}
__device__ __forceinline__ float conv4(const bf16* proj, int row0, int t, int ch, const float* cstate, const float* wconv, const float* bconv) {
    float acc = bconv[ch];
#pragma unroll
    for (int j = 0; j < 4; ++j) acc += wconv[j * 4096 + ch] * conv_in(proj, row0, t - 3 + j, ch, cstate);
    return acc;
}

__device__ __forceinline__ void delta_rec_item(ArgsP a, LAS unsigned char* lds, int row0, int T, int h, const float* cstate, const float* S0, float* Sout, const int tid) {
    const int lane = tid & 63, wave = tid >> 6, c = tid & 127, r = tid >> 7;
    const bf16* proj = (const bf16*)(a->ws + WS_PROJ); const float* gates = (const float*)(a->ws + WS_GATES); bf16* mix = (bf16*)(a->ws + WS_MIX);
    const float* wconv = a->in[I_WCONV]; const float* bconv = a->in[I_BCONV];
    LAS float* act = (LAS float*)lds;
    LAS float* nrm = act + 4 * 384;
    LAS float* gb = nrm + 8;
    LAS float* red = gb + 8;
    LAS float* red2 = red + 512;
    LAS float* obuf = red2 + 512;
    float s[32];
#pragma unroll
    for (int i = 0; i < 32; ++i) s[i] = S0 ? S0[(size_t)(32 * r + i) * 128 + c] : 0.f;
    const float aexp = expf(a->in[I_ALOG][h]), dtb = a->in[I_DTB][h];
#pragma unroll 1
    for (int t0 = 0; t0 < T; t0 += 4) {
#pragma unroll
        for (int j = 0; j < 3; ++j) { const int idx = tid + 512 * j, tok = idx / 384, chl = idx % 384, part = chl >> 7, i = chl & 127;
            const int ch = part * 1024 + h * 128 + i;
            act[tok * 384 + chl] = siluf(conv4(proj, row0, t0 + tok, ch, cstate, wconv, bconv)); }
        __syncthreads();
        { const int tok = wave >> 1, part = wave & 1; const float x0 = act[tok * 384 + part * 128 + lane], x1 = act[tok * 384 + part * 128 + 64 + lane];
          const float ss = wave_sum(x0 * x0 + x1 * x1); if (lane == 0) nrm[tok * 2 + part] = rsqrtf(ss + 1e-6f) * (part == 0 ? 0.08838834764831845f : 1.f); }
        if (tid < 4) { const int row = row0 + t0 + tid; const float g = -aexp * softplusf(gates[(size_t)row * 16 + h] + dtb); gb[tid * 2] = expf(g); gb[tid * 2 + 1] = sigm(gates[(size_t)row * 16 + 8 + h]); }
        __syncthreads();
#pragma unroll 1
        for (int tok = 0; tok < 4; ++tok) {
            const float eg = gb[tok * 2], beta = gb[tok * 2 + 1], nq = nrm[tok * 2], nk = nrm[tok * 2 + 1];
            const LAS float* qv = act + tok * 384 + 32 * r; const LAS float* kv = qv + 128;
            float ks = 0.f;
#pragma unroll
            for (int i = 0; i < 32; ++i) ks += kv[i] * s[i];
            red[r * 128 + c] = ks * nk;
            __syncthreads();
            const float kS = red[c] + red[128 + c] + red[256 + c] + red[384 + c];
            const float vnew = beta * (act[tok * 384 + 256 + c] - eg * kS);
            float os = 0.f;
#pragma unroll
            for (int i = 0; i < 32; ++i) { s[i] = eg * s[i] + (kv[i] * nk) * vnew; os += qv[i] * s[i]; }
            red2[r * 128 + c] = os * nq;
            __syncthreads();
            if (r == 0) obuf[tok * 128 + c] = red2[c] + red2[128 + c] + red2[256 + c] + red2[384 + c];
        }
        __syncthreads();
        if (wave < 4) { const int tok = wave, row = row0 + t0 + tok; const float o0 = obuf[tok * 128 + lane], o1 = obuf[tok * 128 + 64 + lane];
            const float rstd = rsqrtf(wave_sum(o0 * o0 + o1 * o1) * (1.f / 128.f) + RMS_EPS);
            const float* nw = a->in[I_DNORM];
            const float z0 = bf2f(proj[(size_t)row * NPROJ_PAD + 4096 + h * 128 + lane]), z1 = bf2f(proj[(size_t)row * NPROJ_PAD + 4096 + h * 128 + 64 + lane]);
            mix[(size_t)row * D + h * 128 + lane] = (bf16)f2bf(o0 * rstd * nw[lane] * siluf(z0));
            mix[(size_t)row * D + h * 128 + 64 + lane] = (bf16)f2bf(o1 * rstd * nw[64 + lane] * siluf(z1)); }
        __syncthreads();
    }
#pragma unroll
    for (int i = 0; i < 32; ++i) Sout[(size_t)(32 * r + i) * 128 + c] = s[i];
}

__device__ __forceinline__ void lru_rec_item(ArgsP a, LAS unsigned char* lds, int row0, int T, int n, const float* cstate, const float* h0, float* hout, const int tid) {
    const int d = tid & 127, part = tid >> 7;
    const bf16* proj = (const bf16*)(a->ws + WS_PROJ); bf16* mix = (bf16*)(a->ws + WS_MIX);
    const float* wconv = a->in[I_WCONV]; const float* bconv = a->in[I_BCONV];
    const float* wr = a->in[I_LWR] + (size_t)n * 16384; const float* wi = a->in[I_LWI] + (size_t)n * 16384;
    LAS float* xr = (LAS float*)lds;
    LAS float* red = xr + 512;
    const int chn = n * 128 + d;
    float hst = h0 ? h0[chn] : 0.f;
    const float br = a->in[I_LBR][chn], bi = a->in[I_LBI][chn], spl = softplusf(-a->in[I_LLAM][chn]);
#pragma unroll 1
    for (int t0 = 0; t0 < T; t0 += 4) {
        { const int tok = tid >> 7; xr[tok * 128 + d] = conv4(proj, row0, t0 + tok, 3072 + chn, cstate, wconv, bconv); }
        __syncthreads();
        float ar[4] = {0.f, 0.f, 0.f, 0.f}, ai[4] = {0.f, 0.f, 0.f, 0.f};
#pragma unroll 4
        for (int cc = 0; cc < 32; ++cc) { const int c = part * 32 + cc; const float w1 = wr[c * 128 + d], w2 = wi[c * 128 + d];
#pragma unroll
        for (int tok = 0; tok < 4; ++tok) { const float x = xr[tok * 128 + c]; ar[tok] += x * w1; ai[tok] += x * w2; } }
#pragma unroll
        for (int tok = 0; tok < 4; ++tok) { red[((tok * 2 + 0) * 4 + part) * 128 + d] = ar[tok]; red[((tok * 2 + 1) * 4 + part) * 128 + d] = ai[tok]; }
        __syncthreads();
        if (part == 0) {
    #pragma unroll 1
        for (int tok = 0; tok < 4; ++tok) {
                const int row = row0 + t0 + tok;
                float rp = br, ip = bi;
#pragma unroll
                for (int p = 0; p < 4; ++p) { rp += red[((tok * 2 + 0) * 4 + p) * 128 + d]; ip += red[((tok * 2 + 1) * 4 + p) * 128 + d]; }
                const float log_a = -8.f * sigm(rp) * spl;
                const float av = expf(log_a);
                const float bx = sqrtf(-expm1f(2.f * log_a)) * sigm(ip) * xr[tok * 128 + d];
                hst = av * hst + bx;
                const float gate = bf2f(proj[(size_t)row * NPROJ_PAD + 5120 + chn]);
                mix[(size_t)row * D + 1024 + chn] = (bf16)f2bf(hst * gelu_tanh(gate));
            }
        }
        __syncthreads();
    }
    if (part == 0) hout[chn] = hst;
}

__device__ __forceinline__ void mlstm_rec_item(ArgsP a, LAS unsigned char* lds, int row0, int T, int h, const float* C0, const float* n0, const float* m0, float* Cout, float* nout, float* mout, const int tid) {
    const int lane = tid & 63, wave = tid >> 6, v = tid & 255, kh = tid >> 8;
    const bf16* proj = (const bf16*)(a->ws + WS_PROJ); const float* gates = (const float*)(a->ws + WS_GATES); bf16* mix = (bf16*)(a->ws + WS_MIX);
    LAS float* qs = (LAS float*)lds;
    LAS float* ks = qs + 512;
    LAS float* vs = ks + 512;
    LAS float* gs = vs + 1024;
    LAS float* red = gs + 8;
    LAS float* dred = red + 1024;
    LAS float* hbuf = dred + 4;
    float cst[64];
#pragma unroll
    for (int i = 0; i < 64; ++i) cst[i] = C0 ? C0[(size_t)v * 128 + 64 * kh + i] : 0.f;
    float nst = (tid < 128) ? (n0 ? n0[tid] : 0.f) : 0.f;
    float mst = m0 ? m0[0] : 0.f;
    const float big = a->in[I_BIG][h], bfg = a->in[I_BFG][h];
#pragma unroll 1
    for (int t0 = 0; t0 < T; t0 += 4) {
#pragma unroll
        for (int j = 0; j < 4; ++j) { const int tok = j, row = row0 + t0 + tok; const bf16* pr = proj + (size_t)row * NPROJ_PAD;
            float val;
            if (tid < 128) val = bf2f(pr[h * 128 + tid]); else if (tid < 256) val = bf2f(pr[1024 + h * 128 + (tid - 128)]) * 0.08838834764831845f; else val = bf2f(pr[2048 + h * 256 + (tid - 256)]);
            if (tid < 128) qs[tok * 128 + tid] = val; else if (tid < 256) ks[tok * 128 + tid - 128] = val; else vs[tok * 256 + tid - 256] = val; }
        if (tid < 4) { const int row = row0 + t0 + tid; gs[tid * 2] = gates[(size_t)row * 16 + h] + big; gs[tid * 2 + 1] = gates[(size_t)row * 16 + 8 + h] + bfg; }
        __syncthreads();
#pragma unroll 1
        for (int tok = 0; tok < 4; ++tok) {
            const int par = tok & 1;
            const float ig = gs[tok * 2], lf = logsigf(gs[tok * 2 + 1]);
            const float mnew = fmaxf(lf + mst, ig), fp = expf(lf + mst - mnew), ip = expf(ig - mnew); mst = mnew;
            const float vv = vs[tok * 256 + v] * ip;
            const LAS float* kv = ks + tok * 128 + 64 * kh; const LAS float* qv = qs + tok * 128 + 64 * kh;
            float num = 0.f;
#pragma unroll
            for (int i = 0; i < 64; ++i) { cst[i] = fp * cst[i] + vv * kv[i]; num += cst[i] * qv[i]; }
            red[(par * 2 + kh) * 256 + v] = num;
            if (tid < 128) { nst = fp * nst + ip * ks[tok * 128 + tid]; const float dp = wave_sum(nst * qs[tok * 128 + tid]); if (lane == 0) dred[par * 2 + wave] = dp; }
            __syncthreads();
            if (kh == 0) { const float nm = red[(par * 2) * 256 + v] + red[(par * 2 + 1) * 256 + v]; const float den = dred[par * 2] + dred[par * 2 + 1];
                hbuf[tok * 256 + v] = nm / fmaxf(fabsf(den), expf(-mnew)); }
        }
        __syncthreads();
        if (wave < 4) { const int tok = wave, row = row0 + t0 + tok; float hv[4]; float ss = 0.f;
#pragma unroll
            for (int j = 0; j < 4; ++j) { hv[j] = hbuf[tok * 256 + j * 64 + lane]; ss += hv[j] * hv[j]; }
            const float rstd = rsqrtf(wave_sum(ss) * (1.f / 256.f) + RMS_EPS);
            const float* nw = a->in[I_MNORM] + h * 256;
#pragma unroll
            for (int j = 0; j < 4; ++j) { const int vi = j * 64 + lane; const float op = bf2f(proj[(size_t)row * NPROJ_PAD + 4096 + h * 256 + vi]);
                mix[(size_t)row * D + h * 256 + vi] = (bf16)f2bf(hv[j] * rstd * nw[vi] * sigm(op)); } }
        __syncthreads();
    }
#pragma unroll
    for (int i = 0; i < 64; ++i) Cout[(size_t)v * 128 + 64 * kh + i] = cst[i];
    if (tid < 128) nout[tid] = nst;
    if (tid == 0) mout[0] = mst;
}


typedef short bf16x8 __attribute__((ext_vector_type(8)));
#define MFMA32(a_, b_, c_) __builtin_amdgcn_mfma_f32_16x16x32_bf16(a_, b_, c_, 0, 0, 0)

__device__ __forceinline__ void lru_prep_item(ArgsP a, LAS unsigned char* lds, int item, const int tid) {
    const int c = item & 31, n = (item >> 5) & 7, b = item >> 8;
    const int lane = tid & 63, w = __builtin_amdgcn_readfirstlane(tid >> 6), fr = lane & 15, fq = lane >> 4;
    unsigned char* ws = a->ws;
    const bf16* proj = (const bf16*)(ws + WS_PROJ);
    LAS bf16* xa = (LAS bf16*)lds;
    LAS float* xf = (LAS float*)(lds + 17408);
    LAS float* obH = (LAS float*)(lds + 51200);
    LAS float* obP = obH + 64 * 132;
    {
        const int t = tid >> 3, sub = tid & 7, ch0 = 3072 + n * 128 + sub * 16;
        const float* wconv = a->in[I_WCONV]; const float* bconv = a->in[I_BCONV];
        float x[16];
#pragma unroll
        for (int i = 0; i < 4; ++i) { const f32x4 bb = *(const f32x4*)(bconv + ch0 + 4 * i); x[4 * i] = bb.x; x[4 * i + 1] = bb.y; x[4 * i + 2] = bb.z; x[4 * i + 3] = bb.w; }
#pragma unroll
        for (int j = 0; j < 4; ++j) { const int tt = 64 * c + t - 3 + j;
            if (tt >= 0) { const bf16* pr = proj + (size_t)(b * TP + tt) * NPROJ_PAD + ch0; const v4u u0 = *(const v4u*)pr, u1 = *(const v4u*)(pr + 8);
                const unsigned uu[8] = {u0.x, u0.y, u0.z, u0.w, u1.x, u1.y, u1.z, u1.w};
#pragma unroll
                for (int i = 0; i < 4; ++i) { const f32x4 ww = *(const f32x4*)(wconv + j * 4096 + ch0 + 4 * i);
                    x[4 * i] += ww.x * bflo(uu[2 * i]); x[4 * i + 1] += ww.y * bfhi(uu[2 * i]); x[4 * i + 2] += ww.z * bflo(uu[2 * i + 1]); x[4 * i + 3] += ww.w * bfhi(uu[2 * i + 1]); } } }
        v4u o0, o1; o0.x = pk2(x[0], x[1]); o0.y = pk2(x[2], x[3]); o0.z = pk2(x[4], x[5]); o0.w = pk2(x[6], x[7]); o1.x = pk2(x[8], x[9]); o1.y = pk2(x[10], x[11]); o1.z = pk2(x[12], x[13]); o1.w = pk2(x[14], x[15]);
        *(LAS v4u*)(xa + t * 136 + sub * 16) = o0; *(LAS v4u*)(xa + t * 136 + sub * 16 + 8) = o1;
#pragma unroll
        for (int i = 0; i < 4; ++i) *(LAS f32x4*)(xf + t * 132 + sub * 16 + 4 * i) = (f32x4){x[4 * i], x[4 * i + 1], x[4 * i + 2], x[4 * i + 3]};
    }
    __syncthreads();
    const bf16* wrT = (const bf16*)(ws + WS_LRUW) + (size_t)n * 16384; const bf16* wiT = wrT + 8 * 16384;
    bf16x8 br[4], bi[4];
#pragma unroll
    for (int ks = 0; ks < 4; ++ks) { br[ks] = *(const bf16x8*)(wrT + (16 * w + fr) * 128 + 32 * ks + 8 * fq); bi[ks] = *(const bf16x8*)(wiT + (16 * w + fr) * 128 + 32 * ks + 8 * fq); }
    f32x4 accr[4], acci[4];
#pragma unroll
    for (int tb = 0; tb < 4; ++tb) { accr[tb] = (f32x4){0.f, 0.f, 0.f, 0.f}; acci[tb] = (f32x4){0.f, 0.f, 0.f, 0.f};
#pragma unroll
        for (int ks = 0; ks < 4; ++ks) { const bf16x8 af = *(const LAS bf16x8*)(xa + (16 * tb + fr) * 136 + 32 * ks + 8 * fq); accr[tb] = MFMA32(af, br[ks], accr[tb]); acci[tb] = MFMA32(af, bi[ks], acci[tb]); } }
    const int dl = 16 * w + fr, chn = n * 128 + dl;
    const float brs = a->in[I_LBR][chn], bis = a->in[I_LBI][chn], spl = softplusf(-a->in[I_LLAM][chn]);
    float Apre = 1.f, Hpre = 0.f;
#pragma unroll
    for (int tb = 0; tb < 4; ++tb) {
        float P[4], Hh[4];
#pragma unroll
        for (int j = 0; j < 4; ++j) { const int t = 16 * tb + 4 * fq + j;
            const float log_a = -8.f * sigm(accr[tb][j] + brs) * spl; const float av = expf(log_a);
            const float bx = sqrtf(-expm1f(2.f * log_a)) * sigm(acci[tb][j] + bis) * xf[t * 132 + dl];
            if (j == 0) { P[0] = av; Hh[0] = bx; } else { P[j] = P[j - 1] * av; Hh[j] = av * Hh[j - 1] + bx; } }
        float Ai = P[3], Hi = Hh[3];
        { const float A2 = __shfl_up(Ai, 16), H2 = __shfl_up(Hi, 16); if (fq >= 1) { Hi = Ai * H2 + Hi; Ai = A2 * Ai; } }
        { const float A2 = __shfl_up(Ai, 32), H2 = __shfl_up(Hi, 32); if (fq >= 2) { Hi = Ai * H2 + Hi; Ai = A2 * Ai; } }
        float Aex = __shfl_up(Ai, 16), Hex = __shfl_up(Hi, 16); if (fq == 0) { Aex = 1.f; Hex = 0.f; }
        const float Atb = __shfl(Ai, 48 + fr), Htb = __shfl(Hi, 48 + fr);
        const float EA = Apre * Aex, EH = Aex * Hpre + Hex;
#pragma unroll
        for (int j = 0; j < 4; ++j) { const int t = 16 * tb + 4 * fq + j; obP[t * 132 + dl] = EA * P[j]; obH[t * 132 + dl] = P[j] * EH + Hh[j]; }
        Hpre = Atb * Hpre + Htb; Apre = Apre * Atb;
    }
    if (fq == 0) { float* e = (float*)(ws + WS_LRU_END) + (size_t)item * 256; e[dl] = Apre; e[128 + dl] = Hpre; }
    __syncthreads();
    {
        const int t = tid >> 3, sub = tid & 7;
        bf16* hl = (bf16*)(ws + WS_LRU_HL) + ((size_t)item * 64 + t) * 128 + sub * 16; bf16* pp = (bf16*)(ws + WS_LRU_P) + ((size_t)item * 64 + t) * 128 + sub * 16;
        const LAS float* sh = obH + t * 132 + sub * 16; const LAS float* sp = obP + t * 132 + sub * 16;
        v4u o0, o1;
        o0.x = pk2(sh[0], sh[1]); o0.y = pk2(sh[2], sh[3]); o0.z = pk2(sh[4], sh[5]); o0.w = pk2(sh[6], sh[7]); o1.x = pk2(sh[8], sh[9]); o1.y = pk2(sh[10], sh[11]); o1.z = pk2(sh[12], sh[13]); o1.w = pk2(sh[14], sh[15]);
        *(v4u*)hl = o0; *(v4u*)(hl + 8) = o1;
        o0.x = pk2(sp[0], sp[1]); o0.y = pk2(sp[2], sp[3]); o0.z = pk2(sp[4], sp[5]); o0.w = pk2(sp[6], sp[7]); o1.x = pk2(sp[8], sp[9]); o1.y = pk2(sp[10], sp[11]); o1.z = pk2(sp[12], sp[13]); o1.w = pk2(sp[14], sp[15]);
        *(v4u*)pp = o0; *(v4u*)(pp + 8) = o1;
    }
    __syncthreads();
}
__device__ __forceinline__ void lru_out_item(ArgsP a, LAS unsigned char* lds, int item, const int tid) {
    const int c = item & 31, n = (item >> 5) & 7, b = item >> 8;
    unsigned char* ws = a->ws;
    LAS float* carry = (LAS float*)lds;
    if (tid < 128) { float cr = 0.f; const float* e = (const float*)(ws + WS_LRU_END) + (size_t)(item - c) * 256;
        for (int k = 0; k < c; ++k) cr = e[k * 256 + 128 + tid] + e[k * 256 + tid] * cr;
        carry[tid] = cr; }
    __syncthreads();
    const int t = tid >> 3, sub = tid & 7, d0 = sub * 16, row = b * TP + 64 * c + t;
    const bf16* hl = (const bf16*)(ws + WS_LRU_HL) + ((size_t)item * 64 + t) * 128 + d0; const bf16* pp = (const bf16*)(ws + WS_LRU_P) + ((size_t)item * 64 + t) * 128 + d0;
    const bf16* gp = (const bf16*)(ws + WS_PROJ) + (size_t)row * NPROJ_PAD + 5120 + n * 128 + d0;
    const v4u h0 = *(const v4u*)hl, h1 = *(const v4u*)(hl + 8), p0 = *(const v4u*)pp, p1 = *(const v4u*)(pp + 8), g0 = *(const v4u*)gp, g1 = *(const v4u*)(gp + 8);
    const unsigned hu[8] = {h0.x, h0.y, h0.z, h0.w, h1.x, h1.y, h1.z, h1.w}, pu[8] = {p0.x, p0.y, p0.z, p0.w, p1.x, p1.y, p1.z, p1.w}, gu[8] = {g0.x, g0.y, g0.z, g0.w, g1.x, g1.y, g1.z, g1.w};
    float hv[16]; unsigned ou[8];
#pragma unroll
    for (int i = 0; i < 8; ++i) { hv[2 * i] = bflo(hu[i]) + bflo(pu[i]) * carry[d0 + 2 * i]; hv[2 * i + 1] = bfhi(hu[i]) + bfhi(pu[i]) * carry[d0 + 2 * i + 1];
        ou[i] = pk2(hv[2 * i] * gelu_tanh(bflo(gu[i])), hv[2 * i + 1] * gelu_tanh(bfhi(gu[i]))); }
    bf16* mp = (bf16*)(ws + WS_MIX) + (size_t)row * D + 1024 + n * 128 + d0;
    *(v4u*)mp = (v4u){ou[0], ou[1], ou[2], ou[3]}; *(v4u*)(mp + 8) = (v4u){ou[4], ou[5], ou[6], ou[7]};
    if (c == 31 && t == 63) { float* o = a->out + O_LRUP + (size_t)b * 1024 + n * 128 + d0;
#pragma unroll
        for (int i = 0; i < 4; ++i) *(f32x4*)(o + 4 * i) = (f32x4){hv[4 * i], hv[4 * i + 1], hv[4 * i + 2], hv[4 * i + 3]}; }
    __syncthreads();
}


__device__ __forceinline__ void conv16_prompt(const bf16* proj, const float* wconv, const float* bconv, int b, int tseq, int ch0, float (&x)[16]) {
#pragma unroll
    for (int i = 0; i < 4; ++i) { const f32x4 bb = *(const f32x4*)(bconv + ch0 + 4 * i); x[4 * i] = bb.x; x[4 * i + 1] = bb.y; x[4 * i + 2] = bb.z; x[4 * i + 3] = bb.w; }
#pragma unroll
    for (int j = 0; j < 4; ++j) { const int tt = tseq - 3 + j;
        if (tt >= 0) { const bf16* pr = proj + (size_t)(b * TP + tt) * NPROJ_PAD + ch0; const v4u u0 = *(const v4u*)pr, u1 = *(const v4u*)(pr + 8);
            const unsigned uu[8] = {u0.x, u0.y, u0.z, u0.w, u1.x, u1.y, u1.z, u1.w};
#pragma unroll
            for (int i = 0; i < 4; ++i) { const f32x4 ww = *(const f32x4*)(wconv + j * 4096 + ch0 + 4 * i);
                x[4 * i] += ww.x * bflo(uu[2 * i]); x[4 * i + 1] += ww.y * bfhi(uu[2 * i]); x[4 * i + 2] += ww.z * bflo(uu[2 * i + 1]); x[4 * i + 3] += ww.w * bfhi(uu[2 * i + 1]); } } }
}
__device__ __forceinline__ void st16_bf16(LAS bf16* p, const float (&x)[16]) {
    v4u o0, o1; o0.x = pk2(x[0], x[1]); o0.y = pk2(x[2], x[3]); o0.z = pk2(x[4], x[5]); o0.w = pk2(x[6], x[7]); o1.x = pk2(x[8], x[9]); o1.y = pk2(x[10], x[11]); o1.z = pk2(x[12], x[13]); o1.w = pk2(x[14], x[15]);
    *(LAS v4u*)p = o0; *(LAS v4u*)(p + 8) = o1;
}
__device__ __forceinline__ v2u pack4(const f32x4 v) { v2u o; o.x = pk2(v.x, v.y); o.y = pk2(v.z, v.w); return o; }
__device__ __forceinline__ bf16x8 zero8() { return (bf16x8){0, 0, 0, 0, 0, 0, 0, 0}; }

__device__ __forceinline__ void delta_prep_item(ArgsP a, LAS unsigned char* lds, int item, const int tid) {
    const int c = item & 31, h = (item >> 5) & 7, b = item >> 8;
    const int lane = tid & 63, w = __builtin_amdgcn_readfirstlane(tid >> 6), fr = lane & 15, fq = lane >> 4;
    unsigned char* ws = a->ws;
    const bf16* proj = (const bf16*)(ws + WS_PROJ);
    LAS bf16* Kn = (LAS bf16*)lds;
    LAS bf16* Qn = (LAS bf16*)(lds + 17408);
    LAS bf16* KdT = (LAS bf16*)(lds + 34816);
    LAS bf16* RX = (LAS bf16*)(lds + 53248);
    LAS bf16* Mm = (LAS bf16*)(lds + 90112);
    LAS bf16* QKd = (LAS bf16*)(lds + 99328);
    LAS bf16* Td = (LAS bf16*)(lds + 108544);
    LAS bf16* RT = (LAS bf16*)(lds + 111616) + w * 768;
    LAS float* gl = (LAS float*)(lds + 123904);
    LAS float* gcs = gl + 64;
    LAS float* bet = gcs + 64;
    const int t = tid >> 3, sub = tid & 7;
    {
        if (sub == 0) { const float* gt = (const float*)(ws + WS_GATES) + (size_t)(b * TP + 64 * c + t) * 16;
            gl[t] = -expf(a->in[I_ALOG][h]) * softplusf(gt[h] + a->in[I_DTB][h]); bet[t] = sigm(gt[8 + h]); }
        __syncthreads();
        if (w == 0) { float v = gl[lane];
#pragma unroll
            for (int o = 1; o < 64; o <<= 1) { const float u = __shfl_up(v, o); if (lane >= o) v += u; }
            gcs[lane] = v; }
        __syncthreads();
    }
    {
        const float* wconv = a->in[I_WCONV]; const float* bconv = a->in[I_BCONV];
        const float gc = gcs[t], glast = gcs[63], beta = bet[t];
        const float ec = expf(gc), ed = expf(glast - gc);
        float x[16], y[16];
        conv16_prompt(proj, wconv, bconv, b, 64 * c + t, 1024 + h * 128 + sub * 16, x);
        float ss = 0.f;
#pragma unroll
        for (int i = 0; i < 16; ++i) { x[i] = siluf(x[i]); ss += x[i] * x[i]; }
        ss += __shfl_xor(ss, 1); ss += __shfl_xor(ss, 2); ss += __shfl_xor(ss, 4);
        const float rk = rsqrtf(ss + 1e-6f);
#pragma unroll
        for (int i = 0; i < 16; ++i) x[i] *= rk;
        st16_bf16(Kn + t * 136 + sub * 16, x);
#pragma unroll
        for (int i = 0; i < 16; ++i) KdT[(sub * 16 + i) * 72 + t] = (bf16)f2bf(x[i] * ed);
#pragma unroll
        for (int i = 0; i < 16; ++i) y[i] = x[i] * (beta * ec);
        st16_bf16(RX + t * 264 + 128 + sub * 16, y);
        conv16_prompt(proj, wconv, bconv, b, 64 * c + t, h * 128 + sub * 16, x);
        ss = 0.f;
#pragma unroll
        for (int i = 0; i < 16; ++i) { x[i] = siluf(x[i]); ss += x[i] * x[i]; }
        ss += __shfl_xor(ss, 1); ss += __shfl_xor(ss, 2); ss += __shfl_xor(ss, 4);
        const float rq = rsqrtf(ss + 1e-6f) * 0.08838834764831845f;
#pragma unroll
        for (int i = 0; i < 16; ++i) x[i] *= rq;
        st16_bf16(Qn + t * 136 + sub * 16, x);
        conv16_prompt(proj, wconv, bconv, b, 64 * c + t, 2048 + h * 128 + sub * 16, x);
#pragma unroll
        for (int i = 0; i < 16; ++i) x[i] = siluf(x[i]) * beta;
        st16_bf16(RX + t * 264 + sub * 16, x);
    }
    __syncthreads();
    {
        const int ib = w >> 1;
#pragma unroll
        for (int jj = 0; jj < 2; ++jj) { const int jb = 2 * (w & 1) + jj;
            f32x4 ak = (f32x4){0.f, 0.f, 0.f, 0.f}, aq = (f32x4){0.f, 0.f, 0.f, 0.f};
            if (jb <= ib) {
#pragma unroll
                for (int ks = 0; ks < 4; ++ks) { const bf16x8 bfr = *(const LAS bf16x8*)(Kn + (16 * jb + fr) * 136 + 32 * ks + 8 * fq);
                    const bf16x8 afk = *(const LAS bf16x8*)(Kn + (16 * ib + fr) * 136 + 32 * ks + 8 * fq), afq = *(const LAS bf16x8*)(Qn + (16 * ib + fr) * 136 + 32 * ks + 8 * fq);
                    ak = MFMA32(afk, bfr, ak); aq = MFMA32(afq, bfr, aq); } }
            const int col = 16 * jb + fr; const float gcc = gcs[col];
#pragma unroll
            for (int j = 0; j < 4; ++j) { const int row = 16 * ib + 4 * fq + j; const float dec = (row >= col) ? expf(gcs[row] - gcc) : 0.f;
                Mm[row * 72 + col] = (bf16)f2bf(row > col ? -bet[row] * ak[j] * dec : 0.f);
                QKd[row * 72 + col] = (bf16)f2bf(aq[j] * dec); }
        }
    }
    __syncthreads();
    if (w == 0) { const int blk = lane >> 4, col = lane & 15; float xi[16];
#pragma unroll
        for (int i = 0; i < 16; ++i) { float acc = (i == col) ? 1.f : 0.f; const LAS bf16* mr = Mm + (16 * blk + i) * 72 + 16 * blk;
#pragma unroll
            for (int j = 0; j < i; ++j) acc += bf2f(mr[j]) * xi[j];
            xi[i] = acc; }
#pragma unroll
        for (int i = 0; i < 16; ++i) Td[(blk * 16 + i) * 24 + col] = (bf16)f2bf(xi[i]); }
    f32x4 rhs[2][4];
#pragma unroll
    for (int cbl = 0; cbl < 2; ++cbl)
#pragma unroll
        for (int bb = 0; bb < 4; ++bb)
#pragma unroll
            for (int j = 0; j < 4; ++j) rhs[cbl][bb][j] = bf2f(RX[(16 * bb + 4 * fq + j) * 264 + 32 * w + 16 * cbl + fr]);
    __syncthreads();
#pragma unroll
    for (int cbl = 0; cbl < 2; ++cbl) { const int cb = 2 * w + cbl;
#pragma unroll
        for (int bb = 0; bb < 4; ++bb) {
            f32x4 acc = rhs[cbl][bb];
#pragma unroll
            for (int ks = 0; ks < 2; ++ks) { if (32 * ks < 16 * bb) { const bool ok = (32 * ks + 8 * fq) < 16 * bb;
                const bf16x8 af = ok ? *(const LAS bf16x8*)(Mm + (16 * bb + fr) * 72 + 32 * ks + 8 * fq) : zero8();
                const bf16x8 bf_ = ok ? *(const LAS bf16x8*)(RX + (16 * cb + fr) * 72 + 32 * ks + 8 * fq) : zero8();
                acc = MFMA32(af, bf_, acc); } }
            *(LAS v2u*)(RT + (16 * cbl + fr) * 24 + 4 * fq) = pack4(acc);
            asm volatile("s_waitcnt lgkmcnt(0)" ::: "memory");
            const bool ok2 = fq < 2;
            const bf16x8 af2 = ok2 ? *(const LAS bf16x8*)(Td + (bb * 16 + fr) * 24 + 8 * fq) : zero8();
            const bf16x8 bf2 = ok2 ? *(const LAS bf16x8*)(RT + (16 * cbl + fr) * 24 + 8 * fq) : zero8();
            const f32x4 xb4 = MFMA32(af2, bf2, ((f32x4){0.f, 0.f, 0.f, 0.f}));
            *(LAS v2u*)(RX + (16 * cb + fr) * 72 + 16 * bb + 4 * fq) = pack4(xb4);
            asm volatile("s_waitcnt lgkmcnt(0)" ::: "memory");
        }
    }
    __syncthreads();
    {
        v4u* gout = (v4u*)(ws + WS_DG) + ((size_t)item * 8 + w) * 4 * 64 + lane;
        bf16x8 kb[2];
#pragma unroll
        for (int kt = 0; kt < 2; ++kt) kb[kt] = *(const LAS bf16x8*)(KdT + (16 * w + fr) * 72 + 32 * kt + 8 * fq);
#pragma unroll
        for (int ks = 0; ks < 4; ++ks) { f32x4 g0 = (f32x4){0.f, 0.f, 0.f, 0.f}, g1 = (f32x4){0.f, 0.f, 0.f, 0.f};
#pragma unroll
            for (int kt = 0; kt < 2; ++kt) { const bf16x8 a0 = *(const LAS bf16x8*)(RX + (128 + 32 * ks + fr) * 72 + 32 * kt + 8 * fq), a1 = *(const LAS bf16x8*)(RX + (128 + 32 * ks + 16 + fr) * 72 + 32 * kt + 8 * fq);
                g0 = MFMA32(a0, kb[kt], g0); g1 = MFMA32(a1, kb[kt], g1); }
            const v2u p0 = pack4(-g0), p1 = pack4(-g1); gout[ks * 64] = (v4u){p0.x, p0.y, p1.x, p1.y}; }
        v2u* bout = (v2u*)(ws + WS_DB) + ((size_t)item * 64 + w) * 64 + lane;
#pragma unroll
        for (int s2 = 0; s2 < 8; ++s2) { f32x4 bc = (f32x4){0.f, 0.f, 0.f, 0.f};
#pragma unroll
            for (int kt = 0; kt < 2; ++kt) { const bf16x8 ub = *(const LAS bf16x8*)(RX + (16 * s2 + fr) * 72 + 32 * kt + 8 * fq); bc = MFMA32(kb[kt], ub, bc); }
            bout[(size_t)s2 * 8 * 64] = pack4(bc); }
    }
    {
        const int tb = w >> 1, half = w & 1; const float ect = expf(gcs[16 * tb + fr]);
        bf16x8 qk[2];
#pragma unroll
        for (int kt = 0; kt < 2; ++kt) qk[kt] = *(const LAS bf16x8*)(QKd + (16 * tb + fr) * 72 + 32 * kt + 8 * fq);
        v4u* qout = (v4u*)(ws + WS_DQ) + ((size_t)item * 4 + tb) * 4 * 64 + lane;
#pragma unroll
        for (int kk = 0; kk < 2; ++kk) { const int ks = 2 * half + kk; v2u pk[2];
#pragma unroll
            for (int hf = 0; hf < 2; ++hf) { const int db = 2 * ks + hf; f32x4 acc = (f32x4){0.f, 0.f, 0.f, 0.f};
#pragma unroll
                for (int kt = 0; kt < 2; ++kt) { const bf16x8 wa = *(const LAS bf16x8*)(RX + (128 + 16 * db + fr) * 72 + 32 * kt + 8 * fq); acc = MFMA32(wa, qk[kt], acc); }
                const v2u qn4 = *(const LAS v2u*)(Qn + (16 * tb + fr) * 136 + 16 * db + 4 * fq);
                f32x4 qp; qp.x = bflo(qn4.x) * ect - acc.x; qp.y = bfhi(qn4.x) * ect - acc.y; qp.z = bflo(qn4.y) * ect - acc.z; qp.w = bfhi(qn4.y) * ect - acc.w;
                pk[hf] = pack4(qp); }
            qout[ks * 64] = (v4u){pk[0].x, pk[0].y, pk[1].x, pk[1].y}; }
        v2u* oout = (v2u*)(ws + WS_DO) + ((size_t)item * 4 + tb) * 8 * 64 + lane;
#pragma unroll
        for (int ss = 0; ss < 4; ++ss) { const int s2 = 4 * half + ss; f32x4 acc = (f32x4){0.f, 0.f, 0.f, 0.f};
#pragma unroll
            for (int kt = 0; kt < 2; ++kt) { const bf16x8 ua = *(const LAS bf16x8*)(RX + (16 * s2 + fr) * 72 + 32 * kt + 8 * fq); acc = MFMA32(ua, qk[kt], acc); }
            oout[s2 * 64] = pack4(acc); }
    }
    if (tid == 0) ((float*)(ws + WS_DD))[item] = expf(gcs[63]);
    __syncthreads();
}

__device__ __forceinline__ void delta_scan_wave(ArgsP a, int chain, int s, const int lane) {
    unsigned char* ws = a->ws;
    const int fr = lane & 15, fq = lane >> 4;
    f32x4 S[8]; bf16x8 Sb[4];
#pragma unroll
    for (int i = 0; i < 8; ++i) S[i] = (f32x4){0.f, 0.f, 0.f, 0.f};
#pragma unroll
    for (int i = 0; i < 4; ++i) Sb[i] = zero8();
    const bf16x8* gbase = (const bf16x8*)(ws + WS_DG) + (size_t)chain * 32 * 2048 + lane;
    bf16x8 G[8][4];
#pragma unroll
    for (int rb = 0; rb < 8; ++rb)
#pragma unroll
        for (int ks = 0; ks < 4; ++ks) G[rb][ks] = gbase[(rb * 4 + ks) * 64];
#pragma unroll 1
    for (int c = 0; c < 32; ++c) {
        const int item = chain * 32 + c;
        const float d = ((const float*)(ws + WS_DD))[item];
        bf16x8* sout = (bf16x8*)(ws + WS_DS) + ((size_t)item * 8 + s) * 4 * 64 + lane;
#pragma unroll
        for (int ks = 0; ks < 4; ++ks) sout[ks * 64] = Sb[ks];
        const v2u* bin = (const v2u*)(ws + WS_DB) + ((size_t)item * 8 + s) * 8 * 64 + lane;
#pragma unroll
        for (int rb = 0; rb < 8; ++rb) { const v2u bc = bin[rb * 64]; S[rb].x = d * S[rb].x + bflo(bc.x); S[rb].y = d * S[rb].y + bfhi(bc.x); S[rb].z = d * S[rb].z + bflo(bc.y); S[rb].w = d * S[rb].w + bfhi(bc.y); }
        const bf16x8* gnext = gbase + (size_t)(c + 1 < 32 ? c + 1 : c) * 2048;
#pragma unroll
        for (int rb = 0; rb < 8; ++rb) {
#pragma unroll
            for (int ks = 0; ks < 4; ++ks) S[rb] = MFMA32(G[rb][ks], Sb[ks], S[rb]);
#pragma unroll
            for (int ks = 0; ks < 4; ++ks) G[rb][ks] = gnext[(rb * 4 + ks) * 64];
        }
#pragma unroll
        for (int ks = 0; ks < 4; ++ks) { const v2u lo = pack4(S[2 * ks]), hi = pack4(S[2 * ks + 1]); const v4u u = (v4u){lo.x, lo.y, hi.x, hi.y}; Sb[ks] = __builtin_bit_cast(bf16x8, u); }
    }
    f32x4* so = (f32x4*)(ws + WS_DF) + ((size_t)(chain * 8 + s) * 8) * 64 + lane;
#pragma unroll
    for (int rb = 0; rb < 8; ++rb) so[rb * 64] = S[rb];
}

__device__ __forceinline__ void delta_out_wave(ArgsP a, int item, int tb, const int lane) {
    unsigned char* ws = a->ws;
    const int c = item & 31, h = (item >> 5) & 7, b = item >> 8, fr = lane & 15, fq = lane >> 4;
    bf16x8 qf[4];
    const bf16x8* qin = (const bf16x8*)(ws + WS_DQ) + ((size_t)item * 4 + tb) * 4 * 64 + lane;
#pragma unroll
    for (int ks = 0; ks < 4; ++ks) qf[ks] = qin[ks * 64];
    const v2u* oin = (const v2u*)(ws + WS_DO) + ((size_t)item * 4 + tb) * 8 * 64 + lane;
    const bf16x8* sin = (const bf16x8*)(ws + WS_DS) + (size_t)item * 8 * 4 * 64 + lane;
    f32x4 o[8]; float ss = 0.f;
#pragma unroll
    for (int s = 0; s < 8; ++s) { const v2u ol = oin[s * 64]; o[s] = (f32x4){bflo(ol.x), bfhi(ol.x), bflo(ol.y), bfhi(ol.y)};
#pragma unroll
        for (int ks = 0; ks < 4; ++ks) o[s] = MFMA32(sin[(s * 4 + ks) * 64], qf[ks], o[s]);
        ss += (o[s].x * o[s].x + o[s].y * o[s].y) + (o[s].z * o[s].z + o[s].w * o[s].w); }
    ss += __shfl_xor(ss, 16); ss += __shfl_xor(ss, 32);
    const float rstd = rsqrtf(ss * (1.f / 128.f) + RMS_EPS);
    const int row = b * TP + 64 * c + 16 * tb + fr;
    const bf16* zp = (const bf16*)(ws + WS_PROJ) + (size_t)row * NPROJ_PAD + 4096 + h * 128 + 4 * fq;
    bf16* mp = (bf16*)(ws + WS_MIX) + (size_t)row * D + h * 128 + 4 * fq;
    const float* nw = a->in[I_DNORM] + 4 * fq;
#pragma unroll
    for (int s = 0; s < 8; ++s) { const v2u z = *(const v2u*)(zp + 16 * s); const f32x4 n4 = *(const f32x4*)(nw + 16 * s);
        f32x4 y; y.x = o[s].x * rstd * n4.x * siluf(bflo(z.x)); y.y = o[s].y * rstd * n4.y * siluf(bfhi(z.x)); y.z = o[s].z * rstd * n4.z * siluf(bflo(z.y)); y.w = o[s].w * rstd * n4.w * siluf(bfhi(z.y));
        *(v2u*)(mp + 16 * s) = pack4(y); }
}


__device__ __forceinline__ float wave_incl_sum(float v, int lane) {
#pragma unroll
    for (int o = 1; o < 64; o <<= 1) { const float u = __shfl_up(v, o); if (lane >= o) v += u; }
    return v;
}
__device__ __forceinline__ float wave_incl_max(float v, int lane) {
#pragma unroll
    for (int o = 1; o < 64; o <<= 1) { const float u = __shfl_up(v, o); if (lane >= o) v = fmaxf(v, u); }
    return v;
}
__device__ __forceinline__ float wave_max(float v) {
#pragma unroll
    for (int o = 1; o < 64; o <<= 1) v = fmaxf(v, __shfl_xor(v, o));
    return v;
}
__device__ __forceinline__ void mlstm_scan_item(ArgsP a, LAS unsigned char* lds, int chain, int vs, const int tid) {
    const int lane = tid & 63, w = __builtin_amdgcn_readfirstlane(tid >> 6), fr = lane & 15, fq = lane >> 4;
    const int b = chain >> 3, h = chain & 7, row0 = b * TP;
    unsigned char* ws = a->ws;
    const bf16* proj = (const bf16*)(ws + WS_PROJ); const float* gates = (const float*)(ws + WS_GATES);
    LAS bf16* KT = (LAS bf16*)lds;
    LAS bf16* VT = (LAS bf16*)(lds + 36864);
    LAS float* wls = (LAS float*)(lds + 46080);
    const float big = a->in[I_BIG][h], bfg = a->in[I_BFG][h];
    const int ks0 = tid >> 4, kk8 = tid & 15;
    const int vtok = tid >> 2, vv8 = tid & 3;
    const bf16* kptr = proj + (size_t)(row0 + ks0) * NPROJ_PAD + 1024 + h * 128 + 8 * kk8;
    const bf16* vptr = proj + (size_t)(row0 + vtok) * NPROJ_PAD + 2048 + h * 256 + 32 * vs + 8 * vv8;
    const float* gptr = gates + (size_t)(row0 + lane) * 16 + h;
    f32x4 acc[2]; acc[0] = (f32x4){0.f, 0.f, 0.f, 0.f}; acc[1] = acc[0];
    float nst = 0.f, m = 0.f;
    v4u kq[2][2], vq[2]; float gi[2], gf[2];
#define ML_LOAD(set, c_) do { const size_t ro = (size_t)(c_) * 64 * NPROJ_PAD; kq[set][0] = *(const v4u*)(kptr + ro); kq[set][1] = *(const v4u*)(kptr + ro + (size_t)32 * NPROJ_PAD); \
        if (tid < 256) vq[set] = *(const v4u*)(vptr + ro); gi[set] = gptr[(size_t)(c_) * 64 * 16]; gf[set] = gptr[(size_t)(c_) * 64 * 16 + 8]; } while (0)
#define ML_STEP(set, c_) do { const int item = chain * 32 + (c_); \
        const float ig = gi[set] + big, lf = logsigf(gf[set] + bfg); \
        const float bcum = wave_incl_sum(lf, lane), blast = __shfl(bcum, 63), gend = blast - bcum + ig; \
        const float mnew = fmaxf(blast + m, wave_max(gend)), sc = expf(blast + m - mnew), wv = expf(gend - mnew) * 0.08838834764831845f; \
        LAS bf16* kt = KT + (set) * 9216; LAS bf16* vt = VT + (set) * 2304; \
        _Pragma("unroll") for (int i = 0; i < 2; ++i) { const unsigned uu[4] = {kq[set][i].x, kq[set][i].y, kq[set][i].z, kq[set][i].w}; const int tok = ks0 + 32 * i; \
            _Pragma("unroll") for (int e = 0; e < 4; ++e) { kt[(8 * kk8 + 2 * e) * 72 + tok] = (bf16)(uu[e] & 0xffffu); kt[(8 * kk8 + 2 * e + 1) * 72 + tok] = (bf16)(uu[e] >> 16); } } \
        if (tid < 256) { const float wt = __shfl(wv, 16 * w + (lane >> 2)); const unsigned uu[4] = {vq[set].x, vq[set].y, vq[set].z, vq[set].w}; \
            _Pragma("unroll") for (int e = 0; e < 4; ++e) { vt[(8 * vv8 + 2 * e) * 72 + vtok] = (bf16)f2bf(bflo(uu[e]) * wt); vt[(8 * vv8 + 2 * e + 1) * 72 + vtok] = (bf16)f2bf(bfhi(uu[e]) * wt); } } \
        if (w == 0) wls[(set) * 64 + lane] = wv; \
        if ((c_) + 2 < 32) ML_LOAD(set, (c_) + 2); \
        if (vs == 0 && tid == 0) ((float*)(ws + WS_MM))[item] = m; \
        __syncthreads(); \
        _Pragma("unroll") for (int vb = 0; vb < 2; ++vb) { *(v2u*)((bf16*)(ws + WS_MC) + ((size_t)item * 256 + 32 * vs + 16 * vb + fr) * 128 + 16 * w + 4 * fq) = pack4(acc[vb]); } \
        if (vs == 0 && tid < 128) { ((float*)(ws + WS_MN))[(size_t)item * 128 + tid] = nst; float sn = 0.f; \
            _Pragma("unroll") for (int s8 = 0; s8 < 8; ++s8) { const v4u kk = *(const LAS v4u*)(kt + tid * 72 + 8 * s8); const LAS float* wl = wls + (set) * 64 + 8 * s8; \
                sn += bflo(kk.x) * wl[0] + bfhi(kk.x) * wl[1] + bflo(kk.y) * wl[2] + bfhi(kk.y) * wl[3] + bflo(kk.z) * wl[4] + bfhi(kk.z) * wl[5] + bflo(kk.w) * wl[6] + bfhi(kk.w) * wl[7]; } \
            nst = sc * nst + sn; } \
        _Pragma("unroll") for (int vb = 0; vb < 2; ++vb) { acc[vb] = acc[vb] * sc; \
            _Pragma("unroll") for (int kt2 = 0; kt2 < 2; ++kt2) { const bf16x8 af = *(const LAS bf16x8*)(kt + (16 * w + fr) * 72 + 32 * kt2 + 8 * fq), bfv = *(const LAS bf16x8*)(vt + (16 * vb + fr) * 72 + 32 * kt2 + 8 * fq); \
                acc[vb] = MFMA32(af, bfv, acc[vb]); } } \
        m = mnew; } while (0)
    ML_LOAD(0, 0); ML_LOAD(1, 1);
#pragma unroll 1
    for (int c2 = 0; c2 < 32; c2 += 2) { ML_STEP(0, c2); ML_STEP(1, c2 + 1); }
#undef ML_LOAD
#undef ML_STEP
#pragma unroll
    for (int vb = 0; vb < 2; ++vb) *(f32x4*)(a->out + O_MCP + ((size_t)chain * 256 + 32 * vs + 16 * vb + fr) * 128 + 16 * w + 4 * fq) = acc[vb];
    if (vs == 0) { if (tid < 128) a->out[O_MNP + (size_t)chain * 128 + tid] = nst; if (tid == 0) a->out[O_MMP + chain] = m; }
    __syncthreads();
}

__device__ __forceinline__ void mlstm_out_item(ArgsP a, LAS unsigned char* lds, int item, const int tid) {
    const int c = item & 31, h = (item >> 5) & 7, b = item >> 8, row0 = b * TP + 64 * c;
    const int lane = tid & 63, w = __builtin_amdgcn_readfirstlane(tid >> 6), fr = lane & 15, fq = lane >> 4;
    unsigned char* ws = a->ws;
    const bf16* proj = (const bf16*)(ws + WS_PROJ); const float* gates = (const float*)(ws + WS_GATES);
    LAS bf16* VT = (LAS bf16*)lds;
    LAS float* ssq = (LAS float*)(lds + 36864);
    const float mc = ((const float*)(ws + WS_MM))[item];
    float av, Mt, et, em;
    { const float ig = gates[(size_t)(row0 + lane) * 16 + h] + a->in[I_BIG][h], lf = logsigf(gates[(size_t)(row0 + lane) * 16 + 8 + h] + a->in[I_BFG][h]);
      const float bcum = wave_incl_sum(lf, lane); av = ig - bcum; Mt = fmaxf(mc, wave_incl_max(av, lane)); et = expf(mc - Mt); em = expf(-(bcum + Mt)); }
#pragma unroll
    for (int i = 0; i < 4; ++i) { const int idx = tid + 512 * i, s = idx >> 5, v8 = idx & 31; const v4u u = *(const v4u*)(proj + (size_t)(row0 + s) * NPROJ_PAD + 2048 + h * 256 + 8 * v8);
        const unsigned uu[4] = {u.x, u.y, u.z, u.w};
#pragma unroll
        for (int e = 0; e < 4; ++e) { VT[(8 * v8 + 2 * e) * 72 + s] = (bf16)(uu[e] & 0xffffu); VT[(8 * v8 + 2 * e + 1) * 72 + s] = (bf16)(uu[e] >> 16); } }
    const int tb = w & 3, half = w >> 2, t = 16 * tb + fr;
    bf16x8 qf[4]; float qn = 0.f;
#pragma unroll
    for (int ks = 0; ks < 4; ++ks) { const v4u u = *(const v4u*)(proj + (size_t)(row0 + t) * NPROJ_PAD + h * 128 + 32 * ks + 8 * fq); qf[ks] = __builtin_bit_cast(bf16x8, u);
        const float* np = (const float*)(ws + WS_MN) + (size_t)item * 128 + 32 * ks + 8 * fq; const f32x4 n0 = *(const f32x4*)np, n1 = *(const f32x4*)(np + 4);
        qn += bflo(u.x) * n0.x + bfhi(u.x) * n0.y + bflo(u.y) * n0.z + bfhi(u.y) * n0.w + bflo(u.z) * n1.x + bfhi(u.z) * n1.y + bflo(u.w) * n1.z + bfhi(u.w) * n1.w; }
    qn += __shfl_xor(qn, 16); qn += __shfl_xor(qn, 32);
    const float Mtt = __shfl(Mt, t), ett = __shfl(et, t), emt = __shfl(em, t);
    const bf16* cs = (const bf16*)(ws + WS_MC) + (size_t)item * 256 * 128;
    v4u kfr[4][4];
#pragma unroll
    for (int sb = 0; sb < 4; ++sb) if (sb <= tb) {
#pragma unroll
        for (int ks = 0; ks < 4; ++ks) kfr[sb][ks] = *(const v4u*)(proj + (size_t)(row0 + 16 * sb + fr) * NPROJ_PAD + 1024 + h * 128 + 32 * ks + 8 * fq); }
    v2u smp[4]; float rowsum = 0.f;
#pragma unroll
    for (int sb = 0; sb < 4; ++sb) { smp[sb] = (v2u){0u, 0u};
        if (sb <= tb) { f32x4 qk = (f32x4){0.f, 0.f, 0.f, 0.f};
#pragma unroll
            for (int ks = 0; ks < 4; ++ks) qk = MFMA32(__builtin_bit_cast(bf16x8, kfr[sb][ks]), qf[ks], qk);
            f32x4 sm;
#pragma unroll
            for (int j = 0; j < 4; ++j) { const int s = 16 * sb + 4 * fq + j; const float as = __shfl(av, s); sm[j] = (s <= t) ? qk[j] * 0.08838834764831845f * expf(as - Mtt) : 0.f; rowsum += sm[j]; }
            smp[sb] = pack4(sm); } }
    rowsum += __shfl_xor(rowsum, 16); rowsum += __shfl_xor(rowsum, 32);
    const float hden = 1.f / fmaxf(fabsf(ett * qn + rowsum), emt);
    const v4u s0u = (v4u){smp[0].x, smp[0].y, smp[1].x, smp[1].y}, s1u = (v4u){smp[2].x, smp[2].y, smp[3].x, smp[3].y};
    const bf16x8 sf0 = __builtin_bit_cast(bf16x8, s0u), sf1 = __builtin_bit_cast(bf16x8, s1u);
    v4u cfr[4][4];
#pragma unroll
    for (int g4 = 0; g4 < 4; ++g4)
#pragma unroll
        for (int ks = 0; ks < 4; ++ks) cfr[g4][ks] = *(const v4u*)(cs + (size_t)(128 * half + 16 * g4 + fr) * 128 + 32 * ks + 8 * fq);
    __syncthreads();
    f32x4 hv[8]; float ss = 0.f;
#pragma unroll
    for (int grp = 0; grp < 2; ++grp) {
      f32x4 accs[4];
#pragma unroll
      for (int g4 = 0; g4 < 4; ++g4) { f32x4 acc = (f32x4){0.f, 0.f, 0.f, 0.f};
#pragma unroll
          for (int ks = 0; ks < 4; ++ks) acc = MFMA32(__builtin_bit_cast(bf16x8, cfr[g4][ks]), qf[ks], acc);
          accs[g4] = acc * ett; }
      if (grp == 0) {
#pragma unroll
          for (int g4 = 0; g4 < 4; ++g4)
#pragma unroll
              for (int ks = 0; ks < 4; ++ks) cfr[g4][ks] = *(const v4u*)(cs + (size_t)(128 * half + 64 + 16 * g4 + fr) * 128 + 32 * ks + 8 * fq); }
#pragma unroll
      for (int g4 = 0; g4 < 4; ++g4) { const int vb = 4 * grp + g4, vrow = 128 * half + 16 * vb + fr; f32x4 acc = accs[g4];
        { const v2u a0 = *(const LAS v2u*)(VT + vrow * 72 + 4 * fq), a1 = *(const LAS v2u*)(VT + vrow * 72 + 16 + 4 * fq); const v4u au = (v4u){a0.x, a0.y, a1.x, a1.y}; acc = MFMA32(__builtin_bit_cast(bf16x8, au), sf0, acc); }
        { const v2u a0 = *(const LAS v2u*)(VT + vrow * 72 + 32 + 4 * fq), a1 = *(const LAS v2u*)(VT + vrow * 72 + 48 + 4 * fq); const v4u au = (v4u){a0.x, a0.y, a1.x, a1.y}; acc = MFMA32(__builtin_bit_cast(bf16x8, au), sf1, acc); }
        hv[vb] = acc * hden; ss += (hv[vb].x * hv[vb].x + hv[vb].y * hv[vb].y) + (hv[vb].z * hv[vb].z + hv[vb].w * hv[vb].w); }
    }
    ss += __shfl_xor(ss, 16); ss += __shfl_xor(ss, 32);
    if (fq == 0) ssq[half * 64 + t] = ss;
    __syncthreads();
    const float rstd = rsqrtf((ssq[t] + ssq[64 + t]) * (1.f / 256.f) + RMS_EPS);
    const bf16* op = proj + (size_t)(row0 + t) * NPROJ_PAD + 4096 + h * 256 + 128 * half + 4 * fq;
    bf16* mp = (bf16*)(ws + WS_MIX) + (size_t)(row0 + t) * D + h * 256 + 128 * half + 4 * fq;
    const float* nw = a->in[I_MNORM] + h * 256 + 128 * half + 4 * fq;
    v2u opr[8];
#pragma unroll
    for (int vb = 0; vb < 8; ++vb) opr[vb] = *(const v2u*)(op + 16 * vb);
#pragma unroll
    for (int vb = 0; vb < 8; ++vb) { const v2u o = opr[vb]; const f32x4 n4 = *(const f32x4*)(nw + 16 * vb);
        f32x4 y; y.x = hv[vb].x * rstd * n4.x * sigm(bflo(o.x)); y.y = hv[vb].y * rstd * n4.y * sigm(bfhi(o.x)); y.z = hv[vb].z * rstd * n4.z * sigm(bflo(o.y)); y.w = hv[vb].w * rstd * n4.w * sigm(bfhi(o.y));
        *(v2u*)(mp + 16 * vb) = pack4(y); }
    __syncthreads();
}

__device__ __forceinline__ void phase_mixer_even(ArgsP a, LAS unsigned char* lds, int vcu, int G, const int tid) {
#pragma unroll 1
    for (int r = 0; r < 1 + (PROBE_SUB & 1); ++r)
#pragma unroll 1
    for (int it = vcu; it < 1024; it += G) delta_prep_item(a, lds, it, tid);
#pragma unroll 1
    for (int r = 0; r < 1 + ((PROBE_SUB >> 1) & 1); ++r)
#pragma unroll 1
    for (int it = vcu; it < 1024; it += G) lru_prep_item(a, lds, it, tid);
#pragma unroll 1
    for (int r = 0; r < 1 + ((PROBE_SUB >> 2) & 1); ++r)
#pragma unroll 1
    for (int j = vcu; j < 1024; j += G) { const int b = j >> 3, hn = j & 7; delta_rec_item(a, lds, MP + b * TS, TS, hn, a->in[I_SCONV] + (size_t)b * 3 * 4096, a->in[I_SDELTA] + (size_t)j * 16384, a->out + O_DELTAS + (size_t)j * 16384, tid); }
#pragma unroll 1
    for (int r = 0; r < 1 + ((PROBE_SUB >> 3) & 1); ++r)
#pragma unroll 1
    for (int j = vcu; j < 1024; j += G) { const int b = j >> 3, hn = j & 7; lru_rec_item(a, lds, MP + b * TS, TS, hn, a->in[I_SCONV] + (size_t)b * 3 * 4096, a->in[I_SLRU] + (size_t)b * 1024, a->out + O_LRUS + (size_t)b * 1024, tid); }
    const bf16* proj = (const bf16*)(a->ws + WS_PROJ);
    const int nconv = (BP + BS) * 3 * 4096;
    for (int i = vcu * NTHR + tid; i < nconv; i += G * NTHR) {
        const int ch = i & 4095, rj = i >> 12, j = rj % 3, b = rj / 3;
        if (b < BP) a->out[O_CONVP + (size_t)(b * 3 + j) * 4096 + ch] = bf2f(proj[(size_t)(b * TP + TP - 3 + j) * NPROJ_PAD + ch]);
        else { const int bs = b - BP; a->out[O_CONVS + (size_t)(bs * 3 + j) * 4096 + ch] = bf2f(proj[(size_t)(MP + bs * TS + 1 + j) * NPROJ_PAD + ch]); }
    }
}
__device__ __forceinline__ void phase_mixer_even_b(ArgsP a, LAS unsigned char* lds, int vcu, int G, const int tid) {
    const int w = __builtin_amdgcn_readfirstlane(tid >> 6);
    if (w == 0) { for (int it = vcu; it < 256; it += G) delta_scan_wave(a, it >> 3, it & 7, tid & 63); }
    else { LAS float* scr = (LAS float*)(lds + w * 16384);
#pragma unroll 1
        for (int it = vcu * 7 + (w - 1); it < cv::N_REST; it += G * 7) convert_rest_item(a, scr, it, tid & 63); }
}
__device__ __forceinline__ void phase_mixer_even_c(ArgsP a, LAS unsigned char* lds, int vcu, int G, const int tid) {
    const int w = tid >> 6;
#pragma unroll 1
    for (int it = vcu; it < 512; it += G) delta_out_wave(a, 2 * it + (w >> 2), w & 3, tid & 63);
#pragma unroll 1
    for (int it = vcu; it < 1024; it += G) lru_out_item(a, lds, it, tid);
    for (int chain = vcu; chain < 32; chain += G) {
        const float* src = (const float*)(a->ws + WS_DF) + (size_t)chain * 16384; float* dst = a->out + O_DELTAP + (size_t)chain * 16384;
        for (int e = tid; e < 16384; e += NTHR) { const int dk = e >> 7, dv = e & 127;
            dst[e] = src[((((dv >> 4) * 8 + (dk >> 4)) * 64 + ((dk >> 2) & 3) * 16 + (dv & 15)) << 2) + (dk & 3)]; }
    }
}
__device__ __forceinline__ void phase_mixer_odd(ArgsP a, LAS unsigned char* lds, int vcu, int G, const int tid) {
#pragma unroll 1
    for (int r = 0; r < 1 + ((PROBE_SUB >> 4) & 1); ++r)
#pragma unroll 1
    for (int it = vcu; it < 256; it += G) mlstm_scan_item(a, lds, it >> 3, it & 7, tid);
#pragma unroll 1
    for (int r = 0; r < 1 + ((PROBE_SUB >> 5) & 1); ++r)
#pragma unroll 1
    for (int j = vcu; j < 1024; j += G) { const int b = j >> 3, h = j & 7;
        mlstm_rec_item(a, lds, MP + b * TS, TS, h, a->in[I_SMC] + (size_t)j * 32768, a->in[I_SMN] + (size_t)j * 128, a->in[I_SMM] + j, a->out + O_MCS + (size_t)j * 32768, a->out + O_MNS + (size_t)j * 128, a->out + O_MMS + j, tid); }
}
__device__ __forceinline__ void phase_mixer_odd_b(ArgsP a, LAS unsigned char* lds, int vcu, int G, const int tid) {
#pragma unroll 1
    for (int it = vcu; it < 1024; it += G) mlstm_out_item(a, lds, it, tid);
}

__device__ __forceinline__ void phase_ln(const bf16* VB, const float* ST, const float* p1, const bf16* resid, const float* g, const float* bta, bf16* dst, LAS unsigned char* lds, int vcu, int G, const int tid) {
    const int lane = tid & 63, w = __builtin_amdgcn_readfirstlane(tid >> 6), gw = vcu * NWAVES + w, NGW = G * NWAVES;
    {
        LAS float* red = (LAS float*)lds;
        for (int r0 = 2 * vcu; r0 < MS; r0 += 2 * G) {
            const int r = r0 + (w >> 2), q = w & 3, col = 512 * q + 8 * lane; const size_t off = (size_t)(MP + r) * D + col;
            const float* q1 = p1 + (size_t)r * D + col;
            f32x4 x0 = *(const f32x4*)q1, x1 = *(const f32x4*)(q1 + 4);
#pragma unroll
            for (int ch = 1; ch < 16; ++ch) { x0 = x0 + *(const f32x4*)(q1 + (size_t)ch * 512 * D); x1 = x1 + *(const f32x4*)(q1 + (size_t)ch * 512 * D + 4); }
            const v4u rr = *(const v4u*)(resid + off);
            float v[8] = {x0.x + DN_ALPHA * bflo(rr.x), x0.y + DN_ALPHA * bfhi(rr.x), x0.z + DN_ALPHA * bflo(rr.y), x0.w + DN_ALPHA * bfhi(rr.y),
                          x1.x + DN_ALPHA * bflo(rr.z), x1.y + DN_ALPHA * bfhi(rr.z), x1.z + DN_ALPHA * bflo(rr.w), x1.w + DN_ALPHA * bfhi(rr.w)};
            float s = 0.f, ss = 0.f;
#pragma unroll
            for (int i = 0; i < 8; ++i) { s += v[i]; ss += v[i] * v[i]; }
            s = wave_sum(s); ss = wave_sum(ss);
            if (lane == 0) { red[w * 2] = s; red[w * 2 + 1] = ss; }
            __syncthreads();
            const int wb = (w >> 2) * 4; s = (red[wb * 2] + red[wb * 2 + 2]) + (red[wb * 2 + 4] + red[wb * 2 + 6]); ss = (red[wb * 2 + 1] + red[wb * 2 + 3]) + (red[wb * 2 + 5] + red[wb * 2 + 7]);
            const float mean = s * (1.f / D), rstd = rsqrtf(fmaxf(ss * (1.f / D) - mean * mean, 0.f) + LN_EPS);
            const f32x4 g0 = *(const f32x4*)(g + col), g1 = *(const f32x4*)(g + col + 4), b0 = *(const f32x4*)(bta + col), b1 = *(const f32x4*)(bta + col + 4);
            v4u o; o.x = pk2((v[0] - mean) * rstd * g0.x + b0.x, (v[1] - mean) * rstd * g0.y + b0.y); o.y = pk2((v[2] - mean) * rstd * g0.z + b0.z, (v[3] - mean) * rstd * g0.w + b0.w);
            o.z = pk2((v[4] - mean) * rstd * g1.x + b1.x, (v[5] - mean) * rstd * g1.y + b1.y); o.w = pk2((v[6] - mean) * rstd * g1.z + b1.z, (v[7] - mean) * rstd * g1.w + b1.w);
            *(v4u*)(dst + off) = o;
            __syncthreads();
        }
    }
    for (int m0 = gw; m0 < MP; m0 += 4 * NGW) {
        v4u vv[4][4]; float s[4], ss[4];
#pragma unroll
        for (int i = 0; i < 4; ++i) { const int m = m0 + i * NGW; s[i] = 0.f; ss[i] = 0.f;
            if (m < MP) { if (lane < 32) { const float* sp = ST + (((size_t)(lane >> 2) * M + m) * 4 + (lane & 3)) * 2; s[i] = sp[0]; ss[i] = sp[1]; }
#pragma unroll
                for (int j = 0; j < 4; ++j) vv[i][j] = *(const v4u*)(VB + (size_t)m * D + j * 512 + lane * 8); } }
#pragma unroll
        for (int i = 0; i < 4; ++i) { const int m = m0 + i * NGW;
            if (m < MP) { const float st = wave_sum(s[i]), sst = wave_sum(ss[i]);
                const float mean = st * (1.f / D), rstd = rsqrtf(fmaxf(sst * (1.f / D) - mean * mean, 0.f) + LN_EPS);
#pragma unroll
                for (int j = 0; j < 4; ++j) { const int col = j * 512 + lane * 8; const v4u v = vv[i][j];
                    const f32x4 g0 = *(const f32x4*)(g + col), g1 = *(const f32x4*)(g + col + 4), b0 = *(const f32x4*)(bta + col), b1 = *(const f32x4*)(bta + col + 4);
                    v4u o; o.x = pk2((bflo(v.x) - mean) * rstd * g0.x + b0.x, (bfhi(v.x) - mean) * rstd * g0.y + b0.y); o.y = pk2((bflo(v.y) - mean) * rstd * g0.z + b0.z, (bfhi(v.y) - mean) * rstd * g0.w + b0.w);
                    o.z = pk2((bflo(v.z) - mean) * rstd * g1.x + b1.x, (bfhi(v.z) - mean) * rstd * g1.y + b1.y); o.w = pk2((bflo(v.w) - mean) * rstd * g1.z + b1.z, (bfhi(v.w) - mean) * rstd * g1.w + b1.w);
                    *(v4u*)(dst + (size_t)m * D + col) = o; } } }
    }
}
__device__ __forceinline__ void phase_combine(const float* p1, const bf16* h2, const bf16* pw, bf16* xb, float* outf, int vcu, int G, const int tid) {
    const int lane = tid & 63, w = tid >> 6;
    for (int r0 = 2 * vcu; r0 < MS; r0 += 2 * G) {
        const int r = r0 + (w >> 2), q = w & 3, col = 512 * q + 8 * lane; const size_t off = (size_t)(MP + r) * D + col;
        const float* q1 = p1 + (size_t)r * D + col;
        f32x4 x0 = *(const f32x4*)q1, x1 = *(const f32x4*)(q1 + 4);
#pragma unroll
        for (int ch = 1; ch < 16; ++ch) { x0 = x0 + *(const f32x4*)(q1 + (size_t)ch * 512 * D); x1 = x1 + *(const f32x4*)(q1 + (size_t)ch * 512 * D + 4); }
        const v4u hh = *(const v4u*)(h2 + off), pp = *(const v4u*)(pw + off);
        f32x4 o0, o1;
        o0.x = bflo(hh.x) + sigm(x0.x) * bflo(pp.x); o0.y = bfhi(hh.x) + sigm(x0.y) * bfhi(pp.x); o0.z = bflo(hh.y) + sigm(x0.z) * bflo(pp.y); o0.w = bfhi(hh.y) + sigm(x0.w) * bfhi(pp.y);
        o1.x = bflo(hh.z) + sigm(x1.x) * bflo(pp.z); o1.y = bfhi(hh.z) + sigm(x1.y) * bfhi(pp.z); o1.z = bflo(hh.w) + sigm(x1.z) * bflo(pp.w); o1.w = bfhi(hh.w) + sigm(x1.w) * bfhi(pp.w);
        v4u ob; ob.x = pk2(o0.x, o0.y); ob.y = pk2(o0.z, o0.w); ob.z = pk2(o1.x, o1.y); ob.w = pk2(o1.z, o1.w); *(v4u*)(xb + off) = ob;
        if (outf) { *(f32x4*)(outf + off) = o0; *(f32x4*)(outf + off + 4) = o1; }
    }
}

constexpr int N_PHASES = 22;
enum { OP_INPROJ = 0, OP_MIXA, OP_MIXB, OP_MIXC, OP_OUTPROJ, OP_LN1, OP_UP, OP_DOWN, OP_LN2, OP_GATE, OP_COMBINE };
enum { GK_LN = 0, GK_BF16 = 1, GK_SQRELU = 2, GK_COMB = 3 };
__global__ void __launch_bounds__(NTHR, 2) mk_fwd(Args a_in) {
    extern __shared__ __attribute__((aligned(16))) unsigned char lds_raw[];
    LAS unsigned char* lds = (LAS unsigned char*)lds_raw;
    ArgsP kp = (ArgsP)__builtin_amdgcn_kernarg_segment_ptr();
    const int lo = a_in.ph_lo, hi = a_in.ph_hi;
    int wv0; { const int wtmp = (int)threadIdx.x >> 6; asm volatile("s_nop 4\n\tv_readfirstlane_b32 %0, %1\n\ts_nop 4" : "=s"(wv0) : "v"(wtmp)); }
#if MK_N_LAUNCHES == 1
    volatile LAS unsigned* xst = (volatile LAS unsigned*)(lds + LDS_CTL_OFF);
    if (threadIdx.x < 2) xst[threadIdx.x] = 0u;
    __syncthreads();
    XcdBarrier bar = xcd_barrier_post((unsigned*)(a_in.ws + WS_CTL) + 4096, xst);
#endif
    int p = lo; asm volatile("" : "+s"(p));
#pragma unroll 1
    for (; p < hi; ) {
      int nrep = 1;
      if (PROBE_MASK) { const int L_ = p <= 11 ? 0 : 1; const int q_ = p == 0 ? -1 : (L_ == 0 ? p - 1 : (p - 12 < 3 ? p - 12 : p - 11));
        int grp; if (p == 0) grp = 0; else if (q_ == OP_INPROJ || q_ == OP_UP) grp = 1; else if (q_ == OP_OUTPROJ || q_ == OP_DOWN || q_ == OP_GATE) grp = 2; else if (q_ == OP_LN1 || q_ == OP_LN2 || q_ == OP_COMBINE) grp = 3; else grp = (L_ == 0) ? 4 : 5;
        if ((PROBE_MASK >> grp) & 1) nrep = 2; }
      if (p == PROBE_P) nrep = 2;
#pragma unroll 1
      for (int rep = 0; rep < nrep; ++rep) {
        int pp = p; asm volatile("" : "+s"(pp));
        int wvs = wv0; asm volatile("" : "+s"(wvs));
        unsigned ones = ~0u; asm volatile("" : "+s"(ones));
        int tid = (wvs << 6) | (int)__builtin_amdgcn_mbcnt_hi(ones, __builtin_amdgcn_mbcnt_lo(ones, 0u)); asm volatile("" : "+v"(tid));
        int bx = blockIdx.x; asm volatile("" : "+s"(bx));
        int G = gridDim.x; asm volatile("" : "+s"(G));
        ArgsP a = kp; asm volatile("" : "+s"(a));
#define MK_VCU ((G % 8 == 0) ? (bx % 8) * (G / 8) + bx / 8 : bx)
#define MK_WAVE (__builtin_amdgcn_readfirstlane(tid >> 6))
#define MK_GW (MK_VCU * NWAVES + MK_WAVE)
#define MK_NGW (G * NWAVES)
#define MK_LANE (tid & 63)
        unsigned char* ws = a->ws;
        if (pp == 0) {
phase_convert(a, lds, MK_GW, MK_NGW, MK_WAVE, MK_LANE); }
        else {
            const int L = pp <= 11 ? 0 : 1; const int q = L == 0 ? pp - 1 : (pp - 12 < 3 ? pp - 12 : pp - 11);
            bf16* xb = (bf16*)(ws + WS_XB); bf16* mixb = (bf16*)(ws + WS_MIX); bf16* hb = (bf16*)(ws + WS_H); bf16* h2b = (bf16*)(ws + WS_H2); bf16* pwb = (bf16*)(ws + WS_PW);
            bf16* projb = (bf16*)(ws + WS_PROJ); bf16* upb = (bf16*)(ws + WS_PROJ);
            bf16* vbb = (bf16*)(ws + WS_PART0); float* stb = (float*)(ws + WS_PART0 + 34 * MiB); float* part1 = (float*)(ws + WS_PART1); float* gatesb = (float*)(ws + WS_GATES);
            if (q == OP_MIXA) { if (L == 0) phase_mixer_even(a, lds, MK_VCU, G, tid); else phase_mixer_odd(a, lds, MK_VCU, G, tid); }
            else if (q == OP_MIXB) { if (L == 0) phase_mixer_even_b(a, lds, MK_VCU, G, tid); else phase_mixer_odd_b(a, lds, MK_VCU, G, tid); }
            else if (q == OP_MIXC) { phase_mixer_even_c(a, lds, MK_VCU, G, tid); }
            else if (q == OP_LN1) phase_ln(vbb, stb, part1, xb, a->in[I_LN1G] + L * D, a->in[I_LN1B] + L * D, hb, lds, MK_VCU, G, tid);
            else if (q == OP_LN2) phase_ln(vbb, stb, part1, hb, a->in[I_LN2G] + L * D, a->in[I_LN2B] + L * D, h2b, lds, MK_VCU, G, tid);
            else if (q == OP_COMBINE) phase_combine(part1, h2b, pwb, xb, L == 1 ? a->out + O_Y : nullptr, MK_VCU, G, tid);
            else {
                for (int sub = 0; sub < (q == OP_OUTPROJ ? 2 : 1); ++sub) {
                    const bf16* A; const bf16* Bt; int N, K, kind; void* out = nullptr; float* gp = nullptr; const bf16* resid = nullptr; int corder = bx;
                    if (q == OP_INPROJ) { A = xb; Bt = (const bf16*)(ws + (L == 0 ? WS_WINE : WS_WINO)); N = NPROJ_PAD; K = D; kind = GK_BF16; out = projb; gp = gatesb; }
                    else if (q == OP_OUTPROJ && sub == 0) { A = mixb; Bt = (const bf16*)(ws + (L == 0 ? WS_WOUTE : WS_WOUTO)); N = D; K = D; kind = GK_LN; resid = xb; }
                    else if (q == OP_OUTPROJ) { A = (const bf16*)(ws + WS_PB) + (size_t)L * M * PLE; Bt = (const bf16*)(ws + WS_WPLE) + (size_t)L * PLE * D; N = D; K = PLE; kind = GK_BF16; out = pwb; corder = (bx + 128) % G; }
                    else if (q == OP_UP) { A = hb; Bt = (const bf16*)(ws + WS_WUP) + (size_t)L * D * FF; N = FF; K = D; kind = GK_SQRELU; out = upb; }
                    else if (q == OP_DOWN) { A = upb; Bt = (const bf16*)(ws + WS_WDOWN) + (size_t)L * D * FF; N = D; K = FF; kind = GK_LN; resid = hb; }
                    else { A = h2b; Bt = (const bf16*)(ws + WS_WGATE) + (size_t)L * D * D; N = D; K = D; kind = GK_COMB; }
                    pg8::Gemm g{A, Bt, M, N, K};
                    if (kind == GK_LN) { pg8::MainSplit SK; SK.init(K, MK_VCU); pg8::EpiLnStat E{vbb, stb, resid, part1, N, M, DN_ALPHA}; pg8::gemm_phase<pg8::EpiLnStat, pg8::MainSplit, true, true>(lds, g, SK, E, tid); }
                    else if (kind == GK_COMB) { pg8::MainSplit SK; SK.init(K, MK_VCU); pg8::EpiCombine E{h2b, pwb, xb, L == 1 ? a->out + O_Y : nullptr, part1, N}; pg8::gemm_phase<pg8::EpiCombine, pg8::MainSplit, true, true>(lds, g, SK, E, tid); }
                    else if (kind == GK_BF16) { pg8::StaticOrder S; S.init(M, N, K, G, corder); pg8::EpiBf16<0> E{(bf16*)out, N, gp, 24}; pg8::gemm_phase<pg8::EpiBf16<0>, pg8::StaticOrder, true, true>(lds, g, S, E, tid); }
                    else { pg8::StaticOrder S; S.init(M, N, K, G, corder); pg8::EpiBf16<1> E{(bf16*)out, N, nullptr, -1}; pg8::gemm_phase<pg8::EpiBf16<1>, pg8::StaticOrder, true, true>(lds, g, S, E, tid); }
                }
            }
        }
#if MK_N_LAUNCHES == 1
        if (p + 1 < hi || rep + 1 < nrep) xcd_barrier(bar);
#endif
      }
      asm volatile("s_add_i32 %0, %0, 1" : "+s"(p) : : "scc");
    }
}

extern "C" void kernel_launch(void* const* d_in, const int* in_sizes, int n_in, void* d_out, int out_size, void* d_ws, size_t ws_size, hipStream_t stream) {
    static int grid = 0;
    if (grid == 0) {
        if (n_in != 35 || (size_t)out_size != O_END || ws_size < WS_END) { fprintf(stderr, "kernel_launch: unexpected shapes: n_in %d out %d (want %zu) ws %zu (want %zu)\n", n_in, out_size, (size_t)O_END, ws_size, (size_t)WS_END); grid = -1; return; }
        int dev = 0, cus = 0, per_cu = 0;
        hipGetDevice(&dev); hipDeviceGetAttribute(&cus, hipDeviceAttributeMultiprocessorCount, dev);
        if (hipFuncSetAttribute((const void*)mk_fwd, hipFuncAttributeMaxDynamicSharedMemorySize, LDS_BYTES) != hipSuccess) { fprintf(stderr, "kernel_launch: hipFuncSetAttribute failed\n"); grid = -1; return; }
        if (hipOccupancyMaxActiveBlocksPerMultiprocessor(&per_cu, (const void*)mk_fwd, NTHR, LDS_BYTES) != hipSuccess || per_cu < 1) { fprintf(stderr, "kernel_launch: occupancy query says %d\n", per_cu); per_cu = 1; }
        (void)hipGetLastError();
        if (cus != 256) { fprintf(stderr, "kernel_launch: built for a 256-CU device (N = 2048 GEMM schedule), got %d\n", cus); grid = -1; return; }
        grid = cus * 1;
    }
    if (grid < 0) return;
    Args a{};
    for (int i = 0; i < 35; ++i) a.in[i] = (const float*)d_in[i];
    a.out = (float*)d_out; a.ws = (unsigned char*)d_ws;
#if MK_N_LAUNCHES == 1
    hipMemsetAsync((char*)d_ws + WS_CTL, 0, 1 * MiB, stream);
    a.ph_lo = 0; a.ph_hi = N_PHASES;
    hipLaunchKernelGGL(mk_fwd, dim3(grid), dim3(NTHR), LDS_BYTES, stream, a);
#else
    for (int p = 0; p < N_PHASES; ++p) {
        a.ph_lo = p; a.ph_hi = p + 1;
        hipLaunchKernelGGL(mk_fwd, dim3(grid), dim3(NTHR), LDS_BYTES, stream, a);
    }
#endif
}
```

```cpp
#include <hip/hip_runtime.h>
#include <hip/hip_cooperative_groups.h>
#include <cstdio>
#include <cstdint>
namespace cg = cooperative_groups;

#ifndef PROBE_MASK
#define PROBE_MASK 0
#endif
#define PROBE_P (-1)
#define PROBE_SUB 0
#ifndef MK_N_LAUNCHES
#define MK_N_LAUNCHES 1
#endif

namespace pg8 {
#define PG8_LAS __attribute__((address_space(3)))
typedef unsigned short bf16_t;
typedef short bf16x8 __attribute__((ext_vector_type(8)));
typedef float f32x4 __attribute__((ext_vector_type(4)));
typedef unsigned u32x4 __attribute__((ext_vector_type(4)));
constexpr int BM = 256, BK = 64, HALF = 128, HTB = HALF * BK * 2, STAGE_BYTES = 8 * HTB, NXCD = 8, WGM = 8;

__host__ __device__ __forceinline__ int lds_byte(int r, int c) { const int st = (r >> 4) * 2 + (c >> 5), rr = r & 15, cc = c & 31, ob = rr * 64 + cc * 2; return st * 1024 + (ob ^ (((ob >> 9) & 1) << 5)); }
__host__ __device__ __forceinline__ void stage_rc(int b, int& R, int& C) { const int st = b / 1024, sb = b % 1024, swz = sb ^ (((sb >> 9) & 1) << 5); R = (st >> 1) * 16 + swz / 64; C = (st & 1) * 32 + (swz % 64) / 2; }
__host__ __device__ __forceinline__ int perm32(int rho) { const int n = rho >> 4, i = rho & 15; return 8 * (i >> 2) + 4 * n + (i & 3); }

struct Unit { int pm, pn, kt0, nkt, dst; };
struct Gemm { const bf16_t* A; const bf16_t* Bt; int M, N, K; };

struct StaticOrder {
    int nM, nN, nwg, G, c, T;
    __host__ __device__ void init(int M, int N, int K, int G_, int c_) { nM = M / BM; nN = N / BM; nwg = nM * nN; G = G_; c = c_; T = K / BK; }
    __host__ __device__ bool next(int i, Unit& u) const {
        const long L = (long)i * G + c; if (L >= nwg) return false;
        int wgid = (int)L; { const int q = nwg / NXCD, r = nwg % NXCD, xcd = wgid % NXCD, off = wgid / NXCD; wgid = (xcd < r ? xcd * (q + 1) : r * (q + 1) + (xcd - r) * q) + off; }
        const int nig = WGM * nN, gid = wgid / nig, fm = gid * WGM, gsz = (nM - fm) < WGM ? (nM - fm) : WGM;
        u.pm = fm + ((wgid % nig) % gsz); u.pn = (wgid % nig) / gsz; u.kt0 = 0; u.nkt = T; u.dst = 0; return true;
    }
    __device__ __forceinline__ void a_ready(const Unit&) const {}
    __device__ __forceinline__ void done(const Unit&) const {}
};
struct StreamK {
    int nN, T, P, ntot, c;
    __host__ __device__ void init(int M, int N, int K, int G, int c_) { nN = N / BM; T = K / BK; ntot = (M / BM) * nN * T; P = (((ntot + G - 1) / G) + 1) & ~1; c = c_; }
    __host__ __device__ bool next(int i, Unit& u) const {
        int s = c * P; const int e = (s + P < ntot) ? s + P : ntot;
        for (int k = 0; ; ++k) { if (s >= e) return false; const int tile = s / T, kt0 = s - tile * T; const int n = (T - kt0 < e - s) ? T - kt0 : e - s;
            if (k == i) { u.pm = tile / nN; u.pn = tile - u.pm * nN; u.kt0 = kt0; u.nkt = n; u.dst = kt0 ? 1 : 0; return true; }
            s += n; }
    }
    __device__ __forceinline__ void a_ready(const Unit&) const {}
    __device__ __forceinline__ void done(const Unit&) const {}
};
struct MainSplit {
    int T, c;
    __host__ __device__ void init(int K, int c_) { T = K / BK; c = c_; }
    __host__ __device__ bool next(int i, Unit& u) const {
        if (i == 0) { u.pm = c >> 3; u.pn = c & 7; u.kt0 = 0; u.nkt = T; u.dst = 0; return true; }
        if (i == 1) { const int lt = c >> 4, j = c & 15; u.pm = 32 + (lt >> 3); u.pn = lt & 7; u.nkt = T >> 4; u.kt0 = j * u.nkt; u.dst = 1 + j; return true; }
        return false;
    }
    __device__ __forceinline__ void a_ready(const Unit&) const {}
    __device__ __forceinline__ void done(const Unit&) const {}
};
__host__ __device__ __forceinline__ bool split_tile(int tile, int T, int P) { return (tile * T) / P != ((tile + 1) * T - 1) / P; }

__device__ __forceinline__ unsigned cvt_pk_bf16(float lo, float hi) { unsigned r; asm volatile("v_cvt_pk_bf16_f32 %0, %1, %2" : "=v"(r) : "v"(lo), "v"(hi)); return r; }

__device__ __forceinline__ float pg_bflo(unsigned w) { return __builtin_bit_cast(float, w << 16); }
__device__ __forceinline__ float pg_bfhi(unsigned w) { return __builtin_bit_cast(float, w & 0xffff0000u); }
__device__ __forceinline__ void store_chunk(const f32x4 (&acc)[2][2][4][2], const Unit& u, float* C1, int ldc, int wr, int wc, int fr, int fq) {
    const int row0 = u.pm * BM + wr * 64 + fr, col0 = u.pn * BM + wc * 32 + 8 * fq; float* Cb = C1 + ((long)(u.dst - 1) * 512 - 8192) * (long)ldc;
#pragma unroll
    for (int ai = 0; ai < 2; ++ai)
#pragma unroll
        for (int m = 0; m < 4; ++m) { float* rowp = Cb + (size_t)(row0 + ai * HALF + m * 16) * ldc + col0;
#pragma unroll
            for (int bj = 0; bj < 2; ++bj) { *(f32x4*)(rowp + bj * HALF) = acc[ai][bj][m][0]; *(f32x4*)(rowp + bj * HALF + 4) = acc[ai][bj][m][1]; } }
}
struct EpiLnStat {
    static constexpr bool PERM = true, AFTER_DRAIN = false;
    bf16_t* VB; float* ST; const bf16_t* resid; float* C1; int ldc; int mrows; float alpha;
    __device__ __forceinline__ void operator()(const f32x4 (&acc)[2][2][4][2], const Unit& u, int wr, int wc, int fr, int fq) const {
        if (u.dst) { store_chunk(acc, u, C1, ldc, wr, wc, fr, fq); return; }
        const int row0 = u.pm * BM + wr * 64 + fr, col0 = u.pn * BM + wc * 32 + 8 * fq;
#pragma unroll
        for (int ai = 0; ai < 2; ++ai)
#pragma unroll
            for (int m = 0; m < 4; ++m) { const int row = row0 + ai * HALF + m * 16; float s = 0.f, ss = 0.f;
#pragma unroll
                for (int bj = 0; bj < 2; ++bj) { const size_t off = (size_t)row * ldc + col0 + bj * HALF; const u32x4 r = *(const u32x4*)(resid + off);
                    f32x4 v0 = acc[ai][bj][m][0], v1 = acc[ai][bj][m][1];
                    v0[0] += alpha * pg_bflo(r.x); v0[1] += alpha * pg_bfhi(r.x); v0[2] += alpha * pg_bflo(r.y); v0[3] += alpha * pg_bfhi(r.y);
                    v1[0] += alpha * pg_bflo(r.z); v1[1] += alpha * pg_bfhi(r.z); v1[2] += alpha * pg_bflo(r.w); v1[3] += alpha * pg_bfhi(r.w);
                    s += ((v0[0] + v0[1]) + (v0[2] + v0[3])) + ((v1[0] + v1[1]) + (v1[2] + v1[3]));
                    ss += ((v0[0] * v0[0] + v0[1] * v0[1]) + (v0[2] * v0[2] + v0[3] * v0[3])) + ((v1[0] * v1[0] + v1[1] * v1[1]) + (v1[2] * v1[2] + v1[3] * v1[3]));
                    u32x4 w; w.x = cvt_pk_bf16(v0[0], v0[1]); w.y = cvt_pk_bf16(v0[2], v0[3]); w.z = cvt_pk_bf16(v1[0], v1[1]); w.w = cvt_pk_bf16(v1[2], v1[3]);
                    *(u32x4*)(VB + off) = w; }
                s += __shfl_xor(s, 16); s += __shfl_xor(s, 32); ss += __shfl_xor(ss, 16); ss += __shfl_xor(ss, 32);
                if (fq == 0) { float* sp = ST + (((size_t)u.pn * mrows + row) * 4 + wc) * 2; sp[0] = s; sp[1] = ss; } }
    }
};
struct EpiCombine {
    static constexpr bool PERM = true, AFTER_DRAIN = false;
    const bf16_t* h2; const bf16_t* pw; bf16_t* xb; float* outf; float* C1; int ldc;
    __device__ __forceinline__ void operator()(const f32x4 (&acc)[2][2][4][2], const Unit& u, int wr, int wc, int fr, int fq) const {
        if (u.dst) { store_chunk(acc, u, C1, ldc, wr, wc, fr, fq); return; }
        const int row0 = u.pm * BM + wr * 64 + fr, col0 = u.pn * BM + wc * 32 + 8 * fq;
#pragma unroll
        for (int ai = 0; ai < 2; ++ai)
#pragma unroll
            for (int m = 0; m < 4; ++m) { const int row = row0 + ai * HALF + m * 16;
#pragma unroll
                for (int bj = 0; bj < 2; ++bj) { const size_t off = (size_t)row * ldc + col0 + bj * HALF; const u32x4 hh = *(const u32x4*)(h2 + off), pp = *(const u32x4*)(pw + off);
                    const f32x4 a0 = acc[ai][bj][m][0], a1 = acc[ai][bj][m][1]; f32x4 o0, o1;
                    o0[0] = pg_bflo(hh.x) + pg_bflo(pp.x) / (1.f + __expf(-a0[0])); o0[1] = pg_bfhi(hh.x) + pg_bfhi(pp.x) / (1.f + __expf(-a0[1]));
                    o0[2] = pg_bflo(hh.y) + pg_bflo(pp.y) / (1.f + __expf(-a0[2])); o0[3] = pg_bfhi(hh.y) + pg_bfhi(pp.y) / (1.f + __expf(-a0[3]));
                    o1[0] = pg_bflo(hh.z) + pg_bflo(pp.z) / (1.f + __expf(-a1[0])); o1[1] = pg_bfhi(hh.z) + pg_bfhi(pp.z) / (1.f + __expf(-a1[1]));
                    o1[2] = pg_bflo(hh.w) + pg_bflo(pp.w) / (1.f + __expf(-a1[2])); o1[3] = pg_bfhi(hh.w) + pg_bfhi(pp.w) / (1.f + __expf(-a1[3]));
                    u32x4 w; w.x = cvt_pk_bf16(o0[0], o0[1]); w.y = cvt_pk_bf16(o0[2], o0[3]); w.z = cvt_pk_bf16(o1[0], o1[1]); w.w = cvt_pk_bf16(o1[2], o1[3]);
                    *(u32x4*)(xb + off) = w;
                    if (outf) { *(f32x4*)(outf + off) = o0; *(f32x4*)(outf + off + 4) = o1; } } }
    }
};
template <int ACT> struct EpiBf16 {
    static constexpr bool PERM = true, AFTER_DRAIN = false;
    bf16_t* O; int ldc; float* gates; int gate_pn;
    __device__ __forceinline__ void operator()(const f32x4 (&acc)[2][2][4][2], const Unit& u, int wr, int wc, int fr, int fq) const {
        const int row0 = u.pm * BM + wr * 64 + fr; const int col0 = u.pn * BM + wc * 32 + 8 * fq;
        const bool gt = (gates != nullptr) && (u.pn == gate_pn) && (wc == 0) && (fq < 2);
#pragma unroll
        for (int ai = 0; ai < 2; ++ai)
#pragma unroll
            for (int m = 0; m < 4; ++m) { const int row = row0 + ai * HALF + m * 16; bf16_t* rowp = O + (size_t)row * ldc + col0;
#pragma unroll
                for (int bj = 0; bj < 2; ++bj) { f32x4 v0 = acc[ai][bj][m][0], v1 = acc[ai][bj][m][1];
                    if (ACT == 1) {
#pragma unroll
                        for (int j = 0; j < 4; ++j) { const float a = fmaxf(v0[j], 0.f), b = fmaxf(v1[j], 0.f); v0[j] = a * a; v1[j] = b * b; } }
                    u32x4 w; w.x = cvt_pk_bf16(v0[0], v0[1]); w.y = cvt_pk_bf16(v0[2], v0[3]); w.z = cvt_pk_bf16(v1[0], v1[1]); w.w = cvt_pk_bf16(v1[2], v1[3]);
                    *(u32x4*)(rowp + bj * HALF) = w; }
                if (gt) { float* gp = gates + (size_t)row * 16 + 8 * fq; *(f32x4*)gp = acc[ai][0][m][0]; *(f32x4*)(gp + 4) = acc[ai][0][m][1]; } }
    }
};

template <class Epi, class Sched, bool ALIGN_EPI = false, bool SP2 = false>
__device__ __forceinline__ void gemm_phase(PG8_LAS unsigned char* lds, const Gemm g, const Sched& S, const Epi& E, const int tid) {
    const int wid = __builtin_amdgcn_readfirstlane(tid >> 6), lane = tid & 63, wr = wid >> 2, wc = wid & 3, fr = lane & 15, fq = lane >> 4;
    const int K = g.K;
    unsigned voffA[2], voffB[2];
#pragma unroll
    for (int i = 0; i < 2; ++i) { int R, C; stage_rc(tid * 16 + i * 8192, R, C); const int Rb = Epi::PERM ? ((R & ~31) + perm32(R & 31)) : R;
        voffA[i] = (unsigned)(R * K + C) * 2u; voffB[i] = (unsigned)(Rb * K + C) * 2u; }
    const size_t kstep = (size_t)(BK * 2);
    const size_t hstep = (size_t)HALF * K * 2;
    const size_t tstep = 2 * hstep;
    const unsigned ldsw = (unsigned)wid * 1024u;
    const int aoff = lds_byte(wr * 64 + fr, fq * 8), boff = lds_byte(wc * 32 + fr, fq * 8);
#define PG8_SA(b, h) (((b) * 2 + (h)) * HTB)
#define PG8_SB(b, h) ((4 + (b) * 2 + (h)) * HTB)
#define PG8_STAGE(bufoff, gbase, voff) do { _Pragma("unroll") for (int _i = 0; _i < 2; ++_i) \
        __builtin_amdgcn_global_load_lds((const unsigned*)((const char*)(gbase) + (voff)[_i]), (PG8_LAS unsigned*)(lds + (bufoff) + ldsw + _i * 8192), 16, 0, 0); } while (0)
#define PG8_LDA(dst, b, h) do { _Pragma("unroll") for (int m = 0; m < 4; ++m) _Pragma("unroll") for (int k = 0; k < 2; ++k) dst[m][k] = *(const PG8_LAS bf16x8*)(lds + PG8_SA(b, h) + aoff + m * 2048 + k * 1024); } while (0)
#define PG8_LDB(dst, b, h) do { _Pragma("unroll") for (int n = 0; n < 2; ++n) _Pragma("unroll") for (int k = 0; k < 2; ++k) dst[n][k] = *(const PG8_LAS bf16x8*)(lds + PG8_SB(b, h) + boff + n * 2048 + k * 1024); } while (0)
#define PG8_MMA(ai, bj, At, Bt) do { __builtin_amdgcn_s_setprio(1); _Pragma("unroll") for (int m = 0; m < 4; ++m) _Pragma("unroll") for (int n = 0; n < 2; ++n) _Pragma("unroll") for (int k = 0; k < 2; ++k) \
        acc[ai][bj][m][n] = __builtin_amdgcn_mfma_f32_16x16x32_bf16(Bt[n][k], At[m][k], acc[ai][bj][m][n], 0, 0, 0); __builtin_amdgcn_s_setprio(0); } while (0)
#define PG8_WAIT_V(n) asm volatile("s_waitcnt vmcnt(" #n ")" ::: "memory")
#define PG8_WAIT_L(n) asm volatile("s_waitcnt lgkmcnt(" #n ")" ::: "memory")
#define PG8_BAR __builtin_amdgcn_s_barrier()
#define PG8_SCHED __builtin_amdgcn_sched_barrier(0)
    Unit cur, nxt; int ui = 0;
    if (!S.next(0, cur)) return;
    f32x4 acc[2][2][4][2];
#pragma unroll
    for (int a = 0; a < 2; ++a)
#pragma unroll
        for (int b = 0; b < 2; ++b)
#pragma unroll
            for (int m = 0; m < 4; ++m)
#pragma unroll
                for (int n = 0; n < 2; ++n) acc[a][b][m][n] = (f32x4){0.f, 0.f, 0.f, 0.f};
    bf16x8 At[4][2], B0[2][2], B1[2][2];
    const char* cA = (const char*)g.A + (size_t)cur.pm * tstep + (size_t)cur.kt0 * kstep; const char* cB = (const char*)g.Bt + (size_t)cur.pn * tstep + (size_t)cur.kt0 * kstep;
    S.a_ready(cur);
    if constexpr (SP2) {
        PG8_STAGE(PG8_SB(0, 0), cB, voffB); PG8_STAGE(PG8_SB(0, 1), cB + hstep, voffB); PG8_STAGE(PG8_SA(0, 0), cA, voffA); PG8_STAGE(PG8_SA(0, 1), cA + hstep, voffA);
        if (wr == 1) PG8_BAR;
        PG8_WAIT_V(2); PG8_BAR;
        PG8_STAGE(PG8_SB(1, 0), cB + kstep, voffB); PG8_STAGE(PG8_SA(1, 0), cA + kstep, voffA); PG8_STAGE(PG8_SB(1, 1), cB + hstep + kstep, voffB);
        PG8_WAIT_V(6); PG8_BAR;
    } else {
        PG8_STAGE(PG8_SB(0, 0), cB, voffB); PG8_STAGE(PG8_SA(0, 0), cA, voffA); PG8_STAGE(PG8_SB(0, 1), cB + hstep, voffB); PG8_STAGE(PG8_SA(0, 1), cA + hstep, voffA);
        if (wr == 1) PG8_BAR;
        PG8_WAIT_V(4); PG8_BAR;
        PG8_STAGE(PG8_SB(1, 0), cB + kstep, voffB); PG8_STAGE(PG8_SA(1, 0), cA + kstep, voffA); PG8_STAGE(PG8_SB(1, 1), cB + hstep + kstep, voffB);
        PG8_WAIT_V(6); PG8_BAR;
    }
    for (;;) {
        const bool has_next = S.next(ui + 1, nxt);
        const char* nA = has_next ? (const char*)g.A + (size_t)nxt.pm * tstep + (size_t)nxt.kt0 * kstep : cA; const char* nB = has_next ? (const char*)g.Bt + (size_t)nxt.pn * tstep + (size_t)nxt.kt0 * kstep : cB;
        const int nt = cur.nkt;
        for (int t = 0; t < nt; t += 2) {
            const bool last = (t == nt - 2);
            const char* a1 = cA + (size_t)(t + 1) * kstep;
            const char* a2 = last ? nA : cA + (size_t)(t + 2) * kstep; const char* b2 = last ? nB : cB + (size_t)(t + 2) * kstep;
            const char* a3 = a2 + kstep; const char* b3 = b2 + kstep;
            if (last && has_next) S.a_ready(nxt);
            if constexpr (SP2) {
            PG8_LDB(B0, 0, 0); PG8_LDB(B1, 0, 1); PG8_SCHED; PG8_LDA(At, 0, 0); PG8_STAGE(PG8_SA(1, 1), a1 + hstep, voffA);
            PG8_WAIT_V(8); PG8_WAIT_L(0); PG8_BAR; PG8_MMA(0, 0, At, B0); PG8_MMA(0, 1, At, B1); PG8_BAR; PG8_SCHED;
            PG8_LDA(At, 0, 1); PG8_STAGE(PG8_SB(0, 0), b2, voffB); PG8_STAGE(PG8_SB(0, 1), b2 + hstep, voffB); PG8_STAGE(PG8_SA(0, 0), a2, voffA);
            PG8_WAIT_V(8); PG8_WAIT_L(0); PG8_BAR; PG8_MMA(1, 0, At, B0); PG8_MMA(1, 1, At, B1); PG8_BAR; PG8_SCHED;
            PG8_LDB(B0, 1, 0); PG8_LDB(B1, 1, 1); PG8_SCHED; PG8_LDA(At, 1, 0); PG8_STAGE(PG8_SA(0, 1), a2 + hstep, voffA);
            PG8_WAIT_V(8); PG8_WAIT_L(0); PG8_BAR; PG8_MMA(0, 0, At, B0); PG8_MMA(0, 1, At, B1); PG8_BAR; PG8_SCHED;
            PG8_LDA(At, 1, 1); PG8_STAGE(PG8_SB(1, 0), b3, voffB); PG8_STAGE(PG8_SB(1, 1), b3 + hstep, voffB); PG8_STAGE(PG8_SA(1, 0), a3, voffA);
            PG8_WAIT_V(8); PG8_WAIT_L(0); PG8_BAR; PG8_MMA(1, 0, At, B0); PG8_MMA(1, 1, At, B1); PG8_BAR; PG8_SCHED;
            } else {
            PG8_LDB(B0, 0, 0); PG8_SCHED; PG8_LDA(At, 0, 0); PG8_STAGE(PG8_SA(1, 1), a1 + hstep, voffA);
            PG8_WAIT_L(8); PG8_BAR; PG8_WAIT_L(0); PG8_MMA(0, 0, At, B0); PG8_BAR; PG8_SCHED;
            PG8_LDB(B1, 0, 1); PG8_STAGE(PG8_SB(0, 0), b2, voffB);
            PG8_BAR; PG8_WAIT_L(0); PG8_MMA(0, 1, At, B1); PG8_BAR;
            PG8_LDA(At, 0, 1); PG8_STAGE(PG8_SA(0, 0), a2, voffA);
            PG8_BAR; PG8_WAIT_L(0); PG8_MMA(1, 0, At, B0); PG8_BAR; PG8_SCHED;
            PG8_STAGE(PG8_SB(0, 1), b2 + hstep, voffB);
            PG8_WAIT_V(6); PG8_BAR; PG8_MMA(1, 1, At, B1); PG8_BAR;
            PG8_LDB(B0, 1, 0); PG8_SCHED; PG8_LDA(At, 1, 0); PG8_STAGE(PG8_SA(0, 1), a2 + hstep, voffA);
            PG8_WAIT_L(8); PG8_BAR; PG8_WAIT_L(0); PG8_MMA(0, 0, At, B0); PG8_BAR; PG8_SCHED;
            PG8_LDB(B1, 1, 1); PG8_STAGE(PG8_SB(1, 0), b3, voffB);
            PG8_BAR; PG8_WAIT_L(0); PG8_MMA(0, 1, At, B1); PG8_BAR;
            PG8_LDA(At, 1, 1); PG8_STAGE(PG8_SA(1, 0), a3, voffA);
            PG8_BAR; PG8_WAIT_L(0); PG8_MMA(1, 0, At, B0); PG8_BAR; PG8_SCHED;
            PG8_STAGE(PG8_SB(1, 1), b3 + hstep, voffB);
            PG8_WAIT_V(6); PG8_BAR; PG8_MMA(1, 1, At, B1); PG8_BAR;
            }
        }
        if constexpr (ALIGN_EPI) { if (wr == 0) PG8_BAR; }
        E(acc, cur, wr, wc, fr, fq); S.done(cur);
        if (!has_next) break;
#pragma unroll
        for (int a = 0; a < 2; ++a)
#pragma unroll
            for (int b = 0; b < 2; ++b)
#pragma unroll
                for (int m = 0; m < 4; ++m)
#pragma unroll
                    for (int n = 0; n < 2; ++n) acc[a][b][m][n] = (f32x4){0.f, 0.f, 0.f, 0.f};
        cur = nxt; cA = nA; cB = nB; ++ui;
        if constexpr (ALIGN_EPI) { if (wr == 1) PG8_BAR; }
    }
    PG8_WAIT_V(0);
    if constexpr (!ALIGN_EPI) { if (wr == 0) PG8_BAR; }
    PG8_BAR;
#undef PG8_SA
#undef PG8_SB
#undef PG8_STAGE
#undef PG8_LDA
#undef PG8_LDB
#undef PG8_MMA
#undef PG8_WAIT_V
#undef PG8_WAIT_L
#undef PG8_BAR
#undef PG8_SCHED
}
}

constexpr int NWAVES = 8, NTHR = 512;
constexpr int D = 2048, FF = 8192, PLE = 256;
constexpr int TP = 2048, BP = 4, TS = 4, BS = 128;
constexpr int MP = BP * TP, MS = BS * TS, M = MP + MS;
constexpr int NPROJ = 6160, NPROJ_PAD = 6400;
constexpr int NH = 8;
constexpr float LN_EPS = 1e-5f, RMS_EPS = 1e-6f;
constexpr float DN_ALPHA = 1.41421356237f;

constexpr size_t MiB = 1u << 20;
constexpr size_t WS_CTL = 0;
constexpr size_t WS_WINE = 1 * MiB;
constexpr size_t WS_WOUTE = WS_WINE + 25 * MiB;
constexpr size_t WS_WINO = WS_WOUTE + 8 * MiB;
constexpr size_t WS_WOUTO = WS_WINO + 25 * MiB;
constexpr size_t WS_WUP = WS_WOUTO + 8 * MiB;
constexpr size_t WS_WDOWN = WS_WUP + 64 * MiB;
constexpr size_t WS_WPLE = WS_WDOWN + 64 * MiB;
constexpr size_t WS_WGATE = WS_WPLE + 2 * MiB;
constexpr size_t WS_XB = WS_WGATE + 16 * MiB;
constexpr size_t WS_MIX = WS_XB + 34 * MiB;
constexpr size_t WS_H = WS_MIX + 34 * MiB;
constexpr size_t WS_H2 = WS_H + 34 * MiB;
constexpr size_t WS_PW = WS_H2 + 34 * MiB;
constexpr size_t WS_PB = WS_PW + 34 * MiB;
constexpr size_t WS_GATES = WS_PB + 9 * MiB;
constexpr size_t WS_PROJ = WS_GATES + 1 * MiB;
constexpr size_t WS_PART0 = WS_PROJ + 136 * MiB;
constexpr size_t WS_PART1 = WS_PART0 + 68 * MiB;
constexpr size_t WS_LRUW = WS_PART1 + 68 * MiB;
constexpr size_t WS_END = WS_LRUW + 1 * MiB;
constexpr size_t WS_DG = WS_PART0;
constexpr size_t WS_DB = WS_PART0 + 32 * MiB;
constexpr size_t WS_DS = WS_PART0 + 64 * MiB;
constexpr size_t WS_DQ = WS_PART0 + 96 * MiB;
constexpr size_t WS_DO = WS_PART0 + 112 * MiB;
constexpr size_t WS_DD = WS_PART0 + 128 * MiB;
constexpr size_t WS_DF = WS_PART0 + 129 * MiB;
constexpr size_t WS_MC = WS_PART0;
constexpr size_t WS_MN = WS_PART0 + 64 * MiB;
constexpr size_t WS_MM = WS_PART0 + 65 * MiB;
constexpr size_t WS_LRU_HL = WS_H;
constexpr size_t WS_LRU_P = WS_H + 16 * MiB;
constexpr size_t WS_LRU_END = WS_H + 32 * MiB;

constexpr size_t O_Y = 0;
constexpr size_t O_CONVP = (size_t)M * D;
constexpr size_t O_DELTAP = O_CONVP + (size_t)BP * 3 * 4096;
constexpr size_t O_LRUP = O_DELTAP + (size_t)BP * 8 * 128 * 128;
constexpr size_t O_MCP = O_LRUP + (size_t)BP * 1024;
constexpr size_t O_MNP = O_MCP + (size_t)BP * 8 * 256 * 128;
constexpr size_t O_MMP = O_MNP + (size_t)BP * 8 * 128;
constexpr size_t O_CONVS = O_MMP + (size_t)BP * 8;
constexpr size_t O_DELTAS = O_CONVS + (size_t)BS * 3 * 4096;
constexpr size_t O_LRUS = O_DELTAS + (size_t)BS * 8 * 128 * 128;
constexpr size_t O_MCS = O_LRUS + (size_t)BS * 1024;
constexpr size_t O_MNS = O_MCS + (size_t)BS * 8 * 256 * 128;
constexpr size_t O_MMS = O_MNS + (size_t)BS * 8 * 128;
constexpr size_t O_END = O_MMS + (size_t)BS * 8;

constexpr int LDS_BYTES = 147456;
constexpr int LDS_CTL_OFF = 131072;

#define LAS __attribute__((address_space(3)))
typedef unsigned short bf16;
typedef unsigned v4u __attribute__((ext_vector_type(4)));
typedef unsigned v2u __attribute__((ext_vector_type(2)));
typedef float f32x4 __attribute__((ext_vector_type(4)));
#define LDS_WAIT() asm volatile("s_waitcnt lgkmcnt(0)" ::: "memory")
__device__ __forceinline__ unsigned f2bf(float f) { unsigned u = __builtin_bit_cast(unsigned, f); return (u + 0x7fffu + ((u >> 16) & 1u)) >> 16; }
__device__ __forceinline__ unsigned pk2(float lo, float hi) { return f2bf(lo) | (f2bf(hi) << 16); }
__device__ __forceinline__ float bf2f(unsigned short b) { return __builtin_bit_cast(float, ((unsigned)b) << 16); }
__device__ __forceinline__ float bflo(unsigned w) { return __builtin_bit_cast(float, w << 16); }
__device__ __forceinline__ float bfhi(unsigned w) { return __builtin_bit_cast(float, w & 0xffff0000u); }
__device__ __forceinline__ float sigm(float x) { return 1.f / (1.f + expf(-x)); }
__device__ __forceinline__ float siluf(float x) { return x * sigm(x); }
__device__ __forceinline__ float softplusf(float x) { return fmaxf(x, 0.f) + log1pf(expf(-fabsf(x))); }
__device__ __forceinline__ float logsigf(float x) { return -softplusf(-x); }
__device__ __forceinline__ float gelu_tanh(float x) { const float u = 0.7978845608028654f * (x + 0.044715f * x * x * x); return 0.5f * x * (1.f + tanhf(u)); }
__device__ __forceinline__ float wave_sum(float v) {
#pragma unroll
    for (int o = 1; o < 64; o <<= 1) v += __shfl_xor(v, o);
    return v;
}

#define XB_TMO      128
#define XB_XCNT(j)  (256  + 64 * (j))
#define XB_XSUB(j)  (1280 + 64 * (j))
#define XB_XGEN(j)  (2304 + 64 * (j))
#define XB_TOP      3328
#define XB_TOPGEN   3392
#define XCD_BAR_WORDS 3456
#define XB_SPIN_CAP (1u << 22)
__device__ __forceinline__ unsigned xb_ld(unsigned* p)              { return __hip_atomic_load(p, __ATOMIC_RELAXED, __HIP_MEMORY_SCOPE_AGENT); }
__device__ __forceinline__ unsigned xb_add(unsigned* p, unsigned v) { return __hip_atomic_fetch_add(p, v, __ATOMIC_RELAXED, __HIP_MEMORY_SCOPE_AGENT); }
__device__ __forceinline__ unsigned xb_xcc_id() { return (unsigned)__builtin_amdgcn_s_getreg((3 << 11) | 20) & 0xFu; }
#define XB_SPIN(cond, bar) do { unsigned _sp = 0; while (cond) { __builtin_amdgcn_s_sleep(1); \
    if ((++_sp & 255u) == 0u) { if (xb_ld(&(bar)[XB_TMO])) break; if (_sp > XB_SPIN_CAP) { atomicAdd(&(bar)[XB_TMO], 1u); break; } } } } while (0)
struct XcdBarrier { unsigned* bar; unsigned x; volatile LAS unsigned* st; };
__device__ __forceinline__ XcdBarrier xcd_barrier_post(unsigned* bar, volatile LAS unsigned* st) {
    XcdBarrier b; b.bar = bar; b.x = xb_xcc_id(); b.st = st;
    if (threadIdx.x == 0) (void)xb_add(&bar[XB_XCNT(b.x)], 1u);
    return b;
}
__device__ __forceinline__ void xcd_barrier_complete(unsigned* bar, unsigned x, unsigned& nloc, unsigned& nx) {
    const unsigned G = gridDim.x * gridDim.y * gridDim.z;
    unsigned sum, cnt, mine, sp = 0u;
    for (;;) {
        sum = 0u; cnt = 0u; mine = 0u;
#pragma unroll
        for (unsigned j = 0; j < 16; ++j) { const unsigned c = xb_ld(&bar[XB_XCNT(j)]); sum += c; cnt += (c > 0u) ? 1u : 0u; mine = (j == x) ? c : mine; }
        if (sum == G) break;
        __builtin_amdgcn_s_sleep(1);
        if ((++sp & 255u) == 0u) { if (xb_ld(&bar[XB_TMO])) break; if (sp > XB_SPIN_CAP) { atomicAdd(&bar[XB_TMO], 1u); break; } }
    }
    nloc = mine > 0u ? mine : 1u; nx = cnt > 0u ? cnt : 1u;
}
__device__ __forceinline__ void xcd_barrier(const XcdBarrier& b) {
    asm volatile("s_waitcnt vmcnt(0)" ::: "memory");
    __syncthreads();
    if (threadIdx.x == 0) {
        unsigned* bar = b.bar;
        __builtin_amdgcn_s_waitcnt(0);
        unsigned nloc = b.st[0], nx = b.st[1];
        if (nloc == 0u) { xcd_barrier_complete(bar, b.x, nloc, nx); b.st[0] = nloc; b.st[1] = nx; }
        const unsigned old = xb_add(&bar[XB_XSUB(b.x)], 1u);
        const unsigned gen = old / nloc;
        if (old + 1u == (gen + 1u) * nloc) {
            __builtin_amdgcn_fence(__ATOMIC_RELEASE, "agent");
            asm volatile("s_waitcnt vmcnt(0)" ::: "memory");
            const unsigned og = xb_add(&bar[XB_TOP], 1u);
            const unsigned tg = og / nx;
            if (og + 1u == (tg + 1u) * nx) xb_add(&bar[XB_TOPGEN], 1u);
            else XB_SPIN(xb_ld(&bar[XB_TOPGEN]) == tg, bar);
            __builtin_amdgcn_fence(__ATOMIC_ACQUIRE, "agent");
            xb_add(&bar[XB_XGEN(b.x)], 1u);
            asm volatile("s_waitcnt vmcnt(0)" ::: "memory");
        } else {
            XB_SPIN(xb_ld(&bar[XB_XGEN(b.x)]) == gen, bar);
            __builtin_amdgcn_fence(__ATOMIC_ACQUIRE, "agent");
            asm volatile("s_waitcnt vmcnt(0)" ::: "memory");
        }
    }
    __syncthreads();
}

struct Args { const float* in[35]; float* out; unsigned char* ws; int ph_lo, ph_hi; };
typedef const __attribute__((address_space(4))) Args* ArgsP;
enum { I_XP = 0, I_XS, I_PP, I_PS, I_SCONV, I_SDELTA, I_SLRU, I_SMC, I_SMN, I_SMM, I_WINE, I_WCONV, I_BCONV, I_ALOG, I_DTB, I_DNORM, I_LWR, I_LBR, I_LWI, I_LBI, I_LLAM, I_WOUTE,
       I_WINO, I_BIG, I_BFG, I_MNORM, I_WOUTO, I_LN1G, I_LN1B, I_LN2G, I_LN2B, I_WUP, I_WDOWN, I_WPLE, I_WGATE };

struct TDesc { const float* W; bf16* WT; int K, N, Npad, item; };
__device__ __forceinline__ void t_load(const TDesc& d, int lane, f32x4 (&v)[8]) {
    const int nblk = d.Npad / 32, kb = d.item / nblk, nb = d.item % nblk, k0 = 64 * kb, n0 = 32 * nb;
    const int r = lane >> 3, c4 = lane & 7; const bool ok = (n0 + 4 * c4) < d.N;
#pragma unroll
    for (int i = 0; i < 8; ++i) v[i] = ok ? __builtin_nontemporal_load((const f32x4*)(d.W + (size_t)(k0 + 8 * i + r) * d.N + n0 + 4 * c4)) : (f32x4){0.f, 0.f, 0.f, 0.f};
}
__device__ __forceinline__ void t_finish(const TDesc& d, LAS float* scr, int lane, const f32x4 (&v)[8]) {
    const int nblk = d.Npad / 32, kb = d.item / nblk, nb = d.item % nblk, k0 = 64 * kb, n0 = 32 * nb;
    const int r = lane >> 3, c4 = lane & 7;
#pragma unroll
    for (int i = 0; i < 8; ++i) { LAS float* q = scr + (8 * i + r) * 33 + 4 * c4; q[0] = v[i].x; q[1] = v[i].y; q[2] = v[i].z; q[3] = v[i].w; }
    LDS_WAIT(); asm volatile("" ::: "memory");
    const int c = lane & 7;
#pragma unroll
    for (int j = 0; j < 4; ++j) { const int n = (lane >> 3) + 8 * j; const LAS float* s = scr + (8 * c) * 33 + n;
        v4u o; o.x = pk2(s[0 * 33], s[1 * 33]); o.y = pk2(s[2 * 33], s[3 * 33]); o.z = pk2(s[4 * 33], s[5 * 33]); o.w = pk2(s[6 * 33], s[7 * 33]);
        *(v4u*)(d.WT + (size_t)(n0 + n) * d.K + k0 + 8 * c) = o; }
    LDS_WAIT(); asm volatile("" ::: "memory");
}
__device__ __forceinline__ void p0_transpose_item(const float* W, int K, int N, int Npad, bf16* WT, LAS float* scr, int item, int lane) {
    const TDesc d{W, WT, K, N, Npad, item}; f32x4 v[8]; t_load(d, lane, v); t_finish(d, scr, lane, v);
}
__device__ __forceinline__ void row_to_bf16(const float* src, bf16* dst, int n, int lane) {
    for (int j = 0; j < n / 256; ++j) { const f32x4 v = *(const f32x4*)(src + j * 256 + lane * 4); v2u o; o.x = pk2(v.x, v.y); o.y = pk2(v.z, v.w); *(v2u*)(dst + j * 256 + lane * 4) = o; }
}

namespace cv { constexpr int I_IN = (D / 64) * (NPROJ_PAD / 32), I_SQ = (D / 64) * (D / 32), I_UP = (D / 64) * (FF / 32), I_DN = (FF / 64) * (D / 32), I_PL = (PLE / 64) * (D / 32);
               constexpr int N_FIRST = I_IN + 128, N_REST = I_IN + 2 * I_SQ + 2 * I_UP + 2 * I_DN + 2 * I_PL + 2 * I_SQ; }
__device__ __forceinline__ void convert_first_item(ArgsP a, LAS float* scr, int r, int lane) {
    unsigned char* ws = a->ws;
    if (r < cv::I_IN) { p0_transpose_item(a->in[I_WINE], D, NPROJ, NPROJ_PAD, (bf16*)(ws + WS_WINE), scr, r, lane); return; } r -= cv::I_IN;
    { const int mat = r / 64, blk = (r / 8) & 7; p0_transpose_item(a->in[mat == 0 ? I_LWR : I_LWI] + (size_t)blk * 16384, 128, 128, 128, (bf16*)(ws + WS_LRUW) + (size_t)(mat * 8 + blk) * 16384, scr, r % 8, lane); }
}
__device__ __forceinline__ TDesc decode_rest(ArgsP a, int r) {
    using namespace cv; unsigned char* ws = a->ws;
    if (r < I_SQ) return TDesc{a->in[I_WOUTE], (bf16*)(ws + WS_WOUTE), D, D, D, r}; r -= I_SQ;
    if (r < I_UP) return TDesc{a->in[I_WUP], (bf16*)(ws + WS_WUP), D, FF, FF, r}; r -= I_UP;
    if (r < I_DN) return TDesc{a->in[I_WDOWN], (bf16*)(ws + WS_WDOWN), FF, D, D, r}; r -= I_DN;
    if (r < I_PL) return TDesc{a->in[I_WPLE], (bf16*)(ws + WS_WPLE), PLE, D, D, r}; r -= I_PL;
    if (r < I_SQ) return TDesc{a->in[I_WGATE], (bf16*)(ws + WS_WGATE), D, D, D, r}; r -= I_SQ;
    if (r < I_IN) return TDesc{a->in[I_WINO], (bf16*)(ws + WS_WINO), D, NPROJ, NPROJ_PAD, r}; r -= I_IN;
    if (r < I_SQ) return TDesc{a->in[I_WOUTO], (bf16*)(ws + WS_WOUTO), D, D, D, r}; r -= I_SQ;
    if (r < I_UP) return TDesc{a->in[I_WUP] + (size_t)D * FF, (bf16*)(ws + WS_WUP) + (size_t)D * FF, D, FF, FF, r}; r -= I_UP;
    if (r < I_DN) return TDesc{a->in[I_WDOWN] + (size_t)D * FF, (bf16*)(ws + WS_WDOWN) + (size_t)D * FF, FF, D, D, r}; r -= I_DN;
    if (r < I_PL) return TDesc{a->in[I_WPLE] + (size_t)PLE * D, (bf16*)(ws + WS_WPLE) + (size_t)PLE * D, PLE, D, D, r}; r -= I_PL;
    return TDesc{a->in[I_WGATE] + (size_t)D * D, (bf16*)(ws + WS_WGATE) + (size_t)D * D, D, D, D, r};
}
__device__ __forceinline__ void phase_convert(ArgsP a, LAS unsigned char* lds, int gw, int NGW, int wave, int lane) {
    unsigned char* ws = a->ws;
    LAS float* scr = (LAS float*)(lds + wave * 16384);
    for (int it = gw; it < cv::N_FIRST; it += NGW) convert_first_item(a, scr, it, lane);
    bf16* xb = (bf16*)(ws + WS_XB);
    for (int m = gw; m < M; m += NGW) {
        const float* src = m < MP ? a->in[I_XP] + (size_t)m * D : a->in[I_XS] + (size_t)(m - MP) * D;
        row_to_bf16(src, xb + (size_t)m * D, D, lane);
    }
    bf16* pb = (bf16*)(ws + WS_PB);
    for (int r = gw; r < 2 * M; r += NGW) {
        const int l = r / M, m = r % M;
        const float* src = m < MP ? a->in[I_PP] + ((size_t)l * MP + m) * PLE : a->in[I_PS] + ((size_t)l * MS + (m - MP)) * PLE;
        row_to_bf16(src, pb + (size_t)r * PLE, PLE, lane);
    }
}

__device__ __forceinline__ float conv_in(const bf16* proj, int row0, int tq, int ch, const float* cstate) {
    if (tq >= 0) return bf2f(proj[(size_t)(row0 + tq) * NPROJ_PAD + ch]);
    return cstate ? cstate[(3 + tq) * 4096 + ch] : 0.f;
}
__device__ __forceinline__ float conv4(const bf16* proj, int row0, int t, int ch, const float* cstate, const float* wconv, const float* bconv) {
    float acc = bconv[ch];
#pragma unroll
    for (int j = 0; j < 4; ++j) acc += wconv[j * 4096 + ch] * conv_in(proj, row0, t - 3 + j, ch, cstate);
    return acc;
}

__device__ __forceinline__ void delta_rec_item(ArgsP a, LAS unsigned char* lds, int row0, int T, int h, const float* cstate, const float* S0, float* Sout, const int tid) {
    const int lane = tid & 63, wave = tid >> 6, c = tid & 127, r = tid >> 7;
    const bf16* proj = (const bf16*)(a->ws + WS_PROJ); const float* gates = (const float*)(a->ws + WS_GATES); bf16* mix = (bf16*)(a->ws + WS_MIX);
    const float* wconv = a->in[I_WCONV]; const float* bconv = a->in[I_BCONV];
    LAS float* act = (LAS float*)lds;
    LAS float* nrm = act + 4 * 384;
    LAS float* gb = nrm + 8;
    LAS float* red = gb + 8;
    LAS float* red2 = red + 512;
    LAS float* obuf = red2 + 512;
    float s[32];
#pragma unroll
    for (int i = 0; i < 32; ++i) s[i] = S0 ? S0[(size_t)(32 * r + i) * 128 + c] : 0.f;
    const float aexp = expf(a->in[I_ALOG][h]), dtb = a->in[I_DTB][h];
#pragma unroll 1
    for (int t0 = 0; t0 < T; t0 += 4) {
#pragma unroll
        for (int j = 0; j < 3; ++j) { const int idx = tid + 512 * j, tok = idx / 384, chl = idx % 384, part = chl >> 7, i = chl & 127;
            const int ch = part * 1024 + h * 128 + i;
            act[tok * 384 + chl] = siluf(conv4(proj, row0, t0 + tok, ch, cstate, wconv, bconv)); }
        __syncthreads();
        { const int tok = wave >> 1, part = wave & 1; const float x0 = act[tok * 384 + part * 128 + lane], x1 = act[tok * 384 + part * 128 + 64 + lane];
          const float ss = wave_sum(x0 * x0 + x1 * x1); if (lane == 0) nrm[tok * 2 + part] = rsqrtf(ss + 1e-6f) * (part == 0 ? 0.08838834764831845f : 1.f); }
        if (tid < 4) { const int row = row0 + t0 + tid; const float g = -aexp * softplusf(gates[(size_t)row * 16 + h] + dtb); gb[tid * 2] = expf(g); gb[tid * 2 + 1] = sigm(gates[(size_t)row * 16 + 8 + h]); }
        __syncthreads();
#pragma unroll 1
        for (int tok = 0; tok < 4; ++tok) {
            const float eg = gb[tok * 2], beta = gb[tok * 2 + 1], nq = nrm[tok * 2], nk = nrm[tok * 2 + 1];
            const LAS float* qv = act + tok * 384 + 32 * r; const LAS float* kv = qv + 128;
            float ks = 0.f;
#pragma unroll
            for (int i = 0; i < 32; ++i) ks += kv[i] * s[i];
            red[r * 128 + c] = ks * nk;
            __syncthreads();
            const float kS = red[c] + red[128 + c] + red[256 + c] + red[384 + c];
            const float vnew = beta * (act[tok * 384 + 256 + c] - eg * kS);
            float os = 0.f;
#pragma unroll
            for (int i = 0; i < 32; ++i) { s[i] = eg * s[i] + (kv[i] * nk) * vnew; os += qv[i] * s[i]; }
            red2[r * 128 + c] = os * nq;
            __syncthreads();
            if (r == 0) obuf[tok * 128 + c] = red2[c] + red2[128 + c] + red2[256 + c] + red2[384 + c];
        }
        __syncthreads();
        if (wave < 4) { const int tok = wave, row = row0 + t0 + tok; const float o0 = obuf[tok * 128 + lane], o1 = obuf[tok * 128 + 64 + lane];
            const float rstd = rsqrtf(wave_sum(o0 * o0 + o1 * o1) * (1.f / 128.f) + RMS_EPS);
            const float* nw = a->in[I_DNORM];
            const float z0 = bf2f(proj[(size_t)row * NPROJ_PAD + 4096 + h * 128 + lane]), z1 = bf2f(proj[(size_t)row * NPROJ_PAD + 4096 + h * 128 + 64 + lane]);
            mix[(size_t)row * D + h * 128 + lane] = (bf16)f2bf(o0 * rstd * nw[lane] * siluf(z0));
            mix[(size_t)row * D + h * 128 + 64 + lane] = (bf16)f2bf(o1 * rstd * nw[64 + lane] * siluf(z1)); }
        __syncthreads();
    }
#pragma unroll
    for (int i = 0; i < 32; ++i) Sout[(size_t)(32 * r + i) * 128 + c] = s[i];
}

__device__ __forceinline__ void lru_rec_item(ArgsP a, LAS unsigned char* lds, int row0, int T, int n, const float* cstate, const float* h0, float* hout, const int tid) {
    const int d = tid & 127, part = tid >> 7;
    const bf16* proj = (const bf16*)(a->ws + WS_PROJ); bf16* mix = (bf16*)(a->ws + WS_MIX);
    const float* wconv = a->in[I_WCONV]; const float* bconv = a->in[I_BCONV];
    const float* wr = a->in[I_LWR] + (size_t)n * 16384; const float* wi = a->in[I_LWI] + (size_t)n * 16384;
    LAS float* xr = (LAS float*)lds;
    LAS float* red = xr + 512;
    const int chn = n * 128 + d;
    float hst = h0 ? h0[chn] : 0.f;
    const float br = a->in[I_LBR][chn], bi = a->in[I_LBI][chn], spl = softplusf(-a->in[I_LLAM][chn]);
#pragma unroll 1
    for (int t0 = 0; t0 < T; t0 += 4) {
        { const int tok = tid >> 7; xr[tok * 128 + d] = conv4(proj, row0, t0 + tok, 3072 + chn, cstate, wconv, bconv); }
        __syncthreads();
        float ar[4] = {0.f, 0.f, 0.f, 0.f}, ai[4] = {0.f, 0.f, 0.f, 0.f};
#pragma unroll 4
        for (int cc = 0; cc < 32; ++cc) { const int c = part * 32 + cc; const float w1 = wr[c * 128 + d], w2 = wi[c * 128 + d];
#pragma unroll
        for (int tok = 0; tok < 4; ++tok) { const float x = xr[tok * 128 + c]; ar[tok] += x * w1; ai[tok] += x * w2; } }
#pragma unroll
        for (int tok = 0; tok < 4; ++tok) { red[((tok * 2 + 0) * 4 + part) * 128 + d] = ar[tok]; red[((tok * 2 + 1) * 4 + part) * 128 + d] = ai[tok]; }
        __syncthreads();
        if (part == 0) {
    #pragma unroll 1
        for (int tok = 0; tok < 4; ++tok) {
                const int row = row0 + t0 + tok;
                float rp = br, ip = bi;
#pragma unroll
                for (int p = 0; p < 4; ++p) { rp += red[((tok * 2 + 0) * 4 + p) * 128 + d]; ip += red[((tok * 2 + 1) * 4 + p) * 128 + d]; }
                const float log_a = -8.f * sigm(rp) * spl;
                const float av = expf(log_a);
                const float bx = sqrtf(-expm1f(2.f * log_a)) * sigm(ip) * xr[tok * 128 + d];
                hst = av * hst + bx;
                const float gate = bf2f(proj[(size_t)row * NPROJ_PAD + 5120 + chn]);
                mix[(size_t)row * D + 1024 + chn] = (bf16)f2bf(hst * gelu_tanh(gate));
            }
        }
        __syncthreads();
    }
    if (part == 0) hout[chn] = hst;
}

__device__ __forceinline__ void mlstm_rec_item(ArgsP a, LAS unsigned char* lds, int row0, int T, int h, const float* C0, const float* n0, const float* m0, float* Cout, float* nout, float* mout, const int tid) {
    const int lane = tid & 63, wave = tid >> 6, v = tid & 255, kh = tid >> 8;
    const bf16* proj = (const bf16*)(a->ws + WS_PROJ); const float* gates = (const float*)(a->ws + WS_GATES); bf16* mix = (bf16*)(a->ws + WS_MIX);
    LAS float* qs = (LAS float*)lds;
    LAS float* ks = qs + 512;
    LAS float* vs = ks + 512;
    LAS float* gs = vs + 1024;
    LAS float* red = gs + 8;
    LAS float* dred = red + 1024;
    LAS float* hbuf = dred + 4;
    float cst[64];
#pragma unroll
    for (int i = 0; i < 64; ++i) cst[i] = C0 ? C0[(size_t)v * 128 + 64 * kh + i] : 0.f;
    float nst = (tid < 128) ? (n0 ? n0[tid] : 0.f) : 0.f;
    float mst = m0 ? m0[0] : 0.f;
    const float big = a->in[I_BIG][h], bfg = a->in[I_BFG][h];
#pragma unroll 1
    for (int t0 = 0; t0 < T; t0 += 4) {
#pragma unroll
        for (int j = 0; j < 4; ++j) { const int tok = j, row = row0 + t0 + tok; const bf16* pr = proj + (size_t)row * NPROJ_PAD;
            float val;
            if (tid < 128) val = bf2f(pr[h * 128 + tid]); else if (tid < 256) val = bf2f(pr[1024 + h * 128 + (tid - 128)]) * 0.08838834764831845f; else val = bf2f(pr[2048 + h * 256 + (tid - 256)]);
            if (tid < 128) qs[tok * 128 + tid] = val; else if (tid < 256) ks[tok * 128 + tid - 128] = val; else vs[tok * 256 + tid - 256] = val; }
        if (tid < 4) { const int row = row0 + t0 + tid; gs[tid * 2] = gates[(size_t)row * 16 + h] + big; gs[tid * 2 + 1] = gates[(size_t)row * 16 + 8 + h] + bfg; }
        __syncthreads();
#pragma unroll 1
        for (int tok = 0; tok < 4; ++tok) {
            const int par = tok & 1;
            const float ig = gs[tok * 2], lf = logsigf(gs[tok * 2 + 1]);
            const float mnew = fmaxf(lf + mst, ig), fp = expf(lf + mst - mnew), ip = expf(ig - mnew); mst = mnew;
            const float vv = vs[tok * 256 + v] * ip;
            const LAS float* kv = ks + tok * 128 + 64 * kh; const LAS float* qv = qs + tok * 128 + 64 * kh;
            float num = 0.f;
#pragma unroll
            for (int i = 0; i < 64; ++i) { cst[i] = fp * cst[i] + vv * kv[i]; num += cst[i] * qv[i]; }
            red[(par * 2 + kh) * 256 + v] = num;
            if (tid < 128) { nst = fp * nst + ip * ks[tok * 128 + tid]; const float dp = wave_sum(nst * qs[tok * 128 + tid]); if (lane == 0) dred[par * 2 + wave] = dp; }
            __syncthreads();
            if (kh == 0) { const float nm = red[(par * 2) * 256 + v] + red[(par * 2 + 1) * 256 + v]; const float den = dred[par * 2] + dred[par * 2 + 1];
                hbuf[tok * 256 + v] = nm / fmaxf(fabsf(den), expf(-mnew)); }
        }
        __syncthreads();
        if (wave < 4) { const int tok = wave, row = row0 + t0 + tok; float hv[4]; float ss = 0.f;
#pragma unroll
            for (int j = 0; j < 4; ++j) { hv[j] = hbuf[tok * 256 + j * 64 + lane]; ss += hv[j] * hv[j]; }
            const float rstd = rsqrtf(wave_sum(ss) * (1.f / 256.f) + RMS_EPS);
            const float* nw = a->in[I_MNORM] + h * 256;
#pragma unroll
            for (int j = 0; j < 4; ++j) { const int vi = j * 64 + lane; const float op = bf2f(proj[(size_t)row * NPROJ_PAD + 4096 + h * 256 + vi]);
                mix[(size_t)row * D + h * 256 + vi] = (bf16)f2bf(hv[j] * rstd * nw[vi] * sigm(op)); } }
        __syncthreads();
    }
#pragma unroll
    for (int i = 0; i < 64; ++i) Cout[(size_t)v * 128 + 64 * kh + i] = cst[i];
    if (tid < 128) nout[tid] = nst;
    if (tid == 0) mout[0] = mst;
}


typedef short bf16x8 __attribute__((ext_vector_type(8)));
#define MFMA32(a_, b_, c_) __builtin_amdgcn_mfma_f32_16x16x32_bf16(a_, b_, c_, 0, 0, 0)

__device__ __forceinline__ void lru_prep_item(ArgsP a, LAS unsigned char* lds, int item, const int tid) {
    const int c = item & 31, n = (item >> 5) & 7, b = item >> 8;
    const int lane = tid & 63, w = __builtin_amdgcn_readfirstlane(tid >> 6), fr = lane & 15, fq = lane >> 4;
    unsigned char* ws = a->ws;
    const bf16* proj = (const bf16*)(ws + WS_PROJ);
    LAS bf16* xa = (LAS bf16*)lds;
    LAS float* xf = (LAS float*)(lds + 17408);
    LAS float* obH = (LAS float*)(lds + 51200);
    LAS float* obP = obH + 64 * 132;
    {
        const int t = tid >> 3, sub = tid & 7, ch0 = 3072 + n * 128 + sub * 16;
        const float* wconv = a->in[I_WCONV]; const float* bconv = a->in[I_BCONV];
        float x[16];
#pragma unroll
        for (int i = 0; i < 4; ++i) { const f32x4 bb = *(const f32x4*)(bconv + ch0 + 4 * i); x[4 * i] = bb.x; x[4 * i + 1] = bb.y; x[4 * i + 2] = bb.z; x[4 * i + 3] = bb.w; }
#pragma unroll
        for (int j = 0; j < 4; ++j) { const int tt = 64 * c + t - 3 + j;
            if (tt >= 0) { const bf16* pr = proj + (size_t)(b * TP + tt) * NPROJ_PAD + ch0; const v4u u0 = *(const v4u*)pr, u1 = *(const v4u*)(pr + 8);
                const unsigned uu[8] = {u0.x, u0.y, u0.z, u0.w, u1.x, u1.y, u1.z, u1.w};
#pragma unroll
                for (int i = 0; i < 4; ++i) { const f32x4 ww = *(const f32x4*)(wconv + j * 4096 + ch0 + 4 * i);
                    x[4 * i] += ww.x * bflo(uu[2 * i]); x[4 * i + 1] += ww.y * bfhi(uu[2 * i]); x[4 * i + 2] += ww.z * bflo(uu[2 * i + 1]); x[4 * i + 3] += ww.w * bfhi(uu[2 * i + 1]); } } }
        v4u o0, o1; o0.x = pk2(x[0], x[1]); o0.y = pk2(x[2], x[3]); o0.z = pk2(x[4], x[5]); o0.w = pk2(x[6], x[7]); o1.x = pk2(x[8], x[9]); o1.y = pk2(x[10], x[11]); o1.z = pk2(x[12], x[13]); o1.w = pk2(x[14], x[15]);
        *(LAS v4u*)(xa + t * 136 + sub * 16) = o0; *(LAS v4u*)(xa + t * 136 + sub * 16 + 8) = o1;
#pragma unroll
        for (int i = 0; i < 4; ++i) *(LAS f32x4*)(xf + t * 132 + sub * 16 + 4 * i) = (f32x4){x[4 * i], x[4 * i + 1], x[4 * i + 2], x[4 * i + 3]};
    }
    __syncthreads();
    const bf16* wrT = (const bf16*)(ws + WS_LRUW) + (size_t)n * 16384; const bf16* wiT = wrT + 8 * 16384;
    bf16x8 br[4], bi[4];
#pragma unroll
    for (int ks = 0; ks < 4; ++ks) { br[ks] = *(const bf16x8*)(wrT + (16 * w + fr) * 128 + 32 * ks + 8 * fq); bi[ks] = *(const bf16x8*)(wiT + (16 * w + fr) * 128 + 32 * ks + 8 * fq); }
    f32x4 accr[4], acci[4];
#pragma unroll
    for (int tb = 0; tb < 4; ++tb) { accr[tb] = (f32x4){0.f, 0.f, 0.f, 0.f}; acci[tb] = (f32x4){0.f, 0.f, 0.f, 0.f};
#pragma unroll
        for (int ks = 0; ks < 4; ++ks) { const bf16x8 af = *(const LAS bf16x8*)(xa + (16 * tb + fr) * 136 + 32 * ks + 8 * fq); accr[tb] = MFMA32(af, br[ks], accr[tb]); acci[tb] = MFMA32(af, bi[ks], acci[tb]); } }
    const int dl = 16 * w + fr, chn = n * 128 + dl;
    const float brs = a->in[I_LBR][chn], bis = a->in[I_LBI][chn], spl = softplusf(-a->in[I_LLAM][chn]);
    float Apre = 1.f, Hpre = 0.f;
#pragma unroll
    for (int tb = 0; tb < 4; ++tb) {
        float P[4], Hh[4];
#pragma unroll
        for (int j = 0; j < 4; ++j) { const int t = 16 * tb + 4 * fq + j;
            const float log_a = -8.f * sigm(accr[tb][j] + brs) * spl; const float av = expf(log_a);
            const float bx = sqrtf(-expm1f(2.f * log_a)) * sigm(acci[tb][j] + bis) * xf[t * 132 + dl];
            if (j == 0) { P[0] = av; Hh[0] = bx; } else { P[j] = P[j - 1] * av; Hh[j] = av * Hh[j - 1] + bx; } }
        float Ai = P[3], Hi = Hh[3];
        { const float A2 = __shfl_up(Ai, 16), H2 = __shfl_up(Hi, 16); if (fq >= 1) { Hi = Ai * H2 + Hi; Ai = A2 * Ai; } }
        { const float A2 = __shfl_up(Ai, 32), H2 = __shfl_up(Hi, 32); if (fq >= 2) { Hi = Ai * H2 + Hi; Ai = A2 * Ai; } }
        float Aex = __shfl_up(Ai, 16), Hex = __shfl_up(Hi, 16); if (fq == 0) { Aex = 1.f; Hex = 0.f; }
        const float Atb = __shfl(Ai, 48 + fr), Htb = __shfl(Hi, 48 + fr);
        const float EA = Apre * Aex, EH = Aex * Hpre + Hex;
#pragma unroll
        for (int j = 0; j < 4; ++j) { const int t = 16 * tb + 4 * fq + j; obP[t * 132 + dl] = EA * P[j]; obH[t * 132 + dl] = P[j] * EH + Hh[j]; }
        Hpre = Atb * Hpre + Htb; Apre = Apre * Atb;
    }
    if (fq == 0) { float* e = (float*)(ws + WS_LRU_END) + (size_t)item * 256; e[dl] = Apre; e[128 + dl] = Hpre; }
    __syncthreads();
    {
        const int t = tid >> 3, sub = tid & 7;
        bf16* hl = (bf16*)(ws + WS_LRU_HL) + ((size_t)item * 64 + t) * 128 + sub * 16; bf16* pp = (bf16*)(ws + WS_LRU_P) + ((size_t)item * 64 + t) * 128 + sub * 16;
        const LAS float* sh = obH + t * 132 + sub * 16; const LAS float* sp = obP + t * 132 + sub * 16;
        v4u o0, o1;
        o0.x = pk2(sh[0], sh[1]); o0.y = pk2(sh[2], sh[3]); o0.z = pk2(sh[4], sh[5]); o0.w = pk2(sh[6], sh[7]); o1.x = pk2(sh[8], sh[9]); o1.y = pk2(sh[10], sh[11]); o1.z = pk2(sh[12], sh[13]); o1.w = pk2(sh[14], sh[15]);
        *(v4u*)hl = o0; *(v4u*)(hl + 8) = o1;
        o0.x = pk2(sp[0], sp[1]); o0.y = pk2(sp[2], sp[3]); o0.z = pk2(sp[4], sp[5]); o0.w = pk2(sp[6], sp[7]); o1.x = pk2(sp[8], sp[9]); o1.y = pk2(sp[10], sp[11]); o1.z = pk2(sp[12], sp[13]); o1.w = pk2(sp[14], sp[15]);
        *(v4u*)pp = o0; *(v4u*)(pp + 8) = o1;
    }
    __syncthreads();
}
__device__ __forceinline__ void lru_out_item(ArgsP a, LAS unsigned char* lds, int item, const int tid) {
    const int c = item & 31, n = (item >> 5) & 7, b = item >> 8;
    unsigned char* ws = a->ws;
    LAS float* carry = (LAS float*)lds;
    if (tid < 128) { float cr = 0.f; const float* e = (const float*)(ws + WS_LRU_END) + (size_t)(item - c) * 256;
        for (int k = 0; k < c; ++k) cr = e[k * 256 + 128 + tid] + e[k * 256 + tid] * cr;
        carry[tid] = cr; }
    __syncthreads();
    const int t = tid >> 3, sub = tid & 7, d0 = sub * 16, row = b * TP + 64 * c + t;
    const bf16* hl = (const bf16*)(ws + WS_LRU_HL) + ((size_t)item * 64 + t) * 128 + d0; const bf16* pp = (const bf16*)(ws + WS_LRU_P) + ((size_t)item * 64 + t) * 128 + d0;
    const bf16* gp = (const bf16*)(ws + WS_PROJ) + (size_t)row * NPROJ_PAD + 5120 + n * 128 + d0;
    const v4u h0 = *(const v4u*)hl, h1 = *(const v4u*)(hl + 8), p0 = *(const v4u*)pp, p1 = *(const v4u*)(pp + 8), g0 = *(const v4u*)gp, g1 = *(const v4u*)(gp + 8);
    const unsigned hu[8] = {h0.x, h0.y, h0.z, h0.w, h1.x, h1.y, h1.z, h1.w}, pu[8] = {p0.x, p0.y, p0.z, p0.w, p1.x, p1.y, p1.z, p1.w}, gu[8] = {g0.x, g0.y, g0.z, g0.w, g1.x, g1.y, g1.z, g1.w};
    float hv[16]; unsigned ou[8];
#pragma unroll
    for (int i = 0; i < 8; ++i) { hv[2 * i] = bflo(hu[i]) + bflo(pu[i]) * carry[d0 + 2 * i]; hv[2 * i + 1] = bfhi(hu[i]) + bfhi(pu[i]) * carry[d0 + 2 * i + 1];
        ou[i] = pk2(hv[2 * i] * gelu_tanh(bflo(gu[i])), hv[2 * i + 1] * gelu_tanh(bfhi(gu[i]))); }
    bf16* mp = (bf16*)(ws + WS_MIX) + (size_t)row * D + 1024 + n * 128 + d0;
    *(v4u*)mp = (v4u){ou[0], ou[1], ou[2], ou[3]}; *(v4u*)(mp + 8) = (v4u){ou[4], ou[5], ou[6], ou[7]};
    if (c == 31 && t == 63) { float* o = a->out + O_LRUP + (size_t)b * 1024 + n * 128 + d0;
#pragma unroll
        for (int i = 0; i < 4; ++i) *(f32x4*)(o + 4 * i) = (f32x4){hv[4 * i], hv[4 * i + 1], hv[4 * i + 2], hv[4 * i + 3]}; }
    __syncthreads();
}


__device__ __forceinline__ void conv16_prompt(const bf16* proj, const float* wconv, const float* bconv, int b, int tseq, int ch0, float (&x)[16]) {
#pragma unroll
    for (int i = 0; i < 4; ++i) { const f32x4 bb = *(const f32x4*)(bconv + ch0 + 4 * i); x[4 * i] = bb.x; x[4 * i + 1] = bb.y; x[4 * i + 2] = bb.z; x[4 * i + 3] = bb.w; }
#pragma unroll
    for (int j = 0; j < 4; ++j) { const int tt = tseq - 3 + j;
        if (tt >= 0) { const bf16* pr = proj + (size_t)(b * TP + tt) * NPROJ_PAD + ch0; const v4u u0 = *(const v4u*)pr, u1 = *(const v4u*)(pr + 8);
            const unsigned uu[8] = {u0.x, u0.y, u0.z, u0.w, u1.x, u1.y, u1.z, u1.w};
#pragma unroll
            for (int i = 0; i < 4; ++i) { const f32x4 ww = *(const f32x4*)(wconv + j * 4096 + ch0 + 4 * i);
                x[4 * i] += ww.x * bflo(uu[2 * i]); x[4 * i + 1] += ww.y * bfhi(uu[2 * i]); x[4 * i + 2] += ww.z * bflo(uu[2 * i + 1]); x[4 * i + 3] += ww.w * bfhi(uu[2 * i + 1]); } } }
}
__device__ __forceinline__ void st16_bf16(LAS bf16* p, const float (&x)[16]) {
    v4u o0, o1; o0.x = pk2(x[0], x[1]); o0.y = pk2(x[2], x[3]); o0.z = pk2(x[4], x[5]); o0.w = pk2(x[6], x[7]); o1.x = pk2(x[8], x[9]); o1.y = pk2(x[10], x[11]); o1.z = pk2(x[12], x[13]); o1.w = pk2(x[14], x[15]);
    *(LAS v4u*)p = o0; *(LAS v4u*)(p + 8) = o1;
}
__device__ __forceinline__ v2u pack4(const f32x4 v) { v2u o; o.x = pk2(v.x, v.y); o.y = pk2(v.z, v.w); return o; }
__device__ __forceinline__ bf16x8 zero8() { return (bf16x8){0, 0, 0, 0, 0, 0, 0, 0}; }

__device__ __forceinline__ void delta_prep_item(ArgsP a, LAS unsigned char* lds, int item, const int tid) {
    const int c = item & 31, h = (item >> 5) & 7, b = item >> 8;
    const int lane = tid & 63, w = __builtin_amdgcn_readfirstlane(tid >> 6), fr = lane & 15, fq = lane >> 4;
    unsigned char* ws = a->ws;
    const bf16* proj = (const bf16*)(ws + WS_PROJ);
    LAS bf16* Kn = (LAS bf16*)lds;
    LAS bf16* Qn = (LAS bf16*)(lds + 17408);
    LAS bf16* KdT = (LAS bf16*)(lds + 34816);
    LAS bf16* RX = (LAS bf16*)(lds + 53248);
    LAS bf16* Mm = (LAS bf16*)(lds + 90112);
    LAS bf16* QKd = (LAS bf16*)(lds + 99328);
    LAS bf16* Td = (LAS bf16*)(lds + 108544);
    LAS bf16* RT = (LAS bf16*)(lds + 111616) + w * 768;
    LAS float* gl = (LAS float*)(lds + 123904);
    LAS float* gcs = gl + 64;
    LAS float* bet = gcs + 64;
    const int t = tid >> 3, sub = tid & 7;
    {
        if (sub == 0) { const float* gt = (const float*)(ws + WS_GATES) + (size_t)(b * TP + 64 * c + t) * 16;
            gl[t] = -expf(a->in[I_ALOG][h]) * softplusf(gt[h] + a->in[I_DTB][h]); bet[t] = sigm(gt[8 + h]); }
        __syncthreads();
        if (w == 0) { float v = gl[lane];
#pragma unroll
            for (int o = 1; o < 64; o <<= 1) { const float u = __shfl_up(v, o); if (lane >= o) v += u; }
            gcs[lane] = v; }
        __syncthreads();
    }
    {
        const float* wconv = a->in[I_WCONV]; const float* bconv = a->in[I_BCONV];
        const float gc = gcs[t], glast = gcs[63], beta = bet[t];
        const float ec = expf(gc), ed = expf(glast - gc);
        float x[16], y[16];
        conv16_prompt(proj, wconv, bconv, b, 64 * c + t, 1024 + h * 128 + sub * 16, x);
        float ss = 0.f;
#pragma unroll
        for (int i = 0; i < 16; ++i) { x[i] = siluf(x[i]); ss += x[i] * x[i]; }
        ss += __shfl_xor(ss, 1); ss += __shfl_xor(ss, 2); ss += __shfl_xor(ss, 4);
        const float rk = rsqrtf(ss + 1e-6f);
#pragma unroll
        for (int i = 0; i < 16; ++i) x[i] *= rk;
        st16_bf16(Kn + t * 136 + sub * 16, x);
#pragma unroll
        for (int i = 0; i < 16; ++i) KdT[(sub * 16 + i) * 72 + t] = (bf16)f2bf(x[i] * ed);
#pragma unroll
        for (int i = 0; i < 16; ++i) y[i] = x[i] * (beta * ec);
        st16_bf16(RX + t * 264 + 128 + sub * 16, y);
        conv16_prompt(proj, wconv, bconv, b, 64 * c + t, h * 128 + sub * 16, x);
        ss = 0.f;
#pragma unroll
        for (int i = 0; i < 16; ++i) { x[i] = siluf(x[i]); ss += x[i] * x[i]; }
        ss += __shfl_xor(ss, 1); ss += __shfl_xor(ss, 2); ss += __shfl_xor(ss, 4);
        const float rq = rsqrtf(ss + 1e-6f) * 0.08838834764831845f;
#pragma unroll
        for (int i = 0; i < 16; ++i) x[i] *= rq;
        st16_bf16(Qn + t * 136 + sub * 16, x);
        conv16_prompt(proj, wconv, bconv, b, 64 * c + t, 2048 + h * 128 + sub * 16, x);
#pragma unroll
        for (int i = 0; i < 16; ++i) x[i] = siluf(x[i]) * beta;
        st16_bf16(RX + t * 264 + sub * 16, x);
    }
    __syncthreads();
    {
        const int ib = w >> 1;
#pragma unroll
        for (int jj = 0; jj < 2; ++jj) { const int jb = 2 * (w & 1) + jj;
            f32x4 ak = (f32x4){0.f, 0.f, 0.f, 0.f}, aq = (f32x4){0.f, 0.f, 0.f, 0.f};
            if (jb <= ib) {
#pragma unroll
                for (int ks = 0; ks < 4; ++ks) { const bf16x8 bfr = *(const LAS bf16x8*)(Kn + (16 * jb + fr) * 136 + 32 * ks + 8 * fq);
                    const bf16x8 afk = *(const LAS bf16x8*)(Kn + (16 * ib + fr) * 136 + 32 * ks + 8 * fq), afq = *(const LAS bf16x8*)(Qn + (16 * ib + fr) * 136 + 32 * ks + 8 * fq);
                    ak = MFMA32(afk, bfr, ak); aq = MFMA32(afq, bfr, aq); } }
            const int col = 16 * jb + fr; const float gcc = gcs[col];
#pragma unroll
            for (int j = 0; j < 4; ++j) { const int row = 16 * ib + 4 * fq + j; const float dec = (row >= col) ? expf(gcs[row] - gcc) : 0.f;
                Mm[row * 72 + col] = (bf16)f2bf(row > col ? -bet[row] * ak[j] * dec : 0.f);
                QKd[row * 72 + col] = (bf16)f2bf(aq[j] * dec); }
        }
    }
    __syncthreads();
    if (w == 0) { const int blk = lane >> 4, col = lane & 15; float xi[16];
#pragma unroll
        for (int i = 0; i < 16; ++i) { float acc = (i == col) ? 1.f : 0.f; const LAS bf16* mr = Mm + (16 * blk + i) * 72 + 16 * blk;
#pragma unroll
            for (int j = 0; j < i; ++j) acc += bf2f(mr[j]) * xi[j];
            xi[i] = acc; }
#pragma unroll
        for (int i = 0; i < 16; ++i) Td[(blk * 16 + i) * 24 + col] = (bf16)f2bf(xi[i]); }
    f32x4 rhs[2][4];
#pragma unroll
    for (int cbl = 0; cbl < 2; ++cbl)
#pragma unroll
        for (int bb = 0; bb < 4; ++bb)
#pragma unroll
            for (int j = 0; j < 4; ++j) rhs[cbl][bb][j] = bf2f(RX[(16 * bb + 4 * fq + j) * 264 + 32 * w + 16 * cbl + fr]);
    __syncthreads();
#pragma unroll
    for (int cbl = 0; cbl < 2; ++cbl) { const int cb = 2 * w + cbl;
#pragma unroll
        for (int bb = 0; bb < 4; ++bb) {
            f32x4 acc = rhs[cbl][bb];
#pragma unroll
            for (int ks = 0; ks < 2; ++ks) { if (32 * ks < 16 * bb) { const bool ok = (32 * ks + 8 * fq) < 16 * bb;
                const bf16x8 af = ok ? *(const LAS bf16x8*)(Mm + (16 * bb + fr) * 72 + 32 * ks + 8 * fq) : zero8();
                const bf16x8 bf_ = ok ? *(const LAS bf16x8*)(RX + (16 * cb + fr) * 72 + 32 * ks + 8 * fq) : zero8();
                acc = MFMA32(af, bf_, acc); } }
            *(LAS v2u*)(RT + (16 * cbl + fr) * 24 + 4 * fq) = pack4(acc);
            asm volatile("s_waitcnt lgkmcnt(0)" ::: "memory");
            const bool ok2 = fq < 2;
            const bf16x8 af2 = ok2 ? *(const LAS bf16x8*)(Td + (bb * 16 + fr) * 24 + 8 * fq) : zero8();
            const bf16x8 bf2 = ok2 ? *(const LAS bf16x8*)(RT + (16 * cbl + fr) * 24 + 8 * fq) : zero8();
            const f32x4 xb4 = MFMA32(af2, bf2, ((f32x4){0.f, 0.f, 0.f, 0.f}));
            *(LAS v2u*)(RX + (16 * cb + fr) * 72 + 16 * bb + 4 * fq) = pack4(xb4);
            asm volatile("s_waitcnt lgkmcnt(0)" ::: "memory");
        }
    }
    __syncthreads();
    {
        v4u* gout = (v4u*)(ws + WS_DG) + ((size_t)item * 8 + w) * 4 * 64 + lane;
        bf16x8 kb[2];
#pragma unroll
        for (int kt = 0; kt < 2; ++kt) kb[kt] = *(const LAS bf16x8*)(KdT + (16 * w + fr) * 72 + 32 * kt + 8 * fq);
#pragma unroll
        for (int ks = 0; ks < 4; ++ks) { f32x4 g0 = (f32x4){0.f, 0.f, 0.f, 0.f}, g1 = (f32x4){0.f, 0.f, 0.f, 0.f};
#pragma unroll
            for (int kt = 0; kt < 2; ++kt) { const bf16x8 a0 = *(const LAS bf16x8*)(RX + (128 + 32 * ks + fr) * 72 + 32 * kt + 8 * fq), a1 = *(const LAS bf16x8*)(RX + (128 + 32 * ks + 16 + fr) * 72 + 32 * kt + 8 * fq);
                g0 = MFMA32(a0, kb[kt], g0); g1 = MFMA32(a1, kb[kt], g1); }
            const v2u p0 = pack4(-g0), p1 = pack4(-g1); gout[ks * 64] = (v4u){p0.x, p0.y, p1.x, p1.y}; }
        v2u* bout = (v2u*)(ws + WS_DB) + ((size_t)item * 64 + w) * 64 + lane;
#pragma unroll
        for (int s2 = 0; s2 < 8; ++s2) { f32x4 bc = (f32x4){0.f, 0.f, 0.f, 0.f};
#pragma unroll
            for (int kt = 0; kt < 2; ++kt) { const bf16x8 ub = *(const LAS bf16x8*)(RX + (16 * s2 + fr) * 72 + 32 * kt + 8 * fq); bc = MFMA32(kb[kt], ub, bc); }
            bout[(size_t)s2 * 8 * 64] = pack4(bc); }
    }
    {
        const int tb = w >> 1, half = w & 1; const float ect = expf(gcs[16 * tb + fr]);
        bf16x8 qk[2];
#pragma unroll
        for (int kt = 0; kt < 2; ++kt) qk[kt] = *(const LAS bf16x8*)(QKd + (16 * tb + fr) * 72 + 32 * kt + 8 * fq);
        v4u* qout = (v4u*)(ws + WS_DQ) + ((size_t)item * 4 + tb) * 4 * 64 + lane;
#pragma unroll
        for (int kk = 0; kk < 2; ++kk) { const int ks = 2 * half + kk; v2u pk[2];
#pragma unroll
            for (int hf = 0; hf < 2; ++hf) { const int db = 2 * ks + hf; f32x4 acc = (f32x4){0.f, 0.f, 0.f, 0.f};
#pragma unroll
                for (int kt = 0; kt < 2; ++kt) { const bf16x8 wa = *(const LAS bf16x8*)(RX + (128 + 16 * db + fr) * 72 + 32 * kt + 8 * fq); acc = MFMA32(wa, qk[kt], acc); }
                const v2u qn4 = *(const LAS v2u*)(Qn + (16 * tb + fr) * 136 + 16 * db + 4 * fq);
                f32x4 qp; qp.x = bflo(qn4.x) * ect - acc.x; qp.y = bfhi(qn4.x) * ect - acc.y; qp.z = bflo(qn4.y) * ect - acc.z; qp.w = bfhi(qn4.y) * ect - acc.w;
                pk[hf] = pack4(qp); }
            qout[ks * 64] = (v4u){pk[0].x, pk[0].y, pk[1].x, pk[1].y}; }
        v2u* oout = (v2u*)(ws + WS_DO) + ((size_t)item * 4 + tb) * 8 * 64 + lane;
#pragma unroll
        for (int ss = 0; ss < 4; ++ss) { const int s2 = 4 * half + ss; f32x4 acc = (f32x4){0.f, 0.f, 0.f, 0.f};
#pragma unroll
            for (int kt = 0; kt < 2; ++kt) { const bf16x8 ua = *(const LAS bf16x8*)(RX + (16 * s2 + fr) * 72 + 32 * kt + 8 * fq); acc = MFMA32(ua, qk[kt], acc); }
            oout[s2 * 64] = pack4(acc); }
    }
    if (tid == 0) ((float*)(ws + WS_DD))[item] = expf(gcs[63]);
    __syncthreads();
}

__device__ __forceinline__ void delta_scan_wave(ArgsP a, int chain, int s, const int lane) {
    unsigned char* ws = a->ws;
    const int fr = lane & 15, fq = lane >> 4;
    f32x4 S[8]; bf16x8 Sb[4];
#pragma unroll
    for (int i = 0; i < 8; ++i) S[i] = (f32x4){0.f, 0.f, 0.f, 0.f};
#pragma unroll
    for (int i = 0; i < 4; ++i) Sb[i] = zero8();
    const bf16x8* gbase = (const bf16x8*)(ws + WS_DG) + (size_t)chain * 32 * 2048 + lane;
    bf16x8 G[8][4];
#pragma unroll
    for (int rb = 0; rb < 8; ++rb)
#pragma unroll
        for (int ks = 0; ks < 4; ++ks) G[rb][ks] = gbase[(rb * 4 + ks) * 64];
#pragma unroll 1
    for (int c = 0; c < 32; ++c) {
        const int item = chain * 32 + c;
        const float d = ((const float*)(ws + WS_DD))[item];
        bf16x8* sout = (bf16x8*)(ws + WS_DS) + ((size_t)item * 8 + s) * 4 * 64 + lane;
#pragma unroll
        for (int ks = 0; ks < 4; ++ks) sout[ks * 64] = Sb[ks];
        const v2u* bin = (const v2u*)(ws + WS_DB) + ((size_t)item * 8 + s) * 8 * 64 + lane;
#pragma unroll
        for (int rb = 0; rb < 8; ++rb) { const v2u bc = bin[rb * 64]; S[rb].x = d * S[rb].x + bflo(bc.x); S[rb].y = d * S[rb].y + bfhi(bc.x); S[rb].z = d * S[rb].z + bflo(bc.y); S[rb].w = d * S[rb].w + bfhi(bc.y); }
        const bf16x8* gnext = gbase + (size_t)(c + 1 < 32 ? c + 1 : c) * 2048;
#pragma unroll
        for (int rb = 0; rb < 8; ++rb) {
#pragma unroll
            for (int ks = 0; ks < 4; ++ks) S[rb] = MFMA32(G[rb][ks], Sb[ks], S[rb]);
#pragma unroll
            for (int ks = 0; ks < 4; ++ks) G[rb][ks] = gnext[(rb * 4 + ks) * 64];
        }
#pragma unroll
        for (int ks = 0; ks < 4; ++ks) { const v2u lo = pack4(S[2 * ks]), hi = pack4(S[2 * ks + 1]); const v4u u = (v4u){lo.x, lo.y, hi.x, hi.y}; Sb[ks] = __builtin_bit_cast(bf16x8, u); }
    }
    f32x4* so = (f32x4*)(ws + WS_DF) + ((size_t)(chain * 8 + s) * 8) * 64 + lane;
#pragma unroll
    for (int rb = 0; rb < 8; ++rb) so[rb * 64] = S[rb];
}

__device__ __forceinline__ void delta_out_wave(ArgsP a, int item, int tb, const int lane) {
    unsigned char* ws = a->ws;
    const int c = item & 31, h = (item >> 5) & 7, b = item >> 8, fr = lane & 15, fq = lane >> 4;
    bf16x8 qf[4];
    const bf16x8* qin = (const bf16x8*)(ws + WS_DQ) + ((size_t)item * 4 + tb) * 4 * 64 + lane;
#pragma unroll
    for (int ks = 0; ks < 4; ++ks) qf[ks] = qin[ks * 64];
    const v2u* oin = (const v2u*)(ws + WS_DO) + ((size_t)item * 4 + tb) * 8 * 64 + lane;
    const bf16x8* sin = (const bf16x8*)(ws + WS_DS) + (size_t)item * 8 * 4 * 64 + lane;
    f32x4 o[8]; float ss = 0.f;
#pragma unroll
    for (int s = 0; s < 8; ++s) { const v2u ol = oin[s * 64]; o[s] = (f32x4){bflo(ol.x), bfhi(ol.x), bflo(ol.y), bfhi(ol.y)};
#pragma unroll
        for (int ks = 0; ks < 4; ++ks) o[s] = MFMA32(sin[(s * 4 + ks) * 64], qf[ks], o[s]);
        ss += (o[s].x * o[s].x + o[s].y * o[s].y) + (o[s].z * o[s].z + o[s].w * o[s].w); }
    ss += __shfl_xor(ss, 16); ss += __shfl_xor(ss, 32);
    const float rstd = rsqrtf(ss * (1.f / 128.f) + RMS_EPS);
    const int row = b * TP + 64 * c + 16 * tb + fr;
    const bf16* zp = (const bf16*)(ws + WS_PROJ) + (size_t)row * NPROJ_PAD + 4096 + h * 128 + 4 * fq;
    bf16* mp = (bf16*)(ws + WS_MIX) + (size_t)row * D + h * 128 + 4 * fq;
    const float* nw = a->in[I_DNORM] + 4 * fq;
#pragma unroll
    for (int s = 0; s < 8; ++s) { const v2u z = *(const v2u*)(zp + 16 * s); const f32x4 n4 = *(const f32x4*)(nw + 16 * s);
        f32x4 y; y.x = o[s].x * rstd * n4.x * siluf(bflo(z.x)); y.y = o[s].y * rstd * n4.y * siluf(bfhi(z.x)); y.z = o[s].z * rstd * n4.z * siluf(bflo(z.y)); y.w = o[s].w * rstd * n4.w * siluf(bfhi(z.y));
        *(v2u*)(mp + 16 * s) = pack4(y); }
}


__device__ __forceinline__ float wave_incl_sum(float v, int lane) {
#pragma unroll
    for (int o = 1; o < 64; o <<= 1) { const float u = __shfl_up(v, o); if (lane >= o) v += u; }
    return v;
}
__device__ __forceinline__ float wave_incl_max(float v, int lane) {
#pragma unroll
    for (int o = 1; o < 64; o <<= 1) { const float u = __shfl_up(v, o); if (lane >= o) v = fmaxf(v, u); }
    return v;
}
__device__ __forceinline__ float wave_max(float v) {
#pragma unroll
    for (int o = 1; o < 64; o <<= 1) v = fmaxf(v, __shfl_xor(v, o));
    return v;
}
__device__ __forceinline__ void mlstm_scan_item(ArgsP a, LAS unsigned char* lds, int chain, int vs, const int tid) {
    const int lane = tid & 63, w = __builtin_amdgcn_readfirstlane(tid >> 6), fr = lane & 15, fq = lane >> 4;
    const int b = chain >> 3, h = chain & 7, row0 = b * TP;
    unsigned char* ws = a->ws;
    const bf16* proj = (const bf16*)(ws + WS_PROJ); const float* gates = (const float*)(ws + WS_GATES);
    LAS bf16* KT = (LAS bf16*)lds;
    LAS bf16* VT = (LAS bf16*)(lds + 36864);
    LAS float* wls = (LAS float*)(lds + 46080);
    const float big = a->in[I_BIG][h], bfg = a->in[I_BFG][h];
    const bf16* kptr = proj + (size_t)(row0 + lane) * NPROJ_PAD + 1024 + h * 128 + 16 * w;
    const bf16* vptr = proj + (size_t)(row0 + lane) * NPROJ_PAD + 2048 + h * 256 + 32 * vs + 8 * (w & 3);
    const float* gptr = gates + (size_t)(row0 + lane) * 16 + h;
    f32x4 acc[2]; acc[0] = (f32x4){0.f, 0.f, 0.f, 0.f}; acc[1] = acc[0];
    float nst = 0.f, m = 0.f;
    v4u kq[2][2], vq[2]; float gi[2], gf[2];
#define ML_LOAD(set, c_) do { const size_t ro = (size_t)(c_) * 64 * NPROJ_PAD; kq[set][0] = *(const v4u*)(kptr + ro); kq[set][1] = *(const v4u*)(kptr + ro + 8); \
        if (w < 4) vq[set] = *(const v4u*)(vptr + ro); gi[set] = gptr[(size_t)(c_) * 64 * 16]; gf[set] = gptr[(size_t)(c_) * 64 * 16 + 8]; } while (0)
#define ML_STEP(set, c_) do { const int item = chain * 32 + (c_); \
        const float ig = gi[set] + big, lf = logsigf(gf[set] + bfg); \
        const float bcum = wave_incl_sum(lf, lane), blast = __shfl(bcum, 63), gend = blast - bcum + ig; \
        const float mnew = fmaxf(blast + m, wave_max(gend)), sc = expf(blast + m - mnew), wv = expf(gend - mnew) * 0.08838834764831845f; \
        LAS bf16* kt = KT + (set) * 9216; LAS bf16* vt = VT + (set) * 2304; \
        _Pragma("unroll") for (int i = 0; i < 2; ++i) { const unsigned uu[4] = {kq[set][i].x, kq[set][i].y, kq[set][i].z, kq[set][i].w}; const int kr = 8 * (2 * w + i); \
            _Pragma("unroll") for (int e = 0; e < 4; ++e) { kt[(kr + 2 * e) * 72 + lane] = (bf16)(uu[e] & 0xffffu); kt[(kr + 2 * e + 1) * 72 + lane] = (bf16)(uu[e] >> 16); } } \
        if (w < 4) { const unsigned uu[4] = {vq[set].x, vq[set].y, vq[set].z, vq[set].w}; \
            _Pragma("unroll") for (int e = 0; e < 4; ++e) { vt[(8 * w + 2 * e) * 72 + lane] = (bf16)f2bf(bflo(uu[e]) * wv); vt[(8 * w + 2 * e + 1) * 72 + lane] = (bf16)f2bf(bfhi(uu[e]) * wv); } } \
        if (w == 0) wls[(set) * 64 + lane] = wv; \
        if ((c_) + 2 < 32) ML_LOAD(set, (c_) + 2); \
        if (vs == 0 && tid == 0) ((float*)(ws + WS_MM))[item] = m; \
        __syncthreads(); \
        _Pragma("unroll") for (int vb = 0; vb < 2; ++vb) { *(v2u*)((bf16*)(ws + WS_MC) + ((size_t)item * 256 + 32 * vs + 16 * vb + fr) * 128 + 16 * w + 4 * fq) = pack4(acc[vb]); } \
        if (vs == 0 && tid < 128) { ((float*)(ws + WS_MN))[(size_t)item * 128 + tid] = nst; float sn = 0.f; \
            _Pragma("unroll") for (int s8 = 0; s8 < 8; ++s8) { const v4u kk = *(const LAS v4u*)(kt + tid * 72 + 8 * s8); const LAS float* wl = wls + (set) * 64 + 8 * s8; \
                sn += bflo(kk.x) * wl[0] + bfhi(kk.x) * wl[1] + bflo(kk.y) * wl[2] + bfhi(kk.y) * wl[3] + bflo(kk.z) * wl[4] + bfhi(kk.z) * wl[5] + bflo(kk.w) * wl[6] + bfhi(kk.w) * wl[7]; } \
            nst = sc * nst + sn; } \
        _Pragma("unroll") for (int vb = 0; vb < 2; ++vb) { acc[vb] = acc[vb] * sc; \
            _Pragma("unroll") for (int kt2 = 0; kt2 < 2; ++kt2) { const bf16x8 af = *(const LAS bf16x8*)(kt + (16 * w + fr) * 72 + 32 * kt2 + 8 * fq), bfv = *(const LAS bf16x8*)(vt + (16 * vb + fr) * 72 + 32 * kt2 + 8 * fq); \
                acc[vb] = MFMA32(af, bfv, acc[vb]); } } \
        m = mnew; } while (0)
    ML_LOAD(0, 0); ML_LOAD(1, 1);
#pragma unroll 1
    for (int c2 = 0; c2 < 32; c2 += 2) { ML_STEP(0, c2); ML_STEP(1, c2 + 1); }
#undef ML_LOAD
#undef ML_STEP
#pragma unroll
    for (int vb = 0; vb < 2; ++vb) *(f32x4*)(a->out + O_MCP + ((size_t)chain * 256 + 32 * vs + 16 * vb + fr) * 128 + 16 * w + 4 * fq) = acc[vb];
    if (vs == 0) { if (tid < 128) a->out[O_MNP + (size_t)chain * 128 + tid] = nst; if (tid == 0) a->out[O_MMP + chain] = m; }
    __syncthreads();
}

__device__ __forceinline__ void mlstm_out_item(ArgsP a, LAS unsigned char* lds, int item, const int tid) {
    const int c = item & 31, h = (item >> 5) & 7, b = item >> 8, row0 = b * TP + 64 * c;
    const int lane = tid & 63, w = __builtin_amdgcn_readfirstlane(tid >> 6), fr = lane & 15, fq = lane >> 4;
    unsigned char* ws = a->ws;
    const bf16* proj = (const bf16*)(ws + WS_PROJ); const float* gates = (const float*)(ws + WS_GATES);
    LAS bf16* VT = (LAS bf16*)lds;
    LAS float* ssq = (LAS float*)(lds + 36864);
    const float mc = ((const float*)(ws + WS_MM))[item];
    float av, Mt, et, em;
    { const float ig = gates[(size_t)(row0 + lane) * 16 + h] + a->in[I_BIG][h], lf = logsigf(gates[(size_t)(row0 + lane) * 16 + 8 + h] + a->in[I_BFG][h]);
      const float bcum = wave_incl_sum(lf, lane); av = ig - bcum; Mt = fmaxf(mc, wave_incl_max(av, lane)); et = expf(mc - Mt); em = expf(-(bcum + Mt)); }
    {
        v4u vu[4];
#pragma unroll
        for (int i = 0; i < 4; ++i) vu[i] = *(const v4u*)(proj + (size_t)(row0 + lane) * NPROJ_PAD + 2048 + h * 256 + 8 * (w + 8 * i));
#pragma unroll
        for (int i = 0; i < 4; ++i) { const unsigned uu[4] = {vu[i].x, vu[i].y, vu[i].z, vu[i].w}; const int vr = 8 * (w + 8 * i);
#pragma unroll
            for (int e = 0; e < 4; ++e) { VT[(vr + 2 * e) * 72 + lane] = (bf16)(uu[e] & 0xffffu); VT[(vr + 2 * e + 1) * 72 + lane] = (bf16)(uu[e] >> 16); } } }
    const int tb = w & 3, half = w >> 2, t = 16 * tb + fr;
    bf16x8 qf[4]; float qn = 0.f;
#pragma unroll
    for (int ks = 0; ks < 4; ++ks) { const v4u u = *(const v4u*)(proj + (size_t)(row0 + t) * NPROJ_PAD + h * 128 + 32 * ks + 8 * fq); qf[ks] = __builtin_bit_cast(bf16x8, u);
        const float* np = (const float*)(ws + WS_MN) + (size_t)item * 128 + 32 * ks + 8 * fq; const f32x4 n0 = *(const f32x4*)np, n1 = *(const f32x4*)(np + 4);
        qn += bflo(u.x) * n0.x + bfhi(u.x) * n0.y + bflo(u.y) * n0.z + bfhi(u.y) * n0.w + bflo(u.z) * n1.x + bfhi(u.z) * n1.y + bflo(u.w) * n1.z + bfhi(u.w) * n1.w; }
    qn += __shfl_xor(qn, 16); qn += __shfl_xor(qn, 32);
    const float Mtt = __shfl(Mt, t), ett = __shfl(et, t), emt = __shfl(em, t);
    const bf16* cs = (const bf16*)(ws + WS_MC) + (size_t)item * 256 * 128;
    v4u kfr[4][4];
#pragma unroll
    for (int sb = 0; sb < 4; ++sb) if (sb <= tb) {
#pragma unroll
        for (int ks = 0; ks < 4; ++ks) kfr[sb][ks] = *(const v4u*)(proj + (size_t)(row0 + 16 * sb + fr) * NPROJ_PAD + 1024 + h * 128 + 32 * ks + 8 * fq); }
    v2u smp[4]; float rowsum = 0.f;
#pragma unroll
    for (int sb = 0; sb < 4; ++sb) { smp[sb] = (v2u){0u, 0u};
        if (sb <= tb) { f32x4 qk = (f32x4){0.f, 0.f, 0.f, 0.f};
#pragma unroll
            for (int ks = 0; ks < 4; ++ks) qk = MFMA32(__builtin_bit_cast(bf16x8, kfr[sb][ks]), qf[ks], qk);
            f32x4 sm;
#pragma unroll
            for (int j = 0; j < 4; ++j) { const int s = 16 * sb + 4 * fq + j; const float as = __shfl(av, s); sm[j] = (s <= t) ? qk[j] * 0.08838834764831845f * expf(as - Mtt) : 0.f; rowsum += sm[j]; }
            smp[sb] = pack4(sm); } }
    rowsum += __shfl_xor(rowsum, 16); rowsum += __shfl_xor(rowsum, 32);
    const float hden = 1.f / fmaxf(fabsf(ett * qn + rowsum), emt);
    const v4u s0u = (v4u){smp[0].x, smp[0].y, smp[1].x, smp[1].y}, s1u = (v4u){smp[2].x, smp[2].y, smp[3].x, smp[3].y};
    const bf16x8 sf0 = __builtin_bit_cast(bf16x8, s0u), sf1 = __builtin_bit_cast(bf16x8, s1u);
    v4u cfr[4][4];
#pragma unroll
    for (int g4 = 0; g4 < 4; ++g4)
#pragma unroll
        for (int ks = 0; ks < 4; ++ks) cfr[g4][ks] = *(const v4u*)(cs + (size_t)(128 * half + 16 * g4 + fr) * 128 + 32 * ks + 8 * fq);
    __syncthreads();
    f32x4 hv[8]; float ss = 0.f;
#pragma unroll
    for (int grp = 0; grp < 2; ++grp) {
      f32x4 accs[4];
#pragma unroll
      for (int g4 = 0; g4 < 4; ++g4) { f32x4 acc = (f32x4){0.f, 0.f, 0.f, 0.f};
#pragma unroll
          for (int ks = 0; ks < 4; ++ks) acc = MFMA32(__builtin_bit_cast(bf16x8, cfr[g4][ks]), qf[ks], acc);
          accs[g4] = acc * ett; }
      if (grp == 0) {
#pragma unroll
          for (int g4 = 0; g4 < 4; ++g4)
#pragma unroll
              for (int ks = 0; ks < 4; ++ks) cfr[g4][ks] = *(const v4u*)(cs + (size_t)(128 * half + 64 + 16 * g4 + fr) * 128 + 32 * ks + 8 * fq); }
#pragma unroll
      for (int g4 = 0; g4 < 4; ++g4) { const int vb = 4 * grp + g4, vrow = 128 * half + 16 * vb + fr; f32x4 acc = accs[g4];
        { const v2u a0 = *(const LAS v2u*)(VT + vrow * 72 + 4 * fq), a1 = *(const LAS v2u*)(VT + vrow * 72 + 16 + 4 * fq); const v4u au = (v4u){a0.x, a0.y, a1.x, a1.y}; acc = MFMA32(__builtin_bit_cast(bf16x8, au), sf0, acc); }
        { const v2u a0 = *(const LAS v2u*)(VT + vrow * 72 + 32 + 4 * fq), a1 = *(const LAS v2u*)(VT + vrow * 72 + 48 + 4 * fq); const v4u au = (v4u){a0.x, a0.y, a1.x, a1.y}; acc = MFMA32(__builtin_bit_cast(bf16x8, au), sf1, acc); }
        hv[vb] = acc * hden; ss += (hv[vb].x * hv[vb].x + hv[vb].y * hv[vb].y) + (hv[vb].z * hv[vb].z + hv[vb].w * hv[vb].w); }
    }
    ss += __shfl_xor(ss, 16); ss += __shfl_xor(ss, 32);
    if (fq == 0) ssq[half * 64 + t] = ss;
    __syncthreads();
    const float rstd = rsqrtf((ssq[t] + ssq[64 + t]) * (1.f / 256.f) + RMS_EPS);
    const bf16* op = proj + (size_t)(row0 + t) * NPROJ_PAD + 4096 + h * 256 + 128 * half + 4 * fq;
    bf16* mp = (bf16*)(ws + WS_MIX) + (size_t)(row0 + t) * D + h * 256 + 128 * half + 4 * fq;
    const float* nw = a->in[I_MNORM] + h * 256 + 128 * half + 4 * fq;
    v2u opr[8];
#pragma unroll
    for (int vb = 0; vb < 8; ++vb) opr[vb] = *(const v2u*)(op + 16 * vb);
#pragma unroll
    for (int vb = 0; vb < 8; ++vb) { const v2u o = opr[vb]; const f32x4 n4 = *(const f32x4*)(nw + 16 * vb);
        f32x4 y; y.x = hv[vb].x * rstd * n4.x * sigm(bflo(o.x)); y.y = hv[vb].y * rstd * n4.y * sigm(bfhi(o.x)); y.z = hv[vb].z * rstd * n4.z * sigm(bflo(o.y)); y.w = hv[vb].w * rstd * n4.w * sigm(bfhi(o.y));
        *(v2u*)(mp + 16 * vb) = pack4(y); }
    __syncthreads();
}


__device__ __forceinline__ void mlstm_sample_load(ArgsP a, int j, const int tid, f32x4 (&cst)[2][4][2]) {
    const int lane = tid & 63, w = __builtin_amdgcn_readfirstlane(tid >> 6), fr = lane & 15, fq = lane >> 4;
    const float* C0 = a->in[I_SMC] + (size_t)j * 32768;
#pragma unroll
    for (int vb = 0; vb < 2; ++vb)
#pragma unroll
        for (int ksp = 0; ksp < 4; ++ksp) { const float* cp = C0 + (size_t)(32 * w + 16 * vb + fr) * 128 + 32 * ksp + 4 * fq; cst[vb][ksp][0] = __builtin_nontemporal_load((const f32x4*)cp); cst[vb][ksp][1] = __builtin_nontemporal_load((const f32x4*)(cp + 16)); }
}
__device__ __forceinline__ void mlstm_sample_item(ArgsP a, LAS unsigned char* lds, int j, const int tid, const f32x4 (&cst)[2][4][2]) {
    const int b = j >> 3, h = j & 7, row0 = MP + b * TS;
    const int lane = tid & 63, w = __builtin_amdgcn_readfirstlane(tid >> 6), fr = lane & 15, fq = lane >> 4;
    unsigned char* ws = a->ws;
    const bf16* proj = (const bf16*)(ws + WS_PROJ); const float* gates = (const float*)(ws + WS_GATES);
    float* Cout = a->out + O_MCS + (size_t)j * 32768;
    LAS float* qs = (LAS float*)lds;
    LAS float* ks = qs + 512;
    LAS float* vs = ks + 512;
    LAS float* gs = vs + 1024;
    LAS float* qkr = gs + 8;
    LAS float* qnl = qkr + 16;
    LAS float* hbuf = qnl + 8;
#pragma unroll
    for (int tok = 0; tok < 4; ++tok) { const bf16* pr = proj + (size_t)(row0 + tok) * NPROJ_PAD;
        if (tid < 128) qs[tok * 128 + tid] = bf2f(pr[h * 128 + tid]); else if (tid < 256) ks[tok * 128 + tid - 128] = bf2f(pr[1024 + h * 128 + (tid - 128)]) * 0.08838834764831845f; else vs[tok * 256 + tid - 256] = bf2f(pr[2048 + h * 256 + (tid - 256)]); }
    if (tid < 4) { gs[tid * 2] = gates[(size_t)(row0 + tid) * 16 + h] + a->in[I_BIG][h]; gs[tid * 2 + 1] = gates[(size_t)(row0 + tid) * 16 + 8 + h] + a->in[I_BFG][h]; }
    const float n0a = a->in[I_SMN][(size_t)j * 128 + lane], n0b = a->in[I_SMN][(size_t)j * 128 + 64 + lane];
    const float m0 = a->in[I_SMM][j];
    __syncthreads();
#pragma unroll
    for (int i = 0; i < 2; ++i) { const int p = 2 * w + i, t = p >> 2, sx = p & 3; const float d = wave_sum(qs[t * 128 + lane] * ks[sx * 128 + lane] + qs[t * 128 + 64 + lane] * ks[sx * 128 + 64 + lane]); if (lane == 0) qkr[p] = d; }
    if (w < 4) { const float d = wave_sum(qs[w * 128 + lane] * n0a + qs[w * 128 + 64 + lane] * n0b); if (lane == 0) qnl[w] = d; }
    float bc[4], ig[4], mt[4], m = m0, bsum = 0.f;
#pragma unroll
    for (int t = 0; t < 4; ++t) { ig[t] = gs[t * 2]; const float lf = logsigf(gs[t * 2 + 1]); bsum += lf; bc[t] = bsum; m = fmaxf(lf + m, ig[t]); mt[t] = m; }
    const float scf = expf(bc[3] + m0 - mt[3]);
    float wsf[4], et[4];
#pragma unroll
    for (int t = 0; t < 4; ++t) { wsf[t] = expf(bc[3] - bc[t] + ig[t] - mt[3]); et[t] = expf(bc[t] + m0 - mt[t]); }
    __syncthreads();
    float S[4][4], hden[4];
#pragma unroll
    for (int t = 0; t < 4; ++t) { float den = et[t] * qnl[t];
#pragma unroll
        for (int sx = 0; sx < 4; ++sx) { S[t][sx] = (sx <= t) ? qkr[t * 4 + sx] * expf(bc[t] - bc[sx] + ig[sx] - mt[t]) : 0.f; den += S[t][sx]; }
        hden[t] = 1.f / fmaxf(fabsf(den), expf(-mt[t])); }
    bf16x8 qa[4];
#pragma unroll
    for (int ksp = 0; ksp < 4; ++ksp) { v4u u = (v4u){0u, 0u, 0u, 0u};
        if (fr < 4) { const f32x4 x0 = *(const LAS f32x4*)(qs + fr * 128 + 32 * ksp + 4 * fq), x1 = *(const LAS f32x4*)(qs + fr * 128 + 32 * ksp + 16 + 4 * fq); u.x = pk2(x0.x, x0.y); u.y = pk2(x0.z, x0.w); u.z = pk2(x1.x, x1.y); u.w = pk2(x1.z, x1.w); }
        qa[ksp] = __builtin_bit_cast(bf16x8, u); }
#pragma unroll
    for (int vb = 0; vb < 2; ++vb) { const int v = 32 * w + 16 * vb + fr;
        float vw[4];
#pragma unroll
        for (int sx = 0; sx < 4; ++sx) vw[sx] = vs[sx * 256 + v] * wsf[sx];
        f32x4 dacc = (f32x4){0.f, 0.f, 0.f, 0.f};
#pragma unroll
        for (int ksp = 0; ksp < 4; ++ksp) { const f32x4 c0 = cst[vb][ksp][0], c1 = cst[vb][ksp][1];
            v4u u; u.x = pk2(c0.x, c0.y); u.y = pk2(c0.z, c0.w); u.z = pk2(c1.x, c1.y); u.w = pk2(c1.z, c1.w);
            dacc = MFMA32(qa[ksp], __builtin_bit_cast(bf16x8, u), dacc);
            f32x4 n0v = c0 * scf, n1v = c1 * scf;
#pragma unroll
            for (int sx = 0; sx < 4; ++sx) { const f32x4 k0 = *(const LAS f32x4*)(ks + sx * 128 + 32 * ksp + 4 * fq), k1 = *(const LAS f32x4*)(ks + sx * 128 + 32 * ksp + 16 + 4 * fq); n0v = n0v + k0 * vw[sx]; n1v = n1v + k1 * vw[sx]; }
            float* op = Cout + (size_t)v * 128 + 32 * ksp + 4 * fq; __builtin_nontemporal_store(n0v, (f32x4*)op); __builtin_nontemporal_store(n1v, (f32x4*)(op + 16)); }
        if (fq == 0) {
#pragma unroll
            for (int t = 0; t < 4; ++t) { float num = et[t] * dacc[t];
#pragma unroll
                for (int sx = 0; sx < 4; ++sx) num += S[t][sx] * vs[sx * 256 + v];
                hbuf[t * 256 + v] = num * hden[t]; } }
    }
    if (tid < 128) { float nn = scf * a->in[I_SMN][(size_t)j * 128 + tid];
#pragma unroll
        for (int sx = 0; sx < 4; ++sx) nn += wsf[sx] * ks[sx * 128 + tid];
        a->out[O_MNS + (size_t)j * 128 + tid] = nn; }
    if (tid == 0) a->out[O_MMS + j] = mt[3];
    __syncthreads();
    if (w < 4) { const int tok = w, row = row0 + tok; float hv[4]; float ss = 0.f;
#pragma unroll
        for (int i = 0; i < 4; ++i) { hv[i] = hbuf[tok * 256 + i * 64 + lane]; ss += hv[i] * hv[i]; }
        const float rstd = rsqrtf(wave_sum(ss) * (1.f / 256.f) + RMS_EPS);
        const float* nw = a->in[I_MNORM] + h * 256; bf16* mix = (bf16*)(ws + WS_MIX);
#pragma unroll
        for (int i = 0; i < 4; ++i) { const int vi = i * 64 + lane; const float op = bf2f(proj[(size_t)row * NPROJ_PAD + 4096 + h * 256 + vi]);
            mix[(size_t)row * D + h * 256 + vi] = (bf16)f2bf(hv[i] * rstd * nw[vi] * sigm(op)); } }
    __syncthreads();
}

__device__ __forceinline__ void phase_mixer_even(ArgsP a, LAS unsigned char* lds, int vcu, int G, const int tid) {
#pragma unroll 1
    for (int r = 0; r < 1 + (PROBE_SUB & 1); ++r)
#pragma unroll 1
    for (int it = vcu; it < 1024; it += G) delta_prep_item(a, lds, it, tid);
#pragma unroll 1
    for (int r = 0; r < 1 + ((PROBE_SUB >> 1) & 1); ++r)
#pragma unroll 1
    for (int it = vcu; it < 1024; it += G) lru_prep_item(a, lds, it, tid);
#pragma unroll 1
    for (int r = 0; r < 1 + ((PROBE_SUB >> 2) & 1); ++r)
#pragma unroll 1
    for (int j = vcu; j < 1024; j += G) { const int b = j >> 3, hn = j & 7; delta_rec_item(a, lds, MP + b * TS, TS, hn, a->in[I_SCONV] + (size_t)b * 3 * 4096, a->in[I_SDELTA] + (size_t)j * 16384, a->out + O_DELTAS + (size_t)j * 16384, tid); }
#pragma unroll 1
    for (int r = 0; r < 1 + ((PROBE_SUB >> 3) & 1); ++r)
#pragma unroll 1
    for (int j = vcu; j < 1024; j += G) { const int b = j >> 3, hn = j & 7; lru_rec_item(a, lds, MP + b * TS, TS, hn, a->in[I_SCONV] + (size_t)b * 3 * 4096, a->in[I_SLRU] + (size_t)b * 1024, a->out + O_LRUS + (size_t)b * 1024, tid); }
    const bf16* proj = (const bf16*)(a->ws + WS_PROJ);
    const int nconv = (BP + BS) * 3 * 4096;
    for (int i = vcu * NTHR + tid; i < nconv; i += G * NTHR) {
        const int ch = i & 4095, rj = i >> 12, j = rj % 3, b = rj / 3;
        if (b < BP) a->out[O_CONVP + (size_t)(b * 3 + j) * 4096 + ch] = bf2f(proj[(size_t)(b * TP + TP - 3 + j) * NPROJ_PAD + ch]);
        else { const int bs = b - BP; a->out[O_CONVS + (size_t)(bs * 3 + j) * 4096 + ch] = bf2f(proj[(size_t)(MP + bs * TS + 1 + j) * NPROJ_PAD + ch]); }
    }
}
__device__ __forceinline__ void phase_mixer_even_b(ArgsP a, LAS unsigned char* lds, int vcu, int G, const int tid) {
    const int w = __builtin_amdgcn_readfirstlane(tid >> 6);
    if (w == 0) { for (int it = vcu; it < 256; it += G) delta_scan_wave(a, it >> 3, it & 7, tid & 63); }
    else { LAS float* scr = (LAS float*)(lds + w * 16384);
        const int lane = tid & 63, stride = G * 7; int it = vcu * 7 + (w - 1);
        TDesc dA, dB; f32x4 vA[8], vB[8];
        if (it < cv::N_REST) { dA = decode_rest(a, it); t_load(dA, lane, vA);
#pragma unroll 1
            for (;;) {
                const int itB = it + stride; const bool hasB = itB < cv::N_REST;
                if (hasB) { dB = decode_rest(a, itB); t_load(dB, lane, vB); }
                t_finish(dA, scr, lane, vA);
                if (!hasB) break;
                it = itB + stride; const bool hasA = it < cv::N_REST;
                if (hasA) { dA = decode_rest(a, it); t_load(dA, lane, vA); }
                t_finish(dB, scr, lane, vB);
                if (!hasA) break;
            } } }
}
__device__ __forceinline__ void phase_mixer_even_c(ArgsP a, LAS unsigned char* lds, int vcu, int G, const int tid) {
    const int w = tid >> 6;
#pragma unroll 1
    for (int it = vcu; it < 512; it += G) delta_out_wave(a, 2 * it + (w >> 2), w & 3, tid & 63);
#pragma unroll 1
    for (int it = vcu; it < 1024; it += G) lru_out_item(a, lds, it, tid);
    for (int chain = vcu; chain < 32; chain += G) {
        const float* src = (const float*)(a->ws + WS_DF) + (size_t)chain * 16384; float* dst = a->out + O_DELTAP + (size_t)chain * 16384;
        for (int e = tid; e < 16384; e += NTHR) { const int dk = e >> 7, dv = e & 127;
            dst[e] = src[((((dv >> 4) * 8 + (dk >> 4)) * 64 + ((dk >> 2) & 3) * 16 + (dv & 15)) << 2) + (dk & 3)]; }
    }
}
__device__ __forceinline__ void phase_mixer_odd(ArgsP a, LAS unsigned char* lds, int vcu, int G, const int tid) {
#pragma unroll 1
    for (int r = 0; r < 1 + ((PROBE_SUB >> 4) & 1); ++r)
#pragma unroll 1
    for (int it = vcu; it < 256; it += G) mlstm_scan_item(a, lds, it >> 3, it & 7, tid);
#pragma unroll 1
    for (int r = 0; r < 1 + ((PROBE_SUB >> 5) & 1); ++r)
    {
        f32x4 cA[2][4][2], cB[2][4][2]; int j = vcu;
        if (j < 1024) { mlstm_sample_load(a, j, tid, cA);
#pragma unroll 1
            for (;;) {
                const int jB = j + G; const bool hasB = jB < 1024;
                if (hasB) mlstm_sample_load(a, jB, tid, cB);
                mlstm_sample_item(a, lds, j, tid, cA);
                if (!hasB) break;
                j = jB + G; const bool hasA = j < 1024;
                if (hasA) mlstm_sample_load(a, j, tid, cA);
                mlstm_sample_item(a, lds, jB, tid, cB);
                if (!hasA) break;
            } }
    }
}
__device__ __forceinline__ void phase_mixer_odd_b(ArgsP a, LAS unsigned char* lds, int vcu, int G, const int tid) {
#pragma unroll 1
    for (int it = vcu; it < 1024; it += G) mlstm_out_item(a, lds, it, tid);
}

__device__ __forceinline__ void phase_ln(const bf16* VB, const float* ST, const float* p1, const bf16* resid, const float* g, const float* bta, bf16* dst, LAS unsigned char* lds, int vcu, int G, const int tid) {
    const int lane = tid & 63, w = __builtin_amdgcn_readfirstlane(tid >> 6), gw = vcu * NWAVES + w, NGW = G * NWAVES;
    {
        LAS float* red = (LAS float*)lds;
        for (int r0 = 2 * vcu; r0 < MS; r0 += 2 * G) {
            const int r = r0 + (w >> 2), q = w & 3, col = 512 * q + 8 * lane; const size_t off = (size_t)(MP + r) * D + col;
            const float* q1 = p1 + (size_t)r * D + col;
            f32x4 x0 = *(const f32x4*)q1, x1 = *(const f32x4*)(q1 + 4);
#pragma unroll
            for (int ch = 1; ch < 16; ++ch) { x0 = x0 + *(const f32x4*)(q1 + (size_t)ch * 512 * D); x1 = x1 + *(const f32x4*)(q1 + (size_t)ch * 512 * D + 4); }
            const v4u rr = *(const v4u*)(resid + off);
            float v[8] = {x0.x + DN_ALPHA * bflo(rr.x), x0.y + DN_ALPHA * bfhi(rr.x), x0.z + DN_ALPHA * bflo(rr.y), x0.w + DN_ALPHA * bfhi(rr.y),
                          x1.x + DN_ALPHA * bflo(rr.z), x1.y + DN_ALPHA * bfhi(rr.z), x1.z + DN_ALPHA * bflo(rr.w), x1.w + DN_ALPHA * bfhi(rr.w)};
            float s = 0.f, ss = 0.f;
#pragma unroll
            for (int i = 0; i < 8; ++i) { s += v[i]; ss += v[i] * v[i]; }
            s = wave_sum(s); ss = wave_sum(ss);
            if (lane == 0) { red[w * 2] = s; red[w * 2 + 1] = ss; }
            __syncthreads();
            const int wb = (w >> 2) * 4; s = (red[wb * 2] + red[wb * 2 + 2]) + (red[wb * 2 + 4] + red[wb * 2 + 6]); ss = (red[wb * 2 + 1] + red[wb * 2 + 3]) + (red[wb * 2 + 5] + red[wb * 2 + 7]);
            const float mean = s * (1.f / D), rstd = rsqrtf(fmaxf(ss * (1.f / D) - mean * mean, 0.f) + LN_EPS);
            const f32x4 g0 = *(const f32x4*)(g + col), g1 = *(const f32x4*)(g + col + 4), b0 = *(const f32x4*)(bta + col), b1 = *(const f32x4*)(bta + col + 4);
            v4u o; o.x = pk2((v[0] - mean) * rstd * g0.x + b0.x, (v[1] - mean) * rstd * g0.y + b0.y); o.y = pk2((v[2] - mean) * rstd * g0.z + b0.z, (v[3] - mean) * rstd * g0.w + b0.w);
            o.z = pk2((v[4] - mean) * rstd * g1.x + b1.x, (v[5] - mean) * rstd * g1.y + b1.y); o.w = pk2((v[6] - mean) * rstd * g1.z + b1.z, (v[7] - mean) * rstd * g1.w + b1.w);
            *(v4u*)(dst + off) = o;
            __syncthreads();
        }
    }
    for (int m0 = gw; m0 < MP; m0 += 4 * NGW) {
        v4u vv[4][4]; float s[4], ss[4];
#pragma unroll
        for (int i = 0; i < 4; ++i) { const int m = m0 + i * NGW; s[i] = 0.f; ss[i] = 0.f;
            if (m < MP) { if (lane < 32) { const float* sp = ST + (((size_t)(lane >> 2) * M + m) * 4 + (lane & 3)) * 2; s[i] = sp[0]; ss[i] = sp[1]; }
#pragma unroll
                for (int j = 0; j < 4; ++j) vv[i][j] = *(const v4u*)(VB + (size_t)m * D + j * 512 + lane * 8); } }
#pragma unroll
        for (int i = 0; i < 4; ++i) { const int m = m0 + i * NGW;
            if (m < MP) { const float st = wave_sum(s[i]), sst = wave_sum(ss[i]);
                const float mean = st * (1.f / D), rstd = rsqrtf(fmaxf(sst * (1.f / D) - mean * mean, 0.f) + LN_EPS);
#pragma unroll
                for (int j = 0; j < 4; ++j) { const int col = j * 512 + lane * 8; const v4u v = vv[i][j];
                    const f32x4 g0 = *(const f32x4*)(g + col), g1 = *(const f32x4*)(g + col + 4), b0 = *(const f32x4*)(bta + col), b1 = *(const f32x4*)(bta + col + 4);
                    v4u o; o.x = pk2((bflo(v.x) - mean) * rstd * g0.x + b0.x, (bfhi(v.x) - mean) * rstd * g0.y + b0.y); o.y = pk2((bflo(v.y) - mean) * rstd * g0.z + b0.z, (bfhi(v.y) - mean) * rstd * g0.w + b0.w);
                    o.z = pk2((bflo(v.z) - mean) * rstd * g1.x + b1.x, (bfhi(v.z) - mean) * rstd * g1.y + b1.y); o.w = pk2((bflo(v.w) - mean) * rstd * g1.z + b1.z, (bfhi(v.w) - mean) * rstd * g1.w + b1.w);
                    *(v4u*)(dst + (size_t)m * D + col) = o; } } }
    }
}
__device__ __forceinline__ void phase_combine(const float* p1, const bf16* h2, const bf16* pw, bf16* xb, float* outf, int vcu, int G, const int tid) {
    const int lane = tid & 63, w = tid >> 6;
    for (int r0 = 2 * vcu; r0 < MS; r0 += 2 * G) {
        const int r = r0 + (w >> 2), q = w & 3, col = 512 * q + 8 * lane; const size_t off = (size_t)(MP + r) * D + col;
        const float* q1 = p1 + (size_t)r * D + col;
        f32x4 x0 = *(const f32x4*)q1, x1 = *(const f32x4*)(q1 + 4);
#pragma unroll
        for (int ch = 1; ch < 16; ++ch) { x0 = x0 + *(const f32x4*)(q1 + (size_t)ch * 512 * D); x1 = x1 + *(const f32x4*)(q1 + (size_t)ch * 512 * D + 4); }
        const v4u hh = *(const v4u*)(h2 + off), pp = *(const v4u*)(pw + off);
        f32x4 o0, o1;
        o0.x = bflo(hh.x) + sigm(x0.x) * bflo(pp.x); o0.y = bfhi(hh.x) + sigm(x0.y) * bfhi(pp.x); o0.z = bflo(hh.y) + sigm(x0.z) * bflo(pp.y); o0.w = bfhi(hh.y) + sigm(x0.w) * bfhi(pp.y);
        o1.x = bflo(hh.z) + sigm(x1.x) * bflo(pp.z); o1.y = bfhi(hh.z) + sigm(x1.y) * bfhi(pp.z); o1.z = bflo(hh.w) + sigm(x1.z) * bflo(pp.w); o1.w = bfhi(hh.w) + sigm(x1.w) * bfhi(pp.w);
        v4u ob; ob.x = pk2(o0.x, o0.y); ob.y = pk2(o0.z, o0.w); ob.z = pk2(o1.x, o1.y); ob.w = pk2(o1.z, o1.w); *(v4u*)(xb + off) = ob;
        if (outf) { *(f32x4*)(outf + off) = o0; *(f32x4*)(outf + off + 4) = o1; }
    }
}

constexpr int N_PHASES = 22;
enum { OP_INPROJ = 0, OP_MIXA, OP_MIXB, OP_MIXC, OP_OUTPROJ, OP_LN1, OP_UP, OP_DOWN, OP_LN2, OP_GATE, OP_COMBINE };
enum { GK_LN = 0, GK_BF16 = 1, GK_SQRELU = 2, GK_COMB = 3 };
__global__ void __launch_bounds__(NTHR, 2) mk_fwd(Args a_in) {
    extern __shared__ __attribute__((aligned(16))) unsigned char lds_raw[];
    LAS unsigned char* lds = (LAS unsigned char*)lds_raw;
    ArgsP kp = (ArgsP)__builtin_amdgcn_kernarg_segment_ptr();
    const int lo = a_in.ph_lo, hi = a_in.ph_hi;
    int wv0; { const int wtmp = (int)threadIdx.x >> 6; asm volatile("s_nop 4\n\tv_readfirstlane_b32 %0, %1\n\ts_nop 4" : "=s"(wv0) : "v"(wtmp)); }
#if MK_N_LAUNCHES == 1
    volatile LAS unsigned* xst = (volatile LAS unsigned*)(lds + LDS_CTL_OFF);
    if (threadIdx.x < 2) xst[threadIdx.x] = 0u;
    __syncthreads();
    XcdBarrier bar = xcd_barrier_post((unsigned*)(a_in.ws + WS_CTL) + 4096, xst);
#endif
    int p = lo; asm volatile("" : "+s"(p));
#pragma unroll 1
    for (; p < hi; ) {
      int nrep = 1;
      if (PROBE_MASK) { const int L_ = p <= 11 ? 0 : 1; const int q_ = p == 0 ? -1 : (L_ == 0 ? p - 1 : (p - 12 < 3 ? p - 12 : p - 11));
        int grp; if (p == 0) grp = 0; else if (q_ == OP_INPROJ || q_ == OP_UP) grp = 1; else if (q_ == OP_OUTPROJ || q_ == OP_DOWN || q_ == OP_GATE) grp = 2; else if (q_ == OP_LN1 || q_ == OP_LN2 || q_ == OP_COMBINE) grp = 3; else grp = (L_ == 0) ? 4 : 5;
        if ((PROBE_MASK >> grp) & 1) nrep = 2; }
      if (p == PROBE_P) nrep = 2;
#pragma unroll 1
      for (int rep = 0; rep < nrep; ++rep) {
        int pp = p; asm volatile("" : "+s"(pp));
        int wvs = wv0; asm volatile("" : "+s"(wvs));
        unsigned ones = ~0u; asm volatile("" : "+s"(ones));
        int tid = (wvs << 6) | (int)__builtin_amdgcn_mbcnt_hi(ones, __builtin_amdgcn_mbcnt_lo(ones, 0u)); asm volatile("" : "+v"(tid));
        int bx = blockIdx.x; asm volatile("" : "+s"(bx));
        int G = gridDim.x; asm volatile("" : "+s"(G));
        ArgsP a = kp; asm volatile("" : "+s"(a));
#define MK_VCU ((G % 8 == 0) ? (bx % 8) * (G / 8) + bx / 8 : bx)
#define MK_WAVE (__builtin_amdgcn_readfirstlane(tid >> 6))
#define MK_GW (MK_VCU * NWAVES + MK_WAVE)
#define MK_NGW (G * NWAVES)
#define MK_LANE (tid & 63)
        unsigned char* ws = a->ws;
        if (pp == 0) {
phase_convert(a, lds, MK_GW, MK_NGW, MK_WAVE, MK_LANE); }
        else {
            const int L = pp <= 11 ? 0 : 1; const int q = L == 0 ? pp - 1 : (pp - 12 < 3 ? pp - 12 : pp - 11);
            bf16* xb = (bf16*)(ws + WS_XB); bf16* mixb = (bf16*)(ws + WS_MIX); bf16* hb = (bf16*)(ws + WS_H); bf16* h2b = (bf16*)(ws + WS_H2); bf16* pwb = (bf16*)(ws + WS_PW);
            bf16* projb = (bf16*)(ws + WS_PROJ); bf16* upb = (bf16*)(ws + WS_PROJ);
            bf16* vbb = (bf16*)(ws + WS_PART0); float* stb = (float*)(ws + WS_PART0 + 34 * MiB); float* part1 = (float*)(ws + WS_PART1); float* gatesb = (float*)(ws + WS_GATES);
            if (q == OP_MIXA) { if (L == 0) phase_mixer_even(a, lds, MK_VCU, G, tid); else phase_mixer_odd(a, lds, MK_VCU, G, tid); }
            else if (q == OP_MIXB) { if (L == 0) phase_mixer_even_b(a, lds, MK_VCU, G, tid); else phase_mixer_odd_b(a, lds, MK_VCU, G, tid); }
            else if (q == OP_MIXC) { phase_mixer_even_c(a, lds, MK_VCU, G, tid); }
            else if (q == OP_LN1) phase_ln(vbb, stb, part1, xb, a->in[I_LN1G] + L * D, a->in[I_LN1B] + L * D, hb, lds, MK_VCU, G, tid);
            else if (q == OP_LN2) phase_ln(vbb, stb, part1, hb, a->in[I_LN2G] + L * D, a->in[I_LN2B] + L * D, h2b, lds, MK_VCU, G, tid);
            else if (q == OP_COMBINE) phase_combine(part1, h2b, pwb, xb, L == 1 ? a->out + O_Y : nullptr, MK_VCU, G, tid);
            else {
                for (int sub = 0; sub < (q == OP_OUTPROJ ? 2 : 1); ++sub) {
                    const bf16* A; const bf16* Bt; int N, K, kind; void* out = nullptr; float* gp = nullptr; const bf16* resid = nullptr; int corder = bx;
                    if (q == OP_INPROJ) { A = xb; Bt = (const bf16*)(ws + (L == 0 ? WS_WINE : WS_WINO)); N = NPROJ_PAD; K = D; kind = GK_BF16; out = projb; gp = gatesb; }
                    else if (q == OP_OUTPROJ && sub == 0) { A = mixb; Bt = (const bf16*)(ws + (L == 0 ? WS_WOUTE : WS_WOUTO)); N = D; K = D; kind = GK_LN; resid = xb; }
                    else if (q == OP_OUTPROJ) { A = (const bf16*)(ws + WS_PB) + (size_t)L * M * PLE; Bt = (const bf16*)(ws + WS_WPLE) + (size_t)L * PLE * D; N = D; K = PLE; kind = GK_BF16; out = pwb; corder = (bx + 128) % G; }
                    else if (q == OP_UP) { A = hb; Bt = (const bf16*)(ws + WS_WUP) + (size_t)L * D * FF; N = FF; K = D; kind = GK_SQRELU; out = upb; }
                    else if (q == OP_DOWN) { A = upb; Bt = (const bf16*)(ws + WS_WDOWN) + (size_t)L * D * FF; N = D; K = FF; kind = GK_LN; resid = hb; }
                    else { A = h2b; Bt = (const bf16*)(ws + WS_WGATE) + (size_t)L * D * D; N = D; K = D; kind = GK_COMB; }
                    pg8::Gemm g{A, Bt, M, N, K};
                    if (kind == GK_LN) { pg8::MainSplit SK; SK.init(K, MK_VCU); pg8::EpiLnStat E{vbb, stb, resid, part1, N, M, DN_ALPHA}; pg8::gemm_phase<pg8::EpiLnStat, pg8::MainSplit, true, true>(lds, g, SK, E, tid); }
                    else if (kind == GK_COMB) { pg8::MainSplit SK; SK.init(K, MK_VCU); pg8::EpiCombine E{h2b, pwb, xb, L == 1 ? a->out + O_Y : nullptr, part1, N}; pg8::gemm_phase<pg8::EpiCombine, pg8::MainSplit, true, true>(lds, g, SK, E, tid); }
                    else if (kind == GK_BF16) { pg8::StaticOrder S; S.init(M, N, K, G, corder); pg8::EpiBf16<0> E{(bf16*)out, N, gp, 24}; pg8::gemm_phase<pg8::EpiBf16<0>, pg8::StaticOrder, true, true>(lds, g, S, E, tid); }
                    else { pg8::StaticOrder S; S.init(M, N, K, G, corder); pg8::EpiBf16<1> E{(bf16*)out, N, nullptr, -1}; pg8::gemm_phase<pg8::EpiBf16<1>, pg8::StaticOrder, true, true>(lds, g, S, E, tid); }
                }
            }
        }
#if MK_N_LAUNCHES == 1
        if (p + 1 < hi || rep + 1 < nrep) xcd_barrier(bar);
#endif
      }
      asm volatile("s_add_i32 %0, %0, 1" : "+s"(p) : : "scc");
    }
}

extern "C" void kernel_launch(void* const* d_in, const int* in_sizes, int n_in, void* d_out, int out_size, void* d_ws, size_t ws_size, hipStream_t stream) {
    static int grid = 0;
    if (grid == 0) {
        if (n_in != 35 || (size_t)out_size != O_END || ws_size < WS_END) { fprintf(stderr, "kernel_launch: unexpected shapes: n_in %d out %d (want %zu) ws %zu (want %zu)\n", n_in, out_size, (size_t)O_END, ws_size, (size_t)WS_END); grid = -1; return; }
        int dev = 0, cus = 0, per_cu = 0;
        hipGetDevice(&dev); hipDeviceGetAttribute(&cus, hipDeviceAttributeMultiprocessorCount, dev);
        if (hipFuncSetAttribute((const void*)mk_fwd, hipFuncAttributeMaxDynamicSharedMemorySize, LDS_BYTES) != hipSuccess) { fprintf(stderr, "kernel_launch: hipFuncSetAttribute failed\n"); grid = -1; return; }
        if (hipOccupancyMaxActiveBlocksPerMultiprocessor(&per_cu, (const void*)mk_fwd, NTHR, LDS_BYTES) != hipSuccess || per_cu < 1) { fprintf(stderr, "kernel_launch: occupancy query says %d\n", per_cu); per_cu = 1; }
        (void)hipGetLastError();
        if (cus != 256) { fprintf(stderr, "kernel_launch: built for a 256-CU device (N = 2048 GEMM schedule), got %d\n", cus); grid = -1; return; }
        grid = cus * 1;
    }
    if (grid < 0) return;
    Args a{};
    for (int i = 0; i < 35; ++i) a.in[i] = (const float*)d_in[i];
    a.out = (float*)d_out; a.ws = (unsigned char*)d_ws;
#if MK_N_LAUNCHES == 1
    hipMemsetAsync((char*)d_ws + WS_CTL, 0, 1 * MiB, stream);
    a.ph_lo = 0; a.ph_hi = N_PHASES;
    hipLaunchKernelGGL(mk_fwd, dim3(grid), dim3(NTHR), LDS_BYTES, stream, a);
#else
    for (int p = 0; p < N_PHASES; ++p) {
        a.ph_lo = p; a.ph_hi = p + 1;
        hipLaunchKernelGGL(mk_fwd, dim3(grid), dim3(NTHR), LDS_BYTES, stream, a);
    }
#endif
}
```

```cpp
#include <hip/hip_runtime.h>
#include <hip/hip_cooperative_groups.h>
#include <cstdio>
#include <cstdint>
namespace cg = cooperative_groups;

#ifndef PROBE_MASK
#define PROBE_MASK 0
#endif
#define PROBE_P (-1)
#define PROBE_SUB 0
#ifndef MK_N_LAUNCHES
#define MK_N_LAUNCHES 1
#endif

namespace pg8 {
#define PG8_LAS __attribute__((address_space(3)))
typedef unsigned short bf16_t;
typedef short bf16x8 __attribute__((ext_vector_type(8)));
typedef float f32x4 __attribute__((ext_vector_type(4)));
typedef unsigned u32x4 __attribute__((ext_vector_type(4)));
constexpr int BM = 256, BK = 64, HALF = 128, HTB = HALF * BK * 2, STAGE_BYTES = 8 * HTB, NXCD = 8, WGM = 8;

__host__ __device__ __forceinline__ int lds_byte(int r, int c) { const int st = (r >> 4) * 2 + (c >> 5), rr = r & 15, cc = c & 31, ob = rr * 64 + cc * 2; return st * 1024 + (ob ^ (((ob >> 9) & 1) << 5)); }
__host__ __device__ __forceinline__ void stage_rc(int b, int& R, int& C) { const int st = b / 1024, sb = b % 1024, swz = sb ^ (((sb >> 9) & 1) << 5); R = (st >> 1) * 16 + swz / 64; C = (st & 1) * 32 + (swz % 64) / 2; }
__host__ __device__ __forceinline__ int perm32(int rho) { const int n = rho >> 4, i = rho & 15; return 8 * (i >> 2) + 4 * n + (i & 3); }

struct Unit { int pm, pn, kt0, nkt, dst; };
struct Gemm { const bf16_t* A; const bf16_t* Bt; int M, N, K; };

struct StaticOrder {
    int nM, nN, nwg, G, c, T;
    __host__ __device__ void init(int M, int N, int K, int G_, int c_) { nM = M / BM; nN = N / BM; nwg = nM * nN; G = G_; c = c_; T = K / BK; }
    __host__ __device__ bool next(int i, Unit& u) const {
        const long L = (long)i * G + c; if (L >= nwg) return false;
        int wgid = (int)L; { const int q = nwg / NXCD, r = nwg % NXCD, xcd = wgid % NXCD, off = wgid / NXCD; wgid = (xcd < r ? xcd * (q + 1) : r * (q + 1) + (xcd - r) * q) + off; }
        const int nig = WGM * nN, gid = wgid / nig, fm = gid * WGM, gsz = (nM - fm) < WGM ? (nM - fm) : WGM;
        u.pm = fm + ((wgid % nig) % gsz); u.pn = (wgid % nig) / gsz; u.kt0 = 0; u.nkt = T; u.dst = 0; return true;
    }
    __device__ __forceinline__ void a_ready(const Unit&) const {}
    __device__ __forceinline__ void done(const Unit&) const {}
};
struct StreamK {
    int nN, T, P, ntot, c;
    __host__ __device__ void init(int M, int N, int K, int G, int c_) { nN = N / BM; T = K / BK; ntot = (M / BM) * nN * T; P = (((ntot + G - 1) / G) + 1) & ~1; c = c_; }
    __host__ __device__ bool next(int i, Unit& u) const {
        int s = c * P; const int e = (s + P < ntot) ? s + P : ntot;
        for (int k = 0; ; ++k) { if (s >= e) return false; const int tile = s / T, kt0 = s - tile * T; const int n = (T - kt0 < e - s) ? T - kt0 : e - s;
            if (k == i) { u.pm = tile / nN; u.pn = tile - u.pm * nN; u.kt0 = kt0; u.nkt = n; u.dst = kt0 ? 1 : 0; return true; }
            s += n; }
    }
    __device__ __forceinline__ void a_ready(const Unit&) const {}
    __device__ __forceinline__ void done(const Unit&) const {}
};
struct MainSplit {
    int T, c;
    __host__ __device__ void init(int K, int c_) { T = K / BK; c = c_; }
    __host__ __device__ bool next(int i, Unit& u) const {
        if (i == 0) { u.pm = c >> 3; u.pn = c & 7; u.kt0 = 0; u.nkt = T; u.dst = 0; return true; }
        if (i == 1) { const int lt = c >> 4, j = c & 15; u.pm = 32 + (lt >> 3); u.pn = lt & 7; u.nkt = T >> 4; u.kt0 = j * u.nkt; u.dst = 1 + j; return true; }
        return false;
    }
    __device__ __forceinline__ void a_ready(const Unit&) const {}
    __device__ __forceinline__ void done(const Unit&) const {}
};
__host__ __device__ __forceinline__ bool split_tile(int tile, int T, int P) { return (tile * T) / P != ((tile + 1) * T - 1) / P; }

__device__ __forceinline__ unsigned cvt_pk_bf16(float lo, float hi) { unsigned r; asm volatile("v_cvt_pk_bf16_f32 %0, %1, %2" : "=v"(r) : "v"(lo), "v"(hi)); return r; }

__device__ __forceinline__ float pg_bflo(unsigned w) { return __builtin_bit_cast(float, w << 16); }
__device__ __forceinline__ float pg_bfhi(unsigned w) { return __builtin_bit_cast(float, w & 0xffff0000u); }
__device__ __forceinline__ void store_chunk(const f32x4 (&acc)[2][2][4][2], const Unit& u, float* C1, int ldc, int wr, int wc, int fr, int fq) {
    const int row0 = u.pm * BM + wr * 64 + fr, col0 = u.pn * BM + wc * 32 + 8 * fq; float* Cb = C1 + ((long)(u.dst - 1) * 512 - 8192) * (long)ldc;
#pragma unroll
    for (int ai = 0; ai < 2; ++ai)
#pragma unroll
        for (int m = 0; m < 4; ++m) { float* rowp = Cb + (size_t)(row0 + ai * HALF + m * 16) * ldc + col0;
#pragma unroll
            for (int bj = 0; bj < 2; ++bj) { *(f32x4*)(rowp + bj * HALF) = acc[ai][bj][m][0]; *(f32x4*)(rowp + bj * HALF + 4) = acc[ai][bj][m][1]; } }
}
struct EpiLnStat {
    static constexpr bool PERM = true, AFTER_DRAIN = false;
    bf16_t* VB; float* ST; const bf16_t* resid; float* C1; int ldc; int mrows; float alpha;
    __device__ __forceinline__ void operator()(const f32x4 (&acc)[2][2][4][2], const Unit& u, int wr, int wc, int fr, int fq) const {
        if (u.dst) { store_chunk(acc, u, C1, ldc, wr, wc, fr, fq); return; }
        const int row0 = u.pm * BM + wr * 64 + fr, col0 = u.pn * BM + wc * 32 + 8 * fq;
#pragma unroll
        for (int ai = 0; ai < 2; ++ai)
#pragma unroll
            for (int m = 0; m < 4; ++m) { const int row = row0 + ai * HALF + m * 16; float s = 0.f, ss = 0.f;
#pragma unroll
                for (int bj = 0; bj < 2; ++bj) { const size_t off = (size_t)row * ldc + col0 + bj * HALF; const u32x4 r = *(const u32x4*)(resid + off);
                    f32x4 v0 = acc[ai][bj][m][0], v1 = acc[ai][bj][m][1];
                    v0[0] += alpha * pg_bflo(r.x); v0[1] += alpha * pg_bfhi(r.x); v0[2] += alpha * pg_bflo(r.y); v0[3] += alpha * pg_bfhi(r.y);
                    v1[0] += alpha * pg_bflo(r.z); v1[1] += alpha * pg_bfhi(r.z); v1[2] += alpha * pg_bflo(r.w); v1[3] += alpha * pg_bfhi(r.w);
                    s += ((v0[0] + v0[1]) + (v0[2] + v0[3])) + ((v1[0] + v1[1]) + (v1[2] + v1[3]));
                    ss += ((v0[0] * v0[0] + v0[1] * v0[1]) + (v0[2] * v0[2] + v0[3] * v0[3])) + ((v1[0] * v1[0] + v1[1] * v1[1]) + (v1[2] * v1[2] + v1[3] * v1[3]));
                    u32x4 w; w.x = cvt_pk_bf16(v0[0], v0[1]); w.y = cvt_pk_bf16(v0[2], v0[3]); w.z = cvt_pk_bf16(v1[0], v1[1]); w.w = cvt_pk_bf16(v1[2], v1[3]);
                    *(u32x4*)(VB + off) = w; }
                s += __shfl_xor(s, 16); s += __shfl_xor(s, 32); ss += __shfl_xor(ss, 16); ss += __shfl_xor(ss, 32);
                if (fq == 0) { float* sp = ST + (((size_t)u.pn * mrows + row) * 4 + wc) * 2; sp[0] = s; sp[1] = ss; } }
    }
};
struct EpiCombine {
    static constexpr bool PERM = true, AFTER_DRAIN = false;
    const bf16_t* h2; const bf16_t* pw; bf16_t* xb; float* outf; float* C1; int ldc;
    __device__ __forceinline__ void operator()(const f32x4 (&acc)[2][2][4][2], const Unit& u, int wr, int wc, int fr, int fq) const {
        if (u.dst) { store_chunk(acc, u, C1, ldc, wr, wc, fr, fq); return; }
        const int row0 = u.pm * BM + wr * 64 + fr, col0 = u.pn * BM + wc * 32 + 8 * fq;
#pragma unroll
        for (int ai = 0; ai < 2; ++ai)
#pragma unroll
            for (int m = 0; m < 4; ++m) { const int row = row0 + ai * HALF + m * 16;
#pragma unroll
                for (int bj = 0; bj < 2; ++bj) { const size_t off = (size_t)row * ldc + col0 + bj * HALF; const u32x4 hh = *(const u32x4*)(h2 + off), pp = *(const u32x4*)(pw + off);
                    const f32x4 a0 = acc[ai][bj][m][0], a1 = acc[ai][bj][m][1]; f32x4 o0, o1;
                    o0[0] = pg_bflo(hh.x) + pg_bflo(pp.x) / (1.f + __expf(-a0[0])); o0[1] = pg_bfhi(hh.x) + pg_bfhi(pp.x) / (1.f + __expf(-a0[1]));
                    o0[2] = pg_bflo(hh.y) + pg_bflo(pp.y) / (1.f + __expf(-a0[2])); o0[3] = pg_bfhi(hh.y) + pg_bfhi(pp.y) / (1.f + __expf(-a0[3]));
                    o1[0] = pg_bflo(hh.z) + pg_bflo(pp.z) / (1.f + __expf(-a1[0])); o1[1] = pg_bfhi(hh.z) + pg_bfhi(pp.z) / (1.f + __expf(-a1[1]));
                    o1[2] = pg_bflo(hh.w) + pg_bflo(pp.w) / (1.f + __expf(-a1[2])); o1[3] = pg_bfhi(hh.w) + pg_bfhi(pp.w) / (1.f + __expf(-a1[3]));
                    u32x4 w; w.x = cvt_pk_bf16(o0[0], o0[1]); w.y = cvt_pk_bf16(o0[2], o0[3]); w.z = cvt_pk_bf16(o1[0], o1[1]); w.w = cvt_pk_bf16(o1[2], o1[3]);
                    *(u32x4*)(xb + off) = w;
                    if (outf) { *(f32x4*)(outf + off) = o0; *(f32x4*)(outf + off + 4) = o1; } } }
    }
};
template <int ACT> struct EpiBf16 {
    static constexpr bool PERM = true, AFTER_DRAIN = false;
    bf16_t* O; int ldc; float* gates; int gate_pn;
    __device__ __forceinline__ void operator()(const f32x4 (&acc)[2][2][4][2], const Unit& u, int wr, int wc, int fr, int fq) const {
        const int row0 = u.pm * BM + wr * 64 + fr; const int col0 = u.pn * BM + wc * 32 + 8 * fq;
        const bool gt = (gates != nullptr) && (u.pn == gate_pn) && (wc == 0) && (fq < 2);
#pragma unroll
        for (int ai = 0; ai < 2; ++ai)
#pragma unroll
            for (int m = 0; m < 4; ++m) { const int row = row0 + ai * HALF + m * 16; bf16_t* rowp = O + (size_t)row * ldc + col0;
#pragma unroll
                for (int bj = 0; bj < 2; ++bj) { f32x4 v0 = acc[ai][bj][m][0], v1 = acc[ai][bj][m][1];
                    if (ACT == 1) {
#pragma unroll
                        for (int j = 0; j < 4; ++j) { const float a = fmaxf(v0[j], 0.f), b = fmaxf(v1[j], 0.f); v0[j] = a * a; v1[j] = b * b; } }
                    u32x4 w; w.x = cvt_pk_bf16(v0[0], v0[1]); w.y = cvt_pk_bf16(v0[2], v0[3]); w.z = cvt_pk_bf16(v1[0], v1[1]); w.w = cvt_pk_bf16(v1[2], v1[3]);
                    *(u32x4*)(rowp + bj * HALF) = w; }
                if (gt) { float* gp = gates + (size_t)row * 16 + 8 * fq; *(f32x4*)gp = acc[ai][0][m][0]; *(f32x4*)(gp + 4) = acc[ai][0][m][1]; } }
    }
};

template <class Epi, class Sched, bool ALIGN_EPI = false, bool SP2 = false>
__device__ __forceinline__ void gemm_phase(PG8_LAS unsigned char* lds, const Gemm g, const Sched& S, const Epi& E, const int tid) {
    const int wid = __builtin_amdgcn_readfirstlane(tid >> 6), lane = tid & 63, wr = wid >> 2, wc = wid & 3, fr = lane & 15, fq = lane >> 4;
    const int K = g.K;
    unsigned voffA[2], voffB[2];
#pragma unroll
    for (int i = 0; i < 2; ++i) { int R, C; stage_rc(tid * 16 + i * 8192, R, C); const int Rb = Epi::PERM ? ((R & ~31) + perm32(R & 31)) : R;
        voffA[i] = (unsigned)(R * K + C) * 2u; voffB[i] = (unsigned)(Rb * K + C) * 2u; }
    const size_t kstep = (size_t)(BK * 2);
    const size_t hstep = (size_t)HALF * K * 2;
    const size_t tstep = 2 * hstep;
    const unsigned ldsw = (unsigned)wid * 1024u;
    const int aoff = lds_byte(wr * 64 + fr, fq * 8), boff = lds_byte(wc * 32 + fr, fq * 8);
#define PG8_SA(b, h) (((b) * 2 + (h)) * HTB)
#define PG8_SB(b, h) ((4 + (b) * 2 + (h)) * HTB)
#define PG8_STAGE(bufoff, gbase, voff) do { _Pragma("unroll") for (int _i = 0; _i < 2; ++_i) \
        __builtin_amdgcn_global_load_lds((const unsigned*)((const char*)(gbase) + (voff)[_i]), (PG8_LAS unsigned*)(lds + (bufoff) + ldsw + _i * 8192), 16, 0, 0); } while (0)
#define PG8_LDA(dst, b, h) do { _Pragma("unroll") for (int m = 0; m < 4; ++m) _Pragma("unroll") for (int k = 0; k < 2; ++k) dst[m][k] = *(const PG8_LAS bf16x8*)(lds + PG8_SA(b, h) + aoff + m * 2048 + k * 1024); } while (0)
#define PG8_LDB(dst, b, h) do { _Pragma("unroll") for (int n = 0; n < 2; ++n) _Pragma("unroll") for (int k = 0; k < 2; ++k) dst[n][k] = *(const PG8_LAS bf16x8*)(lds + PG8_SB(b, h) + boff + n * 2048 + k * 1024); } while (0)
#define PG8_MMA(ai, bj, At, Bt) do { __builtin_amdgcn_s_setprio(1); _Pragma("unroll") for (int m = 0; m < 4; ++m) _Pragma("unroll") for (int n = 0; n < 2; ++n) _Pragma("unroll") for (int k = 0; k < 2; ++k) \
        acc[ai][bj][m][n] = __builtin_amdgcn_mfma_f32_16x16x32_bf16(Bt[n][k], At[m][k], acc[ai][bj][m][n], 0, 0, 0); __builtin_amdgcn_s_setprio(0); } while (0)
#define PG8_WAIT_V(n) asm volatile("s_waitcnt vmcnt(" #n ")" ::: "memory")
#define PG8_WAIT_L(n) asm volatile("s_waitcnt lgkmcnt(" #n ")" ::: "memory")
#define PG8_BAR __builtin_amdgcn_s_barrier()
#define PG8_SCHED __builtin_amdgcn_sched_barrier(0)
    Unit cur, nxt; int ui = 0;
    if (!S.next(0, cur)) return;
    f32x4 acc[2][2][4][2];
#pragma unroll
    for (int a = 0; a < 2; ++a)
#pragma unroll
        for (int b = 0; b < 2; ++b)
#pragma unroll
            for (int m = 0; m < 4; ++m)
#pragma unroll
                for (int n = 0; n < 2; ++n) acc[a][b][m][n] = (f32x4){0.f, 0.f, 0.f, 0.f};
    bf16x8 At[4][2], B0[2][2], B1[2][2];
    const char* cA = (const char*)g.A + (size_t)cur.pm * tstep + (size_t)cur.kt0 * kstep; const char* cB = (const char*)g.Bt + (size_t)cur.pn * tstep + (size_t)cur.kt0 * kstep;
    S.a_ready(cur);
    if constexpr (SP2) {
        PG8_STAGE(PG8_SB(0, 0), cB, voffB); PG8_STAGE(PG8_SB(0, 1), cB + hstep, voffB); PG8_STAGE(PG8_SA(0, 0), cA, voffA); PG8_STAGE(PG8_SA(0, 1), cA + hstep, voffA);
        if (wr == 1) PG8_BAR;
        PG8_WAIT_V(2); PG8_BAR;
        PG8_STAGE(PG8_SB(1, 0), cB + kstep, voffB); PG8_STAGE(PG8_SA(1, 0), cA + kstep, voffA); PG8_STAGE(PG8_SB(1, 1), cB + hstep + kstep, voffB);
        PG8_WAIT_V(6); PG8_BAR;
    } else {
        PG8_STAGE(PG8_SB(0, 0), cB, voffB); PG8_STAGE(PG8_SA(0, 0), cA, voffA); PG8_STAGE(PG8_SB(0, 1), cB + hstep, voffB); PG8_STAGE(PG8_SA(0, 1), cA + hstep, voffA);
        if (wr == 1) PG8_BAR;
        PG8_WAIT_V(4); PG8_BAR;
        PG8_STAGE(PG8_SB(1, 0), cB + kstep, voffB); PG8_STAGE(PG8_SA(1, 0), cA + kstep, voffA); PG8_STAGE(PG8_SB(1, 1), cB + hstep + kstep, voffB);
        PG8_WAIT_V(6); PG8_BAR;
    }
    for (;;) {
        const bool has_next = S.next(ui + 1, nxt);
        const char* nA = has_next ? (const char*)g.A + (size_t)nxt.pm * tstep + (size_t)nxt.kt0 * kstep : cA; const char* nB = has_next ? (const char*)g.Bt + (size_t)nxt.pn * tstep + (size_t)nxt.kt0 * kstep : cB;
        const int nt = cur.nkt;
        for (int t = 0; t < nt; t += 2) {
            const bool last = (t == nt - 2);
            const char* a1 = cA + (size_t)(t + 1) * kstep;
            const char* a2 = last ? nA : cA + (size_t)(t + 2) * kstep; const char* b2 = last ? nB : cB + (size_t)(t + 2) * kstep;
            const char* a3 = a2 + kstep; const char* b3 = b2 + kstep;
            if (last && has_next) S.a_ready(nxt);
            if constexpr (SP2) {
            PG8_LDB(B0, 0, 0); PG8_LDB(B1, 0, 1); PG8_SCHED; PG8_LDA(At, 0, 0); PG8_STAGE(PG8_SA(1, 1), a1 + hstep, voffA);
            PG8_WAIT_V(8); PG8_WAIT_L(0); PG8_BAR; PG8_MMA(0, 0, At, B0); PG8_MMA(0, 1, At, B1); PG8_BAR; PG8_SCHED;
            PG8_LDA(At, 0, 1); PG8_STAGE(PG8_SB(0, 0), b2, voffB); PG8_STAGE(PG8_SB(0, 1), b2 + hstep, voffB); PG8_STAGE(PG8_SA(0, 0), a2, voffA);
            PG8_WAIT_V(8); PG8_WAIT_L(0); PG8_BAR; PG8_MMA(1, 0, At, B0); PG8_MMA(1, 1, At, B1); PG8_BAR; PG8_SCHED;
            PG8_LDB(B0, 1, 0); PG8_LDB(B1, 1, 1); PG8_SCHED; PG8_LDA(At, 1, 0); PG8_STAGE(PG8_SA(0, 1), a2 + hstep, voffA);
            PG8_WAIT_V(8); PG8_WAIT_L(0); PG8_BAR; PG8_MMA(0, 0, At, B0); PG8_MMA(0, 1, At, B1); PG8_BAR; PG8_SCHED;
            PG8_LDA(At, 1, 1); PG8_STAGE(PG8_SB(1, 0), b3, voffB); PG8_STAGE(PG8_SB(1, 1), b3 + hstep, voffB); PG8_STAGE(PG8_SA(1, 0), a3, voffA);
            PG8_WAIT_V(8); PG8_WAIT_L(0); PG8_BAR; PG8_MMA(1, 0, At, B0); PG8_MMA(1, 1, At, B1); PG8_BAR; PG8_SCHED;
            } else {
            PG8_LDB(B0, 0, 0); PG8_SCHED; PG8_LDA(At, 0, 0); PG8_STAGE(PG8_SA(1, 1), a1 + hstep, voffA);
            PG8_WAIT_L(8); PG8_BAR; PG8_WAIT_L(0); PG8_MMA(0, 0, At, B0); PG8_BAR; PG8_SCHED;
            PG8_LDB(B1, 0, 1); PG8_STAGE(PG8_SB(0, 0), b2, voffB);
            PG8_BAR; PG8_WAIT_L(0); PG8_MMA(0, 1, At, B1); PG8_BAR;
            PG8_LDA(At, 0, 1); PG8_STAGE(PG8_SA(0, 0), a2, voffA);
            PG8_BAR; PG8_WAIT_L(0); PG8_MMA(1, 0, At, B0); PG8_BAR; PG8_SCHED;
            PG8_STAGE(PG8_SB(0, 1), b2 + hstep, voffB);
            PG8_WAIT_V(6); PG8_BAR; PG8_MMA(1, 1, At, B1); PG8_BAR;
            PG8_LDB(B0, 1, 0); PG8_SCHED; PG8_LDA(At, 1, 0); PG8_STAGE(PG8_SA(0, 1), a2 + hstep, voffA);
            PG8_WAIT_L(8); PG8_BAR; PG8_WAIT_L(0); PG8_MMA(0, 0, At, B0); PG8_BAR; PG8_SCHED;
            PG8_LDB(B1, 1, 1); PG8_STAGE(PG8_SB(1, 0), b3, voffB);
            PG8_BAR; PG8_WAIT_L(0); PG8_MMA(0, 1, At, B1); PG8_BAR;
            PG8_LDA(At, 1, 1); PG8_STAGE(PG8_SA(1, 0), a3, voffA);
            PG8_BAR; PG8_WAIT_L(0); PG8_MMA(1, 0, At, B0); PG8_BAR; PG8_SCHED;
            PG8_STAGE(PG8_SB(1, 1), b3 + hstep, voffB);
            PG8_WAIT_V(6); PG8_BAR; PG8_MMA(1, 1, At, B1); PG8_BAR;
            }
        }
        if constexpr (ALIGN_EPI) { if (wr == 0) PG8_BAR; }
        E(acc, cur, wr, wc, fr, fq); S.done(cur);
        if (!has_next) break;
#pragma unroll
        for (int a = 0; a < 2; ++a)
#pragma unroll
            for (int b = 0; b < 2; ++b)
#pragma unroll
                for (int m = 0; m < 4; ++m)
#pragma unroll
                    for (int n = 0; n < 2; ++n) acc[a][b][m][n] = (f32x4){0.f, 0.f, 0.f, 0.f};
        cur = nxt; cA = nA; cB = nB; ++ui;
        if constexpr (ALIGN_EPI) { if (wr == 1) PG8_BAR; }
    }
    PG8_WAIT_V(0);
    if constexpr (!ALIGN_EPI) { if (wr == 0) PG8_BAR; }
    PG8_BAR;
#undef PG8_SA
#undef PG8_SB
#undef PG8_STAGE
#undef PG8_LDA
#undef PG8_LDB
#undef PG8_MMA
#undef PG8_WAIT_V
#undef PG8_WAIT_L
#undef PG8_BAR
#undef PG8_SCHED
}
}

constexpr int NWAVES = 8, NTHR = 512;
constexpr int D = 2048, FF = 8192, PLE = 256;
constexpr int TP = 2048, BP = 4, TS = 4, BS = 128;
constexpr int MP = BP * TP, MS = BS * TS, M = MP + MS;
constexpr int NPROJ = 6160, NPROJ_PAD = 6400;
constexpr int NH = 8;
constexpr float LN_EPS = 1e-5f, RMS_EPS = 1e-6f;
constexpr float DN_ALPHA = 1.41421356237f;

constexpr size_t MiB = 1u << 20;
constexpr size_t WS_CTL = 0;
constexpr size_t WS_WINE = 1 * MiB;
constexpr size_t WS_WOUTE = WS_WINE + 25 * MiB;
constexpr size_t WS_WINO = WS_WOUTE + 8 * MiB;
constexpr size_t WS_WOUTO = WS_WINO + 25 * MiB;
constexpr size_t WS_WUP = WS_WOUTO + 8 * MiB;
constexpr size_t WS_WDOWN = WS_WUP + 64 * MiB;
constexpr size_t WS_WPLE = WS_WDOWN + 64 * MiB;
constexpr size_t WS_WGATE = WS_WPLE + 2 * MiB;
constexpr size_t WS_XB = WS_WGATE + 16 * MiB;
constexpr size_t WS_MIX = WS_XB + 34 * MiB;
constexpr size_t WS_H = WS_MIX + 34 * MiB;
constexpr size_t WS_H2 = WS_H + 34 * MiB;
constexpr size_t WS_PW = WS_H2 + 34 * MiB;
constexpr size_t WS_PB = WS_PW + 34 * MiB;
constexpr size_t WS_GATES = WS_PB + 9 * MiB;
constexpr size_t WS_PROJ = WS_GATES + 1 * MiB;
constexpr size_t WS_PART0 = WS_PROJ + 136 * MiB;
constexpr size_t WS_PART1 = WS_PART0 + 68 * MiB;
constexpr size_t WS_LRUW = WS_PART1 + 68 * MiB;
constexpr size_t WS_END = WS_LRUW + 1 * MiB;
constexpr size_t WS_DG = WS_PART0;
constexpr size_t WS_DB = WS_PART0 + 32 * MiB;
constexpr size_t WS_DS = WS_PART0 + 64 * MiB;
constexpr size_t WS_DQ = WS_PART0 + 96 * MiB;
constexpr size_t WS_DO = WS_PART0 + 112 * MiB;
constexpr size_t WS_DD = WS_PART0 + 128 * MiB;
constexpr size_t WS_DF = WS_PART0 + 129 * MiB;
constexpr size_t WS_MC = WS_PART0;
constexpr size_t WS_MN = WS_PART0 + 64 * MiB;
constexpr size_t WS_MM = WS_PART0 + 65 * MiB;
constexpr size_t WS_LRU_HL = WS_H;
constexpr size_t WS_LRU_P = WS_H + 16 * MiB;
constexpr size_t WS_LRU_END = WS_H + 32 * MiB;

constexpr size_t O_Y = 0;
constexpr size_t O_CONVP = (size_t)M * D;
constexpr size_t O_DELTAP = O_CONVP + (size_t)BP * 3 * 4096;
constexpr size_t O_LRUP = O_DELTAP + (size_t)BP * 8 * 128 * 128;
constexpr size_t O_MCP = O_LRUP + (size_t)BP * 1024;
constexpr size_t O_MNP = O_MCP + (size_t)BP * 8 * 256 * 128;
constexpr size_t O_MMP = O_MNP + (size_t)BP * 8 * 128;
constexpr size_t O_CONVS = O_MMP + (size_t)BP * 8;
constexpr size_t O_DELTAS = O_CONVS + (size_t)BS * 3 * 4096;
constexpr size_t O_LRUS = O_DELTAS + (size_t)BS * 8 * 128 * 128;
constexpr size_t O_MCS = O_LRUS + (size_t)BS * 1024;
constexpr size_t O_MNS = O_MCS + (size_t)BS * 8 * 256 * 128;
constexpr size_t O_MMS = O_MNS + (size_t)BS * 8 * 128;
constexpr size_t O_END = O_MMS + (size_t)BS * 8;

constexpr int LDS_BYTES = 147456;
constexpr int LDS_CTL_OFF = 131072;

#define LAS __attribute__((address_space(3)))
typedef unsigned short bf16;
typedef unsigned v4u __attribute__((ext_vector_type(4)));
typedef unsigned v2u __attribute__((ext_vector_type(2)));
typedef float f32x4 __attribute__((ext_vector_type(4)));
#define LDS_WAIT() asm volatile("s_waitcnt lgkmcnt(0)" ::: "memory")
__device__ __forceinline__ unsigned f2bf(float f) { unsigned u = __builtin_bit_cast(unsigned, f); return (u + 0x7fffu + ((u >> 16) & 1u)) >> 16; }
__device__ __forceinline__ unsigned pk2(float lo, float hi) { return f2bf(lo) | (f2bf(hi) << 16); }
__device__ __forceinline__ float bf2f(unsigned short b) { return __builtin_bit_cast(float, ((unsigned)b) << 16); }
__device__ __forceinline__ float bflo(unsigned w) { return __builtin_bit_cast(float, w << 16); }
__device__ __forceinline__ float bfhi(unsigned w) { return __builtin_bit_cast(float, w & 0xffff0000u); }
__device__ __forceinline__ float fexp(float x) { return __builtin_amdgcn_exp2f(x * 1.4426950408889634f); }
__device__ __forceinline__ float sigm(float x) { return __builtin_amdgcn_rcpf(1.f + fexp(-x)); }
__device__ __forceinline__ float siluf(float x) { return x * sigm(x); }
__device__ __forceinline__ float softplusf(float x) { return fmaxf(x, 0.f) + log1pf(expf(-fabsf(x))); }
__device__ __forceinline__ float logsigf(float x) { return -softplusf(-x); }
__device__ __forceinline__ float neg_expm1(float y) {
    const float ser = -y * (1.f + y * (0.5f + y * (0.16666667f + y * (0.041666668f + y * (0.008333334f + y * 0.0013888889f)))));
    return (y > -0.25f) ? ser : 1.f - fexp(y);
}
__device__ __forceinline__ float gelu_tanh(float x) { const float u = 0.7978845608028654f * (x + 0.044715f * x * x * x); return x * sigm(2.f * u); }
__device__ __forceinline__ float wave_sum(float v) {
#pragma unroll
    for (int o = 1; o < 64; o <<= 1) v += __shfl_xor(v, o);
    return v;
}

#define XB_TMO      128
#define XB_XCNT(j)  (256  + 64 * (j))
#define XB_XSUB(j)  (1280 + 64 * (j))
#define XB_XGEN(j)  (2304 + 64 * (j))
#define XB_TOP      3328
#define XB_TOPGEN   3392
#define XCD_BAR_WORDS 3456
#define XB_SPIN_CAP (1u << 22)
__device__ __forceinline__ unsigned xb_ld(unsigned* p)              { return __hip_atomic_load(p, __ATOMIC_RELAXED, __HIP_MEMORY_SCOPE_AGENT); }
__device__ __forceinline__ unsigned xb_add(unsigned* p, unsigned v) { return __hip_atomic_fetch_add(p, v, __ATOMIC_RELAXED, __HIP_MEMORY_SCOPE_AGENT); }
__device__ __forceinline__ unsigned xb_xcc_id() { return (unsigned)__builtin_amdgcn_s_getreg((3 << 11) | 20) & 0xFu; }
#define XB_SPIN(cond, bar) do { unsigned _sp = 0; while (cond) { __builtin_amdgcn_s_sleep(1); \
    if ((++_sp & 255u) == 0u) { if (xb_ld(&(bar)[XB_TMO])) break; if (_sp > XB_SPIN_CAP) { atomicAdd(&(bar)[XB_TMO], 1u); break; } } } } while (0)
struct XcdBarrier { unsigned* bar; unsigned x; volatile LAS unsigned* st; };
__device__ __forceinline__ XcdBarrier xcd_barrier_post(unsigned* bar, volatile LAS unsigned* st) {
    XcdBarrier b; b.bar = bar; b.x = xb_xcc_id(); b.st = st;
    if (threadIdx.x == 0) (void)xb_add(&bar[XB_XCNT(b.x)], 1u);
    return b;
}
__device__ __forceinline__ void xcd_barrier_complete(unsigned* bar, unsigned x, unsigned& nloc, unsigned& nx) {
    const unsigned G = gridDim.x * gridDim.y * gridDim.z;
    unsigned sum, cnt, mine, sp = 0u;
    for (;;) {
        sum = 0u; cnt = 0u; mine = 0u;
#pragma unroll
        for (unsigned j = 0; j < 16; ++j) { const unsigned c = xb_ld(&bar[XB_XCNT(j)]); sum += c; cnt += (c > 0u) ? 1u : 0u; mine = (j == x) ? c : mine; }
        if (sum == G) break;
        __builtin_amdgcn_s_sleep(1);
        if ((++sp & 255u) == 0u) { if (xb_ld(&bar[XB_TMO])) break; if (sp > XB_SPIN_CAP) { atomicAdd(&bar[XB_TMO], 1u); break; } }
    }
    nloc = mine > 0u ? mine : 1u; nx = cnt > 0u ? cnt : 1u;
}
__device__ __forceinline__ void xcd_barrier(const XcdBarrier& b) {
    asm volatile("s_waitcnt vmcnt(0)" ::: "memory");
    __syncthreads();
    if (threadIdx.x == 0) {
        unsigned* bar = b.bar;
        __builtin_amdgcn_s_waitcnt(0);
        unsigned nloc = b.st[0], nx = b.st[1];
        if (nloc == 0u) { xcd_barrier_complete(bar, b.x, nloc, nx); b.st[0] = nloc; b.st[1] = nx; }
        const unsigned old = xb_add(&bar[XB_XSUB(b.x)], 1u);
        const unsigned gen = old / nloc;
        if (old + 1u == (gen + 1u) * nloc) {
            __builtin_amdgcn_fence(__ATOMIC_RELEASE, "agent");
            asm volatile("s_waitcnt vmcnt(0)" ::: "memory");
            const unsigned og = xb_add(&bar[XB_TOP], 1u);
            const unsigned tg = og / nx;
            if (og + 1u == (tg + 1u) * nx) xb_add(&bar[XB_TOPGEN], 1u);
            else XB_SPIN(xb_ld(&bar[XB_TOPGEN]) == tg, bar);
            __builtin_amdgcn_fence(__ATOMIC_ACQUIRE, "agent");
            xb_add(&bar[XB_XGEN(b.x)], 1u);
            asm volatile("s_waitcnt vmcnt(0)" ::: "memory");
        } else {
            XB_SPIN(xb_ld(&bar[XB_XGEN(b.x)]) == gen, bar);
            __builtin_amdgcn_fence(__ATOMIC_ACQUIRE, "agent");
            asm volatile("s_waitcnt vmcnt(0)" ::: "memory");
        }
    }
    __syncthreads();
}

struct Args { const float* in[35]; float* out; unsigned char* ws; int ph_lo, ph_hi; };
typedef const __attribute__((address_space(4))) Args* ArgsP;
enum { I_XP = 0, I_XS, I_PP, I_PS, I_SCONV, I_SDELTA, I_SLRU, I_SMC, I_SMN, I_SMM, I_WINE, I_WCONV, I_BCONV, I_ALOG, I_DTB, I_DNORM, I_LWR, I_LBR, I_LWI, I_LBI, I_LLAM, I_WOUTE,
       I_WINO, I_BIG, I_BFG, I_MNORM, I_WOUTO, I_LN1G, I_LN1B, I_LN2G, I_LN2B, I_WUP, I_WDOWN, I_WPLE, I_WGATE };

struct TDesc { const float* W; bf16* WT; int K, N, Npad, item; };
__device__ __forceinline__ void t_load(const TDesc& d, int lane, f32x4 (&v)[8]) {
    const int nblk = d.Npad / 32, kb = d.item / nblk, nb = d.item % nblk, k0 = 64 * kb, n0 = 32 * nb;
    const int r = lane >> 3, c4 = lane & 7; const bool ok = (n0 + 4 * c4) < d.N;
#pragma unroll
    for (int i = 0; i < 8; ++i) v[i] = ok ? __builtin_nontemporal_load((const f32x4*)(d.W + (size_t)(k0 + 8 * i + r) * d.N + n0 + 4 * c4)) : (f32x4){0.f, 0.f, 0.f, 0.f};
}
__device__ __forceinline__ void t_finish(const TDesc& d, LAS float* scr, int lane, const f32x4 (&v)[8]) {
    const int nblk = d.Npad / 32, kb = d.item / nblk, nb = d.item % nblk, k0 = 64 * kb, n0 = 32 * nb;
    const int r = lane >> 3, c4 = lane & 7;
#pragma unroll
    for (int i = 0; i < 8; ++i) { LAS float* q = scr + (8 * i + r) * 33 + 4 * c4; q[0] = v[i].x; q[1] = v[i].y; q[2] = v[i].z; q[3] = v[i].w; }
    LDS_WAIT(); asm volatile("" ::: "memory");
    const int c = lane & 7;
#pragma unroll
    for (int j = 0; j < 4; ++j) { const int n = (lane >> 3) + 8 * j; const LAS float* s = scr + (8 * c) * 33 + n;
        v4u o; o.x = pk2(s[0 * 33], s[1 * 33]); o.y = pk2(s[2 * 33], s[3 * 33]); o.z = pk2(s[4 * 33], s[5 * 33]); o.w = pk2(s[6 * 33], s[7 * 33]);
        *(v4u*)(d.WT + (size_t)(n0 + n) * d.K + k0 + 8 * c) = o; }
    LDS_WAIT(); asm volatile("" ::: "memory");
}
__device__ __forceinline__ void p0_transpose_item(const float* W, int K, int N, int Npad, bf16* WT, LAS float* scr, int item, int lane) {
    const TDesc d{W, WT, K, N, Npad, item}; f32x4 v[8]; t_load(d, lane, v); t_finish(d, scr, lane, v);
}
__device__ __forceinline__ void row_to_bf16(const float* src, bf16* dst, int n, int lane) {
    for (int j = 0; j < n / 256; ++j) { const f32x4 v = *(const f32x4*)(src + j * 256 + lane * 4); v2u o; o.x = pk2(v.x, v.y); o.y = pk2(v.z, v.w); *(v2u*)(dst + j * 256 + lane * 4) = o; }
}

namespace cv { constexpr int I_IN = (D / 64) * (NPROJ_PAD / 32), I_SQ = (D / 64) * (D / 32), I_UP = (D / 64) * (FF / 32), I_DN = (FF / 64) * (D / 32), I_PL = (PLE / 64) * (D / 32);
               constexpr int N_FIRST = I_IN + 128, N_REST = I_IN + 2 * I_SQ + 2 * I_UP + 2 * I_DN + 2 * I_PL + 2 * I_SQ; }
__device__ __forceinline__ void convert_first_item(ArgsP a, LAS float* scr, int r, int lane) {
    unsigned char* ws = a->ws;
    if (r < cv::I_IN) { p0_transpose_item(a->in[I_WINE], D, NPROJ, NPROJ_PAD, (bf16*)(ws + WS_WINE), scr, r, lane); return; } r -= cv::I_IN;
    { const int mat = r / 64, blk = (r / 8) & 7; p0_transpose_item(a->in[mat == 0 ? I_LWR : I_LWI] + (size_t)blk * 16384, 128, 128, 128, (bf16*)(ws + WS_LRUW) + (size_t)(mat * 8 + blk) * 16384, scr, r % 8, lane); }
}
__device__ __forceinline__ TDesc decode_rest(ArgsP a, int r) {
    using namespace cv; unsigned char* ws = a->ws;
    if (r < I_SQ) return TDesc{a->in[I_WOUTE], (bf16*)(ws + WS_WOUTE), D, D, D, r}; r -= I_SQ;
    if (r < I_UP) return TDesc{a->in[I_WUP], (bf16*)(ws + WS_WUP), D, FF, FF, r}; r -= I_UP;
    if (r < I_DN) return TDesc{a->in[I_WDOWN], (bf16*)(ws + WS_WDOWN), FF, D, D, r}; r -= I_DN;
    if (r < I_PL) return TDesc{a->in[I_WPLE], (bf16*)(ws + WS_WPLE), PLE, D, D, r}; r -= I_PL;
    if (r < I_SQ) return TDesc{a->in[I_WGATE], (bf16*)(ws + WS_WGATE), D, D, D, r}; r -= I_SQ;
    if (r < I_IN) return TDesc{a->in[I_WINO], (bf16*)(ws + WS_WINO), D, NPROJ, NPROJ_PAD, r}; r -= I_IN;
    if (r < I_SQ) return TDesc{a->in[I_WOUTO], (bf16*)(ws + WS_WOUTO), D, D, D, r}; r -= I_SQ;
    if (r < I_UP) return TDesc{a->in[I_WUP] + (size_t)D * FF, (bf16*)(ws + WS_WUP) + (size_t)D * FF, D, FF, FF, r}; r -= I_UP;
    if (r < I_DN) return TDesc{a->in[I_WDOWN] + (size_t)D * FF, (bf16*)(ws + WS_WDOWN) + (size_t)D * FF, FF, D, D, r}; r -= I_DN;
    if (r < I_PL) return TDesc{a->in[I_WPLE] + (size_t)PLE * D, (bf16*)(ws + WS_WPLE) + (size_t)PLE * D, PLE, D, D, r}; r -= I_PL;
    return TDesc{a->in[I_WGATE] + (size_t)D * D, (bf16*)(ws + WS_WGATE) + (size_t)D * D, D, D, D, r};
}
__device__ __forceinline__ void phase_convert(ArgsP a, LAS unsigned char* lds, int gw, int NGW, int wave, int lane) {
    unsigned char* ws = a->ws;
    LAS float* scr = (LAS float*)(lds + wave * 16384);
    for (int it = gw; it < cv::N_FIRST; it += NGW) convert_first_item(a, scr, it, lane);
    bf16* xb = (bf16*)(ws + WS_XB);
    for (int m = gw; m < M; m += NGW) {
        const float* src = m < MP ? a->in[I_XP] + (size_t)m * D : a->in[I_XS] + (size_t)(m - MP) * D;
        row_to_bf16(src, xb + (size_t)m * D, D, lane);
    }
    bf16* pb = (bf16*)(ws + WS_PB);
    for (int r = gw; r < 2 * M; r += NGW) {
        const int l = r / M, m = r % M;
        const float* src = m < MP ? a->in[I_PP] + ((size_t)l * MP + m) * PLE : a->in[I_PS] + ((size_t)l * MS + (m - MP)) * PLE;
        row_to_bf16(src, pb + (size_t)r * PLE, PLE, lane);
    }
}

__device__ __forceinline__ float conv_in(const bf16* proj, int row0, int tq, int ch, const float* cstate) {
    if (tq >= 0) return bf2f(proj[(size_t)(row0 + tq) * NPROJ_PAD + ch]);
    return cstate ? cstate[(3 + tq) * 4096 + ch] : 0.f;
}
__device__ __forceinline__ float conv4(const bf16* proj, int row0, int t, int ch, const float* cstate, const float* wconv, const float* bconv) {
    float acc = bconv[ch];
#pragma unroll
    for (int j = 0; j < 4; ++j) acc += wconv[j * 4096 + ch] * conv_in(proj, row0, t - 3 + j, ch, cstate);
    return acc;
}

__device__ __forceinline__ void delta_rec_item(ArgsP a, LAS unsigned char* lds, int row0, int T, int h, const float* cstate, const float* S0, float* Sout, const int tid) {
    const int lane = tid & 63, wave = tid >> 6, c = tid & 127, r = tid >> 7;
    const bf16* proj = (const bf16*)(a->ws + WS_PROJ); const float* gates = (const float*)(a->ws + WS_GATES); bf16* mix = (bf16*)(a->ws + WS_MIX);
    const float* wconv = a->in[I_WCONV]; const float* bconv = a->in[I_BCONV];
    LAS float* act = (LAS float*)lds;
    LAS float* nrm = act + 4 * 384;
    LAS float* gb = nrm + 8;
    LAS float* red = gb + 8;
    LAS float* red2 = red + 512;
    LAS float* obuf = red2 + 512;
    float s[32];
#pragma unroll
    for (int i = 0; i < 32; ++i) s[i] = S0 ? S0[(size_t)(32 * r + i) * 128 + c] : 0.f;
    const float aexp = fexp(a->in[I_ALOG][h]), dtb = a->in[I_DTB][h];
#pragma unroll 1
    for (int t0 = 0; t0 < T; t0 += 4) {
#pragma unroll
        for (int j = 0; j < 3; ++j) { const int idx = tid + 512 * j, tok = idx / 384, chl = idx % 384, part = chl >> 7, i = chl & 127;
            const int ch = part * 1024 + h * 128 + i;
            act[tok * 384 + chl] = siluf(conv4(proj, row0, t0 + tok, ch, cstate, wconv, bconv)); }
        __syncthreads();
        { const int tok = wave >> 1, part = wave & 1; const float x0 = act[tok * 384 + part * 128 + lane], x1 = act[tok * 384 + part * 128 + 64 + lane];
          const float ss = wave_sum(x0 * x0 + x1 * x1); if (lane == 0) nrm[tok * 2 + part] = rsqrtf(ss + 1e-6f) * (part == 0 ? 0.08838834764831845f : 1.f); }
        if (tid < 4) { const int row = row0 + t0 + tid; const float g = -aexp * softplusf(gates[(size_t)row * 16 + h] + dtb); gb[tid * 2] = fexp(g); gb[tid * 2 + 1] = sigm(gates[(size_t)row * 16 + 8 + h]); }
        __syncthreads();
#pragma unroll 1
        for (int tok = 0; tok < 4; ++tok) {
            const float eg = gb[tok * 2], beta = gb[tok * 2 + 1], nq = nrm[tok * 2], nk = nrm[tok * 2 + 1];
            const LAS float* qv = act + tok * 384 + 32 * r; const LAS float* kv = qv + 128;
            float ks = 0.f;
#pragma unroll
            for (int i = 0; i < 32; ++i) ks += kv[i] * s[i];
            red[r * 128 + c] = ks * nk;
            __syncthreads();
            const float kS = red[c] + red[128 + c] + red[256 + c] + red[384 + c];
            const float vnew = beta * (act[tok * 384 + 256 + c] - eg * kS);
            float os = 0.f;
#pragma unroll
            for (int i = 0; i < 32; ++i) { s[i] = eg * s[i] + (kv[i] * nk) * vnew; os += qv[i] * s[i]; }
            red2[r * 128 + c] = os * nq;
            __syncthreads();
            if (r == 0) obuf[tok * 128 + c] = red2[c] + red2[128 + c] + red2[256 + c] + red2[384 + c];
        }
        __syncthreads();
        if (wave < 4) { const int tok = wave, row = row0 + t0 + tok; const float o0 = obuf[tok * 128 + lane], o1 = obuf[tok * 128 + 64 + lane];
            const float rstd = rsqrtf(wave_sum(o0 * o0 + o1 * o1) * (1.f / 128.f) + RMS_EPS);
            const float* nw = a->in[I_DNORM];
            const float z0 = bf2f(proj[(size_t)row * NPROJ_PAD + 4096 + h * 128 + lane]), z1 = bf2f(proj[(size_t)row * NPROJ_PAD + 4096 + h * 128 + 64 + lane]);
            mix[(size_t)row * D + h * 128 + lane] = (bf16)f2bf(o0 * rstd * nw[lane] * siluf(z0));
            mix[(size_t)row * D + h * 128 + 64 + lane] = (bf16)f2bf(o1 * rstd * nw[64 + lane] * siluf(z1)); }
        __syncthreads();
    }
#pragma unroll
    for (int i = 0; i < 32; ++i) Sout[(size_t)(32 * r + i) * 128 + c] = s[i];
}

__device__ __forceinline__ void lru_rec_item(ArgsP a, LAS unsigned char* lds, int row0, int T, int n, const float* cstate, const float* h0, float* hout, const int tid) {
    const int d = tid & 127, part = tid >> 7;
    const bf16* proj = (const bf16*)(a->ws + WS_PROJ); bf16* mix = (bf16*)(a->ws + WS_MIX);
    const float* wconv = a->in[I_WCONV]; const float* bconv = a->in[I_BCONV];
    const float* wr = a->in[I_LWR] + (size_t)n * 16384; const float* wi = a->in[I_LWI] + (size_t)n * 16384;
    LAS float* xr = (LAS float*)lds;
    LAS float* red = xr + 512;
    const int chn = n * 128 + d;
    float hst = h0 ? h0[chn] : 0.f;
    const float br = a->in[I_LBR][chn], bi = a->in[I_LBI][chn], spl = softplusf(-a->in[I_LLAM][chn]);
#pragma unroll 1
    for (int t0 = 0; t0 < T; t0 += 4) {
        { const int tok = tid >> 7; xr[tok * 128 + d] = conv4(proj, row0, t0 + tok, 3072 + chn, cstate, wconv, bconv); }
        __syncthreads();
        float ar[4] = {0.f, 0.f, 0.f, 0.f}, ai[4] = {0.f, 0.f, 0.f, 0.f};
#pragma unroll 4
        for (int cc = 0; cc < 32; ++cc) { const int c = part * 32 + cc; const float w1 = wr[c * 128 + d], w2 = wi[c * 128 + d];
#pragma unroll
        for (int tok = 0; tok < 4; ++tok) { const float x = xr[tok * 128 + c]; ar[tok] += x * w1; ai[tok] += x * w2; } }
#pragma unroll
        for (int tok = 0; tok < 4; ++tok) { red[((tok * 2 + 0) * 4 + part) * 128 + d] = ar[tok]; red[((tok * 2 + 1) * 4 + part) * 128 + d] = ai[tok]; }
        __syncthreads();
        if (part == 0) {
    #pragma unroll 1
        for (int tok = 0; tok < 4; ++tok) {
                const int row = row0 + t0 + tok;
                float rp = br, ip = bi;
#pragma unroll
                for (int p = 0; p < 4; ++p) { rp += red[((tok * 2 + 0) * 4 + p) * 128 + d]; ip += red[((tok * 2 + 1) * 4 + p) * 128 + d]; }
                const float log_a = -8.f * sigm(rp) * spl;
                const float av = fexp(log_a);
                const float bx = sqrtf(neg_expm1(2.f * log_a)) * sigm(ip) * xr[tok * 128 + d];
                hst = av * hst + bx;
                const float gate = bf2f(proj[(size_t)row * NPROJ_PAD + 5120 + chn]);
                mix[(size_t)row * D + 1024 + chn] = (bf16)f2bf(hst * gelu_tanh(gate));
            }
        }
        __syncthreads();
    }
    if (part == 0) hout[chn] = hst;
}

__device__ __forceinline__ void mlstm_rec_item(ArgsP a, LAS unsigned char* lds, int row0, int T, int h, const float* C0, const float* n0, const float* m0, float* Cout, float* nout, float* mout, const int tid) {
    const int lane = tid & 63, wave = tid >> 6, v = tid & 255, kh = tid >> 8;
    const bf16* proj = (const bf16*)(a->ws + WS_PROJ); const float* gates = (const float*)(a->ws + WS_GATES); bf16* mix = (bf16*)(a->ws + WS_MIX);
    LAS float* qs = (LAS float*)lds;
    LAS float* ks = qs + 512;
    LAS float* vs = ks + 512;
    LAS float* gs = vs + 1024;
    LAS float* red = gs + 8;
    LAS float* dred = red + 1024;
    LAS float* hbuf = dred + 4;
    float cst[64];
#pragma unroll
    for (int i = 0; i < 64; ++i) cst[i] = C0 ? C0[(size_t)v * 128 + 64 * kh + i] : 0.f;
    float nst = (tid < 128) ? (n0 ? n0[tid] : 0.f) : 0.f;
    float mst = m0 ? m0[0] : 0.f;
    const float big = a->in[I_BIG][h], bfg = a->in[I_BFG][h];
#pragma unroll 1
    for (int t0 = 0; t0 < T; t0 += 4) {
#pragma unroll
        for (int j = 0; j < 4; ++j) { const int tok = j, row = row0 + t0 + tok; const bf16* pr = proj + (size_t)row * NPROJ_PAD;
            float val;
            if (tid < 128) val = bf2f(pr[h * 128 + tid]); else if (tid < 256) val = bf2f(pr[1024 + h * 128 + (tid - 128)]) * 0.08838834764831845f; else val = bf2f(pr[2048 + h * 256 + (tid - 256)]);
            if (tid < 128) qs[tok * 128 + tid] = val; else if (tid < 256) ks[tok * 128 + tid - 128] = val; else vs[tok * 256 + tid - 256] = val; }
        if (tid < 4) { const int row = row0 + t0 + tid; gs[tid * 2] = gates[(size_t)row * 16 + h] + big; gs[tid * 2 + 1] = gates[(size_t)row * 16 + 8 + h] + bfg; }
        __syncthreads();
#pragma unroll 1
        for (int tok = 0; tok < 4; ++tok) {
            const int par = tok & 1;
            const float ig = gs[tok * 2], lf = logsigf(gs[tok * 2 + 1]);
            const float mnew = fmaxf(lf + mst, ig), fp = fexp(lf + mst - mnew), ip = fexp(ig - mnew); mst = mnew;
            const float vv = vs[tok * 256 + v] * ip;
            const LAS float* kv = ks + tok * 128 + 64 * kh; const LAS float* qv = qs + tok * 128 + 64 * kh;
            float num = 0.f;
#pragma unroll
            for (int i = 0; i < 64; ++i) { cst[i] = fp * cst[i] + vv * kv[i]; num += cst[i] * qv[i]; }
            red[(par * 2 + kh) * 256 + v] = num;
            if (tid < 128) { nst = fp * nst + ip * ks[tok * 128 + tid]; const float dp = wave_sum(nst * qs[tok * 128 + tid]); if (lane == 0) dred[par * 2 + wave] = dp; }
            __syncthreads();
            if (kh == 0) { const float nm = red[(par * 2) * 256 + v] + red[(par * 2 + 1) * 256 + v]; const float den = dred[par * 2] + dred[par * 2 + 1];
                hbuf[tok * 256 + v] = nm / fmaxf(fabsf(den), fexp(-mnew)); }
        }
        __syncthreads();
        if (wave < 4) { const int tok = wave, row = row0 + t0 + tok; float hv[4]; float ss = 0.f;
#pragma unroll
            for (int j = 0; j < 4; ++j) { hv[j] = hbuf[tok * 256 + j * 64 + lane]; ss += hv[j] * hv[j]; }
            const float rstd = rsqrtf(wave_sum(ss) * (1.f / 256.f) + RMS_EPS);
            const float* nw = a->in[I_MNORM] + h * 256;
#pragma unroll
            for (int j = 0; j < 4; ++j) { const int vi = j * 64 + lane; const float op = bf2f(proj[(size_t)row * NPROJ_PAD + 4096 + h * 256 + vi]);
                mix[(size_t)row * D + h * 256 + vi] = (bf16)f2bf(hv[j] * rstd * nw[vi] * sigm(op)); } }
        __syncthreads();
    }
#pragma unroll
    for (int i = 0; i < 64; ++i) Cout[(size_t)v * 128 + 64 * kh + i] = cst[i];
    if (tid < 128) nout[tid] = nst;
    if (tid == 0) mout[0] = mst;
}


typedef short bf16x8 __attribute__((ext_vector_type(8)));
#define MFMA32(a_, b_, c_) __builtin_amdgcn_mfma_f32_16x16x32_bf16(a_, b_, c_, 0, 0, 0)

__device__ __forceinline__ void lru_prep_item(ArgsP a, LAS unsigned char* lds, int item, const int tid) {
    const int c = item & 31, n = (item >> 5) & 7, b = item >> 8;
    const int lane = tid & 63, w = __builtin_amdgcn_readfirstlane(tid >> 6), fr = lane & 15, fq = lane >> 4;
    unsigned char* ws = a->ws;
    const bf16* proj = (const bf16*)(ws + WS_PROJ);
    LAS bf16* xa = (LAS bf16*)lds;
    LAS float* xf = (LAS float*)(lds + 17408);
    LAS float* obH = (LAS float*)(lds + 51200);
    LAS float* obP = obH + 64 * 132;
    {
        const int t = tid >> 3, sub = tid & 7, ch0 = 3072 + n * 128 + sub * 16;
        const float* wconv = a->in[I_WCONV]; const float* bconv = a->in[I_BCONV];
        float x[16];
#pragma unroll
        for (int i = 0; i < 4; ++i) { const f32x4 bb = *(const f32x4*)(bconv + ch0 + 4 * i); x[4 * i] = bb.x; x[4 * i + 1] = bb.y; x[4 * i + 2] = bb.z; x[4 * i + 3] = bb.w; }
#pragma unroll
        for (int j = 0; j < 4; ++j) { const int tt = 64 * c + t - 3 + j;
            if (tt >= 0) { const bf16* pr = proj + (size_t)(b * TP + tt) * NPROJ_PAD + ch0; const v4u u0 = *(const v4u*)pr, u1 = *(const v4u*)(pr + 8);
                const unsigned uu[8] = {u0.x, u0.y, u0.z, u0.w, u1.x, u1.y, u1.z, u1.w};
#pragma unroll
                for (int i = 0; i < 4; ++i) { const f32x4 ww = *(const f32x4*)(wconv + j * 4096 + ch0 + 4 * i);
                    x[4 * i] += ww.x * bflo(uu[2 * i]); x[4 * i + 1] += ww.y * bfhi(uu[2 * i]); x[4 * i + 2] += ww.z * bflo(uu[2 * i + 1]); x[4 * i + 3] += ww.w * bfhi(uu[2 * i + 1]); } } }
        v4u o0, o1; o0.x = pk2(x[0], x[1]); o0.y = pk2(x[2], x[3]); o0.z = pk2(x[4], x[5]); o0.w = pk2(x[6], x[7]); o1.x = pk2(x[8], x[9]); o1.y = pk2(x[10], x[11]); o1.z = pk2(x[12], x[13]); o1.w = pk2(x[14], x[15]);
        *(LAS v4u*)(xa + t * 136 + sub * 16) = o0; *(LAS v4u*)(xa + t * 136 + sub * 16 + 8) = o1;
#pragma unroll
        for (int i = 0; i < 4; ++i) *(LAS f32x4*)(xf + t * 132 + sub * 16 + 4 * i) = (f32x4){x[4 * i], x[4 * i + 1], x[4 * i + 2], x[4 * i + 3]};
    }
    __syncthreads();
    const bf16* wrT = (const bf16*)(ws + WS_LRUW) + (size_t)n * 16384; const bf16* wiT = wrT + 8 * 16384;
    bf16x8 br[4], bi[4];
#pragma unroll
    for (int ks = 0; ks < 4; ++ks) { br[ks] = *(const bf16x8*)(wrT + (16 * w + fr) * 128 + 32 * ks + 8 * fq); bi[ks] = *(const bf16x8*)(wiT + (16 * w + fr) * 128 + 32 * ks + 8 * fq); }
    f32x4 accr[4], acci[4];
#pragma unroll
    for (int tb = 0; tb < 4; ++tb) { accr[tb] = (f32x4){0.f, 0.f, 0.f, 0.f}; acci[tb] = (f32x4){0.f, 0.f, 0.f, 0.f};
#pragma unroll
        for (int ks = 0; ks < 4; ++ks) { const bf16x8 af = *(const LAS bf16x8*)(xa + (16 * tb + fr) * 136 + 32 * ks + 8 * fq); accr[tb] = MFMA32(af, br[ks], accr[tb]); acci[tb] = MFMA32(af, bi[ks], acci[tb]); } }
    const int dl = 16 * w + fr, chn = n * 128 + dl;
    const float brs = a->in[I_LBR][chn], bis = a->in[I_LBI][chn], spl = softplusf(-a->in[I_LLAM][chn]);
    float Apre = 1.f, Hpre = 0.f;
#pragma unroll
    for (int tb = 0; tb < 4; ++tb) {
        float P[4], Hh[4];
#pragma unroll
        for (int j = 0; j < 4; ++j) { const int t = 16 * tb + 4 * fq + j;
            const float log_a = -8.f * sigm(accr[tb][j] + brs) * spl; const float av = fexp(log_a);
            const float bx = sqrtf(neg_expm1(2.f * log_a)) * sigm(acci[tb][j] + bis) * xf[t * 132 + dl];
            if (j == 0) { P[0] = av; Hh[0] = bx; } else { P[j] = P[j - 1] * av; Hh[j] = av * Hh[j - 1] + bx; } }
        float Ai = P[3], Hi = Hh[3];
        { const float A2 = __shfl_up(Ai, 16), H2 = __shfl_up(Hi, 16); if (fq >= 1) { Hi = Ai * H2 + Hi; Ai = A2 * Ai; } }
        { const float A2 = __shfl_up(Ai, 32), H2 = __shfl_up(Hi, 32); if (fq >= 2) { Hi = Ai * H2 + Hi; Ai = A2 * Ai; } }
        float Aex = __shfl_up(Ai, 16), Hex = __shfl_up(Hi, 16); if (fq == 0) { Aex = 1.f; Hex = 0.f; }
        const float Atb = __shfl(Ai, 48 + fr), Htb = __shfl(Hi, 48 + fr);
        const float EA = Apre * Aex, EH = Aex * Hpre + Hex;
#pragma unroll
        for (int j = 0; j < 4; ++j) { const int t = 16 * tb + 4 * fq + j; obP[t * 132 + dl] = EA * P[j]; obH[t * 132 + dl] = P[j] * EH + Hh[j]; }
        Hpre = Atb * Hpre + Htb; Apre = Apre * Atb;
    }
    if (fq == 0) { float* e = (float*)(ws + WS_LRU_END) + (size_t)item * 256; e[dl] = Apre; e[128 + dl] = Hpre; }
    __syncthreads();
    {
        const int t = tid >> 3, sub = tid & 7;
        bf16* hl = (bf16*)(ws + WS_LRU_HL) + ((size_t)item * 64 + t) * 128 + sub * 16; bf16* pp = (bf16*)(ws + WS_LRU_P) + ((size_t)item * 64 + t) * 128 + sub * 16;
        const LAS float* sh = obH + t * 132 + sub * 16; const LAS float* sp = obP + t * 132 + sub * 16;
        v4u o0, o1;
        o0.x = pk2(sh[0], sh[1]); o0.y = pk2(sh[2], sh[3]); o0.z = pk2(sh[4], sh[5]); o0.w = pk2(sh[6], sh[7]); o1.x = pk2(sh[8], sh[9]); o1.y = pk2(sh[10], sh[11]); o1.z = pk2(sh[12], sh[13]); o1.w = pk2(sh[14], sh[15]);
        *(v4u*)hl = o0; *(v4u*)(hl + 8) = o1;
        o0.x = pk2(sp[0], sp[1]); o0.y = pk2(sp[2], sp[3]); o0.z = pk2(sp[4], sp[5]); o0.w = pk2(sp[6], sp[7]); o1.x = pk2(sp[8], sp[9]); o1.y = pk2(sp[10], sp[11]); o1.z = pk2(sp[12], sp[13]); o1.w = pk2(sp[14], sp[15]);
        *(v4u*)pp = o0; *(v4u*)(pp + 8) = o1;
    }
    __syncthreads();
}
__device__ __forceinline__ void lru_out_item(ArgsP a, LAS unsigned char* lds, int item, const int tid) {
    const int c = item & 31, n = (item >> 5) & 7, b = item >> 8;
    unsigned char* ws = a->ws;
    LAS float* carry = (LAS float*)lds;
    if (tid < 128) { float cr = 0.f; const float* e = (const float*)(ws + WS_LRU_END) + (size_t)(item - c) * 256;
        for (int k = 0; k < c; ++k) cr = e[k * 256 + 128 + tid] + e[k * 256 + tid] * cr;
        carry[tid] = cr; }
    __syncthreads();
    const int t = tid >> 3, sub = tid & 7, d0 = sub * 16, row = b * TP + 64 * c + t;
    const bf16* hl = (const bf16*)(ws + WS_LRU_HL) + ((size_t)item * 64 + t) * 128 + d0; const bf16* pp = (const bf16*)(ws + WS_LRU_P) + ((size_t)item * 64 + t) * 128 + d0;
    const bf16* gp = (const bf16*)(ws + WS_PROJ) + (size_t)row * NPROJ_PAD + 5120 + n * 128 + d0;
    const v4u h0 = *(const v4u*)hl, h1 = *(const v4u*)(hl + 8), p0 = *(const v4u*)pp, p1 = *(const v4u*)(pp + 8), g0 = *(const v4u*)gp, g1 = *(const v4u*)(gp + 8);
    const unsigned hu[8] = {h0.x, h0.y, h0.z, h0.w, h1.x, h1.y, h1.z, h1.w}, pu[8] = {p0.x, p0.y, p0.z, p0.w, p1.x, p1.y, p1.z, p1.w}, gu[8] = {g0.x, g0.y, g0.z, g0.w, g1.x, g1.y, g1.z, g1.w};
    float hv[16]; unsigned ou[8];
#pragma unroll
    for (int i = 0; i < 8; ++i) { hv[2 * i] = bflo(hu[i]) + bflo(pu[i]) * carry[d0 + 2 * i]; hv[2 * i + 1] = bfhi(hu[i]) + bfhi(pu[i]) * carry[d0 + 2 * i + 1];
        ou[i] = pk2(hv[2 * i] * gelu_tanh(bflo(gu[i])), hv[2 * i + 1] * gelu_tanh(bfhi(gu[i]))); }
    bf16* mp = (bf16*)(ws + WS_MIX) + (size_t)row * D + 1024 + n * 128 + d0;
    *(v4u*)mp = (v4u){ou[0], ou[1], ou[2], ou[3]}; *(v4u*)(mp + 8) = (v4u){ou[4], ou[5], ou[6], ou[7]};
    if (c == 31 && t == 63) { float* o = a->out + O_LRUP + (size_t)b * 1024 + n * 128 + d0;
#pragma unroll
        for (int i = 0; i < 4; ++i) *(f32x4*)(o + 4 * i) = (f32x4){hv[4 * i], hv[4 * i + 1], hv[4 * i + 2], hv[4 * i + 3]}; }
    __syncthreads();
}


__device__ __forceinline__ void conv16_prompt(const bf16* proj, const float* wconv, const float* bconv, int b, int tseq, int ch0, float (&x)[16]) {
#pragma unroll
    for (int i = 0; i < 4; ++i) { const f32x4 bb = *(const f32x4*)(bconv + ch0 + 4 * i); x[4 * i] = bb.x; x[4 * i + 1] = bb.y; x[4 * i + 2] = bb.z; x[4 * i + 3] = bb.w; }
#pragma unroll
    for (int j = 0; j < 4; ++j) { const int tt = tseq - 3 + j;
        if (tt >= 0) { const bf16* pr = proj + (size_t)(b * TP + tt) * NPROJ_PAD + ch0; const v4u u0 = *(const v4u*)pr, u1 = *(const v4u*)(pr + 8);
            const unsigned uu[8] = {u0.x, u0.y, u0.z, u0.w, u1.x, u1.y, u1.z, u1.w};
#pragma unroll
            for (int i = 0; i < 4; ++i) { const f32x4 ww = *(const f32x4*)(wconv + j * 4096 + ch0 + 4 * i);
                x[4 * i] += ww.x * bflo(uu[2 * i]); x[4 * i + 1] += ww.y * bfhi(uu[2 * i]); x[4 * i + 2] += ww.z * bflo(uu[2 * i + 1]); x[4 * i + 3] += ww.w * bfhi(uu[2 * i + 1]); } } }
}
__device__ __forceinline__ void st16_bf16(LAS bf16* p, const float (&x)[16]) {
    v4u o0, o1; o0.x = pk2(x[0], x[1]); o0.y = pk2(x[2], x[3]); o0.z = pk2(x[4], x[5]); o0.w = pk2(x[6], x[7]); o1.x = pk2(x[8], x[9]); o1.y = pk2(x[10], x[11]); o1.z = pk2(x[12], x[13]); o1.w = pk2(x[14], x[15]);
    *(LAS v4u*)p = o0; *(LAS v4u*)(p + 8) = o1;
}
__device__ __forceinline__ v2u pack4(const f32x4 v) { v2u o; o.x = pk2(v.x, v.y); o.y = pk2(v.z, v.w); return o; }
__device__ __forceinline__ bf16x8 zero8() { return (bf16x8){0, 0, 0, 0, 0, 0, 0, 0}; }

__device__ __forceinline__ void delta_prep_item(ArgsP a, LAS unsigned char* lds, int item, const int tid) {
    const int c = item & 31, h = (item >> 5) & 7, b = item >> 8;
    const int lane = tid & 63, w = __builtin_amdgcn_readfirstlane(tid >> 6), fr = lane & 15, fq = lane >> 4;
    unsigned char* ws = a->ws;
    const bf16* proj = (const bf16*)(ws + WS_PROJ);
    LAS bf16* Kn = (LAS bf16*)lds;
    LAS bf16* Qn = (LAS bf16*)(lds + 17408);
    LAS bf16* KdT = (LAS bf16*)(lds + 34816);
    LAS bf16* RX = (LAS bf16*)(lds + 53248);
    LAS bf16* Mm = (LAS bf16*)(lds + 90112);
    LAS bf16* QKd = (LAS bf16*)(lds + 99328);
    LAS bf16* Td = (LAS bf16*)(lds + 108544);
    LAS bf16* RT = (LAS bf16*)(lds + 111616) + w * 768;
    LAS float* gl = (LAS float*)(lds + 123904);
    LAS float* gcs = gl + 64;
    LAS float* bet = gcs + 64;
    const int t = tid >> 3, sub = tid & 7;
    {
        if (sub == 0) { const float* gt = (const float*)(ws + WS_GATES) + (size_t)(b * TP + 64 * c + t) * 16;
            gl[t] = -fexp(a->in[I_ALOG][h]) * softplusf(gt[h] + a->in[I_DTB][h]); bet[t] = sigm(gt[8 + h]); }
        __syncthreads();
        if (w == 0) { float v = gl[lane];
#pragma unroll
            for (int o = 1; o < 64; o <<= 1) { const float u = __shfl_up(v, o); if (lane >= o) v += u; }
            gcs[lane] = v; }
        __syncthreads();
    }
    {
        const float* wconv = a->in[I_WCONV]; const float* bconv = a->in[I_BCONV];
        const float gc = gcs[t], glast = gcs[63], beta = bet[t];
        const float ec = fexp(gc), ed = fexp(glast - gc);
        float x[16], y[16];
        conv16_prompt(proj, wconv, bconv, b, 64 * c + t, 1024 + h * 128 + sub * 16, x);
        float ss = 0.f;
#pragma unroll
        for (int i = 0; i < 16; ++i) { x[i] = siluf(x[i]); ss += x[i] * x[i]; }
        ss += __shfl_xor(ss, 1); ss += __shfl_xor(ss, 2); ss += __shfl_xor(ss, 4);
        const float rk = rsqrtf(ss + 1e-6f);
#pragma unroll
        for (int i = 0; i < 16; ++i) x[i] *= rk;
        st16_bf16(Kn + t * 136 + sub * 16, x);
#pragma unroll
        for (int i = 0; i < 16; ++i) KdT[(sub * 16 + i) * 72 + t] = (bf16)f2bf(x[i] * ed);
#pragma unroll
        for (int i = 0; i < 16; ++i) y[i] = x[i] * (beta * ec);
        st16_bf16(RX + t * 264 + 128 + sub * 16, y);
        conv16_prompt(proj, wconv, bconv, b, 64 * c + t, h * 128 + sub * 16, x);
        ss = 0.f;
#pragma unroll
        for (int i = 0; i < 16; ++i) { x[i] = siluf(x[i]); ss += x[i] * x[i]; }
        ss += __shfl_xor(ss, 1); ss += __shfl_xor(ss, 2); ss += __shfl_xor(ss, 4);
        const float rq = rsqrtf(ss + 1e-6f) * 0.08838834764831845f;
#pragma unroll
        for (int i = 0; i < 16; ++i) x[i] *= rq;
        st16_bf16(Qn + t * 136 + sub * 16, x);
        conv16_prompt(proj, wconv, bconv, b, 64 * c + t, 2048 + h * 128 + sub * 16, x);
#pragma unroll
        for (int i = 0; i < 16; ++i) x[i] = siluf(x[i]) * beta;
        st16_bf16(RX + t * 264 + sub * 16, x);
    }
    __syncthreads();
    {
        const int ib = w >> 1;
#pragma unroll
        for (int jj = 0; jj < 2; ++jj) { const int jb = 2 * (w & 1) + jj;
            f32x4 ak = (f32x4){0.f, 0.f, 0.f, 0.f}, aq = (f32x4){0.f, 0.f, 0.f, 0.f};
            if (jb <= ib) {
#pragma unroll
                for (int ks = 0; ks < 4; ++ks) { const bf16x8 bfr = *(const LAS bf16x8*)(Kn + (16 * jb + fr) * 136 + 32 * ks + 8 * fq);
                    const bf16x8 afk = *(const LAS bf16x8*)(Kn + (16 * ib + fr) * 136 + 32 * ks + 8 * fq), afq = *(const LAS bf16x8*)(Qn + (16 * ib + fr) * 136 + 32 * ks + 8 * fq);
                    ak = MFMA32(afk, bfr, ak); aq = MFMA32(afq, bfr, aq); } }
            const int col = 16 * jb + fr; const float gcc = gcs[col];
#pragma unroll
            for (int j = 0; j < 4; ++j) { const int row = 16 * ib + 4 * fq + j; const float dec = (row >= col) ? fexp(gcs[row] - gcc) : 0.f;
                Mm[row * 72 + col] = (bf16)f2bf(row > col ? -bet[row] * ak[j] * dec : 0.f);
                QKd[row * 72 + col] = (bf16)f2bf(aq[j] * dec); }
        }
    }
    __syncthreads();
    if (w == 0) { const int blk = lane >> 4, col = lane & 15; float xi[16];
#pragma unroll
        for (int i = 0; i < 16; ++i) { float acc = (i == col) ? 1.f : 0.f; const LAS bf16* mr = Mm + (16 * blk + i) * 72 + 16 * blk;
#pragma unroll
            for (int j = 0; j < i; ++j) acc += bf2f(mr[j]) * xi[j];
            xi[i] = acc; }
#pragma unroll
        for (int i = 0; i < 16; ++i) Td[(blk * 16 + i) * 24 + col] = (bf16)f2bf(xi[i]); }
    f32x4 rhs[2][4];
#pragma unroll
    for (int cbl = 0; cbl < 2; ++cbl)
#pragma unroll
        for (int bb = 0; bb < 4; ++bb)
#pragma unroll
            for (int j = 0; j < 4; ++j) rhs[cbl][bb][j] = bf2f(RX[(16 * bb + 4 * fq + j) * 264 + 32 * w + 16 * cbl + fr]);
    __syncthreads();
#pragma unroll
    for (int cbl = 0; cbl < 2; ++cbl) { const int cb = 2 * w + cbl;
#pragma unroll
        for (int bb = 0; bb < 4; ++bb) {
            f32x4 acc = rhs[cbl][bb];
#pragma unroll
            for (int ks = 0; ks < 2; ++ks) { if (32 * ks < 16 * bb) { const bool ok = (32 * ks + 8 * fq) < 16 * bb;
                const bf16x8 af = ok ? *(const LAS bf16x8*)(Mm + (16 * bb + fr) * 72 + 32 * ks + 8 * fq) : zero8();
                const bf16x8 bf_ = ok ? *(const LAS bf16x8*)(RX + (16 * cb + fr) * 72 + 32 * ks + 8 * fq) : zero8();
                acc = MFMA32(af, bf_, acc); } }
            *(LAS v2u*)(RT + (16 * cbl + fr) * 24 + 4 * fq) = pack4(acc);
            asm volatile("s_waitcnt lgkmcnt(0)" ::: "memory");
            const bool ok2 = fq < 2;
            const bf16x8 af2 = ok2 ? *(const LAS bf16x8*)(Td + (bb * 16 + fr) * 24 + 8 * fq) : zero8();
            const bf16x8 bf2 = ok2 ? *(const LAS bf16x8*)(RT + (16 * cbl + fr) * 24 + 8 * fq) : zero8();
            const f32x4 xb4 = MFMA32(af2, bf2, ((f32x4){0.f, 0.f, 0.f, 0.f}));
            *(LAS v2u*)(RX + (16 * cb + fr) * 72 + 16 * bb + 4 * fq) = pack4(xb4);
            asm volatile("s_waitcnt lgkmcnt(0)" ::: "memory");
        }
    }
    __syncthreads();
    {
        v4u* gout = (v4u*)(ws + WS_DG) + ((size_t)item * 8 + w) * 4 * 64 + lane;
        bf16x8 kb[2];
#pragma unroll
        for (int kt = 0; kt < 2; ++kt) kb[kt] = *(const LAS bf16x8*)(KdT + (16 * w + fr) * 72 + 32 * kt + 8 * fq);
#pragma unroll
        for (int ks = 0; ks < 4; ++ks) { f32x4 g0 = (f32x4){0.f, 0.f, 0.f, 0.f}, g1 = (f32x4){0.f, 0.f, 0.f, 0.f};
#pragma unroll
            for (int kt = 0; kt < 2; ++kt) { const bf16x8 a0 = *(const LAS bf16x8*)(RX + (128 + 32 * ks + fr) * 72 + 32 * kt + 8 * fq), a1 = *(const LAS bf16x8*)(RX + (128 + 32 * ks + 16 + fr) * 72 + 32 * kt + 8 * fq);
                g0 = MFMA32(a0, kb[kt], g0); g1 = MFMA32(a1, kb[kt], g1); }
            const v2u p0 = pack4(-g0), p1 = pack4(-g1); gout[ks * 64] = (v4u){p0.x, p0.y, p1.x, p1.y}; }
        v2u* bout = (v2u*)(ws + WS_DB) + ((size_t)item * 64 + w) * 64 + lane;
#pragma unroll
        for (int s2 = 0; s2 < 8; ++s2) { f32x4 bc = (f32x4){0.f, 0.f, 0.f, 0.f};
#pragma unroll
            for (int kt = 0; kt < 2; ++kt) { const bf16x8 ub = *(const LAS bf16x8*)(RX + (16 * s2 + fr) * 72 + 32 * kt + 8 * fq); bc = MFMA32(kb[kt], ub, bc); }
            bout[(size_t)s2 * 8 * 64] = pack4(bc); }
    }
    {
        const int tb = w >> 1, half = w & 1; const float ect = fexp(gcs[16 * tb + fr]);
        bf16x8 qk[2];
#pragma unroll
        for (int kt = 0; kt < 2; ++kt) qk[kt] = *(const LAS bf16x8*)(QKd + (16 * tb + fr) * 72 + 32 * kt + 8 * fq);
        v4u* qout = (v4u*)(ws + WS_DQ) + ((size_t)item * 4 + tb) * 4 * 64 + lane;
#pragma unroll
        for (int kk = 0; kk < 2; ++kk) { const int ks = 2 * half + kk; v2u pk[2];
#pragma unroll
            for (int hf = 0; hf < 2; ++hf) { const int db = 2 * ks + hf; f32x4 acc = (f32x4){0.f, 0.f, 0.f, 0.f};
#pragma unroll
                for (int kt = 0; kt < 2; ++kt) { const bf16x8 wa = *(const LAS bf16x8*)(RX + (128 + 16 * db + fr) * 72 + 32 * kt + 8 * fq); acc = MFMA32(wa, qk[kt], acc); }
                const v2u qn4 = *(const LAS v2u*)(Qn + (16 * tb + fr) * 136 + 16 * db + 4 * fq);
                f32x4 qp; qp.x = bflo(qn4.x) * ect - acc.x; qp.y = bfhi(qn4.x) * ect - acc.y; qp.z = bflo(qn4.y) * ect - acc.z; qp.w = bfhi(qn4.y) * ect - acc.w;
                pk[hf] = pack4(qp); }
            qout[ks * 64] = (v4u){pk[0].x, pk[0].y, pk[1].x, pk[1].y}; }
        v2u* oout = (v2u*)(ws + WS_DO) + ((size_t)item * 4 + tb) * 8 * 64 + lane;
#pragma unroll
        for (int ss = 0; ss < 4; ++ss) { const int s2 = 4 * half + ss; f32x4 acc = (f32x4){0.f, 0.f, 0.f, 0.f};
#pragma unroll
            for (int kt = 0; kt < 2; ++kt) { const bf16x8 ua = *(const LAS bf16x8*)(RX + (16 * s2 + fr) * 72 + 32 * kt + 8 * fq); acc = MFMA32(ua, qk[kt], acc); }
            oout[s2 * 64] = pack4(acc); }
    }
    if (tid == 0) ((float*)(ws + WS_DD))[item] = fexp(gcs[63]);
    __syncthreads();
}

__device__ __forceinline__ void delta_scan_wave(ArgsP a, int chain, int s, const int lane) {
    unsigned char* ws = a->ws;
    const int fr = lane & 15, fq = lane >> 4;
    f32x4 S[8]; bf16x8 Sb[4];
#pragma unroll
    for (int i = 0; i < 8; ++i) S[i] = (f32x4){0.f, 0.f, 0.f, 0.f};
#pragma unroll
    for (int i = 0; i < 4; ++i) Sb[i] = zero8();
    const bf16x8* gbase = (const bf16x8*)(ws + WS_DG) + (size_t)chain * 32 * 2048 + lane;
    bf16x8 G[8][4];
#pragma unroll
    for (int rb = 0; rb < 8; ++rb)
#pragma unroll
        for (int ks = 0; ks < 4; ++ks) G[rb][ks] = gbase[(rb * 4 + ks) * 64];
#pragma unroll 1
    for (int c = 0; c < 32; ++c) {
        const int item = chain * 32 + c;
        const float d = ((const float*)(ws + WS_DD))[item];
        bf16x8* sout = (bf16x8*)(ws + WS_DS) + ((size_t)item * 8 + s) * 4 * 64 + lane;
#pragma unroll
        for (int ks = 0; ks < 4; ++ks) sout[ks * 64] = Sb[ks];
        const v2u* bin = (const v2u*)(ws + WS_DB) + ((size_t)item * 8 + s) * 8 * 64 + lane;
#pragma unroll
        for (int rb = 0; rb < 8; ++rb) { const v2u bc = bin[rb * 64]; S[rb].x = d * S[rb].x + bflo(bc.x); S[rb].y = d * S[rb].y + bfhi(bc.x); S[rb].z = d * S[rb].z + bflo(bc.y); S[rb].w = d * S[rb].w + bfhi(bc.y); }
        const bf16x8* gnext = gbase + (size_t)(c + 1 < 32 ? c + 1 : c) * 2048;
#pragma unroll
        for (int rb = 0; rb < 8; ++rb) {
#pragma unroll
            for (int ks = 0; ks < 4; ++ks) S[rb] = MFMA32(G[rb][ks], Sb[ks], S[rb]);
#pragma unroll
            for (int ks = 0; ks < 4; ++ks) G[rb][ks] = gnext[(rb * 4 + ks) * 64];
        }
#pragma unroll
        for (int ks = 0; ks < 4; ++ks) { const v2u lo = pack4(S[2 * ks]), hi = pack4(S[2 * ks + 1]); const v4u u = (v4u){lo.x, lo.y, hi.x, hi.y}; Sb[ks] = __builtin_bit_cast(bf16x8, u); }
    }
    f32x4* so = (f32x4*)(ws + WS_DF) + ((size_t)(chain * 8 + s) * 8) * 64 + lane;
#pragma unroll
    for (int rb = 0; rb < 8; ++rb) so[rb * 64] = S[rb];
}

__device__ __forceinline__ void delta_out_wave(ArgsP a, int item, int tb, const int lane) {
    unsigned char* ws = a->ws;
    const int c = item & 31, h = (item >> 5) & 7, b = item >> 8, fr = lane & 15, fq = lane >> 4;
    bf16x8 qf[4];
    const bf16x8* qin = (const bf16x8*)(ws + WS_DQ) + ((size_t)item * 4 + tb) * 4 * 64 + lane;
#pragma unroll
    for (int ks = 0; ks < 4; ++ks) qf[ks] = qin[ks * 64];
    const v2u* oin = (const v2u*)(ws + WS_DO) + ((size_t)item * 4 + tb) * 8 * 64 + lane;
    const bf16x8* sin = (const bf16x8*)(ws + WS_DS) + (size_t)item * 8 * 4 * 64 + lane;
    f32x4 o[8]; float ss = 0.f;
#pragma unroll
    for (int s = 0; s < 8; ++s) { const v2u ol = oin[s * 64]; o[s] = (f32x4){bflo(ol.x), bfhi(ol.x), bflo(ol.y), bfhi(ol.y)};
#pragma unroll
        for (int ks = 0; ks < 4; ++ks) o[s] = MFMA32(sin[(s * 4 + ks) * 64], qf[ks], o[s]);
        ss += (o[s].x * o[s].x + o[s].y * o[s].y) + (o[s].z * o[s].z + o[s].w * o[s].w); }
    ss += __shfl_xor(ss, 16); ss += __shfl_xor(ss, 32);
    const float rstd = rsqrtf(ss * (1.f / 128.f) + RMS_EPS);
    const int row = b * TP + 64 * c + 16 * tb + fr;
    const bf16* zp = (const bf16*)(ws + WS_PROJ) + (size_t)row * NPROJ_PAD + 4096 + h * 128 + 4 * fq;
    bf16* mp = (bf16*)(ws + WS_MIX) + (size_t)row * D + h * 128 + 4 * fq;
    const float* nw = a->in[I_DNORM] + 4 * fq;
#pragma unroll
    for (int s = 0; s < 8; ++s) { const v2u z = *(const v2u*)(zp + 16 * s); const f32x4 n4 = *(const f32x4*)(nw + 16 * s);
        f32x4 y; y.x = o[s].x * rstd * n4.x * siluf(bflo(z.x)); y.y = o[s].y * rstd * n4.y * siluf(bfhi(z.x)); y.z = o[s].z * rstd * n4.z * siluf(bflo(z.y)); y.w = o[s].w * rstd * n4.w * siluf(bfhi(z.y));
        *(v2u*)(mp + 16 * s) = pack4(y); }
}


__device__ __forceinline__ float wave_incl_sum(float v, int lane) {
#pragma unroll
    for (int o = 1; o < 64; o <<= 1) { const float u = __shfl_up(v, o); if (lane >= o) v += u; }
    return v;
}
__device__ __forceinline__ float wave_incl_max(float v, int lane) {
#pragma unroll
    for (int o = 1; o < 64; o <<= 1) { const float u = __shfl_up(v, o); if (lane >= o) v = fmaxf(v, u); }
    return v;
}
__device__ __forceinline__ float wave_max(float v) {
#pragma unroll
    for (int o = 1; o < 64; o <<= 1) v = fmaxf(v, __shfl_xor(v, o));
    return v;
}
__device__ __forceinline__ void mlstm_scan_item(ArgsP a, LAS unsigned char* lds, int chain, int vs, const int tid) {
    const int lane = tid & 63, w = __builtin_amdgcn_readfirstlane(tid >> 6), fr = lane & 15, fq = lane >> 4;
    const int b = chain >> 3, h = chain & 7, row0 = b * TP;
    unsigned char* ws = a->ws;
    const bf16* proj = (const bf16*)(ws + WS_PROJ); const float* gates = (const float*)(ws + WS_GATES);
    LAS bf16* KT = (LAS bf16*)lds;
    LAS bf16* VT = (LAS bf16*)(lds + 36864);
    LAS float* wls = (LAS float*)(lds + 46080);
    const float big = a->in[I_BIG][h], bfg = a->in[I_BFG][h];
    const bf16* kptr = proj + (size_t)(row0 + lane) * NPROJ_PAD + 1024 + h * 128 + 16 * w;
    const bf16* vptr = proj + (size_t)(row0 + lane) * NPROJ_PAD + 2048 + h * 256 + 32 * vs + 8 * (w & 3);
    const float* gptr = gates + (size_t)(row0 + lane) * 16 + h;
    f32x4 acc[2]; acc[0] = (f32x4){0.f, 0.f, 0.f, 0.f}; acc[1] = acc[0];
    float nst = 0.f, m = 0.f;
    v4u kq[2][2], vq[2]; float gi[2], gf[2];
#define ML_LOAD(set, c_) do { const size_t ro = (size_t)(c_) * 64 * NPROJ_PAD; kq[set][0] = *(const v4u*)(kptr + ro); kq[set][1] = *(const v4u*)(kptr + ro + 8); \
        if (w < 4) vq[set] = *(const v4u*)(vptr + ro); gi[set] = gptr[(size_t)(c_) * 64 * 16]; gf[set] = gptr[(size_t)(c_) * 64 * 16 + 8]; } while (0)
#define ML_STEP(set, c_) do { const int item = chain * 32 + (c_); \
        const float ig = gi[set] + big, lf = logsigf(gf[set] + bfg); \
        const float bcum = wave_incl_sum(lf, lane), blast = __shfl(bcum, 63), gend = blast - bcum + ig; \
        const float mnew = fmaxf(blast + m, wave_max(gend)), sc = fexp(blast + m - mnew), wv = fexp(gend - mnew) * 0.08838834764831845f; \
        LAS bf16* kt = KT + (set) * 9216; LAS bf16* vt = VT + (set) * 2304; \
        _Pragma("unroll") for (int i = 0; i < 2; ++i) { const unsigned uu[4] = {kq[set][i].x, kq[set][i].y, kq[set][i].z, kq[set][i].w}; const int kr = 8 * (2 * w + i); \
            _Pragma("unroll") for (int e = 0; e < 4; ++e) { kt[(kr + 2 * e) * 72 + lane] = (bf16)(uu[e] & 0xffffu); kt[(kr + 2 * e + 1) * 72 + lane] = (bf16)(uu[e] >> 16); } } \
        if (w < 4) { const unsigned uu[4] = {vq[set].x, vq[set].y, vq[set].z, vq[set].w}; \
            _Pragma("unroll") for (int e = 0; e < 4; ++e) { vt[(8 * w + 2 * e) * 72 + lane] = (bf16)f2bf(bflo(uu[e]) * wv); vt[(8 * w + 2 * e + 1) * 72 + lane] = (bf16)f2bf(bfhi(uu[e]) * wv); } } \
        if (w == 0) wls[(set) * 64 + lane] = wv; \
        if ((c_) + 2 < 32) ML_LOAD(set, (c_) + 2); \
        if (vs == 0 && tid == 0) ((float*)(ws + WS_MM))[item] = m; \
        __syncthreads(); \
        _Pragma("unroll") for (int vb = 0; vb < 2; ++vb) { *(v2u*)((bf16*)(ws + WS_MC) + ((size_t)item * 256 + 32 * vs + 16 * vb + fr) * 128 + 16 * w + 4 * fq) = pack4(acc[vb]); } \
        if (vs == 0 && tid < 128) { ((float*)(ws + WS_MN))[(size_t)item * 128 + tid] = nst; float sn = 0.f; \
            _Pragma("unroll") for (int s8 = 0; s8 < 8; ++s8) { const v4u kk = *(const LAS v4u*)(kt + tid * 72 + 8 * s8); const LAS float* wl = wls + (set) * 64 + 8 * s8; \
                sn += bflo(kk.x) * wl[0] + bfhi(kk.x) * wl[1] + bflo(kk.y) * wl[2] + bfhi(kk.y) * wl[3] + bflo(kk.z) * wl[4] + bfhi(kk.z) * wl[5] + bflo(kk.w) * wl[6] + bfhi(kk.w) * wl[7]; } \
            nst = sc * nst + sn; } \
        _Pragma("unroll") for (int vb = 0; vb < 2; ++vb) { acc[vb] = acc[vb] * sc; \
            _Pragma("unroll") for (int kt2 = 0; kt2 < 2; ++kt2) { const bf16x8 af = *(const LAS bf16x8*)(kt + (16 * w + fr) * 72 + 32 * kt2 + 8 * fq), bfv = *(const LAS bf16x8*)(vt + (16 * vb + fr) * 72 + 32 * kt2 + 8 * fq); \
                acc[vb] = MFMA32(af, bfv, acc[vb]); } } \
        m = mnew; } while (0)
    ML_LOAD(0, 0); ML_LOAD(1, 1);
#pragma unroll 1
    for (int c2 = 0; c2 < 32; c2 += 2) { ML_STEP(0, c2); ML_STEP(1, c2 + 1); }
#undef ML_LOAD
#undef ML_STEP
#pragma unroll
    for (int vb = 0; vb < 2; ++vb) *(f32x4*)(a->out + O_MCP + ((size_t)chain * 256 + 32 * vs + 16 * vb + fr) * 128 + 16 * w + 4 * fq) = acc[vb];
    if (vs == 0) { if (tid < 128) a->out[O_MNP + (size_t)chain * 128 + tid] = nst; if (tid == 0) a->out[O_MMP + chain] = m; }
    __syncthreads();
}

__device__ __forceinline__ void mlstm_out_item(ArgsP a, LAS unsigned char* lds, int item, const int tid) {
    const int c = item & 31, h = (item >> 5) & 7, b = item >> 8, row0 = b * TP + 64 * c;
    const int lane = tid & 63, w = __builtin_amdgcn_readfirstlane(tid >> 6), fr = lane & 15, fq = lane >> 4;
    unsigned char* ws = a->ws;
    const bf16* proj = (const bf16*)(ws + WS_PROJ); const float* gates = (const float*)(ws + WS_GATES);
    LAS bf16* VT = (LAS bf16*)lds;
    LAS float* ssq = (LAS float*)(lds + 36864);
    const float mc = ((const float*)(ws + WS_MM))[item];
    float av, Mt, et, em;
    { const float ig = gates[(size_t)(row0 + lane) * 16 + h] + a->in[I_BIG][h], lf = logsigf(gates[(size_t)(row0 + lane) * 16 + 8 + h] + a->in[I_BFG][h]);
      const float bcum = wave_incl_sum(lf, lane); av = ig - bcum; Mt = fmaxf(mc, wave_incl_max(av, lane)); et = fexp(mc - Mt); em = fexp(-(bcum + Mt)); }
    {
        v4u vu[4];
#pragma unroll
        for (int i = 0; i < 4; ++i) vu[i] = *(const v4u*)(proj + (size_t)(row0 + lane) * NPROJ_PAD + 2048 + h * 256 + 8 * (w + 8 * i));
#pragma unroll
        for (int i = 0; i < 4; ++i) { const unsigned uu[4] = {vu[i].x, vu[i].y, vu[i].z, vu[i].w}; const int vr = 8 * (w + 8 * i);
#pragma unroll
            for (int e = 0; e < 4; ++e) { VT[(vr + 2 * e) * 72 + lane] = (bf16)(uu[e] & 0xffffu); VT[(vr + 2 * e + 1) * 72 + lane] = (bf16)(uu[e] >> 16); } } }
    const int tb = w & 3, half = w >> 2, t = 16 * tb + fr;
    bf16x8 qf[4]; float qn = 0.f;
#pragma unroll
    for (int ks = 0; ks < 4; ++ks) { const v4u u = *(const v4u*)(proj + (size_t)(row0 + t) * NPROJ_PAD + h * 128 + 32 * ks + 8 * fq); qf[ks] = __builtin_bit_cast(bf16x8, u);
        const float* np = (const float*)(ws + WS_MN) + (size_t)item * 128 + 32 * ks + 8 * fq; const f32x4 n0 = *(const f32x4*)np, n1 = *(const f32x4*)(np + 4);
        qn += bflo(u.x) * n0.x + bfhi(u.x) * n0.y + bflo(u.y) * n0.z + bfhi(u.y) * n0.w + bflo(u.z) * n1.x + bfhi(u.z) * n1.y + bflo(u.w) * n1.z + bfhi(u.w) * n1.w; }
    qn += __shfl_xor(qn, 16); qn += __shfl_xor(qn, 32);
    const float Mtt = __shfl(Mt, t), ett = __shfl(et, t), emt = __shfl(em, t);
    const bf16* cs = (const bf16*)(ws + WS_MC) + (size_t)item * 256 * 128;
    v4u kfr[4][4];
#pragma unroll
    for (int sb = 0; sb < 4; ++sb) if (sb <= tb) {
#pragma unroll
        for (int ks = 0; ks < 4; ++ks) kfr[sb][ks] = *(const v4u*)(proj + (size_t)(row0 + 16 * sb + fr) * NPROJ_PAD + 1024 + h * 128 + 32 * ks + 8 * fq); }
    v2u smp[4]; float rowsum = 0.f;
#pragma unroll
    for (int sb = 0; sb < 4; ++sb) { smp[sb] = (v2u){0u, 0u};
        if (sb <= tb) { f32x4 qk = (f32x4){0.f, 0.f, 0.f, 0.f};
#pragma unroll
            for (int ks = 0; ks < 4; ++ks) qk = MFMA32(__builtin_bit_cast(bf16x8, kfr[sb][ks]), qf[ks], qk);
            f32x4 sm;
#pragma unroll
            for (int j = 0; j < 4; ++j) { const int s = 16 * sb + 4 * fq + j; const float as = __shfl(av, s); sm[j] = (s <= t) ? qk[j] * 0.08838834764831845f * fexp(as - Mtt) : 0.f; rowsum += sm[j]; }
            smp[sb] = pack4(sm); } }
    rowsum += __shfl_xor(rowsum, 16); rowsum += __shfl_xor(rowsum, 32);
    const float hden = 1.f / fmaxf(fabsf(ett * qn + rowsum), emt);
    const v4u s0u = (v4u){smp[0].x, smp[0].y, smp[1].x, smp[1].y}, s1u = (v4u){smp[2].x, smp[2].y, smp[3].x, smp[3].y};
    const bf16x8 sf0 = __builtin_bit_cast(bf16x8, s0u), sf1 = __builtin_bit_cast(bf16x8, s1u);
    v4u cfr[4][4];
#pragma unroll
    for (int g4 = 0; g4 < 4; ++g4)
#pragma unroll
        for (int ks = 0; ks < 4; ++ks) cfr[g4][ks] = *(const v4u*)(cs + (size_t)(128 * half + 16 * g4 + fr) * 128 + 32 * ks + 8 * fq);
    __syncthreads();
    f32x4 hv[8]; float ss = 0.f;
#pragma unroll
    for (int grp = 0; grp < 2; ++grp) {
      f32x4 accs[4];
#pragma unroll
      for (int g4 = 0; g4 < 4; ++g4) { f32x4 acc = (f32x4){0.f, 0.f, 0.f, 0.f};
#pragma unroll
          for (int ks = 0; ks < 4; ++ks) acc = MFMA32(__builtin_bit_cast(bf16x8, cfr[g4][ks]), qf[ks], acc);
          accs[g4] = acc * ett; }
      if (grp == 0) {
#pragma unroll
          for (int g4 = 0; g4 < 4; ++g4)
#pragma unroll
              for (int ks = 0; ks < 4; ++ks) cfr[g4][ks] = *(const v4u*)(cs + (size_t)(128 * half + 64 + 16 * g4 + fr) * 128 + 32 * ks + 8 * fq); }
#pragma unroll
      for (int g4 = 0; g4 < 4; ++g4) { const int vb = 4 * grp + g4, vrow = 128 * half + 16 * vb + fr; f32x4 acc = accs[g4];
        { const v2u a0 = *(const LAS v2u*)(VT + vrow * 72 + 4 * fq), a1 = *(const LAS v2u*)(VT + vrow * 72 + 16 + 4 * fq); const v4u au = (v4u){a0.x, a0.y, a1.x, a1.y}; acc = MFMA32(__builtin_bit_cast(bf16x8, au), sf0, acc); }
        { const v2u a0 = *(const LAS v2u*)(VT + vrow * 72 + 32 + 4 * fq), a1 = *(const LAS v2u*)(VT + vrow * 72 + 48 + 4 * fq); const v4u au = (v4u){a0.x, a0.y, a1.x, a1.y}; acc = MFMA32(__builtin_bit_cast(bf16x8, au), sf1, acc); }
        hv[vb] = acc * hden; ss += (hv[vb].x * hv[vb].x + hv[vb].y * hv[vb].y) + (hv[vb].z * hv[vb].z + hv[vb].w * hv[vb].w); }
    }
    ss += __shfl_xor(ss, 16); ss += __shfl_xor(ss, 32);
    if (fq == 0) ssq[half * 64 + t] = ss;
    __syncthreads();
    const float rstd = rsqrtf((ssq[t] + ssq[64 + t]) * (1.f / 256.f) + RMS_EPS);
    const bf16* op = proj + (size_t)(row0 + t) * NPROJ_PAD + 4096 + h * 256 + 128 * half + 4 * fq;
    bf16* mp = (bf16*)(ws + WS_MIX) + (size_t)(row0 + t) * D + h * 256 + 128 * half + 4 * fq;
    const float* nw = a->in[I_MNORM] + h * 256 + 128 * half + 4 * fq;
    v2u opr[8];
#pragma unroll
    for (int vb = 0; vb < 8; ++vb) opr[vb] = *(const v2u*)(op + 16 * vb);
#pragma unroll
    for (int vb = 0; vb < 8; ++vb) { const v2u o = opr[vb]; const f32x4 n4 = *(const f32x4*)(nw + 16 * vb);
        f32x4 y; y.x = hv[vb].x * rstd * n4.x * sigm(bflo(o.x)); y.y = hv[vb].y * rstd * n4.y * sigm(bfhi(o.x)); y.z = hv[vb].z * rstd * n4.z * sigm(bflo(o.y)); y.w = hv[vb].w * rstd * n4.w * sigm(bfhi(o.y));
        *(v2u*)(mp + 16 * vb) = pack4(y); }
    __syncthreads();
}


__device__ __forceinline__ void mlstm_sample_load(ArgsP a, int j, const int tid, f32x4 (&cst)[2][4][2]) {
    const int lane = tid & 63, w = __builtin_amdgcn_readfirstlane(tid >> 6), fr = lane & 15, fq = lane >> 4;
    const float* C0 = a->in[I_SMC] + (size_t)j * 32768;
#pragma unroll
    for (int vb = 0; vb < 2; ++vb)
#pragma unroll
        for (int ksp = 0; ksp < 4; ++ksp) { const float* cp = C0 + (size_t)(32 * w + 16 * vb + fr) * 128 + 32 * ksp + 4 * fq; cst[vb][ksp][0] = __builtin_nontemporal_load((const f32x4*)cp); cst[vb][ksp][1] = __builtin_nontemporal_load((const f32x4*)(cp + 16)); }
}
__device__ __forceinline__ void mlstm_sample_item(ArgsP a, LAS unsigned char* lds, int j, const int tid, const f32x4 (&cst)[2][4][2]) {
    const int b = j >> 3, h = j & 7, row0 = MP + b * TS;
    const int lane = tid & 63, w = __builtin_amdgcn_readfirstlane(tid >> 6), fr = lane & 15, fq = lane >> 4;
    unsigned char* ws = a->ws;
    const bf16* proj = (const bf16*)(ws + WS_PROJ); const float* gates = (const float*)(ws + WS_GATES);
    float* Cout = a->out + O_MCS + (size_t)j * 32768;
    LAS float* qs = (LAS float*)lds;
    LAS float* ks = qs + 512;
    LAS float* vs = ks + 512;
    LAS float* gs = vs + 1024;
    LAS float* qkr = gs + 8;
    LAS float* qnl = qkr + 16;
    LAS float* hbuf = qnl + 8;
#pragma unroll
    for (int tok = 0; tok < 4; ++tok) { const bf16* pr = proj + (size_t)(row0 + tok) * NPROJ_PAD;
        if (tid < 128) qs[tok * 128 + tid] = bf2f(pr[h * 128 + tid]); else if (tid < 256) ks[tok * 128 + tid - 128] = bf2f(pr[1024 + h * 128 + (tid - 128)]) * 0.08838834764831845f; else vs[tok * 256 + tid - 256] = bf2f(pr[2048 + h * 256 + (tid - 256)]); }
    if (tid < 4) { gs[tid * 2] = gates[(size_t)(row0 + tid) * 16 + h] + a->in[I_BIG][h]; gs[tid * 2 + 1] = gates[(size_t)(row0 + tid) * 16 + 8 + h] + a->in[I_BFG][h]; }
    const float n0a = a->in[I_SMN][(size_t)j * 128 + lane], n0b = a->in[I_SMN][(size_t)j * 128 + 64 + lane];
    const float m0 = a->in[I_SMM][j];
    __syncthreads();
#pragma unroll
    for (int i = 0; i < 2; ++i) { const int p = 2 * w + i, t = p >> 2, sx = p & 3; const float d = wave_sum(qs[t * 128 + lane] * ks[sx * 128 + lane] + qs[t * 128 + 64 + lane] * ks[sx * 128 + 64 + lane]); if (lane == 0) qkr[p] = d; }
    if (w < 4) { const float d = wave_sum(qs[w * 128 + lane] * n0a + qs[w * 128 + 64 + lane] * n0b); if (lane == 0) qnl[w] = d; }
    float bc[4], ig[4], mt[4], m = m0, bsum = 0.f;
#pragma unroll
    for (int t = 0; t < 4; ++t) { ig[t] = gs[t * 2]; const float lf = logsigf(gs[t * 2 + 1]); bsum += lf; bc[t] = bsum; m = fmaxf(lf + m, ig[t]); mt[t] = m; }
    const float scf = fexp(bc[3] + m0 - mt[3]);
    float wsf[4], et[4];
#pragma unroll
    for (int t = 0; t < 4; ++t) { wsf[t] = fexp(bc[3] - bc[t] + ig[t] - mt[3]); et[t] = fexp(bc[t] + m0 - mt[t]); }
    __syncthreads();
    float S[4][4], hden[4];
#pragma unroll
    for (int t = 0; t < 4; ++t) { float den = et[t] * qnl[t];
#pragma unroll
        for (int sx = 0; sx < 4; ++sx) { S[t][sx] = (sx <= t) ? qkr[t * 4 + sx] * fexp(bc[t] - bc[sx] + ig[sx] - mt[t]) : 0.f; den += S[t][sx]; }
        hden[t] = 1.f / fmaxf(fabsf(den), fexp(-mt[t])); }
    bf16x8 qa[4];
#pragma unroll
    for (int ksp = 0; ksp < 4; ++ksp) { v4u u = (v4u){0u, 0u, 0u, 0u};
        if (fr < 4) { const f32x4 x0 = *(const LAS f32x4*)(qs + fr * 128 + 32 * ksp + 4 * fq), x1 = *(const LAS f32x4*)(qs + fr * 128 + 32 * ksp + 16 + 4 * fq); u.x = pk2(x0.x, x0.y); u.y = pk2(x0.z, x0.w); u.z = pk2(x1.x, x1.y); u.w = pk2(x1.z, x1.w); }
        qa[ksp] = __builtin_bit_cast(bf16x8, u); }
#pragma unroll
    for (int vb = 0; vb < 2; ++vb) { const int v = 32 * w + 16 * vb + fr;
        float vw[4];
#pragma unroll
        for (int sx = 0; sx < 4; ++sx) vw[sx] = vs[sx * 256 + v] * wsf[sx];
        f32x4 dacc = (f32x4){0.f, 0.f, 0.f, 0.f};
#pragma unroll
        for (int ksp = 0; ksp < 4; ++ksp) { const f32x4 c0 = cst[vb][ksp][0], c1 = cst[vb][ksp][1];
            v4u u; u.x = pk2(c0.x, c0.y); u.y = pk2(c0.z, c0.w); u.z = pk2(c1.x, c1.y); u.w = pk2(c1.z, c1.w);
            dacc = MFMA32(qa[ksp], __builtin_bit_cast(bf16x8, u), dacc);
            f32x4 n0v = c0 * scf, n1v = c1 * scf;
#pragma unroll
            for (int sx = 0; sx < 4; ++sx) { const f32x4 k0 = *(const LAS f32x4*)(ks + sx * 128 + 32 * ksp + 4 * fq), k1 = *(const LAS f32x4*)(ks + sx * 128 + 32 * ksp + 16 + 4 * fq); n0v = n0v + k0 * vw[sx]; n1v = n1v + k1 * vw[sx]; }
            float* op = Cout + (size_t)v * 128 + 32 * ksp + 4 * fq; __builtin_nontemporal_store(n0v, (f32x4*)op); __builtin_nontemporal_store(n1v, (f32x4*)(op + 16)); }
        if (fq == 0) {
#pragma unroll
            for (int t = 0; t < 4; ++t) { float num = et[t] * dacc[t];
#pragma unroll
                for (int sx = 0; sx < 4; ++sx) num += S[t][sx] * vs[sx * 256 + v];
                hbuf[t * 256 + v] = num * hden[t]; } }
    }
    if (tid < 128) { float nn = scf * a->in[I_SMN][(size_t)j * 128 + tid];
#pragma unroll
        for (int sx = 0; sx < 4; ++sx) nn += wsf[sx] * ks[sx * 128 + tid];
        a->out[O_MNS + (size_t)j * 128 + tid] = nn; }
    if (tid == 0) a->out[O_MMS + j] = mt[3];
    __syncthreads();
    if (w < 4) { const int tok = w, row = row0 + tok; float hv[4]; float ss = 0.f;
#pragma unroll
        for (int i = 0; i < 4; ++i) { hv[i] = hbuf[tok * 256 + i * 64 + lane]; ss += hv[i] * hv[i]; }
        const float rstd = rsqrtf(wave_sum(ss) * (1.f / 256.f) + RMS_EPS);
        const float* nw = a->in[I_MNORM] + h * 256; bf16* mix = (bf16*)(ws + WS_MIX);
#pragma unroll
        for (int i = 0; i < 4; ++i) { const int vi = i * 64 + lane; const float op = bf2f(proj[(size_t)row * NPROJ_PAD + 4096 + h * 256 + vi]);
            mix[(size_t)row * D + h * 256 + vi] = (bf16)f2bf(hv[i] * rstd * nw[vi] * sigm(op)); } }
    __syncthreads();
}

__device__ __forceinline__ void phase_mixer_even(ArgsP a, LAS unsigned char* lds, int vcu, int G, const int tid) {
#pragma unroll 1
    for (int r = 0; r < 1 + (PROBE_SUB & 1); ++r)
#pragma unroll 1
    for (int it = vcu; it < 1024; it += G) delta_prep_item(a, lds, it, tid);
#pragma unroll 1
    for (int r = 0; r < 1 + ((PROBE_SUB >> 1) & 1); ++r)
#pragma unroll 1
    for (int it = vcu; it < 1024; it += G) lru_prep_item(a, lds, it, tid);
#pragma unroll 1
    for (int r = 0; r < 1 + ((PROBE_SUB >> 2) & 1); ++r)
#pragma unroll 1
    for (int j = vcu; j < 1024; j += G) { const int b = j >> 3, hn = j & 7; delta_rec_item(a, lds, MP + b * TS, TS, hn, a->in[I_SCONV] + (size_t)b * 3 * 4096, a->in[I_SDELTA] + (size_t)j * 16384, a->out + O_DELTAS + (size_t)j * 16384, tid); }
#pragma unroll 1
    for (int r = 0; r < 1 + ((PROBE_SUB >> 3) & 1); ++r)
#pragma unroll 1
    for (int j = vcu; j < 1024; j += G) { const int b = j >> 3, hn = j & 7; lru_rec_item(a, lds, MP + b * TS, TS, hn, a->in[I_SCONV] + (size_t)b * 3 * 4096, a->in[I_SLRU] + (size_t)b * 1024, a->out + O_LRUS + (size_t)b * 1024, tid); }
    const bf16* proj = (const bf16*)(a->ws + WS_PROJ);
    const int nconv = (BP + BS) * 3 * 4096;
    for (int i = vcu * NTHR + tid; i < nconv; i += G * NTHR) {
        const int ch = i & 4095, rj = i >> 12, j = rj % 3, b = rj / 3;
        if (b < BP) a->out[O_CONVP + (size_t)(b * 3 + j) * 4096 + ch] = bf2f(proj[(size_t)(b * TP + TP - 3 + j) * NPROJ_PAD + ch]);
        else { const int bs = b - BP; a->out[O_CONVS + (size_t)(bs * 3 + j) * 4096 + ch] = bf2f(proj[(size_t)(MP + bs * TS + 1 + j) * NPROJ_PAD + ch]); }
    }
}
__device__ __forceinline__ void phase_mixer_even_b(ArgsP a, LAS unsigned char* lds, int vcu, int G, const int tid) {
    const int w = __builtin_amdgcn_readfirstlane(tid >> 6);
    if (w == 0) { for (int it = vcu; it < 256; it += G) delta_scan_wave(a, it >> 3, it & 7, tid & 63); }
    else { LAS float* scr = (LAS float*)(lds + w * 16384);
        const int lane = tid & 63, stride = G * 7; int it = vcu * 7 + (w - 1);
        TDesc dA, dB; f32x4 vA[8], vB[8];
        if (it < cv::N_REST) { dA = decode_rest(a, it); t_load(dA, lane, vA);
#pragma unroll 1
            for (;;) {
                const int itB = it + stride; const bool hasB = itB < cv::N_REST;
                if (hasB) { dB = decode_rest(a, itB); t_load(dB, lane, vB); }
                t_finish(dA, scr, lane, vA);
                if (!hasB) break;
                it = itB + stride; const bool hasA = it < cv::N_REST;
                if (hasA) { dA = decode_rest(a, it); t_load(dA, lane, vA); }
                t_finish(dB, scr, lane, vB);
                if (!hasA) break;
            } } }
}
__device__ __forceinline__ void phase_mixer_even_c(ArgsP a, LAS unsigned char* lds, int vcu, int G, const int tid) {
    const int w = tid >> 6;
#pragma unroll 1
    for (int it = vcu; it < 512; it += G) delta_out_wave(a, 2 * it + (w >> 2), w & 3, tid & 63);
#pragma unroll 1
    for (int it = vcu; it < 1024; it += G) lru_out_item(a, lds, it, tid);
    for (int chain = vcu; chain < 32; chain += G) {
        const float* src = (const float*)(a->ws + WS_DF) + (size_t)chain * 16384; float* dst = a->out + O_DELTAP + (size_t)chain * 16384;
        for (int e = tid; e < 16384; e += NTHR) { const int dk = e >> 7, dv = e & 127;
            dst[e] = src[((((dv >> 4) * 8 + (dk >> 4)) * 64 + ((dk >> 2) & 3) * 16 + (dv & 15)) << 2) + (dk & 3)]; }
    }
}
__device__ __forceinline__ void phase_mixer_odd(ArgsP a, LAS unsigned char* lds, int vcu, int G, const int tid) {
#pragma unroll 1
    for (int r = 0; r < 1 + ((PROBE_SUB >> 4) & 1); ++r)
#pragma unroll 1
    for (int it = vcu; it < 256; it += G) mlstm_scan_item(a, lds, it >> 3, it & 7, tid);
#pragma unroll 1
    for (int r = 0; r < 1 + ((PROBE_SUB >> 5) & 1); ++r)
    {
        f32x4 cA[2][4][2], cB[2][4][2]; int j = vcu;
        if (j < 1024) { mlstm_sample_load(a, j, tid, cA);
#pragma unroll 1
            for (;;) {
                const int jB = j + G; const bool hasB = jB < 1024;
                if (hasB) mlstm_sample_load(a, jB, tid, cB);
                mlstm_sample_item(a, lds, j, tid, cA);
                if (!hasB) break;
                j = jB + G; const bool hasA = j < 1024;
                if (hasA) mlstm_sample_load(a, j, tid, cA);
                mlstm_sample_item(a, lds, jB, tid, cB);
                if (!hasA) break;
            } }
    }
}
__device__ __forceinline__ void phase_mixer_odd_b(ArgsP a, LAS unsigned char* lds, int vcu, int G, const int tid) {
#pragma unroll 1
    for (int it = vcu; it < 1024; it += G) mlstm_out_item(a, lds, it, tid);
}

__device__ __forceinline__ void phase_ln(const bf16* VB, const float* ST, const float* p1, const bf16* resid, const float* g, const float* bta, bf16* dst, LAS unsigned char* lds, int vcu, int G, const int tid) {
    const int lane = tid & 63, w = __builtin_amdgcn_readfirstlane(tid >> 6), gw = vcu * NWAVES + w, NGW = G * NWAVES;
    {
        LAS float* red = (LAS float*)lds;
        for (int r0 = 2 * vcu; r0 < MS; r0 += 2 * G) {
            const int r = r0 + (w >> 2), q = w & 3, col = 512 * q + 8 * lane; const size_t off = (size_t)(MP + r) * D + col;
            const float* q1 = p1 + (size_t)r * D + col;
            f32x4 x0 = *(const f32x4*)q1, x1 = *(const f32x4*)(q1 + 4);
#pragma unroll
            for (int ch = 1; ch < 16; ++ch) { x0 = x0 + *(const f32x4*)(q1 + (size_t)ch * 512 * D); x1 = x1 + *(const f32x4*)(q1 + (size_t)ch * 512 * D + 4); }
            const v4u rr = *(const v4u*)(resid + off);
            float v[8] = {x0.x + DN_ALPHA * bflo(rr.x), x0.y + DN_ALPHA * bfhi(rr.x), x0.z + DN_ALPHA * bflo(rr.y), x0.w + DN_ALPHA * bfhi(rr.y),
                          x1.x + DN_ALPHA * bflo(rr.z), x1.y + DN_ALPHA * bfhi(rr.z), x1.z + DN_ALPHA * bflo(rr.w), x1.w + DN_ALPHA * bfhi(rr.w)};
            float s = 0.f, ss = 0.f;
#pragma unroll
            for (int i = 0; i < 8; ++i) { s += v[i]; ss += v[i] * v[i]; }
            s = wave_sum(s); ss = wave_sum(ss);
            if (lane == 0) { red[w * 2] = s; red[w * 2 + 1] = ss; }
            __syncthreads();
            const int wb = (w >> 2) * 4; s = (red[wb * 2] + red[wb * 2 + 2]) + (red[wb * 2 + 4] + red[wb * 2 + 6]); ss = (red[wb * 2 + 1] + red[wb * 2 + 3]) + (red[wb * 2 + 5] + red[wb * 2 + 7]);
            const float mean = s * (1.f / D), rstd = rsqrtf(fmaxf(ss * (1.f / D) - mean * mean, 0.f) + LN_EPS);
            const f32x4 g0 = *(const f32x4*)(g + col), g1 = *(const f32x4*)(g + col + 4), b0 = *(const f32x4*)(bta + col), b1 = *(const f32x4*)(bta + col + 4);
            v4u o; o.x = pk2((v[0] - mean) * rstd * g0.x + b0.x, (v[1] - mean) * rstd * g0.y + b0.y); o.y = pk2((v[2] - mean) * rstd * g0.z + b0.z, (v[3] - mean) * rstd * g0.w + b0.w);
            o.z = pk2((v[4] - mean) * rstd * g1.x + b1.x, (v[5] - mean) * rstd * g1.y + b1.y); o.w = pk2((v[6] - mean) * rstd * g1.z + b1.z, (v[7] - mean) * rstd * g1.w + b1.w);
            *(v4u*)(dst + off) = o;
            __syncthreads();
        }
    }
    for (int m0 = gw; m0 < MP; m0 += 4 * NGW) {
        v4u vv[4][4]; float s[4], ss[4];
#pragma unroll
        for (int i = 0; i < 4; ++i) { const int m = m0 + i * NGW; s[i] = 0.f; ss[i] = 0.f;
            if (m < MP) { if (lane < 32) { const float* sp = ST + (((size_t)(lane >> 2) * M + m) * 4 + (lane & 3)) * 2; s[i] = sp[0]; ss[i] = sp[1]; }
#pragma unroll
                for (int j = 0; j < 4; ++j) vv[i][j] = *(const v4u*)(VB + (size_t)m * D + j * 512 + lane * 8); } }
#pragma unroll
        for (int i = 0; i < 4; ++i) { const int m = m0 + i * NGW;
            if (m < MP) { const float st = wave_sum(s[i]), sst = wave_sum(ss[i]);
                const float mean = st * (1.f / D), rstd = rsqrtf(fmaxf(sst * (1.f / D) - mean * mean, 0.f) + LN_EPS);
#pragma unroll
                for (int j = 0; j < 4; ++j) { const int col = j * 512 + lane * 8; const v4u v = vv[i][j];
                    const f32x4 g0 = *(const f32x4*)(g + col), g1 = *(const f32x4*)(g + col + 4), b0 = *(const f32x4*)(bta + col), b1 = *(const f32x4*)(bta + col + 4);
                    v4u o; o.x = pk2((bflo(v.x) - mean) * rstd * g0.x + b0.x, (bfhi(v.x) - mean) * rstd * g0.y + b0.y); o.y = pk2((bflo(v.y) - mean) * rstd * g0.z + b0.z, (bfhi(v.y) - mean) * rstd * g0.w + b0.w);
                    o.z = pk2((bflo(v.z) - mean) * rstd * g1.x + b1.x, (bfhi(v.z) - mean) * rstd * g1.y + b1.y); o.w = pk2((bflo(v.w) - mean) * rstd * g1.z + b1.z, (bfhi(v.w) - mean) * rstd * g1.w + b1.w);
                    *(v4u*)(dst + (size_t)m * D + col) = o; } } }
    }
}
__device__ __forceinline__ void phase_combine(const float* p1, const bf16* h2, const bf16* pw, bf16* xb, float* outf, int vcu, int G, const int tid) {
    const int lane = tid & 63, w = tid >> 6;
    for (int r0 = 2 * vcu; r0 < MS; r0 += 2 * G) {
        const int r = r0 + (w >> 2), q = w & 3, col = 512 * q + 8 * lane; const size_t off = (size_t)(MP + r) * D + col;
        const float* q1 = p1 + (size_t)r * D + col;
        f32x4 x0 = *(const f32x4*)q1, x1 = *(const f32x4*)(q1 + 4);
#pragma unroll
        for (int ch = 1; ch < 16; ++ch) { x0 = x0 + *(const f32x4*)(q1 + (size_t)ch * 512 * D); x1 = x1 + *(const f32x4*)(q1 + (size_t)ch * 512 * D + 4); }
        const v4u hh = *(const v4u*)(h2 + off), pp = *(const v4u*)(pw + off);
        f32x4 o0, o1;
        o0.x = bflo(hh.x) + sigm(x0.x) * bflo(pp.x); o0.y = bfhi(hh.x) + sigm(x0.y) * bfhi(pp.x); o0.z = bflo(hh.y) + sigm(x0.z) * bflo(pp.y); o0.w = bfhi(hh.y) + sigm(x0.w) * bfhi(pp.y);
        o1.x = bflo(hh.z) + sigm(x1.x) * bflo(pp.z); o1.y = bfhi(hh.z) + sigm(x1.y) * bfhi(pp.z); o1.z = bflo(hh.w) + sigm(x1.z) * bflo(pp.w); o1.w = bfhi(hh.w) + sigm(x1.w) * bfhi(pp.w);
        v4u ob; ob.x = pk2(o0.x, o0.y); ob.y = pk2(o0.z, o0.w); ob.z = pk2(o1.x, o1.y); ob.w = pk2(o1.z, o1.w); *(v4u*)(xb + off) = ob;
        if (outf) { *(f32x4*)(outf + off) = o0; *(f32x4*)(outf + off + 4) = o1; }
    }
}

constexpr int N_PHASES = 22;
enum { OP_INPROJ = 0, OP_MIXA, OP_MIXB, OP_MIXC, OP_OUTPROJ, OP_LN1, OP_UP, OP_DOWN, OP_LN2, OP_GATE, OP_COMBINE };
enum { GK_LN = 0, GK_BF16 = 1, GK_SQRELU = 2, GK_COMB = 3 };
__global__ void __launch_bounds__(NTHR, 2) mk_fwd(Args a_in) {
    extern __shared__ __attribute__((aligned(16))) unsigned char lds_raw[];
    LAS unsigned char* lds = (LAS unsigned char*)lds_raw;
    ArgsP kp = (ArgsP)__builtin_amdgcn_kernarg_segment_ptr();
    const int lo = a_in.ph_lo, hi = a_in.ph_hi;
    int wv0; { const int wtmp = (int)threadIdx.x >> 6; asm volatile("s_nop 4\n\tv_readfirstlane_b32 %0, %1\n\ts_nop 4" : "=s"(wv0) : "v"(wtmp)); }
#if MK_N_LAUNCHES == 1
    volatile LAS unsigned* xst = (volatile LAS unsigned*)(lds + LDS_CTL_OFF);
    if (threadIdx.x < 2) xst[threadIdx.x] = 0u;
    __syncthreads();
    XcdBarrier bar = xcd_barrier_post((unsigned*)(a_in.ws + WS_CTL) + 4096, xst);
#endif
    int p = lo; asm volatile("" : "+s"(p));
#pragma unroll 1
    for (; p < hi; ) {
      int nrep = 1;
      if (PROBE_MASK) { const int L_ = p <= 11 ? 0 : 1; const int q_ = p == 0 ? -1 : (L_ == 0 ? p - 1 : (p - 12 < 3 ? p - 12 : p - 11));
        int grp; if (p == 0) grp = 0; else if (q_ == OP_INPROJ || q_ == OP_UP) grp = 1; else if (q_ == OP_OUTPROJ || q_ == OP_DOWN || q_ == OP_GATE) grp = 2; else if (q_ == OP_LN1 || q_ == OP_LN2 || q_ == OP_COMBINE) grp = 3; else grp = (L_ == 0) ? 4 : 5;
        if ((PROBE_MASK >> grp) & 1) nrep = 2; }
      if (p == PROBE_P) nrep = 2;
#pragma unroll 1
      for (int rep = 0; rep < nrep; ++rep) {
        int pp = p; asm volatile("" : "+s"(pp));
        int wvs = wv0; asm volatile("" : "+s"(wvs));
        unsigned ones = ~0u; asm volatile("" : "+s"(ones));
        int tid = (wvs << 6) | (int)__builtin_amdgcn_mbcnt_hi(ones, __builtin_amdgcn_mbcnt_lo(ones, 0u)); asm volatile("" : "+v"(tid));
        int bx = blockIdx.x; asm volatile("" : "+s"(bx));
        int G = gridDim.x; asm volatile("" : "+s"(G));
        ArgsP a = kp; asm volatile("" : "+s"(a));
#define MK_VCU ((G % 8 == 0) ? (bx % 8) * (G / 8) + bx / 8 : bx)
#define MK_WAVE (__builtin_amdgcn_readfirstlane(tid >> 6))
#define MK_GW (MK_VCU * NWAVES + MK_WAVE)
#define MK_NGW (G * NWAVES)
#define MK_LANE (tid & 63)
        unsigned char* ws = a->ws;
        if (pp == 0) {
phase_convert(a, lds, MK_GW, MK_NGW, MK_WAVE, MK_LANE); }
        else {
            const int L = pp <= 11 ? 0 : 1; const int q = L == 0 ? pp - 1 : (pp - 12 < 3 ? pp - 12 : pp - 11);
            bf16* xb = (bf16*)(ws + WS_XB); bf16* mixb = (bf16*)(ws + WS_MIX); bf16* hb = (bf16*)(ws + WS_H); bf16* h2b = (bf16*)(ws + WS_H2); bf16* pwb = (bf16*)(ws + WS_PW);
            bf16* projb = (bf16*)(ws + WS_PROJ); bf16* upb = (bf16*)(ws + WS_PROJ);
            bf16* vbb = (bf16*)(ws + WS_PART0); float* stb = (float*)(ws + WS_PART0 + 34 * MiB); float* part1 = (float*)(ws + WS_PART1); float* gatesb = (float*)(ws + WS_GATES);
            if (q == OP_MIXA) { if (L == 0) phase_mixer_even(a, lds, MK_VCU, G, tid); else phase_mixer_odd(a, lds, MK_VCU, G, tid); }
            else if (q == OP_MIXB) { if (L == 0) phase_mixer_even_b(a, lds, MK_VCU, G, tid); else phase_mixer_odd_b(a, lds, MK_VCU, G, tid); }
            else if (q == OP_MIXC) { phase_mixer_even_c(a, lds, MK_VCU, G, tid); }
            else if (q == OP_LN1) phase_ln(vbb, stb, part1, xb, a->in[I_LN1G] + L * D, a->in[I_LN1B] + L * D, hb, lds, MK_VCU, G, tid);
            else if (q == OP_LN2) phase_ln(vbb, stb, part1, hb, a->in[I_LN2G] + L * D, a->in[I_LN2B] + L * D, h2b, lds, MK_VCU, G, tid);
            else if (q == OP_COMBINE) phase_combine(part1, h2b, pwb, xb, L == 1 ? a->out + O_Y : nullptr, MK_VCU, G, tid);
            else {
                for (int sub = 0; sub < (q == OP_OUTPROJ ? 2 : 1); ++sub) {
                    const bf16* A; const bf16* Bt; int N, K, kind; void* out = nullptr; float* gp = nullptr; const bf16* resid = nullptr; int corder = bx;
                    if (q == OP_INPROJ) { A = xb; Bt = (const bf16*)(ws + (L == 0 ? WS_WINE : WS_WINO)); N = NPROJ_PAD; K = D; kind = GK_BF16; out = projb; gp = gatesb; }
                    else if (q == OP_OUTPROJ && sub == 0) { A = mixb; Bt = (const bf16*)(ws + (L == 0 ? WS_WOUTE : WS_WOUTO)); N = D; K = D; kind = GK_LN; resid = xb; }
                    else if (q == OP_OUTPROJ) { A = (const bf16*)(ws + WS_PB) + (size_t)L * M * PLE; Bt = (const bf16*)(ws + WS_WPLE) + (size_t)L * PLE * D; N = D; K = PLE; kind = GK_BF16; out = pwb; corder = (bx + 128) % G; }
                    else if (q == OP_UP) { A = hb; Bt = (const bf16*)(ws + WS_WUP) + (size_t)L * D * FF; N = FF; K = D; kind = GK_SQRELU; out = upb; }
                    else if (q == OP_DOWN) { A = upb; Bt = (const bf16*)(ws + WS_WDOWN) + (size_t)L * D * FF; N = D; K = FF; kind = GK_LN; resid = hb; }
                    else { A = h2b; Bt = (const bf16*)(ws + WS_WGATE) + (size_t)L * D * D; N = D; K = D; kind = GK_COMB; }
                    pg8::Gemm g{A, Bt, M, N, K};
                    if (kind == GK_LN) { pg8::MainSplit SK; SK.init(K, MK_VCU); pg8::EpiLnStat E{vbb, stb, resid, part1, N, M, DN_ALPHA}; pg8::gemm_phase<pg8::EpiLnStat, pg8::MainSplit, true, true>(lds, g, SK, E, tid); }
                    else if (kind == GK_COMB) { pg8::MainSplit SK; SK.init(K, MK_VCU); pg8::EpiCombine E{h2b, pwb, xb, L == 1 ? a->out + O_Y : nullptr, part1, N}; pg8::gemm_phase<pg8::EpiCombine, pg8::MainSplit, true, true>(lds, g, SK, E, tid); }
                    else if (kind == GK_BF16) { pg8::StaticOrder S; S.init(M, N, K, G, corder); pg8::EpiBf16<0> E{(bf16*)out, N, gp, 24}; pg8::gemm_phase<pg8::EpiBf16<0>, pg8::StaticOrder, true, true>(lds, g, S, E, tid); }
                    else { pg8::StaticOrder S; S.init(M, N, K, G, corder); pg8::EpiBf16<1> E{(bf16*)out, N, nullptr, -1}; pg8::gemm_phase<pg8::EpiBf16<1>, pg8::StaticOrder, true, true>(lds, g, S, E, tid); }
                }
            }
        }
#if MK_N_LAUNCHES == 1
        if (p + 1 < hi || rep + 1 < nrep) xcd_barrier(bar);
#endif
      }
      asm volatile("s_add_i32 %0, %0, 1" : "+s"(p) : : "scc");
    }
}

extern "C" void kernel_launch(void* const* d_in, const int* in_sizes, int n_in, void* d_out, int out_size, void* d_ws, size_t ws_size, hipStream_t stream) {
    static int grid = 0;
    if (grid == 0) {
        if (n_in != 35 || (size_t)out_size != O_END || ws_size < WS_END) { fprintf(stderr, "kernel_launch: unexpected shapes: n_in %d out %d (want %zu) ws %zu (want %zu)\n", n_in, out_size, (size_t)O_END, ws_size, (size_t)WS_END); grid = -1; return; }
        int dev = 0, cus = 0, per_cu = 0;
        hipGetDevice(&dev); hipDeviceGetAttribute(&cus, hipDeviceAttributeMultiprocessorCount, dev);
        if (hipFuncSetAttribute((const void*)mk_fwd, hipFuncAttributeMaxDynamicSharedMemorySize, LDS_BYTES) != hipSuccess) { fprintf(stderr, "kernel_launch: hipFuncSetAttribute failed\n"); grid = -1; return; }
        if (hipOccupancyMaxActiveBlocksPerMultiprocessor(&per_cu, (const void*)mk_fwd, NTHR, LDS_BYTES) != hipSuccess || per_cu < 1) { fprintf(stderr, "kernel_launch: occupancy query says %d\n", per_cu); per_cu = 1; }
        (void)hipGetLastError();
        if (cus != 256) { fprintf(stderr, "kernel_launch: built for a 256-CU device (N = 2048 GEMM schedule), got %d\n", cus); grid = -1; return; }
        grid = cus * 1;
    }
    if (grid < 0) return;
    Args a{};
    for (int i = 0; i < 35; ++i) a.in[i] = (const float*)d_in[i];
    a.out = (float*)d_out; a.ws = (unsigned char*)d_ws;
#if MK_N_LAUNCHES == 1
    hipMemsetAsync((char*)d_ws + WS_CTL, 0, 1 * MiB, stream);
    a.ph_lo = 0; a.ph_hi = N_PHASES;
    hipLaunchKernelGGL(mk_fwd, dim3(grid), dim3(NTHR), LDS_BYTES, stream, a);
#else
    for (int p = 0; p < N_PHASES; ++p) {
        a.ph_lo = p; a.ph_hi = p + 1;
        hipLaunchKernelGGL(mk_fwd, dim3(grid), dim3(NTHR), LDS_BYTES, stream, a);
    }
#endif
}
```

```cpp
#include <hip/hip_runtime.h>
#include <hip/hip_cooperative_groups.h>
#include <cstdio>
#include <cstdint>
namespace cg = cooperative_groups;

#ifndef PROBE_MASK
#define PROBE_MASK 0
#endif
#define PROBE_P (-1)
#define PROBE_SUB 0
#ifndef MK_N_LAUNCHES
#define MK_N_LAUNCHES 1
#endif

namespace pg8 {
#define PG8_LAS __attribute__((address_space(3)))
typedef unsigned short bf16_t;
typedef short bf16x8 __attribute__((ext_vector_type(8)));
typedef float f32x4 __attribute__((ext_vector_type(4)));
typedef unsigned u32x4 __attribute__((ext_vector_type(4)));
constexpr int BM = 256, BK = 64, HALF = 128, HTB = HALF * BK * 2, STAGE_BYTES = 8 * HTB, NXCD = 8, WGM = 8;

__host__ __device__ __forceinline__ int lds_byte(int r, int c) { const int st = (r >> 4) * 2 + (c >> 5), rr = r & 15, cc = c & 31, ob = rr * 64 + cc * 2; return st * 1024 + (ob ^ (((ob >> 9) & 1) << 5)); }
__host__ __device__ __forceinline__ void stage_rc(int b, int& R, int& C) { const int st = b / 1024, sb = b % 1024, swz = sb ^ (((sb >> 9) & 1) << 5); R = (st >> 1) * 16 + swz / 64; C = (st & 1) * 32 + (swz % 64) / 2; }
__host__ __device__ __forceinline__ int perm32(int rho) { const int n = rho >> 4, i = rho & 15; return 8 * (i >> 2) + 4 * n + (i & 3); }

struct Unit { int pm, pn, kt0, nkt, dst; };
struct Gemm { const bf16_t* A; const bf16_t* Bt; int M, N, K; };

struct StaticOrder {
    int nM, nN, nwg, G, c, T;
    __host__ __device__ void init(int M, int N, int K, int G_, int c_) { nM = M / BM; nN = N / BM; nwg = nM * nN; G = G_; c = c_; T = K / BK; }
    __host__ __device__ bool next(int i, Unit& u) const {
        const long L = (long)i * G + c; if (L >= nwg) return false;
        int wgid = (int)L; { const int q = nwg / NXCD, r = nwg % NXCD, xcd = wgid % NXCD, off = wgid / NXCD; wgid = (xcd < r ? xcd * (q + 1) : r * (q + 1) + (xcd - r) * q) + off; }
        const int nig = WGM * nN, gid = wgid / nig, fm = gid * WGM, gsz = (nM - fm) < WGM ? (nM - fm) : WGM;
        u.pm = fm + ((wgid % nig) % gsz); u.pn = (wgid % nig) / gsz; u.kt0 = 0; u.nkt = T; u.dst = 0; return true;
    }
    __device__ __forceinline__ void a_ready(const Unit&) const {}
    __device__ __forceinline__ void done(const Unit&) const {}
};
struct StreamK {
    int nN, T, P, ntot, c;
    __host__ __device__ void init(int M, int N, int K, int G, int c_) { nN = N / BM; T = K / BK; ntot = (M / BM) * nN * T; P = (((ntot + G - 1) / G) + 1) & ~1; c = c_; }
    __host__ __device__ bool next(int i, Unit& u) const {
        int s = c * P; const int e = (s + P < ntot) ? s + P : ntot;
        for (int k = 0; ; ++k) { if (s >= e) return false; const int tile = s / T, kt0 = s - tile * T; const int n = (T - kt0 < e - s) ? T - kt0 : e - s;
            if (k == i) { u.pm = tile / nN; u.pn = tile - u.pm * nN; u.kt0 = kt0; u.nkt = n; u.dst = kt0 ? 1 : 0; return true; }
            s += n; }
    }
    __device__ __forceinline__ void a_ready(const Unit&) const {}
    __device__ __forceinline__ void done(const Unit&) const {}
};
struct MainSplit {
    int T, c;
    __host__ __device__ void init(int K, int c_) { T = K / BK; c = c_; }
    __host__ __device__ bool next(int i, Unit& u) const {
        if (i == 0) { u.pm = c >> 3; u.pn = c & 7; u.kt0 = 0; u.nkt = T; u.dst = 0; return true; }
        if (i == 1) { const int lt = c >> 4, j = c & 15; u.pm = 32 + (lt >> 3); u.pn = lt & 7; u.nkt = T >> 4; u.kt0 = j * u.nkt; u.dst = 1 + j; return true; }
        return false;
    }
    __device__ __forceinline__ void a_ready(const Unit&) const {}
    __device__ __forceinline__ void done(const Unit&) const {}
};
__host__ __device__ __forceinline__ bool split_tile(int tile, int T, int P) { return (tile * T) / P != ((tile + 1) * T - 1) / P; }

__device__ __forceinline__ unsigned cvt_pk_bf16(float lo, float hi) { unsigned r; asm volatile("v_cvt_pk_bf16_f32 %0, %1, %2" : "=v"(r) : "v"(lo), "v"(hi)); return r; }

__device__ __forceinline__ float pg_bflo(unsigned w) { return __builtin_bit_cast(float, w << 16); }
__device__ __forceinline__ float pg_bfhi(unsigned w) { return __builtin_bit_cast(float, w & 0xffff0000u); }
__device__ __forceinline__ void store_chunk(const f32x4 (&acc)[2][2][4][2], const Unit& u, float* C1, int ldc, int wr, int wc, int fr, int fq) {
    const int row0 = u.pm * BM + wr * 64 + fr, col0 = u.pn * BM + wc * 32 + 8 * fq; float* Cb = C1 + ((long)(u.dst - 1) * 512 - 8192) * (long)ldc;
#pragma unroll
    for (int ai = 0; ai < 2; ++ai)
#pragma unroll
        for (int m = 0; m < 4; ++m) { float* rowp = Cb + (size_t)(row0 + ai * HALF + m * 16) * ldc + col0;
#pragma unroll
            for (int bj = 0; bj < 2; ++bj) { *(f32x4*)(rowp + bj * HALF) = acc[ai][bj][m][0]; *(f32x4*)(rowp + bj * HALF + 4) = acc[ai][bj][m][1]; } }
}
struct EpiLnStat {
    static constexpr bool PERM = true, AFTER_DRAIN = false;
    bf16_t* VB; float* ST; const bf16_t* resid; float* C1; int ldc; int mrows; float alpha;
    __device__ __forceinline__ void operator()(const f32x4 (&acc)[2][2][4][2], const Unit& u, int wr, int wc, int fr, int fq) const {
        if (u.dst) { store_chunk(acc, u, C1, ldc, wr, wc, fr, fq); return; }
        const int row0 = u.pm * BM + wr * 64 + fr, col0 = u.pn * BM + wc * 32 + 8 * fq;
#pragma unroll
        for (int ai = 0; ai < 2; ++ai)
#pragma unroll
            for (int m = 0; m < 4; ++m) { const int row = row0 + ai * HALF + m * 16; float s = 0.f, ss = 0.f;
#pragma unroll
                for (int bj = 0; bj < 2; ++bj) { const size_t off = (size_t)row * ldc + col0 + bj * HALF; const u32x4 r = *(const u32x4*)(resid + off);
                    f32x4 v0 = acc[ai][bj][m][0], v1 = acc[ai][bj][m][1];
                    v0[0] += alpha * pg_bflo(r.x); v0[1] += alpha * pg_bfhi(r.x); v0[2] += alpha * pg_bflo(r.y); v0[3] += alpha * pg_bfhi(r.y);
                    v1[0] += alpha * pg_bflo(r.z); v1[1] += alpha * pg_bfhi(r.z); v1[2] += alpha * pg_bflo(r.w); v1[3] += alpha * pg_bfhi(r.w);
                    s += ((v0[0] + v0[1]) + (v0[2] + v0[3])) + ((v1[0] + v1[1]) + (v1[2] + v1[3]));
                    ss += ((v0[0] * v0[0] + v0[1] * v0[1]) + (v0[2] * v0[2] + v0[3] * v0[3])) + ((v1[0] * v1[0] + v1[1] * v1[1]) + (v1[2] * v1[2] + v1[3] * v1[3]));
                    u32x4 w; w.x = cvt_pk_bf16(v0[0], v0[1]); w.y = cvt_pk_bf16(v0[2], v0[3]); w.z = cvt_pk_bf16(v1[0], v1[1]); w.w = cvt_pk_bf16(v1[2], v1[3]);
                    *(u32x4*)(VB + off) = w; }
                s += __shfl_xor(s, 16); s += __shfl_xor(s, 32); ss += __shfl_xor(ss, 16); ss += __shfl_xor(ss, 32);
                if (fq == 0) { float* sp = ST + (((size_t)u.pn * mrows + row) * 4 + wc) * 2; sp[0] = s; sp[1] = ss; } }
    }
};
struct EpiCombine {
    static constexpr bool PERM = true, AFTER_DRAIN = false;
    const bf16_t* h2; const bf16_t* pw; bf16_t* xb; float* outf; float* C1; int ldc;
    __device__ __forceinline__ void operator()(const f32x4 (&acc)[2][2][4][2], const Unit& u, int wr, int wc, int fr, int fq) const {
        if (u.dst) { store_chunk(acc, u, C1, ldc, wr, wc, fr, fq); return; }
        const int row0 = u.pm * BM + wr * 64 + fr, col0 = u.pn * BM + wc * 32 + 8 * fq;
#pragma unroll
        for (int ai = 0; ai < 2; ++ai)
#pragma unroll
            for (int m = 0; m < 4; ++m) { const int row = row0 + ai * HALF + m * 16;
#pragma unroll
                for (int bj = 0; bj < 2; ++bj) { const size_t off = (size_t)row * ldc + col0 + bj * HALF; const u32x4 hh = *(const u32x4*)(h2 + off), pp = *(const u32x4*)(pw + off);
                    const f32x4 a0 = acc[ai][bj][m][0], a1 = acc[ai][bj][m][1]; f32x4 o0, o1;
                    o0[0] = pg_bflo(hh.x) + pg_bflo(pp.x) / (1.f + __expf(-a0[0])); o0[1] = pg_bfhi(hh.x) + pg_bfhi(pp.x) / (1.f + __expf(-a0[1]));
                    o0[2] = pg_bflo(hh.y) + pg_bflo(pp.y) / (1.f + __expf(-a0[2])); o0[3] = pg_bfhi(hh.y) + pg_bfhi(pp.y) / (1.f + __expf(-a0[3]));
                    o1[0] = pg_bflo(hh.z) + pg_bflo(pp.z) / (1.f + __expf(-a1[0])); o1[1] = pg_bfhi(hh.z) + pg_bfhi(pp.z) / (1.f + __expf(-a1[1]));
                    o1[2] = pg_bflo(hh.w) + pg_bflo(pp.w) / (1.f + __expf(-a1[2])); o1[3] = pg_bfhi(hh.w) + pg_bfhi(pp.w) / (1.f + __expf(-a1[3]));
                    u32x4 w; w.x = cvt_pk_bf16(o0[0], o0[1]); w.y = cvt_pk_bf16(o0[2], o0[3]); w.z = cvt_pk_bf16(o1[0], o1[1]); w.w = cvt_pk_bf16(o1[2], o1[3]);
                    *(u32x4*)(xb + off) = w;
                    if (outf) { *(f32x4*)(outf + off) = o0; *(f32x4*)(outf + off + 4) = o1; } } }
    }
};
template <int ACT> struct EpiBf16 {
    static constexpr bool PERM = true, AFTER_DRAIN = false;
    bf16_t* O; int ldc; float* gates; int gate_pn;
    __device__ __forceinline__ void operator()(const f32x4 (&acc)[2][2][4][2], const Unit& u, int wr, int wc, int fr, int fq) const {
        const int row0 = u.pm * BM + wr * 64 + fr; const int col0 = u.pn * BM + wc * 32 + 8 * fq;
        const bool gt = (gates != nullptr) && (u.pn == gate_pn) && (wc == 0) && (fq < 2);
#pragma unroll
        for (int ai = 0; ai < 2; ++ai)
#pragma unroll
            for (int m = 0; m < 4; ++m) { const int row = row0 + ai * HALF + m * 16; bf16_t* rowp = O + (size_t)row * ldc + col0;
#pragma unroll
                for (int bj = 0; bj < 2; ++bj) { f32x4 v0 = acc[ai][bj][m][0], v1 = acc[ai][bj][m][1];
                    if (ACT == 1) {
#pragma unroll
                        for (int j = 0; j < 4; ++j) { const float a = fmaxf(v0[j], 0.f), b = fmaxf(v1[j], 0.f); v0[j] = a * a; v1[j] = b * b; } }
                    u32x4 w; w.x = cvt_pk_bf16(v0[0], v0[1]); w.y = cvt_pk_bf16(v0[2], v0[3]); w.z = cvt_pk_bf16(v1[0], v1[1]); w.w = cvt_pk_bf16(v1[2], v1[3]);
                    *(u32x4*)(rowp + bj * HALF) = w; }
                if (gt) { float* gp = gates + (size_t)row * 16 + 8 * fq; *(f32x4*)gp = acc[ai][0][m][0]; *(f32x4*)(gp + 4) = acc[ai][0][m][1]; } }
    }
};

template <class Epi, class Sched, bool ALIGN_EPI = false, bool SP2 = false>
__device__ __forceinline__ void gemm_phase(PG8_LAS unsigned char* lds, const Gemm g, const Sched& S, const Epi& E, const int tid) {
    const int wid = __builtin_amdgcn_readfirstlane(tid >> 6), lane = tid & 63, wr = wid >> 2, wc = wid & 3, fr = lane & 15, fq = lane >> 4;
    const int K = g.K;
    unsigned voffA[2], voffB[2];
#pragma unroll
    for (int i = 0; i < 2; ++i) { int R, C; stage_rc(tid * 16 + i * 8192, R, C); const int Rb = Epi::PERM ? ((R & ~31) + perm32(R & 31)) : R;
        voffA[i] = (unsigned)(R * K + C) * 2u; voffB[i] = (unsigned)(Rb * K + C) * 2u; }
    const size_t kstep = (size_t)(BK * 2);
    const size_t hstep = (size_t)HALF * K * 2;
    const size_t tstep = 2 * hstep;
    const unsigned ldsw = (unsigned)wid * 1024u;
    const int aoff = lds_byte(wr * 64 + fr, fq * 8), boff = lds_byte(wc * 32 + fr, fq * 8);
#define PG8_SA(b, h) (((b) * 2 + (h)) * HTB)
#define PG8_SB(b, h) ((4 + (b) * 2 + (h)) * HTB)
#define PG8_STAGE(bufoff, gbase, voff) do { _Pragma("unroll") for (int _i = 0; _i < 2; ++_i) \
        __builtin_amdgcn_global_load_lds((const unsigned*)((const char*)(gbase) + (voff)[_i]), (PG8_LAS unsigned*)(lds + (bufoff) + ldsw + _i * 8192), 16, 0, 0); } while (0)
#define PG8_LDA(dst, b, h) do { _Pragma("unroll") for (int m = 0; m < 4; ++m) _Pragma("unroll") for (int k = 0; k < 2; ++k) dst[m][k] = *(const PG8_LAS bf16x8*)(lds + PG8_SA(b, h) + aoff + m * 2048 + k * 1024); } while (0)
#define PG8_LDB(dst, b, h) do { _Pragma("unroll") for (int n = 0; n < 2; ++n) _Pragma("unroll") for (int k = 0; k < 2; ++k) dst[n][k] = *(const PG8_LAS bf16x8*)(lds + PG8_SB(b, h) + boff + n * 2048 + k * 1024); } while (0)
#define PG8_MMA(ai, bj, At, Bt) do { __builtin_amdgcn_s_setprio(1); _Pragma("unroll") for (int m = 0; m < 4; ++m) _Pragma("unroll") for (int n = 0; n < 2; ++n) _Pragma("unroll") for (int k = 0; k < 2; ++k) \
        acc[ai][bj][m][n] = __builtin_amdgcn_mfma_f32_16x16x32_bf16(Bt[n][k], At[m][k], acc[ai][bj][m][n], 0, 0, 0); __builtin_amdgcn_s_setprio(0); } while (0)
#define PG8_WAIT_V(n) asm volatile("s_waitcnt vmcnt(" #n ")" ::: "memory")
#define PG8_WAIT_L(n) asm volatile("s_waitcnt lgkmcnt(" #n ")" ::: "memory")
#define PG8_BAR __builtin_amdgcn_s_barrier()
#define PG8_SCHED __builtin_amdgcn_sched_barrier(0)
    Unit cur, nxt; int ui = 0;
    if (!S.next(0, cur)) return;
    f32x4 acc[2][2][4][2];
#pragma unroll
    for (int a = 0; a < 2; ++a)
#pragma unroll
        for (int b = 0; b < 2; ++b)
#pragma unroll
            for (int m = 0; m < 4; ++m)
#pragma unroll
                for (int n = 0; n < 2; ++n) acc[a][b][m][n] = (f32x4){0.f, 0.f, 0.f, 0.f};
    bf16x8 At[4][2], B0[2][2], B1[2][2];
    const char* cA = (const char*)g.A + (size_t)cur.pm * tstep + (size_t)cur.kt0 * kstep; const char* cB = (const char*)g.Bt + (size_t)cur.pn * tstep + (size_t)cur.kt0 * kstep;
    S.a_ready(cur);
    if constexpr (SP2) {
        PG8_STAGE(PG8_SB(0, 0), cB, voffB); PG8_STAGE(PG8_SB(0, 1), cB + hstep, voffB); PG8_STAGE(PG8_SA(0, 0), cA, voffA); PG8_STAGE(PG8_SA(0, 1), cA + hstep, voffA);
        if (wr == 1) PG8_BAR;
        PG8_WAIT_V(2); PG8_BAR;
        PG8_STAGE(PG8_SB(1, 0), cB + kstep, voffB); PG8_STAGE(PG8_SA(1, 0), cA + kstep, voffA); PG8_STAGE(PG8_SB(1, 1), cB + hstep + kstep, voffB);
        PG8_WAIT_V(6); PG8_BAR;
    } else {
        PG8_STAGE(PG8_SB(0, 0), cB, voffB); PG8_STAGE(PG8_SA(0, 0), cA, voffA); PG8_STAGE(PG8_SB(0, 1), cB + hstep, voffB); PG8_STAGE(PG8_SA(0, 1), cA + hstep, voffA);
        if (wr == 1) PG8_BAR;
        PG8_WAIT_V(4); PG8_BAR;
        PG8_STAGE(PG8_SB(1, 0), cB + kstep, voffB); PG8_STAGE(PG8_SA(1, 0), cA + kstep, voffA); PG8_STAGE(PG8_SB(1, 1), cB + hstep + kstep, voffB);
        PG8_WAIT_V(6); PG8_BAR;
    }
    for (;;) {
        const bool has_next = S.next(ui + 1, nxt);
        const char* nA = has_next ? (const char*)g.A + (size_t)nxt.pm * tstep + (size_t)nxt.kt0 * kstep : cA; const char* nB = has_next ? (const char*)g.Bt + (size_t)nxt.pn * tstep + (size_t)nxt.kt0 * kstep : cB;
        const int nt = cur.nkt;
        for (int t = 0; t < nt; t += 2) {
            const bool last = (t == nt - 2);
            const char* a1 = cA + (size_t)(t + 1) * kstep;
            const char* a2 = last ? nA : cA + (size_t)(t + 2) * kstep; const char* b2 = last ? nB : cB + (size_t)(t + 2) * kstep;
            const char* a3 = a2 + kstep; const char* b3 = b2 + kstep;
            if (last && has_next) S.a_ready(nxt);
            if constexpr (SP2) {
            PG8_LDB(B0, 0, 0); PG8_LDB(B1, 0, 1); PG8_SCHED; PG8_LDA(At, 0, 0); PG8_STAGE(PG8_SA(1, 1), a1 + hstep, voffA);
            PG8_WAIT_V(8); PG8_WAIT_L(0); PG8_BAR; PG8_MMA(0, 0, At, B0); PG8_MMA(0, 1, At, B1); PG8_BAR; PG8_SCHED;
            PG8_LDA(At, 0, 1); PG8_STAGE(PG8_SB(0, 0), b2, voffB); PG8_STAGE(PG8_SB(0, 1), b2 + hstep, voffB); PG8_STAGE(PG8_SA(0, 0), a2, voffA);
            PG8_WAIT_V(8); PG8_WAIT_L(0); PG8_BAR; PG8_MMA(1, 0, At, B0); PG8_MMA(1, 1, At, B1); PG8_BAR; PG8_SCHED;
            PG8_LDB(B0, 1, 0); PG8_LDB(B1, 1, 1); PG8_SCHED; PG8_LDA(At, 1, 0); PG8_STAGE(PG8_SA(0, 1), a2 + hstep, voffA);
            PG8_WAIT_V(8); PG8_WAIT_L(0); PG8_BAR; PG8_MMA(0, 0, At, B0); PG8_MMA(0, 1, At, B1); PG8_BAR; PG8_SCHED;
            PG8_LDA(At, 1, 1); PG8_STAGE(PG8_SB(1, 0), b3, voffB); PG8_STAGE(PG8_SB(1, 1), b3 + hstep, voffB); PG8_STAGE(PG8_SA(1, 0), a3, voffA);
            PG8_WAIT_V(8); PG8_WAIT_L(0); PG8_BAR; PG8_MMA(1, 0, At, B0); PG8_MMA(1, 1, At, B1); PG8_BAR; PG8_SCHED;
            } else {
            PG8_LDB(B0, 0, 0); PG8_SCHED; PG8_LDA(At, 0, 0); PG8_STAGE(PG8_SA(1, 1), a1 + hstep, voffA);
            PG8_WAIT_L(8); PG8_BAR; PG8_WAIT_L(0); PG8_MMA(0, 0, At, B0); PG8_BAR; PG8_SCHED;
            PG8_LDB(B1, 0, 1); PG8_STAGE(PG8_SB(0, 0), b2, voffB);
            PG8_BAR; PG8_WAIT_L(0); PG8_MMA(0, 1, At, B1); PG8_BAR;
            PG8_LDA(At, 0, 1); PG8_STAGE(PG8_SA(0, 0), a2, voffA);
            PG8_BAR; PG8_WAIT_L(0); PG8_MMA(1, 0, At, B0); PG8_BAR; PG8_SCHED;
            PG8_STAGE(PG8_SB(0, 1), b2 + hstep, voffB);
            PG8_WAIT_V(6); PG8_BAR; PG8_MMA(1, 1, At, B1); PG8_BAR;
            PG8_LDB(B0, 1, 0); PG8_SCHED; PG8_LDA(At, 1, 0); PG8_STAGE(PG8_SA(0, 1), a2 + hstep, voffA);
            PG8_WAIT_L(8); PG8_BAR; PG8_WAIT_L(0); PG8_MMA(0, 0, At, B0); PG8_BAR; PG8_SCHED;
            PG8_LDB(B1, 1, 1); PG8_STAGE(PG8_SB(1, 0), b3, voffB);
            PG8_BAR; PG8_WAIT_L(0); PG8_MMA(0, 1, At, B1); PG8_BAR;
            PG8_LDA(At, 1, 1); PG8_STAGE(PG8_SA(1, 0), a3, voffA);
            PG8_BAR; PG8_WAIT_L(0); PG8_MMA(1, 0, At, B0); PG8_BAR; PG8_SCHED;
            PG8_STAGE(PG8_SB(1, 1), b3 + hstep, voffB);
            PG8_WAIT_V(6); PG8_BAR; PG8_MMA(1, 1, At, B1); PG8_BAR;
            }
        }
        if constexpr (ALIGN_EPI) { if (wr == 0) PG8_BAR; }
        E(acc, cur, wr, wc, fr, fq); S.done(cur);
        if (!has_next) break;
#pragma unroll
        for (int a = 0; a < 2; ++a)
#pragma unroll
            for (int b = 0; b < 2; ++b)
#pragma unroll
                for (int m = 0; m < 4; ++m)
#pragma unroll
                    for (int n = 0; n < 2; ++n) acc[a][b][m][n] = (f32x4){0.f, 0.f, 0.f, 0.f};
        cur = nxt; cA = nA; cB = nB; ++ui;
        if constexpr (ALIGN_EPI) { if (wr == 1) PG8_BAR; }
    }
    PG8_WAIT_V(0);
    if constexpr (!ALIGN_EPI) { if (wr == 0) PG8_BAR; }
    PG8_BAR;
#undef PG8_SA
#undef PG8_SB
#undef PG8_STAGE
#undef PG8_LDA
#undef PG8_LDB
#undef PG8_MMA
#undef PG8_WAIT_V
#undef PG8_WAIT_L
#undef PG8_BAR
#undef PG8_SCHED
}
}

constexpr int NWAVES = 8, NTHR = 512;
constexpr int D = 2048, FF = 8192, PLE = 256;
constexpr int TP = 2048, BP = 4, TS = 4, BS = 128;
constexpr int MP = BP * TP, MS = BS * TS, M = MP + MS;
constexpr int NPROJ = 6160, NPROJ_PAD = 6400;
constexpr int NH = 8;
constexpr float LN_EPS = 1e-5f, RMS_EPS = 1e-6f;
constexpr float DN_ALPHA = 1.41421356237f;

constexpr size_t MiB = 1u << 20;
constexpr size_t WS_CTL = 0;
constexpr size_t WS_WINE = 1 * MiB;
constexpr size_t WS_WOUTE = WS_WINE + 25 * MiB;
constexpr size_t WS_WINO = WS_WOUTE + 8 * MiB;
constexpr size_t WS_WOUTO = WS_WINO + 25 * MiB;
constexpr size_t WS_WUP = WS_WOUTO + 8 * MiB;
constexpr size_t WS_WDOWN = WS_WUP + 64 * MiB;
constexpr size_t WS_WPLE = WS_WDOWN + 64 * MiB;
constexpr size_t WS_WGATE = WS_WPLE + 2 * MiB;
constexpr size_t WS_XB = WS_WGATE + 16 * MiB;
constexpr size_t WS_MIX = WS_XB + 34 * MiB;
constexpr size_t WS_H = WS_MIX + 34 * MiB;
constexpr size_t WS_H2 = WS_H + 34 * MiB;
constexpr size_t WS_PW = WS_H2 + 34 * MiB;
constexpr size_t WS_PB = WS_PW + 34 * MiB;
constexpr size_t WS_GATES = WS_PB + 9 * MiB;
constexpr size_t WS_PROJ = WS_GATES + 1 * MiB;
constexpr size_t WS_PART0 = WS_PROJ + 136 * MiB;
constexpr size_t WS_PART1 = WS_PART0 + 68 * MiB;
constexpr size_t WS_LRUW = WS_PART1 + 68 * MiB;
constexpr size_t WS_END = WS_LRUW + 1 * MiB;
constexpr size_t WS_DG = WS_PART0;
constexpr size_t WS_DB = WS_PART0 + 32 * MiB;
constexpr size_t WS_DS = WS_PART0 + 64 * MiB;
constexpr size_t WS_DQ = WS_PART0 + 96 * MiB;
constexpr size_t WS_DO = WS_PART0 + 112 * MiB;
constexpr size_t WS_DD = WS_PART0 + 128 * MiB;
constexpr size_t WS_DF = WS_PART0 + 129 * MiB;
constexpr size_t WS_MC = WS_PART0;
constexpr size_t WS_MN = WS_PART0 + 64 * MiB;
constexpr size_t WS_MM = WS_PART0 + 65 * MiB;
constexpr size_t WS_LRU_HL = WS_H;
constexpr size_t WS_LRU_P = WS_H + 16 * MiB;
constexpr size_t WS_LRU_END = WS_H + 32 * MiB;

constexpr size_t O_Y = 0;
constexpr size_t O_CONVP = (size_t)M * D;
constexpr size_t O_DELTAP = O_CONVP + (size_t)BP * 3 * 4096;
constexpr size_t O_LRUP = O_DELTAP + (size_t)BP * 8 * 128 * 128;
constexpr size_t O_MCP = O_LRUP + (size_t)BP * 1024;
constexpr size_t O_MNP = O_MCP + (size_t)BP * 8 * 256 * 128;
constexpr size_t O_MMP = O_MNP + (size_t)BP * 8 * 128;
constexpr size_t O_CONVS = O_MMP + (size_t)BP * 8;
constexpr size_t O_DELTAS = O_CONVS + (size_t)BS * 3 * 4096;
constexpr size_t O_LRUS = O_DELTAS + (size_t)BS * 8 * 128 * 128;
constexpr size_t O_MCS = O_LRUS + (size_t)BS * 1024;
constexpr size_t O_MNS = O_MCS + (size_t)BS * 8 * 256 * 128;
constexpr size_t O_MMS = O_MNS + (size_t)BS * 8 * 128;
constexpr size_t O_END = O_MMS + (size_t)BS * 8;

constexpr int LDS_BYTES = 147456;
constexpr int LDS_CTL_OFF = 131072;

#define LAS __attribute__((address_space(3)))
typedef unsigned short bf16;
typedef unsigned v4u __attribute__((ext_vector_type(4)));
typedef unsigned v2u __attribute__((ext_vector_type(2)));
typedef float f32x4 __attribute__((ext_vector_type(4)));
#define LDS_WAIT() asm volatile("s_waitcnt lgkmcnt(0)" ::: "memory")
__device__ __forceinline__ unsigned f2bf(float f) { unsigned u = __builtin_bit_cast(unsigned, f); return (u + 0x7fffu + ((u >> 16) & 1u)) >> 16; }
__device__ __forceinline__ unsigned pk2(float lo, float hi) { return f2bf(lo) | (f2bf(hi) << 16); }
__device__ __forceinline__ float bf2f(unsigned short b) { return __builtin_bit_cast(float, ((unsigned)b) << 16); }
__device__ __forceinline__ float bflo(unsigned w) { return __builtin_bit_cast(float, w << 16); }
__device__ __forceinline__ float bfhi(unsigned w) { return __builtin_bit_cast(float, w & 0xffff0000u); }
__device__ __forceinline__ float fexp(float x) { return __builtin_amdgcn_exp2f(x * 1.4426950408889634f); }
__device__ __forceinline__ float sigm(float x) { return __builtin_amdgcn_rcpf(1.f + fexp(-x)); }
__device__ __forceinline__ float siluf(float x) { return x * sigm(x); }
__device__ __forceinline__ float softplusf(float x) { return fmaxf(x, 0.f) + log1pf(expf(-fabsf(x))); }
__device__ __forceinline__ float logsigf(float x) { return -softplusf(-x); }
__device__ __forceinline__ float neg_expm1(float y) {
    const float ser = -y * (1.f + y * (0.5f + y * (0.16666667f + y * (0.041666668f + y * (0.008333334f + y * 0.0013888889f)))));
    return (y > -0.25f) ? ser : 1.f - fexp(y);
}
__device__ __forceinline__ float gelu_tanh(float x) { const float u = 0.7978845608028654f * (x + 0.044715f * x * x * x); return x * sigm(2.f * u); }
__device__ __forceinline__ float wave_sum(float v) {
#pragma unroll
    for (int o = 1; o < 64; o <<= 1) v += __shfl_xor(v, o);
    return v;
}

#define XB_TMO      128
#define XB_XCNT(j)  (256  + 64 * (j))
#define XB_XSUB(j)  (1280 + 64 * (j))
#define XB_XGEN(j)  (2304 + 64 * (j))
#define XB_TOP      3328
#define XB_TOPGEN   3392
#define XCD_BAR_WORDS 3456
#define XB_SPIN_CAP (1u << 22)
__device__ __forceinline__ unsigned xb_ld(unsigned* p)              { return __hip_atomic_load(p, __ATOMIC_RELAXED, __HIP_MEMORY_SCOPE_AGENT); }
__device__ __forceinline__ unsigned xb_add(unsigned* p, unsigned v) { return __hip_atomic_fetch_add(p, v, __ATOMIC_RELAXED, __HIP_MEMORY_SCOPE_AGENT); }
__device__ __forceinline__ unsigned xb_xcc_id() { return (unsigned)__builtin_amdgcn_s_getreg((3 << 11) | 20) & 0xFu; }
#define XB_SPIN(cond, bar) do { unsigned _sp = 0; while (cond) { __builtin_amdgcn_s_sleep(1); \
    if ((++_sp & 255u) == 0u) { if (xb_ld(&(bar)[XB_TMO])) break; if (_sp > XB_SPIN_CAP) { atomicAdd(&(bar)[XB_TMO], 1u); break; } } } } while (0)
struct XcdBarrier { unsigned* bar; unsigned x; volatile LAS unsigned* st; };
__device__ __forceinline__ XcdBarrier xcd_barrier_post(unsigned* bar, volatile LAS unsigned* st) {
    XcdBarrier b; b.bar = bar; b.x = xb_xcc_id(); b.st = st;
    if (threadIdx.x == 0) (void)xb_add(&bar[XB_XCNT(b.x)], 1u);
    return b;
}
__device__ __forceinline__ void xcd_barrier_complete(unsigned* bar, unsigned x, unsigned& nloc, unsigned& nx) {
    const unsigned G = gridDim.x * gridDim.y * gridDim.z;
    unsigned sum, cnt, mine, sp = 0u;
    for (;;) {
        sum = 0u; cnt = 0u; mine = 0u;
#pragma unroll
        for (unsigned j = 0; j < 16; ++j) { const unsigned c = xb_ld(&bar[XB_XCNT(j)]); sum += c; cnt += (c > 0u) ? 1u : 0u; mine = (j == x) ? c : mine; }
        if (sum == G) break;
        __builtin_amdgcn_s_sleep(1);
        if ((++sp & 255u) == 0u) { if (xb_ld(&bar[XB_TMO])) break; if (sp > XB_SPIN_CAP) { atomicAdd(&bar[XB_TMO], 1u); break; } }
    }
    nloc = mine > 0u ? mine : 1u; nx = cnt > 0u ? cnt : 1u;
}
__device__ __forceinline__ void xcd_barrier(const XcdBarrier& b) {
    asm volatile("s_waitcnt vmcnt(0)" ::: "memory");
    __syncthreads();
    if (threadIdx.x == 0) {
        unsigned* bar = b.bar;
        __builtin_amdgcn_s_waitcnt(0);
        unsigned nloc = b.st[0], nx = b.st[1];
        if (nloc == 0u) { xcd_barrier_complete(bar, b.x, nloc, nx); b.st[0] = nloc; b.st[1] = nx; }
        const unsigned old = xb_add(&bar[XB_XSUB(b.x)], 1u);
        const unsigned gen = old / nloc;
        if (old + 1u == (gen + 1u) * nloc) {
            __builtin_amdgcn_fence(__ATOMIC_RELEASE, "agent");
            asm volatile("s_waitcnt vmcnt(0)" ::: "memory");
            const unsigned og = xb_add(&bar[XB_TOP], 1u);
            const unsigned tg = og / nx;
            if (og + 1u == (tg + 1u) * nx) xb_add(&bar[XB_TOPGEN], 1u);
            else XB_SPIN(xb_ld(&bar[XB_TOPGEN]) == tg, bar);
            __builtin_amdgcn_fence(__ATOMIC_ACQUIRE, "agent");
            xb_add(&bar[XB_XGEN(b.x)], 1u);
            asm volatile("s_waitcnt vmcnt(0)" ::: "memory");
        } else {
            XB_SPIN(xb_ld(&bar[XB_XGEN(b.x)]) == gen, bar);
            __builtin_amdgcn_fence(__ATOMIC_ACQUIRE, "agent");
            asm volatile("s_waitcnt vmcnt(0)" ::: "memory");
        }
    }
    __syncthreads();
}

struct Args { const float* in[35]; float* out; unsigned char* ws; int ph_lo, ph_hi; };
typedef const __attribute__((address_space(4))) Args* ArgsP;
enum { I_XP = 0, I_XS, I_PP, I_PS, I_SCONV, I_SDELTA, I_SLRU, I_SMC, I_SMN, I_SMM, I_WINE, I_WCONV, I_BCONV, I_ALOG, I_DTB, I_DNORM, I_LWR, I_LBR, I_LWI, I_LBI, I_LLAM, I_WOUTE,
       I_WINO, I_BIG, I_BFG, I_MNORM, I_WOUTO, I_LN1G, I_LN1B, I_LN2G, I_LN2B, I_WUP, I_WDOWN, I_WPLE, I_WGATE };

struct TDesc { const float* W; bf16* WT; int K, N, Npad, item; };
__device__ __forceinline__ void t_load(const TDesc& d, int lane, f32x4 (&v)[8]) {
    const int nblk = d.Npad / 32, kb = d.item / nblk, nb = d.item % nblk, k0 = 64 * kb, n0 = 32 * nb;
    const int r = lane >> 3, c4 = lane & 7; const bool ok = (n0 + 4 * c4) < d.N;
#pragma unroll
    for (int i = 0; i < 8; ++i) v[i] = ok ? __builtin_nontemporal_load((const f32x4*)(d.W + (size_t)(k0 + 8 * i + r) * d.N + n0 + 4 * c4)) : (f32x4){0.f, 0.f, 0.f, 0.f};
}
__device__ __forceinline__ void t_finish(const TDesc& d, LAS float* scr, int lane, const f32x4 (&v)[8]) {
    const int nblk = d.Npad / 32, kb = d.item / nblk, nb = d.item % nblk, k0 = 64 * kb, n0 = 32 * nb;
    const int r = lane >> 3, c4 = lane & 7;
#pragma unroll
    for (int i = 0; i < 8; ++i) { LAS float* q = scr + (8 * i + r) * 33 + 4 * c4; q[0] = v[i].x; q[1] = v[i].y; q[2] = v[i].z; q[3] = v[i].w; }
    LDS_WAIT(); asm volatile("" ::: "memory");
    const int c = lane & 7;
#pragma unroll
    for (int j = 0; j < 4; ++j) { const int n = (lane >> 3) + 8 * j; const LAS float* s = scr + (8 * c) * 33 + n;
        v4u o; o.x = pk2(s[0 * 33], s[1 * 33]); o.y = pk2(s[2 * 33], s[3 * 33]); o.z = pk2(s[4 * 33], s[5 * 33]); o.w = pk2(s[6 * 33], s[7 * 33]);
        *(v4u*)(d.WT + (size_t)(n0 + n) * d.K + k0 + 8 * c) = o; }
    LDS_WAIT(); asm volatile("" ::: "memory");
}
__device__ __forceinline__ void p0_transpose_item(const float* W, int K, int N, int Npad, bf16* WT, LAS float* scr, int item, int lane) {
    const TDesc d{W, WT, K, N, Npad, item}; f32x4 v[8]; t_load(d, lane, v); t_finish(d, scr, lane, v);
}
__device__ __forceinline__ void row_to_bf16(const float* src, bf16* dst, int n, int lane) {
    for (int j = 0; j < n / 256; ++j) { const f32x4 v = *(const f32x4*)(src + j * 256 + lane * 4); v2u o; o.x = pk2(v.x, v.y); o.y = pk2(v.z, v.w); *(v2u*)(dst + j * 256 + lane * 4) = o; }
}

namespace cv { constexpr int I_IN = (D / 64) * (NPROJ_PAD / 32), I_SQ = (D / 64) * (D / 32), I_UP = (D / 64) * (FF / 32), I_DN = (FF / 64) * (D / 32), I_PL = (PLE / 64) * (D / 32);
               constexpr int N_FIRST = I_IN + I_PL + 128, N_REST = I_IN + 2 * I_SQ + 2 * I_UP + 2 * I_DN + I_PL + 2 * I_SQ;
               constexpr int R_IN0 = 6200;
               constexpr int R_G1 = I_SQ + I_UP + I_SQ + I_IN + I_SQ + I_PL + I_SQ;
               constexpr int R_IN1 = R_G1 + I_UP;
               constexpr int R_SCAN = R_IN1 - 6200;
               constexpr int R_UP0 = R_IN1 + I_DN;
               static_assert(R_UP0 + I_DN == N_REST && R_SCAN > R_G1 && R_SCAN > R_IN0, "conversion ranges"); }
__device__ __forceinline__ void convert_first_item(ArgsP a, LAS float* scr, int r, int lane) {
    unsigned char* ws = a->ws;
    if (r < cv::I_IN) { p0_transpose_item(a->in[I_WINE], D, NPROJ, NPROJ_PAD, (bf16*)(ws + WS_WINE), scr, r, lane); return; } r -= cv::I_IN;
    if (r < cv::I_PL) { p0_transpose_item(a->in[I_WPLE], PLE, D, D, (bf16*)(ws + WS_WPLE), scr, r, lane); return; } r -= cv::I_PL;
    { const int mat = r / 64, blk = (r / 8) & 7; p0_transpose_item(a->in[mat == 0 ? I_LWR : I_LWI] + (size_t)blk * 16384, 128, 128, 128, (bf16*)(ws + WS_LRUW) + (size_t)(mat * 8 + blk) * 16384, scr, r % 8, lane); }
}
__device__ __forceinline__ TDesc decode_rest(ArgsP a, int r) {
    using namespace cv; unsigned char* ws = a->ws;
    if (r < I_SQ) return TDesc{a->in[I_WOUTE], (bf16*)(ws + WS_WOUTE), D, D, D, r}; r -= I_SQ;
    if (r < I_UP) return TDesc{a->in[I_WUP], (bf16*)(ws + WS_WUP), D, FF, FF, r}; r -= I_UP;
    if (r < I_SQ) return TDesc{a->in[I_WGATE], (bf16*)(ws + WS_WGATE), D, D, D, r}; r -= I_SQ;
    if (r < I_IN) return TDesc{a->in[I_WINO], (bf16*)(ws + WS_WINO), D, NPROJ, NPROJ_PAD, r}; r -= I_IN;
    if (r < I_SQ) return TDesc{a->in[I_WOUTO], (bf16*)(ws + WS_WOUTO), D, D, D, r}; r -= I_SQ;
    if (r < I_PL) return TDesc{a->in[I_WPLE] + (size_t)PLE * D, (bf16*)(ws + WS_WPLE) + (size_t)PLE * D, PLE, D, D, r}; r -= I_PL;
    if (r < I_SQ) return TDesc{a->in[I_WGATE] + (size_t)D * D, (bf16*)(ws + WS_WGATE) + (size_t)D * D, D, D, D, r}; r -= I_SQ;
    if (r < I_UP) return TDesc{a->in[I_WUP] + (size_t)D * FF, (bf16*)(ws + WS_WUP) + (size_t)D * FF, D, FF, FF, r}; r -= I_UP;
    if (r < I_DN) return TDesc{a->in[I_WDOWN], (bf16*)(ws + WS_WDOWN), FF, D, D, r}; r -= I_DN;
    return TDesc{a->in[I_WDOWN] + (size_t)D * FF, (bf16*)(ws + WS_WDOWN) + (size_t)D * FF, FF, D, D, r};
}
__device__ __forceinline__ void convert_range(ArgsP a, LAS float* scr, int first, int last, int widx, int nw, int lane) {
    int it = first + widx;
    TDesc dA, dB; f32x4 vA[8], vB[8];
    if (it < last) { dA = decode_rest(a, it); t_load(dA, lane, vA);
#pragma unroll 1
        for (;;) {
            const int itB = it + nw; const bool hasB = itB < last;
            if (hasB) { dB = decode_rest(a, itB); t_load(dB, lane, vB); }
            t_finish(dA, scr, lane, vA);
            if (!hasB) break;
            it = itB + nw; const bool hasA = it < last;
            if (hasA) { dA = decode_rest(a, it); t_load(dA, lane, vA); }
            t_finish(dB, scr, lane, vB);
            if (!hasA) break;
        } }
}
__device__ __forceinline__ void phase_convert(ArgsP a, LAS unsigned char* lds, int gw, int NGW, int wave, int lane) {
    unsigned char* ws = a->ws;
    LAS float* scr = (LAS float*)(lds + wave * 16384);
    for (int it = gw; it < cv::N_FIRST; it += NGW) convert_first_item(a, scr, it, lane);
    bf16* xb = (bf16*)(ws + WS_XB);
    for (int m = gw; m < M; m += NGW) {
        const float* src = m < MP ? a->in[I_XP] + (size_t)m * D : a->in[I_XS] + (size_t)(m - MP) * D;
        row_to_bf16(src, xb + (size_t)m * D, D, lane);
    }
    bf16* pb = (bf16*)(ws + WS_PB);
    for (int r = gw; r < 2 * M; r += NGW) {
        const int l = r / M, m = r % M;
        const float* src = m < MP ? a->in[I_PP] + ((size_t)l * MP + m) * PLE : a->in[I_PS] + ((size_t)l * MS + (m - MP)) * PLE;
        row_to_bf16(src, pb + (size_t)r * PLE, PLE, lane);
    }
}

__device__ __forceinline__ float conv_in(const bf16* proj, int row0, int tq, int ch, const float* cstate) {
    if (tq >= 0) return bf2f(proj[(size_t)(row0 + tq) * NPROJ_PAD + ch]);
    return cstate ? cstate[(3 + tq) * 4096 + ch] : 0.f;
}
__device__ __forceinline__ float conv4(const bf16* proj, int row0, int t, int ch, const float* cstate, const float* wconv, const float* bconv) {
    float acc = bconv[ch];
#pragma unroll
    for (int j = 0; j < 4; ++j) acc += wconv[j * 4096 + ch] * conv_in(proj, row0, t - 3 + j, ch, cstate);
    return acc;
}

__device__ __forceinline__ void delta_rec_item(ArgsP a, LAS unsigned char* lds, int row0, int T, int h, const float* cstate, const float* S0, float* Sout, const int tid) {
    const int lane = tid & 63, wave = tid >> 6, c = tid & 127, r = tid >> 7;
    const bf16* proj = (const bf16*)(a->ws + WS_PROJ); const float* gates = (const float*)(a->ws + WS_GATES); bf16* mix = (bf16*)(a->ws + WS_MIX);
    const float* wconv = a->in[I_WCONV]; const float* bconv = a->in[I_BCONV];
    LAS float* act = (LAS float*)lds;
    LAS float* nrm = act + 4 * 384;
    LAS float* gb = nrm + 8;
    LAS float* red = gb + 8;
    LAS float* red2 = red + 512;
    LAS float* obuf = red2 + 512;
    float s[32];
#pragma unroll
    for (int i = 0; i < 32; ++i) s[i] = S0 ? S0[(size_t)(32 * r + i) * 128 + c] : 0.f;
    const float aexp = fexp(a->in[I_ALOG][h]), dtb = a->in[I_DTB][h];
#pragma unroll 1
    for (int t0 = 0; t0 < T; t0 += 4) {
#pragma unroll
        for (int j = 0; j < 3; ++j) { const int idx = tid + 512 * j, tok = idx / 384, chl = idx % 384, part = chl >> 7, i = chl & 127;
            const int ch = part * 1024 + h * 128 + i;
            act[tok * 384 + chl] = siluf(conv4(proj, row0, t0 + tok, ch, cstate, wconv, bconv)); }
        __syncthreads();
        { const int tok = wave >> 1, part = wave & 1; const float x0 = act[tok * 384 + part * 128 + lane], x1 = act[tok * 384 + part * 128 + 64 + lane];
          const float ss = wave_sum(x0 * x0 + x1 * x1); if (lane == 0) nrm[tok * 2 + part] = rsqrtf(ss + 1e-6f) * (part == 0 ? 0.08838834764831845f : 1.f); }
        if (tid < 4) { const int row = row0 + t0 + tid; const float g = -aexp * softplusf(gates[(size_t)row * 16 + h] + dtb); gb[tid * 2] = fexp(g); gb[tid * 2 + 1] = sigm(gates[(size_t)row * 16 + 8 + h]); }
        __syncthreads();
#pragma unroll 1
        for (int tok = 0; tok < 4; ++tok) {
            const float eg = gb[tok * 2], beta = gb[tok * 2 + 1], nq = nrm[tok * 2], nk = nrm[tok * 2 + 1];
            const LAS float* qv = act + tok * 384 + 32 * r; const LAS float* kv = qv + 128;
            float ks = 0.f;
#pragma unroll
            for (int i = 0; i < 32; ++i) ks += kv[i] * s[i];
            red[r * 128 + c] = ks * nk;
            __syncthreads();
            const float kS = red[c] + red[128 + c] + red[256 + c] + red[384 + c];
            const float vnew = beta * (act[tok * 384 + 256 + c] - eg * kS);
            float os = 0.f;
#pragma unroll
            for (int i = 0; i < 32; ++i) { s[i] = eg * s[i] + (kv[i] * nk) * vnew; os += qv[i] * s[i]; }
            red2[r * 128 + c] = os * nq;
            __syncthreads();
            if (r == 0) obuf[tok * 128 + c] = red2[c] + red2[128 + c] + red2[256 + c] + red2[384 + c];
        }
        __syncthreads();
        if (wave < 4) { const int tok = wave, row = row0 + t0 + tok; const float o0 = obuf[tok * 128 + lane], o1 = obuf[tok * 128 + 64 + lane];
            const float rstd = rsqrtf(wave_sum(o0 * o0 + o1 * o1) * (1.f / 128.f) + RMS_EPS);
            const float* nw = a->in[I_DNORM];
            const float z0 = bf2f(proj[(size_t)row * NPROJ_PAD + 4096 + h * 128 + lane]), z1 = bf2f(proj[(size_t)row * NPROJ_PAD + 4096 + h * 128 + 64 + lane]);
            mix[(size_t)row * D + h * 128 + lane] = (bf16)f2bf(o0 * rstd * nw[lane] * siluf(z0));
            mix[(size_t)row * D + h * 128 + 64 + lane] = (bf16)f2bf(o1 * rstd * nw[64 + lane] * siluf(z1)); }
        __syncthreads();
    }
#pragma unroll
    for (int i = 0; i < 32; ++i) Sout[(size_t)(32 * r + i) * 128 + c] = s[i];
}

__device__ __forceinline__ void lru_rec_item(ArgsP a, LAS unsigned char* lds, int row0, int T, int n, const float* cstate, const float* h0, float* hout, const int tid) {
    const int d = tid & 127, part = tid >> 7;
    const bf16* proj = (const bf16*)(a->ws + WS_PROJ); bf16* mix = (bf16*)(a->ws + WS_MIX);
    const float* wconv = a->in[I_WCONV]; const float* bconv = a->in[I_BCONV];
    const float* wr = a->in[I_LWR] + (size_t)n * 16384; const float* wi = a->in[I_LWI] + (size_t)n * 16384;
    LAS float* xr = (LAS float*)lds;
    LAS float* red = xr + 512;
    const int chn = n * 128 + d;
    float hst = h0 ? h0[chn] : 0.f;
    const float br = a->in[I_LBR][chn], bi = a->in[I_LBI][chn], spl = softplusf(-a->in[I_LLAM][chn]);
#pragma unroll 1
    for (int t0 = 0; t0 < T; t0 += 4) {
        { const int tok = tid >> 7; xr[tok * 128 + d] = conv4(proj, row0, t0 + tok, 3072 + chn, cstate, wconv, bconv); }
        __syncthreads();
        float ar[4] = {0.f, 0.f, 0.f, 0.f}, ai[4] = {0.f, 0.f, 0.f, 0.f};
#pragma unroll 4
        for (int cc = 0; cc < 32; ++cc) { const int c = part * 32 + cc; const float w1 = wr[c * 128 + d], w2 = wi[c * 128 + d];
#pragma unroll
        for (int tok = 0; tok < 4; ++tok) { const float x = xr[tok * 128 + c]; ar[tok] += x * w1; ai[tok] += x * w2; } }
#pragma unroll
        for (int tok = 0; tok < 4; ++tok) { red[((tok * 2 + 0) * 4 + part) * 128 + d] = ar[tok]; red[((tok * 2 + 1) * 4 + part) * 128 + d] = ai[tok]; }
        __syncthreads();
        if (part == 0) {
    #pragma unroll 1
        for (int tok = 0; tok < 4; ++tok) {
                const int row = row0 + t0 + tok;
                float rp = br, ip = bi;
#pragma unroll
                for (int p = 0; p < 4; ++p) { rp += red[((tok * 2 + 0) * 4 + p) * 128 + d]; ip += red[((tok * 2 + 1) * 4 + p) * 128 + d]; }
                const float log_a = -8.f * sigm(rp) * spl;
                const float av = fexp(log_a);
                const float bx = sqrtf(neg_expm1(2.f * log_a)) * sigm(ip) * xr[tok * 128 + d];
                hst = av * hst + bx;
                const float gate = bf2f(proj[(size_t)row * NPROJ_PAD + 5120 + chn]);
                mix[(size_t)row * D + 1024 + chn] = (bf16)f2bf(hst * gelu_tanh(gate));
            }
        }
        __syncthreads();
    }
    if (part == 0) hout[chn] = hst;
}

__device__ __forceinline__ void mlstm_rec_item(ArgsP a, LAS unsigned char* lds, int row0, int T, int h, const float* C0, const float* n0, const float* m0, float* Cout, float* nout, float* mout, const int tid) {
    const int lane = tid & 63, wave = tid >> 6, v = tid & 255, kh = tid >> 8;
    const bf16* proj = (const bf16*)(a->ws + WS_PROJ); const float* gates = (const float*)(a->ws + WS_GATES); bf16* mix = (bf16*)(a->ws + WS_MIX);
    LAS float* qs = (LAS float*)lds;
    LAS float* ks = qs + 512;
    LAS float* vs = ks + 512;
    LAS float* gs = vs + 1024;
    LAS float* red = gs + 8;
    LAS float* dred = red + 1024;
    LAS float* hbuf = dred + 4;
    float cst[64];
#pragma unroll
    for (int i = 0; i < 64; ++i) cst[i] = C0 ? C0[(size_t)v * 128 + 64 * kh + i] : 0.f;
    float nst = (tid < 128) ? (n0 ? n0[tid] : 0.f) : 0.f;
    float mst = m0 ? m0[0] : 0.f;
    const float big = a->in[I_BIG][h], bfg = a->in[I_BFG][h];
#pragma unroll 1
    for (int t0 = 0; t0 < T; t0 += 4) {
#pragma unroll
        for (int j = 0; j < 4; ++j) { const int tok = j, row = row0 + t0 + tok; const bf16* pr = proj + (size_t)row * NPROJ_PAD;
            float val;
            if (tid < 128) val = bf2f(pr[h * 128 + tid]); else if (tid < 256) val = bf2f(pr[1024 + h * 128 + (tid - 128)]) * 0.08838834764831845f; else val = bf2f(pr[2048 + h * 256 + (tid - 256)]);
            if (tid < 128) qs[tok * 128 + tid] = val; else if (tid < 256) ks[tok * 128 + tid - 128] = val; else vs[tok * 256 + tid - 256] = val; }
        if (tid < 4) { const int row = row0 + t0 + tid; gs[tid * 2] = gates[(size_t)row * 16 + h] + big; gs[tid * 2 + 1] = gates[(size_t)row * 16 + 8 + h] + bfg; }
        __syncthreads();
#pragma unroll 1
        for (int tok = 0; tok < 4; ++tok) {
            const int par = tok & 1;
            const float ig = gs[tok * 2], lf = logsigf(gs[tok * 2 + 1]);
            const float mnew = fmaxf(lf + mst, ig), fp = fexp(lf + mst - mnew), ip = fexp(ig - mnew); mst = mnew;
            const float vv = vs[tok * 256 + v] * ip;
            const LAS float* kv = ks + tok * 128 + 64 * kh; const LAS float* qv = qs + tok * 128 + 64 * kh;
            float num = 0.f;
#pragma unroll
            for (int i = 0; i < 64; ++i) { cst[i] = fp * cst[i] + vv * kv[i]; num += cst[i] * qv[i]; }
            red[(par * 2 + kh) * 256 + v] = num;
            if (tid < 128) { nst = fp * nst + ip * ks[tok * 128 + tid]; const float dp = wave_sum(nst * qs[tok * 128 + tid]); if (lane == 0) dred[par * 2 + wave] = dp; }
            __syncthreads();
            if (kh == 0) { const float nm = red[(par * 2) * 256 + v] + red[(par * 2 + 1) * 256 + v]; const float den = dred[par * 2] + dred[par * 2 + 1];
                hbuf[tok * 256 + v] = nm / fmaxf(fabsf(den), fexp(-mnew)); }
        }
        __syncthreads();
        if (wave < 4) { const int tok = wave, row = row0 + t0 + tok; float hv[4]; float ss = 0.f;
#pragma unroll
            for (int j = 0; j < 4; ++j) { hv[j] = hbuf[tok * 256 + j * 64 + lane]; ss += hv[j] * hv[j]; }
            const float rstd = rsqrtf(wave_sum(ss) * (1.f / 256.f) + RMS_EPS);
            const float* nw = a->in[I_MNORM] + h * 256;
#pragma unroll
            for (int j = 0; j < 4; ++j) { const int vi = j * 64 + lane; const float op = bf2f(proj[(size_t)row * NPROJ_PAD + 4096 + h * 256 + vi]);
                mix[(size_t)row * D + h * 256 + vi] = (bf16)f2bf(hv[j] * rstd * nw[vi] * sigm(op)); } }
        __syncthreads();
    }
#pragma unroll
    for (int i = 0; i < 64; ++i) Cout[(size_t)v * 128 + 64 * kh + i] = cst[i];
    if (tid < 128) nout[tid] = nst;
    if (tid == 0) mout[0] = mst;
}


typedef short bf16x8 __attribute__((ext_vector_type(8)));
#define MFMA32(a_, b_, c_) __builtin_amdgcn_mfma_f32_16x16x32_bf16(a_, b_, c_, 0, 0, 0)

__device__ __forceinline__ void lru_prep_item(ArgsP a, LAS unsigned char* lds, int item, const int tid) {
    const int c = item & 31, n = (item >> 5) & 7, b = item >> 8;
    const int lane = tid & 63, w = __builtin_amdgcn_readfirstlane(tid >> 6), fr = lane & 15, fq = lane >> 4;
    unsigned char* ws = a->ws;
    const bf16* proj = (const bf16*)(ws + WS_PROJ);
    LAS bf16* xa = (LAS bf16*)lds;
    LAS float* xf = (LAS float*)(lds + 17408);
    LAS float* obH = (LAS float*)(lds + 51200);
    LAS float* obP = obH + 64 * 132;
    {
        const int t = tid >> 3, sub = tid & 7, ch0 = 3072 + n * 128 + sub * 16;
        const float* wconv = a->in[I_WCONV]; const float* bconv = a->in[I_BCONV];
        float x[16];
#pragma unroll
        for (int i = 0; i < 4; ++i) { const f32x4 bb = *(const f32x4*)(bconv + ch0 + 4 * i); x[4 * i] = bb.x; x[4 * i + 1] = bb.y; x[4 * i + 2] = bb.z; x[4 * i + 3] = bb.w; }
#pragma unroll
        for (int j = 0; j < 4; ++j) { const int tt = 64 * c + t - 3 + j;
            if (tt >= 0) { const bf16* pr = proj + (size_t)(b * TP + tt) * NPROJ_PAD + ch0; const v4u u0 = *(const v4u*)pr, u1 = *(const v4u*)(pr + 8);
                const unsigned uu[8] = {u0.x, u0.y, u0.z, u0.w, u1.x, u1.y, u1.z, u1.w};
#pragma unroll
                for (int i = 0; i < 4; ++i) { const f32x4 ww = *(const f32x4*)(wconv + j * 4096 + ch0 + 4 * i);
                    x[4 * i] += ww.x * bflo(uu[2 * i]); x[4 * i + 1] += ww.y * bfhi(uu[2 * i]); x[4 * i + 2] += ww.z * bflo(uu[2 * i + 1]); x[4 * i + 3] += ww.w * bfhi(uu[2 * i + 1]); } } }
        v4u o0, o1; o0.x = pk2(x[0], x[1]); o0.y = pk2(x[2], x[3]); o0.z = pk2(x[4], x[5]); o0.w = pk2(x[6], x[7]); o1.x = pk2(x[8], x[9]); o1.y = pk2(x[10], x[11]); o1.z = pk2(x[12], x[13]); o1.w = pk2(x[14], x[15]);
        *(LAS v4u*)(xa + t * 136 + sub * 16) = o0; *(LAS v4u*)(xa + t * 136 + sub * 16 + 8) = o1;
#pragma unroll
        for (int i = 0; i < 4; ++i) *(LAS f32x4*)(xf + t * 132 + sub * 16 + 4 * i) = (f32x4){x[4 * i], x[4 * i + 1], x[4 * i + 2], x[4 * i + 3]};
    }
    __syncthreads();
    const bf16* wrT = (const bf16*)(ws + WS_LRUW) + (size_t)n * 16384; const bf16* wiT = wrT + 8 * 16384;
    bf16x8 br[4], bi[4];
#pragma unroll
    for (int ks = 0; ks < 4; ++ks) { br[ks] = *(const bf16x8*)(wrT + (16 * w + fr) * 128 + 32 * ks + 8 * fq); bi[ks] = *(const bf16x8*)(wiT + (16 * w + fr) * 128 + 32 * ks + 8 * fq); }
    f32x4 accr[4], acci[4];
#pragma unroll
    for (int tb = 0; tb < 4; ++tb) { accr[tb] = (f32x4){0.f, 0.f, 0.f, 0.f}; acci[tb] = (f32x4){0.f, 0.f, 0.f, 0.f};
#pragma unroll
        for (int ks = 0; ks < 4; ++ks) { const bf16x8 af = *(const LAS bf16x8*)(xa + (16 * tb + fr) * 136 + 32 * ks + 8 * fq); accr[tb] = MFMA32(af, br[ks], accr[tb]); acci[tb] = MFMA32(af, bi[ks], acci[tb]); } }
    const int dl = 16 * w + fr, chn = n * 128 + dl;
    const float brs = a->in[I_LBR][chn], bis = a->in[I_LBI][chn], spl = softplusf(-a->in[I_LLAM][chn]);
    float Apre = 1.f, Hpre = 0.f;
#pragma unroll
    for (int tb = 0; tb < 4; ++tb) {
        float P[4], Hh[4];
#pragma unroll
        for (int j = 0; j < 4; ++j) { const int t = 16 * tb + 4 * fq + j;
            const float log_a = -8.f * sigm(accr[tb][j] + brs) * spl; const float av = fexp(log_a);
            const float bx = sqrtf(neg_expm1(2.f * log_a)) * sigm(acci[tb][j] + bis) * xf[t * 132 + dl];
            if (j == 0) { P[0] = av; Hh[0] = bx; } else { P[j] = P[j - 1] * av; Hh[j] = av * Hh[j - 1] + bx; } }
        float Ai = P[3], Hi = Hh[3];
        { const float A2 = __shfl_up(Ai, 16), H2 = __shfl_up(Hi, 16); if (fq >= 1) { Hi = Ai * H2 + Hi; Ai = A2 * Ai; } }
        { const float A2 = __shfl_up(Ai, 32), H2 = __shfl_up(Hi, 32); if (fq >= 2) { Hi = Ai * H2 + Hi; Ai = A2 * Ai; } }
        float Aex = __shfl_up(Ai, 16), Hex = __shfl_up(Hi, 16); if (fq == 0) { Aex = 1.f; Hex = 0.f; }
        const float Atb = __shfl(Ai, 48 + fr), Htb = __shfl(Hi, 48 + fr);
        const float EA = Apre * Aex, EH = Aex * Hpre + Hex;
#pragma unroll
        for (int j = 0; j < 4; ++j) { const int t = 16 * tb + 4 * fq + j; obP[t * 132 + dl] = EA * P[j]; obH[t * 132 + dl] = P[j] * EH + Hh[j]; }
        Hpre = Atb * Hpre + Htb; Apre = Apre * Atb;
    }
    if (fq == 0) { float* e = (float*)(ws + WS_LRU_END) + (size_t)item * 256; e[dl] = Apre; e[128 + dl] = Hpre; }
    __syncthreads();
    {
        const int t = tid >> 3, sub = tid & 7;
        bf16* hl = (bf16*)(ws + WS_LRU_HL) + ((size_t)item * 64 + t) * 128 + sub * 16; bf16* pp = (bf16*)(ws + WS_LRU_P) + ((size_t)item * 64 + t) * 128 + sub * 16;
        const LAS float* sh = obH + t * 132 + sub * 16; const LAS float* sp = obP + t * 132 + sub * 16;
        v4u o0, o1;
        o0.x = pk2(sh[0], sh[1]); o0.y = pk2(sh[2], sh[3]); o0.z = pk2(sh[4], sh[5]); o0.w = pk2(sh[6], sh[7]); o1.x = pk2(sh[8], sh[9]); o1.y = pk2(sh[10], sh[11]); o1.z = pk2(sh[12], sh[13]); o1.w = pk2(sh[14], sh[15]);
        *(v4u*)hl = o0; *(v4u*)(hl + 8) = o1;
        o0.x = pk2(sp[0], sp[1]); o0.y = pk2(sp[2], sp[3]); o0.z = pk2(sp[4], sp[5]); o0.w = pk2(sp[6], sp[7]); o1.x = pk2(sp[8], sp[9]); o1.y = pk2(sp[10], sp[11]); o1.z = pk2(sp[12], sp[13]); o1.w = pk2(sp[14], sp[15]);
        *(v4u*)pp = o0; *(v4u*)(pp + 8) = o1;
    }
    __syncthreads();
}
__device__ __forceinline__ void lru_out_item(ArgsP a, LAS unsigned char* lds, int item, const int tid) {
    const int c = item & 31, n = (item >> 5) & 7, b = item >> 8;
    unsigned char* ws = a->ws;
    LAS float* carry = (LAS float*)lds;
    if (tid < 128) { float cr = 0.f; const float* e = (const float*)(ws + WS_LRU_END) + (size_t)(item - c) * 256;
        for (int k = 0; k < c; ++k) cr = e[k * 256 + 128 + tid] + e[k * 256 + tid] * cr;
        carry[tid] = cr; }
    __syncthreads();
    const int t = tid >> 3, sub = tid & 7, d0 = sub * 16, row = b * TP + 64 * c + t;
    const bf16* hl = (const bf16*)(ws + WS_LRU_HL) + ((size_t)item * 64 + t) * 128 + d0; const bf16* pp = (const bf16*)(ws + WS_LRU_P) + ((size_t)item * 64 + t) * 128 + d0;
    const bf16* gp = (const bf16*)(ws + WS_PROJ) + (size_t)row * NPROJ_PAD + 5120 + n * 128 + d0;
    const v4u h0 = *(const v4u*)hl, h1 = *(const v4u*)(hl + 8), p0 = *(const v4u*)pp, p1 = *(const v4u*)(pp + 8), g0 = *(const v4u*)gp, g1 = *(const v4u*)(gp + 8);
    const unsigned hu[8] = {h0.x, h0.y, h0.z, h0.w, h1.x, h1.y, h1.z, h1.w}, pu[8] = {p0.x, p0.y, p0.z, p0.w, p1.x, p1.y, p1.z, p1.w}, gu[8] = {g0.x, g0.y, g0.z, g0.w, g1.x, g1.y, g1.z, g1.w};
    float hv[16]; unsigned ou[8];
#pragma unroll
    for (int i = 0; i < 8; ++i) { hv[2 * i] = bflo(hu[i]) + bflo(pu[i]) * carry[d0 + 2 * i]; hv[2 * i + 1] = bfhi(hu[i]) + bfhi(pu[i]) * carry[d0 + 2 * i + 1];
        ou[i] = pk2(hv[2 * i] * gelu_tanh(bflo(gu[i])), hv[2 * i + 1] * gelu_tanh(bfhi(gu[i]))); }
    bf16* mp = (bf16*)(ws + WS_MIX) + (size_t)row * D + 1024 + n * 128 + d0;
    *(v4u*)mp = (v4u){ou[0], ou[1], ou[2], ou[3]}; *(v4u*)(mp + 8) = (v4u){ou[4], ou[5], ou[6], ou[7]};
    if (c == 31 && t == 63) { float* o = a->out + O_LRUP + (size_t)b * 1024 + n * 128 + d0;
#pragma unroll
        for (int i = 0; i < 4; ++i) *(f32x4*)(o + 4 * i) = (f32x4){hv[4 * i], hv[4 * i + 1], hv[4 * i + 2], hv[4 * i + 3]}; }
    __syncthreads();
}


__device__ __forceinline__ void conv16_load(const bf16* proj, int b, int tseq, int ch0, v4u (&u)[8]) {
#pragma unroll
    for (int j = 0; j < 4; ++j) { const int tt = tseq - 3 + j;
        if (tt >= 0) { const bf16* pr = proj + (size_t)(b * TP + tt) * NPROJ_PAD + ch0; u[2 * j] = *(const v4u*)pr; u[2 * j + 1] = *(const v4u*)(pr + 8); }
        else { u[2 * j] = (v4u){0u, 0u, 0u, 0u}; u[2 * j + 1] = (v4u){0u, 0u, 0u, 0u}; } }
}
__device__ __forceinline__ void conv16_compute(const v4u (&u)[8], const float* wconv, const float* bconv, int ch0, float (&x)[16]) {
#pragma unroll
    for (int i = 0; i < 4; ++i) { const f32x4 bb = *(const f32x4*)(bconv + ch0 + 4 * i); x[4 * i] = bb.x; x[4 * i + 1] = bb.y; x[4 * i + 2] = bb.z; x[4 * i + 3] = bb.w; }
#pragma unroll
    for (int j = 0; j < 4; ++j) { const unsigned uu[8] = {u[2 * j].x, u[2 * j].y, u[2 * j].z, u[2 * j].w, u[2 * j + 1].x, u[2 * j + 1].y, u[2 * j + 1].z, u[2 * j + 1].w};
#pragma unroll
        for (int i = 0; i < 4; ++i) { const f32x4 ww = *(const f32x4*)(wconv + j * 4096 + ch0 + 4 * i);
            x[4 * i] += ww.x * bflo(uu[2 * i]); x[4 * i + 1] += ww.y * bfhi(uu[2 * i]); x[4 * i + 2] += ww.z * bflo(uu[2 * i + 1]); x[4 * i + 3] += ww.w * bfhi(uu[2 * i + 1]); } }
}
__device__ __forceinline__ void conv16_prompt(const bf16* proj, const float* wconv, const float* bconv, int b, int tseq, int ch0, float (&x)[16]) {
    v4u u[8]; conv16_load(proj, b, tseq, ch0, u); conv16_compute(u, wconv, bconv, ch0, x);
}
__device__ __forceinline__ void st16_bf16(LAS bf16* p, const float (&x)[16]) {
    v4u o0, o1; o0.x = pk2(x[0], x[1]); o0.y = pk2(x[2], x[3]); o0.z = pk2(x[4], x[5]); o0.w = pk2(x[6], x[7]); o1.x = pk2(x[8], x[9]); o1.y = pk2(x[10], x[11]); o1.z = pk2(x[12], x[13]); o1.w = pk2(x[14], x[15]);
    *(LAS v4u*)p = o0; *(LAS v4u*)(p + 8) = o1;
}
__device__ __forceinline__ v2u pack4(const f32x4 v) { v2u o; o.x = pk2(v.x, v.y); o.y = pk2(v.z, v.w); return o; }
__device__ __forceinline__ bf16x8 zero8() { return (bf16x8){0, 0, 0, 0, 0, 0, 0, 0}; }

__device__ __forceinline__ void delta_prep_item(ArgsP a, LAS unsigned char* lds, int item, const int tid) {
    const int c = item & 31, h = (item >> 5) & 7, b = item >> 8;
    const int lane = tid & 63, w = __builtin_amdgcn_readfirstlane(tid >> 6), fr = lane & 15, fq = lane >> 4;
    unsigned char* ws = a->ws;
    const bf16* proj = (const bf16*)(ws + WS_PROJ);
    LAS bf16* Kn = (LAS bf16*)lds;
    LAS bf16* Qn = (LAS bf16*)(lds + 17408);
    LAS bf16* KdT = (LAS bf16*)(lds + 34816);
    LAS bf16* RX = (LAS bf16*)(lds + 53248);
    LAS bf16* Mm = (LAS bf16*)(lds + 90112);
    LAS bf16* QKd = (LAS bf16*)(lds + 99328);
    LAS bf16* Td = (LAS bf16*)(lds + 108544);
    LAS bf16* RT = (LAS bf16*)(lds + 111616) + w * 768;
    LAS float* gl = (LAS float*)(lds + 123904);
    LAS float* gcs = gl + 64;
    LAS float* bet = gcs + 64;
    const int t = tid >> 3, sub = tid & 7;
    {
        if (sub == 0) { const float* gt = (const float*)(ws + WS_GATES) + (size_t)(b * TP + 64 * c + t) * 16;
            gl[t] = -fexp(a->in[I_ALOG][h]) * softplusf(gt[h] + a->in[I_DTB][h]); bet[t] = sigm(gt[8 + h]); }
        __syncthreads();
        if (w == 0) { float v = gl[lane];
#pragma unroll
            for (int o = 1; o < 64; o <<= 1) { const float u = __shfl_up(v, o); if (lane >= o) v += u; }
            gcs[lane] = v; }
        __syncthreads();
    }
    {
        const float* wconv = a->in[I_WCONV]; const float* bconv = a->in[I_BCONV];
        const float gc = gcs[t], glast = gcs[63], beta = bet[t];
        const float ec = fexp(gc), ed = fexp(glast - gc);
        float x[16], y[16];
        conv16_prompt(proj, wconv, bconv, b, 64 * c + t, 1024 + h * 128 + sub * 16, x);
        float ss = 0.f;
#pragma unroll
        for (int i = 0; i < 16; ++i) { x[i] = siluf(x[i]); ss += x[i] * x[i]; }
        ss += __shfl_xor(ss, 1); ss += __shfl_xor(ss, 2); ss += __shfl_xor(ss, 4);
        const float rk = rsqrtf(ss + 1e-6f);
#pragma unroll
        for (int i = 0; i < 16; ++i) x[i] *= rk;
        st16_bf16(Kn + t * 136 + sub * 16, x);
#pragma unroll
        for (int i = 0; i < 16; ++i) KdT[(sub * 16 + i) * 72 + t] = (bf16)f2bf(x[i] * ed);
#pragma unroll
        for (int i = 0; i < 16; ++i) y[i] = x[i] * (beta * ec);
        st16_bf16(RX + t * 264 + 128 + sub * 16, y);
        conv16_prompt(proj, wconv, bconv, b, 64 * c + t, h * 128 + sub * 16, x);
        ss = 0.f;
#pragma unroll
        for (int i = 0; i < 16; ++i) { x[i] = siluf(x[i]); ss += x[i] * x[i]; }
        ss += __shfl_xor(ss, 1); ss += __shfl_xor(ss, 2); ss += __shfl_xor(ss, 4);
        const float rq = rsqrtf(ss + 1e-6f) * 0.08838834764831845f;
#pragma unroll
        for (int i = 0; i < 16; ++i) x[i] *= rq;
        st16_bf16(Qn + t * 136 + sub * 16, x);
        conv16_prompt(proj, wconv, bconv, b, 64 * c + t, 2048 + h * 128 + sub * 16, x);
#pragma unroll
        for (int i = 0; i < 16; ++i) x[i] = siluf(x[i]) * beta;
        st16_bf16(RX + t * 264 + sub * 16, x);
    }
    __syncthreads();
    {
        const int ib = w >> 1;
#pragma unroll
        for (int jj = 0; jj < 2; ++jj) { const int jb = 2 * (w & 1) + jj;
            f32x4 ak = (f32x4){0.f, 0.f, 0.f, 0.f}, aq = (f32x4){0.f, 0.f, 0.f, 0.f};
            if (jb <= ib) {
#pragma unroll
                for (int ks = 0; ks < 4; ++ks) { const bf16x8 bfr = *(const LAS bf16x8*)(Kn + (16 * jb + fr) * 136 + 32 * ks + 8 * fq);
                    const bf16x8 afk = *(const LAS bf16x8*)(Kn + (16 * ib + fr) * 136 + 32 * ks + 8 * fq), afq = *(const LAS bf16x8*)(Qn + (16 * ib + fr) * 136 + 32 * ks + 8 * fq);
                    ak = MFMA32(afk, bfr, ak); aq = MFMA32(afq, bfr, aq); } }
            const int col = 16 * jb + fr; const float gcc = gcs[col];
#pragma unroll
            for (int j = 0; j < 4; ++j) { const int row = 16 * ib + 4 * fq + j; const float dec = (row >= col) ? fexp(gcs[row] - gcc) : 0.f;
                Mm[row * 72 + col] = (bf16)f2bf(row > col ? -bet[row] * ak[j] * dec : 0.f);
                QKd[row * 72 + col] = (bf16)f2bf(aq[j] * dec); }
        }
    }
    __syncthreads();
    if (w == 0) { const int blk = lane >> 4, col = lane & 15; float xi[16];
#pragma unroll
        for (int i = 0; i < 16; ++i) { float acc = (i == col) ? 1.f : 0.f; const LAS bf16* mr = Mm + (16 * blk + i) * 72 + 16 * blk;
#pragma unroll
            for (int j = 0; j < i; ++j) acc += bf2f(mr[j]) * xi[j];
            xi[i] = acc; }
#pragma unroll
        for (int i = 0; i < 16; ++i) Td[(blk * 16 + i) * 24 + col] = (bf16)f2bf(xi[i]); }
    f32x4 rhs[2][4];
#pragma unroll
    for (int cbl = 0; cbl < 2; ++cbl)
#pragma unroll
        for (int bb = 0; bb < 4; ++bb)
#pragma unroll
            for (int j = 0; j < 4; ++j) rhs[cbl][bb][j] = bf2f(RX[(16 * bb + 4 * fq + j) * 264 + 32 * w + 16 * cbl + fr]);
    __syncthreads();
#pragma unroll
    for (int cbl = 0; cbl < 2; ++cbl) { const int cb = 2 * w + cbl;
#pragma unroll
        for (int bb = 0; bb < 4; ++bb) {
            f32x4 acc = rhs[cbl][bb];
#pragma unroll
            for (int ks = 0; ks < 2; ++ks) { if (32 * ks < 16 * bb) { const bool ok = (32 * ks + 8 * fq) < 16 * bb;
                const bf16x8 af = ok ? *(const LAS bf16x8*)(Mm + (16 * bb + fr) * 72 + 32 * ks + 8 * fq) : zero8();
                const bf16x8 bf_ = ok ? *(const LAS bf16x8*)(RX + (16 * cb + fr) * 72 + 32 * ks + 8 * fq) : zero8();
                acc = MFMA32(af, bf_, acc); } }
            *(LAS v2u*)(RT + (16 * cbl + fr) * 24 + 4 * fq) = pack4(acc);
            asm volatile("s_waitcnt lgkmcnt(0)" ::: "memory");
            const bool ok2 = fq < 2;
            const bf16x8 af2 = ok2 ? *(const LAS bf16x8*)(Td + (bb * 16 + fr) * 24 + 8 * fq) : zero8();
            const bf16x8 bf2 = ok2 ? *(const LAS bf16x8*)(RT + (16 * cbl + fr) * 24 + 8 * fq) : zero8();
            const f32x4 xb4 = MFMA32(af2, bf2, ((f32x4){0.f, 0.f, 0.f, 0.f}));
            *(LAS v2u*)(RX + (16 * cb + fr) * 72 + 16 * bb + 4 * fq) = pack4(xb4);
            asm volatile("s_waitcnt lgkmcnt(0)" ::: "memory");
        }
    }
    __syncthreads();
    {
        v4u* gout = (v4u*)(ws + WS_DG) + ((size_t)item * 8 + w) * 4 * 64 + lane;
        bf16x8 kb[2];
#pragma unroll
        for (int kt = 0; kt < 2; ++kt) kb[kt] = *(const LAS bf16x8*)(KdT + (16 * w + fr) * 72 + 32 * kt + 8 * fq);
#pragma unroll
        for (int ks = 0; ks < 4; ++ks) { f32x4 g0 = (f32x4){0.f, 0.f, 0.f, 0.f}, g1 = (f32x4){0.f, 0.f, 0.f, 0.f};
#pragma unroll
            for (int kt = 0; kt < 2; ++kt) { const bf16x8 a0 = *(const LAS bf16x8*)(RX + (128 + 32 * ks + fr) * 72 + 32 * kt + 8 * fq), a1 = *(const LAS bf16x8*)(RX + (128 + 32 * ks + 16 + fr) * 72 + 32 * kt + 8 * fq);
                g0 = MFMA32(a0, kb[kt], g0); g1 = MFMA32(a1, kb[kt], g1); }
            const v2u p0 = pack4(-g0), p1 = pack4(-g1); gout[ks * 64] = (v4u){p0.x, p0.y, p1.x, p1.y}; }
        v2u* bout = (v2u*)(ws + WS_DB) + ((size_t)item * 64 + w) * 64 + lane;
#pragma unroll
        for (int s2 = 0; s2 < 8; ++s2) { f32x4 bc = (f32x4){0.f, 0.f, 0.f, 0.f};
#pragma unroll
            for (int kt = 0; kt < 2; ++kt) { const bf16x8 ub = *(const LAS bf16x8*)(RX + (16 * s2 + fr) * 72 + 32 * kt + 8 * fq); bc = MFMA32(kb[kt], ub, bc); }
            bout[(size_t)s2 * 8 * 64] = pack4(bc); }
    }
    {
        const int tb = w >> 1, half = w & 1; const float ect = fexp(gcs[16 * tb + fr]);
        bf16x8 qk[2];
#pragma unroll
        for (int kt = 0; kt < 2; ++kt) qk[kt] = *(const LAS bf16x8*)(QKd + (16 * tb + fr) * 72 + 32 * kt + 8 * fq);
        v4u* qout = (v4u*)(ws + WS_DQ) + ((size_t)item * 4 + tb) * 4 * 64 + lane;
#pragma unroll
        for (int kk = 0; kk < 2; ++kk) { const int ks = 2 * half + kk; v2u pk[2];
#pragma unroll
            for (int hf = 0; hf < 2; ++hf) { const int db = 2 * ks + hf; f32x4 acc = (f32x4){0.f, 0.f, 0.f, 0.f};
#pragma unroll
                for (int kt = 0; kt < 2; ++kt) { const bf16x8 wa = *(const LAS bf16x8*)(RX + (128 + 16 * db + fr) * 72 + 32 * kt + 8 * fq); acc = MFMA32(wa, qk[kt], acc); }
                const v2u qn4 = *(const LAS v2u*)(Qn + (16 * tb + fr) * 136 + 16 * db + 4 * fq);
                f32x4 qp; qp.x = bflo(qn4.x) * ect - acc.x; qp.y = bfhi(qn4.x) * ect - acc.y; qp.z = bflo(qn4.y) * ect - acc.z; qp.w = bfhi(qn4.y) * ect - acc.w;
                pk[hf] = pack4(qp); }
            qout[ks * 64] = (v4u){pk[0].x, pk[0].y, pk[1].x, pk[1].y}; }
        v2u* oout = (v2u*)(ws + WS_DO) + ((size_t)item * 4 + tb) * 8 * 64 + lane;
#pragma unroll
        for (int ss = 0; ss < 4; ++ss) { const int s2 = 4 * half + ss; f32x4 acc = (f32x4){0.f, 0.f, 0.f, 0.f};
#pragma unroll
            for (int kt = 0; kt < 2; ++kt) { const bf16x8 ua = *(const LAS bf16x8*)(RX + (16 * s2 + fr) * 72 + 32 * kt + 8 * fq); acc = MFMA32(ua, qk[kt], acc); }
            oout[s2 * 64] = pack4(acc); }
    }
    if (tid == 0) ((float*)(ws + WS_DD))[item] = fexp(gcs[63]);
    __syncthreads();
}

__device__ __forceinline__ void delta_scan_wave(ArgsP a, int chain, int s, const int lane) {
    unsigned char* ws = a->ws;
    const int fr = lane & 15, fq = lane >> 4;
    f32x4 S[8]; bf16x8 Sb[4];
#pragma unroll
    for (int i = 0; i < 8; ++i) S[i] = (f32x4){0.f, 0.f, 0.f, 0.f};
#pragma unroll
    for (int i = 0; i < 4; ++i) Sb[i] = zero8();
    const bf16x8* gbase = (const bf16x8*)(ws + WS_DG) + (size_t)chain * 32 * 2048 + lane;
    bf16x8 G[8][4];
#pragma unroll
    for (int rb = 0; rb < 8; ++rb)
#pragma unroll
        for (int ks = 0; ks < 4; ++ks) G[rb][ks] = gbase[(rb * 4 + ks) * 64];
#pragma unroll 1
    for (int c = 0; c < 32; ++c) {
        const int item = chain * 32 + c;
        const float d = ((const float*)(ws + WS_DD))[item];
        bf16x8* sout = (bf16x8*)(ws + WS_DS) + ((size_t)item * 8 + s) * 4 * 64 + lane;
#pragma unroll
        for (int ks = 0; ks < 4; ++ks) sout[ks * 64] = Sb[ks];
        const v2u* bin = (const v2u*)(ws + WS_DB) + ((size_t)item * 8 + s) * 8 * 64 + lane;
#pragma unroll
        for (int rb = 0; rb < 8; ++rb) { const v2u bc = bin[rb * 64]; S[rb].x = d * S[rb].x + bflo(bc.x); S[rb].y = d * S[rb].y + bfhi(bc.x); S[rb].z = d * S[rb].z + bflo(bc.y); S[rb].w = d * S[rb].w + bfhi(bc.y); }
        const bf16x8* gnext = gbase + (size_t)(c + 1 < 32 ? c + 1 : c) * 2048;
#pragma unroll
        for (int rb = 0; rb < 8; ++rb) {
#pragma unroll
            for (int ks = 0; ks < 4; ++ks) S[rb] = MFMA32(G[rb][ks], Sb[ks], S[rb]);
#pragma unroll
            for (int ks = 0; ks < 4; ++ks) G[rb][ks] = gnext[(rb * 4 + ks) * 64];
        }
#pragma unroll
        for (int ks = 0; ks < 4; ++ks) { const v2u lo = pack4(S[2 * ks]), hi = pack4(S[2 * ks + 1]); const v4u u = (v4u){lo.x, lo.y, hi.x, hi.y}; Sb[ks] = __builtin_bit_cast(bf16x8, u); }
    }
    f32x4* so = (f32x4*)(ws + WS_DF) + ((size_t)(chain * 8 + s) * 8) * 64 + lane;
#pragma unroll
    for (int rb = 0; rb < 8; ++rb) so[rb * 64] = S[rb];
}

__device__ __forceinline__ void delta_out_wave(ArgsP a, int item, int tb, const int lane) {
    unsigned char* ws = a->ws;
    const int c = item & 31, h = (item >> 5) & 7, b = item >> 8, fr = lane & 15, fq = lane >> 4;
    bf16x8 qf[4];
    const bf16x8* qin = (const bf16x8*)(ws + WS_DQ) + ((size_t)item * 4 + tb) * 4 * 64 + lane;
#pragma unroll
    for (int ks = 0; ks < 4; ++ks) qf[ks] = qin[ks * 64];
    const v2u* oin = (const v2u*)(ws + WS_DO) + ((size_t)item * 4 + tb) * 8 * 64 + lane;
    const bf16x8* sin = (const bf16x8*)(ws + WS_DS) + (size_t)item * 8 * 4 * 64 + lane;
    f32x4 o[8]; float ss = 0.f;
    v2u olv[8]; bf16x8 sfr[4][4];
#pragma unroll
    for (int s = 0; s < 8; ++s) olv[s] = oin[s * 64];
#pragma unroll
    for (int s = 0; s < 4; ++s)
#pragma unroll
        for (int ks = 0; ks < 4; ++ks) sfr[s][ks] = sin[(s * 4 + ks) * 64];
    const int row_ = b * TP + 64 * c + 16 * tb + fr;
    v2u zv[8];
#pragma unroll
    for (int s = 0; s < 8; ++s) zv[s] = *(const v2u*)((const bf16*)(ws + WS_PROJ) + (size_t)row_ * NPROJ_PAD + 4096 + h * 128 + 4 * fq + 16 * s);
#pragma unroll
    for (int grp = 0; grp < 2; ++grp) {
#pragma unroll
        for (int s4 = 0; s4 < 4; ++s4) { const int s = 4 * grp + s4; const v2u ol = olv[s]; o[s] = (f32x4){bflo(ol.x), bfhi(ol.x), bflo(ol.y), bfhi(ol.y)};
#pragma unroll
            for (int ks = 0; ks < 4; ++ks) o[s] = MFMA32(sfr[s4][ks], qf[ks], o[s]);
            ss += (o[s].x * o[s].x + o[s].y * o[s].y) + (o[s].z * o[s].z + o[s].w * o[s].w); }
        if (grp == 0) {
#pragma unroll
            for (int s4 = 0; s4 < 4; ++s4)
#pragma unroll
                for (int ks = 0; ks < 4; ++ks) sfr[s4][ks] = sin[((4 + s4) * 4 + ks) * 64]; }
    }
    ss += __shfl_xor(ss, 16); ss += __shfl_xor(ss, 32);
    const float rstd = rsqrtf(ss * (1.f / 128.f) + RMS_EPS);
    const int row = b * TP + 64 * c + 16 * tb + fr;
    const bf16* zp = (const bf16*)(ws + WS_PROJ) + (size_t)row * NPROJ_PAD + 4096 + h * 128 + 4 * fq;
    bf16* mp = (bf16*)(ws + WS_MIX) + (size_t)row * D + h * 128 + 4 * fq;
    const float* nw = a->in[I_DNORM] + 4 * fq;
#pragma unroll
    for (int s = 0; s < 8; ++s) { const v2u z = zv[s]; const f32x4 n4 = *(const f32x4*)(nw + 16 * s);
        f32x4 y; y.x = o[s].x * rstd * n4.x * siluf(bflo(z.x)); y.y = o[s].y * rstd * n4.y * siluf(bfhi(z.x)); y.z = o[s].z * rstd * n4.z * siluf(bflo(z.y)); y.w = o[s].w * rstd * n4.w * siluf(bfhi(z.y));
        *(v2u*)(mp + 16 * s) = pack4(y); }
}


__device__ __forceinline__ float wave_incl_sum(float v, int lane) {
#pragma unroll
    for (int o = 1; o < 64; o <<= 1) { const float u = __shfl_up(v, o); if (lane >= o) v += u; }
    return v;
}
__device__ __forceinline__ float wave_incl_max(float v, int lane) {
#pragma unroll
    for (int o = 1; o < 64; o <<= 1) { const float u = __shfl_up(v, o); if (lane >= o) v = fmaxf(v, u); }
    return v;
}
__device__ __forceinline__ float wave_max(float v) {
#pragma unroll
    for (int o = 1; o < 64; o <<= 1) v = fmaxf(v, __shfl_xor(v, o));
    return v;
}
__device__ __forceinline__ void mlstm_scan_item(ArgsP a, LAS unsigned char* lds, int chain, int vs, const int tid) {
    const int lane = tid & 63, w = __builtin_amdgcn_readfirstlane(tid >> 6), fr = lane & 15, fq = lane >> 4;
    const int b = chain >> 3, h = chain & 7, row0 = b * TP;
    unsigned char* ws = a->ws;
    const bf16* proj = (const bf16*)(ws + WS_PROJ); const float* gates = (const float*)(ws + WS_GATES);
    LAS bf16* KT = (LAS bf16*)lds;
    LAS bf16* VT = (LAS bf16*)(lds + 36864);
    LAS float* wls = (LAS float*)(lds + 46080);
    const float big = a->in[I_BIG][h], bfg = a->in[I_BFG][h];
    const bf16* kptr = proj + (size_t)(row0 + lane) * NPROJ_PAD + 1024 + h * 128 + 16 * w;
    const bf16* vptr = proj + (size_t)(row0 + lane) * NPROJ_PAD + 2048 + h * 256 + 32 * vs + 8 * (w & 3);
    const float* gptr = gates + (size_t)(row0 + lane) * 16 + h;
    f32x4 acc[2]; acc[0] = (f32x4){0.f, 0.f, 0.f, 0.f}; acc[1] = acc[0];
    float nst = 0.f, m = 0.f;
    v4u kq[2][2], vq[2]; float gi[2], gf[2];
#define ML_LOAD(set, c_) do { const size_t ro = (size_t)(c_) * 64 * NPROJ_PAD; kq[set][0] = *(const v4u*)(kptr + ro); kq[set][1] = *(const v4u*)(kptr + ro + 8); \
        if (w < 4) vq[set] = *(const v4u*)(vptr + ro); gi[set] = gptr[(size_t)(c_) * 64 * 16]; gf[set] = gptr[(size_t)(c_) * 64 * 16 + 8]; } while (0)
#define ML_STEP(set, c_) do { const int item = chain * 32 + (c_); \
        const float ig = gi[set] + big, lf = logsigf(gf[set] + bfg); \
        const float bcum = wave_incl_sum(lf, lane), blast = __shfl(bcum, 63), gend = blast - bcum + ig; \
        const float mnew = fmaxf(blast + m, wave_max(gend)), sc = fexp(blast + m - mnew), wv = fexp(gend - mnew) * 0.08838834764831845f; \
        LAS bf16* kt = KT + (set) * 9216; LAS bf16* vt = VT + (set) * 2304; \
        _Pragma("unroll") for (int i = 0; i < 2; ++i) { const unsigned uu[4] = {kq[set][i].x, kq[set][i].y, kq[set][i].z, kq[set][i].w}; const int kr = 8 * (2 * w + i); \
            _Pragma("unroll") for (int e = 0; e < 4; ++e) { kt[(kr + 2 * e) * 72 + lane] = (bf16)(uu[e] & 0xffffu); kt[(kr + 2 * e + 1) * 72 + lane] = (bf16)(uu[e] >> 16); } } \
        if (w < 4) { const unsigned uu[4] = {vq[set].x, vq[set].y, vq[set].z, vq[set].w}; \
            _Pragma("unroll") for (int e = 0; e < 4; ++e) { vt[(8 * w + 2 * e) * 72 + lane] = (bf16)f2bf(bflo(uu[e]) * wv); vt[(8 * w + 2 * e + 1) * 72 + lane] = (bf16)f2bf(bfhi(uu[e]) * wv); } } \
        if (w == 0) wls[(set) * 64 + lane] = wv; \
        if ((c_) + 2 < 32) ML_LOAD(set, (c_) + 2); \
        if (vs == 0 && tid == 0) ((float*)(ws + WS_MM))[item] = m; \
        __syncthreads(); \
        _Pragma("unroll") for (int vb = 0; vb < 2; ++vb) { *(v2u*)((bf16*)(ws + WS_MC) + ((size_t)item * 256 + 32 * vs + 16 * vb + fr) * 128 + 16 * w + 4 * fq) = pack4(acc[vb]); } \
        if (vs == 0 && tid < 128) { ((float*)(ws + WS_MN))[(size_t)item * 128 + tid] = nst; float sn = 0.f; \
            _Pragma("unroll") for (int s8 = 0; s8 < 8; ++s8) { const v4u kk = *(const LAS v4u*)(kt + tid * 72 + 8 * s8); const LAS float* wl = wls + (set) * 64 + 8 * s8; \
                sn += bflo(kk.x) * wl[0] + bfhi(kk.x) * wl[1] + bflo(kk.y) * wl[2] + bfhi(kk.y) * wl[3] + bflo(kk.z) * wl[4] + bfhi(kk.z) * wl[5] + bflo(kk.w) * wl[6] + bfhi(kk.w) * wl[7]; } \
            nst = sc * nst + sn; } \
        _Pragma("unroll") for (int vb = 0; vb < 2; ++vb) { acc[vb] = acc[vb] * sc; \
            _Pragma("unroll") for (int kt2 = 0; kt2 < 2; ++kt2) { const bf16x8 af = *(const LAS bf16x8*)(kt + (16 * w + fr) * 72 + 32 * kt2 + 8 * fq), bfv = *(const LAS bf16x8*)(vt + (16 * vb + fr) * 72 + 32 * kt2 + 8 * fq); \
                acc[vb] = MFMA32(af, bfv, acc[vb]); } } \
        m = mnew; } while (0)
    ML_LOAD(0, 0); ML_LOAD(1, 1);
#pragma unroll 1
    for (int c2 = 0; c2 < 32; c2 += 2) { ML_STEP(0, c2); ML_STEP(1, c2 + 1); }
#undef ML_LOAD
#undef ML_STEP
#pragma unroll
    for (int vb = 0; vb < 2; ++vb) *(f32x4*)(a->out + O_MCP + ((size_t)chain * 256 + 32 * vs + 16 * vb + fr) * 128 + 16 * w + 4 * fq) = acc[vb];
    if (vs == 0) { if (tid < 128) a->out[O_MNP + (size_t)chain * 128 + tid] = nst; if (tid == 0) a->out[O_MMP + chain] = m; }
    __syncthreads();
}

__device__ __forceinline__ void mlstm_out_item(ArgsP a, LAS unsigned char* lds, int item, const int tid) {
    const int c = item & 31, h = (item >> 5) & 7, b = item >> 8, row0 = b * TP + 64 * c;
    const int lane = tid & 63, w = __builtin_amdgcn_readfirstlane(tid >> 6), fr = lane & 15, fq = lane >> 4;
    unsigned char* ws = a->ws;
    const bf16* proj = (const bf16*)(ws + WS_PROJ); const float* gates = (const float*)(ws + WS_GATES);
    LAS bf16* VT = (LAS bf16*)lds;
    LAS float* ssq = (LAS float*)(lds + 36864);
    const float mc = ((const float*)(ws + WS_MM))[item];
    float av, Mt, et, em;
    { const float ig = gates[(size_t)(row0 + lane) * 16 + h] + a->in[I_BIG][h], lf = logsigf(gates[(size_t)(row0 + lane) * 16 + 8 + h] + a->in[I_BFG][h]);
      const float bcum = wave_incl_sum(lf, lane); av = ig - bcum; Mt = fmaxf(mc, wave_incl_max(av, lane)); et = fexp(mc - Mt); em = fexp(-(bcum + Mt)); }
    {
        v4u vu[4];
#pragma unroll
        for (int i = 0; i < 4; ++i) vu[i] = *(const v4u*)(proj + (size_t)(row0 + lane) * NPROJ_PAD + 2048 + h * 256 + 8 * (w + 8 * i));
#pragma unroll
        for (int i = 0; i < 4; ++i) { const unsigned uu[4] = {vu[i].x, vu[i].y, vu[i].z, vu[i].w}; const int vr = 8 * (w + 8 * i);
#pragma unroll
            for (int e = 0; e < 4; ++e) { VT[(vr + 2 * e) * 72 + lane] = (bf16)(uu[e] & 0xffffu); VT[(vr + 2 * e + 1) * 72 + lane] = (bf16)(uu[e] >> 16); } } }
    const int tb = w & 3, half = w >> 2, t = 16 * tb + fr;
    bf16x8 qf[4]; float qn = 0.f;
#pragma unroll
    for (int ks = 0; ks < 4; ++ks) { const v4u u = *(const v4u*)(proj + (size_t)(row0 + t) * NPROJ_PAD + h * 128 + 32 * ks + 8 * fq); qf[ks] = __builtin_bit_cast(bf16x8, u);
        const float* np = (const float*)(ws + WS_MN) + (size_t)item * 128 + 32 * ks + 8 * fq; const f32x4 n0 = *(const f32x4*)np, n1 = *(const f32x4*)(np + 4);
        qn += bflo(u.x) * n0.x + bfhi(u.x) * n0.y + bflo(u.y) * n0.z + bfhi(u.y) * n0.w + bflo(u.z) * n1.x + bfhi(u.z) * n1.y + bflo(u.w) * n1.z + bfhi(u.w) * n1.w; }
    qn += __shfl_xor(qn, 16); qn += __shfl_xor(qn, 32);
    const float Mtt = __shfl(Mt, t), ett = __shfl(et, t), emt = __shfl(em, t);
    const bf16* cs = (const bf16*)(ws + WS_MC) + (size_t)item * 256 * 128;
    v4u kfr[4][4];
#pragma unroll
    for (int sb = 0; sb < 4; ++sb) if (sb <= tb) {
#pragma unroll
        for (int ks = 0; ks < 4; ++ks) kfr[sb][ks] = *(const v4u*)(proj + (size_t)(row0 + 16 * sb + fr) * NPROJ_PAD + 1024 + h * 128 + 32 * ks + 8 * fq); }
    v2u smp[4]; float rowsum = 0.f;
#pragma unroll
    for (int sb = 0; sb < 4; ++sb) { smp[sb] = (v2u){0u, 0u};
        if (sb <= tb) { f32x4 qk = (f32x4){0.f, 0.f, 0.f, 0.f};
#pragma unroll
            for (int ks = 0; ks < 4; ++ks) qk = MFMA32(__builtin_bit_cast(bf16x8, kfr[sb][ks]), qf[ks], qk);
            f32x4 sm;
#pragma unroll
            for (int j = 0; j < 4; ++j) { const int s = 16 * sb + 4 * fq + j; const float as = __shfl(av, s); sm[j] = (s <= t) ? qk[j] * 0.08838834764831845f * fexp(as - Mtt) : 0.f; rowsum += sm[j]; }
            smp[sb] = pack4(sm); } }
    rowsum += __shfl_xor(rowsum, 16); rowsum += __shfl_xor(rowsum, 32);
    const float hden = 1.f / fmaxf(fabsf(ett * qn + rowsum), emt);
    const v4u s0u = (v4u){smp[0].x, smp[0].y, smp[1].x, smp[1].y}, s1u = (v4u){smp[2].x, smp[2].y, smp[3].x, smp[3].y};
    const bf16x8 sf0 = __builtin_bit_cast(bf16x8, s0u), sf1 = __builtin_bit_cast(bf16x8, s1u);
    v4u cfr[4][4];
#pragma unroll
    for (int g4 = 0; g4 < 4; ++g4)
#pragma unroll
        for (int ks = 0; ks < 4; ++ks) cfr[g4][ks] = *(const v4u*)(cs + (size_t)(128 * half + 16 * g4 + fr) * 128 + 32 * ks + 8 * fq);
    __syncthreads();
    f32x4 hv[8]; float ss = 0.f;
#pragma unroll
    for (int grp = 0; grp < 2; ++grp) {
      f32x4 accs[4];
#pragma unroll
      for (int g4 = 0; g4 < 4; ++g4) { f32x4 acc = (f32x4){0.f, 0.f, 0.f, 0.f};
#pragma unroll
          for (int ks = 0; ks < 4; ++ks) acc = MFMA32(__builtin_bit_cast(bf16x8, cfr[g4][ks]), qf[ks], acc);
          accs[g4] = acc * ett; }
      if (grp == 0) {
#pragma unroll
          for (int g4 = 0; g4 < 4; ++g4)
#pragma unroll
              for (int ks = 0; ks < 4; ++ks) cfr[g4][ks] = *(const v4u*)(cs + (size_t)(128 * half + 64 + 16 * g4 + fr) * 128 + 32 * ks + 8 * fq); }
#pragma unroll
      for (int g4 = 0; g4 < 4; ++g4) { const int vb = 4 * grp + g4, vrow = 128 * half + 16 * vb + fr; f32x4 acc = accs[g4];
        { const v2u a0 = *(const LAS v2u*)(VT + vrow * 72 + 4 * fq), a1 = *(const LAS v2u*)(VT + vrow * 72 + 16 + 4 * fq); const v4u au = (v4u){a0.x, a0.y, a1.x, a1.y}; acc = MFMA32(__builtin_bit_cast(bf16x8, au), sf0, acc); }
        { const v2u a0 = *(const LAS v2u*)(VT + vrow * 72 + 32 + 4 * fq), a1 = *(const LAS v2u*)(VT + vrow * 72 + 48 + 4 * fq); const v4u au = (v4u){a0.x, a0.y, a1.x, a1.y}; acc = MFMA32(__builtin_bit_cast(bf16x8, au), sf1, acc); }
        hv[vb] = acc * hden; ss += (hv[vb].x * hv[vb].x + hv[vb].y * hv[vb].y) + (hv[vb].z * hv[vb].z + hv[vb].w * hv[vb].w); }
    }
    ss += __shfl_xor(ss, 16); ss += __shfl_xor(ss, 32);
    if (fq == 0) ssq[half * 64 + t] = ss;
    __syncthreads();
    const float rstd = rsqrtf((ssq[t] + ssq[64 + t]) * (1.f / 256.f) + RMS_EPS);
    const bf16* op = proj + (size_t)(row0 + t) * NPROJ_PAD + 4096 + h * 256 + 128 * half + 4 * fq;
    bf16* mp = (bf16*)(ws + WS_MIX) + (size_t)(row0 + t) * D + h * 256 + 128 * half + 4 * fq;
    const float* nw = a->in[I_MNORM] + h * 256 + 128 * half + 4 * fq;
    v2u opr[8];
#pragma unroll
    for (int vb = 0; vb < 8; ++vb) opr[vb] = *(const v2u*)(op + 16 * vb);
#pragma unroll
    for (int vb = 0; vb < 8; ++vb) { const v2u o = opr[vb]; const f32x4 n4 = *(const f32x4*)(nw + 16 * vb);
        f32x4 y; y.x = hv[vb].x * rstd * n4.x * sigm(bflo(o.x)); y.y = hv[vb].y * rstd * n4.y * sigm(bfhi(o.x)); y.z = hv[vb].z * rstd * n4.z * sigm(bflo(o.y)); y.w = hv[vb].w * rstd * n4.w * sigm(bfhi(o.y));
        *(v2u*)(mp + 16 * vb) = pack4(y); }
    __syncthreads();
}


__device__ __forceinline__ void mlstm_sample_load(ArgsP a, int j, const int tid, f32x4 (&cst)[2][4][2]) {
    const int lane = tid & 63, w = __builtin_amdgcn_readfirstlane(tid >> 6), fr = lane & 15, fq = lane >> 4;
    const float* C0 = a->in[I_SMC] + (size_t)j * 32768;
#pragma unroll
    for (int vb = 0; vb < 2; ++vb)
#pragma unroll
        for (int ksp = 0; ksp < 4; ++ksp) { const float* cp = C0 + (size_t)(32 * w + 16 * vb + fr) * 128 + 32 * ksp + 4 * fq; cst[vb][ksp][0] = __builtin_nontemporal_load((const f32x4*)cp); cst[vb][ksp][1] = __builtin_nontemporal_load((const f32x4*)(cp + 16)); }
}
__device__ __forceinline__ void mlstm_sample_item(ArgsP a, LAS unsigned char* lds, int j, const int tid, const f32x4 (&cst)[2][4][2]) {
    const int b = j >> 3, h = j & 7, row0 = MP + b * TS;
    const int lane = tid & 63, w = __builtin_amdgcn_readfirstlane(tid >> 6), fr = lane & 15, fq = lane >> 4;
    unsigned char* ws = a->ws;
    const bf16* proj = (const bf16*)(ws + WS_PROJ); const float* gates = (const float*)(ws + WS_GATES);
    float* Cout = a->out + O_MCS + (size_t)j * 32768;
    LAS float* qs = (LAS float*)lds;
    LAS float* ks = qs + 512;
    LAS float* vs = ks + 512;
    LAS float* gs = vs + 1024;
    LAS float* qkr = gs + 8;
    LAS float* qnl = qkr + 16;
    LAS float* hbuf = qnl + 8;
#pragma unroll
    for (int tok = 0; tok < 4; ++tok) { const bf16* pr = proj + (size_t)(row0 + tok) * NPROJ_PAD;
        if (tid < 128) qs[tok * 128 + tid] = bf2f(pr[h * 128 + tid]); else if (tid < 256) ks[tok * 128 + tid - 128] = bf2f(pr[1024 + h * 128 + (tid - 128)]) * 0.08838834764831845f; else vs[tok * 256 + tid - 256] = bf2f(pr[2048 + h * 256 + (tid - 256)]); }
    if (tid < 4) { gs[tid * 2] = gates[(size_t)(row0 + tid) * 16 + h] + a->in[I_BIG][h]; gs[tid * 2 + 1] = gates[(size_t)(row0 + tid) * 16 + 8 + h] + a->in[I_BFG][h]; }
    const float n0a = a->in[I_SMN][(size_t)j * 128 + lane], n0b = a->in[I_SMN][(size_t)j * 128 + 64 + lane];
    const float m0 = a->in[I_SMM][j];
    __syncthreads();
#pragma unroll
    for (int i = 0; i < 2; ++i) { const int p = 2 * w + i, t = p >> 2, sx = p & 3; const float d = wave_sum(qs[t * 128 + lane] * ks[sx * 128 + lane] + qs[t * 128 + 64 + lane] * ks[sx * 128 + 64 + lane]); if (lane == 0) qkr[p] = d; }
    if (w < 4) { const float d = wave_sum(qs[w * 128 + lane] * n0a + qs[w * 128 + 64 + lane] * n0b); if (lane == 0) qnl[w] = d; }
    float bc[4], ig[4], mt[4], m = m0, bsum = 0.f;
#pragma unroll
    for (int t = 0; t < 4; ++t) { ig[t] = gs[t * 2]; const float lf = logsigf(gs[t * 2 + 1]); bsum += lf; bc[t] = bsum; m = fmaxf(lf + m, ig[t]); mt[t] = m; }
    const float scf = fexp(bc[3] + m0 - mt[3]);
    float wsf[4], et[4];
#pragma unroll
    for (int t = 0; t < 4; ++t) { wsf[t] = fexp(bc[3] - bc[t] + ig[t] - mt[3]); et[t] = fexp(bc[t] + m0 - mt[t]); }
    __syncthreads();
    float S[4][4], hden[4];
#pragma unroll
    for (int t = 0; t < 4; ++t) { float den = et[t] * qnl[t];
#pragma unroll
        for (int sx = 0; sx < 4; ++sx) { S[t][sx] = (sx <= t) ? qkr[t * 4 + sx] * fexp(bc[t] - bc[sx] + ig[sx] - mt[t]) : 0.f; den += S[t][sx]; }
        hden[t] = 1.f / fmaxf(fabsf(den), fexp(-mt[t])); }
    bf16x8 qa[4];
#pragma unroll
    for (int ksp = 0; ksp < 4; ++ksp) { v4u u = (v4u){0u, 0u, 0u, 0u};
        if (fr < 4) { const f32x4 x0 = *(const LAS f32x4*)(qs + fr * 128 + 32 * ksp + 4 * fq), x1 = *(const LAS f32x4*)(qs + fr * 128 + 32 * ksp + 16 + 4 * fq); u.x = pk2(x0.x, x0.y); u.y = pk2(x0.z, x0.w); u.z = pk2(x1.x, x1.y); u.w = pk2(x1.z, x1.w); }
        qa[ksp] = __builtin_bit_cast(bf16x8, u); }
#pragma unroll
    for (int vb = 0; vb < 2; ++vb) { const int v = 32 * w + 16 * vb + fr;
        float vw[4];
#pragma unroll
        for (int sx = 0; sx < 4; ++sx) vw[sx] = vs[sx * 256 + v] * wsf[sx];
        f32x4 dacc = (f32x4){0.f, 0.f, 0.f, 0.f};
#pragma unroll
        for (int ksp = 0; ksp < 4; ++ksp) { const f32x4 c0 = cst[vb][ksp][0], c1 = cst[vb][ksp][1];
            v4u u; u.x = pk2(c0.x, c0.y); u.y = pk2(c0.z, c0.w); u.z = pk2(c1.x, c1.y); u.w = pk2(c1.z, c1.w);
            dacc = MFMA32(qa[ksp], __builtin_bit_cast(bf16x8, u), dacc);
            f32x4 n0v = c0 * scf, n1v = c1 * scf;
#pragma unroll
            for (int sx = 0; sx < 4; ++sx) { const f32x4 k0 = *(const LAS f32x4*)(ks + sx * 128 + 32 * ksp + 4 * fq), k1 = *(const LAS f32x4*)(ks + sx * 128 + 32 * ksp + 16 + 4 * fq); n0v = n0v + k0 * vw[sx]; n1v = n1v + k1 * vw[sx]; }
            float* op = Cout + (size_t)v * 128 + 32 * ksp + 4 * fq; __builtin_nontemporal_store(n0v, (f32x4*)op); __builtin_nontemporal_store(n1v, (f32x4*)(op + 16)); }
        if (fq == 0) {
#pragma unroll
            for (int t = 0; t < 4; ++t) { float num = et[t] * dacc[t];
#pragma unroll
                for (int sx = 0; sx < 4; ++sx) num += S[t][sx] * vs[sx * 256 + v];
                hbuf[t * 256 + v] = num * hden[t]; } }
    }
    if (tid < 128) { float nn = scf * a->in[I_SMN][(size_t)j * 128 + tid];
#pragma unroll
        for (int sx = 0; sx < 4; ++sx) nn += wsf[sx] * ks[sx * 128 + tid];
        a->out[O_MNS + (size_t)j * 128 + tid] = nn; }
    if (tid == 0) a->out[O_MMS + j] = mt[3];
    __syncthreads();
    if (w < 4) { const int tok = w, row = row0 + tok; float hv[4]; float ss = 0.f;
#pragma unroll
        for (int i = 0; i < 4; ++i) { hv[i] = hbuf[tok * 256 + i * 64 + lane]; ss += hv[i] * hv[i]; }
        const float rstd = rsqrtf(wave_sum(ss) * (1.f / 256.f) + RMS_EPS);
        const float* nw = a->in[I_MNORM] + h * 256; bf16* mix = (bf16*)(ws + WS_MIX);
#pragma unroll
        for (int i = 0; i < 4; ++i) { const int vi = i * 64 + lane; const float op = bf2f(proj[(size_t)row * NPROJ_PAD + 4096 + h * 256 + vi]);
            mix[(size_t)row * D + h * 256 + vi] = (bf16)f2bf(hv[i] * rstd * nw[vi] * sigm(op)); } }
    __syncthreads();
}

__device__ __forceinline__ void phase_mixer_even(ArgsP a, LAS unsigned char* lds, int vcu, int G, const int tid) {
#pragma unroll 1
    for (int r = 0; r < 1 + (PROBE_SUB & 1); ++r)
#pragma unroll 1
    for (int it = vcu; it < 1024; it += G) delta_prep_item(a, lds, it, tid);
#pragma unroll 1
    for (int r = 0; r < 1 + ((PROBE_SUB >> 1) & 1); ++r)
#pragma unroll 1
    for (int it = vcu; it < 1024; it += G) lru_prep_item(a, lds, it, tid);
#pragma unroll 1
    for (int r = 0; r < 1 + ((PROBE_SUB >> 2) & 1); ++r)
#pragma unroll 1
    for (int j = vcu; j < 1024; j += G) { const int b = j >> 3, hn = j & 7; delta_rec_item(a, lds, MP + b * TS, TS, hn, a->in[I_SCONV] + (size_t)b * 3 * 4096, a->in[I_SDELTA] + (size_t)j * 16384, a->out + O_DELTAS + (size_t)j * 16384, tid); }
#pragma unroll 1
    for (int r = 0; r < 1 + ((PROBE_SUB >> 3) & 1); ++r)
#pragma unroll 1
    for (int j = vcu; j < 1024; j += G) { const int b = j >> 3, hn = j & 7; lru_rec_item(a, lds, MP + b * TS, TS, hn, a->in[I_SCONV] + (size_t)b * 3 * 4096, a->in[I_SLRU] + (size_t)b * 1024, a->out + O_LRUS + (size_t)b * 1024, tid); }
    const bf16* proj = (const bf16*)(a->ws + WS_PROJ);
    const int nconv = (BP + BS) * 3 * 4096;
    for (int i = vcu * NTHR + tid; i < nconv; i += G * NTHR) {
        const int ch = i & 4095, rj = i >> 12, j = rj % 3, b = rj / 3;
        if (b < BP) a->out[O_CONVP + (size_t)(b * 3 + j) * 4096 + ch] = bf2f(proj[(size_t)(b * TP + TP - 3 + j) * NPROJ_PAD + ch]);
        else { const int bs = b - BP; a->out[O_CONVS + (size_t)(bs * 3 + j) * 4096 + ch] = bf2f(proj[(size_t)(MP + bs * TS + 1 + j) * NPROJ_PAD + ch]); }
    }
}
__device__ __forceinline__ void phase_mixer_even_b(ArgsP a, LAS unsigned char* lds, int vcu, int G, const int tid) {
    const int w = __builtin_amdgcn_readfirstlane(tid >> 6);
    if (w == 0) { for (int it = vcu; it < 256; it += G) delta_scan_wave(a, it >> 3, it & 7, tid & 63); }
    else { LAS float* scr = (LAS float*)(lds + w * 16384);
        convert_range(a, scr, cv::R_IN0, cv::R_SCAN, vcu * 7 + (w - 1), G * 7, tid & 63); }
}
__device__ __forceinline__ void phase_mixer_even_c(ArgsP a, LAS unsigned char* lds, int vcu, int G, const int tid) {
    const int w = tid >> 6;
#pragma unroll 1
    for (int it = vcu; it < 512; it += G) delta_out_wave(a, 2 * it + (w >> 2), w & 3, tid & 63);
#pragma unroll 1
    for (int it = vcu; it < 1024; it += G) lru_out_item(a, lds, it, tid);
    for (int chain = vcu; chain < 32; chain += G) {
        const float* src = (const float*)(a->ws + WS_DF) + (size_t)chain * 16384; float* dst = a->out + O_DELTAP + (size_t)chain * 16384;
        for (int e = tid; e < 16384; e += NTHR) { const int dk = e >> 7, dv = e & 127;
            dst[e] = src[((((dv >> 4) * 8 + (dk >> 4)) * 64 + ((dk >> 2) & 3) * 16 + (dv & 15)) << 2) + (dk & 3)]; }
    }
}
__device__ __forceinline__ void phase_mixer_odd(ArgsP a, LAS unsigned char* lds, int vcu, int G, const int tid) {
#pragma unroll 1
    for (int r = 0; r < 1 + ((PROBE_SUB >> 4) & 1); ++r)
#pragma unroll 1
    for (int it = vcu; it < 256; it += G) mlstm_scan_item(a, lds, it >> 3, it & 7, tid);
#pragma unroll 1
    for (int r = 0; r < 1 + ((PROBE_SUB >> 5) & 1); ++r)
    {
        f32x4 cA[2][4][2], cB[2][4][2]; int j = vcu;
        if (j < 1024) { mlstm_sample_load(a, j, tid, cA);
#pragma unroll 1
            for (;;) {
                const int jB = j + G; const bool hasB = jB < 1024;
                if (hasB) mlstm_sample_load(a, jB, tid, cB);
                mlstm_sample_item(a, lds, j, tid, cA);
                if (!hasB) break;
                j = jB + G; const bool hasA = j < 1024;
                if (hasA) mlstm_sample_load(a, j, tid, cA);
                mlstm_sample_item(a, lds, jB, tid, cB);
                if (!hasA) break;
            } }
    }
}
__device__ __forceinline__ void phase_mixer_odd_b(ArgsP a, LAS unsigned char* lds, int vcu, int G, const int tid) {
#pragma unroll 1
    for (int it = vcu; it < 1024; it += G) mlstm_out_item(a, lds, it, tid);
}

__device__ __forceinline__ void phase_ln(const bf16* VB, const float* ST, const float* p1, const bf16* resid, const float* g, const float* bta, bf16* dst, LAS unsigned char* lds, int vcu, int G, const int tid) {
    const int lane = tid & 63, w = __builtin_amdgcn_readfirstlane(tid >> 6), gw = vcu * NWAVES + w, NGW = G * NWAVES;
    {
        LAS float* red = (LAS float*)lds;
        for (int r0 = 2 * vcu; r0 < MS; r0 += 2 * G) {
            const int r = r0 + (w >> 2), q = w & 3, col = 512 * q + 8 * lane; const size_t off = (size_t)(MP + r) * D + col;
            const float* q1 = p1 + (size_t)r * D + col;
            f32x4 x0 = *(const f32x4*)q1, x1 = *(const f32x4*)(q1 + 4);
#pragma unroll
            for (int ch = 1; ch < 16; ++ch) { x0 = x0 + *(const f32x4*)(q1 + (size_t)ch * 512 * D); x1 = x1 + *(const f32x4*)(q1 + (size_t)ch * 512 * D + 4); }
            const v4u rr = *(const v4u*)(resid + off);
            float v[8] = {x0.x + DN_ALPHA * bflo(rr.x), x0.y + DN_ALPHA * bfhi(rr.x), x0.z + DN_ALPHA * bflo(rr.y), x0.w + DN_ALPHA * bfhi(rr.y),
                          x1.x + DN_ALPHA * bflo(rr.z), x1.y + DN_ALPHA * bfhi(rr.z), x1.z + DN_ALPHA * bflo(rr.w), x1.w + DN_ALPHA * bfhi(rr.w)};
            float s = 0.f, ss = 0.f;
#pragma unroll
            for (int i = 0; i < 8; ++i) { s += v[i]; ss += v[i] * v[i]; }
            s = wave_sum(s); ss = wave_sum(ss);
            if (lane == 0) { red[w * 2] = s; red[w * 2 + 1] = ss; }
            __syncthreads();
            const int wb = (w >> 2) * 4; s = (red[wb * 2] + red[wb * 2 + 2]) + (red[wb * 2 + 4] + red[wb * 2 + 6]); ss = (red[wb * 2 + 1] + red[wb * 2 + 3]) + (red[wb * 2 + 5] + red[wb * 2 + 7]);
            const float mean = s * (1.f / D), rstd = rsqrtf(fmaxf(ss * (1.f / D) - mean * mean, 0.f) + LN_EPS);
            const f32x4 g0 = *(const f32x4*)(g + col), g1 = *(const f32x4*)(g + col + 4), b0 = *(const f32x4*)(bta + col), b1 = *(const f32x4*)(bta + col + 4);
            v4u o; o.x = pk2((v[0] - mean) * rstd * g0.x + b0.x, (v[1] - mean) * rstd * g0.y + b0.y); o.y = pk2((v[2] - mean) * rstd * g0.z + b0.z, (v[3] - mean) * rstd * g0.w + b0.w);
            o.z = pk2((v[4] - mean) * rstd * g1.x + b1.x, (v[5] - mean) * rstd * g1.y + b1.y); o.w = pk2((v[6] - mean) * rstd * g1.z + b1.z, (v[7] - mean) * rstd * g1.w + b1.w);
            *(v4u*)(dst + off) = o;
            __syncthreads();
        }
    }
    for (int m0 = gw; m0 < MP; m0 += 4 * NGW) {
        v4u vv[4][4]; float s[4], ss[4];
#pragma unroll
        for (int i = 0; i < 4; ++i) { const int m = m0 + i * NGW; s[i] = 0.f; ss[i] = 0.f;
            if (m < MP) { if (lane < 32) { const float* sp = ST + (((size_t)(lane >> 2) * M + m) * 4 + (lane & 3)) * 2; s[i] = sp[0]; ss[i] = sp[1]; }
#pragma unroll
                for (int j = 0; j < 4; ++j) vv[i][j] = *(const v4u*)(VB + (size_t)m * D + j * 512 + lane * 8); } }
#pragma unroll
        for (int i = 0; i < 4; ++i) { const int m = m0 + i * NGW;
            if (m < MP) { const float st = wave_sum(s[i]), sst = wave_sum(ss[i]);
                const float mean = st * (1.f / D), rstd = rsqrtf(fmaxf(sst * (1.f / D) - mean * mean, 0.f) + LN_EPS);
#pragma unroll
                for (int j = 0; j < 4; ++j) { const int col = j * 512 + lane * 8; const v4u v = vv[i][j];
                    const f32x4 g0 = *(const f32x4*)(g + col), g1 = *(const f32x4*)(g + col + 4), b0 = *(const f32x4*)(bta + col), b1 = *(const f32x4*)(bta + col + 4);
                    v4u o; o.x = pk2((bflo(v.x) - mean) * rstd * g0.x + b0.x, (bfhi(v.x) - mean) * rstd * g0.y + b0.y); o.y = pk2((bflo(v.y) - mean) * rstd * g0.z + b0.z, (bfhi(v.y) - mean) * rstd * g0.w + b0.w);
                    o.z = pk2((bflo(v.z) - mean) * rstd * g1.x + b1.x, (bfhi(v.z) - mean) * rstd * g1.y + b1.y); o.w = pk2((bflo(v.w) - mean) * rstd * g1.z + b1.z, (bfhi(v.w) - mean) * rstd * g1.w + b1.w);
                    *(v4u*)(dst + (size_t)m * D + col) = o; } } }
    }
}
__device__ __forceinline__ void phase_combine(const float* p1, const bf16* h2, const bf16* pw, bf16* xb, float* outf, int vcu, int G, const int tid) {
    const int lane = tid & 63, w = tid >> 6;
    for (int r0 = 2 * vcu; r0 < MS; r0 += 2 * G) {
        const int r = r0 + (w >> 2), q = w & 3, col = 512 * q + 8 * lane; const size_t off = (size_t)(MP + r) * D + col;
        const float* q1 = p1 + (size_t)r * D + col;
        f32x4 x0 = *(const f32x4*)q1, x1 = *(const f32x4*)(q1 + 4);
#pragma unroll
        for (int ch = 1; ch < 16; ++ch) { x0 = x0 + *(const f32x4*)(q1 + (size_t)ch * 512 * D); x1 = x1 + *(const f32x4*)(q1 + (size_t)ch * 512 * D + 4); }
        const v4u hh = *(const v4u*)(h2 + off), pp = *(const v4u*)(pw + off);
        f32x4 o0, o1;
        o0.x = bflo(hh.x) + sigm(x0.x) * bflo(pp.x); o0.y = bfhi(hh.x) + sigm(x0.y) * bfhi(pp.x); o0.z = bflo(hh.y) + sigm(x0.z) * bflo(pp.y); o0.w = bfhi(hh.y) + sigm(x0.w) * bfhi(pp.y);
        o1.x = bflo(hh.z) + sigm(x1.x) * bflo(pp.z); o1.y = bfhi(hh.z) + sigm(x1.y) * bfhi(pp.z); o1.z = bflo(hh.w) + sigm(x1.z) * bflo(pp.w); o1.w = bfhi(hh.w) + sigm(x1.w) * bfhi(pp.w);
        v4u ob; ob.x = pk2(o0.x, o0.y); ob.y = pk2(o0.z, o0.w); ob.z = pk2(o1.x, o1.y); ob.w = pk2(o1.z, o1.w); *(v4u*)(xb + off) = ob;
        if (outf) { *(f32x4*)(outf + off) = o0; *(f32x4*)(outf + off + 4) = o1; }
    }
}

constexpr int N_PHASES = 22;
enum { OP_INPROJ = 0, OP_MIXA, OP_MIXB, OP_MIXC, OP_OUTPROJ, OP_LN1, OP_UP, OP_DOWN, OP_LN2, OP_GATE, OP_COMBINE };
enum { GK_LN = 0, GK_BF16 = 1, GK_SQRELU = 2, GK_COMB = 3 };
__global__ void __launch_bounds__(NTHR, 2) mk_fwd(Args a_in) {
    extern __shared__ __attribute__((aligned(16))) unsigned char lds_raw[];
    LAS unsigned char* lds = (LAS unsigned char*)lds_raw;
    ArgsP kp = (ArgsP)__builtin_amdgcn_kernarg_segment_ptr();
    const int lo = a_in.ph_lo, hi = a_in.ph_hi;
    int wv0; { const int wtmp = (int)threadIdx.x >> 6; asm volatile("s_nop 4\n\tv_readfirstlane_b32 %0, %1\n\ts_nop 4" : "=s"(wv0) : "v"(wtmp)); }
#if MK_N_LAUNCHES == 1
    volatile LAS unsigned* xst = (volatile LAS unsigned*)(lds + LDS_CTL_OFF);
    if (threadIdx.x < 2) xst[threadIdx.x] = 0u;
    __syncthreads();
    XcdBarrier bar = xcd_barrier_post((unsigned*)(a_in.ws + WS_CTL) + 4096, xst);
#endif
    int p = lo; asm volatile("" : "+s"(p));
#pragma unroll 1
    for (; p < hi; ) {
      int nrep = 1;
      if (PROBE_MASK) { const int L_ = p <= 11 ? 0 : 1; const int q_ = p == 0 ? -1 : (L_ == 0 ? p - 1 : (p - 12 < 3 ? p - 12 : p - 11));
        int grp; if (p == 0) grp = 0; else if (q_ == OP_INPROJ || q_ == OP_UP) grp = 1; else if (q_ == OP_OUTPROJ || q_ == OP_DOWN || q_ == OP_GATE) grp = 2; else if (q_ == OP_LN1 || q_ == OP_LN2 || q_ == OP_COMBINE) grp = 3; else grp = (L_ == 0) ? 4 : 5;
        if ((PROBE_MASK >> grp) & 1) nrep = 2; }
      if (p == PROBE_P) nrep = 2;
#pragma unroll 1
      for (int rep = 0; rep < nrep; ++rep) {
        int pp = p; asm volatile("" : "+s"(pp));
        int wvs = wv0; asm volatile("" : "+s"(wvs));
        unsigned ones = ~0u; asm volatile("" : "+s"(ones));
        int tid = (wvs << 6) | (int)__builtin_amdgcn_mbcnt_hi(ones, __builtin_amdgcn_mbcnt_lo(ones, 0u)); asm volatile("" : "+v"(tid));
        int bx = blockIdx.x; asm volatile("" : "+s"(bx));
        int G = gridDim.x; asm volatile("" : "+s"(G));
        ArgsP a = kp; asm volatile("" : "+s"(a));
#define MK_VCU ((G % 8 == 0) ? (bx % 8) * (G / 8) + bx / 8 : bx)
#define MK_WAVE (__builtin_amdgcn_readfirstlane(tid >> 6))
#define MK_GW (MK_VCU * NWAVES + MK_WAVE)
#define MK_NGW (G * NWAVES)
#define MK_LANE (tid & 63)
        unsigned char* ws = a->ws;
        if (pp == 0) {
phase_convert(a, lds, MK_GW, MK_NGW, MK_WAVE, MK_LANE); }
        else {
            const int L = pp <= 11 ? 0 : 1; const int q = L == 0 ? pp - 1 : (pp - 12 < 3 ? pp - 12 : pp - 11);
            bf16* xb = (bf16*)(ws + WS_XB); bf16* mixb = (bf16*)(ws + WS_MIX); bf16* hb = (bf16*)(ws + WS_H); bf16* h2b = (bf16*)(ws + WS_H2); bf16* pwb = (bf16*)(ws + WS_PW);
            bf16* projb = (bf16*)(ws + WS_PROJ); bf16* upb = (bf16*)(ws + WS_PROJ);
            bf16* vbb = (bf16*)(ws + WS_PART0); float* stb = (float*)(ws + WS_PART0 + 34 * MiB); float* part1 = (float*)(ws + WS_PART1); float* gatesb = (float*)(ws + WS_GATES);
            if (q == OP_MIXA) { if (L == 0) phase_mixer_even(a, lds, MK_VCU, G, tid); else phase_mixer_odd(a, lds, MK_VCU, G, tid); }
            else if (q == OP_MIXB) { if (L == 0) phase_mixer_even_b(a, lds, MK_VCU, G, tid); else phase_mixer_odd_b(a, lds, MK_VCU, G, tid); }
            else if (q == OP_MIXC) { phase_mixer_even_c(a, lds, MK_VCU, G, tid); }
            else if (q == OP_LN1) phase_ln(vbb, stb, part1, xb, a->in[I_LN1G] + L * D, a->in[I_LN1B] + L * D, hb, lds, MK_VCU, G, tid);
            else if (q == OP_LN2) phase_ln(vbb, stb, part1, hb, a->in[I_LN2G] + L * D, a->in[I_LN2B] + L * D, h2b, lds, MK_VCU, G, tid);
            else if (q == OP_COMBINE) phase_combine(part1, h2b, pwb, xb, L == 1 ? a->out + O_Y : nullptr, MK_VCU, G, tid);
            else {
                for (int sub = 0; sub < (q == OP_INPROJ ? 2 : 1); ++sub) {
                    const bf16* A; const bf16* Bt; int N, K, kind; void* out = nullptr; float* gp = nullptr; const bf16* resid = nullptr; int corder = bx, gorder = G;
                    const int busy_in = ((M / 256) * (NPROJ_PAD / 256)) % 256;
                    if (q == OP_INPROJ && sub == 0) { A = xb; Bt = (const bf16*)(ws + (L == 0 ? WS_WINE : WS_WINO)); N = NPROJ_PAD; K = D; kind = GK_BF16; out = projb; gp = gatesb; }
                    else if (q == OP_INPROJ) { A = (const bf16*)(ws + WS_PB) + (size_t)L * M * PLE; Bt = (const bf16*)(ws + WS_WPLE) + (size_t)L * PLE * D; N = D; K = PLE; kind = GK_BF16; out = pwb;
                        gorder = G - busy_in; corder = (bx >= busy_in) ? bx - busy_in : 1 << 20; }
                    else if (q == OP_OUTPROJ) { A = mixb; Bt = (const bf16*)(ws + (L == 0 ? WS_WOUTE : WS_WOUTO)); N = D; K = D; kind = GK_LN; resid = xb; }
                    else if (q == OP_UP) { A = hb; Bt = (const bf16*)(ws + WS_WUP) + (size_t)L * D * FF; N = FF; K = D; kind = GK_SQRELU; out = upb; }
                    else if (q == OP_DOWN) { A = upb; Bt = (const bf16*)(ws + WS_WDOWN) + (size_t)L * D * FF; N = D; K = FF; kind = GK_LN; resid = hb; }
                    else { A = h2b; Bt = (const bf16*)(ws + WS_WGATE) + (size_t)L * D * D; N = D; K = D; kind = GK_COMB; }
                    pg8::Gemm g{A, Bt, M, N, K};
                    if (kind == GK_LN) { pg8::MainSplit SK; SK.init(K, MK_VCU); pg8::EpiLnStat E{vbb, stb, resid, part1, N, M, DN_ALPHA}; pg8::gemm_phase<pg8::EpiLnStat, pg8::MainSplit, true, true>(lds, g, SK, E, tid); }
                    else if (kind == GK_COMB) { pg8::MainSplit SK; SK.init(K, MK_VCU); pg8::EpiCombine E{h2b, pwb, xb, L == 1 ? a->out + O_Y : nullptr, part1, N}; pg8::gemm_phase<pg8::EpiCombine, pg8::MainSplit, true, true>(lds, g, SK, E, tid); }
                    else if (kind == GK_BF16) { pg8::StaticOrder S; S.init(M, N, K, gorder, corder); pg8::EpiBf16<0> E{(bf16*)out, N, gp, 24}; pg8::gemm_phase<pg8::EpiBf16<0>, pg8::StaticOrder, true, true>(lds, g, S, E, tid);}
                    else { pg8::StaticOrder S; S.init(M, N, K, G, corder); pg8::EpiBf16<1> E{(bf16*)out, N, nullptr, -1}; pg8::gemm_phase<pg8::EpiBf16<1>, pg8::StaticOrder, true, true>(lds, g, S, E, tid);}
                }
                if (q == OP_INPROJ || q == OP_UP) {
                    const int busy = (q == OP_INPROJ) ? ((M / 256) * (NPROJ_PAD / 256)) % 256 : ((M / 256) * (FF / 256)) % 256;
                    const int first = (q == OP_INPROJ) ? (L == 0 ? 0 : cv::R_SCAN) : (L == 0 ? cv::R_IN1 : cv::R_UP0), last = (q == OP_INPROJ) ? (L == 0 ? cv::R_IN0 : cv::R_IN1) : (L == 0 ? cv::R_UP0 : cv::N_REST);
                    if (G == 256 && bx >= busy) { const int w_ = MK_WAVE; convert_range(a, (LAS float*)(lds + w_ * 16384), first, last, (bx - busy) * NWAVES + w_, (G - busy) * NWAVES, MK_LANE); }
                }
            }
        }
#if MK_N_LAUNCHES == 1
        if (p + 1 < hi || rep + 1 < nrep) xcd_barrier(bar);
#endif
      }
      asm volatile("s_add_i32 %0, %0, 1" : "+s"(p) : : "scc");
    }
}

extern "C" void kernel_launch(void* const* d_in, const int* in_sizes, int n_in, void* d_out, int out_size, void* d_ws, size_t ws_size, hipStream_t stream) {
    static int grid = 0;
    if (grid == 0) {
        if (n_in != 35 || (size_t)out_size != O_END || ws_size < WS_END) { fprintf(stderr, "kernel_launch: unexpected shapes: n_in %d out %d (want %zu) ws %zu (want %zu)\n", n_in, out_size, (size_t)O_END, ws_size, (size_t)WS_END); grid = -1; return; }
        int dev = 0, cus = 0, per_cu = 0;
        hipGetDevice(&dev); hipDeviceGetAttribute(&cus, hipDeviceAttributeMultiprocessorCount, dev);
        if (hipFuncSetAttribute((const void*)mk_fwd, hipFuncAttributeMaxDynamicSharedMemorySize, LDS_BYTES) != hipSuccess) { fprintf(stderr, "kernel_launch: hipFuncSetAttribute failed\n"); grid = -1; return; }
        if (hipOccupancyMaxActiveBlocksPerMultiprocessor(&per_cu, (const void*)mk_fwd, NTHR, LDS_BYTES) != hipSuccess || per_cu < 1) { fprintf(stderr, "kernel_launch: occupancy query says %d\n", per_cu); per_cu = 1; }
        (void)hipGetLastError();
        if (cus != 256) { fprintf(stderr, "kernel_launch: built for a 256-CU device (N = 2048 GEMM schedule), got %d\n", cus); grid = -1; return; }
        grid = cus * 1;
    }
    if (grid < 0) return;
    Args a{};
    for (int i = 0; i < 35; ++i) a.in[i] = (const float*)d_in[i];
    a.out = (float*)d_out; a.ws = (unsigned char*)d_ws;
#if MK_N_LAUNCHES == 1
    hipMemsetAsync((char*)d_ws + WS_CTL, 0, 1 * MiB, stream);
    a.ph_lo = 0; a.ph_hi = N_PHASES;
    hipLaunchKernelGGL(mk_fwd, dim3(grid), dim3(NTHR), LDS_BYTES, stream, a);
#else
    for (int p = 0; p < N_PHASES; ++p) {
        a.ph_lo = p; a.ph_hi = p + 1;
        hipLaunchKernelGGL(mk_fwd, dim3(grid), dim3(NTHR), LDS_BYTES, stream, a);
    }
#endif
}
```

```cpp
#include <hip/hip_runtime.h>
#include <hip/hip_cooperative_groups.h>
#include <cstdio>
#include <cstdint>
namespace cg = cooperative_groups;

#ifndef PROBE_MASK
#define PROBE_MASK 0
#endif
#define PROBE_P (-1)
#define PROBE_SUB 0
#ifndef MK_N_LAUNCHES
#define MK_N_LAUNCHES 1
#endif

namespace pg8 {
#define PG8_LAS __attribute__((address_space(3)))
typedef unsigned short bf16_t;
typedef short bf16x8 __attribute__((ext_vector_type(8)));
typedef float f32x4 __attribute__((ext_vector_type(4)));
typedef unsigned u32x4 __attribute__((ext_vector_type(4)));
constexpr int BM = 256, BK = 64, HALF = 128, HTB = HALF * BK * 2, STAGE_BYTES = 8 * HTB, NXCD = 8, WGM = 8;

__host__ __device__ __forceinline__ int lds_byte(int r, int c) { const int st = (r >> 4) * 2 + (c >> 5), rr = r & 15, cc = c & 31, ob = rr * 64 + cc * 2; return st * 1024 + (ob ^ (((ob >> 9) & 1) << 5)); }
__host__ __device__ __forceinline__ void stage_rc(int b, int& R, int& C) { const int st = b / 1024, sb = b % 1024, swz = sb ^ (((sb >> 9) & 1) << 5); R = (st >> 1) * 16 + swz / 64; C = (st & 1) * 32 + (swz % 64) / 2; }
__host__ __device__ __forceinline__ int perm32(int rho) { const int n = rho >> 4, i = rho & 15; return 8 * (i >> 2) + 4 * n + (i & 3); }

struct Unit { int pm, pn, kt0, nkt, dst; };
struct Gemm { const bf16_t* A; const bf16_t* Bt; int M, N, K; };

struct StaticOrder {
    int nM, nN, nwg, G, c, T;
    __host__ __device__ void init(int M, int N, int K, int G_, int c_) { nM = M / BM; nN = N / BM; nwg = nM * nN; G = G_; c = c_; T = K / BK; }
    __host__ __device__ bool next(int i, Unit& u) const {
        const long L = (long)i * G + c; if (L >= nwg) return false;
        int wgid = (int)L; { const int q = nwg / NXCD, r = nwg % NXCD, xcd = wgid % NXCD, off = wgid / NXCD; wgid = (xcd < r ? xcd * (q + 1) : r * (q + 1) + (xcd - r) * q) + off; }
        const int nig = WGM * nN, gid = wgid / nig, fm = gid * WGM, gsz = (nM - fm) < WGM ? (nM - fm) : WGM;
        u.pm = fm + ((wgid % nig) % gsz); u.pn = (wgid % nig) / gsz; u.kt0 = 0; u.nkt = T; u.dst = 0; return true;
    }
    __device__ __forceinline__ void a_ready(const Unit&) const {}
    __device__ __forceinline__ void done(const Unit&) const {}
};
struct StreamK {
    int nN, T, P, ntot, c;
    __host__ __device__ void init(int M, int N, int K, int G, int c_) { nN = N / BM; T = K / BK; ntot = (M / BM) * nN * T; P = (((ntot + G - 1) / G) + 1) & ~1; c = c_; }
    __host__ __device__ bool next(int i, Unit& u) const {
        int s = c * P; const int e = (s + P < ntot) ? s + P : ntot;
        for (int k = 0; ; ++k) { if (s >= e) return false; const int tile = s / T, kt0 = s - tile * T; const int n = (T - kt0 < e - s) ? T - kt0 : e - s;
            if (k == i) { u.pm = tile / nN; u.pn = tile - u.pm * nN; u.kt0 = kt0; u.nkt = n; u.dst = kt0 ? 1 : 0; return true; }
            s += n; }
    }
    __device__ __forceinline__ void a_ready(const Unit&) const {}
    __device__ __forceinline__ void done(const Unit&) const {}
};
struct MainSplit {
    int T, c;
    __host__ __device__ void init(int K, int c_) { T = K / BK; c = c_; }
    __host__ __device__ bool next(int i, Unit& u) const {
        if (i == 0) { u.pm = c >> 3; u.pn = c & 7; u.kt0 = 0; u.nkt = T; u.dst = 0; return true; }
        if (i == 1) { const int lt = c >> 4, j = c & 15; u.pm = 32 + (lt >> 3); u.pn = lt & 7; u.nkt = T >> 4; u.kt0 = j * u.nkt; u.dst = 1 + j; return true; }
        return false;
    }
    __device__ __forceinline__ void a_ready(const Unit&) const {}
    __device__ __forceinline__ void done(const Unit&) const {}
};
__host__ __device__ __forceinline__ bool split_tile(int tile, int T, int P) { return (tile * T) / P != ((tile + 1) * T - 1) / P; }

__device__ __forceinline__ unsigned cvt_pk_bf16(float lo, float hi) { unsigned r; asm volatile("v_cvt_pk_bf16_f32 %0, %1, %2" : "=v"(r) : "v"(lo), "v"(hi)); return r; }

__device__ __forceinline__ float pg_bflo(unsigned w) { return __builtin_bit_cast(float, w << 16); }
__device__ __forceinline__ float pg_bfhi(unsigned w) { return __builtin_bit_cast(float, w & 0xffff0000u); }
__device__ __forceinline__ void store_chunk(const f32x4 (&acc)[2][2][4][2], const Unit& u, float* C1, int ldc, int wr, int wc, int fr, int fq) {
    const int row0 = u.pm * BM + wr * 64 + fr, col0 = u.pn * BM + wc * 32 + 8 * fq; float* Cb = C1 + ((long)(u.dst - 1) * 512 - 8192) * (long)ldc;
#pragma unroll
    for (int ai = 0; ai < 2; ++ai)
#pragma unroll
        for (int m = 0; m < 4; ++m) { float* rowp = Cb + (size_t)(row0 + ai * HALF + m * 16) * ldc + col0;
#pragma unroll
            for (int bj = 0; bj < 2; ++bj) { *(f32x4*)(rowp + bj * HALF) = acc[ai][bj][m][0]; *(f32x4*)(rowp + bj * HALF + 4) = acc[ai][bj][m][1]; } }
}
struct EpiLnStat {
    static constexpr bool PERM = true, AFTER_DRAIN = false;
    bf16_t* VB; float* ST; const bf16_t* resid; float* C1; int ldc; int mrows; float alpha;
    __device__ __forceinline__ void operator()(const f32x4 (&acc)[2][2][4][2], const Unit& u, int wr, int wc, int fr, int fq) const {
        if (u.dst) { store_chunk(acc, u, C1, ldc, wr, wc, fr, fq); return; }
        const int row0 = u.pm * BM + wr * 64 + fr, col0 = u.pn * BM + wc * 32 + 8 * fq;
        u32x4 rq[2];
#pragma unroll
        for (int bj = 0; bj < 2; ++bj) rq[bj] = *(const u32x4*)(resid + (size_t)(row0) * ldc + col0 + bj * HALF);
#pragma unroll
        for (int idx = 0; idx < 8; ++idx) { const int ai = idx >> 2, m = idx & 3; const int row = row0 + ai * HALF + m * 16; float s = 0.f, ss = 0.f;
                u32x4 rc[2] = {rq[0], rq[1]};
                if (idx + 1 < 8) { const int nrow = row0 + ((idx + 1) >> 2) * HALF + ((idx + 1) & 3) * 16;
#pragma unroll
                    for (int bj = 0; bj < 2; ++bj) rq[bj] = *(const u32x4*)(resid + (size_t)nrow * ldc + col0 + bj * HALF); }
#pragma unroll
                for (int bj = 0; bj < 2; ++bj) { const size_t off = (size_t)row * ldc + col0 + bj * HALF; const u32x4 r = rc[bj];
                    f32x4 v0 = acc[ai][bj][m][0], v1 = acc[ai][bj][m][1];
                    v0[0] += alpha * pg_bflo(r.x); v0[1] += alpha * pg_bfhi(r.x); v0[2] += alpha * pg_bflo(r.y); v0[3] += alpha * pg_bfhi(r.y);
                    v1[0] += alpha * pg_bflo(r.z); v1[1] += alpha * pg_bfhi(r.z); v1[2] += alpha * pg_bflo(r.w); v1[3] += alpha * pg_bfhi(r.w);
                    s += ((v0[0] + v0[1]) + (v0[2] + v0[3])) + ((v1[0] + v1[1]) + (v1[2] + v1[3]));
                    ss += ((v0[0] * v0[0] + v0[1] * v0[1]) + (v0[2] * v0[2] + v0[3] * v0[3])) + ((v1[0] * v1[0] + v1[1] * v1[1]) + (v1[2] * v1[2] + v1[3] * v1[3]));
                    u32x4 w; w.x = cvt_pk_bf16(v0[0], v0[1]); w.y = cvt_pk_bf16(v0[2], v0[3]); w.z = cvt_pk_bf16(v1[0], v1[1]); w.w = cvt_pk_bf16(v1[2], v1[3]);
                    *(u32x4*)(VB + off) = w; }
                s += __shfl_xor(s, 16); s += __shfl_xor(s, 32); ss += __shfl_xor(ss, 16); ss += __shfl_xor(ss, 32);
                if (fq == 0) { float* sp = ST + (((size_t)u.pn * mrows + row) * 4 + wc) * 2; sp[0] = s; sp[1] = ss; } }
    }
};
struct EpiCombine {
    static constexpr bool PERM = true, AFTER_DRAIN = false;
    const bf16_t* h2; const bf16_t* pw; bf16_t* xb; float* outf; float* C1; int ldc;
    __device__ __forceinline__ void operator()(const f32x4 (&acc)[2][2][4][2], const Unit& u, int wr, int wc, int fr, int fq) const {
        if (u.dst) { store_chunk(acc, u, C1, ldc, wr, wc, fr, fq); return; }
        const int row0 = u.pm * BM + wr * 64 + fr, col0 = u.pn * BM + wc * 32 + 8 * fq;
        u32x4 hq[2], pq[2];
#pragma unroll
        for (int bj = 0; bj < 2; ++bj) { const size_t o0 = (size_t)row0 * ldc + col0 + bj * HALF; hq[bj] = *(const u32x4*)(h2 + o0); pq[bj] = *(const u32x4*)(pw + o0); }
#pragma unroll
        for (int idx = 0; idx < 8; ++idx) { const int ai = idx >> 2, m = idx & 3; const int row = row0 + ai * HALF + m * 16;
                u32x4 hc[2] = {hq[0], hq[1]}, pc[2] = {pq[0], pq[1]};
                if (idx + 1 < 8) { const int nrow = row0 + ((idx + 1) >> 2) * HALF + ((idx + 1) & 3) * 16;
#pragma unroll
                    for (int bj = 0; bj < 2; ++bj) { const size_t on = (size_t)nrow * ldc + col0 + bj * HALF; hq[bj] = *(const u32x4*)(h2 + on); pq[bj] = *(const u32x4*)(pw + on); } }
#pragma unroll
                for (int bj = 0; bj < 2; ++bj) { const size_t off = (size_t)row * ldc + col0 + bj * HALF; const u32x4 hh = hc[bj], pp = pc[bj];
                    const f32x4 a0 = acc[ai][bj][m][0], a1 = acc[ai][bj][m][1]; f32x4 o0, o1;
                    o0[0] = pg_bflo(hh.x) + pg_bflo(pp.x) / (1.f + __expf(-a0[0])); o0[1] = pg_bfhi(hh.x) + pg_bfhi(pp.x) / (1.f + __expf(-a0[1]));
                    o0[2] = pg_bflo(hh.y) + pg_bflo(pp.y) / (1.f + __expf(-a0[2])); o0[3] = pg_bfhi(hh.y) + pg_bfhi(pp.y) / (1.f + __expf(-a0[3]));
                    o1[0] = pg_bflo(hh.z) + pg_bflo(pp.z) / (1.f + __expf(-a1[0])); o1[1] = pg_bfhi(hh.z) + pg_bfhi(pp.z) / (1.f + __expf(-a1[1]));
                    o1[2] = pg_bflo(hh.w) + pg_bflo(pp.w) / (1.f + __expf(-a1[2])); o1[3] = pg_bfhi(hh.w) + pg_bfhi(pp.w) / (1.f + __expf(-a1[3]));
                    u32x4 w; w.x = cvt_pk_bf16(o0[0], o0[1]); w.y = cvt_pk_bf16(o0[2], o0[3]); w.z = cvt_pk_bf16(o1[0], o1[1]); w.w = cvt_pk_bf16(o1[2], o1[3]);
                    *(u32x4*)(xb + off) = w;
                    if (outf) { *(f32x4*)(outf + off) = o0; *(f32x4*)(outf + off + 4) = o1; } } }
    }
};
template <int ACT> struct EpiBf16 {
    static constexpr bool PERM = true, AFTER_DRAIN = false;
    bf16_t* O; int ldc; float* gates; int gate_pn;
    __device__ __forceinline__ void operator()(const f32x4 (&acc)[2][2][4][2], const Unit& u, int wr, int wc, int fr, int fq) const {
        const int row0 = u.pm * BM + wr * 64 + fr; const int col0 = u.pn * BM + wc * 32 + 8 * fq;
        const bool gt = (gates != nullptr) && (u.pn == gate_pn) && (wc == 0) && (fq < 2);
#pragma unroll
        for (int ai = 0; ai < 2; ++ai)
#pragma unroll
            for (int m = 0; m < 4; ++m) { const int row = row0 + ai * HALF + m * 16; bf16_t* rowp = O + (size_t)row * ldc + col0;
#pragma unroll
                for (int bj = 0; bj < 2; ++bj) { f32x4 v0 = acc[ai][bj][m][0], v1 = acc[ai][bj][m][1];
                    if (ACT == 1) {
#pragma unroll
                        for (int j = 0; j < 4; ++j) { const float a = fmaxf(v0[j], 0.f), b = fmaxf(v1[j], 0.f); v0[j] = a * a; v1[j] = b * b; } }
                    u32x4 w; w.x = cvt_pk_bf16(v0[0], v0[1]); w.y = cvt_pk_bf16(v0[2], v0[3]); w.z = cvt_pk_bf16(v1[0], v1[1]); w.w = cvt_pk_bf16(v1[2], v1[3]);
                    *(u32x4*)(rowp + bj * HALF) = w; }
                if (gt) { float* gp = gates + (size_t)row * 16 + 8 * fq; *(f32x4*)gp = acc[ai][0][m][0]; *(f32x4*)(gp + 4) = acc[ai][0][m][1]; } }
    }
};

template <class Epi, class Sched, bool ALIGN_EPI = false, bool SP2 = false>
__device__ __forceinline__ void gemm_phase(PG8_LAS unsigned char* lds, const Gemm g, const Sched& S, const Epi& E, const int tid) {
    const int wid = __builtin_amdgcn_readfirstlane(tid >> 6), lane = tid & 63, wr = wid >> 2, wc = wid & 3, fr = lane & 15, fq = lane >> 4;
    const int K = g.K;
    unsigned voffA[2], voffB[2];
#pragma unroll
    for (int i = 0; i < 2; ++i) { int R, C; stage_rc(tid * 16 + i * 8192, R, C); const int Rb = Epi::PERM ? ((R & ~31) + perm32(R & 31)) : R;
        voffA[i] = (unsigned)(R * K + C) * 2u; voffB[i] = (unsigned)(Rb * K + C) * 2u; }
    const size_t kstep = (size_t)(BK * 2);
    const size_t hstep = (size_t)HALF * K * 2;
    const size_t tstep = 2 * hstep;
    const unsigned ldsw = (unsigned)wid * 1024u;
    const int aoff = lds_byte(wr * 64 + fr, fq * 8), boff = lds_byte(wc * 32 + fr, fq * 8);
#define PG8_SA(b, h) (((b) * 2 + (h)) * HTB)
#define PG8_SB(b, h) ((4 + (b) * 2 + (h)) * HTB)
#define PG8_STAGE(bufoff, gbase, voff) do { _Pragma("unroll") for (int _i = 0; _i < 2; ++_i) \
        __builtin_amdgcn_global_load_lds((const unsigned*)((const char*)(gbase) + (voff)[_i]), (PG8_LAS unsigned*)(lds + (bufoff) + ldsw + _i * 8192), 16, 0, 0); } while (0)
#define PG8_LDA(dst, b, h) do { _Pragma("unroll") for (int m = 0; m < 4; ++m) _Pragma("unroll") for (int k = 0; k < 2; ++k) dst[m][k] = *(const PG8_LAS bf16x8*)(lds + PG8_SA(b, h) + aoff + m * 2048 + k * 1024); } while (0)
#define PG8_LDB(dst, b, h) do { _Pragma("unroll") for (int n = 0; n < 2; ++n) _Pragma("unroll") for (int k = 0; k < 2; ++k) dst[n][k] = *(const PG8_LAS bf16x8*)(lds + PG8_SB(b, h) + boff + n * 2048 + k * 1024); } while (0)
#define PG8_MMA(ai, bj, At, Bt) do { __builtin_amdgcn_s_setprio(1); _Pragma("unroll") for (int m = 0; m < 4; ++m) _Pragma("unroll") for (int n = 0; n < 2; ++n) _Pragma("unroll") for (int k = 0; k < 2; ++k) \
        acc[ai][bj][m][n] = __builtin_amdgcn_mfma_f32_16x16x32_bf16(Bt[n][k], At[m][k], acc[ai][bj][m][n], 0, 0, 0); __builtin_amdgcn_s_setprio(0); } while (0)
#define PG8_WAIT_V(n) asm volatile("s_waitcnt vmcnt(" #n ")" ::: "memory")
#define PG8_WAIT_L(n) asm volatile("s_waitcnt lgkmcnt(" #n ")" ::: "memory")
#define PG8_BAR __builtin_amdgcn_s_barrier()
#define PG8_SCHED __builtin_amdgcn_sched_barrier(0)
    Unit cur, nxt; int ui = 0;
    if (!S.next(0, cur)) return;
    f32x4 acc[2][2][4][2];
#pragma unroll
    for (int a = 0; a < 2; ++a)
#pragma unroll
        for (int b = 0; b < 2; ++b)
#pragma unroll
            for (int m = 0; m < 4; ++m)
#pragma unroll
                for (int n = 0; n < 2; ++n) acc[a][b][m][n] = (f32x4){0.f, 0.f, 0.f, 0.f};
    bf16x8 At[4][2], B0[2][2], B1[2][2];
    const char* cA = (const char*)g.A + (size_t)cur.pm * tstep + (size_t)cur.kt0 * kstep; const char* cB = (const char*)g.Bt + (size_t)cur.pn * tstep + (size_t)cur.kt0 * kstep;
    S.a_ready(cur);
    if constexpr (SP2) {
        PG8_STAGE(PG8_SB(0, 0), cB, voffB); PG8_STAGE(PG8_SB(0, 1), cB + hstep, voffB); PG8_STAGE(PG8_SA(0, 0), cA, voffA); PG8_STAGE(PG8_SA(0, 1), cA + hstep, voffA);
        if (wr == 1) PG8_BAR;
        PG8_WAIT_V(2); PG8_BAR;
        PG8_STAGE(PG8_SB(1, 0), cB + kstep, voffB); PG8_STAGE(PG8_SA(1, 0), cA + kstep, voffA); PG8_STAGE(PG8_SB(1, 1), cB + hstep + kstep, voffB);
        PG8_WAIT_V(6); PG8_BAR;
    } else {
        PG8_STAGE(PG8_SB(0, 0), cB, voffB); PG8_STAGE(PG8_SA(0, 0), cA, voffA); PG8_STAGE(PG8_SB(0, 1), cB + hstep, voffB); PG8_STAGE(PG8_SA(0, 1), cA + hstep, voffA);
        if (wr == 1) PG8_BAR;
        PG8_WAIT_V(4); PG8_BAR;
        PG8_STAGE(PG8_SB(1, 0), cB + kstep, voffB); PG8_STAGE(PG8_SA(1, 0), cA + kstep, voffA); PG8_STAGE(PG8_SB(1, 1), cB + hstep + kstep, voffB);
        PG8_WAIT_V(6); PG8_BAR;
    }
    for (;;) {
        const bool has_next = S.next(ui + 1, nxt);
        const char* nA = has_next ? (const char*)g.A + (size_t)nxt.pm * tstep + (size_t)nxt.kt0 * kstep : cA; const char* nB = has_next ? (const char*)g.Bt + (size_t)nxt.pn * tstep + (size_t)nxt.kt0 * kstep : cB;
        const int nt = cur.nkt;
        for (int t = 0; t < nt; t += 2) {
            const bool last = (t == nt - 2);
            const char* a1 = cA + (size_t)(t + 1) * kstep;
            const char* a2 = last ? nA : cA + (size_t)(t + 2) * kstep; const char* b2 = last ? nB : cB + (size_t)(t + 2) * kstep;
            const char* a3 = a2 + kstep; const char* b3 = b2 + kstep;
            if (last && has_next) S.a_ready(nxt);
            if constexpr (SP2) {
            PG8_LDB(B0, 0, 0); PG8_LDB(B1, 0, 1); PG8_SCHED; PG8_LDA(At, 0, 0); PG8_STAGE(PG8_SA(1, 1), a1 + hstep, voffA);
            PG8_WAIT_V(8); PG8_WAIT_L(0); PG8_BAR; PG8_MMA(0, 0, At, B0); PG8_MMA(0, 1, At, B1); PG8_BAR; PG8_SCHED;
            PG8_LDA(At, 0, 1); PG8_STAGE(PG8_SB(0, 0), b2, voffB); PG8_STAGE(PG8_SB(0, 1), b2 + hstep, voffB); PG8_STAGE(PG8_SA(0, 0), a2, voffA);
            PG8_WAIT_V(8); PG8_WAIT_L(0); PG8_BAR; PG8_MMA(1, 0, At, B0); PG8_MMA(1, 1, At, B1); PG8_BAR; PG8_SCHED;
            PG8_LDB(B0, 1, 0); PG8_LDB(B1, 1, 1); PG8_SCHED; PG8_LDA(At, 1, 0); PG8_STAGE(PG8_SA(0, 1), a2 + hstep, voffA);
            PG8_WAIT_V(8); PG8_WAIT_L(0); PG8_BAR; PG8_MMA(0, 0, At, B0); PG8_MMA(0, 1, At, B1); PG8_BAR; PG8_SCHED;
            PG8_LDA(At, 1, 1); PG8_STAGE(PG8_SB(1, 0), b3, voffB); PG8_STAGE(PG8_SB(1, 1), b3 + hstep, voffB); PG8_STAGE(PG8_SA(1, 0), a3, voffA);
            PG8_WAIT_V(8); PG8_WAIT_L(0); PG8_BAR; PG8_MMA(1, 0, At, B0); PG8_MMA(1, 1, At, B1); PG8_BAR; PG8_SCHED;
            } else {
            PG8_LDB(B0, 0, 0); PG8_SCHED; PG8_LDA(At, 0, 0); PG8_STAGE(PG8_SA(1, 1), a1 + hstep, voffA);
            PG8_WAIT_L(8); PG8_BAR; PG8_WAIT_L(0); PG8_MMA(0, 0, At, B0); PG8_BAR; PG8_SCHED;
            PG8_LDB(B1, 0, 1); PG8_STAGE(PG8_SB(0, 0), b2, voffB);
            PG8_BAR; PG8_WAIT_L(0); PG8_MMA(0, 1, At, B1); PG8_BAR;
            PG8_LDA(At, 0, 1); PG8_STAGE(PG8_SA(0, 0), a2, voffA);
            PG8_BAR; PG8_WAIT_L(0); PG8_MMA(1, 0, At, B0); PG8_BAR; PG8_SCHED;
            PG8_STAGE(PG8_SB(0, 1), b2 + hstep, voffB);
            PG8_WAIT_V(6); PG8_BAR; PG8_MMA(1, 1, At, B1); PG8_BAR;
            PG8_LDB(B0, 1, 0); PG8_SCHED; PG8_LDA(At, 1, 0); PG8_STAGE(PG8_SA(0, 1), a2 + hstep, voffA);
            PG8_WAIT_L(8); PG8_BAR; PG8_WAIT_L(0); PG8_MMA(0, 0, At, B0); PG8_BAR; PG8_SCHED;
            PG8_LDB(B1, 1, 1); PG8_STAGE(PG8_SB(1, 0), b3, voffB);
            PG8_BAR; PG8_WAIT_L(0); PG8_MMA(0, 1, At, B1); PG8_BAR;
            PG8_LDA(At, 1, 1); PG8_STAGE(PG8_SA(1, 0), a3, voffA);
            PG8_BAR; PG8_WAIT_L(0); PG8_MMA(1, 0, At, B0); PG8_BAR; PG8_SCHED;
            PG8_STAGE(PG8_SB(1, 1), b3 + hstep, voffB);
            PG8_WAIT_V(6); PG8_BAR; PG8_MMA(1, 1, At, B1); PG8_BAR;
            }
        }
        if constexpr (ALIGN_EPI) { if (wr == 0) PG8_BAR; }
        E(acc, cur, wr, wc, fr, fq); S.done(cur);
        if (!has_next) break;
#pragma unroll
        for (int a = 0; a < 2; ++a)
#pragma unroll
            for (int b = 0; b < 2; ++b)
#pragma unroll
                for (int m = 0; m < 4; ++m)
#pragma unroll
                    for (int n = 0; n < 2; ++n) acc[a][b][m][n] = (f32x4){0.f, 0.f, 0.f, 0.f};
        cur = nxt; cA = nA; cB = nB; ++ui;
        if constexpr (ALIGN_EPI) { if (wr == 1) PG8_BAR; }
    }
    PG8_WAIT_V(0);
    if constexpr (!ALIGN_EPI) { if (wr == 0) PG8_BAR; }
    PG8_BAR;
#undef PG8_SA
#undef PG8_SB
#undef PG8_STAGE
#undef PG8_LDA
#undef PG8_LDB
#undef PG8_MMA
#undef PG8_WAIT_V
#undef PG8_WAIT_L
#undef PG8_BAR
#undef PG8_SCHED
}
}

constexpr int NWAVES = 8, NTHR = 512;
constexpr int D = 2048, FF = 8192, PLE = 256;
constexpr int TP = 2048, BP = 4, TS = 4, BS = 128;
constexpr int MP = BP * TP, MS = BS * TS, M = MP + MS;
constexpr int NPROJ = 6160, NPROJ_PAD = 6400;
constexpr int NH = 8;
constexpr float LN_EPS = 1e-5f, RMS_EPS = 1e-6f;
constexpr float DN_ALPHA = 1.41421356237f;

constexpr size_t MiB = 1u << 20;
constexpr size_t WS_CTL = 0;
constexpr size_t WS_WINE = 1 * MiB;
constexpr size_t WS_WOUTE = WS_WINE + 25 * MiB;
constexpr size_t WS_WINO = WS_WOUTE + 8 * MiB;
constexpr size_t WS_WOUTO = WS_WINO + 25 * MiB;
constexpr size_t WS_WUP = WS_WOUTO + 8 * MiB;
constexpr size_t WS_WDOWN = WS_WUP + 64 * MiB;
constexpr size_t WS_WPLE = WS_WDOWN + 64 * MiB;
constexpr size_t WS_WGATE = WS_WPLE + 2 * MiB;
constexpr size_t WS_XB = WS_WGATE + 16 * MiB;
constexpr size_t WS_MIX = WS_XB + 34 * MiB;
constexpr size_t WS_H = WS_MIX + 34 * MiB;
constexpr size_t WS_H2 = WS_H + 34 * MiB;
constexpr size_t WS_PW = WS_H2 + 34 * MiB;
constexpr size_t WS_PB = WS_PW + 34 * MiB;
constexpr size_t WS_GATES = WS_PB + 9 * MiB;
constexpr size_t WS_PROJ = WS_GATES + 1 * MiB;
constexpr size_t WS_PART0 = WS_PROJ + 136 * MiB;
constexpr size_t WS_PART1 = WS_PART0 + 68 * MiB;
constexpr size_t WS_LRUW = WS_PART1 + 68 * MiB;
constexpr size_t WS_END = WS_LRUW + 1 * MiB;
constexpr size_t WS_DG = WS_PART0;
constexpr size_t WS_DB = WS_PART0 + 32 * MiB;
constexpr size_t WS_DS = WS_PART0 + 64 * MiB;
constexpr size_t WS_DQ = WS_PART0 + 96 * MiB;
constexpr size_t WS_DO = WS_PART0 + 112 * MiB;
constexpr size_t WS_DD = WS_PART0 + 128 * MiB;
constexpr size_t WS_DF = WS_PART0 + 129 * MiB;
constexpr size_t WS_MC = WS_PART0;
constexpr size_t WS_MN = WS_PART0 + 64 * MiB;
constexpr size_t WS_MM = WS_PART0 + 65 * MiB;
constexpr size_t WS_LRU_HL = WS_H;
constexpr size_t WS_LRU_P = WS_H + 16 * MiB;
constexpr size_t WS_LRU_END = WS_H + 32 * MiB;

constexpr size_t O_Y = 0;
constexpr size_t O_CONVP = (size_t)M * D;
constexpr size_t O_DELTAP = O_CONVP + (size_t)BP * 3 * 4096;
constexpr size_t O_LRUP = O_DELTAP + (size_t)BP * 8 * 128 * 128;
constexpr size_t O_MCP = O_LRUP + (size_t)BP * 1024;
constexpr size_t O_MNP = O_MCP + (size_t)BP * 8 * 256 * 128;
constexpr size_t O_MMP = O_MNP + (size_t)BP * 8 * 128;
constexpr size_t O_CONVS = O_MMP + (size_t)BP * 8;
constexpr size_t O_DELTAS = O_CONVS + (size_t)BS * 3 * 4096;
constexpr size_t O_LRUS = O_DELTAS + (size_t)BS * 8 * 128 * 128;
constexpr size_t O_MCS = O_LRUS + (size_t)BS * 1024;
constexpr size_t O_MNS = O_MCS + (size_t)BS * 8 * 256 * 128;
constexpr size_t O_MMS = O_MNS + (size_t)BS * 8 * 128;
constexpr size_t O_END = O_MMS + (size_t)BS * 8;

constexpr int LDS_BYTES = 147456;
constexpr int LDS_CTL_OFF = 131072;

#define LAS __attribute__((address_space(3)))
typedef unsigned short bf16;
typedef unsigned v4u __attribute__((ext_vector_type(4)));
typedef unsigned v2u __attribute__((ext_vector_type(2)));
typedef float f32x4 __attribute__((ext_vector_type(4)));
#define LDS_WAIT() asm volatile("s_waitcnt lgkmcnt(0)" ::: "memory")
__device__ __forceinline__ unsigned f2bf(float f) { unsigned u = __builtin_bit_cast(unsigned, f); return (u + 0x7fffu + ((u >> 16) & 1u)) >> 16; }
__device__ __forceinline__ unsigned pk2(float lo, float hi) { return f2bf(lo) | (f2bf(hi) << 16); }
__device__ __forceinline__ float bf2f(unsigned short b) { return __builtin_bit_cast(float, ((unsigned)b) << 16); }
__device__ __forceinline__ float bflo(unsigned w) { return __builtin_bit_cast(float, w << 16); }
__device__ __forceinline__ float bfhi(unsigned w) { return __builtin_bit_cast(float, w & 0xffff0000u); }
__device__ __forceinline__ float fexp(float x) { return __builtin_amdgcn_exp2f(x * 1.4426950408889634f); }
__device__ __forceinline__ float sigm(float x) { return __builtin_amdgcn_rcpf(1.f + fexp(-x)); }
__device__ __forceinline__ float siluf(float x) { return x * sigm(x); }
__device__ __forceinline__ float softplusf(float x) { return fmaxf(x, 0.f) + log1pf(expf(-fabsf(x))); }
__device__ __forceinline__ float logsigf(float x) { return -softplusf(-x); }
__device__ __forceinline__ float neg_expm1(float y) {
    const float ser = -y * (1.f + y * (0.5f + y * (0.16666667f + y * (0.041666668f + y * (0.008333334f + y * 0.0013888889f)))));
    return (y > -0.25f) ? ser : 1.f - fexp(y);
}
__device__ __forceinline__ float gelu_tanh(float x) { const float u = 0.7978845608028654f * (x + 0.044715f * x * x * x); return x * sigm(2.f * u); }
__device__ __forceinline__ float wave_sum(float v) {
#pragma unroll
    for (int o = 1; o < 64; o <<= 1) v += __shfl_xor(v, o);
    return v;
}

#define XB_TMO      128
#define XB_XCNT(j)  (256  + 64 * (j))
#define XB_XSUB(j)  (1280 + 64 * (j))
#define XB_XGEN(j)  (2304 + 64 * (j))
#define XB_TOP      3328
#define XB_TOPGEN   3392
#define XCD_BAR_WORDS 3456
#define XB_SPIN_CAP (1u << 22)
__device__ __forceinline__ unsigned xb_ld(unsigned* p)              { return __hip_atomic_load(p, __ATOMIC_RELAXED, __HIP_MEMORY_SCOPE_AGENT); }
__device__ __forceinline__ unsigned xb_add(unsigned* p, unsigned v) { return __hip_atomic_fetch_add(p, v, __ATOMIC_RELAXED, __HIP_MEMORY_SCOPE_AGENT); }
__device__ __forceinline__ unsigned xb_xcc_id() { return (unsigned)__builtin_amdgcn_s_getreg((3 << 11) | 20) & 0xFu; }
#define XB_SPIN(cond, bar) do { unsigned _sp = 0; while (cond) { __builtin_amdgcn_s_sleep(1); \
    if ((++_sp & 255u) == 0u) { if (xb_ld(&(bar)[XB_TMO])) break; if (_sp > XB_SPIN_CAP) { atomicAdd(&(bar)[XB_TMO], 1u); break; } } } } while (0)
struct XcdBarrier { unsigned* bar; unsigned x; volatile LAS unsigned* st; };
__device__ __forceinline__ XcdBarrier xcd_barrier_post(unsigned* bar, volatile LAS unsigned* st) {
    XcdBarrier b; b.bar = bar; b.x = xb_xcc_id(); b.st = st;
    if (threadIdx.x == 0) (void)xb_add(&bar[XB_XCNT(b.x)], 1u);
    return b;
}
__device__ __forceinline__ void xcd_barrier_complete(unsigned* bar, unsigned x, unsigned& nloc, unsigned& nx) {
    const unsigned G = gridDim.x * gridDim.y * gridDim.z;
    unsigned sum, cnt, mine, sp = 0u;
    for (;;) {
        sum = 0u; cnt = 0u; mine = 0u;
#pragma unroll
        for (unsigned j = 0; j < 16; ++j) { const unsigned c = xb_ld(&bar[XB_XCNT(j)]); sum += c; cnt += (c > 0u) ? 1u : 0u; mine = (j == x) ? c : mine; }
        if (sum == G) break;
        __builtin_amdgcn_s_sleep(1);
        if ((++sp & 255u) == 0u) { if (xb_ld(&bar[XB_TMO])) break; if (sp > XB_SPIN_CAP) { atomicAdd(&bar[XB_TMO], 1u); break; } }
    }
    nloc = mine > 0u ? mine : 1u; nx = cnt > 0u ? cnt : 1u;
}
__device__ __forceinline__ void xcd_barrier(const XcdBarrier& b) {
    asm volatile("s_waitcnt vmcnt(0)" ::: "memory");
    __syncthreads();
    if (threadIdx.x == 0) {
        unsigned* bar = b.bar;
        __builtin_amdgcn_s_waitcnt(0);
        unsigned nloc = b.st[0], nx = b.st[1];
        if (nloc == 0u) { xcd_barrier_complete(bar, b.x, nloc, nx); b.st[0] = nloc; b.st[1] = nx; }
        const unsigned old = xb_add(&bar[XB_XSUB(b.x)], 1u);
        const unsigned gen = old / nloc;
        if (old + 1u == (gen + 1u) * nloc) {
            __builtin_amdgcn_fence(__ATOMIC_RELEASE, "agent");
            asm volatile("s_waitcnt vmcnt(0)" ::: "memory");
            const unsigned og = xb_add(&bar[XB_TOP], 1u);
            const unsigned tg = og / nx;
            if (og + 1u == (tg + 1u) * nx) xb_add(&bar[XB_TOPGEN], 1u);
            else XB_SPIN(xb_ld(&bar[XB_TOPGEN]) == tg, bar);
            __builtin_amdgcn_fence(__ATOMIC_ACQUIRE, "agent");
            xb_add(&bar[XB_XGEN(b.x)], 1u);
            asm volatile("s_waitcnt vmcnt(0)" ::: "memory");
        } else {
            XB_SPIN(xb_ld(&bar[XB_XGEN(b.x)]) == gen, bar);
            __builtin_amdgcn_fence(__ATOMIC_ACQUIRE, "agent");
            asm volatile("s_waitcnt vmcnt(0)" ::: "memory");
        }
    }
    __syncthreads();
}

struct Args { const float* in[35]; float* out; unsigned char* ws; int ph_lo, ph_hi; };
typedef const __attribute__((address_space(4))) Args* ArgsP;
enum { I_XP = 0, I_XS, I_PP, I_PS, I_SCONV, I_SDELTA, I_SLRU, I_SMC, I_SMN, I_SMM, I_WINE, I_WCONV, I_BCONV, I_ALOG, I_DTB, I_DNORM, I_LWR, I_LBR, I_LWI, I_LBI, I_LLAM, I_WOUTE,
       I_WINO, I_BIG, I_BFG, I_MNORM, I_WOUTO, I_LN1G, I_LN1B, I_LN2G, I_LN2B, I_WUP, I_WDOWN, I_WPLE, I_WGATE };

struct TDesc { const float* W; bf16* WT; int K, N, Npad, item; };
__device__ __forceinline__ void t_load(const TDesc& d, int lane, f32x4 (&v)[8]) {
    const int nblk = d.Npad / 32, kb = d.item / nblk, nb = d.item % nblk, k0 = 64 * kb, n0 = 32 * nb;
    const int r = lane >> 3, c4 = lane & 7; const bool ok = (n0 + 4 * c4) < d.N;
#pragma unroll
    for (int i = 0; i < 8; ++i) v[i] = ok ? __builtin_nontemporal_load((const f32x4*)(d.W + (size_t)(k0 + 8 * i + r) * d.N + n0 + 4 * c4)) : (f32x4){0.f, 0.f, 0.f, 0.f};
}
__device__ __forceinline__ void t_finish(const TDesc& d, LAS float* scr, int lane, const f32x4 (&v)[8]) {
    const int nblk = d.Npad / 32, kb = d.item / nblk, nb = d.item % nblk, k0 = 64 * kb, n0 = 32 * nb;
    const int r = lane >> 3, c4 = lane & 7;
#pragma unroll
    for (int i = 0; i < 8; ++i) { LAS float* q = scr + (8 * i + r) * 33 + 4 * c4; q[0] = v[i].x; q[1] = v[i].y; q[2] = v[i].z; q[3] = v[i].w; }
    LDS_WAIT(); asm volatile("" ::: "memory");
    const int c = lane & 7;
#pragma unroll
    for (int j = 0; j < 4; ++j) { const int n = (lane >> 3) + 8 * j; const LAS float* s = scr + (8 * c) * 33 + n;
        v4u o; o.x = pk2(s[0 * 33], s[1 * 33]); o.y = pk2(s[2 * 33], s[3 * 33]); o.z = pk2(s[4 * 33], s[5 * 33]); o.w = pk2(s[6 * 33], s[7 * 33]);
        *(v4u*)(d.WT + (size_t)(n0 + n) * d.K + k0 + 8 * c) = o; }
    LDS_WAIT(); asm volatile("" ::: "memory");
}
__device__ __forceinline__ void p0_transpose_item(const float* W, int K, int N, int Npad, bf16* WT, LAS float* scr, int item, int lane) {
    const TDesc d{W, WT, K, N, Npad, item}; f32x4 v[8]; t_load(d, lane, v); t_finish(d, scr, lane, v);
}
template <int N> __device__ __forceinline__ void row_to_bf16(const float* src, bf16* dst, int lane) {
    f32x4 v[N / 256];
#pragma unroll
    for (int j = 0; j < N / 256; ++j) v[j] = __builtin_nontemporal_load((const f32x4*)(src + j * 256 + lane * 4));
#pragma unroll
    for (int j = 0; j < N / 256; ++j) { v2u o; o.x = pk2(v[j].x, v[j].y); o.y = pk2(v[j].z, v[j].w); *(v2u*)(dst + j * 256 + lane * 4) = o; }
}
namespace cv { constexpr int I_IN = (D / 64) * (NPROJ_PAD / 32), I_SQ = (D / 64) * (D / 32), I_UP = (D / 64) * (FF / 32), I_DN = (FF / 64) * (D / 32), I_PL = (PLE / 64) * (D / 32);
               constexpr int N_FIRST = I_IN + I_PL + 128, N_REST = I_IN + 2 * I_SQ + 2 * I_UP + 2 * I_DN + I_PL + 2 * I_SQ;
               constexpr int R_IN0 = 6200;
               constexpr int R_G1 = I_SQ + I_UP + I_SQ + I_IN + I_SQ + I_PL + I_SQ;
               constexpr int R_IN1 = R_G1 + I_UP;
               constexpr int R_SCAN = R_IN1 - 6200;
               constexpr int R_UP0 = R_IN1 + I_DN;
               static_assert(R_UP0 + I_DN == N_REST && R_SCAN > R_G1 && R_SCAN > R_IN0, "conversion ranges"); }
__device__ __forceinline__ void convert_first_item(ArgsP a, LAS float* scr, int r, int lane) {
    unsigned char* ws = a->ws;
    if (r < cv::I_IN) { p0_transpose_item(a->in[I_WINE], D, NPROJ, NPROJ_PAD, (bf16*)(ws + WS_WINE), scr, r, lane); return; } r -= cv::I_IN;
    if (r < cv::I_PL) { p0_transpose_item(a->in[I_WPLE], PLE, D, D, (bf16*)(ws + WS_WPLE), scr, r, lane); return; } r -= cv::I_PL;
    { const int mat = r / 64, blk = (r / 8) & 7; p0_transpose_item(a->in[mat == 0 ? I_LWR : I_LWI] + (size_t)blk * 16384, 128, 128, 128, (bf16*)(ws + WS_LRUW) + (size_t)(mat * 8 + blk) * 16384, scr, r % 8, lane); }
}
__device__ __forceinline__ TDesc decode_rest(ArgsP a, int r) {
    using namespace cv; unsigned char* ws = a->ws;
    if (r < I_SQ) return TDesc{a->in[I_WOUTE], (bf16*)(ws + WS_WOUTE), D, D, D, r}; r -= I_SQ;
    if (r < I_UP) return TDesc{a->in[I_WUP], (bf16*)(ws + WS_WUP), D, FF, FF, r}; r -= I_UP;
    if (r < I_SQ) return TDesc{a->in[I_WGATE], (bf16*)(ws + WS_WGATE), D, D, D, r}; r -= I_SQ;
    if (r < I_IN) return TDesc{a->in[I_WINO], (bf16*)(ws + WS_WINO), D, NPROJ, NPROJ_PAD, r}; r -= I_IN;
    if (r < I_SQ) return TDesc{a->in[I_WOUTO], (bf16*)(ws + WS_WOUTO), D, D, D, r}; r -= I_SQ;
    if (r < I_PL) return TDesc{a->in[I_WPLE] + (size_t)PLE * D, (bf16*)(ws + WS_WPLE) + (size_t)PLE * D, PLE, D, D, r}; r -= I_PL;
    if (r < I_SQ) return TDesc{a->in[I_WGATE] + (size_t)D * D, (bf16*)(ws + WS_WGATE) + (size_t)D * D, D, D, D, r}; r -= I_SQ;
    if (r < I_UP) return TDesc{a->in[I_WUP] + (size_t)D * FF, (bf16*)(ws + WS_WUP) + (size_t)D * FF, D, FF, FF, r}; r -= I_UP;
    if (r < I_DN) return TDesc{a->in[I_WDOWN], (bf16*)(ws + WS_WDOWN), FF, D, D, r}; r -= I_DN;
    return TDesc{a->in[I_WDOWN] + (size_t)D * FF, (bf16*)(ws + WS_WDOWN) + (size_t)D * FF, FF, D, D, r};
}
__device__ __forceinline__ void convert_range(ArgsP a, LAS float* scr, int first, int last, int widx, int nw, int lane) {
    int it = first + widx;
    TDesc dA, dB; f32x4 vA[8], vB[8];
    if (it < last) { dA = decode_rest(a, it); t_load(dA, lane, vA);
#pragma unroll 1
        for (;;) {
            const int itB = it + nw; const bool hasB = itB < last;
            if (hasB) { dB = decode_rest(a, itB); t_load(dB, lane, vB); }
            t_finish(dA, scr, lane, vA);
            if (!hasB) break;
            it = itB + nw; const bool hasA = it < last;
            if (hasA) { dA = decode_rest(a, it); t_load(dA, lane, vA); }
            t_finish(dB, scr, lane, vB);
            if (!hasA) break;
        } }
}
__device__ __forceinline__ void phase_convert(ArgsP a, LAS unsigned char* lds, int gw, int NGW, int wave, int lane) {
    unsigned char* ws = a->ws;
    LAS float* scr = (LAS float*)(lds + wave * 16384);
    for (int it = gw; it < cv::N_FIRST; it += NGW) convert_first_item(a, scr, it, lane);
    bf16* xb = (bf16*)(ws + WS_XB);
    for (int m = gw; m < M; m += NGW) {
        const float* src = m < MP ? a->in[I_XP] + (size_t)m * D : a->in[I_XS] + (size_t)(m - MP) * D;
        row_to_bf16<D>(src, xb + (size_t)m * D, lane);
    }
    bf16* pb = (bf16*)(ws + WS_PB);
    for (int r = gw; r < 2 * M; r += NGW) {
        const int l = r / M, m = r % M;
        const float* src = m < MP ? a->in[I_PP] + ((size_t)l * MP + m) * PLE : a->in[I_PS] + ((size_t)l * MS + (m - MP)) * PLE;
        row_to_bf16<PLE>(src, pb + (size_t)r * PLE, lane);
    }
}

__device__ __forceinline__ float conv_in(const bf16* proj, int row0, int tq, int ch, const float* cstate) {
    if (tq >= 0) return bf2f(proj[(size_t)(row0 + tq) * NPROJ_PAD + ch]);
    return cstate ? cstate[(3 + tq) * 4096 + ch] : 0.f;
}
__device__ __forceinline__ float conv4(const bf16* proj, int row0, int t, int ch, const float* cstate, const float* wconv, const float* bconv) {
    float acc = bconv[ch];
#pragma unroll
    for (int j = 0; j < 4; ++j) acc += wconv[j * 4096 + ch] * conv_in(proj, row0, t - 3 + j, ch, cstate);
    return acc;
}

__device__ __forceinline__ void delta_rec_item(ArgsP a, LAS unsigned char* lds, int row0, int T, int h, const float* cstate, const float* S0, float* Sout, const int tid) {
    const int lane = tid & 63, wave = tid >> 6, c = tid & 127, r = tid >> 7;
    const bf16* proj = (const bf16*)(a->ws + WS_PROJ); const float* gates = (const float*)(a->ws + WS_GATES); bf16* mix = (bf16*)(a->ws + WS_MIX);
    const float* wconv = a->in[I_WCONV]; const float* bconv = a->in[I_BCONV];
    LAS float* act = (LAS float*)lds;
    LAS float* nrm = act + 4 * 384;
    LAS float* gb = nrm + 8;
    LAS float* red = gb + 8;
    LAS float* red2 = red + 512;
    LAS float* obuf = red2 + 512;
    float s[32];
#pragma unroll
    for (int i = 0; i < 32; ++i) s[i] = S0 ? S0[(size_t)(32 * r + i) * 128 + c] : 0.f;
    const float aexp = fexp(a->in[I_ALOG][h]), dtb = a->in[I_DTB][h];
#pragma unroll 1
    for (int t0 = 0; t0 < T; t0 += 4) {
#pragma unroll
        for (int j = 0; j < 3; ++j) { const int idx = tid + 512 * j, tok = idx / 384, chl = idx % 384, part = chl >> 7, i = chl & 127;
            const int ch = part * 1024 + h * 128 + i;
            act[tok * 384 + chl] = siluf(conv4(proj, row0, t0 + tok, ch, cstate, wconv, bconv)); }
        __syncthreads();
        { const int tok = wave >> 1, part = wave & 1; const float x0 = act[tok * 384 + part * 128 + lane], x1 = act[tok * 384 + part * 128 + 64 + lane];
          const float ss = wave_sum(x0 * x0 + x1 * x1); if (lane == 0) nrm[tok * 2 + part] = rsqrtf(ss + 1e-6f) * (part == 0 ? 0.08838834764831845f : 1.f); }
        if (tid < 4) { const int row = row0 + t0 + tid; const float g = -aexp * softplusf(gates[(size_t)row * 16 + h] + dtb); gb[tid * 2] = fexp(g); gb[tid * 2 + 1] = sigm(gates[(size_t)row * 16 + 8 + h]); }
        __syncthreads();
#pragma unroll 1
        for (int tok = 0; tok < 4; ++tok) {
            const float eg = gb[tok * 2], beta = gb[tok * 2 + 1], nq = nrm[tok * 2], nk = nrm[tok * 2 + 1];
            const LAS float* qv = act + tok * 384 + 32 * r; const LAS float* kv = qv + 128;
            float ks = 0.f;
#pragma unroll
            for (int i = 0; i < 32; ++i) ks += kv[i] * s[i];
            red[r * 128 + c] = ks * nk;
            __syncthreads();
            const float kS = red[c] + red[128 + c] + red[256 + c] + red[384 + c];
            const float vnew = beta * (act[tok * 384 + 256 + c] - eg * kS);
            float os = 0.f;
#pragma unroll
            for (int i = 0; i < 32; ++i) { s[i] = eg * s[i] + (kv[i] * nk) * vnew; os += qv[i] * s[i]; }
            red2[r * 128 + c] = os * nq;
            __syncthreads();
            if (r == 0) obuf[tok * 128 + c] = red2[c] + red2[128 + c] + red2[256 + c] + red2[384 + c];
        }
        __syncthreads();
        if (wave < 4) { const int tok = wave, row = row0 + t0 + tok; const float o0 = obuf[tok * 128 + lane], o1 = obuf[tok * 128 + 64 + lane];
            const float rstd = rsqrtf(wave_sum(o0 * o0 + o1 * o1) * (1.f / 128.f) + RMS_EPS);
            const float* nw = a->in[I_DNORM];
            const float z0 = bf2f(proj[(size_t)row * NPROJ_PAD + 4096 + h * 128 + lane]), z1 = bf2f(proj[(size_t)row * NPROJ_PAD + 4096 + h * 128 + 64 + lane]);
            mix[(size_t)row * D + h * 128 + lane] = (bf16)f2bf(o0 * rstd * nw[lane] * siluf(z0));
            mix[(size_t)row * D + h * 128 + 64 + lane] = (bf16)f2bf(o1 * rstd * nw[64 + lane] * siluf(z1)); }
        __syncthreads();
    }
#pragma unroll
    for (int i = 0; i < 32; ++i) Sout[(size_t)(32 * r + i) * 128 + c] = s[i];
}

__device__ __forceinline__ void lru_rec_item(ArgsP a, LAS unsigned char* lds, int row0, int T, int n, const float* cstate, const float* h0, float* hout, const int tid) {
    const int d = tid & 127, part = tid >> 7;
    const bf16* proj = (const bf16*)(a->ws + WS_PROJ); bf16* mix = (bf16*)(a->ws + WS_MIX);
    const float* wconv = a->in[I_WCONV]; const float* bconv = a->in[I_BCONV];
    const float* wr = a->in[I_LWR] + (size_t)n * 16384; const float* wi = a->in[I_LWI] + (size_t)n * 16384;
    LAS float* xr = (LAS float*)lds;
    LAS float* red = xr + 512;
    const int chn = n * 128 + d;
    float hst = h0 ? h0[chn] : 0.f;
    const float br = a->in[I_LBR][chn], bi = a->in[I_LBI][chn], spl = softplusf(-a->in[I_LLAM][chn]);
#pragma unroll 1
    for (int t0 = 0; t0 < T; t0 += 4) {
        { const int tok = tid >> 7; xr[tok * 128 + d] = conv4(proj, row0, t0 + tok, 3072 + chn, cstate, wconv, bconv); }
        __syncthreads();
        float ar[4] = {0.f, 0.f, 0.f, 0.f}, ai[4] = {0.f, 0.f, 0.f, 0.f};
#pragma unroll 16
        for (int cc = 0; cc < 32; ++cc) { const int c = part * 32 + cc; const float w1 = wr[c * 128 + d], w2 = wi[c * 128 + d];
#pragma unroll
        for (int tok = 0; tok < 4; ++tok) { const float x = xr[tok * 128 + c]; ar[tok] += x * w1; ai[tok] += x * w2; } }
#pragma unroll
        for (int tok = 0; tok < 4; ++tok) { red[((tok * 2 + 0) * 4 + part) * 128 + d] = ar[tok]; red[((tok * 2 + 1) * 4 + part) * 128 + d] = ai[tok]; }
        __syncthreads();
        if (part == 0) {
    #pragma unroll 1
        for (int tok = 0; tok < 4; ++tok) {
                const int row = row0 + t0 + tok;
                float rp = br, ip = bi;
#pragma unroll
                for (int p = 0; p < 4; ++p) { rp += red[((tok * 2 + 0) * 4 + p) * 128 + d]; ip += red[((tok * 2 + 1) * 4 + p) * 128 + d]; }
                const float log_a = -8.f * sigm(rp) * spl;
                const float av = fexp(log_a);
                const float bx = sqrtf(neg_expm1(2.f * log_a)) * sigm(ip) * xr[tok * 128 + d];
                hst = av * hst + bx;
                const float gate = bf2f(proj[(size_t)row * NPROJ_PAD + 5120 + chn]);
                mix[(size_t)row * D + 1024 + chn] = (bf16)f2bf(hst * gelu_tanh(gate));
            }
        }
        __syncthreads();
    }
    if (part == 0) hout[chn] = hst;
}

__device__ __forceinline__ void mlstm_rec_item(ArgsP a, LAS unsigned char* lds, int row0, int T, int h, const float* C0, const float* n0, const float* m0, float* Cout, float* nout, float* mout, const int tid) {
    const int lane = tid & 63, wave = tid >> 6, v = tid & 255, kh = tid >> 8;
    const bf16* proj = (const bf16*)(a->ws + WS_PROJ); const float* gates = (const float*)(a->ws + WS_GATES); bf16* mix = (bf16*)(a->ws + WS_MIX);
    LAS float* qs = (LAS float*)lds;
    LAS float* ks = qs + 512;
    LAS float* vs = ks + 512;
    LAS float* gs = vs + 1024;
    LAS float* red = gs + 8;
    LAS float* dred = red + 1024;
    LAS float* hbuf = dred + 4;
    float cst[64];
#pragma unroll
    for (int i = 0; i < 64; ++i) cst[i] = C0 ? C0[(size_t)v * 128 + 64 * kh + i] : 0.f;
    float nst = (tid < 128) ? (n0 ? n0[tid] : 0.f) : 0.f;
    float mst = m0 ? m0[0] : 0.f;
    const float big = a->in[I_BIG][h], bfg = a->in[I_BFG][h];
#pragma unroll 1
    for (int t0 = 0; t0 < T; t0 += 4) {
#pragma unroll
        for (int j = 0; j < 4; ++j) { const int tok = j, row = row0 + t0 + tok; const bf16* pr = proj + (size_t)row * NPROJ_PAD;
            float val;
            if (tid < 128) val = bf2f(pr[h * 128 + tid]); else if (tid < 256) val = bf2f(pr[1024 + h * 128 + (tid - 128)]) * 0.08838834764831845f; else val = bf2f(pr[2048 + h * 256 + (tid - 256)]);
            if (tid < 128) qs[tok * 128 + tid] = val; else if (tid < 256) ks[tok * 128 + tid - 128] = val; else vs[tok * 256 + tid - 256] = val; }
        if (tid < 4) { const int row = row0 + t0 + tid; gs[tid * 2] = gates[(size_t)row * 16 + h] + big; gs[tid * 2 + 1] = gates[(size_t)row * 16 + 8 + h] + bfg; }
        __syncthreads();
#pragma unroll 1
        for (int tok = 0; tok < 4; ++tok) {
            const int par = tok & 1;
            const float ig = gs[tok * 2], lf = logsigf(gs[tok * 2 + 1]);
            const float mnew = fmaxf(lf + mst, ig), fp = fexp(lf + mst - mnew), ip = fexp(ig - mnew); mst = mnew;
            const float vv = vs[tok * 256 + v] * ip;
            const LAS float* kv = ks + tok * 128 + 64 * kh; const LAS float* qv = qs + tok * 128 + 64 * kh;
            float num = 0.f;
#pragma unroll
            for (int i = 0; i < 64; ++i) { cst[i] = fp * cst[i] + vv * kv[i]; num += cst[i] * qv[i]; }
            red[(par * 2 + kh) * 256 + v] = num;
            if (tid < 128) { nst = fp * nst + ip * ks[tok * 128 + tid]; const float dp = wave_sum(nst * qs[tok * 128 + tid]); if (lane == 0) dred[par * 2 + wave] = dp; }
            __syncthreads();
            if (kh == 0) { const float nm = red[(par * 2) * 256 + v] + red[(par * 2 + 1) * 256 + v]; const float den = dred[par * 2] + dred[par * 2 + 1];
                hbuf[tok * 256 + v] = nm / fmaxf(fabsf(den), fexp(-mnew)); }
        }
        __syncthreads();
        if (wave < 4) { const int tok = wave, row = row0 + t0 + tok; float hv[4]; float ss = 0.f;
#pragma unroll
            for (int j = 0; j < 4; ++j) { hv[j] = hbuf[tok * 256 + j * 64 + lane]; ss += hv[j] * hv[j]; }
            const float rstd = rsqrtf(wave_sum(ss) * (1.f / 256.f) + RMS_EPS);
            const float* nw = a->in[I_MNORM] + h * 256;
#pragma unroll
            for (int j = 0; j < 4; ++j) { const int vi = j * 64 + lane; const float op = bf2f(proj[(size_t)row * NPROJ_PAD + 4096 + h * 256 + vi]);
                mix[(size_t)row * D + h * 256 + vi] = (bf16)f2bf(hv[j] * rstd * nw[vi] * sigm(op)); } }
        __syncthreads();
    }
#pragma unroll
    for (int i = 0; i < 64; ++i) Cout[(size_t)v * 128 + 64 * kh + i] = cst[i];
    if (tid < 128) nout[tid] = nst;
    if (tid == 0) mout[0] = mst;
}


typedef short bf16x8 __attribute__((ext_vector_type(8)));
#define MFMA32(a_, b_, c_) __builtin_amdgcn_mfma_f32_16x16x32_bf16(a_, b_, c_, 0, 0, 0)

__device__ __forceinline__ void lru_prep_item(ArgsP a, LAS unsigned char* lds, int item, const int tid) {
    const int c = item & 31, n = (item >> 5) & 7, b = item >> 8;
    const int lane = tid & 63, w = __builtin_amdgcn_readfirstlane(tid >> 6), fr = lane & 15, fq = lane >> 4;
    unsigned char* ws = a->ws;
    const bf16* proj = (const bf16*)(ws + WS_PROJ);
    LAS bf16* xa = (LAS bf16*)lds;
    LAS float* xf = (LAS float*)(lds + 17408);
    LAS float* obH = (LAS float*)(lds + 51200);
    LAS float* obP = obH + 64 * 132;
    {
        const int t = tid >> 3, sub = tid & 7, ch0 = 3072 + n * 128 + sub * 16;
        const float* wconv = a->in[I_WCONV]; const float* bconv = a->in[I_BCONV];
        float x[16];
#pragma unroll
        for (int i = 0; i < 4; ++i) { const f32x4 bb = *(const f32x4*)(bconv + ch0 + 4 * i); x[4 * i] = bb.x; x[4 * i + 1] = bb.y; x[4 * i + 2] = bb.z; x[4 * i + 3] = bb.w; }
#pragma unroll
        for (int j = 0; j < 4; ++j) { const int tt = 64 * c + t - 3 + j;
            if (tt >= 0) { const bf16* pr = proj + (size_t)(b * TP + tt) * NPROJ_PAD + ch0; const v4u u0 = *(const v4u*)pr, u1 = *(const v4u*)(pr + 8);
                const unsigned uu[8] = {u0.x, u0.y, u0.z, u0.w, u1.x, u1.y, u1.z, u1.w};
#pragma unroll
                for (int i = 0; i < 4; ++i) { const f32x4 ww = *(const f32x4*)(wconv + j * 4096 + ch0 + 4 * i);
                    x[4 * i] += ww.x * bflo(uu[2 * i]); x[4 * i + 1] += ww.y * bfhi(uu[2 * i]); x[4 * i + 2] += ww.z * bflo(uu[2 * i + 1]); x[4 * i + 3] += ww.w * bfhi(uu[2 * i + 1]); } } }
        v4u o0, o1; o0.x = pk2(x[0], x[1]); o0.y = pk2(x[2], x[3]); o0.z = pk2(x[4], x[5]); o0.w = pk2(x[6], x[7]); o1.x = pk2(x[8], x[9]); o1.y = pk2(x[10], x[11]); o1.z = pk2(x[12], x[13]); o1.w = pk2(x[14], x[15]);
        *(LAS v4u*)(xa + t * 136 + sub * 16) = o0; *(LAS v4u*)(xa + t * 136 + sub * 16 + 8) = o1;
#pragma unroll
        for (int i = 0; i < 4; ++i) *(LAS f32x4*)(xf + t * 132 + sub * 16 + 4 * i) = (f32x4){x[4 * i], x[4 * i + 1], x[4 * i + 2], x[4 * i + 3]};
    }
    __syncthreads();
    const bf16* wrT = (const bf16*)(ws + WS_LRUW) + (size_t)n * 16384; const bf16* wiT = wrT + 8 * 16384;
    bf16x8 br[4], bi[4];
#pragma unroll
    for (int ks = 0; ks < 4; ++ks) { br[ks] = *(const bf16x8*)(wrT + (16 * w + fr) * 128 + 32 * ks + 8 * fq); bi[ks] = *(const bf16x8*)(wiT + (16 * w + fr) * 128 + 32 * ks + 8 * fq); }
    f32x4 accr[4], acci[4];
#pragma unroll
    for (int tb = 0; tb < 4; ++tb) { accr[tb] = (f32x4){0.f, 0.f, 0.f, 0.f}; acci[tb] = (f32x4){0.f, 0.f, 0.f, 0.f};
#pragma unroll
        for (int ks = 0; ks < 4; ++ks) { const bf16x8 af = *(const LAS bf16x8*)(xa + (16 * tb + fr) * 136 + 32 * ks + 8 * fq); accr[tb] = MFMA32(af, br[ks], accr[tb]); acci[tb] = MFMA32(af, bi[ks], acci[tb]); } }
    const int dl = 16 * w + fr, chn = n * 128 + dl;
    const float brs = a->in[I_LBR][chn], bis = a->in[I_LBI][chn], spl = softplusf(-a->in[I_LLAM][chn]);
    float Apre = 1.f, Hpre = 0.f;
#pragma unroll
    for (int tb = 0; tb < 4; ++tb) {
        float P[4], Hh[4];
#pragma unroll
        for (int j = 0; j < 4; ++j) { const int t = 16 * tb + 4 * fq + j;
            const float log_a = -8.f * sigm(accr[tb][j] + brs) * spl; const float av = fexp(log_a);
            const float bx = sqrtf(neg_expm1(2.f * log_a)) * sigm(acci[tb][j] + bis) * xf[t * 132 + dl];
            if (j == 0) { P[0] = av; Hh[0] = bx; } else { P[j] = P[j - 1] * av; Hh[j] = av * Hh[j - 1] + bx; } }
        float Ai = P[3], Hi = Hh[3];
        { const float A2 = __shfl_up(Ai, 16), H2 = __shfl_up(Hi, 16); if (fq >= 1) { Hi = Ai * H2 + Hi; Ai = A2 * Ai; } }
        { const float A2 = __shfl_up(Ai, 32), H2 = __shfl_up(Hi, 32); if (fq >= 2) { Hi = Ai * H2 + Hi; Ai = A2 * Ai; } }
        float Aex = __shfl_up(Ai, 16), Hex = __shfl_up(Hi, 16); if (fq == 0) { Aex = 1.f; Hex = 0.f; }
        const float Atb = __shfl(Ai, 48 + fr), Htb = __shfl(Hi, 48 + fr);
        const float EA = Apre * Aex, EH = Aex * Hpre + Hex;
#pragma unroll
        for (int j = 0; j < 4; ++j) { const int t = 16 * tb + 4 * fq + j; obP[t * 132 + dl] = EA * P[j]; obH[t * 132 + dl] = P[j] * EH + Hh[j]; }
        Hpre = Atb * Hpre + Htb; Apre = Apre * Atb;
    }
    if (fq == 0) { float* e = (float*)(ws + WS_LRU_END) + (size_t)item * 256; e[dl] = Apre; e[128 + dl] = Hpre; }
    __syncthreads();
    {
        const int t = tid >> 3, sub = tid & 7;
        bf16* hl = (bf16*)(ws + WS_LRU_HL) + ((size_t)item * 64 + t) * 128 + sub * 16; bf16* pp = (bf16*)(ws + WS_LRU_P) + ((size_t)item * 64 + t) * 128 + sub * 16;
        const LAS float* sh = obH + t * 132 + sub * 16; const LAS float* sp = obP + t * 132 + sub * 16;
        v4u o0, o1;
        o0.x = pk2(sh[0], sh[1]); o0.y = pk2(sh[2], sh[3]); o0.z = pk2(sh[4], sh[5]); o0.w = pk2(sh[6], sh[7]); o1.x = pk2(sh[8], sh[9]); o1.y = pk2(sh[10], sh[11]); o1.z = pk2(sh[12], sh[13]); o1.w = pk2(sh[14], sh[15]);
        *(v4u*)hl = o0; *(v4u*)(hl + 8) = o1;
        o0.x = pk2(sp[0], sp[1]); o0.y = pk2(sp[2], sp[3]); o0.z = pk2(sp[4], sp[5]); o0.w = pk2(sp[6], sp[7]); o1.x = pk2(sp[8], sp[9]); o1.y = pk2(sp[10], sp[11]); o1.z = pk2(sp[12], sp[13]); o1.w = pk2(sp[14], sp[15]);
        *(v4u*)pp = o0; *(v4u*)(pp + 8) = o1;
    }
    __syncthreads();
}
__device__ __forceinline__ void lru_out_item(ArgsP a, LAS unsigned char* lds, int item, const int tid) {
    const int c = item & 31, n = (item >> 5) & 7, b = item >> 8;
    unsigned char* ws = a->ws;
    LAS float* carry = (LAS float*)lds;
    if (tid < 128) { float cr = 0.f; const float* e = (const float*)(ws + WS_LRU_END) + (size_t)(item - c) * 256;
        float pv[31], hv_[31];
#pragma unroll
        for (int k = 0; k < 31; ++k) { const bool on = k < c; pv[k] = on ? e[k * 256 + tid] : 1.f; hv_[k] = on ? e[k * 256 + 128 + tid] : 0.f; }
#pragma unroll
        for (int k = 0; k < 31; ++k) cr = hv_[k] + pv[k] * cr;
        carry[tid] = cr; }
    __syncthreads();
    const int t = tid >> 3, sub = tid & 7, d0 = sub * 16, row = b * TP + 64 * c + t;
    const bf16* hl = (const bf16*)(ws + WS_LRU_HL) + ((size_t)item * 64 + t) * 128 + d0; const bf16* pp = (const bf16*)(ws + WS_LRU_P) + ((size_t)item * 64 + t) * 128 + d0;
    const bf16* gp = (const bf16*)(ws + WS_PROJ) + (size_t)row * NPROJ_PAD + 5120 + n * 128 + d0;
    const v4u h0 = *(const v4u*)hl, h1 = *(const v4u*)(hl + 8), p0 = *(const v4u*)pp, p1 = *(const v4u*)(pp + 8), g0 = *(const v4u*)gp, g1 = *(const v4u*)(gp + 8);
    const unsigned hu[8] = {h0.x, h0.y, h0.z, h0.w, h1.x, h1.y, h1.z, h1.w}, pu[8] = {p0.x, p0.y, p0.z, p0.w, p1.x, p1.y, p1.z, p1.w}, gu[8] = {g0.x, g0.y, g0.z, g0.w, g1.x, g1.y, g1.z, g1.w};
    float hv[16]; unsigned ou[8];
#pragma unroll
    for (int i = 0; i < 8; ++i) { hv[2 * i] = bflo(hu[i]) + bflo(pu[i]) * carry[d0 + 2 * i]; hv[2 * i + 1] = bfhi(hu[i]) + bfhi(pu[i]) * carry[d0 + 2 * i + 1];
        ou[i] = pk2(hv[2 * i] * gelu_tanh(bflo(gu[i])), hv[2 * i + 1] * gelu_tanh(bfhi(gu[i]))); }
    bf16* mp = (bf16*)(ws + WS_MIX) + (size_t)row * D + 1024 + n * 128 + d0;
    *(v4u*)mp = (v4u){ou[0], ou[1], ou[2], ou[3]}; *(v4u*)(mp + 8) = (v4u){ou[4], ou[5], ou[6], ou[7]};
    if (c == 31 && t == 63) { float* o = a->out + O_LRUP + (size_t)b * 1024 + n * 128 + d0;
#pragma unroll
        for (int i = 0; i < 4; ++i) *(f32x4*)(o + 4 * i) = (f32x4){hv[4 * i], hv[4 * i + 1], hv[4 * i + 2], hv[4 * i + 3]}; }
    __syncthreads();
}


__device__ __forceinline__ void conv16_load(const bf16* proj, int b, int tseq, int ch0, v4u (&u)[8]) {
#pragma unroll
    for (int j = 0; j < 4; ++j) { const int tt = tseq - 3 + j;
        if (tt >= 0) { const bf16* pr = proj + (size_t)(b * TP + tt) * NPROJ_PAD + ch0; u[2 * j] = *(const v4u*)pr; u[2 * j + 1] = *(const v4u*)(pr + 8); }
        else { u[2 * j] = (v4u){0u, 0u, 0u, 0u}; u[2 * j + 1] = (v4u){0u, 0u, 0u, 0u}; } }
}
__device__ __forceinline__ void conv16_compute(const v4u (&u)[8], const float* wconv, const float* bconv, int ch0, float (&x)[16]) {
#pragma unroll
    for (int i = 0; i < 4; ++i) { const f32x4 bb = *(const f32x4*)(bconv + ch0 + 4 * i); x[4 * i] = bb.x; x[4 * i + 1] = bb.y; x[4 * i + 2] = bb.z; x[4 * i + 3] = bb.w; }
#pragma unroll
    for (int j = 0; j < 4; ++j) { const unsigned uu[8] = {u[2 * j].x, u[2 * j].y, u[2 * j].z, u[2 * j].w, u[2 * j + 1].x, u[2 * j + 1].y, u[2 * j + 1].z, u[2 * j + 1].w};
#pragma unroll
        for (int i = 0; i < 4; ++i) { const f32x4 ww = *(const f32x4*)(wconv + j * 4096 + ch0 + 4 * i);
            x[4 * i] += ww.x * bflo(uu[2 * i]); x[4 * i + 1] += ww.y * bfhi(uu[2 * i]); x[4 * i + 2] += ww.z * bflo(uu[2 * i + 1]); x[4 * i + 3] += ww.w * bfhi(uu[2 * i + 1]); } }
}
__device__ __forceinline__ void conv16_compute_lds(const v4u (&u)[8], const LAS float* cw, int c0, float (&x)[16]) {
#pragma unroll
    for (int i = 0; i < 4; ++i) { const f32x4 bb = *(const LAS f32x4*)(cw + 4 * 128 + c0 + 4 * i); x[4 * i] = bb.x; x[4 * i + 1] = bb.y; x[4 * i + 2] = bb.z; x[4 * i + 3] = bb.w; }
#pragma unroll
    for (int j = 0; j < 4; ++j) { const unsigned uu[8] = {u[2 * j].x, u[2 * j].y, u[2 * j].z, u[2 * j].w, u[2 * j + 1].x, u[2 * j + 1].y, u[2 * j + 1].z, u[2 * j + 1].w};
#pragma unroll
        for (int i = 0; i < 4; ++i) { const f32x4 ww = *(const LAS f32x4*)(cw + j * 128 + c0 + 4 * i);
            x[4 * i] += ww.x * bflo(uu[2 * i]); x[4 * i + 1] += ww.y * bfhi(uu[2 * i]); x[4 * i + 2] += ww.z * bflo(uu[2 * i + 1]); x[4 * i + 3] += ww.w * bfhi(uu[2 * i + 1]); } }
}
__device__ __forceinline__ void conv16_prompt(const bf16* proj, const float* wconv, const float* bconv, int b, int tseq, int ch0, float (&x)[16]) {
    v4u u[8]; conv16_load(proj, b, tseq, ch0, u); conv16_compute(u, wconv, bconv, ch0, x);
}
__device__ __forceinline__ void st16_bf16(LAS bf16* p, const float (&x)[16]) {
    v4u o0, o1; o0.x = pk2(x[0], x[1]); o0.y = pk2(x[2], x[3]); o0.z = pk2(x[4], x[5]); o0.w = pk2(x[6], x[7]); o1.x = pk2(x[8], x[9]); o1.y = pk2(x[10], x[11]); o1.z = pk2(x[12], x[13]); o1.w = pk2(x[14], x[15]);
    *(LAS v4u*)p = o0; *(LAS v4u*)(p + 8) = o1;
}
__device__ __forceinline__ v2u pack4(const f32x4 v) { v2u o; o.x = pk2(v.x, v.y); o.y = pk2(v.z, v.w); return o; }
__device__ __forceinline__ bf16x8 zero8() { return (bf16x8){0, 0, 0, 0, 0, 0, 0, 0}; }

__device__ __forceinline__ void delta_prep_item(ArgsP a, LAS unsigned char* lds, int item, const int tid) {
    const int c = item & 31, h = (item >> 5) & 7, b = item >> 8;
    const int lane = tid & 63, w = __builtin_amdgcn_readfirstlane(tid >> 6), fr = lane & 15, fq = lane >> 4;
    unsigned char* ws = a->ws;
    const bf16* proj = (const bf16*)(ws + WS_PROJ);
    LAS bf16* Kn = (LAS bf16*)lds;
    LAS bf16* Qn = (LAS bf16*)(lds + 17408);
    LAS bf16* KdT = (LAS bf16*)(lds + 34816);
    LAS bf16* RX = (LAS bf16*)(lds + 53248);
    LAS bf16* Mm = (LAS bf16*)(lds + 90112);
    LAS bf16* QKd = (LAS bf16*)(lds + 99328);
    LAS bf16* Td = (LAS bf16*)(lds + 108544);
    LAS bf16* RT = (LAS bf16*)(lds + 111616) + w * 768;
    LAS float* gl = (LAS float*)(lds + 123904);
    LAS float* gcs = gl + 64;
    LAS float* bet = gcs + 64;
    const int t = tid >> 3, sub = tid & 7;
    {
        if (sub == 0) { const float* gt = (const float*)(ws + WS_GATES) + (size_t)(b * TP + 64 * c + t) * 16;
            gl[t] = -fexp(a->in[I_ALOG][h]) * softplusf(gt[h] + a->in[I_DTB][h]); bet[t] = sigm(gt[8 + h]); }
        __syncthreads();
        if (w == 0) { float v = gl[lane];
#pragma unroll
            for (int o = 1; o < 64; o <<= 1) { const float u = __shfl_up(v, o); if (lane >= o) v += u; }
            gcs[lane] = v; }
        __syncthreads();
    }
    {
        const float* wconv = a->in[I_WCONV]; const float* bconv = a->in[I_BCONV];
        const float gc = gcs[t], glast = gcs[63], beta = bet[t];
        const float ec = fexp(gc), ed = fexp(glast - gc);
        float x[16], y[16];
        conv16_prompt(proj, wconv, bconv, b, 64 * c + t, 1024 + h * 128 + sub * 16, x);
        float ss = 0.f;
#pragma unroll
        for (int i = 0; i < 16; ++i) { x[i] = siluf(x[i]); ss += x[i] * x[i]; }
        ss += __shfl_xor(ss, 1); ss += __shfl_xor(ss, 2); ss += __shfl_xor(ss, 4);
        const float rk = rsqrtf(ss + 1e-6f);
#pragma unroll
        for (int i = 0; i < 16; ++i) x[i] *= rk;
        st16_bf16(Kn + t * 136 + sub * 16, x);
#pragma unroll
        for (int i = 0; i < 16; ++i) KdT[(sub * 16 + i) * 72 + t] = (bf16)f2bf(x[i] * ed);
#pragma unroll
        for (int i = 0; i < 16; ++i) y[i] = x[i] * (beta * ec);
        st16_bf16(RX + t * 264 + 128 + sub * 16, y);
        conv16_prompt(proj, wconv, bconv, b, 64 * c + t, h * 128 + sub * 16, x);
        ss = 0.f;
#pragma unroll
        for (int i = 0; i < 16; ++i) { x[i] = siluf(x[i]); ss += x[i] * x[i]; }
        ss += __shfl_xor(ss, 1); ss += __shfl_xor(ss, 2); ss += __shfl_xor(ss, 4);
        const float rq = rsqrtf(ss + 1e-6f) * 0.08838834764831845f;
#pragma unroll
        for (int i = 0; i < 16; ++i) x[i] *= rq;
        st16_bf16(Qn + t * 136 + sub * 16, x);
        conv16_prompt(proj, wconv, bconv, b, 64 * c + t, 2048 + h * 128 + sub * 16, x);
#pragma unroll
        for (int i = 0; i < 16; ++i) x[i] = siluf(x[i]) * beta;
        st16_bf16(RX + t * 264 + sub * 16, x);
    }
    __syncthreads();
    {
        const int ib = w >> 1;
#pragma unroll
        for (int jj = 0; jj < 2; ++jj) { const int jb = 2 * (w & 1) + jj;
            f32x4 ak = (f32x4){0.f, 0.f, 0.f, 0.f}, aq = (f32x4){0.f, 0.f, 0.f, 0.f};
            if (jb <= ib) {
#pragma unroll
                for (int ks = 0; ks < 4; ++ks) { const bf16x8 bfr = *(const LAS bf16x8*)(Kn + (16 * jb + fr) * 136 + 32 * ks + 8 * fq);
                    const bf16x8 afk = *(const LAS bf16x8*)(Kn + (16 * ib + fr) * 136 + 32 * ks + 8 * fq), afq = *(const LAS bf16x8*)(Qn + (16 * ib + fr) * 136 + 32 * ks + 8 * fq);
                    ak = MFMA32(afk, bfr, ak); aq = MFMA32(afq, bfr, aq); } }
            const int col = 16 * jb + fr; const float gcc = gcs[col];
#pragma unroll
            for (int j = 0; j < 4; ++j) { const int row = 16 * ib + 4 * fq + j; const float dec = (row >= col) ? fexp(gcs[row] - gcc) : 0.f;
                Mm[row * 72 + col] = (bf16)f2bf(row > col ? -bet[row] * ak[j] * dec : 0.f);
                QKd[row * 72 + col] = (bf16)f2bf(aq[j] * dec); }
        }
    }
    __syncthreads();
    if (w == 0) { const int blk = lane >> 4, col = lane & 15; float xi[16];
#pragma unroll
        for (int i = 0; i < 16; ++i) { float acc = (i == col) ? 1.f : 0.f; const LAS bf16* mr = Mm + (16 * blk + i) * 72 + 16 * blk;
#pragma unroll
            for (int j = 0; j < i; ++j) acc += bf2f(mr[j]) * xi[j];
            xi[i] = acc; }
#pragma unroll
        for (int i = 0; i < 16; ++i) Td[(blk * 16 + i) * 24 + col] = (bf16)f2bf(xi[i]); }
    f32x4 rhs[2][4];
#pragma unroll
    for (int cbl = 0; cbl < 2; ++cbl)
#pragma unroll
        for (int bb = 0; bb < 4; ++bb)
#pragma unroll
            for (int j = 0; j < 4; ++j) rhs[cbl][bb][j] = bf2f(RX[(16 * bb + 4 * fq + j) * 264 + 32 * w + 16 * cbl + fr]);
    __syncthreads();
#pragma unroll
    for (int cbl = 0; cbl < 2; ++cbl) { const int cb = 2 * w + cbl;
#pragma unroll
        for (int bb = 0; bb < 4; ++bb) {
            f32x4 acc = rhs[cbl][bb];
#pragma unroll
            for (int ks = 0; ks < 2; ++ks) { if (32 * ks < 16 * bb) { const bool ok = (32 * ks + 8 * fq) < 16 * bb;
                const bf16x8 af = ok ? *(const LAS bf16x8*)(Mm + (16 * bb + fr) * 72 + 32 * ks + 8 * fq) : zero8();
                const bf16x8 bf_ = ok ? *(const LAS bf16x8*)(RX + (16 * cb + fr) * 72 + 32 * ks + 8 * fq) : zero8();
                acc = MFMA32(af, bf_, acc); } }
            *(LAS v2u*)(RT + (16 * cbl + fr) * 24 + 4 * fq) = pack4(acc);
            asm volatile("s_waitcnt lgkmcnt(0)" ::: "memory");
            const bool ok2 = fq < 2;
            const bf16x8 af2 = ok2 ? *(const LAS bf16x8*)(Td + (bb * 16 + fr) * 24 + 8 * fq) : zero8();
            const bf16x8 bf2 = ok2 ? *(const LAS bf16x8*)(RT + (16 * cbl + fr) * 24 + 8 * fq) : zero8();
            const f32x4 xb4 = MFMA32(af2, bf2, ((f32x4){0.f, 0.f, 0.f, 0.f}));
            *(LAS v2u*)(RX + (16 * cb + fr) * 72 + 16 * bb + 4 * fq) = pack4(xb4);
            asm volatile("s_waitcnt lgkmcnt(0)" ::: "memory");
        }
    }
    __syncthreads();
    {
        v4u* gout = (v4u*)(ws + WS_DG) + ((size_t)item * 8 + w) * 4 * 64 + lane;
        bf16x8 kb[2];
#pragma unroll
        for (int kt = 0; kt < 2; ++kt) kb[kt] = *(const LAS bf16x8*)(KdT + (16 * w + fr) * 72 + 32 * kt + 8 * fq);
#pragma unroll
        for (int ks = 0; ks < 4; ++ks) { f32x4 g0 = (f32x4){0.f, 0.f, 0.f, 0.f}, g1 = (f32x4){0.f, 0.f, 0.f, 0.f};
#pragma unroll
            for (int kt = 0; kt < 2; ++kt) { const bf16x8 a0 = *(const LAS bf16x8*)(RX + (128 + 32 * ks + fr) * 72 + 32 * kt + 8 * fq), a1 = *(const LAS bf16x8*)(RX + (128 + 32 * ks + 16 + fr) * 72 + 32 * kt + 8 * fq);
                g0 = MFMA32(a0, kb[kt], g0); g1 = MFMA32(a1, kb[kt], g1); }
            const v2u p0 = pack4(-g0), p1 = pack4(-g1); gout[ks * 64] = (v4u){p0.x, p0.y, p1.x, p1.y}; }
        v2u* bout = (v2u*)(ws + WS_DB) + ((size_t)item * 64 + w) * 64 + lane;
#pragma unroll
        for (int s2 = 0; s2 < 8; ++s2) { f32x4 bc = (f32x4){0.f, 0.f, 0.f, 0.f};
#pragma unroll
            for (int kt = 0; kt < 2; ++kt) { const bf16x8 ub = *(const LAS bf16x8*)(RX + (16 * s2 + fr) * 72 + 32 * kt + 8 * fq); bc = MFMA32(kb[kt], ub, bc); }
            bout[(size_t)s2 * 8 * 64] = pack4(bc); }
    }
    {
        const int tb = w >> 1, half = w & 1; const float ect = fexp(gcs[16 * tb + fr]);
        bf16x8 qk[2];
#pragma unroll
        for (int kt = 0; kt < 2; ++kt) qk[kt] = *(const LAS bf16x8*)(QKd + (16 * tb + fr) * 72 + 32 * kt + 8 * fq);
        v4u* qout = (v4u*)(ws + WS_DQ) + ((size_t)item * 4 + tb) * 4 * 64 + lane;
#pragma unroll
        for (int kk = 0; kk < 2; ++kk) { const int ks = 2 * half + kk; v2u pk[2];
#pragma unroll
            for (int hf = 0; hf < 2; ++hf) { const int db = 2 * ks + hf; f32x4 acc = (f32x4){0.f, 0.f, 0.f, 0.f};
#pragma unroll
                for (int kt = 0; kt < 2; ++kt) { const bf16x8 wa = *(const LAS bf16x8*)(RX + (128 + 16 * db + fr) * 72 + 32 * kt + 8 * fq); acc = MFMA32(wa, qk[kt], acc); }
                const v2u qn4 = *(const LAS v2u*)(Qn + (16 * tb + fr) * 136 + 16 * db + 4 * fq);
                f32x4 qp; qp.x = bflo(qn4.x) * ect - acc.x; qp.y = bfhi(qn4.x) * ect - acc.y; qp.z = bflo(qn4.y) * ect - acc.z; qp.w = bfhi(qn4.y) * ect - acc.w;
                pk[hf] = pack4(qp); }
            qout[ks * 64] = (v4u){pk[0].x, pk[0].y, pk[1].x, pk[1].y}; }
        v2u* oout = (v2u*)(ws + WS_DO) + ((size_t)item * 4 + tb) * 8 * 64 + lane;
#pragma unroll
        for (int ss = 0; ss < 4; ++ss) { const int s2 = 4 * half + ss; f32x4 acc = (f32x4){0.f, 0.f, 0.f, 0.f};
#pragma unroll
            for (int kt = 0; kt < 2; ++kt) { const bf16x8 ua = *(const LAS bf16x8*)(RX + (16 * s2 + fr) * 72 + 32 * kt + 8 * fq); acc = MFMA32(ua, qk[kt], acc); }
            oout[s2 * 64] = pack4(acc); }
    }
    if (tid == 0) ((float*)(ws + WS_DD))[item] = fexp(gcs[63]);
    __syncthreads();
}

__device__ __forceinline__ void delta_scan_wave(ArgsP a, int chain, int s, const int lane) {
    unsigned char* ws = a->ws;
    const int fr = lane & 15, fq = lane >> 4;
    f32x4 S[8]; bf16x8 Sb[4];
#pragma unroll
    for (int i = 0; i < 8; ++i) S[i] = (f32x4){0.f, 0.f, 0.f, 0.f};
#pragma unroll
    for (int i = 0; i < 4; ++i) Sb[i] = zero8();
    const bf16x8* gbase = (const bf16x8*)(ws + WS_DG) + (size_t)chain * 32 * 2048 + lane;
    bf16x8 G[8][4];
#pragma unroll
    for (int rb = 0; rb < 8; ++rb)
#pragma unroll
        for (int ks = 0; ks < 4; ++ks) G[rb][ks] = gbase[(rb * 4 + ks) * 64];
#pragma unroll 1
    for (int c = 0; c < 32; ++c) {
        const int item = chain * 32 + c;
        const float d = ((const float*)(ws + WS_DD))[item];
        bf16x8* sout = (bf16x8*)(ws + WS_DS) + ((size_t)item * 8 + s) * 4 * 64 + lane;
#pragma unroll
        for (int ks = 0; ks < 4; ++ks) sout[ks * 64] = Sb[ks];
        const v2u* bin = (const v2u*)(ws + WS_DB) + ((size_t)item * 8 + s) * 8 * 64 + lane;
#pragma unroll
        for (int rb = 0; rb < 8; ++rb) { const v2u bc = bin[rb * 64]; S[rb].x = d * S[rb].x + bflo(bc.x); S[rb].y = d * S[rb].y + bfhi(bc.x); S[rb].z = d * S[rb].z + bflo(bc.y); S[rb].w = d * S[rb].w + bfhi(bc.y); }
        const bf16x8* gnext = gbase + (size_t)(c + 1 < 32 ? c + 1 : c) * 2048;
#pragma unroll
        for (int rb = 0; rb < 8; ++rb) {
#pragma unroll
            for (int ks = 0; ks < 4; ++ks) S[rb] = MFMA32(G[rb][ks], Sb[ks], S[rb]);
#pragma unroll
            for (int ks = 0; ks < 4; ++ks) G[rb][ks] = gnext[(rb * 4 + ks) * 64];
        }
#pragma unroll
        for (int ks = 0; ks < 4; ++ks) { const v2u lo = pack4(S[2 * ks]), hi = pack4(S[2 * ks + 1]); const v4u u = (v4u){lo.x, lo.y, hi.x, hi.y}; Sb[ks] = __builtin_bit_cast(bf16x8, u); }
    }
    f32x4* so = (f32x4*)(ws + WS_DF) + ((size_t)(chain * 8 + s) * 8) * 64 + lane;
#pragma unroll
    for (int rb = 0; rb < 8; ++rb) so[rb * 64] = S[rb];
}

__device__ __forceinline__ void delta_out_wave(ArgsP a, int item, int tb, const int lane) {
    unsigned char* ws = a->ws;
    const int c = item & 31, h = (item >> 5) & 7, b = item >> 8, fr = lane & 15, fq = lane >> 4;
    bf16x8 qf[4];
    const bf16x8* qin = (const bf16x8*)(ws + WS_DQ) + ((size_t)item * 4 + tb) * 4 * 64 + lane;
#pragma unroll
    for (int ks = 0; ks < 4; ++ks) qf[ks] = qin[ks * 64];
    const v2u* oin = (const v2u*)(ws + WS_DO) + ((size_t)item * 4 + tb) * 8 * 64 + lane;
    const bf16x8* sin = (const bf16x8*)(ws + WS_DS) + (size_t)item * 8 * 4 * 64 + lane;
    f32x4 o[8]; float ss = 0.f;
    v2u olv[8]; bf16x8 sfr[4][4];
#pragma unroll
    for (int s = 0; s < 8; ++s) olv[s] = oin[s * 64];
#pragma unroll
    for (int s = 0; s < 4; ++s)
#pragma unroll
        for (int ks = 0; ks < 4; ++ks) sfr[s][ks] = sin[(s * 4 + ks) * 64];
    const int row_ = b * TP + 64 * c + 16 * tb + fr;
    v2u zv[8];
#pragma unroll
    for (int s = 0; s < 8; ++s) zv[s] = *(const v2u*)((const bf16*)(ws + WS_PROJ) + (size_t)row_ * NPROJ_PAD + 4096 + h * 128 + 4 * fq + 16 * s);
#pragma unroll
    for (int grp = 0; grp < 2; ++grp) {
#pragma unroll
        for (int s4 = 0; s4 < 4; ++s4) { const int s = 4 * grp + s4; const v2u ol = olv[s]; o[s] = (f32x4){bflo(ol.x), bfhi(ol.x), bflo(ol.y), bfhi(ol.y)};
#pragma unroll
            for (int ks = 0; ks < 4; ++ks) o[s] = MFMA32(sfr[s4][ks], qf[ks], o[s]);
            ss += (o[s].x * o[s].x + o[s].y * o[s].y) + (o[s].z * o[s].z + o[s].w * o[s].w); }
        if (grp == 0) {
#pragma unroll
            for (int s4 = 0; s4 < 4; ++s4)
#pragma unroll
                for (int ks = 0; ks < 4; ++ks) sfr[s4][ks] = sin[((4 + s4) * 4 + ks) * 64]; }
    }
    ss += __shfl_xor(ss, 16); ss += __shfl_xor(ss, 32);
    const float rstd = rsqrtf(ss * (1.f / 128.f) + RMS_EPS);
    const int row = b * TP + 64 * c + 16 * tb + fr;
    const bf16* zp = (const bf16*)(ws + WS_PROJ) + (size_t)row * NPROJ_PAD + 4096 + h * 128 + 4 * fq;
    bf16* mp = (bf16*)(ws + WS_MIX) + (size_t)row * D + h * 128 + 4 * fq;
    const float* nw = a->in[I_DNORM] + 4 * fq;
#pragma unroll
    for (int s = 0; s < 8; ++s) { const v2u z = zv[s]; const f32x4 n4 = *(const f32x4*)(nw + 16 * s);
        f32x4 y; y.x = o[s].x * rstd * n4.x * siluf(bflo(z.x)); y.y = o[s].y * rstd * n4.y * siluf(bfhi(z.x)); y.z = o[s].z * rstd * n4.z * siluf(bflo(z.y)); y.w = o[s].w * rstd * n4.w * siluf(bfhi(z.y));
        *(v2u*)(mp + 16 * s) = pack4(y); }
}


__device__ __forceinline__ float wave_incl_sum(float v, int lane) {
#pragma unroll
    for (int o = 1; o < 64; o <<= 1) { const float u = __shfl_up(v, o); if (lane >= o) v += u; }
    return v;
}
__device__ __forceinline__ float wave_incl_max(float v, int lane) {
#pragma unroll
    for (int o = 1; o < 64; o <<= 1) { const float u = __shfl_up(v, o); if (lane >= o) v = fmaxf(v, u); }
    return v;
}
__device__ __forceinline__ float wave_max(float v) {
#pragma unroll
    for (int o = 1; o < 64; o <<= 1) v = fmaxf(v, __shfl_xor(v, o));
    return v;
}
__device__ __forceinline__ void mlstm_scan_item(ArgsP a, LAS unsigned char* lds, int chain, int vs, const int tid) {
    const int lane = tid & 63, w = __builtin_amdgcn_readfirstlane(tid >> 6), fr = lane & 15, fq = lane >> 4;
    const int b = chain >> 3, h = chain & 7, row0 = b * TP;
    unsigned char* ws = a->ws;
    const bf16* proj = (const bf16*)(ws + WS_PROJ); const float* gates = (const float*)(ws + WS_GATES);
    LAS bf16* KT = (LAS bf16*)lds;
    LAS bf16* VT = (LAS bf16*)(lds + 36864);
    LAS float* wls = (LAS float*)(lds + 46080);
    const float big = a->in[I_BIG][h], bfg = a->in[I_BFG][h];
    const bf16* kptr = proj + (size_t)(row0 + lane) * NPROJ_PAD + 1024 + h * 128 + 16 * w;
    const bf16* vptr = proj + (size_t)(row0 + lane) * NPROJ_PAD + 2048 + h * 256 + 32 * vs + 8 * (w & 3);
    const float* gptr = gates + (size_t)(row0 + lane) * 16 + h;
    f32x4 acc[2]; acc[0] = (f32x4){0.f, 0.f, 0.f, 0.f}; acc[1] = acc[0];
    float nst = 0.f, m = 0.f;
    v4u kq[2][2], vq[2]; float gi[2], gf[2];
#define ML_LOAD(set, c_) do { const size_t ro = (size_t)(c_) * 64 * NPROJ_PAD; kq[set][0] = *(const v4u*)(kptr + ro); kq[set][1] = *(const v4u*)(kptr + ro + 8); \
        if (w < 4) vq[set] = *(const v4u*)(vptr + ro); gi[set] = gptr[(size_t)(c_) * 64 * 16]; gf[set] = gptr[(size_t)(c_) * 64 * 16 + 8]; } while (0)
#define ML_STEP(set, c_) do { const int item = chain * 32 + (c_); \
        const float ig = gi[set] + big, lf = logsigf(gf[set] + bfg); \
        const float bcum = wave_incl_sum(lf, lane), blast = __shfl(bcum, 63), gend = blast - bcum + ig; \
        const float mnew = fmaxf(blast + m, wave_max(gend)), sc = fexp(blast + m - mnew), wv = fexp(gend - mnew) * 0.08838834764831845f; \
        LAS bf16* kt = KT + (set) * 9216; LAS bf16* vt = VT + (set) * 2304; \
        _Pragma("unroll") for (int i = 0; i < 2; ++i) { const unsigned uu[4] = {kq[set][i].x, kq[set][i].y, kq[set][i].z, kq[set][i].w}; const int kr = 8 * (2 * w + i); \
            _Pragma("unroll") for (int e = 0; e < 4; ++e) { kt[(kr + 2 * e) * 72 + lane] = (bf16)(uu[e] & 0xffffu); kt[(kr + 2 * e + 1) * 72 + lane] = (bf16)(uu[e] >> 16); } } \
        if (w < 4) { const unsigned uu[4] = {vq[set].x, vq[set].y, vq[set].z, vq[set].w}; \
            _Pragma("unroll") for (int e = 0; e < 4; ++e) { vt[(8 * w + 2 * e) * 72 + lane] = (bf16)f2bf(bflo(uu[e]) * wv); vt[(8 * w + 2 * e + 1) * 72 + lane] = (bf16)f2bf(bfhi(uu[e]) * wv); } } \
        if (w == 0) wls[(set) * 64 + lane] = wv; \
        if ((c_) + 2 < 32) ML_LOAD(set, (c_) + 2); \
        if (vs == 0 && tid == 0) ((float*)(ws + WS_MM))[item] = m; \
        __syncthreads(); \
        _Pragma("unroll") for (int vb = 0; vb < 2; ++vb) { *(v2u*)((bf16*)(ws + WS_MC) + ((size_t)item * 256 + 32 * vs + 16 * vb + fr) * 128 + 16 * w + 4 * fq) = pack4(acc[vb]); } \
        if (vs == 0 && tid < 128) { ((float*)(ws + WS_MN))[(size_t)item * 128 + tid] = nst; float sn = 0.f; \
            _Pragma("unroll") for (int s8 = 0; s8 < 8; ++s8) { const v4u kk = *(const LAS v4u*)(kt + tid * 72 + 8 * s8); const LAS float* wl = wls + (set) * 64 + 8 * s8; \
                sn += bflo(kk.x) * wl[0] + bfhi(kk.x) * wl[1] + bflo(kk.y) * wl[2] + bfhi(kk.y) * wl[3] + bflo(kk.z) * wl[4] + bfhi(kk.z) * wl[5] + bflo(kk.w) * wl[6] + bfhi(kk.w) * wl[7]; } \
            nst = sc * nst + sn; } \
        _Pragma("unroll") for (int vb = 0; vb < 2; ++vb) { acc[vb] = acc[vb] * sc; \
            _Pragma("unroll") for (int kt2 = 0; kt2 < 2; ++kt2) { const bf16x8 af = *(const LAS bf16x8*)(kt + (16 * w + fr) * 72 + 32 * kt2 + 8 * fq), bfv = *(const LAS bf16x8*)(vt + (16 * vb + fr) * 72 + 32 * kt2 + 8 * fq); \
                acc[vb] = MFMA32(af, bfv, acc[vb]); } } \
        m = mnew; } while (0)
    ML_LOAD(0, 0); ML_LOAD(1, 1);
#pragma unroll 1
    for (int c2 = 0; c2 < 32; c2 += 2) { ML_STEP(0, c2); ML_STEP(1, c2 + 1); }
#undef ML_LOAD
#undef ML_STEP
#pragma unroll
    for (int vb = 0; vb < 2; ++vb) *(f32x4*)(a->out + O_MCP + ((size_t)chain * 256 + 32 * vs + 16 * vb + fr) * 128 + 16 * w + 4 * fq) = acc[vb];
    if (vs == 0) { if (tid < 128) a->out[O_MNP + (size_t)chain * 128 + tid] = nst; if (tid == 0) a->out[O_MMP + chain] = m; }
    __syncthreads();
}

__device__ __forceinline__ void mlstm_out_item(ArgsP a, LAS unsigned char* lds, int item, const int tid) {
    const int c = item & 31, h = (item >> 5) & 7, b = item >> 8, row0 = b * TP + 64 * c;
    const int lane = tid & 63, w = __builtin_amdgcn_readfirstlane(tid >> 6), fr = lane & 15, fq = lane >> 4;
    unsigned char* ws = a->ws;
    const bf16* proj = (const bf16*)(ws + WS_PROJ); const float* gates = (const float*)(ws + WS_GATES);
    LAS bf16* VT = (LAS bf16*)lds;
    LAS float* ssq = (LAS float*)(lds + 36864);
    const int tb = w & 3, half = w >> 2, t = 16 * tb + fr;
    v4u vu[4];
#pragma unroll
    for (int i = 0; i < 4; ++i) vu[i] = *(const v4u*)(proj + (size_t)(row0 + lane) * NPROJ_PAD + 2048 + h * 256 + 8 * (w + 8 * i));
    v4u qu[4]; f32x4 nv[4][2];
#pragma unroll
    for (int ks = 0; ks < 4; ++ks) { qu[ks] = *(const v4u*)(proj + (size_t)(row0 + t) * NPROJ_PAD + h * 128 + 32 * ks + 8 * fq);
        const float* np = (const float*)(ws + WS_MN) + (size_t)item * 128 + 32 * ks + 8 * fq; nv[ks][0] = *(const f32x4*)np; nv[ks][1] = *(const f32x4*)(np + 4); }
    v4u kfr[4][4];
#pragma unroll
    for (int sb = 0; sb < 4; ++sb) if (sb <= tb) {
#pragma unroll
        for (int ks = 0; ks < 4; ++ks) kfr[sb][ks] = *(const v4u*)(proj + (size_t)(row0 + 16 * sb + fr) * NPROJ_PAD + 1024 + h * 128 + 32 * ks + 8 * fq); }
    const float mc = ((const float*)(ws + WS_MM))[item];
    float av, Mt, et, em;
    { const float ig = gates[(size_t)(row0 + lane) * 16 + h] + a->in[I_BIG][h], lf = logsigf(gates[(size_t)(row0 + lane) * 16 + 8 + h] + a->in[I_BFG][h]);
      const float bcum = wave_incl_sum(lf, lane); av = ig - bcum; Mt = fmaxf(mc, wave_incl_max(av, lane)); et = fexp(mc - Mt); em = fexp(-(bcum + Mt)); }
#pragma unroll
    for (int i = 0; i < 4; ++i) { const unsigned uu[4] = {vu[i].x, vu[i].y, vu[i].z, vu[i].w}; const int vr = 8 * (w + 8 * i);
#pragma unroll
        for (int e = 0; e < 4; ++e) { VT[(vr + 2 * e) * 72 + lane] = (bf16)(uu[e] & 0xffffu); VT[(vr + 2 * e + 1) * 72 + lane] = (bf16)(uu[e] >> 16); } }
    bf16x8 qf[4]; float qn = 0.f;
#pragma unroll
    for (int ks = 0; ks < 4; ++ks) { const v4u u = qu[ks]; qf[ks] = __builtin_bit_cast(bf16x8, u); const f32x4 n0 = nv[ks][0], n1 = nv[ks][1];
        qn += bflo(u.x) * n0.x + bfhi(u.x) * n0.y + bflo(u.y) * n0.z + bfhi(u.y) * n0.w + bflo(u.z) * n1.x + bfhi(u.z) * n1.y + bflo(u.w) * n1.z + bfhi(u.w) * n1.w; }
    qn += __shfl_xor(qn, 16); qn += __shfl_xor(qn, 32);
    const float Mtt = __shfl(Mt, t), ett = __shfl(et, t), emt = __shfl(em, t);
    const bf16* cs = (const bf16*)(ws + WS_MC) + (size_t)item * 256 * 128;
    v2u smp[4]; float rowsum = 0.f;
#pragma unroll
    for (int sb = 0; sb < 4; ++sb) { smp[sb] = (v2u){0u, 0u};
        if (sb <= tb) { f32x4 qk = (f32x4){0.f, 0.f, 0.f, 0.f};
#pragma unroll
            for (int ks = 0; ks < 4; ++ks) qk = MFMA32(__builtin_bit_cast(bf16x8, kfr[sb][ks]), qf[ks], qk);
            f32x4 sm;
#pragma unroll
            for (int j = 0; j < 4; ++j) { const int s = 16 * sb + 4 * fq + j; const float as = __shfl(av, s); sm[j] = (s <= t) ? qk[j] * 0.08838834764831845f * fexp(as - Mtt) : 0.f; rowsum += sm[j]; }
            smp[sb] = pack4(sm); } }
    rowsum += __shfl_xor(rowsum, 16); rowsum += __shfl_xor(rowsum, 32);
    const float hden = 1.f / fmaxf(fabsf(ett * qn + rowsum), emt);
    const v4u s0u = (v4u){smp[0].x, smp[0].y, smp[1].x, smp[1].y}, s1u = (v4u){smp[2].x, smp[2].y, smp[3].x, smp[3].y};
    const bf16x8 sf0 = __builtin_bit_cast(bf16x8, s0u), sf1 = __builtin_bit_cast(bf16x8, s1u);
    v4u cfr[4][4];
#pragma unroll
    for (int g4 = 0; g4 < 4; ++g4)
#pragma unroll
        for (int ks = 0; ks < 4; ++ks) cfr[g4][ks] = *(const v4u*)(cs + (size_t)(128 * half + 16 * g4 + fr) * 128 + 32 * ks + 8 * fq);
    __syncthreads();
    f32x4 hv[8]; float ss = 0.f;
#pragma unroll
    for (int grp = 0; grp < 2; ++grp) {
      f32x4 accs[4];
#pragma unroll
      for (int g4 = 0; g4 < 4; ++g4) { f32x4 acc = (f32x4){0.f, 0.f, 0.f, 0.f};
#pragma unroll
          for (int ks = 0; ks < 4; ++ks) acc = MFMA32(__builtin_bit_cast(bf16x8, cfr[g4][ks]), qf[ks], acc);
          accs[g4] = acc * ett; }
      if (grp == 0) {
#pragma unroll
          for (int g4 = 0; g4 < 4; ++g4)
#pragma unroll
              for (int ks = 0; ks < 4; ++ks) cfr[g4][ks] = *(const v4u*)(cs + (size_t)(128 * half + 64 + 16 * g4 + fr) * 128 + 32 * ks + 8 * fq); }
#pragma unroll
      for (int g4 = 0; g4 < 4; ++g4) { const int vb = 4 * grp + g4, vrow = 128 * half + 16 * vb + fr; f32x4 acc = accs[g4];
        { const v2u a0 = *(const LAS v2u*)(VT + vrow * 72 + 4 * fq), a1 = *(const LAS v2u*)(VT + vrow * 72 + 16 + 4 * fq); const v4u au = (v4u){a0.x, a0.y, a1.x, a1.y}; acc = MFMA32(__builtin_bit_cast(bf16x8, au), sf0, acc); }
        { const v2u a0 = *(const LAS v2u*)(VT + vrow * 72 + 32 + 4 * fq), a1 = *(const LAS v2u*)(VT + vrow * 72 + 48 + 4 * fq); const v4u au = (v4u){a0.x, a0.y, a1.x, a1.y}; acc = MFMA32(__builtin_bit_cast(bf16x8, au), sf1, acc); }
        hv[vb] = acc * hden; ss += (hv[vb].x * hv[vb].x + hv[vb].y * hv[vb].y) + (hv[vb].z * hv[vb].z + hv[vb].w * hv[vb].w); }
    }
    ss += __shfl_xor(ss, 16); ss += __shfl_xor(ss, 32);
    if (fq == 0) ssq[half * 64 + t] = ss;
    __syncthreads();
    const float rstd = rsqrtf((ssq[t] + ssq[64 + t]) * (1.f / 256.f) + RMS_EPS);
    const bf16* op = proj + (size_t)(row0 + t) * NPROJ_PAD + 4096 + h * 256 + 128 * half + 4 * fq;
    bf16* mp = (bf16*)(ws + WS_MIX) + (size_t)(row0 + t) * D + h * 256 + 128 * half + 4 * fq;
    const float* nw = a->in[I_MNORM] + h * 256 + 128 * half + 4 * fq;
    v2u opr[8];
#pragma unroll
    for (int vb = 0; vb < 8; ++vb) opr[vb] = *(const v2u*)(op + 16 * vb);
#pragma unroll
    for (int vb = 0; vb < 8; ++vb) { const v2u o = opr[vb]; const f32x4 n4 = *(const f32x4*)(nw + 16 * vb);
        f32x4 y; y.x = hv[vb].x * rstd * n4.x * sigm(bflo(o.x)); y.y = hv[vb].y * rstd * n4.y * sigm(bfhi(o.x)); y.z = hv[vb].z * rstd * n4.z * sigm(bflo(o.y)); y.w = hv[vb].w * rstd * n4.w * sigm(bfhi(o.y));
        *(v2u*)(mp + 16 * vb) = pack4(y); }
    __syncthreads();
}


__device__ __forceinline__ void mlstm_sample_load(ArgsP a, int j, const int tid, f32x4 (&cst)[2][4][2]) {
    const int lane = tid & 63, w = __builtin_amdgcn_readfirstlane(tid >> 6), fr = lane & 15, fq = lane >> 4;
    const float* C0 = a->in[I_SMC] + (size_t)j * 32768;
#pragma unroll
    for (int vb = 0; vb < 2; ++vb)
#pragma unroll
        for (int ksp = 0; ksp < 4; ++ksp) { const float* cp = C0 + (size_t)(32 * w + 16 * vb + fr) * 128 + 32 * ksp + 4 * fq; cst[vb][ksp][0] = __builtin_nontemporal_load((const f32x4*)cp); cst[vb][ksp][1] = __builtin_nontemporal_load((const f32x4*)(cp + 16)); }
}
__device__ __forceinline__ void mlstm_sample_item(ArgsP a, LAS unsigned char* lds, int j, const int tid, const f32x4 (&cst)[2][4][2]) {
    const int b = j >> 3, h = j & 7, row0 = MP + b * TS;
    const int lane = tid & 63, w = __builtin_amdgcn_readfirstlane(tid >> 6), fr = lane & 15, fq = lane >> 4;
    unsigned char* ws = a->ws;
    const bf16* proj = (const bf16*)(ws + WS_PROJ); const float* gates = (const float*)(ws + WS_GATES);
    float* Cout = a->out + O_MCS + (size_t)j * 32768;
    LAS float* qs = (LAS float*)lds;
    LAS float* ks = qs + 512;
    LAS float* vs = ks + 512;
    LAS float* gs = vs + 1024;
    LAS float* qkr = gs + 8;
    LAS float* qnl = qkr + 16;
    LAS float* hbuf = qnl + 8;
#pragma unroll
    for (int tok = 0; tok < 4; ++tok) { const bf16* pr = proj + (size_t)(row0 + tok) * NPROJ_PAD;
        if (tid < 128) qs[tok * 128 + tid] = bf2f(pr[h * 128 + tid]); else if (tid < 256) ks[tok * 128 + tid - 128] = bf2f(pr[1024 + h * 128 + (tid - 128)]) * 0.08838834764831845f; else vs[tok * 256 + tid - 256] = bf2f(pr[2048 + h * 256 + (tid - 256)]); }
    if (tid < 4) { gs[tid * 2] = gates[(size_t)(row0 + tid) * 16 + h] + a->in[I_BIG][h]; gs[tid * 2 + 1] = gates[(size_t)(row0 + tid) * 16 + 8 + h] + a->in[I_BFG][h]; }
    const float n0a = a->in[I_SMN][(size_t)j * 128 + lane], n0b = a->in[I_SMN][(size_t)j * 128 + 64 + lane];
    const float m0 = a->in[I_SMM][j];
    __syncthreads();
#pragma unroll
    for (int i = 0; i < 2; ++i) { const int p = 2 * w + i, t = p >> 2, sx = p & 3; const float d = wave_sum(qs[t * 128 + lane] * ks[sx * 128 + lane] + qs[t * 128 + 64 + lane] * ks[sx * 128 + 64 + lane]); if (lane == 0) qkr[p] = d; }
    if (w < 4) { const float d = wave_sum(qs[w * 128 + lane] * n0a + qs[w * 128 + 64 + lane] * n0b); if (lane == 0) qnl[w] = d; }
    float bc[4], ig[4], mt[4], m = m0, bsum = 0.f;
#pragma unroll
    for (int t = 0; t < 4; ++t) { ig[t] = gs[t * 2]; const float lf = logsigf(gs[t * 2 + 1]); bsum += lf; bc[t] = bsum; m = fmaxf(lf + m, ig[t]); mt[t] = m; }
    const float scf = fexp(bc[3] + m0 - mt[3]);
    float wsf[4], et[4];
#pragma unroll
    for (int t = 0; t < 4; ++t) { wsf[t] = fexp(bc[3] - bc[t] + ig[t] - mt[3]); et[t] = fexp(bc[t] + m0 - mt[t]); }
    __syncthreads();
    float S[4][4], hden[4];
#pragma unroll
    for (int t = 0; t < 4; ++t) { float den = et[t] * qnl[t];
#pragma unroll
        for (int sx = 0; sx < 4; ++sx) { S[t][sx] = (sx <= t) ? qkr[t * 4 + sx] * fexp(bc[t] - bc[sx] + ig[sx] - mt[t]) : 0.f; den += S[t][sx]; }
        hden[t] = 1.f / fmaxf(fabsf(den), fexp(-mt[t])); }
    bf16x8 qa[4];
#pragma unroll
    for (int ksp = 0; ksp < 4; ++ksp) { v4u u = (v4u){0u, 0u, 0u, 0u};
        if (fr < 4) { const f32x4 x0 = *(const LAS f32x4*)(qs + fr * 128 + 32 * ksp + 4 * fq), x1 = *(const LAS f32x4*)(qs + fr * 128 + 32 * ksp + 16 + 4 * fq); u.x = pk2(x0.x, x0.y); u.y = pk2(x0.z, x0.w); u.z = pk2(x1.x, x1.y); u.w = pk2(x1.z, x1.w); }
        qa[ksp] = __builtin_bit_cast(bf16x8, u); }
#pragma unroll
    for (int vb = 0; vb < 2; ++vb) { const int v = 32 * w + 16 * vb + fr;
        float vw[4];
#pragma unroll
        for (int sx = 0; sx < 4; ++sx) vw[sx] = vs[sx * 256 + v] * wsf[sx];
        f32x4 dacc = (f32x4){0.f, 0.f, 0.f, 0.f};
#pragma unroll
        for (int ksp = 0; ksp < 4; ++ksp) { const f32x4 c0 = cst[vb][ksp][0], c1 = cst[vb][ksp][1];
            v4u u; u.x = pk2(c0.x, c0.y); u.y = pk2(c0.z, c0.w); u.z = pk2(c1.x, c1.y); u.w = pk2(c1.z, c1.w);
            dacc = MFMA32(qa[ksp], __builtin_bit_cast(bf16x8, u), dacc);
            f32x4 n0v = c0 * scf, n1v = c1 * scf;
#pragma unroll
            for (int sx = 0; sx < 4; ++sx) { const f32x4 k0 = *(const LAS f32x4*)(ks + sx * 128 + 32 * ksp + 4 * fq), k1 = *(const LAS f32x4*)(ks + sx * 128 + 32 * ksp + 16 + 4 * fq); n0v = n0v + k0 * vw[sx]; n1v = n1v + k1 * vw[sx]; }
            float* op = Cout + (size_t)v * 128 + 32 * ksp + 4 * fq; __builtin_nontemporal_store(n0v, (f32x4*)op); __builtin_nontemporal_store(n1v, (f32x4*)(op + 16)); }
        if (fq == 0) {
#pragma unroll
            for (int t = 0; t < 4; ++t) { float num = et[t] * dacc[t];
#pragma unroll
                for (int sx = 0; sx < 4; ++sx) num += S[t][sx] * vs[sx * 256 + v];
                hbuf[t * 256 + v] = num * hden[t]; } }
    }
    if (tid < 128) { float nn = scf * a->in[I_SMN][(size_t)j * 128 + tid];
#pragma unroll
        for (int sx = 0; sx < 4; ++sx) nn += wsf[sx] * ks[sx * 128 + tid];
        a->out[O_MNS + (size_t)j * 128 + tid] = nn; }
    if (tid == 0) a->out[O_MMS + j] = mt[3];
    __syncthreads();
    if (w < 4) { const int tok = w, row = row0 + tok; float hv[4]; float ss = 0.f;
#pragma unroll
        for (int i = 0; i < 4; ++i) { hv[i] = hbuf[tok * 256 + i * 64 + lane]; ss += hv[i] * hv[i]; }
        const float rstd = rsqrtf(wave_sum(ss) * (1.f / 256.f) + RMS_EPS);
        const float* nw = a->in[I_MNORM] + h * 256; bf16* mix = (bf16*)(ws + WS_MIX);
#pragma unroll
        for (int i = 0; i < 4; ++i) { const int vi = i * 64 + lane; const float op = bf2f(proj[(size_t)row * NPROJ_PAD + 4096 + h * 256 + vi]);
            mix[(size_t)row * D + h * 256 + vi] = (bf16)f2bf(hv[i] * rstd * nw[vi] * sigm(op)); } }
    __syncthreads();
}

__device__ __forceinline__ void phase_mixer_even(ArgsP a, LAS unsigned char* lds, int vcu, int G, const int tid) {
#pragma unroll 1
    for (int r = 0; r < 1 + (PROBE_SUB & 1); ++r)
#pragma unroll 1
    for (int it = vcu; it < 1024; it += G) delta_prep_item(a, lds, it, tid);
#pragma unroll 1
    for (int r = 0; r < 1 + ((PROBE_SUB >> 1) & 1); ++r)
#pragma unroll 1
    for (int it = vcu; it < 1024; it += G) lru_prep_item(a, lds, it, tid);
#pragma unroll 1
    for (int r = 0; r < 1 + ((PROBE_SUB >> 2) & 1); ++r)
#pragma unroll 1
    for (int j = vcu; j < 1024; j += G) { const int b = j >> 3, hn = j & 7; delta_rec_item(a, lds, MP + b * TS, TS, hn, a->in[I_SCONV] + (size_t)b * 3 * 4096, a->in[I_SDELTA] + (size_t)j * 16384, a->out + O_DELTAS + (size_t)j * 16384, tid); }
#pragma unroll 1
    for (int r = 0; r < 1 + ((PROBE_SUB >> 3) & 1); ++r)
#pragma unroll 1
    for (int j = vcu; j < 1024; j += G) { const int b = j >> 3, hn = j & 7; lru_rec_item(a, lds, MP + b * TS, TS, hn, a->in[I_SCONV] + (size_t)b * 3 * 4096, a->in[I_SLRU] + (size_t)b * 1024, a->out + O_LRUS + (size_t)b * 1024, tid); }
    const bf16* proj = (const bf16*)(a->ws + WS_PROJ);
    const int npieces = (BP + BS) * 3 * 512;
    for (int i = vcu * NTHR + tid; i < npieces; i += G * NTHR) {
        const int c8 = i & 511, rj = i >> 9, j = rj % 3, b = rj / 3;
        const bf16* src; float* dst;
        if (b < BP) { src = proj + (size_t)(b * TP + TP - 3 + j) * NPROJ_PAD + 8 * c8; dst = a->out + O_CONVP + (size_t)(b * 3 + j) * 4096 + 8 * c8; }
        else { const int bs = b - BP; src = proj + (size_t)(MP + bs * TS + 1 + j) * NPROJ_PAD + 8 * c8; dst = a->out + O_CONVS + (size_t)(bs * 3 + j) * 4096 + 8 * c8; }
        const v4u u = *(const v4u*)src;
        *(f32x4*)dst = (f32x4){bflo(u.x), bfhi(u.x), bflo(u.y), bfhi(u.y)}; *(f32x4*)(dst + 4) = (f32x4){bflo(u.z), bfhi(u.z), bflo(u.w), bfhi(u.w)};
    }
}
__device__ __forceinline__ void phase_mixer_even_b(ArgsP a, LAS unsigned char* lds, int vcu, int G, const int tid) {
    const int w = __builtin_amdgcn_readfirstlane(tid >> 6);
    if (w == 0) { for (int it = vcu; it < 256; it += G) delta_scan_wave(a, it >> 3, it & 7, tid & 63); }
    else { LAS float* scr = (LAS float*)(lds + w * 16384);
        convert_range(a, scr, cv::R_IN0, cv::R_SCAN, vcu * 7 + (w - 1), G * 7, tid & 63); }
}
__device__ __forceinline__ void phase_mixer_even_c(ArgsP a, LAS unsigned char* lds, int vcu, int G, const int tid) {
    const int w = tid >> 6;
#pragma unroll 1
    for (int it = vcu; it < 512; it += G) delta_out_wave(a, 2 * it + (w >> 2), w & 3, tid & 63);
#pragma unroll 1
    for (int it = vcu; it < 1024; it += G) lru_out_item(a, lds, it, tid);
    for (int chain = vcu; chain < 32; chain += G) {
        const f32x4* src = (const f32x4*)(a->ws + WS_DF) + (size_t)chain * 4096; float* dst = a->out + O_DELTAP + (size_t)chain * 16384;
        f32x4 v[8];
#pragma unroll
        for (int i = 0; i < 8; ++i) v[i] = src[tid + 512 * i];
#pragma unroll
        for (int i = 0; i < 8; ++i) { const int idx = tid + 512 * i, ln = idx & 63, rb = (idx >> 6) & 7, s8 = idx >> 9; const int dk0 = 16 * rb + 4 * (ln >> 4), dv = 16 * s8 + (ln & 15);
            dst[(size_t)(dk0 + 0) * 128 + dv] = v[i].x; dst[(size_t)(dk0 + 1) * 128 + dv] = v[i].y; dst[(size_t)(dk0 + 2) * 128 + dv] = v[i].z; dst[(size_t)(dk0 + 3) * 128 + dv] = v[i].w; }
    }
}
__device__ __forceinline__ void phase_mixer_odd(ArgsP a, LAS unsigned char* lds, int vcu, int G, const int tid) {
#pragma unroll 1
    for (int r = 0; r < 1 + ((PROBE_SUB >> 4) & 1); ++r)
#pragma unroll 1
    for (int it = vcu; it < 256; it += G) mlstm_scan_item(a, lds, it >> 3, it & 7, tid);
#pragma unroll 1
    for (int r = 0; r < 1 + ((PROBE_SUB >> 5) & 1); ++r)
    {
        f32x4 cA[2][4][2], cB[2][4][2]; int j = vcu;
        if (j < 1024) { mlstm_sample_load(a, j, tid, cA);
#pragma unroll 1
            for (;;) {
                const int jB = j + G; const bool hasB = jB < 1024;
                if (hasB) mlstm_sample_load(a, jB, tid, cB);
                mlstm_sample_item(a, lds, j, tid, cA);
                if (!hasB) break;
                j = jB + G; const bool hasA = j < 1024;
                if (hasA) mlstm_sample_load(a, j, tid, cA);
                mlstm_sample_item(a, lds, jB, tid, cB);
                if (!hasA) break;
            } }
    }
}
__device__ __forceinline__ void phase_mixer_odd_b(ArgsP a, LAS unsigned char* lds, int vcu, int G, const int tid) {
#pragma unroll 1
    for (int it = vcu; it < 1024; it += G) mlstm_out_item(a, lds, it, tid);
}

__device__ __forceinline__ void phase_ln(const bf16* VB, const float* ST, const float* p1, const bf16* resid, const float* g, const float* bta, bf16* dst, LAS unsigned char* lds, int vcu, int G, const int tid) {
    const int lane = tid & 63, w = __builtin_amdgcn_readfirstlane(tid >> 6), gw = vcu * NWAVES + w, NGW = G * NWAVES;
    {
        LAS float* red = (LAS float*)lds;
        for (int r0 = 2 * vcu; r0 < MS; r0 += 2 * G) {
            const int r = r0 + (w >> 2), q = w & 3, col = 512 * q + 8 * lane; const size_t off = (size_t)(MP + r) * D + col;
            const float* q1 = p1 + (size_t)r * D + col;
            f32x4 x0 = *(const f32x4*)q1, x1 = *(const f32x4*)(q1 + 4);
#pragma unroll
            for (int ch = 1; ch < 16; ++ch) { x0 = x0 + *(const f32x4*)(q1 + (size_t)ch * 512 * D); x1 = x1 + *(const f32x4*)(q1 + (size_t)ch * 512 * D + 4); }
            const v4u rr = *(const v4u*)(resid + off);
            float v[8] = {x0.x + DN_ALPHA * bflo(rr.x), x0.y + DN_ALPHA * bfhi(rr.x), x0.z + DN_ALPHA * bflo(rr.y), x0.w + DN_ALPHA * bfhi(rr.y),
                          x1.x + DN_ALPHA * bflo(rr.z), x1.y + DN_ALPHA * bfhi(rr.z), x1.z + DN_ALPHA * bflo(rr.w), x1.w + DN_ALPHA * bfhi(rr.w)};
            float s = 0.f, ss = 0.f;
#pragma unroll
            for (int i = 0; i < 8; ++i) { s += v[i]; ss += v[i] * v[i]; }
            s = wave_sum(s); ss = wave_sum(ss);
            if (lane == 0) { red[w * 2] = s; red[w * 2 + 1] = ss; }
            __syncthreads();
            const int wb = (w >> 2) * 4; s = (red[wb * 2] + red[wb * 2 + 2]) + (red[wb * 2 + 4] + red[wb * 2 + 6]); ss = (red[wb * 2 + 1] + red[wb * 2 + 3]) + (red[wb * 2 + 5] + red[wb * 2 + 7]);
            const float mean = s * (1.f / D), rstd = rsqrtf(fmaxf(ss * (1.f / D) - mean * mean, 0.f) + LN_EPS);
            const f32x4 g0 = *(const f32x4*)(g + col), g1 = *(const f32x4*)(g + col + 4), b0 = *(const f32x4*)(bta + col), b1 = *(const f32x4*)(bta + col + 4);
            v4u o; o.x = pk2((v[0] - mean) * rstd * g0.x + b0.x, (v[1] - mean) * rstd * g0.y + b0.y); o.y = pk2((v[2] - mean) * rstd * g0.z + b0.z, (v[3] - mean) * rstd * g0.w + b0.w);
            o.z = pk2((v[4] - mean) * rstd * g1.x + b1.x, (v[5] - mean) * rstd * g1.y + b1.y); o.w = pk2((v[6] - mean) * rstd * g1.z + b1.z, (v[7] - mean) * rstd * g1.w + b1.w);
            *(v4u*)(dst + off) = o;
            __syncthreads();
        }
    }
    for (int m0 = gw; m0 < MP; m0 += 4 * NGW) {
        v4u vv[4][4]; float s[4], ss[4];
#pragma unroll
        for (int i = 0; i < 4; ++i) { const int m = m0 + i * NGW; s[i] = 0.f; ss[i] = 0.f;
            if (m < MP) { if (lane < 32) { const float* sp = ST + (((size_t)(lane >> 2) * M + m) * 4 + (lane & 3)) * 2; s[i] = sp[0]; ss[i] = sp[1]; }
#pragma unroll
                for (int j = 0; j < 4; ++j) vv[i][j] = *(const v4u*)(VB + (size_t)m * D + j * 512 + lane * 8); } }
#pragma unroll
        for (int i = 0; i < 4; ++i) { const int m = m0 + i * NGW;
            if (m < MP) { const float st = wave_sum(s[i]), sst = wave_sum(ss[i]);
                const float mean = st * (1.f / D), rstd = rsqrtf(fmaxf(sst * (1.f / D) - mean * mean, 0.f) + LN_EPS);
#pragma unroll
                for (int j = 0; j < 4; ++j) { const int col = j * 512 + lane * 8; const v4u v = vv[i][j];
                    const f32x4 g0 = *(const f32x4*)(g + col), g1 = *(const f32x4*)(g + col + 4), b0 = *(const f32x4*)(bta + col), b1 = *(const f32x4*)(bta + col + 4);
                    v4u o; o.x = pk2((bflo(v.x) - mean) * rstd * g0.x + b0.x, (bfhi(v.x) - mean) * rstd * g0.y + b0.y); o.y = pk2((bflo(v.y) - mean) * rstd * g0.z + b0.z, (bfhi(v.y) - mean) * rstd * g0.w + b0.w);
                    o.z = pk2((bflo(v.z) - mean) * rstd * g1.x + b1.x, (bfhi(v.z) - mean) * rstd * g1.y + b1.y); o.w = pk2((bflo(v.w) - mean) * rstd * g1.z + b1.z, (bfhi(v.w) - mean) * rstd * g1.w + b1.w);
                    *(v4u*)(dst + (size_t)m * D + col) = o; } } }
    }
}
__device__ __forceinline__ void phase_combine(const float* p1, const bf16* h2, const bf16* pw, bf16* xb, float* outf, int vcu, int G, const int tid) {
    const int lane = tid & 63, w = tid >> 6;
    for (int r0 = 2 * vcu; r0 < MS; r0 += 2 * G) {
        const int r = r0 + (w >> 2), q = w & 3, col = 512 * q + 8 * lane; const size_t off = (size_t)(MP + r) * D + col;
        const float* q1 = p1 + (size_t)r * D + col;
        f32x4 x0 = *(const f32x4*)q1, x1 = *(const f32x4*)(q1 + 4);
#pragma unroll
        for (int ch = 1; ch < 16; ++ch) { x0 = x0 + *(const f32x4*)(q1 + (size_t)ch * 512 * D); x1 = x1 + *(const f32x4*)(q1 + (size_t)ch * 512 * D + 4); }
        const v4u hh = *(const v4u*)(h2 + off), pp = *(const v4u*)(pw + off);
        f32x4 o0, o1;
        o0.x = bflo(hh.x) + sigm(x0.x) * bflo(pp.x); o0.y = bfhi(hh.x) + sigm(x0.y) * bfhi(pp.x); o0.z = bflo(hh.y) + sigm(x0.z) * bflo(pp.y); o0.w = bfhi(hh.y) + sigm(x0.w) * bfhi(pp.y);
        o1.x = bflo(hh.z) + sigm(x1.x) * bflo(pp.z); o1.y = bfhi(hh.z) + sigm(x1.y) * bfhi(pp.z); o1.z = bflo(hh.w) + sigm(x1.z) * bflo(pp.w); o1.w = bfhi(hh.w) + sigm(x1.w) * bfhi(pp.w);
        v4u ob; ob.x = pk2(o0.x, o0.y); ob.y = pk2(o0.z, o0.w); ob.z = pk2(o1.x, o1.y); ob.w = pk2(o1.z, o1.w); *(v4u*)(xb + off) = ob;
        if (outf) { *(f32x4*)(outf + off) = o0; *(f32x4*)(outf + off + 4) = o1; }
    }
}

constexpr int N_PHASES = 22;
enum { OP_INPROJ = 0, OP_MIXA, OP_MIXB, OP_MIXC, OP_OUTPROJ, OP_LN1, OP_UP, OP_DOWN, OP_LN2, OP_GATE, OP_COMBINE };
enum { GK_LN = 0, GK_BF16 = 1, GK_SQRELU = 2, GK_COMB = 3 };
__global__ void __launch_bounds__(NTHR, 2) mk_fwd(Args a_in) {
    extern __shared__ __attribute__((aligned(16))) unsigned char lds_raw[];
    LAS unsigned char* lds = (LAS unsigned char*)lds_raw;
    ArgsP kp = (ArgsP)__builtin_amdgcn_kernarg_segment_ptr();
    const int lo = a_in.ph_lo, hi = a_in.ph_hi;
    int wv0; { const int wtmp = (int)threadIdx.x >> 6; asm volatile("s_nop 4\n\tv_readfirstlane_b32 %0, %1\n\ts_nop 4" : "=s"(wv0) : "v"(wtmp)); }
#if MK_N_LAUNCHES == 1
    volatile LAS unsigned* xst = (volatile LAS unsigned*)(lds + LDS_CTL_OFF);
    if (threadIdx.x < 2) xst[threadIdx.x] = 0u;
    __syncthreads();
    XcdBarrier bar = xcd_barrier_post((unsigned*)(a_in.ws + WS_CTL) + 4096, xst);
#endif
    int p = lo; asm volatile("" : "+s"(p));
#pragma unroll 1
    for (; p < hi; ) {
      int nrep = 1;
      if (PROBE_MASK) { const int L_ = p <= 11 ? 0 : 1; const int q_ = p == 0 ? -1 : (L_ == 0 ? p - 1 : (p - 12 < 3 ? p - 12 : p - 11));
        int grp; if (p == 0) grp = 0; else if (q_ == OP_INPROJ || q_ == OP_UP) grp = 1; else if (q_ == OP_OUTPROJ || q_ == OP_DOWN || q_ == OP_GATE) grp = 2; else if (q_ == OP_LN1 || q_ == OP_LN2 || q_ == OP_COMBINE) grp = 3; else grp = (L_ == 0) ? 4 : 5;
        if ((PROBE_MASK >> grp) & 1) nrep = 2; }
      if (p == PROBE_P) nrep = 2;
#pragma unroll 1
      for (int rep = 0; rep < nrep; ++rep) {
        int pp = p; asm volatile("" : "+s"(pp));
        int wvs = wv0; asm volatile("" : "+s"(wvs));
        unsigned ones = ~0u; asm volatile("" : "+s"(ones));
        int tid = (wvs << 6) | (int)__builtin_amdgcn_mbcnt_hi(ones, __builtin_amdgcn_mbcnt_lo(ones, 0u)); asm volatile("" : "+v"(tid));
        int bx = blockIdx.x; asm volatile("" : "+s"(bx));
        int G = gridDim.x; asm volatile("" : "+s"(G));
        ArgsP a = kp; asm volatile("" : "+s"(a));
#define MK_VCU ((G % 8 == 0) ? (bx % 8) * (G / 8) + bx / 8 : bx)
#define MK_WAVE (__builtin_amdgcn_readfirstlane(tid >> 6))
#define MK_GW (MK_VCU * NWAVES + MK_WAVE)
#define MK_NGW (G * NWAVES)
#define MK_LANE (tid & 63)
        unsigned char* ws = a->ws;
        if (pp == 0) {
phase_convert(a, lds, MK_GW, MK_NGW, MK_WAVE, MK_LANE); }
        else {
            const int L = pp <= 11 ? 0 : 1; const int q = L == 0 ? pp - 1 : (pp - 12 < 3 ? pp - 12 : pp - 11);
            bf16* xb = (bf16*)(ws + WS_XB); bf16* mixb = (bf16*)(ws + WS_MIX); bf16* hb = (bf16*)(ws + WS_H); bf16* h2b = (bf16*)(ws + WS_H2); bf16* pwb = (bf16*)(ws + WS_PW);
            bf16* projb = (bf16*)(ws + WS_PROJ); bf16* upb = (bf16*)(ws + WS_PROJ);
            bf16* vbb = (bf16*)(ws + WS_PART0); float* stb = (float*)(ws + WS_PART0 + 34 * MiB); float* part1 = (float*)(ws + WS_PART1); float* gatesb = (float*)(ws + WS_GATES);
            if (q == OP_MIXA) { if (L == 0) phase_mixer_even(a, lds, MK_VCU, G, tid); else phase_mixer_odd(a, lds, MK_VCU, G, tid); }
            else if (q == OP_MIXB) { if (L == 0) phase_mixer_even_b(a, lds, MK_VCU, G, tid); else phase_mixer_odd_b(a, lds, MK_VCU, G, tid); }
            else if (q == OP_MIXC) { phase_mixer_even_c(a, lds, MK_VCU, G, tid); }
            else if (q == OP_LN1) phase_ln(vbb, stb, part1, xb, a->in[I_LN1G] + L * D, a->in[I_LN1B] + L * D, hb, lds, MK_VCU, G, tid);
            else if (q == OP_LN2) phase_ln(vbb, stb, part1, hb, a->in[I_LN2G] + L * D, a->in[I_LN2B] + L * D, h2b, lds, MK_VCU, G, tid);
            else if (q == OP_COMBINE) phase_combine(part1, h2b, pwb, xb, L == 1 ? a->out + O_Y : nullptr, MK_VCU, G, tid);
            else {
                for (int sub = 0; sub < (q == OP_INPROJ ? 2 : 1); ++sub) {
                    const bf16* A; const bf16* Bt; int N, K, kind; void* out = nullptr; float* gp = nullptr; const bf16* resid = nullptr; int corder = bx, gorder = G;
                    const int busy_in = ((M / 256) * (NPROJ_PAD / 256)) % 256;
                    if (q == OP_INPROJ && sub == 0) { A = xb; Bt = (const bf16*)(ws + (L == 0 ? WS_WINE : WS_WINO)); N = NPROJ_PAD; K = D; kind = GK_BF16; out = projb; gp = gatesb; }
                    else if (q == OP_INPROJ) { A = (const bf16*)(ws + WS_PB) + (size_t)L * M * PLE; Bt = (const bf16*)(ws + WS_WPLE) + (size_t)L * PLE * D; N = D; K = PLE; kind = GK_BF16; out = pwb;
                        gorder = G - busy_in; corder = (bx >= busy_in) ? bx - busy_in : 1 << 20; }
                    else if (q == OP_OUTPROJ) { A = mixb; Bt = (const bf16*)(ws + (L == 0 ? WS_WOUTE : WS_WOUTO)); N = D; K = D; kind = GK_LN; resid = xb; }
                    else if (q == OP_UP) { A = hb; Bt = (const bf16*)(ws + WS_WUP) + (size_t)L * D * FF; N = FF; K = D; kind = GK_SQRELU; out = upb; }
                    else if (q == OP_DOWN) { A = upb; Bt = (const bf16*)(ws + WS_WDOWN) + (size_t)L * D * FF; N = D; K = FF; kind = GK_LN; resid = hb; }
                    else { A = h2b; Bt = (const bf16*)(ws + WS_WGATE) + (size_t)L * D * D; N = D; K = D; kind = GK_COMB; }
                    pg8::Gemm g{A, Bt, M, N, K};
                    if (kind == GK_LN) { pg8::MainSplit SK; SK.init(K, MK_VCU); pg8::EpiLnStat E{vbb, stb, resid, part1, N, M, DN_ALPHA}; pg8::gemm_phase<pg8::EpiLnStat, pg8::MainSplit, true, true>(lds, g, SK, E, tid); }
                    else if (kind == GK_COMB) { pg8::MainSplit SK; SK.init(K, MK_VCU); pg8::EpiCombine E{h2b, pwb, xb, L == 1 ? a->out + O_Y : nullptr, part1, N}; pg8::gemm_phase<pg8::EpiCombine, pg8::MainSplit, true, true>(lds, g, SK, E, tid); }
                    else if (kind == GK_BF16) { pg8::StaticOrder S; S.init(M, N, K, gorder, corder); pg8::EpiBf16<0> E{(bf16*)out, N, gp, 24}; pg8::gemm_phase<pg8::EpiBf16<0>, pg8::StaticOrder, true, true>(lds, g, S, E, tid);}
                    else { pg8::StaticOrder S; S.init(M, N, K, G, corder); pg8::EpiBf16<1> E{(bf16*)out, N, nullptr, -1}; pg8::gemm_phase<pg8::EpiBf16<1>, pg8::StaticOrder, true, true>(lds, g, S, E, tid);}
                }
                if (q == OP_INPROJ || q == OP_UP) {
                    const int busy = (q == OP_INPROJ) ? ((M / 256) * (NPROJ_PAD / 256)) % 256 : ((M / 256) * (FF / 256)) % 256;
                    const int first = (q == OP_INPROJ) ? (L == 0 ? 0 : cv::R_SCAN) : (L == 0 ? cv::R_IN1 : cv::R_UP0), last = (q == OP_INPROJ) ? (L == 0 ? cv::R_IN0 : cv::R_IN1) : (L == 0 ? cv::R_UP0 : cv::N_REST);
                    if (G == 256 && bx >= busy) { const int w_ = MK_WAVE; convert_range(a, (LAS float*)(lds + w_ * 16384), first, last, (bx - busy) * NWAVES + w_, (G - busy) * NWAVES, MK_LANE); }
                }
            }
        }
#if MK_N_LAUNCHES == 1
        if (p + 1 < hi || rep + 1 < nrep) xcd_barrier(bar);
#endif
      }
      asm volatile("s_add_i32 %0, %0, 1" : "+s"(p) : : "scc");
    }
}

extern "C" void kernel_launch(void* const* d_in, const int* in_sizes, int n_in, void* d_out, int out_size, void* d_ws, size_t ws_size, hipStream_t stream) {
    static int grid = 0;
    if (grid == 0) {
        if (n_in != 35 || (size_t)out_size != O_END || ws_size < WS_END) { fprintf(stderr, "kernel_launch: unexpected shapes: n_in %d out %d (want %zu) ws %zu (want %zu)\n", n_in, out_size, (size_t)O_END, ws_size, (size_t)WS_END); grid = -1; return; }
        int dev = 0, cus = 0, per_cu = 0;
        hipGetDevice(&dev); hipDeviceGetAttribute(&cus, hipDeviceAttributeMultiprocessorCount, dev);
        if (hipFuncSetAttribute((const void*)mk_fwd, hipFuncAttributeMaxDynamicSharedMemorySize, LDS_BYTES) != hipSuccess) { fprintf(stderr, "kernel_launch: hipFuncSetAttribute failed\n"); grid = -1; return; }
        if (hipOccupancyMaxActiveBlocksPerMultiprocessor(&per_cu, (const void*)mk_fwd, NTHR, LDS_BYTES) != hipSuccess || per_cu < 1) { fprintf(stderr, "kernel_launch: occupancy query says %d\n", per_cu); per_cu = 1; }
        (void)hipGetLastError();
        if (cus != 256) { fprintf(stderr, "kernel_launch: built for a 256-CU device (N = 2048 GEMM schedule), got %d\n", cus); grid = -1; return; }
        grid = cus * 1;
    }
    if (grid < 0) return;
    Args a{};
    for (int i = 0; i < 35; ++i) a.in[i] = (const float*)d_in[i];
    a.out = (float*)d_out; a.ws = (unsigned char*)d_ws;
#if MK_N_LAUNCHES == 1
    hipMemsetAsync((char*)d_ws + WS_CTL, 0, 1 * MiB, stream);
    a.ph_lo = 0; a.ph_hi = N_PHASES;
    hipLaunchKernelGGL(mk_fwd, dim3(grid), dim3(NTHR), LDS_BYTES, stream, a);
#else
    for (int p = 0; p < N_PHASES; ++p) {
        a.ph_lo = p; a.ph_hi = p + 1;
        hipLaunchKernelGGL(mk_fwd, dim3(grid), dim3(NTHR), LDS_BYTES, stream, a);
    }
#endif
}
```

```cpp
#include <hip/hip_runtime.h>
#include <hip/hip_cooperative_groups.h>
#include <cstdio>
#include <cstdint>
namespace cg = cooperative_groups;

#ifndef PROBE_MASK
#define PROBE_MASK 0
#endif
#define PROBE_P (-1)
#define PROBE_SUB 0
#ifndef MK_N_LAUNCHES
#define MK_N_LAUNCHES 1
#endif

namespace pg8 {
#define PG8_LAS __attribute__((address_space(3)))
typedef unsigned short bf16_t;
typedef short bf16x8 __attribute__((ext_vector_type(8)));
typedef float f32x4 __attribute__((ext_vector_type(4)));
typedef unsigned u32x4 __attribute__((ext_vector_type(4)));
constexpr int BM = 256, BK = 64, HALF = 128, HTB = HALF * BK * 2, STAGE_BYTES = 8 * HTB, NXCD = 8, WGM = 8;

__host__ __device__ __forceinline__ int lds_byte(int r, int c) { const int st = (r >> 4) * 2 + (c >> 5), rr = r & 15, cc = c & 31, ob = rr * 64 + cc * 2; return st * 1024 + (ob ^ (((ob >> 9) & 1) << 5)); }
__host__ __device__ __forceinline__ void stage_rc(int b, int& R, int& C) { const int st = b / 1024, sb = b % 1024, swz = sb ^ (((sb >> 9) & 1) << 5); R = (st >> 1) * 16 + swz / 64; C = (st & 1) * 32 + (swz % 64) / 2; }
__host__ __device__ __forceinline__ int perm32(int rho) { const int n = rho >> 4, i = rho & 15; return 8 * (i >> 2) + 4 * n + (i & 3); }

struct Unit { int pm, pn, kt0, nkt, dst; };
struct Gemm { const bf16_t* A; const bf16_t* Bt; int M, N, K; };

struct StaticOrder {
    int nM, nN, nwg, G, c, T;
    __host__ __device__ void init(int M, int N, int K, int G_, int c_) { nM = M / BM; nN = N / BM; nwg = nM * nN; G = G_; c = c_; T = K / BK; }
    __host__ __device__ bool next(int i, Unit& u) const {
        const long L = (long)i * G + c; if (L >= nwg) return false;
        int wgid = (int)L; { const int q = nwg / NXCD, r = nwg % NXCD, xcd = wgid % NXCD, off = wgid / NXCD; wgid = (xcd < r ? xcd * (q + 1) : r * (q + 1) + (xcd - r) * q) + off; }
        const int nig = WGM * nN, gid = wgid / nig, fm = gid * WGM, gsz = (nM - fm) < WGM ? (nM - fm) : WGM;
        u.pm = fm + ((wgid % nig) % gsz); u.pn = (wgid % nig) / gsz; u.kt0 = 0; u.nkt = T; u.dst = 0; return true;
    }
    __device__ __forceinline__ void a_ready(const Unit&) const {}
    __device__ __forceinline__ void done(const Unit&) const {}
};
struct StreamK {
    int nN, T, P, ntot, c;
    __host__ __device__ void init(int M, int N, int K, int G, int c_) { nN = N / BM; T = K / BK; ntot = (M / BM) * nN * T; P = (((ntot + G - 1) / G) + 1) & ~1; c = c_; }
    __host__ __device__ bool next(int i, Unit& u) const {
        int s = c * P; const int e = (s + P < ntot) ? s + P : ntot;
        for (int k = 0; ; ++k) { if (s >= e) return false; const int tile = s / T, kt0 = s - tile * T; const int n = (T - kt0 < e - s) ? T - kt0 : e - s;
            if (k == i) { u.pm = tile / nN; u.pn = tile - u.pm * nN; u.kt0 = kt0; u.nkt = n; u.dst = kt0 ? 1 : 0; return true; }
            s += n; }
    }
    __device__ __forceinline__ void a_ready(const Unit&) const {}
    __device__ __forceinline__ void done(const Unit&) const {}
};
struct MainSplit {
    int T, c;
    __host__ __device__ void init(int K, int c_) { T = K / BK; c = c_; }
    __host__ __device__ bool next(int i, Unit& u) const {
        if (i == 0) { u.pm = c >> 3; u.pn = c & 7; u.kt0 = 0; u.nkt = T; u.dst = 0; return true; }
        if (i == 1) { const int lt = c >> 4, j = c & 15; u.pm = 32 + (lt >> 3); u.pn = lt & 7; u.nkt = T >> 4; u.kt0 = j * u.nkt; u.dst = 1 + j; return true; }
        return false;
    }
    __device__ __forceinline__ void a_ready(const Unit&) const {}
    __device__ __forceinline__ void done(const Unit&) const {}
};
__host__ __device__ __forceinline__ bool split_tile(int tile, int T, int P) { return (tile * T) / P != ((tile + 1) * T - 1) / P; }

__device__ __forceinline__ unsigned cvt_pk_bf16(float lo, float hi) { unsigned r; asm volatile("v_cvt_pk_bf16_f32 %0, %1, %2" : "=v"(r) : "v"(lo), "v"(hi)); return r; }

__device__ __forceinline__ float pg_bflo(unsigned w) { return __builtin_bit_cast(float, w << 16); }
__device__ __forceinline__ float pg_bfhi(unsigned w) { return __builtin_bit_cast(float, w & 0xffff0000u); }
__device__ __forceinline__ void store_chunk(const f32x4 (&acc)[2][2][4][2], const Unit& u, float* C1, int ldc, int wr, int wc, int fr, int fq) {
    const int row0 = u.pm * BM + wr * 64 + fr, col0 = u.pn * BM + wc * 32 + 8 * fq; float* Cb = C1 + ((long)(u.dst - 1) * 512 - 8192) * (long)ldc;
#pragma unroll
    for (int ai = 0; ai < 2; ++ai)
#pragma unroll
        for (int m = 0; m < 4; ++m) { float* rowp = Cb + (size_t)(row0 + ai * HALF + m * 16) * ldc + col0;
#pragma unroll
            for (int bj = 0; bj < 2; ++bj) { *(f32x4*)(rowp + bj * HALF) = acc[ai][bj][m][0]; *(f32x4*)(rowp + bj * HALF + 4) = acc[ai][bj][m][1]; } }
}
struct EpiLnStat {
    static constexpr bool PERM = true, AFTER_DRAIN = false;
    bf16_t* VB; float* ST; const bf16_t* resid; float* C1; int ldc; int mrows; float alpha;
    __device__ __forceinline__ void operator()(const f32x4 (&acc)[2][2][4][2], const Unit& u, int wr, int wc, int fr, int fq) const {
        if (u.dst) { store_chunk(acc, u, C1, ldc, wr, wc, fr, fq); return; }
        const int row0 = u.pm * BM + wr * 64 + fr, col0 = u.pn * BM + wc * 32 + 8 * fq;
        u32x4 rq[2];
#pragma unroll
        for (int bj = 0; bj < 2; ++bj) rq[bj] = *(const u32x4*)(resid + (size_t)(row0) * ldc + col0 + bj * HALF);
#pragma unroll
        for (int idx = 0; idx < 8; ++idx) { const int ai = idx >> 2, m = idx & 3; const int row = row0 + ai * HALF + m * 16; float s = 0.f, ss = 0.f;
                u32x4 rc[2] = {rq[0], rq[1]};
                if (idx + 1 < 8) { const int nrow = row0 + ((idx + 1) >> 2) * HALF + ((idx + 1) & 3) * 16;
#pragma unroll
                    for (int bj = 0; bj < 2; ++bj) rq[bj] = *(const u32x4*)(resid + (size_t)nrow * ldc + col0 + bj * HALF); }
#pragma unroll
                for (int bj = 0; bj < 2; ++bj) { const size_t off = (size_t)row * ldc + col0 + bj * HALF; const u32x4 r = rc[bj];
                    f32x4 v0 = acc[ai][bj][m][0], v1 = acc[ai][bj][m][1];
                    v0[0] += alpha * pg_bflo(r.x); v0[1] += alpha * pg_bfhi(r.x); v0[2] += alpha * pg_bflo(r.y); v0[3] += alpha * pg_bfhi(r.y);
                    v1[0] += alpha * pg_bflo(r.z); v1[1] += alpha * pg_bfhi(r.z); v1[2] += alpha * pg_bflo(r.w); v1[3] += alpha * pg_bfhi(r.w);
                    s += ((v0[0] + v0[1]) + (v0[2] + v0[3])) + ((v1[0] + v1[1]) + (v1[2] + v1[3]));
                    ss += ((v0[0] * v0[0] + v0[1] * v0[1]) + (v0[2] * v0[2] + v0[3] * v0[3])) + ((v1[0] * v1[0] + v1[1] * v1[1]) + (v1[2] * v1[2] + v1[3] * v1[3]));
                    u32x4 w; w.x = cvt_pk_bf16(v0[0], v0[1]); w.y = cvt_pk_bf16(v0[2], v0[3]); w.z = cvt_pk_bf16(v1[0], v1[1]); w.w = cvt_pk_bf16(v1[2], v1[3]);
                    *(u32x4*)(VB + off) = w; }
                s += __shfl_xor(s, 16); s += __shfl_xor(s, 32); ss += __shfl_xor(ss, 16); ss += __shfl_xor(ss, 32);
                if (fq == 0) { float* sp = ST + (((size_t)u.pn * mrows + row) * 4 + wc) * 2; sp[0] = s; sp[1] = ss; } }
    }
};
struct EpiCombine {
    static constexpr bool PERM = true, AFTER_DRAIN = false;
    const bf16_t* h2; const bf16_t* pw; bf16_t* xb; float* outf; float* C1; int ldc;
    __device__ __forceinline__ void operator()(const f32x4 (&acc)[2][2][4][2], const Unit& u, int wr, int wc, int fr, int fq) const {
        if (u.dst) { store_chunk(acc, u, C1, ldc, wr, wc, fr, fq); return; }
        const int row0 = u.pm * BM + wr * 64 + fr, col0 = u.pn * BM + wc * 32 + 8 * fq;
        u32x4 hq[2], pq[2];
#pragma unroll
        for (int bj = 0; bj < 2; ++bj) { const size_t o0 = (size_t)row0 * ldc + col0 + bj * HALF; hq[bj] = *(const u32x4*)(h2 + o0); pq[bj] = *(const u32x4*)(pw + o0); }
#pragma unroll
        for (int idx = 0; idx < 8; ++idx) { const int ai = idx >> 2, m = idx & 3; const int row = row0 + ai * HALF + m * 16;
                u32x4 hc[2] = {hq[0], hq[1]}, pc[2] = {pq[0], pq[1]};
                if (idx + 1 < 8) { const int nrow = row0 + ((idx + 1) >> 2) * HALF + ((idx + 1) & 3) * 16;
#pragma unroll
                    for (int bj = 0; bj < 2; ++bj) { const size_t on = (size_t)nrow * ldc + col0 + bj * HALF; hq[bj] = *(const u32x4*)(h2 + on); pq[bj] = *(const u32x4*)(pw + on); } }
#pragma unroll
                for (int bj = 0; bj < 2; ++bj) { const size_t off = (size_t)row * ldc + col0 + bj * HALF; const u32x4 hh = hc[bj], pp = pc[bj];
                    const f32x4 a0 = acc[ai][bj][m][0], a1 = acc[ai][bj][m][1]; f32x4 o0, o1;
                    o0[0] = pg_bflo(hh.x) + pg_bflo(pp.x) / (1.f + __expf(-a0[0])); o0[1] = pg_bfhi(hh.x) + pg_bfhi(pp.x) / (1.f + __expf(-a0[1]));
                    o0[2] = pg_bflo(hh.y) + pg_bflo(pp.y) / (1.f + __expf(-a0[2])); o0[3] = pg_bfhi(hh.y) + pg_bfhi(pp.y) / (1.f + __expf(-a0[3]));
                    o1[0] = pg_bflo(hh.z) + pg_bflo(pp.z) / (1.f + __expf(-a1[0])); o1[1] = pg_bfhi(hh.z) + pg_bfhi(pp.z) / (1.f + __expf(-a1[1]));
                    o1[2] = pg_bflo(hh.w) + pg_bflo(pp.w) / (1.f + __expf(-a1[2])); o1[3] = pg_bfhi(hh.w) + pg_bfhi(pp.w) / (1.f + __expf(-a1[3]));
                    u32x4 w; w.x = cvt_pk_bf16(o0[0], o0[1]); w.y = cvt_pk_bf16(o0[2], o0[3]); w.z = cvt_pk_bf16(o1[0], o1[1]); w.w = cvt_pk_bf16(o1[2], o1[3]);
                    *(u32x4*)(xb + off) = w;
                    if (outf) { *(f32x4*)(outf + off) = o0; *(f32x4*)(outf + off + 4) = o1; } } }
    }
};
template <int ACT> struct EpiBf16 {
    static constexpr bool PERM = true, AFTER_DRAIN = false;
    bf16_t* O; int ldc; float* gates; int gate_pn;
    __device__ __forceinline__ void operator()(const f32x4 (&acc)[2][2][4][2], const Unit& u, int wr, int wc, int fr, int fq) const {
        const int row0 = u.pm * BM + wr * 64 + fr; const int col0 = u.pn * BM + wc * 32 + 8 * fq;
        const bool gt = (gates != nullptr) && (u.pn == gate_pn) && (wc == 0) && (fq < 2);
#pragma unroll
        for (int ai = 0; ai < 2; ++ai)
#pragma unroll
            for (int m = 0; m < 4; ++m) { const int row = row0 + ai * HALF + m * 16; bf16_t* rowp = O + (size_t)row * ldc + col0;
#pragma unroll
                for (int bj = 0; bj < 2; ++bj) { f32x4 v0 = acc[ai][bj][m][0], v1 = acc[ai][bj][m][1];
                    if (ACT == 1) {
#pragma unroll
                        for (int j = 0; j < 4; ++j) { const float a = fmaxf(v0[j], 0.f), b = fmaxf(v1[j], 0.f); v0[j] = a * a; v1[j] = b * b; } }
                    u32x4 w; w.x = cvt_pk_bf16(v0[0], v0[1]); w.y = cvt_pk_bf16(v0[2], v0[3]); w.z = cvt_pk_bf16(v1[0], v1[1]); w.w = cvt_pk_bf16(v1[2], v1[3]);
                    *(u32x4*)(rowp + bj * HALF) = w; }
                if (gt) { float* gp = gates + (size_t)row * 16 + 8 * fq; *(f32x4*)gp = acc[ai][0][m][0]; *(f32x4*)(gp + 4) = acc[ai][0][m][1]; } }
    }
};

template <class Epi, class Sched, bool ALIGN_EPI = false, bool SP2 = false>
__device__ __forceinline__ void gemm_phase(PG8_LAS unsigned char* lds, const Gemm g, const Sched& S, const Epi& E, const int tid) {
    const int wid = __builtin_amdgcn_readfirstlane(tid >> 6), lane = tid & 63, wr = wid >> 2, wc = wid & 3, fr = lane & 15, fq = lane >> 4;
    const int K = g.K;
    unsigned voffA[2], voffB[2];
#pragma unroll
    for (int i = 0; i < 2; ++i) { int R, C; stage_rc(tid * 16 + i * 8192, R, C); const int Rb = Epi::PERM ? ((R & ~31) + perm32(R & 31)) : R;
        voffA[i] = (unsigned)(R * K + C) * 2u; voffB[i] = (unsigned)(Rb * K + C) * 2u; }
    const size_t kstep = (size_t)(BK * 2);
    const size_t hstep = (size_t)HALF * K * 2;
    const size_t tstep = 2 * hstep;
    const unsigned ldsw = (unsigned)wid * 1024u;
    const int aoff = lds_byte(wr * 64 + fr, fq * 8), boff = lds_byte(wc * 32 + fr, fq * 8);
#define PG8_SA(b, h) (((b) * 2 + (h)) * HTB)
#define PG8_SB(b, h) ((4 + (b) * 2 + (h)) * HTB)
#define PG8_STAGE(bufoff, gbase, voff) do { _Pragma("unroll") for (int _i = 0; _i < 2; ++_i) \
        __builtin_amdgcn_global_load_lds((const unsigned*)((const char*)(gbase) + (voff)[_i]), (PG8_LAS unsigned*)(lds + (bufoff) + ldsw + _i * 8192), 16, 0, 0); } while (0)
#define PG8_LDA(dst, b, h) do { _Pragma("unroll") for (int m = 0; m < 4; ++m) _Pragma("unroll") for (int k = 0; k < 2; ++k) dst[m][k] = *(const PG8_LAS bf16x8*)(lds + PG8_SA(b, h) + aoff + m * 2048 + k * 1024); } while (0)
#define PG8_LDB(dst, b, h) do { _Pragma("unroll") for (int n = 0; n < 2; ++n) _Pragma("unroll") for (int k = 0; k < 2; ++k) dst[n][k] = *(const PG8_LAS bf16x8*)(lds + PG8_SB(b, h) + boff + n * 2048 + k * 1024); } while (0)
#define PG8_MMA(ai, bj, At, Bt) do { __builtin_amdgcn_s_setprio(1); _Pragma("unroll") for (int m = 0; m < 4; ++m) _Pragma("unroll") for (int n = 0; n < 2; ++n) _Pragma("unroll") for (int k = 0; k < 2; ++k) \
        acc[ai][bj][m][n] = __builtin_amdgcn_mfma_f32_16x16x32_bf16(Bt[n][k], At[m][k], acc[ai][bj][m][n], 0, 0, 0); __builtin_amdgcn_s_setprio(0); } while (0)
#define PG8_WAIT_V(n) asm volatile("s_waitcnt vmcnt(" #n ")" ::: "memory")
#define PG8_WAIT_L(n) asm volatile("s_waitcnt lgkmcnt(" #n ")" ::: "memory")
#define PG8_BAR __builtin_amdgcn_s_barrier()
#define PG8_SCHED __builtin_amdgcn_sched_barrier(0)
    Unit cur, nxt; int ui = 0;
    if (!S.next(0, cur)) return;
    f32x4 acc[2][2][4][2];
#pragma unroll
    for (int a = 0; a < 2; ++a)
#pragma unroll
        for (int b = 0; b < 2; ++b)
#pragma unroll
            for (int m = 0; m < 4; ++m)
#pragma unroll
                for (int n = 0; n < 2; ++n) acc[a][b][m][n] = (f32x4){0.f, 0.f, 0.f, 0.f};
    bf16x8 At[4][2], B0[2][2], B1[2][2];
    const char* cA = (const char*)g.A + (size_t)cur.pm * tstep + (size_t)cur.kt0 * kstep; const char* cB = (const char*)g.Bt + (size_t)cur.pn * tstep + (size_t)cur.kt0 * kstep;
    S.a_ready(cur);
    if constexpr (SP2) {
        PG8_STAGE(PG8_SB(0, 0), cB, voffB); PG8_STAGE(PG8_SB(0, 1), cB + hstep, voffB); PG8_STAGE(PG8_SA(0, 0), cA, voffA); PG8_STAGE(PG8_SA(0, 1), cA + hstep, voffA);
        if (wr == 1) PG8_BAR;
        PG8_WAIT_V(2); PG8_BAR;
        PG8_STAGE(PG8_SB(1, 0), cB + kstep, voffB); PG8_STAGE(PG8_SA(1, 0), cA + kstep, voffA); PG8_STAGE(PG8_SB(1, 1), cB + hstep + kstep, voffB);
        PG8_WAIT_V(6); PG8_BAR;
    } else {
        PG8_STAGE(PG8_SB(0, 0), cB, voffB); PG8_STAGE(PG8_SA(0, 0), cA, voffA); PG8_STAGE(PG8_SB(0, 1), cB + hstep, voffB); PG8_STAGE(PG8_SA(0, 1), cA + hstep, voffA);
        if (wr == 1) PG8_BAR;
        PG8_WAIT_V(4); PG8_BAR;
        PG8_STAGE(PG8_SB(1, 0), cB + kstep, voffB); PG8_STAGE(PG8_SA(1, 0), cA + kstep, voffA); PG8_STAGE(PG8_SB(1, 1), cB + hstep + kstep, voffB);
        PG8_WAIT_V(6); PG8_BAR;
    }
    for (;;) {
        const bool has_next = S.next(ui + 1, nxt);
        const char* nA = has_next ? (const char*)g.A + (size_t)nxt.pm * tstep + (size_t)nxt.kt0 * kstep : cA; const char* nB = has_next ? (const char*)g.Bt + (size_t)nxt.pn * tstep + (size_t)nxt.kt0 * kstep : cB;
        const int nt = cur.nkt;
        for (int t = 0; t < nt; t += 2) {
            const bool last = (t == nt - 2);
            const char* a1 = cA + (size_t)(t + 1) * kstep;
            const char* a2 = last ? nA : cA + (size_t)(t + 2) * kstep; const char* b2 = last ? nB : cB + (size_t)(t + 2) * kstep;
            const char* a3 = a2 + kstep; const char* b3 = b2 + kstep;
            if (last && has_next) S.a_ready(nxt);
            if constexpr (SP2) {
            PG8_LDB(B0, 0, 0); PG8_LDB(B1, 0, 1); PG8_SCHED; PG8_LDA(At, 0, 0); PG8_STAGE(PG8_SA(1, 1), a1 + hstep, voffA);
            PG8_WAIT_V(8); PG8_WAIT_L(0); PG8_BAR; PG8_MMA(0, 0, At, B0); PG8_MMA(0, 1, At, B1); PG8_BAR; PG8_SCHED;
            PG8_LDA(At, 0, 1); PG8_STAGE(PG8_SB(0, 0), b2, voffB); PG8_STAGE(PG8_SB(0, 1), b2 + hstep, voffB); PG8_STAGE(PG8_SA(0, 0), a2, voffA);
            PG8_WAIT_V(8); PG8_WAIT_L(0); PG8_BAR; PG8_MMA(1, 0, At, B0); PG8_MMA(1, 1, At, B1); PG8_BAR; PG8_SCHED;
            PG8_LDB(B0, 1, 0); PG8_LDB(B1, 1, 1); PG8_SCHED; PG8_LDA(At, 1, 0); PG8_STAGE(PG8_SA(0, 1), a2 + hstep, voffA);
            PG8_WAIT_V(8); PG8_WAIT_L(0); PG8_BAR; PG8_MMA(0, 0, At, B0); PG8_MMA(0, 1, At, B1); PG8_BAR; PG8_SCHED;
            PG8_LDA(At, 1, 1); PG8_STAGE(PG8_SB(1, 0), b3, voffB); PG8_STAGE(PG8_SB(1, 1), b3 + hstep, voffB); PG8_STAGE(PG8_SA(1, 0), a3, voffA);
            PG8_WAIT_V(8); PG8_WAIT_L(0); PG8_BAR; PG8_MMA(1, 0, At, B0); PG8_MMA(1, 1, At, B1); PG8_BAR; PG8_SCHED;
            } else {
            PG8_LDB(B0, 0, 0); PG8_SCHED; PG8_LDA(At, 0, 0); PG8_STAGE(PG8_SA(1, 1), a1 + hstep, voffA);
            PG8_WAIT_L(8); PG8_BAR; PG8_WAIT_L(0); PG8_MMA(0, 0, At, B0); PG8_BAR; PG8_SCHED;
            PG8_LDB(B1, 0, 1); PG8_STAGE(PG8_SB(0, 0), b2, voffB);
            PG8_BAR; PG8_WAIT_L(0); PG8_MMA(0, 1, At, B1); PG8_BAR;
            PG8_LDA(At, 0, 1); PG8_STAGE(PG8_SA(0, 0), a2, voffA);
            PG8_BAR; PG8_WAIT_L(0); PG8_MMA(1, 0, At, B0); PG8_BAR; PG8_SCHED;
            PG8_STAGE(PG8_SB(0, 1), b2 + hstep, voffB);
            PG8_WAIT_V(6); PG8_BAR; PG8_MMA(1, 1, At, B1); PG8_BAR;
            PG8_LDB(B0, 1, 0); PG8_SCHED; PG8_LDA(At, 1, 0); PG8_STAGE(PG8_SA(0, 1), a2 + hstep, voffA);
            PG8_WAIT_L(8); PG8_BAR; PG8_WAIT_L(0); PG8_MMA(0, 0, At, B0); PG8_BAR; PG8_SCHED;
            PG8_LDB(B1, 1, 1); PG8_STAGE(PG8_SB(1, 0), b3, voffB);
            PG8_BAR; PG8_WAIT_L(0); PG8_MMA(0, 1, At, B1); PG8_BAR;
            PG8_LDA(At, 1, 1); PG8_STAGE(PG8_SA(1, 0), a3, voffA);
            PG8_BAR; PG8_WAIT_L(0); PG8_MMA(1, 0, At, B0); PG8_BAR; PG8_SCHED;
            PG8_STAGE(PG8_SB(1, 1), b3 + hstep, voffB);
            PG8_WAIT_V(6); PG8_BAR; PG8_MMA(1, 1, At, B1); PG8_BAR;
            }
        }
        if constexpr (ALIGN_EPI) { if (wr == 0) PG8_BAR; }
        E(acc, cur, wr, wc, fr, fq); S.done(cur);
        if (!has_next) break;
#pragma unroll
        for (int a = 0; a < 2; ++a)
#pragma unroll
            for (int b = 0; b < 2; ++b)
#pragma unroll
                for (int m = 0; m < 4; ++m)
#pragma unroll
                    for (int n = 0; n < 2; ++n) acc[a][b][m][n] = (f32x4){0.f, 0.f, 0.f, 0.f};
        cur = nxt; cA = nA; cB = nB; ++ui;
        if constexpr (ALIGN_EPI) { if (wr == 1) PG8_BAR; }
    }
    PG8_WAIT_V(0);
    if constexpr (!ALIGN_EPI) { if (wr == 0) PG8_BAR; }
    PG8_BAR;
#undef PG8_SA
#undef PG8_SB
#undef PG8_STAGE
#undef PG8_LDA
#undef PG8_LDB
#undef PG8_MMA
#undef PG8_WAIT_V
#undef PG8_WAIT_L
#undef PG8_BAR
#undef PG8_SCHED
}
}

constexpr int NWAVES = 8, NTHR = 512;
constexpr int D = 2048, FF = 8192, PLE = 256;
constexpr int TP = 2048, BP = 4, TS = 4, BS = 128;
constexpr int MP = BP * TP, MS = BS * TS, M = MP + MS;
constexpr int NPROJ = 6160, NPROJ_PAD = 6400;
constexpr int NH = 8;
constexpr float LN_EPS = 1e-5f, RMS_EPS = 1e-6f;
constexpr float DN_ALPHA = 1.41421356237f;

constexpr size_t MiB = 1u << 20;
constexpr size_t WS_CTL = 0;
constexpr size_t WS_WINE = 1 * MiB;
constexpr size_t WS_WOUTE = WS_WINE + 25 * MiB;
constexpr size_t WS_WINO = WS_WOUTE + 8 * MiB;
constexpr size_t WS_WOUTO = WS_WINO + 25 * MiB;
constexpr size_t WS_WUP = WS_WOUTO + 8 * MiB;
constexpr size_t WS_WDOWN = WS_WUP + 64 * MiB;
constexpr size_t WS_WPLE = WS_WDOWN + 64 * MiB;
constexpr size_t WS_WGATE = WS_WPLE + 2 * MiB;
constexpr size_t WS_XB = WS_WGATE + 16 * MiB;
constexpr size_t WS_MIX = WS_XB + 34 * MiB;
constexpr size_t WS_H = WS_MIX + 34 * MiB;
constexpr size_t WS_H2 = WS_H + 34 * MiB;
constexpr size_t WS_PW = WS_H2 + 34 * MiB;
constexpr size_t WS_PB = WS_PW + 34 * MiB;
constexpr size_t WS_GATES = WS_PB + 9 * MiB;
constexpr size_t WS_PROJ = WS_GATES + 1 * MiB;
constexpr size_t WS_PART0 = WS_PROJ + 136 * MiB;
constexpr size_t WS_PART1 = WS_PART0 + 68 * MiB;
constexpr size_t WS_LRUW = WS_PART1 + 68 * MiB;
constexpr size_t WS_END = WS_LRUW + 1 * MiB;
constexpr size_t WS_DG = WS_PART0;
constexpr size_t WS_DB = WS_PART0 + 32 * MiB;
constexpr size_t WS_DS = WS_PART0 + 64 * MiB;
constexpr size_t WS_DQ = WS_PART0 + 96 * MiB;
constexpr size_t WS_DO = WS_PART0 + 112 * MiB;
constexpr size_t WS_DD = WS_PART0 + 128 * MiB;
constexpr size_t WS_DF = WS_PART0 + 129 * MiB;
constexpr size_t WS_MC = WS_PART0;
constexpr size_t WS_MN = WS_PART0 + 64 * MiB;
constexpr size_t WS_MM = WS_PART0 + 65 * MiB;
constexpr size_t WS_LRU_HL = WS_H;
constexpr size_t WS_LRU_P = WS_H + 16 * MiB;
constexpr size_t WS_LRU_END = WS_H + 32 * MiB;

constexpr size_t O_Y = 0;
constexpr size_t O_CONVP = (size_t)M * D;
constexpr size_t O_DELTAP = O_CONVP + (size_t)BP * 3 * 4096;
constexpr size_t O_LRUP = O_DELTAP + (size_t)BP * 8 * 128 * 128;
constexpr size_t O_MCP = O_LRUP + (size_t)BP * 1024;
constexpr size_t O_MNP = O_MCP + (size_t)BP * 8 * 256 * 128;
constexpr size_t O_MMP = O_MNP + (size_t)BP * 8 * 128;
constexpr size_t O_CONVS = O_MMP + (size_t)BP * 8;
constexpr size_t O_DELTAS = O_CONVS + (size_t)BS * 3 * 4096;
constexpr size_t O_LRUS = O_DELTAS + (size_t)BS * 8 * 128 * 128;
constexpr size_t O_MCS = O_LRUS + (size_t)BS * 1024;
constexpr size_t O_MNS = O_MCS + (size_t)BS * 8 * 256 * 128;
constexpr size_t O_MMS = O_MNS + (size_t)BS * 8 * 128;
constexpr size_t O_END = O_MMS + (size_t)BS * 8;

constexpr int LDS_BYTES = 147456;
constexpr int LDS_CTL_OFF = 131072;

#define LAS __attribute__((address_space(3)))
typedef unsigned short bf16;
typedef unsigned v4u __attribute__((ext_vector_type(4)));
typedef unsigned v2u __attribute__((ext_vector_type(2)));
typedef float f32x4 __attribute__((ext_vector_type(4)));
#define LDS_WAIT() asm volatile("s_waitcnt lgkmcnt(0)" ::: "memory")
#define LDS_BARRIER() do { asm volatile("s_waitcnt lgkmcnt(0)" ::: "memory"); __builtin_amdgcn_s_barrier(); asm volatile("" ::: "memory"); } while (0)
__device__ __forceinline__ unsigned f2bf(float f) { unsigned u = __builtin_bit_cast(unsigned, f); return (u + 0x7fffu + ((u >> 16) & 1u)) >> 16; }
__device__ __forceinline__ unsigned pk2(float lo, float hi) { return f2bf(lo) | (f2bf(hi) << 16); }
__device__ __forceinline__ float bf2f(unsigned short b) { return __builtin_bit_cast(float, ((unsigned)b) << 16); }
__device__ __forceinline__ float bflo(unsigned w) { return __builtin_bit_cast(float, w << 16); }
__device__ __forceinline__ float bfhi(unsigned w) { return __builtin_bit_cast(float, w & 0xffff0000u); }
__device__ __forceinline__ float fexp(float x) { return __builtin_amdgcn_exp2f(x * 1.4426950408889634f); }
__device__ __forceinline__ float sigm(float x) { return __builtin_amdgcn_rcpf(1.f + fexp(-x)); }
__device__ __forceinline__ float siluf(float x) { return x * sigm(x); }
__device__ __forceinline__ float softplusf(float x) { return fmaxf(x, 0.f) + log1pf(expf(-fabsf(x))); }
__device__ __forceinline__ float logsigf(float x) { return -softplusf(-x); }
__device__ __forceinline__ float neg_expm1(float y) {
    const float ser = -y * (1.f + y * (0.5f + y * (0.16666667f + y * (0.041666668f + y * (0.008333334f + y * 0.0013888889f)))));
    return (y > -0.25f) ? ser : 1.f - fexp(y);
}
__device__ __forceinline__ float gelu_tanh(float x) { const float u = 0.7978845608028654f * (x + 0.044715f * x * x * x); return x * sigm(2.f * u); }
__device__ __forceinline__ float wave_sum(float v) {
#pragma unroll
    for (int o = 1; o < 64; o <<= 1) v += __shfl_xor(v, o);
    return v;
}

__device__ __forceinline__ float wave_incl_sum(float v, int lane) {
#pragma unroll
    for (int o = 1; o < 64; o <<= 1) { const float u = __shfl_up(v, o); if (lane >= o) v += u; }
    return v;
}
__device__ __forceinline__ float wave_incl_max(float v, int lane) {
#pragma unroll
    for (int o = 1; o < 64; o <<= 1) { const float u = __shfl_up(v, o); if (lane >= o) v = fmaxf(v, u); }
    return v;
}
__device__ __forceinline__ float wave_max(float v) {
#pragma unroll
    for (int o = 1; o < 64; o <<= 1) v = fmaxf(v, __shfl_xor(v, o));
    return v;
}
#define XB_TMO      128
#define XB_XCNT(j)  (256  + 64 * (j))
#define XB_XSUB(j)  (1280 + 64 * (j))
#define XB_XGEN(j)  (2304 + 64 * (j))
#define XB_TOP      3328
#define XB_TOPGEN   3392
#define XCD_BAR_WORDS 3456
#define XB_SPIN_CAP (1u << 22)
__device__ __forceinline__ unsigned xb_ld(unsigned* p)              { return __hip_atomic_load(p, __ATOMIC_RELAXED, __HIP_MEMORY_SCOPE_AGENT); }
__device__ __forceinline__ unsigned xb_add(unsigned* p, unsigned v) { return __hip_atomic_fetch_add(p, v, __ATOMIC_RELAXED, __HIP_MEMORY_SCOPE_AGENT); }
__device__ __forceinline__ unsigned xb_xcc_id() { return (unsigned)__builtin_amdgcn_s_getreg((3 << 11) | 20) & 0xFu; }
#define XB_SPIN(cond, bar) do { unsigned _sp = 0; while (cond) { __builtin_amdgcn_s_sleep(1); \
    if ((++_sp & 255u) == 0u) { if (xb_ld(&(bar)[XB_TMO])) break; if (_sp > XB_SPIN_CAP) { atomicAdd(&(bar)[XB_TMO], 1u); break; } } } } while (0)
struct XcdBarrier { unsigned* bar; unsigned x; volatile LAS unsigned* st; };
__device__ __forceinline__ XcdBarrier xcd_barrier_post(unsigned* bar, volatile LAS unsigned* st) {
    XcdBarrier b; b.bar = bar; b.x = xb_xcc_id(); b.st = st;
    if (threadIdx.x == 0) (void)xb_add(&bar[XB_XCNT(b.x)], 1u);
    return b;
}
__device__ __forceinline__ void xcd_barrier_complete(unsigned* bar, unsigned x, unsigned& nloc, unsigned& nx) {
    const unsigned G = gridDim.x * gridDim.y * gridDim.z;
    unsigned sum, cnt, mine, sp = 0u;
    for (;;) {
        sum = 0u; cnt = 0u; mine = 0u;
#pragma unroll
        for (unsigned j = 0; j < 16; ++j) { const unsigned c = xb_ld(&bar[XB_XCNT(j)]); sum += c; cnt += (c > 0u) ? 1u : 0u; mine = (j == x) ? c : mine; }
        if (sum == G) break;
        __builtin_amdgcn_s_sleep(1);
        if ((++sp & 255u) == 0u) { if (xb_ld(&bar[XB_TMO])) break; if (sp > XB_SPIN_CAP) { atomicAdd(&bar[XB_TMO], 1u); break; } }
    }
    nloc = mine > 0u ? mine : 1u; nx = cnt > 0u ? cnt : 1u;
}
__device__ __forceinline__ void xcd_barrier(const XcdBarrier& b) {
    asm volatile("s_waitcnt vmcnt(0)" ::: "memory");
    __syncthreads();
    if (threadIdx.x == 0) {
        unsigned* bar = b.bar;
        __builtin_amdgcn_s_waitcnt(0);
        unsigned nloc = b.st[0], nx = b.st[1];
        if (nloc == 0u) { xcd_barrier_complete(bar, b.x, nloc, nx); b.st[0] = nloc; b.st[1] = nx; }
        const unsigned old = xb_add(&bar[XB_XSUB(b.x)], 1u);
        const unsigned gen = old / nloc;
        if (old + 1u == (gen + 1u) * nloc) {
            __builtin_amdgcn_fence(__ATOMIC_RELEASE, "agent");
            asm volatile("s_waitcnt vmcnt(0)" ::: "memory");
            const unsigned og = xb_add(&bar[XB_TOP], 1u);
            const unsigned tg = og / nx;
            if (og + 1u == (tg + 1u) * nx) xb_add(&bar[XB_TOPGEN], 1u);
            else XB_SPIN(xb_ld(&bar[XB_TOPGEN]) == tg, bar);
            __builtin_amdgcn_fence(__ATOMIC_ACQUIRE, "agent");
            xb_add(&bar[XB_XGEN(b.x)], 1u);
            asm volatile("s_waitcnt vmcnt(0)" ::: "memory");
        } else {
            XB_SPIN(xb_ld(&bar[XB_XGEN(b.x)]) == gen, bar);
            __builtin_amdgcn_fence(__ATOMIC_ACQUIRE, "agent");
            asm volatile("s_waitcnt vmcnt(0)" ::: "memory");
        }
    }
    __syncthreads();
}

struct Args { const float* in[35]; float* out; unsigned char* ws; int ph_lo, ph_hi; };
typedef const __attribute__((address_space(4))) Args* ArgsP;
enum { I_XP = 0, I_XS, I_PP, I_PS, I_SCONV, I_SDELTA, I_SLRU, I_SMC, I_SMN, I_SMM, I_WINE, I_WCONV, I_BCONV, I_ALOG, I_DTB, I_DNORM, I_LWR, I_LBR, I_LWI, I_LBI, I_LLAM, I_WOUTE,
       I_WINO, I_BIG, I_BFG, I_MNORM, I_WOUTO, I_LN1G, I_LN1B, I_LN2G, I_LN2B, I_WUP, I_WDOWN, I_WPLE, I_WGATE };

struct TDesc { const float* W; bf16* WT; int K, N, Npad, item; };
__device__ __forceinline__ void t_load(const TDesc& d, int lane, f32x4 (&v)[8]) {
    const int nblk = d.Npad / 32, kb = d.item / nblk, nb = d.item % nblk, k0 = 64 * kb, n0 = 32 * nb;
    const int r = lane >> 3, c4 = lane & 7; const bool ok = (n0 + 4 * c4) < d.N;
#pragma unroll
    for (int i = 0; i < 8; ++i) v[i] = ok ? __builtin_nontemporal_load((const f32x4*)(d.W + (size_t)(k0 + 8 * i + r) * d.N + n0 + 4 * c4)) : (f32x4){0.f, 0.f, 0.f, 0.f};
}
__device__ __forceinline__ void t_finish(const TDesc& d, LAS float* scr, int lane, const f32x4 (&v)[8]) {
    const int nblk = d.Npad / 32, kb = d.item / nblk, nb = d.item % nblk, k0 = 64 * kb, n0 = 32 * nb;
    const int r = lane >> 3, c4 = lane & 7;
#pragma unroll
    for (int i = 0; i < 8; ++i) { LAS float* q = scr + (8 * i + r) * 33 + 4 * c4; q[0] = v[i].x; q[1] = v[i].y; q[2] = v[i].z; q[3] = v[i].w; }
    LDS_WAIT(); asm volatile("" ::: "memory");
    const int c = lane & 7;
#pragma unroll
    for (int j = 0; j < 4; ++j) { const int n = (lane >> 3) + 8 * j; const LAS float* s = scr + (8 * c) * 33 + n;
        v4u o; o.x = pk2(s[0 * 33], s[1 * 33]); o.y = pk2(s[2 * 33], s[3 * 33]); o.z = pk2(s[4 * 33], s[5 * 33]); o.w = pk2(s[6 * 33], s[7 * 33]);
        *(v4u*)(d.WT + (size_t)(n0 + n) * d.K + k0 + 8 * c) = o; }
    LDS_WAIT(); asm volatile("" ::: "memory");
}
__device__ __forceinline__ void p0_transpose_item(const float* W, int K, int N, int Npad, bf16* WT, LAS float* scr, int item, int lane) {
    const TDesc d{W, WT, K, N, Npad, item}; f32x4 v[8]; t_load(d, lane, v); t_finish(d, scr, lane, v);
}
template <int N> __device__ __forceinline__ void row_to_bf16(const float* src, bf16* dst, int lane) {
    f32x4 v[N / 256];
#pragma unroll
    for (int j = 0; j < N / 256; ++j) v[j] = __builtin_nontemporal_load((const f32x4*)(src + j * 256 + lane * 4));
#pragma unroll
    for (int j = 0; j < N / 256; ++j) { v2u o; o.x = pk2(v[j].x, v[j].y); o.y = pk2(v[j].z, v[j].w); *(v2u*)(dst + j * 256 + lane * 4) = o; }
}
namespace cv { constexpr int I_IN = (D / 64) * (NPROJ_PAD / 32), I_SQ = (D / 64) * (D / 32), I_UP = (D / 64) * (FF / 32), I_DN = (FF / 64) * (D / 32), I_PL = (PLE / 64) * (D / 32);
               constexpr int N_FIRST = I_IN + I_PL + 128, N_REST = I_IN + 2 * I_SQ + 2 * I_UP + 2 * I_DN + I_PL + 2 * I_SQ;
               constexpr int R_IN0 = 6200;
               constexpr int R_G1 = I_SQ + I_UP + I_SQ + I_IN + I_SQ + I_PL + I_SQ;
               constexpr int R_IN1 = R_G1 + I_UP;
               constexpr int R_SCAN = R_IN1 - 6200;
               constexpr int R_UP0 = R_IN1 + I_DN;
               static_assert(R_UP0 + I_DN == N_REST && R_SCAN > R_G1 && R_SCAN > R_IN0, "conversion ranges"); }
__device__ __forceinline__ void convert_first_item(ArgsP a, LAS float* scr, int r, int lane) {
    unsigned char* ws = a->ws;
    if (r < cv::I_IN) { p0_transpose_item(a->in[I_WINE], D, NPROJ, NPROJ_PAD, (bf16*)(ws + WS_WINE), scr, r, lane); return; } r -= cv::I_IN;
    if (r < cv::I_PL) { p0_transpose_item(a->in[I_WPLE], PLE, D, D, (bf16*)(ws + WS_WPLE), scr, r, lane); return; } r -= cv::I_PL;
    { const int mat = r / 64, blk = (r / 8) & 7; p0_transpose_item(a->in[mat == 0 ? I_LWR : I_LWI] + (size_t)blk * 16384, 128, 128, 128, (bf16*)(ws + WS_LRUW) + (size_t)(mat * 8 + blk) * 16384, scr, r % 8, lane); }
}
__device__ __forceinline__ TDesc decode_rest(ArgsP a, int r) {
    using namespace cv; unsigned char* ws = a->ws;
    if (r < I_SQ) return TDesc{a->in[I_WOUTE], (bf16*)(ws + WS_WOUTE), D, D, D, r}; r -= I_SQ;
    if (r < I_UP) return TDesc{a->in[I_WUP], (bf16*)(ws + WS_WUP), D, FF, FF, r}; r -= I_UP;
    if (r < I_SQ) return TDesc{a->in[I_WGATE], (bf16*)(ws + WS_WGATE), D, D, D, r}; r -= I_SQ;
    if (r < I_IN) return TDesc{a->in[I_WINO], (bf16*)(ws + WS_WINO), D, NPROJ, NPROJ_PAD, r}; r -= I_IN;
    if (r < I_SQ) return TDesc{a->in[I_WOUTO], (bf16*)(ws + WS_WOUTO), D, D, D, r}; r -= I_SQ;
    if (r < I_PL) return TDesc{a->in[I_WPLE] + (size_t)PLE * D, (bf16*)(ws + WS_WPLE) + (size_t)PLE * D, PLE, D, D, r}; r -= I_PL;
    if (r < I_SQ) return TDesc{a->in[I_WGATE] + (size_t)D * D, (bf16*)(ws + WS_WGATE) + (size_t)D * D, D, D, D, r}; r -= I_SQ;
    if (r < I_UP) return TDesc{a->in[I_WUP] + (size_t)D * FF, (bf16*)(ws + WS_WUP) + (size_t)D * FF, D, FF, FF, r}; r -= I_UP;
    if (r < I_DN) return TDesc{a->in[I_WDOWN], (bf16*)(ws + WS_WDOWN), FF, D, D, r}; r -= I_DN;
    return TDesc{a->in[I_WDOWN] + (size_t)D * FF, (bf16*)(ws + WS_WDOWN) + (size_t)D * FF, FF, D, D, r};
}
__device__ __forceinline__ void convert_range(ArgsP a, LAS float* scr, int first, int last, int widx, int nw, int lane) {
    int it = first + widx;
    TDesc dA, dB; f32x4 vA[8], vB[8];
    if (it < last) { dA = decode_rest(a, it); t_load(dA, lane, vA);
#pragma unroll 1
        for (;;) {
            const int itB = it + nw; const bool hasB = itB < last;
            if (hasB) { dB = decode_rest(a, itB); t_load(dB, lane, vB); }
            t_finish(dA, scr, lane, vA);
            if (!hasB) break;
            it = itB + nw; const bool hasA = it < last;
            if (hasA) { dA = decode_rest(a, it); t_load(dA, lane, vA); }
            t_finish(dB, scr, lane, vB);
            if (!hasA) break;
        } }
}
__device__ __forceinline__ void phase_convert(ArgsP a, LAS unsigned char* lds, int gw, int NGW, int wave, int lane) {
    unsigned char* ws = a->ws;
    LAS float* scr = (LAS float*)(lds + wave * 16384);
    for (int it = gw; it < cv::N_FIRST; it += NGW) convert_first_item(a, scr, it, lane);
    bf16* xb = (bf16*)(ws + WS_XB);
    for (int m = gw; m < M; m += NGW) {
        const float* src = m < MP ? a->in[I_XP] + (size_t)m * D : a->in[I_XS] + (size_t)(m - MP) * D;
        row_to_bf16<D>(src, xb + (size_t)m * D, lane);
    }
    bf16* pb = (bf16*)(ws + WS_PB);
    for (int r = gw; r < 2 * M; r += NGW) {
        const int l = r / M, m = r % M;
        const float* src = m < MP ? a->in[I_PP] + ((size_t)l * MP + m) * PLE : a->in[I_PS] + ((size_t)l * MS + (m - MP)) * PLE;
        row_to_bf16<PLE>(src, pb + (size_t)r * PLE, lane);
    }
}

__device__ __forceinline__ float conv_in(const bf16* proj, int row0, int tq, int ch, const float* cstate) {
    if (tq >= 0) return bf2f(proj[(size_t)(row0 + tq) * NPROJ_PAD + ch]);
    return cstate ? cstate[(3 + tq) * 4096 + ch] : 0.f;
}
__device__ __forceinline__ float conv4(const bf16* proj, int row0, int t, int ch, const float* cstate, const float* wconv, const float* bconv) {
    float acc = bconv[ch];
#pragma unroll
    for (int j = 0; j < 4; ++j) acc += wconv[j * 4096 + ch] * conv_in(proj, row0, t - 3 + j, ch, cstate);
    return acc;
}

__device__ __forceinline__ void delta_rec_item(ArgsP a, LAS unsigned char* lds, int row0, int T, int h, const float* cstate, const float* S0, float* Sout, const int tid) {
    const int lane = tid & 63, wave = tid >> 6, c = tid & 127, r = tid >> 7;
    const bf16* proj = (const bf16*)(a->ws + WS_PROJ); const float* gates = (const float*)(a->ws + WS_GATES); bf16* mix = (bf16*)(a->ws + WS_MIX);
    const float* wconv = a->in[I_WCONV]; const float* bconv = a->in[I_BCONV];
    LAS float* act = (LAS float*)lds;
    LAS float* nrm = act + 4 * 384;
    LAS float* gb = nrm + 8;
    LAS float* red = gb + 8;
    LAS float* red2 = red + 512;
    LAS float* obuf = red2 + 512;
    float s[32];
#pragma unroll
    for (int i = 0; i < 32; ++i) s[i] = S0 ? S0[(size_t)(32 * r + i) * 128 + c] : 0.f;
    const float aexp = fexp(a->in[I_ALOG][h]), dtb = a->in[I_DTB][h];
#pragma unroll 1
    for (int t0 = 0; t0 < T; t0 += 4) {
#pragma unroll
        for (int j = 0; j < 3; ++j) { const int idx = tid + 512 * j, tok = idx / 384, chl = idx % 384, part = chl >> 7, i = chl & 127;
            const int ch = part * 1024 + h * 128 + i;
            act[tok * 384 + chl] = siluf(conv4(proj, row0, t0 + tok, ch, cstate, wconv, bconv)); }
        LDS_BARRIER();
        { const int tok = wave >> 1, part = wave & 1; const float x0 = act[tok * 384 + part * 128 + lane], x1 = act[tok * 384 + part * 128 + 64 + lane];
          const float ss = wave_sum(x0 * x0 + x1 * x1); if (lane == 0) nrm[tok * 2 + part] = rsqrtf(ss + 1e-6f) * (part == 0 ? 0.08838834764831845f : 1.f); }
        if (tid < 4) { const int row = row0 + t0 + tid; const float g = -aexp * softplusf(gates[(size_t)row * 16 + h] + dtb); gb[tid * 2] = fexp(g); gb[tid * 2 + 1] = sigm(gates[(size_t)row * 16 + 8 + h]); }
        LDS_BARRIER();
#pragma unroll 1
        for (int tok = 0; tok < 4; ++tok) {
            const float eg = gb[tok * 2], beta = gb[tok * 2 + 1], nq = nrm[tok * 2], nk = nrm[tok * 2 + 1];
            const LAS float* qv = act + tok * 384 + 32 * r; const LAS float* kv = qv + 128;
            float ks = 0.f;
#pragma unroll
            for (int i = 0; i < 32; ++i) ks += kv[i] * s[i];
            red[r * 128 + c] = ks * nk;
            LDS_BARRIER();
            const float kS = red[c] + red[128 + c] + red[256 + c] + red[384 + c];
            const float vnew = beta * (act[tok * 384 + 256 + c] - eg * kS);
            float os = 0.f;
#pragma unroll
            for (int i = 0; i < 32; ++i) { s[i] = eg * s[i] + (kv[i] * nk) * vnew; os += qv[i] * s[i]; }
            red2[r * 128 + c] = os * nq;
            LDS_BARRIER();
            if (r == 0) obuf[tok * 128 + c] = red2[c] + red2[128 + c] + red2[256 + c] + red2[384 + c];
        }
        LDS_BARRIER();
        if (wave < 4) { const int tok = wave, row = row0 + t0 + tok; const float o0 = obuf[tok * 128 + lane], o1 = obuf[tok * 128 + 64 + lane];
            const float rstd = rsqrtf(wave_sum(o0 * o0 + o1 * o1) * (1.f / 128.f) + RMS_EPS);
            const float* nw = a->in[I_DNORM];
            const float z0 = bf2f(proj[(size_t)row * NPROJ_PAD + 4096 + h * 128 + lane]), z1 = bf2f(proj[(size_t)row * NPROJ_PAD + 4096 + h * 128 + 64 + lane]);
            mix[(size_t)row * D + h * 128 + lane] = (bf16)f2bf(o0 * rstd * nw[lane] * siluf(z0));
            mix[(size_t)row * D + h * 128 + 64 + lane] = (bf16)f2bf(o1 * rstd * nw[64 + lane] * siluf(z1)); }
        LDS_BARRIER();
    }
#pragma unroll
    for (int i = 0; i < 32; ++i) Sout[(size_t)(32 * r + i) * 128 + c] = s[i];
}

__device__ __forceinline__ void lru_rec_item(ArgsP a, LAS unsigned char* lds, int row0, int T, int n, const float* cstate, const float* h0, float* hout, const int tid) {
    const int d = tid & 127, part = tid >> 7;
    const bf16* proj = (const bf16*)(a->ws + WS_PROJ); bf16* mix = (bf16*)(a->ws + WS_MIX);
    const float* wconv = a->in[I_WCONV]; const float* bconv = a->in[I_BCONV];
    const float* wr = a->in[I_LWR] + (size_t)n * 16384; const float* wi = a->in[I_LWI] + (size_t)n * 16384;
    LAS float* xr = (LAS float*)lds;
    LAS float* red = xr + 512;
    const int chn = n * 128 + d;
    float hst = h0 ? h0[chn] : 0.f;
    const float br = a->in[I_LBR][chn], bi = a->in[I_LBI][chn], spl = softplusf(-a->in[I_LLAM][chn]);
#pragma unroll 1
    for (int t0 = 0; t0 < T; t0 += 4) {
        { const int tok = tid >> 7; xr[tok * 128 + d] = conv4(proj, row0, t0 + tok, 3072 + chn, cstate, wconv, bconv); }
        LDS_BARRIER();
        float ar[4] = {0.f, 0.f, 0.f, 0.f}, ai[4] = {0.f, 0.f, 0.f, 0.f};
#pragma unroll 16
        for (int cc = 0; cc < 32; ++cc) { const int c = part * 32 + cc; const float w1 = wr[c * 128 + d], w2 = wi[c * 128 + d];
#pragma unroll
        for (int tok = 0; tok < 4; ++tok) { const float x = xr[tok * 128 + c]; ar[tok] += x * w1; ai[tok] += x * w2; } }
#pragma unroll
        for (int tok = 0; tok < 4; ++tok) { red[((tok * 2 + 0) * 4 + part) * 128 + d] = ar[tok]; red[((tok * 2 + 1) * 4 + part) * 128 + d] = ai[tok]; }
        LDS_BARRIER();
        if (part == 0) {
    #pragma unroll 1
        for (int tok = 0; tok < 4; ++tok) {
                const int row = row0 + t0 + tok;
                float rp = br, ip = bi;
#pragma unroll
                for (int p = 0; p < 4; ++p) { rp += red[((tok * 2 + 0) * 4 + p) * 128 + d]; ip += red[((tok * 2 + 1) * 4 + p) * 128 + d]; }
                const float log_a = -8.f * sigm(rp) * spl;
                const float av = fexp(log_a);
                const float bx = sqrtf(neg_expm1(2.f * log_a)) * sigm(ip) * xr[tok * 128 + d];
                hst = av * hst + bx;
                const float gate = bf2f(proj[(size_t)row * NPROJ_PAD + 5120 + chn]);
                mix[(size_t)row * D + 1024 + chn] = (bf16)f2bf(hst * gelu_tanh(gate));
            }
        }
        LDS_BARRIER();
    }
    if (part == 0) hout[chn] = hst;
}

__device__ __forceinline__ void mlstm_rec_item(ArgsP a, LAS unsigned char* lds, int row0, int T, int h, const float* C0, const float* n0, const float* m0, float* Cout, float* nout, float* mout, const int tid) {
    const int lane = tid & 63, wave = tid >> 6, v = tid & 255, kh = tid >> 8;
    const bf16* proj = (const bf16*)(a->ws + WS_PROJ); const float* gates = (const float*)(a->ws + WS_GATES); bf16* mix = (bf16*)(a->ws + WS_MIX);
    LAS float* qs = (LAS float*)lds;
    LAS float* ks = qs + 512;
    LAS float* vs = ks + 512;
    LAS float* gs = vs + 1024;
    LAS float* red = gs + 8;
    LAS float* dred = red + 1024;
    LAS float* hbuf = dred + 4;
    float cst[64];
#pragma unroll
    for (int i = 0; i < 64; ++i) cst[i] = C0 ? C0[(size_t)v * 128 + 64 * kh + i] : 0.f;
    float nst = (tid < 128) ? (n0 ? n0[tid] : 0.f) : 0.f;
    float mst = m0 ? m0[0] : 0.f;
    const float big = a->in[I_BIG][h], bfg = a->in[I_BFG][h];
#pragma unroll 1
    for (int t0 = 0; t0 < T; t0 += 4) {
#pragma unroll
        for (int j = 0; j < 4; ++j) { const int tok = j, row = row0 + t0 + tok; const bf16* pr = proj + (size_t)row * NPROJ_PAD;
            float val;
            if (tid < 128) val = bf2f(pr[h * 128 + tid]); else if (tid < 256) val = bf2f(pr[1024 + h * 128 + (tid - 128)]) * 0.08838834764831845f; else val = bf2f(pr[2048 + h * 256 + (tid - 256)]);
            if (tid < 128) qs[tok * 128 + tid] = val; else if (tid < 256) ks[tok * 128 + tid - 128] = val; else vs[tok * 256 + tid - 256] = val; }
        if (tid < 4) { const int row = row0 + t0 + tid; gs[tid * 2] = gates[(size_t)row * 16 + h] + big; gs[tid * 2 + 1] = gates[(size_t)row * 16 + 8 + h] + bfg; }
        LDS_BARRIER();
#pragma unroll 1
        for (int tok = 0; tok < 4; ++tok) {
            const int par = tok & 1;
            const float ig = gs[tok * 2], lf = logsigf(gs[tok * 2 + 1]);
            const float mnew = fmaxf(lf + mst, ig), fp = fexp(lf + mst - mnew), ip = fexp(ig - mnew); mst = mnew;
            const float vv = vs[tok * 256 + v] * ip;
            const LAS float* kv = ks + tok * 128 + 64 * kh; const LAS float* qv = qs + tok * 128 + 64 * kh;
            float num = 0.f;
#pragma unroll
            for (int i = 0; i < 64; ++i) { cst[i] = fp * cst[i] + vv * kv[i]; num += cst[i] * qv[i]; }
            red[(par * 2 + kh) * 256 + v] = num;
            if (tid < 128) { nst = fp * nst + ip * ks[tok * 128 + tid]; const float dp = wave_sum(nst * qs[tok * 128 + tid]); if (lane == 0) dred[par * 2 + wave] = dp; }
            LDS_BARRIER();
            if (kh == 0) { const float nm = red[(par * 2) * 256 + v] + red[(par * 2 + 1) * 256 + v]; const float den = dred[par * 2] + dred[par * 2 + 1];
                hbuf[tok * 256 + v] = nm / fmaxf(fabsf(den), fexp(-mnew)); }
        }
        LDS_BARRIER();
        if (wave < 4) { const int tok = wave, row = row0 + t0 + tok; float hv[4]; float ss = 0.f;
#pragma unroll
            for (int j = 0; j < 4; ++j) { hv[j] = hbuf[tok * 256 + j * 64 + lane]; ss += hv[j] * hv[j]; }
            const float rstd = rsqrtf(wave_sum(ss) * (1.f / 256.f) + RMS_EPS);
            const float* nw = a->in[I_MNORM] + h * 256;
#pragma unroll
            for (int j = 0; j < 4; ++j) { const int vi = j * 64 + lane; const float op = bf2f(proj[(size_t)row * NPROJ_PAD + 4096 + h * 256 + vi]);
                mix[(size_t)row * D + h * 256 + vi] = (bf16)f2bf(hv[j] * rstd * nw[vi] * sigm(op)); } }
        LDS_BARRIER();
    }
#pragma unroll
    for (int i = 0; i < 64; ++i) Cout[(size_t)v * 128 + 64 * kh + i] = cst[i];
    if (tid < 128) nout[tid] = nst;
    if (tid == 0) mout[0] = mst;
}


typedef short bf16x8 __attribute__((ext_vector_type(8)));
#define MFMA32(a_, b_, c_) __builtin_amdgcn_mfma_f32_16x16x32_bf16(a_, b_, c_, 0, 0, 0)

__device__ __forceinline__ void lru_prep_item(ArgsP a, LAS unsigned char* lds, int item, const int tid) {
    const int c = item & 31, n = (item >> 5) & 7, b = item >> 8;
    const int lane = tid & 63, w = __builtin_amdgcn_readfirstlane(tid >> 6), fr = lane & 15, fq = lane >> 4;
    unsigned char* ws = a->ws;
    const bf16* proj = (const bf16*)(ws + WS_PROJ);
    LAS bf16* xa = (LAS bf16*)lds;
    LAS float* xf = (LAS float*)(lds + 17408);
    LAS float* obH = (LAS float*)(lds + 51200);
    LAS float* obP = obH + 64 * 132;
    {
        const int t = tid >> 3, sub = tid & 7, ch0 = 3072 + n * 128 + sub * 16;
        const float* wconv = a->in[I_WCONV]; const float* bconv = a->in[I_BCONV];
        float x[16];
#pragma unroll
        for (int i = 0; i < 4; ++i) { const f32x4 bb = *(const f32x4*)(bconv + ch0 + 4 * i); x[4 * i] = bb.x; x[4 * i + 1] = bb.y; x[4 * i + 2] = bb.z; x[4 * i + 3] = bb.w; }
#pragma unroll
        for (int j = 0; j < 4; ++j) { const int tt = 64 * c + t - 3 + j;
            if (tt >= 0) { const bf16* pr = proj + (size_t)(b * TP + tt) * NPROJ_PAD + ch0; const v4u u0 = *(const v4u*)pr, u1 = *(const v4u*)(pr + 8);
                const unsigned uu[8] = {u0.x, u0.y, u0.z, u0.w, u1.x, u1.y, u1.z, u1.w};
#pragma unroll
                for (int i = 0; i < 4; ++i) { const f32x4 ww = *(const f32x4*)(wconv + j * 4096 + ch0 + 4 * i);
                    x[4 * i] += ww.x * bflo(uu[2 * i]); x[4 * i + 1] += ww.y * bfhi(uu[2 * i]); x[4 * i + 2] += ww.z * bflo(uu[2 * i + 1]); x[4 * i + 3] += ww.w * bfhi(uu[2 * i + 1]); } } }
        v4u o0, o1; o0.x = pk2(x[0], x[1]); o0.y = pk2(x[2], x[3]); o0.z = pk2(x[4], x[5]); o0.w = pk2(x[6], x[7]); o1.x = pk2(x[8], x[9]); o1.y = pk2(x[10], x[11]); o1.z = pk2(x[12], x[13]); o1.w = pk2(x[14], x[15]);
        *(LAS v4u*)(xa + t * 136 + sub * 16) = o0; *(LAS v4u*)(xa + t * 136 + sub * 16 + 8) = o1;
#pragma unroll
        for (int i = 0; i < 4; ++i) *(LAS f32x4*)(xf + t * 132 + sub * 16 + 4 * i) = (f32x4){x[4 * i], x[4 * i + 1], x[4 * i + 2], x[4 * i + 3]};
    }
    LDS_BARRIER();
    const bf16* wrT = (const bf16*)(ws + WS_LRUW) + (size_t)n * 16384; const bf16* wiT = wrT + 8 * 16384;
    bf16x8 br[4], bi[4];
#pragma unroll
    for (int ks = 0; ks < 4; ++ks) { br[ks] = *(const bf16x8*)(wrT + (16 * w + fr) * 128 + 32 * ks + 8 * fq); bi[ks] = *(const bf16x8*)(wiT + (16 * w + fr) * 128 + 32 * ks + 8 * fq); }
    f32x4 accr[4], acci[4];
#pragma unroll
    for (int tb = 0; tb < 4; ++tb) { accr[tb] = (f32x4){0.f, 0.f, 0.f, 0.f}; acci[tb] = (f32x4){0.f, 0.f, 0.f, 0.f};
#pragma unroll
        for (int ks = 0; ks < 4; ++ks) { const bf16x8 af = *(const LAS bf16x8*)(xa + (16 * tb + fr) * 136 + 32 * ks + 8 * fq); accr[tb] = MFMA32(af, br[ks], accr[tb]); acci[tb] = MFMA32(af, bi[ks], acci[tb]); } }
    const int dl = 16 * w + fr, chn = n * 128 + dl;
    const float brs = a->in[I_LBR][chn], bis = a->in[I_LBI][chn], spl = softplusf(-a->in[I_LLAM][chn]);
    float Apre = 1.f, Hpre = 0.f;
#pragma unroll
    for (int tb = 0; tb < 4; ++tb) {
        float P[4], Hh[4];
#pragma unroll
        for (int j = 0; j < 4; ++j) { const int t = 16 * tb + 4 * fq + j;
            const float log_a = -8.f * sigm(accr[tb][j] + brs) * spl; const float av = fexp(log_a);
            const float bx = sqrtf(neg_expm1(2.f * log_a)) * sigm(acci[tb][j] + bis) * xf[t * 132 + dl];
            if (j == 0) { P[0] = av; Hh[0] = bx; } else { P[j] = P[j - 1] * av; Hh[j] = av * Hh[j - 1] + bx; } }
        float Ai = P[3], Hi = Hh[3];
        { const float A2 = __shfl_up(Ai, 16), H2 = __shfl_up(Hi, 16); if (fq >= 1) { Hi = Ai * H2 + Hi; Ai = A2 * Ai; } }
        { const float A2 = __shfl_up(Ai, 32), H2 = __shfl_up(Hi, 32); if (fq >= 2) { Hi = Ai * H2 + Hi; Ai = A2 * Ai; } }
        float Aex = __shfl_up(Ai, 16), Hex = __shfl_up(Hi, 16); if (fq == 0) { Aex = 1.f; Hex = 0.f; }
        const float Atb = __shfl(Ai, 48 + fr), Htb = __shfl(Hi, 48 + fr);
        const float EA = Apre * Aex, EH = Aex * Hpre + Hex;
#pragma unroll
        for (int j = 0; j < 4; ++j) { const int t = 16 * tb + 4 * fq + j; obP[t * 132 + dl] = EA * P[j]; obH[t * 132 + dl] = P[j] * EH + Hh[j]; }
        Hpre = Atb * Hpre + Htb; Apre = Apre * Atb;
    }
    if (fq == 0) { float* e = (float*)(ws + WS_LRU_END) + (size_t)item * 256; e[dl] = Apre; e[128 + dl] = Hpre; }
    LDS_BARRIER();
    {
        const int t = tid >> 3, sub = tid & 7;
        bf16* hl = (bf16*)(ws + WS_LRU_HL) + ((size_t)item * 64 + t) * 128 + sub * 16; bf16* pp = (bf16*)(ws + WS_LRU_P) + ((size_t)item * 64 + t) * 128 + sub * 16;
        const LAS float* sh = obH + t * 132 + sub * 16; const LAS float* sp = obP + t * 132 + sub * 16;
        v4u o0, o1;
        o0.x = pk2(sh[0], sh[1]); o0.y = pk2(sh[2], sh[3]); o0.z = pk2(sh[4], sh[5]); o0.w = pk2(sh[6], sh[7]); o1.x = pk2(sh[8], sh[9]); o1.y = pk2(sh[10], sh[11]); o1.z = pk2(sh[12], sh[13]); o1.w = pk2(sh[14], sh[15]);
        *(v4u*)hl = o0; *(v4u*)(hl + 8) = o1;
        o0.x = pk2(sp[0], sp[1]); o0.y = pk2(sp[2], sp[3]); o0.z = pk2(sp[4], sp[5]); o0.w = pk2(sp[6], sp[7]); o1.x = pk2(sp[8], sp[9]); o1.y = pk2(sp[10], sp[11]); o1.z = pk2(sp[12], sp[13]); o1.w = pk2(sp[14], sp[15]);
        *(v4u*)pp = o0; *(v4u*)(pp + 8) = o1;
    }
    LDS_BARRIER();
}
__device__ __forceinline__ void lru_out_item(ArgsP a, LAS unsigned char* lds, int item, const int tid) {
    const int c = item & 31, n = (item >> 5) & 7, b = item >> 8;
    unsigned char* ws = a->ws;
    LAS float* carry = (LAS float*)lds;
    if (tid < 128) { float cr = 0.f; const float* e = (const float*)(ws + WS_LRU_END) + (size_t)(item - c) * 256;
        float pv[31], hv_[31];
#pragma unroll
        for (int k = 0; k < 31; ++k) { const bool on = k < c; pv[k] = on ? e[k * 256 + tid] : 1.f; hv_[k] = on ? e[k * 256 + 128 + tid] : 0.f; }
#pragma unroll
        for (int k = 0; k < 31; ++k) cr = hv_[k] + pv[k] * cr;
        carry[tid] = cr; }
    LDS_BARRIER();
    const int t = tid >> 3, sub = tid & 7, d0 = sub * 16, row = b * TP + 64 * c + t;
    const bf16* hl = (const bf16*)(ws + WS_LRU_HL) + ((size_t)item * 64 + t) * 128 + d0; const bf16* pp = (const bf16*)(ws + WS_LRU_P) + ((size_t)item * 64 + t) * 128 + d0;
    const bf16* gp = (const bf16*)(ws + WS_PROJ) + (size_t)row * NPROJ_PAD + 5120 + n * 128 + d0;
    const v4u h0 = *(const v4u*)hl, h1 = *(const v4u*)(hl + 8), p0 = *(const v4u*)pp, p1 = *(const v4u*)(pp + 8), g0 = *(const v4u*)gp, g1 = *(const v4u*)(gp + 8);
    const unsigned hu[8] = {h0.x, h0.y, h0.z, h0.w, h1.x, h1.y, h1.z, h1.w}, pu[8] = {p0.x, p0.y, p0.z, p0.w, p1.x, p1.y, p1.z, p1.w}, gu[8] = {g0.x, g0.y, g0.z, g0.w, g1.x, g1.y, g1.z, g1.w};
    float hv[16]; unsigned ou[8];
#pragma unroll
    for (int i = 0; i < 8; ++i) { hv[2 * i] = bflo(hu[i]) + bflo(pu[i]) * carry[d0 + 2 * i]; hv[2 * i + 1] = bfhi(hu[i]) + bfhi(pu[i]) * carry[d0 + 2 * i + 1];
        ou[i] = pk2(hv[2 * i] * gelu_tanh(bflo(gu[i])), hv[2 * i + 1] * gelu_tanh(bfhi(gu[i]))); }
    bf16* mp = (bf16*)(ws + WS_MIX) + (size_t)row * D + 1024 + n * 128 + d0;
    *(v4u*)mp = (v4u){ou[0], ou[1], ou[2], ou[3]}; *(v4u*)(mp + 8) = (v4u){ou[4], ou[5], ou[6], ou[7]};
    if (c == 31 && t == 63) { float* o = a->out + O_LRUP + (size_t)b * 1024 + n * 128 + d0;
#pragma unroll
        for (int i = 0; i < 4; ++i) *(f32x4*)(o + 4 * i) = (f32x4){hv[4 * i], hv[4 * i + 1], hv[4 * i + 2], hv[4 * i + 3]}; }
    LDS_BARRIER();
}


__device__ __forceinline__ void conv16_load(const bf16* proj, int b, int tseq, int ch0, v4u (&u)[8]) {
#pragma unroll
    for (int j = 0; j < 4; ++j) { const int tt = tseq - 3 + j;
        if (tt >= 0) { const bf16* pr = proj + (size_t)(b * TP + tt) * NPROJ_PAD + ch0; u[2 * j] = *(const v4u*)pr; u[2 * j + 1] = *(const v4u*)(pr + 8); }
        else { u[2 * j] = (v4u){0u, 0u, 0u, 0u}; u[2 * j + 1] = (v4u){0u, 0u, 0u, 0u}; } }
}
__device__ __forceinline__ void conv16_compute(const v4u (&u)[8], const float* wconv, const float* bconv, int ch0, float (&x)[16]) {
#pragma unroll
    for (int i = 0; i < 4; ++i) { const f32x4 bb = *(const f32x4*)(bconv + ch0 + 4 * i); x[4 * i] = bb.x; x[4 * i + 1] = bb.y; x[4 * i + 2] = bb.z; x[4 * i + 3] = bb.w; }
#pragma unroll
    for (int j = 0; j < 4; ++j) { const unsigned uu[8] = {u[2 * j].x, u[2 * j].y, u[2 * j].z, u[2 * j].w, u[2 * j + 1].x, u[2 * j + 1].y, u[2 * j + 1].z, u[2 * j + 1].w};
#pragma unroll
        for (int i = 0; i < 4; ++i) { const f32x4 ww = *(const f32x4*)(wconv + j * 4096 + ch0 + 4 * i);
            x[4 * i] += ww.x * bflo(uu[2 * i]); x[4 * i + 1] += ww.y * bfhi(uu[2 * i]); x[4 * i + 2] += ww.z * bflo(uu[2 * i + 1]); x[4 * i + 3] += ww.w * bfhi(uu[2 * i + 1]); } }
}
__device__ __forceinline__ void conv16_compute_lds(const v4u (&u)[8], const LAS float* cw, int c0, float (&x)[16]) {
#pragma unroll
    for (int i = 0; i < 4; ++i) { const f32x4 bb = *(const LAS f32x4*)(cw + 4 * 128 + c0 + 4 * i); x[4 * i] = bb.x; x[4 * i + 1] = bb.y; x[4 * i + 2] = bb.z; x[4 * i + 3] = bb.w; }
#pragma unroll
    for (int j = 0; j < 4; ++j) { const unsigned uu[8] = {u[2 * j].x, u[2 * j].y, u[2 * j].z, u[2 * j].w, u[2 * j + 1].x, u[2 * j + 1].y, u[2 * j + 1].z, u[2 * j + 1].w};
#pragma unroll
        for (int i = 0; i < 4; ++i) { const f32x4 ww = *(const LAS f32x4*)(cw + j * 128 + c0 + 4 * i);
            x[4 * i] += ww.x * bflo(uu[2 * i]); x[4 * i + 1] += ww.y * bfhi(uu[2 * i]); x[4 * i + 2] += ww.z * bflo(uu[2 * i + 1]); x[4 * i + 3] += ww.w * bfhi(uu[2 * i + 1]); } }
}
__device__ __forceinline__ void conv16_prompt(const bf16* proj, const float* wconv, const float* bconv, int b, int tseq, int ch0, float (&x)[16]) {
    v4u u[8]; conv16_load(proj, b, tseq, ch0, u); conv16_compute(u, wconv, bconv, ch0, x);
}
__device__ __forceinline__ void st16_bf16(LAS bf16* p, const float (&x)[16]) {
    v4u o0, o1; o0.x = pk2(x[0], x[1]); o0.y = pk2(x[2], x[3]); o0.z = pk2(x[4], x[5]); o0.w = pk2(x[6], x[7]); o1.x = pk2(x[8], x[9]); o1.y = pk2(x[10], x[11]); o1.z = pk2(x[12], x[13]); o1.w = pk2(x[14], x[15]);
    *(LAS v4u*)p = o0; *(LAS v4u*)(p + 8) = o1;
}
__device__ __forceinline__ v2u pack4(const f32x4 v) { v2u o; o.x = pk2(v.x, v.y); o.y = pk2(v.z, v.w); return o; }
__device__ __forceinline__ bf16x8 zero8() { return (bf16x8){0, 0, 0, 0, 0, 0, 0, 0}; }

__device__ __forceinline__ void delta_prep_item(ArgsP a, LAS unsigned char* lds, int item, const int tid) {
    const int c = item & 31, h = (item >> 5) & 7, b = item >> 8;
    const int lane = tid & 63, w = __builtin_amdgcn_readfirstlane(tid >> 6), fr = lane & 15, fq = lane >> 4;
    unsigned char* ws = a->ws;
    const bf16* proj = (const bf16*)(ws + WS_PROJ);
    LAS bf16* Kn = (LAS bf16*)lds;
    LAS bf16* Qn = (LAS bf16*)(lds + 17408);
    LAS bf16* KdT = (LAS bf16*)(lds + 34816);
    LAS bf16* RX = (LAS bf16*)(lds + 53248);
    LAS bf16* Mm = (LAS bf16*)(lds + 90112);
    LAS bf16* QKd = (LAS bf16*)(lds + 99328);
    LAS bf16* Td = (LAS bf16*)(lds + 108544);
    LAS bf16* RT = (LAS bf16*)(lds + 111616) + w * 768;
    LAS float* gl = (LAS float*)(lds + 123904);
    LAS float* gcs = gl + 64;
    LAS float* bet = gcs + 64;
    const int t = tid >> 3, sub = tid & 7;
    float gc_t, glast_t, beta_t;
    {
        const float* gt = (const float*)(ws + WS_GATES) + (size_t)(b * TP + 64 * c + lane) * 16;
        const float gv = -fexp(a->in[I_ALOG][h]) * softplusf(gt[h] + a->in[I_DTB][h]), bv = sigm(gt[8 + h]);
        const float gcv = wave_incl_sum(gv, lane);
        if (w == 0) { gl[lane] = gv; gcs[lane] = gcv; bet[lane] = bv; }
        gc_t = __shfl(gcv, t); glast_t = __shfl(gcv, 63); beta_t = __shfl(bv, t);
    }
    {
        const float* wconv = a->in[I_WCONV]; const float* bconv = a->in[I_BCONV];
        const float gc = gc_t, glast = glast_t, beta = beta_t;
        const float ec = fexp(gc), ed = fexp(glast - gc);
        float x[16], y[16];
        conv16_prompt(proj, wconv, bconv, b, 64 * c + t, 1024 + h * 128 + sub * 16, x);
        float ss = 0.f;
#pragma unroll
        for (int i = 0; i < 16; ++i) { x[i] = siluf(x[i]); ss += x[i] * x[i]; }
        ss += __shfl_xor(ss, 1); ss += __shfl_xor(ss, 2); ss += __shfl_xor(ss, 4);
        const float rk = rsqrtf(ss + 1e-6f);
#pragma unroll
        for (int i = 0; i < 16; ++i) x[i] *= rk;
        st16_bf16(Kn + t * 136 + sub * 16, x);
#pragma unroll
        for (int i = 0; i < 16; ++i) KdT[(sub * 16 + i) * 72 + t] = (bf16)f2bf(x[i] * ed);
#pragma unroll
        for (int i = 0; i < 16; ++i) y[i] = x[i] * (beta * ec);
        st16_bf16(RX + t * 264 + 128 + sub * 16, y);
        conv16_prompt(proj, wconv, bconv, b, 64 * c + t, h * 128 + sub * 16, x);
        ss = 0.f;
#pragma unroll
        for (int i = 0; i < 16; ++i) { x[i] = siluf(x[i]); ss += x[i] * x[i]; }
        ss += __shfl_xor(ss, 1); ss += __shfl_xor(ss, 2); ss += __shfl_xor(ss, 4);
        const float rq = rsqrtf(ss + 1e-6f) * 0.08838834764831845f;
#pragma unroll
        for (int i = 0; i < 16; ++i) x[i] *= rq;
        st16_bf16(Qn + t * 136 + sub * 16, x);
        conv16_prompt(proj, wconv, bconv, b, 64 * c + t, 2048 + h * 128 + sub * 16, x);
#pragma unroll
        for (int i = 0; i < 16; ++i) x[i] = siluf(x[i]) * beta;
        st16_bf16(RX + t * 264 + sub * 16, x);
    }
    LDS_BARRIER();
    {
        const int ib = w >> 1;
#pragma unroll
        for (int jj = 0; jj < 2; ++jj) { const int jb = 2 * (w & 1) + jj;
            f32x4 ak = (f32x4){0.f, 0.f, 0.f, 0.f}, aq = (f32x4){0.f, 0.f, 0.f, 0.f};
            if (jb <= ib) {
#pragma unroll
                for (int ks = 0; ks < 4; ++ks) { const bf16x8 bfr = *(const LAS bf16x8*)(Kn + (16 * jb + fr) * 136 + 32 * ks + 8 * fq);
                    const bf16x8 afk = *(const LAS bf16x8*)(Kn + (16 * ib + fr) * 136 + 32 * ks + 8 * fq), afq = *(const LAS bf16x8*)(Qn + (16 * ib + fr) * 136 + 32 * ks + 8 * fq);
                    ak = MFMA32(afk, bfr, ak); aq = MFMA32(afq, bfr, aq); } }
            const int col = 16 * jb + fr; const float gcc = gcs[col];
#pragma unroll
            for (int j = 0; j < 4; ++j) { const int row = 16 * ib + 4 * fq + j; const float dec = (row >= col) ? fexp(gcs[row] - gcc) : 0.f;
                Mm[row * 72 + col] = (bf16)f2bf(row > col ? -bet[row] * ak[j] * dec : 0.f);
                QKd[row * 72 + col] = (bf16)f2bf(aq[j] * dec); }
        }
    }
    LDS_BARRIER();
    if (w == 0) { const int blk = lane >> 4, col = lane & 15; float xi[16];
#pragma unroll
        for (int i = 0; i < 16; ++i) { float acc = (i == col) ? 1.f : 0.f; const LAS bf16* mr = Mm + (16 * blk + i) * 72 + 16 * blk;
#pragma unroll
            for (int j = 0; j < i; ++j) acc += bf2f(mr[j]) * xi[j];
            xi[i] = acc; }
#pragma unroll
        for (int i = 0; i < 16; ++i) Td[(blk * 16 + i) * 24 + col] = (bf16)f2bf(xi[i]); }
    f32x4 rhs[2][4];
#pragma unroll
    for (int cbl = 0; cbl < 2; ++cbl)
#pragma unroll
        for (int bb = 0; bb < 4; ++bb)
#pragma unroll
            for (int j = 0; j < 4; ++j) rhs[cbl][bb][j] = bf2f(RX[(16 * bb + 4 * fq + j) * 264 + 32 * w + 16 * cbl + fr]);
    LDS_BARRIER();
#pragma unroll
    for (int cbl = 0; cbl < 2; ++cbl) { const int cb = 2 * w + cbl;
#pragma unroll
        for (int bb = 0; bb < 4; ++bb) {
            f32x4 acc = rhs[cbl][bb];
#pragma unroll
            for (int ks = 0; ks < 2; ++ks) { if (32 * ks < 16 * bb) { const bool ok = (32 * ks + 8 * fq) < 16 * bb;
                const bf16x8 af = ok ? *(const LAS bf16x8*)(Mm + (16 * bb + fr) * 72 + 32 * ks + 8 * fq) : zero8();
                const bf16x8 bf_ = ok ? *(const LAS bf16x8*)(RX + (16 * cb + fr) * 72 + 32 * ks + 8 * fq) : zero8();
                acc = MFMA32(af, bf_, acc); } }
            *(LAS v2u*)(RT + (16 * cbl + fr) * 24 + 4 * fq) = pack4(acc);
            asm volatile("s_waitcnt lgkmcnt(0)" ::: "memory");
            const bool ok2 = fq < 2;
            const bf16x8 af2 = ok2 ? *(const LAS bf16x8*)(Td + (bb * 16 + fr) * 24 + 8 * fq) : zero8();
            const bf16x8 bf2 = ok2 ? *(const LAS bf16x8*)(RT + (16 * cbl + fr) * 24 + 8 * fq) : zero8();
            const f32x4 xb4 = MFMA32(af2, bf2, ((f32x4){0.f, 0.f, 0.f, 0.f}));
            *(LAS v2u*)(RX + (16 * cb + fr) * 72 + 16 * bb + 4 * fq) = pack4(xb4);
            asm volatile("s_waitcnt lgkmcnt(0)" ::: "memory");
        }
    }
    LDS_BARRIER();
    {
        v4u* gout = (v4u*)(ws + WS_DG) + ((size_t)item * 8 + w) * 4 * 64 + lane;
        bf16x8 kb[2];
#pragma unroll
        for (int kt = 0; kt < 2; ++kt) kb[kt] = *(const LAS bf16x8*)(KdT + (16 * w + fr) * 72 + 32 * kt + 8 * fq);
#pragma unroll
        for (int ks = 0; ks < 4; ++ks) { f32x4 g0 = (f32x4){0.f, 0.f, 0.f, 0.f}, g1 = (f32x4){0.f, 0.f, 0.f, 0.f};
#pragma unroll
            for (int kt = 0; kt < 2; ++kt) { const bf16x8 a0 = *(const LAS bf16x8*)(RX + (128 + 32 * ks + fr) * 72 + 32 * kt + 8 * fq), a1 = *(const LAS bf16x8*)(RX + (128 + 32 * ks + 16 + fr) * 72 + 32 * kt + 8 * fq);
                g0 = MFMA32(a0, kb[kt], g0); g1 = MFMA32(a1, kb[kt], g1); }
            const v2u p0 = pack4(-g0), p1 = pack4(-g1); gout[ks * 64] = (v4u){p0.x, p0.y, p1.x, p1.y}; }
        v2u* bout = (v2u*)(ws + WS_DB) + ((size_t)item * 64 + w) * 64 + lane;
#pragma unroll
        for (int s2 = 0; s2 < 8; ++s2) { f32x4 bc = (f32x4){0.f, 0.f, 0.f, 0.f};
#pragma unroll
            for (int kt = 0; kt < 2; ++kt) { const bf16x8 ub = *(const LAS bf16x8*)(RX + (16 * s2 + fr) * 72 + 32 * kt + 8 * fq); bc = MFMA32(kb[kt], ub, bc); }
            bout[(size_t)s2 * 8 * 64] = pack4(bc); }
    }
    {
        const int tb = w >> 1, half = w & 1; const float ect = fexp(gcs[16 * tb + fr]);
        bf16x8 qk[2];
#pragma unroll
        for (int kt = 0; kt < 2; ++kt) qk[kt] = *(const LAS bf16x8*)(QKd + (16 * tb + fr) * 72 + 32 * kt + 8 * fq);
        v4u* qout = (v4u*)(ws + WS_DQ) + ((size_t)item * 4 + tb) * 4 * 64 + lane;
#pragma unroll
        for (int kk = 0; kk < 2; ++kk) { const int ks = 2 * half + kk; v2u pk[2];
#pragma unroll
            for (int hf = 0; hf < 2; ++hf) { const int db = 2 * ks + hf; f32x4 acc = (f32x4){0.f, 0.f, 0.f, 0.f};
#pragma unroll
                for (int kt = 0; kt < 2; ++kt) { const bf16x8 wa = *(const LAS bf16x8*)(RX + (128 + 16 * db + fr) * 72 + 32 * kt + 8 * fq); acc = MFMA32(wa, qk[kt], acc); }
                const v2u qn4 = *(const LAS v2u*)(Qn + (16 * tb + fr) * 136 + 16 * db + 4 * fq);
                f32x4 qp; qp.x = bflo(qn4.x) * ect - acc.x; qp.y = bfhi(qn4.x) * ect - acc.y; qp.z = bflo(qn4.y) * ect - acc.z; qp.w = bfhi(qn4.y) * ect - acc.w;
                pk[hf] = pack4(qp); }
            qout[ks * 64] = (v4u){pk[0].x, pk[0].y, pk[1].x, pk[1].y}; }
        v2u* oout = (v2u*)(ws + WS_DO) + ((size_t)item * 4 + tb) * 8 * 64 + lane;
#pragma unroll
        for (int ss = 0; ss < 4; ++ss) { const int s2 = 4 * half + ss; f32x4 acc = (f32x4){0.f, 0.f, 0.f, 0.f};
#pragma unroll
            for (int kt = 0; kt < 2; ++kt) { const bf16x8 ua = *(const LAS bf16x8*)(RX + (16 * s2 + fr) * 72 + 32 * kt + 8 * fq); acc = MFMA32(ua, qk[kt], acc); }
            oout[s2 * 64] = pack4(acc); }
    }
    if (tid == 0) ((float*)(ws + WS_DD))[item] = fexp(gcs[63]);
    LDS_BARRIER();
}

__device__ __forceinline__ void delta_scan_wave(ArgsP a, int chain, int s, const int lane) {
    unsigned char* ws = a->ws;
    const int fr = lane & 15, fq = lane >> 4;
    f32x4 S[8]; bf16x8 Sb[4];
#pragma unroll
    for (int i = 0; i < 8; ++i) S[i] = (f32x4){0.f, 0.f, 0.f, 0.f};
#pragma unroll
    for (int i = 0; i < 4; ++i) Sb[i] = zero8();
    const bf16x8* gbase = (const bf16x8*)(ws + WS_DG) + (size_t)chain * 32 * 2048 + lane;
    bf16x8 G[8][4];
#pragma unroll
    for (int rb = 0; rb < 8; ++rb)
#pragma unroll
        for (int ks = 0; ks < 4; ++ks) G[rb][ks] = gbase[(rb * 4 + ks) * 64];
#pragma unroll 1
    for (int c = 0; c < 32; ++c) {
        const int item = chain * 32 + c;
        const float d = ((const float*)(ws + WS_DD))[item];
        bf16x8* sout = (bf16x8*)(ws + WS_DS) + ((size_t)item * 8 + s) * 4 * 64 + lane;
#pragma unroll
        for (int ks = 0; ks < 4; ++ks) sout[ks * 64] = Sb[ks];
        const v2u* bin = (const v2u*)(ws + WS_DB) + ((size_t)item * 8 + s) * 8 * 64 + lane;
#pragma unroll
        for (int rb = 0; rb < 8; ++rb) { const v2u bc = bin[rb * 64]; S[rb].x = d * S[rb].x + bflo(bc.x); S[rb].y = d * S[rb].y + bfhi(bc.x); S[rb].z = d * S[rb].z + bflo(bc.y); S[rb].w = d * S[rb].w + bfhi(bc.y); }
        const bf16x8* gnext = gbase + (size_t)(c + 1 < 32 ? c + 1 : c) * 2048;
#pragma unroll
        for (int rb = 0; rb < 8; ++rb) {
#pragma unroll
            for (int ks = 0; ks < 4; ++ks) S[rb] = MFMA32(G[rb][ks], Sb[ks], S[rb]);
#pragma unroll
            for (int ks = 0; ks < 4; ++ks) G[rb][ks] = gnext[(rb * 4 + ks) * 64];
        }
#pragma unroll
        for (int ks = 0; ks < 4; ++ks) { const v2u lo = pack4(S[2 * ks]), hi = pack4(S[2 * ks + 1]); const v4u u = (v4u){lo.x, lo.y, hi.x, hi.y}; Sb[ks] = __builtin_bit_cast(bf16x8, u); }
    }
    f32x4* so = (f32x4*)(ws + WS_DF) + ((size_t)(chain * 8 + s) * 8) * 64 + lane;
#pragma unroll
    for (int rb = 0; rb < 8; ++rb) so[rb * 64] = S[rb];
}

__device__ __forceinline__ void delta_out_wave(ArgsP a, int item, int tb, const int lane) {
    unsigned char* ws = a->ws;
    const int c = item & 31, h = (item >> 5) & 7, b = item >> 8, fr = lane & 15, fq = lane >> 4;
    bf16x8 qf[4];
    const bf16x8* qin = (const bf16x8*)(ws + WS_DQ) + ((size_t)item * 4 + tb) * 4 * 64 + lane;
#pragma unroll
    for (int ks = 0; ks < 4; ++ks) qf[ks] = qin[ks * 64];
    const v2u* oin = (const v2u*)(ws + WS_DO) + ((size_t)item * 4 + tb) * 8 * 64 + lane;
    const bf16x8* sin = (const bf16x8*)(ws + WS_DS) + (size_t)item * 8 * 4 * 64 + lane;
    f32x4 o[8]; float ss = 0.f;
    v2u olv[8]; bf16x8 sfr[4][4];
#pragma unroll
    for (int s = 0; s < 8; ++s) olv[s] = oin[s * 64];
#pragma unroll
    for (int s = 0; s < 4; ++s)
#pragma unroll
        for (int ks = 0; ks < 4; ++ks) sfr[s][ks] = sin[(s * 4 + ks) * 64];
    const int row_ = b * TP + 64 * c + 16 * tb + fr;
    v2u zv[8];
#pragma unroll
    for (int s = 0; s < 8; ++s) zv[s] = *(const v2u*)((const bf16*)(ws + WS_PROJ) + (size_t)row_ * NPROJ_PAD + 4096 + h * 128 + 4 * fq + 16 * s);
#pragma unroll
    for (int grp = 0; grp < 2; ++grp) {
#pragma unroll
        for (int s4 = 0; s4 < 4; ++s4) { const int s = 4 * grp + s4; const v2u ol = olv[s]; o[s] = (f32x4){bflo(ol.x), bfhi(ol.x), bflo(ol.y), bfhi(ol.y)};
#pragma unroll
            for (int ks = 0; ks < 4; ++ks) o[s] = MFMA32(sfr[s4][ks], qf[ks], o[s]);
            ss += (o[s].x * o[s].x + o[s].y * o[s].y) + (o[s].z * o[s].z + o[s].w * o[s].w); }
        if (grp == 0) {
#pragma unroll
            for (int s4 = 0; s4 < 4; ++s4)
#pragma unroll
                for (int ks = 0; ks < 4; ++ks) sfr[s4][ks] = sin[((4 + s4) * 4 + ks) * 64]; }
    }
    ss += __shfl_xor(ss, 16); ss += __shfl_xor(ss, 32);
    const float rstd = rsqrtf(ss * (1.f / 128.f) + RMS_EPS);
    const int row = b * TP + 64 * c + 16 * tb + fr;
    const bf16* zp = (const bf16*)(ws + WS_PROJ) + (size_t)row * NPROJ_PAD + 4096 + h * 128 + 4 * fq;
    bf16* mp = (bf16*)(ws + WS_MIX) + (size_t)row * D + h * 128 + 4 * fq;
    const float* nw = a->in[I_DNORM] + 4 * fq;
#pragma unroll
    for (int s = 0; s < 8; ++s) { const v2u z = zv[s]; const f32x4 n4 = *(const f32x4*)(nw + 16 * s);
        f32x4 y; y.x = o[s].x * rstd * n4.x * siluf(bflo(z.x)); y.y = o[s].y * rstd * n4.y * siluf(bfhi(z.x)); y.z = o[s].z * rstd * n4.z * siluf(bflo(z.y)); y.w = o[s].w * rstd * n4.w * siluf(bfhi(z.y));
        *(v2u*)(mp + 16 * s) = pack4(y); }
}


__device__ __forceinline__ void mlstm_scan_item(ArgsP a, LAS unsigned char* lds, int chain, int vs, const int tid) {
    const int lane = tid & 63, w = __builtin_amdgcn_readfirstlane(tid >> 6), fr = lane & 15, fq = lane >> 4;
    const int b = chain >> 3, h = chain & 7, row0 = b * TP;
    unsigned char* ws = a->ws;
    const bf16* proj = (const bf16*)(ws + WS_PROJ); const float* gates = (const float*)(ws + WS_GATES);
    LAS bf16* KT = (LAS bf16*)lds;
    LAS bf16* VT = (LAS bf16*)(lds + 36864);
    LAS float* wls = (LAS float*)(lds + 46080);
    LAS float* gendA = (LAS float*)(lds + 46592);
    LAS float* blastA = gendA + 2048;
    LAS float* mxA = blastA + 32;
    const float big = a->in[I_BIG][h], bfg = a->in[I_BFG][h];
    {
        float lf4[4], ig4[4];
#pragma unroll
        for (int i = 0; i < 4; ++i) { const float* gp = gates + (size_t)(row0 + 64 * (w + 8 * i) + lane) * 16 + h; ig4[i] = gp[0] + big; lf4[i] = logsigf(gp[8] + bfg); }
#pragma unroll
        for (int i = 0; i < 4; ++i) { const float bcum = wave_incl_sum(lf4[i], lane), blast = __shfl(bcum, 63), gend = blast - bcum + ig4[i]; const float mx = wave_max(gend);
            gendA[(w + 8 * i) * 64 + lane] = gend; if (lane == 0) { blastA[w + 8 * i] = blast; mxA[w + 8 * i] = mx; } }
    }
    LDS_BARRIER();
    const bf16* kptr = proj + (size_t)(row0 + lane) * NPROJ_PAD + 1024 + h * 128 + 16 * w;
    const bf16* vptr = proj + (size_t)(row0 + lane) * NPROJ_PAD + 2048 + h * 256 + 32 * vs + 8 * (w & 3);
    f32x4 acc[2]; acc[0] = (f32x4){0.f, 0.f, 0.f, 0.f}; acc[1] = acc[0];
    float nst = 0.f, m = 0.f;
    v4u kq[2][2], vq[2];
#define ML_LOAD(set, c_) do { const size_t ro = (size_t)(c_) * 64 * NPROJ_PAD; kq[set][0] = *(const v4u*)(kptr + ro); kq[set][1] = *(const v4u*)(kptr + ro + 8); \
        if (w < 4) vq[set] = *(const v4u*)(vptr + ro); } while (0)
#define ML_STEP(set, c_) do { const int item = chain * 32 + (c_); \
        const float blast = blastA[(c_)], gend = gendA[(c_) * 64 + lane]; \
        const float mnew = fmaxf(blast + m, mxA[(c_)]), sc = fexp(blast + m - mnew), wv = fexp(gend - mnew) * 0.08838834764831845f; \
        LAS bf16* kt = KT + (set) * 9216; LAS bf16* vt = VT + (set) * 2304; \
        _Pragma("unroll") for (int i = 0; i < 2; ++i) { const unsigned uu[4] = {kq[set][i].x, kq[set][i].y, kq[set][i].z, kq[set][i].w}; const int kr = 8 * (2 * w + i); \
            _Pragma("unroll") for (int e = 0; e < 4; ++e) { kt[(kr + 2 * e) * 72 + lane] = (bf16)(uu[e] & 0xffffu); kt[(kr + 2 * e + 1) * 72 + lane] = (bf16)(uu[e] >> 16); } } \
        if (w < 4) { const unsigned uu[4] = {vq[set].x, vq[set].y, vq[set].z, vq[set].w}; \
            _Pragma("unroll") for (int e = 0; e < 4; ++e) { vt[(8 * w + 2 * e) * 72 + lane] = (bf16)f2bf(bflo(uu[e]) * wv); vt[(8 * w + 2 * e + 1) * 72 + lane] = (bf16)f2bf(bfhi(uu[e]) * wv); } } \
        if (w == 0) wls[(set) * 64 + lane] = wv; \
        if ((c_) + 2 < 32) ML_LOAD(set, (c_) + 2); \
        if (vs == 0 && tid == 0) ((float*)(ws + WS_MM))[item] = m; \
        LDS_BARRIER(); \
        _Pragma("unroll") for (int vb = 0; vb < 2; ++vb) { *(v2u*)((bf16*)(ws + WS_MC) + ((size_t)item * 256 + 32 * vs + 16 * vb + fr) * 128 + 16 * w + 4 * fq) = pack4(acc[vb]); } \
        if (vs == 0 && tid < 128) { ((float*)(ws + WS_MN))[(size_t)item * 128 + tid] = nst; float sn = 0.f; \
            _Pragma("unroll") for (int s8 = 0; s8 < 8; ++s8) { const v4u kk = *(const LAS v4u*)(kt + tid * 72 + 8 * s8); const LAS float* wl = wls + (set) * 64 + 8 * s8; \
                sn += bflo(kk.x) * wl[0] + bfhi(kk.x) * wl[1] + bflo(kk.y) * wl[2] + bfhi(kk.y) * wl[3] + bflo(kk.z) * wl[4] + bfhi(kk.z) * wl[5] + bflo(kk.w) * wl[6] + bfhi(kk.w) * wl[7]; } \
            nst = sc * nst + sn; } \
        _Pragma("unroll") for (int vb = 0; vb < 2; ++vb) { acc[vb] = acc[vb] * sc; \
            _Pragma("unroll") for (int kt2 = 0; kt2 < 2; ++kt2) { const bf16x8 af = *(const LAS bf16x8*)(kt + (16 * w + fr) * 72 + 32 * kt2 + 8 * fq), bfv = *(const LAS bf16x8*)(vt + (16 * vb + fr) * 72 + 32 * kt2 + 8 * fq); \
                acc[vb] = MFMA32(af, bfv, acc[vb]); } } \
        m = mnew; } while (0)
    ML_LOAD(0, 0); ML_LOAD(1, 1);
#pragma unroll 1
    for (int c2 = 0; c2 < 32; c2 += 2) { ML_STEP(0, c2); ML_STEP(1, c2 + 1); }
#undef ML_LOAD
#undef ML_STEP
#pragma unroll
    for (int vb = 0; vb < 2; ++vb) *(f32x4*)(a->out + O_MCP + ((size_t)chain * 256 + 32 * vs + 16 * vb + fr) * 128 + 16 * w + 4 * fq) = acc[vb];
    if (vs == 0) { if (tid < 128) a->out[O_MNP + (size_t)chain * 128 + tid] = nst; if (tid == 0) a->out[O_MMP + chain] = m; }
    LDS_BARRIER();
}

__device__ __forceinline__ void mlstm_out_item(ArgsP a, LAS unsigned char* lds, int item, const int tid) {
    const int c = item & 31, h = (item >> 5) & 7, b = item >> 8, row0 = b * TP + 64 * c;
    const int lane = tid & 63, w = __builtin_amdgcn_readfirstlane(tid >> 6), fr = lane & 15, fq = lane >> 4;
    unsigned char* ws = a->ws;
    const bf16* proj = (const bf16*)(ws + WS_PROJ); const float* gates = (const float*)(ws + WS_GATES);
    LAS bf16* VT = (LAS bf16*)lds;
    LAS float* ssq = (LAS float*)(lds + 36864);
    const int tb = w & 3, half = w >> 2, t = 16 * tb + fr;
    v4u vu[4];
#pragma unroll
    for (int i = 0; i < 4; ++i) vu[i] = *(const v4u*)(proj + (size_t)(row0 + lane) * NPROJ_PAD + 2048 + h * 256 + 8 * (w + 8 * i));
    v4u qu[4]; f32x4 nv[4][2];
#pragma unroll
    for (int ks = 0; ks < 4; ++ks) { qu[ks] = *(const v4u*)(proj + (size_t)(row0 + t) * NPROJ_PAD + h * 128 + 32 * ks + 8 * fq);
        const float* np = (const float*)(ws + WS_MN) + (size_t)item * 128 + 32 * ks + 8 * fq; nv[ks][0] = *(const f32x4*)np; nv[ks][1] = *(const f32x4*)(np + 4); }
    v4u kfr[4][4];
#pragma unroll
    for (int sb = 0; sb < 4; ++sb) if (sb <= tb) {
#pragma unroll
        for (int ks = 0; ks < 4; ++ks) kfr[sb][ks] = *(const v4u*)(proj + (size_t)(row0 + 16 * sb + fr) * NPROJ_PAD + 1024 + h * 128 + 32 * ks + 8 * fq); }
    const float mc = ((const float*)(ws + WS_MM))[item];
    float av, Mt, et, em;
    { const float ig = gates[(size_t)(row0 + lane) * 16 + h] + a->in[I_BIG][h], lf = logsigf(gates[(size_t)(row0 + lane) * 16 + 8 + h] + a->in[I_BFG][h]);
      const float bcum = wave_incl_sum(lf, lane); av = ig - bcum; Mt = fmaxf(mc, wave_incl_max(av, lane)); et = fexp(mc - Mt); em = fexp(-(bcum + Mt)); }
#pragma unroll
    for (int i = 0; i < 4; ++i) { const unsigned uu[4] = {vu[i].x, vu[i].y, vu[i].z, vu[i].w}; const int vr = 8 * (w + 8 * i);
#pragma unroll
        for (int e = 0; e < 4; ++e) { VT[(vr + 2 * e) * 72 + lane] = (bf16)(uu[e] & 0xffffu); VT[(vr + 2 * e + 1) * 72 + lane] = (bf16)(uu[e] >> 16); } }
    bf16x8 qf[4]; float qn = 0.f;
#pragma unroll
    for (int ks = 0; ks < 4; ++ks) { const v4u u = qu[ks]; qf[ks] = __builtin_bit_cast(bf16x8, u); const f32x4 n0 = nv[ks][0], n1 = nv[ks][1];
        qn += bflo(u.x) * n0.x + bfhi(u.x) * n0.y + bflo(u.y) * n0.z + bfhi(u.y) * n0.w + bflo(u.z) * n1.x + bfhi(u.z) * n1.y + bflo(u.w) * n1.z + bfhi(u.w) * n1.w; }
    qn += __shfl_xor(qn, 16); qn += __shfl_xor(qn, 32);
    const float Mtt = __shfl(Mt, t), ett = __shfl(et, t), emt = __shfl(em, t);
    const bf16* cs = (const bf16*)(ws + WS_MC) + (size_t)item * 256 * 128;
    v2u smp[4]; float rowsum = 0.f;
#pragma unroll
    for (int sb = 0; sb < 4; ++sb) { smp[sb] = (v2u){0u, 0u};
        if (sb <= tb) { f32x4 qk = (f32x4){0.f, 0.f, 0.f, 0.f};
#pragma unroll
            for (int ks = 0; ks < 4; ++ks) qk = MFMA32(__builtin_bit_cast(bf16x8, kfr[sb][ks]), qf[ks], qk);
            f32x4 sm;
#pragma unroll
            for (int j = 0; j < 4; ++j) { const int s = 16 * sb + 4 * fq + j; const float as = __shfl(av, s); sm[j] = (s <= t) ? qk[j] * 0.08838834764831845f * fexp(as - Mtt) : 0.f; rowsum += sm[j]; }
            smp[sb] = pack4(sm); } }
    rowsum += __shfl_xor(rowsum, 16); rowsum += __shfl_xor(rowsum, 32);
    const float hden = 1.f / fmaxf(fabsf(ett * qn + rowsum), emt);
    const v4u s0u = (v4u){smp[0].x, smp[0].y, smp[1].x, smp[1].y}, s1u = (v4u){smp[2].x, smp[2].y, smp[3].x, smp[3].y};
    const bf16x8 sf0 = __builtin_bit_cast(bf16x8, s0u), sf1 = __builtin_bit_cast(bf16x8, s1u);
    v4u cfr[4][4];
#pragma unroll
    for (int g4 = 0; g4 < 4; ++g4)
#pragma unroll
        for (int ks = 0; ks < 4; ++ks) cfr[g4][ks] = *(const v4u*)(cs + (size_t)(128 * half + 16 * g4 + fr) * 128 + 32 * ks + 8 * fq);
    LDS_BARRIER();
    f32x4 hv[8]; float ss = 0.f;
#pragma unroll
    for (int grp = 0; grp < 2; ++grp) {
      f32x4 accs[4];
#pragma unroll
      for (int g4 = 0; g4 < 4; ++g4) { f32x4 acc = (f32x4){0.f, 0.f, 0.f, 0.f};
#pragma unroll
          for (int ks = 0; ks < 4; ++ks) acc = MFMA32(__builtin_bit_cast(bf16x8, cfr[g4][ks]), qf[ks], acc);
          accs[g4] = acc * ett; }
      if (grp == 0) {
#pragma unroll
          for (int g4 = 0; g4 < 4; ++g4)
#pragma unroll
              for (int ks = 0; ks < 4; ++ks) cfr[g4][ks] = *(const v4u*)(cs + (size_t)(128 * half + 64 + 16 * g4 + fr) * 128 + 32 * ks + 8 * fq); }
#pragma unroll
      for (int g4 = 0; g4 < 4; ++g4) { const int vb = 4 * grp + g4, vrow = 128 * half + 16 * vb + fr; f32x4 acc = accs[g4];
        { const v2u a0 = *(const LAS v2u*)(VT + vrow * 72 + 4 * fq), a1 = *(const LAS v2u*)(VT + vrow * 72 + 16 + 4 * fq); const v4u au = (v4u){a0.x, a0.y, a1.x, a1.y}; acc = MFMA32(__builtin_bit_cast(bf16x8, au), sf0, acc); }
        { const v2u a0 = *(const LAS v2u*)(VT + vrow * 72 + 32 + 4 * fq), a1 = *(const LAS v2u*)(VT + vrow * 72 + 48 + 4 * fq); const v4u au = (v4u){a0.x, a0.y, a1.x, a1.y}; acc = MFMA32(__builtin_bit_cast(bf16x8, au), sf1, acc); }
        hv[vb] = acc * hden; ss += (hv[vb].x * hv[vb].x + hv[vb].y * hv[vb].y) + (hv[vb].z * hv[vb].z + hv[vb].w * hv[vb].w); }
    }
    ss += __shfl_xor(ss, 16); ss += __shfl_xor(ss, 32);
    if (fq == 0) ssq[half * 64 + t] = ss;
    LDS_BARRIER();
    const float rstd = rsqrtf((ssq[t] + ssq[64 + t]) * (1.f / 256.f) + RMS_EPS);
    const bf16* op = proj + (size_t)(row0 + t) * NPROJ_PAD + 4096 + h * 256 + 128 * half + 4 * fq;
    bf16* mp = (bf16*)(ws + WS_MIX) + (size_t)(row0 + t) * D + h * 256 + 128 * half + 4 * fq;
    const float* nw = a->in[I_MNORM] + h * 256 + 128 * half + 4 * fq;
    v2u opr[8];
#pragma unroll
    for (int vb = 0; vb < 8; ++vb) opr[vb] = *(const v2u*)(op + 16 * vb);
#pragma unroll
    for (int vb = 0; vb < 8; ++vb) { const v2u o = opr[vb]; const f32x4 n4 = *(const f32x4*)(nw + 16 * vb);
        f32x4 y; y.x = hv[vb].x * rstd * n4.x * sigm(bflo(o.x)); y.y = hv[vb].y * rstd * n4.y * sigm(bfhi(o.x)); y.z = hv[vb].z * rstd * n4.z * sigm(bflo(o.y)); y.w = hv[vb].w * rstd * n4.w * sigm(bfhi(o.y));
        *(v2u*)(mp + 16 * vb) = pack4(y); }
    LDS_BARRIER();
}


__device__ __forceinline__ void mlstm_sample_load(ArgsP a, int j, const int tid, f32x4 (&cst)[2][4][2]) {
    const int lane = tid & 63, w = __builtin_amdgcn_readfirstlane(tid >> 6), fr = lane & 15, fq = lane >> 4;
    const float* C0 = a->in[I_SMC] + (size_t)j * 32768;
#pragma unroll
    for (int vb = 0; vb < 2; ++vb)
#pragma unroll
        for (int ksp = 0; ksp < 4; ++ksp) { const float* cp = C0 + (size_t)(32 * w + 16 * vb + fr) * 128 + 32 * ksp + 4 * fq; cst[vb][ksp][0] = __builtin_nontemporal_load((const f32x4*)cp); cst[vb][ksp][1] = __builtin_nontemporal_load((const f32x4*)(cp + 16)); }
}
__device__ __forceinline__ void mlstm_sample_item(ArgsP a, LAS unsigned char* lds, int j, const int tid, const f32x4 (&cst)[2][4][2]) {
    const int b = j >> 3, h = j & 7, row0 = MP + b * TS;
    const int lane = tid & 63, w = __builtin_amdgcn_readfirstlane(tid >> 6), fr = lane & 15, fq = lane >> 4;
    unsigned char* ws = a->ws;
    const bf16* proj = (const bf16*)(ws + WS_PROJ); const float* gates = (const float*)(ws + WS_GATES);
    float* Cout = a->out + O_MCS + (size_t)j * 32768;
    LAS float* qs = (LAS float*)lds;
    LAS float* ks = qs + 512;
    LAS float* vs = ks + 512;
    LAS float* gs = vs + 1024;
    LAS float* qkr = gs + 8;
    LAS float* qnl = qkr + 16;
    LAS float* hbuf = qnl + 8;
#pragma unroll
    for (int tok = 0; tok < 4; ++tok) { const bf16* pr = proj + (size_t)(row0 + tok) * NPROJ_PAD;
        if (tid < 128) qs[tok * 128 + tid] = bf2f(pr[h * 128 + tid]); else if (tid < 256) ks[tok * 128 + tid - 128] = bf2f(pr[1024 + h * 128 + (tid - 128)]) * 0.08838834764831845f; else vs[tok * 256 + tid - 256] = bf2f(pr[2048 + h * 256 + (tid - 256)]); }
    if (tid < 4) { gs[tid * 2] = gates[(size_t)(row0 + tid) * 16 + h] + a->in[I_BIG][h]; gs[tid * 2 + 1] = gates[(size_t)(row0 + tid) * 16 + 8 + h] + a->in[I_BFG][h]; }
    const float n0a = a->in[I_SMN][(size_t)j * 128 + lane], n0b = a->in[I_SMN][(size_t)j * 128 + 64 + lane];
    const float m0 = a->in[I_SMM][j];
    LDS_BARRIER();
#pragma unroll
    for (int i = 0; i < 2; ++i) { const int p = 2 * w + i, t = p >> 2, sx = p & 3; const float d = wave_sum(qs[t * 128 + lane] * ks[sx * 128 + lane] + qs[t * 128 + 64 + lane] * ks[sx * 128 + 64 + lane]); if (lane == 0) qkr[p] = d; }
    if (w < 4) { const float d = wave_sum(qs[w * 128 + lane] * n0a + qs[w * 128 + 64 + lane] * n0b); if (lane == 0) qnl[w] = d; }
    float bc[4], ig[4], mt[4], m = m0, bsum = 0.f;
#pragma unroll
    for (int t = 0; t < 4; ++t) { ig[t] = gs[t * 2]; const float lf = logsigf(gs[t * 2 + 1]); bsum += lf; bc[t] = bsum; m = fmaxf(lf + m, ig[t]); mt[t] = m; }
    const float scf = fexp(bc[3] + m0 - mt[3]);
    float wsf[4], et[4];
#pragma unroll
    for (int t = 0; t < 4; ++t) { wsf[t] = fexp(bc[3] - bc[t] + ig[t] - mt[3]); et[t] = fexp(bc[t] + m0 - mt[t]); }
    LDS_BARRIER();
    float S[4][4], hden[4];
#pragma unroll
    for (int t = 0; t < 4; ++t) { float den = et[t] * qnl[t];
#pragma unroll
        for (int sx = 0; sx < 4; ++sx) { S[t][sx] = (sx <= t) ? qkr[t * 4 + sx] * fexp(bc[t] - bc[sx] + ig[sx] - mt[t]) : 0.f; den += S[t][sx]; }
        hden[t] = 1.f / fmaxf(fabsf(den), fexp(-mt[t])); }
    bf16x8 qa[4];
#pragma unroll
    for (int ksp = 0; ksp < 4; ++ksp) { v4u u = (v4u){0u, 0u, 0u, 0u};
        if (fr < 4) { const f32x4 x0 = *(const LAS f32x4*)(qs + fr * 128 + 32 * ksp + 4 * fq), x1 = *(const LAS f32x4*)(qs + fr * 128 + 32 * ksp + 16 + 4 * fq); u.x = pk2(x0.x, x0.y); u.y = pk2(x0.z, x0.w); u.z = pk2(x1.x, x1.y); u.w = pk2(x1.z, x1.w); }
        qa[ksp] = __builtin_bit_cast(bf16x8, u); }
#pragma unroll
    for (int vb = 0; vb < 2; ++vb) { const int v = 32 * w + 16 * vb + fr;
        float vw[4];
#pragma unroll
        for (int sx = 0; sx < 4; ++sx) vw[sx] = vs[sx * 256 + v] * wsf[sx];
        f32x4 dacc = (f32x4){0.f, 0.f, 0.f, 0.f};
#pragma unroll
        for (int ksp = 0; ksp < 4; ++ksp) { const f32x4 c0 = cst[vb][ksp][0], c1 = cst[vb][ksp][1];
            v4u u; u.x = pk2(c0.x, c0.y); u.y = pk2(c0.z, c0.w); u.z = pk2(c1.x, c1.y); u.w = pk2(c1.z, c1.w);
            dacc = MFMA32(qa[ksp], __builtin_bit_cast(bf16x8, u), dacc);
            f32x4 n0v = c0 * scf, n1v = c1 * scf;
#pragma unroll
            for (int sx = 0; sx < 4; ++sx) { const f32x4 k0 = *(const LAS f32x4*)(ks + sx * 128 + 32 * ksp + 4 * fq), k1 = *(const LAS f32x4*)(ks + sx * 128 + 32 * ksp + 16 + 4 * fq); n0v = n0v + k0 * vw[sx]; n1v = n1v + k1 * vw[sx]; }
            float* op = Cout + (size_t)v * 128 + 32 * ksp + 4 * fq; __builtin_nontemporal_store(n0v, (f32x4*)op); __builtin_nontemporal_store(n1v, (f32x4*)(op + 16)); }
        if (fq == 0) {
#pragma unroll
            for (int t = 0; t < 4; ++t) { float num = et[t] * dacc[t];
#pragma unroll
                for (int sx = 0; sx < 4; ++sx) num += S[t][sx] * vs[sx * 256 + v];
                hbuf[t * 256 + v] = num * hden[t]; } }
    }
    if (tid < 128) { float nn = scf * a->in[I_SMN][(size_t)j * 128 + tid];
#pragma unroll
        for (int sx = 0; sx < 4; ++sx) nn += wsf[sx] * ks[sx * 128 + tid];
        a->out[O_MNS + (size_t)j * 128 + tid] = nn; }
    if (tid == 0) a->out[O_MMS + j] = mt[3];
    LDS_BARRIER();
    if (w < 4) { const int tok = w, row = row0 + tok; float hv[4]; float ss = 0.f;
#pragma unroll
        for (int i = 0; i < 4; ++i) { hv[i] = hbuf[tok * 256 + i * 64 + lane]; ss += hv[i] * hv[i]; }
        const float rstd = rsqrtf(wave_sum(ss) * (1.f / 256.f) + RMS_EPS);
        const float* nw = a->in[I_MNORM] + h * 256; bf16* mix = (bf16*)(ws + WS_MIX);
#pragma unroll
        for (int i = 0; i < 4; ++i) { const int vi = i * 64 + lane; const float op = bf2f(proj[(size_t)row * NPROJ_PAD + 4096 + h * 256 + vi]);
            mix[(size_t)row * D + h * 256 + vi] = (bf16)f2bf(hv[i] * rstd * nw[vi] * sigm(op)); } }
    LDS_BARRIER();
}


__device__ __forceinline__ void lru_sample_loop(ArgsP a, LAS unsigned char* lds, int vcu, int G, const int tid) {
    const int d = tid & 127, part = tid >> 7, n = vcu & 7, chn = n * 128 + d;
    const bf16* proj = (const bf16*)(a->ws + WS_PROJ); bf16* mix = (bf16*)(a->ws + WS_MIX);
    const float* wconv = a->in[I_WCONV]; const float* bconv = a->in[I_BCONV];
    const float* wr = a->in[I_LWR] + (size_t)n * 16384; const float* wi = a->in[I_LWI] + (size_t)n * 16384;
    LAS float* xr = (LAS float*)lds;
    LAS float* red = xr + 512;
    float w1[32], w2[32];
#pragma unroll
    for (int cc = 0; cc < 32; ++cc) { w1[cc] = wr[(part * 32 + cc) * 128 + d]; w2[cc] = wi[(part * 32 + cc) * 128 + d]; }
    const float br = a->in[I_LBR][chn], bi = a->in[I_LBI][chn], spl = softplusf(-a->in[I_LLAM][chn]);
#pragma unroll 1
    for (int j = vcu; j < 1024; j += G) {
        const int b = j >> 3, row0 = MP + b * TS; const float* cstate = a->in[I_SCONV] + (size_t)b * 3 * 4096;
        float hst = a->in[I_SLRU][(size_t)b * 1024 + chn];
        float gt[4];
        if (part == 0) {
#pragma unroll
            for (int tok = 0; tok < 4; ++tok) gt[tok] = bf2f(proj[(size_t)(row0 + tok) * NPROJ_PAD + 5120 + chn]); }
        { const int tok = tid >> 7; xr[tok * 128 + d] = conv4(proj, row0, tok, 3072 + chn, cstate, wconv, bconv); }
        LDS_BARRIER();
        float ar[4] = {0.f, 0.f, 0.f, 0.f}, ai[4] = {0.f, 0.f, 0.f, 0.f};
#pragma unroll
        for (int cc = 0; cc < 32; ++cc) { const int c = part * 32 + cc;
#pragma unroll
            for (int tok = 0; tok < 4; ++tok) { const float x = xr[tok * 128 + c]; ar[tok] += x * w1[cc]; ai[tok] += x * w2[cc]; } }
#pragma unroll
        for (int tok = 0; tok < 4; ++tok) { red[((tok * 2 + 0) * 4 + part) * 128 + d] = ar[tok]; red[((tok * 2 + 1) * 4 + part) * 128 + d] = ai[tok]; }
        LDS_BARRIER();
        if (part == 0) {
#pragma unroll
            for (int tok = 0; tok < 4; ++tok) {
                float rp = br, ip = bi;
#pragma unroll
                for (int p = 0; p < 4; ++p) { rp += red[((tok * 2 + 0) * 4 + p) * 128 + d]; ip += red[((tok * 2 + 1) * 4 + p) * 128 + d]; }
                const float log_a = -8.f * sigm(rp) * spl;
                const float av = fexp(log_a);
                const float bx = sqrtf(neg_expm1(2.f * log_a)) * sigm(ip) * xr[tok * 128 + d];
                hst = av * hst + bx;
                mix[(size_t)(row0 + tok) * D + 1024 + chn] = (bf16)f2bf(hst * gelu_tanh(gt[tok]));
            }
            a->out[O_LRUS + (size_t)b * 1024 + chn] = hst;
        }
        LDS_BARRIER();
    }
}

__device__ __forceinline__ void phase_mixer_even(ArgsP a, LAS unsigned char* lds, int vcu, int G, const int tid) {
#pragma unroll 1
    for (int r = 0; r < 1 + (PROBE_SUB & 1); ++r)
#pragma unroll 1
    for (int it = vcu; it < 1024; it += G) delta_prep_item(a, lds, it, tid);
#pragma unroll 1
    for (int r = 0; r < 1 + ((PROBE_SUB >> 1) & 1); ++r)
#pragma unroll 1
    for (int it = vcu; it < 1024; it += G) lru_prep_item(a, lds, it, tid);
#pragma unroll 1
    for (int r = 0; r < 1 + ((PROBE_SUB >> 2) & 1); ++r)
#pragma unroll 1
    for (int j = vcu; j < 1024; j += G) { const int b = j >> 3, hn = j & 7; delta_rec_item(a, lds, MP + b * TS, TS, hn, a->in[I_SCONV] + (size_t)b * 3 * 4096, a->in[I_SDELTA] + (size_t)j * 16384, a->out + O_DELTAS + (size_t)j * 16384, tid); }
#pragma unroll 1
    for (int r = 0; r < 1 + ((PROBE_SUB >> 3) & 1); ++r)
    lru_sample_loop(a, lds, vcu, G, tid);
    const bf16* proj = (const bf16*)(a->ws + WS_PROJ);
    const int npieces = (BP + BS) * 3 * 512;
    for (int i = vcu * NTHR + tid; i < npieces; i += G * NTHR) {
        const int c8 = i & 511, rj = i >> 9, j = rj % 3, b = rj / 3;
        const bf16* src; float* dst;
        if (b < BP) { src = proj + (size_t)(b * TP + TP - 3 + j) * NPROJ_PAD + 8 * c8; dst = a->out + O_CONVP + (size_t)(b * 3 + j) * 4096 + 8 * c8; }
        else { const int bs = b - BP; src = proj + (size_t)(MP + bs * TS + 1 + j) * NPROJ_PAD + 8 * c8; dst = a->out + O_CONVS + (size_t)(bs * 3 + j) * 4096 + 8 * c8; }
        const v4u u = *(const v4u*)src;
        *(f32x4*)dst = (f32x4){bflo(u.x), bfhi(u.x), bflo(u.y), bfhi(u.y)}; *(f32x4*)(dst + 4) = (f32x4){bflo(u.z), bfhi(u.z), bflo(u.w), bfhi(u.w)};
    }
}
__device__ __forceinline__ void phase_mixer_even_b(ArgsP a, LAS unsigned char* lds, int vcu, int G, const int tid) {
    const int w = __builtin_amdgcn_readfirstlane(tid >> 6);
    if (w == 0) { for (int it = vcu; it < 256; it += G) delta_scan_wave(a, it >> 3, it & 7, tid & 63); }
    else { LAS float* scr = (LAS float*)(lds + w * 16384);
        convert_range(a, scr, cv::R_IN0, cv::R_SCAN, vcu * 7 + (w - 1), G * 7, tid & 63); }
}
__device__ __forceinline__ void phase_mixer_even_c(ArgsP a, LAS unsigned char* lds, int vcu, int G, const int tid) {
    const int w = tid >> 6;
#pragma unroll 1
    for (int it = vcu; it < 512; it += G) delta_out_wave(a, 2 * it + (w >> 2), w & 3, tid & 63);
#pragma unroll 1
    for (int it = vcu; it < 1024; it += G) lru_out_item(a, lds, it, tid);
    for (int chain = vcu; chain < 32; chain += G) {
        const f32x4* src = (const f32x4*)(a->ws + WS_DF) + (size_t)chain * 4096; float* dst = a->out + O_DELTAP + (size_t)chain * 16384;
        f32x4 v[8];
#pragma unroll
        for (int i = 0; i < 8; ++i) v[i] = src[tid + 512 * i];
#pragma unroll
        for (int i = 0; i < 8; ++i) { const int idx = tid + 512 * i, ln = idx & 63, rb = (idx >> 6) & 7, s8 = idx >> 9; const int dk0 = 16 * rb + 4 * (ln >> 4), dv = 16 * s8 + (ln & 15);
            dst[(size_t)(dk0 + 0) * 128 + dv] = v[i].x; dst[(size_t)(dk0 + 1) * 128 + dv] = v[i].y; dst[(size_t)(dk0 + 2) * 128 + dv] = v[i].z; dst[(size_t)(dk0 + 3) * 128 + dv] = v[i].w; }
    }
}
__device__ __forceinline__ void phase_mixer_odd(ArgsP a, LAS unsigned char* lds, int vcu, int G, const int tid) {
#pragma unroll 1
    for (int r = 0; r < 1 + ((PROBE_SUB >> 4) & 1); ++r)
#pragma unroll 1
    for (int it = vcu; it < 256; it += G) mlstm_scan_item(a, lds, it >> 3, it & 7, tid);
#pragma unroll 1
    for (int r = 0; r < 1 + ((PROBE_SUB >> 5) & 1); ++r)
    {
        f32x4 cA[2][4][2], cB[2][4][2]; int j = vcu;
        if (j < 1024) { mlstm_sample_load(a, j, tid, cA);
#pragma unroll 1
            for (;;) {
                const int jB = j + G; const bool hasB = jB < 1024;
                if (hasB) mlstm_sample_load(a, jB, tid, cB);
                mlstm_sample_item(a, lds, j, tid, cA);
                if (!hasB) break;
                j = jB + G; const bool hasA = j < 1024;
                if (hasA) mlstm_sample_load(a, j, tid, cA);
                mlstm_sample_item(a, lds, jB, tid, cB);
                if (!hasA) break;
            } }
    }
}
__device__ __forceinline__ void phase_mixer_odd_b(ArgsP a, LAS unsigned char* lds, int vcu, int G, const int tid) {
#pragma unroll 1
    for (int it = vcu; it < 1024; it += G) mlstm_out_item(a, lds, it, tid);
}

__device__ __forceinline__ void phase_ln(const bf16* VB, const float* ST, const float* p1, const bf16* resid, const float* g, const float* bta, bf16* dst, LAS unsigned char* lds, int vcu, int G, const int tid) {
    const int lane = tid & 63, w = __builtin_amdgcn_readfirstlane(tid >> 6), gw = vcu * NWAVES + w, NGW = G * NWAVES;
    {
        LAS float* red = (LAS float*)lds;
        for (int r0 = 2 * vcu; r0 < MS; r0 += 2 * G) {
            const int r = r0 + (w >> 2), q = w & 3, col = 512 * q + 8 * lane; const size_t off = (size_t)(MP + r) * D + col;
            const float* q1 = p1 + (size_t)r * D + col;
            f32x4 x0 = *(const f32x4*)q1, x1 = *(const f32x4*)(q1 + 4);
#pragma unroll
            for (int ch = 1; ch < 16; ++ch) { x0 = x0 + *(const f32x4*)(q1 + (size_t)ch * 512 * D); x1 = x1 + *(const f32x4*)(q1 + (size_t)ch * 512 * D + 4); }
            const v4u rr = *(const v4u*)(resid + off);
            float v[8] = {x0.x + DN_ALPHA * bflo(rr.x), x0.y + DN_ALPHA * bfhi(rr.x), x0.z + DN_ALPHA * bflo(rr.y), x0.w + DN_ALPHA * bfhi(rr.y),
                          x1.x + DN_ALPHA * bflo(rr.z), x1.y + DN_ALPHA * bfhi(rr.z), x1.z + DN_ALPHA * bflo(rr.w), x1.w + DN_ALPHA * bfhi(rr.w)};
            float s = 0.f, ss = 0.f;
#pragma unroll
            for (int i = 0; i < 8; ++i) { s += v[i]; ss += v[i] * v[i]; }
            s = wave_sum(s); ss = wave_sum(ss);
            if (lane == 0) { red[w * 2] = s; red[w * 2 + 1] = ss; }
            LDS_BARRIER();
            const int wb = (w >> 2) * 4; s = (red[wb * 2] + red[wb * 2 + 2]) + (red[wb * 2 + 4] + red[wb * 2 + 6]); ss = (red[wb * 2 + 1] + red[wb * 2 + 3]) + (red[wb * 2 + 5] + red[wb * 2 + 7]);
            const float mean = s * (1.f / D), rstd = rsqrtf(fmaxf(ss * (1.f / D) - mean * mean, 0.f) + LN_EPS);
            const f32x4 g0 = *(const f32x4*)(g + col), g1 = *(const f32x4*)(g + col + 4), b0 = *(const f32x4*)(bta + col), b1 = *(const f32x4*)(bta + col + 4);
            v4u o; o.x = pk2((v[0] - mean) * rstd * g0.x + b0.x, (v[1] - mean) * rstd * g0.y + b0.y); o.y = pk2((v[2] - mean) * rstd * g0.z + b0.z, (v[3] - mean) * rstd * g0.w + b0.w);
            o.z = pk2((v[4] - mean) * rstd * g1.x + b1.x, (v[5] - mean) * rstd * g1.y + b1.y); o.w = pk2((v[6] - mean) * rstd * g1.z + b1.z, (v[7] - mean) * rstd * g1.w + b1.w);
            *(v4u*)(dst + off) = o;
            LDS_BARRIER();
        }
    }
    for (int m0 = gw; m0 < MP; m0 += 4 * NGW) {
        v4u vv[4][4]; float s[4], ss[4];
#pragma unroll
        for (int i = 0; i < 4; ++i) { const int m = m0 + i * NGW; s[i] = 0.f; ss[i] = 0.f;
            if (m < MP) { if (lane < 32) { const float* sp = ST + (((size_t)(lane >> 2) * M + m) * 4 + (lane & 3)) * 2; s[i] = sp[0]; ss[i] = sp[1]; }
#pragma unroll
                for (int j = 0; j < 4; ++j) vv[i][j] = *(const v4u*)(VB + (size_t)m * D + j * 512 + lane * 8); } }
#pragma unroll
        for (int i = 0; i < 4; ++i) { const int m = m0 + i * NGW;
            if (m < MP) { const float st = wave_sum(s[i]), sst = wave_sum(ss[i]);
                const float mean = st * (1.f / D), rstd = rsqrtf(fmaxf(sst * (1.f / D) - mean * mean, 0.f) + LN_EPS);
#pragma unroll
                for (int j = 0; j < 4; ++j) { const int col = j * 512 + lane * 8; const v4u v = vv[i][j];
                    const f32x4 g0 = *(const f32x4*)(g + col), g1 = *(const f32x4*)(g + col + 4), b0 = *(const f32x4*)(bta + col), b1 = *(const f32x4*)(bta + col + 4);
                    v4u o; o.x = pk2((bflo(v.x) - mean) * rstd * g0.x + b0.x, (bfhi(v.x) - mean) * rstd * g0.y + b0.y); o.y = pk2((bflo(v.y) - mean) * rstd * g0.z + b0.z, (bfhi(v.y) - mean) * rstd * g0.w + b0.w);
                    o.z = pk2((bflo(v.z) - mean) * rstd * g1.x + b1.x, (bfhi(v.z) - mean) * rstd * g1.y + b1.y); o.w = pk2((bflo(v.w) - mean) * rstd * g1.z + b1.z, (bfhi(v.w) - mean) * rstd * g1.w + b1.w);
                    *(v4u*)(dst + (size_t)m * D + col) = o; } } }
    }
}
__device__ __forceinline__ void phase_combine(const float* p1, const bf16* h2, const bf16* pw, bf16* xb, float* outf, int vcu, int G, const int tid) {
    const int lane = tid & 63, w = tid >> 6;
    for (int r0 = 2 * vcu; r0 < MS; r0 += 2 * G) {
        const int r = r0 + (w >> 2), q = w & 3, col = 512 * q + 8 * lane; const size_t off = (size_t)(MP + r) * D + col;
        const float* q1 = p1 + (size_t)r * D + col;
        f32x4 x0 = *(const f32x4*)q1, x1 = *(const f32x4*)(q1 + 4);
#pragma unroll
        for (int ch = 1; ch < 16; ++ch) { x0 = x0 + *(const f32x4*)(q1 + (size_t)ch * 512 * D); x1 = x1 + *(const f32x4*)(q1 + (size_t)ch * 512 * D + 4); }
        const v4u hh = *(const v4u*)(h2 + off), pp = *(const v4u*)(pw + off);
        f32x4 o0, o1;
        o0.x = bflo(hh.x) + sigm(x0.x) * bflo(pp.x); o0.y = bfhi(hh.x) + sigm(x0.y) * bfhi(pp.x); o0.z = bflo(hh.y) + sigm(x0.z) * bflo(pp.y); o0.w = bfhi(hh.y) + sigm(x0.w) * bfhi(pp.y);
        o1.x = bflo(hh.z) + sigm(x1.x) * bflo(pp.z); o1.y = bfhi(hh.z) + sigm(x1.y) * bfhi(pp.z); o1.z = bflo(hh.w) + sigm(x1.z) * bflo(pp.w); o1.w = bfhi(hh.w) + sigm(x1.w) * bfhi(pp.w);
        v4u ob; ob.x = pk2(o0.x, o0.y); ob.y = pk2(o0.z, o0.w); ob.z = pk2(o1.x, o1.y); ob.w = pk2(o1.z, o1.w); *(v4u*)(xb + off) = ob;
        if (outf) { *(f32x4*)(outf + off) = o0; *(f32x4*)(outf + off + 4) = o1; }
    }
}

constexpr int N_PHASES = 22;
enum { OP_INPROJ = 0, OP_MIXA, OP_MIXB, OP_MIXC, OP_OUTPROJ, OP_LN1, OP_UP, OP_DOWN, OP_LN2, OP_GATE, OP_COMBINE };
enum { GK_LN = 0, GK_BF16 = 1, GK_SQRELU = 2, GK_COMB = 3 };
__global__ void __launch_bounds__(NTHR, 2) mk_fwd(Args a_in) {
    extern __shared__ __attribute__((aligned(16))) unsigned char lds_raw[];
    LAS unsigned char* lds = (LAS unsigned char*)lds_raw;
    ArgsP kp = (ArgsP)__builtin_amdgcn_kernarg_segment_ptr();
    const int lo = a_in.ph_lo, hi = a_in.ph_hi;
    int wv0; { const int wtmp = (int)threadIdx.x >> 6; asm volatile("s_nop 4\n\tv_readfirstlane_b32 %0, %1\n\ts_nop 4" : "=s"(wv0) : "v"(wtmp)); }
#if MK_N_LAUNCHES == 1
    volatile LAS unsigned* xst = (volatile LAS unsigned*)(lds + LDS_CTL_OFF);
    if (threadIdx.x < 2) xst[threadIdx.x] = 0u;
    __syncthreads();
    XcdBarrier bar = xcd_barrier_post((unsigned*)(a_in.ws + WS_CTL) + 4096, xst);
#endif
    int p = lo; asm volatile("" : "+s"(p));
#pragma unroll 1
    for (; p < hi; ) {
      int nrep = 1;
      if (PROBE_MASK) { const int L_ = p <= 11 ? 0 : 1; const int q_ = p == 0 ? -1 : (L_ == 0 ? p - 1 : (p - 12 < 3 ? p - 12 : p - 11));
        int grp; if (p == 0) grp = 0; else if (q_ == OP_INPROJ || q_ == OP_UP) grp = 1; else if (q_ == OP_OUTPROJ || q_ == OP_DOWN || q_ == OP_GATE) grp = 2; else if (q_ == OP_LN1 || q_ == OP_LN2 || q_ == OP_COMBINE) grp = 3; else grp = (L_ == 0) ? 4 : 5;
        if ((PROBE_MASK >> grp) & 1) nrep = 2; }
      if (p == PROBE_P) nrep = 2;
#pragma unroll 1
      for (int rep = 0; rep < nrep; ++rep) {
        int pp = p; asm volatile("" : "+s"(pp));
        int wvs = wv0; asm volatile("" : "+s"(wvs));
        unsigned ones = ~0u; asm volatile("" : "+s"(ones));
        int tid = (wvs << 6) | (int)__builtin_amdgcn_mbcnt_hi(ones, __builtin_amdgcn_mbcnt_lo(ones, 0u)); asm volatile("" : "+v"(tid));
        int bx = blockIdx.x; asm volatile("" : "+s"(bx));
        int G = gridDim.x; asm volatile("" : "+s"(G));
        ArgsP a = kp; asm volatile("" : "+s"(a));
#define MK_VCU ((G % 8 == 0) ? (bx % 8) * (G / 8) + bx / 8 : bx)
#define MK_WAVE (__builtin_amdgcn_readfirstlane(tid >> 6))
#define MK_GW (MK_VCU * NWAVES + MK_WAVE)
#define MK_NGW (G * NWAVES)
#define MK_LANE (tid & 63)
        unsigned char* ws = a->ws;
        if (pp == 0) {
phase_convert(a, lds, MK_GW, MK_NGW, MK_WAVE, MK_LANE); }
        else {
            const int L = pp <= 11 ? 0 : 1; const int q = L == 0 ? pp - 1 : (pp - 12 < 3 ? pp - 12 : pp - 11);
            bf16* xb = (bf16*)(ws + WS_XB); bf16* mixb = (bf16*)(ws + WS_MIX); bf16* hb = (bf16*)(ws + WS_H); bf16* h2b = (bf16*)(ws + WS_H2); bf16* pwb = (bf16*)(ws + WS_PW);
            bf16* projb = (bf16*)(ws + WS_PROJ); bf16* upb = (bf16*)(ws + WS_PROJ);
            bf16* vbb = (bf16*)(ws + WS_PART0); float* stb = (float*)(ws + WS_PART0 + 34 * MiB); float* part1 = (float*)(ws + WS_PART1); float* gatesb = (float*)(ws + WS_GATES);
            if (q == OP_MIXA) { if (L == 0) phase_mixer_even(a, lds, MK_VCU, G, tid); else phase_mixer_odd(a, lds, MK_VCU, G, tid); }
            else if (q == OP_MIXB) { if (L == 0) phase_mixer_even_b(a, lds, MK_VCU, G, tid); else phase_mixer_odd_b(a, lds, MK_VCU, G, tid); }
            else if (q == OP_MIXC) { phase_mixer_even_c(a, lds, MK_VCU, G, tid); }
            else if (q == OP_LN1) phase_ln(vbb, stb, part1, xb, a->in[I_LN1G] + L * D, a->in[I_LN1B] + L * D, hb, lds, MK_VCU, G, tid);
            else if (q == OP_LN2) phase_ln(vbb, stb, part1, hb, a->in[I_LN2G] + L * D, a->in[I_LN2B] + L * D, h2b, lds, MK_VCU, G, tid);
            else if (q == OP_COMBINE) phase_combine(part1, h2b, pwb, xb, L == 1 ? a->out + O_Y : nullptr, MK_VCU, G, tid);
            else {
                for (int sub = 0; sub < (q == OP_INPROJ ? 2 : 1); ++sub) {
                    const bf16* A; const bf16* Bt; int N, K, kind; void* out = nullptr; float* gp = nullptr; const bf16* resid = nullptr; int corder = bx, gorder = G;
                    const int busy_in = ((M / 256) * (NPROJ_PAD / 256)) % 256;
                    if (q == OP_INPROJ && sub == 0) { A = xb; Bt = (const bf16*)(ws + (L == 0 ? WS_WINE : WS_WINO)); N = NPROJ_PAD; K = D; kind = GK_BF16; out = projb; gp = gatesb; }
                    else if (q == OP_INPROJ) { A = (const bf16*)(ws + WS_PB) + (size_t)L * M * PLE; Bt = (const bf16*)(ws + WS_WPLE) + (size_t)L * PLE * D; N = D; K = PLE; kind = GK_BF16; out = pwb;
                        gorder = G - busy_in; corder = (bx >= busy_in) ? bx - busy_in : 1 << 20; }
                    else if (q == OP_OUTPROJ) { A = mixb; Bt = (const bf16*)(ws + (L == 0 ? WS_WOUTE : WS_WOUTO)); N = D; K = D; kind = GK_LN; resid = xb; }
                    else if (q == OP_UP) { A = hb; Bt = (const bf16*)(ws + WS_WUP) + (size_t)L * D * FF; N = FF; K = D; kind = GK_SQRELU; out = upb; }
                    else if (q == OP_DOWN) { A = upb; Bt = (const bf16*)(ws + WS_WDOWN) + (size_t)L * D * FF; N = D; K = FF; kind = GK_LN; resid = hb; }
                    else { A = h2b; Bt = (const bf16*)(ws + WS_WGATE) + (size_t)L * D * D; N = D; K = D; kind = GK_COMB; }
                    pg8::Gemm g{A, Bt, M, N, K};
                    if (kind == GK_LN) { pg8::MainSplit SK; SK.init(K, MK_VCU); pg8::EpiLnStat E{vbb, stb, resid, part1, N, M, DN_ALPHA}; pg8::gemm_phase<pg8::EpiLnStat, pg8::MainSplit, true, true>(lds, g, SK, E, tid); }
                    else if (kind == GK_COMB) { pg8::MainSplit SK; SK.init(K, MK_VCU); pg8::EpiCombine E{h2b, pwb, xb, L == 1 ? a->out + O_Y : nullptr, part1, N}; pg8::gemm_phase<pg8::EpiCombine, pg8::MainSplit, true, true>(lds, g, SK, E, tid); }
                    else if (kind == GK_BF16) { pg8::StaticOrder S; S.init(M, N, K, gorder, corder); pg8::EpiBf16<0> E{(bf16*)out, N, gp, 24}; pg8::gemm_phase<pg8::EpiBf16<0>, pg8::StaticOrder, true, true>(lds, g, S, E, tid);}
                    else { pg8::StaticOrder S; S.init(M, N, K, G, corder); pg8::EpiBf16<1> E{(bf16*)out, N, nullptr, -1}; pg8::gemm_phase<pg8::EpiBf16<1>, pg8::StaticOrder, true, true>(lds, g, S, E, tid);}
                }
                if (q == OP_INPROJ || q == OP_UP) {
                    const int busy = (q == OP_INPROJ) ? ((M / 256) * (NPROJ_PAD / 256)) % 256 : ((M / 256) * (FF / 256)) % 256;
                    const int first = (q == OP_INPROJ) ? (L == 0 ? 0 : cv::R_SCAN) : (L == 0 ? cv::R_IN1 : cv::R_UP0), last = (q == OP_INPROJ) ? (L == 0 ? cv::R_IN0 : cv::R_IN1) : (L == 0 ? cv::R_UP0 : cv::N_REST);
                    if (G == 256 && bx >= busy) { const int w_ = MK_WAVE; convert_range(a, (LAS float*)(lds + w_ * 16384), first, last, (bx - busy) * NWAVES + w_, (G - busy) * NWAVES, MK_LANE); }
                }
            }
        }
#if MK_N_LAUNCHES == 1
        if (p + 1 < hi || rep + 1 < nrep) xcd_barrier(bar);
#endif
      }
      asm volatile("s_add_i32 %0, %0, 1" : "+s"(p) : : "scc");
    }
}

extern "C" void kernel_launch(void* const* d_in, const int* in_sizes, int n_in, void* d_out, int out_size, void* d_ws, size_t ws_size, hipStream_t stream) {
    static int grid = 0;
    if (grid == 0) {
        if (n_in != 35 || (size_t)out_size != O_END || ws_size < WS_END) { fprintf(stderr, "kernel_launch: unexpected shapes: n_in %d out %d (want %zu) ws %zu (want %zu)\n", n_in, out_size, (size_t)O_END, ws_size, (size_t)WS_END); grid = -1; return; }
        int dev = 0, cus = 0, per_cu = 0;
        hipGetDevice(&dev); hipDeviceGetAttribute(&cus, hipDeviceAttributeMultiprocessorCount, dev);
        if (hipFuncSetAttribute((const void*)mk_fwd, hipFuncAttributeMaxDynamicSharedMemorySize, LDS_BYTES) != hipSuccess) { fprintf(stderr, "kernel_launch: hipFuncSetAttribute failed\n"); grid = -1; return; }
        if (hipOccupancyMaxActiveBlocksPerMultiprocessor(&per_cu, (const void*)mk_fwd, NTHR, LDS_BYTES) != hipSuccess || per_cu < 1) { fprintf(stderr, "kernel_launch: occupancy query says %d\n", per_cu); per_cu = 1; }
        (void)hipGetLastError();
        if (cus != 256) { fprintf(stderr, "kernel_launch: built for a 256-CU device (N = 2048 GEMM schedule), got %d\n", cus); grid = -1; return; }
        grid = cus * 1;
    }
    if (grid < 0) return;
    Args a{};
    for (int i = 0; i < 35; ++i) a.in[i] = (const float*)d_in[i];
    a.out = (float*)d_out; a.ws = (unsigned char*)d_ws;
#if MK_N_LAUNCHES == 1
    hipMemsetAsync((char*)d_ws + WS_CTL, 0, 1 * MiB, stream);
    a.ph_lo = 0; a.ph_hi = N_PHASES;
    hipLaunchKernelGGL(mk_fwd, dim3(grid), dim3(NTHR), LDS_BYTES, stream, a);
#else
    for (int p = 0; p < N_PHASES; ++p) {
        a.ph_lo = p; a.ph_hi = p + 1;
        hipLaunchKernelGGL(mk_fwd, dim3(grid), dim3(NTHR), LDS_BYTES, stream, a);
    }
#endif
}
```

```cpp
#include <hip/hip_runtime.h>
#include <hip/hip_cooperative_groups.h>
#include <cstdio>
#include <cstdint>
namespace cg = cooperative_groups;

#ifndef PROBE_MASK
#define PROBE_MASK 0
#endif
#define PROBE_P (-1)
#define PROBE_SUB 0
#ifndef MK_N_LAUNCHES
#define MK_N_LAUNCHES 1
#endif

namespace pg8 {
#define PG8_LAS __attribute__((address_space(3)))
typedef unsigned short bf16_t;
typedef short bf16x8 __attribute__((ext_vector_type(8)));
typedef float f32x4 __attribute__((ext_vector_type(4)));
typedef unsigned u32x4 __attribute__((ext_vector_type(4)));
constexpr int BM = 256, BK = 64, HALF = 128, HTB = HALF * BK * 2, STAGE_BYTES = 8 * HTB, NXCD = 8, WGM = 8;

__host__ __device__ __forceinline__ int lds_byte(int r, int c) { const int st = (r >> 4) * 2 + (c >> 5), rr = r & 15, cc = c & 31, ob = rr * 64 + cc * 2; return st * 1024 + (ob ^ (((ob >> 9) & 1) << 5)); }
__host__ __device__ __forceinline__ void stage_rc(int b, int& R, int& C) { const int st = b / 1024, sb = b % 1024, swz = sb ^ (((sb >> 9) & 1) << 5); R = (st >> 1) * 16 + swz / 64; C = (st & 1) * 32 + (swz % 64) / 2; }
__host__ __device__ __forceinline__ int perm32(int rho) { const int n = rho >> 4, i = rho & 15; return 8 * (i >> 2) + 4 * n + (i & 3); }

struct Unit { int pm, pn, kt0, nkt, dst; };
struct Gemm { const bf16_t* A; const bf16_t* Bt; int M, N, K; };

struct StaticOrder {
    int nM, nN, nwg, G, c, T;
    __host__ __device__ void init(int M, int N, int K, int G_, int c_) { nM = M / BM; nN = N / BM; nwg = nM * nN; G = G_; c = c_; T = K / BK; }
    __host__ __device__ bool next(int i, Unit& u) const {
        const long L = (long)i * G + c; if (L >= nwg) return false;
        int wgid = (int)L; { const int q = nwg / NXCD, r = nwg % NXCD, xcd = wgid % NXCD, off = wgid / NXCD; wgid = (xcd < r ? xcd * (q + 1) : r * (q + 1) + (xcd - r) * q) + off; }
        const int nig = WGM * nN, gid = wgid / nig, fm = gid * WGM, gsz = (nM - fm) < WGM ? (nM - fm) : WGM;
        u.pm = fm + ((wgid % nig) % gsz); u.pn = (wgid % nig) / gsz; u.kt0 = 0; u.nkt = T; u.dst = 0; return true;
    }
    __device__ __forceinline__ void a_ready(const Unit&) const {}
    __device__ __forceinline__ void done(const Unit&) const {}
};
struct StreamK {
    int nN, T, P, ntot, c;
    __host__ __device__ void init(int M, int N, int K, int G, int c_) { nN = N / BM; T = K / BK; ntot = (M / BM) * nN * T; P = (((ntot + G - 1) / G) + 1) & ~1; c = c_; }
    __host__ __device__ bool next(int i, Unit& u) const {
        int s = c * P; const int e = (s + P < ntot) ? s + P : ntot;
        for (int k = 0; ; ++k) { if (s >= e) return false; const int tile = s / T, kt0 = s - tile * T; const int n = (T - kt0 < e - s) ? T - kt0 : e - s;
            if (k == i) { u.pm = tile / nN; u.pn = tile - u.pm * nN; u.kt0 = kt0; u.nkt = n; u.dst = kt0 ? 1 : 0; return true; }
            s += n; }
    }
    __device__ __forceinline__ void a_ready(const Unit&) const {}
    __device__ __forceinline__ void done(const Unit&) const {}
};
struct MainSplit {
    int T, c;
    __host__ __device__ void init(int K, int c_) { T = K / BK; c = c_; }
    __host__ __device__ bool next(int i, Unit& u) const {
        if (i == 0) { u.pm = c >> 3; u.pn = c & 7; u.kt0 = 0; u.nkt = T; u.dst = 0; return true; }
        if (i == 1) { const int lt = c >> 4, j = c & 15; u.pm = 32 + (lt >> 3); u.pn = lt & 7; u.nkt = T >> 4; u.kt0 = j * u.nkt; u.dst = 1 + j; return true; }
        return false;
    }
    __device__ __forceinline__ void a_ready(const Unit&) const {}
    __device__ __forceinline__ void done(const Unit&) const {}
};
__host__ __device__ __forceinline__ bool split_tile(int tile, int T, int P) { return (tile * T) / P != ((tile + 1) * T - 1) / P; }

__device__ __forceinline__ unsigned cvt_pk_bf16(float lo, float hi) { unsigned r; asm volatile("v_cvt_pk_bf16_f32 %0, %1, %2" : "=v"(r) : "v"(lo), "v"(hi)); return r; }

__device__ __forceinline__ float pg_bflo(unsigned w) { return __builtin_bit_cast(float, w << 16); }
__device__ __forceinline__ float pg_bfhi(unsigned w) { return __builtin_bit_cast(float, w & 0xffff0000u); }
__device__ __forceinline__ void store_chunk(const f32x4 (&acc)[2][2][4][2], const Unit& u, float* C1, int ldc, int wr, int wc, int fr, int fq) {
    const int row0 = u.pm * BM + wr * 64 + fr, col0 = u.pn * BM + wc * 32 + 8 * fq; float* Cb = C1 + ((long)(u.dst - 1) * 512 - 8192) * (long)ldc;
#pragma unroll
    for (int ai = 0; ai < 2; ++ai)
#pragma unroll
        for (int m = 0; m < 4; ++m) { float* rowp = Cb + (size_t)(row0 + ai * HALF + m * 16) * ldc + col0;
#pragma unroll
            for (int bj = 0; bj < 2; ++bj) { *(f32x4*)(rowp + bj * HALF) = acc[ai][bj][m][0]; *(f32x4*)(rowp + bj * HALF + 4) = acc[ai][bj][m][1]; } }
}
struct EpiLnStat {
    static constexpr bool PERM = true, AFTER_DRAIN = false;
    bf16_t* VB; float* ST; const bf16_t* resid; float* C1; int ldc; int mrows; float alpha;
    __device__ __forceinline__ void operator()(const f32x4 (&acc)[2][2][4][2], const Unit& u, int wr, int wc, int fr, int fq) const {
        if (u.dst) { store_chunk(acc, u, C1, ldc, wr, wc, fr, fq); return; }
        const int row0 = u.pm * BM + wr * 64 + fr, col0 = u.pn * BM + wc * 32 + 8 * fq;
        u32x4 rq[2];
#pragma unroll
        for (int bj = 0; bj < 2; ++bj) rq[bj] = *(const u32x4*)(resid + (size_t)(row0) * ldc + col0 + bj * HALF);
#pragma unroll
        for (int idx = 0; idx < 8; ++idx) { const int ai = idx >> 2, m = idx & 3; const int row = row0 + ai * HALF + m * 16; float s = 0.f, ss = 0.f;
                u32x4 rc[2] = {rq[0], rq[1]};
                if (idx + 1 < 8) { const int nrow = row0 + ((idx + 1) >> 2) * HALF + ((idx + 1) & 3) * 16;
#pragma unroll
                    for (int bj = 0; bj < 2; ++bj) rq[bj] = *(const u32x4*)(resid + (size_t)nrow * ldc + col0 + bj * HALF); }
#pragma unroll
                for (int bj = 0; bj < 2; ++bj) { const size_t off = (size_t)row * ldc + col0 + bj * HALF; const u32x4 r = rc[bj];
                    f32x4 v0 = acc[ai][bj][m][0], v1 = acc[ai][bj][m][1];
                    v0[0] += alpha * pg_bflo(r.x); v0[1] += alpha * pg_bfhi(r.x); v0[2] += alpha * pg_bflo(r.y); v0[3] += alpha * pg_bfhi(r.y);
                    v1[0] += alpha * pg_bflo(r.z); v1[1] += alpha * pg_bfhi(r.z); v1[2] += alpha * pg_bflo(r.w); v1[3] += alpha * pg_bfhi(r.w);
                    s += ((v0[0] + v0[1]) + (v0[2] + v0[3])) + ((v1[0] + v1[1]) + (v1[2] + v1[3]));
                    ss += ((v0[0] * v0[0] + v0[1] * v0[1]) + (v0[2] * v0[2] + v0[3] * v0[3])) + ((v1[0] * v1[0] + v1[1] * v1[1]) + (v1[2] * v1[2] + v1[3] * v1[3]));
                    u32x4 w; w.x = cvt_pk_bf16(v0[0], v0[1]); w.y = cvt_pk_bf16(v0[2], v0[3]); w.z = cvt_pk_bf16(v1[0], v1[1]); w.w = cvt_pk_bf16(v1[2], v1[3]);
                    *(u32x4*)(VB + off) = w; }
                s += __shfl_xor(s, 16); s += __shfl_xor(s, 32); ss += __shfl_xor(ss, 16); ss += __shfl_xor(ss, 32);
                if (fq == 0) { float* sp = ST + (((size_t)u.pn * mrows + row) * 4 + wc) * 2; sp[0] = s; sp[1] = ss; } }
    }
};
struct EpiCombine {
    static constexpr bool PERM = true, AFTER_DRAIN = false;
    const bf16_t* h2; const bf16_t* pw; bf16_t* xb; float* outf; float* C1; int ldc;
    __device__ __forceinline__ void operator()(const f32x4 (&acc)[2][2][4][2], const Unit& u, int wr, int wc, int fr, int fq) const {
        if (u.dst) { store_chunk(acc, u, C1, ldc, wr, wc, fr, fq); return; }
        const int row0 = u.pm * BM + wr * 64 + fr, col0 = u.pn * BM + wc * 32 + 8 * fq;
        u32x4 hq[2], pq[2];
#pragma unroll
        for (int bj = 0; bj < 2; ++bj) { const size_t o0 = (size_t)row0 * ldc + col0 + bj * HALF; hq[bj] = *(const u32x4*)(h2 + o0); pq[bj] = *(const u32x4*)(pw + o0); }
#pragma unroll
        for (int idx = 0; idx < 8; ++idx) { const int ai = idx >> 2, m = idx & 3; const int row = row0 + ai * HALF + m * 16;
                u32x4 hc[2] = {hq[0], hq[1]}, pc[2] = {pq[0], pq[1]};
                if (idx + 1 < 8) { const int nrow = row0 + ((idx + 1) >> 2) * HALF + ((idx + 1) & 3) * 16;
#pragma unroll
                    for (int bj = 0; bj < 2; ++bj) { const size_t on = (size_t)nrow * ldc + col0 + bj * HALF; hq[bj] = *(const u32x4*)(h2 + on); pq[bj] = *(const u32x4*)(pw + on); } }
#pragma unroll
                for (int bj = 0; bj < 2; ++bj) { const size_t off = (size_t)row * ldc + col0 + bj * HALF; const u32x4 hh = hc[bj], pp = pc[bj];
                    const f32x4 a0 = acc[ai][bj][m][0], a1 = acc[ai][bj][m][1]; f32x4 o0, o1;
                    o0[0] = pg_bflo(hh.x) + pg_bflo(pp.x) / (1.f + __expf(-a0[0])); o0[1] = pg_bfhi(hh.x) + pg_bfhi(pp.x) / (1.f + __expf(-a0[1]));
                    o0[2] = pg_bflo(hh.y) + pg_bflo(pp.y) / (1.f + __expf(-a0[2])); o0[3] = pg_bfhi(hh.y) + pg_bfhi(pp.y) / (1.f + __expf(-a0[3]));
                    o1[0] = pg_bflo(hh.z) + pg_bflo(pp.z) / (1.f + __expf(-a1[0])); o1[1] = pg_bfhi(hh.z) + pg_bfhi(pp.z) / (1.f + __expf(-a1[1]));
                    o1[2] = pg_bflo(hh.w) + pg_bflo(pp.w) / (1.f + __expf(-a1[2])); o1[3] = pg_bfhi(hh.w) + pg_bfhi(pp.w) / (1.f + __expf(-a1[3]));
                    u32x4 w; w.x = cvt_pk_bf16(o0[0], o0[1]); w.y = cvt_pk_bf16(o0[2], o0[3]); w.z = cvt_pk_bf16(o1[0], o1[1]); w.w = cvt_pk_bf16(o1[2], o1[3]);
                    *(u32x4*)(xb + off) = w;
                    if (outf) { *(f32x4*)(outf + off) = o0; *(f32x4*)(outf + off + 4) = o1; } } }
    }
};
template <int ACT> struct EpiBf16 {
    static constexpr bool PERM = true, AFTER_DRAIN = false;
    bf16_t* O; int ldc; float* gates; int gate_pn;
    __device__ __forceinline__ void operator()(const f32x4 (&acc)[2][2][4][2], const Unit& u, int wr, int wc, int fr, int fq) const {
        const int row0 = u.pm * BM + wr * 64 + fr; const int col0 = u.pn * BM + wc * 32 + 8 * fq;
        const bool gt = (gates != nullptr) && (u.pn == gate_pn) && (wc == 0) && (fq < 2);
#pragma unroll
        for (int ai = 0; ai < 2; ++ai)
#pragma unroll
            for (int m = 0; m < 4; ++m) { const int row = row0 + ai * HALF + m * 16; bf16_t* rowp = O + (size_t)row * ldc + col0;
#pragma unroll
                for (int bj = 0; bj < 2; ++bj) { f32x4 v0 = acc[ai][bj][m][0], v1 = acc[ai][bj][m][1];
                    if (ACT == 1) {
#pragma unroll
                        for (int j = 0; j < 4; ++j) { const float a = fmaxf(v0[j], 0.f), b = fmaxf(v1[j], 0.f); v0[j] = a * a; v1[j] = b * b; } }
                    u32x4 w; w.x = cvt_pk_bf16(v0[0], v0[1]); w.y = cvt_pk_bf16(v0[2], v0[3]); w.z = cvt_pk_bf16(v1[0], v1[1]); w.w = cvt_pk_bf16(v1[2], v1[3]);
                    *(u32x4*)(rowp + bj * HALF) = w; }
                if (gt) { float* gp = gates + (size_t)row * 16 + 8 * fq; *(f32x4*)gp = acc[ai][0][m][0]; *(f32x4*)(gp + 4) = acc[ai][0][m][1]; } }
    }
};

template <class Epi, class Sched, bool ALIGN_EPI = false, bool SP2 = false>
__device__ __forceinline__ void gemm_phase(PG8_LAS unsigned char* lds, const Gemm g, const Sched& S, const Epi& E, const int tid) {
    const int wid = __builtin_amdgcn_readfirstlane(tid >> 6), lane = tid & 63, wr = wid >> 2, wc = wid & 3, fr = lane & 15, fq = lane >> 4;
    const int K = g.K;
    unsigned voffA[2], voffB[2];
#pragma unroll
    for (int i = 0; i < 2; ++i) { int R, C; stage_rc(tid * 16 + i * 8192, R, C); const int Rb = Epi::PERM ? ((R & ~31) + perm32(R & 31)) : R;
        voffA[i] = (unsigned)(R * K + C) * 2u; voffB[i] = (unsigned)(Rb * K + C) * 2u; }
    const size_t kstep = (size_t)(BK * 2);
    const size_t hstep = (size_t)HALF * K * 2;
    const size_t tstep = 2 * hstep;
    const unsigned ldsw = (unsigned)wid * 1024u;
    const int aoff = lds_byte(wr * 64 + fr, fq * 8), boff = lds_byte(wc * 32 + fr, fq * 8);
#define PG8_SA(b, h) (((b) * 2 + (h)) * HTB)
#define PG8_SB(b, h) ((4 + (b) * 2 + (h)) * HTB)
#define PG8_STAGE(bufoff, gbase, voff) do { _Pragma("unroll") for (int _i = 0; _i < 2; ++_i) \
        __builtin_amdgcn_global_load_lds((const unsigned*)((const char*)(gbase) + (voff)[_i]), (PG8_LAS unsigned*)(lds + (bufoff) + ldsw + _i * 8192), 16, 0, 0); } while (0)
#define PG8_LDA(dst, b, h) do { _Pragma("unroll") for (int m = 0; m < 4; ++m) _Pragma("unroll") for (int k = 0; k < 2; ++k) dst[m][k] = *(const PG8_LAS bf16x8*)(lds + PG8_SA(b, h) + aoff + m * 2048 + k * 1024); } while (0)
#define PG8_LDB(dst, b, h) do { _Pragma("unroll") for (int n = 0; n < 2; ++n) _Pragma("unroll") for (int k = 0; k < 2; ++k) dst[n][k] = *(const PG8_LAS bf16x8*)(lds + PG8_SB(b, h) + boff + n * 2048 + k * 1024); } while (0)
#define PG8_MMA(ai, bj, At, Bt) do { __builtin_amdgcn_s_setprio(1); _Pragma("unroll") for (int m = 0; m < 4; ++m) _Pragma("unroll") for (int n = 0; n < 2; ++n) _Pragma("unroll") for (int k = 0; k < 2; ++k) \
        acc[ai][bj][m][n] = __builtin_amdgcn_mfma_f32_16x16x32_bf16(Bt[n][k], At[m][k], acc[ai][bj][m][n], 0, 0, 0); __builtin_amdgcn_s_setprio(0); } while (0)
#define PG8_WAIT_V(n) asm volatile("s_waitcnt vmcnt(" #n ")" ::: "memory")
#define PG8_WAIT_L(n) asm volatile("s_waitcnt lgkmcnt(" #n ")" ::: "memory")
#define PG8_BAR __builtin_amdgcn_s_barrier()
#define PG8_SCHED __builtin_amdgcn_sched_barrier(0)
    Unit cur, nxt; int ui = 0;
    if (!S.next(0, cur)) return;
    f32x4 acc[2][2][4][2];
#pragma unroll
    for (int a = 0; a < 2; ++a)
#pragma unroll
        for (int b = 0; b < 2; ++b)
#pragma unroll
            for (int m = 0; m < 4; ++m)
#pragma unroll
                for (int n = 0; n < 2; ++n) acc[a][b][m][n] = (f32x4){0.f, 0.f, 0.f, 0.f};
    bf16x8 At[4][2], B0[2][2], B1[2][2];
    const char* cA = (const char*)g.A + (size_t)cur.pm * tstep + (size_t)cur.kt0 * kstep; const char* cB = (const char*)g.Bt + (size_t)cur.pn * tstep + (size_t)cur.kt0 * kstep;
    S.a_ready(cur);
    if constexpr (SP2) {
        PG8_STAGE(PG8_SB(0, 0), cB, voffB); PG8_STAGE(PG8_SB(0, 1), cB + hstep, voffB); PG8_STAGE(PG8_SA(0, 0), cA, voffA); PG8_STAGE(PG8_SA(0, 1), cA + hstep, voffA);
        if (wr == 1) PG8_BAR;
        PG8_WAIT_V(2); PG8_BAR;
        PG8_STAGE(PG8_SB(1, 0), cB + kstep, voffB); PG8_STAGE(PG8_SA(1, 0), cA + kstep, voffA); PG8_STAGE(PG8_SB(1, 1), cB + hstep + kstep, voffB);
        PG8_WAIT_V(6); PG8_BAR;
    } else {
        PG8_STAGE(PG8_SB(0, 0), cB, voffB); PG8_STAGE(PG8_SA(0, 0), cA, voffA); PG8_STAGE(PG8_SB(0, 1), cB + hstep, voffB); PG8_STAGE(PG8_SA(0, 1), cA + hstep, voffA);
        if (wr == 1) PG8_BAR;
        PG8_WAIT_V(4); PG8_BAR;
        PG8_STAGE(PG8_SB(1, 0), cB + kstep, voffB); PG8_STAGE(PG8_SA(1, 0), cA + kstep, voffA); PG8_STAGE(PG8_SB(1, 1), cB + hstep + kstep, voffB);
        PG8_WAIT_V(6); PG8_BAR;
    }
    for (;;) {
        const bool has_next = S.next(ui + 1, nxt);
        const char* nA = has_next ? (const char*)g.A + (size_t)nxt.pm * tstep + (size_t)nxt.kt0 * kstep : cA; const char* nB = has_next ? (const char*)g.Bt + (size_t)nxt.pn * tstep + (size_t)nxt.kt0 * kstep : cB;
        const int nt = cur.nkt;
        for (int t = 0; t < nt; t += 2) {
            const bool last = (t == nt - 2);
            const char* a1 = cA + (size_t)(t + 1) * kstep;
            const char* a2 = last ? nA : cA + (size_t)(t + 2) * kstep; const char* b2 = last ? nB : cB + (size_t)(t + 2) * kstep;
            const char* a3 = a2 + kstep; const char* b3 = b2 + kstep;
            if (last && has_next) S.a_ready(nxt);
            if constexpr (SP2) {
            PG8_LDB(B0, 0, 0); PG8_LDB(B1, 0, 1); PG8_SCHED; PG8_LDA(At, 0, 0); PG8_STAGE(PG8_SA(1, 1), a1 + hstep, voffA);
            PG8_WAIT_V(8); PG8_WAIT_L(0); PG8_BAR; PG8_MMA(0, 0, At, B0); PG8_MMA(0, 1, At, B1); PG8_BAR; PG8_SCHED;
            PG8_LDA(At, 0, 1); PG8_STAGE(PG8_SB(0, 0), b2, voffB); PG8_STAGE(PG8_SB(0, 1), b2 + hstep, voffB); PG8_STAGE(PG8_SA(0, 0), a2, voffA);
            PG8_WAIT_V(8); PG8_WAIT_L(0); PG8_BAR; PG8_MMA(1, 0, At, B0); PG8_MMA(1, 1, At, B1); PG8_BAR; PG8_SCHED;
            PG8_LDB(B0, 1, 0); PG8_LDB(B1, 1, 1); PG8_SCHED; PG8_LDA(At, 1, 0); PG8_STAGE(PG8_SA(0, 1), a2 + hstep, voffA);
            PG8_WAIT_V(8); PG8_WAIT_L(0); PG8_BAR; PG8_MMA(0, 0, At, B0); PG8_MMA(0, 1, At, B1); PG8_BAR; PG8_SCHED;
            PG8_LDA(At, 1, 1); PG8_STAGE(PG8_SB(1, 0), b3, voffB); PG8_STAGE(PG8_SB(1, 1), b3 + hstep, voffB); PG8_STAGE(PG8_SA(1, 0), a3, voffA);
            PG8_WAIT_V(8); PG8_WAIT_L(0); PG8_BAR; PG8_MMA(1, 0, At, B0); PG8_MMA(1, 1, At, B1); PG8_BAR; PG8_SCHED;
            } else {
            PG8_LDB(B0, 0, 0); PG8_SCHED; PG8_LDA(At, 0, 0); PG8_STAGE(PG8_SA(1, 1), a1 + hstep, voffA);
            PG8_WAIT_L(8); PG8_BAR; PG8_WAIT_L(0); PG8_MMA(0, 0, At, B0); PG8_BAR; PG8_SCHED;
            PG8_LDB(B1, 0, 1); PG8_STAGE(PG8_SB(0, 0), b2, voffB);
            PG8_BAR; PG8_WAIT_L(0); PG8_MMA(0, 1, At, B1); PG8_BAR;
            PG8_LDA(At, 0, 1); PG8_STAGE(PG8_SA(0, 0), a2, voffA);
            PG8_BAR; PG8_WAIT_L(0); PG8_MMA(1, 0, At, B0); PG8_BAR; PG8_SCHED;
            PG8_STAGE(PG8_SB(0, 1), b2 + hstep, voffB);
            PG8_WAIT_V(6); PG8_BAR; PG8_MMA(1, 1, At, B1); PG8_BAR;
            PG8_LDB(B0, 1, 0); PG8_SCHED; PG8_LDA(At, 1, 0); PG8_STAGE(PG8_SA(0, 1), a2 + hstep, voffA);
            PG8_WAIT_L(8); PG8_BAR; PG8_WAIT_L(0); PG8_MMA(0, 0, At, B0); PG8_BAR; PG8_SCHED;
            PG8_LDB(B1, 1, 1); PG8_STAGE(PG8_SB(1, 0), b3, voffB);
            PG8_BAR; PG8_WAIT_L(0); PG8_MMA(0, 1, At, B1); PG8_BAR;
            PG8_LDA(At, 1, 1); PG8_STAGE(PG8_SA(1, 0), a3, voffA);
            PG8_BAR; PG8_WAIT_L(0); PG8_MMA(1, 0, At, B0); PG8_BAR; PG8_SCHED;
            PG8_STAGE(PG8_SB(1, 1), b3 + hstep, voffB);
            PG8_WAIT_V(6); PG8_BAR; PG8_MMA(1, 1, At, B1); PG8_BAR;
            }
        }
        if constexpr (ALIGN_EPI) { if (wr == 0) PG8_BAR; }
        E(acc, cur, wr, wc, fr, fq); S.done(cur);
        if (!has_next) break;
#pragma unroll
        for (int a = 0; a < 2; ++a)
#pragma unroll
            for (int b = 0; b < 2; ++b)
#pragma unroll
                for (int m = 0; m < 4; ++m)
#pragma unroll
                    for (int n = 0; n < 2; ++n) acc[a][b][m][n] = (f32x4){0.f, 0.f, 0.f, 0.f};
        cur = nxt; cA = nA; cB = nB; ++ui;
        if constexpr (ALIGN_EPI) { if (wr == 1) PG8_BAR; }
    }
    PG8_WAIT_V(0);
    if constexpr (!ALIGN_EPI) { if (wr == 0) PG8_BAR; }
    PG8_BAR;
#undef PG8_SA
#undef PG8_SB
#undef PG8_STAGE
#undef PG8_LDA
#undef PG8_LDB
#undef PG8_MMA
#undef PG8_WAIT_V
#undef PG8_WAIT_L
#undef PG8_BAR
#undef PG8_SCHED
}
}

constexpr int NWAVES = 8, NTHR = 512;
constexpr int D = 2048, FF = 8192, PLE = 256;
constexpr int TP = 2048, BP = 4, TS = 4, BS = 128;
constexpr int MP = BP * TP, MS = BS * TS, M = MP + MS;
constexpr int NPROJ = 6160, NPROJ_PAD = 6400;
constexpr int NH = 8;
constexpr float LN_EPS = 1e-5f, RMS_EPS = 1e-6f;
constexpr float DN_ALPHA = 1.41421356237f;

constexpr size_t MiB = 1u << 20;
constexpr size_t WS_CTL = 0;
constexpr size_t WS_WINE = 1 * MiB;
constexpr size_t WS_WOUTE = WS_WINE + 25 * MiB;
constexpr size_t WS_WINO = WS_WOUTE + 8 * MiB;
constexpr size_t WS_WOUTO = WS_WINO + 25 * MiB;
constexpr size_t WS_WUP = WS_WOUTO + 8 * MiB;
constexpr size_t WS_WDOWN = WS_WUP + 64 * MiB;
constexpr size_t WS_WPLE = WS_WDOWN + 64 * MiB;
constexpr size_t WS_WGATE = WS_WPLE + 2 * MiB;
constexpr size_t WS_XB = WS_WGATE + 16 * MiB;
constexpr size_t WS_MIX = WS_XB + 34 * MiB;
constexpr size_t WS_H = WS_MIX + 34 * MiB;
constexpr size_t WS_H2 = WS_H + 34 * MiB;
constexpr size_t WS_PW = WS_H2 + 34 * MiB;
constexpr size_t WS_PB = WS_PW + 34 * MiB;
constexpr size_t WS_GATES = WS_PB + 9 * MiB;
constexpr size_t WS_PROJ = WS_GATES + 1 * MiB;
constexpr size_t WS_PART0 = WS_PROJ + 136 * MiB;
constexpr size_t WS_PART1 = WS_PART0 + 68 * MiB;
constexpr size_t WS_LRUW = WS_PART1 + 68 * MiB;
constexpr size_t WS_END = WS_LRUW + 1 * MiB;
constexpr size_t WS_DG = WS_PART0;
constexpr size_t WS_DB = WS_PART0 + 32 * MiB;
constexpr size_t WS_DS = WS_PART0 + 64 * MiB;
constexpr size_t WS_DQ = WS_PART0 + 96 * MiB;
constexpr size_t WS_DO = WS_PART0 + 112 * MiB;
constexpr size_t WS_DD = WS_PART0 + 128 * MiB;
constexpr size_t WS_DF = WS_PART0 + 129 * MiB;
constexpr size_t WS_MC = WS_PART0;
constexpr size_t WS_MN = WS_PART0 + 64 * MiB;
constexpr size_t WS_MM = WS_PART0 + 65 * MiB;
constexpr size_t WS_LRU_HL = WS_H;
constexpr size_t WS_LRU_P = WS_H + 16 * MiB;
constexpr size_t WS_LRU_END = WS_H + 32 * MiB;

constexpr size_t O_Y = 0;
constexpr size_t O_CONVP = (size_t)M * D;
constexpr size_t O_DELTAP = O_CONVP + (size_t)BP * 3 * 4096;
constexpr size_t O_LRUP = O_DELTAP + (size_t)BP * 8 * 128 * 128;
constexpr size_t O_MCP = O_LRUP + (size_t)BP * 1024;
constexpr size_t O_MNP = O_MCP + (size_t)BP * 8 * 256 * 128;
constexpr size_t O_MMP = O_MNP + (size_t)BP * 8 * 128;
constexpr size_t O_CONVS = O_MMP + (size_t)BP * 8;
constexpr size_t O_DELTAS = O_CONVS + (size_t)BS * 3 * 4096;
constexpr size_t O_LRUS = O_DELTAS + (size_t)BS * 8 * 128 * 128;
constexpr size_t O_MCS = O_LRUS + (size_t)BS * 1024;
constexpr size_t O_MNS = O_MCS + (size_t)BS * 8 * 256 * 128;
constexpr size_t O_MMS = O_MNS + (size_t)BS * 8 * 128;
constexpr size_t O_END = O_MMS + (size_t)BS * 8;

constexpr int LDS_BYTES = 147456;
constexpr int LDS_CTL_OFF = 131072;

#define LAS __attribute__((address_space(3)))
typedef unsigned short bf16;
typedef unsigned v4u __attribute__((ext_vector_type(4)));
typedef unsigned v2u __attribute__((ext_vector_type(2)));
typedef float f32x4 __attribute__((ext_vector_type(4)));
#define LDS_WAIT() asm volatile("s_waitcnt lgkmcnt(0)" ::: "memory")
#define LDS_BARRIER() do { asm volatile("s_waitcnt lgkmcnt(0)" ::: "memory"); __builtin_amdgcn_s_barrier(); asm volatile("" ::: "memory"); } while (0)
__device__ __forceinline__ unsigned f2bf(float f) { unsigned u = __builtin_bit_cast(unsigned, f); return (u + 0x7fffu + ((u >> 16) & 1u)) >> 16; }
__device__ __forceinline__ unsigned pk2(float lo, float hi) { return f2bf(lo) | (f2bf(hi) << 16); }
__device__ __forceinline__ float bf2f(unsigned short b) { return __builtin_bit_cast(float, ((unsigned)b) << 16); }
__device__ __forceinline__ float bflo(unsigned w) { return __builtin_bit_cast(float, w << 16); }
__device__ __forceinline__ float bfhi(unsigned w) { return __builtin_bit_cast(float, w & 0xffff0000u); }
__device__ __forceinline__ float fexp(float x) { return __builtin_amdgcn_exp2f(x * 1.4426950408889634f); }
__device__ __forceinline__ float sigm(float x) { return __builtin_amdgcn_rcpf(1.f + fexp(-x)); }
__device__ __forceinline__ float siluf(float x) { return x * sigm(x); }
__device__ __forceinline__ float softplusf(float x) { return fmaxf(x, 0.f) + log1pf(expf(-fabsf(x))); }
__device__ __forceinline__ float logsigf(float x) { return -softplusf(-x); }
__device__ __forceinline__ float neg_expm1(float y) {
    const float ser = -y * (1.f + y * (0.5f + y * (0.16666667f + y * (0.041666668f + y * (0.008333334f + y * 0.0013888889f)))));
    return (y > -0.25f) ? ser : 1.f - fexp(y);
}
__device__ __forceinline__ float gelu_tanh(float x) { const float u = 0.7978845608028654f * (x + 0.044715f * x * x * x); return x * sigm(2.f * u); }
__device__ __forceinline__ float wave_sum(float v) {
#pragma unroll
    for (int o = 1; o < 64; o <<= 1) v += __shfl_xor(v, o);
    return v;
}

__device__ __forceinline__ float wave_incl_sum(float v, int lane) {
#pragma unroll
    for (int o = 1; o < 64; o <<= 1) { const float u = __shfl_up(v, o); if (lane >= o) v += u; }
    return v;
}
__device__ __forceinline__ float wave_incl_max(float v, int lane) {
#pragma unroll
    for (int o = 1; o < 64; o <<= 1) { const float u = __shfl_up(v, o); if (lane >= o) v = fmaxf(v, u); }
    return v;
}
__device__ __forceinline__ float wave_max(float v) {
#pragma unroll
    for (int o = 1; o < 64; o <<= 1) v = fmaxf(v, __shfl_xor(v, o));
    return v;
}
#define XB_TMO      128
#define XB_XCNT(j)  (256  + 64 * (j))
#define XB_XSUB(j)  (1280 + 64 * (j))
#define XB_XGEN(j)  (2304 + 64 * (j))
#define XB_TOP      3328
#define XB_TOPGEN   3392
#define XCD_BAR_WORDS 3456
#define XB_SPIN_CAP (1u << 22)
__device__ __forceinline__ unsigned xb_ld(unsigned* p)              { return __hip_atomic_load(p, __ATOMIC_RELAXED, __HIP_MEMORY_SCOPE_AGENT); }
__device__ __forceinline__ unsigned xb_add(unsigned* p, unsigned v) { return __hip_atomic_fetch_add(p, v, __ATOMIC_RELAXED, __HIP_MEMORY_SCOPE_AGENT); }
__device__ __forceinline__ unsigned xb_xcc_id() { return (unsigned)__builtin_amdgcn_s_getreg((3 << 11) | 20) & 0xFu; }
#define XB_SPIN(cond, bar) do { unsigned _sp = 0; while (cond) { __builtin_amdgcn_s_sleep(1); \
    if ((++_sp & 255u) == 0u) { if (xb_ld(&(bar)[XB_TMO])) break; if (_sp > XB_SPIN_CAP) { atomicAdd(&(bar)[XB_TMO], 1u); break; } } } } while (0)
struct XcdBarrier { unsigned* bar; unsigned x; volatile LAS unsigned* st; };
__device__ __forceinline__ XcdBarrier xcd_barrier_post(unsigned* bar, volatile LAS unsigned* st) {
    XcdBarrier b; b.bar = bar; b.x = xb_xcc_id(); b.st = st;
    if (threadIdx.x == 0) (void)xb_add(&bar[XB_XCNT(b.x)], 1u);
    return b;
}
__device__ __forceinline__ void xcd_barrier_complete(unsigned* bar, unsigned x, unsigned& nloc, unsigned& nx) {
    const unsigned G = gridDim.x * gridDim.y * gridDim.z;
    unsigned sum, cnt, mine, sp = 0u;
    for (;;) {
        sum = 0u; cnt = 0u; mine = 0u;
#pragma unroll
        for (unsigned j = 0; j < 16; ++j) { const unsigned c = xb_ld(&bar[XB_XCNT(j)]); sum += c; cnt += (c > 0u) ? 1u : 0u; mine = (j == x) ? c : mine; }
        if (sum == G) break;
        __builtin_amdgcn_s_sleep(1);
        if ((++sp & 255u) == 0u) { if (xb_ld(&bar[XB_TMO])) break; if (sp > XB_SPIN_CAP) { atomicAdd(&bar[XB_TMO], 1u); break; } }
    }
    nloc = mine > 0u ? mine : 1u; nx = cnt > 0u ? cnt : 1u;
}
__device__ __forceinline__ void xcd_barrier(const XcdBarrier& b) {
    asm volatile("s_waitcnt vmcnt(0)" ::: "memory");
    __syncthreads();
    if (threadIdx.x == 0) {
        unsigned* bar = b.bar;
        __builtin_amdgcn_s_waitcnt(0);
        unsigned nloc = b.st[0], nx = b.st[1];
        if (nloc == 0u) { xcd_barrier_complete(bar, b.x, nloc, nx); b.st[0] = nloc; b.st[1] = nx; }
        const unsigned old = xb_add(&bar[XB_XSUB(b.x)], 1u);
        const unsigned gen = old / nloc;
        if (old + 1u == (gen + 1u) * nloc) {
            __builtin_amdgcn_fence(__ATOMIC_RELEASE, "agent");
            asm volatile("s_waitcnt vmcnt(0)" ::: "memory");
            const unsigned og = xb_add(&bar[XB_TOP], 1u);
            const unsigned tg = og / nx;
            if (og + 1u == (tg + 1u) * nx) xb_add(&bar[XB_TOPGEN], 1u);
            else XB_SPIN(xb_ld(&bar[XB_TOPGEN]) == tg, bar);
            __builtin_amdgcn_fence(__ATOMIC_ACQUIRE, "agent");
            xb_add(&bar[XB_XGEN(b.x)], 1u);
            asm volatile("s_waitcnt vmcnt(0)" ::: "memory");
        } else {
            XB_SPIN(xb_ld(&bar[XB_XGEN(b.x)]) == gen, bar);
            __builtin_amdgcn_fence(__ATOMIC_ACQUIRE, "agent");
            asm volatile("s_waitcnt vmcnt(0)" ::: "memory");
        }
    }
    __syncthreads();
}

struct Args { const float* in[35]; float* out; unsigned char* ws; int ph_lo, ph_hi; };
typedef const __attribute__((address_space(4))) Args* ArgsP;
enum { I_XP = 0, I_XS, I_PP, I_PS, I_SCONV, I_SDELTA, I_SLRU, I_SMC, I_SMN, I_SMM, I_WINE, I_WCONV, I_BCONV, I_ALOG, I_DTB, I_DNORM, I_LWR, I_LBR, I_LWI, I_LBI, I_LLAM, I_WOUTE,
       I_WINO, I_BIG, I_BFG, I_MNORM, I_WOUTO, I_LN1G, I_LN1B, I_LN2G, I_LN2B, I_WUP, I_WDOWN, I_WPLE, I_WGATE };

struct TDesc { const float* W; bf16* WT; int K, N, Npad, item; };
__device__ __forceinline__ void t_load(const TDesc& d, int lane, f32x4 (&v)[8]) {
    const int nblk = d.Npad / 32, kb = d.item / nblk, nb = d.item % nblk, k0 = 64 * kb, n0 = 32 * nb;
    const int r = lane >> 3, c4 = lane & 7; const bool ok = (n0 + 4 * c4) < d.N;
#pragma unroll
    for (int i = 0; i < 8; ++i) v[i] = ok ? __builtin_nontemporal_load((const f32x4*)(d.W + (size_t)(k0 + 8 * i + r) * d.N + n0 + 4 * c4)) : (f32x4){0.f, 0.f, 0.f, 0.f};
}
__device__ __forceinline__ void t_finish(const TDesc& d, LAS float* scr, int lane, const f32x4 (&v)[8]) {
    const int nblk = d.Npad / 32, kb = d.item / nblk, nb = d.item % nblk, k0 = 64 * kb, n0 = 32 * nb;
    const int r = lane >> 3, c4 = lane & 7;
#pragma unroll
    for (int i = 0; i < 8; ++i) { LAS float* q = scr + (8 * i + r) * 33 + 4 * c4; q[0] = v[i].x; q[1] = v[i].y; q[2] = v[i].z; q[3] = v[i].w; }
    LDS_WAIT(); asm volatile("" ::: "memory");
    const int c = lane & 7;
#pragma unroll
    for (int j = 0; j < 4; ++j) { const int n = (lane >> 3) + 8 * j; const LAS float* s = scr + (8 * c) * 33 + n;
        v4u o; o.x = pk2(s[0 * 33], s[1 * 33]); o.y = pk2(s[2 * 33], s[3 * 33]); o.z = pk2(s[4 * 33], s[5 * 33]); o.w = pk2(s[6 * 33], s[7 * 33]);
        *(v4u*)(d.WT + (size_t)(n0 + n) * d.K + k0 + 8 * c) = o; }
    LDS_WAIT(); asm volatile("" ::: "memory");
}
__device__ __forceinline__ void p0_transpose_item(const float* W, int K, int N, int Npad, bf16* WT, LAS float* scr, int item, int lane) {
    const TDesc d{W, WT, K, N, Npad, item}; f32x4 v[8]; t_load(d, lane, v); t_finish(d, scr, lane, v);
}
template <int N> __device__ __forceinline__ void row_to_bf16(const float* src, bf16* dst, int lane) {
    f32x4 v[N / 256];
#pragma unroll
    for (int j = 0; j < N / 256; ++j) v[j] = __builtin_nontemporal_load((const f32x4*)(src + j * 256 + lane * 4));
#pragma unroll
    for (int j = 0; j < N / 256; ++j) { v2u o; o.x = pk2(v[j].x, v[j].y); o.y = pk2(v[j].z, v[j].w); *(v2u*)(dst + j * 256 + lane * 4) = o; }
}
namespace cv { constexpr int I_IN = (D / 64) * (NPROJ_PAD / 32), I_SQ = (D / 64) * (D / 32), I_UP = (D / 64) * (FF / 32), I_DN = (FF / 64) * (D / 32), I_PL = (PLE / 64) * (D / 32);
               constexpr int N_FIRST = I_IN + I_PL + 128, N_REST = I_IN + 2 * I_SQ + 2 * I_UP + 2 * I_DN + I_PL + 2 * I_SQ;
               constexpr int R_IN0 = 6200;
               constexpr int R_G1 = I_SQ + I_UP + I_SQ + I_IN + I_SQ + I_PL + I_SQ;
               constexpr int R_IN1 = R_G1 + I_UP;
               constexpr int R_SCAN = R_IN1 - 6200;
               constexpr int R_UP0 = R_IN1 + I_DN;
               static_assert(R_UP0 + I_DN == N_REST && R_SCAN > R_G1 && R_SCAN > R_IN0, "conversion ranges"); }
__device__ __forceinline__ void convert_first_item(ArgsP a, LAS float* scr, int r, int lane) {
    unsigned char* ws = a->ws;
    if (r < cv::I_IN) { p0_transpose_item(a->in[I_WINE], D, NPROJ, NPROJ_PAD, (bf16*)(ws + WS_WINE), scr, r, lane); return; } r -= cv::I_IN;
    if (r < cv::I_PL) { p0_transpose_item(a->in[I_WPLE], PLE, D, D, (bf16*)(ws + WS_WPLE), scr, r, lane); return; } r -= cv::I_PL;
    { const int mat = r / 64, blk = (r / 8) & 7; p0_transpose_item(a->in[mat == 0 ? I_LWR : I_LWI] + (size_t)blk * 16384, 128, 128, 128, (bf16*)(ws + WS_LRUW) + (size_t)(mat * 8 + blk) * 16384, scr, r % 8, lane); }
}
__device__ __forceinline__ TDesc decode_rest(ArgsP a, int r) {
    using namespace cv; unsigned char* ws = a->ws;
    if (r < I_SQ) return TDesc{a->in[I_WOUTE], (bf16*)(ws + WS_WOUTE), D, D, D, r}; r -= I_SQ;
    if (r < I_UP) return TDesc{a->in[I_WUP], (bf16*)(ws + WS_WUP), D, FF, FF, r}; r -= I_UP;
    if (r < I_SQ) return TDesc{a->in[I_WGATE], (bf16*)(ws + WS_WGATE), D, D, D, r}; r -= I_SQ;
    if (r < I_IN) return TDesc{a->in[I_WINO], (bf16*)(ws + WS_WINO), D, NPROJ, NPROJ_PAD, r}; r -= I_IN;
    if (r < I_SQ) return TDesc{a->in[I_WOUTO], (bf16*)(ws + WS_WOUTO), D, D, D, r}; r -= I_SQ;
    if (r < I_PL) return TDesc{a->in[I_WPLE] + (size_t)PLE * D, (bf16*)(ws + WS_WPLE) + (size_t)PLE * D, PLE, D, D, r}; r -= I_PL;
    if (r < I_SQ) return TDesc{a->in[I_WGATE] + (size_t)D * D, (bf16*)(ws + WS_WGATE) + (size_t)D * D, D, D, D, r}; r -= I_SQ;
    if (r < I_UP) return TDesc{a->in[I_WUP] + (size_t)D * FF, (bf16*)(ws + WS_WUP) + (size_t)D * FF, D, FF, FF, r}; r -= I_UP;
    if (r < I_DN) return TDesc{a->in[I_WDOWN], (bf16*)(ws + WS_WDOWN), FF, D, D, r}; r -= I_DN;
    return TDesc{a->in[I_WDOWN] + (size_t)D * FF, (bf16*)(ws + WS_WDOWN) + (size_t)D * FF, FF, D, D, r};
}
__device__ __forceinline__ void convert_range(ArgsP a, LAS float* scr, int first, int last, int widx, int nw, int lane) {
    int it = first + widx;
    TDesc dA, dB; f32x4 vA[8], vB[8];
    if (it < last) { dA = decode_rest(a, it); t_load(dA, lane, vA);
#pragma unroll 1
        for (;;) {
            const int itB = it + nw; const bool hasB = itB < last;
            if (hasB) { dB = decode_rest(a, itB); t_load(dB, lane, vB); }
            t_finish(dA, scr, lane, vA);
            if (!hasB) break;
            it = itB + nw; const bool hasA = it < last;
            if (hasA) { dA = decode_rest(a, it); t_load(dA, lane, vA); }
            t_finish(dB, scr, lane, vB);
            if (!hasA) break;
        } }
}
__device__ __forceinline__ void phase_convert(ArgsP a, LAS unsigned char* lds, int gw, int NGW, int wave, int lane) {
    unsigned char* ws = a->ws;
    LAS float* scr = (LAS float*)(lds + wave * 16384);
    for (int it = gw; it < cv::N_FIRST; it += NGW) convert_first_item(a, scr, it, lane);
    bf16* xb = (bf16*)(ws + WS_XB);
    for (int m = gw; m < M; m += NGW) {
        const float* src = m < MP ? a->in[I_XP] + (size_t)m * D : a->in[I_XS] + (size_t)(m - MP) * D;
        row_to_bf16<D>(src, xb + (size_t)m * D, lane);
    }
    bf16* pb = (bf16*)(ws + WS_PB);
    for (int r = gw; r < 2 * M; r += NGW) {
        const int l = r / M, m = r % M;
        const float* src = m < MP ? a->in[I_PP] + ((size_t)l * MP + m) * PLE : a->in[I_PS] + ((size_t)l * MS + (m - MP)) * PLE;
        row_to_bf16<PLE>(src, pb + (size_t)r * PLE, lane);
    }
}

__device__ __forceinline__ float conv_in(const bf16* proj, int row0, int tq, int ch, const float* cstate) {
    if (tq >= 0) return bf2f(proj[(size_t)(row0 + tq) * NPROJ_PAD + ch]);
    return cstate ? cstate[(3 + tq) * 4096 + ch] : 0.f;
}
__device__ __forceinline__ float conv4(const bf16* proj, int row0, int t, int ch, const float* cstate, const float* wconv, const float* bconv) {
    float acc = bconv[ch];
#pragma unroll
    for (int j = 0; j < 4; ++j) acc += wconv[j * 4096 + ch] * conv_in(proj, row0, t - 3 + j, ch, cstate);
    return acc;
}

__device__ __forceinline__ void delta_rec_item(ArgsP a, LAS unsigned char* lds, int row0, int T, int h, const float* cstate, const float* S0, float* Sout, const int tid) {
    const int lane = tid & 63, wave = tid >> 6, c = tid & 127, r = tid >> 7;
    const bf16* proj = (const bf16*)(a->ws + WS_PROJ); const float* gates = (const float*)(a->ws + WS_GATES); bf16* mix = (bf16*)(a->ws + WS_MIX);
    const float* wconv = a->in[I_WCONV]; const float* bconv = a->in[I_BCONV];
    LAS float* act = (LAS float*)lds;
    LAS float* nrm = act + 4 * 384;
    LAS float* gb = nrm + 8;
    LAS float* red = gb + 8;
    LAS float* red2 = red + 512;
    LAS float* obuf = red2 + 512;
    float s[32];
#pragma unroll
    for (int i = 0; i < 32; ++i) s[i] = S0 ? S0[(size_t)(32 * r + i) * 128 + c] : 0.f;
    const float aexp = fexp(a->in[I_ALOG][h]), dtb = a->in[I_DTB][h];
#pragma unroll 1
    for (int t0 = 0; t0 < T; t0 += 4) {
#pragma unroll
        for (int j = 0; j < 3; ++j) { const int idx = tid + 512 * j, tok = idx / 384, chl = idx % 384, part = chl >> 7, i = chl & 127;
            const int ch = part * 1024 + h * 128 + i;
            act[tok * 384 + chl] = siluf(conv4(proj, row0, t0 + tok, ch, cstate, wconv, bconv)); }
        LDS_BARRIER();
        { const int tok = wave >> 1, part = wave & 1; const float x0 = act[tok * 384 + part * 128 + lane], x1 = act[tok * 384 + part * 128 + 64 + lane];
          const float ss = wave_sum(x0 * x0 + x1 * x1); if (lane == 0) nrm[tok * 2 + part] = rsqrtf(ss + 1e-6f) * (part == 0 ? 0.08838834764831845f : 1.f); }
        if (tid < 4) { const int row = row0 + t0 + tid; const float g = -aexp * softplusf(gates[(size_t)row * 16 + h] + dtb); gb[tid * 2] = fexp(g); gb[tid * 2 + 1] = sigm(gates[(size_t)row * 16 + 8 + h]); }
        LDS_BARRIER();
#pragma unroll 1
        for (int tok = 0; tok < 4; ++tok) {
            const float eg = gb[tok * 2], beta = gb[tok * 2 + 1], nq = nrm[tok * 2], nk = nrm[tok * 2 + 1];
            const LAS float* qv = act + tok * 384 + 32 * r; const LAS float* kv = qv + 128;
            float ks = 0.f;
#pragma unroll
            for (int i = 0; i < 32; ++i) ks += kv[i] * s[i];
            red[r * 128 + c] = ks * nk;
            LDS_BARRIER();
            const float kS = red[c] + red[128 + c] + red[256 + c] + red[384 + c];
            const float vnew = beta * (act[tok * 384 + 256 + c] - eg * kS);
            float os = 0.f;
#pragma unroll
            for (int i = 0; i < 32; ++i) { s[i] = eg * s[i] + (kv[i] * nk) * vnew; os += qv[i] * s[i]; }
            red2[r * 128 + c] = os * nq;
            LDS_BARRIER();
            if (r == 0) obuf[tok * 128 + c] = red2[c] + red2[128 + c] + red2[256 + c] + red2[384 + c];
        }
        LDS_BARRIER();
        if (wave < 4) { const int tok = wave, row = row0 + t0 + tok; const float o0 = obuf[tok * 128 + lane], o1 = obuf[tok * 128 + 64 + lane];
            const float rstd = rsqrtf(wave_sum(o0 * o0 + o1 * o1) * (1.f / 128.f) + RMS_EPS);
            const float* nw = a->in[I_DNORM];
            const float z0 = bf2f(proj[(size_t)row * NPROJ_PAD + 4096 + h * 128 + lane]), z1 = bf2f(proj[(size_t)row * NPROJ_PAD + 4096 + h * 128 + 64 + lane]);
            mix[(size_t)row * D + h * 128 + lane] = (bf16)f2bf(o0 * rstd * nw[lane] * siluf(z0));
            mix[(size_t)row * D + h * 128 + 64 + lane] = (bf16)f2bf(o1 * rstd * nw[64 + lane] * siluf(z1)); }
        LDS_BARRIER();
    }
#pragma unroll
    for (int i = 0; i < 32; ++i) Sout[(size_t)(32 * r + i) * 128 + c] = s[i];
}


typedef short bf16x8 __attribute__((ext_vector_type(8)));
#define MFMA32(a_, b_, c_) __builtin_amdgcn_mfma_f32_16x16x32_bf16(a_, b_, c_, 0, 0, 0)

__device__ __forceinline__ void lru_prep_item(ArgsP a, LAS unsigned char* lds, int item, const int tid) {
    const int c = item & 31, n = (item >> 5) & 7, b = item >> 8;
    const int lane = tid & 63, w = __builtin_amdgcn_readfirstlane(tid >> 6), fr = lane & 15, fq = lane >> 4;
    unsigned char* ws = a->ws;
    const bf16* proj = (const bf16*)(ws + WS_PROJ);
    LAS bf16* xa = (LAS bf16*)lds;
    LAS float* xf = (LAS float*)(lds + 17408);
    LAS float* obH = (LAS float*)(lds + 51200);
    LAS float* obP = obH + 64 * 132;
    {
        const int t = tid >> 3, sub = tid & 7, ch0 = 3072 + n * 128 + sub * 16;
        const float* wconv = a->in[I_WCONV]; const float* bconv = a->in[I_BCONV];
        float x[16];
#pragma unroll
        for (int i = 0; i < 4; ++i) { const f32x4 bb = *(const f32x4*)(bconv + ch0 + 4 * i); x[4 * i] = bb.x; x[4 * i + 1] = bb.y; x[4 * i + 2] = bb.z; x[4 * i + 3] = bb.w; }
#pragma unroll
        for (int j = 0; j < 4; ++j) { const int tt = 64 * c + t - 3 + j;
            if (tt >= 0) { const bf16* pr = proj + (size_t)(b * TP + tt) * NPROJ_PAD + ch0; const v4u u0 = *(const v4u*)pr, u1 = *(const v4u*)(pr + 8);
                const unsigned uu[8] = {u0.x, u0.y, u0.z, u0.w, u1.x, u1.y, u1.z, u1.w};
#pragma unroll
                for (int i = 0; i < 4; ++i) { const f32x4 ww = *(const f32x4*)(wconv + j * 4096 + ch0 + 4 * i);
                    x[4 * i] += ww.x * bflo(uu[2 * i]); x[4 * i + 1] += ww.y * bfhi(uu[2 * i]); x[4 * i + 2] += ww.z * bflo(uu[2 * i + 1]); x[4 * i + 3] += ww.w * bfhi(uu[2 * i + 1]); } } }
        v4u o0, o1; o0.x = pk2(x[0], x[1]); o0.y = pk2(x[2], x[3]); o0.z = pk2(x[4], x[5]); o0.w = pk2(x[6], x[7]); o1.x = pk2(x[8], x[9]); o1.y = pk2(x[10], x[11]); o1.z = pk2(x[12], x[13]); o1.w = pk2(x[14], x[15]);
        *(LAS v4u*)(xa + t * 136 + sub * 16) = o0; *(LAS v4u*)(xa + t * 136 + sub * 16 + 8) = o1;
#pragma unroll
        for (int i = 0; i < 4; ++i) *(LAS f32x4*)(xf + t * 132 + sub * 16 + 4 * i) = (f32x4){x[4 * i], x[4 * i + 1], x[4 * i + 2], x[4 * i + 3]};
    }
    LDS_BARRIER();
    const bf16* wrT = (const bf16*)(ws + WS_LRUW) + (size_t)n * 16384; const bf16* wiT = wrT + 8 * 16384;
    bf16x8 br[4], bi[4];
#pragma unroll
    for (int ks = 0; ks < 4; ++ks) { br[ks] = *(const bf16x8*)(wrT + (16 * w + fr) * 128 + 32 * ks + 8 * fq); bi[ks] = *(const bf16x8*)(wiT + (16 * w + fr) * 128 + 32 * ks + 8 * fq); }
    f32x4 accr[4], acci[4];
#pragma unroll
    for (int tb = 0; tb < 4; ++tb) { accr[tb] = (f32x4){0.f, 0.f, 0.f, 0.f}; acci[tb] = (f32x4){0.f, 0.f, 0.f, 0.f};
#pragma unroll
        for (int ks = 0; ks < 4; ++ks) { const bf16x8 af = *(const LAS bf16x8*)(xa + (16 * tb + fr) * 136 + 32 * ks + 8 * fq); accr[tb] = MFMA32(af, br[ks], accr[tb]); acci[tb] = MFMA32(af, bi[ks], acci[tb]); } }
    const int dl = 16 * w + fr, chn = n * 128 + dl;
    const float brs = a->in[I_LBR][chn], bis = a->in[I_LBI][chn], spl = softplusf(-a->in[I_LLAM][chn]);
    float Apre = 1.f, Hpre = 0.f;
#pragma unroll
    for (int tb = 0; tb < 4; ++tb) {
        float P[4], Hh[4];
#pragma unroll
        for (int j = 0; j < 4; ++j) { const int t = 16 * tb + 4 * fq + j;
            const float log_a = -8.f * sigm(accr[tb][j] + brs) * spl; const float av = fexp(log_a);
            const float bx = sqrtf(neg_expm1(2.f * log_a)) * sigm(acci[tb][j] + bis) * xf[t * 132 + dl];
            if (j == 0) { P[0] = av; Hh[0] = bx; } else { P[j] = P[j - 1] * av; Hh[j] = av * Hh[j - 1] + bx; } }
        float Ai = P[3], Hi = Hh[3];
        { const float A2 = __shfl_up(Ai, 16), H2 = __shfl_up(Hi, 16); if (fq >= 1) { Hi = Ai * H2 + Hi; Ai = A2 * Ai; } }
        { const float A2 = __shfl_up(Ai, 32), H2 = __shfl_up(Hi, 32); if (fq >= 2) { Hi = Ai * H2 + Hi; Ai = A2 * Ai; } }
        float Aex = __shfl_up(Ai, 16), Hex = __shfl_up(Hi, 16); if (fq == 0) { Aex = 1.f; Hex = 0.f; }
        const float Atb = __shfl(Ai, 48 + fr), Htb = __shfl(Hi, 48 + fr);
        const float EA = Apre * Aex, EH = Aex * Hpre + Hex;
#pragma unroll
        for (int j = 0; j < 4; ++j) { const int t = 16 * tb + 4 * fq + j; obP[t * 132 + dl] = EA * P[j]; obH[t * 132 + dl] = P[j] * EH + Hh[j]; }
        Hpre = Atb * Hpre + Htb; Apre = Apre * Atb;
    }
    if (fq == 0) { float* e = (float*)(ws + WS_LRU_END) + (size_t)item * 256; e[dl] = Apre; e[128 + dl] = Hpre; }
    LDS_BARRIER();
    {
        const int t = tid >> 3, sub = tid & 7;
        bf16* hl = (bf16*)(ws + WS_LRU_HL) + ((size_t)item * 64 + t) * 128 + sub * 16; bf16* pp = (bf16*)(ws + WS_LRU_P) + ((size_t)item * 64 + t) * 128 + sub * 16;
        const LAS float* sh = obH + t * 132 + sub * 16; const LAS float* sp = obP + t * 132 + sub * 16;
        v4u o0, o1;
        o0.x = pk2(sh[0], sh[1]); o0.y = pk2(sh[2], sh[3]); o0.z = pk2(sh[4], sh[5]); o0.w = pk2(sh[6], sh[7]); o1.x = pk2(sh[8], sh[9]); o1.y = pk2(sh[10], sh[11]); o1.z = pk2(sh[12], sh[13]); o1.w = pk2(sh[14], sh[15]);
        *(v4u*)hl = o0; *(v4u*)(hl + 8) = o1;
        o0.x = pk2(sp[0], sp[1]); o0.y = pk2(sp[2], sp[3]); o0.z = pk2(sp[4], sp[5]); o0.w = pk2(sp[6], sp[7]); o1.x = pk2(sp[8], sp[9]); o1.y = pk2(sp[10], sp[11]); o1.z = pk2(sp[12], sp[13]); o1.w = pk2(sp[14], sp[15]);
        *(v4u*)pp = o0; *(v4u*)(pp + 8) = o1;
    }
    LDS_BARRIER();
}
__device__ __forceinline__ void lru_out_item(ArgsP a, LAS unsigned char* lds, int item, const int tid) {
    const int c = item & 31, n = (item >> 5) & 7, b = item >> 8;
    unsigned char* ws = a->ws;
    LAS float* carry = (LAS float*)lds;
    if (tid < 128) { float cr = 0.f; const float* e = (const float*)(ws + WS_LRU_END) + (size_t)(item - c) * 256;
        float pv[31], hv_[31];
#pragma unroll
        for (int k = 0; k < 31; ++k) { const bool on = k < c; pv[k] = on ? e[k * 256 + tid] : 1.f; hv_[k] = on ? e[k * 256 + 128 + tid] : 0.f; }
#pragma unroll
        for (int k = 0; k < 31; ++k) cr = hv_[k] + pv[k] * cr;
        carry[tid] = cr; }
    LDS_BARRIER();
    const int t = tid >> 3, sub = tid & 7, d0 = sub * 16, row = b * TP + 64 * c + t;
    const bf16* hl = (const bf16*)(ws + WS_LRU_HL) + ((size_t)item * 64 + t) * 128 + d0; const bf16* pp = (const bf16*)(ws + WS_LRU_P) + ((size_t)item * 64 + t) * 128 + d0;
    const bf16* gp = (const bf16*)(ws + WS_PROJ) + (size_t)row * NPROJ_PAD + 5120 + n * 128 + d0;
    const v4u h0 = *(const v4u*)hl, h1 = *(const v4u*)(hl + 8), p0 = *(const v4u*)pp, p1 = *(const v4u*)(pp + 8), g0 = *(const v4u*)gp, g1 = *(const v4u*)(gp + 8);
    const unsigned hu[8] = {h0.x, h0.y, h0.z, h0.w, h1.x, h1.y, h1.z, h1.w}, pu[8] = {p0.x, p0.y, p0.z, p0.w, p1.x, p1.y, p1.z, p1.w}, gu[8] = {g0.x, g0.y, g0.z, g0.w, g1.x, g1.y, g1.z, g1.w};
    float hv[16]; unsigned ou[8];
#pragma unroll
    for (int i = 0; i < 8; ++i) { hv[2 * i] = bflo(hu[i]) + bflo(pu[i]) * carry[d0 + 2 * i]; hv[2 * i + 1] = bfhi(hu[i]) + bfhi(pu[i]) * carry[d0 + 2 * i + 1];
        ou[i] = pk2(hv[2 * i] * gelu_tanh(bflo(gu[i])), hv[2 * i + 1] * gelu_tanh(bfhi(gu[i]))); }
    bf16* mp = (bf16*)(ws + WS_MIX) + (size_t)row * D + 1024 + n * 128 + d0;
    *(v4u*)mp = (v4u){ou[0], ou[1], ou[2], ou[3]}; *(v4u*)(mp + 8) = (v4u){ou[4], ou[5], ou[6], ou[7]};
    if (c == 31 && t == 63) { float* o = a->out + O_LRUP + (size_t)b * 1024 + n * 128 + d0;
#pragma unroll
        for (int i = 0; i < 4; ++i) *(f32x4*)(o + 4 * i) = (f32x4){hv[4 * i], hv[4 * i + 1], hv[4 * i + 2], hv[4 * i + 3]}; }
    LDS_BARRIER();
}


__device__ __forceinline__ void conv16_load(const bf16* proj, int b, int tseq, int ch0, v4u (&u)[8]) {
#pragma unroll
    for (int j = 0; j < 4; ++j) { const int tt = tseq - 3 + j;
        if (tt >= 0) { const bf16* pr = proj + (size_t)(b * TP + tt) * NPROJ_PAD + ch0; u[2 * j] = *(const v4u*)pr; u[2 * j + 1] = *(const v4u*)(pr + 8); }
        else { u[2 * j] = (v4u){0u, 0u, 0u, 0u}; u[2 * j + 1] = (v4u){0u, 0u, 0u, 0u}; } }
}
__device__ __forceinline__ void conv16_compute(const v4u (&u)[8], const float* wconv, const float* bconv, int ch0, float (&x)[16]) {
#pragma unroll
    for (int i = 0; i < 4; ++i) { const f32x4 bb = *(const f32x4*)(bconv + ch0 + 4 * i); x[4 * i] = bb.x; x[4 * i + 1] = bb.y; x[4 * i + 2] = bb.z; x[4 * i + 3] = bb.w; }
#pragma unroll
    for (int j = 0; j < 4; ++j) { const unsigned uu[8] = {u[2 * j].x, u[2 * j].y, u[2 * j].z, u[2 * j].w, u[2 * j + 1].x, u[2 * j + 1].y, u[2 * j + 1].z, u[2 * j + 1].w};
#pragma unroll
        for (int i = 0; i < 4; ++i) { const f32x4 ww = *(const f32x4*)(wconv + j * 4096 + ch0 + 4 * i);
            x[4 * i] += ww.x * bflo(uu[2 * i]); x[4 * i + 1] += ww.y * bfhi(uu[2 * i]); x[4 * i + 2] += ww.z * bflo(uu[2 * i + 1]); x[4 * i + 3] += ww.w * bfhi(uu[2 * i + 1]); } }
}
__device__ __forceinline__ void conv16_prompt(const bf16* proj, const float* wconv, const float* bconv, int b, int tseq, int ch0, float (&x)[16]) {
    v4u u[8]; conv16_load(proj, b, tseq, ch0, u); conv16_compute(u, wconv, bconv, ch0, x);
}
__device__ __forceinline__ void st16_bf16(LAS bf16* p, const float (&x)[16]) {
    v4u o0, o1; o0.x = pk2(x[0], x[1]); o0.y = pk2(x[2], x[3]); o0.z = pk2(x[4], x[5]); o0.w = pk2(x[6], x[7]); o1.x = pk2(x[8], x[9]); o1.y = pk2(x[10], x[11]); o1.z = pk2(x[12], x[13]); o1.w = pk2(x[14], x[15]);
    *(LAS v4u*)p = o0; *(LAS v4u*)(p + 8) = o1;
}
__device__ __forceinline__ v2u pack4(const f32x4 v) { v2u o; o.x = pk2(v.x, v.y); o.y = pk2(v.z, v.w); return o; }
__device__ __forceinline__ bf16x8 zero8() { return (bf16x8){0, 0, 0, 0, 0, 0, 0, 0}; }

__device__ __forceinline__ void delta_prep_item(ArgsP a, LAS unsigned char* lds, int item, const int tid) {
    const int c = item & 31, h = (item >> 5) & 7, b = item >> 8;
    const int lane = tid & 63, w = __builtin_amdgcn_readfirstlane(tid >> 6), fr = lane & 15, fq = lane >> 4;
    unsigned char* ws = a->ws;
    const bf16* proj = (const bf16*)(ws + WS_PROJ);
    LAS bf16* Kn = (LAS bf16*)lds;
    LAS bf16* Qn = (LAS bf16*)(lds + 17408);
    LAS bf16* KdT = (LAS bf16*)(lds + 34816);
    LAS bf16* RX = (LAS bf16*)(lds + 53248);
    LAS bf16* Mm = (LAS bf16*)(lds + 90112);
    LAS bf16* QKd = (LAS bf16*)(lds + 99328);
    LAS bf16* Td = (LAS bf16*)(lds + 108544);
    LAS bf16* RT = (LAS bf16*)(lds + 111616) + w * 768;
    LAS float* gl = (LAS float*)(lds + 123904);
    LAS float* gcs = gl + 64;
    LAS float* bet = gcs + 64;
    const int t = tid >> 3, sub = tid & 7;
    float gc_t, glast_t, beta_t;
    {
        const float* gt = (const float*)(ws + WS_GATES) + (size_t)(b * TP + 64 * c + lane) * 16;
        const float gv = -fexp(a->in[I_ALOG][h]) * softplusf(gt[h] + a->in[I_DTB][h]), bv = sigm(gt[8 + h]);
        const float gcv = wave_incl_sum(gv, lane);
        if (w == 0) { gl[lane] = gv; gcs[lane] = gcv; bet[lane] = bv; }
        gc_t = __shfl(gcv, t); glast_t = __shfl(gcv, 63); beta_t = __shfl(bv, t);
    }
    {
        const float* wconv = a->in[I_WCONV]; const float* bconv = a->in[I_BCONV];
        const float gc = gc_t, glast = glast_t, beta = beta_t;
        const float ec = fexp(gc), ed = fexp(glast - gc);
        float x[16], y[16];
        conv16_prompt(proj, wconv, bconv, b, 64 * c + t, 1024 + h * 128 + sub * 16, x);
        float ss = 0.f;
#pragma unroll
        for (int i = 0; i < 16; ++i) { x[i] = siluf(x[i]); ss += x[i] * x[i]; }
        ss += __shfl_xor(ss, 1); ss += __shfl_xor(ss, 2); ss += __shfl_xor(ss, 4);
        const float rk = rsqrtf(ss + 1e-6f);
#pragma unroll
        for (int i = 0; i < 16; ++i) x[i] *= rk;
        st16_bf16(Kn + t * 136 + sub * 16, x);
#pragma unroll
        for (int i = 0; i < 16; ++i) KdT[(sub * 16 + i) * 72 + t] = (bf16)f2bf(x[i] * ed);
#pragma unroll
        for (int i = 0; i < 16; ++i) y[i] = x[i] * (beta * ec);
        st16_bf16(RX + t * 264 + 128 + sub * 16, y);
        conv16_prompt(proj, wconv, bconv, b, 64 * c + t, h * 128 + sub * 16, x);
        ss = 0.f;
#pragma unroll
        for (int i = 0; i < 16; ++i) { x[i] = siluf(x[i]); ss += x[i] * x[i]; }
        ss += __shfl_xor(ss, 1); ss += __shfl_xor(ss, 2); ss += __shfl_xor(ss, 4);
        const float rq = rsqrtf(ss + 1e-6f) * 0.08838834764831845f;
#pragma unroll
        for (int i = 0; i < 16; ++i) x[i] *= rq;
        st16_bf16(Qn + t * 136 + sub * 16, x);
        conv16_prompt(proj, wconv, bconv, b, 64 * c + t, 2048 + h * 128 + sub * 16, x);
#pragma unroll
        for (int i = 0; i < 16; ++i) x[i] = siluf(x[i]) * beta;
        st16_bf16(RX + t * 264 + sub * 16, x);
    }
    LDS_BARRIER();
    {
        const int ib = w >> 1;
#pragma unroll
        for (int jj = 0; jj < 2; ++jj) { const int jb = 2 * (w & 1) + jj;
            f32x4 ak = (f32x4){0.f, 0.f, 0.f, 0.f}, aq = (f32x4){0.f, 0.f, 0.f, 0.f};
            if (jb <= ib) {
#pragma unroll
                for (int ks = 0; ks < 4; ++ks) { const bf16x8 bfr = *(const LAS bf16x8*)(Kn + (16 * jb + fr) * 136 + 32 * ks + 8 * fq);
                    const bf16x8 afk = *(const LAS bf16x8*)(Kn + (16 * ib + fr) * 136 + 32 * ks + 8 * fq), afq = *(const LAS bf16x8*)(Qn + (16 * ib + fr) * 136 + 32 * ks + 8 * fq);
                    ak = MFMA32(afk, bfr, ak); aq = MFMA32(afq, bfr, aq); } }
            const int col = 16 * jb + fr; const float gcc = gcs[col];
#pragma unroll
            for (int j = 0; j < 4; ++j) { const int row = 16 * ib + 4 * fq + j; const float dec = (row >= col) ? fexp(gcs[row] - gcc) : 0.f;
                Mm[row * 72 + col] = (bf16)f2bf(row > col ? -bet[row] * ak[j] * dec : 0.f);
                QKd[row * 72 + col] = (bf16)f2bf(aq[j] * dec); }
        }
    }
    LDS_BARRIER();
    if (w == 0) { const int blk = lane >> 4, col = lane & 15; float xi[16];
#pragma unroll
        for (int i = 0; i < 16; ++i) { float acc = (i == col) ? 1.f : 0.f; const LAS bf16* mr = Mm + (16 * blk + i) * 72 + 16 * blk;
#pragma unroll
            for (int j = 0; j < i; ++j) acc += bf2f(mr[j]) * xi[j];
            xi[i] = acc; }
#pragma unroll
        for (int i = 0; i < 16; ++i) Td[(blk * 16 + i) * 24 + col] = (bf16)f2bf(xi[i]); }
    f32x4 rhs[2][4];
#pragma unroll
    for (int cbl = 0; cbl < 2; ++cbl)
#pragma unroll
        for (int bb = 0; bb < 4; ++bb)
#pragma unroll
            for (int j = 0; j < 4; ++j) rhs[cbl][bb][j] = bf2f(RX[(16 * bb + 4 * fq + j) * 264 + 32 * w + 16 * cbl + fr]);
    LDS_BARRIER();
#pragma unroll
    for (int cbl = 0; cbl < 2; ++cbl) { const int cb = 2 * w + cbl;
#pragma unroll
        for (int bb = 0; bb < 4; ++bb) {
            f32x4 acc = rhs[cbl][bb];
#pragma unroll
            for (int ks = 0; ks < 2; ++ks) { if (32 * ks < 16 * bb) { const bool ok = (32 * ks + 8 * fq) < 16 * bb;
                const bf16x8 af = ok ? *(const LAS bf16x8*)(Mm + (16 * bb + fr) * 72 + 32 * ks + 8 * fq) : zero8();
                const bf16x8 bf_ = ok ? *(const LAS bf16x8*)(RX + (16 * cb + fr) * 72 + 32 * ks + 8 * fq) : zero8();
                acc = MFMA32(af, bf_, acc); } }
            *(LAS v2u*)(RT + (16 * cbl + fr) * 24 + 4 * fq) = pack4(acc);
            asm volatile("s_waitcnt lgkmcnt(0)" ::: "memory");
            const bool ok2 = fq < 2;
            const bf16x8 af2 = ok2 ? *(const LAS bf16x8*)(Td + (bb * 16 + fr) * 24 + 8 * fq) : zero8();
            const bf16x8 bf2 = ok2 ? *(const LAS bf16x8*)(RT + (16 * cbl + fr) * 24 + 8 * fq) : zero8();
            const f32x4 xb4 = MFMA32(af2, bf2, ((f32x4){0.f, 0.f, 0.f, 0.f}));
            *(LAS v2u*)(RX + (16 * cb + fr) * 72 + 16 * bb + 4 * fq) = pack4(xb4);
            asm volatile("s_waitcnt lgkmcnt(0)" ::: "memory");
        }
    }
    LDS_BARRIER();
    {
        v4u* gout = (v4u*)(ws + WS_DG) + ((size_t)item * 8 + w) * 4 * 64 + lane;
        bf16x8 kb[2];
#pragma unroll
        for (int kt = 0; kt < 2; ++kt) kb[kt] = *(const LAS bf16x8*)(KdT + (16 * w + fr) * 72 + 32 * kt + 8 * fq);
#pragma unroll
        for (int ks = 0; ks < 4; ++ks) { f32x4 g0 = (f32x4){0.f, 0.f, 0.f, 0.f}, g1 = (f32x4){0.f, 0.f, 0.f, 0.f};
#pragma unroll
            for (int kt = 0; kt < 2; ++kt) { const bf16x8 a0 = *(const LAS bf16x8*)(RX + (128 + 32 * ks + fr) * 72 + 32 * kt + 8 * fq), a1 = *(const LAS bf16x8*)(RX + (128 + 32 * ks + 16 + fr) * 72 + 32 * kt + 8 * fq);
                g0 = MFMA32(a0, kb[kt], g0); g1 = MFMA32(a1, kb[kt], g1); }
            const v2u p0 = pack4(-g0), p1 = pack4(-g1); gout[ks * 64] = (v4u){p0.x, p0.y, p1.x, p1.y}; }
        v2u* bout = (v2u*)(ws + WS_DB) + ((size_t)item * 64 + w) * 64 + lane;
#pragma unroll
        for (int s2 = 0; s2 < 8; ++s2) { f32x4 bc = (f32x4){0.f, 0.f, 0.f, 0.f};
#pragma unroll
            for (int kt = 0; kt < 2; ++kt) { const bf16x8 ub = *(const LAS bf16x8*)(RX + (16 * s2 + fr) * 72 + 32 * kt + 8 * fq); bc = MFMA32(kb[kt], ub, bc); }
            bout[(size_t)s2 * 8 * 64] = pack4(bc); }
    }
    {
        const int tb = w >> 1, half = w & 1; const float ect = fexp(gcs[16 * tb + fr]);
        bf16x8 qk[2];
#pragma unroll
        for (int kt = 0; kt < 2; ++kt) qk[kt] = *(const LAS bf16x8*)(QKd + (16 * tb + fr) * 72 + 32 * kt + 8 * fq);
        v4u* qout = (v4u*)(ws + WS_DQ) + ((size_t)item * 4 + tb) * 4 * 64 + lane;
#pragma unroll
        for (int kk = 0; kk < 2; ++kk) { const int ks = 2 * half + kk; v2u pk[2];
#pragma unroll
            for (int hf = 0; hf < 2; ++hf) { const int db = 2 * ks + hf; f32x4 acc = (f32x4){0.f, 0.f, 0.f, 0.f};
#pragma unroll
                for (int kt = 0; kt < 2; ++kt) { const bf16x8 wa = *(const LAS bf16x8*)(RX + (128 + 16 * db + fr) * 72 + 32 * kt + 8 * fq); acc = MFMA32(wa, qk[kt], acc); }
                const v2u qn4 = *(const LAS v2u*)(Qn + (16 * tb + fr) * 136 + 16 * db + 4 * fq);
                f32x4 qp; qp.x = bflo(qn4.x) * ect - acc.x; qp.y = bfhi(qn4.x) * ect - acc.y; qp.z = bflo(qn4.y) * ect - acc.z; qp.w = bfhi(qn4.y) * ect - acc.w;
                pk[hf] = pack4(qp); }
            qout[ks * 64] = (v4u){pk[0].x, pk[0].y, pk[1].x, pk[1].y}; }
        v2u* oout = (v2u*)(ws + WS_DO) + ((size_t)item * 4 + tb) * 8 * 64 + lane;
#pragma unroll
        for (int ss = 0; ss < 4; ++ss) { const int s2 = 4 * half + ss; f32x4 acc = (f32x4){0.f, 0.f, 0.f, 0.f};
#pragma unroll
            for (int kt = 0; kt < 2; ++kt) { const bf16x8 ua = *(const LAS bf16x8*)(RX + (16 * s2 + fr) * 72 + 32 * kt + 8 * fq); acc = MFMA32(ua, qk[kt], acc); }
            oout[s2 * 64] = pack4(acc); }
    }
    if (tid == 0) ((float*)(ws + WS_DD))[item] = fexp(gcs[63]);
    LDS_BARRIER();
}

__device__ __forceinline__ void delta_scan_wave(ArgsP a, int chain, int s, const int lane) {
    unsigned char* ws = a->ws;
    const int fr = lane & 15, fq = lane >> 4;
    f32x4 S[8]; bf16x8 Sb[4];
#pragma unroll
    for (int i = 0; i < 8; ++i) S[i] = (f32x4){0.f, 0.f, 0.f, 0.f};
#pragma unroll
    for (int i = 0; i < 4; ++i) Sb[i] = zero8();
    const bf16x8* gbase = (const bf16x8*)(ws + WS_DG) + (size_t)chain * 32 * 2048 + lane;
    bf16x8 G[8][4];
#pragma unroll
    for (int rb = 0; rb < 8; ++rb)
#pragma unroll
        for (int ks = 0; ks < 4; ++ks) G[rb][ks] = gbase[(rb * 4 + ks) * 64];
#pragma unroll 1
    for (int c = 0; c < 32; ++c) {
        const int item = chain * 32 + c;
        const float d = ((const float*)(ws + WS_DD))[item];
        bf16x8* sout = (bf16x8*)(ws + WS_DS) + ((size_t)item * 8 + s) * 4 * 64 + lane;
#pragma unroll
        for (int ks = 0; ks < 4; ++ks) sout[ks * 64] = Sb[ks];
        const v2u* bin = (const v2u*)(ws + WS_DB) + ((size_t)item * 8 + s) * 8 * 64 + lane;
#pragma unroll
        for (int rb = 0; rb < 8; ++rb) { const v2u bc = bin[rb * 64]; S[rb].x = d * S[rb].x + bflo(bc.x); S[rb].y = d * S[rb].y + bfhi(bc.x); S[rb].z = d * S[rb].z + bflo(bc.y); S[rb].w = d * S[rb].w + bfhi(bc.y); }
        const bf16x8* gnext = gbase + (size_t)(c + 1 < 32 ? c + 1 : c) * 2048;
#pragma unroll
        for (int rb = 0; rb < 8; ++rb) {
#pragma unroll
            for (int ks = 0; ks < 4; ++ks) S[rb] = MFMA32(G[rb][ks], Sb[ks], S[rb]);
#pragma unroll
            for (int ks = 0; ks < 4; ++ks) G[rb][ks] = gnext[(rb * 4 + ks) * 64];
        }
#pragma unroll
        for (int ks = 0; ks < 4; ++ks) { const v2u lo = pack4(S[2 * ks]), hi = pack4(S[2 * ks + 1]); const v4u u = (v4u){lo.x, lo.y, hi.x, hi.y}; Sb[ks] = __builtin_bit_cast(bf16x8, u); }
    }
    f32x4* so = (f32x4*)(ws + WS_DF) + ((size_t)(chain * 8 + s) * 8) * 64 + lane;
#pragma unroll
    for (int rb = 0; rb < 8; ++rb) so[rb * 64] = S[rb];
}

__device__ __forceinline__ void delta_out_wave(ArgsP a, int item, int tb, const int lane) {
    unsigned char* ws = a->ws;
    const int c = item & 31, h = (item >> 5) & 7, b = item >> 8, fr = lane & 15, fq = lane >> 4;
    bf16x8 qf[4];
    const bf16x8* qin = (const bf16x8*)(ws + WS_DQ) + ((size_t)item * 4 + tb) * 4 * 64 + lane;
#pragma unroll
    for (int ks = 0; ks < 4; ++ks) qf[ks] = qin[ks * 64];
    const v2u* oin = (const v2u*)(ws + WS_DO) + ((size_t)item * 4 + tb) * 8 * 64 + lane;
    const bf16x8* sin = (const bf16x8*)(ws + WS_DS) + (size_t)item * 8 * 4 * 64 + lane;
    f32x4 o[8]; float ss = 0.f;
    v2u olv[8]; bf16x8 sfr[4][4];
#pragma unroll
    for (int s = 0; s < 8; ++s) olv[s] = oin[s * 64];
#pragma unroll
    for (int s = 0; s < 4; ++s)
#pragma unroll
        for (int ks = 0; ks < 4; ++ks) sfr[s][ks] = sin[(s * 4 + ks) * 64];
    const int row_ = b * TP + 64 * c + 16 * tb + fr;
    v2u zv[8];
#pragma unroll
    for (int s = 0; s < 8; ++s) zv[s] = *(const v2u*)((const bf16*)(ws + WS_PROJ) + (size_t)row_ * NPROJ_PAD + 4096 + h * 128 + 4 * fq + 16 * s);
#pragma unroll
    for (int grp = 0; grp < 2; ++grp) {
#pragma unroll
        for (int s4 = 0; s4 < 4; ++s4) { const int s = 4 * grp + s4; const v2u ol = olv[s]; o[s] = (f32x4){bflo(ol.x), bfhi(ol.x), bflo(ol.y), bfhi(ol.y)};
#pragma unroll
            for (int ks = 0; ks < 4; ++ks) o[s] = MFMA32(sfr[s4][ks], qf[ks], o[s]);
            ss += (o[s].x * o[s].x + o[s].y * o[s].y) + (o[s].z * o[s].z + o[s].w * o[s].w); }
        if (grp == 0) {
#pragma unroll
            for (int s4 = 0; s4 < 4; ++s4)
#pragma unroll
                for (int ks = 0; ks < 4; ++ks) sfr[s4][ks] = sin[((4 + s4) * 4 + ks) * 64]; }
    }
    ss += __shfl_xor(ss, 16); ss += __shfl_xor(ss, 32);
    const float rstd = rsqrtf(ss * (1.f / 128.f) + RMS_EPS);
    const int row = b * TP + 64 * c + 16 * tb + fr;
    const bf16* zp = (const bf16*)(ws + WS_PROJ) + (size_t)row * NPROJ_PAD + 4096 + h * 128 + 4 * fq;
    bf16* mp = (bf16*)(ws + WS_MIX) + (size_t)row * D + h * 128 + 4 * fq;
    const float* nw = a->in[I_DNORM] + 4 * fq;
#pragma unroll
    for (int s = 0; s < 8; ++s) { const v2u z = zv[s]; const f32x4 n4 = *(const f32x4*)(nw + 16 * s);
        f32x4 y; y.x = o[s].x * rstd * n4.x * siluf(bflo(z.x)); y.y = o[s].y * rstd * n4.y * siluf(bfhi(z.x)); y.z = o[s].z * rstd * n4.z * siluf(bflo(z.y)); y.w = o[s].w * rstd * n4.w * siluf(bfhi(z.y));
        *(v2u*)(mp + 16 * s) = pack4(y); }
}


__device__ __forceinline__ void mlstm_scan_item(ArgsP a, LAS unsigned char* lds, int chain, int vs, const int tid) {
    const int lane = tid & 63, w = __builtin_amdgcn_readfirstlane(tid >> 6), fr = lane & 15, fq = lane >> 4;
    const int b = chain >> 3, h = chain & 7, row0 = b * TP;
    unsigned char* ws = a->ws;
    const bf16* proj = (const bf16*)(ws + WS_PROJ); const float* gates = (const float*)(ws + WS_GATES);
    LAS bf16* KT = (LAS bf16*)lds;
    LAS bf16* VT = (LAS bf16*)(lds + 36864);
    LAS float* wls = (LAS float*)(lds + 46080);
    LAS float* gendA = (LAS float*)(lds + 46592);
    LAS float* blastA = gendA + 2048;
    LAS float* mxA = blastA + 32;
    const float big = a->in[I_BIG][h], bfg = a->in[I_BFG][h];
    {
        float lf4[4], ig4[4];
#pragma unroll
        for (int i = 0; i < 4; ++i) { const float* gp = gates + (size_t)(row0 + 64 * (w + 8 * i) + lane) * 16 + h; ig4[i] = gp[0] + big; lf4[i] = logsigf(gp[8] + bfg); }
#pragma unroll
        for (int i = 0; i < 4; ++i) { const float bcum = wave_incl_sum(lf4[i], lane), blast = __shfl(bcum, 63), gend = blast - bcum + ig4[i]; const float mx = wave_max(gend);
            gendA[(w + 8 * i) * 64 + lane] = gend; if (lane == 0) { blastA[w + 8 * i] = blast; mxA[w + 8 * i] = mx; } }
    }
    LDS_BARRIER();
    const bf16* kptr = proj + (size_t)(row0 + lane) * NPROJ_PAD + 1024 + h * 128 + 16 * w;
    const bf16* vptr = proj + (size_t)(row0 + lane) * NPROJ_PAD + 2048 + h * 256 + 32 * vs + 8 * (w & 3);
    f32x4 acc[2]; acc[0] = (f32x4){0.f, 0.f, 0.f, 0.f}; acc[1] = acc[0];
    float nst = 0.f, m = 0.f;
    v4u kq[2][2], vq[2];
#define ML_LOAD(set, c_) do { const size_t ro = (size_t)(c_) * 64 * NPROJ_PAD; kq[set][0] = *(const v4u*)(kptr + ro); kq[set][1] = *(const v4u*)(kptr + ro + 8); \
        if (w < 4) vq[set] = *(const v4u*)(vptr + ro); } while (0)
#define ML_STEP(set, c_) do { const int item = chain * 32 + (c_); \
        const float blast = blastA[(c_)], gend = gendA[(c_) * 64 + lane]; \
        const float mnew = fmaxf(blast + m, mxA[(c_)]), sc = fexp(blast + m - mnew), wv = fexp(gend - mnew) * 0.08838834764831845f; \
        LAS bf16* kt = KT + (set) * 9216; LAS bf16* vt = VT + (set) * 2304; \
        _Pragma("unroll") for (int i = 0; i < 2; ++i) { const unsigned uu[4] = {kq[set][i].x, kq[set][i].y, kq[set][i].z, kq[set][i].w}; const int kr = 8 * (2 * w + i); \
            _Pragma("unroll") for (int e = 0; e < 4; ++e) { kt[(kr + 2 * e) * 72 + lane] = (bf16)(uu[e] & 0xffffu); kt[(kr + 2 * e + 1) * 72 + lane] = (bf16)(uu[e] >> 16); } } \
        if (w < 4) { const unsigned uu[4] = {vq[set].x, vq[set].y, vq[set].z, vq[set].w}; \
            _Pragma("unroll") for (int e = 0; e < 4; ++e) { vt[(8 * w + 2 * e) * 72 + lane] = (bf16)f2bf(bflo(uu[e]) * wv); vt[(8 * w + 2 * e + 1) * 72 + lane] = (bf16)f2bf(bfhi(uu[e]) * wv); } } \
        if (w == 0) wls[(set) * 64 + lane] = wv; \
        if ((c_) + 2 < 32) ML_LOAD(set, (c_) + 2); \
        if (vs == 0 && tid == 0) ((float*)(ws + WS_MM))[item] = m; \
        LDS_BARRIER(); \
        _Pragma("unroll") for (int vb = 0; vb < 2; ++vb) { *(v2u*)((bf16*)(ws + WS_MC) + ((size_t)item * 256 + 32 * vs + 16 * vb + fr) * 128 + 16 * w + 4 * fq) = pack4(acc[vb]); } \
        if (vs == 0 && tid < 128) { ((float*)(ws + WS_MN))[(size_t)item * 128 + tid] = nst; float sn = 0.f; \
            _Pragma("unroll") for (int s8 = 0; s8 < 8; ++s8) { const v4u kk = *(const LAS v4u*)(kt + tid * 72 + 8 * s8); const LAS float* wl = wls + (set) * 64 + 8 * s8; \
                sn += bflo(kk.x) * wl[0] + bfhi(kk.x) * wl[1] + bflo(kk.y) * wl[2] + bfhi(kk.y) * wl[3] + bflo(kk.z) * wl[4] + bfhi(kk.z) * wl[5] + bflo(kk.w) * wl[6] + bfhi(kk.w) * wl[7]; } \
            nst = sc * nst + sn; } \
        _Pragma("unroll") for (int vb = 0; vb < 2; ++vb) { acc[vb] = acc[vb] * sc; \
            _Pragma("unroll") for (int kt2 = 0; kt2 < 2; ++kt2) { const bf16x8 af = *(const LAS bf16x8*)(kt + (16 * w + fr) * 72 + 32 * kt2 + 8 * fq), bfv = *(const LAS bf16x8*)(vt + (16 * vb + fr) * 72 + 32 * kt2 + 8 * fq); \
                acc[vb] = MFMA32(af, bfv, acc[vb]); } } \
        m = mnew; } while (0)
    ML_LOAD(0, 0); ML_LOAD(1, 1);
#pragma unroll 1
    for (int c2 = 0; c2 < 32; c2 += 2) { ML_STEP(0, c2); ML_STEP(1, c2 + 1); }
#undef ML_LOAD
#undef ML_STEP
#pragma unroll
    for (int vb = 0; vb < 2; ++vb) *(f32x4*)(a->out + O_MCP + ((size_t)chain * 256 + 32 * vs + 16 * vb + fr) * 128 + 16 * w + 4 * fq) = acc[vb];
    if (vs == 0) { if (tid < 128) a->out[O_MNP + (size_t)chain * 128 + tid] = nst; if (tid == 0) a->out[O_MMP + chain] = m; }
    LDS_BARRIER();
}

__device__ __forceinline__ void mlstm_out_item(ArgsP a, LAS unsigned char* lds, int item, const int tid) {
    const int c = item & 31, h = (item >> 5) & 7, b = item >> 8, row0 = b * TP + 64 * c;
    const int lane = tid & 63, w = __builtin_amdgcn_readfirstlane(tid >> 6), fr = lane & 15, fq = lane >> 4;
    unsigned char* ws = a->ws;
    const bf16* proj = (const bf16*)(ws + WS_PROJ); const float* gates = (const float*)(ws + WS_GATES);
    LAS bf16* VT = (LAS bf16*)lds;
    LAS float* ssq = (LAS float*)(lds + 36864);
    const int tb = w & 3, half = w >> 2, t = 16 * tb + fr;
    v4u vu[4];
#pragma unroll
    for (int i = 0; i < 4; ++i) vu[i] = *(const v4u*)(proj + (size_t)(row0 + lane) * NPROJ_PAD + 2048 + h * 256 + 8 * (w + 8 * i));
    v4u qu[4]; f32x4 nv[4][2];
#pragma unroll
    for (int ks = 0; ks < 4; ++ks) { qu[ks] = *(const v4u*)(proj + (size_t)(row0 + t) * NPROJ_PAD + h * 128 + 32 * ks + 8 * fq);
        const float* np = (const float*)(ws + WS_MN) + (size_t)item * 128 + 32 * ks + 8 * fq; nv[ks][0] = *(const f32x4*)np; nv[ks][1] = *(const f32x4*)(np + 4); }
    v4u kfr[4][4];
#pragma unroll
    for (int sb = 0; sb < 4; ++sb) if (sb <= tb) {
#pragma unroll
        for (int ks = 0; ks < 4; ++ks) kfr[sb][ks] = *(const v4u*)(proj + (size_t)(row0 + 16 * sb + fr) * NPROJ_PAD + 1024 + h * 128 + 32 * ks + 8 * fq); }
    const float mc = ((const float*)(ws + WS_MM))[item];
    float av, Mt, et, em;
    { const float ig = gates[(size_t)(row0 + lane) * 16 + h] + a->in[I_BIG][h], lf = logsigf(gates[(size_t)(row0 + lane) * 16 + 8 + h] + a->in[I_BFG][h]);
      const float bcum = wave_incl_sum(lf, lane); av = ig - bcum; Mt = fmaxf(mc, wave_incl_max(av, lane)); et = fexp(mc - Mt); em = fexp(-(bcum + Mt)); }
#pragma unroll
    for (int i = 0; i < 4; ++i) { const unsigned uu[4] = {vu[i].x, vu[i].y, vu[i].z, vu[i].w}; const int vr = 8 * (w + 8 * i);
#pragma unroll
        for (int e = 0; e < 4; ++e) { VT[(vr + 2 * e) * 72 + lane] = (bf16)(uu[e] & 0xffffu); VT[(vr + 2 * e + 1) * 72 + lane] = (bf16)(uu[e] >> 16); } }
    bf16x8 qf[4]; float qn = 0.f;
#pragma unroll
    for (int ks = 0; ks < 4; ++ks) { const v4u u = qu[ks]; qf[ks] = __builtin_bit_cast(bf16x8, u); const f32x4 n0 = nv[ks][0], n1 = nv[ks][1];
        qn += bflo(u.x) * n0.x + bfhi(u.x) * n0.y + bflo(u.y) * n0.z + bfhi(u.y) * n0.w + bflo(u.z) * n1.x + bfhi(u.z) * n1.y + bflo(u.w) * n1.z + bfhi(u.w) * n1.w; }
    qn += __shfl_xor(qn, 16); qn += __shfl_xor(qn, 32);
    const float Mtt = __shfl(Mt, t), ett = __shfl(et, t), emt = __shfl(em, t);
    const bf16* cs = (const bf16*)(ws + WS_MC) + (size_t)item * 256 * 128;
    v2u smp[4]; float rowsum = 0.f;
#pragma unroll
    for (int sb = 0; sb < 4; ++sb) { smp[sb] = (v2u){0u, 0u};
        if (sb <= tb) { f32x4 qk = (f32x4){0.f, 0.f, 0.f, 0.f};
#pragma unroll
            for (int ks = 0; ks < 4; ++ks) qk = MFMA32(__builtin_bit_cast(bf16x8, kfr[sb][ks]), qf[ks], qk);
            f32x4 sm;
#pragma unroll
            for (int j = 0; j < 4; ++j) { const int s = 16 * sb + 4 * fq + j; const float as = __shfl(av, s); sm[j] = (s <= t) ? qk[j] * 0.08838834764831845f * fexp(as - Mtt) : 0.f; rowsum += sm[j]; }
            smp[sb] = pack4(sm); } }
    rowsum += __shfl_xor(rowsum, 16); rowsum += __shfl_xor(rowsum, 32);
    const float hden = 1.f / fmaxf(fabsf(ett * qn + rowsum), emt);
    const v4u s0u = (v4u){smp[0].x, smp[0].y, smp[1].x, smp[1].y}, s1u = (v4u){smp[2].x, smp[2].y, smp[3].x, smp[3].y};
    const bf16x8 sf0 = __builtin_bit_cast(bf16x8, s0u), sf1 = __builtin_bit_cast(bf16x8, s1u);
    v4u cfr[4][4];
#pragma unroll
    for (int g4 = 0; g4 < 4; ++g4)
#pragma unroll
        for (int ks = 0; ks < 4; ++ks) cfr[g4][ks] = *(const v4u*)(cs + (size_t)(128 * half + 16 * g4 + fr) * 128 + 32 * ks + 8 * fq);
    LDS_BARRIER();
    f32x4 hv[8]; float ss = 0.f;
#pragma unroll
    for (int grp = 0; grp < 2; ++grp) {
      f32x4 accs[4];
#pragma unroll
      for (int g4 = 0; g4 < 4; ++g4) { f32x4 acc = (f32x4){0.f, 0.f, 0.f, 0.f};
#pragma unroll
          for (int ks = 0; ks < 4; ++ks) acc = MFMA32(__builtin_bit_cast(bf16x8, cfr[g4][ks]), qf[ks], acc);
          accs[g4] = acc * ett; }
      if (grp == 0) {
#pragma unroll
          for (int g4 = 0; g4 < 4; ++g4)
#pragma unroll
              for (int ks = 0; ks < 4; ++ks) cfr[g4][ks] = *(const v4u*)(cs + (size_t)(128 * half + 64 + 16 * g4 + fr) * 128 + 32 * ks + 8 * fq); }
#pragma unroll
      for (int g4 = 0; g4 < 4; ++g4) { const int vb = 4 * grp + g4, vrow = 128 * half + 16 * vb + fr; f32x4 acc = accs[g4];
        { const v2u a0 = *(const LAS v2u*)(VT + vrow * 72 + 4 * fq), a1 = *(const LAS v2u*)(VT + vrow * 72 + 16 + 4 * fq); const v4u au = (v4u){a0.x, a0.y, a1.x, a1.y}; acc = MFMA32(__builtin_bit_cast(bf16x8, au), sf0, acc); }
        { const v2u a0 = *(const LAS v2u*)(VT + vrow * 72 + 32 + 4 * fq), a1 = *(const LAS v2u*)(VT + vrow * 72 + 48 + 4 * fq); const v4u au = (v4u){a0.x, a0.y, a1.x, a1.y}; acc = MFMA32(__builtin_bit_cast(bf16x8, au), sf1, acc); }
        hv[vb] = acc * hden; ss += (hv[vb].x * hv[vb].x + hv[vb].y * hv[vb].y) + (hv[vb].z * hv[vb].z + hv[vb].w * hv[vb].w); }
    }
    ss += __shfl_xor(ss, 16); ss += __shfl_xor(ss, 32);
    if (fq == 0) ssq[half * 64 + t] = ss;
    LDS_BARRIER();
    const float rstd = rsqrtf((ssq[t] + ssq[64 + t]) * (1.f / 256.f) + RMS_EPS);
    const bf16* op = proj + (size_t)(row0 + t) * NPROJ_PAD + 4096 + h * 256 + 128 * half + 4 * fq;
    bf16* mp = (bf16*)(ws + WS_MIX) + (size_t)(row0 + t) * D + h * 256 + 128 * half + 4 * fq;
    const float* nw = a->in[I_MNORM] + h * 256 + 128 * half + 4 * fq;
    v2u opr[8];
#pragma unroll
    for (int vb = 0; vb < 8; ++vb) opr[vb] = *(const v2u*)(op + 16 * vb);
#pragma unroll
    for (int vb = 0; vb < 8; ++vb) { const v2u o = opr[vb]; const f32x4 n4 = *(const f32x4*)(nw + 16 * vb);
        f32x4 y; y.x = hv[vb].x * rstd * n4.x * sigm(bflo(o.x)); y.y = hv[vb].y * rstd * n4.y * sigm(bfhi(o.x)); y.z = hv[vb].z * rstd * n4.z * sigm(bflo(o.y)); y.w = hv[vb].w * rstd * n4.w * sigm(bfhi(o.y));
        *(v2u*)(mp + 16 * vb) = pack4(y); }
    LDS_BARRIER();
}


__device__ __forceinline__ void mlstm_sample_load(ArgsP a, int j, const int tid, f32x4 (&cst)[2][4][2]) {
    const int lane = tid & 63, w = __builtin_amdgcn_readfirstlane(tid >> 6), fr = lane & 15, fq = lane >> 4;
    const float* C0 = a->in[I_SMC] + (size_t)j * 32768;
#pragma unroll
    for (int vb = 0; vb < 2; ++vb)
#pragma unroll
        for (int ksp = 0; ksp < 4; ++ksp) { const float* cp = C0 + (size_t)(32 * w + 16 * vb + fr) * 128 + 32 * ksp + 4 * fq; cst[vb][ksp][0] = __builtin_nontemporal_load((const f32x4*)cp); cst[vb][ksp][1] = __builtin_nontemporal_load((const f32x4*)(cp + 16)); }
}
__device__ __forceinline__ void mlstm_sample_item(ArgsP a, LAS unsigned char* lds, int j, const int tid, const f32x4 (&cst)[2][4][2]) {
    const int b = j >> 3, h = j & 7, row0 = MP + b * TS;
    const int lane = tid & 63, w = __builtin_amdgcn_readfirstlane(tid >> 6), fr = lane & 15, fq = lane >> 4;
    unsigned char* ws = a->ws;
    const bf16* proj = (const bf16*)(ws + WS_PROJ); const float* gates = (const float*)(ws + WS_GATES);
    float* Cout = a->out + O_MCS + (size_t)j * 32768;
    LAS float* qs = (LAS float*)lds;
    LAS float* ks = qs + 512;
    LAS float* vs = ks + 512;
    LAS float* gs = vs + 1024;
    LAS float* qkr = gs + 8;
    LAS float* qnl = qkr + 16;
    LAS float* hbuf = qnl + 8;
#pragma unroll
    for (int tok = 0; tok < 4; ++tok) { const bf16* pr = proj + (size_t)(row0 + tok) * NPROJ_PAD;
        if (tid < 128) qs[tok * 128 + tid] = bf2f(pr[h * 128 + tid]); else if (tid < 256) ks[tok * 128 + tid - 128] = bf2f(pr[1024 + h * 128 + (tid - 128)]) * 0.08838834764831845f; else vs[tok * 256 + tid - 256] = bf2f(pr[2048 + h * 256 + (tid - 256)]); }
    if (tid < 4) { gs[tid * 2] = gates[(size_t)(row0 + tid) * 16 + h] + a->in[I_BIG][h]; gs[tid * 2 + 1] = gates[(size_t)(row0 + tid) * 16 + 8 + h] + a->in[I_BFG][h]; }
    const float n0a = a->in[I_SMN][(size_t)j * 128 + lane], n0b = a->in[I_SMN][(size_t)j * 128 + 64 + lane];
    const float m0 = a->in[I_SMM][j];
    LDS_BARRIER();
#pragma unroll
    for (int i = 0; i < 2; ++i) { const int p = 2 * w + i, t = p >> 2, sx = p & 3; const float d = wave_sum(qs[t * 128 + lane] * ks[sx * 128 + lane] + qs[t * 128 + 64 + lane] * ks[sx * 128 + 64 + lane]); if (lane == 0) qkr[p] = d; }
    if (w < 4) { const float d = wave_sum(qs[w * 128 + lane] * n0a + qs[w * 128 + 64 + lane] * n0b); if (lane == 0) qnl[w] = d; }
    float bc[4], ig[4], mt[4], m = m0, bsum = 0.f;
#pragma unroll
    for (int t = 0; t < 4; ++t) { ig[t] = gs[t * 2]; const float lf = logsigf(gs[t * 2 + 1]); bsum += lf; bc[t] = bsum; m = fmaxf(lf + m, ig[t]); mt[t] = m; }
    const float scf = fexp(bc[3] + m0 - mt[3]);
    float wsf[4], et[4];
#pragma unroll
    for (int t = 0; t < 4; ++t) { wsf[t] = fexp(bc[3] - bc[t] + ig[t] - mt[3]); et[t] = fexp(bc[t] + m0 - mt[t]); }
    LDS_BARRIER();
    float S[4][4], hden[4];
#pragma unroll
    for (int t = 0; t < 4; ++t) { float den = et[t] * qnl[t];
#pragma unroll
        for (int sx = 0; sx < 4; ++sx) { S[t][sx] = (sx <= t) ? qkr[t * 4 + sx] * fexp(bc[t] - bc[sx] + ig[sx] - mt[t]) : 0.f; den += S[t][sx]; }
        hden[t] = 1.f / fmaxf(fabsf(den), fexp(-mt[t])); }
    bf16x8 qa[4];
#pragma unroll
    for (int ksp = 0; ksp < 4; ++ksp) { v4u u = (v4u){0u, 0u, 0u, 0u};
        if (fr < 4) { const f32x4 x0 = *(const LAS f32x4*)(qs + fr * 128 + 32 * ksp + 4 * fq), x1 = *(const LAS f32x4*)(qs + fr * 128 + 32 * ksp + 16 + 4 * fq); u.x = pk2(x0.x, x0.y); u.y = pk2(x0.z, x0.w); u.z = pk2(x1.x, x1.y); u.w = pk2(x1.z, x1.w); }
        qa[ksp] = __builtin_bit_cast(bf16x8, u); }
#pragma unroll
    for (int vb = 0; vb < 2; ++vb) { const int v = 32 * w + 16 * vb + fr;
        float vw[4];
#pragma unroll
        for (int sx = 0; sx < 4; ++sx) vw[sx] = vs[sx * 256 + v] * wsf[sx];
        f32x4 dacc = (f32x4){0.f, 0.f, 0.f, 0.f};
#pragma unroll
        for (int ksp = 0; ksp < 4; ++ksp) { const f32x4 c0 = cst[vb][ksp][0], c1 = cst[vb][ksp][1];
            v4u u; u.x = pk2(c0.x, c0.y); u.y = pk2(c0.z, c0.w); u.z = pk2(c1.x, c1.y); u.w = pk2(c1.z, c1.w);
            dacc = MFMA32(qa[ksp], __builtin_bit_cast(bf16x8, u), dacc);
            f32x4 n0v = c0 * scf, n1v = c1 * scf;
#pragma unroll
            for (int sx = 0; sx < 4; ++sx) { const f32x4 k0 = *(const LAS f32x4*)(ks + sx * 128 + 32 * ksp + 4 * fq), k1 = *(const LAS f32x4*)(ks + sx * 128 + 32 * ksp + 16 + 4 * fq); n0v = n0v + k0 * vw[sx]; n1v = n1v + k1 * vw[sx]; }
            float* op = Cout + (size_t)v * 128 + 32 * ksp + 4 * fq; __builtin_nontemporal_store(n0v, (f32x4*)op); __builtin_nontemporal_store(n1v, (f32x4*)(op + 16)); }
        if (fq == 0) {
#pragma unroll
            for (int t = 0; t < 4; ++t) { float num = et[t] * dacc[t];
#pragma unroll
                for (int sx = 0; sx < 4; ++sx) num += S[t][sx] * vs[sx * 256 + v];
                hbuf[t * 256 + v] = num * hden[t]; } }
    }
    if (tid < 128) { float nn = scf * a->in[I_SMN][(size_t)j * 128 + tid];
#pragma unroll
        for (int sx = 0; sx < 4; ++sx) nn += wsf[sx] * ks[sx * 128 + tid];
        a->out[O_MNS + (size_t)j * 128 + tid] = nn; }
    if (tid == 0) a->out[O_MMS + j] = mt[3];
    LDS_BARRIER();
    if (w < 4) { const int tok = w, row = row0 + tok; float hv[4]; float ss = 0.f;
#pragma unroll
        for (int i = 0; i < 4; ++i) { hv[i] = hbuf[tok * 256 + i * 64 + lane]; ss += hv[i] * hv[i]; }
        const float rstd = rsqrtf(wave_sum(ss) * (1.f / 256.f) + RMS_EPS);
        const float* nw = a->in[I_MNORM] + h * 256; bf16* mix = (bf16*)(ws + WS_MIX);
#pragma unroll
        for (int i = 0; i < 4; ++i) { const int vi = i * 64 + lane; const float op = bf2f(proj[(size_t)row * NPROJ_PAD + 4096 + h * 256 + vi]);
            mix[(size_t)row * D + h * 256 + vi] = (bf16)f2bf(hv[i] * rstd * nw[vi] * sigm(op)); } }
    LDS_BARRIER();
}


__device__ __forceinline__ void lru_sample_loop(ArgsP a, LAS unsigned char* lds, int vcu, int G, const int tid) {
    const int d = tid & 127, part = tid >> 7, n = vcu & 7, chn = n * 128 + d;
    const bf16* proj = (const bf16*)(a->ws + WS_PROJ); bf16* mix = (bf16*)(a->ws + WS_MIX);
    const float* wconv = a->in[I_WCONV]; const float* bconv = a->in[I_BCONV];
    const float* wr = a->in[I_LWR] + (size_t)n * 16384; const float* wi = a->in[I_LWI] + (size_t)n * 16384;
    LAS float* xr = (LAS float*)lds;
    LAS float* red = xr + 512;
    float w1[32], w2[32];
#pragma unroll
    for (int cc = 0; cc < 32; ++cc) { w1[cc] = wr[(part * 32 + cc) * 128 + d]; w2[cc] = wi[(part * 32 + cc) * 128 + d]; }
    const float br = a->in[I_LBR][chn], bi = a->in[I_LBI][chn], spl = softplusf(-a->in[I_LLAM][chn]);
#pragma unroll 1
    for (int j = vcu; j < 1024; j += G) {
        const int b = j >> 3, row0 = MP + b * TS; const float* cstate = a->in[I_SCONV] + (size_t)b * 3 * 4096;
        float hst = a->in[I_SLRU][(size_t)b * 1024 + chn];
        float gt[4];
        if (part == 0) {
#pragma unroll
            for (int tok = 0; tok < 4; ++tok) gt[tok] = bf2f(proj[(size_t)(row0 + tok) * NPROJ_PAD + 5120 + chn]); }
        { const int tok = tid >> 7; xr[tok * 128 + d] = conv4(proj, row0, tok, 3072 + chn, cstate, wconv, bconv); }
        LDS_BARRIER();
        float ar[4] = {0.f, 0.f, 0.f, 0.f}, ai[4] = {0.f, 0.f, 0.f, 0.f};
#pragma unroll
        for (int cc = 0; cc < 32; ++cc) { const int c = part * 32 + cc;
#pragma unroll
            for (int tok = 0; tok < 4; ++tok) { const float x = xr[tok * 128 + c]; ar[tok] += x * w1[cc]; ai[tok] += x * w2[cc]; } }
#pragma unroll
        for (int tok = 0; tok < 4; ++tok) { red[((tok * 2 + 0) * 4 + part) * 128 + d] = ar[tok]; red[((tok * 2 + 1) * 4 + part) * 128 + d] = ai[tok]; }
        LDS_BARRIER();
        if (part == 0) {
#pragma unroll
            for (int tok = 0; tok < 4; ++tok) {
                float rp = br, ip = bi;
#pragma unroll
                for (int p = 0; p < 4; ++p) { rp += red[((tok * 2 + 0) * 4 + p) * 128 + d]; ip += red[((tok * 2 + 1) * 4 + p) * 128 + d]; }
                const float log_a = -8.f * sigm(rp) * spl;
                const float av = fexp(log_a);
                const float bx = sqrtf(neg_expm1(2.f * log_a)) * sigm(ip) * xr[tok * 128 + d];
                hst = av * hst + bx;
                mix[(size_t)(row0 + tok) * D + 1024 + chn] = (bf16)f2bf(hst * gelu_tanh(gt[tok]));
            }
            a->out[O_LRUS + (size_t)b * 1024 + chn] = hst;
        }
        LDS_BARRIER();
    }
}

__device__ __forceinline__ void phase_mixer_even(ArgsP a, LAS unsigned char* lds, int vcu, int G, const int tid) {
#pragma unroll 1
    for (int r = 0; r < 1 + (PROBE_SUB & 1); ++r)
#pragma unroll 1
    for (int it = vcu; it < 1024; it += G) delta_prep_item(a, lds, it, tid);
#pragma unroll 1
    for (int r = 0; r < 1 + ((PROBE_SUB >> 1) & 1); ++r)
#pragma unroll 1
    for (int it = vcu; it < 1024; it += G) lru_prep_item(a, lds, it, tid);
#pragma unroll 1
    for (int r = 0; r < 1 + ((PROBE_SUB >> 2) & 1); ++r)
#pragma unroll 1
    for (int j = vcu; j < 1024; j += G) { const int b = j >> 3, hn = j & 7; delta_rec_item(a, lds, MP + b * TS, TS, hn, a->in[I_SCONV] + (size_t)b * 3 * 4096, a->in[I_SDELTA] + (size_t)j * 16384, a->out + O_DELTAS + (size_t)j * 16384, tid); }
#pragma unroll 1
    for (int r = 0; r < 1 + ((PROBE_SUB >> 3) & 1); ++r)
    lru_sample_loop(a, lds, vcu, G, tid);
    const bf16* proj = (const bf16*)(a->ws + WS_PROJ);
    const int npieces = (BP + BS) * 3 * 512;
    for (int i = vcu * NTHR + tid; i < npieces; i += G * NTHR) {
        const int c8 = i & 511, rj = i >> 9, j = rj % 3, b = rj / 3;
        const bf16* src; float* dst;
        if (b < BP) { src = proj + (size_t)(b * TP + TP - 3 + j) * NPROJ_PAD + 8 * c8; dst = a->out + O_CONVP + (size_t)(b * 3 + j) * 4096 + 8 * c8; }
        else { const int bs = b - BP; src = proj + (size_t)(MP + bs * TS + 1 + j) * NPROJ_PAD + 8 * c8; dst = a->out + O_CONVS + (size_t)(bs * 3 + j) * 4096 + 8 * c8; }
        const v4u u = *(const v4u*)src;
        *(f32x4*)dst = (f32x4){bflo(u.x), bfhi(u.x), bflo(u.y), bfhi(u.y)}; *(f32x4*)(dst + 4) = (f32x4){bflo(u.z), bfhi(u.z), bflo(u.w), bfhi(u.w)};
    }
}
__device__ __forceinline__ void phase_mixer_even_b(ArgsP a, LAS unsigned char* lds, int vcu, int G, const int tid) {
    const int w = __builtin_amdgcn_readfirstlane(tid >> 6);
    if (w == 0) { for (int it = vcu; it < 256; it += G) delta_scan_wave(a, it >> 3, it & 7, tid & 63); }
    else { LAS float* scr = (LAS float*)(lds + w * 16384);
        convert_range(a, scr, cv::R_IN0, cv::R_SCAN, vcu * 7 + (w - 1), G * 7, tid & 63); }
}
__device__ __forceinline__ void phase_mixer_even_c(ArgsP a, LAS unsigned char* lds, int vcu, int G, const int tid) {
    const int w = tid >> 6;
#pragma unroll 1
    for (int it = vcu; it < 512; it += G) delta_out_wave(a, 2 * it + (w >> 2), w & 3, tid & 63);
#pragma unroll 1
    for (int it = vcu; it < 1024; it += G) lru_out_item(a, lds, it, tid);
    for (int chain = vcu; chain < 32; chain += G) {
        const f32x4* src = (const f32x4*)(a->ws + WS_DF) + (size_t)chain * 4096; float* dst = a->out + O_DELTAP + (size_t)chain * 16384;
        f32x4 v[8];
#pragma unroll
        for (int i = 0; i < 8; ++i) v[i] = src[tid + 512 * i];
#pragma unroll
        for (int i = 0; i < 8; ++i) { const int idx = tid + 512 * i, ln = idx & 63, rb = (idx >> 6) & 7, s8 = idx >> 9; const int dk0 = 16 * rb + 4 * (ln >> 4), dv = 16 * s8 + (ln & 15);
            dst[(size_t)(dk0 + 0) * 128 + dv] = v[i].x; dst[(size_t)(dk0 + 1) * 128 + dv] = v[i].y; dst[(size_t)(dk0 + 2) * 128 + dv] = v[i].z; dst[(size_t)(dk0 + 3) * 128 + dv] = v[i].w; }
    }
}
__device__ __forceinline__ void phase_mixer_odd(ArgsP a, LAS unsigned char* lds, int vcu, int G, const int tid) {
#pragma unroll 1
    for (int r = 0; r < 1 + ((PROBE_SUB >> 4) & 1); ++r)
#pragma unroll 1
    for (int it = vcu; it < 256; it += G) mlstm_scan_item(a, lds, it >> 3, it & 7, tid);
#pragma unroll 1
    for (int r = 0; r < 1 + ((PROBE_SUB >> 5) & 1); ++r)
    {
        f32x4 cA[2][4][2], cB[2][4][2]; int j = vcu;
        if (j < 1024) { mlstm_sample_load(a, j, tid, cA);
#pragma unroll 1
            for (;;) {
                const int jB = j + G; const bool hasB = jB < 1024;
                if (hasB) mlstm_sample_load(a, jB, tid, cB);
                mlstm_sample_item(a, lds, j, tid, cA);
                if (!hasB) break;
                j = jB + G; const bool hasA = j < 1024;
                if (hasA) mlstm_sample_load(a, j, tid, cA);
                mlstm_sample_item(a, lds, jB, tid, cB);
                if (!hasA) break;
            } }
    }
}
__device__ __forceinline__ void phase_mixer_odd_b(ArgsP a, LAS unsigned char* lds, int vcu, int G, const int tid) {
#pragma unroll 1
    for (int it = vcu; it < 1024; it += G) mlstm_out_item(a, lds, it, tid);
}

__device__ __forceinline__ void phase_ln(const bf16* VB, const float* ST, const float* p1, const bf16* resid, const float* g, const float* bta, bf16* dst, LAS unsigned char* lds, int vcu, int G, const int tid) {
    const int lane = tid & 63, w = __builtin_amdgcn_readfirstlane(tid >> 6), gw = vcu * NWAVES + w, NGW = G * NWAVES;
    {
        LAS float* red = (LAS float*)lds;
        for (int r0 = 2 * vcu; r0 < MS; r0 += 2 * G) {
            const int r = r0 + (w >> 2), q = w & 3, col = 512 * q + 8 * lane; const size_t off = (size_t)(MP + r) * D + col;
            const float* q1 = p1 + (size_t)r * D + col;
            f32x4 x0 = *(const f32x4*)q1, x1 = *(const f32x4*)(q1 + 4);
#pragma unroll
            for (int ch = 1; ch < 16; ++ch) { x0 = x0 + *(const f32x4*)(q1 + (size_t)ch * 512 * D); x1 = x1 + *(const f32x4*)(q1 + (size_t)ch * 512 * D + 4); }
            const v4u rr = *(const v4u*)(resid + off);
            float v[8] = {x0.x + DN_ALPHA * bflo(rr.x), x0.y + DN_ALPHA * bfhi(rr.x), x0.z + DN_ALPHA * bflo(rr.y), x0.w + DN_ALPHA * bfhi(rr.y),
                          x1.x + DN_ALPHA * bflo(rr.z), x1.y + DN_ALPHA * bfhi(rr.z), x1.z + DN_ALPHA * bflo(rr.w), x1.w + DN_ALPHA * bfhi(rr.w)};
            float s = 0.f, ss = 0.f;
#pragma unroll
            for (int i = 0; i < 8; ++i) { s += v[i]; ss += v[i] * v[i]; }
            s = wave_sum(s); ss = wave_sum(ss);
            if (lane == 0) { red[w * 2] = s; red[w * 2 + 1] = ss; }
            LDS_BARRIER();
            const int wb = (w >> 2) * 4; s = (red[wb * 2] + red[wb * 2 + 2]) + (red[wb * 2 + 4] + red[wb * 2 + 6]); ss = (red[wb * 2 + 1] + red[wb * 2 + 3]) + (red[wb * 2 + 5] + red[wb * 2 + 7]);
            const float mean = s * (1.f / D), rstd = rsqrtf(fmaxf(ss * (1.f / D) - mean * mean, 0.f) + LN_EPS);
            const f32x4 g0 = *(const f32x4*)(g + col), g1 = *(const f32x4*)(g + col + 4), b0 = *(const f32x4*)(bta + col), b1 = *(const f32x4*)(bta + col + 4);
            v4u o; o.x = pk2((v[0] - mean) * rstd * g0.x + b0.x, (v[1] - mean) * rstd * g0.y + b0.y); o.y = pk2((v[2] - mean) * rstd * g0.z + b0.z, (v[3] - mean) * rstd * g0.w + b0.w);
            o.z = pk2((v[4] - mean) * rstd * g1.x + b1.x, (v[5] - mean) * rstd * g1.y + b1.y); o.w = pk2((v[6] - mean) * rstd * g1.z + b1.z, (v[7] - mean) * rstd * g1.w + b1.w);
            *(v4u*)(dst + off) = o;
            LDS_BARRIER();
        }
    }
    for (int m0 = gw; m0 < MP; m0 += 4 * NGW) {
        v4u vv[4][4]; float s[4], ss[4];
#pragma unroll
        for (int i = 0; i < 4; ++i) { const int m = m0 + i * NGW; s[i] = 0.f; ss[i] = 0.f;
            if (m < MP) { if (lane < 32) { const float* sp = ST + (((size_t)(lane >> 2) * M + m) * 4 + (lane & 3)) * 2; s[i] = sp[0]; ss[i] = sp[1]; }
#pragma unroll
                for (int j = 0; j < 4; ++j) vv[i][j] = *(const v4u*)(VB + (size_t)m * D + j * 512 + lane * 8); } }
#pragma unroll
        for (int i = 0; i < 4; ++i) { const int m = m0 + i * NGW;
            if (m < MP) { const float st = wave_sum(s[i]), sst = wave_sum(ss[i]);
                const float mean = st * (1.f / D), rstd = rsqrtf(fmaxf(sst * (1.f / D) - mean * mean, 0.f) + LN_EPS);
#pragma unroll
                for (int j = 0; j < 4; ++j) { const int col = j * 512 + lane * 8; const v4u v = vv[i][j];
                    const f32x4 g0 = *(const f32x4*)(g + col), g1 = *(const f32x4*)(g + col + 4), b0 = *(const f32x4*)(bta + col), b1 = *(const f32x4*)(bta + col + 4);
                    v4u o; o.x = pk2((bflo(v.x) - mean) * rstd * g0.x + b0.x, (bfhi(v.x) - mean) * rstd * g0.y + b0.y); o.y = pk2((bflo(v.y) - mean) * rstd * g0.z + b0.z, (bfhi(v.y) - mean) * rstd * g0.w + b0.w);
                    o.z = pk2((bflo(v.z) - mean) * rstd * g1.x + b1.x, (bfhi(v.z) - mean) * rstd * g1.y + b1.y); o.w = pk2((bflo(v.w) - mean) * rstd * g1.z + b1.z, (bfhi(v.w) - mean) * rstd * g1.w + b1.w);
                    *(v4u*)(dst + (size_t)m * D + col) = o; } } }
    }
}
__device__ __forceinline__ void phase_combine(const float* p1, const bf16* h2, const bf16* pw, bf16* xb, float* outf, int vcu, int G, const int tid) {
    const int lane = tid & 63, w = tid >> 6;
    for (int r0 = 2 * vcu; r0 < MS; r0 += 2 * G) {
        const int r = r0 + (w >> 2), q = w & 3, col = 512 * q + 8 * lane; const size_t off = (size_t)(MP + r) * D + col;
        const float* q1 = p1 + (size_t)r * D + col;
        f32x4 x0 = *(const f32x4*)q1, x1 = *(const f32x4*)(q1 + 4);
#pragma unroll
        for (int ch = 1; ch < 16; ++ch) { x0 = x0 + *(const f32x4*)(q1 + (size_t)ch * 512 * D); x1 = x1 + *(const f32x4*)(q1 + (size_t)ch * 512 * D + 4); }
        const v4u hh = *(const v4u*)(h2 + off), pp = *(const v4u*)(pw + off);
        f32x4 o0, o1;
        o0.x = bflo(hh.x) + sigm(x0.x) * bflo(pp.x); o0.y = bfhi(hh.x) + sigm(x0.y) * bfhi(pp.x); o0.z = bflo(hh.y) + sigm(x0.z) * bflo(pp.y); o0.w = bfhi(hh.y) + sigm(x0.w) * bfhi(pp.y);
        o1.x = bflo(hh.z) + sigm(x1.x) * bflo(pp.z); o1.y = bfhi(hh.z) + sigm(x1.y) * bfhi(pp.z); o1.z = bflo(hh.w) + sigm(x1.z) * bflo(pp.w); o1.w = bfhi(hh.w) + sigm(x1.w) * bfhi(pp.w);
        v4u ob; ob.x = pk2(o0.x, o0.y); ob.y = pk2(o0.z, o0.w); ob.z = pk2(o1.x, o1.y); ob.w = pk2(o1.z, o1.w); *(v4u*)(xb + off) = ob;
        if (outf) { *(f32x4*)(outf + off) = o0; *(f32x4*)(outf + off + 4) = o1; }
    }
}

constexpr int N_PHASES = 22;
enum { OP_INPROJ = 0, OP_MIXA, OP_MIXB, OP_MIXC, OP_OUTPROJ, OP_LN1, OP_UP, OP_DOWN, OP_LN2, OP_GATE, OP_COMBINE };
enum { GK_LN = 0, GK_BF16 = 1, GK_SQRELU = 2, GK_COMB = 3 };
__global__ void __launch_bounds__(NTHR, 2) mk_fwd(Args a_in) {
    extern __shared__ __attribute__((aligned(16))) unsigned char lds_raw[];
    LAS unsigned char* lds = (LAS unsigned char*)lds_raw;
    ArgsP kp = (ArgsP)__builtin_amdgcn_kernarg_segment_ptr();
    const int lo = a_in.ph_lo, hi = a_in.ph_hi;
    int wv0; { const int wtmp = (int)threadIdx.x >> 6; asm volatile("s_nop 4\n\tv_readfirstlane_b32 %0, %1\n\ts_nop 4" : "=s"(wv0) : "v"(wtmp)); }
#if MK_N_LAUNCHES == 1
    volatile LAS unsigned* xst = (volatile LAS unsigned*)(lds + LDS_CTL_OFF);
    if (threadIdx.x < 2) xst[threadIdx.x] = 0u;
    __syncthreads();
    XcdBarrier bar = xcd_barrier_post((unsigned*)(a_in.ws + WS_CTL) + 4096, xst);
#endif
    int p = lo; asm volatile("" : "+s"(p));
#pragma unroll 1
    for (; p < hi; ) {
      int nrep = 1;
      if (PROBE_MASK) { const int L_ = p <= 11 ? 0 : 1; const int q_ = p == 0 ? -1 : (L_ == 0 ? p - 1 : (p - 12 < 3 ? p - 12 : p - 11));
        int grp; if (p == 0) grp = 0; else if (q_ == OP_INPROJ || q_ == OP_UP) grp = 1; else if (q_ == OP_OUTPROJ || q_ == OP_DOWN || q_ == OP_GATE) grp = 2; else if (q_ == OP_LN1 || q_ == OP_LN2 || q_ == OP_COMBINE) grp = 3; else grp = (L_ == 0) ? 4 : 5;
        if ((PROBE_MASK >> grp) & 1) nrep = 2; }
      if (p == PROBE_P) nrep = 2;
#pragma unroll 1
      for (int rep = 0; rep < nrep; ++rep) {
        int pp = p; asm volatile("" : "+s"(pp));
        int wvs = wv0; asm volatile("" : "+s"(wvs));
        unsigned ones = ~0u; asm volatile("" : "+s"(ones));
        int tid = (wvs << 6) | (int)__builtin_amdgcn_mbcnt_hi(ones, __builtin_amdgcn_mbcnt_lo(ones, 0u)); asm volatile("" : "+v"(tid));
        int bx = blockIdx.x; asm volatile("" : "+s"(bx));
        int G = gridDim.x; asm volatile("" : "+s"(G));
        ArgsP a = kp; asm volatile("" : "+s"(a));
#define MK_VCU ((G % 8 == 0) ? (bx % 8) * (G / 8) + bx / 8 : bx)
#define MK_WAVE (__builtin_amdgcn_readfirstlane(tid >> 6))
#define MK_GW (MK_VCU * NWAVES + MK_WAVE)
#define MK_NGW (G * NWAVES)
#define MK_LANE (tid & 63)
        unsigned char* ws = a->ws;
        if (pp == 0) {
phase_convert(a, lds, MK_GW, MK_NGW, MK_WAVE, MK_LANE); }
        else {
            const int L = pp <= 11 ? 0 : 1; const int q = L == 0 ? pp - 1 : (pp - 12 < 3 ? pp - 12 : pp - 11);
            bf16* xb = (bf16*)(ws + WS_XB); bf16* mixb = (bf16*)(ws + WS_MIX); bf16* hb = (bf16*)(ws + WS_H); bf16* h2b = (bf16*)(ws + WS_H2); bf16* pwb = (bf16*)(ws + WS_PW);
            bf16* projb = (bf16*)(ws + WS_PROJ); bf16* upb = (bf16*)(ws + WS_PROJ);
            bf16* vbb = (bf16*)(ws + WS_PART0); float* stb = (float*)(ws + WS_PART0 + 34 * MiB); float* part1 = (float*)(ws + WS_PART1); float* gatesb = (float*)(ws + WS_GATES);
            if (q == OP_MIXA) { if (L == 0) phase_mixer_even(a, lds, MK_VCU, G, tid); else phase_mixer_odd(a, lds, MK_VCU, G, tid); }
            else if (q == OP_MIXB) { if (L == 0) phase_mixer_even_b(a, lds, MK_VCU, G, tid); else phase_mixer_odd_b(a, lds, MK_VCU, G, tid); }
            else if (q == OP_MIXC) { phase_mixer_even_c(a, lds, MK_VCU, G, tid); }
            else if (q == OP_LN1) phase_ln(vbb, stb, part1, xb, a->in[I_LN1G] + L * D, a->in[I_LN1B] + L * D, hb, lds, MK_VCU, G, tid);
            else if (q == OP_LN2) phase_ln(vbb, stb, part1, hb, a->in[I_LN2G] + L * D, a->in[I_LN2B] + L * D, h2b, lds, MK_VCU, G, tid);
            else if (q == OP_COMBINE) phase_combine(part1, h2b, pwb, xb, L == 1 ? a->out + O_Y : nullptr, MK_VCU, G, tid);
            else {
                for (int sub = 0; sub < (q == OP_INPROJ ? 2 : 1); ++sub) {
                    const bf16* A; const bf16* Bt; int N, K, kind; void* out = nullptr; float* gp = nullptr; const bf16* resid = nullptr; int corder = bx, gorder = G;
                    const int busy_in = ((M / 256) * (NPROJ_PAD / 256)) % 256;
                    if (q == OP_INPROJ && sub == 0) { A = xb; Bt = (const bf16*)(ws + (L == 0 ? WS_WINE : WS_WINO)); N = NPROJ_PAD; K = D; kind = GK_BF16; out = projb; gp = gatesb; }
                    else if (q == OP_INPROJ) { A = (const bf16*)(ws + WS_PB) + (size_t)L * M * PLE; Bt = (const bf16*)(ws + WS_WPLE) + (size_t)L * PLE * D; N = D; K = PLE; kind = GK_BF16; out = pwb;
                        gorder = G - busy_in; corder = (bx >= busy_in) ? bx - busy_in : 1 << 20; }
                    else if (q == OP_OUTPROJ) { A = mixb; Bt = (const bf16*)(ws + (L == 0 ? WS_WOUTE : WS_WOUTO)); N = D; K = D; kind = GK_LN; resid = xb; }
                    else if (q == OP_UP) { A = hb; Bt = (const bf16*)(ws + WS_WUP) + (size_t)L * D * FF; N = FF; K = D; kind = GK_SQRELU; out = upb; }
                    else if (q == OP_DOWN) { A = upb; Bt = (const bf16*)(ws + WS_WDOWN) + (size_t)L * D * FF; N = D; K = FF; kind = GK_LN; resid = hb; }
                    else { A = h2b; Bt = (const bf16*)(ws + WS_WGATE) + (size_t)L * D * D; N = D; K = D; kind = GK_COMB; }
                    pg8::Gemm g{A, Bt, M, N, K};
                    if (kind == GK_LN) { pg8::MainSplit SK; SK.init(K, MK_VCU); pg8::EpiLnStat E{vbb, stb, resid, part1, N, M, DN_ALPHA}; pg8::gemm_phase<pg8::EpiLnStat, pg8::MainSplit, true, true>(lds, g, SK, E, tid); }
                    else if (kind == GK_COMB) { pg8::MainSplit SK; SK.init(K, MK_VCU); pg8::EpiCombine E{h2b, pwb, xb, L == 1 ? a->out + O_Y : nullptr, part1, N}; pg8::gemm_phase<pg8::EpiCombine, pg8::MainSplit, true, true>(lds, g, SK, E, tid); }
                    else if (kind == GK_BF16) { pg8::StaticOrder S; S.init(M, N, K, gorder, corder); pg8::EpiBf16<0> E{(bf16*)out, N, gp, 24}; pg8::gemm_phase<pg8::EpiBf16<0>, pg8::StaticOrder, true, true>(lds, g, S, E, tid);}
                    else { pg8::StaticOrder S; S.init(M, N, K, G, corder); pg8::EpiBf16<1> E{(bf16*)out, N, nullptr, -1}; pg8::gemm_phase<pg8::EpiBf16<1>, pg8::StaticOrder, true, true>(lds, g, S, E, tid);}
                }
                if (q == OP_INPROJ || q == OP_UP) {
                    const int busy = (q == OP_INPROJ) ? ((M / 256) * (NPROJ_PAD / 256)) % 256 : ((M / 256) * (FF / 256)) % 256;
                    const int first = (q == OP_INPROJ) ? (L == 0 ? 0 : cv::R_SCAN) : (L == 0 ? cv::R_IN1 : cv::R_UP0), last = (q == OP_INPROJ) ? (L == 0 ? cv::R_IN0 : cv::R_IN1) : (L == 0 ? cv::R_UP0 : cv::N_REST);
                    if (G == 256 && bx >= busy) { const int w_ = MK_WAVE; convert_range(a, (LAS float*)(lds + w_ * 16384), first, last, (bx - busy) * NWAVES + w_, (G - busy) * NWAVES, MK_LANE); }
                }
            }
        }
#if MK_N_LAUNCHES == 1
        if (p + 1 < hi || rep + 1 < nrep) xcd_barrier(bar);
#endif
      }
      asm volatile("s_add_i32 %0, %0, 1" : "+s"(p) : : "scc");
    }
}

extern "C" void kernel_launch(void* const* d_in, const int* in_sizes, int n_in, void* d_out, int out_size, void* d_ws, size_t ws_size, hipStream_t stream) {
    static int grid = 0;
    if (grid == 0) {
        if (n_in != 35 || (size_t)out_size != O_END || ws_size < WS_END) { fprintf(stderr, "kernel_launch: unexpected shapes: n_in %d out %d (want %zu) ws %zu (want %zu)\n", n_in, out_size, (size_t)O_END, ws_size, (size_t)WS_END); grid = -1; return; }
        int dev = 0, cus = 0, per_cu = 0;
        hipGetDevice(&dev); hipDeviceGetAttribute(&cus, hipDeviceAttributeMultiprocessorCount, dev);
        if (hipFuncSetAttribute((const void*)mk_fwd, hipFuncAttributeMaxDynamicSharedMemorySize, LDS_BYTES) != hipSuccess) { fprintf(stderr, "kernel_launch: hipFuncSetAttribute failed\n"); grid = -1; return; }
        if (hipOccupancyMaxActiveBlocksPerMultiprocessor(&per_cu, (const void*)mk_fwd, NTHR, LDS_BYTES) != hipSuccess || per_cu < 1) { fprintf(stderr, "kernel_launch: occupancy query says %d\n", per_cu); per_cu = 1; }
        (void)hipGetLastError();
        if (cus != 256) { fprintf(stderr, "kernel_launch: built for a 256-CU device (N = 2048 GEMM schedule), got %d\n", cus); grid = -1; return; }
        grid = cus * 1;
    }
    if (grid < 0) return;
    Args a{};
    for (int i = 0; i < 35; ++i) a.in[i] = (const float*)d_in[i];
    a.out = (float*)d_out; a.ws = (unsigned char*)d_ws;
#if MK_N_LAUNCHES == 1
    hipMemsetAsync((char*)d_ws + WS_CTL, 0, 1 * MiB, stream);
    a.ph_lo = 0; a.ph_hi = N_PHASES;
    hipLaunchKernelGGL(mk_fwd, dim3(grid), dim3(NTHR), LDS_BYTES, stream, a);
#else
    for (int p = 0; p < N_PHASES; ++p) {
        a.ph_lo = p; a.ph_hi = p + 1;
        hipLaunchKernelGGL(mk_fwd, dim3(grid), dim3(NTHR), LDS_BYTES, stream, a);
    }
#endif
}
```

```cpp
#include <hip/hip_runtime.h>
#include <hip/hip_cooperative_groups.h>
#include <cstdio>
#include <cstdint>
namespace cg = cooperative_groups;

#ifndef PROBE_MASK
#define PROBE_MASK 0
#endif
#define PROBE_P (-1)
#define PROBE_SUB 0
#ifndef MK_N_LAUNCHES
#define MK_N_LAUNCHES 1
#endif

namespace pg8 {
#define PG8_LAS __attribute__((address_space(3)))
typedef unsigned short bf16_t;
typedef short bf16x8 __attribute__((ext_vector_type(8)));
typedef float f32x4 __attribute__((ext_vector_type(4)));
typedef unsigned u32x4 __attribute__((ext_vector_type(4)));
constexpr int BM = 256, BK = 64, HALF = 128, HTB = HALF * BK * 2, STAGE_BYTES = 8 * HTB, NXCD = 8, WGM = 8;

__host__ __device__ __forceinline__ int lds_byte(int r, int c) { const int st = (r >> 4) * 2 + (c >> 5), rr = r & 15, cc = c & 31, ob = rr * 64 + cc * 2; return st * 1024 + (ob ^ (((ob >> 9) & 1) << 5)); }
__host__ __device__ __forceinline__ void stage_rc(int b, int& R, int& C) { const int st = b / 1024, sb = b % 1024, swz = sb ^ (((sb >> 9) & 1) << 5); R = (st >> 1) * 16 + swz / 64; C = (st & 1) * 32 + (swz % 64) / 2; }
__host__ __device__ __forceinline__ int perm32(int rho) { const int n = rho >> 4, i = rho & 15; return 8 * (i >> 2) + 4 * n + (i & 3); }

struct Unit { int pm, pn, kt0, nkt, dst; };
struct Gemm { const bf16_t* A; const bf16_t* Bt; int M, N, K; };

struct StaticOrder {
    int nM, nN, nwg, G, c, T;
    __host__ __device__ void init(int M, int N, int K, int G_, int c_) { nM = M / BM; nN = N / BM; nwg = nM * nN; G = G_; c = c_; T = K / BK; }
    __host__ __device__ bool next(int i, Unit& u) const {
        const long L = (long)i * G + c; if (L >= nwg) return false;
        int wgid = (int)L; { const int q = nwg / NXCD, r = nwg % NXCD, xcd = wgid % NXCD, off = wgid / NXCD; wgid = (xcd < r ? xcd * (q + 1) : r * (q + 1) + (xcd - r) * q) + off; }
        const int nig = WGM * nN, gid = wgid / nig, fm = gid * WGM, gsz = (nM - fm) < WGM ? (nM - fm) : WGM;
        u.pm = fm + ((wgid % nig) % gsz); u.pn = (wgid % nig) / gsz; u.kt0 = 0; u.nkt = T; u.dst = 0; return true;
    }
    __device__ __forceinline__ void a_ready(const Unit&) const {}
    __device__ __forceinline__ void done(const Unit&) const {}
};
struct StreamK {
    int nN, T, P, ntot, c;
    __host__ __device__ void init(int M, int N, int K, int G, int c_) { nN = N / BM; T = K / BK; ntot = (M / BM) * nN * T; P = (((ntot + G - 1) / G) + 1) & ~1; c = c_; }
    __host__ __device__ bool next(int i, Unit& u) const {
        int s = c * P; const int e = (s + P < ntot) ? s + P : ntot;
        for (int k = 0; ; ++k) { if (s >= e) return false; const int tile = s / T, kt0 = s - tile * T; const int n = (T - kt0 < e - s) ? T - kt0 : e - s;
            if (k == i) { u.pm = tile / nN; u.pn = tile - u.pm * nN; u.kt0 = kt0; u.nkt = n; u.dst = kt0 ? 1 : 0; return true; }
            s += n; }
    }
    __device__ __forceinline__ void a_ready(const Unit&) const {}
    __device__ __forceinline__ void done(const Unit&) const {}
};
struct MainSplit {
    int T, c;
    __host__ __device__ void init(int K, int c_) { T = K / BK; c = c_; }
    __host__ __device__ bool next(int i, Unit& u) const {
        if (i == 0) { u.pm = c >> 3; u.pn = c & 7; u.kt0 = 0; u.nkt = T; u.dst = 0; return true; }
        if (i == 1) { const int lt = c >> 4, j = c & 15; u.pm = 32 + (lt >> 3); u.pn = lt & 7; u.nkt = T >> 4; u.kt0 = j * u.nkt; u.dst = 1 + j; return true; }
        return false;
    }
    __device__ __forceinline__ void a_ready(const Unit&) const {}
    __device__ __forceinline__ void done(const Unit&) const {}
};
__host__ __device__ __forceinline__ bool split_tile(int tile, int T, int P) { return (tile * T) / P != ((tile + 1) * T - 1) / P; }

typedef __bf16 hwbf16x2 __attribute__((ext_vector_type(2)));
typedef float hwf32x2 __attribute__((ext_vector_type(2)));
__device__ __forceinline__ unsigned cvt_pk_bf16(float lo, float hi) { return __builtin_bit_cast(unsigned, __builtin_convertvector((hwf32x2){lo, hi}, hwbf16x2)); }

__device__ __forceinline__ float pg_bflo(unsigned w) { return __builtin_bit_cast(float, w << 16); }
__device__ __forceinline__ float pg_bfhi(unsigned w) { return __builtin_bit_cast(float, w & 0xffff0000u); }
__device__ __forceinline__ void store_chunk(const f32x4 (&acc)[2][2][4][2], const Unit& u, float* C1, int ldc, int wr, int wc, int fr, int fq) {
    const int row0 = u.pm * BM + wr * 64 + fr, col0 = u.pn * BM + wc * 32 + 8 * fq; float* Cb = C1 + ((long)(u.dst - 1) * 512 - 8192) * (long)ldc;
#pragma unroll
    for (int ai = 0; ai < 2; ++ai)
#pragma unroll
        for (int m = 0; m < 4; ++m) { float* rowp = Cb + (size_t)(row0 + ai * HALF + m * 16) * ldc + col0;
#pragma unroll
            for (int bj = 0; bj < 2; ++bj) { *(f32x4*)(rowp + bj * HALF) = acc[ai][bj][m][0]; *(f32x4*)(rowp + bj * HALF + 4) = acc[ai][bj][m][1]; } }
}
struct EpiLnStat {
    static constexpr bool PERM = true, AFTER_DRAIN = false;
    bf16_t* VB; float* ST; const bf16_t* resid; float* C1; int ldc; int mrows; float alpha;
    __device__ __forceinline__ void operator()(const f32x4 (&acc)[2][2][4][2], const Unit& u, int wr, int wc, int fr, int fq) const {
        if (u.dst) { store_chunk(acc, u, C1, ldc, wr, wc, fr, fq); return; }
        const int row0 = u.pm * BM + wr * 64 + fr, col0 = u.pn * BM + wc * 32 + 8 * fq;
        u32x4 rq[2];
#pragma unroll
        for (int bj = 0; bj < 2; ++bj) rq[bj] = *(const u32x4*)(resid + (size_t)(row0) * ldc + col0 + bj * HALF);
#pragma unroll
        for (int idx = 0; idx < 8; ++idx) { const int ai = idx >> 2, m = idx & 3; const int row = row0 + ai * HALF + m * 16; float s = 0.f, ss = 0.f;
                u32x4 rc[2] = {rq[0], rq[1]};
                if (idx + 1 < 8) { const int nrow = row0 + ((idx + 1) >> 2) * HALF + ((idx + 1) & 3) * 16;
#pragma unroll
                    for (int bj = 0; bj < 2; ++bj) rq[bj] = *(const u32x4*)(resid + (size_t)nrow * ldc + col0 + bj * HALF); }
#pragma unroll
                for (int bj = 0; bj < 2; ++bj) { const size_t off = (size_t)row * ldc + col0 + bj * HALF; const u32x4 r = rc[bj];
                    f32x4 v0 = acc[ai][bj][m][0], v1 = acc[ai][bj][m][1];
                    v0[0] += alpha * pg_bflo(r.x); v0[1] += alpha * pg_bfhi(r.x); v0[2] += alpha * pg_bflo(r.y); v0[3] += alpha * pg_bfhi(r.y);
                    v1[0] += alpha * pg_bflo(r.z); v1[1] += alpha * pg_bfhi(r.z); v1[2] += alpha * pg_bflo(r.w); v1[3] += alpha * pg_bfhi(r.w);
                    s += ((v0[0] + v0[1]) + (v0[2] + v0[3])) + ((v1[0] + v1[1]) + (v1[2] + v1[3]));
                    ss += ((v0[0] * v0[0] + v0[1] * v0[1]) + (v0[2] * v0[2] + v0[3] * v0[3])) + ((v1[0] * v1[0] + v1[1] * v1[1]) + (v1[2] * v1[2] + v1[3] * v1[3]));
                    u32x4 w; w.x = cvt_pk_bf16(v0[0], v0[1]); w.y = cvt_pk_bf16(v0[2], v0[3]); w.z = cvt_pk_bf16(v1[0], v1[1]); w.w = cvt_pk_bf16(v1[2], v1[3]);
                    *(u32x4*)(VB + off) = w; }
                s += __shfl_xor(s, 16); s += __shfl_xor(s, 32); ss += __shfl_xor(ss, 16); ss += __shfl_xor(ss, 32);
                if (fq == 0) { float* sp = ST + (((size_t)u.pn * mrows + row) * 4 + wc) * 2; sp[0] = s; sp[1] = ss; } }
    }
};
struct EpiCombine {
    static constexpr bool PERM = true, AFTER_DRAIN = false;
    const bf16_t* h2; const bf16_t* pw; bf16_t* xb; float* outf; float* C1; int ldc;
    __device__ __forceinline__ void operator()(const f32x4 (&acc)[2][2][4][2], const Unit& u, int wr, int wc, int fr, int fq) const {
        if (u.dst) { store_chunk(acc, u, C1, ldc, wr, wc, fr, fq); return; }
        const int row0 = u.pm * BM + wr * 64 + fr, col0 = u.pn * BM + wc * 32 + 8 * fq;
        u32x4 hq[2], pq[2];
#pragma unroll
        for (int bj = 0; bj < 2; ++bj) { const size_t o0 = (size_t)row0 * ldc + col0 + bj * HALF; hq[bj] = *(const u32x4*)(h2 + o0); pq[bj] = *(const u32x4*)(pw + o0); }
#pragma unroll
        for (int idx = 0; idx < 8; ++idx) { const int ai = idx >> 2, m = idx & 3; const int row = row0 + ai * HALF + m * 16;
                u32x4 hc[2] = {hq[0], hq[1]}, pc[2] = {pq[0], pq[1]};
                if (idx + 1 < 8) { const int nrow = row0 + ((idx + 1) >> 2) * HALF + ((idx + 1) & 3) * 16;
#pragma unroll
                    for (int bj = 0; bj < 2; ++bj) { const size_t on = (size_t)nrow * ldc + col0 + bj * HALF; hq[bj] = *(const u32x4*)(h2 + on); pq[bj] = *(const u32x4*)(pw + on); } }
#pragma unroll
                for (int bj = 0; bj < 2; ++bj) { const size_t off = (size_t)row * ldc + col0 + bj * HALF; const u32x4 hh = hc[bj], pp = pc[bj];
                    const f32x4 a0 = acc[ai][bj][m][0], a1 = acc[ai][bj][m][1]; f32x4 o0, o1;
                    o0[0] = pg_bflo(hh.x) + pg_bflo(pp.x) / (1.f + __expf(-a0[0])); o0[1] = pg_bfhi(hh.x) + pg_bfhi(pp.x) / (1.f + __expf(-a0[1]));
                    o0[2] = pg_bflo(hh.y) + pg_bflo(pp.y) / (1.f + __expf(-a0[2])); o0[3] = pg_bfhi(hh.y) + pg_bfhi(pp.y) / (1.f + __expf(-a0[3]));
                    o1[0] = pg_bflo(hh.z) + pg_bflo(pp.z) / (1.f + __expf(-a1[0])); o1[1] = pg_bfhi(hh.z) + pg_bfhi(pp.z) / (1.f + __expf(-a1[1]));
                    o1[2] = pg_bflo(hh.w) + pg_bflo(pp.w) / (1.f + __expf(-a1[2])); o1[3] = pg_bfhi(hh.w) + pg_bfhi(pp.w) / (1.f + __expf(-a1[3]));
                    u32x4 w; w.x = cvt_pk_bf16(o0[0], o0[1]); w.y = cvt_pk_bf16(o0[2], o0[3]); w.z = cvt_pk_bf16(o1[0], o1[1]); w.w = cvt_pk_bf16(o1[2], o1[3]);
                    *(u32x4*)(xb + off) = w;
                    if (outf) { *(f32x4*)(outf + off) = o0; *(f32x4*)(outf + off + 4) = o1; } } }
    }
};
template <int ACT> struct EpiBf16 {
    static constexpr bool PERM = true, AFTER_DRAIN = false;
    bf16_t* O; int ldc; float* gates; int gate_pn;
    __device__ __forceinline__ void operator()(const f32x4 (&acc)[2][2][4][2], const Unit& u, int wr, int wc, int fr, int fq) const {
        const int row0 = u.pm * BM + wr * 64 + fr; const int col0 = u.pn * BM + wc * 32 + 8 * fq;
        const bool gt = (gates != nullptr) && (u.pn == gate_pn) && (wc == 0) && (fq < 2);
#pragma unroll
        for (int ai = 0; ai < 2; ++ai)
#pragma unroll
            for (int m = 0; m < 4; ++m) { const int row = row0 + ai * HALF + m * 16; bf16_t* rowp = O + (size_t)row * ldc + col0;
#pragma unroll
                for (int bj = 0; bj < 2; ++bj) { f32x4 v0 = acc[ai][bj][m][0], v1 = acc[ai][bj][m][1];
                    if (ACT == 1) {
#pragma unroll
                        for (int j = 0; j < 4; ++j) { const float a = fmaxf(v0[j], 0.f), b = fmaxf(v1[j], 0.f); v0[j] = a * a; v1[j] = b * b; } }
                    u32x4 w; w.x = cvt_pk_bf16(v0[0], v0[1]); w.y = cvt_pk_bf16(v0[2], v0[3]); w.z = cvt_pk_bf16(v1[0], v1[1]); w.w = cvt_pk_bf16(v1[2], v1[3]);
                    *(u32x4*)(rowp + bj * HALF) = w; }
                if (gt) { float* gp = gates + (size_t)row * 16 + 8 * fq; *(f32x4*)gp = acc[ai][0][m][0]; *(f32x4*)(gp + 4) = acc[ai][0][m][1]; } }
    }
};

template <class Epi, class Sched, bool ALIGN_EPI = false, bool SP2 = false>
__device__ __forceinline__ void gemm_phase(PG8_LAS unsigned char* lds, const Gemm g, const Sched& S, const Epi& E, const int tid) {
    const int wid = __builtin_amdgcn_readfirstlane(tid >> 6), lane = tid & 63, wr = wid >> 2, wc = wid & 3, fr = lane & 15, fq = lane >> 4;
    const int K = g.K;
    unsigned voffA[2], voffB[2];
#pragma unroll
    for (int i = 0; i < 2; ++i) { int R, C; stage_rc(tid * 16 + i * 8192, R, C); const int Rb = Epi::PERM ? ((R & ~31) + perm32(R & 31)) : R;
        voffA[i] = (unsigned)(R * K + C) * 2u; voffB[i] = (unsigned)(Rb * K + C) * 2u; }
    const size_t kstep = (size_t)(BK * 2);
    const size_t hstep = (size_t)HALF * K * 2;
    const size_t tstep = 2 * hstep;
    const unsigned ldsw = (unsigned)wid * 1024u;
    const int aoff = lds_byte(wr * 64 + fr, fq * 8), boff = lds_byte(wc * 32 + fr, fq * 8);
#define PG8_SA(b, h) (((b) * 2 + (h)) * HTB)
#define PG8_SB(b, h) ((4 + (b) * 2 + (h)) * HTB)
#define PG8_STAGE(bufoff, gbase, voff) do { _Pragma("unroll") for (int _i = 0; _i < 2; ++_i) \
        __builtin_amdgcn_global_load_lds((const unsigned*)((const char*)(gbase) + (voff)[_i]), (PG8_LAS unsigned*)(lds + (bufoff) + ldsw + _i * 8192), 16, 0, 0); } while (0)
#define PG8_LDA(dst, b, h) do { _Pragma("unroll") for (int m = 0; m < 4; ++m) _Pragma("unroll") for (int k = 0; k < 2; ++k) dst[m][k] = *(const PG8_LAS bf16x8*)(lds + PG8_SA(b, h) + aoff + m * 2048 + k * 1024); } while (0)
#define PG8_LDB(dst, b, h) do { _Pragma("unroll") for (int n = 0; n < 2; ++n) _Pragma("unroll") for (int k = 0; k < 2; ++k) dst[n][k] = *(const PG8_LAS bf16x8*)(lds + PG8_SB(b, h) + boff + n * 2048 + k * 1024); } while (0)
#define PG8_MMA(ai, bj, At, Bt) do { __builtin_amdgcn_s_setprio(1); _Pragma("unroll") for (int m = 0; m < 4; ++m) _Pragma("unroll") for (int n = 0; n < 2; ++n) _Pragma("unroll") for (int k = 0; k < 2; ++k) \
        acc[ai][bj][m][n] = __builtin_amdgcn_mfma_f32_16x16x32_bf16(Bt[n][k], At[m][k], acc[ai][bj][m][n], 0, 0, 0); __builtin_amdgcn_s_setprio(0); } while (0)
#define PG8_WAIT_V(n) asm volatile("s_waitcnt vmcnt(" #n ")" ::: "memory")
#define PG8_WAIT_L(n) asm volatile("s_waitcnt lgkmcnt(" #n ")" ::: "memory")
#define PG8_BAR __builtin_amdgcn_s_barrier()
#define PG8_SCHED __builtin_amdgcn_sched_barrier(0)
    Unit cur, nxt; int ui = 0;
    if (!S.next(0, cur)) return;
    f32x4 acc[2][2][4][2];
#pragma unroll
    for (int a = 0; a < 2; ++a)
#pragma unroll
        for (int b = 0; b < 2; ++b)
#pragma unroll
            for (int m = 0; m < 4; ++m)
#pragma unroll
                for (int n = 0; n < 2; ++n) acc[a][b][m][n] = (f32x4){0.f, 0.f, 0.f, 0.f};
    bf16x8 At[4][2], B0[2][2], B1[2][2];
    const char* cA = (const char*)g.A + (size_t)cur.pm * tstep + (size_t)cur.kt0 * kstep; const char* cB = (const char*)g.Bt + (size_t)cur.pn * tstep + (size_t)cur.kt0 * kstep;
    S.a_ready(cur);
    if constexpr (SP2) {
        PG8_STAGE(PG8_SB(0, 0), cB, voffB); PG8_STAGE(PG8_SB(0, 1), cB + hstep, voffB); PG8_STAGE(PG8_SA(0, 0), cA, voffA); PG8_STAGE(PG8_SA(0, 1), cA + hstep, voffA);
        if (wr == 1) PG8_BAR;
        PG8_WAIT_V(2); PG8_BAR;
        PG8_STAGE(PG8_SB(1, 0), cB + kstep, voffB); PG8_STAGE(PG8_SA(1, 0), cA + kstep, voffA); PG8_STAGE(PG8_SB(1, 1), cB + hstep + kstep, voffB);
        PG8_WAIT_V(6); PG8_BAR;
    } else {
        PG8_STAGE(PG8_SB(0, 0), cB, voffB); PG8_STAGE(PG8_SA(0, 0), cA, voffA); PG8_STAGE(PG8_SB(0, 1), cB + hstep, voffB); PG8_STAGE(PG8_SA(0, 1), cA + hstep, voffA);
        if (wr == 1) PG8_BAR;
        PG8_WAIT_V(4); PG8_BAR;
        PG8_STAGE(PG8_SB(1, 0), cB + kstep, voffB); PG8_STAGE(PG8_SA(1, 0), cA + kstep, voffA); PG8_STAGE(PG8_SB(1, 1), cB + hstep + kstep, voffB);
        PG8_WAIT_V(6); PG8_BAR;
    }
    for (;;) {
        const bool has_next = S.next(ui + 1, nxt);
        const char* nA = has_next ? (const char*)g.A + (size_t)nxt.pm * tstep + (size_t)nxt.kt0 * kstep : cA; const char* nB = has_next ? (const char*)g.Bt + (size_t)nxt.pn * tstep + (size_t)nxt.kt0 * kstep : cB;
        const int nt = cur.nkt;
        for (int t = 0; t < nt; t += 2) {
            const bool last = (t == nt - 2);
            const char* a1 = cA + (size_t)(t + 1) * kstep;
            const char* a2 = last ? nA : cA + (size_t)(t + 2) * kstep; const char* b2 = last ? nB : cB + (size_t)(t + 2) * kstep;
            const char* a3 = a2 + kstep; const char* b3 = b2 + kstep;
            if (last && has_next) S.a_ready(nxt);
            if constexpr (SP2) {
            PG8_LDB(B0, 0, 0); PG8_LDB(B1, 0, 1); PG8_SCHED; PG8_LDA(At, 0, 0); PG8_STAGE(PG8_SA(1, 1), a1 + hstep, voffA);
            PG8_WAIT_V(8); PG8_WAIT_L(0); PG8_BAR; PG8_MMA(0, 0, At, B0); PG8_MMA(0, 1, At, B1); PG8_BAR; PG8_SCHED;
            PG8_LDA(At, 0, 1); PG8_STAGE(PG8_SB(0, 0), b2, voffB); PG8_STAGE(PG8_SB(0, 1), b2 + hstep, voffB); PG8_STAGE(PG8_SA(0, 0), a2, voffA);
            PG8_WAIT_V(8); PG8_WAIT_L(0); PG8_BAR; PG8_MMA(1, 0, At, B0); PG8_MMA(1, 1, At, B1); PG8_BAR; PG8_SCHED;
            PG8_LDB(B0, 1, 0); PG8_LDB(B1, 1, 1); PG8_SCHED; PG8_LDA(At, 1, 0); PG8_STAGE(PG8_SA(0, 1), a2 + hstep, voffA);
            PG8_WAIT_V(8); PG8_WAIT_L(0); PG8_BAR; PG8_MMA(0, 0, At, B0); PG8_MMA(0, 1, At, B1); PG8_BAR; PG8_SCHED;
            PG8_LDA(At, 1, 1); PG8_STAGE(PG8_SB(1, 0), b3, voffB); PG8_STAGE(PG8_SB(1, 1), b3 + hstep, voffB); PG8_STAGE(PG8_SA(1, 0), a3, voffA);
            PG8_WAIT_V(8); PG8_WAIT_L(0); PG8_BAR; PG8_MMA(1, 0, At, B0); PG8_MMA(1, 1, At, B1); PG8_BAR; PG8_SCHED;
            } else {
            PG8_LDB(B0, 0, 0); PG8_SCHED; PG8_LDA(At, 0, 0); PG8_STAGE(PG8_SA(1, 1), a1 + hstep, voffA);
            PG8_WAIT_L(8); PG8_BAR; PG8_WAIT_L(0); PG8_MMA(0, 0, At, B0); PG8_BAR; PG8_SCHED;
            PG8_LDB(B1, 0, 1); PG8_STAGE(PG8_SB(0, 0), b2, voffB);
            PG8_BAR; PG8_WAIT_L(0); PG8_MMA(0, 1, At, B1); PG8_BAR;
            PG8_LDA(At, 0, 1); PG8_STAGE(PG8_SA(0, 0), a2, voffA);
            PG8_BAR; PG8_WAIT_L(0); PG8_MMA(1, 0, At, B0); PG8_BAR; PG8_SCHED;
            PG8_STAGE(PG8_SB(0, 1), b2 + hstep, voffB);
            PG8_WAIT_V(6); PG8_BAR; PG8_MMA(1, 1, At, B1); PG8_BAR;
            PG8_LDB(B0, 1, 0); PG8_SCHED; PG8_LDA(At, 1, 0); PG8_STAGE(PG8_SA(0, 1), a2 + hstep, voffA);
            PG8_WAIT_L(8); PG8_BAR; PG8_WAIT_L(0); PG8_MMA(0, 0, At, B0); PG8_BAR; PG8_SCHED;
            PG8_LDB(B1, 1, 1); PG8_STAGE(PG8_SB(1, 0), b3, voffB);
            PG8_BAR; PG8_WAIT_L(0); PG8_MMA(0, 1, At, B1); PG8_BAR;
            PG8_LDA(At, 1, 1); PG8_STAGE(PG8_SA(1, 0), a3, voffA);
            PG8_BAR; PG8_WAIT_L(0); PG8_MMA(1, 0, At, B0); PG8_BAR; PG8_SCHED;
            PG8_STAGE(PG8_SB(1, 1), b3 + hstep, voffB);
            PG8_WAIT_V(6); PG8_BAR; PG8_MMA(1, 1, At, B1); PG8_BAR;
            }
        }
        if constexpr (ALIGN_EPI) { if (wr == 0) PG8_BAR; }
        E(acc, cur, wr, wc, fr, fq); S.done(cur);
        if (!has_next) break;
#pragma unroll
        for (int a = 0; a < 2; ++a)
#pragma unroll
            for (int b = 0; b < 2; ++b)
#pragma unroll
                for (int m = 0; m < 4; ++m)
#pragma unroll
                    for (int n = 0; n < 2; ++n) acc[a][b][m][n] = (f32x4){0.f, 0.f, 0.f, 0.f};
        cur = nxt; cA = nA; cB = nB; ++ui;
        if constexpr (ALIGN_EPI) { if (wr == 1) PG8_BAR; }
    }
    PG8_WAIT_V(0);
    if constexpr (!ALIGN_EPI) { if (wr == 0) PG8_BAR; }
    PG8_BAR;
#undef PG8_SA
#undef PG8_SB
#undef PG8_STAGE
#undef PG8_LDA
#undef PG8_LDB
#undef PG8_MMA
#undef PG8_WAIT_V
#undef PG8_WAIT_L
#undef PG8_BAR
#undef PG8_SCHED
}
}

constexpr int NWAVES = 8, NTHR = 512;
constexpr int D = 2048, FF = 8192, PLE = 256;
constexpr int TP = 2048, BP = 4, TS = 4, BS = 128;
constexpr int MP = BP * TP, MS = BS * TS, M = MP + MS;
constexpr int NPROJ = 6160, NPROJ_PAD = 6400;
constexpr int NH = 8;
constexpr float LN_EPS = 1e-5f, RMS_EPS = 1e-6f;
constexpr float DN_ALPHA = 1.41421356237f;

constexpr size_t MiB = 1u << 20;
constexpr size_t WS_CTL = 0;
constexpr size_t WS_WINE = 1 * MiB;
constexpr size_t WS_WOUTE = WS_WINE + 25 * MiB;
constexpr size_t WS_WINO = WS_WOUTE + 8 * MiB;
constexpr size_t WS_WOUTO = WS_WINO + 25 * MiB;
constexpr size_t WS_WUP = WS_WOUTO + 8 * MiB;
constexpr size_t WS_WDOWN = WS_WUP + 64 * MiB;
constexpr size_t WS_WPLE = WS_WDOWN + 64 * MiB;
constexpr size_t WS_WGATE = WS_WPLE + 2 * MiB;
constexpr size_t WS_XB = WS_WGATE + 16 * MiB;
constexpr size_t WS_MIX = WS_XB + 34 * MiB;
constexpr size_t WS_H = WS_MIX + 34 * MiB;
constexpr size_t WS_H2 = WS_H + 34 * MiB;
constexpr size_t WS_PW = WS_H2 + 34 * MiB;
constexpr size_t WS_PB = WS_PW + 34 * MiB;
constexpr size_t WS_GATES = WS_PB + 9 * MiB;
constexpr size_t WS_PROJ = WS_GATES + 1 * MiB;
constexpr size_t WS_PART0 = WS_PROJ + 136 * MiB;
constexpr size_t WS_PART1 = WS_PART0 + 68 * MiB;
constexpr size_t WS_LRUW = WS_PART1 + 68 * MiB;
constexpr size_t WS_END = WS_LRUW + 1 * MiB;
constexpr size_t WS_DG = WS_PART0;
constexpr size_t WS_DB = WS_PART0 + 32 * MiB;
constexpr size_t WS_DS = WS_PART0 + 64 * MiB;
constexpr size_t WS_DQ = WS_PART0 + 96 * MiB;
constexpr size_t WS_DO = WS_PART0 + 112 * MiB;
constexpr size_t WS_DD = WS_PART0 + 128 * MiB;
constexpr size_t WS_DF = WS_PART0 + 129 * MiB;
constexpr size_t WS_MC = WS_PART0;
constexpr size_t WS_MN = WS_PART0 + 64 * MiB;
constexpr size_t WS_MM = WS_PART0 + 65 * MiB;
constexpr size_t WS_LRU_HL = WS_H;
constexpr size_t WS_LRU_P = WS_H + 16 * MiB;
constexpr size_t WS_LRU_END = WS_H + 32 * MiB;

constexpr size_t O_Y = 0;
constexpr size_t O_CONVP = (size_t)M * D;
constexpr size_t O_DELTAP = O_CONVP + (size_t)BP * 3 * 4096;
constexpr size_t O_LRUP = O_DELTAP + (size_t)BP * 8 * 128 * 128;
constexpr size_t O_MCP = O_LRUP + (size_t)BP * 1024;
constexpr size_t O_MNP = O_MCP + (size_t)BP * 8 * 256 * 128;
constexpr size_t O_MMP = O_MNP + (size_t)BP * 8 * 128;
constexpr size_t O_CONVS = O_MMP + (size_t)BP * 8;
constexpr size_t O_DELTAS = O_CONVS + (size_t)BS * 3 * 4096;
constexpr size_t O_LRUS = O_DELTAS + (size_t)BS * 8 * 128 * 128;
constexpr size_t O_MCS = O_LRUS + (size_t)BS * 1024;
constexpr size_t O_MNS = O_MCS + (size_t)BS * 8 * 256 * 128;
constexpr size_t O_MMS = O_MNS + (size_t)BS * 8 * 128;
constexpr size_t O_END = O_MMS + (size_t)BS * 8;

constexpr int LDS_BYTES = 147456;
constexpr int LDS_CTL_OFF = 131072;

#define LAS __attribute__((address_space(3)))
typedef unsigned short bf16;
typedef unsigned v4u __attribute__((ext_vector_type(4)));
typedef unsigned v2u __attribute__((ext_vector_type(2)));
typedef float f32x4 __attribute__((ext_vector_type(4)));
#define LDS_WAIT() asm volatile("s_waitcnt lgkmcnt(0)" ::: "memory")
#define LDS_BARRIER() do { asm volatile("s_waitcnt lgkmcnt(0)" ::: "memory"); __builtin_amdgcn_s_barrier(); asm volatile("" ::: "memory"); } while (0)
__device__ __forceinline__ unsigned pk2(float lo, float hi) { return pg8::cvt_pk_bf16(lo, hi); }
__device__ __forceinline__ unsigned f2bf(float f) { return pg8::cvt_pk_bf16(f, 0.f) & 0xffffu; }
__device__ __forceinline__ float bf2f(unsigned short b) { return __builtin_bit_cast(float, ((unsigned)b) << 16); }
__device__ __forceinline__ float bflo(unsigned w) { return __builtin_bit_cast(float, w << 16); }
__device__ __forceinline__ float bfhi(unsigned w) { return __builtin_bit_cast(float, w & 0xffff0000u); }
__device__ __forceinline__ float fexp(float x) { return __builtin_amdgcn_exp2f(x * 1.4426950408889634f); }
__device__ __forceinline__ float sigm(float x) { return __builtin_amdgcn_rcpf(1.f + fexp(-x)); }
__device__ __forceinline__ float siluf(float x) { return x * sigm(x); }
__device__ __forceinline__ float softplusf(float x) { return fmaxf(x, 0.f) + log1pf(expf(-fabsf(x))); }
__device__ __forceinline__ float logsigf(float x) { return -softplusf(-x); }
__device__ __forceinline__ float neg_expm1(float y) {
    const float ser = -y * (1.f + y * (0.5f + y * (0.16666667f + y * (0.041666668f + y * (0.008333334f + y * 0.0013888889f)))));
    return (y > -0.25f) ? ser : 1.f - fexp(y);
}
__device__ __forceinline__ float gelu_tanh(float x) { const float u = 0.7978845608028654f * (x + 0.044715f * x * x * x); return x * sigm(2.f * u); }
__device__ __forceinline__ float wave_sum(float v) {
#pragma unroll
    for (int o = 1; o < 64; o <<= 1) v += __shfl_xor(v, o);
    return v;
}

__device__ __forceinline__ float wave_incl_sum(float v, int lane) {
#pragma unroll
    for (int o = 1; o < 64; o <<= 1) { const float u = __shfl_up(v, o); if (lane >= o) v += u; }
    return v;
}
__device__ __forceinline__ float wave_incl_max(float v, int lane) {
#pragma unroll
    for (int o = 1; o < 64; o <<= 1) { const float u = __shfl_up(v, o); if (lane >= o) v = fmaxf(v, u); }
    return v;
}
__device__ __forceinline__ float wave_max(float v) {
#pragma unroll
    for (int o = 1; o < 64; o <<= 1) v = fmaxf(v, __shfl_xor(v, o));
    return v;
}
#define XB_TMO      128
#define XB_XCNT(j)  (256  + 64 * (j))
#define XB_XSUB(j)  (1280 + 64 * (j))
#define XB_XGEN(j)  (2304 + 64 * (j))
#define XB_TOP      3328
#define XB_TOPGEN   3392
#define XCD_BAR_WORDS 3456
#define XB_SPIN_CAP (1u << 22)
__device__ __forceinline__ unsigned xb_ld(unsigned* p)              { return __hip_atomic_load(p, __ATOMIC_RELAXED, __HIP_MEMORY_SCOPE_AGENT); }
__device__ __forceinline__ unsigned xb_add(unsigned* p, unsigned v) { return __hip_atomic_fetch_add(p, v, __ATOMIC_RELAXED, __HIP_MEMORY_SCOPE_AGENT); }
__device__ __forceinline__ unsigned xb_xcc_id() { return (unsigned)__builtin_amdgcn_s_getreg((3 << 11) | 20) & 0xFu; }
#define XB_SPIN(cond, bar) do { unsigned _sp = 0; while (cond) { __builtin_amdgcn_s_sleep(1); \
    if ((++_sp & 255u) == 0u) { if (xb_ld(&(bar)[XB_TMO])) break; if (_sp > XB_SPIN_CAP) { atomicAdd(&(bar)[XB_TMO], 1u); break; } } } } while (0)
struct XcdBarrier { unsigned* bar; unsigned x; volatile LAS unsigned* st; };
__device__ __forceinline__ XcdBarrier xcd_barrier_post(unsigned* bar, volatile LAS unsigned* st) {
    XcdBarrier b; b.bar = bar; b.x = xb_xcc_id(); b.st = st;
    if (threadIdx.x == 0) (void)xb_add(&bar[XB_XCNT(b.x)], 1u);
    return b;
}
__device__ __forceinline__ void xcd_barrier_complete(unsigned* bar, unsigned x, unsigned& nloc, unsigned& nx) {
    const unsigned G = gridDim.x * gridDim.y * gridDim.z;
    unsigned sum, cnt, mine, sp = 0u;
    for (;;) {
        sum = 0u; cnt = 0u; mine = 0u;
#pragma unroll
        for (unsigned j = 0; j < 16; ++j) { const unsigned c = xb_ld(&bar[XB_XCNT(j)]); sum += c; cnt += (c > 0u) ? 1u : 0u; mine = (j == x) ? c : mine; }
        if (sum == G) break;
        __builtin_amdgcn_s_sleep(1);
        if ((++sp & 255u) == 0u) { if (xb_ld(&bar[XB_TMO])) break; if (sp > XB_SPIN_CAP) { atomicAdd(&bar[XB_TMO], 1u); break; } }
    }
    nloc = mine > 0u ? mine : 1u; nx = cnt > 0u ? cnt : 1u;
}
__device__ __forceinline__ void xcd_barrier(const XcdBarrier& b) {
    asm volatile("s_waitcnt vmcnt(0)" ::: "memory");
    __syncthreads();
    if (threadIdx.x == 0) {
        unsigned* bar = b.bar;
        __builtin_amdgcn_s_waitcnt(0);
        unsigned nloc = b.st[0], nx = b.st[1];
        if (nloc == 0u) { xcd_barrier_complete(bar, b.x, nloc, nx); b.st[0] = nloc; b.st[1] = nx; }
        const unsigned old = xb_add(&bar[XB_XSUB(b.x)], 1u);
        const unsigned gen = old / nloc;
        if (old + 1u == (gen + 1u) * nloc) {
            __builtin_amdgcn_fence(__ATOMIC_RELEASE, "agent");
            asm volatile("s_waitcnt vmcnt(0)" ::: "memory");
            const unsigned og = xb_add(&bar[XB_TOP], 1u);
            const unsigned tg = og / nx;
            if (og + 1u == (tg + 1u) * nx) xb_add(&bar[XB_TOPGEN], 1u);
            else XB_SPIN(xb_ld(&bar[XB_TOPGEN]) == tg, bar);
            __builtin_amdgcn_fence(__ATOMIC_ACQUIRE, "agent");
            xb_add(&bar[XB_XGEN(b.x)], 1u);
            asm volatile("s_waitcnt vmcnt(0)" ::: "memory");
        } else {
            XB_SPIN(xb_ld(&bar[XB_XGEN(b.x)]) == gen, bar);
            __builtin_amdgcn_fence(__ATOMIC_ACQUIRE, "agent");
            asm volatile("s_waitcnt vmcnt(0)" ::: "memory");
        }
    }
    __syncthreads();
}

struct Args { const float* in[35]; float* out; unsigned char* ws; int ph_lo, ph_hi; };
typedef const __attribute__((address_space(4))) Args* ArgsP;
enum { I_XP = 0, I_XS, I_PP, I_PS, I_SCONV, I_SDELTA, I_SLRU, I_SMC, I_SMN, I_SMM, I_WINE, I_WCONV, I_BCONV, I_ALOG, I_DTB, I_DNORM, I_LWR, I_LBR, I_LWI, I_LBI, I_LLAM, I_WOUTE,
       I_WINO, I_BIG, I_BFG, I_MNORM, I_WOUTO, I_LN1G, I_LN1B, I_LN2G, I_LN2B, I_WUP, I_WDOWN, I_WPLE, I_WGATE };

struct TDesc { const float* W; bf16* WT; int K, N, Npad, item; };
__device__ __forceinline__ void t_load(const TDesc& d, int lane, f32x4 (&v)[8]) {
    const int nblk = d.Npad / 32, kb = d.item / nblk, nb = d.item % nblk, k0 = 64 * kb, n0 = 32 * nb;
    const int r = lane >> 3, c4 = lane & 7; const bool ok = (n0 + 4 * c4) < d.N;
#pragma unroll
    for (int i = 0; i < 8; ++i) v[i] = ok ? __builtin_nontemporal_load((const f32x4*)(d.W + (size_t)(k0 + 8 * i + r) * d.N + n0 + 4 * c4)) : (f32x4){0.f, 0.f, 0.f, 0.f};
}
__device__ __forceinline__ void t_finish(const TDesc& d, LAS float* scr, int lane, const f32x4 (&v)[8]) {
    const int nblk = d.Npad / 32, kb = d.item / nblk, nb = d.item % nblk, k0 = 64 * kb, n0 = 32 * nb;
    const int r = lane >> 3, c4 = lane & 7;
#pragma unroll
    for (int i = 0; i < 8; ++i) { LAS float* q = scr + (8 * i + r) * 33 + 4 * c4; q[0] = v[i].x; q[1] = v[i].y; q[2] = v[i].z; q[3] = v[i].w; }
    LDS_WAIT(); asm volatile("" ::: "memory");
    const int c = lane & 7;
#pragma unroll
    for (int j = 0; j < 4; ++j) { const int n = (lane >> 3) + 8 * j; const LAS float* s = scr + (8 * c) * 33 + n;
        v4u o; o.x = pk2(s[0 * 33], s[1 * 33]); o.y = pk2(s[2 * 33], s[3 * 33]); o.z = pk2(s[4 * 33], s[5 * 33]); o.w = pk2(s[6 * 33], s[7 * 33]);
        *(v4u*)(d.WT + (size_t)(n0 + n) * d.K + k0 + 8 * c) = o; }
    LDS_WAIT(); asm volatile("" ::: "memory");
}
__device__ __forceinline__ void p0_transpose_item(const float* W, int K, int N, int Npad, bf16* WT, LAS float* scr, int item, int lane) {
    const TDesc d{W, WT, K, N, Npad, item}; f32x4 v[8]; t_load(d, lane, v); t_finish(d, scr, lane, v);
}
template <int N> __device__ __forceinline__ void row_to_bf16(const float* src, bf16* dst, int lane) {
    f32x4 v[N / 256];
#pragma unroll
    for (int j = 0; j < N / 256; ++j) v[j] = __builtin_nontemporal_load((const f32x4*)(src + j * 256 + lane * 4));
#pragma unroll
    for (int j = 0; j < N / 256; ++j) { v2u o; o.x = pk2(v[j].x, v[j].y); o.y = pk2(v[j].z, v[j].w); *(v2u*)(dst + j * 256 + lane * 4) = o; }
}
namespace cv { constexpr int I_IN = (D / 64) * (NPROJ_PAD / 32), I_SQ = (D / 64) * (D / 32), I_UP = (D / 64) * (FF / 32), I_DN = (FF / 64) * (D / 32), I_PL = (PLE / 64) * (D / 32);
               constexpr int N_FIRST = I_IN + I_PL + 128, N_REST = I_IN + 2 * I_SQ + 2 * I_UP + 2 * I_DN + I_PL + 2 * I_SQ;
               constexpr int R_IN0 = 6200;
               constexpr int R_G1 = I_SQ + I_UP + I_SQ + I_IN + I_SQ + I_PL + I_SQ;
               constexpr int R_IN1 = R_G1 + I_UP;
               constexpr int R_SCAN = R_IN1 - 6200;
               constexpr int R_UP0 = R_IN1 + I_DN;
               static_assert(R_UP0 + I_DN == N_REST && R_SCAN > R_G1 && R_SCAN > R_IN0, "conversion ranges"); }
__device__ __forceinline__ void convert_first_item(ArgsP a, LAS float* scr, int r, int lane) {
    unsigned char* ws = a->ws;
    if (r < cv::I_IN) { p0_transpose_item(a->in[I_WINE], D, NPROJ, NPROJ_PAD, (bf16*)(ws + WS_WINE), scr, r, lane); return; } r -= cv::I_IN;
    if (r < cv::I_PL) { p0_transpose_item(a->in[I_WPLE], PLE, D, D, (bf16*)(ws + WS_WPLE), scr, r, lane); return; } r -= cv::I_PL;
    { const int mat = r / 64, blk = (r / 8) & 7; p0_transpose_item(a->in[mat == 0 ? I_LWR : I_LWI] + (size_t)blk * 16384, 128, 128, 128, (bf16*)(ws + WS_LRUW) + (size_t)(mat * 8 + blk) * 16384, scr, r % 8, lane); }
}
__device__ __forceinline__ TDesc decode_rest(ArgsP a, int r) {
    using namespace cv; unsigned char* ws = a->ws;
    if (r < I_SQ) return TDesc{a->in[I_WOUTE], (bf16*)(ws + WS_WOUTE), D, D, D, r}; r -= I_SQ;
    if (r < I_UP) return TDesc{a->in[I_WUP], (bf16*)(ws + WS_WUP), D, FF, FF, r}; r -= I_UP;
    if (r < I_SQ) return TDesc{a->in[I_WGATE], (bf16*)(ws + WS_WGATE), D, D, D, r}; r -= I_SQ;
    if (r < I_IN) return TDesc{a->in[I_WINO], (bf16*)(ws + WS_WINO), D, NPROJ, NPROJ_PAD, r}; r -= I_IN;
    if (r < I_SQ) return TDesc{a->in[I_WOUTO], (bf16*)(ws + WS_WOUTO), D, D, D, r}; r -= I_SQ;
    if (r < I_PL) return TDesc{a->in[I_WPLE] + (size_t)PLE * D, (bf16*)(ws + WS_WPLE) + (size_t)PLE * D, PLE, D, D, r}; r -= I_PL;
    if (r < I_SQ) return TDesc{a->in[I_WGATE] + (size_t)D * D, (bf16*)(ws + WS_WGATE) + (size_t)D * D, D, D, D, r}; r -= I_SQ;
    if (r < I_UP) return TDesc{a->in[I_WUP] + (size_t)D * FF, (bf16*)(ws + WS_WUP) + (size_t)D * FF, D, FF, FF, r}; r -= I_UP;
    if (r < I_DN) return TDesc{a->in[I_WDOWN], (bf16*)(ws + WS_WDOWN), FF, D, D, r}; r -= I_DN;
    return TDesc{a->in[I_WDOWN] + (size_t)D * FF, (bf16*)(ws + WS_WDOWN) + (size_t)D * FF, FF, D, D, r};
}
__device__ __forceinline__ void convert_range(ArgsP a, LAS float* scr, int first, int last, int widx, int nw, int lane) {
    int it = first + widx;
    TDesc dA, dB; f32x4 vA[8], vB[8];
    if (it < last) { dA = decode_rest(a, it); t_load(dA, lane, vA);
#pragma unroll 1
        for (;;) {
            const int itB = it + nw; const bool hasB = itB < last;
            if (hasB) { dB = decode_rest(a, itB); t_load(dB, lane, vB); }
            t_finish(dA, scr, lane, vA);
            if (!hasB) break;
            it = itB + nw; const bool hasA = it < last;
            if (hasA) { dA = decode_rest(a, it); t_load(dA, lane, vA); }
            t_finish(dB, scr, lane, vB);
            if (!hasA) break;
        } }
}
__device__ __forceinline__ void phase_convert(ArgsP a, LAS unsigned char* lds, int gw, int NGW, int wave, int lane) {
    unsigned char* ws = a->ws;
    LAS float* scr = (LAS float*)(lds + wave * 16384);
    for (int it = gw; it < cv::N_FIRST; it += NGW) convert_first_item(a, scr, it, lane);
    bf16* xb = (bf16*)(ws + WS_XB);
    for (int m = gw; m < M; m += NGW) {
        const float* src = m < MP ? a->in[I_XP] + (size_t)m * D : a->in[I_XS] + (size_t)(m - MP) * D;
        row_to_bf16<D>(src, xb + (size_t)m * D, lane);
    }
    bf16* pb = (bf16*)(ws + WS_PB);
    for (int r = gw; r < 2 * M; r += NGW) {
        const int l = r / M, m = r % M;
        const float* src = m < MP ? a->in[I_PP] + ((size_t)l * MP + m) * PLE : a->in[I_PS] + ((size_t)l * MS + (m - MP)) * PLE;
        row_to_bf16<PLE>(src, pb + (size_t)r * PLE, lane);
    }
}

__device__ __forceinline__ float conv_in(const bf16* proj, int row0, int tq, int ch, const float* cstate) {
    if (tq >= 0) return bf2f(proj[(size_t)(row0 + tq) * NPROJ_PAD + ch]);
    return cstate ? cstate[(3 + tq) * 4096 + ch] : 0.f;
}
__device__ __forceinline__ float conv4(const bf16* proj, int row0, int t, int ch, const float* cstate, const float* wconv, const float* bconv) {
    float acc = bconv[ch];
#pragma unroll
    for (int j = 0; j < 4; ++j) acc += wconv[j * 4096 + ch] * conv_in(proj, row0, t - 3 + j, ch, cstate);
    return acc;
}

__device__ __forceinline__ void delta_rec_item(ArgsP a, LAS unsigned char* lds, int row0, int T, int h, const float* cstate, const float* S0, float* Sout, const int tid) {
    const int lane = tid & 63, wave = tid >> 6, c = tid & 127, r = tid >> 7;
    const bf16* proj = (const bf16*)(a->ws + WS_PROJ); const float* gates = (const float*)(a->ws + WS_GATES); bf16* mix = (bf16*)(a->ws + WS_MIX);
    const float* wconv = a->in[I_WCONV]; const float* bconv = a->in[I_BCONV];
    LAS float* act = (LAS float*)lds;
    LAS float* nrm = act + 4 * 384;
    LAS float* gb = nrm + 8;
    LAS float* red = gb + 8;
    LAS float* red2 = red + 512;
    LAS float* obuf = red2 + 512;
    float s[32];
#pragma unroll
    for (int i = 0; i < 32; ++i) s[i] = S0 ? S0[(size_t)(32 * r + i) * 128 + c] : 0.f;
    const float aexp = fexp(a->in[I_ALOG][h]), dtb = a->in[I_DTB][h];
#pragma unroll 1
    for (int t0 = 0; t0 < T; t0 += 4) {
#pragma unroll
        for (int j = 0; j < 3; ++j) { const int idx = tid + 512 * j, tok = idx / 384, chl = idx % 384, part = chl >> 7, i = chl & 127;
            const int ch = part * 1024 + h * 128 + i;
            act[tok * 384 + chl] = siluf(conv4(proj, row0, t0 + tok, ch, cstate, wconv, bconv)); }
        LDS_BARRIER();
        { const int tok = wave >> 1, part = wave & 1; const float x0 = act[tok * 384 + part * 128 + lane], x1 = act[tok * 384 + part * 128 + 64 + lane];
          const float ss = wave_sum(x0 * x0 + x1 * x1); if (lane == 0) nrm[tok * 2 + part] = rsqrtf(ss + 1e-6f) * (part == 0 ? 0.08838834764831845f : 1.f); }
        if (tid < 4) { const int row = row0 + t0 + tid; const float g = -aexp * softplusf(gates[(size_t)row * 16 + h] + dtb); gb[tid * 2] = fexp(g); gb[tid * 2 + 1] = sigm(gates[(size_t)row * 16 + 8 + h]); }
        LDS_BARRIER();
#pragma unroll 1
        for (int tok = 0; tok < 4; ++tok) {
            const float eg = gb[tok * 2], beta = gb[tok * 2 + 1], nq = nrm[tok * 2], nk = nrm[tok * 2 + 1];
            const LAS float* qv = act + tok * 384 + 32 * r; const LAS float* kv = qv + 128;
            float ks = 0.f;
#pragma unroll
            for (int i = 0; i < 32; ++i) ks += kv[i] * s[i];
            red[r * 128 + c] = ks * nk;
            LDS_BARRIER();
            const float kS = red[c] + red[128 + c] + red[256 + c] + red[384 + c];
            const float vnew = beta * (act[tok * 384 + 256 + c] - eg * kS);
            float os = 0.f;
#pragma unroll
            for (int i = 0; i < 32; ++i) { s[i] = eg * s[i] + (kv[i] * nk) * vnew; os += qv[i] * s[i]; }
            red2[r * 128 + c] = os * nq;
            LDS_BARRIER();
            if (r == 0) obuf[tok * 128 + c] = red2[c] + red2[128 + c] + red2[256 + c] + red2[384 + c];
        }
        LDS_BARRIER();
        if (wave < 4) { const int tok = wave, row = row0 + t0 + tok; const float o0 = obuf[tok * 128 + lane], o1 = obuf[tok * 128 + 64 + lane];
            const float rstd = rsqrtf(wave_sum(o0 * o0 + o1 * o1) * (1.f / 128.f) + RMS_EPS);
            const float* nw = a->in[I_DNORM];
            const float z0 = bf2f(proj[(size_t)row * NPROJ_PAD + 4096 + h * 128 + lane]), z1 = bf2f(proj[(size_t)row * NPROJ_PAD + 4096 + h * 128 + 64 + lane]);
            mix[(size_t)row * D + h * 128 + lane] = (bf16)f2bf(o0 * rstd * nw[lane] * siluf(z0));
            mix[(size_t)row * D + h * 128 + 64 + lane] = (bf16)f2bf(o1 * rstd * nw[64 + lane] * siluf(z1)); }
        LDS_BARRIER();
    }
#pragma unroll
    for (int i = 0; i < 32; ++i) Sout[(size_t)(32 * r + i) * 128 + c] = s[i];
}


typedef short bf16x8 __attribute__((ext_vector_type(8)));
#define MFMA32(a_, b_, c_) __builtin_amdgcn_mfma_f32_16x16x32_bf16(a_, b_, c_, 0, 0, 0)

__device__ __forceinline__ void lru_prep_item(ArgsP a, LAS unsigned char* lds, int item, const int tid) {
    const int c = item & 31, n = (item >> 5) & 7, b = item >> 8;
    const int lane = tid & 63, w = __builtin_amdgcn_readfirstlane(tid >> 6), fr = lane & 15, fq = lane >> 4;
    unsigned char* ws = a->ws;
    const bf16* proj = (const bf16*)(ws + WS_PROJ);
    LAS bf16* xa = (LAS bf16*)lds;
    LAS float* xf = (LAS float*)(lds + 17408);
    LAS float* obH = (LAS float*)(lds + 51200);
    LAS float* obP = obH + 64 * 132;
    {
        const int t = tid >> 3, sub = tid & 7, ch0 = 3072 + n * 128 + sub * 16;
        const float* wconv = a->in[I_WCONV]; const float* bconv = a->in[I_BCONV];
        float x[16];
#pragma unroll
        for (int i = 0; i < 4; ++i) { const f32x4 bb = *(const f32x4*)(bconv + ch0 + 4 * i); x[4 * i] = bb.x; x[4 * i + 1] = bb.y; x[4 * i + 2] = bb.z; x[4 * i + 3] = bb.w; }
#pragma unroll
        for (int j = 0; j < 4; ++j) { const int tt = 64 * c + t - 3 + j;
            if (tt >= 0) { const bf16* pr = proj + (size_t)(b * TP + tt) * NPROJ_PAD + ch0; const v4u u0 = *(const v4u*)pr, u1 = *(const v4u*)(pr + 8);
                const unsigned uu[8] = {u0.x, u0.y, u0.z, u0.w, u1.x, u1.y, u1.z, u1.w};
#pragma unroll
                for (int i = 0; i < 4; ++i) { const f32x4 ww = *(const f32x4*)(wconv + j * 4096 + ch0 + 4 * i);
                    x[4 * i] += ww.x * bflo(uu[2 * i]); x[4 * i + 1] += ww.y * bfhi(uu[2 * i]); x[4 * i + 2] += ww.z * bflo(uu[2 * i + 1]); x[4 * i + 3] += ww.w * bfhi(uu[2 * i + 1]); } } }
        v4u o0, o1; o0.x = pk2(x[0], x[1]); o0.y = pk2(x[2], x[3]); o0.z = pk2(x[4], x[5]); o0.w = pk2(x[6], x[7]); o1.x = pk2(x[8], x[9]); o1.y = pk2(x[10], x[11]); o1.z = pk2(x[12], x[13]); o1.w = pk2(x[14], x[15]);
        *(LAS v4u*)(xa + t * 136 + sub * 16) = o0; *(LAS v4u*)(xa + t * 136 + sub * 16 + 8) = o1;
#pragma unroll
        for (int i = 0; i < 4; ++i) *(LAS f32x4*)(xf + t * 132 + sub * 16 + 4 * i) = (f32x4){x[4 * i], x[4 * i + 1], x[4 * i + 2], x[4 * i + 3]};
    }
    LDS_BARRIER();
    const bf16* wrT = (const bf16*)(ws + WS_LRUW) + (size_t)n * 16384; const bf16* wiT = wrT + 8 * 16384;
    bf16x8 br[4], bi[4];
#pragma unroll
    for (int ks = 0; ks < 4; ++ks) { br[ks] = *(const bf16x8*)(wrT + (16 * w + fr) * 128 + 32 * ks + 8 * fq); bi[ks] = *(const bf16x8*)(wiT + (16 * w + fr) * 128 + 32 * ks + 8 * fq); }
    f32x4 accr[4], acci[4];
#pragma unroll
    for (int tb = 0; tb < 4; ++tb) { accr[tb] = (f32x4){0.f, 0.f, 0.f, 0.f}; acci[tb] = (f32x4){0.f, 0.f, 0.f, 0.f};
#pragma unroll
        for (int ks = 0; ks < 4; ++ks) { const bf16x8 af = *(const LAS bf16x8*)(xa + (16 * tb + fr) * 136 + 32 * ks + 8 * fq); accr[tb] = MFMA32(af, br[ks], accr[tb]); acci[tb] = MFMA32(af, bi[ks], acci[tb]); } }
    const int dl = 16 * w + fr, chn = n * 128 + dl;
    const float brs = a->in[I_LBR][chn], bis = a->in[I_LBI][chn], spl = softplusf(-a->in[I_LLAM][chn]);
    float Apre = 1.f, Hpre = 0.f;
#pragma unroll
    for (int tb = 0; tb < 4; ++tb) {
        float P[4], Hh[4];
#pragma unroll
        for (int j = 0; j < 4; ++j) { const int t = 16 * tb + 4 * fq + j;
            const float log_a = -8.f * sigm(accr[tb][j] + brs) * spl; const float av = fexp(log_a);
            const float bx = sqrtf(neg_expm1(2.f * log_a)) * sigm(acci[tb][j] + bis) * xf[t * 132 + dl];
            if (j == 0) { P[0] = av; Hh[0] = bx; } else { P[j] = P[j - 1] * av; Hh[j] = av * Hh[j - 1] + bx; } }
        float Ai = P[3], Hi = Hh[3];
        { const float A2 = __shfl_up(Ai, 16), H2 = __shfl_up(Hi, 16); if (fq >= 1) { Hi = Ai * H2 + Hi; Ai = A2 * Ai; } }
        { const float A2 = __shfl_up(Ai, 32), H2 = __shfl_up(Hi, 32); if (fq >= 2) { Hi = Ai * H2 + Hi; Ai = A2 * Ai; } }
        float Aex = __shfl_up(Ai, 16), Hex = __shfl_up(Hi, 16); if (fq == 0) { Aex = 1.f; Hex = 0.f; }
        const float Atb = __shfl(Ai, 48 + fr), Htb = __shfl(Hi, 48 + fr);
        const float EA = Apre * Aex, EH = Aex * Hpre + Hex;
#pragma unroll
        for (int j = 0; j < 4; ++j) { const int t = 16 * tb + 4 * fq + j; obP[t * 132 + dl] = EA * P[j]; obH[t * 132 + dl] = P[j] * EH + Hh[j]; }
        Hpre = Atb * Hpre + Htb; Apre = Apre * Atb;
    }
    if (fq == 0) { float* e = (float*)(ws + WS_LRU_END) + (size_t)item * 256; e[dl] = Apre; e[128 + dl] = Hpre; }
    LDS_BARRIER();
    {
        const int t = tid >> 3, sub = tid & 7;
        bf16* hl = (bf16*)(ws + WS_LRU_HL) + ((size_t)item * 64 + t) * 128 + sub * 16; bf16* pp = (bf16*)(ws + WS_LRU_P) + ((size_t)item * 64 + t) * 128 + sub * 16;
        const LAS float* sh = obH + t * 132 + sub * 16; const LAS float* sp = obP + t * 132 + sub * 16;
        v4u o0, o1;
        o0.x = pk2(sh[0], sh[1]); o0.y = pk2(sh[2], sh[3]); o0.z = pk2(sh[4], sh[5]); o0.w = pk2(sh[6], sh[7]); o1.x = pk2(sh[8], sh[9]); o1.y = pk2(sh[10], sh[11]); o1.z = pk2(sh[12], sh[13]); o1.w = pk2(sh[14], sh[15]);
        *(v4u*)hl = o0; *(v4u*)(hl + 8) = o1;
        o0.x = pk2(sp[0], sp[1]); o0.y = pk2(sp[2], sp[3]); o0.z = pk2(sp[4], sp[5]); o0.w = pk2(sp[6], sp[7]); o1.x = pk2(sp[8], sp[9]); o1.y = pk2(sp[10], sp[11]); o1.z = pk2(sp[12], sp[13]); o1.w = pk2(sp[14], sp[15]);
        *(v4u*)pp = o0; *(v4u*)(pp + 8) = o1;
    }
    LDS_BARRIER();
}
__device__ __forceinline__ void lru_out_item(ArgsP a, LAS unsigned char* lds, int item, const int tid) {
    const int c = item & 31, n = (item >> 5) & 7, b = item >> 8;
    unsigned char* ws = a->ws;
    LAS float* carry = (LAS float*)lds;
    if (tid < 128) { float cr = 0.f; const float* e = (const float*)(ws + WS_LRU_END) + (size_t)(item - c) * 256;
        float pv[31], hv_[31];
#pragma unroll
        for (int k = 0; k < 31; ++k) { const bool on = k < c; pv[k] = on ? e[k * 256 + tid] : 1.f; hv_[k] = on ? e[k * 256 + 128 + tid] : 0.f; }
#pragma unroll
        for (int k = 0; k < 31; ++k) cr = hv_[k] + pv[k] * cr;
        carry[tid] = cr; }
    LDS_BARRIER();
    const int t = tid >> 3, sub = tid & 7, d0 = sub * 16, row = b * TP + 64 * c + t;
    const bf16* hl = (const bf16*)(ws + WS_LRU_HL) + ((size_t)item * 64 + t) * 128 + d0; const bf16* pp = (const bf16*)(ws + WS_LRU_P) + ((size_t)item * 64 + t) * 128 + d0;
    const bf16* gp = (const bf16*)(ws + WS_PROJ) + (size_t)row * NPROJ_PAD + 5120 + n * 128 + d0;
    const v4u h0 = *(const v4u*)hl, h1 = *(const v4u*)(hl + 8), p0 = *(const v4u*)pp, p1 = *(const v4u*)(pp + 8), g0 = *(const v4u*)gp, g1 = *(const v4u*)(gp + 8);
    const unsigned hu[8] = {h0.x, h0.y, h0.z, h0.w, h1.x, h1.y, h1.z, h1.w}, pu[8] = {p0.x, p0.y, p0.z, p0.w, p1.x, p1.y, p1.z, p1.w}, gu[8] = {g0.x, g0.y, g0.z, g0.w, g1.x, g1.y, g1.z, g1.w};
    float hv[16]; unsigned ou[8];
#pragma unroll
    for (int i = 0; i < 8; ++i) { hv[2 * i] = bflo(hu[i]) + bflo(pu[i]) * carry[d0 + 2 * i]; hv[2 * i + 1] = bfhi(hu[i]) + bfhi(pu[i]) * carry[d0 + 2 * i + 1];
        ou[i] = pk2(hv[2 * i] * gelu_tanh(bflo(gu[i])), hv[2 * i + 1] * gelu_tanh(bfhi(gu[i]))); }
    bf16* mp = (bf16*)(ws + WS_MIX) + (size_t)row * D + 1024 + n * 128 + d0;
    *(v4u*)mp = (v4u){ou[0], ou[1], ou[2], ou[3]}; *(v4u*)(mp + 8) = (v4u){ou[4], ou[5], ou[6], ou[7]};
    if (c == 31 && t == 63) { float* o = a->out + O_LRUP + (size_t)b * 1024 + n * 128 + d0;
#pragma unroll
        for (int i = 0; i < 4; ++i) *(f32x4*)(o + 4 * i) = (f32x4){hv[4 * i], hv[4 * i + 1], hv[4 * i + 2], hv[4 * i + 3]}; }
    LDS_BARRIER();
}


__device__ __forceinline__ void conv16_load(const bf16* proj, int b, int tseq, int ch0, v4u (&u)[8]) {
#pragma unroll
    for (int j = 0; j < 4; ++j) { const int tt = tseq - 3 + j;
        if (tt >= 0) { const bf16* pr = proj + (size_t)(b * TP + tt) * NPROJ_PAD + ch0; u[2 * j] = *(const v4u*)pr; u[2 * j + 1] = *(const v4u*)(pr + 8); }
        else { u[2 * j] = (v4u){0u, 0u, 0u, 0u}; u[2 * j + 1] = (v4u){0u, 0u, 0u, 0u}; } }
}
__device__ __forceinline__ void conv16_compute(const v4u (&u)[8], const float* wconv, const float* bconv, int ch0, float (&x)[16]) {
#pragma unroll
    for (int i = 0; i < 4; ++i) { const f32x4 bb = *(const f32x4*)(bconv + ch0 + 4 * i); x[4 * i] = bb.x; x[4 * i + 1] = bb.y; x[4 * i + 2] = bb.z; x[4 * i + 3] = bb.w; }
#pragma unroll
    for (int j = 0; j < 4; ++j) { const unsigned uu[8] = {u[2 * j].x, u[2 * j].y, u[2 * j].z, u[2 * j].w, u[2 * j + 1].x, u[2 * j + 1].y, u[2 * j + 1].z, u[2 * j + 1].w};
#pragma unroll
        for (int i = 0; i < 4; ++i) { const f32x4 ww = *(const f32x4*)(wconv + j * 4096 + ch0 + 4 * i);
            x[4 * i] += ww.x * bflo(uu[2 * i]); x[4 * i + 1] += ww.y * bfhi(uu[2 * i]); x[4 * i + 2] += ww.z * bflo(uu[2 * i + 1]); x[4 * i + 3] += ww.w * bfhi(uu[2 * i + 1]); } }
}
__device__ __forceinline__ void conv16_prompt(const bf16* proj, const float* wconv, const float* bconv, int b, int tseq, int ch0, float (&x)[16]) {
    v4u u[8]; conv16_load(proj, b, tseq, ch0, u); conv16_compute(u, wconv, bconv, ch0, x);
}
__device__ __forceinline__ void st16_bf16(LAS bf16* p, const float (&x)[16]) {
    v4u o0, o1; o0.x = pk2(x[0], x[1]); o0.y = pk2(x[2], x[3]); o0.z = pk2(x[4], x[5]); o0.w = pk2(x[6], x[7]); o1.x = pk2(x[8], x[9]); o1.y = pk2(x[10], x[11]); o1.z = pk2(x[12], x[13]); o1.w = pk2(x[14], x[15]);
    *(LAS v4u*)p = o0; *(LAS v4u*)(p + 8) = o1;
}
__device__ __forceinline__ v2u pack4(const f32x4 v) { v2u o; o.x = pk2(v.x, v.y); o.y = pk2(v.z, v.w); return o; }
__device__ __forceinline__ bf16x8 zero8() { return (bf16x8){0, 0, 0, 0, 0, 0, 0, 0}; }

__device__ __forceinline__ void delta_prep_item(ArgsP a, LAS unsigned char* lds, int item, const int tid) {
    const int c = item & 31, h = (item >> 5) & 7, b = item >> 8;
    const int lane = tid & 63, w = __builtin_amdgcn_readfirstlane(tid >> 6), fr = lane & 15, fq = lane >> 4;
    unsigned char* ws = a->ws;
    const bf16* proj = (const bf16*)(ws + WS_PROJ);
    LAS bf16* Kn = (LAS bf16*)lds;
    LAS bf16* Qn = (LAS bf16*)(lds + 17408);
    LAS bf16* KdT = (LAS bf16*)(lds + 34816);
    LAS bf16* RX = (LAS bf16*)(lds + 53248);
    LAS bf16* Mm = (LAS bf16*)(lds + 90112);
    LAS bf16* QKd = (LAS bf16*)(lds + 99328);
    LAS bf16* Td = (LAS bf16*)(lds + 108544);
    LAS bf16* RT = (LAS bf16*)(lds + 111616) + w * 768;
    LAS float* gl = (LAS float*)(lds + 123904);
    LAS float* gcs = gl + 64;
    LAS float* bet = gcs + 64;
    const int t = tid >> 3, sub = tid & 7;
    float gc_t, glast_t, beta_t;
    {
        const float* gt = (const float*)(ws + WS_GATES) + (size_t)(b * TP + 64 * c + lane) * 16;
        const float gv = -fexp(a->in[I_ALOG][h]) * softplusf(gt[h] + a->in[I_DTB][h]), bv = sigm(gt[8 + h]);
        const float gcv = wave_incl_sum(gv, lane);
        if (w == 0) { gl[lane] = gv; gcs[lane] = gcv; bet[lane] = bv; }
        gc_t = __shfl(gcv, t); glast_t = __shfl(gcv, 63); beta_t = __shfl(bv, t);
    }
    {
        const float* wconv = a->in[I_WCONV]; const float* bconv = a->in[I_BCONV];
        const float gc = gc_t, glast = glast_t, beta = beta_t;
        const float ec = fexp(gc), ed = fexp(glast - gc);
        float x[16], y[16];
        conv16_prompt(proj, wconv, bconv, b, 64 * c + t, 1024 + h * 128 + sub * 16, x);
        float ss = 0.f;
#pragma unroll
        for (int i = 0; i < 16; ++i) { x[i] = siluf(x[i]); ss += x[i] * x[i]; }
        ss += __shfl_xor(ss, 1); ss += __shfl_xor(ss, 2); ss += __shfl_xor(ss, 4);
        const float rk = rsqrtf(ss + 1e-6f);
#pragma unroll
        for (int i = 0; i < 16; ++i) x[i] *= rk;
        st16_bf16(Kn + t * 136 + sub * 16, x);
#pragma unroll
        for (int i = 0; i < 16; ++i) KdT[(sub * 16 + i) * 72 + t] = (bf16)f2bf(x[i] * ed);
#pragma unroll
        for (int i = 0; i < 16; ++i) y[i] = x[i] * (beta * ec);
        st16_bf16(RX + t * 264 + 128 + sub * 16, y);
        conv16_prompt(proj, wconv, bconv, b, 64 * c + t, h * 128 + sub * 16, x);
        ss = 0.f;
#pragma unroll
        for (int i = 0; i < 16; ++i) { x[i] = siluf(x[i]); ss += x[i] * x[i]; }
        ss += __shfl_xor(ss, 1); ss += __shfl_xor(ss, 2); ss += __shfl_xor(ss, 4);
        const float rq = rsqrtf(ss + 1e-6f) * 0.08838834764831845f;
#pragma unroll
        for (int i = 0; i < 16; ++i) x[i] *= rq;
        st16_bf16(Qn + t * 136 + sub * 16, x);
        conv16_prompt(proj, wconv, bconv, b, 64 * c + t, 2048 + h * 128 + sub * 16, x);
#pragma unroll
        for (int i = 0; i < 16; ++i) x[i] = siluf(x[i]) * beta;
        st16_bf16(RX + t * 264 + sub * 16, x);
    }
    LDS_BARRIER();
    {
        const int ib = w >> 1;
#pragma unroll
        for (int jj = 0; jj < 2; ++jj) { const int jb = 2 * (w & 1) + jj;
            f32x4 ak = (f32x4){0.f, 0.f, 0.f, 0.f}, aq = (f32x4){0.f, 0.f, 0.f, 0.f};
            if (jb <= ib) {
#pragma unroll
                for (int ks = 0; ks < 4; ++ks) { const bf16x8 bfr = *(const LAS bf16x8*)(Kn + (16 * jb + fr) * 136 + 32 * ks + 8 * fq);
                    const bf16x8 afk = *(const LAS bf16x8*)(Kn + (16 * ib + fr) * 136 + 32 * ks + 8 * fq), afq = *(const LAS bf16x8*)(Qn + (16 * ib + fr) * 136 + 32 * ks + 8 * fq);
                    ak = MFMA32(afk, bfr, ak); aq = MFMA32(afq, bfr, aq); } }
            const int col = 16 * jb + fr; const float gcc = gcs[col];
#pragma unroll
            for (int j = 0; j < 4; ++j) { const int row = 16 * ib + 4 * fq + j; const float dec = (row >= col) ? fexp(gcs[row] - gcc) : 0.f;
                Mm[row * 72 + col] = (bf16)f2bf(row > col ? -bet[row] * ak[j] * dec : 0.f);
                QKd[row * 72 + col] = (bf16)f2bf(aq[j] * dec); }
        }
    }
    LDS_BARRIER();
    if (w == 0) { const int blk = lane >> 4, col = lane & 15; float xi[16];
#pragma unroll
        for (int i = 0; i < 16; ++i) { float acc = (i == col) ? 1.f : 0.f; const LAS bf16* mr = Mm + (16 * blk + i) * 72 + 16 * blk;
#pragma unroll
            for (int j = 0; j < i; ++j) acc += bf2f(mr[j]) * xi[j];
            xi[i] = acc; }
#pragma unroll
        for (int i = 0; i < 16; ++i) Td[(blk * 16 + i) * 24 + col] = (bf16)f2bf(xi[i]); }
    f32x4 rhs[2][4];
#pragma unroll
    for (int cbl = 0; cbl < 2; ++cbl)
#pragma unroll
        for (int bb = 0; bb < 4; ++bb)
#pragma unroll
            for (int j = 0; j < 4; ++j) rhs[cbl][bb][j] = bf2f(RX[(16 * bb + 4 * fq + j) * 264 + 32 * w + 16 * cbl + fr]);
    LDS_BARRIER();
#pragma unroll
    for (int cbl = 0; cbl < 2; ++cbl) { const int cb = 2 * w + cbl;
#pragma unroll
        for (int bb = 0; bb < 4; ++bb) {
            f32x4 acc = rhs[cbl][bb];
#pragma unroll
            for (int ks = 0; ks < 2; ++ks) { if (32 * ks < 16 * bb) { const bool ok = (32 * ks + 8 * fq) < 16 * bb;
                const bf16x8 af = ok ? *(const LAS bf16x8*)(Mm + (16 * bb + fr) * 72 + 32 * ks + 8 * fq) : zero8();
                const bf16x8 bf_ = ok ? *(const LAS bf16x8*)(RX + (16 * cb + fr) * 72 + 32 * ks + 8 * fq) : zero8();
                acc = MFMA32(af, bf_, acc); } }
            *(LAS v2u*)(RT + (16 * cbl + fr) * 24 + 4 * fq) = pack4(acc);
            asm volatile("s_waitcnt lgkmcnt(0)" ::: "memory");
            const bool ok2 = fq < 2;
            const bf16x8 af2 = ok2 ? *(const LAS bf16x8*)(Td + (bb * 16 + fr) * 24 + 8 * fq) : zero8();
            const bf16x8 bf2 = ok2 ? *(const LAS bf16x8*)(RT + (16 * cbl + fr) * 24 + 8 * fq) : zero8();
            const f32x4 xb4 = MFMA32(af2, bf2, ((f32x4){0.f, 0.f, 0.f, 0.f}));
            *(LAS v2u*)(RX + (16 * cb + fr) * 72 + 16 * bb + 4 * fq) = pack4(xb4);
            asm volatile("s_waitcnt lgkmcnt(0)" ::: "memory");
        }
    }
    LDS_BARRIER();
    {
        v4u* gout = (v4u*)(ws + WS_DG) + ((size_t)item * 8 + w) * 4 * 64 + lane;
        bf16x8 kb[2];
#pragma unroll
        for (int kt = 0; kt < 2; ++kt) kb[kt] = *(const LAS bf16x8*)(KdT + (16 * w + fr) * 72 + 32 * kt + 8 * fq);
#pragma unroll
        for (int ks = 0; ks < 4; ++ks) { f32x4 g0 = (f32x4){0.f, 0.f, 0.f, 0.f}, g1 = (f32x4){0.f, 0.f, 0.f, 0.f};
#pragma unroll
            for (int kt = 0; kt < 2; ++kt) { const bf16x8 a0 = *(const LAS bf16x8*)(RX + (128 + 32 * ks + fr) * 72 + 32 * kt + 8 * fq), a1 = *(const LAS bf16x8*)(RX + (128 + 32 * ks + 16 + fr) * 72 + 32 * kt + 8 * fq);
                g0 = MFMA32(a0, kb[kt], g0); g1 = MFMA32(a1, kb[kt], g1); }
            const v2u p0 = pack4(-g0), p1 = pack4(-g1); gout[ks * 64] = (v4u){p0.x, p0.y, p1.x, p1.y}; }
        v2u* bout = (v2u*)(ws + WS_DB) + ((size_t)item * 64 + w) * 64 + lane;
#pragma unroll
        for (int s2 = 0; s2 < 8; ++s2) { f32x4 bc = (f32x4){0.f, 0.f, 0.f, 0.f};
#pragma unroll
            for (int kt = 0; kt < 2; ++kt) { const bf16x8 ub = *(const LAS bf16x8*)(RX + (16 * s2 + fr) * 72 + 32 * kt + 8 * fq); bc = MFMA32(kb[kt], ub, bc); }
            bout[(size_t)s2 * 8 * 64] = pack4(bc); }
    }
    {
        const int tb = w >> 1, half = w & 1; const float ect = fexp(gcs[16 * tb + fr]);
        bf16x8 qk[2];
#pragma unroll
        for (int kt = 0; kt < 2; ++kt) qk[kt] = *(const LAS bf16x8*)(QKd + (16 * tb + fr) * 72 + 32 * kt + 8 * fq);
        v4u* qout = (v4u*)(ws + WS_DQ) + ((size_t)item * 4 + tb) * 4 * 64 + lane;
#pragma unroll
        for (int kk = 0; kk < 2; ++kk) { const int ks = 2 * half + kk; v2u pk[2];
#pragma unroll
            for (int hf = 0; hf < 2; ++hf) { const int db = 2 * ks + hf; f32x4 acc = (f32x4){0.f, 0.f, 0.f, 0.f};
#pragma unroll
                for (int kt = 0; kt < 2; ++kt) { const bf16x8 wa = *(const LAS bf16x8*)(RX + (128 + 16 * db + fr) * 72 + 32 * kt + 8 * fq); acc = MFMA32(wa, qk[kt], acc); }
                const v2u qn4 = *(const LAS v2u*)(Qn + (16 * tb + fr) * 136 + 16 * db + 4 * fq);
                f32x4 qp; qp.x = bflo(qn4.x) * ect - acc.x; qp.y = bfhi(qn4.x) * ect - acc.y; qp.z = bflo(qn4.y) * ect - acc.z; qp.w = bfhi(qn4.y) * ect - acc.w;
                pk[hf] = pack4(qp); }
            qout[ks * 64] = (v4u){pk[0].x, pk[0].y, pk[1].x, pk[1].y}; }
        v2u* oout = (v2u*)(ws + WS_DO) + ((size_t)item * 4 + tb) * 8 * 64 + lane;
#pragma unroll
        for (int ss = 0; ss < 4; ++ss) { const int s2 = 4 * half + ss; f32x4 acc = (f32x4){0.f, 0.f, 0.f, 0.f};
#pragma unroll
            for (int kt = 0; kt < 2; ++kt) { const bf16x8 ua = *(const LAS bf16x8*)(RX + (16 * s2 + fr) * 72 + 32 * kt + 8 * fq); acc = MFMA32(ua, qk[kt], acc); }
            oout[s2 * 64] = pack4(acc); }
    }
    if (tid == 0) ((float*)(ws + WS_DD))[item] = fexp(gcs[63]);
    LDS_BARRIER();
}

__device__ __forceinline__ void delta_scan_wave(ArgsP a, int chain, int s, const int lane) {
    unsigned char* ws = a->ws;
    const int fr = lane & 15, fq = lane >> 4;
    f32x4 S[8]; bf16x8 Sb[4];
#pragma unroll
    for (int i = 0; i < 8; ++i) S[i] = (f32x4){0.f, 0.f, 0.f, 0.f};
#pragma unroll
    for (int i = 0; i < 4; ++i) Sb[i] = zero8();
    const bf16x8* gbase = (const bf16x8*)(ws + WS_DG) + (size_t)chain * 32 * 2048 + lane;
    bf16x8 G[8][4];
#pragma unroll
    for (int rb = 0; rb < 8; ++rb)
#pragma unroll
        for (int ks = 0; ks < 4; ++ks) G[rb][ks] = gbase[(rb * 4 + ks) * 64];
#pragma unroll 1
    for (int c = 0; c < 32; ++c) {
        const int item = chain * 32 + c;
        const float d = ((const float*)(ws + WS_DD))[item];
        bf16x8* sout = (bf16x8*)(ws + WS_DS) + ((size_t)item * 8 + s) * 4 * 64 + lane;
#pragma unroll
        for (int ks = 0; ks < 4; ++ks) sout[ks * 64] = Sb[ks];
        const v2u* bin = (const v2u*)(ws + WS_DB) + ((size_t)item * 8 + s) * 8 * 64 + lane;
#pragma unroll
        for (int rb = 0; rb < 8; ++rb) { const v2u bc = bin[rb * 64]; S[rb].x = d * S[rb].x + bflo(bc.x); S[rb].y = d * S[rb].y + bfhi(bc.x); S[rb].z = d * S[rb].z + bflo(bc.y); S[rb].w = d * S[rb].w + bfhi(bc.y); }
        const bf16x8* gnext = gbase + (size_t)(c + 1 < 32 ? c + 1 : c) * 2048;
#pragma unroll
        for (int rb = 0; rb < 8; ++rb) {
#pragma unroll
            for (int ks = 0; ks < 4; ++ks) S[rb] = MFMA32(G[rb][ks], Sb[ks], S[rb]);
#pragma unroll
            for (int ks = 0; ks < 4; ++ks) G[rb][ks] = gnext[(rb * 4 + ks) * 64];
        }
#pragma unroll
        for (int ks = 0; ks < 4; ++ks) { const v2u lo = pack4(S[2 * ks]), hi = pack4(S[2 * ks + 1]); const v4u u = (v4u){lo.x, lo.y, hi.x, hi.y}; Sb[ks] = __builtin_bit_cast(bf16x8, u); }
    }
    f32x4* so = (f32x4*)(ws + WS_DF) + ((size_t)(chain * 8 + s) * 8) * 64 + lane;
#pragma unroll
    for (int rb = 0; rb < 8; ++rb) so[rb * 64] = S[rb];
}

__device__ __forceinline__ void delta_out_wave(ArgsP a, int item, int tb, const int lane) {
    unsigned char* ws = a->ws;
    const int c = item & 31, h = (item >> 5) & 7, b = item >> 8, fr = lane & 15, fq = lane >> 4;
    bf16x8 qf[4];
    const bf16x8* qin = (const bf16x8*)(ws + WS_DQ) + ((size_t)item * 4 + tb) * 4 * 64 + lane;
#pragma unroll
    for (int ks = 0; ks < 4; ++ks) qf[ks] = qin[ks * 64];
    const v2u* oin = (const v2u*)(ws + WS_DO) + ((size_t)item * 4 + tb) * 8 * 64 + lane;
    const bf16x8* sin = (const bf16x8*)(ws + WS_DS) + (size_t)item * 8 * 4 * 64 + lane;
    f32x4 o[8]; float ss = 0.f;
    v2u olv[8]; bf16x8 sfr[4][4];
#pragma unroll
    for (int s = 0; s < 8; ++s) olv[s] = oin[s * 64];
#pragma unroll
    for (int s = 0; s < 4; ++s)
#pragma unroll
        for (int ks = 0; ks < 4; ++ks) sfr[s][ks] = sin[(s * 4 + ks) * 64];
    const int row_ = b * TP + 64 * c + 16 * tb + fr;
    v2u zv[8];
#pragma unroll
    for (int s = 0; s < 8; ++s) zv[s] = *(const v2u*)((const bf16*)(ws + WS_PROJ) + (size_t)row_ * NPROJ_PAD + 4096 + h * 128 + 4 * fq + 16 * s);
#pragma unroll
    for (int grp = 0; grp < 2; ++grp) {
#pragma unroll
        for (int s4 = 0; s4 < 4; ++s4) { const int s = 4 * grp + s4; const v2u ol = olv[s]; o[s] = (f32x4){bflo(ol.x), bfhi(ol.x), bflo(ol.y), bfhi(ol.y)};
#pragma unroll
            for (int ks = 0; ks < 4; ++ks) o[s] = MFMA32(sfr[s4][ks], qf[ks], o[s]);
            ss += (o[s].x * o[s].x + o[s].y * o[s].y) + (o[s].z * o[s].z + o[s].w * o[s].w); }
        if (grp == 0) {
#pragma unroll
            for (int s4 = 0; s4 < 4; ++s4)
#pragma unroll
                for (int ks = 0; ks < 4; ++ks) sfr[s4][ks] = sin[((4 + s4) * 4 + ks) * 64]; }
    }
    ss += __shfl_xor(ss, 16); ss += __shfl_xor(ss, 32);
    const float rstd = rsqrtf(ss * (1.f / 128.f) + RMS_EPS);
    const int row = b * TP + 64 * c + 16 * tb + fr;
    const bf16* zp = (const bf16*)(ws + WS_PROJ) + (size_t)row * NPROJ_PAD + 4096 + h * 128 + 4 * fq;
    bf16* mp = (bf16*)(ws + WS_MIX) + (size_t)row * D + h * 128 + 4 * fq;
    const float* nw = a->in[I_DNORM] + 4 * fq;
#pragma unroll
    for (int s = 0; s < 8; ++s) { const v2u z = zv[s]; const f32x4 n4 = *(const f32x4*)(nw + 16 * s);
        f32x4 y; y.x = o[s].x * rstd * n4.x * siluf(bflo(z.x)); y.y = o[s].y * rstd * n4.y * siluf(bfhi(z.x)); y.z = o[s].z * rstd * n4.z * siluf(bflo(z.y)); y.w = o[s].w * rstd * n4.w * siluf(bfhi(z.y));
        *(v2u*)(mp + 16 * s) = pack4(y); }
}


__device__ __forceinline__ void mlstm_scan_item(ArgsP a, LAS unsigned char* lds, int chain, int vs, const int tid) {
    const int lane = tid & 63, w = __builtin_amdgcn_readfirstlane(tid >> 6), fr = lane & 15, fq = lane >> 4;
    const int b = chain >> 3, h = chain & 7, row0 = b * TP;
    unsigned char* ws = a->ws;
    const bf16* proj = (const bf16*)(ws + WS_PROJ); const float* gates = (const float*)(ws + WS_GATES);
    LAS bf16* KT = (LAS bf16*)lds;
    LAS bf16* VT = (LAS bf16*)(lds + 36864);
    LAS float* wls = (LAS float*)(lds + 46080);
    LAS float* gendA = (LAS float*)(lds + 46592);
    LAS float* blastA = gendA + 2048;
    LAS float* mxA = blastA + 32;
    const float big = a->in[I_BIG][h], bfg = a->in[I_BFG][h];
    {
        float lf4[4], ig4[4];
#pragma unroll
        for (int i = 0; i < 4; ++i) { const float* gp = gates + (size_t)(row0 + 64 * (w + 8 * i) + lane) * 16 + h; ig4[i] = gp[0] + big; lf4[i] = logsigf(gp[8] + bfg); }
#pragma unroll
        for (int i = 0; i < 4; ++i) { const float bcum = wave_incl_sum(lf4[i], lane), blast = __shfl(bcum, 63), gend = blast - bcum + ig4[i]; const float mx = wave_max(gend);
            gendA[(w + 8 * i) * 64 + lane] = gend; if (lane == 0) { blastA[w + 8 * i] = blast; mxA[w + 8 * i] = mx; } }
    }
    LDS_BARRIER();
    const bf16* kptr = proj + (size_t)(row0 + lane) * NPROJ_PAD + 1024 + h * 128 + 16 * w;
    const bf16* vptr = proj + (size_t)(row0 + lane) * NPROJ_PAD + 2048 + h * 256 + 32 * vs + 8 * (w & 3);
    f32x4 acc[2]; acc[0] = (f32x4){0.f, 0.f, 0.f, 0.f}; acc[1] = acc[0];
    float nst = 0.f, m = 0.f;
    v4u kq[2][2], vq[2];
#define ML_LOAD(set, c_) do { const size_t ro = (size_t)(c_) * 64 * NPROJ_PAD; kq[set][0] = *(const v4u*)(kptr + ro); kq[set][1] = *(const v4u*)(kptr + ro + 8); \
        if (w < 4) vq[set] = *(const v4u*)(vptr + ro); } while (0)
#define ML_STEP(set, c_) do { const int item = chain * 32 + (c_); \
        const float blast = blastA[(c_)], gend = gendA[(c_) * 64 + lane]; \
        const float mnew = fmaxf(blast + m, mxA[(c_)]), sc = fexp(blast + m - mnew), wv = fexp(gend - mnew) * 0.08838834764831845f; \
        LAS bf16* kt = KT + (set) * 9216; LAS bf16* vt = VT + (set) * 2304; \
        _Pragma("unroll") for (int i = 0; i < 2; ++i) { const unsigned uu[4] = {kq[set][i].x, kq[set][i].y, kq[set][i].z, kq[set][i].w}; const int kr = 8 * (2 * w + i); \
            _Pragma("unroll") for (int e = 0; e < 4; ++e) { kt[(kr + 2 * e) * 72 + lane] = (bf16)(uu[e] & 0xffffu); kt[(kr + 2 * e + 1) * 72 + lane] = (bf16)(uu[e] >> 16); } } \
        if (w < 4) { const unsigned uu[4] = {vq[set].x, vq[set].y, vq[set].z, vq[set].w}; \
            _Pragma("unroll") for (int e = 0; e < 4; ++e) { vt[(8 * w + 2 * e) * 72 + lane] = (bf16)f2bf(bflo(uu[e]) * wv); vt[(8 * w + 2 * e + 1) * 72 + lane] = (bf16)f2bf(bfhi(uu[e]) * wv); } } \
        if (w == 0) wls[(set) * 64 + lane] = wv; \
        if ((c_) + 2 < 32) ML_LOAD(set, (c_) + 2); \
        if (vs == 0 && tid == 0) ((float*)(ws + WS_MM))[item] = m; \
        LDS_BARRIER(); \
        _Pragma("unroll") for (int vb = 0; vb < 2; ++vb) { *(v2u*)((bf16*)(ws + WS_MC) + ((size_t)item * 256 + 32 * vs + 16 * vb + fr) * 128 + 16 * w + 4 * fq) = pack4(acc[vb]); } \
        if (vs == 0 && tid < 128) { ((float*)(ws + WS_MN))[(size_t)item * 128 + tid] = nst; float sn = 0.f; \
            _Pragma("unroll") for (int s8 = 0; s8 < 8; ++s8) { const v4u kk = *(const LAS v4u*)(kt + tid * 72 + 8 * s8); const LAS float* wl = wls + (set) * 64 + 8 * s8; \
                sn += bflo(kk.x) * wl[0] + bfhi(kk.x) * wl[1] + bflo(kk.y) * wl[2] + bfhi(kk.y) * wl[3] + bflo(kk.z) * wl[4] + bfhi(kk.z) * wl[5] + bflo(kk.w) * wl[6] + bfhi(kk.w) * wl[7]; } \
            nst = sc * nst + sn; } \
        _Pragma("unroll") for (int vb = 0; vb < 2; ++vb) { acc[vb] = acc[vb] * sc; \
            _Pragma("unroll") for (int kt2 = 0; kt2 < 2; ++kt2) { const bf16x8 af = *(const LAS bf16x8*)(kt + (16 * w + fr) * 72 + 32 * kt2 + 8 * fq), bfv = *(const LAS bf16x8*)(vt + (16 * vb + fr) * 72 + 32 * kt2 + 8 * fq); \
                acc[vb] = MFMA32(af, bfv, acc[vb]); } } \
        m = mnew; } while (0)
    ML_LOAD(0, 0); ML_LOAD(1, 1);
#pragma unroll 1
    for (int c2 = 0; c2 < 32; c2 += 2) { ML_STEP(0, c2); ML_STEP(1, c2 + 1); }
#undef ML_LOAD
#undef ML_STEP
#pragma unroll
    for (int vb = 0; vb < 2; ++vb) *(f32x4*)(a->out + O_MCP + ((size_t)chain * 256 + 32 * vs + 16 * vb + fr) * 128 + 16 * w + 4 * fq) = acc[vb];
    if (vs == 0) { if (tid < 128) a->out[O_MNP + (size_t)chain * 128 + tid] = nst; if (tid == 0) a->out[O_MMP + chain] = m; }
    LDS_BARRIER();
}

__device__ __forceinline__ void mlstm_out_item(ArgsP a, LAS unsigned char* lds, int item, const int tid) {
    const int c = item & 31, h = (item >> 5) & 7, b = item >> 8, row0 = b * TP + 64 * c;
    const int lane = tid & 63, w = __builtin_amdgcn_readfirstlane(tid >> 6), fr = lane & 15, fq = lane >> 4;
    unsigned char* ws = a->ws;
    const bf16* proj = (const bf16*)(ws + WS_PROJ); const float* gates = (const float*)(ws + WS_GATES);
    LAS bf16* VT = (LAS bf16*)lds;
    LAS float* ssq = (LAS float*)(lds + 36864);
    const int tb = w & 3, half = w >> 2, t = 16 * tb + fr;
    v4u vu[4];
#pragma unroll
    for (int i = 0; i < 4; ++i) vu[i] = *(const v4u*)(proj + (size_t)(row0 + lane) * NPROJ_PAD + 2048 + h * 256 + 8 * (w + 8 * i));
    v4u qu[4]; f32x4 nv[4][2];
#pragma unroll
    for (int ks = 0; ks < 4; ++ks) { qu[ks] = *(const v4u*)(proj + (size_t)(row0 + t) * NPROJ_PAD + h * 128 + 32 * ks + 8 * fq);
        const float* np = (const float*)(ws + WS_MN) + (size_t)item * 128 + 32 * ks + 8 * fq; nv[ks][0] = *(const f32x4*)np; nv[ks][1] = *(const f32x4*)(np + 4); }
    v4u kfr[4][4];
#pragma unroll
    for (int sb = 0; sb < 4; ++sb) if (sb <= tb) {
#pragma unroll
        for (int ks = 0; ks < 4; ++ks) kfr[sb][ks] = *(const v4u*)(proj + (size_t)(row0 + 16 * sb + fr) * NPROJ_PAD + 1024 + h * 128 + 32 * ks + 8 * fq); }
    const float mc = ((const float*)(ws + WS_MM))[item];
    float av, Mt, et, em;
    { const float ig = gates[(size_t)(row0 + lane) * 16 + h] + a->in[I_BIG][h], lf = logsigf(gates[(size_t)(row0 + lane) * 16 + 8 + h] + a->in[I_BFG][h]);
      const float bcum = wave_incl_sum(lf, lane); av = ig - bcum; Mt = fmaxf(mc, wave_incl_max(av, lane)); et = fexp(mc - Mt); em = fexp(-(bcum + Mt)); }
#pragma unroll
    for (int i = 0; i < 4; ++i) { const unsigned uu[4] = {vu[i].x, vu[i].y, vu[i].z, vu[i].w}; const int vr = 8 * (w + 8 * i);
#pragma unroll
        for (int e = 0; e < 4; ++e) { VT[(vr + 2 * e) * 72 + lane] = (bf16)(uu[e] & 0xffffu); VT[(vr + 2 * e + 1) * 72 + lane] = (bf16)(uu[e] >> 16); } }
    bf16x8 qf[4]; float qn = 0.f;
#pragma unroll
    for (int ks = 0; ks < 4; ++ks) { const v4u u = qu[ks]; qf[ks] = __builtin_bit_cast(bf16x8, u); const f32x4 n0 = nv[ks][0], n1 = nv[ks][1];
        qn += bflo(u.x) * n0.x + bfhi(u.x) * n0.y + bflo(u.y) * n0.z + bfhi(u.y) * n0.w + bflo(u.z) * n1.x + bfhi(u.z) * n1.y + bflo(u.w) * n1.z + bfhi(u.w) * n1.w; }
    qn += __shfl_xor(qn, 16); qn += __shfl_xor(qn, 32);
    const float Mtt = __shfl(Mt, t), ett = __shfl(et, t), emt = __shfl(em, t);
    const bf16* cs = (const bf16*)(ws + WS_MC) + (size_t)item * 256 * 128;
    v2u smp[4]; float rowsum = 0.f;
#pragma unroll
    for (int sb = 0; sb < 4; ++sb) { smp[sb] = (v2u){0u, 0u};
        if (sb <= tb) { f32x4 qk = (f32x4){0.f, 0.f, 0.f, 0.f};
#pragma unroll
            for (int ks = 0; ks < 4; ++ks) qk = MFMA32(__builtin_bit_cast(bf16x8, kfr[sb][ks]), qf[ks], qk);
            f32x4 sm;
#pragma unroll
            for (int j = 0; j < 4; ++j) { const int s = 16 * sb + 4 * fq + j; const float as = __shfl(av, s); sm[j] = (s <= t) ? qk[j] * 0.08838834764831845f * fexp(as - Mtt) : 0.f; rowsum += sm[j]; }
            smp[sb] = pack4(sm); } }
    rowsum += __shfl_xor(rowsum, 16); rowsum += __shfl_xor(rowsum, 32);
    const float hden = 1.f / fmaxf(fabsf(ett * qn + rowsum), emt);
    const v4u s0u = (v4u){smp[0].x, smp[0].y, smp[1].x, smp[1].y}, s1u = (v4u){smp[2].x, smp[2].y, smp[3].x, smp[3].y};
    const bf16x8 sf0 = __builtin_bit_cast(bf16x8, s0u), sf1 = __builtin_bit_cast(bf16x8, s1u);
    v4u cfr[4][4];
#pragma unroll
    for (int g4 = 0; g4 < 4; ++g4)
#pragma unroll
        for (int ks = 0; ks < 4; ++ks) cfr[g4][ks] = *(const v4u*)(cs + (size_t)(128 * half + 16 * g4 + fr) * 128 + 32 * ks + 8 * fq);
    LDS_BARRIER();
    f32x4 hv[8]; float ss = 0.f;
#pragma unroll
    for (int grp = 0; grp < 2; ++grp) {
      f32x4 accs[4];
#pragma unroll
      for (int g4 = 0; g4 < 4; ++g4) { f32x4 acc = (f32x4){0.f, 0.f, 0.f, 0.f};
#pragma unroll
          for (int ks = 0; ks < 4; ++ks) acc = MFMA32(__builtin_bit_cast(bf16x8, cfr[g4][ks]), qf[ks], acc);
          accs[g4] = acc * ett; }
      if (grp == 0) {
#pragma unroll
          for (int g4 = 0; g4 < 4; ++g4)
#pragma unroll
              for (int ks = 0; ks < 4; ++ks) cfr[g4][ks] = *(const v4u*)(cs + (size_t)(128 * half + 64 + 16 * g4 + fr) * 128 + 32 * ks + 8 * fq); }
#pragma unroll
      for (int g4 = 0; g4 < 4; ++g4) { const int vb = 4 * grp + g4, vrow = 128 * half + 16 * vb + fr; f32x4 acc = accs[g4];
        { const v2u a0 = *(const LAS v2u*)(VT + vrow * 72 + 4 * fq), a1 = *(const LAS v2u*)(VT + vrow * 72 + 16 + 4 * fq); const v4u au = (v4u){a0.x, a0.y, a1.x, a1.y}; acc = MFMA32(__builtin_bit_cast(bf16x8, au), sf0, acc); }
        { const v2u a0 = *(const LAS v2u*)(VT + vrow * 72 + 32 + 4 * fq), a1 = *(const LAS v2u*)(VT + vrow * 72 + 48 + 4 * fq); const v4u au = (v4u){a0.x, a0.y, a1.x, a1.y}; acc = MFMA32(__builtin_bit_cast(bf16x8, au), sf1, acc); }
        hv[vb] = acc * hden; ss += (hv[vb].x * hv[vb].x + hv[vb].y * hv[vb].y) + (hv[vb].z * hv[vb].z + hv[vb].w * hv[vb].w); }
    }
    ss += __shfl_xor(ss, 16); ss += __shfl_xor(ss, 32);
    if (fq == 0) ssq[half * 64 + t] = ss;
    LDS_BARRIER();
    const float rstd = rsqrtf((ssq[t] + ssq[64 + t]) * (1.f / 256.f) + RMS_EPS);
    const bf16* op = proj + (size_t)(row0 + t) * NPROJ_PAD + 4096 + h * 256 + 128 * half + 4 * fq;
    bf16* mp = (bf16*)(ws + WS_MIX) + (size_t)(row0 + t) * D + h * 256 + 128 * half + 4 * fq;
    const float* nw = a->in[I_MNORM] + h * 256 + 128 * half + 4 * fq;
    v2u opr[8];
#pragma unroll
    for (int vb = 0; vb < 8; ++vb) opr[vb] = *(const v2u*)(op + 16 * vb);
#pragma unroll
    for (int vb = 0; vb < 8; ++vb) { const v2u o = opr[vb]; const f32x4 n4 = *(const f32x4*)(nw + 16 * vb);
        f32x4 y; y.x = hv[vb].x * rstd * n4.x * sigm(bflo(o.x)); y.y = hv[vb].y * rstd * n4.y * sigm(bfhi(o.x)); y.z = hv[vb].z * rstd * n4.z * sigm(bflo(o.y)); y.w = hv[vb].w * rstd * n4.w * sigm(bfhi(o.y));
        *(v2u*)(mp + 16 * vb) = pack4(y); }
    LDS_BARRIER();
}


__device__ __forceinline__ void mlstm_sample_load(ArgsP a, int j, const int tid, f32x4 (&cst)[2][4][2]) {
    const int lane = tid & 63, w = __builtin_amdgcn_readfirstlane(tid >> 6), fr = lane & 15, fq = lane >> 4;
    const float* C0 = a->in[I_SMC] + (size_t)j * 32768;
#pragma unroll
    for (int vb = 0; vb < 2; ++vb)
#pragma unroll
        for (int ksp = 0; ksp < 4; ++ksp) { const float* cp = C0 + (size_t)(32 * w + 16 * vb + fr) * 128 + 32 * ksp + 4 * fq; cst[vb][ksp][0] = __builtin_nontemporal_load((const f32x4*)cp); cst[vb][ksp][1] = __builtin_nontemporal_load((const f32x4*)(cp + 16)); }
}
__device__ __forceinline__ void mlstm_sample_item(ArgsP a, LAS unsigned char* lds, int j, const int tid, const f32x4 (&cst)[2][4][2]) {
    const int b = j >> 3, h = j & 7, row0 = MP + b * TS;
    const int lane = tid & 63, w = __builtin_amdgcn_readfirstlane(tid >> 6), fr = lane & 15, fq = lane >> 4;
    unsigned char* ws = a->ws;
    const bf16* proj = (const bf16*)(ws + WS_PROJ); const float* gates = (const float*)(ws + WS_GATES);
    float* Cout = a->out + O_MCS + (size_t)j * 32768;
    LAS float* qs = (LAS float*)lds;
    LAS float* ks = qs + 512;
    LAS float* vs = ks + 512;
    LAS float* gs = vs + 1024;
    LAS float* qkr = gs + 8;
    LAS float* qnl = qkr + 16;
    LAS float* hbuf = qnl + 8;
#pragma unroll
    for (int tok = 0; tok < 4; ++tok) { const bf16* pr = proj + (size_t)(row0 + tok) * NPROJ_PAD;
        if (tid < 128) qs[tok * 128 + tid] = bf2f(pr[h * 128 + tid]); else if (tid < 256) ks[tok * 128 + tid - 128] = bf2f(pr[1024 + h * 128 + (tid - 128)]) * 0.08838834764831845f; else vs[tok * 256 + tid - 256] = bf2f(pr[2048 + h * 256 + (tid - 256)]); }
    if (tid < 4) { gs[tid * 2] = gates[(size_t)(row0 + tid) * 16 + h] + a->in[I_BIG][h]; gs[tid * 2 + 1] = gates[(size_t)(row0 + tid) * 16 + 8 + h] + a->in[I_BFG][h]; }
    const float n0a = a->in[I_SMN][(size_t)j * 128 + lane], n0b = a->in[I_SMN][(size_t)j * 128 + 64 + lane];
    const float m0 = a->in[I_SMM][j];
    LDS_BARRIER();
#pragma unroll
    for (int i = 0; i < 2; ++i) { const int p = 2 * w + i, t = p >> 2, sx = p & 3; const float d = wave_sum(qs[t * 128 + lane] * ks[sx * 128 + lane] + qs[t * 128 + 64 + lane] * ks[sx * 128 + 64 + lane]); if (lane == 0) qkr[p] = d; }
    if (w < 4) { const float d = wave_sum(qs[w * 128 + lane] * n0a + qs[w * 128 + 64 + lane] * n0b); if (lane == 0) qnl[w] = d; }
    float bc[4], ig[4], mt[4], m = m0, bsum = 0.f;
#pragma unroll
    for (int t = 0; t < 4; ++t) { ig[t] = gs[t * 2]; const float lf = logsigf(gs[t * 2 + 1]); bsum += lf; bc[t] = bsum; m = fmaxf(lf + m, ig[t]); mt[t] = m; }
    const float scf = fexp(bc[3] + m0 - mt[3]);
    float wsf[4], et[4];
#pragma unroll
    for (int t = 0; t < 4; ++t) { wsf[t] = fexp(bc[3] - bc[t] + ig[t] - mt[3]); et[t] = fexp(bc[t] + m0 - mt[t]); }
    LDS_BARRIER();
    float S[4][4], hden[4];
#pragma unroll
    for (int t = 0; t < 4; ++t) { float den = et[t] * qnl[t];
#pragma unroll
        for (int sx = 0; sx < 4; ++sx) { S[t][sx] = (sx <= t) ? qkr[t * 4 + sx] * fexp(bc[t] - bc[sx] + ig[sx] - mt[t]) : 0.f; den += S[t][sx]; }
        hden[t] = 1.f / fmaxf(fabsf(den), fexp(-mt[t])); }
    bf16x8 qa[4];
#pragma unroll
    for (int ksp = 0; ksp < 4; ++ksp) { v4u u = (v4u){0u, 0u, 0u, 0u};
        if (fr < 4) { const f32x4 x0 = *(const LAS f32x4*)(qs + fr * 128 + 32 * ksp + 4 * fq), x1 = *(const LAS f32x4*)(qs + fr * 128 + 32 * ksp + 16 + 4 * fq); u.x = pk2(x0.x, x0.y); u.y = pk2(x0.z, x0.w); u.z = pk2(x1.x, x1.y); u.w = pk2(x1.z, x1.w); }
        qa[ksp] = __builtin_bit_cast(bf16x8, u); }
#pragma unroll
    for (int vb = 0; vb < 2; ++vb) { const int v = 32 * w + 16 * vb + fr;
        float vw[4];
#pragma unroll
        for (int sx = 0; sx < 4; ++sx) vw[sx] = vs[sx * 256 + v] * wsf[sx];
        f32x4 dacc = (f32x4){0.f, 0.f, 0.f, 0.f};
#pragma unroll
        for (int ksp = 0; ksp < 4; ++ksp) { const f32x4 c0 = cst[vb][ksp][0], c1 = cst[vb][ksp][1];
            v4u u; u.x = pk2(c0.x, c0.y); u.y = pk2(c0.z, c0.w); u.z = pk2(c1.x, c1.y); u.w = pk2(c1.z, c1.w);
            dacc = MFMA32(qa[ksp], __builtin_bit_cast(bf16x8, u), dacc);
            f32x4 n0v = c0 * scf, n1v = c1 * scf;
#pragma unroll
            for (int sx = 0; sx < 4; ++sx) { const f32x4 k0 = *(const LAS f32x4*)(ks + sx * 128 + 32 * ksp + 4 * fq), k1 = *(const LAS f32x4*)(ks + sx * 128 + 32 * ksp + 16 + 4 * fq); n0v = n0v + k0 * vw[sx]; n1v = n1v + k1 * vw[sx]; }
            float* op = Cout + (size_t)v * 128 + 32 * ksp + 4 * fq; __builtin_nontemporal_store(n0v, (f32x4*)op); __builtin_nontemporal_store(n1v, (f32x4*)(op + 16)); }
        if (fq == 0) {
#pragma unroll
            for (int t = 0; t < 4; ++t) { float num = et[t] * dacc[t];
#pragma unroll
                for (int sx = 0; sx < 4; ++sx) num += S[t][sx] * vs[sx * 256 + v];
                hbuf[t * 256 + v] = num * hden[t]; } }
    }
    if (tid < 128) { float nn = scf * a->in[I_SMN][(size_t)j * 128 + tid];
#pragma unroll
        for (int sx = 0; sx < 4; ++sx) nn += wsf[sx] * ks[sx * 128 + tid];
        a->out[O_MNS + (size_t)j * 128 + tid] = nn; }
    if (tid == 0) a->out[O_MMS + j] = mt[3];
    LDS_BARRIER();
    if (w < 4) { const int tok = w, row = row0 + tok; float hv[4]; float ss = 0.f;
#pragma unroll
        for (int i = 0; i < 4; ++i) { hv[i] = hbuf[tok * 256 + i * 64 + lane]; ss += hv[i] * hv[i]; }
        const float rstd = rsqrtf(wave_sum(ss) * (1.f / 256.f) + RMS_EPS);
        const float* nw = a->in[I_MNORM] + h * 256; bf16* mix = (bf16*)(ws + WS_MIX);
#pragma unroll
        for (int i = 0; i < 4; ++i) { const int vi = i * 64 + lane; const float op = bf2f(proj[(size_t)row * NPROJ_PAD + 4096 + h * 256 + vi]);
            mix[(size_t)row * D + h * 256 + vi] = (bf16)f2bf(hv[i] * rstd * nw[vi] * sigm(op)); } }
    LDS_BARRIER();
}


__device__ __forceinline__ void lru_sample_loop(ArgsP a, LAS unsigned char* lds, int vcu, int G, const int tid) {
    const int d = tid & 127, part = tid >> 7, n = vcu & 7, chn = n * 128 + d;
    const bf16* proj = (const bf16*)(a->ws + WS_PROJ); bf16* mix = (bf16*)(a->ws + WS_MIX);
    const float* wconv = a->in[I_WCONV]; const float* bconv = a->in[I_BCONV];
    const float* wr = a->in[I_LWR] + (size_t)n * 16384; const float* wi = a->in[I_LWI] + (size_t)n * 16384;
    LAS float* xr = (LAS float*)lds;
    LAS float* red = xr + 512;
    float w1[32], w2[32];
#pragma unroll
    for (int cc = 0; cc < 32; ++cc) { w1[cc] = wr[(part * 32 + cc) * 128 + d]; w2[cc] = wi[(part * 32 + cc) * 128 + d]; }
    const float br = a->in[I_LBR][chn], bi = a->in[I_LBI][chn], spl = softplusf(-a->in[I_LLAM][chn]);
#pragma unroll 1
    for (int j = vcu; j < 1024; j += G) {
        const int b = j >> 3, row0 = MP + b * TS; const float* cstate = a->in[I_SCONV] + (size_t)b * 3 * 4096;
        float hst = a->in[I_SLRU][(size_t)b * 1024 + chn];
        float gt[4];
        if (part == 0) {
#pragma unroll
            for (int tok = 0; tok < 4; ++tok) gt[tok] = bf2f(proj[(size_t)(row0 + tok) * NPROJ_PAD + 5120 + chn]); }
        { const int tok = tid >> 7; xr[tok * 128 + d] = conv4(proj, row0, tok, 3072 + chn, cstate, wconv, bconv); }
        LDS_BARRIER();
        float ar[4] = {0.f, 0.f, 0.f, 0.f}, ai[4] = {0.f, 0.f, 0.f, 0.f};
#pragma unroll
        for (int cc = 0; cc < 32; ++cc) { const int c = part * 32 + cc;
#pragma unroll
            for (int tok = 0; tok < 4; ++tok) { const float x = xr[tok * 128 + c]; ar[tok] += x * w1[cc]; ai[tok] += x * w2[cc]; } }
#pragma unroll
        for (int tok = 0; tok < 4; ++tok) { red[((tok * 2 + 0) * 4 + part) * 128 + d] = ar[tok]; red[((tok * 2 + 1) * 4 + part) * 128 + d] = ai[tok]; }
        LDS_BARRIER();
        if (part == 0) {
#pragma unroll
            for (int tok = 0; tok < 4; ++tok) {
                float rp = br, ip = bi;
#pragma unroll
                for (int p = 0; p < 4; ++p) { rp += red[((tok * 2 + 0) * 4 + p) * 128 + d]; ip += red[((tok * 2 + 1) * 4 + p) * 128 + d]; }
                const float log_a = -8.f * sigm(rp) * spl;
                const float av = fexp(log_a);
                const float bx = sqrtf(neg_expm1(2.f * log_a)) * sigm(ip) * xr[tok * 128 + d];
                hst = av * hst + bx;
                mix[(size_t)(row0 + tok) * D + 1024 + chn] = (bf16)f2bf(hst * gelu_tanh(gt[tok]));
            }
            a->out[O_LRUS + (size_t)b * 1024 + chn] = hst;
        }
        LDS_BARRIER();
    }
}

__device__ __forceinline__ void phase_mixer_even(ArgsP a, LAS unsigned char* lds, int vcu, int G, const int tid) {
#pragma unroll 1
    for (int r = 0; r < 1 + (PROBE_SUB & 1); ++r)
#pragma unroll 1
    for (int it = vcu; it < 1024; it += G) delta_prep_item(a, lds, it, tid);
#pragma unroll 1
    for (int r = 0; r < 1 + ((PROBE_SUB >> 1) & 1); ++r)
#pragma unroll 1
    for (int it = vcu; it < 1024; it += G) lru_prep_item(a, lds, it, tid);
#pragma unroll 1
    for (int r = 0; r < 1 + ((PROBE_SUB >> 2) & 1); ++r)
#pragma unroll 1
    for (int j = vcu; j < 1024; j += G) { const int b = j >> 3, hn = j & 7; delta_rec_item(a, lds, MP + b * TS, TS, hn, a->in[I_SCONV] + (size_t)b * 3 * 4096, a->in[I_SDELTA] + (size_t)j * 16384, a->out + O_DELTAS + (size_t)j * 16384, tid); }
#pragma unroll 1
    for (int r = 0; r < 1 + ((PROBE_SUB >> 3) & 1); ++r)
    lru_sample_loop(a, lds, vcu, G, tid);
    const bf16* proj = (const bf16*)(a->ws + WS_PROJ);
    const int npieces = (BP + BS) * 3 * 512;
    for (int i = vcu * NTHR + tid; i < npieces; i += G * NTHR) {
        const int c8 = i & 511, rj = i >> 9, j = rj % 3, b = rj / 3;
        const bf16* src; float* dst;
        if (b < BP) { src = proj + (size_t)(b * TP + TP - 3 + j) * NPROJ_PAD + 8 * c8; dst = a->out + O_CONVP + (size_t)(b * 3 + j) * 4096 + 8 * c8; }
        else { const int bs = b - BP; src = proj + (size_t)(MP + bs * TS + 1 + j) * NPROJ_PAD + 8 * c8; dst = a->out + O_CONVS + (size_t)(bs * 3 + j) * 4096 + 8 * c8; }
        const v4u u = *(const v4u*)src;
        *(f32x4*)dst = (f32x4){bflo(u.x), bfhi(u.x), bflo(u.y), bfhi(u.y)}; *(f32x4*)(dst + 4) = (f32x4){bflo(u.z), bfhi(u.z), bflo(u.w), bfhi(u.w)};
    }
}
__device__ __forceinline__ void phase_mixer_even_b(ArgsP a, LAS unsigned char* lds, int vcu, int G, const int tid) {
    const int w = __builtin_amdgcn_readfirstlane(tid >> 6);
    if (w == 0) { for (int it = vcu; it < 256; it += G) delta_scan_wave(a, it >> 3, it & 7, tid & 63); }
    else { LAS float* scr = (LAS float*)(lds + w * 16384);
        convert_range(a, scr, cv::R_IN0, cv::R_SCAN, vcu * 7 + (w - 1), G * 7, tid & 63); }
}
__device__ __forceinline__ void phase_mixer_even_c(ArgsP a, LAS unsigned char* lds, int vcu, int G, const int tid) {
    const int w = tid >> 6;
#pragma unroll 1
    for (int it = vcu; it < 512; it += G) delta_out_wave(a, 2 * it + (w >> 2), w & 3, tid & 63);
#pragma unroll 1
    for (int it = vcu; it < 1024; it += G) lru_out_item(a, lds, it, tid);
    for (int chain = vcu; chain < 32; chain += G) {
        const f32x4* src = (const f32x4*)(a->ws + WS_DF) + (size_t)chain * 4096; float* dst = a->out + O_DELTAP + (size_t)chain * 16384;
        f32x4 v[8];
#pragma unroll
        for (int i = 0; i < 8; ++i) v[i] = src[tid + 512 * i];
#pragma unroll
        for (int i = 0; i < 8; ++i) { const int idx = tid + 512 * i, ln = idx & 63, rb = (idx >> 6) & 7, s8 = idx >> 9; const int dk0 = 16 * rb + 4 * (ln >> 4), dv = 16 * s8 + (ln & 15);
            dst[(size_t)(dk0 + 0) * 128 + dv] = v[i].x; dst[(size_t)(dk0 + 1) * 128 + dv] = v[i].y; dst[(size_t)(dk0 + 2) * 128 + dv] = v[i].z; dst[(size_t)(dk0 + 3) * 128 + dv] = v[i].w; }
    }
}
__device__ __forceinline__ void phase_mixer_odd(ArgsP a, LAS unsigned char* lds, int vcu, int G, const int tid) {
#pragma unroll 1
    for (int r = 0; r < 1 + ((PROBE_SUB >> 4) & 1); ++r)
#pragma unroll 1
    for (int it = vcu; it < 256; it += G) mlstm_scan_item(a, lds, it >> 3, it & 7, tid);
#pragma unroll 1
    for (int r = 0; r < 1 + ((PROBE_SUB >> 5) & 1); ++r)
    {
        f32x4 cA[2][4][2], cB[2][4][2]; int j = vcu;
        if (j < 1024) { mlstm_sample_load(a, j, tid, cA);
#pragma unroll 1
            for (;;) {
                const int jB = j + G; const bool hasB = jB < 1024;
                if (hasB) mlstm_sample_load(a, jB, tid, cB);
                mlstm_sample_item(a, lds, j, tid, cA);
                if (!hasB) break;
                j = jB + G; const bool hasA = j < 1024;
                if (hasA) mlstm_sample_load(a, j, tid, cA);
                mlstm_sample_item(a, lds, jB, tid, cB);
                if (!hasA) break;
            } }
    }
}
__device__ __forceinline__ void phase_mixer_odd_b(ArgsP a, LAS unsigned char* lds, int vcu, int G, const int tid) {
#pragma unroll 1
    for (int it = vcu; it < 1024; it += G) mlstm_out_item(a, lds, it, tid);
}

__device__ __forceinline__ void phase_ln(const bf16* VB, const float* ST, const float* p1, const bf16* resid, const float* g, const float* bta, bf16* dst, LAS unsigned char* lds, int vcu, int G, const int tid) {
    const int lane = tid & 63, w = __builtin_amdgcn_readfirstlane(tid >> 6), gw = vcu * NWAVES + w, NGW = G * NWAVES;
    {
        LAS float* red = (LAS float*)lds;
        for (int r0 = 2 * vcu; r0 < MS; r0 += 2 * G) {
            const int r = r0 + (w >> 2), q = w & 3, col = 512 * q + 8 * lane; const size_t off = (size_t)(MP + r) * D + col;
            const float* q1 = p1 + (size_t)r * D + col;
            f32x4 x0 = *(const f32x4*)q1, x1 = *(const f32x4*)(q1 + 4);
#pragma unroll
            for (int ch = 1; ch < 16; ++ch) { x0 = x0 + *(const f32x4*)(q1 + (size_t)ch * 512 * D); x1 = x1 + *(const f32x4*)(q1 + (size_t)ch * 512 * D + 4); }
            const v4u rr = *(const v4u*)(resid + off);
            float v[8] = {x0.x + DN_ALPHA * bflo(rr.x), x0.y + DN_ALPHA * bfhi(rr.x), x0.z + DN_ALPHA * bflo(rr.y), x0.w + DN_ALPHA * bfhi(rr.y),
                          x1.x + DN_ALPHA * bflo(rr.z), x1.y + DN_ALPHA * bfhi(rr.z), x1.z + DN_ALPHA * bflo(rr.w), x1.w + DN_ALPHA * bfhi(rr.w)};
            float s = 0.f, ss = 0.f;
#pragma unroll
            for (int i = 0; i < 8; ++i) { s += v[i]; ss += v[i] * v[i]; }
            s = wave_sum(s); ss = wave_sum(ss);
            if (lane == 0) { red[w * 2] = s; red[w * 2 + 1] = ss; }
            LDS_BARRIER();
            const int wb = (w >> 2) * 4; s = (red[wb * 2] + red[wb * 2 + 2]) + (red[wb * 2 + 4] + red[wb * 2 + 6]); ss = (red[wb * 2 + 1] + red[wb * 2 + 3]) + (red[wb * 2 + 5] + red[wb * 2 + 7]);
            const float mean = s * (1.f / D), rstd = rsqrtf(fmaxf(ss * (1.f / D) - mean * mean, 0.f) + LN_EPS);
            const f32x4 g0 = *(const f32x4*)(g + col), g1 = *(const f32x4*)(g + col + 4), b0 = *(const f32x4*)(bta + col), b1 = *(const f32x4*)(bta + col + 4);
            v4u o; o.x = pk2((v[0] - mean) * rstd * g0.x + b0.x, (v[1] - mean) * rstd * g0.y + b0.y); o.y = pk2((v[2] - mean) * rstd * g0.z + b0.z, (v[3] - mean) * rstd * g0.w + b0.w);
            o.z = pk2((v[4] - mean) * rstd * g1.x + b1.x, (v[5] - mean) * rstd * g1.y + b1.y); o.w = pk2((v[6] - mean) * rstd * g1.z + b1.z, (v[7] - mean) * rstd * g1.w + b1.w);
            *(v4u*)(dst + off) = o;
            LDS_BARRIER();
        }
    }
    for (int m0 = gw; m0 < MP; m0 += 4 * NGW) {
        v4u vv[4][4]; float s[4], ss[4];
#pragma unroll
        for (int i = 0; i < 4; ++i) { const int m = m0 + i * NGW; s[i] = 0.f; ss[i] = 0.f;
            if (m < MP) { if (lane < 32) { const float* sp = ST + (((size_t)(lane >> 2) * M + m) * 4 + (lane & 3)) * 2; s[i] = sp[0]; ss[i] = sp[1]; }
#pragma unroll
                for (int j = 0; j < 4; ++j) vv[i][j] = *(const v4u*)(VB + (size_t)m * D + j * 512 + lane * 8); } }
#pragma unroll
        for (int i = 0; i < 4; ++i) { const int m = m0 + i * NGW;
            if (m < MP) { const float st = wave_sum(s[i]), sst = wave_sum(ss[i]);
                const float mean = st * (1.f / D), rstd = rsqrtf(fmaxf(sst * (1.f / D) - mean * mean, 0.f) + LN_EPS);
#pragma unroll
                for (int j = 0; j < 4; ++j) { const int col = j * 512 + lane * 8; const v4u v = vv[i][j];
                    const f32x4 g0 = *(const f32x4*)(g + col), g1 = *(const f32x4*)(g + col + 4), b0 = *(const f32x4*)(bta + col), b1 = *(const f32x4*)(bta + col + 4);
                    v4u o; o.x = pk2((bflo(v.x) - mean) * rstd * g0.x + b0.x, (bfhi(v.x) - mean) * rstd * g0.y + b0.y); o.y = pk2((bflo(v.y) - mean) * rstd * g0.z + b0.z, (bfhi(v.y) - mean) * rstd * g0.w + b0.w);
                    o.z = pk2((bflo(v.z) - mean) * rstd * g1.x + b1.x, (bfhi(v.z) - mean) * rstd * g1.y + b1.y); o.w = pk2((bflo(v.w) - mean) * rstd * g1.z + b1.z, (bfhi(v.w) - mean) * rstd * g1.w + b1.w);
                    *(v4u*)(dst + (size_t)m * D + col) = o; } } }
    }
}
__device__ __forceinline__ void phase_combine(const float* p1, const bf16* h2, const bf16* pw, bf16* xb, float* outf, int vcu, int G, const int tid) {
    const int lane = tid & 63, w = tid >> 6;
    for (int r0 = 2 * vcu; r0 < MS; r0 += 2 * G) {
        const int r = r0 + (w >> 2), q = w & 3, col = 512 * q + 8 * lane; const size_t off = (size_t)(MP + r) * D + col;
        const float* q1 = p1 + (size_t)r * D + col;
        f32x4 x0 = *(const f32x4*)q1, x1 = *(const f32x4*)(q1 + 4);
#pragma unroll
        for (int ch = 1; ch < 16; ++ch) { x0 = x0 + *(const f32x4*)(q1 + (size_t)ch * 512 * D); x1 = x1 + *(const f32x4*)(q1 + (size_t)ch * 512 * D + 4); }
        const v4u hh = *(const v4u*)(h2 + off), pp = *(const v4u*)(pw + off);
        f32x4 o0, o1;
        o0.x = bflo(hh.x) + sigm(x0.x) * bflo(pp.x); o0.y = bfhi(hh.x) + sigm(x0.y) * bfhi(pp.x); o0.z = bflo(hh.y) + sigm(x0.z) * bflo(pp.y); o0.w = bfhi(hh.y) + sigm(x0.w) * bfhi(pp.y);
        o1.x = bflo(hh.z) + sigm(x1.x) * bflo(pp.z); o1.y = bfhi(hh.z) + sigm(x1.y) * bfhi(pp.z); o1.z = bflo(hh.w) + sigm(x1.z) * bflo(pp.w); o1.w = bfhi(hh.w) + sigm(x1.w) * bfhi(pp.w);
        v4u ob; ob.x = pk2(o0.x, o0.y); ob.y = pk2(o0.z, o0.w); ob.z = pk2(o1.x, o1.y); ob.w = pk2(o1.z, o1.w); *(v4u*)(xb + off) = ob;
        if (outf) { *(f32x4*)(outf + off) = o0; *(f32x4*)(outf + off + 4) = o1; }
    }
}

constexpr int N_PHASES = 22;
enum { OP_INPROJ = 0, OP_MIXA, OP_MIXB, OP_MIXC, OP_OUTPROJ, OP_LN1, OP_UP, OP_DOWN, OP_LN2, OP_GATE, OP_COMBINE };
enum { GK_LN = 0, GK_BF16 = 1, GK_SQRELU = 2, GK_COMB = 3 };
__global__ void __launch_bounds__(NTHR, 2) mk_fwd(Args a_in) {
    extern __shared__ __attribute__((aligned(16))) unsigned char lds_raw[];
    LAS unsigned char* lds = (LAS unsigned char*)lds_raw;
    ArgsP kp = (ArgsP)__builtin_amdgcn_kernarg_segment_ptr();
    const int lo = a_in.ph_lo, hi = a_in.ph_hi;
    int wv0; { const int wtmp = (int)threadIdx.x >> 6; asm volatile("s_nop 4\n\tv_readfirstlane_b32 %0, %1\n\ts_nop 4" : "=s"(wv0) : "v"(wtmp)); }
#if MK_N_LAUNCHES == 1
    volatile LAS unsigned* xst = (volatile LAS unsigned*)(lds + LDS_CTL_OFF);
    if (threadIdx.x < 2) xst[threadIdx.x] = 0u;
    __syncthreads();
    XcdBarrier bar = xcd_barrier_post((unsigned*)(a_in.ws + WS_CTL) + 4096, xst);
#endif
    int p = lo; asm volatile("" : "+s"(p));
#pragma unroll 1
    for (; p < hi; ) {
      int nrep = 1;
      if (PROBE_MASK) { const int L_ = p <= 11 ? 0 : 1; const int q_ = p == 0 ? -1 : (L_ == 0 ? p - 1 : (p - 12 < 3 ? p - 12 : p - 11));
        int grp; if (p == 0) grp = 0; else if (q_ == OP_INPROJ || q_ == OP_UP) grp = 1; else if (q_ == OP_OUTPROJ || q_ == OP_DOWN || q_ == OP_GATE) grp = 2; else if (q_ == OP_LN1 || q_ == OP_LN2 || q_ == OP_COMBINE) grp = 3; else grp = (L_ == 0) ? 4 : 5;
        if ((PROBE_MASK >> grp) & 1) nrep = 2; }
      if (p == PROBE_P) nrep = 2;
#pragma unroll 1
      for (int rep = 0; rep < nrep; ++rep) {
        int pp = p; asm volatile("" : "+s"(pp));
        int wvs = wv0; asm volatile("" : "+s"(wvs));
        unsigned ones = ~0u; asm volatile("" : "+s"(ones));
        int tid = (wvs << 6) | (int)__builtin_amdgcn_mbcnt_hi(ones, __builtin_amdgcn_mbcnt_lo(ones, 0u)); asm volatile("" : "+v"(tid));
        int bx = blockIdx.x; asm volatile("" : "+s"(bx));
        int G = gridDim.x; asm volatile("" : "+s"(G));
        ArgsP a = kp; asm volatile("" : "+s"(a));
#define MK_VCU ((G % 8 == 0) ? (bx % 8) * (G / 8) + bx / 8 : bx)
#define MK_WAVE (__builtin_amdgcn_readfirstlane(tid >> 6))
#define MK_GW (MK_VCU * NWAVES + MK_WAVE)
#define MK_NGW (G * NWAVES)
#define MK_LANE (tid & 63)
        unsigned char* ws = a->ws;
        if (pp == 0) {
phase_convert(a, lds, MK_GW, MK_NGW, MK_WAVE, MK_LANE); }
        else {
            const int L = pp <= 11 ? 0 : 1; const int q = L == 0 ? pp - 1 : (pp - 12 < 3 ? pp - 12 : pp - 11);
            bf16* xb = (bf16*)(ws + WS_XB); bf16* mixb = (bf16*)(ws + WS_MIX); bf16* hb = (bf16*)(ws + WS_H); bf16* h2b = (bf16*)(ws + WS_H2); bf16* pwb = (bf16*)(ws + WS_PW);
            bf16* projb = (bf16*)(ws + WS_PROJ); bf16* upb = (bf16*)(ws + WS_PROJ);
            bf16* vbb = (bf16*)(ws + WS_PART0); float* stb = (float*)(ws + WS_PART0 + 34 * MiB); float* part1 = (float*)(ws + WS_PART1); float* gatesb = (float*)(ws + WS_GATES);
            if (q == OP_MIXA) { if (L == 0) phase_mixer_even(a, lds, MK_VCU, G, tid); else phase_mixer_odd(a, lds, MK_VCU, G, tid); }
            else if (q == OP_MIXB) { if (L == 0) phase_mixer_even_b(a, lds, MK_VCU, G, tid); else phase_mixer_odd_b(a, lds, MK_VCU, G, tid); }
            else if (q == OP_MIXC) { phase_mixer_even_c(a, lds, MK_VCU, G, tid); }
            else if (q == OP_LN1) phase_ln(vbb, stb, part1, xb, a->in[I_LN1G] + L * D, a->in[I_LN1B] + L * D, hb, lds, MK_VCU, G, tid);
            else if (q == OP_LN2) phase_ln(vbb, stb, part1, hb, a->in[I_LN2G] + L * D, a->in[I_LN2B] + L * D, h2b, lds, MK_VCU, G, tid);
            else if (q == OP_COMBINE) phase_combine(part1, h2b, pwb, xb, L == 1 ? a->out + O_Y : nullptr, MK_VCU, G, tid);
            else {
                for (int sub = 0; sub < (q == OP_INPROJ ? 2 : 1); ++sub) {
                    const bf16* A; const bf16* Bt; int N, K, kind; void* out = nullptr; float* gp = nullptr; const bf16* resid = nullptr; int corder = bx, gorder = G;
                    const int busy_in = ((M / 256) * (NPROJ_PAD / 256)) % 256;
                    if (q == OP_INPROJ && sub == 0) { A = xb; Bt = (const bf16*)(ws + (L == 0 ? WS_WINE : WS_WINO)); N = NPROJ_PAD; K = D; kind = GK_BF16; out = projb; gp = gatesb; }
                    else if (q == OP_INPROJ) { A = (const bf16*)(ws + WS_PB) + (size_t)L * M * PLE; Bt = (const bf16*)(ws + WS_WPLE) + (size_t)L * PLE * D; N = D; K = PLE; kind = GK_BF16; out = pwb;
                        gorder = G - busy_in; corder = (bx >= busy_in) ? bx - busy_in : 1 << 20; }
                    else if (q == OP_OUTPROJ) { A = mixb; Bt = (const bf16*)(ws + (L == 0 ? WS_WOUTE : WS_WOUTO)); N = D; K = D; kind = GK_LN; resid = xb; }
                    else if (q == OP_UP) { A = hb; Bt = (const bf16*)(ws + WS_WUP) + (size_t)L * D * FF; N = FF; K = D; kind = GK_SQRELU; out = upb; }
                    else if (q == OP_DOWN) { A = upb; Bt = (const bf16*)(ws + WS_WDOWN) + (size_t)L * D * FF; N = D; K = FF; kind = GK_LN; resid = hb; }
                    else { A = h2b; Bt = (const bf16*)(ws + WS_WGATE) + (size_t)L * D * D; N = D; K = D; kind = GK_COMB; }
                    pg8::Gemm g{A, Bt, M, N, K};
                    if (kind == GK_LN) { pg8::MainSplit SK; SK.init(K, MK_VCU); pg8::EpiLnStat E{vbb, stb, resid, part1, N, M, DN_ALPHA}; pg8::gemm_phase<pg8::EpiLnStat, pg8::MainSplit, true, true>(lds, g, SK, E, tid); }
                    else if (kind == GK_COMB) { pg8::MainSplit SK; SK.init(K, MK_VCU); pg8::EpiCombine E{h2b, pwb, xb, L == 1 ? a->out + O_Y : nullptr, part1, N}; pg8::gemm_phase<pg8::EpiCombine, pg8::MainSplit, true, true>(lds, g, SK, E, tid); }
                    else if (kind == GK_BF16) { pg8::StaticOrder S; S.init(M, N, K, gorder, corder); pg8::EpiBf16<0> E{(bf16*)out, N, gp, 24}; pg8::gemm_phase<pg8::EpiBf16<0>, pg8::StaticOrder, true, true>(lds, g, S, E, tid);}
                    else { pg8::StaticOrder S; S.init(M, N, K, G, corder); pg8::EpiBf16<1> E{(bf16*)out, N, nullptr, -1}; pg8::gemm_phase<pg8::EpiBf16<1>, pg8::StaticOrder, true, true>(lds, g, S, E, tid);}
                }
                if (q == OP_INPROJ || q == OP_UP) {
                    const int busy = (q == OP_INPROJ) ? ((M / 256) * (NPROJ_PAD / 256)) % 256 : ((M / 256) * (FF / 256)) % 256;
                    const int first = (q == OP_INPROJ) ? (L == 0 ? 0 : cv::R_SCAN) : (L == 0 ? cv::R_IN1 : cv::R_UP0), last = (q == OP_INPROJ) ? (L == 0 ? cv::R_IN0 : cv::R_IN1) : (L == 0 ? cv::R_UP0 : cv::N_REST);
                    if (G == 256 && bx >= busy) { const int w_ = MK_WAVE; convert_range(a, (LAS float*)(lds + w_ * 16384), first, last, (bx - busy) * NWAVES + w_, (G - busy) * NWAVES, MK_LANE); }
                }
            }
        }
#if MK_N_LAUNCHES == 1
        if (p + 1 < hi || rep + 1 < nrep) xcd_barrier(bar);
#endif
      }
      asm volatile("s_add_i32 %0, %0, 1" : "+s"(p) : : "scc");
    }
}

extern "C" void kernel_launch(void* const* d_in, const int* in_sizes, int n_in, void* d_out, int out_size, void* d_ws, size_t ws_size, hipStream_t stream) {
    static int grid = 0;
    if (grid == 0) {
        if (n_in != 35 || (size_t)out_size != O_END || ws_size < WS_END) { fprintf(stderr, "kernel_launch: unexpected shapes: n_in %d out %d (want %zu) ws %zu (want %zu)\n", n_in, out_size, (size_t)O_END, ws_size, (size_t)WS_END); grid = -1; return; }
        int dev = 0, cus = 0, per_cu = 0;
        hipGetDevice(&dev); hipDeviceGetAttribute(&cus, hipDeviceAttributeMultiprocessorCount, dev);
        if (hipFuncSetAttribute((const void*)mk_fwd, hipFuncAttributeMaxDynamicSharedMemorySize, LDS_BYTES) != hipSuccess) { fprintf(stderr, "kernel_launch: hipFuncSetAttribute failed\n"); grid = -1; return; }
        if (hipOccupancyMaxActiveBlocksPerMultiprocessor(&per_cu, (const void*)mk_fwd, NTHR, LDS_BYTES) != hipSuccess || per_cu < 1) { fprintf(stderr, "kernel_launch: occupancy query says %d\n", per_cu); per_cu = 1; }
        (void)hipGetLastError();
        if (cus != 256) { fprintf(stderr, "kernel_launch: built for a 256-CU device (N = 2048 GEMM schedule), got %d\n", cus); grid = -1; return; }
        grid = cus * 1;
    }
    if (grid < 0) return;
    Args a{};
    for (int i = 0; i < 35; ++i) a.in[i] = (const float*)d_in[i];
    a.out = (float*)d_out; a.ws = (unsigned char*)d_ws;
#if MK_N_LAUNCHES == 1
    hipMemsetAsync((char*)d_ws + WS_CTL, 0, 1 * MiB, stream);
    a.ph_lo = 0; a.ph_hi = N_PHASES;
    hipLaunchKernelGGL(mk_fwd, dim3(grid), dim3(NTHR), LDS_BYTES, stream, a);
#else
    for (int p = 0; p < N_PHASES; ++p) {
        a.ph_lo = p; a.ph_hi = p + 1;
        hipLaunchKernelGGL(mk_fwd, dim3(grid), dim3(NTHR), LDS_BYTES, stream, a);
    }
#endif
}
```

```cpp
#include <hip/hip_runtime.h>
#include <hip/hip_cooperative_groups.h>
#include <cstdio>
#include <cstdint>
namespace cg = cooperative_groups;

#ifndef PROBE_MASK
#define PROBE_MASK 0
#endif
#define PROBE_P (-1)
#define PROBE_SUB 0
#ifndef MK_N_LAUNCHES
#define MK_N_LAUNCHES 1
#endif

namespace pg8 {
#define PG8_LAS __attribute__((address_space(3)))
typedef unsigned short bf16_t;
typedef short bf16x8 __attribute__((ext_vector_type(8)));
typedef float f32x4 __attribute__((ext_vector_type(4)));
typedef unsigned u32x4 __attribute__((ext_vector_type(4)));
constexpr int BM = 256, BK = 64, HALF = 128, HTB = HALF * BK * 2, STAGE_BYTES = 8 * HTB, NXCD = 8, WGM = 8;

__host__ __device__ __forceinline__ int lds_byte(int r, int c) { const int st = (r >> 4) * 2 + (c >> 5), rr = r & 15, cc = c & 31, ob = rr * 64 + cc * 2; return st * 1024 + (ob ^ (((ob >> 9) & 1) << 5)); }
__host__ __device__ __forceinline__ void stage_rc(int b, int& R, int& C) { const int st = b / 1024, sb = b % 1024, swz = sb ^ (((sb >> 9) & 1) << 5); R = (st >> 1) * 16 + swz / 64; C = (st & 1) * 32 + (swz % 64) / 2; }
__host__ __device__ __forceinline__ int perm32(int rho) { const int n = rho >> 4, i = rho & 15; return 8 * (i >> 2) + 4 * n + (i & 3); }

struct Unit { int pm, pn, kt0, nkt, dst; };
struct Gemm { const bf16_t* A; const bf16_t* Bt; int M, N, K; };

struct StaticOrder {
    int nM, nN, nwg, G, c, T;
    __host__ __device__ void init(int M, int N, int K, int G_, int c_) { nM = M / BM; nN = N / BM; nwg = nM * nN; G = G_; c = c_; T = K / BK; }
    __host__ __device__ bool next(int i, Unit& u) const {
        const long L = (long)i * G + c; if (L >= nwg) return false;
        int wgid = (int)L; { const int q = nwg / NXCD, r = nwg % NXCD, xcd = wgid % NXCD, off = wgid / NXCD; wgid = (xcd < r ? xcd * (q + 1) : r * (q + 1) + (xcd - r) * q) + off; }
        const int nig = WGM * nN, gid = wgid / nig, fm = gid * WGM, gsz = (nM - fm) < WGM ? (nM - fm) : WGM;
        u.pm = fm + ((wgid % nig) % gsz); u.pn = (wgid % nig) / gsz; u.kt0 = 0; u.nkt = T; u.dst = 0; return true;
    }
    __device__ __forceinline__ void a_ready(const Unit&) const {}
    __device__ __forceinline__ void done(const Unit&) const {}
};
struct StreamK {
    int nN, T, P, ntot, c;
    __host__ __device__ void init(int M, int N, int K, int G, int c_) { nN = N / BM; T = K / BK; ntot = (M / BM) * nN * T; P = (((ntot + G - 1) / G) + 1) & ~1; c = c_; }
    __host__ __device__ bool next(int i, Unit& u) const {
        int s = c * P; const int e = (s + P < ntot) ? s + P : ntot;
        for (int k = 0; ; ++k) { if (s >= e) return false; const int tile = s / T, kt0 = s - tile * T; const int n = (T - kt0 < e - s) ? T - kt0 : e - s;
            if (k == i) { u.pm = tile / nN; u.pn = tile - u.pm * nN; u.kt0 = kt0; u.nkt = n; u.dst = kt0 ? 1 : 0; return true; }
            s += n; }
    }
    __device__ __forceinline__ void a_ready(const Unit&) const {}
    __device__ __forceinline__ void done(const Unit&) const {}
};
struct MainSplit {
    int T, c;
    __host__ __device__ void init(int K, int c_) { T = K / BK; c = c_; }
    __host__ __device__ bool next(int i, Unit& u) const {
        if (i == 0) { u.pm = c >> 3; u.pn = c & 7; u.kt0 = 0; u.nkt = T; u.dst = 0; return true; }
        if (i == 1) { const int lt = c >> 4, j = c & 15; u.pm = 32 + (lt >> 3); u.pn = lt & 7; u.nkt = T >> 4; u.kt0 = j * u.nkt; u.dst = 1 + j; return true; }
        return false;
    }
    __device__ __forceinline__ void a_ready(const Unit&) const {}
    __device__ __forceinline__ void done(const Unit&) const {}
};
__host__ __device__ __forceinline__ bool split_tile(int tile, int T, int P) { return (tile * T) / P != ((tile + 1) * T - 1) / P; }

typedef __bf16 hwbf16x2 __attribute__((ext_vector_type(2)));
typedef float hwf32x2 __attribute__((ext_vector_type(2)));
__device__ __forceinline__ unsigned cvt_pk_bf16(float lo, float hi) { return __builtin_bit_cast(unsigned, __builtin_convertvector((hwf32x2){lo, hi}, hwbf16x2)); }

__device__ __forceinline__ float pg_bflo(unsigned w) { return __builtin_bit_cast(float, w << 16); }
__device__ __forceinline__ float pg_bfhi(unsigned w) { return __builtin_bit_cast(float, w & 0xffff0000u); }
__device__ __forceinline__ void store_chunk(const f32x4 (&acc)[2][2][4][2], const Unit& u, float* C1, int ldc, int wr, int wc, int fr, int fq) {
    const int row0 = u.pm * BM + wr * 64 + fr, col0 = u.pn * BM + wc * 32 + 8 * fq; float* Cb = C1 + ((long)(u.dst - 1) * 512 - 8192) * (long)ldc;
#pragma unroll
    for (int ai = 0; ai < 2; ++ai)
#pragma unroll
        for (int m = 0; m < 4; ++m) { float* rowp = Cb + (size_t)(row0 + ai * HALF + m * 16) * ldc + col0;
#pragma unroll
            for (int bj = 0; bj < 2; ++bj) { *(f32x4*)(rowp + bj * HALF) = acc[ai][bj][m][0]; *(f32x4*)(rowp + bj * HALF + 4) = acc[ai][bj][m][1]; } }
}
struct EpiLnStat {
    static constexpr bool PERM = true, AFTER_DRAIN = false;
    bf16_t* VB; float* ST; const bf16_t* resid; float* C1; int ldc; int mrows; float alpha;
    __device__ __forceinline__ void operator()(const f32x4 (&acc)[2][2][4][2], const Unit& u, int wr, int wc, int fr, int fq) const {
        if (u.dst) { store_chunk(acc, u, C1, ldc, wr, wc, fr, fq); return; }
        const int row0 = u.pm * BM + wr * 64 + fr, col0 = u.pn * BM + wc * 32 + 8 * fq;
        u32x4 rq[2];
#pragma unroll
        for (int bj = 0; bj < 2; ++bj) rq[bj] = *(const u32x4*)(resid + (size_t)(row0) * ldc + col0 + bj * HALF);
#pragma unroll
        for (int idx = 0; idx < 8; ++idx) { const int ai = idx >> 2, m = idx & 3; const int row = row0 + ai * HALF + m * 16; float s = 0.f, ss = 0.f;
                u32x4 rc[2] = {rq[0], rq[1]};
                if (idx + 1 < 8) { const int nrow = row0 + ((idx + 1) >> 2) * HALF + ((idx + 1) & 3) * 16;
#pragma unroll
                    for (int bj = 0; bj < 2; ++bj) rq[bj] = *(const u32x4*)(resid + (size_t)nrow * ldc + col0 + bj * HALF); }
#pragma unroll
                for (int bj = 0; bj < 2; ++bj) { const size_t off = (size_t)row * ldc + col0 + bj * HALF; const u32x4 r = rc[bj];
                    f32x4 v0 = acc[ai][bj][m][0], v1 = acc[ai][bj][m][1];
                    v0[0] += alpha * pg_bflo(r.x); v0[1] += alpha * pg_bfhi(r.x); v0[2] += alpha * pg_bflo(r.y); v0[3] += alpha * pg_bfhi(r.y);
                    v1[0] += alpha * pg_bflo(r.z); v1[1] += alpha * pg_bfhi(r.z); v1[2] += alpha * pg_bflo(r.w); v1[3] += alpha * pg_bfhi(r.w);
                    s += ((v0[0] + v0[1]) + (v0[2] + v0[3])) + ((v1[0] + v1[1]) + (v1[2] + v1[3]));
                    ss += ((v0[0] * v0[0] + v0[1] * v0[1]) + (v0[2] * v0[2] + v0[3] * v0[3])) + ((v1[0] * v1[0] + v1[1] * v1[1]) + (v1[2] * v1[2] + v1[3] * v1[3]));
                    u32x4 w; w.x = cvt_pk_bf16(v0[0], v0[1]); w.y = cvt_pk_bf16(v0[2], v0[3]); w.z = cvt_pk_bf16(v1[0], v1[1]); w.w = cvt_pk_bf16(v1[2], v1[3]);
                    *(u32x4*)(VB + off) = w; }
                s += __shfl_xor(s, 16); s += __shfl_xor(s, 32); ss += __shfl_xor(ss, 16); ss += __shfl_xor(ss, 32);
                if (fq == 0) { float* sp = ST + (((size_t)u.pn * mrows + row) * 4 + wc) * 2; sp[0] = s; sp[1] = ss; } }
    }
};
struct EpiCombine {
    static constexpr bool PERM = true, AFTER_DRAIN = false;
    const bf16_t* h2; const bf16_t* pw; bf16_t* xb; float* outf; float* C1; int ldc;
    __device__ __forceinline__ void operator()(const f32x4 (&acc)[2][2][4][2], const Unit& u, int wr, int wc, int fr, int fq) const {
        if (u.dst) { store_chunk(acc, u, C1, ldc, wr, wc, fr, fq); return; }
        const int row0 = u.pm * BM + wr * 64 + fr, col0 = u.pn * BM + wc * 32 + 8 * fq;
        u32x4 hq[2], pq[2];
#pragma unroll
        for (int bj = 0; bj < 2; ++bj) { const size_t o0 = (size_t)row0 * ldc + col0 + bj * HALF; hq[bj] = *(const u32x4*)(h2 + o0); pq[bj] = *(const u32x4*)(pw + o0); }
#pragma unroll
        for (int idx = 0; idx < 8; ++idx) { const int ai = idx >> 2, m = idx & 3; const int row = row0 + ai * HALF + m * 16;
                u32x4 hc[2] = {hq[0], hq[1]}, pc[2] = {pq[0], pq[1]};
                if (idx + 1 < 8) { const int nrow = row0 + ((idx + 1) >> 2) * HALF + ((idx + 1) & 3) * 16;
#pragma unroll
                    for (int bj = 0; bj < 2; ++bj) { const size_t on = (size_t)nrow * ldc + col0 + bj * HALF; hq[bj] = *(const u32x4*)(h2 + on); pq[bj] = *(const u32x4*)(pw + on); } }
#pragma unroll
                for (int bj = 0; bj < 2; ++bj) { const size_t off = (size_t)row * ldc + col0 + bj * HALF; const u32x4 hh = hc[bj], pp = pc[bj];
                    const f32x4 a0 = acc[ai][bj][m][0], a1 = acc[ai][bj][m][1]; f32x4 o0, o1;
                    o0[0] = pg_bflo(hh.x) + pg_bflo(pp.x) / (1.f + __expf(-a0[0])); o0[1] = pg_bfhi(hh.x) + pg_bfhi(pp.x) / (1.f + __expf(-a0[1]));
                    o0[2] = pg_bflo(hh.y) + pg_bflo(pp.y) / (1.f + __expf(-a0[2])); o0[3] = pg_bfhi(hh.y) + pg_bfhi(pp.y) / (1.f + __expf(-a0[3]));
                    o1[0] = pg_bflo(hh.z) + pg_bflo(pp.z) / (1.f + __expf(-a1[0])); o1[1] = pg_bfhi(hh.z) + pg_bfhi(pp.z) / (1.f + __expf(-a1[1]));
                    o1[2] = pg_bflo(hh.w) + pg_bflo(pp.w) / (1.f + __expf(-a1[2])); o1[3] = pg_bfhi(hh.w) + pg_bfhi(pp.w) / (1.f + __expf(-a1[3]));
                    u32x4 w; w.x = cvt_pk_bf16(o0[0], o0[1]); w.y = cvt_pk_bf16(o0[2], o0[3]); w.z = cvt_pk_bf16(o1[0], o1[1]); w.w = cvt_pk_bf16(o1[2], o1[3]);
                    *(u32x4*)(xb + off) = w;
                    if (outf) { *(f32x4*)(outf + off) = o0; *(f32x4*)(outf + off + 4) = o1; } } }
    }
};
template <int ACT> struct EpiBf16 {
    static constexpr bool PERM = true, AFTER_DRAIN = false;
    bf16_t* O; int ldc; float* gates; int gate_pn;
    __device__ __forceinline__ void operator()(const f32x4 (&acc)[2][2][4][2], const Unit& u, int wr, int wc, int fr, int fq) const {
        const int row0 = u.pm * BM + wr * 64 + fr; const int col0 = u.pn * BM + wc * 32 + 8 * fq;
        const bool gt = (gates != nullptr) && (u.pn == gate_pn) && (wc == 0) && (fq < 2);
#pragma unroll
        for (int ai = 0; ai < 2; ++ai)
#pragma unroll
            for (int m = 0; m < 4; ++m) { const int row = row0 + ai * HALF + m * 16; bf16_t* rowp = O + (size_t)row * ldc + col0;
#pragma unroll
                for (int bj = 0; bj < 2; ++bj) { f32x4 v0 = acc[ai][bj][m][0], v1 = acc[ai][bj][m][1];
                    if (ACT == 1) {
#pragma unroll
                        for (int j = 0; j < 4; ++j) { const float a = fmaxf(v0[j], 0.f), b = fmaxf(v1[j], 0.f); v0[j] = a * a; v1[j] = b * b; } }
                    u32x4 w; w.x = cvt_pk_bf16(v0[0], v0[1]); w.y = cvt_pk_bf16(v0[2], v0[3]); w.z = cvt_pk_bf16(v1[0], v1[1]); w.w = cvt_pk_bf16(v1[2], v1[3]);
                    *(u32x4*)(rowp + bj * HALF) = w; }
                if (gt) { float* gp = gates + (size_t)row * 16 + 8 * fq; *(f32x4*)gp = acc[ai][0][m][0]; *(f32x4*)(gp + 4) = acc[ai][0][m][1]; } }
    }
};

template <class Epi, class Sched, bool ALIGN_EPI = false, bool SP2 = false>
__device__ __forceinline__ void gemm_phase(PG8_LAS unsigned char* lds, const Gemm g, const Sched& S, const Epi& E, const int tid) {
    const int wid = __builtin_amdgcn_readfirstlane(tid >> 6), lane = tid & 63, wr = wid >> 2, wc = wid & 3, fr = lane & 15, fq = lane >> 4;
    const int K = g.K;
    unsigned voffA[2], voffB[2];
#pragma unroll
    for (int i = 0; i < 2; ++i) { int R, C; stage_rc(tid * 16 + i * 8192, R, C); const int Rb = Epi::PERM ? ((R & ~31) + perm32(R & 31)) : R;
        voffA[i] = (unsigned)(R * K + C) * 2u; voffB[i] = (unsigned)(Rb * K + C) * 2u; }
    const size_t kstep = (size_t)(BK * 2);
    const size_t hstep = (size_t)HALF * K * 2;
    const size_t tstep = 2 * hstep;
    const unsigned ldsw = (unsigned)wid * 1024u;
    const int aoff = lds_byte(wr * 64 + fr, fq * 8), boff = lds_byte(wc * 32 + fr, fq * 8);
#define PG8_SA(b, h) (((b) * 2 + (h)) * HTB)
#define PG8_SB(b, h) ((4 + (b) * 2 + (h)) * HTB)
#define PG8_STAGE(bufoff, gbase, voff) do { _Pragma("unroll") for (int _i = 0; _i < 2; ++_i) \
        __builtin_amdgcn_global_load_lds((const unsigned*)((const char*)(gbase) + (voff)[_i]), (PG8_LAS unsigned*)(lds + (bufoff) + ldsw + _i * 8192), 16, 0, 0); } while (0)
#define PG8_LDA(dst, b, h) do { _Pragma("unroll") for (int m = 0; m < 4; ++m) _Pragma("unroll") for (int k = 0; k < 2; ++k) dst[m][k] = *(const PG8_LAS bf16x8*)(lds + PG8_SA(b, h) + aoff + m * 2048 + k * 1024); } while (0)
#define PG8_LDB(dst, b, h) do { _Pragma("unroll") for (int n = 0; n < 2; ++n) _Pragma("unroll") for (int k = 0; k < 2; ++k) dst[n][k] = *(const PG8_LAS bf16x8*)(lds + PG8_SB(b, h) + boff + n * 2048 + k * 1024); } while (0)
#define PG8_MMA(ai, bj, At, Bt) do { __builtin_amdgcn_s_setprio(1); _Pragma("unroll") for (int m = 0; m < 4; ++m) _Pragma("unroll") for (int n = 0; n < 2; ++n) _Pragma("unroll") for (int k = 0; k < 2; ++k) \
        acc[ai][bj][m][n] = __builtin_amdgcn_mfma_f32_16x16x32_bf16(Bt[n][k], At[m][k], acc[ai][bj][m][n], 0, 0, 0); __builtin_amdgcn_s_setprio(0); } while (0)
#define PG8_WAIT_V(n) asm volatile("s_waitcnt vmcnt(" #n ")" ::: "memory")
#define PG8_WAIT_L(n) asm volatile("s_waitcnt lgkmcnt(" #n ")" ::: "memory")
#define PG8_BAR __builtin_amdgcn_s_barrier()
#define PG8_SCHED __builtin_amdgcn_sched_barrier(0)
    Unit cur, nxt; int ui = 0;
    if (!S.next(0, cur)) return;
    f32x4 acc[2][2][4][2];
#pragma unroll
    for (int a = 0; a < 2; ++a)
#pragma unroll
        for (int b = 0; b < 2; ++b)
#pragma unroll
            for (int m = 0; m < 4; ++m)
#pragma unroll
                for (int n = 0; n < 2; ++n) acc[a][b][m][n] = (f32x4){0.f, 0.f, 0.f, 0.f};
    bf16x8 At[4][2], B0[2][2], B1[2][2];
    const char* cA = (const char*)g.A + (size_t)cur.pm * tstep + (size_t)cur.kt0 * kstep; const char* cB = (const char*)g.Bt + (size_t)cur.pn * tstep + (size_t)cur.kt0 * kstep;
    S.a_ready(cur);
    if constexpr (SP2) {
        PG8_STAGE(PG8_SB(0, 0), cB, voffB); PG8_STAGE(PG8_SB(0, 1), cB + hstep, voffB); PG8_STAGE(PG8_SA(0, 0), cA, voffA); PG8_STAGE(PG8_SA(0, 1), cA + hstep, voffA);
        if (wr == 1) PG8_BAR;
        PG8_WAIT_V(2); PG8_BAR;
        PG8_STAGE(PG8_SB(1, 0), cB + kstep, voffB); PG8_STAGE(PG8_SA(1, 0), cA + kstep, voffA); PG8_STAGE(PG8_SB(1, 1), cB + hstep + kstep, voffB);
        PG8_WAIT_V(6); PG8_BAR;
    } else {
        PG8_STAGE(PG8_SB(0, 0), cB, voffB); PG8_STAGE(PG8_SA(0, 0), cA, voffA); PG8_STAGE(PG8_SB(0, 1), cB + hstep, voffB); PG8_STAGE(PG8_SA(0, 1), cA + hstep, voffA);
        if (wr == 1) PG8_BAR;
        PG8_WAIT_V(4); PG8_BAR;
        PG8_STAGE(PG8_SB(1, 0), cB + kstep, voffB); PG8_STAGE(PG8_SA(1, 0), cA + kstep, voffA); PG8_STAGE(PG8_SB(1, 1), cB + hstep + kstep, voffB);
        PG8_WAIT_V(6); PG8_BAR;
    }
    for (;;) {
        const bool has_next = S.next(ui + 1, nxt);
        const char* nA = has_next ? (const char*)g.A + (size_t)nxt.pm * tstep + (size_t)nxt.kt0 * kstep : cA; const char* nB = has_next ? (const char*)g.Bt + (size_t)nxt.pn * tstep + (size_t)nxt.kt0 * kstep : cB;
        const int nt = cur.nkt;
        for (int t = 0; t < nt; t += 2) {
            const bool last = (t == nt - 2);
            const char* a1 = cA + (size_t)(t + 1) * kstep;
            const char* a2 = last ? nA : cA + (size_t)(t + 2) * kstep; const char* b2 = last ? nB : cB + (size_t)(t + 2) * kstep;
            const char* a3 = a2 + kstep; const char* b3 = b2 + kstep;
            if (last && has_next) S.a_ready(nxt);
            if constexpr (SP2) {
            PG8_LDB(B0, 0, 0); PG8_LDB(B1, 0, 1); PG8_SCHED; PG8_LDA(At, 0, 0); PG8_STAGE(PG8_SA(1, 1), a1 + hstep, voffA);
            PG8_WAIT_V(8); PG8_WAIT_L(0); PG8_BAR; PG8_MMA(0, 0, At, B0); PG8_MMA(0, 1, At, B1); PG8_BAR; PG8_SCHED;
            PG8_LDA(At, 0, 1); PG8_STAGE(PG8_SB(0, 0), b2, voffB); PG8_STAGE(PG8_SB(0, 1), b2 + hstep, voffB); PG8_STAGE(PG8_SA(0, 0), a2, voffA);
            PG8_WAIT_V(8); PG8_WAIT_L(0); PG8_BAR; PG8_MMA(1, 0, At, B0); PG8_MMA(1, 1, At, B1); PG8_BAR; PG8_SCHED;
            PG8_LDB(B0, 1, 0); PG8_LDB(B1, 1, 1); PG8_SCHED; PG8_LDA(At, 1, 0); PG8_STAGE(PG8_SA(0, 1), a2 + hstep, voffA);
            PG8_WAIT_V(8); PG8_WAIT_L(0); PG8_BAR; PG8_MMA(0, 0, At, B0); PG8_MMA(0, 1, At, B1); PG8_BAR; PG8_SCHED;
            PG8_LDA(At, 1, 1); PG8_STAGE(PG8_SB(1, 0), b3, voffB); PG8_STAGE(PG8_SB(1, 1), b3 + hstep, voffB); PG8_STAGE(PG8_SA(1, 0), a3, voffA);
            PG8_WAIT_V(8); PG8_WAIT_L(0); PG8_BAR; PG8_MMA(1, 0, At, B0); PG8_MMA(1, 1, At, B1); PG8_BAR; PG8_SCHED;
            } else {
            PG8_LDB(B0, 0, 0); PG8_SCHED; PG8_LDA(At, 0, 0); PG8_STAGE(PG8_SA(1, 1), a1 + hstep, voffA);
            PG8_WAIT_L(8); PG8_BAR; PG8_WAIT_L(0); PG8_MMA(0, 0, At, B0); PG8_BAR; PG8_SCHED;
            PG8_LDB(B1, 0, 1); PG8_STAGE(PG8_SB(0, 0), b2, voffB);
            PG8_BAR; PG8_WAIT_L(0); PG8_MMA(0, 1, At, B1); PG8_BAR;
            PG8_LDA(At, 0, 1); PG8_STAGE(PG8_SA(0, 0), a2, voffA);
            PG8_BAR; PG8_WAIT_L(0); PG8_MMA(1, 0, At, B0); PG8_BAR; PG8_SCHED;
            PG8_STAGE(PG8_SB(0, 1), b2 + hstep, voffB);
            PG8_WAIT_V(6); PG8_BAR; PG8_MMA(1, 1, At, B1); PG8_BAR;
            PG8_LDB(B0, 1, 0); PG8_SCHED; PG8_LDA(At, 1, 0); PG8_STAGE(PG8_SA(0, 1), a2 + hstep, voffA);
            PG8_WAIT_L(8); PG8_BAR; PG8_WAIT_L(0); PG8_MMA(0, 0, At, B0); PG8_BAR; PG8_SCHED;
            PG8_LDB(B1, 1, 1); PG8_STAGE(PG8_SB(1, 0), b3, voffB);
            PG8_BAR; PG8_WAIT_L(0); PG8_MMA(0, 1, At, B1); PG8_BAR;
            PG8_LDA(At, 1, 1); PG8_STAGE(PG8_SA(1, 0), a3, voffA);
            PG8_BAR; PG8_WAIT_L(0); PG8_MMA(1, 0, At, B0); PG8_BAR; PG8_SCHED;
            PG8_STAGE(PG8_SB(1, 1), b3 + hstep, voffB);
            PG8_WAIT_V(6); PG8_BAR; PG8_MMA(1, 1, At, B1); PG8_BAR;
            }
        }
        if constexpr (ALIGN_EPI) { if (wr == 0) PG8_BAR; }
        E(acc, cur, wr, wc, fr, fq); S.done(cur);
        if (!has_next) break;
#pragma unroll
        for (int a = 0; a < 2; ++a)
#pragma unroll
            for (int b = 0; b < 2; ++b)
#pragma unroll
                for (int m = 0; m < 4; ++m)
#pragma unroll
                    for (int n = 0; n < 2; ++n) acc[a][b][m][n] = (f32x4){0.f, 0.f, 0.f, 0.f};
        cur = nxt; cA = nA; cB = nB; ++ui;
        if constexpr (ALIGN_EPI) { if (wr == 1) PG8_BAR; }
    }
    PG8_WAIT_V(0);
    if constexpr (!ALIGN_EPI) { if (wr == 0) PG8_BAR; }
    PG8_BAR;
#undef PG8_SA
#undef PG8_SB
#undef PG8_STAGE
#undef PG8_LDA
#undef PG8_LDB
#undef PG8_MMA
#undef PG8_WAIT_V
#undef PG8_WAIT_L
#undef PG8_BAR
#undef PG8_SCHED
}
}

constexpr int NWAVES = 8, NTHR = 512;
constexpr int D = 2048, FF = 8192, PLE = 256;
constexpr int TP = 2048, BP = 4, TS = 4, BS = 128;
constexpr int MP = BP * TP, MS = BS * TS, M = MP + MS;
constexpr int NPROJ = 6160, NPROJ_PAD = 6400;
constexpr int NH = 8;
constexpr float LN_EPS = 1e-5f, RMS_EPS = 1e-6f;
constexpr float DN_ALPHA = 1.41421356237f;

constexpr size_t MiB = 1u << 20;
constexpr size_t WS_CTL = 0;
constexpr size_t WS_WINE = 1 * MiB;
constexpr size_t WS_WOUTE = WS_WINE + 25 * MiB;
constexpr size_t WS_WINO = WS_WOUTE + 8 * MiB;
constexpr size_t WS_WOUTO = WS_WINO + 25 * MiB;
constexpr size_t WS_WUP = WS_WOUTO + 8 * MiB;
constexpr size_t WS_WDOWN = WS_WUP + 64 * MiB;
constexpr size_t WS_WPLE = WS_WDOWN + 64 * MiB;
constexpr size_t WS_WGATE = WS_WPLE + 2 * MiB;
constexpr size_t WS_XB = WS_WGATE + 16 * MiB;
constexpr size_t WS_MIX = WS_XB + 34 * MiB;
constexpr size_t WS_H = WS_MIX + 34 * MiB;
constexpr size_t WS_H2 = WS_H + 34 * MiB;
constexpr size_t WS_PW = WS_H2 + 34 * MiB;
constexpr size_t WS_PB = WS_PW + 34 * MiB;
constexpr size_t WS_GATES = WS_PB + 9 * MiB;
constexpr size_t WS_PROJ = WS_GATES + 1 * MiB;
constexpr size_t WS_PART0 = WS_PROJ + 136 * MiB;
constexpr size_t WS_PART1 = WS_PART0 + 68 * MiB;
constexpr size_t WS_LRUW = WS_PART1 + 68 * MiB;
constexpr size_t WS_END = WS_LRUW + 1 * MiB;
constexpr size_t WS_DG = WS_PART0;
constexpr size_t WS_DB = WS_PART0 + 32 * MiB;
constexpr size_t WS_DS = WS_PART0 + 64 * MiB;
constexpr size_t WS_DQ = WS_PART0 + 96 * MiB;
constexpr size_t WS_DO = WS_PART0 + 112 * MiB;
constexpr size_t WS_DD = WS_PART0 + 128 * MiB;
constexpr size_t WS_DF = WS_PART0 + 129 * MiB;
constexpr size_t WS_MC = WS_PART0;
constexpr size_t WS_MN = WS_PART0 + 64 * MiB;
constexpr size_t WS_MM = WS_PART0 + 65 * MiB;
constexpr size_t WS_LRU_HL = WS_H;
constexpr size_t WS_LRU_P = WS_H + 16 * MiB;
constexpr size_t WS_LRU_END = WS_H + 32 * MiB;

constexpr size_t O_Y = 0;
constexpr size_t O_CONVP = (size_t)M * D;
constexpr size_t O_DELTAP = O_CONVP + (size_t)BP * 3 * 4096;
constexpr size_t O_LRUP = O_DELTAP + (size_t)BP * 8 * 128 * 128;
constexpr size_t O_MCP = O_LRUP + (size_t)BP * 1024;
constexpr size_t O_MNP = O_MCP + (size_t)BP * 8 * 256 * 128;
constexpr size_t O_MMP = O_MNP + (size_t)BP * 8 * 128;
constexpr size_t O_CONVS = O_MMP + (size_t)BP * 8;
constexpr size_t O_DELTAS = O_CONVS + (size_t)BS * 3 * 4096;
constexpr size_t O_LRUS = O_DELTAS + (size_t)BS * 8 * 128 * 128;
constexpr size_t O_MCS = O_LRUS + (size_t)BS * 1024;
constexpr size_t O_MNS = O_MCS + (size_t)BS * 8 * 256 * 128;
constexpr size_t O_MMS = O_MNS + (size_t)BS * 8 * 128;
constexpr size_t O_END = O_MMS + (size_t)BS * 8;

constexpr int LDS_BYTES = 147456;
constexpr int LDS_CTL_OFF = 131072;

#define LAS __attribute__((address_space(3)))
typedef unsigned short bf16;
typedef unsigned v4u __attribute__((ext_vector_type(4)));
typedef unsigned v2u __attribute__((ext_vector_type(2)));
typedef float f32x4 __attribute__((ext_vector_type(4)));
#define LDS_WAIT() asm volatile("s_waitcnt lgkmcnt(0)" ::: "memory")
#define LDS_BARRIER() do { asm volatile("s_waitcnt lgkmcnt(0)" ::: "memory"); __builtin_amdgcn_s_barrier(); asm volatile("" ::: "memory"); } while (0)
__device__ __forceinline__ unsigned pk2(float lo, float hi) { return pg8::cvt_pk_bf16(lo, hi); }
__device__ __forceinline__ unsigned f2bf(float f) { return pg8::cvt_pk_bf16(f, 0.f) & 0xffffu; }
__device__ __forceinline__ float bf2f(unsigned short b) { return __builtin_bit_cast(float, ((unsigned)b) << 16); }
__device__ __forceinline__ float bflo(unsigned w) { return __builtin_bit_cast(float, w << 16); }
__device__ __forceinline__ float bfhi(unsigned w) { return __builtin_bit_cast(float, w & 0xffff0000u); }
__device__ __forceinline__ float fexp(float x) { return __builtin_amdgcn_exp2f(x * 1.4426950408889634f); }
__device__ __forceinline__ float sigm(float x) { return __builtin_amdgcn_rcpf(1.f + fexp(-x)); }
__device__ __forceinline__ float siluf(float x) { return x * sigm(x); }
__device__ __forceinline__ float softplusf(float x) { return fmaxf(x, 0.f) + log1pf(expf(-fabsf(x))); }
__device__ __forceinline__ float logsigf(float x) { return -softplusf(-x); }
__device__ __forceinline__ float neg_expm1(float y) {
    const float ser = -y * (1.f + y * (0.5f + y * (0.16666667f + y * (0.041666668f + y * (0.008333334f + y * 0.0013888889f)))));
    return (y > -0.25f) ? ser : 1.f - fexp(y);
}
__device__ __forceinline__ float gelu_tanh(float x) { const float u = 0.7978845608028654f * (x + 0.044715f * x * x * x); return x * sigm(2.f * u); }
__device__ __forceinline__ float wave_sum(float v) {
#pragma unroll
    for (int o = 1; o < 64; o <<= 1) v += __shfl_xor(v, o);
    return v;
}

__device__ __forceinline__ float wave_incl_sum(float v, int lane) {
#pragma unroll
    for (int o = 1; o < 64; o <<= 1) { const float u = __shfl_up(v, o); if (lane >= o) v += u; }
    return v;
}
__device__ __forceinline__ float wave_incl_max(float v, int lane) {
#pragma unroll
    for (int o = 1; o < 64; o <<= 1) { const float u = __shfl_up(v, o); if (lane >= o) v = fmaxf(v, u); }
    return v;
}
__device__ __forceinline__ float wave_max(float v) {
#pragma unroll
    for (int o = 1; o < 64; o <<= 1) v = fmaxf(v, __shfl_xor(v, o));
    return v;
}
#define XB_TMO      128
#define XB_XCNT(j)  (256  + 64 * (j))
#define XB_XSUB(j)  (1280 + 64 * (j))
#define XB_XGEN(j)  (2304 + 64 * (j))
#define XB_TOP      3328
#define XB_TOPGEN   3392
#define XCD_BAR_WORDS 3456
#define XB_SPIN_CAP (1u << 22)
__device__ __forceinline__ unsigned xb_ld(unsigned* p)              { return __hip_atomic_load(p, __ATOMIC_RELAXED, __HIP_MEMORY_SCOPE_AGENT); }
__device__ __forceinline__ unsigned xb_add(unsigned* p, unsigned v) { return __hip_atomic_fetch_add(p, v, __ATOMIC_RELAXED, __HIP_MEMORY_SCOPE_AGENT); }
__device__ __forceinline__ unsigned xb_xcc_id() { return (unsigned)__builtin_amdgcn_s_getreg((3 << 11) | 20) & 0xFu; }
#define XB_SPIN(cond, bar) do { unsigned _sp = 0; while (cond) { __builtin_amdgcn_s_sleep(1); \
    if ((++_sp & 255u) == 0u) { if (xb_ld(&(bar)[XB_TMO])) break; if (_sp > XB_SPIN_CAP) { atomicAdd(&(bar)[XB_TMO], 1u); break; } } } } while (0)
struct XcdBarrier { unsigned* bar; unsigned x; volatile LAS unsigned* st; };
__device__ __forceinline__ XcdBarrier xcd_barrier_post(unsigned* bar, volatile LAS unsigned* st) {
    XcdBarrier b; b.bar = bar; b.x = xb_xcc_id(); b.st = st;
    if (threadIdx.x == 0) (void)xb_add(&bar[XB_XCNT(b.x)], 1u);
    return b;
}
__device__ __forceinline__ void xcd_barrier_complete(unsigned* bar, unsigned x, unsigned& nloc, unsigned& nx) {
    const unsigned G = gridDim.x * gridDim.y * gridDim.z;
    unsigned sum, cnt, mine, sp = 0u;
    for (;;) {
        sum = 0u; cnt = 0u; mine = 0u;
#pragma unroll
        for (unsigned j = 0; j < 16; ++j) { const unsigned c = xb_ld(&bar[XB_XCNT(j)]); sum += c; cnt += (c > 0u) ? 1u : 0u; mine = (j == x) ? c : mine; }
        if (sum == G) break;
        __builtin_amdgcn_s_sleep(1);
        if ((++sp & 255u) == 0u) { if (xb_ld(&bar[XB_TMO])) break; if (sp > XB_SPIN_CAP) { atomicAdd(&bar[XB_TMO], 1u); break; } }
    }
    nloc = mine > 0u ? mine : 1u; nx = cnt > 0u ? cnt : 1u;
}
__device__ __forceinline__ void xcd_barrier(const XcdBarrier& b) {
    asm volatile("s_waitcnt vmcnt(0)" ::: "memory");
    __syncthreads();
    if (threadIdx.x == 0) {
        unsigned* bar = b.bar;
        __builtin_amdgcn_s_waitcnt(0);
        unsigned nloc = b.st[0], nx = b.st[1];
        if (nloc == 0u) { xcd_barrier_complete(bar, b.x, nloc, nx); b.st[0] = nloc; b.st[1] = nx; }
        const unsigned old = xb_add(&bar[XB_XSUB(b.x)], 1u);
        const unsigned gen = old / nloc;
        if (old + 1u == (gen + 1u) * nloc) {
            __builtin_amdgcn_fence(__ATOMIC_RELEASE, "agent");
            asm volatile("s_waitcnt vmcnt(0)" ::: "memory");
            const unsigned og = xb_add(&bar[XB_TOP], 1u);
            const unsigned tg = og / nx;
            if (og + 1u == (tg + 1u) * nx) xb_add(&bar[XB_TOPGEN], 1u);
            else XB_SPIN(xb_ld(&bar[XB_TOPGEN]) == tg, bar);
            __builtin_amdgcn_fence(__ATOMIC_ACQUIRE, "agent");
            xb_add(&bar[XB_XGEN(b.x)], 1u);
            asm volatile("s_waitcnt vmcnt(0)" ::: "memory");
        } else {
            XB_SPIN(xb_ld(&bar[XB_XGEN(b.x)]) == gen, bar);
            __builtin_amdgcn_fence(__ATOMIC_ACQUIRE, "agent");
            asm volatile("s_waitcnt vmcnt(0)" ::: "memory");
        }
    }
    __syncthreads();
}

struct Args { const float* in[35]; float* out; unsigned char* ws; int ph_lo, ph_hi; };
typedef const __attribute__((address_space(4))) Args* ArgsP;
enum { I_XP = 0, I_XS, I_PP, I_PS, I_SCONV, I_SDELTA, I_SLRU, I_SMC, I_SMN, I_SMM, I_WINE, I_WCONV, I_BCONV, I_ALOG, I_DTB, I_DNORM, I_LWR, I_LBR, I_LWI, I_LBI, I_LLAM, I_WOUTE,
       I_WINO, I_BIG, I_BFG, I_MNORM, I_WOUTO, I_LN1G, I_LN1B, I_LN2G, I_LN2B, I_WUP, I_WDOWN, I_WPLE, I_WGATE };

struct TDesc { const float* W; bf16* WT; int K, N, Npad, item; };
__device__ __forceinline__ void t_load(const TDesc& d, int lane, f32x4 (&v)[8]) {
    const int nblk = d.Npad / 32, kb = d.item / nblk, nb = d.item % nblk, k0 = 64 * kb, n0 = 32 * nb;
    const int r8 = lane >> 3, c4 = lane & 7; const bool ok = (n0 + 4 * c4) < d.N;
#pragma unroll
    for (int i = 0; i < 8; ++i) v[i] = ok ? __builtin_nontemporal_load((const f32x4*)(d.W + (size_t)(k0 + 8 * r8 + i) * d.N + n0 + 4 * c4)) : (f32x4){0.f, 0.f, 0.f, 0.f};
}
__device__ __forceinline__ void t_finish(const TDesc& d, LAS float*  , int lane, const f32x4 (&v)[8]) {
    const int nblk = d.Npad / 32, kb = d.item / nblk, nb = d.item % nblk, k0 = 64 * kb, n0 = 32 * nb;
    const int r8 = lane >> 3, c4 = lane & 7;
    bf16* o = d.WT + (size_t)(n0 + 4 * c4) * d.K + k0 + 8 * r8;
    *(v4u*)(o) = (v4u){pk2(v[0].x, v[1].x), pk2(v[2].x, v[3].x), pk2(v[4].x, v[5].x), pk2(v[6].x, v[7].x)};
    *(v4u*)(o + (size_t)d.K) = (v4u){pk2(v[0].y, v[1].y), pk2(v[2].y, v[3].y), pk2(v[4].y, v[5].y), pk2(v[6].y, v[7].y)};
    *(v4u*)(o + 2 * (size_t)d.K) = (v4u){pk2(v[0].z, v[1].z), pk2(v[2].z, v[3].z), pk2(v[4].z, v[5].z), pk2(v[6].z, v[7].z)};
    *(v4u*)(o + 3 * (size_t)d.K) = (v4u){pk2(v[0].w, v[1].w), pk2(v[2].w, v[3].w), pk2(v[4].w, v[5].w), pk2(v[6].w, v[7].w)};
}
__device__ __forceinline__ void p0_transpose_item(const float* W, int K, int N, int Npad, bf16* WT, LAS float* scr, int item, int lane) {
    const TDesc d{W, WT, K, N, Npad, item}; f32x4 v[8]; t_load(d, lane, v); t_finish(d, scr, lane, v);
}
template <int N> __device__ __forceinline__ void row_to_bf16(const float* src, bf16* dst, int lane) {
    f32x4 v[N / 256];
#pragma unroll
    for (int j = 0; j < N / 256; ++j) v[j] = __builtin_nontemporal_load((const f32x4*)(src + j * 256 + lane * 4));
#pragma unroll
    for (int j = 0; j < N / 256; ++j) { v2u o; o.x = pk2(v[j].x, v[j].y); o.y = pk2(v[j].z, v[j].w); *(v2u*)(dst + j * 256 + lane * 4) = o; }
}
namespace cv { constexpr int I_IN = (D / 64) * (NPROJ_PAD / 32), I_SQ = (D / 64) * (D / 32), I_UP = (D / 64) * (FF / 32), I_DN = (FF / 64) * (D / 32), I_PL = (PLE / 64) * (D / 32);
               constexpr int N_FIRST = I_IN + I_PL + 128, N_REST = I_IN + 2 * I_SQ + 2 * I_UP + 2 * I_DN + I_PL + 2 * I_SQ;
               constexpr int R_IN0 = 6200;
               constexpr int R_G1 = I_SQ + I_UP + I_SQ + I_IN + I_SQ + I_PL + I_SQ;
               constexpr int R_IN1 = R_G1 + I_UP;
               constexpr int R_SCAN = R_IN1 - 6200;
               constexpr int R_UP0 = R_IN1 + I_DN;
               static_assert(R_UP0 + I_DN == N_REST && R_SCAN > R_G1 && R_SCAN > R_IN0, "conversion ranges"); }
__device__ __forceinline__ void convert_first_item(ArgsP a, LAS float* scr, int r, int lane) {
    unsigned char* ws = a->ws;
    if (r < cv::I_IN) { p0_transpose_item(a->in[I_WINE], D, NPROJ, NPROJ_PAD, (bf16*)(ws + WS_WINE), scr, r, lane); return; } r -= cv::I_IN;
    if (r < cv::I_PL) { p0_transpose_item(a->in[I_WPLE], PLE, D, D, (bf16*)(ws + WS_WPLE), scr, r, lane); return; } r -= cv::I_PL;
    { const int mat = r / 64, blk = (r / 8) & 7; p0_transpose_item(a->in[mat == 0 ? I_LWR : I_LWI] + (size_t)blk * 16384, 128, 128, 128, (bf16*)(ws + WS_LRUW) + (size_t)(mat * 8 + blk) * 16384, scr, r % 8, lane); }
}
__device__ __forceinline__ TDesc decode_rest(ArgsP a, int r) {
    using namespace cv; unsigned char* ws = a->ws;
    if (r < I_SQ) return TDesc{a->in[I_WOUTE], (bf16*)(ws + WS_WOUTE), D, D, D, r}; r -= I_SQ;
    if (r < I_UP) return TDesc{a->in[I_WUP], (bf16*)(ws + WS_WUP), D, FF, FF, r}; r -= I_UP;
    if (r < I_SQ) return TDesc{a->in[I_WGATE], (bf16*)(ws + WS_WGATE), D, D, D, r}; r -= I_SQ;
    if (r < I_IN) return TDesc{a->in[I_WINO], (bf16*)(ws + WS_WINO), D, NPROJ, NPROJ_PAD, r}; r -= I_IN;
    if (r < I_SQ) return TDesc{a->in[I_WOUTO], (bf16*)(ws + WS_WOUTO), D, D, D, r}; r -= I_SQ;
    if (r < I_PL) return TDesc{a->in[I_WPLE] + (size_t)PLE * D, (bf16*)(ws + WS_WPLE) + (size_t)PLE * D, PLE, D, D, r}; r -= I_PL;
    if (r < I_SQ) return TDesc{a->in[I_WGATE] + (size_t)D * D, (bf16*)(ws + WS_WGATE) + (size_t)D * D, D, D, D, r}; r -= I_SQ;
    if (r < I_UP) return TDesc{a->in[I_WUP] + (size_t)D * FF, (bf16*)(ws + WS_WUP) + (size_t)D * FF, D, FF, FF, r}; r -= I_UP;
    if (r < I_DN) return TDesc{a->in[I_WDOWN], (bf16*)(ws + WS_WDOWN), FF, D, D, r}; r -= I_DN;
    return TDesc{a->in[I_WDOWN] + (size_t)D * FF, (bf16*)(ws + WS_WDOWN) + (size_t)D * FF, FF, D, D, r};
}
__device__ __forceinline__ void convert_range(ArgsP a, LAS float* scr, int first, int last, int widx, int nw, int lane) {
    int it = first + widx;
    TDesc dA, dB; f32x4 vA[8], vB[8];
    if (it < last) { dA = decode_rest(a, it); t_load(dA, lane, vA);
#pragma unroll 1
        for (;;) {
            const int itB = it + nw; const bool hasB = itB < last;
            if (hasB) { dB = decode_rest(a, itB); t_load(dB, lane, vB); }
            t_finish(dA, scr, lane, vA);
            if (!hasB) break;
            it = itB + nw; const bool hasA = it < last;
            if (hasA) { dA = decode_rest(a, it); t_load(dA, lane, vA); }
            t_finish(dB, scr, lane, vB);
            if (!hasA) break;
        } }
}
__device__ __forceinline__ void phase_convert(ArgsP a, LAS unsigned char* lds, int gw, int NGW, int wave, int lane) {
    unsigned char* ws = a->ws;
    LAS float* scr = (LAS float*)(lds + wave * 16384);
    for (int it = gw; it < cv::N_FIRST; it += NGW) convert_first_item(a, scr, it, lane);
    bf16* xb = (bf16*)(ws + WS_XB);
    for (int m = gw; m < M; m += NGW) {
        const float* src = m < MP ? a->in[I_XP] + (size_t)m * D : a->in[I_XS] + (size_t)(m - MP) * D;
        row_to_bf16<D>(src, xb + (size_t)m * D, lane);
    }
    bf16* pb = (bf16*)(ws + WS_PB);
    for (int r = gw; r < 2 * M; r += NGW) {
        const int l = r / M, m = r % M;
        const float* src = m < MP ? a->in[I_PP] + ((size_t)l * MP + m) * PLE : a->in[I_PS] + ((size_t)l * MS + (m - MP)) * PLE;
        row_to_bf16<PLE>(src, pb + (size_t)r * PLE, lane);
    }
}

__device__ __forceinline__ float conv_in(const bf16* proj, int row0, int tq, int ch, const float* cstate) {
    if (tq >= 0) return bf2f(proj[(size_t)(row0 + tq) * NPROJ_PAD + ch]);
    return cstate ? cstate[(3 + tq) * 4096 + ch] : 0.f;
}
__device__ __forceinline__ float conv4(const bf16* proj, int row0, int t, int ch, const float* cstate, const float* wconv, const float* bconv) {
    float acc = bconv[ch];
#pragma unroll
    for (int j = 0; j < 4; ++j) acc += wconv[j * 4096 + ch] * conv_in(proj, row0, t - 3 + j, ch, cstate);
    return acc;
}

__device__ __forceinline__ void delta_rec_item(ArgsP a, LAS unsigned char* lds, int row0, int T, int h, const float* cstate, const float* S0, float* Sout, const int tid) {
    const int lane = tid & 63, wave = tid >> 6, c = tid & 127, r = tid >> 7;
    const bf16* proj = (const bf16*)(a->ws + WS_PROJ); const float* gates = (const float*)(a->ws + WS_GATES); bf16* mix = (bf16*)(a->ws + WS_MIX);
    const float* wconv = a->in[I_WCONV]; const float* bconv = a->in[I_BCONV];
    LAS float* act = (LAS float*)lds;
    LAS float* nrm = act + 4 * 384;
    LAS float* gb = nrm + 8;
    LAS float* red = gb + 8;
    LAS float* red2 = red + 512;
    LAS float* obuf = red2 + 512;
    float s[32];
#pragma unroll
    for (int i = 0; i < 32; ++i) s[i] = S0 ? S0[(size_t)(32 * r + i) * 128 + c] : 0.f;
    const float aexp = fexp(a->in[I_ALOG][h]), dtb = a->in[I_DTB][h];
#pragma unroll 1
    for (int t0 = 0; t0 < T; t0 += 4) {
#pragma unroll
        for (int j = 0; j < 3; ++j) { const int idx = tid + 512 * j, tok = idx / 384, chl = idx % 384, part = chl >> 7, i = chl & 127;
            const int ch = part * 1024 + h * 128 + i;
            act[tok * 384 + chl] = siluf(conv4(proj, row0, t0 + tok, ch, cstate, wconv, bconv)); }
        LDS_BARRIER();
        { const int tok = wave >> 1, part = wave & 1; const float x0 = act[tok * 384 + part * 128 + lane], x1 = act[tok * 384 + part * 128 + 64 + lane];
          const float ss = wave_sum(x0 * x0 + x1 * x1); if (lane == 0) nrm[tok * 2 + part] = rsqrtf(ss + 1e-6f) * (part == 0 ? 0.08838834764831845f : 1.f); }
        if (tid < 4) { const int row = row0 + t0 + tid; const float g = -aexp * softplusf(gates[(size_t)row * 16 + h] + dtb); gb[tid * 2] = fexp(g); gb[tid * 2 + 1] = sigm(gates[(size_t)row * 16 + 8 + h]); }
        LDS_BARRIER();
#pragma unroll 1
        for (int tok = 0; tok < 4; ++tok) {
            const float eg = gb[tok * 2], beta = gb[tok * 2 + 1], nq = nrm[tok * 2], nk = nrm[tok * 2 + 1];
            const LAS float* qv = act + tok * 384 + 32 * r; const LAS float* kv = qv + 128;
            float ks = 0.f;
#pragma unroll
            for (int i = 0; i < 32; ++i) ks += kv[i] * s[i];
            red[r * 128 + c] = ks * nk;
            LDS_BARRIER();
            const float kS = red[c] + red[128 + c] + red[256 + c] + red[384 + c];
            const float vnew = beta * (act[tok * 384 + 256 + c] - eg * kS);
            float os = 0.f;
#pragma unroll
            for (int i = 0; i < 32; ++i) { s[i] = eg * s[i] + (kv[i] * nk) * vnew; os += qv[i] * s[i]; }
            red2[r * 128 + c] = os * nq;
            LDS_BARRIER();
            if (r == 0) obuf[tok * 128 + c] = red2[c] + red2[128 + c] + red2[256 + c] + red2[384 + c];
        }
        LDS_BARRIER();
        if (wave < 4) { const int tok = wave, row = row0 + t0 + tok; const float o0 = obuf[tok * 128 + lane], o1 = obuf[tok * 128 + 64 + lane];
            const float rstd = rsqrtf(wave_sum(o0 * o0 + o1 * o1) * (1.f / 128.f) + RMS_EPS);
            const float* nw = a->in[I_DNORM];
            const float z0 = bf2f(proj[(size_t)row * NPROJ_PAD + 4096 + h * 128 + lane]), z1 = bf2f(proj[(size_t)row * NPROJ_PAD + 4096 + h * 128 + 64 + lane]);
            mix[(size_t)row * D + h * 128 + lane] = (bf16)f2bf(o0 * rstd * nw[lane] * siluf(z0));
            mix[(size_t)row * D + h * 128 + 64 + lane] = (bf16)f2bf(o1 * rstd * nw[64 + lane] * siluf(z1)); }
        LDS_BARRIER();
    }
#pragma unroll
    for (int i = 0; i < 32; ++i) Sout[(size_t)(32 * r + i) * 128 + c] = s[i];
}


typedef short bf16x8 __attribute__((ext_vector_type(8)));
#define MFMA32(a_, b_, c_) __builtin_amdgcn_mfma_f32_16x16x32_bf16(a_, b_, c_, 0, 0, 0)

__device__ __forceinline__ void lru_prep_item(ArgsP a, LAS unsigned char* lds, int item, const int tid) {
    const int c = item & 31, n = (item >> 5) & 7, b = item >> 8;
    const int lane = tid & 63, w = __builtin_amdgcn_readfirstlane(tid >> 6), fr = lane & 15, fq = lane >> 4;
    unsigned char* ws = a->ws;
    const bf16* proj = (const bf16*)(ws + WS_PROJ);
    LAS bf16* xa = (LAS bf16*)lds;
    LAS float* xf = (LAS float*)(lds + 17408);
    LAS float* obH = (LAS float*)(lds + 51200);
    LAS float* obP = obH + 64 * 132;
    {
        const int t = tid >> 3, sub = tid & 7, ch0 = 3072 + n * 128 + sub * 16;
        const float* wconv = a->in[I_WCONV]; const float* bconv = a->in[I_BCONV];
        float x[16];
#pragma unroll
        for (int i = 0; i < 4; ++i) { const f32x4 bb = *(const f32x4*)(bconv + ch0 + 4 * i); x[4 * i] = bb.x; x[4 * i + 1] = bb.y; x[4 * i + 2] = bb.z; x[4 * i + 3] = bb.w; }
#pragma unroll
        for (int j = 0; j < 4; ++j) { const int tt = 64 * c + t - 3 + j;
            if (tt >= 0) { const bf16* pr = proj + (size_t)(b * TP + tt) * NPROJ_PAD + ch0; const v4u u0 = *(const v4u*)pr, u1 = *(const v4u*)(pr + 8);
                const unsigned uu[8] = {u0.x, u0.y, u0.z, u0.w, u1.x, u1.y, u1.z, u1.w};
#pragma unroll
                for (int i = 0; i < 4; ++i) { const f32x4 ww = *(const f32x4*)(wconv + j * 4096 + ch0 + 4 * i);
                    x[4 * i] += ww.x * bflo(uu[2 * i]); x[4 * i + 1] += ww.y * bfhi(uu[2 * i]); x[4 * i + 2] += ww.z * bflo(uu[2 * i + 1]); x[4 * i + 3] += ww.w * bfhi(uu[2 * i + 1]); } } }
        v4u o0, o1; o0.x = pk2(x[0], x[1]); o0.y = pk2(x[2], x[3]); o0.z = pk2(x[4], x[5]); o0.w = pk2(x[6], x[7]); o1.x = pk2(x[8], x[9]); o1.y = pk2(x[10], x[11]); o1.z = pk2(x[12], x[13]); o1.w = pk2(x[14], x[15]);
        *(LAS v4u*)(xa + t * 136 + sub * 16) = o0; *(LAS v4u*)(xa + t * 136 + sub * 16 + 8) = o1;
#pragma unroll
        for (int i = 0; i < 4; ++i) *(LAS f32x4*)(xf + t * 132 + sub * 16 + 4 * i) = (f32x4){x[4 * i], x[4 * i + 1], x[4 * i + 2], x[4 * i + 3]};
    }
    LDS_BARRIER();
    const bf16* wrT = (const bf16*)(ws + WS_LRUW) + (size_t)n * 16384; const bf16* wiT = wrT + 8 * 16384;
    bf16x8 br[4], bi[4];
#pragma unroll
    for (int ks = 0; ks < 4; ++ks) { br[ks] = *(const bf16x8*)(wrT + (16 * w + fr) * 128 + 32 * ks + 8 * fq); bi[ks] = *(const bf16x8*)(wiT + (16 * w + fr) * 128 + 32 * ks + 8 * fq); }
    f32x4 accr[4], acci[4];
#pragma unroll
    for (int tb = 0; tb < 4; ++tb) { accr[tb] = (f32x4){0.f, 0.f, 0.f, 0.f}; acci[tb] = (f32x4){0.f, 0.f, 0.f, 0.f};
#pragma unroll
        for (int ks = 0; ks < 4; ++ks) { const bf16x8 af = *(const LAS bf16x8*)(xa + (16 * tb + fr) * 136 + 32 * ks + 8 * fq); accr[tb] = MFMA32(af, br[ks], accr[tb]); acci[tb] = MFMA32(af, bi[ks], acci[tb]); } }
    const int dl = 16 * w + fr, chn = n * 128 + dl;
    const float brs = a->in[I_LBR][chn], bis = a->in[I_LBI][chn], spl = softplusf(-a->in[I_LLAM][chn]);
    float Apre = 1.f, Hpre = 0.f;
#pragma unroll
    for (int tb = 0; tb < 4; ++tb) {
        float P[4], Hh[4];
#pragma unroll
        for (int j = 0; j < 4; ++j) { const int t = 16 * tb + 4 * fq + j;
            const float log_a = -8.f * sigm(accr[tb][j] + brs) * spl; const float av = fexp(log_a);
            const float bx = sqrtf(neg_expm1(2.f * log_a)) * sigm(acci[tb][j] + bis) * xf[t * 132 + dl];
            if (j == 0) { P[0] = av; Hh[0] = bx; } else { P[j] = P[j - 1] * av; Hh[j] = av * Hh[j - 1] + bx; } }
        float Ai = P[3], Hi = Hh[3];
        { const float A2 = __shfl_up(Ai, 16), H2 = __shfl_up(Hi, 16); if (fq >= 1) { Hi = Ai * H2 + Hi; Ai = A2 * Ai; } }
        { const float A2 = __shfl_up(Ai, 32), H2 = __shfl_up(Hi, 32); if (fq >= 2) { Hi = Ai * H2 + Hi; Ai = A2 * Ai; } }
        float Aex = __shfl_up(Ai, 16), Hex = __shfl_up(Hi, 16); if (fq == 0) { Aex = 1.f; Hex = 0.f; }
        const float Atb = __shfl(Ai, 48 + fr), Htb = __shfl(Hi, 48 + fr);
        const float EA = Apre * Aex, EH = Aex * Hpre + Hex;
#pragma unroll
        for (int j = 0; j < 4; ++j) { const int t = 16 * tb + 4 * fq + j; obP[t * 132 + dl] = EA * P[j]; obH[t * 132 + dl] = P[j] * EH + Hh[j]; }
        Hpre = Atb * Hpre + Htb; Apre = Apre * Atb;
    }
    if (fq == 0) { float* e = (float*)(ws + WS_LRU_END) + (size_t)item * 256; e[dl] = Apre; e[128 + dl] = Hpre; }
    LDS_BARRIER();
    {
        const int t = tid >> 3, sub = tid & 7;
        bf16* hl = (bf16*)(ws + WS_LRU_HL) + ((size_t)item * 64 + t) * 128 + sub * 16; bf16* pp = (bf16*)(ws + WS_LRU_P) + ((size_t)item * 64 + t) * 128 + sub * 16;
        const LAS float* sh = obH + t * 132 + sub * 16; const LAS float* sp = obP + t * 132 + sub * 16;
        v4u o0, o1;
        o0.x = pk2(sh[0], sh[1]); o0.y = pk2(sh[2], sh[3]); o0.z = pk2(sh[4], sh[5]); o0.w = pk2(sh[6], sh[7]); o1.x = pk2(sh[8], sh[9]); o1.y = pk2(sh[10], sh[11]); o1.z = pk2(sh[12], sh[13]); o1.w = pk2(sh[14], sh[15]);
        *(v4u*)hl = o0; *(v4u*)(hl + 8) = o1;
        o0.x = pk2(sp[0], sp[1]); o0.y = pk2(sp[2], sp[3]); o0.z = pk2(sp[4], sp[5]); o0.w = pk2(sp[6], sp[7]); o1.x = pk2(sp[8], sp[9]); o1.y = pk2(sp[10], sp[11]); o1.z = pk2(sp[12], sp[13]); o1.w = pk2(sp[14], sp[15]);
        *(v4u*)pp = o0; *(v4u*)(pp + 8) = o1;
    }
    LDS_BARRIER();
}
__device__ __forceinline__ void lru_out_item(ArgsP a, LAS unsigned char* lds, int item, const int tid) {
    const int c = item & 31, n = (item >> 5) & 7, b = item >> 8;
    unsigned char* ws = a->ws;
    LAS float* carry = (LAS float*)lds;
    if (tid < 128) { float cr = 0.f; const float* e = (const float*)(ws + WS_LRU_END) + (size_t)(item - c) * 256;
        float pv[31], hv_[31];
#pragma unroll
        for (int k = 0; k < 31; ++k) { const bool on = k < c; pv[k] = on ? e[k * 256 + tid] : 1.f; hv_[k] = on ? e[k * 256 + 128 + tid] : 0.f; }
#pragma unroll
        for (int k = 0; k < 31; ++k) cr = hv_[k] + pv[k] * cr;
        carry[tid] = cr; }
    LDS_BARRIER();
    const int t = tid >> 3, sub = tid & 7, d0 = sub * 16, row = b * TP + 64 * c + t;
    const bf16* hl = (const bf16*)(ws + WS_LRU_HL) + ((size_t)item * 64 + t) * 128 + d0; const bf16* pp = (const bf16*)(ws + WS_LRU_P) + ((size_t)item * 64 + t) * 128 + d0;
    const bf16* gp = (const bf16*)(ws + WS_PROJ) + (size_t)row * NPROJ_PAD + 5120 + n * 128 + d0;
    const v4u h0 = *(const v4u*)hl, h1 = *(const v4u*)(hl + 8), p0 = *(const v4u*)pp, p1 = *(const v4u*)(pp + 8), g0 = *(const v4u*)gp, g1 = *(const v4u*)(gp + 8);
    const unsigned hu[8] = {h0.x, h0.y, h0.z, h0.w, h1.x, h1.y, h1.z, h1.w}, pu[8] = {p0.x, p0.y, p0.z, p0.w, p1.x, p1.y, p1.z, p1.w}, gu[8] = {g0.x, g0.y, g0.z, g0.w, g1.x, g1.y, g1.z, g1.w};
    float hv[16]; unsigned ou[8];
#pragma unroll
    for (int i = 0; i < 8; ++i) { hv[2 * i] = bflo(hu[i]) + bflo(pu[i]) * carry[d0 + 2 * i]; hv[2 * i + 1] = bfhi(hu[i]) + bfhi(pu[i]) * carry[d0 + 2 * i + 1];
        ou[i] = pk2(hv[2 * i] * gelu_tanh(bflo(gu[i])), hv[2 * i + 1] * gelu_tanh(bfhi(gu[i]))); }
    bf16* mp = (bf16*)(ws + WS_MIX) + (size_t)row * D + 1024 + n * 128 + d0;
    *(v4u*)mp = (v4u){ou[0], ou[1], ou[2], ou[3]}; *(v4u*)(mp + 8) = (v4u){ou[4], ou[5], ou[6], ou[7]};
    if (c == 31 && t == 63) { float* o = a->out + O_LRUP + (size_t)b * 1024 + n * 128 + d0;
#pragma unroll
        for (int i = 0; i < 4; ++i) *(f32x4*)(o + 4 * i) = (f32x4){hv[4 * i], hv[4 * i + 1], hv[4 * i + 2], hv[4 * i + 3]}; }
    LDS_BARRIER();
}


__device__ __forceinline__ void conv16_load(const bf16* proj, int b, int tseq, int ch0, v4u (&u)[8]) {
#pragma unroll
    for (int j = 0; j < 4; ++j) { const int tt = tseq - 3 + j;
        if (tt >= 0) { const bf16* pr = proj + (size_t)(b * TP + tt) * NPROJ_PAD + ch0; u[2 * j] = *(const v4u*)pr; u[2 * j + 1] = *(const v4u*)(pr + 8); }
        else { u[2 * j] = (v4u){0u, 0u, 0u, 0u}; u[2 * j + 1] = (v4u){0u, 0u, 0u, 0u}; } }
}
__device__ __forceinline__ void conv16_compute(const v4u (&u)[8], const float* wconv, const float* bconv, int ch0, float (&x)[16]) {
#pragma unroll
    for (int i = 0; i < 4; ++i) { const f32x4 bb = *(const f32x4*)(bconv + ch0 + 4 * i); x[4 * i] = bb.x; x[4 * i + 1] = bb.y; x[4 * i + 2] = bb.z; x[4 * i + 3] = bb.w; }
#pragma unroll
    for (int j = 0; j < 4; ++j) { const unsigned uu[8] = {u[2 * j].x, u[2 * j].y, u[2 * j].z, u[2 * j].w, u[2 * j + 1].x, u[2 * j + 1].y, u[2 * j + 1].z, u[2 * j + 1].w};
#pragma unroll
        for (int i = 0; i < 4; ++i) { const f32x4 ww = *(const f32x4*)(wconv + j * 4096 + ch0 + 4 * i);
            x[4 * i] += ww.x * bflo(uu[2 * i]); x[4 * i + 1] += ww.y * bfhi(uu[2 * i]); x[4 * i + 2] += ww.z * bflo(uu[2 * i + 1]); x[4 * i + 3] += ww.w * bfhi(uu[2 * i + 1]); } }
}
__device__ __forceinline__ void conv16_prompt(const bf16* proj, const float* wconv, const float* bconv, int b, int tseq, int ch0, float (&x)[16]) {
    v4u u[8]; conv16_load(proj, b, tseq, ch0, u); conv16_compute(u, wconv, bconv, ch0, x);
}
__device__ __forceinline__ void st16_bf16(LAS bf16* p, const float (&x)[16]) {
    v4u o0, o1; o0.x = pk2(x[0], x[1]); o0.y = pk2(x[2], x[3]); o0.z = pk2(x[4], x[5]); o0.w = pk2(x[6], x[7]); o1.x = pk2(x[8], x[9]); o1.y = pk2(x[10], x[11]); o1.z = pk2(x[12], x[13]); o1.w = pk2(x[14], x[15]);
    *(LAS v4u*)p = o0; *(LAS v4u*)(p + 8) = o1;
}
__device__ __forceinline__ v2u pack4(const f32x4 v) { v2u o; o.x = pk2(v.x, v.y); o.y = pk2(v.z, v.w); return o; }
__device__ __forceinline__ bf16x8 zero8() { return (bf16x8){0, 0, 0, 0, 0, 0, 0, 0}; }

__device__ __forceinline__ void delta_prep_item(ArgsP a, LAS unsigned char* lds, int item, const int tid) {
    const int c = item & 31, h = (item >> 5) & 7, b = item >> 8;
    const int lane = tid & 63, w = __builtin_amdgcn_readfirstlane(tid >> 6), fr = lane & 15, fq = lane >> 4;
    unsigned char* ws = a->ws;
    const bf16* proj = (const bf16*)(ws + WS_PROJ);
    LAS bf16* Kn = (LAS bf16*)lds;
    LAS bf16* Qn = (LAS bf16*)(lds + 17408);
    LAS bf16* KdT = (LAS bf16*)(lds + 34816);
    LAS bf16* RX = (LAS bf16*)(lds + 53248);
    LAS bf16* Mm = (LAS bf16*)(lds + 90112);
    LAS bf16* QKd = (LAS bf16*)(lds + 99328);
    LAS bf16* Td = (LAS bf16*)(lds + 108544);
    LAS bf16* RT = (LAS bf16*)(lds + 111616) + w * 768;
    LAS float* gl = (LAS float*)(lds + 123904);
    LAS float* gcs = gl + 64;
    LAS float* bet = gcs + 64;
    const int t = tid >> 3, sub = tid & 7;
    float gc_t, glast_t, beta_t;
    {
        const float* gt = (const float*)(ws + WS_GATES) + (size_t)(b * TP + 64 * c + lane) * 16;
        const float gv = -fexp(a->in[I_ALOG][h]) * softplusf(gt[h] + a->in[I_DTB][h]), bv = sigm(gt[8 + h]);
        const float gcv = wave_incl_sum(gv, lane);
        if (w == 0) { gl[lane] = gv; gcs[lane] = gcv; bet[lane] = bv; }
        gc_t = __shfl(gcv, t); glast_t = __shfl(gcv, 63); beta_t = __shfl(bv, t);
    }
    {
        const float* wconv = a->in[I_WCONV]; const float* bconv = a->in[I_BCONV];
        const float gc = gc_t, glast = glast_t, beta = beta_t;
        const float ec = fexp(gc), ed = fexp(glast - gc);
        float x[16], y[16];
        conv16_prompt(proj, wconv, bconv, b, 64 * c + t, 1024 + h * 128 + sub * 16, x);
        float ss = 0.f;
#pragma unroll
        for (int i = 0; i < 16; ++i) { x[i] = siluf(x[i]); ss += x[i] * x[i]; }
        ss += __shfl_xor(ss, 1); ss += __shfl_xor(ss, 2); ss += __shfl_xor(ss, 4);
        const float rk = rsqrtf(ss + 1e-6f);
#pragma unroll
        for (int i = 0; i < 16; ++i) x[i] *= rk;
        st16_bf16(Kn + t * 136 + sub * 16, x);
#pragma unroll
        for (int i = 0; i < 16; ++i) KdT[(sub * 16 + i) * 72 + t] = (bf16)f2bf(x[i] * ed);
#pragma unroll
        for (int i = 0; i < 16; ++i) y[i] = x[i] * (beta * ec);
        st16_bf16(RX + t * 264 + 128 + sub * 16, y);
        conv16_prompt(proj, wconv, bconv, b, 64 * c + t, h * 128 + sub * 16, x);
        ss = 0.f;
#pragma unroll
        for (int i = 0; i < 16; ++i) { x[i] = siluf(x[i]); ss += x[i] * x[i]; }
        ss += __shfl_xor(ss, 1); ss += __shfl_xor(ss, 2); ss += __shfl_xor(ss, 4);
        const float rq = rsqrtf(ss + 1e-6f) * 0.08838834764831845f;
#pragma unroll
        for (int i = 0; i < 16; ++i) x[i] *= rq;
        st16_bf16(Qn + t * 136 + sub * 16, x);
        conv16_prompt(proj, wconv, bconv, b, 64 * c + t, 2048 + h * 128 + sub * 16, x);
#pragma unroll
        for (int i = 0; i < 16; ++i) x[i] = siluf(x[i]) * beta;
        st16_bf16(RX + t * 264 + sub * 16, x);
    }
    LDS_BARRIER();
    {
        const int ib = w >> 1;
#pragma unroll
        for (int jj = 0; jj < 2; ++jj) { const int jb = 2 * (w & 1) + jj;
            f32x4 ak = (f32x4){0.f, 0.f, 0.f, 0.f}, aq = (f32x4){0.f, 0.f, 0.f, 0.f};
            if (jb <= ib) {
#pragma unroll
                for (int ks = 0; ks < 4; ++ks) { const bf16x8 bfr = *(const LAS bf16x8*)(Kn + (16 * jb + fr) * 136 + 32 * ks + 8 * fq);
                    const bf16x8 afk = *(const LAS bf16x8*)(Kn + (16 * ib + fr) * 136 + 32 * ks + 8 * fq), afq = *(const LAS bf16x8*)(Qn + (16 * ib + fr) * 136 + 32 * ks + 8 * fq);
                    ak = MFMA32(afk, bfr, ak); aq = MFMA32(afq, bfr, aq); } }
            const int col = 16 * jb + fr; const float gcc = gcs[col];
#pragma unroll
            for (int j = 0; j < 4; ++j) { const int row = 16 * ib + 4 * fq + j; const float dec = (row >= col) ? fexp(gcs[row] - gcc) : 0.f;
                Mm[row * 72 + col] = (bf16)f2bf(row > col ? -bet[row] * ak[j] * dec : 0.f);
                QKd[row * 72 + col] = (bf16)f2bf(aq[j] * dec); }
        }
    }
    LDS_BARRIER();
    if (w == 0) { const int blk = lane >> 4, col = lane & 15; float xi[16];
#pragma unroll
        for (int i = 0; i < 16; ++i) { float acc = (i == col) ? 1.f : 0.f; const LAS bf16* mr = Mm + (16 * blk + i) * 72 + 16 * blk;
#pragma unroll
            for (int j = 0; j < i; ++j) acc += bf2f(mr[j]) * xi[j];
            xi[i] = acc; }
#pragma unroll
        for (int i = 0; i < 16; ++i) Td[(blk * 16 + i) * 24 + col] = (bf16)f2bf(xi[i]); }
    f32x4 rhs[2][4];
#pragma unroll
    for (int cbl = 0; cbl < 2; ++cbl)
#pragma unroll
        for (int bb = 0; bb < 4; ++bb)
#pragma unroll
            for (int j = 0; j < 4; ++j) rhs[cbl][bb][j] = bf2f(RX[(16 * bb + 4 * fq + j) * 264 + 32 * w + 16 * cbl + fr]);
    LDS_BARRIER();
#pragma unroll
    for (int cbl = 0; cbl < 2; ++cbl) { const int cb = 2 * w + cbl;
#pragma unroll
        for (int bb = 0; bb < 4; ++bb) {
            f32x4 acc = rhs[cbl][bb];
#pragma unroll
            for (int ks = 0; ks < 2; ++ks) { if (32 * ks < 16 * bb) { const bool ok = (32 * ks + 8 * fq) < 16 * bb;
                const bf16x8 af = ok ? *(const LAS bf16x8*)(Mm + (16 * bb + fr) * 72 + 32 * ks + 8 * fq) : zero8();
                const bf16x8 bf_ = ok ? *(const LAS bf16x8*)(RX + (16 * cb + fr) * 72 + 32 * ks + 8 * fq) : zero8();
                acc = MFMA32(af, bf_, acc); } }
            *(LAS v2u*)(RT + (16 * cbl + fr) * 24 + 4 * fq) = pack4(acc);
            asm volatile("s_waitcnt lgkmcnt(0)" ::: "memory");
            const bool ok2 = fq < 2;
            const bf16x8 af2 = ok2 ? *(const LAS bf16x8*)(Td + (bb * 16 + fr) * 24 + 8 * fq) : zero8();
            const bf16x8 bf2 = ok2 ? *(const LAS bf16x8*)(RT + (16 * cbl + fr) * 24 + 8 * fq) : zero8();
            const f32x4 xb4 = MFMA32(af2, bf2, ((f32x4){0.f, 0.f, 0.f, 0.f}));
            *(LAS v2u*)(RX + (16 * cb + fr) * 72 + 16 * bb + 4 * fq) = pack4(xb4);
            asm volatile("s_waitcnt lgkmcnt(0)" ::: "memory");
        }
    }
    LDS_BARRIER();
    {
        v4u* gout = (v4u*)(ws + WS_DG) + ((size_t)item * 8 + w) * 4 * 64 + lane;
        bf16x8 kb[2];
#pragma unroll
        for (int kt = 0; kt < 2; ++kt) kb[kt] = *(const LAS bf16x8*)(KdT + (16 * w + fr) * 72 + 32 * kt + 8 * fq);
#pragma unroll
        for (int ks = 0; ks < 4; ++ks) { f32x4 g0 = (f32x4){0.f, 0.f, 0.f, 0.f}, g1 = (f32x4){0.f, 0.f, 0.f, 0.f};
#pragma unroll
            for (int kt = 0; kt < 2; ++kt) { const bf16x8 a0 = *(const LAS bf16x8*)(RX + (128 + 32 * ks + fr) * 72 + 32 * kt + 8 * fq), a1 = *(const LAS bf16x8*)(RX + (128 + 32 * ks + 16 + fr) * 72 + 32 * kt + 8 * fq);
                g0 = MFMA32(a0, kb[kt], g0); g1 = MFMA32(a1, kb[kt], g1); }
            const v2u p0 = pack4(-g0), p1 = pack4(-g1); gout[ks * 64] = (v4u){p0.x, p0.y, p1.x, p1.y}; }
        v2u* bout = (v2u*)(ws + WS_DB) + ((size_t)item * 64 + w) * 64 + lane;
#pragma unroll
        for (int s2 = 0; s2 < 8; ++s2) { f32x4 bc = (f32x4){0.f, 0.f, 0.f, 0.f};
#pragma unroll
            for (int kt = 0; kt < 2; ++kt) { const bf16x8 ub = *(const LAS bf16x8*)(RX + (16 * s2 + fr) * 72 + 32 * kt + 8 * fq); bc = MFMA32(kb[kt], ub, bc); }
            bout[(size_t)s2 * 8 * 64] = pack4(bc); }
    }
    {
        const int tb = w >> 1, half = w & 1; const float ect = fexp(gcs[16 * tb + fr]);
        bf16x8 qk[2];
#pragma unroll
        for (int kt = 0; kt < 2; ++kt) qk[kt] = *(const LAS bf16x8*)(QKd + (16 * tb + fr) * 72 + 32 * kt + 8 * fq);
        v4u* qout = (v4u*)(ws + WS_DQ) + ((size_t)item * 4 + tb) * 4 * 64 + lane;
#pragma unroll
        for (int kk = 0; kk < 2; ++kk) { const int ks = 2 * half + kk; v2u pk[2];
#pragma unroll
            for (int hf = 0; hf < 2; ++hf) { const int db = 2 * ks + hf; f32x4 acc = (f32x4){0.f, 0.f, 0.f, 0.f};
#pragma unroll
                for (int kt = 0; kt < 2; ++kt) { const bf16x8 wa = *(const LAS bf16x8*)(RX + (128 + 16 * db + fr) * 72 + 32 * kt + 8 * fq); acc = MFMA32(wa, qk[kt], acc); }
                const v2u qn4 = *(const LAS v2u*)(Qn + (16 * tb + fr) * 136 + 16 * db + 4 * fq);
                f32x4 qp; qp.x = bflo(qn4.x) * ect - acc.x; qp.y = bfhi(qn4.x) * ect - acc.y; qp.z = bflo(qn4.y) * ect - acc.z; qp.w = bfhi(qn4.y) * ect - acc.w;
                pk[hf] = pack4(qp); }
            qout[ks * 64] = (v4u){pk[0].x, pk[0].y, pk[1].x, pk[1].y}; }
        v2u* oout = (v2u*)(ws + WS_DO) + ((size_t)item * 4 + tb) * 8 * 64 + lane;
#pragma unroll
        for (int ss = 0; ss < 4; ++ss) { const int s2 = 4 * half + ss; f32x4 acc = (f32x4){0.f, 0.f, 0.f, 0.f};
#pragma unroll
            for (int kt = 0; kt < 2; ++kt) { const bf16x8 ua = *(const LAS bf16x8*)(RX + (16 * s2 + fr) * 72 + 32 * kt + 8 * fq); acc = MFMA32(ua, qk[kt], acc); }
            oout[s2 * 64] = pack4(acc); }
    }
    if (tid == 0) ((float*)(ws + WS_DD))[item] = fexp(gcs[63]);
    LDS_BARRIER();
}

__device__ __forceinline__ void delta_scan_wave(ArgsP a, int chain, int s, const int lane) {
    unsigned char* ws = a->ws;
    const int fr = lane & 15, fq = lane >> 4;
    f32x4 S[8]; bf16x8 Sb[4];
#pragma unroll
    for (int i = 0; i < 8; ++i) S[i] = (f32x4){0.f, 0.f, 0.f, 0.f};
#pragma unroll
    for (int i = 0; i < 4; ++i) Sb[i] = zero8();
    const bf16x8* gbase = (const bf16x8*)(ws + WS_DG) + (size_t)chain * 32 * 2048 + lane;
    bf16x8 G[8][4];
#pragma unroll
    for (int rb = 0; rb < 8; ++rb)
#pragma unroll
        for (int ks = 0; ks < 4; ++ks) G[rb][ks] = gbase[(rb * 4 + ks) * 64];
#pragma unroll 1
    for (int c = 0; c < 32; ++c) {
        const int item = chain * 32 + c;
        const float d = ((const float*)(ws + WS_DD))[item];
        bf16x8* sout = (bf16x8*)(ws + WS_DS) + ((size_t)item * 8 + s) * 4 * 64 + lane;
#pragma unroll
        for (int ks = 0; ks < 4; ++ks) sout[ks * 64] = Sb[ks];
        const v2u* bin = (const v2u*)(ws + WS_DB) + ((size_t)item * 8 + s) * 8 * 64 + lane;
#pragma unroll
        for (int rb = 0; rb < 8; ++rb) { const v2u bc = bin[rb * 64]; S[rb].x = d * S[rb].x + bflo(bc.x); S[rb].y = d * S[rb].y + bfhi(bc.x); S[rb].z = d * S[rb].z + bflo(bc.y); S[rb].w = d * S[rb].w + bfhi(bc.y); }
        const bf16x8* gnext = gbase + (size_t)(c + 1 < 32 ? c + 1 : c) * 2048;
#pragma unroll
        for (int rb = 0; rb < 8; ++rb) {
#pragma unroll
            for (int ks = 0; ks < 4; ++ks) S[rb] = MFMA32(G[rb][ks], Sb[ks], S[rb]);
#pragma unroll
            for (int ks = 0; ks < 4; ++ks) G[rb][ks] = gnext[(rb * 4 + ks) * 64];
        }
#pragma unroll
        for (int ks = 0; ks < 4; ++ks) { const v2u lo = pack4(S[2 * ks]), hi = pack4(S[2 * ks + 1]); const v4u u = (v4u){lo.x, lo.y, hi.x, hi.y}; Sb[ks] = __builtin_bit_cast(bf16x8, u); }
    }
    f32x4* so = (f32x4*)(ws + WS_DF) + ((size_t)(chain * 8 + s) * 8) * 64 + lane;
#pragma unroll
    for (int rb = 0; rb < 8; ++rb) so[rb * 64] = S[rb];
}

__device__ __forceinline__ void delta_out_wave(ArgsP a, int item, int tb, const int lane) {
    unsigned char* ws = a->ws;
    const int c = item & 31, h = (item >> 5) & 7, b = item >> 8, fr = lane & 15, fq = lane >> 4;
    bf16x8 qf[4];
    const bf16x8* qin = (const bf16x8*)(ws + WS_DQ) + ((size_t)item * 4 + tb) * 4 * 64 + lane;
#pragma unroll
    for (int ks = 0; ks < 4; ++ks) qf[ks] = qin[ks * 64];
    const v2u* oin = (const v2u*)(ws + WS_DO) + ((size_t)item * 4 + tb) * 8 * 64 + lane;
    const bf16x8* sin = (const bf16x8*)(ws + WS_DS) + (size_t)item * 8 * 4 * 64 + lane;
    f32x4 o[8]; float ss = 0.f;
    v2u olv[8]; bf16x8 sfr[4][4];
#pragma unroll
    for (int s = 0; s < 8; ++s) olv[s] = oin[s * 64];
#pragma unroll
    for (int s = 0; s < 4; ++s)
#pragma unroll
        for (int ks = 0; ks < 4; ++ks) sfr[s][ks] = sin[(s * 4 + ks) * 64];
    const int row_ = b * TP + 64 * c + 16 * tb + fr;
    v2u zv[8];
#pragma unroll
    for (int s = 0; s < 8; ++s) zv[s] = *(const v2u*)((const bf16*)(ws + WS_PROJ) + (size_t)row_ * NPROJ_PAD + 4096 + h * 128 + 4 * fq + 16 * s);
#pragma unroll
    for (int grp = 0; grp < 2; ++grp) {
#pragma unroll
        for (int s4 = 0; s4 < 4; ++s4) { const int s = 4 * grp + s4; const v2u ol = olv[s]; o[s] = (f32x4){bflo(ol.x), bfhi(ol.x), bflo(ol.y), bfhi(ol.y)};
#pragma unroll
            for (int ks = 0; ks < 4; ++ks) o[s] = MFMA32(sfr[s4][ks], qf[ks], o[s]);
            ss += (o[s].x * o[s].x + o[s].y * o[s].y) + (o[s].z * o[s].z + o[s].w * o[s].w); }
        if (grp == 0) {
#pragma unroll
            for (int s4 = 0; s4 < 4; ++s4)
#pragma unroll
                for (int ks = 0; ks < 4; ++ks) sfr[s4][ks] = sin[((4 + s4) * 4 + ks) * 64]; }
    }
    ss += __shfl_xor(ss, 16); ss += __shfl_xor(ss, 32);
    const float rstd = rsqrtf(ss * (1.f / 128.f) + RMS_EPS);
    const int row = b * TP + 64 * c + 16 * tb + fr;
    const bf16* zp = (const bf16*)(ws + WS_PROJ) + (size_t)row * NPROJ_PAD + 4096 + h * 128 + 4 * fq;
    bf16* mp = (bf16*)(ws + WS_MIX) + (size_t)row * D + h * 128 + 4 * fq;
    const float* nw = a->in[I_DNORM] + 4 * fq;
#pragma unroll
    for (int s = 0; s < 8; ++s) { const v2u z = zv[s]; const f32x4 n4 = *(const f32x4*)(nw + 16 * s);
        f32x4 y; y.x = o[s].x * rstd * n4.x * siluf(bflo(z.x)); y.y = o[s].y * rstd * n4.y * siluf(bfhi(z.x)); y.z = o[s].z * rstd * n4.z * siluf(bflo(z.y)); y.w = o[s].w * rstd * n4.w * siluf(bfhi(z.y));
        *(v2u*)(mp + 16 * s) = pack4(y); }
}


__device__ __forceinline__ void mlstm_scan_item(ArgsP a, LAS unsigned char* lds, int chain, int vs, const int tid) {
    const int lane = tid & 63, w = __builtin_amdgcn_readfirstlane(tid >> 6), fr = lane & 15, fq = lane >> 4;
    const int b = chain >> 3, h = chain & 7, row0 = b * TP;
    unsigned char* ws = a->ws;
    const bf16* proj = (const bf16*)(ws + WS_PROJ); const float* gates = (const float*)(ws + WS_GATES);
    LAS bf16* KT = (LAS bf16*)lds;
    LAS bf16* VT = (LAS bf16*)(lds + 36864);
    LAS float* wls = (LAS float*)(lds + 46080);
    LAS float* gendA = (LAS float*)(lds + 46592);
    LAS float* blastA = gendA + 2048;
    LAS float* mxA = blastA + 32;
    const float big = a->in[I_BIG][h], bfg = a->in[I_BFG][h];
    {
        float lf4[4], ig4[4];
#pragma unroll
        for (int i = 0; i < 4; ++i) { const float* gp = gates + (size_t)(row0 + 64 * (w + 8 * i) + lane) * 16 + h; ig4[i] = gp[0] + big; lf4[i] = logsigf(gp[8] + bfg); }
#pragma unroll
        for (int i = 0; i < 4; ++i) { const float bcum = wave_incl_sum(lf4[i], lane), blast = __shfl(bcum, 63), gend = blast - bcum + ig4[i]; const float mx = wave_max(gend);
            gendA[(w + 8 * i) * 64 + lane] = gend; if (lane == 0) { blastA[w + 8 * i] = blast; mxA[w + 8 * i] = mx; } }
    }
    LDS_BARRIER();
    const bf16* kptr = proj + (size_t)(row0 + lane) * NPROJ_PAD + 1024 + h * 128 + 16 * w;
    const bf16* vptr = proj + (size_t)(row0 + lane) * NPROJ_PAD + 2048 + h * 256 + 32 * vs + 8 * (w & 3);
    f32x4 acc[2]; acc[0] = (f32x4){0.f, 0.f, 0.f, 0.f}; acc[1] = acc[0];
    float nst = 0.f, m = 0.f;
    v4u kq[2][2], vq[2];
#define ML_LOAD(set, c_) do { const size_t ro = (size_t)(c_) * 64 * NPROJ_PAD; kq[set][0] = *(const v4u*)(kptr + ro); kq[set][1] = *(const v4u*)(kptr + ro + 8); \
        if (w < 4) vq[set] = *(const v4u*)(vptr + ro); } while (0)
#define ML_STEP(set, c_) do { const int item = chain * 32 + (c_); \
        const float blast = blastA[(c_)], gend = gendA[(c_) * 64 + lane]; \
        const float mnew = fmaxf(blast + m, mxA[(c_)]), sc = fexp(blast + m - mnew), wv = fexp(gend - mnew) * 0.08838834764831845f; \
        LAS bf16* kt = KT + (set) * 9216; LAS bf16* vt = VT + (set) * 2304; \
        _Pragma("unroll") for (int i = 0; i < 2; ++i) { const unsigned uu[4] = {kq[set][i].x, kq[set][i].y, kq[set][i].z, kq[set][i].w}; const int kr = 8 * (2 * w + i); \
            _Pragma("unroll") for (int e = 0; e < 4; ++e) { kt[(kr + 2 * e) * 72 + lane] = (bf16)(uu[e] & 0xffffu); kt[(kr + 2 * e + 1) * 72 + lane] = (bf16)(uu[e] >> 16); } } \
        if (w < 4) { const unsigned uu[4] = {vq[set].x, vq[set].y, vq[set].z, vq[set].w}; \
            _Pragma("unroll") for (int e = 0; e < 4; ++e) { vt[(8 * w + 2 * e) * 72 + lane] = (bf16)f2bf(bflo(uu[e]) * wv); vt[(8 * w + 2 * e + 1) * 72 + lane] = (bf16)f2bf(bfhi(uu[e]) * wv); } } \
        if (w == 0) wls[(set) * 64 + lane] = wv; \
        if ((c_) + 2 < 32) ML_LOAD(set, (c_) + 2); \
        if (vs == 0 && tid == 0) ((float*)(ws + WS_MM))[item] = m; \
        LDS_BARRIER(); \
        _Pragma("unroll") for (int vb = 0; vb < 2; ++vb) { *(v2u*)((bf16*)(ws + WS_MC) + ((size_t)item * 256 + 32 * vs + 16 * vb + fr) * 128 + 16 * w + 4 * fq) = pack4(acc[vb]); } \
        if (vs == 0 && tid < 128) { ((float*)(ws + WS_MN))[(size_t)item * 128 + tid] = nst; float sn = 0.f; \
            _Pragma("unroll") for (int s8 = 0; s8 < 8; ++s8) { const v4u kk = *(const LAS v4u*)(kt + tid * 72 + 8 * s8); const LAS float* wl = wls + (set) * 64 + 8 * s8; \
                sn += bflo(kk.x) * wl[0] + bfhi(kk.x) * wl[1] + bflo(kk.y) * wl[2] + bfhi(kk.y) * wl[3] + bflo(kk.z) * wl[4] + bfhi(kk.z) * wl[5] + bflo(kk.w) * wl[6] + bfhi(kk.w) * wl[7]; } \
            nst = sc * nst + sn; } \
        _Pragma("unroll") for (int vb = 0; vb < 2; ++vb) { acc[vb] = acc[vb] * sc; \
            _Pragma("unroll") for (int kt2 = 0; kt2 < 2; ++kt2) { const bf16x8 af = *(const LAS bf16x8*)(kt + (16 * w + fr) * 72 + 32 * kt2 + 8 * fq), bfv = *(const LAS bf16x8*)(vt + (16 * vb + fr) * 72 + 32 * kt2 + 8 * fq); \
                acc[vb] = MFMA32(af, bfv, acc[vb]); } } \
        m = mnew; } while (0)
    ML_LOAD(0, 0); ML_LOAD(1, 1);
#pragma unroll 1
    for (int c2 = 0; c2 < 32; c2 += 2) { ML_STEP(0, c2); ML_STEP(1, c2 + 1); }
#undef ML_LOAD
#undef ML_STEP
#pragma unroll
    for (int vb = 0; vb < 2; ++vb) *(f32x4*)(a->out + O_MCP + ((size_t)chain * 256 + 32 * vs + 16 * vb + fr) * 128 + 16 * w + 4 * fq) = acc[vb];
    if (vs == 0) { if (tid < 128) a->out[O_MNP + (size_t)chain * 128 + tid] = nst; if (tid == 0) a->out[O_MMP + chain] = m; }
    LDS_BARRIER();
}

__device__ __forceinline__ void mlstm_out_item(ArgsP a, LAS unsigned char* lds, int item, const int tid) {
    const int c = item & 31, h = (item >> 5) & 7, b = item >> 8, row0 = b * TP + 64 * c;
    const int lane = tid & 63, w = __builtin_amdgcn_readfirstlane(tid >> 6), fr = lane & 15, fq = lane >> 4;
    unsigned char* ws = a->ws;
    const bf16* proj = (const bf16*)(ws + WS_PROJ); const float* gates = (const float*)(ws + WS_GATES);
    LAS bf16* VT = (LAS bf16*)lds;
    LAS float* ssq = (LAS float*)(lds + 36864);
    const int tb = w & 3, half = w >> 2, t = 16 * tb + fr;
    v4u vu[4];
#pragma unroll
    for (int i = 0; i < 4; ++i) vu[i] = *(const v4u*)(proj + (size_t)(row0 + lane) * NPROJ_PAD + 2048 + h * 256 + 8 * (w + 8 * i));
    v4u qu[4]; f32x4 nv[4][2];
#pragma unroll
    for (int ks = 0; ks < 4; ++ks) { qu[ks] = *(const v4u*)(proj + (size_t)(row0 + t) * NPROJ_PAD + h * 128 + 32 * ks + 8 * fq);
        const float* np = (const float*)(ws + WS_MN) + (size_t)item * 128 + 32 * ks + 8 * fq; nv[ks][0] = *(const f32x4*)np; nv[ks][1] = *(const f32x4*)(np + 4); }
    v4u kfr[4][4];
#pragma unroll
    for (int sb = 0; sb < 4; ++sb) if (sb <= tb) {
#pragma unroll
        for (int ks = 0; ks < 4; ++ks) kfr[sb][ks] = *(const v4u*)(proj + (size_t)(row0 + 16 * sb + fr) * NPROJ_PAD + 1024 + h * 128 + 32 * ks + 8 * fq); }
    const float mc = ((const float*)(ws + WS_MM))[item];
    float av, Mt, et, em;
    { const float ig = gates[(size_t)(row0 + lane) * 16 + h] + a->in[I_BIG][h], lf = logsigf(gates[(size_t)(row0 + lane) * 16 + 8 + h] + a->in[I_BFG][h]);
      const float bcum = wave_incl_sum(lf, lane); av = ig - bcum; Mt = fmaxf(mc, wave_incl_max(av, lane)); et = fexp(mc - Mt); em = fexp(-(bcum + Mt)); }
#pragma unroll
    for (int i = 0; i < 4; ++i) { const unsigned uu[4] = {vu[i].x, vu[i].y, vu[i].z, vu[i].w}; const int vr = 8 * (w + 8 * i);
#pragma unroll
        for (int e = 0; e < 4; ++e) { VT[(vr + 2 * e) * 72 + lane] = (bf16)(uu[e] & 0xffffu); VT[(vr + 2 * e + 1) * 72 + lane] = (bf16)(uu[e] >> 16); } }
    bf16x8 qf[4]; float qn = 0.f;
#pragma unroll
    for (int ks = 0; ks < 4; ++ks) { const v4u u = qu[ks]; qf[ks] = __builtin_bit_cast(bf16x8, u); const f32x4 n0 = nv[ks][0], n1 = nv[ks][1];
        qn += bflo(u.x) * n0.x + bfhi(u.x) * n0.y + bflo(u.y) * n0.z + bfhi(u.y) * n0.w + bflo(u.z) * n1.x + bfhi(u.z) * n1.y + bflo(u.w) * n1.z + bfhi(u.w) * n1.w; }
    qn += __shfl_xor(qn, 16); qn += __shfl_xor(qn, 32);
    const float Mtt = __shfl(Mt, t), ett = __shfl(et, t), emt = __shfl(em, t);
    const bf16* cs = (const bf16*)(ws + WS_MC) + (size_t)item * 256 * 128;
    v2u smp[4]; float rowsum = 0.f;
#pragma unroll
    for (int sb = 0; sb < 4; ++sb) { smp[sb] = (v2u){0u, 0u};
        if (sb <= tb) { f32x4 qk = (f32x4){0.f, 0.f, 0.f, 0.f};
#pragma unroll
            for (int ks = 0; ks < 4; ++ks) qk = MFMA32(__builtin_bit_cast(bf16x8, kfr[sb][ks]), qf[ks], qk);
            f32x4 sm;
#pragma unroll
            for (int j = 0; j < 4; ++j) { const int s = 16 * sb + 4 * fq + j; const float as = __shfl(av, s); sm[j] = (s <= t) ? qk[j] * 0.08838834764831845f * fexp(as - Mtt) : 0.f; rowsum += sm[j]; }
            smp[sb] = pack4(sm); } }
    rowsum += __shfl_xor(rowsum, 16); rowsum += __shfl_xor(rowsum, 32);
    const float hden = 1.f / fmaxf(fabsf(ett * qn + rowsum), emt);
    const v4u s0u = (v4u){smp[0].x, smp[0].y, smp[1].x, smp[1].y}, s1u = (v4u){smp[2].x, smp[2].y, smp[3].x, smp[3].y};
    const bf16x8 sf0 = __builtin_bit_cast(bf16x8, s0u), sf1 = __builtin_bit_cast(bf16x8, s1u);
    v4u cfr[4][4];
#pragma unroll
    for (int g4 = 0; g4 < 4; ++g4)
#pragma unroll
        for (int ks = 0; ks < 4; ++ks) cfr[g4][ks] = *(const v4u*)(cs + (size_t)(128 * half + 16 * g4 + fr) * 128 + 32 * ks + 8 * fq);
    LDS_BARRIER();
    f32x4 hv[8]; float ss = 0.f;
#pragma unroll
    for (int grp = 0; grp < 2; ++grp) {
      f32x4 accs[4];
#pragma unroll
      for (int g4 = 0; g4 < 4; ++g4) { f32x4 acc = (f32x4){0.f, 0.f, 0.f, 0.f};
#pragma unroll
          for (int ks = 0; ks < 4; ++ks) acc = MFMA32(__builtin_bit_cast(bf16x8, cfr[g4][ks]), qf[ks], acc);
          accs[g4] = acc * ett; }
      if (grp == 0) {
#pragma unroll
          for (int g4 = 0; g4 < 4; ++g4)
#pragma unroll
              for (int ks = 0; ks < 4; ++ks) cfr[g4][ks] = *(const v4u*)(cs + (size_t)(128 * half + 64 + 16 * g4 + fr) * 128 + 32 * ks + 8 * fq); }
#pragma unroll
      for (int g4 = 0; g4 < 4; ++g4) { const int vb = 4 * grp + g4, vrow = 128 * half + 16 * vb + fr; f32x4 acc = accs[g4];
        { const v2u a0 = *(const LAS v2u*)(VT + vrow * 72 + 4 * fq), a1 = *(const LAS v2u*)(VT + vrow * 72 + 16 + 4 * fq); const v4u au = (v4u){a0.x, a0.y, a1.x, a1.y}; acc = MFMA32(__builtin_bit_cast(bf16x8, au), sf0, acc); }
        { const v2u a0 = *(const LAS v2u*)(VT + vrow * 72 + 32 + 4 * fq), a1 = *(const LAS v2u*)(VT + vrow * 72 + 48 + 4 * fq); const v4u au = (v4u){a0.x, a0.y, a1.x, a1.y}; acc = MFMA32(__builtin_bit_cast(bf16x8, au), sf1, acc); }
        hv[vb] = acc * hden; ss += (hv[vb].x * hv[vb].x + hv[vb].y * hv[vb].y) + (hv[vb].z * hv[vb].z + hv[vb].w * hv[vb].w); }
    }
    ss += __shfl_xor(ss, 16); ss += __shfl_xor(ss, 32);
    if (fq == 0) ssq[half * 64 + t] = ss;
    LDS_BARRIER();
    const float rstd = rsqrtf((ssq[t] + ssq[64 + t]) * (1.f / 256.f) + RMS_EPS);
    const bf16* op = proj + (size_t)(row0 + t) * NPROJ_PAD + 4096 + h * 256 + 128 * half + 4 * fq;
    bf16* mp = (bf16*)(ws + WS_MIX) + (size_t)(row0 + t) * D + h * 256 + 128 * half + 4 * fq;
    const float* nw = a->in[I_MNORM] + h * 256 + 128 * half + 4 * fq;
    v2u opr[8];
#pragma unroll
    for (int vb = 0; vb < 8; ++vb) opr[vb] = *(const v2u*)(op + 16 * vb);
#pragma unroll
    for (int vb = 0; vb < 8; ++vb) { const v2u o = opr[vb]; const f32x4 n4 = *(const f32x4*)(nw + 16 * vb);
        f32x4 y; y.x = hv[vb].x * rstd * n4.x * sigm(bflo(o.x)); y.y = hv[vb].y * rstd * n4.y * sigm(bfhi(o.x)); y.z = hv[vb].z * rstd * n4.z * sigm(bflo(o.y)); y.w = hv[vb].w * rstd * n4.w * sigm(bfhi(o.y));
        *(v2u*)(mp + 16 * vb) = pack4(y); }
    LDS_BARRIER();
}


__device__ __forceinline__ void mlstm_sample_load(ArgsP a, int j, const int tid, f32x4 (&cst)[2][4][2]) {
    const int lane = tid & 63, w = __builtin_amdgcn_readfirstlane(tid >> 6), fr = lane & 15, fq = lane >> 4;
    const float* C0 = a->in[I_SMC] + (size_t)j * 32768;
#pragma unroll
    for (int vb = 0; vb < 2; ++vb)
#pragma unroll
        for (int ksp = 0; ksp < 4; ++ksp) { const float* cp = C0 + (size_t)(32 * w + 16 * vb + fr) * 128 + 32 * ksp + 4 * fq; cst[vb][ksp][0] = __builtin_nontemporal_load((const f32x4*)cp); cst[vb][ksp][1] = __builtin_nontemporal_load((const f32x4*)(cp + 16)); }
}
__device__ __forceinline__ void mlstm_sample_item(ArgsP a, LAS unsigned char* lds, int j, const int tid, const f32x4 (&cst)[2][4][2]) {
    const int b = j >> 3, h = j & 7, row0 = MP + b * TS;
    const int lane = tid & 63, w = __builtin_amdgcn_readfirstlane(tid >> 6), fr = lane & 15, fq = lane >> 4;
    unsigned char* ws = a->ws;
    const bf16* proj = (const bf16*)(ws + WS_PROJ); const float* gates = (const float*)(ws + WS_GATES);
    float* Cout = a->out + O_MCS + (size_t)j * 32768;
    LAS float* qs = (LAS float*)lds;
    LAS float* ks = qs + 512;
    LAS float* vs = ks + 512;
    LAS float* gs = vs + 1024;
    LAS float* qkr = gs + 8;
    LAS float* qnl = qkr + 16;
    LAS float* hbuf = qnl + 8;
#pragma unroll
    for (int tok = 0; tok < 4; ++tok) { const bf16* pr = proj + (size_t)(row0 + tok) * NPROJ_PAD;
        if (tid < 128) qs[tok * 128 + tid] = bf2f(pr[h * 128 + tid]); else if (tid < 256) ks[tok * 128 + tid - 128] = bf2f(pr[1024 + h * 128 + (tid - 128)]) * 0.08838834764831845f; else vs[tok * 256 + tid - 256] = bf2f(pr[2048 + h * 256 + (tid - 256)]); }
    if (tid < 4) { gs[tid * 2] = gates[(size_t)(row0 + tid) * 16 + h] + a->in[I_BIG][h]; gs[tid * 2 + 1] = gates[(size_t)(row0 + tid) * 16 + 8 + h] + a->in[I_BFG][h]; }
    const float n0a = a->in[I_SMN][(size_t)j * 128 + lane], n0b = a->in[I_SMN][(size_t)j * 128 + 64 + lane];
    const float m0 = a->in[I_SMM][j];
    LDS_BARRIER();
#pragma unroll
    for (int i = 0; i < 2; ++i) { const int p = 2 * w + i, t = p >> 2, sx = p & 3; const float d = wave_sum(qs[t * 128 + lane] * ks[sx * 128 + lane] + qs[t * 128 + 64 + lane] * ks[sx * 128 + 64 + lane]); if (lane == 0) qkr[p] = d; }
    if (w < 4) { const float d = wave_sum(qs[w * 128 + lane] * n0a + qs[w * 128 + 64 + lane] * n0b); if (lane == 0) qnl[w] = d; }
    float bc[4], ig[4], mt[4], m = m0, bsum = 0.f;
#pragma unroll
    for (int t = 0; t < 4; ++t) { ig[t] = gs[t * 2]; const float lf = logsigf(gs[t * 2 + 1]); bsum += lf; bc[t] = bsum; m = fmaxf(lf + m, ig[t]); mt[t] = m; }
    const float scf = fexp(bc[3] + m0 - mt[3]);
    float wsf[4], et[4];
#pragma unroll
    for (int t = 0; t < 4; ++t) { wsf[t] = fexp(bc[3] - bc[t] + ig[t] - mt[3]); et[t] = fexp(bc[t] + m0 - mt[t]); }
    LDS_BARRIER();
    float S[4][4], hden[4];
#pragma unroll
    for (int t = 0; t < 4; ++t) { float den = et[t] * qnl[t];
#pragma unroll
        for (int sx = 0; sx < 4; ++sx) { S[t][sx] = (sx <= t) ? qkr[t * 4 + sx] * fexp(bc[t] - bc[sx] + ig[sx] - mt[t]) : 0.f; den += S[t][sx]; }
        hden[t] = 1.f / fmaxf(fabsf(den), fexp(-mt[t])); }
    bf16x8 qa[4];
#pragma unroll
    for (int ksp = 0; ksp < 4; ++ksp) { v4u u = (v4u){0u, 0u, 0u, 0u};
        if (fr < 4) { const f32x4 x0 = *(const LAS f32x4*)(qs + fr * 128 + 32 * ksp + 4 * fq), x1 = *(const LAS f32x4*)(qs + fr * 128 + 32 * ksp + 16 + 4 * fq); u.x = pk2(x0.x, x0.y); u.y = pk2(x0.z, x0.w); u.z = pk2(x1.x, x1.y); u.w = pk2(x1.z, x1.w); }
        qa[ksp] = __builtin_bit_cast(bf16x8, u); }
#pragma unroll
    for (int vb = 0; vb < 2; ++vb) { const int v = 32 * w + 16 * vb + fr;
        float vw[4];
#pragma unroll
        for (int sx = 0; sx < 4; ++sx) vw[sx] = vs[sx * 256 + v] * wsf[sx];
        f32x4 dacc = (f32x4){0.f, 0.f, 0.f, 0.f};
#pragma unroll
        for (int ksp = 0; ksp < 4; ++ksp) { const f32x4 c0 = cst[vb][ksp][0], c1 = cst[vb][ksp][1];
            v4u u; u.x = pk2(c0.x, c0.y); u.y = pk2(c0.z, c0.w); u.z = pk2(c1.x, c1.y); u.w = pk2(c1.z, c1.w);
            dacc = MFMA32(qa[ksp], __builtin_bit_cast(bf16x8, u), dacc);
            f32x4 n0v = c0 * scf, n1v = c1 * scf;
#pragma unroll
            for (int sx = 0; sx < 4; ++sx) { const f32x4 k0 = *(const LAS f32x4*)(ks + sx * 128 + 32 * ksp + 4 * fq), k1 = *(const LAS f32x4*)(ks + sx * 128 + 32 * ksp + 16 + 4 * fq); n0v = n0v + k0 * vw[sx]; n1v = n1v + k1 * vw[sx]; }
            float* op = Cout + (size_t)v * 128 + 32 * ksp + 4 * fq; __builtin_nontemporal_store(n0v, (f32x4*)op); __builtin_nontemporal_store(n1v, (f32x4*)(op + 16)); }
        if (fq == 0) {
#pragma unroll
            for (int t = 0; t < 4; ++t) { float num = et[t] * dacc[t];
#pragma unroll
                for (int sx = 0; sx < 4; ++sx) num += S[t][sx] * vs[sx * 256 + v];
                hbuf[t * 256 + v] = num * hden[t]; } }
    }
    if (tid < 128) { float nn = scf * a->in[I_SMN][(size_t)j * 128 + tid];
#pragma unroll
        for (int sx = 0; sx < 4; ++sx) nn += wsf[sx] * ks[sx * 128 + tid];
        a->out[O_MNS + (size_t)j * 128 + tid] = nn; }
    if (tid == 0) a->out[O_MMS + j] = mt[3];
    LDS_BARRIER();
    if (w < 4) { const int tok = w, row = row0 + tok; float hv[4]; float ss = 0.f;
#pragma unroll
        for (int i = 0; i < 4; ++i) { hv[i] = hbuf[tok * 256 + i * 64 + lane]; ss += hv[i] * hv[i]; }
        const float rstd = rsqrtf(wave_sum(ss) * (1.f / 256.f) + RMS_EPS);
        const float* nw = a->in[I_MNORM] + h * 256; bf16* mix = (bf16*)(ws + WS_MIX);
#pragma unroll
        for (int i = 0; i < 4; ++i) { const int vi = i * 64 + lane; const float op = bf2f(proj[(size_t)row * NPROJ_PAD + 4096 + h * 256 + vi]);
            mix[(size_t)row * D + h * 256 + vi] = (bf16)f2bf(hv[i] * rstd * nw[vi] * sigm(op)); } }
    LDS_BARRIER();
}


__device__ __forceinline__ void lru_sample_loop(ArgsP a, LAS unsigned char* lds, int vcu, int G, const int tid) {
    const int d = tid & 127, part = tid >> 7, n = vcu & 7, chn = n * 128 + d;
    const bf16* proj = (const bf16*)(a->ws + WS_PROJ); bf16* mix = (bf16*)(a->ws + WS_MIX);
    const float* wconv = a->in[I_WCONV]; const float* bconv = a->in[I_BCONV];
    const float* wr = a->in[I_LWR] + (size_t)n * 16384; const float* wi = a->in[I_LWI] + (size_t)n * 16384;
    LAS float* xr = (LAS float*)lds;
    LAS float* red = xr + 512;
    float w1[32], w2[32];
#pragma unroll
    for (int cc = 0; cc < 32; ++cc) { w1[cc] = wr[(part * 32 + cc) * 128 + d]; w2[cc] = wi[(part * 32 + cc) * 128 + d]; }
    const float br = a->in[I_LBR][chn], bi = a->in[I_LBI][chn], spl = softplusf(-a->in[I_LLAM][chn]);
#pragma unroll 1
    for (int j = vcu; j < 1024; j += G) {
        const int b = j >> 3, row0 = MP + b * TS; const float* cstate = a->in[I_SCONV] + (size_t)b * 3 * 4096;
        float hst = a->in[I_SLRU][(size_t)b * 1024 + chn];
        float gt[4];
        if (part == 0) {
#pragma unroll
            for (int tok = 0; tok < 4; ++tok) gt[tok] = bf2f(proj[(size_t)(row0 + tok) * NPROJ_PAD + 5120 + chn]); }
        { const int tok = tid >> 7; xr[tok * 128 + d] = conv4(proj, row0, tok, 3072 + chn, cstate, wconv, bconv); }
        LDS_BARRIER();
        float ar[4] = {0.f, 0.f, 0.f, 0.f}, ai[4] = {0.f, 0.f, 0.f, 0.f};
#pragma unroll
        for (int cc = 0; cc < 32; ++cc) { const int c = part * 32 + cc;
#pragma unroll
            for (int tok = 0; tok < 4; ++tok) { const float x = xr[tok * 128 + c]; ar[tok] += x * w1[cc]; ai[tok] += x * w2[cc]; } }
#pragma unroll
        for (int tok = 0; tok < 4; ++tok) { red[((tok * 2 + 0) * 4 + part) * 128 + d] = ar[tok]; red[((tok * 2 + 1) * 4 + part) * 128 + d] = ai[tok]; }
        LDS_BARRIER();
        if (part == 0) {
#pragma unroll
            for (int tok = 0; tok < 4; ++tok) {
                float rp = br, ip = bi;
#pragma unroll
                for (int p = 0; p < 4; ++p) { rp += red[((tok * 2 + 0) * 4 + p) * 128 + d]; ip += red[((tok * 2 + 1) * 4 + p) * 128 + d]; }
                const float log_a = -8.f * sigm(rp) * spl;
                const float av = fexp(log_a);
                const float bx = sqrtf(neg_expm1(2.f * log_a)) * sigm(ip) * xr[tok * 128 + d];
                hst = av * hst + bx;
                mix[(size_t)(row0 + tok) * D + 1024 + chn] = (bf16)f2bf(hst * gelu_tanh(gt[tok]));
            }
            a->out[O_LRUS + (size_t)b * 1024 + chn] = hst;
        }
        LDS_BARRIER();
    }
}

__device__ __forceinline__ void phase_mixer_even(ArgsP a, LAS unsigned char* lds, int vcu, int G, const int tid) {
#pragma unroll 1
    for (int r = 0; r < 1 + (PROBE_SUB & 1); ++r)
#pragma unroll 1
    for (int it = vcu; it < 1024; it += G) delta_prep_item(a, lds, it, tid);
#pragma unroll 1
    for (int r = 0; r < 1 + ((PROBE_SUB >> 1) & 1); ++r)
#pragma unroll 1
    for (int it = vcu; it < 1024; it += G) lru_prep_item(a, lds, it, tid);
#pragma unroll 1
    for (int r = 0; r < 1 + ((PROBE_SUB >> 2) & 1); ++r)
#pragma unroll 1
    for (int j = vcu; j < 1024; j += G) { const int b = j >> 3, hn = j & 7; delta_rec_item(a, lds, MP + b * TS, TS, hn, a->in[I_SCONV] + (size_t)b * 3 * 4096, a->in[I_SDELTA] + (size_t)j * 16384, a->out + O_DELTAS + (size_t)j * 16384, tid); }
#pragma unroll 1
    for (int r = 0; r < 1 + ((PROBE_SUB >> 3) & 1); ++r)
    lru_sample_loop(a, lds, vcu, G, tid);
    const bf16* proj = (const bf16*)(a->ws + WS_PROJ);
    const int npieces = (BP + BS) * 3 * 512;
    for (int i = vcu * NTHR + tid; i < npieces; i += G * NTHR) {
        const int c8 = i & 511, rj = i >> 9, j = rj % 3, b = rj / 3;
        const bf16* src; float* dst;
        if (b < BP) { src = proj + (size_t)(b * TP + TP - 3 + j) * NPROJ_PAD + 8 * c8; dst = a->out + O_CONVP + (size_t)(b * 3 + j) * 4096 + 8 * c8; }
        else { const int bs = b - BP; src = proj + (size_t)(MP + bs * TS + 1 + j) * NPROJ_PAD + 8 * c8; dst = a->out + O_CONVS + (size_t)(bs * 3 + j) * 4096 + 8 * c8; }
        const v4u u = *(const v4u*)src;
        *(f32x4*)dst = (f32x4){bflo(u.x), bfhi(u.x), bflo(u.y), bfhi(u.y)}; *(f32x4*)(dst + 4) = (f32x4){bflo(u.z), bfhi(u.z), bflo(u.w), bfhi(u.w)};
    }
}
__device__ __forceinline__ void phase_mixer_even_b(ArgsP a, LAS unsigned char* lds, int vcu, int G, const int tid) {
    const int w = __builtin_amdgcn_readfirstlane(tid >> 6);
    if (w == 0) { for (int it = vcu; it < 256; it += G) delta_scan_wave(a, it >> 3, it & 7, tid & 63); }
    else { LAS float* scr = (LAS float*)(lds + w * 16384);
        convert_range(a, scr, cv::R_IN0, cv::R_SCAN, vcu * 7 + (w - 1), G * 7, tid & 63); }
}
__device__ __forceinline__ void phase_mixer_even_c(ArgsP a, LAS unsigned char* lds, int vcu, int G, const int tid) {
    const int w = tid >> 6;
#pragma unroll 1
    for (int it = vcu; it < 512; it += G) delta_out_wave(a, 2 * it + (w >> 2), w & 3, tid & 63);
#pragma unroll 1
    for (int it = vcu; it < 1024; it += G) lru_out_item(a, lds, it, tid);
    for (int chain = vcu; chain < 32; chain += G) {
        const f32x4* src = (const f32x4*)(a->ws + WS_DF) + (size_t)chain * 4096; float* dst = a->out + O_DELTAP + (size_t)chain * 16384;
        f32x4 v[8];
#pragma unroll
        for (int i = 0; i < 8; ++i) v[i] = src[tid + 512 * i];
#pragma unroll
        for (int i = 0; i < 8; ++i) { const int idx = tid + 512 * i, ln = idx & 63, rb = (idx >> 6) & 7, s8 = idx >> 9; const int dk0 = 16 * rb + 4 * (ln >> 4), dv = 16 * s8 + (ln & 15);
            dst[(size_t)(dk0 + 0) * 128 + dv] = v[i].x; dst[(size_t)(dk0 + 1) * 128 + dv] = v[i].y; dst[(size_t)(dk0 + 2) * 128 + dv] = v[i].z; dst[(size_t)(dk0 + 3) * 128 + dv] = v[i].w; }
    }
}
__device__ __forceinline__ void phase_mixer_odd(ArgsP a, LAS unsigned char* lds, int vcu, int G, const int tid) {
#pragma unroll 1
    for (int r = 0; r < 1 + ((PROBE_SUB >> 4) & 1); ++r)
#pragma unroll 1
    for (int it = vcu; it < 256; it += G) mlstm_scan_item(a, lds, it >> 3, it & 7, tid);
#pragma unroll 1
    for (int r = 0; r < 1 + ((PROBE_SUB >> 5) & 1); ++r)
    {
        f32x4 cA[2][4][2], cB[2][4][2]; int j = vcu;
        if (j < 1024) { mlstm_sample_load(a, j, tid, cA);
#pragma unroll 1
            for (;;) {
                const int jB = j + G; const bool hasB = jB < 1024;
                if (hasB) mlstm_sample_load(a, jB, tid, cB);
                mlstm_sample_item(a, lds, j, tid, cA);
                if (!hasB) break;
                j = jB + G; const bool hasA = j < 1024;
                if (hasA) mlstm_sample_load(a, j, tid, cA);
                mlstm_sample_item(a, lds, jB, tid, cB);
                if (!hasA) break;
            } }
    }
}
__device__ __forceinline__ void phase_mixer_odd_b(ArgsP a, LAS unsigned char* lds, int vcu, int G, const int tid) {
#pragma unroll 1
    for (int it = vcu; it < 1024; it += G) mlstm_out_item(a, lds, it, tid);
}

__device__ __forceinline__ void phase_ln(const bf16* VB, const float* ST, const float* p1, const bf16* resid, const float* g, const float* bta, bf16* dst, LAS unsigned char* lds, int vcu, int G, const int tid) {
    const int lane = tid & 63, w = __builtin_amdgcn_readfirstlane(tid >> 6), gw = vcu * NWAVES + w, NGW = G * NWAVES;
    {
        LAS float* red = (LAS float*)lds;
        for (int r0 = 2 * vcu; r0 < MS; r0 += 2 * G) {
            const int r = r0 + (w >> 2), q = w & 3, col = 512 * q + 8 * lane; const size_t off = (size_t)(MP + r) * D + col;
            const float* q1 = p1 + (size_t)r * D + col;
            f32x4 x0 = *(const f32x4*)q1, x1 = *(const f32x4*)(q1 + 4);
#pragma unroll
            for (int ch = 1; ch < 16; ++ch) { x0 = x0 + *(const f32x4*)(q1 + (size_t)ch * 512 * D); x1 = x1 + *(const f32x4*)(q1 + (size_t)ch * 512 * D + 4); }
            const v4u rr = *(const v4u*)(resid + off);
            float v[8] = {x0.x + DN_ALPHA * bflo(rr.x), x0.y + DN_ALPHA * bfhi(rr.x), x0.z + DN_ALPHA * bflo(rr.y), x0.w + DN_ALPHA * bfhi(rr.y),
                          x1.x + DN_ALPHA * bflo(rr.z), x1.y + DN_ALPHA * bfhi(rr.z), x1.z + DN_ALPHA * bflo(rr.w), x1.w + DN_ALPHA * bfhi(rr.w)};
            float s = 0.f, ss = 0.f;
#pragma unroll
            for (int i = 0; i < 8; ++i) { s += v[i]; ss += v[i] * v[i]; }
            s = wave_sum(s); ss = wave_sum(ss);
            if (lane == 0) { red[w * 2] = s; red[w * 2 + 1] = ss; }
            LDS_BARRIER();
            const int wb = (w >> 2) * 4; s = (red[wb * 2] + red[wb * 2 + 2]) + (red[wb * 2 + 4] + red[wb * 2 + 6]); ss = (red[wb * 2 + 1] + red[wb * 2 + 3]) + (red[wb * 2 + 5] + red[wb * 2 + 7]);
            const float mean = s * (1.f / D), rstd = rsqrtf(fmaxf(ss * (1.f / D) - mean * mean, 0.f) + LN_EPS);
            const f32x4 g0 = *(const f32x4*)(g + col), g1 = *(const f32x4*)(g + col + 4), b0 = *(const f32x4*)(bta + col), b1 = *(const f32x4*)(bta + col + 4);
            v4u o; o.x = pk2((v[0] - mean) * rstd * g0.x + b0.x, (v[1] - mean) * rstd * g0.y + b0.y); o.y = pk2((v[2] - mean) * rstd * g0.z + b0.z, (v[3] - mean) * rstd * g0.w + b0.w);
            o.z = pk2((v[4] - mean) * rstd * g1.x + b1.x, (v[5] - mean) * rstd * g1.y + b1.y); o.w = pk2((v[6] - mean) * rstd * g1.z + b1.z, (v[7] - mean) * rstd * g1.w + b1.w);
            *(v4u*)(dst + off) = o;
            LDS_BARRIER();
        }
    }
    for (int m0 = gw; m0 < MP; m0 += 4 * NGW) {
        v4u vv[4][4]; float s[4], ss[4];
#pragma unroll
        for (int i = 0; i < 4; ++i) { const int m = m0 + i * NGW; s[i] = 0.f; ss[i] = 0.f;
            if (m < MP) { if (lane < 32) { const float* sp = ST + (((size_t)(lane >> 2) * M + m) * 4 + (lane & 3)) * 2; s[i] = sp[0]; ss[i] = sp[1]; }
#pragma unroll
                for (int j = 0; j < 4; ++j) vv[i][j] = *(const v4u*)(VB + (size_t)m * D + j * 512 + lane * 8); } }
#pragma unroll
        for (int i = 0; i < 4; ++i) { const int m = m0 + i * NGW;
            if (m < MP) { const float st = wave_sum(s[i]), sst = wave_sum(ss[i]);
                const float mean = st * (1.f / D), rstd = rsqrtf(fmaxf(sst * (1.f / D) - mean * mean, 0.f) + LN_EPS);
#pragma unroll
                for (int j = 0; j < 4; ++j) { const int col = j * 512 + lane * 8; const v4u v = vv[i][j];
                    const f32x4 g0 = *(const f32x4*)(g + col), g1 = *(const f32x4*)(g + col + 4), b0 = *(const f32x4*)(bta + col), b1 = *(const f32x4*)(bta + col + 4);
                    v4u o; o.x = pk2((bflo(v.x) - mean) * rstd * g0.x + b0.x, (bfhi(v.x) - mean) * rstd * g0.y + b0.y); o.y = pk2((bflo(v.y) - mean) * rstd * g0.z + b0.z, (bfhi(v.y) - mean) * rstd * g0.w + b0.w);
                    o.z = pk2((bflo(v.z) - mean) * rstd * g1.x + b1.x, (bfhi(v.z) - mean) * rstd * g1.y + b1.y); o.w = pk2((bflo(v.w) - mean) * rstd * g1.z + b1.z, (bfhi(v.w) - mean) * rstd * g1.w + b1.w);
                    *(v4u*)(dst + (size_t)m * D + col) = o; } } }
    }
}
__device__ __forceinline__ void phase_combine(const float* p1, const bf16* h2, const bf16* pw, bf16* xb, float* outf, int vcu, int G, const int tid) {
    const int lane = tid & 63, w = tid >> 6;
    for (int r0 = 2 * vcu; r0 < MS; r0 += 2 * G) {
        const int r = r0 + (w >> 2), q = w & 3, col = 512 * q + 8 * lane; const size_t off = (size_t)(MP + r) * D + col;
        const float* q1 = p1 + (size_t)r * D + col;
        f32x4 x0 = *(const f32x4*)q1, x1 = *(const f32x4*)(q1 + 4);
#pragma unroll
        for (int ch = 1; ch < 16; ++ch) { x0 = x0 + *(const f32x4*)(q1 + (size_t)ch * 512 * D); x1 = x1 + *(const f32x4*)(q1 + (size_t)ch * 512 * D + 4); }
        const v4u hh = *(const v4u*)(h2 + off), pp = *(const v4u*)(pw + off);
        f32x4 o0, o1;
        o0.x = bflo(hh.x) + sigm(x0.x) * bflo(pp.x); o0.y = bfhi(hh.x) + sigm(x0.y) * bfhi(pp.x); o0.z = bflo(hh.y) + sigm(x0.z) * bflo(pp.y); o0.w = bfhi(hh.y) + sigm(x0.w) * bfhi(pp.y);
        o1.x = bflo(hh.z) + sigm(x1.x) * bflo(pp.z); o1.y = bfhi(hh.z) + sigm(x1.y) * bfhi(pp.z); o1.z = bflo(hh.w) + sigm(x1.z) * bflo(pp.w); o1.w = bfhi(hh.w) + sigm(x1.w) * bfhi(pp.w);
        v4u ob; ob.x = pk2(o0.x, o0.y); ob.y = pk2(o0.z, o0.w); ob.z = pk2(o1.x, o1.y); ob.w = pk2(o1.z, o1.w); *(v4u*)(xb + off) = ob;
        if (outf) { *(f32x4*)(outf + off) = o0; *(f32x4*)(outf + off + 4) = o1; }
    }
}

constexpr int N_PHASES = 22;
enum { OP_INPROJ = 0, OP_MIXA, OP_MIXB, OP_MIXC, OP_OUTPROJ, OP_LN1, OP_UP, OP_DOWN, OP_LN2, OP_GATE, OP_COMBINE };
enum { GK_LN = 0, GK_BF16 = 1, GK_SQRELU = 2, GK_COMB = 3 };
__global__ void __launch_bounds__(NTHR, 2) mk_fwd(Args a_in) {
    extern __shared__ __attribute__((aligned(16))) unsigned char lds_raw[];
    LAS unsigned char* lds = (LAS unsigned char*)lds_raw;
    ArgsP kp = (ArgsP)__builtin_amdgcn_kernarg_segment_ptr();
    const int lo = a_in.ph_lo, hi = a_in.ph_hi;
    int wv0; { const int wtmp = (int)threadIdx.x >> 6; asm volatile("s_nop 4\n\tv_readfirstlane_b32 %0, %1\n\ts_nop 4" : "=s"(wv0) : "v"(wtmp)); }
#if MK_N_LAUNCHES == 1
    volatile LAS unsigned* xst = (volatile LAS unsigned*)(lds + LDS_CTL_OFF);
    if (threadIdx.x < 2) xst[threadIdx.x] = 0u;
    __syncthreads();
    XcdBarrier bar = xcd_barrier_post((unsigned*)(a_in.ws + WS_CTL) + 4096, xst);
#endif
    int p = lo; asm volatile("" : "+s"(p));
#pragma unroll 1
    for (; p < hi; ) {
      int nrep = 1;
      if (PROBE_MASK) { const int L_ = p <= 11 ? 0 : 1; const int q_ = p == 0 ? -1 : (L_ == 0 ? p - 1 : (p - 12 < 3 ? p - 12 : p - 11));
        int grp; if (p == 0) grp = 0; else if (q_ == OP_INPROJ || q_ == OP_UP) grp = 1; else if (q_ == OP_OUTPROJ || q_ == OP_DOWN || q_ == OP_GATE) grp = 2; else if (q_ == OP_LN1 || q_ == OP_LN2 || q_ == OP_COMBINE) grp = 3; else grp = (L_ == 0) ? 4 : 5;
        if ((PROBE_MASK >> grp) & 1) nrep = 2; }
      if (p == PROBE_P) nrep = 2;
#pragma unroll 1
      for (int rep = 0; rep < nrep; ++rep) {
        int pp = p; asm volatile("" : "+s"(pp));
        int wvs = wv0; asm volatile("" : "+s"(wvs));
        unsigned ones = ~0u; asm volatile("" : "+s"(ones));
        int tid = (wvs << 6) | (int)__builtin_amdgcn_mbcnt_hi(ones, __builtin_amdgcn_mbcnt_lo(ones, 0u)); asm volatile("" : "+v"(tid));
        int bx = blockIdx.x; asm volatile("" : "+s"(bx));
        int G = gridDim.x; asm volatile("" : "+s"(G));
        ArgsP a = kp; asm volatile("" : "+s"(a));
#define MK_VCU ((G % 8 == 0) ? (bx % 8) * (G / 8) + bx / 8 : bx)
#define MK_WAVE (__builtin_amdgcn_readfirstlane(tid >> 6))
#define MK_GW (MK_VCU * NWAVES + MK_WAVE)
#define MK_NGW (G * NWAVES)
#define MK_LANE (tid & 63)
        unsigned char* ws = a->ws;
        if (pp == 0) {
phase_convert(a, lds, MK_GW, MK_NGW, MK_WAVE, MK_LANE); }
        else {
            const int L = pp <= 11 ? 0 : 1; const int q = L == 0 ? pp - 1 : (pp - 12 < 3 ? pp - 12 : pp - 11);
            bf16* xb = (bf16*)(ws + WS_XB); bf16* mixb = (bf16*)(ws + WS_MIX); bf16* hb = (bf16*)(ws + WS_H); bf16* h2b = (bf16*)(ws + WS_H2); bf16* pwb = (bf16*)(ws + WS_PW);
            bf16* projb = (bf16*)(ws + WS_PROJ); bf16* upb = (bf16*)(ws + WS_PROJ);
            bf16* vbb = (bf16*)(ws + WS_PART0); float* stb = (float*)(ws + WS_PART0 + 34 * MiB); float* part1 = (float*)(ws + WS_PART1); float* gatesb = (float*)(ws + WS_GATES);
            if (q == OP_MIXA) { if (L == 0) phase_mixer_even(a, lds, MK_VCU, G, tid); else phase_mixer_odd(a, lds, MK_VCU, G, tid); }
            else if (q == OP_MIXB) { if (L == 0) phase_mixer_even_b(a, lds, MK_VCU, G, tid); else phase_mixer_odd_b(a, lds, MK_VCU, G, tid); }
            else if (q == OP_MIXC) { phase_mixer_even_c(a, lds, MK_VCU, G, tid); }
            else if (q == OP_LN1) phase_ln(vbb, stb, part1, xb, a->in[I_LN1G] + L * D, a->in[I_LN1B] + L * D, hb, lds, MK_VCU, G, tid);
            else if (q == OP_LN2) phase_ln(vbb, stb, part1, hb, a->in[I_LN2G] + L * D, a->in[I_LN2B] + L * D, h2b, lds, MK_VCU, G, tid);
            else if (q == OP_COMBINE) phase_combine(part1, h2b, pwb, xb, L == 1 ? a->out + O_Y : nullptr, MK_VCU, G, tid);
            else {
                for (int sub = 0; sub < (q == OP_INPROJ ? 2 : 1); ++sub) {
                    const bf16* A; const bf16* Bt; int N, K, kind; void* out = nullptr; float* gp = nullptr; const bf16* resid = nullptr; int corder = bx, gorder = G;
                    const int busy_in = ((M / 256) * (NPROJ_PAD / 256)) % 256;
                    if (q == OP_INPROJ && sub == 0) { A = xb; Bt = (const bf16*)(ws + (L == 0 ? WS_WINE : WS_WINO)); N = NPROJ_PAD; K = D; kind = GK_BF16; out = projb; gp = gatesb; }
                    else if (q == OP_INPROJ) { A = (const bf16*)(ws + WS_PB) + (size_t)L * M * PLE; Bt = (const bf16*)(ws + WS_WPLE) + (size_t)L * PLE * D; N = D; K = PLE; kind = GK_BF16; out = pwb;
                        gorder = G - busy_in; corder = (bx >= busy_in) ? bx - busy_in : 1 << 20; }
                    else if (q == OP_OUTPROJ) { A = mixb; Bt = (const bf16*)(ws + (L == 0 ? WS_WOUTE : WS_WOUTO)); N = D; K = D; kind = GK_LN; resid = xb; }
                    else if (q == OP_UP) { A = hb; Bt = (const bf16*)(ws + WS_WUP) + (size_t)L * D * FF; N = FF; K = D; kind = GK_SQRELU; out = upb; }
                    else if (q == OP_DOWN) { A = upb; Bt = (const bf16*)(ws + WS_WDOWN) + (size_t)L * D * FF; N = D; K = FF; kind = GK_LN; resid = hb; }
                    else { A = h2b; Bt = (const bf16*)(ws + WS_WGATE) + (size_t)L * D * D; N = D; K = D; kind = GK_COMB; }
                    pg8::Gemm g{A, Bt, M, N, K};
                    if (kind == GK_LN) { pg8::MainSplit SK; SK.init(K, MK_VCU); pg8::EpiLnStat E{vbb, stb, resid, part1, N, M, DN_ALPHA}; pg8::gemm_phase<pg8::EpiLnStat, pg8::MainSplit, true, true>(lds, g, SK, E, tid); }
                    else if (kind == GK_COMB) { pg8::MainSplit SK; SK.init(K, MK_VCU); pg8::EpiCombine E{h2b, pwb, xb, L == 1 ? a->out + O_Y : nullptr, part1, N}; pg8::gemm_phase<pg8::EpiCombine, pg8::MainSplit, true, true>(lds, g, SK, E, tid); }
                    else if (kind == GK_BF16) { pg8::StaticOrder S; S.init(M, N, K, gorder, corder); pg8::EpiBf16<0> E{(bf16*)out, N, gp, 24}; pg8::gemm_phase<pg8::EpiBf16<0>, pg8::StaticOrder, true, true>(lds, g, S, E, tid);}
                    else { pg8::StaticOrder S; S.init(M, N, K, G, corder); pg8::EpiBf16<1> E{(bf16*)out, N, nullptr, -1}; pg8::gemm_phase<pg8::EpiBf16<1>, pg8::StaticOrder, true, true>(lds, g, S, E, tid);}
                }
                if (q == OP_INPROJ || q == OP_UP) {
                    const int busy = (q == OP_INPROJ) ? ((M / 256) * (NPROJ_PAD / 256)) % 256 : ((M / 256) * (FF / 256)) % 256;
                    const int first = (q == OP_INPROJ) ? (L == 0 ? 0 : cv::R_SCAN) : (L == 0 ? cv::R_IN1 : cv::R_UP0), last = (q == OP_INPROJ) ? (L == 0 ? cv::R_IN0 : cv::R_IN1) : (L == 0 ? cv::R_UP0 : cv::N_REST);
                    if (G == 256 && bx >= busy) { const int w_ = MK_WAVE; convert_range(a, (LAS float*)(lds + w_ * 16384), first, last, (bx - busy) * NWAVES + w_, (G - busy) * NWAVES, MK_LANE); }
                }
            }
        }
#if MK_N_LAUNCHES == 1
        if (p + 1 < hi || rep + 1 < nrep) xcd_barrier(bar);
#endif
      }
      asm volatile("s_add_i32 %0, %0, 1" : "+s"(p) : : "scc");
    }
}

extern "C" void kernel_launch(void* const* d_in, const int* in_sizes, int n_in, void* d_out, int out_size, void* d_ws, size_t ws_size, hipStream_t stream) {
    static int grid = 0;
    if (grid == 0) {
        if (n_in != 35 || (size_t)out_size != O_END || ws_size < WS_END) { fprintf(stderr, "kernel_launch: unexpected shapes: n_in %d out %d (want %zu) ws %zu (want %zu)\n", n_in, out_size, (size_t)O_END, ws_size, (size_t)WS_END); grid = -1; return; }
        int dev = 0, cus = 0, per_cu = 0;
        hipGetDevice(&dev); hipDeviceGetAttribute(&cus, hipDeviceAttributeMultiprocessorCount, dev);
        if (hipFuncSetAttribute((const void*)mk_fwd, hipFuncAttributeMaxDynamicSharedMemorySize, LDS_BYTES) != hipSuccess) { fprintf(stderr, "kernel_launch: hipFuncSetAttribute failed\n"); grid = -1; return; }
        if (hipOccupancyMaxActiveBlocksPerMultiprocessor(&per_cu, (const void*)mk_fwd, NTHR, LDS_BYTES) != hipSuccess || per_cu < 1) { fprintf(stderr, "kernel_launch: occupancy query says %d\n", per_cu); per_cu = 1; }
        (void)hipGetLastError();
        if (cus != 256) { fprintf(stderr, "kernel_launch: built for a 256-CU device (N = 2048 GEMM schedule), got %d\n", cus); grid = -1; return; }
        grid = cus * 1;
    }
    if (grid < 0) return;
    Args a{};
    for (int i = 0; i < 35; ++i) a.in[i] = (const float*)d_in[i];
    a.out = (float*)d_out; a.ws = (unsigned char*)d_ws;
#if MK_N_LAUNCHES == 1
    hipMemsetAsync((char*)d_ws + WS_CTL, 0, 1 * MiB, stream);
    a.ph_lo = 0; a.ph_hi = N_PHASES;
    hipLaunchKernelGGL(mk_fwd, dim3(grid), dim3(NTHR), LDS_BYTES, stream, a);
#else
    for (int p = 0; p < N_PHASES; ++p) {
        a.ph_lo = p; a.ph_hi = p + 1;
        hipLaunchKernelGGL(mk_fwd, dim3(grid), dim3(NTHR), LDS_BYTES, stream, a);
    }
#endif
}
```

```cpp
#include <hip/hip_runtime.h>
#include <hip/hip_cooperative_groups.h>
#include <cstdio>
#include <cstdint>
namespace cg = cooperative_groups;

#ifndef PROBE_MASK
#define PROBE_MASK 0
#endif
#define PROBE_P (-1)
#define PROBE_SUB 0
#ifndef MK_N_LAUNCHES
#define MK_N_LAUNCHES 1
#endif

namespace pg8 {
#define PG8_LAS __attribute__((address_space(3)))
typedef unsigned short bf16_t;
typedef short bf16x8 __attribute__((ext_vector_type(8)));
typedef float f32x4 __attribute__((ext_vector_type(4)));
typedef unsigned u32x4 __attribute__((ext_vector_type(4)));
constexpr int BM = 256, BK = 64, HALF = 128, HTB = HALF * BK * 2, STAGE_BYTES = 8 * HTB, NXCD = 8, WGM = 8;

__host__ __device__ __forceinline__ int lds_byte(int r, int c) { const int st = (r >> 4) * 2 + (c >> 5), rr = r & 15, cc = c & 31, ob = rr * 64 + cc * 2; return st * 1024 + (ob ^ (((ob >> 9) & 1) << 5)); }
__host__ __device__ __forceinline__ void stage_rc(int b, int& R, int& C) { const int st = b / 1024, sb = b % 1024, swz = sb ^ (((sb >> 9) & 1) << 5); R = (st >> 1) * 16 + swz / 64; C = (st & 1) * 32 + (swz % 64) / 2; }
__host__ __device__ __forceinline__ int perm32(int rho) { const int n = rho >> 4, i = rho & 15; return 8 * (i >> 2) + 4 * n + (i & 3); }

struct Unit { int pm, pn, kt0, nkt, dst; };
struct Gemm { const bf16_t* A; const bf16_t* Bt; int M, N, K; };

struct StaticOrder {
    int nM, nN, nwg, G, c, T;
    __host__ __device__ void init(int M, int N, int K, int G_, int c_) { nM = M / BM; nN = N / BM; nwg = nM * nN; G = G_; c = c_; T = K / BK; }
    __host__ __device__ bool next(int i, Unit& u) const {
        const long L = (long)i * G + c; if (L >= nwg) return false;
        int wgid = (int)L; { const int q = nwg / NXCD, r = nwg % NXCD, xcd = wgid % NXCD, off = wgid / NXCD; wgid = (xcd < r ? xcd * (q + 1) : r * (q + 1) + (xcd - r) * q) + off; }
        const int nig = WGM * nN, gid = wgid / nig, fm = gid * WGM, gsz = (nM - fm) < WGM ? (nM - fm) : WGM;
        u.pm = fm + ((wgid % nig) % gsz); u.pn = (wgid % nig) / gsz; u.kt0 = 0; u.nkt = T; u.dst = 0; return true;
    }
    __device__ __forceinline__ void a_ready(const Unit&) const {}
    __device__ __forceinline__ void done(const Unit&) const {}
};
struct StreamK {
    int nN, T, P, ntot, c;
    __host__ __device__ void init(int M, int N, int K, int G, int c_) { nN = N / BM; T = K / BK; ntot = (M / BM) * nN * T; P = (((ntot + G - 1) / G) + 1) & ~1; c = c_; }
    __host__ __device__ bool next(int i, Unit& u) const {
        int s = c * P; const int e = (s + P < ntot) ? s + P : ntot;
        for (int k = 0; ; ++k) { if (s >= e) return false; const int tile = s / T, kt0 = s - tile * T; const int n = (T - kt0 < e - s) ? T - kt0 : e - s;
            if (k == i) { u.pm = tile / nN; u.pn = tile - u.pm * nN; u.kt0 = kt0; u.nkt = n; u.dst = kt0 ? 1 : 0; return true; }
            s += n; }
    }
    __device__ __forceinline__ void a_ready(const Unit&) const {}
    __device__ __forceinline__ void done(const Unit&) const {}
};
struct MainSplit {
    int T, c;
    __host__ __device__ void init(int K, int c_) { T = K / BK; c = c_; }
    __host__ __device__ bool next(int i, Unit& u) const {
        if (i == 0) { u.pm = c >> 3; u.pn = c & 7; u.kt0 = 0; u.nkt = T; u.dst = 0; return true; }
        if (i == 1) { const int lt = c >> 4, j = c & 15; u.pm = 32 + (lt >> 3); u.pn = lt & 7; u.nkt = T >> 4; u.kt0 = j * u.nkt; u.dst = 1 + j; return true; }
        return false;
    }
    __device__ __forceinline__ void a_ready(const Unit&) const {}
    __device__ __forceinline__ void done(const Unit&) const {}
};
__host__ __device__ __forceinline__ bool split_tile(int tile, int T, int P) { return (tile * T) / P != ((tile + 1) * T - 1) / P; }

typedef __bf16 hwbf16x2 __attribute__((ext_vector_type(2)));
typedef float hwf32x2 __attribute__((ext_vector_type(2)));
__device__ __forceinline__ unsigned cvt_pk_bf16(float lo, float hi) { return __builtin_bit_cast(unsigned, __builtin_convertvector((hwf32x2){lo, hi}, hwbf16x2)); }

__device__ __forceinline__ float pg_bflo(unsigned w) { return __builtin_bit_cast(float, w << 16); }
__device__ __forceinline__ float pg_bfhi(unsigned w) { return __builtin_bit_cast(float, w & 0xffff0000u); }
__device__ __forceinline__ void store_chunk(const f32x4 (&acc)[2][2][4][2], const Unit& u, float* C1, int ldc, int wr, int wc, int fr, int fq) {
    const int row0 = u.pm * BM + wr * 64 + fr, col0 = u.pn * BM + wc * 32 + 8 * fq; float* Cb = C1 + ((long)(u.dst - 1) * 512 - 8192) * (long)ldc;
#pragma unroll
    for (int ai = 0; ai < 2; ++ai)
#pragma unroll
        for (int m = 0; m < 4; ++m) { float* rowp = Cb + (size_t)(row0 + ai * HALF + m * 16) * ldc + col0;
#pragma unroll
            for (int bj = 0; bj < 2; ++bj) { *(f32x4*)(rowp + bj * HALF) = acc[ai][bj][m][0]; *(f32x4*)(rowp + bj * HALF + 4) = acc[ai][bj][m][1]; } }
}
struct EpiLnStat {
    static constexpr bool PERM = true, AFTER_DRAIN = false;
    bf16_t* VB; float* ST; const bf16_t* resid; float* C1; int ldc; int mrows; float alpha;
    __device__ __forceinline__ void operator()(const f32x4 (&acc)[2][2][4][2], const Unit& u, int wr, int wc, int fr, int fq) const {
        if (u.dst) { store_chunk(acc, u, C1, ldc, wr, wc, fr, fq); return; }
        const int row0 = u.pm * BM + wr * 64 + fr, col0 = u.pn * BM + wc * 32 + 8 * fq;
        u32x4 rq[2];
#pragma unroll
        for (int bj = 0; bj < 2; ++bj) rq[bj] = *(const u32x4*)(resid + (size_t)(row0) * ldc + col0 + bj * HALF);
#pragma unroll
        for (int idx = 0; idx < 8; ++idx) { const int ai = idx >> 2, m = idx & 3; const int row = row0 + ai * HALF + m * 16; float s = 0.f, ss = 0.f;
                u32x4 rc[2] = {rq[0], rq[1]};
                if (idx + 1 < 8) { const int nrow = row0 + ((idx + 1) >> 2) * HALF + ((idx + 1) & 3) * 16;
#pragma unroll
                    for (int bj = 0; bj < 2; ++bj) rq[bj] = *(const u32x4*)(resid + (size_t)nrow * ldc + col0 + bj * HALF); }
#pragma unroll
                for (int bj = 0; bj < 2; ++bj) { const size_t off = (size_t)row * ldc + col0 + bj * HALF; const u32x4 r = rc[bj];
                    f32x4 v0 = acc[ai][bj][m][0], v1 = acc[ai][bj][m][1];
                    v0[0] += alpha * pg_bflo(r.x); v0[1] += alpha * pg_bfhi(r.x); v0[2] += alpha * pg_bflo(r.y); v0[3] += alpha * pg_bfhi(r.y);
                    v1[0] += alpha * pg_bflo(r.z); v1[1] += alpha * pg_bfhi(r.z); v1[2] += alpha * pg_bflo(r.w); v1[3] += alpha * pg_bfhi(r.w);
                    s += ((v0[0] + v0[1]) + (v0[2] + v0[3])) + ((v1[0] + v1[1]) + (v1[2] + v1[3]));
                    ss += ((v0[0] * v0[0] + v0[1] * v0[1]) + (v0[2] * v0[2] + v0[3] * v0[3])) + ((v1[0] * v1[0] + v1[1] * v1[1]) + (v1[2] * v1[2] + v1[3] * v1[3]));
                    u32x4 w; w.x = cvt_pk_bf16(v0[0], v0[1]); w.y = cvt_pk_bf16(v0[2], v0[3]); w.z = cvt_pk_bf16(v1[0], v1[1]); w.w = cvt_pk_bf16(v1[2], v1[3]);
                    *(u32x4*)(VB + off) = w; }
                s += __shfl_xor(s, 16); s += __shfl_xor(s, 32); ss += __shfl_xor(ss, 16); ss += __shfl_xor(ss, 32);
                if (fq == 0) { float* sp = ST + (((size_t)u.pn * mrows + row) * 4 + wc) * 2; sp[0] = s; sp[1] = ss; } }
    }
};
struct EpiCombine {
    static constexpr bool PERM = true, AFTER_DRAIN = false;
    const bf16_t* h2; const bf16_t* pw; bf16_t* xb; float* outf; float* C1; int ldc;
    __device__ __forceinline__ void operator()(const f32x4 (&acc)[2][2][4][2], const Unit& u, int wr, int wc, int fr, int fq) const {
        if (u.dst) { store_chunk(acc, u, C1, ldc, wr, wc, fr, fq); return; }
        const int row0 = u.pm * BM + wr * 64 + fr, col0 = u.pn * BM + wc * 32 + 8 * fq;
        u32x4 hq[2], pq[2];
#pragma unroll
        for (int bj = 0; bj < 2; ++bj) { const size_t o0 = (size_t)row0 * ldc + col0 + bj * HALF; hq[bj] = *(const u32x4*)(h2 + o0); pq[bj] = *(const u32x4*)(pw + o0); }
#pragma unroll
        for (int idx = 0; idx < 8; ++idx) { const int ai = idx >> 2, m = idx & 3; const int row = row0 + ai * HALF + m * 16;
                u32x4 hc[2] = {hq[0], hq[1]}, pc[2] = {pq[0], pq[1]};
                if (idx + 1 < 8) { const int nrow = row0 + ((idx + 1) >> 2) * HALF + ((idx + 1) & 3) * 16;
#pragma unroll
                    for (int bj = 0; bj < 2; ++bj) { const size_t on = (size_t)nrow * ldc + col0 + bj * HALF; hq[bj] = *(const u32x4*)(h2 + on); pq[bj] = *(const u32x4*)(pw + on); } }
#pragma unroll
                for (int bj = 0; bj < 2; ++bj) { const size_t off = (size_t)row * ldc + col0 + bj * HALF; const u32x4 hh = hc[bj], pp = pc[bj];
                    const f32x4 a0 = acc[ai][bj][m][0], a1 = acc[ai][bj][m][1]; f32x4 o0, o1;
                    o0[0] = pg_bflo(hh.x) + pg_bflo(pp.x) / (1.f + __expf(-a0[0])); o0[1] = pg_bfhi(hh.x) + pg_bfhi(pp.x) / (1.f + __expf(-a0[1]));
                    o0[2] = pg_bflo(hh.y) + pg_bflo(pp.y) / (1.f + __expf(-a0[2])); o0[3] = pg_bfhi(hh.y) + pg_bfhi(pp.y) / (1.f + __expf(-a0[3]));
                    o1[0] = pg_bflo(hh.z) + pg_bflo(pp.z) / (1.f + __expf(-a1[0])); o1[1] = pg_bfhi(hh.z) + pg_bfhi(pp.z) / (1.f + __expf(-a1[1]));
                    o1[2] = pg_bflo(hh.w) + pg_bflo(pp.w) / (1.f + __expf(-a1[2])); o1[3] = pg_bfhi(hh.w) + pg_bfhi(pp.w) / (1.f + __expf(-a1[3]));
                    u32x4 w; w.x = cvt_pk_bf16(o0[0], o0[1]); w.y = cvt_pk_bf16(o0[2], o0[3]); w.z = cvt_pk_bf16(o1[0], o1[1]); w.w = cvt_pk_bf16(o1[2], o1[3]);
                    *(u32x4*)(xb + off) = w;
                    if (outf) { *(f32x4*)(outf + off) = o0; *(f32x4*)(outf + off + 4) = o1; } } }
    }
};
template <int ACT> struct EpiBf16 {
    static constexpr bool PERM = true, AFTER_DRAIN = false;
    bf16_t* O; int ldc; float* gates; int gate_pn;
    __device__ __forceinline__ void operator()(const f32x4 (&acc)[2][2][4][2], const Unit& u, int wr, int wc, int fr, int fq) const {
        const int row0 = u.pm * BM + wr * 64 + fr; const int col0 = u.pn * BM + wc * 32 + 8 * fq;
        const bool gt = (gates != nullptr) && (u.pn == gate_pn) && (wc == 0) && (fq < 2);
#pragma unroll
        for (int ai = 0; ai < 2; ++ai)
#pragma unroll
            for (int m = 0; m < 4; ++m) { const int row = row0 + ai * HALF + m * 16; bf16_t* rowp = O + (size_t)row * ldc + col0;
#pragma unroll
                for (int bj = 0; bj < 2; ++bj) { f32x4 v0 = acc[ai][bj][m][0], v1 = acc[ai][bj][m][1];
                    if (ACT == 1) {
#pragma unroll
                        for (int j = 0; j < 4; ++j) { const float a = fmaxf(v0[j], 0.f), b = fmaxf(v1[j], 0.f); v0[j] = a * a; v1[j] = b * b; } }
                    u32x4 w; w.x = cvt_pk_bf16(v0[0], v0[1]); w.y = cvt_pk_bf16(v0[2], v0[3]); w.z = cvt_pk_bf16(v1[0], v1[1]); w.w = cvt_pk_bf16(v1[2], v1[3]);
                    *(u32x4*)(rowp + bj * HALF) = w; }
                if (gt) { float* gp = gates + (size_t)row * 16 + 8 * fq; *(f32x4*)gp = acc[ai][0][m][0]; *(f32x4*)(gp + 4) = acc[ai][0][m][1]; } }
    }
};

template <class Epi, class Sched, bool ALIGN_EPI = false, bool SP2 = false>
__device__ __forceinline__ void gemm_phase(PG8_LAS unsigned char* lds, const Gemm g, const Sched& S, const Epi& E, const int tid) {
    const int wid = __builtin_amdgcn_readfirstlane(tid >> 6), lane = tid & 63, wr = wid >> 2, wc = wid & 3, fr = lane & 15, fq = lane >> 4;
    const int K = g.K;
    unsigned voffA[2], voffB[2];
#pragma unroll
    for (int i = 0; i < 2; ++i) { int R, C; stage_rc(tid * 16 + i * 8192, R, C); const int Rb = Epi::PERM ? ((R & ~31) + perm32(R & 31)) : R;
        voffA[i] = (unsigned)(R * K + C) * 2u; voffB[i] = (unsigned)(Rb * K + C) * 2u; }
    const size_t kstep = (size_t)(BK * 2);
    const size_t hstep = (size_t)HALF * K * 2;
    const size_t tstep = 2 * hstep;
    const unsigned ldsw = (unsigned)wid * 1024u;
    const int aoff = lds_byte(wr * 64 + fr, fq * 8), boff = lds_byte(wc * 32 + fr, fq * 8);
#define PG8_SA(b, h) (((b) * 2 + (h)) * HTB)
#define PG8_SB(b, h) ((4 + (b) * 2 + (h)) * HTB)
#define PG8_STAGE(bufoff, gbase, voff) do { _Pragma("unroll") for (int _i = 0; _i < 2; ++_i) \
        __builtin_amdgcn_global_load_lds((const unsigned*)((const char*)(gbase) + (voff)[_i]), (PG8_LAS unsigned*)(lds + (bufoff) + ldsw + _i * 8192), 16, 0, 0); } while (0)
#define PG8_LDA(dst, b, h) do { _Pragma("unroll") for (int m = 0; m < 4; ++m) _Pragma("unroll") for (int k = 0; k < 2; ++k) dst[m][k] = *(const PG8_LAS bf16x8*)(lds + PG8_SA(b, h) + aoff + m * 2048 + k * 1024); } while (0)
#define PG8_LDB(dst, b, h) do { _Pragma("unroll") for (int n = 0; n < 2; ++n) _Pragma("unroll") for (int k = 0; k < 2; ++k) dst[n][k] = *(const PG8_LAS bf16x8*)(lds + PG8_SB(b, h) + boff + n * 2048 + k * 1024); } while (0)
#define PG8_MMA(ai, bj, At, Bt) do { __builtin_amdgcn_s_setprio(1); _Pragma("unroll") for (int m = 0; m < 4; ++m) _Pragma("unroll") for (int n = 0; n < 2; ++n) _Pragma("unroll") for (int k = 0; k < 2; ++k) \
        acc[ai][bj][m][n] = __builtin_amdgcn_mfma_f32_16x16x32_bf16(Bt[n][k], At[m][k], acc[ai][bj][m][n], 0, 0, 0); __builtin_amdgcn_s_setprio(0); } while (0)
#define PG8_WAIT_V(n) asm volatile("s_waitcnt vmcnt(" #n ")" ::: "memory")
#define PG8_WAIT_L(n) asm volatile("s_waitcnt lgkmcnt(" #n ")" ::: "memory")
#define PG8_BAR __builtin_amdgcn_s_barrier()
#define PG8_SCHED __builtin_amdgcn_sched_barrier(0)
    Unit cur, nxt; int ui = 0;
    if (!S.next(0, cur)) return;
    f32x4 acc[2][2][4][2];
#pragma unroll
    for (int a = 0; a < 2; ++a)
#pragma unroll
        for (int b = 0; b < 2; ++b)
#pragma unroll
            for (int m = 0; m < 4; ++m)
#pragma unroll
                for (int n = 0; n < 2; ++n) acc[a][b][m][n] = (f32x4){0.f, 0.f, 0.f, 0.f};
    bf16x8 At[4][2], B0[2][2], B1[2][2];
    const char* cA = (const char*)g.A + (size_t)cur.pm * tstep + (size_t)cur.kt0 * kstep; const char* cB = (const char*)g.Bt + (size_t)cur.pn * tstep + (size_t)cur.kt0 * kstep;
    S.a_ready(cur);
    if constexpr (SP2) {
        PG8_STAGE(PG8_SB(0, 0), cB, voffB); PG8_STAGE(PG8_SB(0, 1), cB + hstep, voffB); PG8_STAGE(PG8_SA(0, 0), cA, voffA); PG8_STAGE(PG8_SA(0, 1), cA + hstep, voffA);
        if (wr == 1) PG8_BAR;
        PG8_WAIT_V(2); PG8_BAR;
        PG8_STAGE(PG8_SB(1, 0), cB + kstep, voffB); PG8_STAGE(PG8_SA(1, 0), cA + kstep, voffA); PG8_STAGE(PG8_SB(1, 1), cB + hstep + kstep, voffB);
        PG8_WAIT_V(6); PG8_BAR;
    } else {
        PG8_STAGE(PG8_SB(0, 0), cB, voffB); PG8_STAGE(PG8_SA(0, 0), cA, voffA); PG8_STAGE(PG8_SB(0, 1), cB + hstep, voffB); PG8_STAGE(PG8_SA(0, 1), cA + hstep, voffA);
        if (wr == 1) PG8_BAR;
        PG8_WAIT_V(4); PG8_BAR;
        PG8_STAGE(PG8_SB(1, 0), cB + kstep, voffB); PG8_STAGE(PG8_SA(1, 0), cA + kstep, voffA); PG8_STAGE(PG8_SB(1, 1), cB + hstep + kstep, voffB);
        PG8_WAIT_V(6); PG8_BAR;
    }
    for (;;) {
        const bool has_next = S.next(ui + 1, nxt);
        const char* nA = has_next ? (const char*)g.A + (size_t)nxt.pm * tstep + (size_t)nxt.kt0 * kstep : cA; const char* nB = has_next ? (const char*)g.Bt + (size_t)nxt.pn * tstep + (size_t)nxt.kt0 * kstep : cB;
        const int nt = cur.nkt;
        for (int t = 0; t < nt; t += 2) {
            const bool last = (t == nt - 2);
            const char* a1 = cA + (size_t)(t + 1) * kstep;
            const char* a2 = last ? nA : cA + (size_t)(t + 2) * kstep; const char* b2 = last ? nB : cB + (size_t)(t + 2) * kstep;
            const char* a3 = a2 + kstep; const char* b3 = b2 + kstep;
            if (last && has_next) S.a_ready(nxt);
            if constexpr (SP2) {
            PG8_LDB(B0, 0, 0); PG8_LDB(B1, 0, 1); PG8_SCHED; PG8_LDA(At, 0, 0); PG8_STAGE(PG8_SA(1, 1), a1 + hstep, voffA);
            PG8_WAIT_V(8); PG8_WAIT_L(0); PG8_BAR; PG8_MMA(0, 0, At, B0); PG8_MMA(0, 1, At, B1); PG8_BAR; PG8_SCHED;
            PG8_LDA(At, 0, 1); PG8_STAGE(PG8_SB(0, 0), b2, voffB); PG8_STAGE(PG8_SB(0, 1), b2 + hstep, voffB); PG8_STAGE(PG8_SA(0, 0), a2, voffA);
            PG8_WAIT_V(8); PG8_WAIT_L(0); PG8_BAR; PG8_MMA(1, 0, At, B0); PG8_MMA(1, 1, At, B1); PG8_BAR; PG8_SCHED;
            PG8_LDB(B0, 1, 0); PG8_LDB(B1, 1, 1); PG8_SCHED; PG8_LDA(At, 1, 0); PG8_STAGE(PG8_SA(0, 1), a2 + hstep, voffA);
            PG8_WAIT_V(8); PG8_WAIT_L(0); PG8_BAR; PG8_MMA(0, 0, At, B0); PG8_MMA(0, 1, At, B1); PG8_BAR; PG8_SCHED;
            PG8_LDA(At, 1, 1); PG8_STAGE(PG8_SB(1, 0), b3, voffB); PG8_STAGE(PG8_SB(1, 1), b3 + hstep, voffB); PG8_STAGE(PG8_SA(1, 0), a3, voffA);
            PG8_WAIT_V(8); PG8_WAIT_L(0); PG8_BAR; PG8_MMA(1, 0, At, B0); PG8_MMA(1, 1, At, B1); PG8_BAR; PG8_SCHED;
            } else {
            PG8_LDB(B0, 0, 0); PG8_SCHED; PG8_LDA(At, 0, 0); PG8_STAGE(PG8_SA(1, 1), a1 + hstep, voffA);
            PG8_WAIT_L(8); PG8_BAR; PG8_WAIT_L(0); PG8_MMA(0, 0, At, B0); PG8_BAR; PG8_SCHED;
            PG8_LDB(B1, 0, 1); PG8_STAGE(PG8_SB(0, 0), b2, voffB);
            PG8_BAR; PG8_WAIT_L(0); PG8_MMA(0, 1, At, B1); PG8_BAR;
            PG8_LDA(At, 0, 1); PG8_STAGE(PG8_SA(0, 0), a2, voffA);
            PG8_BAR; PG8_WAIT_L(0); PG8_MMA(1, 0, At, B0); PG8_BAR; PG8_SCHED;
            PG8_STAGE(PG8_SB(0, 1), b2 + hstep, voffB);
            PG8_WAIT_V(6); PG8_BAR; PG8_MMA(1, 1, At, B1); PG8_BAR;
            PG8_LDB(B0, 1, 0); PG8_SCHED; PG8_LDA(At, 1, 0); PG8_STAGE(PG8_SA(0, 1), a2 + hstep, voffA);
            PG8_WAIT_L(8); PG8_BAR; PG8_WAIT_L(0); PG8_MMA(0, 0, At, B0); PG8_BAR; PG8_SCHED;
            PG8_LDB(B1, 1, 1); PG8_STAGE(PG8_SB(1, 0), b3, voffB);
            PG8_BAR; PG8_WAIT_L(0); PG8_MMA(0, 1, At, B1); PG8_BAR;
            PG8_LDA(At, 1, 1); PG8_STAGE(PG8_SA(1, 0), a3, voffA);
            PG8_BAR; PG8_WAIT_L(0); PG8_MMA(1, 0, At, B0); PG8_BAR; PG8_SCHED;
            PG8_STAGE(PG8_SB(1, 1), b3 + hstep, voffB);
            PG8_WAIT_V(6); PG8_BAR; PG8_MMA(1, 1, At, B1); PG8_BAR;
            }
        }
        if constexpr (ALIGN_EPI) { if (wr == 0) PG8_BAR; }
        E(acc, cur, wr, wc, fr, fq); S.done(cur);
        if (!has_next) break;
#pragma unroll
        for (int a = 0; a < 2; ++a)
#pragma unroll
            for (int b = 0; b < 2; ++b)
#pragma unroll
                for (int m = 0; m < 4; ++m)
#pragma unroll
                    for (int n = 0; n < 2; ++n) acc[a][b][m][n] = (f32x4){0.f, 0.f, 0.f, 0.f};
        cur = nxt; cA = nA; cB = nB; ++ui;
        if constexpr (ALIGN_EPI) { if (wr == 1) PG8_BAR; }
    }
    PG8_WAIT_V(0);
    if constexpr (!ALIGN_EPI) { if (wr == 0) PG8_BAR; }
    PG8_BAR;
#undef PG8_SA
#undef PG8_SB
#undef PG8_STAGE
#undef PG8_LDA
#undef PG8_LDB
#undef PG8_MMA
#undef PG8_WAIT_V
#undef PG8_WAIT_L
#undef PG8_BAR
#undef PG8_SCHED
}
}

constexpr int NWAVES = 8, NTHR = 512;
constexpr int D = 2048, FF = 8192, PLE = 256;
constexpr int TP = 2048, BP = 4, TS = 4, BS = 128;
constexpr int MP = BP * TP, MS = BS * TS, M = MP + MS;
constexpr int NPROJ = 6160, NPROJ_PAD = 6400;
constexpr int NH = 8;
constexpr float LN_EPS = 1e-5f, RMS_EPS = 1e-6f;
constexpr float DN_ALPHA = 1.41421356237f;

constexpr size_t MiB = 1u << 20;
constexpr size_t WS_CTL = 0;
constexpr size_t WS_WINE = 1 * MiB;
constexpr size_t WS_WOUTE = WS_WINE + 25 * MiB;
constexpr size_t WS_WINO = WS_WOUTE + 8 * MiB;
constexpr size_t WS_WOUTO = WS_WINO + 25 * MiB;
constexpr size_t WS_WUP = WS_WOUTO + 8 * MiB;
constexpr size_t WS_WDOWN = WS_WUP + 64 * MiB;
constexpr size_t WS_WPLE = WS_WDOWN + 64 * MiB;
constexpr size_t WS_WGATE = WS_WPLE + 2 * MiB;
constexpr size_t WS_XB = WS_WGATE + 16 * MiB;
constexpr size_t WS_MIX = WS_XB + 34 * MiB;
constexpr size_t WS_H = WS_MIX + 34 * MiB;
constexpr size_t WS_H2 = WS_H + 34 * MiB;
constexpr size_t WS_PW = WS_H2 + 34 * MiB;
constexpr size_t WS_PB = WS_PW + 34 * MiB;
constexpr size_t WS_GATES = WS_PB + 9 * MiB;
constexpr size_t WS_PROJ = WS_GATES + 1 * MiB;
constexpr size_t WS_PART0 = WS_PROJ + 136 * MiB;
constexpr size_t WS_PART1 = WS_PART0 + 68 * MiB;
constexpr size_t WS_LRUW = WS_PART1 + 68 * MiB;
constexpr size_t WS_END = WS_LRUW + 1 * MiB;
constexpr size_t WS_DG = WS_PART0;
constexpr size_t WS_DB = WS_PART0 + 32 * MiB;
constexpr size_t WS_DS = WS_PART0 + 64 * MiB;
constexpr size_t WS_DQ = WS_PART0 + 96 * MiB;
constexpr size_t WS_DO = WS_PART0 + 112 * MiB;
constexpr size_t WS_DD = WS_PART0 + 128 * MiB;
constexpr size_t WS_DF = WS_PART0 + 129 * MiB;
constexpr size_t WS_MC = WS_PART0;
constexpr size_t WS_MN = WS_PART0 + 64 * MiB;
constexpr size_t WS_MM = WS_PART0 + 65 * MiB;
constexpr size_t WS_LRU_HL = WS_H;
constexpr size_t WS_LRU_P = WS_H + 16 * MiB;
constexpr size_t WS_LRU_END = WS_H + 32 * MiB;

constexpr size_t O_Y = 0;
constexpr size_t O_CONVP = (size_t)M * D;
constexpr size_t O_DELTAP = O_CONVP + (size_t)BP * 3 * 4096;
constexpr size_t O_LRUP = O_DELTAP + (size_t)BP * 8 * 128 * 128;
constexpr size_t O_MCP = O_LRUP + (size_t)BP * 1024;
constexpr size_t O_MNP = O_MCP + (size_t)BP * 8 * 256 * 128;
constexpr size_t O_MMP = O_MNP + (size_t)BP * 8 * 128;
constexpr size_t O_CONVS = O_MMP + (size_t)BP * 8;
constexpr size_t O_DELTAS = O_CONVS + (size_t)BS * 3 * 4096;
constexpr size_t O_LRUS = O_DELTAS + (size_t)BS * 8 * 128 * 128;
constexpr size_t O_MCS = O_LRUS + (size_t)BS * 1024;
constexpr size_t O_MNS = O_MCS + (size_t)BS * 8 * 256 * 128;
constexpr size_t O_MMS = O_MNS + (size_t)BS * 8 * 128;
constexpr size_t O_END = O_MMS + (size_t)BS * 8;

constexpr int LDS_BYTES = 147456;
constexpr int LDS_CTL_OFF = 131072;

#define LAS __attribute__((address_space(3)))
typedef unsigned short bf16;
typedef unsigned v4u __attribute__((ext_vector_type(4)));
typedef unsigned v2u __attribute__((ext_vector_type(2)));
typedef float f32x4 __attribute__((ext_vector_type(4)));
#define LDS_WAIT() asm volatile("s_waitcnt lgkmcnt(0)" ::: "memory")
#define LDS_BARRIER() do { asm volatile("s_waitcnt lgkmcnt(0)" ::: "memory"); __builtin_amdgcn_s_barrier(); asm volatile("" ::: "memory"); } while (0)
__device__ __forceinline__ unsigned pk2(float lo, float hi) { return pg8::cvt_pk_bf16(lo, hi); }
__device__ __forceinline__ unsigned f2bf(float f) { return pg8::cvt_pk_bf16(f, 0.f) & 0xffffu; }
__device__ __forceinline__ float bf2f(unsigned short b) { return __builtin_bit_cast(float, ((unsigned)b) << 16); }
__device__ __forceinline__ float bflo(unsigned w) { return __builtin_bit_cast(float, w << 16); }
__device__ __forceinline__ float bfhi(unsigned w) { return __builtin_bit_cast(float, w & 0xffff0000u); }
__device__ __forceinline__ float fexp(float x) { return __builtin_amdgcn_exp2f(x * 1.4426950408889634f); }
__device__ __forceinline__ float sigm(float x) { return __builtin_amdgcn_rcpf(1.f + fexp(-x)); }
__device__ __forceinline__ float siluf(float x) { return x * sigm(x); }
__device__ __forceinline__ float softplusf(float x) { return fmaxf(x, 0.f) + log1pf(expf(-fabsf(x))); }
__device__ __forceinline__ float logsigf(float x) { return -softplusf(-x); }
__device__ __forceinline__ float neg_expm1(float y) {
    const float ser = -y * (1.f + y * (0.5f + y * (0.16666667f + y * (0.041666668f + y * (0.008333334f + y * 0.0013888889f)))));
    return (y > -0.25f) ? ser : 1.f - fexp(y);
}
__device__ __forceinline__ float gelu_tanh(float x) { const float u = 0.7978845608028654f * (x + 0.044715f * x * x * x); return x * sigm(2.f * u); }
__device__ __forceinline__ float wave_sum(float v) {
#pragma unroll
    for (int o = 1; o < 64; o <<= 1) v += __shfl_xor(v, o);
    return v;
}

__device__ __forceinline__ float wave_incl_sum(float v, int lane) {
#pragma unroll
    for (int o = 1; o < 64; o <<= 1) { const float u = __shfl_up(v, o); if (lane >= o) v += u; }
    return v;
}
__device__ __forceinline__ float wave_incl_max(float v, int lane) {
#pragma unroll
    for (int o = 1; o < 64; o <<= 1) { const float u = __shfl_up(v, o); if (lane >= o) v = fmaxf(v, u); }
    return v;
}
__device__ __forceinline__ float wave_max(float v) {
#pragma unroll
    for (int o = 1; o < 64; o <<= 1) v = fmaxf(v, __shfl_xor(v, o));
    return v;
}
#define XB_TMO      128
#define XB_XCNT(j)  (256  + 64 * (j))
#define XB_XSUB(j)  (1280 + 64 * (j))
#define XB_XGEN(j)  (2304 + 64 * (j))
#define XB_TOP      3328
#define XB_TOPGEN   3392
#define XCD_BAR_WORDS 3456
#define XB_SPIN_CAP (1u << 22)
__device__ __forceinline__ unsigned xb_ld(unsigned* p)              { return __hip_atomic_load(p, __ATOMIC_RELAXED, __HIP_MEMORY_SCOPE_AGENT); }
__device__ __forceinline__ unsigned xb_add(unsigned* p, unsigned v) { return __hip_atomic_fetch_add(p, v, __ATOMIC_RELAXED, __HIP_MEMORY_SCOPE_AGENT); }
__device__ __forceinline__ unsigned xb_xcc_id() { return (unsigned)__builtin_amdgcn_s_getreg((3 << 11) | 20) & 0xFu; }
#define XB_SPIN(cond, bar) do { unsigned _sp = 0; while (cond) { __builtin_amdgcn_s_sleep(1); \
    if ((++_sp & 255u) == 0u) { if (xb_ld(&(bar)[XB_TMO])) break; if (_sp > XB_SPIN_CAP) { atomicAdd(&(bar)[XB_TMO], 1u); break; } } } } while (0)
struct XcdBarrier { unsigned* bar; unsigned x; volatile LAS unsigned* st; };
__device__ __forceinline__ XcdBarrier xcd_barrier_post(unsigned* bar, volatile LAS unsigned* st) {
    XcdBarrier b; b.bar = bar; b.x = xb_xcc_id(); b.st = st;
    if (threadIdx.x == 0) (void)xb_add(&bar[XB_XCNT(b.x)], 1u);
    return b;
}
__device__ __forceinline__ void xcd_barrier_complete(unsigned* bar, unsigned x, unsigned& nloc, unsigned& nx) {
    const unsigned G = gridDim.x * gridDim.y * gridDim.z;
    unsigned sum, cnt, mine, sp = 0u;
    for (;;) {
        sum = 0u; cnt = 0u; mine = 0u;
#pragma unroll
        for (unsigned j = 0; j < 16; ++j) { const unsigned c = xb_ld(&bar[XB_XCNT(j)]); sum += c; cnt += (c > 0u) ? 1u : 0u; mine = (j == x) ? c : mine; }
        if (sum == G) break;
        __builtin_amdgcn_s_sleep(1);
        if ((++sp & 255u) == 0u) { if (xb_ld(&bar[XB_TMO])) break; if (sp > XB_SPIN_CAP) { atomicAdd(&bar[XB_TMO], 1u); break; } }
    }
    nloc = mine > 0u ? mine : 1u; nx = cnt > 0u ? cnt : 1u;
}
__device__ __forceinline__ void xcd_barrier(const XcdBarrier& b) {
    asm volatile("s_waitcnt vmcnt(0)" ::: "memory");
    __syncthreads();
    if (threadIdx.x == 0) {
        unsigned* bar = b.bar;
        __builtin_amdgcn_s_waitcnt(0);
        unsigned nloc = b.st[0], nx = b.st[1];
        if (nloc == 0u) { xcd_barrier_complete(bar, b.x, nloc, nx); b.st[0] = nloc; b.st[1] = nx; }
        const unsigned old = xb_add(&bar[XB_XSUB(b.x)], 1u);
        const unsigned gen = old / nloc;
        if (old + 1u == (gen + 1u) * nloc) {
            __builtin_amdgcn_fence(__ATOMIC_RELEASE, "agent");
            asm volatile("s_waitcnt vmcnt(0)" ::: "memory");
            const unsigned og = xb_add(&bar[XB_TOP], 1u);
            const unsigned tg = og / nx;
            if (og + 1u == (tg + 1u) * nx) xb_add(&bar[XB_TOPGEN], 1u);
            else XB_SPIN(xb_ld(&bar[XB_TOPGEN]) == tg, bar);
            __builtin_amdgcn_fence(__ATOMIC_ACQUIRE, "agent");
            xb_add(&bar[XB_XGEN(b.x)], 1u);
            asm volatile("s_waitcnt vmcnt(0)" ::: "memory");
        } else {
            XB_SPIN(xb_ld(&bar[XB_XGEN(b.x)]) == gen, bar);
            __builtin_amdgcn_fence(__ATOMIC_ACQUIRE, "agent");
            asm volatile("s_waitcnt vmcnt(0)" ::: "memory");
        }
    }
    __syncthreads();
}

struct Args { const float* in[35]; float* out; unsigned char* ws; int ph_lo, ph_hi; };
typedef const __attribute__((address_space(4))) Args* ArgsP;
enum { I_XP = 0, I_XS, I_PP, I_PS, I_SCONV, I_SDELTA, I_SLRU, I_SMC, I_SMN, I_SMM, I_WINE, I_WCONV, I_BCONV, I_ALOG, I_DTB, I_DNORM, I_LWR, I_LBR, I_LWI, I_LBI, I_LLAM, I_WOUTE,
       I_WINO, I_BIG, I_BFG, I_MNORM, I_WOUTO, I_LN1G, I_LN1B, I_LN2G, I_LN2B, I_WUP, I_WDOWN, I_WPLE, I_WGATE };

struct TDesc { const float* W; bf16* WT; int K, N, Npad, item; };
__device__ __forceinline__ void t_load(const TDesc& d, int lane, f32x4 (&v)[8]) {
    const int nblk = d.Npad / 32, kb = d.item / nblk, nb = d.item % nblk, k0 = 64 * kb, n0 = 32 * nb;
    const int r8 = lane >> 3, c4 = lane & 7; const bool ok = (n0 + 4 * c4) < d.N;
#pragma unroll
    for (int i = 0; i < 8; ++i) v[i] = ok ? __builtin_nontemporal_load((const f32x4*)(d.W + (size_t)(k0 + 8 * r8 + i) * d.N + n0 + 4 * c4)) : (f32x4){0.f, 0.f, 0.f, 0.f};
}
__device__ __forceinline__ void t_finish(const TDesc& d, LAS float*  , int lane, const f32x4 (&v)[8]) {
    const int nblk = d.Npad / 32, kb = d.item / nblk, nb = d.item % nblk, k0 = 64 * kb, n0 = 32 * nb;
    const int r8 = lane >> 3, c4 = lane & 7;
    bf16* o = d.WT + (size_t)(n0 + 4 * c4) * d.K + k0 + 8 * r8;
    *(v4u*)(o) = (v4u){pk2(v[0].x, v[1].x), pk2(v[2].x, v[3].x), pk2(v[4].x, v[5].x), pk2(v[6].x, v[7].x)};
    *(v4u*)(o + (size_t)d.K) = (v4u){pk2(v[0].y, v[1].y), pk2(v[2].y, v[3].y), pk2(v[4].y, v[5].y), pk2(v[6].y, v[7].y)};
    *(v4u*)(o + 2 * (size_t)d.K) = (v4u){pk2(v[0].z, v[1].z), pk2(v[2].z, v[3].z), pk2(v[4].z, v[5].z), pk2(v[6].z, v[7].z)};
    *(v4u*)(o + 3 * (size_t)d.K) = (v4u){pk2(v[0].w, v[1].w), pk2(v[2].w, v[3].w), pk2(v[4].w, v[5].w), pk2(v[6].w, v[7].w)};
}
__device__ __forceinline__ void p0_transpose_item(const float* W, int K, int N, int Npad, bf16* WT, LAS float* scr, int item, int lane) {
    const TDesc d{W, WT, K, N, Npad, item}; f32x4 v[8]; t_load(d, lane, v); t_finish(d, scr, lane, v);
}
template <int N> __device__ __forceinline__ void row_to_bf16(const float* src, bf16* dst, int lane) {
    f32x4 v[N / 256];
#pragma unroll
    for (int j = 0; j < N / 256; ++j) v[j] = __builtin_nontemporal_load((const f32x4*)(src + j * 256 + lane * 4));
#pragma unroll
    for (int j = 0; j < N / 256; ++j) { v2u o; o.x = pk2(v[j].x, v[j].y); o.y = pk2(v[j].z, v[j].w); *(v2u*)(dst + j * 256 + lane * 4) = o; }
}
namespace cv { constexpr int I_IN = (D / 64) * (NPROJ_PAD / 32), I_SQ = (D / 64) * (D / 32), I_UP = (D / 64) * (FF / 32), I_DN = (FF / 64) * (D / 32), I_PL = (PLE / 64) * (D / 32);
               constexpr int N_FIRST = I_IN + I_PL + 128, N_REST = I_IN + 2 * I_SQ + 2 * I_UP + 2 * I_DN + I_PL + 2 * I_SQ;
               constexpr int R_IN0 = 6200;
               constexpr int R_G1 = I_SQ + I_UP + I_SQ + I_IN + I_SQ + I_PL + I_SQ;
               constexpr int R_IN1 = R_G1 + I_UP;
               constexpr int R_SCAN = R_IN1 - 6200;
               constexpr int R_UP0 = R_IN1 + I_DN;
               static_assert(R_UP0 + I_DN == N_REST && R_SCAN > R_G1 && R_SCAN > R_IN0, "conversion ranges"); }
__device__ __forceinline__ void convert_first_item(ArgsP a, LAS float* scr, int r, int lane) {
    unsigned char* ws = a->ws;
    if (r < cv::I_IN) { p0_transpose_item(a->in[I_WINE], D, NPROJ, NPROJ_PAD, (bf16*)(ws + WS_WINE), scr, r, lane); return; } r -= cv::I_IN;
    if (r < cv::I_PL) { p0_transpose_item(a->in[I_WPLE], PLE, D, D, (bf16*)(ws + WS_WPLE), scr, r, lane); return; } r -= cv::I_PL;
    { const int mat = r / 64, blk = (r / 8) & 7; p0_transpose_item(a->in[mat == 0 ? I_LWR : I_LWI] + (size_t)blk * 16384, 128, 128, 128, (bf16*)(ws + WS_LRUW) + (size_t)(mat * 8 + blk) * 16384, scr, r % 8, lane); }
}
__device__ __forceinline__ TDesc decode_rest(ArgsP a, int r) {
    using namespace cv; unsigned char* ws = a->ws;
    if (r < I_SQ) return TDesc{a->in[I_WOUTE], (bf16*)(ws + WS_WOUTE), D, D, D, r}; r -= I_SQ;
    if (r < I_UP) return TDesc{a->in[I_WUP], (bf16*)(ws + WS_WUP), D, FF, FF, r}; r -= I_UP;
    if (r < I_SQ) return TDesc{a->in[I_WGATE], (bf16*)(ws + WS_WGATE), D, D, D, r}; r -= I_SQ;
    if (r < I_IN) return TDesc{a->in[I_WINO], (bf16*)(ws + WS_WINO), D, NPROJ, NPROJ_PAD, r}; r -= I_IN;
    if (r < I_SQ) return TDesc{a->in[I_WOUTO], (bf16*)(ws + WS_WOUTO), D, D, D, r}; r -= I_SQ;
    if (r < I_PL) return TDesc{a->in[I_WPLE] + (size_t)PLE * D, (bf16*)(ws + WS_WPLE) + (size_t)PLE * D, PLE, D, D, r}; r -= I_PL;
    if (r < I_SQ) return TDesc{a->in[I_WGATE] + (size_t)D * D, (bf16*)(ws + WS_WGATE) + (size_t)D * D, D, D, D, r}; r -= I_SQ;
    if (r < I_UP) return TDesc{a->in[I_WUP] + (size_t)D * FF, (bf16*)(ws + WS_WUP) + (size_t)D * FF, D, FF, FF, r}; r -= I_UP;
    if (r < I_DN) return TDesc{a->in[I_WDOWN], (bf16*)(ws + WS_WDOWN), FF, D, D, r}; r -= I_DN;
    return TDesc{a->in[I_WDOWN] + (size_t)D * FF, (bf16*)(ws + WS_WDOWN) + (size_t)D * FF, FF, D, D, r};
}
__device__ __forceinline__ void convert_range(ArgsP a, LAS float* scr, int first, int last, int widx, int nw, int lane) {
    int it = first + widx;
    TDesc dA, dB; f32x4 vA[8], vB[8];
    if (it < last) { dA = decode_rest(a, it); t_load(dA, lane, vA);
#pragma unroll 1
        for (;;) {
            const int itB = it + nw; const bool hasB = itB < last;
            if (hasB) { dB = decode_rest(a, itB); t_load(dB, lane, vB); }
            t_finish(dA, scr, lane, vA);
            if (!hasB) break;
            it = itB + nw; const bool hasA = it < last;
            if (hasA) { dA = decode_rest(a, it); t_load(dA, lane, vA); }
            t_finish(dB, scr, lane, vB);
            if (!hasA) break;
        } }
}
__device__ __forceinline__ void phase_convert(ArgsP a, LAS unsigned char* lds, int gw, int NGW, int wave, int lane) {
    unsigned char* ws = a->ws;
    LAS float* scr = (LAS float*)(lds + wave * 16384);
    for (int it = gw; it < cv::N_FIRST; it += NGW) convert_first_item(a, scr, it, lane);
    bf16* xb = (bf16*)(ws + WS_XB);
    for (int m = gw; m < M; m += NGW) {
        const float* src = m < MP ? a->in[I_XP] + (size_t)m * D : a->in[I_XS] + (size_t)(m - MP) * D;
        row_to_bf16<D>(src, xb + (size_t)m * D, lane);
    }
    bf16* pb = (bf16*)(ws + WS_PB);
    for (int r = gw; r < 2 * M; r += NGW) {
        const int l = r / M, m = r % M;
        const float* src = m < MP ? a->in[I_PP] + ((size_t)l * MP + m) * PLE : a->in[I_PS] + ((size_t)l * MS + (m - MP)) * PLE;
        row_to_bf16<PLE>(src, pb + (size_t)r * PLE, lane);
    }
}

__device__ __forceinline__ float conv_in(const bf16* proj, int row0, int tq, int ch, const float* cstate) {
    if (tq >= 0) return bf2f(proj[(size_t)(row0 + tq) * NPROJ_PAD + ch]);
    return cstate ? cstate[(3 + tq) * 4096 + ch] : 0.f;
}
__device__ __forceinline__ float conv4(const bf16* proj, int row0, int t, int ch, const float* cstate, const float* wconv, const float* bconv) {
    float acc = bconv[ch];
#pragma unroll
    for (int j = 0; j < 4; ++j) acc += wconv[j * 4096 + ch] * conv_in(proj, row0, t - 3 + j, ch, cstate);
    return acc;
}

__device__ __forceinline__ void delta_rec_item(ArgsP a, LAS unsigned char* lds, int row0, int T, int h, const float* cstate, const float* S0, float* Sout, const int tid) {
    const int lane = tid & 63, wave = tid >> 6, c = tid & 127, r = tid >> 7;
    const bf16* proj = (const bf16*)(a->ws + WS_PROJ); const float* gates = (const float*)(a->ws + WS_GATES); bf16* mix = (bf16*)(a->ws + WS_MIX);
    const float* wconv = a->in[I_WCONV]; const float* bconv = a->in[I_BCONV];
    LAS float* act = (LAS float*)lds;
    LAS float* nrm = act + 4 * 384;
    LAS float* gb = nrm + 8;
    LAS float* red = gb + 8;
    LAS float* red2 = red + 512;
    LAS float* obuf = red2 + 512;
    float s[32];
#pragma unroll
    for (int i = 0; i < 32; ++i) s[i] = S0 ? S0[(size_t)(32 * r + i) * 128 + c] : 0.f;
    const float aexp = fexp(a->in[I_ALOG][h]), dtb = a->in[I_DTB][h];
#pragma unroll 1
    for (int t0 = 0; t0 < T; t0 += 4) {
#pragma unroll
        for (int j = 0; j < 3; ++j) { const int idx = tid + 512 * j, tok = idx / 384, chl = idx % 384, part = chl >> 7, i = chl & 127;
            const int ch = part * 1024 + h * 128 + i;
            act[tok * 384 + chl] = siluf(conv4(proj, row0, t0 + tok, ch, cstate, wconv, bconv)); }
        LDS_BARRIER();
        { const int tok = wave >> 1, part = wave & 1; const float x0 = act[tok * 384 + part * 128 + lane], x1 = act[tok * 384 + part * 128 + 64 + lane];
          const float ss = wave_sum(x0 * x0 + x1 * x1); if (lane == 0) nrm[tok * 2 + part] = rsqrtf(ss + 1e-6f) * (part == 0 ? 0.08838834764831845f : 1.f); }
        if (tid < 4) { const int row = row0 + t0 + tid; const float g = -aexp * softplusf(gates[(size_t)row * 16 + h] + dtb); gb[tid * 2] = fexp(g); gb[tid * 2 + 1] = sigm(gates[(size_t)row * 16 + 8 + h]); }
        LDS_BARRIER();
#pragma unroll 1
        for (int tok = 0; tok < 4; ++tok) {
            const float eg = gb[tok * 2], beta = gb[tok * 2 + 1], nq = nrm[tok * 2], nk = nrm[tok * 2 + 1];
            const LAS float* qv = act + tok * 384 + 32 * r; const LAS float* kv = qv + 128;
            float ks = 0.f;
#pragma unroll
            for (int i = 0; i < 32; ++i) ks += kv[i] * s[i];
            red[r * 128 + c] = ks * nk;
            LDS_BARRIER();
            const float kS = red[c] + red[128 + c] + red[256 + c] + red[384 + c];
            const float vnew = beta * (act[tok * 384 + 256 + c] - eg * kS);
            float os = 0.f;
#pragma unroll
            for (int i = 0; i < 32; ++i) { s[i] = eg * s[i] + (kv[i] * nk) * vnew; os += qv[i] * s[i]; }
            red2[r * 128 + c] = os * nq;
            LDS_BARRIER();
            if (r == 0) obuf[tok * 128 + c] = red2[c] + red2[128 + c] + red2[256 + c] + red2[384 + c];
        }
        LDS_BARRIER();
        if (wave < 4) { const int tok = wave, row = row0 + t0 + tok; const float o0 = obuf[tok * 128 + lane], o1 = obuf[tok * 128 + 64 + lane];
            const float rstd = rsqrtf(wave_sum(o0 * o0 + o1 * o1) * (1.f / 128.f) + RMS_EPS);
            const float* nw = a->in[I_DNORM];
            const float z0 = bf2f(proj[(size_t)row * NPROJ_PAD + 4096 + h * 128 + lane]), z1 = bf2f(proj[(size_t)row * NPROJ_PAD + 4096 + h * 128 + 64 + lane]);
            mix[(size_t)row * D + h * 128 + lane] = (bf16)f2bf(o0 * rstd * nw[lane] * siluf(z0));
            mix[(size_t)row * D + h * 128 + 64 + lane] = (bf16)f2bf(o1 * rstd * nw[64 + lane] * siluf(z1)); }
        LDS_BARRIER();
    }
#pragma unroll
    for (int i = 0; i < 32; ++i) Sout[(size_t)(32 * r + i) * 128 + c] = s[i];
}


typedef short bf16x8 __attribute__((ext_vector_type(8)));
#define MFMA32(a_, b_, c_) __builtin_amdgcn_mfma_f32_16x16x32_bf16(a_, b_, c_, 0, 0, 0)

__device__ __forceinline__ void lru_prep_item(ArgsP a, LAS unsigned char* lds, int item, const int tid) {
    const int c = item & 31, n = (item >> 5) & 7, b = item >> 8;
    const int lane = tid & 63, w = __builtin_amdgcn_readfirstlane(tid >> 6), fr = lane & 15, fq = lane >> 4;
    unsigned char* ws = a->ws;
    const bf16* proj = (const bf16*)(ws + WS_PROJ);
    LAS bf16* xa = (LAS bf16*)lds;
    LAS float* xf = (LAS float*)(lds + 17408);
    LAS float* obH = (LAS float*)(lds + 51200);
    LAS float* obP = obH + 64 * 132;
    {
        const int t = tid >> 3, sub = tid & 7, ch0 = 3072 + n * 128 + sub * 16;
        const float* wconv = a->in[I_WCONV]; const float* bconv = a->in[I_BCONV];
        float x[16];
#pragma unroll
        for (int i = 0; i < 4; ++i) { const f32x4 bb = *(const f32x4*)(bconv + ch0 + 4 * i); x[4 * i] = bb.x; x[4 * i + 1] = bb.y; x[4 * i + 2] = bb.z; x[4 * i + 3] = bb.w; }
#pragma unroll
        for (int j = 0; j < 4; ++j) { const int tt = 64 * c + t - 3 + j;
            if (tt >= 0) { const bf16* pr = proj + (size_t)(b * TP + tt) * NPROJ_PAD + ch0; const v4u u0 = *(const v4u*)pr, u1 = *(const v4u*)(pr + 8);
                const unsigned uu[8] = {u0.x, u0.y, u0.z, u0.w, u1.x, u1.y, u1.z, u1.w};
#pragma unroll
                for (int i = 0; i < 4; ++i) { const f32x4 ww = *(const f32x4*)(wconv + j * 4096 + ch0 + 4 * i);
                    x[4 * i] += ww.x * bflo(uu[2 * i]); x[4 * i + 1] += ww.y * bfhi(uu[2 * i]); x[4 * i + 2] += ww.z * bflo(uu[2 * i + 1]); x[4 * i + 3] += ww.w * bfhi(uu[2 * i + 1]); } } }
        v4u o0, o1; o0.x = pk2(x[0], x[1]); o0.y = pk2(x[2], x[3]); o0.z = pk2(x[4], x[5]); o0.w = pk2(x[6], x[7]); o1.x = pk2(x[8], x[9]); o1.y = pk2(x[10], x[11]); o1.z = pk2(x[12], x[13]); o1.w = pk2(x[14], x[15]);
        *(LAS v4u*)(xa + t * 136 + sub * 16) = o0; *(LAS v4u*)(xa + t * 136 + sub * 16 + 8) = o1;
#pragma unroll
        for (int i = 0; i < 4; ++i) *(LAS f32x4*)(xf + t * 132 + sub * 16 + 4 * i) = (f32x4){x[4 * i], x[4 * i + 1], x[4 * i + 2], x[4 * i + 3]};
    }
    LDS_BARRIER();
    const bf16* wrT = (const bf16*)(ws + WS_LRUW) + (size_t)n * 16384; const bf16* wiT = wrT + 8 * 16384;
    bf16x8 br[4], bi[4];
#pragma unroll
    for (int ks = 0; ks < 4; ++ks) { br[ks] = *(const bf16x8*)(wrT + (16 * w + fr) * 128 + 32 * ks + 8 * fq); bi[ks] = *(const bf16x8*)(wiT + (16 * w + fr) * 128 + 32 * ks + 8 * fq); }
    f32x4 accr[4], acci[4];
#pragma unroll
    for (int tb = 0; tb < 4; ++tb) { accr[tb] = (f32x4){0.f, 0.f, 0.f, 0.f}; acci[tb] = (f32x4){0.f, 0.f, 0.f, 0.f};
#pragma unroll
        for (int ks = 0; ks < 4; ++ks) { const bf16x8 af = *(const LAS bf16x8*)(xa + (16 * tb + fr) * 136 + 32 * ks + 8 * fq); accr[tb] = MFMA32(af, br[ks], accr[tb]); acci[tb] = MFMA32(af, bi[ks], acci[tb]); } }
    const int dl = 16 * w + fr, chn = n * 128 + dl;
    const float brs = a->in[I_LBR][chn], bis = a->in[I_LBI][chn], spl = softplusf(-a->in[I_LLAM][chn]);
    float Apre = 1.f, Hpre = 0.f;
#pragma unroll
    for (int tb = 0; tb < 4; ++tb) {
        float P[4], Hh[4];
#pragma unroll
        for (int j = 0; j < 4; ++j) { const int t = 16 * tb + 4 * fq + j;
            const float log_a = -8.f * sigm(accr[tb][j] + brs) * spl; const float av = fexp(log_a);
            const float bx = sqrtf(neg_expm1(2.f * log_a)) * sigm(acci[tb][j] + bis) * xf[t * 132 + dl];
            if (j == 0) { P[0] = av; Hh[0] = bx; } else { P[j] = P[j - 1] * av; Hh[j] = av * Hh[j - 1] + bx; } }
        float Ai = P[3], Hi = Hh[3];
        { const float A2 = __shfl_up(Ai, 16), H2 = __shfl_up(Hi, 16); if (fq >= 1) { Hi = Ai * H2 + Hi; Ai = A2 * Ai; } }
        { const float A2 = __shfl_up(Ai, 32), H2 = __shfl_up(Hi, 32); if (fq >= 2) { Hi = Ai * H2 + Hi; Ai = A2 * Ai; } }
        float Aex = __shfl_up(Ai, 16), Hex = __shfl_up(Hi, 16); if (fq == 0) { Aex = 1.f; Hex = 0.f; }
        const float Atb = __shfl(Ai, 48 + fr), Htb = __shfl(Hi, 48 + fr);
        const float EA = Apre * Aex, EH = Aex * Hpre + Hex;
#pragma unroll
        for (int j = 0; j < 4; ++j) { const int t = 16 * tb + 4 * fq + j; obP[t * 132 + dl] = EA * P[j]; obH[t * 132 + dl] = P[j] * EH + Hh[j]; }
        Hpre = Atb * Hpre + Htb; Apre = Apre * Atb;
    }
    if (fq == 0) { float* e = (float*)(ws + WS_LRU_END) + (size_t)item * 256; e[dl] = Apre; e[128 + dl] = Hpre; }
    LDS_BARRIER();
    {
        const int t = tid >> 3, sub = tid & 7;
        bf16* hl = (bf16*)(ws + WS_LRU_HL) + ((size_t)item * 64 + t) * 128 + sub * 16; bf16* pp = (bf16*)(ws + WS_LRU_P) + ((size_t)item * 64 + t) * 128 + sub * 16;
        const LAS float* sh = obH + t * 132 + sub * 16; const LAS float* sp = obP + t * 132 + sub * 16;
        v4u o0, o1;
        o0.x = pk2(sh[0], sh[1]); o0.y = pk2(sh[2], sh[3]); o0.z = pk2(sh[4], sh[5]); o0.w = pk2(sh[6], sh[7]); o1.x = pk2(sh[8], sh[9]); o1.y = pk2(sh[10], sh[11]); o1.z = pk2(sh[12], sh[13]); o1.w = pk2(sh[14], sh[15]);
        *(v4u*)hl = o0; *(v4u*)(hl + 8) = o1;
        o0.x = pk2(sp[0], sp[1]); o0.y = pk2(sp[2], sp[3]); o0.z = pk2(sp[4], sp[5]); o0.w = pk2(sp[6], sp[7]); o1.x = pk2(sp[8], sp[9]); o1.y = pk2(sp[10], sp[11]); o1.z = pk2(sp[12], sp[13]); o1.w = pk2(sp[14], sp[15]);
        *(v4u*)pp = o0; *(v4u*)(pp + 8) = o1;
    }
    LDS_BARRIER();
}
__device__ __forceinline__ void lru_out_item(ArgsP a, LAS unsigned char* lds, int item, const int tid) {
    const int c = item & 31, n = (item >> 5) & 7, b = item >> 8;
    unsigned char* ws = a->ws;
    LAS float* carry = (LAS float*)lds;
    if (tid < 128) { float cr = 0.f; const float* e = (const float*)(ws + WS_LRU_END) + (size_t)(item - c) * 256;
        float pv[31], hv_[31];
#pragma unroll
        for (int k = 0; k < 31; ++k) { const bool on = k < c; pv[k] = on ? e[k * 256 + tid] : 1.f; hv_[k] = on ? e[k * 256 + 128 + tid] : 0.f; }
#pragma unroll
        for (int k = 0; k < 31; ++k) cr = hv_[k] + pv[k] * cr;
        carry[tid] = cr; }
    LDS_BARRIER();
    const int t = tid >> 3, sub = tid & 7, d0 = sub * 16, row = b * TP + 64 * c + t;
    const bf16* hl = (const bf16*)(ws + WS_LRU_HL) + ((size_t)item * 64 + t) * 128 + d0; const bf16* pp = (const bf16*)(ws + WS_LRU_P) + ((size_t)item * 64 + t) * 128 + d0;
    const bf16* gp = (const bf16*)(ws + WS_PROJ) + (size_t)row * NPROJ_PAD + 5120 + n * 128 + d0;
    const v4u h0 = *(const v4u*)hl, h1 = *(const v4u*)(hl + 8), p0 = *(const v4u*)pp, p1 = *(const v4u*)(pp + 8), g0 = *(const v4u*)gp, g1 = *(const v4u*)(gp + 8);
    const unsigned hu[8] = {h0.x, h0.y, h0.z, h0.w, h1.x, h1.y, h1.z, h1.w}, pu[8] = {p0.x, p0.y, p0.z, p0.w, p1.x, p1.y, p1.z, p1.w}, gu[8] = {g0.x, g0.y, g0.z, g0.w, g1.x, g1.y, g1.z, g1.w};
    float hv[16]; unsigned ou[8];
#pragma unroll
    for (int i = 0; i < 8; ++i) { hv[2 * i] = bflo(hu[i]) + bflo(pu[i]) * carry[d0 + 2 * i]; hv[2 * i + 1] = bfhi(hu[i]) + bfhi(pu[i]) * carry[d0 + 2 * i + 1];
        ou[i] = pk2(hv[2 * i] * gelu_tanh(bflo(gu[i])), hv[2 * i + 1] * gelu_tanh(bfhi(gu[i]))); }
    bf16* mp = (bf16*)(ws + WS_MIX) + (size_t)row * D + 1024 + n * 128 + d0;
    *(v4u*)mp = (v4u){ou[0], ou[1], ou[2], ou[3]}; *(v4u*)(mp + 8) = (v4u){ou[4], ou[5], ou[6], ou[7]};
    if (c == 31 && t == 63) { float* o = a->out + O_LRUP + (size_t)b * 1024 + n * 128 + d0;
#pragma unroll
        for (int i = 0; i < 4; ++i) *(f32x4*)(o + 4 * i) = (f32x4){hv[4 * i], hv[4 * i + 1], hv[4 * i + 2], hv[4 * i + 3]}; }
    LDS_BARRIER();
}


__device__ __forceinline__ void conv16_load(const bf16* proj, int b, int tseq, int ch0, v4u (&u)[8]) {
#pragma unroll
    for (int j = 0; j < 4; ++j) { const int tt = tseq - 3 + j;
        if (tt >= 0) { const bf16* pr = proj + (size_t)(b * TP + tt) * NPROJ_PAD + ch0; u[2 * j] = *(const v4u*)pr; u[2 * j + 1] = *(const v4u*)(pr + 8); }
        else { u[2 * j] = (v4u){0u, 0u, 0u, 0u}; u[2 * j + 1] = (v4u){0u, 0u, 0u, 0u}; } }
}
__device__ __forceinline__ void conv16_compute(const v4u (&u)[8], const float* wconv, const float* bconv, int ch0, float (&x)[16]) {
#pragma unroll
    for (int i = 0; i < 4; ++i) { const f32x4 bb = *(const f32x4*)(bconv + ch0 + 4 * i); x[4 * i] = bb.x; x[4 * i + 1] = bb.y; x[4 * i + 2] = bb.z; x[4 * i + 3] = bb.w; }
#pragma unroll
    for (int j = 0; j < 4; ++j) { const unsigned uu[8] = {u[2 * j].x, u[2 * j].y, u[2 * j].z, u[2 * j].w, u[2 * j + 1].x, u[2 * j + 1].y, u[2 * j + 1].z, u[2 * j + 1].w};
#pragma unroll
        for (int i = 0; i < 4; ++i) { const f32x4 ww = *(const f32x4*)(wconv + j * 4096 + ch0 + 4 * i);
            x[4 * i] += ww.x * bflo(uu[2 * i]); x[4 * i + 1] += ww.y * bfhi(uu[2 * i]); x[4 * i + 2] += ww.z * bflo(uu[2 * i + 1]); x[4 * i + 3] += ww.w * bfhi(uu[2 * i + 1]); } }
}
__device__ __forceinline__ void conv16_prompt(const bf16* proj, const float* wconv, const float* bconv, int b, int tseq, int ch0, float (&x)[16]) {
    v4u u[8]; conv16_load(proj, b, tseq, ch0, u); conv16_compute(u, wconv, bconv, ch0, x);
}
__device__ __forceinline__ void st16_bf16(LAS bf16* p, const float (&x)[16]) {
    v4u o0, o1; o0.x = pk2(x[0], x[1]); o0.y = pk2(x[2], x[3]); o0.z = pk2(x[4], x[5]); o0.w = pk2(x[6], x[7]); o1.x = pk2(x[8], x[9]); o1.y = pk2(x[10], x[11]); o1.z = pk2(x[12], x[13]); o1.w = pk2(x[14], x[15]);
    *(LAS v4u*)p = o0; *(LAS v4u*)(p + 8) = o1;
}
__device__ __forceinline__ v2u pack4(const f32x4 v) { v2u o; o.x = pk2(v.x, v.y); o.y = pk2(v.z, v.w); return o; }
__device__ __forceinline__ bf16x8 zero8() { return (bf16x8){0, 0, 0, 0, 0, 0, 0, 0}; }

__device__ __forceinline__ void delta_prep_item(ArgsP a, LAS unsigned char* lds, int item, const int tid) {
    const int c = item & 31, h = (item >> 5) & 7, b = item >> 8;
    const int lane = tid & 63, w = __builtin_amdgcn_readfirstlane(tid >> 6), fr = lane & 15, fq = lane >> 4;
    unsigned char* ws = a->ws;
    const bf16* proj = (const bf16*)(ws + WS_PROJ);
    LAS bf16* Kn = (LAS bf16*)lds;
    LAS bf16* Qn = (LAS bf16*)(lds + 17408);
    LAS bf16* KdT = (LAS bf16*)(lds + 34816);
    LAS bf16* RX = (LAS bf16*)(lds + 53248);
    LAS bf16* Mm = (LAS bf16*)(lds + 90112);
    LAS bf16* QKd = (LAS bf16*)(lds + 99328);
    LAS bf16* Td = (LAS bf16*)(lds + 108544);
    LAS bf16* RT = (LAS bf16*)(lds + 111616) + w * 768;
    LAS float* gl = (LAS float*)(lds + 123904);
    LAS float* gcs = gl + 64;
    LAS float* bet = gcs + 64;
    float gcv, bvv;
    {
        const float* gt = (const float*)(ws + WS_GATES) + (size_t)(b * TP + 64 * c + lane) * 16;
        const float gv = -fexp(a->in[I_ALOG][h]) * softplusf(gt[h] + a->in[I_DTB][h]); bvv = sigm(gt[8 + h]);
        gcv = wave_incl_sum(gv, lane);
        if (w == 0) { gl[lane] = gv; gcs[lane] = gcv; bet[lane] = bvv; }
    }
    {
        const int part = w >> 1;
        if (part < 3) {
            const float* wconv = a->in[I_WCONV]; const float* bconv = a->in[I_BCONV];
            const int sub = tid & 7, tg = (tid >> 3) & 15, ch0 = (part == 0 ? 0 : part == 1 ? 1024 : 2048) + h * 128 + sub * 16;
            f32x4 wv[4][4], bv4[4];
#pragma unroll
            for (int i = 0; i < 4; ++i) { bv4[i] = *(const f32x4*)(bconv + ch0 + 4 * i);
#pragma unroll
                for (int j = 0; j < 4; ++j) wv[j][i] = *(const f32x4*)(wconv + j * 4096 + ch0 + 4 * i); }
            v4u u[7][2];
#pragma unroll
            for (int r = 0; r < 7; ++r) { const int tt = 64 * c + 4 * tg - 3 + r;
                if (tt >= 0) { const bf16* pr = proj + (size_t)(b * TP + tt) * NPROJ_PAD + ch0; u[r][0] = *(const v4u*)pr; u[r][1] = *(const v4u*)(pr + 8); }
                else { u[r][0] = (v4u){0u, 0u, 0u, 0u}; u[r][1] = (v4u){0u, 0u, 0u, 0u}; } }
            const float glast = __shfl(gcv, 63);
#pragma unroll
            for (int e = 0; e < 4; ++e) { const int t = 4 * tg + e;
                float x[16];
#pragma unroll
                for (int i = 0; i < 4; ++i) { x[4 * i] = bv4[i].x; x[4 * i + 1] = bv4[i].y; x[4 * i + 2] = bv4[i].z; x[4 * i + 3] = bv4[i].w; }
#pragma unroll
                for (int j = 0; j < 4; ++j) { const unsigned uu[8] = {u[e + j][0].x, u[e + j][0].y, u[e + j][0].z, u[e + j][0].w, u[e + j][1].x, u[e + j][1].y, u[e + j][1].z, u[e + j][1].w};
#pragma unroll
                    for (int i = 0; i < 4; ++i) { x[4 * i] += wv[j][i].x * bflo(uu[2 * i]); x[4 * i + 1] += wv[j][i].y * bfhi(uu[2 * i]); x[4 * i + 2] += wv[j][i].z * bflo(uu[2 * i + 1]); x[4 * i + 3] += wv[j][i].w * bfhi(uu[2 * i + 1]); } }
                float ss = 0.f;
#pragma unroll
                for (int i = 0; i < 16; ++i) { x[i] = siluf(x[i]); ss += x[i] * x[i]; }
                const float gc = __shfl(gcv, t), beta = __shfl(bvv, t);
                if (part == 2) {
#pragma unroll
                    for (int i = 0; i < 16; ++i) x[i] *= beta;
                    st16_bf16(RX + t * 264 + sub * 16, x);
                } else {
                    ss += __shfl_xor(ss, 1); ss += __shfl_xor(ss, 2); ss += __shfl_xor(ss, 4);
                    const float rn = rsqrtf(ss + 1e-6f) * (part == 0 ? 0.08838834764831845f : 1.f);
#pragma unroll
                    for (int i = 0; i < 16; ++i) x[i] *= rn;
                    if (part == 0) st16_bf16(Qn + t * 136 + sub * 16, x);
                    else { st16_bf16(Kn + t * 136 + sub * 16, x);
                        const float ec = fexp(gc), ed = fexp(glast - gc); float y[16];
#pragma unroll
                        for (int i = 0; i < 16; ++i) { KdT[(sub * 16 + i) * 72 + t] = (bf16)f2bf(x[i] * ed); y[i] = x[i] * (beta * ec); }
                        st16_bf16(RX + t * 264 + 128 + sub * 16, y); }
                }
            }
        }
    }
    LDS_BARRIER();
    {
        const int ib = w >> 1;
#pragma unroll
        for (int jj = 0; jj < 2; ++jj) { const int jb = 2 * (w & 1) + jj;
            f32x4 ak = (f32x4){0.f, 0.f, 0.f, 0.f}, aq = (f32x4){0.f, 0.f, 0.f, 0.f};
            if (jb <= ib) {
#pragma unroll
                for (int ks = 0; ks < 4; ++ks) { const bf16x8 bfr = *(const LAS bf16x8*)(Kn + (16 * jb + fr) * 136 + 32 * ks + 8 * fq);
                    const bf16x8 afk = *(const LAS bf16x8*)(Kn + (16 * ib + fr) * 136 + 32 * ks + 8 * fq), afq = *(const LAS bf16x8*)(Qn + (16 * ib + fr) * 136 + 32 * ks + 8 * fq);
                    ak = MFMA32(afk, bfr, ak); aq = MFMA32(afq, bfr, aq); } }
            const int col = 16 * jb + fr; const float gcc = gcs[col];
#pragma unroll
            for (int j = 0; j < 4; ++j) { const int row = 16 * ib + 4 * fq + j; const float dec = (row >= col) ? fexp(gcs[row] - gcc) : 0.f;
                Mm[row * 72 + col] = (bf16)f2bf(row > col ? -bet[row] * ak[j] * dec : 0.f);
                QKd[row * 72 + col] = (bf16)f2bf(aq[j] * dec); }
        }
    }
    LDS_BARRIER();
    if (w == 0) { const int blk = lane >> 4, col = lane & 15; float xi[16];
#pragma unroll
        for (int i = 0; i < 16; ++i) { float acc = (i == col) ? 1.f : 0.f; const LAS bf16* mr = Mm + (16 * blk + i) * 72 + 16 * blk;
#pragma unroll
            for (int j = 0; j < i; ++j) acc += bf2f(mr[j]) * xi[j];
            xi[i] = acc; }
#pragma unroll
        for (int i = 0; i < 16; ++i) Td[(blk * 16 + i) * 24 + col] = (bf16)f2bf(xi[i]); }
    f32x4 rhs[2][4];
#pragma unroll
    for (int cbl = 0; cbl < 2; ++cbl)
#pragma unroll
        for (int bb = 0; bb < 4; ++bb)
#pragma unroll
            for (int j = 0; j < 4; ++j) rhs[cbl][bb][j] = bf2f(RX[(16 * bb + 4 * fq + j) * 264 + 32 * w + 16 * cbl + fr]);
    LDS_BARRIER();
#pragma unroll
    for (int cbl = 0; cbl < 2; ++cbl) { const int cb = 2 * w + cbl;
#pragma unroll
        for (int bb = 0; bb < 4; ++bb) {
            f32x4 acc = rhs[cbl][bb];
#pragma unroll
            for (int ks = 0; ks < 2; ++ks) { if (32 * ks < 16 * bb) { const bool ok = (32 * ks + 8 * fq) < 16 * bb;
                const bf16x8 af = ok ? *(const LAS bf16x8*)(Mm + (16 * bb + fr) * 72 + 32 * ks + 8 * fq) : zero8();
                const bf16x8 bf_ = ok ? *(const LAS bf16x8*)(RX + (16 * cb + fr) * 72 + 32 * ks + 8 * fq) : zero8();
                acc = MFMA32(af, bf_, acc); } }
            *(LAS v2u*)(RT + (16 * cbl + fr) * 24 + 4 * fq) = pack4(acc);
            asm volatile("s_waitcnt lgkmcnt(0)" ::: "memory");
            const bool ok2 = fq < 2;
            const bf16x8 af2 = ok2 ? *(const LAS bf16x8*)(Td + (bb * 16 + fr) * 24 + 8 * fq) : zero8();
            const bf16x8 bf2 = ok2 ? *(const LAS bf16x8*)(RT + (16 * cbl + fr) * 24 + 8 * fq) : zero8();
            const f32x4 xb4 = MFMA32(af2, bf2, ((f32x4){0.f, 0.f, 0.f, 0.f}));
            *(LAS v2u*)(RX + (16 * cb + fr) * 72 + 16 * bb + 4 * fq) = pack4(xb4);
            asm volatile("s_waitcnt lgkmcnt(0)" ::: "memory");
        }
    }
    LDS_BARRIER();
    {
        v4u* gout = (v4u*)(ws + WS_DG) + ((size_t)item * 8 + w) * 4 * 64 + lane;
        bf16x8 kb[2];
#pragma unroll
        for (int kt = 0; kt < 2; ++kt) kb[kt] = *(const LAS bf16x8*)(KdT + (16 * w + fr) * 72 + 32 * kt + 8 * fq);
#pragma unroll
        for (int ks = 0; ks < 4; ++ks) { f32x4 g0 = (f32x4){0.f, 0.f, 0.f, 0.f}, g1 = (f32x4){0.f, 0.f, 0.f, 0.f};
#pragma unroll
            for (int kt = 0; kt < 2; ++kt) { const bf16x8 a0 = *(const LAS bf16x8*)(RX + (128 + 32 * ks + fr) * 72 + 32 * kt + 8 * fq), a1 = *(const LAS bf16x8*)(RX + (128 + 32 * ks + 16 + fr) * 72 + 32 * kt + 8 * fq);
                g0 = MFMA32(a0, kb[kt], g0); g1 = MFMA32(a1, kb[kt], g1); }
            const v2u p0 = pack4(-g0), p1 = pack4(-g1); gout[ks * 64] = (v4u){p0.x, p0.y, p1.x, p1.y}; }
        v2u* bout = (v2u*)(ws + WS_DB) + ((size_t)item * 64 + w) * 64 + lane;
#pragma unroll
        for (int s2 = 0; s2 < 8; ++s2) { f32x4 bc = (f32x4){0.f, 0.f, 0.f, 0.f};
#pragma unroll
            for (int kt = 0; kt < 2; ++kt) { const bf16x8 ub = *(const LAS bf16x8*)(RX + (16 * s2 + fr) * 72 + 32 * kt + 8 * fq); bc = MFMA32(kb[kt], ub, bc); }
            bout[(size_t)s2 * 8 * 64] = pack4(bc); }
    }
    {
        const int tb = w >> 1, half = w & 1; const float ect = fexp(gcs[16 * tb + fr]);
        bf16x8 qk[2];
#pragma unroll
        for (int kt = 0; kt < 2; ++kt) qk[kt] = *(const LAS bf16x8*)(QKd + (16 * tb + fr) * 72 + 32 * kt + 8 * fq);
        v4u* qout = (v4u*)(ws + WS_DQ) + ((size_t)item * 4 + tb) * 4 * 64 + lane;
#pragma unroll
        for (int kk = 0; kk < 2; ++kk) { const int ks = 2 * half + kk; v2u pk[2];
#pragma unroll
            for (int hf = 0; hf < 2; ++hf) { const int db = 2 * ks + hf; f32x4 acc = (f32x4){0.f, 0.f, 0.f, 0.f};
#pragma unroll
                for (int kt = 0; kt < 2; ++kt) { const bf16x8 wa = *(const LAS bf16x8*)(RX + (128 + 16 * db + fr) * 72 + 32 * kt + 8 * fq); acc = MFMA32(wa, qk[kt], acc); }
                const v2u qn4 = *(const LAS v2u*)(Qn + (16 * tb + fr) * 136 + 16 * db + 4 * fq);
                f32x4 qp; qp.x = bflo(qn4.x) * ect - acc.x; qp.y = bfhi(qn4.x) * ect - acc.y; qp.z = bflo(qn4.y) * ect - acc.z; qp.w = bfhi(qn4.y) * ect - acc.w;
                pk[hf] = pack4(qp); }
            qout[ks * 64] = (v4u){pk[0].x, pk[0].y, pk[1].x, pk[1].y}; }
        v2u* oout = (v2u*)(ws + WS_DO) + ((size_t)item * 4 + tb) * 8 * 64 + lane;
#pragma unroll
        for (int ss = 0; ss < 4; ++ss) { const int s2 = 4 * half + ss; f32x4 acc = (f32x4){0.f, 0.f, 0.f, 0.f};
#pragma unroll
            for (int kt = 0; kt < 2; ++kt) { const bf16x8 ua = *(const LAS bf16x8*)(RX + (16 * s2 + fr) * 72 + 32 * kt + 8 * fq); acc = MFMA32(ua, qk[kt], acc); }
            oout[s2 * 64] = pack4(acc); }
    }
    if (tid == 0) ((float*)(ws + WS_DD))[item] = fexp(gcs[63]);
    LDS_BARRIER();
}

__device__ __forceinline__ void delta_scan_wave(ArgsP a, int chain, int s, const int lane) {
    unsigned char* ws = a->ws;
    const int fr = lane & 15, fq = lane >> 4;
    f32x4 S[8]; bf16x8 Sb[4];
#pragma unroll
    for (int i = 0; i < 8; ++i) S[i] = (f32x4){0.f, 0.f, 0.f, 0.f};
#pragma unroll
    for (int i = 0; i < 4; ++i) Sb[i] = zero8();
    const bf16x8* gbase = (const bf16x8*)(ws + WS_DG) + (size_t)chain * 32 * 2048 + lane;
    bf16x8 G[8][4];
#pragma unroll
    for (int rb = 0; rb < 8; ++rb)
#pragma unroll
        for (int ks = 0; ks < 4; ++ks) G[rb][ks] = gbase[(rb * 4 + ks) * 64];
#pragma unroll 1
    for (int c = 0; c < 32; ++c) {
        const int item = chain * 32 + c;
        const float d = ((const float*)(ws + WS_DD))[item];
        bf16x8* sout = (bf16x8*)(ws + WS_DS) + ((size_t)item * 8 + s) * 4 * 64 + lane;
#pragma unroll
        for (int ks = 0; ks < 4; ++ks) sout[ks * 64] = Sb[ks];
        const v2u* bin = (const v2u*)(ws + WS_DB) + ((size_t)item * 8 + s) * 8 * 64 + lane;
#pragma unroll
        for (int rb = 0; rb < 8; ++rb) { const v2u bc = bin[rb * 64]; S[rb].x = d * S[rb].x + bflo(bc.x); S[rb].y = d * S[rb].y + bfhi(bc.x); S[rb].z = d * S[rb].z + bflo(bc.y); S[rb].w = d * S[rb].w + bfhi(bc.y); }
        const bf16x8* gnext = gbase + (size_t)(c + 1 < 32 ? c + 1 : c) * 2048;
#pragma unroll
        for (int rb = 0; rb < 8; ++rb) {
#pragma unroll
            for (int ks = 0; ks < 4; ++ks) S[rb] = MFMA32(G[rb][ks], Sb[ks], S[rb]);
#pragma unroll
            for (int ks = 0; ks < 4; ++ks) G[rb][ks] = gnext[(rb * 4 + ks) * 64];
        }
#pragma unroll
        for (int ks = 0; ks < 4; ++ks) { const v2u lo = pack4(S[2 * ks]), hi = pack4(S[2 * ks + 1]); const v4u u = (v4u){lo.x, lo.y, hi.x, hi.y}; Sb[ks] = __builtin_bit_cast(bf16x8, u); }
    }
    f32x4* so = (f32x4*)(ws + WS_DF) + ((size_t)(chain * 8 + s) * 8) * 64 + lane;
#pragma unroll
    for (int rb = 0; rb < 8; ++rb) so[rb * 64] = S[rb];
}

__device__ __forceinline__ void delta_out_wave(ArgsP a, int item, int tb, const int lane) {
    unsigned char* ws = a->ws;
    const int c = item & 31, h = (item >> 5) & 7, b = item >> 8, fr = lane & 15, fq = lane >> 4;
    bf16x8 qf[4];
    const bf16x8* qin = (const bf16x8*)(ws + WS_DQ) + ((size_t)item * 4 + tb) * 4 * 64 + lane;
#pragma unroll
    for (int ks = 0; ks < 4; ++ks) qf[ks] = qin[ks * 64];
    const v2u* oin = (const v2u*)(ws + WS_DO) + ((size_t)item * 4 + tb) * 8 * 64 + lane;
    const bf16x8* sin = (const bf16x8*)(ws + WS_DS) + (size_t)item * 8 * 4 * 64 + lane;
    f32x4 o[8]; float ss = 0.f;
    v2u olv[8]; bf16x8 sfr[4][4];
#pragma unroll
    for (int s = 0; s < 8; ++s) olv[s] = oin[s * 64];
#pragma unroll
    for (int s = 0; s < 4; ++s)
#pragma unroll
        for (int ks = 0; ks < 4; ++ks) sfr[s][ks] = sin[(s * 4 + ks) * 64];
    const int row_ = b * TP + 64 * c + 16 * tb + fr;
    v2u zv[8];
#pragma unroll
    for (int s = 0; s < 8; ++s) zv[s] = *(const v2u*)((const bf16*)(ws + WS_PROJ) + (size_t)row_ * NPROJ_PAD + 4096 + h * 128 + 4 * fq + 16 * s);
#pragma unroll
    for (int grp = 0; grp < 2; ++grp) {
#pragma unroll
        for (int s4 = 0; s4 < 4; ++s4) { const int s = 4 * grp + s4; const v2u ol = olv[s]; o[s] = (f32x4){bflo(ol.x), bfhi(ol.x), bflo(ol.y), bfhi(ol.y)};
#pragma unroll
            for (int ks = 0; ks < 4; ++ks) o[s] = MFMA32(sfr[s4][ks], qf[ks], o[s]);
            ss += (o[s].x * o[s].x + o[s].y * o[s].y) + (o[s].z * o[s].z + o[s].w * o[s].w); }
        if (grp == 0) {
#pragma unroll
            for (int s4 = 0; s4 < 4; ++s4)
#pragma unroll
                for (int ks = 0; ks < 4; ++ks) sfr[s4][ks] = sin[((4 + s4) * 4 + ks) * 64]; }
    }
    ss += __shfl_xor(ss, 16); ss += __shfl_xor(ss, 32);
    const float rstd = rsqrtf(ss * (1.f / 128.f) + RMS_EPS);
    const int row = b * TP + 64 * c + 16 * tb + fr;
    const bf16* zp = (const bf16*)(ws + WS_PROJ) + (size_t)row * NPROJ_PAD + 4096 + h * 128 + 4 * fq;
    bf16* mp = (bf16*)(ws + WS_MIX) + (size_t)row * D + h * 128 + 4 * fq;
    const float* nw = a->in[I_DNORM] + 4 * fq;
#pragma unroll
    for (int s = 0; s < 8; ++s) { const v2u z = zv[s]; const f32x4 n4 = *(const f32x4*)(nw + 16 * s);
        f32x4 y; y.x = o[s].x * rstd * n4.x * siluf(bflo(z.x)); y.y = o[s].y * rstd * n4.y * siluf(bfhi(z.x)); y.z = o[s].z * rstd * n4.z * siluf(bflo(z.y)); y.w = o[s].w * rstd * n4.w * siluf(bfhi(z.y));
        *(v2u*)(mp + 16 * s) = pack4(y); }
}


__device__ __forceinline__ void mlstm_scan_item(ArgsP a, LAS unsigned char* lds, int chain, int vs, const int tid) {
    const int lane = tid & 63, w = __builtin_amdgcn_readfirstlane(tid >> 6), fr = lane & 15, fq = lane >> 4;
    const int b = chain >> 3, h = chain & 7, row0 = b * TP;
    unsigned char* ws = a->ws;
    const bf16* proj = (const bf16*)(ws + WS_PROJ); const float* gates = (const float*)(ws + WS_GATES);
    LAS bf16* KT = (LAS bf16*)lds;
    LAS bf16* VT = (LAS bf16*)(lds + 36864);
    LAS float* wls = (LAS float*)(lds + 46080);
    LAS float* gendA = (LAS float*)(lds + 46592);
    LAS float* blastA = gendA + 2048;
    LAS float* mxA = blastA + 32;
    const float big = a->in[I_BIG][h], bfg = a->in[I_BFG][h];
    {
        float lf4[4], ig4[4];
#pragma unroll
        for (int i = 0; i < 4; ++i) { const float* gp = gates + (size_t)(row0 + 64 * (w + 8 * i) + lane) * 16 + h; ig4[i] = gp[0] + big; lf4[i] = logsigf(gp[8] + bfg); }
#pragma unroll
        for (int i = 0; i < 4; ++i) { const float bcum = wave_incl_sum(lf4[i], lane), blast = __shfl(bcum, 63), gend = blast - bcum + ig4[i]; const float mx = wave_max(gend);
            gendA[(w + 8 * i) * 64 + lane] = gend; if (lane == 0) { blastA[w + 8 * i] = blast; mxA[w + 8 * i] = mx; } }
    }
    LDS_BARRIER();
    const bf16* kptr = proj + (size_t)(row0 + lane) * NPROJ_PAD + 1024 + h * 128 + 16 * w;
    const bf16* vptr = proj + (size_t)(row0 + lane) * NPROJ_PAD + 2048 + h * 256 + 32 * vs + 8 * (w & 3);
    f32x4 acc[2]; acc[0] = (f32x4){0.f, 0.f, 0.f, 0.f}; acc[1] = acc[0];
    float nst = 0.f, m = 0.f;
    v4u kq[2][2], vq[2];
#define ML_LOAD(set, c_) do { const size_t ro = (size_t)(c_) * 64 * NPROJ_PAD; kq[set][0] = *(const v4u*)(kptr + ro); kq[set][1] = *(const v4u*)(kptr + ro + 8); \
        if (w < 4) vq[set] = *(const v4u*)(vptr + ro); } while (0)
#define ML_STEP(set, c_) do { const int item = chain * 32 + (c_); \
        const float blast = blastA[(c_)], gend = gendA[(c_) * 64 + lane]; \
        const float mnew = fmaxf(blast + m, mxA[(c_)]), sc = fexp(blast + m - mnew), wv = fexp(gend - mnew) * 0.08838834764831845f; \
        LAS bf16* kt = KT + (set) * 9216; LAS bf16* vt = VT + (set) * 2304; \
        _Pragma("unroll") for (int i = 0; i < 2; ++i) { const unsigned uu[4] = {kq[set][i].x, kq[set][i].y, kq[set][i].z, kq[set][i].w}; const int kr = 8 * (2 * w + i); \
            _Pragma("unroll") for (int e = 0; e < 4; ++e) { kt[(kr + 2 * e) * 72 + lane] = (bf16)(uu[e] & 0xffffu); kt[(kr + 2 * e + 1) * 72 + lane] = (bf16)(uu[e] >> 16); } } \
        if (w < 4) { const unsigned uu[4] = {vq[set].x, vq[set].y, vq[set].z, vq[set].w}; \
            _Pragma("unroll") for (int e = 0; e < 4; ++e) { vt[(8 * w + 2 * e) * 72 + lane] = (bf16)f2bf(bflo(uu[e]) * wv); vt[(8 * w + 2 * e + 1) * 72 + lane] = (bf16)f2bf(bfhi(uu[e]) * wv); } } \
        if (w == 0) wls[(set) * 64 + lane] = wv; \
        if ((c_) + 2 < 32) ML_LOAD(set, (c_) + 2); \
        if (vs == 0 && tid == 0) ((float*)(ws + WS_MM))[item] = m; \
        LDS_BARRIER(); \
        _Pragma("unroll") for (int vb = 0; vb < 2; ++vb) { *(v2u*)((bf16*)(ws + WS_MC) + ((size_t)item * 256 + 32 * vs + 16 * vb + fr) * 128 + 16 * w + 4 * fq) = pack4(acc[vb]); } \
        if (vs == 0 && tid < 128) { ((float*)(ws + WS_MN))[(size_t)item * 128 + tid] = nst; float sn = 0.f; \
            _Pragma("unroll") for (int s8 = 0; s8 < 8; ++s8) { const v4u kk = *(const LAS v4u*)(kt + tid * 72 + 8 * s8); const LAS float* wl = wls + (set) * 64 + 8 * s8; \
                sn += bflo(kk.x) * wl[0] + bfhi(kk.x) * wl[1] + bflo(kk.y) * wl[2] + bfhi(kk.y) * wl[3] + bflo(kk.z) * wl[4] + bfhi(kk.z) * wl[5] + bflo(kk.w) * wl[6] + bfhi(kk.w) * wl[7]; } \
            nst = sc * nst + sn; } \
        _Pragma("unroll") for (int vb = 0; vb < 2; ++vb) { acc[vb] = acc[vb] * sc; \
            _Pragma("unroll") for (int kt2 = 0; kt2 < 2; ++kt2) { const bf16x8 af = *(const LAS bf16x8*)(kt + (16 * w + fr) * 72 + 32 * kt2 + 8 * fq), bfv = *(const LAS bf16x8*)(vt + (16 * vb + fr) * 72 + 32 * kt2 + 8 * fq); \
                acc[vb] = MFMA32(af, bfv, acc[vb]); } } \
        m = mnew; } while (0)
    ML_LOAD(0, 0); ML_LOAD(1, 1);
#pragma unroll 1
    for (int c2 = 0; c2 < 32; c2 += 2) { ML_STEP(0, c2); ML_STEP(1, c2 + 1); }
#undef ML_LOAD
#undef ML_STEP
#pragma unroll
    for (int vb = 0; vb < 2; ++vb) *(f32x4*)(a->out + O_MCP + ((size_t)chain * 256 + 32 * vs + 16 * vb + fr) * 128 + 16 * w + 4 * fq) = acc[vb];
    if (vs == 0) { if (tid < 128) a->out[O_MNP + (size_t)chain * 128 + tid] = nst; if (tid == 0) a->out[O_MMP + chain] = m; }
    LDS_BARRIER();
}

__device__ __forceinline__ void mlstm_out_item(ArgsP a, LAS unsigned char* lds, int item, const int tid) {
    const int c = item & 31, h = (item >> 5) & 7, b = item >> 8, row0 = b * TP + 64 * c;
    const int lane = tid & 63, w = __builtin_amdgcn_readfirstlane(tid >> 6), fr = lane & 15, fq = lane >> 4;
    unsigned char* ws = a->ws;
    const bf16* proj = (const bf16*)(ws + WS_PROJ); const float* gates = (const float*)(ws + WS_GATES);
    LAS bf16* VT = (LAS bf16*)lds;
    LAS float* ssq = (LAS float*)(lds + 36864);
    const int tb = w & 3, half = w >> 2, t = 16 * tb + fr;
    v4u vu[4];
#pragma unroll
    for (int i = 0; i < 4; ++i) vu[i] = *(const v4u*)(proj + (size_t)(row0 + lane) * NPROJ_PAD + 2048 + h * 256 + 8 * (w + 8 * i));
    v4u qu[4]; f32x4 nv[4][2];
#pragma unroll
    for (int ks = 0; ks < 4; ++ks) { qu[ks] = *(const v4u*)(proj + (size_t)(row0 + t) * NPROJ_PAD + h * 128 + 32 * ks + 8 * fq);
        const float* np = (const float*)(ws + WS_MN) + (size_t)item * 128 + 32 * ks + 8 * fq; nv[ks][0] = *(const f32x4*)np; nv[ks][1] = *(const f32x4*)(np + 4); }
    v4u kfr[4][4];
#pragma unroll
    for (int sb = 0; sb < 4; ++sb) if (sb <= tb) {
#pragma unroll
        for (int ks = 0; ks < 4; ++ks) kfr[sb][ks] = *(const v4u*)(proj + (size_t)(row0 + 16 * sb + fr) * NPROJ_PAD + 1024 + h * 128 + 32 * ks + 8 * fq); }
    const float mc = ((const float*)(ws + WS_MM))[item];
    float av, Mt, et, em;
    { const float ig = gates[(size_t)(row0 + lane) * 16 + h] + a->in[I_BIG][h], lf = logsigf(gates[(size_t)(row0 + lane) * 16 + 8 + h] + a->in[I_BFG][h]);
      const float bcum = wave_incl_sum(lf, lane); av = ig - bcum; Mt = fmaxf(mc, wave_incl_max(av, lane)); et = fexp(mc - Mt); em = fexp(-(bcum + Mt)); }
#pragma unroll
    for (int i = 0; i < 4; ++i) { const unsigned uu[4] = {vu[i].x, vu[i].y, vu[i].z, vu[i].w}; const int vr = 8 * (w + 8 * i);
#pragma unroll
        for (int e = 0; e < 4; ++e) { VT[(vr + 2 * e) * 72 + lane] = (bf16)(uu[e] & 0xffffu); VT[(vr + 2 * e + 1) * 72 + lane] = (bf16)(uu[e] >> 16); } }
    bf16x8 qf[4]; float qn = 0.f;
#pragma unroll
    for (int ks = 0; ks < 4; ++ks) { const v4u u = qu[ks]; qf[ks] = __builtin_bit_cast(bf16x8, u); const f32x4 n0 = nv[ks][0], n1 = nv[ks][1];
        qn += bflo(u.x) * n0.x + bfhi(u.x) * n0.y + bflo(u.y) * n0.z + bfhi(u.y) * n0.w + bflo(u.z) * n1.x + bfhi(u.z) * n1.y + bflo(u.w) * n1.z + bfhi(u.w) * n1.w; }
    qn += __shfl_xor(qn, 16); qn += __shfl_xor(qn, 32);
    const float Mtt = __shfl(Mt, t), ett = __shfl(et, t), emt = __shfl(em, t);
    const bf16* cs = (const bf16*)(ws + WS_MC) + (size_t)item * 256 * 128;
    v2u smp[4]; float rowsum = 0.f;
#pragma unroll
    for (int sb = 0; sb < 4; ++sb) { smp[sb] = (v2u){0u, 0u};
        if (sb <= tb) { f32x4 qk = (f32x4){0.f, 0.f, 0.f, 0.f};
#pragma unroll
            for (int ks = 0; ks < 4; ++ks) qk = MFMA32(__builtin_bit_cast(bf16x8, kfr[sb][ks]), qf[ks], qk);
            f32x4 sm;
#pragma unroll
            for (int j = 0; j < 4; ++j) { const int s = 16 * sb + 4 * fq + j; const float as = __shfl(av, s); sm[j] = (s <= t) ? qk[j] * 0.08838834764831845f * fexp(as - Mtt) : 0.f; rowsum += sm[j]; }
            smp[sb] = pack4(sm); } }
    rowsum += __shfl_xor(rowsum, 16); rowsum += __shfl_xor(rowsum, 32);
    const float hden = 1.f / fmaxf(fabsf(ett * qn + rowsum), emt);
    const v4u s0u = (v4u){smp[0].x, smp[0].y, smp[1].x, smp[1].y}, s1u = (v4u){smp[2].x, smp[2].y, smp[3].x, smp[3].y};
    const bf16x8 sf0 = __builtin_bit_cast(bf16x8, s0u), sf1 = __builtin_bit_cast(bf16x8, s1u);
    v4u cfr[4][4];
#pragma unroll
    for (int g4 = 0; g4 < 4; ++g4)
#pragma unroll
        for (int ks = 0; ks < 4; ++ks) cfr[g4][ks] = *(const v4u*)(cs + (size_t)(128 * half + 16 * g4 + fr) * 128 + 32 * ks + 8 * fq);
    LDS_BARRIER();
    f32x4 hv[8]; float ss = 0.f;
#pragma unroll
    for (int grp = 0; grp < 2; ++grp) {
      f32x4 accs[4];
#pragma unroll
      for (int g4 = 0; g4 < 4; ++g4) { f32x4 acc = (f32x4){0.f, 0.f, 0.f, 0.f};
#pragma unroll
          for (int ks = 0; ks < 4; ++ks) acc = MFMA32(__builtin_bit_cast(bf16x8, cfr[g4][ks]), qf[ks], acc);
          accs[g4] = acc * ett; }
      if (grp == 0) {
#pragma unroll
          for (int g4 = 0; g4 < 4; ++g4)
#pragma unroll
              for (int ks = 0; ks < 4; ++ks) cfr[g4][ks] = *(const v4u*)(cs + (size_t)(128 * half + 64 + 16 * g4 + fr) * 128 + 32 * ks + 8 * fq); }
#pragma unroll
      for (int g4 = 0; g4 < 4; ++g4) { const int vb = 4 * grp + g4, vrow = 128 * half + 16 * vb + fr; f32x4 acc = accs[g4];
        { const v2u a0 = *(const LAS v2u*)(VT + vrow * 72 + 4 * fq), a1 = *(const LAS v2u*)(VT + vrow * 72 + 16 + 4 * fq); const v4u au = (v4u){a0.x, a0.y, a1.x, a1.y}; acc = MFMA32(__builtin_bit_cast(bf16x8, au), sf0, acc); }
        { const v2u a0 = *(const LAS v2u*)(VT + vrow * 72 + 32 + 4 * fq), a1 = *(const LAS v2u*)(VT + vrow * 72 + 48 + 4 * fq); const v4u au = (v4u){a0.x, a0.y, a1.x, a1.y}; acc = MFMA32(__builtin_bit_cast(bf16x8, au), sf1, acc); }
        hv[vb] = acc * hden; ss += (hv[vb].x * hv[vb].x + hv[vb].y * hv[vb].y) + (hv[vb].z * hv[vb].z + hv[vb].w * hv[vb].w); }
    }
    ss += __shfl_xor(ss, 16); ss += __shfl_xor(ss, 32);
    if (fq == 0) ssq[half * 64 + t] = ss;
    LDS_BARRIER();
    const float rstd = rsqrtf((ssq[t] + ssq[64 + t]) * (1.f / 256.f) + RMS_EPS);
    const bf16* op = proj + (size_t)(row0 + t) * NPROJ_PAD + 4096 + h * 256 + 128 * half + 4 * fq;
    bf16* mp = (bf16*)(ws + WS_MIX) + (size_t)(row0 + t) * D + h * 256 + 128 * half + 4 * fq;
    const float* nw = a->in[I_MNORM] + h * 256 + 128 * half + 4 * fq;
    v2u opr[8];
#pragma unroll
    for (int vb = 0; vb < 8; ++vb) opr[vb] = *(const v2u*)(op + 16 * vb);
#pragma unroll
    for (int vb = 0; vb < 8; ++vb) { const v2u o = opr[vb]; const f32x4 n4 = *(const f32x4*)(nw + 16 * vb);
        f32x4 y; y.x = hv[vb].x * rstd * n4.x * sigm(bflo(o.x)); y.y = hv[vb].y * rstd * n4.y * sigm(bfhi(o.x)); y.z = hv[vb].z * rstd * n4.z * sigm(bflo(o.y)); y.w = hv[vb].w * rstd * n4.w * sigm(bfhi(o.y));
        *(v2u*)(mp + 16 * vb) = pack4(y); }
    LDS_BARRIER();
}


__device__ __forceinline__ void mlstm_sample_load(ArgsP a, int j, const int tid, f32x4 (&cst)[2][4][2]) {
    const int lane = tid & 63, w = __builtin_amdgcn_readfirstlane(tid >> 6), fr = lane & 15, fq = lane >> 4;
    const float* C0 = a->in[I_SMC] + (size_t)j * 32768;
#pragma unroll
    for (int vb = 0; vb < 2; ++vb)
#pragma unroll
        for (int ksp = 0; ksp < 4; ++ksp) { const float* cp = C0 + (size_t)(32 * w + 16 * vb + fr) * 128 + 32 * ksp + 4 * fq; cst[vb][ksp][0] = __builtin_nontemporal_load((const f32x4*)cp); cst[vb][ksp][1] = __builtin_nontemporal_load((const f32x4*)(cp + 16)); }
}
__device__ __forceinline__ void mlstm_sample_item(ArgsP a, LAS unsigned char* lds, int j, const int tid, const f32x4 (&cst)[2][4][2]) {
    const int b = j >> 3, h = j & 7, row0 = MP + b * TS;
    const int lane = tid & 63, w = __builtin_amdgcn_readfirstlane(tid >> 6), fr = lane & 15, fq = lane >> 4;
    unsigned char* ws = a->ws;
    const bf16* proj = (const bf16*)(ws + WS_PROJ); const float* gates = (const float*)(ws + WS_GATES);
    float* Cout = a->out + O_MCS + (size_t)j * 32768;
    LAS float* qs = (LAS float*)lds;
    LAS float* ks = qs + 512;
    LAS float* vs = ks + 512;
    LAS float* gs = vs + 1024;
    LAS float* qkr = gs + 8;
    LAS float* qnl = qkr + 16;
    LAS float* hbuf = qnl + 8;
#pragma unroll
    for (int tok = 0; tok < 4; ++tok) { const bf16* pr = proj + (size_t)(row0 + tok) * NPROJ_PAD;
        if (tid < 128) qs[tok * 128 + tid] = bf2f(pr[h * 128 + tid]); else if (tid < 256) ks[tok * 128 + tid - 128] = bf2f(pr[1024 + h * 128 + (tid - 128)]) * 0.08838834764831845f; else vs[tok * 256 + tid - 256] = bf2f(pr[2048 + h * 256 + (tid - 256)]); }
    if (tid < 4) { gs[tid * 2] = gates[(size_t)(row0 + tid) * 16 + h] + a->in[I_BIG][h]; gs[tid * 2 + 1] = gates[(size_t)(row0 + tid) * 16 + 8 + h] + a->in[I_BFG][h]; }
    const float n0a = a->in[I_SMN][(size_t)j * 128 + lane], n0b = a->in[I_SMN][(size_t)j * 128 + 64 + lane];
    const float m0 = a->in[I_SMM][j];
    LDS_BARRIER();
#pragma unroll
    for (int i = 0; i < 2; ++i) { const int p = 2 * w + i, t = p >> 2, sx = p & 3; const float d = wave_sum(qs[t * 128 + lane] * ks[sx * 128 + lane] + qs[t * 128 + 64 + lane] * ks[sx * 128 + 64 + lane]); if (lane == 0) qkr[p] = d; }
    if (w < 4) { const float d = wave_sum(qs[w * 128 + lane] * n0a + qs[w * 128 + 64 + lane] * n0b); if (lane == 0) qnl[w] = d; }
    float bc[4], ig[4], mt[4], m = m0, bsum = 0.f;
#pragma unroll
    for (int t = 0; t < 4; ++t) { ig[t] = gs[t * 2]; const float lf = logsigf(gs[t * 2 + 1]); bsum += lf; bc[t] = bsum; m = fmaxf(lf + m, ig[t]); mt[t] = m; }
    const float scf = fexp(bc[3] + m0 - mt[3]);
    float wsf[4], et[4];
#pragma unroll
    for (int t = 0; t < 4; ++t) { wsf[t] = fexp(bc[3] - bc[t] + ig[t] - mt[3]); et[t] = fexp(bc[t] + m0 - mt[t]); }
    LDS_BARRIER();
    float S[4][4], hden[4];
#pragma unroll
    for (int t = 0; t < 4; ++t) { float den = et[t] * qnl[t];
#pragma unroll
        for (int sx = 0; sx < 4; ++sx) { S[t][sx] = (sx <= t) ? qkr[t * 4 + sx] * fexp(bc[t] - bc[sx] + ig[sx] - mt[t]) : 0.f; den += S[t][sx]; }
        hden[t] = 1.f / fmaxf(fabsf(den), fexp(-mt[t])); }
    bf16x8 qa[4];
#pragma unroll
    for (int ksp = 0; ksp < 4; ++ksp) { v4u u = (v4u){0u, 0u, 0u, 0u};
        if (fr < 4) { const f32x4 x0 = *(const LAS f32x4*)(qs + fr * 128 + 32 * ksp + 4 * fq), x1 = *(const LAS f32x4*)(qs + fr * 128 + 32 * ksp + 16 + 4 * fq); u.x = pk2(x0.x, x0.y); u.y = pk2(x0.z, x0.w); u.z = pk2(x1.x, x1.y); u.w = pk2(x1.z, x1.w); }
        qa[ksp] = __builtin_bit_cast(bf16x8, u); }
#pragma unroll
    for (int vb = 0; vb < 2; ++vb) { const int v = 32 * w + 16 * vb + fr;
        float vw[4];
#pragma unroll
        for (int sx = 0; sx < 4; ++sx) vw[sx] = vs[sx * 256 + v] * wsf[sx];
        f32x4 dacc = (f32x4){0.f, 0.f, 0.f, 0.f};
#pragma unroll
        for (int ksp = 0; ksp < 4; ++ksp) { const f32x4 c0 = cst[vb][ksp][0], c1 = cst[vb][ksp][1];
            v4u u; u.x = pk2(c0.x, c0.y); u.y = pk2(c0.z, c0.w); u.z = pk2(c1.x, c1.y); u.w = pk2(c1.z, c1.w);
            dacc = MFMA32(qa[ksp], __builtin_bit_cast(bf16x8, u), dacc);
            f32x4 n0v = c0 * scf, n1v = c1 * scf;
#pragma unroll
            for (int sx = 0; sx < 4; ++sx) { const f32x4 k0 = *(const LAS f32x4*)(ks + sx * 128 + 32 * ksp + 4 * fq), k1 = *(const LAS f32x4*)(ks + sx * 128 + 32 * ksp + 16 + 4 * fq); n0v = n0v + k0 * vw[sx]; n1v = n1v + k1 * vw[sx]; }
            float* op = Cout + (size_t)v * 128 + 32 * ksp + 4 * fq; __builtin_nontemporal_store(n0v, (f32x4*)op); __builtin_nontemporal_store(n1v, (f32x4*)(op + 16)); }
        if (fq == 0) {
#pragma unroll
            for (int t = 0; t < 4; ++t) { float num = et[t] * dacc[t];
#pragma unroll
                for (int sx = 0; sx < 4; ++sx) num += S[t][sx] * vs[sx * 256 + v];
                hbuf[t * 256 + v] = num * hden[t]; } }
    }
    if (tid < 128) { float nn = scf * a->in[I_SMN][(size_t)j * 128 + tid];
#pragma unroll
        for (int sx = 0; sx < 4; ++sx) nn += wsf[sx] * ks[sx * 128 + tid];
        a->out[O_MNS + (size_t)j * 128 + tid] = nn; }
    if (tid == 0) a->out[O_MMS + j] = mt[3];
    LDS_BARRIER();
    if (w < 4) { const int tok = w, row = row0 + tok; float hv[4]; float ss = 0.f;
#pragma unroll
        for (int i = 0; i < 4; ++i) { hv[i] = hbuf[tok * 256 + i * 64 + lane]; ss += hv[i] * hv[i]; }
        const float rstd = rsqrtf(wave_sum(ss) * (1.f / 256.f) + RMS_EPS);
        const float* nw = a->in[I_MNORM] + h * 256; bf16* mix = (bf16*)(ws + WS_MIX);
#pragma unroll
        for (int i = 0; i < 4; ++i) { const int vi = i * 64 + lane; const float op = bf2f(proj[(size_t)row * NPROJ_PAD + 4096 + h * 256 + vi]);
            mix[(size_t)row * D + h * 256 + vi] = (bf16)f2bf(hv[i] * rstd * nw[vi] * sigm(op)); } }
    LDS_BARRIER();
}


__device__ __forceinline__ void lru_sample_loop(ArgsP a, LAS unsigned char* lds, int vcu, int G, const int tid) {
    const int d = tid & 127, part = tid >> 7, n = vcu & 7, chn = n * 128 + d;
    const bf16* proj = (const bf16*)(a->ws + WS_PROJ); bf16* mix = (bf16*)(a->ws + WS_MIX);
    const float* wconv = a->in[I_WCONV]; const float* bconv = a->in[I_BCONV];
    const float* wr = a->in[I_LWR] + (size_t)n * 16384; const float* wi = a->in[I_LWI] + (size_t)n * 16384;
    LAS float* xr = (LAS float*)lds;
    LAS float* red = xr + 512;
    float w1[32], w2[32];
#pragma unroll
    for (int cc = 0; cc < 32; ++cc) { w1[cc] = wr[(part * 32 + cc) * 128 + d]; w2[cc] = wi[(part * 32 + cc) * 128 + d]; }
    const float br = a->in[I_LBR][chn], bi = a->in[I_LBI][chn], spl = softplusf(-a->in[I_LLAM][chn]);
#pragma unroll 1
    for (int j = vcu; j < 1024; j += G) {
        const int b = j >> 3, row0 = MP + b * TS; const float* cstate = a->in[I_SCONV] + (size_t)b * 3 * 4096;
        float hst = a->in[I_SLRU][(size_t)b * 1024 + chn];
        float gt[4];
        if (part == 0) {
#pragma unroll
            for (int tok = 0; tok < 4; ++tok) gt[tok] = bf2f(proj[(size_t)(row0 + tok) * NPROJ_PAD + 5120 + chn]); }
        { const int tok = tid >> 7; xr[tok * 128 + d] = conv4(proj, row0, tok, 3072 + chn, cstate, wconv, bconv); }
        LDS_BARRIER();
        float ar[4] = {0.f, 0.f, 0.f, 0.f}, ai[4] = {0.f, 0.f, 0.f, 0.f};
#pragma unroll
        for (int cc = 0; cc < 32; ++cc) { const int c = part * 32 + cc;
#pragma unroll
            for (int tok = 0; tok < 4; ++tok) { const float x = xr[tok * 128 + c]; ar[tok] += x * w1[cc]; ai[tok] += x * w2[cc]; } }
#pragma unroll
        for (int tok = 0; tok < 4; ++tok) { red[((tok * 2 + 0) * 4 + part) * 128 + d] = ar[tok]; red[((tok * 2 + 1) * 4 + part) * 128 + d] = ai[tok]; }
        LDS_BARRIER();
        if (part == 0) {
#pragma unroll
            for (int tok = 0; tok < 4; ++tok) {
                float rp = br, ip = bi;
#pragma unroll
                for (int p = 0; p < 4; ++p) { rp += red[((tok * 2 + 0) * 4 + p) * 128 + d]; ip += red[((tok * 2 + 1) * 4 + p) * 128 + d]; }
                const float log_a = -8.f * sigm(rp) * spl;
                const float av = fexp(log_a);
                const float bx = sqrtf(neg_expm1(2.f * log_a)) * sigm(ip) * xr[tok * 128 + d];
                hst = av * hst + bx;
                mix[(size_t)(row0 + tok) * D + 1024 + chn] = (bf16)f2bf(hst * gelu_tanh(gt[tok]));
            }
            a->out[O_LRUS + (size_t)b * 1024 + chn] = hst;
        }
        LDS_BARRIER();
    }
}

__device__ __forceinline__ void phase_mixer_even(ArgsP a, LAS unsigned char* lds, int vcu, int G, const int tid) {
#pragma unroll 1
    for (int r = 0; r < 1 + (PROBE_SUB & 1); ++r)
#pragma unroll 1
    for (int it = vcu; it < 1024; it += G) { int tq = tid; asm volatile("" : "+v"(tq)); delta_prep_item(a, lds, it, tq); }
#pragma unroll 1
    for (int r = 0; r < 1 + ((PROBE_SUB >> 1) & 1); ++r)
#pragma unroll 1
    for (int it = vcu; it < 1024; it += G) lru_prep_item(a, lds, it, tid);
#pragma unroll 1
    for (int r = 0; r < 1 + ((PROBE_SUB >> 2) & 1); ++r)
#pragma unroll 1
    for (int j = vcu; j < 1024; j += G) { const int b = j >> 3, hn = j & 7; delta_rec_item(a, lds, MP + b * TS, TS, hn, a->in[I_SCONV] + (size_t)b * 3 * 4096, a->in[I_SDELTA] + (size_t)j * 16384, a->out + O_DELTAS + (size_t)j * 16384, tid); }
#pragma unroll 1
    for (int r = 0; r < 1 + ((PROBE_SUB >> 3) & 1); ++r)
    lru_sample_loop(a, lds, vcu, G, tid);
    const bf16* proj = (const bf16*)(a->ws + WS_PROJ);
    const int npieces = (BP + BS) * 3 * 512;
    for (int i = vcu * NTHR + tid; i < npieces; i += G * NTHR) {
        const int c8 = i & 511, rj = i >> 9, j = rj % 3, b = rj / 3;
        const bf16* src; float* dst;
        if (b < BP) { src = proj + (size_t)(b * TP + TP - 3 + j) * NPROJ_PAD + 8 * c8; dst = a->out + O_CONVP + (size_t)(b * 3 + j) * 4096 + 8 * c8; }
        else { const int bs = b - BP; src = proj + (size_t)(MP + bs * TS + 1 + j) * NPROJ_PAD + 8 * c8; dst = a->out + O_CONVS + (size_t)(bs * 3 + j) * 4096 + 8 * c8; }
        const v4u u = *(const v4u*)src;
        *(f32x4*)dst = (f32x4){bflo(u.x), bfhi(u.x), bflo(u.y), bfhi(u.y)}; *(f32x4*)(dst + 4) = (f32x4){bflo(u.z), bfhi(u.z), bflo(u.w), bfhi(u.w)};
    }
}
__device__ __forceinline__ void phase_mixer_even_b(ArgsP a, LAS unsigned char* lds, int vcu, int G, const int tid) {
    const int w = __builtin_amdgcn_readfirstlane(tid >> 6);
    if (w == 0) { for (int it = vcu; it < 256; it += G) delta_scan_wave(a, it >> 3, it & 7, tid & 63); }
    else { LAS float* scr = (LAS float*)(lds + w * 16384);
        convert_range(a, scr, cv::R_IN0, cv::R_SCAN, vcu * 7 + (w - 1), G * 7, tid & 63); }
}
__device__ __forceinline__ void phase_mixer_even_c(ArgsP a, LAS unsigned char* lds, int vcu, int G, const int tid) {
    const int w = tid >> 6;
#pragma unroll 1
    for (int it = vcu; it < 512; it += G) delta_out_wave(a, 2 * it + (w >> 2), w & 3, tid & 63);
#pragma unroll 1
    for (int it = vcu; it < 1024; it += G) lru_out_item(a, lds, it, tid);
    for (int chain = vcu; chain < 32; chain += G) {
        const f32x4* src = (const f32x4*)(a->ws + WS_DF) + (size_t)chain * 4096; float* dst = a->out + O_DELTAP + (size_t)chain * 16384;
        f32x4 v[8];
#pragma unroll
        for (int i = 0; i < 8; ++i) v[i] = src[tid + 512 * i];
#pragma unroll
        for (int i = 0; i < 8; ++i) { const int idx = tid + 512 * i, ln = idx & 63, rb = (idx >> 6) & 7, s8 = idx >> 9; const int dk0 = 16 * rb + 4 * (ln >> 4), dv = 16 * s8 + (ln & 15);
            dst[(size_t)(dk0 + 0) * 128 + dv] = v[i].x; dst[(size_t)(dk0 + 1) * 128 + dv] = v[i].y; dst[(size_t)(dk0 + 2) * 128 + dv] = v[i].z; dst[(size_t)(dk0 + 3) * 128 + dv] = v[i].w; }
    }
}
__device__ __forceinline__ void phase_mixer_odd(ArgsP a, LAS unsigned char* lds, int vcu, int G, const int tid) {
#pragma unroll 1
    for (int r = 0; r < 1 + ((PROBE_SUB >> 4) & 1); ++r)
#pragma unroll 1
    for (int it = vcu; it < 256; it += G) mlstm_scan_item(a, lds, it >> 3, it & 7, tid);
#pragma unroll 1
    for (int r = 0; r < 1 + ((PROBE_SUB >> 5) & 1); ++r)
    {
        f32x4 cA[2][4][2], cB[2][4][2]; int j = vcu;
        if (j < 1024) { mlstm_sample_load(a, j, tid, cA);
#pragma unroll 1
            for (;;) {
                const int jB = j + G; const bool hasB = jB < 1024;
                if (hasB) mlstm_sample_load(a, jB, tid, cB);
                mlstm_sample_item(a, lds, j, tid, cA);
                if (!hasB) break;
                j = jB + G; const bool hasA = j < 1024;
                if (hasA) mlstm_sample_load(a, j, tid, cA);
                mlstm_sample_item(a, lds, jB, tid, cB);
                if (!hasA) break;
            } }
    }
}
__device__ __forceinline__ void phase_mixer_odd_b(ArgsP a, LAS unsigned char* lds, int vcu, int G, const int tid) {
#pragma unroll 1
    for (int it = vcu; it < 1024; it += G) mlstm_out_item(a, lds, it, tid);
}

__device__ __forceinline__ void phase_ln(const bf16* VB, const float* ST, const float* p1, const bf16* resid, const float* g, const float* bta, bf16* dst, LAS unsigned char* lds, int vcu, int G, const int tid) {
    const int lane = tid & 63, w = __builtin_amdgcn_readfirstlane(tid >> 6), gw = vcu * NWAVES + w, NGW = G * NWAVES;
    {
        LAS float* red = (LAS float*)lds;
        for (int r0 = 2 * vcu; r0 < MS; r0 += 2 * G) {
            const int r = r0 + (w >> 2), q = w & 3, col = 512 * q + 8 * lane; const size_t off = (size_t)(MP + r) * D + col;
            const float* q1 = p1 + (size_t)r * D + col;
            f32x4 x0 = *(const f32x4*)q1, x1 = *(const f32x4*)(q1 + 4);
#pragma unroll
            for (int ch = 1; ch < 16; ++ch) { x0 = x0 + *(const f32x4*)(q1 + (size_t)ch * 512 * D); x1 = x1 + *(const f32x4*)(q1 + (size_t)ch * 512 * D + 4); }
            const v4u rr = *(const v4u*)(resid + off);
            float v[8] = {x0.x + DN_ALPHA * bflo(rr.x), x0.y + DN_ALPHA * bfhi(rr.x), x0.z + DN_ALPHA * bflo(rr.y), x0.w + DN_ALPHA * bfhi(rr.y),
                          x1.x + DN_ALPHA * bflo(rr.z), x1.y + DN_ALPHA * bfhi(rr.z), x1.z + DN_ALPHA * bflo(rr.w), x1.w + DN_ALPHA * bfhi(rr.w)};
            float s = 0.f, ss = 0.f;
#pragma unroll
            for (int i = 0; i < 8; ++i) { s += v[i]; ss += v[i] * v[i]; }
            s = wave_sum(s); ss = wave_sum(ss);
            if (lane == 0) { red[w * 2] = s; red[w * 2 + 1] = ss; }
            LDS_BARRIER();
            const int wb = (w >> 2) * 4; s = (red[wb * 2] + red[wb * 2 + 2]) + (red[wb * 2 + 4] + red[wb * 2 + 6]); ss = (red[wb * 2 + 1] + red[wb * 2 + 3]) + (red[wb * 2 + 5] + red[wb * 2 + 7]);
            const float mean = s * (1.f / D), rstd = rsqrtf(fmaxf(ss * (1.f / D) - mean * mean, 0.f) + LN_EPS);
            const f32x4 g0 = *(const f32x4*)(g + col), g1 = *(const f32x4*)(g + col + 4), b0 = *(const f32x4*)(bta + col), b1 = *(const f32x4*)(bta + col + 4);
            v4u o; o.x = pk2((v[0] - mean) * rstd * g0.x + b0.x, (v[1] - mean) * rstd * g0.y + b0.y); o.y = pk2((v[2] - mean) * rstd * g0.z + b0.z, (v[3] - mean) * rstd * g0.w + b0.w);
            o.z = pk2((v[4] - mean) * rstd * g1.x + b1.x, (v[5] - mean) * rstd * g1.y + b1.y); o.w = pk2((v[6] - mean) * rstd * g1.z + b1.z, (v[7] - mean) * rstd * g1.w + b1.w);
            *(v4u*)(dst + off) = o;
            LDS_BARRIER();
        }
    }
    for (int m0 = gw; m0 < MP; m0 += 4 * NGW) {
        v4u vv[4][4]; float s[4], ss[4];
#pragma unroll
        for (int i = 0; i < 4; ++i) { const int m = m0 + i * NGW; s[i] = 0.f; ss[i] = 0.f;
            if (m < MP) { if (lane < 32) { const float* sp = ST + (((size_t)(lane >> 2) * M + m) * 4 + (lane & 3)) * 2; s[i] = sp[0]; ss[i] = sp[1]; }
#pragma unroll
                for (int j = 0; j < 4; ++j) vv[i][j] = *(const v4u*)(VB + (size_t)m * D + j * 512 + lane * 8); } }
#pragma unroll
        for (int i = 0; i < 4; ++i) { const int m = m0 + i * NGW;
            if (m < MP) { const float st = wave_sum(s[i]), sst = wave_sum(ss[i]);
                const float mean = st * (1.f / D), rstd = rsqrtf(fmaxf(sst * (1.f / D) - mean * mean, 0.f) + LN_EPS);
#pragma unroll
                for (int j = 0; j < 4; ++j) { const int col = j * 512 + lane * 8; const v4u v = vv[i][j];
                    const f32x4 g0 = *(const f32x4*)(g + col), g1 = *(const f32x4*)(g + col + 4), b0 = *(const f32x4*)(bta + col), b1 = *(const f32x4*)(bta + col + 4);
                    v4u o; o.x = pk2((bflo(v.x) - mean) * rstd * g0.x + b0.x, (bfhi(v.x) - mean) * rstd * g0.y + b0.y); o.y = pk2((bflo(v.y) - mean) * rstd * g0.z + b0.z, (bfhi(v.y) - mean) * rstd * g0.w + b0.w);
                    o.z = pk2((bflo(v.z) - mean) * rstd * g1.x + b1.x, (bfhi(v.z) - mean) * rstd * g1.y + b1.y); o.w = pk2((bflo(v.w) - mean) * rstd * g1.z + b1.z, (bfhi(v.w) - mean) * rstd * g1.w + b1.w);
                    *(v4u*)(dst + (size_t)m * D + col) = o; } } }
    }
}
__device__ __forceinline__ void phase_combine(const float* p1, const bf16* h2, const bf16* pw, bf16* xb, float* outf, int vcu, int G, const int tid) {
    const int lane = tid & 63, w = tid >> 6;
    for (int r0 = 2 * vcu; r0 < MS; r0 += 2 * G) {
        const int r = r0 + (w >> 2), q = w & 3, col = 512 * q + 8 * lane; const size_t off = (size_t)(MP + r) * D + col;
        const float* q1 = p1 + (size_t)r * D + col;
        f32x4 x0 = *(const f32x4*)q1, x1 = *(const f32x4*)(q1 + 4);
#pragma unroll
        for (int ch = 1; ch < 16; ++ch) { x0 = x0 + *(const f32x4*)(q1 + (size_t)ch * 512 * D); x1 = x1 + *(const f32x4*)(q1 + (size_t)ch * 512 * D + 4); }
        const v4u hh = *(const v4u*)(h2 + off), pp = *(const v4u*)(pw + off);
        f32x4 o0, o1;
        o0.x = bflo(hh.x) + sigm(x0.x) * bflo(pp.x); o0.y = bfhi(hh.x) + sigm(x0.y) * bfhi(pp.x); o0.z = bflo(hh.y) + sigm(x0.z) * bflo(pp.y); o0.w = bfhi(hh.y) + sigm(x0.w) * bfhi(pp.y);
        o1.x = bflo(hh.z) + sigm(x1.x) * bflo(pp.z); o1.y = bfhi(hh.z) + sigm(x1.y) * bfhi(pp.z); o1.z = bflo(hh.w) + sigm(x1.z) * bflo(pp.w); o1.w = bfhi(hh.w) + sigm(x1.w) * bfhi(pp.w);
        v4u ob; ob.x = pk2(o0.x, o0.y); ob.y = pk2(o0.z, o0.w); ob.z = pk2(o1.x, o1.y); ob.w = pk2(o1.z, o1.w); *(v4u*)(xb + off) = ob;
        if (outf) { *(f32x4*)(outf + off) = o0; *(f32x4*)(outf + off + 4) = o1; }
    }
}

constexpr int N_PHASES = 22;
enum { OP_INPROJ = 0, OP_MIXA, OP_MIXB, OP_MIXC, OP_OUTPROJ, OP_LN1, OP_UP, OP_DOWN, OP_LN2, OP_GATE, OP_COMBINE };
enum { GK_LN = 0, GK_BF16 = 1, GK_SQRELU = 2, GK_COMB = 3 };
__global__ void __launch_bounds__(NTHR, 2) mk_fwd(Args a_in) {
    extern __shared__ __attribute__((aligned(16))) unsigned char lds_raw[];
    LAS unsigned char* lds = (LAS unsigned char*)lds_raw;
    ArgsP kp = (ArgsP)__builtin_amdgcn_kernarg_segment_ptr();
    const int lo = a_in.ph_lo, hi = a_in.ph_hi;
    int wv0; { const int wtmp = (int)threadIdx.x >> 6; asm volatile("s_nop 4\n\tv_readfirstlane_b32 %0, %1\n\ts_nop 4" : "=s"(wv0) : "v"(wtmp)); }
#if MK_N_LAUNCHES == 1
    volatile LAS unsigned* xst = (volatile LAS unsigned*)(lds + LDS_CTL_OFF);
    if (threadIdx.x < 2) xst[threadIdx.x] = 0u;
    __syncthreads();
    XcdBarrier bar = xcd_barrier_post((unsigned*)(a_in.ws + WS_CTL) + 4096, xst);
#endif
    int p = lo; asm volatile("" : "+s"(p));
#pragma unroll 1
    for (; p < hi; ) {
      int nrep = 1;
      if (PROBE_MASK) { const int L_ = p <= 11 ? 0 : 1; const int q_ = p == 0 ? -1 : (L_ == 0 ? p - 1 : (p - 12 < 3 ? p - 12 : p - 11));
        int grp; if (p == 0) grp = 0; else if (q_ == OP_INPROJ || q_ == OP_UP) grp = 1; else if (q_ == OP_OUTPROJ || q_ == OP_DOWN || q_ == OP_GATE) grp = 2; else if (q_ == OP_LN1 || q_ == OP_LN2 || q_ == OP_COMBINE) grp = 3; else grp = (L_ == 0) ? 4 : 5;
        if ((PROBE_MASK >> grp) & 1) nrep = 2; }
      if (p == PROBE_P) nrep = 2;
#pragma unroll 1
      for (int rep = 0; rep < nrep; ++rep) {
        int pp = p; asm volatile("" : "+s"(pp));
        int wvs = wv0; asm volatile("" : "+s"(wvs));
        unsigned ones = ~0u; asm volatile("" : "+s"(ones));
        int tid = (wvs << 6) | (int)__builtin_amdgcn_mbcnt_hi(ones, __builtin_amdgcn_mbcnt_lo(ones, 0u)); asm volatile("" : "+v"(tid));
        int bx = blockIdx.x; asm volatile("" : "+s"(bx));
        int G = gridDim.x; asm volatile("" : "+s"(G));
        ArgsP a = kp; asm volatile("" : "+s"(a));
#define MK_VCU ((G % 8 == 0) ? (bx % 8) * (G / 8) + bx / 8 : bx)
#define MK_WAVE (__builtin_amdgcn_readfirstlane(tid >> 6))
#define MK_GW (MK_VCU * NWAVES + MK_WAVE)
#define MK_NGW (G * NWAVES)
#define MK_LANE (tid & 63)
        unsigned char* ws = a->ws;
        if (pp == 0) {
phase_convert(a, lds, MK_GW, MK_NGW, MK_WAVE, MK_LANE); }
        else {
            const int L = pp <= 11 ? 0 : 1; const int q = L == 0 ? pp - 1 : (pp - 12 < 3 ? pp - 12 : pp - 11);
            bf16* xb = (bf16*)(ws + WS_XB); bf16* mixb = (bf16*)(ws + WS_MIX); bf16* hb = (bf16*)(ws + WS_H); bf16* h2b = (bf16*)(ws + WS_H2); bf16* pwb = (bf16*)(ws + WS_PW);
            bf16* projb = (bf16*)(ws + WS_PROJ); bf16* upb = (bf16*)(ws + WS_PROJ);
            bf16* vbb = (bf16*)(ws + WS_PART0); float* stb = (float*)(ws + WS_PART0 + 34 * MiB); float* part1 = (float*)(ws + WS_PART1); float* gatesb = (float*)(ws + WS_GATES);
            if (q == OP_MIXA) { if (L == 0) phase_mixer_even(a, lds, MK_VCU, G, tid); else phase_mixer_odd(a, lds, MK_VCU, G, tid); }
            else if (q == OP_MIXB) { if (L == 0) phase_mixer_even_b(a, lds, MK_VCU, G, tid); else phase_mixer_odd_b(a, lds, MK_VCU, G, tid); }
            else if (q == OP_MIXC) { phase_mixer_even_c(a, lds, MK_VCU, G, tid); }
            else if (q == OP_LN1) phase_ln(vbb, stb, part1, xb, a->in[I_LN1G] + L * D, a->in[I_LN1B] + L * D, hb, lds, MK_VCU, G, tid);
            else if (q == OP_LN2) phase_ln(vbb, stb, part1, hb, a->in[I_LN2G] + L * D, a->in[I_LN2B] + L * D, h2b, lds, MK_VCU, G, tid);
            else if (q == OP_COMBINE) phase_combine(part1, h2b, pwb, xb, L == 1 ? a->out + O_Y : nullptr, MK_VCU, G, tid);
            else {
                for (int sub = 0; sub < (q == OP_INPROJ ? 2 : 1); ++sub) {
                    const bf16* A; const bf16* Bt; int N, K, kind; void* out = nullptr; float* gp = nullptr; const bf16* resid = nullptr; int corder = bx, gorder = G;
                    const int busy_in = ((M / 256) * (NPROJ_PAD / 256)) % 256;
                    if (q == OP_INPROJ && sub == 0) { A = xb; Bt = (const bf16*)(ws + (L == 0 ? WS_WINE : WS_WINO)); N = NPROJ_PAD; K = D; kind = GK_BF16; out = projb; gp = gatesb; }
                    else if (q == OP_INPROJ) { A = (const bf16*)(ws + WS_PB) + (size_t)L * M * PLE; Bt = (const bf16*)(ws + WS_WPLE) + (size_t)L * PLE * D; N = D; K = PLE; kind = GK_BF16; out = pwb;
                        gorder = G - busy_in; corder = (bx >= busy_in) ? bx - busy_in : 1 << 20; }
                    else if (q == OP_OUTPROJ) { A = mixb; Bt = (const bf16*)(ws + (L == 0 ? WS_WOUTE : WS_WOUTO)); N = D; K = D; kind = GK_LN; resid = xb; }
                    else if (q == OP_UP) { A = hb; Bt = (const bf16*)(ws + WS_WUP) + (size_t)L * D * FF; N = FF; K = D; kind = GK_SQRELU; out = upb; }
                    else if (q == OP_DOWN) { A = upb; Bt = (const bf16*)(ws + WS_WDOWN) + (size_t)L * D * FF; N = D; K = FF; kind = GK_LN; resid = hb; }
                    else { A = h2b; Bt = (const bf16*)(ws + WS_WGATE) + (size_t)L * D * D; N = D; K = D; kind = GK_COMB; }
                    pg8::Gemm g{A, Bt, M, N, K};
                    if (kind == GK_LN) { pg8::MainSplit SK; SK.init(K, MK_VCU); pg8::EpiLnStat E{vbb, stb, resid, part1, N, M, DN_ALPHA}; pg8::gemm_phase<pg8::EpiLnStat, pg8::MainSplit, true, true>(lds, g, SK, E, tid); }
                    else if (kind == GK_COMB) { pg8::MainSplit SK; SK.init(K, MK_VCU); pg8::EpiCombine E{h2b, pwb, xb, L == 1 ? a->out + O_Y : nullptr, part1, N}; pg8::gemm_phase<pg8::EpiCombine, pg8::MainSplit, true, true>(lds, g, SK, E, tid); }
                    else if (kind == GK_BF16) { pg8::StaticOrder S; S.init(M, N, K, gorder, corder); pg8::EpiBf16<0> E{(bf16*)out, N, gp, 24}; pg8::gemm_phase<pg8::EpiBf16<0>, pg8::StaticOrder, true, true>(lds, g, S, E, tid);}
                    else { pg8::StaticOrder S; S.init(M, N, K, G, corder); pg8::EpiBf16<1> E{(bf16*)out, N, nullptr, -1}; pg8::gemm_phase<pg8::EpiBf16<1>, pg8::StaticOrder, true, true>(lds, g, S, E, tid);}
                }
                if (q == OP_INPROJ || q == OP_UP) {
                    const int busy = (q == OP_INPROJ) ? ((M / 256) * (NPROJ_PAD / 256)) % 256 : ((M / 256) * (FF / 256)) % 256;
                    const int first = (q == OP_INPROJ) ? (L == 0 ? 0 : cv::R_SCAN) : (L == 0 ? cv::R_IN1 : cv::R_UP0), last = (q == OP_INPROJ) ? (L == 0 ? cv::R_IN0 : cv::R_IN1) : (L == 0 ? cv::R_UP0 : cv::N_REST);
                    if (G == 256 && bx >= busy) { const int w_ = MK_WAVE; convert_range(a, (LAS float*)(lds + w_ * 16384), first, last, (bx - busy) * NWAVES + w_, (G - busy) * NWAVES, MK_LANE); }
                }
            }
        }
#if MK_N_LAUNCHES == 1
        if (p + 1 < hi || rep + 1 < nrep) xcd_barrier(bar);
#endif
      }
      asm volatile("s_add_i32 %0, %0, 1" : "+s"(p) : : "scc");
    }
}

extern "C" void kernel_launch(void* const* d_in, const int* in_sizes, int n_in, void* d_out, int out_size, void* d_ws, size_t ws_size, hipStream_t stream) {
    static int grid = 0;
    if (grid == 0) {
        if (n_in != 35 || (size_t)out_size != O_END || ws_size < WS_END) { fprintf(stderr, "kernel_launch: unexpected shapes: n_in %d out %d (want %zu) ws %zu (want %zu)\n", n_in, out_size, (size_t)O_END, ws_size, (size_t)WS_END); grid = -1; return; }
        int dev = 0, cus = 0, per_cu = 0;
        hipGetDevice(&dev); hipDeviceGetAttribute(&cus, hipDeviceAttributeMultiprocessorCount, dev);
        if (hipFuncSetAttribute((const void*)mk_fwd, hipFuncAttributeMaxDynamicSharedMemorySize, LDS_BYTES) != hipSuccess) { fprintf(stderr, "kernel_launch: hipFuncSetAttribute failed\n"); grid = -1; return; }
        if (hipOccupancyMaxActiveBlocksPerMultiprocessor(&per_cu, (const void*)mk_fwd, NTHR, LDS_BYTES) != hipSuccess || per_cu < 1) { fprintf(stderr, "kernel_launch: occupancy query says %d\n", per_cu); per_cu = 1; }
        (void)hipGetLastError();
        if (cus != 256) { fprintf(stderr, "kernel_launch: built for a 256-CU device (N = 2048 GEMM schedule), got %d\n", cus); grid = -1; return; }
        grid = cus * 1;
    }
    if (grid < 0) return;
    Args a{};
    for (int i = 0; i < 35; ++i) a.in[i] = (const float*)d_in[i];
    a.out = (float*)d_out; a.ws = (unsigned char*)d_ws;
#if MK_N_LAUNCHES == 1
    hipMemsetAsync((char*)d_ws + WS_CTL, 0, 1 * MiB, stream);
    a.ph_lo = 0; a.ph_hi = N_PHASES;
    hipLaunchKernelGGL(mk_fwd, dim3(grid), dim3(NTHR), LDS_BYTES, stream, a);
#else
    for (int p = 0; p < N_PHASES; ++p) {
        a.ph_lo = p; a.ph_hi = p + 1;
        hipLaunchKernelGGL(mk_fwd, dim3(grid), dim3(NTHR), LDS_BYTES, stream, a);
    }
#endif
}
```

```cpp
#include <hip/hip_runtime.h>
#include <hip/hip_cooperative_groups.h>
#include <cstdio>
#include <cstdint>
namespace cg = cooperative_groups;

#ifndef PROBE_MASK
#define PROBE_MASK 0
#endif
#define PROBE_P (-1)
#define PROBE_SUB 0
#ifndef MK_N_LAUNCHES
#define MK_N_LAUNCHES 1
#endif

namespace pg8 {
#define PG8_LAS __attribute__((address_space(3)))
typedef unsigned short bf16_t;
typedef short bf16x8 __attribute__((ext_vector_type(8)));
typedef float f32x4 __attribute__((ext_vector_type(4)));
typedef unsigned u32x4 __attribute__((ext_vector_type(4)));
constexpr int BM = 256, BK = 64, HALF = 128, HTB = HALF * BK * 2, STAGE_BYTES = 8 * HTB, NXCD = 8, WGM = 8;

__host__ __device__ __forceinline__ int lds_byte(int r, int c) { const int st = (r >> 4) * 2 + (c >> 5), rr = r & 15, cc = c & 31, ob = rr * 64 + cc * 2; return st * 1024 + (ob ^ (((ob >> 9) & 1) << 5)); }
__host__ __device__ __forceinline__ void stage_rc(int b, int& R, int& C) { const int st = b / 1024, sb = b % 1024, swz = sb ^ (((sb >> 9) & 1) << 5); R = (st >> 1) * 16 + swz / 64; C = (st & 1) * 32 + (swz % 64) / 2; }
__host__ __device__ __forceinline__ int perm32(int rho) { const int n = rho >> 4, i = rho & 15; return 8 * (i >> 2) + 4 * n + (i & 3); }

struct Unit { int pm, pn, kt0, nkt, dst; };
struct Gemm { const bf16_t* A; const bf16_t* Bt; int M, N, K; };

struct StaticOrder {
    int nM, nN, nwg, G, c, T;
    __host__ __device__ void init(int M, int N, int K, int G_, int c_) { nM = M / BM; nN = N / BM; nwg = nM * nN; G = G_; c = c_; T = K / BK; }
    __host__ __device__ bool next(int i, Unit& u) const {
        const long L = (long)i * G + c; if (L >= nwg) return false;
        int wgid = (int)L; { const int q = nwg / NXCD, r = nwg % NXCD, xcd = wgid % NXCD, off = wgid / NXCD; wgid = (xcd < r ? xcd * (q + 1) : r * (q + 1) + (xcd - r) * q) + off; }
        const int nig = WGM * nN, gid = wgid / nig, fm = gid * WGM, gsz = (nM - fm) < WGM ? (nM - fm) : WGM;
        u.pm = fm + ((wgid % nig) % gsz); u.pn = (wgid % nig) / gsz; u.kt0 = 0; u.nkt = T; u.dst = 0; return true;
    }
    __device__ __forceinline__ void a_ready(const Unit&) const {}
    __device__ __forceinline__ void done(const Unit&) const {}
};
struct StreamK {
    int nN, T, P, ntot, c;
    __host__ __device__ void init(int M, int N, int K, int G, int c_) { nN = N / BM; T = K / BK; ntot = (M / BM) * nN * T; P = (((ntot + G - 1) / G) + 1) & ~1; c = c_; }
    __host__ __device__ bool next(int i, Unit& u) const {
        int s = c * P; const int e = (s + P < ntot) ? s + P : ntot;
        for (int k = 0; ; ++k) { if (s >= e) return false; const int tile = s / T, kt0 = s - tile * T; const int n = (T - kt0 < e - s) ? T - kt0 : e - s;
            if (k == i) { u.pm = tile / nN; u.pn = tile - u.pm * nN; u.kt0 = kt0; u.nkt = n; u.dst = kt0 ? 1 : 0; return true; }
            s += n; }
    }
    __device__ __forceinline__ void a_ready(const Unit&) const {}
    __device__ __forceinline__ void done(const Unit&) const {}
};
struct MainSplit {
    int T, c;
    __host__ __device__ void init(int K, int c_) { T = K / BK; c = c_; }
    __host__ __device__ bool next(int i, Unit& u) const {
        if (i == 0) { u.pm = c >> 3; u.pn = c & 7; u.kt0 = 0; u.nkt = T; u.dst = 0; return true; }
        if (i == 1) { const int lt = c >> 4, j = c & 15; u.pm = 32 + (lt >> 3); u.pn = lt & 7; u.nkt = T >> 4; u.kt0 = j * u.nkt; u.dst = 1 + j; return true; }
        return false;
    }
    __device__ __forceinline__ void a_ready(const Unit&) const {}
    __device__ __forceinline__ void done(const Unit&) const {}
};
__host__ __device__ __forceinline__ bool split_tile(int tile, int T, int P) { return (tile * T) / P != ((tile + 1) * T - 1) / P; }

typedef __bf16 hwbf16x2 __attribute__((ext_vector_type(2)));
typedef float hwf32x2 __attribute__((ext_vector_type(2)));
__device__ __forceinline__ unsigned cvt_pk_bf16(float lo, float hi) { return __builtin_bit_cast(unsigned, __builtin_convertvector((hwf32x2){lo, hi}, hwbf16x2)); }

__device__ __forceinline__ float pg_bflo(unsigned w) { return __builtin_bit_cast(float, w << 16); }
__device__ __forceinline__ float pg_bfhi(unsigned w) { return __builtin_bit_cast(float, w & 0xffff0000u); }
__device__ __forceinline__ void store_chunk(const f32x4 (&acc)[2][2][4][2], const Unit& u, float* C1, int ldc, int wr, int wc, int fr, int fq) {
    const int row0 = u.pm * BM + wr * 64 + fr, col0 = u.pn * BM + wc * 32 + 8 * fq; float* Cb = C1 + ((long)(u.dst - 1) * 512 - 8192) * (long)ldc;
#pragma unroll
    for (int ai = 0; ai < 2; ++ai)
#pragma unroll
        for (int m = 0; m < 4; ++m) { float* rowp = Cb + (size_t)(row0 + ai * HALF + m * 16) * ldc + col0;
#pragma unroll
            for (int bj = 0; bj < 2; ++bj) { *(f32x4*)(rowp + bj * HALF) = acc[ai][bj][m][0]; *(f32x4*)(rowp + bj * HALF + 4) = acc[ai][bj][m][1]; } }
}
struct EpiLnStat {
    static constexpr bool PERM = true, AFTER_DRAIN = false;
    bf16_t* VB; float* ST; const bf16_t* resid; float* C1; int ldc; int mrows; float alpha;
    __device__ __forceinline__ void operator()(const f32x4 (&acc)[2][2][4][2], const Unit& u, int wr, int wc, int fr, int fq) const {
        if (u.dst) { store_chunk(acc, u, C1, ldc, wr, wc, fr, fq); return; }
        const int row0 = u.pm * BM + wr * 64 + fr, col0 = u.pn * BM + wc * 32 + 8 * fq;
        u32x4 rq[2];
#pragma unroll
        for (int bj = 0; bj < 2; ++bj) rq[bj] = *(const u32x4*)(resid + (size_t)(row0) * ldc + col0 + bj * HALF);
#pragma unroll
        for (int idx = 0; idx < 8; ++idx) { const int ai = idx >> 2, m = idx & 3; const int row = row0 + ai * HALF + m * 16; float s = 0.f, ss = 0.f;
                u32x4 rc[2] = {rq[0], rq[1]};
                if (idx + 1 < 8) { const int nrow = row0 + ((idx + 1) >> 2) * HALF + ((idx + 1) & 3) * 16;
#pragma unroll
                    for (int bj = 0; bj < 2; ++bj) rq[bj] = *(const u32x4*)(resid + (size_t)nrow * ldc + col0 + bj * HALF); }
#pragma unroll
                for (int bj = 0; bj < 2; ++bj) { const size_t off = (size_t)row * ldc + col0 + bj * HALF; const u32x4 r = rc[bj];
                    f32x4 v0 = acc[ai][bj][m][0], v1 = acc[ai][bj][m][1];
                    v0[0] += alpha * pg_bflo(r.x); v0[1] += alpha * pg_bfhi(r.x); v0[2] += alpha * pg_bflo(r.y); v0[3] += alpha * pg_bfhi(r.y);
                    v1[0] += alpha * pg_bflo(r.z); v1[1] += alpha * pg_bfhi(r.z); v1[2] += alpha * pg_bflo(r.w); v1[3] += alpha * pg_bfhi(r.w);
                    s += ((v0[0] + v0[1]) + (v0[2] + v0[3])) + ((v1[0] + v1[1]) + (v1[2] + v1[3]));
                    ss += ((v0[0] * v0[0] + v0[1] * v0[1]) + (v0[2] * v0[2] + v0[3] * v0[3])) + ((v1[0] * v1[0] + v1[1] * v1[1]) + (v1[2] * v1[2] + v1[3] * v1[3]));
                    u32x4 w; w.x = cvt_pk_bf16(v0[0], v0[1]); w.y = cvt_pk_bf16(v0[2], v0[3]); w.z = cvt_pk_bf16(v1[0], v1[1]); w.w = cvt_pk_bf16(v1[2], v1[3]);
                    *(u32x4*)(VB + off) = w; }
                s += __shfl_xor(s, 16); s += __shfl_xor(s, 32); ss += __shfl_xor(ss, 16); ss += __shfl_xor(ss, 32);
                if (fq == 0) { float* sp = ST + (((size_t)u.pn * mrows + row) * 4 + wc) * 2; sp[0] = s; sp[1] = ss; } }
    }
};
struct EpiCombine {
    static constexpr bool PERM = true, AFTER_DRAIN = false;
    const bf16_t* h2; const bf16_t* pw; bf16_t* xb; float* outf; float* C1; int ldc;
    __device__ __forceinline__ void operator()(const f32x4 (&acc)[2][2][4][2], const Unit& u, int wr, int wc, int fr, int fq) const {
        if (u.dst) { store_chunk(acc, u, C1, ldc, wr, wc, fr, fq); return; }
        const int row0 = u.pm * BM + wr * 64 + fr, col0 = u.pn * BM + wc * 32 + 8 * fq;
        u32x4 hq[2], pq[2];
#pragma unroll
        for (int bj = 0; bj < 2; ++bj) { const size_t o0 = (size_t)row0 * ldc + col0 + bj * HALF; hq[bj] = *(const u32x4*)(h2 + o0); pq[bj] = *(const u32x4*)(pw + o0); }
#pragma unroll
        for (int idx = 0; idx < 8; ++idx) { const int ai = idx >> 2, m = idx & 3; const int row = row0 + ai * HALF + m * 16;
                u32x4 hc[2] = {hq[0], hq[1]}, pc[2] = {pq[0], pq[1]};
                if (idx + 1 < 8) { const int nrow = row0 + ((idx + 1) >> 2) * HALF + ((idx + 1) & 3) * 16;
#pragma unroll
                    for (int bj = 0; bj < 2; ++bj) { const size_t on = (size_t)nrow * ldc + col0 + bj * HALF; hq[bj] = *(const u32x4*)(h2 + on); pq[bj] = *(const u32x4*)(pw + on); } }
#pragma unroll
                for (int bj = 0; bj < 2; ++bj) { const size_t off = (size_t)row * ldc + col0 + bj * HALF; const u32x4 hh = hc[bj], pp = pc[bj];
                    const f32x4 a0 = acc[ai][bj][m][0], a1 = acc[ai][bj][m][1]; f32x4 o0, o1;
                    o0[0] = pg_bflo(hh.x) + pg_bflo(pp.x) / (1.f + __expf(-a0[0])); o0[1] = pg_bfhi(hh.x) + pg_bfhi(pp.x) / (1.f + __expf(-a0[1]));
                    o0[2] = pg_bflo(hh.y) + pg_bflo(pp.y) / (1.f + __expf(-a0[2])); o0[3] = pg_bfhi(hh.y) + pg_bfhi(pp.y) / (1.f + __expf(-a0[3]));
                    o1[0] = pg_bflo(hh.z) + pg_bflo(pp.z) / (1.f + __expf(-a1[0])); o1[1] = pg_bfhi(hh.z) + pg_bfhi(pp.z) / (1.f + __expf(-a1[1]));
                    o1[2] = pg_bflo(hh.w) + pg_bflo(pp.w) / (1.f + __expf(-a1[2])); o1[3] = pg_bfhi(hh.w) + pg_bfhi(pp.w) / (1.f + __expf(-a1[3]));
                    u32x4 w; w.x = cvt_pk_bf16(o0[0], o0[1]); w.y = cvt_pk_bf16(o0[2], o0[3]); w.z = cvt_pk_bf16(o1[0], o1[1]); w.w = cvt_pk_bf16(o1[2], o1[3]);
                    *(u32x4*)(xb + off) = w;
                    if (outf) { *(f32x4*)(outf + off) = o0; *(f32x4*)(outf + off + 4) = o1; } } }
    }
};
template <int ACT> struct EpiBf16 {
    static constexpr bool PERM = true, AFTER_DRAIN = false;
    bf16_t* O; int ldc; float* gates; int gate_pn;
    __device__ __forceinline__ void operator()(const f32x4 (&acc)[2][2][4][2], const Unit& u, int wr, int wc, int fr, int fq) const {
        const int row0 = u.pm * BM + wr * 64 + fr; const int col0 = u.pn * BM + wc * 32 + 8 * fq;
        const bool gt = (gates != nullptr) && (u.pn == gate_pn) && (wc == 0) && (fq < 2);
#pragma unroll
        for (int ai = 0; ai < 2; ++ai)
#pragma unroll
            for (int m = 0; m < 4; ++m) { const int row = row0 + ai * HALF + m * 16; bf16_t* rowp = O + (size_t)row * ldc + col0;
#pragma unroll
                for (int bj = 0; bj < 2; ++bj) { f32x4 v0 = acc[ai][bj][m][0], v1 = acc[ai][bj][m][1];
                    if (ACT == 1) {
#pragma unroll
                        for (int j = 0; j < 4; ++j) { const float a = fmaxf(v0[j], 0.f), b = fmaxf(v1[j], 0.f); v0[j] = a * a; v1[j] = b * b; } }
                    u32x4 w; w.x = cvt_pk_bf16(v0[0], v0[1]); w.y = cvt_pk_bf16(v0[2], v0[3]); w.z = cvt_pk_bf16(v1[0], v1[1]); w.w = cvt_pk_bf16(v1[2], v1[3]);
                    *(u32x4*)(rowp + bj * HALF) = w; }
                if (gt) { float* gp = gates + (size_t)row * 16 + 8 * fq; *(f32x4*)gp = acc[ai][0][m][0]; *(f32x4*)(gp + 4) = acc[ai][0][m][1]; } }
    }
};

template <class Epi, class Sched, bool ALIGN_EPI = false, bool SP2 = false>
__device__ __forceinline__ void gemm_phase(PG8_LAS unsigned char* lds, const Gemm g, const Sched& S, const Epi& E, const int tid) {
    const int wid = __builtin_amdgcn_readfirstlane(tid >> 6), lane = tid & 63, wr = wid >> 2, wc = wid & 3, fr = lane & 15, fq = lane >> 4;
    const int K = g.K;
    unsigned voffA[2], voffB[2];
#pragma unroll
    for (int i = 0; i < 2; ++i) { int R, C; stage_rc(tid * 16 + i * 8192, R, C); const int Rb = Epi::PERM ? ((R & ~31) + perm32(R & 31)) : R;
        voffA[i] = (unsigned)(R * K + C) * 2u; voffB[i] = (unsigned)(Rb * K + C) * 2u; }
    const size_t kstep = (size_t)(BK * 2);
    const size_t hstep = (size_t)HALF * K * 2;
    const size_t tstep = 2 * hstep;
    const unsigned ldsw = (unsigned)wid * 1024u;
    const int aoff = lds_byte(wr * 64 + fr, fq * 8), boff = lds_byte(wc * 32 + fr, fq * 8);
#define PG8_SA(b, h) (((b) * 2 + (h)) * HTB)
#define PG8_SB(b, h) ((4 + (b) * 2 + (h)) * HTB)
#define PG8_STAGE(bufoff, gbase, voff) do { _Pragma("unroll") for (int _i = 0; _i < 2; ++_i) \
        __builtin_amdgcn_global_load_lds((const unsigned*)((const char*)(gbase) + (voff)[_i]), (PG8_LAS unsigned*)(lds + (bufoff) + ldsw + _i * 8192), 16, 0, 0); } while (0)
#define PG8_LDA(dst, b, h) do { _Pragma("unroll") for (int m = 0; m < 4; ++m) _Pragma("unroll") for (int k = 0; k < 2; ++k) dst[m][k] = *(const PG8_LAS bf16x8*)(lds + PG8_SA(b, h) + aoff + m * 2048 + k * 1024); } while (0)
#define PG8_LDB(dst, b, h) do { _Pragma("unroll") for (int n = 0; n < 2; ++n) _Pragma("unroll") for (int k = 0; k < 2; ++k) dst[n][k] = *(const PG8_LAS bf16x8*)(lds + PG8_SB(b, h) + boff + n * 2048 + k * 1024); } while (0)
#define PG8_MMA(ai, bj, At, Bt) do { __builtin_amdgcn_s_setprio(1); _Pragma("unroll") for (int m = 0; m < 4; ++m) _Pragma("unroll") for (int n = 0; n < 2; ++n) _Pragma("unroll") for (int k = 0; k < 2; ++k) \
        acc[ai][bj][m][n] = __builtin_amdgcn_mfma_f32_16x16x32_bf16(Bt[n][k], At[m][k], acc[ai][bj][m][n], 0, 0, 0); __builtin_amdgcn_s_setprio(0); } while (0)
#define PG8_WAIT_V(n) asm volatile("s_waitcnt vmcnt(" #n ")" ::: "memory")
#define PG8_WAIT_L(n) asm volatile("s_waitcnt lgkmcnt(" #n ")" ::: "memory")
#define PG8_BAR __builtin_amdgcn_s_barrier()
#define PG8_SCHED __builtin_amdgcn_sched_barrier(0)
    Unit cur, nxt; int ui = 0;
    if (!S.next(0, cur)) return;
    f32x4 acc[2][2][4][2];
#pragma unroll
    for (int a = 0; a < 2; ++a)
#pragma unroll
        for (int b = 0; b < 2; ++b)
#pragma unroll
            for (int m = 0; m < 4; ++m)
#pragma unroll
                for (int n = 0; n < 2; ++n) acc[a][b][m][n] = (f32x4){0.f, 0.f, 0.f, 0.f};
    bf16x8 At[4][2], B0[2][2], B1[2][2];
    const char* cA = (const char*)g.A + (size_t)cur.pm * tstep + (size_t)cur.kt0 * kstep; const char* cB = (const char*)g.Bt + (size_t)cur.pn * tstep + (size_t)cur.kt0 * kstep;
    S.a_ready(cur);
    if constexpr (SP2) {
        PG8_STAGE(PG8_SB(0, 0), cB, voffB); PG8_STAGE(PG8_SB(0, 1), cB + hstep, voffB); PG8_STAGE(PG8_SA(0, 0), cA, voffA); PG8_STAGE(PG8_SA(0, 1), cA + hstep, voffA);
        if (wr == 1) PG8_BAR;
        PG8_WAIT_V(2); PG8_BAR;
        PG8_STAGE(PG8_SB(1, 0), cB + kstep, voffB); PG8_STAGE(PG8_SA(1, 0), cA + kstep, voffA); PG8_STAGE(PG8_SB(1, 1), cB + hstep + kstep, voffB);
        PG8_WAIT_V(6); PG8_BAR;
    } else {
        PG8_STAGE(PG8_SB(0, 0), cB, voffB); PG8_STAGE(PG8_SA(0, 0), cA, voffA); PG8_STAGE(PG8_SB(0, 1), cB + hstep, voffB); PG8_STAGE(PG8_SA(0, 1), cA + hstep, voffA);
        if (wr == 1) PG8_BAR;
        PG8_WAIT_V(4); PG8_BAR;
        PG8_STAGE(PG8_SB(1, 0), cB + kstep, voffB); PG8_STAGE(PG8_SA(1, 0), cA + kstep, voffA); PG8_STAGE(PG8_SB(1, 1), cB + hstep + kstep, voffB);
        PG8_WAIT_V(6); PG8_BAR;
    }
    for (;;) {
        const bool has_next = S.next(ui + 1, nxt);
        const char* nA = has_next ? (const char*)g.A + (size_t)nxt.pm * tstep + (size_t)nxt.kt0 * kstep : cA; const char* nB = has_next ? (const char*)g.Bt + (size_t)nxt.pn * tstep + (size_t)nxt.kt0 * kstep : cB;
        const int nt = cur.nkt;
        for (int t = 0; t < nt; t += 2) {
            const bool last = (t == nt - 2);
            const char* a1 = cA + (size_t)(t + 1) * kstep;
            const char* a2 = last ? nA : cA + (size_t)(t + 2) * kstep; const char* b2 = last ? nB : cB + (size_t)(t + 2) * kstep;
            const char* a3 = a2 + kstep; const char* b3 = b2 + kstep;
            if (last && has_next) S.a_ready(nxt);
            if constexpr (SP2) {
            PG8_LDB(B0, 0, 0); PG8_LDB(B1, 0, 1); PG8_SCHED; PG8_LDA(At, 0, 0); PG8_STAGE(PG8_SA(1, 1), a1 + hstep, voffA);
            PG8_WAIT_V(8); PG8_WAIT_L(0); PG8_BAR; PG8_MMA(0, 0, At, B0); PG8_MMA(0, 1, At, B1); PG8_BAR; PG8_SCHED;
            PG8_LDA(At, 0, 1); PG8_STAGE(PG8_SB(0, 0), b2, voffB); PG8_STAGE(PG8_SB(0, 1), b2 + hstep, voffB); PG8_STAGE(PG8_SA(0, 0), a2, voffA);
            PG8_WAIT_V(8); PG8_WAIT_L(0); PG8_BAR; PG8_MMA(1, 0, At, B0); PG8_MMA(1, 1, At, B1); PG8_BAR; PG8_SCHED;
            PG8_LDB(B0, 1, 0); PG8_LDB(B1, 1, 1); PG8_SCHED; PG8_LDA(At, 1, 0); PG8_STAGE(PG8_SA(0, 1), a2 + hstep, voffA);
            PG8_WAIT_V(8); PG8_WAIT_L(0); PG8_BAR; PG8_MMA(0, 0, At, B0); PG8_MMA(0, 1, At, B1); PG8_BAR; PG8_SCHED;
            PG8_LDA(At, 1, 1); PG8_STAGE(PG8_SB(1, 0), b3, voffB); PG8_STAGE(PG8_SB(1, 1), b3 + hstep, voffB); PG8_STAGE(PG8_SA(1, 0), a3, voffA);
            PG8_WAIT_V(8); PG8_WAIT_L(0); PG8_BAR; PG8_MMA(1, 0, At, B0); PG8_MMA(1, 1, At, B1); PG8_BAR; PG8_SCHED;
            } else {
            PG8_LDB(B0, 0, 0); PG8_SCHED; PG8_LDA(At, 0, 0); PG8_STAGE(PG8_SA(1, 1), a1 + hstep, voffA);
            PG8_WAIT_L(8); PG8_BAR; PG8_WAIT_L(0); PG8_MMA(0, 0, At, B0); PG8_BAR; PG8_SCHED;
            PG8_LDB(B1, 0, 1); PG8_STAGE(PG8_SB(0, 0), b2, voffB);
            PG8_BAR; PG8_WAIT_L(0); PG8_MMA(0, 1, At, B1); PG8_BAR;
            PG8_LDA(At, 0, 1); PG8_STAGE(PG8_SA(0, 0), a2, voffA);
            PG8_BAR; PG8_WAIT_L(0); PG8_MMA(1, 0, At, B0); PG8_BAR; PG8_SCHED;
            PG8_STAGE(PG8_SB(0, 1), b2 + hstep, voffB);
            PG8_WAIT_V(6); PG8_BAR; PG8_MMA(1, 1, At, B1); PG8_BAR;
            PG8_LDB(B0, 1, 0); PG8_SCHED; PG8_LDA(At, 1, 0); PG8_STAGE(PG8_SA(0, 1), a2 + hstep, voffA);
            PG8_WAIT_L(8); PG8_BAR; PG8_WAIT_L(0); PG8_MMA(0, 0, At, B0); PG8_BAR; PG8_SCHED;
            PG8_LDB(B1, 1, 1); PG8_STAGE(PG8_SB(1, 0), b3, voffB);
            PG8_BAR; PG8_WAIT_L(0); PG8_MMA(0, 1, At, B1); PG8_BAR;
            PG8_LDA(At, 1, 1); PG8_STAGE(PG8_SA(1, 0), a3, voffA);
            PG8_BAR; PG8_WAIT_L(0); PG8_MMA(1, 0, At, B0); PG8_BAR; PG8_SCHED;
            PG8_STAGE(PG8_SB(1, 1), b3 + hstep, voffB);
            PG8_WAIT_V(6); PG8_BAR; PG8_MMA(1, 1, At, B1); PG8_BAR;
            }
        }
        if constexpr (ALIGN_EPI) { if (wr == 0) PG8_BAR; }
        E(acc, cur, wr, wc, fr, fq); S.done(cur);
        if (!has_next) break;
#pragma unroll
        for (int a = 0; a < 2; ++a)
#pragma unroll
            for (int b = 0; b < 2; ++b)
#pragma unroll
                for (int m = 0; m < 4; ++m)
#pragma unroll
                    for (int n = 0; n < 2; ++n) acc[a][b][m][n] = (f32x4){0.f, 0.f, 0.f, 0.f};
        cur = nxt; cA = nA; cB = nB; ++ui;
        if constexpr (ALIGN_EPI) { if (wr == 1) PG8_BAR; }
    }
    PG8_WAIT_V(0);
    if constexpr (!ALIGN_EPI) { if (wr == 0) PG8_BAR; }
    PG8_BAR;
#undef PG8_SA
#undef PG8_SB
#undef PG8_STAGE
#undef PG8_LDA
#undef PG8_LDB
#undef PG8_MMA
#undef PG8_WAIT_V
#undef PG8_WAIT_L
#undef PG8_BAR
#undef PG8_SCHED
}
}

constexpr int NWAVES = 8, NTHR = 512;
constexpr int D = 2048, FF = 8192, PLE = 256;
constexpr int TP = 2048, BP = 4, TS = 4, BS = 128;
constexpr int MP = BP * TP, MS = BS * TS, M = MP + MS;
constexpr int NPROJ = 6160, NPROJ_PAD = 6400;
constexpr int NH = 8;
constexpr float LN_EPS = 1e-5f, RMS_EPS = 1e-6f;
constexpr float DN_ALPHA = 1.41421356237f;

constexpr size_t MiB = 1u << 20;
constexpr size_t WS_CTL = 0;
constexpr size_t WS_WINE = 1 * MiB;
constexpr size_t WS_WOUTE = WS_WINE + 25 * MiB;
constexpr size_t WS_WINO = WS_WOUTE + 8 * MiB;
constexpr size_t WS_WOUTO = WS_WINO + 25 * MiB;
constexpr size_t WS_WUP = WS_WOUTO + 8 * MiB;
constexpr size_t WS_WDOWN = WS_WUP + 64 * MiB;
constexpr size_t WS_WPLE = WS_WDOWN + 64 * MiB;
constexpr size_t WS_WGATE = WS_WPLE + 2 * MiB;
constexpr size_t WS_XB = WS_WGATE + 16 * MiB;
constexpr size_t WS_MIX = WS_XB + 34 * MiB;
constexpr size_t WS_H = WS_MIX + 34 * MiB;
constexpr size_t WS_H2 = WS_H + 34 * MiB;
constexpr size_t WS_PW = WS_H2 + 34 * MiB;
constexpr size_t WS_PB = WS_PW + 34 * MiB;
constexpr size_t WS_GATES = WS_PB + 9 * MiB;
constexpr size_t WS_PROJ = WS_GATES + 1 * MiB;
constexpr size_t WS_PART0 = WS_PROJ + 136 * MiB;
constexpr size_t WS_PART1 = WS_PART0 + 68 * MiB;
constexpr size_t WS_LRUW = WS_PART1 + 68 * MiB;
constexpr size_t WS_END = WS_LRUW + 1 * MiB;
constexpr size_t WS_DG = WS_PART0;
constexpr size_t WS_DB = WS_PART0 + 32 * MiB;
constexpr size_t WS_DS = WS_PART0 + 64 * MiB;
constexpr size_t WS_DQ = WS_PART0 + 96 * MiB;
constexpr size_t WS_DO = WS_PART0 + 112 * MiB;
constexpr size_t WS_DD = WS_PART0 + 128 * MiB;
constexpr size_t WS_DF = WS_PART0 + 129 * MiB;
constexpr size_t WS_MC = WS_PART0;
constexpr size_t WS_MN = WS_PART0 + 64 * MiB;
constexpr size_t WS_MM = WS_PART0 + 65 * MiB;
constexpr size_t WS_LRU_HL = WS_H;
constexpr size_t WS_LRU_P = WS_H + 16 * MiB;
constexpr size_t WS_LRU_END = WS_H + 32 * MiB;

constexpr size_t O_Y = 0;
constexpr size_t O_CONVP = (size_t)M * D;
constexpr size_t O_DELTAP = O_CONVP + (size_t)BP * 3 * 4096;
constexpr size_t O_LRUP = O_DELTAP + (size_t)BP * 8 * 128 * 128;
constexpr size_t O_MCP = O_LRUP + (size_t)BP * 1024;
constexpr size_t O_MNP = O_MCP + (size_t)BP * 8 * 256 * 128;
constexpr size_t O_MMP = O_MNP + (size_t)BP * 8 * 128;
constexpr size_t O_CONVS = O_MMP + (size_t)BP * 8;
constexpr size_t O_DELTAS = O_CONVS + (size_t)BS * 3 * 4096;
constexpr size_t O_LRUS = O_DELTAS + (size_t)BS * 8 * 128 * 128;
constexpr size_t O_MCS = O_LRUS + (size_t)BS * 1024;
constexpr size_t O_MNS = O_MCS + (size_t)BS * 8 * 256 * 128;
constexpr size_t O_MMS = O_MNS + (size_t)BS * 8 * 128;
constexpr size_t O_END = O_MMS + (size_t)BS * 8;

constexpr int LDS_BYTES = 147456;
constexpr int LDS_CTL_OFF = 131072;

#define LAS __attribute__((address_space(3)))
typedef unsigned short bf16;
typedef unsigned v4u __attribute__((ext_vector_type(4)));
typedef unsigned v2u __attribute__((ext_vector_type(2)));
typedef float f32x4 __attribute__((ext_vector_type(4)));
#define LDS_WAIT() asm volatile("s_waitcnt lgkmcnt(0)" ::: "memory")
#define LDS_BARRIER() do { asm volatile("s_waitcnt lgkmcnt(0)" ::: "memory"); __builtin_amdgcn_s_barrier(); asm volatile("" ::: "memory"); } while (0)
__device__ __forceinline__ unsigned pk2(float lo, float hi) { return pg8::cvt_pk_bf16(lo, hi); }
__device__ __forceinline__ unsigned f2bf(float f) { return pg8::cvt_pk_bf16(f, 0.f) & 0xffffu; }
__device__ __forceinline__ float bf2f(unsigned short b) { return __builtin_bit_cast(float, ((unsigned)b) << 16); }
__device__ __forceinline__ float bflo(unsigned w) { return __builtin_bit_cast(float, w << 16); }
__device__ __forceinline__ float bfhi(unsigned w) { return __builtin_bit_cast(float, w & 0xffff0000u); }
__device__ __forceinline__ float fexp(float x) { return __builtin_amdgcn_exp2f(x * 1.4426950408889634f); }
__device__ __forceinline__ float sigm(float x) { return __builtin_amdgcn_rcpf(1.f + fexp(-x)); }
__device__ __forceinline__ float siluf(float x) { return x * sigm(x); }
__device__ __forceinline__ float softplusf(float x) { return fmaxf(x, 0.f) + log1pf(expf(-fabsf(x))); }
__device__ __forceinline__ float logsigf(float x) { return -softplusf(-x); }
__device__ __forceinline__ float neg_expm1(float y) {
    const float ser = -y * (1.f + y * (0.5f + y * (0.16666667f + y * (0.041666668f + y * (0.008333334f + y * 0.0013888889f)))));
    return (y > -0.25f) ? ser : 1.f - fexp(y);
}
__device__ __forceinline__ float gelu_tanh(float x) { const float u = 0.7978845608028654f * (x + 0.044715f * x * x * x); return x * sigm(2.f * u); }
__device__ __forceinline__ float wave_sum(float v) {
#pragma unroll
    for (int o = 1; o < 64; o <<= 1) v += __shfl_xor(v, o);
    return v;
}

__device__ __forceinline__ float wave_incl_sum(float v, int lane) {
#pragma unroll
    for (int o = 1; o < 64; o <<= 1) { const float u = __shfl_up(v, o); if (lane >= o) v += u; }
    return v;
}
__device__ __forceinline__ float wave_incl_max(float v, int lane) {
#pragma unroll
    for (int o = 1; o < 64; o <<= 1) { const float u = __shfl_up(v, o); if (lane >= o) v = fmaxf(v, u); }
    return v;
}
__device__ __forceinline__ float wave_max(float v) {
#pragma unroll
    for (int o = 1; o < 64; o <<= 1) v = fmaxf(v, __shfl_xor(v, o));
    return v;
}
#define XB_TMO      128
#define XB_XCNT(j)  (256  + 64 * (j))
#define XB_XSUB(j)  (1280 + 64 * (j))
#define XB_XGEN(j)  (2304 + 64 * (j))
#define XB_TOP      3328
#define XB_TOPGEN   3392
#define XCD_BAR_WORDS 3456
#define XB_SPIN_CAP (1u << 22)
__device__ __forceinline__ unsigned xb_ld(unsigned* p)              { return __hip_atomic_load(p, __ATOMIC_RELAXED, __HIP_MEMORY_SCOPE_AGENT); }
__device__ __forceinline__ unsigned xb_add(unsigned* p, unsigned v) { return __hip_atomic_fetch_add(p, v, __ATOMIC_RELAXED, __HIP_MEMORY_SCOPE_AGENT); }
__device__ __forceinline__ unsigned xb_xcc_id() { return (unsigned)__builtin_amdgcn_s_getreg((3 << 11) | 20) & 0xFu; }
#define XB_SPIN(cond, bar) do { unsigned _sp = 0; while (cond) { __builtin_amdgcn_s_sleep(1); \
    if ((++_sp & 255u) == 0u) { if (xb_ld(&(bar)[XB_TMO])) break; if (_sp > XB_SPIN_CAP) { atomicAdd(&(bar)[XB_TMO], 1u); break; } } } } while (0)
struct XcdBarrier { unsigned* bar; unsigned x; volatile LAS unsigned* st; };
__device__ __forceinline__ XcdBarrier xcd_barrier_post(unsigned* bar, volatile LAS unsigned* st) {
    XcdBarrier b; b.bar = bar; b.x = xb_xcc_id(); b.st = st;
    if (threadIdx.x == 0) (void)xb_add(&bar[XB_XCNT(b.x)], 1u);
    return b;
}
__device__ __forceinline__ void xcd_barrier_complete(unsigned* bar, unsigned x, unsigned& nloc, unsigned& nx) {
    const unsigned G = gridDim.x * gridDim.y * gridDim.z;
    unsigned sum, cnt, mine, sp = 0u;
    for (;;) {
        sum = 0u; cnt = 0u; mine = 0u;
#pragma unroll
        for (unsigned j = 0; j < 16; ++j) { const unsigned c = xb_ld(&bar[XB_XCNT(j)]); sum += c; cnt += (c > 0u) ? 1u : 0u; mine = (j == x) ? c : mine; }
        if (sum == G) break;
        __builtin_amdgcn_s_sleep(1);
        if ((++sp & 255u) == 0u) { if (xb_ld(&bar[XB_TMO])) break; if (sp > XB_SPIN_CAP) { atomicAdd(&bar[XB_TMO], 1u); break; } }
    }
    nloc = mine > 0u ? mine : 1u; nx = cnt > 0u ? cnt : 1u;
}
__device__ __forceinline__ void xcd_barrier(const XcdBarrier& b) {
    asm volatile("s_waitcnt vmcnt(0)" ::: "memory");
    __syncthreads();
    if (threadIdx.x == 0) {
        unsigned* bar = b.bar;
        __builtin_amdgcn_s_waitcnt(0);
        unsigned nloc = b.st[0], nx = b.st[1];
        if (nloc == 0u) { xcd_barrier_complete(bar, b.x, nloc, nx); b.st[0] = nloc; b.st[1] = nx; }
        const unsigned old = xb_add(&bar[XB_XSUB(b.x)], 1u);
        const unsigned gen = old / nloc;
        if (old + 1u == (gen + 1u) * nloc) {
            __builtin_amdgcn_fence(__ATOMIC_RELEASE, "agent");
            asm volatile("s_waitcnt vmcnt(0)" ::: "memory");
            const unsigned og = xb_add(&bar[XB_TOP], 1u);
            const unsigned tg = og / nx;
            if (og + 1u == (tg + 1u) * nx) xb_add(&bar[XB_TOPGEN], 1u);
            else XB_SPIN(xb_ld(&bar[XB_TOPGEN]) == tg, bar);
            __builtin_amdgcn_fence(__ATOMIC_ACQUIRE, "agent");
            xb_add(&bar[XB_XGEN(b.x)], 1u);
            asm volatile("s_waitcnt vmcnt(0)" ::: "memory");
        } else {
            XB_SPIN(xb_ld(&bar[XB_XGEN(b.x)]) == gen, bar);
            __builtin_amdgcn_fence(__ATOMIC_ACQUIRE, "agent");
            asm volatile("s_waitcnt vmcnt(0)" ::: "memory");
        }
    }
    __syncthreads();
}

struct Args { const float* in[35]; float* out; unsigned char* ws; int ph_lo, ph_hi; };
typedef const __attribute__((address_space(4))) Args* ArgsP;
enum { I_XP = 0, I_XS, I_PP, I_PS, I_SCONV, I_SDELTA, I_SLRU, I_SMC, I_SMN, I_SMM, I_WINE, I_WCONV, I_BCONV, I_ALOG, I_DTB, I_DNORM, I_LWR, I_LBR, I_LWI, I_LBI, I_LLAM, I_WOUTE,
       I_WINO, I_BIG, I_BFG, I_MNORM, I_WOUTO, I_LN1G, I_LN1B, I_LN2G, I_LN2B, I_WUP, I_WDOWN, I_WPLE, I_WGATE };

struct TDesc { const float* W; bf16* WT; int K, N, Npad, item; };
__device__ __forceinline__ void t_load(const TDesc& d, int lane, f32x4 (&v)[8]) {
    const int nblk = d.Npad / 32, kb = d.item / nblk, nb = d.item % nblk, k0 = 64 * kb, n0 = 32 * nb;
    const int r8 = lane >> 3, c4 = lane & 7; const bool ok = (n0 + 4 * c4) < d.N;
#pragma unroll
    for (int i = 0; i < 8; ++i) v[i] = ok ? __builtin_nontemporal_load((const f32x4*)(d.W + (size_t)(k0 + 8 * r8 + i) * d.N + n0 + 4 * c4)) : (f32x4){0.f, 0.f, 0.f, 0.f};
}
__device__ __forceinline__ void t_finish(const TDesc& d, LAS float*  , int lane, const f32x4 (&v)[8]) {
    const int nblk = d.Npad / 32, kb = d.item / nblk, nb = d.item % nblk, k0 = 64 * kb, n0 = 32 * nb;
    const int r8 = lane >> 3, c4 = lane & 7;
    bf16* o = d.WT + (size_t)(n0 + 4 * c4) * d.K + k0 + 8 * r8;
    *(v4u*)(o) = (v4u){pk2(v[0].x, v[1].x), pk2(v[2].x, v[3].x), pk2(v[4].x, v[5].x), pk2(v[6].x, v[7].x)};
    *(v4u*)(o + (size_t)d.K) = (v4u){pk2(v[0].y, v[1].y), pk2(v[2].y, v[3].y), pk2(v[4].y, v[5].y), pk2(v[6].y, v[7].y)};
    *(v4u*)(o + 2 * (size_t)d.K) = (v4u){pk2(v[0].z, v[1].z), pk2(v[2].z, v[3].z), pk2(v[4].z, v[5].z), pk2(v[6].z, v[7].z)};
    *(v4u*)(o + 3 * (size_t)d.K) = (v4u){pk2(v[0].w, v[1].w), pk2(v[2].w, v[3].w), pk2(v[4].w, v[5].w), pk2(v[6].w, v[7].w)};
}
__device__ __forceinline__ void p0_transpose_item(const float* W, int K, int N, int Npad, bf16* WT, LAS float* scr, int item, int lane) {
    const TDesc d{W, WT, K, N, Npad, item}; f32x4 v[8]; t_load(d, lane, v); t_finish(d, scr, lane, v);
}
template <int N> __device__ __forceinline__ void row_to_bf16(const float* src, bf16* dst, int lane) {
    f32x4 v[N / 256];
#pragma unroll
    for (int j = 0; j < N / 256; ++j) v[j] = __builtin_nontemporal_load((const f32x4*)(src + j * 256 + lane * 4));
#pragma unroll
    for (int j = 0; j < N / 256; ++j) { v2u o; o.x = pk2(v[j].x, v[j].y); o.y = pk2(v[j].z, v[j].w); *(v2u*)(dst + j * 256 + lane * 4) = o; }
}
namespace cv { constexpr int I_IN = (D / 64) * (NPROJ_PAD / 32), I_SQ = (D / 64) * (D / 32), I_UP = (D / 64) * (FF / 32), I_DN = (FF / 64) * (D / 32), I_PL = (PLE / 64) * (D / 32);
               constexpr int N_FIRST = I_IN + I_PL + 128, N_REST = I_IN + 2 * I_SQ + 2 * I_UP + 2 * I_DN + I_PL + 2 * I_SQ;
               constexpr int R_IN0 = 6200;
               constexpr int R_G1 = I_SQ + I_UP + I_SQ + I_IN + I_SQ + I_PL + I_SQ;
               constexpr int R_IN1 = R_G1 + I_UP;
               constexpr int R_SCAN = R_IN1 - 6200;
               constexpr int R_UP0 = R_IN1 + I_DN;
               static_assert(R_UP0 + I_DN == N_REST && R_SCAN > R_G1 && R_SCAN > R_IN0, "conversion ranges"); }
__device__ __forceinline__ void convert_first_item(ArgsP a, LAS float* scr, int r, int lane) {
    unsigned char* ws = a->ws;
    if (r < cv::I_IN) { p0_transpose_item(a->in[I_WINE], D, NPROJ, NPROJ_PAD, (bf16*)(ws + WS_WINE), scr, r, lane); return; } r -= cv::I_IN;
    if (r < cv::I_PL) { p0_transpose_item(a->in[I_WPLE], PLE, D, D, (bf16*)(ws + WS_WPLE), scr, r, lane); return; } r -= cv::I_PL;
    { const int mat = r / 64, blk = (r / 8) & 7; p0_transpose_item(a->in[mat == 0 ? I_LWR : I_LWI] + (size_t)blk * 16384, 128, 128, 128, (bf16*)(ws + WS_LRUW) + (size_t)(mat * 8 + blk) * 16384, scr, r % 8, lane); }
}
__device__ __forceinline__ TDesc decode_rest(ArgsP a, int r) {
    using namespace cv; unsigned char* ws = a->ws;
    if (r < I_SQ) return TDesc{a->in[I_WOUTE], (bf16*)(ws + WS_WOUTE), D, D, D, r}; r -= I_SQ;
    if (r < I_UP) return TDesc{a->in[I_WUP], (bf16*)(ws + WS_WUP), D, FF, FF, r}; r -= I_UP;
    if (r < I_SQ) return TDesc{a->in[I_WGATE], (bf16*)(ws + WS_WGATE), D, D, D, r}; r -= I_SQ;
    if (r < I_IN) return TDesc{a->in[I_WINO], (bf16*)(ws + WS_WINO), D, NPROJ, NPROJ_PAD, r}; r -= I_IN;
    if (r < I_SQ) return TDesc{a->in[I_WOUTO], (bf16*)(ws + WS_WOUTO), D, D, D, r}; r -= I_SQ;
    if (r < I_PL) return TDesc{a->in[I_WPLE] + (size_t)PLE * D, (bf16*)(ws + WS_WPLE) + (size_t)PLE * D, PLE, D, D, r}; r -= I_PL;
    if (r < I_SQ) return TDesc{a->in[I_WGATE] + (size_t)D * D, (bf16*)(ws + WS_WGATE) + (size_t)D * D, D, D, D, r}; r -= I_SQ;
    if (r < I_UP) return TDesc{a->in[I_WUP] + (size_t)D * FF, (bf16*)(ws + WS_WUP) + (size_t)D * FF, D, FF, FF, r}; r -= I_UP;
    if (r < I_DN) return TDesc{a->in[I_WDOWN], (bf16*)(ws + WS_WDOWN), FF, D, D, r}; r -= I_DN;
    return TDesc{a->in[I_WDOWN] + (size_t)D * FF, (bf16*)(ws + WS_WDOWN) + (size_t)D * FF, FF, D, D, r};
}
__device__ __forceinline__ void convert_range(ArgsP a, LAS float* scr, int first, int last, int widx, int nw, int lane) {
    int it = first + widx;
    TDesc dA, dB; f32x4 vA[8], vB[8];
    if (it < last) { dA = decode_rest(a, it); t_load(dA, lane, vA);
#pragma unroll 1
        for (;;) {
            const int itB = it + nw; const bool hasB = itB < last;
            if (hasB) { dB = decode_rest(a, itB); t_load(dB, lane, vB); }
            t_finish(dA, scr, lane, vA);
            if (!hasB) break;
            it = itB + nw; const bool hasA = it < last;
            if (hasA) { dA = decode_rest(a, it); t_load(dA, lane, vA); }
            t_finish(dB, scr, lane, vB);
            if (!hasA) break;
        } }
}
__device__ __forceinline__ void phase_convert(ArgsP a, LAS unsigned char* lds, int gw, int NGW, int wave, int lane) {
    unsigned char* ws = a->ws;
    LAS float* scr = (LAS float*)(lds + wave * 16384);
    for (int it = gw; it < cv::N_FIRST; it += NGW) convert_first_item(a, scr, it, lane);
    bf16* xb = (bf16*)(ws + WS_XB);
    for (int m0 = gw; m0 < M; m0 += 2 * NGW) {
        const int m1 = m0 + NGW; const bool two = m1 < M;
        const float* s0 = m0 < MP ? a->in[I_XP] + (size_t)m0 * D : a->in[I_XS] + (size_t)(m0 - MP) * D;
        const float* s1 = two ? (m1 < MP ? a->in[I_XP] + (size_t)m1 * D : a->in[I_XS] + (size_t)(m1 - MP) * D) : s0;
        f32x4 v0[8], v1[8];
#pragma unroll
        for (int j = 0; j < 8; ++j) { v0[j] = __builtin_nontemporal_load((const f32x4*)(s0 + j * 256 + lane * 4)); v1[j] = __builtin_nontemporal_load((const f32x4*)(s1 + j * 256 + lane * 4)); }
#pragma unroll
        for (int j = 0; j < 8; ++j) { v2u o; o.x = pk2(v0[j].x, v0[j].y); o.y = pk2(v0[j].z, v0[j].w); *(v2u*)(xb + (size_t)m0 * D + j * 256 + lane * 4) = o; }
        if (two) {
#pragma unroll
            for (int j = 0; j < 8; ++j) { v2u o; o.x = pk2(v1[j].x, v1[j].y); o.y = pk2(v1[j].z, v1[j].w); *(v2u*)(xb + (size_t)m1 * D + j * 256 + lane * 4) = o; } }
    }
    bf16* pb = (bf16*)(ws + WS_PB);
    for (int r0 = gw; r0 < 2 * M; r0 += 4 * NGW) {
        f32x4 v[4];
#pragma unroll
        for (int k = 0; k < 4; ++k) { const int r = r0 + k * NGW; const int rr = r < 2 * M ? r : r0; const int l = rr / M, m = rr % M;
            const float* src = m < MP ? a->in[I_PP] + ((size_t)l * MP + m) * PLE : a->in[I_PS] + ((size_t)l * MS + (m - MP)) * PLE;
            v[k] = __builtin_nontemporal_load((const f32x4*)(src + lane * 4)); }
#pragma unroll
        for (int k = 0; k < 4; ++k) { const int r = r0 + k * NGW; if (r < 2 * M) { v2u o; o.x = pk2(v[k].x, v[k].y); o.y = pk2(v[k].z, v[k].w); *(v2u*)(pb + (size_t)r * PLE + lane * 4) = o; } }
    }
}

__device__ __forceinline__ float conv_in(const bf16* proj, int row0, int tq, int ch, const float* cstate) {
    if (tq >= 0) return bf2f(proj[(size_t)(row0 + tq) * NPROJ_PAD + ch]);
    return cstate ? cstate[(3 + tq) * 4096 + ch] : 0.f;
}
__device__ __forceinline__ float conv4(const bf16* proj, int row0, int t, int ch, const float* cstate, const float* wconv, const float* bconv) {
    float acc = bconv[ch];
#pragma unroll
    for (int j = 0; j < 4; ++j) acc += wconv[j * 4096 + ch] * conv_in(proj, row0, t - 3 + j, ch, cstate);
    return acc;
}

__device__ __forceinline__ void delta_rec_item(ArgsP a, LAS unsigned char* lds, int row0, int T, int h, const float* cstate, const float* S0, float* Sout, const int tid) {
    const int lane = tid & 63, wave = tid >> 6, c = tid & 127, r = tid >> 7;
    const bf16* proj = (const bf16*)(a->ws + WS_PROJ); const float* gates = (const float*)(a->ws + WS_GATES); bf16* mix = (bf16*)(a->ws + WS_MIX);
    const float* wconv = a->in[I_WCONV]; const float* bconv = a->in[I_BCONV];
    LAS float* act = (LAS float*)lds;
    LAS float* nrm = act + 4 * 384;
    LAS float* gb = nrm + 8;
    LAS float* red = gb + 8;
    LAS float* red2 = red + 512;
    LAS float* obuf = red2 + 512;
    float s[32];
#pragma unroll
    for (int i = 0; i < 32; ++i) s[i] = S0 ? S0[(size_t)(32 * r + i) * 128 + c] : 0.f;
    const float aexp = fexp(a->in[I_ALOG][h]), dtb = a->in[I_DTB][h];
#pragma unroll 1
    for (int t0 = 0; t0 < T; t0 += 4) {
#pragma unroll
        for (int j = 0; j < 3; ++j) { const int idx = tid + 512 * j, tok = idx / 384, chl = idx % 384, part = chl >> 7, i = chl & 127;
            const int ch = part * 1024 + h * 128 + i;
            act[tok * 384 + chl] = siluf(conv4(proj, row0, t0 + tok, ch, cstate, wconv, bconv)); }
        LDS_BARRIER();
        { const int tok = wave >> 1, part = wave & 1; const float x0 = act[tok * 384 + part * 128 + lane], x1 = act[tok * 384 + part * 128 + 64 + lane];
          const float ss = wave_sum(x0 * x0 + x1 * x1); if (lane == 0) nrm[tok * 2 + part] = rsqrtf(ss + 1e-6f) * (part == 0 ? 0.08838834764831845f : 1.f); }
        if (tid < 4) { const int row = row0 + t0 + tid; const float g = -aexp * softplusf(gates[(size_t)row * 16 + h] + dtb); gb[tid * 2] = fexp(g); gb[tid * 2 + 1] = sigm(gates[(size_t)row * 16 + 8 + h]); }
        LDS_BARRIER();
#pragma unroll 1
        for (int tok = 0; tok < 4; ++tok) {
            const float eg = gb[tok * 2], beta = gb[tok * 2 + 1], nq = nrm[tok * 2], nk = nrm[tok * 2 + 1];
            const LAS float* qv = act + tok * 384 + 32 * r; const LAS float* kv = qv + 128;
            float ks = 0.f;
#pragma unroll
            for (int i = 0; i < 32; ++i) ks += kv[i] * s[i];
            red[r * 128 + c] = ks * nk;
            LDS_BARRIER();
            const float kS = red[c] + red[128 + c] + red[256 + c] + red[384 + c];
            const float vnew = beta * (act[tok * 384 + 256 + c] - eg * kS);
            float os = 0.f;
#pragma unroll
            for (int i = 0; i < 32; ++i) { s[i] = eg * s[i] + (kv[i] * nk) * vnew; os += qv[i] * s[i]; }
            red2[r * 128 + c] = os * nq;
            LDS_BARRIER();
            if (r == 0) obuf[tok * 128 + c] = red2[c] + red2[128 + c] + red2[256 + c] + red2[384 + c];
        }
        LDS_BARRIER();
        if (wave < 4) { const int tok = wave, row = row0 + t0 + tok; const float o0 = obuf[tok * 128 + lane], o1 = obuf[tok * 128 + 64 + lane];
            const float rstd = rsqrtf(wave_sum(o0 * o0 + o1 * o1) * (1.f / 128.f) + RMS_EPS);
            const float* nw = a->in[I_DNORM];
            const float z0 = bf2f(proj[(size_t)row * NPROJ_PAD + 4096 + h * 128 + lane]), z1 = bf2f(proj[(size_t)row * NPROJ_PAD + 4096 + h * 128 + 64 + lane]);
            mix[(size_t)row * D + h * 128 + lane] = (bf16)f2bf(o0 * rstd * nw[lane] * siluf(z0));
            mix[(size_t)row * D + h * 128 + 64 + lane] = (bf16)f2bf(o1 * rstd * nw[64 + lane] * siluf(z1)); }
        LDS_BARRIER();
    }
#pragma unroll
    for (int i = 0; i < 32; ++i) Sout[(size_t)(32 * r + i) * 128 + c] = s[i];
}


typedef short bf16x8 __attribute__((ext_vector_type(8)));
#define MFMA32(a_, b_, c_) __builtin_amdgcn_mfma_f32_16x16x32_bf16(a_, b_, c_, 0, 0, 0)

__device__ __forceinline__ void lru_prep_item(ArgsP a, LAS unsigned char* lds, int item, const int tid) {
    const int c = item & 31, n = (item >> 5) & 7, b = item >> 8;
    const int lane = tid & 63, w = __builtin_amdgcn_readfirstlane(tid >> 6), fr = lane & 15, fq = lane >> 4;
    unsigned char* ws = a->ws;
    const bf16* proj = (const bf16*)(ws + WS_PROJ);
    LAS bf16* xa = (LAS bf16*)lds;
    LAS float* xf = (LAS float*)(lds + 17408);
    LAS float* obH = (LAS float*)(lds + 51200);
    LAS float* obP = obH + 64 * 132;
    {
        const int t = tid >> 3, sub = tid & 7, ch0 = 3072 + n * 128 + sub * 16;
        const float* wconv = a->in[I_WCONV]; const float* bconv = a->in[I_BCONV];
        float x[16];
#pragma unroll
        for (int i = 0; i < 4; ++i) { const f32x4 bb = *(const f32x4*)(bconv + ch0 + 4 * i); x[4 * i] = bb.x; x[4 * i + 1] = bb.y; x[4 * i + 2] = bb.z; x[4 * i + 3] = bb.w; }
#pragma unroll
        for (int j = 0; j < 4; ++j) { const int tt = 64 * c + t - 3 + j;
            if (tt >= 0) { const bf16* pr = proj + (size_t)(b * TP + tt) * NPROJ_PAD + ch0; const v4u u0 = *(const v4u*)pr, u1 = *(const v4u*)(pr + 8);
                const unsigned uu[8] = {u0.x, u0.y, u0.z, u0.w, u1.x, u1.y, u1.z, u1.w};
#pragma unroll
                for (int i = 0; i < 4; ++i) { const f32x4 ww = *(const f32x4*)(wconv + j * 4096 + ch0 + 4 * i);
                    x[4 * i] += ww.x * bflo(uu[2 * i]); x[4 * i + 1] += ww.y * bfhi(uu[2 * i]); x[4 * i + 2] += ww.z * bflo(uu[2 * i + 1]); x[4 * i + 3] += ww.w * bfhi(uu[2 * i + 1]); } } }
        v4u o0, o1; o0.x = pk2(x[0], x[1]); o0.y = pk2(x[2], x[3]); o0.z = pk2(x[4], x[5]); o0.w = pk2(x[6], x[7]); o1.x = pk2(x[8], x[9]); o1.y = pk2(x[10], x[11]); o1.z = pk2(x[12], x[13]); o1.w = pk2(x[14], x[15]);
        *(LAS v4u*)(xa + t * 136 + sub * 16) = o0; *(LAS v4u*)(xa + t * 136 + sub * 16 + 8) = o1;
#pragma unroll
        for (int i = 0; i < 4; ++i) *(LAS f32x4*)(xf + t * 132 + sub * 16 + 4 * i) = (f32x4){x[4 * i], x[4 * i + 1], x[4 * i + 2], x[4 * i + 3]};
    }
    LDS_BARRIER();
    const bf16* wrT = (const bf16*)(ws + WS_LRUW) + (size_t)n * 16384; const bf16* wiT = wrT + 8 * 16384;
    bf16x8 br[4], bi[4];
#pragma unroll
    for (int ks = 0; ks < 4; ++ks) { br[ks] = *(const bf16x8*)(wrT + (16 * w + fr) * 128 + 32 * ks + 8 * fq); bi[ks] = *(const bf16x8*)(wiT + (16 * w + fr) * 128 + 32 * ks + 8 * fq); }
    f32x4 accr[4], acci[4];
#pragma unroll
    for (int tb = 0; tb < 4; ++tb) { accr[tb] = (f32x4){0.f, 0.f, 0.f, 0.f}; acci[tb] = (f32x4){0.f, 0.f, 0.f, 0.f};
#pragma unroll
        for (int ks = 0; ks < 4; ++ks) { const bf16x8 af = *(const LAS bf16x8*)(xa + (16 * tb + fr) * 136 + 32 * ks + 8 * fq); accr[tb] = MFMA32(af, br[ks], accr[tb]); acci[tb] = MFMA32(af, bi[ks], acci[tb]); } }
    const int dl = 16 * w + fr, chn = n * 128 + dl;
    const float brs = a->in[I_LBR][chn], bis = a->in[I_LBI][chn], spl = softplusf(-a->in[I_LLAM][chn]);
    float Apre = 1.f, Hpre = 0.f;
#pragma unroll
    for (int tb = 0; tb < 4; ++tb) {
        float P[4], Hh[4];
#pragma unroll
        for (int j = 0; j < 4; ++j) { const int t = 16 * tb + 4 * fq + j;
            const float log_a = -8.f * sigm(accr[tb][j] + brs) * spl; const float av = fexp(log_a);
            const float bx = sqrtf(neg_expm1(2.f * log_a)) * sigm(acci[tb][j] + bis) * xf[t * 132 + dl];
            if (j == 0) { P[0] = av; Hh[0] = bx; } else { P[j] = P[j - 1] * av; Hh[j] = av * Hh[j - 1] + bx; } }
        float Ai = P[3], Hi = Hh[3];
        { const float A2 = __shfl_up(Ai, 16), H2 = __shfl_up(Hi, 16); if (fq >= 1) { Hi = Ai * H2 + Hi; Ai = A2 * Ai; } }
        { const float A2 = __shfl_up(Ai, 32), H2 = __shfl_up(Hi, 32); if (fq >= 2) { Hi = Ai * H2 + Hi; Ai = A2 * Ai; } }
        float Aex = __shfl_up(Ai, 16), Hex = __shfl_up(Hi, 16); if (fq == 0) { Aex = 1.f; Hex = 0.f; }
        const float Atb = __shfl(Ai, 48 + fr), Htb = __shfl(Hi, 48 + fr);
        const float EA = Apre * Aex, EH = Aex * Hpre + Hex;
#pragma unroll
        for (int j = 0; j < 4; ++j) { const int t = 16 * tb + 4 * fq + j; obP[t * 132 + dl] = EA * P[j]; obH[t * 132 + dl] = P[j] * EH + Hh[j]; }
        Hpre = Atb * Hpre + Htb; Apre = Apre * Atb;
    }
    if (fq == 0) { float* e = (float*)(ws + WS_LRU_END) + (size_t)item * 256; e[dl] = Apre; e[128 + dl] = Hpre; }
    LDS_BARRIER();
    {
        const int t = tid >> 3, sub = tid & 7;
        bf16* hl = (bf16*)(ws + WS_LRU_HL) + ((size_t)item * 64 + t) * 128 + sub * 16; bf16* pp = (bf16*)(ws + WS_LRU_P) + ((size_t)item * 64 + t) * 128 + sub * 16;
        const LAS float* sh = obH + t * 132 + sub * 16; const LAS float* sp = obP + t * 132 + sub * 16;
        v4u o0, o1;
        o0.x = pk2(sh[0], sh[1]); o0.y = pk2(sh[2], sh[3]); o0.z = pk2(sh[4], sh[5]); o0.w = pk2(sh[6], sh[7]); o1.x = pk2(sh[8], sh[9]); o1.y = pk2(sh[10], sh[11]); o1.z = pk2(sh[12], sh[13]); o1.w = pk2(sh[14], sh[15]);
        *(v4u*)hl = o0; *(v4u*)(hl + 8) = o1;
        o0.x = pk2(sp[0], sp[1]); o0.y = pk2(sp[2], sp[3]); o0.z = pk2(sp[4], sp[5]); o0.w = pk2(sp[6], sp[7]); o1.x = pk2(sp[8], sp[9]); o1.y = pk2(sp[10], sp[11]); o1.z = pk2(sp[12], sp[13]); o1.w = pk2(sp[14], sp[15]);
        *(v4u*)pp = o0; *(v4u*)(pp + 8) = o1;
    }
    LDS_BARRIER();
}
__device__ __forceinline__ void lru_out_item(ArgsP a, LAS unsigned char* lds, int item, const int tid) {
    const int c = item & 31, n = (item >> 5) & 7, b = item >> 8;
    unsigned char* ws = a->ws;
    LAS float* carry = (LAS float*)lds;
    if (tid < 128) { float cr = 0.f; const float* e = (const float*)(ws + WS_LRU_END) + (size_t)(item - c) * 256;
        float pv[31], hv_[31];
#pragma unroll
        for (int k = 0; k < 31; ++k) { const bool on = k < c; pv[k] = on ? e[k * 256 + tid] : 1.f; hv_[k] = on ? e[k * 256 + 128 + tid] : 0.f; }
#pragma unroll
        for (int k = 0; k < 31; ++k) cr = hv_[k] + pv[k] * cr;
        carry[tid] = cr; }
    LDS_BARRIER();
    const int t = tid >> 3, sub = tid & 7, d0 = sub * 16, row = b * TP + 64 * c + t;
    const bf16* hl = (const bf16*)(ws + WS_LRU_HL) + ((size_t)item * 64 + t) * 128 + d0; const bf16* pp = (const bf16*)(ws + WS_LRU_P) + ((size_t)item * 64 + t) * 128 + d0;
    const bf16* gp = (const bf16*)(ws + WS_PROJ) + (size_t)row * NPROJ_PAD + 5120 + n * 128 + d0;
    const v4u h0 = *(const v4u*)hl, h1 = *(const v4u*)(hl + 8), p0 = *(const v4u*)pp, p1 = *(const v4u*)(pp + 8), g0 = *(const v4u*)gp, g1 = *(const v4u*)(gp + 8);
    const unsigned hu[8] = {h0.x, h0.y, h0.z, h0.w, h1.x, h1.y, h1.z, h1.w}, pu[8] = {p0.x, p0.y, p0.z, p0.w, p1.x, p1.y, p1.z, p1.w}, gu[8] = {g0.x, g0.y, g0.z, g0.w, g1.x, g1.y, g1.z, g1.w};
    float hv[16]; unsigned ou[8];
#pragma unroll
    for (int i = 0; i < 8; ++i) { hv[2 * i] = bflo(hu[i]) + bflo(pu[i]) * carry[d0 + 2 * i]; hv[2 * i + 1] = bfhi(hu[i]) + bfhi(pu[i]) * carry[d0 + 2 * i + 1];
        ou[i] = pk2(hv[2 * i] * gelu_tanh(bflo(gu[i])), hv[2 * i + 1] * gelu_tanh(bfhi(gu[i]))); }
    bf16* mp = (bf16*)(ws + WS_MIX) + (size_t)row * D + 1024 + n * 128 + d0;
    *(v4u*)mp = (v4u){ou[0], ou[1], ou[2], ou[3]}; *(v4u*)(mp + 8) = (v4u){ou[4], ou[5], ou[6], ou[7]};
    if (c == 31 && t == 63) { float* o = a->out + O_LRUP + (size_t)b * 1024 + n * 128 + d0;
#pragma unroll
        for (int i = 0; i < 4; ++i) *(f32x4*)(o + 4 * i) = (f32x4){hv[4 * i], hv[4 * i + 1], hv[4 * i + 2], hv[4 * i + 3]}; }
    LDS_BARRIER();
}


__device__ __forceinline__ void conv16_load(const bf16* proj, int b, int tseq, int ch0, v4u (&u)[8]) {
#pragma unroll
    for (int j = 0; j < 4; ++j) { const int tt = tseq - 3 + j;
        if (tt >= 0) { const bf16* pr = proj + (size_t)(b * TP + tt) * NPROJ_PAD + ch0; u[2 * j] = *(const v4u*)pr; u[2 * j + 1] = *(const v4u*)(pr + 8); }
        else { u[2 * j] = (v4u){0u, 0u, 0u, 0u}; u[2 * j + 1] = (v4u){0u, 0u, 0u, 0u}; } }
}
__device__ __forceinline__ void conv16_compute(const v4u (&u)[8], const float* wconv, const float* bconv, int ch0, float (&x)[16]) {
#pragma unroll
    for (int i = 0; i < 4; ++i) { const f32x4 bb = *(const f32x4*)(bconv + ch0 + 4 * i); x[4 * i] = bb.x; x[4 * i + 1] = bb.y; x[4 * i + 2] = bb.z; x[4 * i + 3] = bb.w; }
#pragma unroll
    for (int j = 0; j < 4; ++j) { const unsigned uu[8] = {u[2 * j].x, u[2 * j].y, u[2 * j].z, u[2 * j].w, u[2 * j + 1].x, u[2 * j + 1].y, u[2 * j + 1].z, u[2 * j + 1].w};
#pragma unroll
        for (int i = 0; i < 4; ++i) { const f32x4 ww = *(const f32x4*)(wconv + j * 4096 + ch0 + 4 * i);
            x[4 * i] += ww.x * bflo(uu[2 * i]); x[4 * i + 1] += ww.y * bfhi(uu[2 * i]); x[4 * i + 2] += ww.z * bflo(uu[2 * i + 1]); x[4 * i + 3] += ww.w * bfhi(uu[2 * i + 1]); } }
}
__device__ __forceinline__ void conv16_prompt(const bf16* proj, const float* wconv, const float* bconv, int b, int tseq, int ch0, float (&x)[16]) {
    v4u u[8]; conv16_load(proj, b, tseq, ch0, u); conv16_compute(u, wconv, bconv, ch0, x);
}
__device__ __forceinline__ void st16_bf16(LAS bf16* p, const float (&x)[16]) {
    v4u o0, o1; o0.x = pk2(x[0], x[1]); o0.y = pk2(x[2], x[3]); o0.z = pk2(x[4], x[5]); o0.w = pk2(x[6], x[7]); o1.x = pk2(x[8], x[9]); o1.y = pk2(x[10], x[11]); o1.z = pk2(x[12], x[13]); o1.w = pk2(x[14], x[15]);
    *(LAS v4u*)p = o0; *(LAS v4u*)(p + 8) = o1;
}
__device__ __forceinline__ v2u pack4(const f32x4 v) { v2u o; o.x = pk2(v.x, v.y); o.y = pk2(v.z, v.w); return o; }
__device__ __forceinline__ bf16x8 zero8() { return (bf16x8){0, 0, 0, 0, 0, 0, 0, 0}; }

__device__ __forceinline__ void delta_prep_item(ArgsP a, LAS unsigned char* lds, int item, const int tid) {
    const int c = item & 31, h = (item >> 5) & 7, b = item >> 8;
    const int lane = tid & 63, w = __builtin_amdgcn_readfirstlane(tid >> 6), fr = lane & 15, fq = lane >> 4;
    unsigned char* ws = a->ws;
    const bf16* proj = (const bf16*)(ws + WS_PROJ);
    LAS bf16* Kn = (LAS bf16*)lds;
    LAS bf16* Qn = (LAS bf16*)(lds + 17408);
    LAS bf16* KdT = (LAS bf16*)(lds + 34816);
    LAS bf16* RX = (LAS bf16*)(lds + 53248);
    LAS bf16* Mm = (LAS bf16*)(lds + 90112);
    LAS bf16* QKd = (LAS bf16*)(lds + 99328);
    LAS bf16* Td = (LAS bf16*)(lds + 108544);
    LAS bf16* RT = (LAS bf16*)(lds + 111616) + w * 768;
    LAS float* gl = (LAS float*)(lds + 123904);
    LAS float* gcs = gl + 64;
    LAS float* bet = gcs + 64;
    float gcv, bvv;
    {
        const float* gt = (const float*)(ws + WS_GATES) + (size_t)(b * TP + 64 * c + lane) * 16;
        const float gv = -fexp(a->in[I_ALOG][h]) * softplusf(gt[h] + a->in[I_DTB][h]); bvv = sigm(gt[8 + h]);
        gcv = wave_incl_sum(gv, lane);
        if (w == 0) { gl[lane] = gv; gcs[lane] = gcv; bet[lane] = bvv; }
    }
    {
        const int part = w >> 1;
        if (part < 3) {
            const float* wconv = a->in[I_WCONV]; const float* bconv = a->in[I_BCONV];
            const int sub = tid & 7, tg = (tid >> 3) & 15, ch0 = (part == 0 ? 0 : part == 1 ? 1024 : 2048) + h * 128 + sub * 16;
            f32x4 wv[4][4], bv4[4];
#pragma unroll
            for (int i = 0; i < 4; ++i) { bv4[i] = *(const f32x4*)(bconv + ch0 + 4 * i);
#pragma unroll
                for (int j = 0; j < 4; ++j) wv[j][i] = *(const f32x4*)(wconv + j * 4096 + ch0 + 4 * i); }
            v4u u[7][2];
#pragma unroll
            for (int r = 0; r < 7; ++r) { const int tt = 64 * c + 4 * tg - 3 + r;
                if (tt >= 0) { const bf16* pr = proj + (size_t)(b * TP + tt) * NPROJ_PAD + ch0; u[r][0] = *(const v4u*)pr; u[r][1] = *(const v4u*)(pr + 8); }
                else { u[r][0] = (v4u){0u, 0u, 0u, 0u}; u[r][1] = (v4u){0u, 0u, 0u, 0u}; } }
            const float glast = __shfl(gcv, 63);
#pragma unroll
            for (int e = 0; e < 4; ++e) { const int t = 4 * tg + e;
                float x[16];
#pragma unroll
                for (int i = 0; i < 4; ++i) { x[4 * i] = bv4[i].x; x[4 * i + 1] = bv4[i].y; x[4 * i + 2] = bv4[i].z; x[4 * i + 3] = bv4[i].w; }
#pragma unroll
                for (int j = 0; j < 4; ++j) { const unsigned uu[8] = {u[e + j][0].x, u[e + j][0].y, u[e + j][0].z, u[e + j][0].w, u[e + j][1].x, u[e + j][1].y, u[e + j][1].z, u[e + j][1].w};
#pragma unroll
                    for (int i = 0; i < 4; ++i) { x[4 * i] += wv[j][i].x * bflo(uu[2 * i]); x[4 * i + 1] += wv[j][i].y * bfhi(uu[2 * i]); x[4 * i + 2] += wv[j][i].z * bflo(uu[2 * i + 1]); x[4 * i + 3] += wv[j][i].w * bfhi(uu[2 * i + 1]); } }
                float ss = 0.f;
#pragma unroll
                for (int i = 0; i < 16; ++i) { x[i] = siluf(x[i]); ss += x[i] * x[i]; }
                const float gc = __shfl(gcv, t), beta = __shfl(bvv, t);
                if (part == 2) {
#pragma unroll
                    for (int i = 0; i < 16; ++i) x[i] *= beta;
                    st16_bf16(RX + t * 264 + sub * 16, x);
                } else {
                    ss += __shfl_xor(ss, 1); ss += __shfl_xor(ss, 2); ss += __shfl_xor(ss, 4);
                    const float rn = rsqrtf(ss + 1e-6f) * (part == 0 ? 0.08838834764831845f : 1.f);
#pragma unroll
                    for (int i = 0; i < 16; ++i) x[i] *= rn;
                    if (part == 0) st16_bf16(Qn + t * 136 + sub * 16, x);
                    else { st16_bf16(Kn + t * 136 + sub * 16, x);
                        const float ec = fexp(gc), ed = fexp(glast - gc); float y[16];
#pragma unroll
                        for (int i = 0; i < 16; ++i) { KdT[(sub * 16 + i) * 72 + t] = (bf16)f2bf(x[i] * ed); y[i] = x[i] * (beta * ec); }
                        st16_bf16(RX + t * 264 + 128 + sub * 16, y); }
                }
            }
        }
    }
    LDS_BARRIER();
    {
        const int ib = w >> 1;
#pragma unroll
        for (int jj = 0; jj < 2; ++jj) { const int jb = 2 * (w & 1) + jj;
            f32x4 ak = (f32x4){0.f, 0.f, 0.f, 0.f}, aq = (f32x4){0.f, 0.f, 0.f, 0.f};
            if (jb <= ib) {
#pragma unroll
                for (int ks = 0; ks < 4; ++ks) { const bf16x8 bfr = *(const LAS bf16x8*)(Kn + (16 * jb + fr) * 136 + 32 * ks + 8 * fq);
                    const bf16x8 afk = *(const LAS bf16x8*)(Kn + (16 * ib + fr) * 136 + 32 * ks + 8 * fq), afq = *(const LAS bf16x8*)(Qn + (16 * ib + fr) * 136 + 32 * ks + 8 * fq);
                    ak = MFMA32(afk, bfr, ak); aq = MFMA32(afq, bfr, aq); } }
            const int col = 16 * jb + fr; const float gcc = gcs[col];
#pragma unroll
            for (int j = 0; j < 4; ++j) { const int row = 16 * ib + 4 * fq + j; const float dec = (row >= col) ? fexp(gcs[row] - gcc) : 0.f;
                Mm[row * 72 + col] = (bf16)f2bf(row > col ? -bet[row] * ak[j] * dec : 0.f);
                QKd[row * 72 + col] = (bf16)f2bf(aq[j] * dec); }
        }
    }
    LDS_BARRIER();
    if (w == 0) { const int blk = lane >> 4, col = lane & 15; float xi[16];
#pragma unroll
        for (int i = 0; i < 16; ++i) { float acc = (i == col) ? 1.f : 0.f; const LAS bf16* mr = Mm + (16 * blk + i) * 72 + 16 * blk;
#pragma unroll
            for (int j = 0; j < i; ++j) acc += bf2f(mr[j]) * xi[j];
            xi[i] = acc; }
#pragma unroll
        for (int i = 0; i < 16; ++i) Td[(blk * 16 + i) * 24 + col] = (bf16)f2bf(xi[i]); }
    f32x4 rhs[2][4];
#pragma unroll
    for (int cbl = 0; cbl < 2; ++cbl)
#pragma unroll
        for (int bb = 0; bb < 4; ++bb)
#pragma unroll
            for (int j = 0; j < 4; ++j) rhs[cbl][bb][j] = bf2f(RX[(16 * bb + 4 * fq + j) * 264 + 32 * w + 16 * cbl + fr]);
    LDS_BARRIER();
#pragma unroll
    for (int cbl = 0; cbl < 2; ++cbl) { const int cb = 2 * w + cbl;
#pragma unroll
        for (int bb = 0; bb < 4; ++bb) {
            f32x4 acc = rhs[cbl][bb];
#pragma unroll
            for (int ks = 0; ks < 2; ++ks) { if (32 * ks < 16 * bb) { const bool ok = (32 * ks + 8 * fq) < 16 * bb;
                const bf16x8 af = ok ? *(const LAS bf16x8*)(Mm + (16 * bb + fr) * 72 + 32 * ks + 8 * fq) : zero8();
                const bf16x8 bf_ = ok ? *(const LAS bf16x8*)(RX + (16 * cb + fr) * 72 + 32 * ks + 8 * fq) : zero8();
                acc = MFMA32(af, bf_, acc); } }
            *(LAS v2u*)(RT + (16 * cbl + fr) * 24 + 4 * fq) = pack4(acc);
            asm volatile("s_waitcnt lgkmcnt(0)" ::: "memory");
            const bool ok2 = fq < 2;
            const bf16x8 af2 = ok2 ? *(const LAS bf16x8*)(Td + (bb * 16 + fr) * 24 + 8 * fq) : zero8();
            const bf16x8 bf2 = ok2 ? *(const LAS bf16x8*)(RT + (16 * cbl + fr) * 24 + 8 * fq) : zero8();
            const f32x4 xb4 = MFMA32(af2, bf2, ((f32x4){0.f, 0.f, 0.f, 0.f}));
            *(LAS v2u*)(RX + (16 * cb + fr) * 72 + 16 * bb + 4 * fq) = pack4(xb4);
            asm volatile("s_waitcnt lgkmcnt(0)" ::: "memory");
        }
    }
    LDS_BARRIER();
    {
        v4u* gout = (v4u*)(ws + WS_DG) + ((size_t)item * 8 + w) * 4 * 64 + lane;
        bf16x8 kb[2];
#pragma unroll
        for (int kt = 0; kt < 2; ++kt) kb[kt] = *(const LAS bf16x8*)(KdT + (16 * w + fr) * 72 + 32 * kt + 8 * fq);
#pragma unroll
        for (int ks = 0; ks < 4; ++ks) { f32x4 g0 = (f32x4){0.f, 0.f, 0.f, 0.f}, g1 = (f32x4){0.f, 0.f, 0.f, 0.f};
#pragma unroll
            for (int kt = 0; kt < 2; ++kt) { const bf16x8 a0 = *(const LAS bf16x8*)(RX + (128 + 32 * ks + fr) * 72 + 32 * kt + 8 * fq), a1 = *(const LAS bf16x8*)(RX + (128 + 32 * ks + 16 + fr) * 72 + 32 * kt + 8 * fq);
                g0 = MFMA32(a0, kb[kt], g0); g1 = MFMA32(a1, kb[kt], g1); }
            const v2u p0 = pack4(-g0), p1 = pack4(-g1); gout[ks * 64] = (v4u){p0.x, p0.y, p1.x, p1.y}; }
        v2u* bout = (v2u*)(ws + WS_DB) + ((size_t)item * 64 + w) * 64 + lane;
#pragma unroll
        for (int s2 = 0; s2 < 8; ++s2) { f32x4 bc = (f32x4){0.f, 0.f, 0.f, 0.f};
#pragma unroll
            for (int kt = 0; kt < 2; ++kt) { const bf16x8 ub = *(const LAS bf16x8*)(RX + (16 * s2 + fr) * 72 + 32 * kt + 8 * fq); bc = MFMA32(kb[kt], ub, bc); }
            bout[(size_t)s2 * 8 * 64] = pack4(bc); }
    }
    {
        const int tb = w >> 1, half = w & 1; const float ect = fexp(gcs[16 * tb + fr]);
        bf16x8 qk[2];
#pragma unroll
        for (int kt = 0; kt < 2; ++kt) qk[kt] = *(const LAS bf16x8*)(QKd + (16 * tb + fr) * 72 + 32 * kt + 8 * fq);
        v4u* qout = (v4u*)(ws + WS_DQ) + ((size_t)item * 4 + tb) * 4 * 64 + lane;
#pragma unroll
        for (int kk = 0; kk < 2; ++kk) { const int ks = 2 * half + kk; v2u pk[2];
#pragma unroll
            for (int hf = 0; hf < 2; ++hf) { const int db = 2 * ks + hf; f32x4 acc = (f32x4){0.f, 0.f, 0.f, 0.f};
#pragma unroll
                for (int kt = 0; kt < 2; ++kt) { const bf16x8 wa = *(const LAS bf16x8*)(RX + (128 + 16 * db + fr) * 72 + 32 * kt + 8 * fq); acc = MFMA32(wa, qk[kt], acc); }
                const v2u qn4 = *(const LAS v2u*)(Qn + (16 * tb + fr) * 136 + 16 * db + 4 * fq);
                f32x4 qp; qp.x = bflo(qn4.x) * ect - acc.x; qp.y = bfhi(qn4.x) * ect - acc.y; qp.z = bflo(qn4.y) * ect - acc.z; qp.w = bfhi(qn4.y) * ect - acc.w;
                pk[hf] = pack4(qp); }
            qout[ks * 64] = (v4u){pk[0].x, pk[0].y, pk[1].x, pk[1].y}; }
        v2u* oout = (v2u*)(ws + WS_DO) + ((size_t)item * 4 + tb) * 8 * 64 + lane;
#pragma unroll
        for (int ss = 0; ss < 4; ++ss) { const int s2 = 4 * half + ss; f32x4 acc = (f32x4){0.f, 0.f, 0.f, 0.f};
#pragma unroll
            for (int kt = 0; kt < 2; ++kt) { const bf16x8 ua = *(const LAS bf16x8*)(RX + (16 * s2 + fr) * 72 + 32 * kt + 8 * fq); acc = MFMA32(ua, qk[kt], acc); }
            oout[s2 * 64] = pack4(acc); }
    }
    if (tid == 0) ((float*)(ws + WS_DD))[item] = fexp(gcs[63]);
    LDS_BARRIER();
}

__device__ __forceinline__ void delta_scan_wave(ArgsP a, int chain, int s, const int lane) {
    unsigned char* ws = a->ws;
    const int fr = lane & 15, fq = lane >> 4;
    f32x4 S[8]; bf16x8 Sb[4];
#pragma unroll
    for (int i = 0; i < 8; ++i) S[i] = (f32x4){0.f, 0.f, 0.f, 0.f};
#pragma unroll
    for (int i = 0; i < 4; ++i) Sb[i] = zero8();
    const bf16x8* gbase = (const bf16x8*)(ws + WS_DG) + (size_t)chain * 32 * 2048 + lane;
    bf16x8 G[8][4];
#pragma unroll
    for (int rb = 0; rb < 8; ++rb)
#pragma unroll
        for (int ks = 0; ks < 4; ++ks) G[rb][ks] = gbase[(rb * 4 + ks) * 64];
#pragma unroll 1
    for (int c = 0; c < 32; ++c) {
        const int item = chain * 32 + c;
        const float d = ((const float*)(ws + WS_DD))[item];
        bf16x8* sout = (bf16x8*)(ws + WS_DS) + ((size_t)item * 8 + s) * 4 * 64 + lane;
#pragma unroll
        for (int ks = 0; ks < 4; ++ks) sout[ks * 64] = Sb[ks];
        const v2u* bin = (const v2u*)(ws + WS_DB) + ((size_t)item * 8 + s) * 8 * 64 + lane;
#pragma unroll
        for (int rb = 0; rb < 8; ++rb) { const v2u bc = bin[rb * 64]; S[rb].x = d * S[rb].x + bflo(bc.x); S[rb].y = d * S[rb].y + bfhi(bc.x); S[rb].z = d * S[rb].z + bflo(bc.y); S[rb].w = d * S[rb].w + bfhi(bc.y); }
        const bf16x8* gnext = gbase + (size_t)(c + 1 < 32 ? c + 1 : c) * 2048;
#pragma unroll
        for (int rb = 0; rb < 8; ++rb) {
#pragma unroll
            for (int ks = 0; ks < 4; ++ks) S[rb] = MFMA32(G[rb][ks], Sb[ks], S[rb]);
#pragma unroll
            for (int ks = 0; ks < 4; ++ks) G[rb][ks] = gnext[(rb * 4 + ks) * 64];
        }
#pragma unroll
        for (int ks = 0; ks < 4; ++ks) { const v2u lo = pack4(S[2 * ks]), hi = pack4(S[2 * ks + 1]); const v4u u = (v4u){lo.x, lo.y, hi.x, hi.y}; Sb[ks] = __builtin_bit_cast(bf16x8, u); }
    }
    f32x4* so = (f32x4*)(ws + WS_DF) + ((size_t)(chain * 8 + s) * 8) * 64 + lane;
#pragma unroll
    for (int rb = 0; rb < 8; ++rb) so[rb * 64] = S[rb];
}

__device__ __forceinline__ void delta_out_wave(ArgsP a, int item, int tb, const int lane) {
    unsigned char* ws = a->ws;
    const int c = item & 31, h = (item >> 5) & 7, b = item >> 8, fr = lane & 15, fq = lane >> 4;
    bf16x8 qf[4];
    const bf16x8* qin = (const bf16x8*)(ws + WS_DQ) + ((size_t)item * 4 + tb) * 4 * 64 + lane;
#pragma unroll
    for (int ks = 0; ks < 4; ++ks) qf[ks] = qin[ks * 64];
    const v2u* oin = (const v2u*)(ws + WS_DO) + ((size_t)item * 4 + tb) * 8 * 64 + lane;
    const bf16x8* sin = (const bf16x8*)(ws + WS_DS) + (size_t)item * 8 * 4 * 64 + lane;
    f32x4 o[8]; float ss = 0.f;
    v2u olv[8]; bf16x8 sfr[4][4];
#pragma unroll
    for (int s = 0; s < 8; ++s) olv[s] = oin[s * 64];
#pragma unroll
    for (int s = 0; s < 4; ++s)
#pragma unroll
        for (int ks = 0; ks < 4; ++ks) sfr[s][ks] = sin[(s * 4 + ks) * 64];
    const int row_ = b * TP + 64 * c + 16 * tb + fr;
    v2u zv[8];
#pragma unroll
    for (int s = 0; s < 8; ++s) zv[s] = *(const v2u*)((const bf16*)(ws + WS_PROJ) + (size_t)row_ * NPROJ_PAD + 4096 + h * 128 + 4 * fq + 16 * s);
#pragma unroll
    for (int grp = 0; grp < 2; ++grp) {
#pragma unroll
        for (int s4 = 0; s4 < 4; ++s4) { const int s = 4 * grp + s4; const v2u ol = olv[s]; o[s] = (f32x4){bflo(ol.x), bfhi(ol.x), bflo(ol.y), bfhi(ol.y)};
#pragma unroll
            for (int ks = 0; ks < 4; ++ks) o[s] = MFMA32(sfr[s4][ks], qf[ks], o[s]);
            ss += (o[s].x * o[s].x + o[s].y * o[s].y) + (o[s].z * o[s].z + o[s].w * o[s].w); }
        if (grp == 0) {
#pragma unroll
            for (int s4 = 0; s4 < 4; ++s4)
#pragma unroll
                for (int ks = 0; ks < 4; ++ks) sfr[s4][ks] = sin[((4 + s4) * 4 + ks) * 64]; }
    }
    ss += __shfl_xor(ss, 16); ss += __shfl_xor(ss, 32);
    const float rstd = rsqrtf(ss * (1.f / 128.f) + RMS_EPS);
    const int row = b * TP + 64 * c + 16 * tb + fr;
    const bf16* zp = (const bf16*)(ws + WS_PROJ) + (size_t)row * NPROJ_PAD + 4096 + h * 128 + 4 * fq;
    bf16* mp = (bf16*)(ws + WS_MIX) + (size_t)row * D + h * 128 + 4 * fq;
    const float* nw = a->in[I_DNORM] + 4 * fq;
#pragma unroll
    for (int s = 0; s < 8; ++s) { const v2u z = zv[s]; const f32x4 n4 = *(const f32x4*)(nw + 16 * s);
        f32x4 y; y.x = o[s].x * rstd * n4.x * siluf(bflo(z.x)); y.y = o[s].y * rstd * n4.y * siluf(bfhi(z.x)); y.z = o[s].z * rstd * n4.z * siluf(bflo(z.y)); y.w = o[s].w * rstd * n4.w * siluf(bfhi(z.y));
        *(v2u*)(mp + 16 * s) = pack4(y); }
}


__device__ __forceinline__ void mlstm_scan_item(ArgsP a, LAS unsigned char* lds, int chain, int vs, const int tid) {
    const int lane = tid & 63, w = __builtin_amdgcn_readfirstlane(tid >> 6), fr = lane & 15, fq = lane >> 4;
    const int b = chain >> 3, h = chain & 7, row0 = b * TP;
    unsigned char* ws = a->ws;
    const bf16* proj = (const bf16*)(ws + WS_PROJ); const float* gates = (const float*)(ws + WS_GATES);
    LAS bf16* KT = (LAS bf16*)lds;
    LAS bf16* VT = (LAS bf16*)(lds + 36864);
    LAS float* wls = (LAS float*)(lds + 46080);
    LAS float* gendA = (LAS float*)(lds + 46592);
    LAS float* blastA = gendA + 2048;
    LAS float* mxA = blastA + 32;
    const float big = a->in[I_BIG][h], bfg = a->in[I_BFG][h];
    {
        float lf4[4], ig4[4];
#pragma unroll
        for (int i = 0; i < 4; ++i) { const float* gp = gates + (size_t)(row0 + 64 * (w + 8 * i) + lane) * 16 + h; ig4[i] = gp[0] + big; lf4[i] = logsigf(gp[8] + bfg); }
#pragma unroll
        for (int i = 0; i < 4; ++i) { const float bcum = wave_incl_sum(lf4[i], lane), blast = __shfl(bcum, 63), gend = blast - bcum + ig4[i]; const float mx = wave_max(gend);
            gendA[(w + 8 * i) * 64 + lane] = gend; if (lane == 0) { blastA[w + 8 * i] = blast; mxA[w + 8 * i] = mx; } }
    }
    LDS_BARRIER();
    const bf16* kptr = proj + (size_t)(row0 + lane) * NPROJ_PAD + 1024 + h * 128 + 16 * w;
    const bf16* vptr = proj + (size_t)(row0 + lane) * NPROJ_PAD + 2048 + h * 256 + 32 * vs + 8 * (w & 3);
    f32x4 acc[2]; acc[0] = (f32x4){0.f, 0.f, 0.f, 0.f}; acc[1] = acc[0];
    float nst = 0.f, m = 0.f;
    v4u kq[2][2], vq[2];
#define ML_LOAD(set, c_) do { const size_t ro = (size_t)(c_) * 64 * NPROJ_PAD; kq[set][0] = *(const v4u*)(kptr + ro); kq[set][1] = *(const v4u*)(kptr + ro + 8); \
        if (w < 4) vq[set] = *(const v4u*)(vptr + ro); } while (0)
#define ML_STEP(set, c_) do { const int item = chain * 32 + (c_); \
        const float blast = blastA[(c_)], gend = gendA[(c_) * 64 + lane]; \
        const float mnew = fmaxf(blast + m, mxA[(c_)]), sc = fexp(blast + m - mnew), wv = fexp(gend - mnew) * 0.08838834764831845f; \
        LAS bf16* kt = KT + (set) * 9216; LAS bf16* vt = VT + (set) * 2304; \
        _Pragma("unroll") for (int i = 0; i < 2; ++i) { const unsigned uu[4] = {kq[set][i].x, kq[set][i].y, kq[set][i].z, kq[set][i].w}; const int kr = 8 * (2 * w + i); \
            _Pragma("unroll") for (int e = 0; e < 4; ++e) { kt[(kr + 2 * e) * 72 + lane] = (bf16)(uu[e] & 0xffffu); kt[(kr + 2 * e + 1) * 72 + lane] = (bf16)(uu[e] >> 16); } } \
        if (w < 4) { const unsigned uu[4] = {vq[set].x, vq[set].y, vq[set].z, vq[set].w}; \
            _Pragma("unroll") for (int e = 0; e < 4; ++e) { vt[(8 * w + 2 * e) * 72 + lane] = (bf16)f2bf(bflo(uu[e]) * wv); vt[(8 * w + 2 * e + 1) * 72 + lane] = (bf16)f2bf(bfhi(uu[e]) * wv); } } \
        if (w == 0) wls[(set) * 64 + lane] = wv; \
        if ((c_) + 2 < 32) ML_LOAD(set, (c_) + 2); \
        if (vs == 0 && tid == 0) ((float*)(ws + WS_MM))[item] = m; \
        LDS_BARRIER(); \
        _Pragma("unroll") for (int vb = 0; vb < 2; ++vb) { *(v2u*)((bf16*)(ws + WS_MC) + ((size_t)item * 256 + 32 * vs + 16 * vb + fr) * 128 + 16 * w + 4 * fq) = pack4(acc[vb]); } \
        if (vs == 0 && tid < 128) { ((float*)(ws + WS_MN))[(size_t)item * 128 + tid] = nst; float sn = 0.f; \
            _Pragma("unroll") for (int s8 = 0; s8 < 8; ++s8) { const v4u kk = *(const LAS v4u*)(kt + tid * 72 + 8 * s8); const LAS float* wl = wls + (set) * 64 + 8 * s8; \
                sn += bflo(kk.x) * wl[0] + bfhi(kk.x) * wl[1] + bflo(kk.y) * wl[2] + bfhi(kk.y) * wl[3] + bflo(kk.z) * wl[4] + bfhi(kk.z) * wl[5] + bflo(kk.w) * wl[6] + bfhi(kk.w) * wl[7]; } \
            nst = sc * nst + sn; } \
        _Pragma("unroll") for (int vb = 0; vb < 2; ++vb) { acc[vb] = acc[vb] * sc; \
            _Pragma("unroll") for (int kt2 = 0; kt2 < 2; ++kt2) { const bf16x8 af = *(const LAS bf16x8*)(kt + (16 * w + fr) * 72 + 32 * kt2 + 8 * fq), bfv = *(const LAS bf16x8*)(vt + (16 * vb + fr) * 72 + 32 * kt2 + 8 * fq); \
                acc[vb] = MFMA32(af, bfv, acc[vb]); } } \
        m = mnew; } while (0)
    ML_LOAD(0, 0); ML_LOAD(1, 1);
#pragma unroll 1
    for (int c2 = 0; c2 < 32; c2 += 2) { ML_STEP(0, c2); ML_STEP(1, c2 + 1); }
#undef ML_LOAD
#undef ML_STEP
#pragma unroll
    for (int vb = 0; vb < 2; ++vb) *(f32x4*)(a->out + O_MCP + ((size_t)chain * 256 + 32 * vs + 16 * vb + fr) * 128 + 16 * w + 4 * fq) = acc[vb];
    if (vs == 0) { if (tid < 128) a->out[O_MNP + (size_t)chain * 128 + tid] = nst; if (tid == 0) a->out[O_MMP + chain] = m; }
    LDS_BARRIER();
}

__device__ __forceinline__ void mlstm_out_item(ArgsP a, LAS unsigned char* lds, int item, const int tid) {
    const int c = item & 31, h = (item >> 5) & 7, b = item >> 8, row0 = b * TP + 64 * c;
    const int lane = tid & 63, w = __builtin_amdgcn_readfirstlane(tid >> 6), fr = lane & 15, fq = lane >> 4;
    unsigned char* ws = a->ws;
    const bf16* proj = (const bf16*)(ws + WS_PROJ); const float* gates = (const float*)(ws + WS_GATES);
    LAS bf16* VT = (LAS bf16*)lds;
    LAS float* ssq = (LAS float*)(lds + 36864);
    const int tb = w & 3, half = w >> 2, t = 16 * tb + fr;
    v4u vu[4];
#pragma unroll
    for (int i = 0; i < 4; ++i) vu[i] = *(const v4u*)(proj + (size_t)(row0 + lane) * NPROJ_PAD + 2048 + h * 256 + 8 * (w + 8 * i));
    v4u qu[4]; f32x4 nv[4][2];
#pragma unroll
    for (int ks = 0; ks < 4; ++ks) { qu[ks] = *(const v4u*)(proj + (size_t)(row0 + t) * NPROJ_PAD + h * 128 + 32 * ks + 8 * fq);
        const float* np = (const float*)(ws + WS_MN) + (size_t)item * 128 + 32 * ks + 8 * fq; nv[ks][0] = *(const f32x4*)np; nv[ks][1] = *(const f32x4*)(np + 4); }
    v4u kfr[4][4];
#pragma unroll
    for (int sb = 0; sb < 4; ++sb) if (sb <= tb) {
#pragma unroll
        for (int ks = 0; ks < 4; ++ks) kfr[sb][ks] = *(const v4u*)(proj + (size_t)(row0 + 16 * sb + fr) * NPROJ_PAD + 1024 + h * 128 + 32 * ks + 8 * fq); }
    const float mc = ((const float*)(ws + WS_MM))[item];
    float av, Mt, et, em;
    { const float ig = gates[(size_t)(row0 + lane) * 16 + h] + a->in[I_BIG][h], lf = logsigf(gates[(size_t)(row0 + lane) * 16 + 8 + h] + a->in[I_BFG][h]);
      const float bcum = wave_incl_sum(lf, lane); av = ig - bcum; Mt = fmaxf(mc, wave_incl_max(av, lane)); et = fexp(mc - Mt); em = fexp(-(bcum + Mt)); }
#pragma unroll
    for (int i = 0; i < 4; ++i) { const unsigned uu[4] = {vu[i].x, vu[i].y, vu[i].z, vu[i].w}; const int vr = 8 * (w + 8 * i);
#pragma unroll
        for (int e = 0; e < 4; ++e) { VT[(vr + 2 * e) * 72 + lane] = (bf16)(uu[e] & 0xffffu); VT[(vr + 2 * e + 1) * 72 + lane] = (bf16)(uu[e] >> 16); } }
    bf16x8 qf[4]; float qn = 0.f;
#pragma unroll
    for (int ks = 0; ks < 4; ++ks) { const v4u u = qu[ks]; qf[ks] = __builtin_bit_cast(bf16x8, u); const f32x4 n0 = nv[ks][0], n1 = nv[ks][1];
        qn += bflo(u.x) * n0.x + bfhi(u.x) * n0.y + bflo(u.y) * n0.z + bfhi(u.y) * n0.w + bflo(u.z) * n1.x + bfhi(u.z) * n1.y + bflo(u.w) * n1.z + bfhi(u.w) * n1.w; }
    qn += __shfl_xor(qn, 16); qn += __shfl_xor(qn, 32);
    const float Mtt = __shfl(Mt, t), ett = __shfl(et, t), emt = __shfl(em, t);
    const bf16* cs = (const bf16*)(ws + WS_MC) + (size_t)item * 256 * 128;
    v2u smp[4]; float rowsum = 0.f;
#pragma unroll
    for (int sb = 0; sb < 4; ++sb) { smp[sb] = (v2u){0u, 0u};
        if (sb <= tb) { f32x4 qk = (f32x4){0.f, 0.f, 0.f, 0.f};
#pragma unroll
            for (int ks = 0; ks < 4; ++ks) qk = MFMA32(__builtin_bit_cast(bf16x8, kfr[sb][ks]), qf[ks], qk);
            f32x4 sm;
#pragma unroll
            for (int j = 0; j < 4; ++j) { const int s = 16 * sb + 4 * fq + j; const float as = __shfl(av, s); sm[j] = (s <= t) ? qk[j] * 0.08838834764831845f * fexp(as - Mtt) : 0.f; rowsum += sm[j]; }
            smp[sb] = pack4(sm); } }
    rowsum += __shfl_xor(rowsum, 16); rowsum += __shfl_xor(rowsum, 32);
    const float hden = 1.f / fmaxf(fabsf(ett * qn + rowsum), emt);
    const v4u s0u = (v4u){smp[0].x, smp[0].y, smp[1].x, smp[1].y}, s1u = (v4u){smp[2].x, smp[2].y, smp[3].x, smp[3].y};
    const bf16x8 sf0 = __builtin_bit_cast(bf16x8, s0u), sf1 = __builtin_bit_cast(bf16x8, s1u);
    v4u cfr[4][4];
#pragma unroll
    for (int g4 = 0; g4 < 4; ++g4)
#pragma unroll
        for (int ks = 0; ks < 4; ++ks) cfr[g4][ks] = *(const v4u*)(cs + (size_t)(128 * half + 16 * g4 + fr) * 128 + 32 * ks + 8 * fq);
    LDS_BARRIER();
    f32x4 hv[8]; float ss = 0.f;
#pragma unroll
    for (int grp = 0; grp < 2; ++grp) {
      f32x4 accs[4];
#pragma unroll
      for (int g4 = 0; g4 < 4; ++g4) { f32x4 acc = (f32x4){0.f, 0.f, 0.f, 0.f};
#pragma unroll
          for (int ks = 0; ks < 4; ++ks) acc = MFMA32(__builtin_bit_cast(bf16x8, cfr[g4][ks]), qf[ks], acc);
          accs[g4] = acc * ett; }
      if (grp == 0) {
#pragma unroll
          for (int g4 = 0; g4 < 4; ++g4)
#pragma unroll
              for (int ks = 0; ks < 4; ++ks) cfr[g4][ks] = *(const v4u*)(cs + (size_t)(128 * half + 64 + 16 * g4 + fr) * 128 + 32 * ks + 8 * fq); }
#pragma unroll
      for (int g4 = 0; g4 < 4; ++g4) { const int vb = 4 * grp + g4, vrow = 128 * half + 16 * vb + fr; f32x4 acc = accs[g4];
        { const v2u a0 = *(const LAS v2u*)(VT + vrow * 72 + 4 * fq), a1 = *(const LAS v2u*)(VT + vrow * 72 + 16 + 4 * fq); const v4u au = (v4u){a0.x, a0.y, a1.x, a1.y}; acc = MFMA32(__builtin_bit_cast(bf16x8, au), sf0, acc); }
        { const v2u a0 = *(const LAS v2u*)(VT + vrow * 72 + 32 + 4 * fq), a1 = *(const LAS v2u*)(VT + vrow * 72 + 48 + 4 * fq); const v4u au = (v4u){a0.x, a0.y, a1.x, a1.y}; acc = MFMA32(__builtin_bit_cast(bf16x8, au), sf1, acc); }
        hv[vb] = acc * hden; ss += (hv[vb].x * hv[vb].x + hv[vb].y * hv[vb].y) + (hv[vb].z * hv[vb].z + hv[vb].w * hv[vb].w); }
    }
    ss += __shfl_xor(ss, 16); ss += __shfl_xor(ss, 32);
    if (fq == 0) ssq[half * 64 + t] = ss;
    LDS_BARRIER();
    const float rstd = rsqrtf((ssq[t] + ssq[64 + t]) * (1.f / 256.f) + RMS_EPS);
    const bf16* op = proj + (size_t)(row0 + t) * NPROJ_PAD + 4096 + h * 256 + 128 * half + 4 * fq;
    bf16* mp = (bf16*)(ws + WS_MIX) + (size_t)(row0 + t) * D + h * 256 + 128 * half + 4 * fq;
    const float* nw = a->in[I_MNORM] + h * 256 + 128 * half + 4 * fq;
    v2u opr[8];
#pragma unroll
    for (int vb = 0; vb < 8; ++vb) opr[vb] = *(const v2u*)(op + 16 * vb);
#pragma unroll
    for (int vb = 0; vb < 8; ++vb) { const v2u o = opr[vb]; const f32x4 n4 = *(const f32x4*)(nw + 16 * vb);
        f32x4 y; y.x = hv[vb].x * rstd * n4.x * sigm(bflo(o.x)); y.y = hv[vb].y * rstd * n4.y * sigm(bfhi(o.x)); y.z = hv[vb].z * rstd * n4.z * sigm(bflo(o.y)); y.w = hv[vb].w * rstd * n4.w * sigm(bfhi(o.y));
        *(v2u*)(mp + 16 * vb) = pack4(y); }
    LDS_BARRIER();
}


__device__ __forceinline__ void mlstm_sample_load(ArgsP a, int j, const int tid, f32x4 (&cst)[2][4][2]) {
    const int lane = tid & 63, w = __builtin_amdgcn_readfirstlane(tid >> 6), fr = lane & 15, fq = lane >> 4;
    const float* C0 = a->in[I_SMC] + (size_t)j * 32768;
#pragma unroll
    for (int vb = 0; vb < 2; ++vb)
#pragma unroll
        for (int ksp = 0; ksp < 4; ++ksp) { const float* cp = C0 + (size_t)(32 * w + 16 * vb + fr) * 128 + 32 * ksp + 4 * fq; cst[vb][ksp][0] = __builtin_nontemporal_load((const f32x4*)cp); cst[vb][ksp][1] = __builtin_nontemporal_load((const f32x4*)(cp + 16)); }
}
__device__ __forceinline__ void mlstm_sample_item(ArgsP a, LAS unsigned char* lds, int j, const int tid, const f32x4 (&cst)[2][4][2]) {
    const int b = j >> 3, h = j & 7, row0 = MP + b * TS;
    const int lane = tid & 63, w = __builtin_amdgcn_readfirstlane(tid >> 6), fr = lane & 15, fq = lane >> 4;
    unsigned char* ws = a->ws;
    const bf16* proj = (const bf16*)(ws + WS_PROJ); const float* gates = (const float*)(ws + WS_GATES);
    float* Cout = a->out + O_MCS + (size_t)j * 32768;
    LAS float* qs = (LAS float*)lds;
    LAS float* ks = qs + 512;
    LAS float* vs = ks + 512;
    LAS float* gs = vs + 1024;
    LAS float* qkr = gs + 8;
    LAS float* qnl = qkr + 16;
    LAS float* hbuf = qnl + 8;
#pragma unroll
    for (int tok = 0; tok < 4; ++tok) { const bf16* pr = proj + (size_t)(row0 + tok) * NPROJ_PAD;
        if (tid < 128) qs[tok * 128 + tid] = bf2f(pr[h * 128 + tid]); else if (tid < 256) ks[tok * 128 + tid - 128] = bf2f(pr[1024 + h * 128 + (tid - 128)]) * 0.08838834764831845f; else vs[tok * 256 + tid - 256] = bf2f(pr[2048 + h * 256 + (tid - 256)]); }
    if (tid < 4) { gs[tid * 2] = gates[(size_t)(row0 + tid) * 16 + h] + a->in[I_BIG][h]; gs[tid * 2 + 1] = gates[(size_t)(row0 + tid) * 16 + 8 + h] + a->in[I_BFG][h]; }
    const float n0a = a->in[I_SMN][(size_t)j * 128 + lane], n0b = a->in[I_SMN][(size_t)j * 128 + 64 + lane];
    const float m0 = a->in[I_SMM][j];
    LDS_BARRIER();
#pragma unroll
    for (int i = 0; i < 2; ++i) { const int p = 2 * w + i, t = p >> 2, sx = p & 3; const float d = wave_sum(qs[t * 128 + lane] * ks[sx * 128 + lane] + qs[t * 128 + 64 + lane] * ks[sx * 128 + 64 + lane]); if (lane == 0) qkr[p] = d; }
    if (w < 4) { const float d = wave_sum(qs[w * 128 + lane] * n0a + qs[w * 128 + 64 + lane] * n0b); if (lane == 0) qnl[w] = d; }
    float bc[4], ig[4], mt[4], m = m0, bsum = 0.f;
#pragma unroll
    for (int t = 0; t < 4; ++t) { ig[t] = gs[t * 2]; const float lf = logsigf(gs[t * 2 + 1]); bsum += lf; bc[t] = bsum; m = fmaxf(lf + m, ig[t]); mt[t] = m; }
    const float scf = fexp(bc[3] + m0 - mt[3]);
    float wsf[4], et[4];
#pragma unroll
    for (int t = 0; t < 4; ++t) { wsf[t] = fexp(bc[3] - bc[t] + ig[t] - mt[3]); et[t] = fexp(bc[t] + m0 - mt[t]); }
    LDS_BARRIER();
    float S[4][4], hden[4];
#pragma unroll
    for (int t = 0; t < 4; ++t) { float den = et[t] * qnl[t];
#pragma unroll
        for (int sx = 0; sx < 4; ++sx) { S[t][sx] = (sx <= t) ? qkr[t * 4 + sx] * fexp(bc[t] - bc[sx] + ig[sx] - mt[t]) : 0.f; den += S[t][sx]; }
        hden[t] = 1.f / fmaxf(fabsf(den), fexp(-mt[t])); }
    bf16x8 qa[4];
#pragma unroll
    for (int ksp = 0; ksp < 4; ++ksp) { v4u u = (v4u){0u, 0u, 0u, 0u};
        if (fr < 4) { const f32x4 x0 = *(const LAS f32x4*)(qs + fr * 128 + 32 * ksp + 4 * fq), x1 = *(const LAS f32x4*)(qs + fr * 128 + 32 * ksp + 16 + 4 * fq); u.x = pk2(x0.x, x0.y); u.y = pk2(x0.z, x0.w); u.z = pk2(x1.x, x1.y); u.w = pk2(x1.z, x1.w); }
        qa[ksp] = __builtin_bit_cast(bf16x8, u); }
#pragma unroll
    for (int vb = 0; vb < 2; ++vb) { const int v = 32 * w + 16 * vb + fr;
        float vw[4];
#pragma unroll
        for (int sx = 0; sx < 4; ++sx) vw[sx] = vs[sx * 256 + v] * wsf[sx];
        f32x4 dacc = (f32x4){0.f, 0.f, 0.f, 0.f};
#pragma unroll
        for (int ksp = 0; ksp < 4; ++ksp) { const f32x4 c0 = cst[vb][ksp][0], c1 = cst[vb][ksp][1];
            v4u u; u.x = pk2(c0.x, c0.y); u.y = pk2(c0.z, c0.w); u.z = pk2(c1.x, c1.y); u.w = pk2(c1.z, c1.w);
            dacc = MFMA32(qa[ksp], __builtin_bit_cast(bf16x8, u), dacc);
            f32x4 n0v = c0 * scf, n1v = c1 * scf;
#pragma unroll
            for (int sx = 0; sx < 4; ++sx) { const f32x4 k0 = *(const LAS f32x4*)(ks + sx * 128 + 32 * ksp + 4 * fq), k1 = *(const LAS f32x4*)(ks + sx * 128 + 32 * ksp + 16 + 4 * fq); n0v = n0v + k0 * vw[sx]; n1v = n1v + k1 * vw[sx]; }
            float* op = Cout + (size_t)v * 128 + 32 * ksp + 4 * fq; __builtin_nontemporal_store(n0v, (f32x4*)op); __builtin_nontemporal_store(n1v, (f32x4*)(op + 16)); }
        if (fq == 0) {
#pragma unroll
            for (int t = 0; t < 4; ++t) { float num = et[t] * dacc[t];
#pragma unroll
                for (int sx = 0; sx < 4; ++sx) num += S[t][sx] * vs[sx * 256 + v];
                hbuf[t * 256 + v] = num * hden[t]; } }
    }
    if (tid < 128) { float nn = scf * a->in[I_SMN][(size_t)j * 128 + tid];
#pragma unroll
        for (int sx = 0; sx < 4; ++sx) nn += wsf[sx] * ks[sx * 128 + tid];
        a->out[O_MNS + (size_t)j * 128 + tid] = nn; }
    if (tid == 0) a->out[O_MMS + j] = mt[3];
    LDS_BARRIER();
    if (w < 4) { const int tok = w, row = row0 + tok; float hv[4]; float ss = 0.f;
#pragma unroll
        for (int i = 0; i < 4; ++i) { hv[i] = hbuf[tok * 256 + i * 64 + lane]; ss += hv[i] * hv[i]; }
        const float rstd = rsqrtf(wave_sum(ss) * (1.f / 256.f) + RMS_EPS);
        const float* nw = a->in[I_MNORM] + h * 256; bf16* mix = (bf16*)(ws + WS_MIX);
#pragma unroll
        for (int i = 0; i < 4; ++i) { const int vi = i * 64 + lane; const float op = bf2f(proj[(size_t)row * NPROJ_PAD + 4096 + h * 256 + vi]);
            mix[(size_t)row * D + h * 256 + vi] = (bf16)f2bf(hv[i] * rstd * nw[vi] * sigm(op)); } }
    LDS_BARRIER();
}


__device__ __forceinline__ void lru_sample_loop(ArgsP a, LAS unsigned char* lds, int vcu, int G, const int tid) {
    const int d = tid & 127, part = tid >> 7, n = vcu & 7, chn = n * 128 + d;
    const bf16* proj = (const bf16*)(a->ws + WS_PROJ); bf16* mix = (bf16*)(a->ws + WS_MIX);
    const float* wconv = a->in[I_WCONV]; const float* bconv = a->in[I_BCONV];
    const float* wr = a->in[I_LWR] + (size_t)n * 16384; const float* wi = a->in[I_LWI] + (size_t)n * 16384;
    LAS float* xr = (LAS float*)lds;
    LAS float* red = xr + 512;
    float w1[32], w2[32];
#pragma unroll
    for (int cc = 0; cc < 32; ++cc) { w1[cc] = wr[(part * 32 + cc) * 128 + d]; w2[cc] = wi[(part * 32 + cc) * 128 + d]; }
    const float br = a->in[I_LBR][chn], bi = a->in[I_LBI][chn], spl = softplusf(-a->in[I_LLAM][chn]);
#pragma unroll 1
    for (int j = vcu; j < 1024; j += G) {
        const int b = j >> 3, row0 = MP + b * TS; const float* cstate = a->in[I_SCONV] + (size_t)b * 3 * 4096;
        float hst = a->in[I_SLRU][(size_t)b * 1024 + chn];
        float gt[4];
        if (part == 0) {
#pragma unroll
            for (int tok = 0; tok < 4; ++tok) gt[tok] = bf2f(proj[(size_t)(row0 + tok) * NPROJ_PAD + 5120 + chn]); }
        { const int tok = tid >> 7; xr[tok * 128 + d] = conv4(proj, row0, tok, 3072 + chn, cstate, wconv, bconv); }
        LDS_BARRIER();
        float ar[4] = {0.f, 0.f, 0.f, 0.f}, ai[4] = {0.f, 0.f, 0.f, 0.f};
#pragma unroll
        for (int cc = 0; cc < 32; ++cc) { const int c = part * 32 + cc;
#pragma unroll
            for (int tok = 0; tok < 4; ++tok) { const float x = xr[tok * 128 + c]; ar[tok] += x * w1[cc]; ai[tok] += x * w2[cc]; } }
#pragma unroll
        for (int tok = 0; tok < 4; ++tok) { red[((tok * 2 + 0) * 4 + part) * 128 + d] = ar[tok]; red[((tok * 2 + 1) * 4 + part) * 128 + d] = ai[tok]; }
        LDS_BARRIER();
        if (part == 0) {
#pragma unroll
            for (int tok = 0; tok < 4; ++tok) {
                float rp = br, ip = bi;
#pragma unroll
                for (int p = 0; p < 4; ++p) { rp += red[((tok * 2 + 0) * 4 + p) * 128 + d]; ip += red[((tok * 2 + 1) * 4 + p) * 128 + d]; }
                const float log_a = -8.f * sigm(rp) * spl;
                const float av = fexp(log_a);
                const float bx = sqrtf(neg_expm1(2.f * log_a)) * sigm(ip) * xr[tok * 128 + d];
                hst = av * hst + bx;
                mix[(size_t)(row0 + tok) * D + 1024 + chn] = (bf16)f2bf(hst * gelu_tanh(gt[tok]));
            }
            a->out[O_LRUS + (size_t)b * 1024 + chn] = hst;
        }
        LDS_BARRIER();
    }
}

__device__ __forceinline__ void phase_mixer_even(ArgsP a, LAS unsigned char* lds, int vcu, int G, const int tid) {
#pragma unroll 1
    for (int r = 0; r < 1 + (PROBE_SUB & 1); ++r)
#pragma unroll 1
    for (int it = vcu; it < 1024; it += G) { int tq = tid; asm volatile("" : "+v"(tq)); delta_prep_item(a, lds, it, tq); }
#pragma unroll 1
    for (int r = 0; r < 1 + ((PROBE_SUB >> 1) & 1); ++r)
#pragma unroll 1
    for (int it = vcu; it < 1024; it += G) lru_prep_item(a, lds, it, tid);
#pragma unroll 1
    for (int r = 0; r < 1 + ((PROBE_SUB >> 2) & 1); ++r)
#pragma unroll 1
    for (int j = vcu; j < 1024; j += G) { const int b = j >> 3, hn = j & 7; delta_rec_item(a, lds, MP + b * TS, TS, hn, a->in[I_SCONV] + (size_t)b * 3 * 4096, a->in[I_SDELTA] + (size_t)j * 16384, a->out + O_DELTAS + (size_t)j * 16384, tid); }
#pragma unroll 1
    for (int r = 0; r < 1 + ((PROBE_SUB >> 3) & 1); ++r)
    lru_sample_loop(a, lds, vcu, G, tid);
    const bf16* proj = (const bf16*)(a->ws + WS_PROJ);
    const int npieces = (BP + BS) * 3 * 512;
    for (int i = vcu * NTHR + tid; i < npieces; i += G * NTHR) {
        const int c8 = i & 511, rj = i >> 9, j = rj % 3, b = rj / 3;
        const bf16* src; float* dst;
        if (b < BP) { src = proj + (size_t)(b * TP + TP - 3 + j) * NPROJ_PAD + 8 * c8; dst = a->out + O_CONVP + (size_t)(b * 3 + j) * 4096 + 8 * c8; }
        else { const int bs = b - BP; src = proj + (size_t)(MP + bs * TS + 1 + j) * NPROJ_PAD + 8 * c8; dst = a->out + O_CONVS + (size_t)(bs * 3 + j) * 4096 + 8 * c8; }
        const v4u u = *(const v4u*)src;
        *(f32x4*)dst = (f32x4){bflo(u.x), bfhi(u.x), bflo(u.y), bfhi(u.y)}; *(f32x4*)(dst + 4) = (f32x4){bflo(u.z), bfhi(u.z), bflo(u.w), bfhi(u.w)};
    }
}
__device__ __forceinline__ void phase_mixer_even_b(ArgsP a, LAS unsigned char* lds, int vcu, int G, const int tid) {
    const int w = __builtin_amdgcn_readfirstlane(tid >> 6);
    if (w == 0) { for (int it = vcu; it < 256; it += G) delta_scan_wave(a, it >> 3, it & 7, tid & 63); }
    else { LAS float* scr = (LAS float*)(lds + w * 16384);
        convert_range(a, scr, cv::R_IN0, cv::R_SCAN, vcu * 7 + (w - 1), G * 7, tid & 63); }
}
__device__ __forceinline__ void phase_mixer_even_c(ArgsP a, LAS unsigned char* lds, int vcu, int G, const int tid) {
    const int w = tid >> 6;
#pragma unroll 1
    for (int it = vcu; it < 512; it += G) delta_out_wave(a, 2 * it + (w >> 2), w & 3, tid & 63);
#pragma unroll 1
    for (int it = vcu; it < 1024; it += G) lru_out_item(a, lds, it, tid);
    for (int chain = vcu; chain < 32; chain += G) {
        const f32x4* src = (const f32x4*)(a->ws + WS_DF) + (size_t)chain * 4096; float* dst = a->out + O_DELTAP + (size_t)chain * 16384;
        f32x4 v[8];
#pragma unroll
        for (int i = 0; i < 8; ++i) v[i] = src[tid + 512 * i];
#pragma unroll
        for (int i = 0; i < 8; ++i) { const int idx = tid + 512 * i, ln = idx & 63, rb = (idx >> 6) & 7, s8 = idx >> 9; const int dk0 = 16 * rb + 4 * (ln >> 4), dv = 16 * s8 + (ln & 15);
            dst[(size_t)(dk0 + 0) * 128 + dv] = v[i].x; dst[(size_t)(dk0 + 1) * 128 + dv] = v[i].y; dst[(size_t)(dk0 + 2) * 128 + dv] = v[i].z; dst[(size_t)(dk0 + 3) * 128 + dv] = v[i].w; }
    }
}
__device__ __forceinline__ void phase_mixer_odd(ArgsP a, LAS unsigned char* lds, int vcu, int G, const int tid) {
#pragma unroll 1
    for (int r = 0; r < 1 + ((PROBE_SUB >> 4) & 1); ++r)
#pragma unroll 1
    for (int it = vcu; it < 256; it += G) mlstm_scan_item(a, lds, it >> 3, it & 7, tid);
#pragma unroll 1
    for (int r = 0; r < 1 + ((PROBE_SUB >> 5) & 1); ++r)
    {
        f32x4 cA[2][4][2], cB[2][4][2]; int j = vcu;
        if (j < 1024) { mlstm_sample_load(a, j, tid, cA);
#pragma unroll 1
            for (;;) {
                const int jB = j + G; const bool hasB = jB < 1024;
                if (hasB) mlstm_sample_load(a, jB, tid, cB);
                mlstm_sample_item(a, lds, j, tid, cA);
                if (!hasB) break;
                j = jB + G; const bool hasA = j < 1024;
                if (hasA) mlstm_sample_load(a, j, tid, cA);
                mlstm_sample_item(a, lds, jB, tid, cB);
                if (!hasA) break;
            } }
    }
}
__device__ __forceinline__ void phase_mixer_odd_b(ArgsP a, LAS unsigned char* lds, int vcu, int G, const int tid) {
#pragma unroll 1
    for (int it = vcu; it < 1024; it += G) mlstm_out_item(a, lds, it, tid);
}

__device__ __forceinline__ void phase_ln(const bf16* VB, const float* ST, const float* p1, const bf16* resid, const float* g, const float* bta, bf16* dst, LAS unsigned char* lds, int vcu, int G, const int tid) {
    const int lane = tid & 63, w = __builtin_amdgcn_readfirstlane(tid >> 6), gw = vcu * NWAVES + w, NGW = G * NWAVES;
    {
        LAS float* red = (LAS float*)lds;
        for (int r0 = 2 * vcu; r0 < MS; r0 += 2 * G) {
            const int r = r0 + (w >> 2), q = w & 3, col = 512 * q + 8 * lane; const size_t off = (size_t)(MP + r) * D + col;
            const float* q1 = p1 + (size_t)r * D + col;
            f32x4 x0 = *(const f32x4*)q1, x1 = *(const f32x4*)(q1 + 4);
#pragma unroll
            for (int ch = 1; ch < 16; ++ch) { x0 = x0 + *(const f32x4*)(q1 + (size_t)ch * 512 * D); x1 = x1 + *(const f32x4*)(q1 + (size_t)ch * 512 * D + 4); }
            const v4u rr = *(const v4u*)(resid + off);
            float v[8] = {x0.x + DN_ALPHA * bflo(rr.x), x0.y + DN_ALPHA * bfhi(rr.x), x0.z + DN_ALPHA * bflo(rr.y), x0.w + DN_ALPHA * bfhi(rr.y),
                          x1.x + DN_ALPHA * bflo(rr.z), x1.y + DN_ALPHA * bfhi(rr.z), x1.z + DN_ALPHA * bflo(rr.w), x1.w + DN_ALPHA * bfhi(rr.w)};
            float s = 0.f, ss = 0.f;
#pragma unroll
            for (int i = 0; i < 8; ++i) { s += v[i]; ss += v[i] * v[i]; }
            s = wave_sum(s); ss = wave_sum(ss);
            if (lane == 0) { red[w * 2] = s; red[w * 2 + 1] = ss; }
            LDS_BARRIER();
            const int wb = (w >> 2) * 4; s = (red[wb * 2] + red[wb * 2 + 2]) + (red[wb * 2 + 4] + red[wb * 2 + 6]); ss = (red[wb * 2 + 1] + red[wb * 2 + 3]) + (red[wb * 2 + 5] + red[wb * 2 + 7]);
            const float mean = s * (1.f / D), rstd = rsqrtf(fmaxf(ss * (1.f / D) - mean * mean, 0.f) + LN_EPS);
            const f32x4 g0 = *(const f32x4*)(g + col), g1 = *(const f32x4*)(g + col + 4), b0 = *(const f32x4*)(bta + col), b1 = *(const f32x4*)(bta + col + 4);
            v4u o; o.x = pk2((v[0] - mean) * rstd * g0.x + b0.x, (v[1] - mean) * rstd * g0.y + b0.y); o.y = pk2((v[2] - mean) * rstd * g0.z + b0.z, (v[3] - mean) * rstd * g0.w + b0.w);
            o.z = pk2((v[4] - mean) * rstd * g1.x + b1.x, (v[5] - mean) * rstd * g1.y + b1.y); o.w = pk2((v[6] - mean) * rstd * g1.z + b1.z, (v[7] - mean) * rstd * g1.w + b1.w);
            *(v4u*)(dst + off) = o;
            LDS_BARRIER();
        }
    }
    for (int m0 = gw; m0 < MP; m0 += 4 * NGW) {
        v4u vv[4][4]; float s[4], ss[4];
#pragma unroll
        for (int i = 0; i < 4; ++i) { const int m = m0 + i * NGW; s[i] = 0.f; ss[i] = 0.f;
            if (m < MP) { if (lane < 32) { const float* sp = ST + (((size_t)(lane >> 2) * M + m) * 4 + (lane & 3)) * 2; s[i] = sp[0]; ss[i] = sp[1]; }
#pragma unroll
                for (int j = 0; j < 4; ++j) vv[i][j] = *(const v4u*)(VB + (size_t)m * D + j * 512 + lane * 8); } }
#pragma unroll
        for (int i = 0; i < 4; ++i) { const int m = m0 + i * NGW;
            if (m < MP) { const float st = wave_sum(s[i]), sst = wave_sum(ss[i]);
                const float mean = st * (1.f / D), rstd = rsqrtf(fmaxf(sst * (1.f / D) - mean * mean, 0.f) + LN_EPS);
#pragma unroll
                for (int j = 0; j < 4; ++j) { const int col = j * 512 + lane * 8; const v4u v = vv[i][j];
                    const f32x4 g0 = *(const f32x4*)(g + col), g1 = *(const f32x4*)(g + col + 4), b0 = *(const f32x4*)(bta + col), b1 = *(const f32x4*)(bta + col + 4);
                    v4u o; o.x = pk2((bflo(v.x) - mean) * rstd * g0.x + b0.x, (bfhi(v.x) - mean) * rstd * g0.y + b0.y); o.y = pk2((bflo(v.y) - mean) * rstd * g0.z + b0.z, (bfhi(v.y) - mean) * rstd * g0.w + b0.w);
                    o.z = pk2((bflo(v.z) - mean) * rstd * g1.x + b1.x, (bfhi(v.z) - mean) * rstd * g1.y + b1.y); o.w = pk2((bflo(v.w) - mean) * rstd * g1.z + b1.z, (bfhi(v.w) - mean) * rstd * g1.w + b1.w);
                    *(v4u*)(dst + (size_t)m * D + col) = o; } } }
    }
}
__device__ __forceinline__ void phase_combine(const float* p1, const bf16* h2, const bf16* pw, bf16* xb, float* outf, int vcu, int G, const int tid) {
    const int lane = tid & 63, w = tid >> 6;
    for (int r0 = 2 * vcu; r0 < MS; r0 += 2 * G) {
        const int r = r0 + (w >> 2), q = w & 3, col = 512 * q + 8 * lane; const size_t off = (size_t)(MP + r) * D + col;
        const float* q1 = p1 + (size_t)r * D + col;
        f32x4 x0 = *(const f32x4*)q1, x1 = *(const f32x4*)(q1 + 4);
#pragma unroll
        for (int ch = 1; ch < 16; ++ch) { x0 = x0 + *(const f32x4*)(q1 + (size_t)ch * 512 * D); x1 = x1 + *(const f32x4*)(q1 + (size_t)ch * 512 * D + 4); }
        const v4u hh = *(const v4u*)(h2 + off), pp = *(const v4u*)(pw + off);
        f32x4 o0, o1;
        o0.x = bflo(hh.x) + sigm(x0.x) * bflo(pp.x); o0.y = bfhi(hh.x) + sigm(x0.y) * bfhi(pp.x); o0.z = bflo(hh.y) + sigm(x0.z) * bflo(pp.y); o0.w = bfhi(hh.y) + sigm(x0.w) * bfhi(pp.y);
        o1.x = bflo(hh.z) + sigm(x1.x) * bflo(pp.z); o1.y = bfhi(hh.z) + sigm(x1.y) * bfhi(pp.z); o1.z = bflo(hh.w) + sigm(x1.z) * bflo(pp.w); o1.w = bfhi(hh.w) + sigm(x1.w) * bfhi(pp.w);
        v4u ob; ob.x = pk2(o0.x, o0.y); ob.y = pk2(o0.z, o0.w); ob.z = pk2(o1.x, o1.y); ob.w = pk2(o1.z, o1.w); *(v4u*)(xb + off) = ob;
        if (outf) { *(f32x4*)(outf + off) = o0; *(f32x4*)(outf + off + 4) = o1; }
    }
}

constexpr int N_PHASES = 22;
enum { OP_INPROJ = 0, OP_MIXA, OP_MIXB, OP_MIXC, OP_OUTPROJ, OP_LN1, OP_UP, OP_DOWN, OP_LN2, OP_GATE, OP_COMBINE };
enum { GK_LN = 0, GK_BF16 = 1, GK_SQRELU = 2, GK_COMB = 3 };
__global__ void __launch_bounds__(NTHR, 2) mk_fwd(Args a_in) {
    extern __shared__ __attribute__((aligned(16))) unsigned char lds_raw[];
    LAS unsigned char* lds = (LAS unsigned char*)lds_raw;
    ArgsP kp = (ArgsP)__builtin_amdgcn_kernarg_segment_ptr();
    const int lo = a_in.ph_lo, hi = a_in.ph_hi;
    int wv0; { const int wtmp = (int)threadIdx.x >> 6; asm volatile("s_nop 4\n\tv_readfirstlane_b32 %0, %1\n\ts_nop 4" : "=s"(wv0) : "v"(wtmp)); }
#if MK_N_LAUNCHES == 1
    volatile LAS unsigned* xst = (volatile LAS unsigned*)(lds + LDS_CTL_OFF);
    if (threadIdx.x < 2) xst[threadIdx.x] = 0u;
    __syncthreads();
    XcdBarrier bar = xcd_barrier_post((unsigned*)(a_in.ws + WS_CTL) + 4096, xst);
#endif
    int p = lo; asm volatile("" : "+s"(p));
#pragma unroll 1
    for (; p < hi; ) {
      int nrep = 1;
      if (PROBE_MASK) { const int L_ = p <= 11 ? 0 : 1; const int q_ = p == 0 ? -1 : (L_ == 0 ? p - 1 : (p - 12 < 3 ? p - 12 : p - 11));
        int grp; if (p == 0) grp = 0; else if (q_ == OP_INPROJ || q_ == OP_UP) grp = 1; else if (q_ == OP_OUTPROJ || q_ == OP_DOWN || q_ == OP_GATE) grp = 2; else if (q_ == OP_LN1 || q_ == OP_LN2 || q_ == OP_COMBINE) grp = 3; else grp = (L_ == 0) ? 4 : 5;
        if ((PROBE_MASK >> grp) & 1) nrep = 2; }
      if (p == PROBE_P) nrep = 2;
#pragma unroll 1
      for (int rep = 0; rep < nrep; ++rep) {
        int pp = p; asm volatile("" : "+s"(pp));
        int wvs = wv0; asm volatile("" : "+s"(wvs));
        unsigned ones = ~0u; asm volatile("" : "+s"(ones));
        int tid = (wvs << 6) | (int)__builtin_amdgcn_mbcnt_hi(ones, __builtin_amdgcn_mbcnt_lo(ones, 0u)); asm volatile("" : "+v"(tid));
        int bx = blockIdx.x; asm volatile("" : "+s"(bx));
        int G = gridDim.x; asm volatile("" : "+s"(G));
        ArgsP a = kp; asm volatile("" : "+s"(a));
#define MK_VCU ((G % 8 == 0) ? (bx % 8) * (G / 8) + bx / 8 : bx)
#define MK_WAVE (__builtin_amdgcn_readfirstlane(tid >> 6))
#define MK_GW (MK_VCU * NWAVES + MK_WAVE)
#define MK_NGW (G * NWAVES)
#define MK_LANE (tid & 63)
        unsigned char* ws = a->ws;
        if (pp == 0) {
phase_convert(a, lds, MK_GW, MK_NGW, MK_WAVE, MK_LANE); }
        else {
            const int L = pp <= 11 ? 0 : 1; const int q = L == 0 ? pp - 1 : (pp - 12 < 3 ? pp - 12 : pp - 11);
            bf16* xb = (bf16*)(ws + WS_XB); bf16* mixb = (bf16*)(ws + WS_MIX); bf16* hb = (bf16*)(ws + WS_H); bf16* h2b = (bf16*)(ws + WS_H2); bf16* pwb = (bf16*)(ws + WS_PW);
            bf16* projb = (bf16*)(ws + WS_PROJ); bf16* upb = (bf16*)(ws + WS_PROJ);
            bf16* vbb = (bf16*)(ws + WS_PART0); float* stb = (float*)(ws + WS_PART0 + 34 * MiB); float* part1 = (float*)(ws + WS_PART1); float* gatesb = (float*)(ws + WS_GATES);
            if (q == OP_MIXA) { if (L == 0) phase_mixer_even(a, lds, MK_VCU, G, tid); else phase_mixer_odd(a, lds, MK_VCU, G, tid); }
            else if (q == OP_MIXB) { if (L == 0) phase_mixer_even_b(a, lds, MK_VCU, G, tid); else phase_mixer_odd_b(a, lds, MK_VCU, G, tid); }
            else if (q == OP_MIXC) { phase_mixer_even_c(a, lds, MK_VCU, G, tid); }
            else if (q == OP_LN1) phase_ln(vbb, stb, part1, xb, a->in[I_LN1G] + L * D, a->in[I_LN1B] + L * D, hb, lds, MK_VCU, G, tid);
            else if (q == OP_LN2) phase_ln(vbb, stb, part1, hb, a->in[I_LN2G] + L * D, a->in[I_LN2B] + L * D, h2b, lds, MK_VCU, G, tid);
            else if (q == OP_COMBINE) phase_combine(part1, h2b, pwb, xb, L == 1 ? a->out + O_Y : nullptr, MK_VCU, G, tid);
            else {
                for (int sub = 0; sub < (q == OP_INPROJ ? 2 : 1); ++sub) {
                    const bf16* A; const bf16* Bt; int N, K, kind; void* out = nullptr; float* gp = nullptr; const bf16* resid = nullptr; int corder = bx, gorder = G;
                    const int busy_in = ((M / 256) * (NPROJ_PAD / 256)) % 256;
                    if (q == OP_INPROJ && sub == 0) { A = xb; Bt = (const bf16*)(ws + (L == 0 ? WS_WINE : WS_WINO)); N = NPROJ_PAD; K = D; kind = GK_BF16; out = projb; gp = gatesb; }
                    else if (q == OP_INPROJ) { A = (const bf16*)(ws + WS_PB) + (size_t)L * M * PLE; Bt = (const bf16*)(ws + WS_WPLE) + (size_t)L * PLE * D; N = D; K = PLE; kind = GK_BF16; out = pwb;
                        gorder = G - busy_in; corder = (bx >= busy_in) ? bx - busy_in : 1 << 20; }
                    else if (q == OP_OUTPROJ) { A = mixb; Bt = (const bf16*)(ws + (L == 0 ? WS_WOUTE : WS_WOUTO)); N = D; K = D; kind = GK_LN; resid = xb; }
                    else if (q == OP_UP) { A = hb; Bt = (const bf16*)(ws + WS_WUP) + (size_t)L * D * FF; N = FF; K = D; kind = GK_SQRELU; out = upb; }
                    else if (q == OP_DOWN) { A = upb; Bt = (const bf16*)(ws + WS_WDOWN) + (size_t)L * D * FF; N = D; K = FF; kind = GK_LN; resid = hb; }
                    else { A = h2b; Bt = (const bf16*)(ws + WS_WGATE) + (size_t)L * D * D; N = D; K = D; kind = GK_COMB; }
                    pg8::Gemm g{A, Bt, M, N, K};
                    if (kind == GK_LN) { pg8::MainSplit SK; SK.init(K, MK_VCU); pg8::EpiLnStat E{vbb, stb, resid, part1, N, M, DN_ALPHA}; pg8::gemm_phase<pg8::EpiLnStat, pg8::MainSplit, true, true>(lds, g, SK, E, tid); }
                    else if (kind == GK_COMB) { pg8::MainSplit SK; SK.init(K, MK_VCU); pg8::EpiCombine E{h2b, pwb, xb, L == 1 ? a->out + O_Y : nullptr, part1, N}; pg8::gemm_phase<pg8::EpiCombine, pg8::MainSplit, true, true>(lds, g, SK, E, tid); }
                    else if (kind == GK_BF16) { pg8::StaticOrder S; S.init(M, N, K, gorder, corder); pg8::EpiBf16<0> E{(bf16*)out, N, gp, 24}; pg8::gemm_phase<pg8::EpiBf16<0>, pg8::StaticOrder, true, true>(lds, g, S, E, tid);}
                    else { pg8::StaticOrder S; S.init(M, N, K, G, corder); pg8::EpiBf16<1> E{(bf16*)out, N, nullptr, -1}; pg8::gemm_phase<pg8::EpiBf16<1>, pg8::StaticOrder, true, true>(lds, g, S, E, tid);}
                }
                if (q == OP_INPROJ || q == OP_UP) {
                    const int busy = (q == OP_INPROJ) ? ((M / 256) * (NPROJ_PAD / 256)) % 256 : ((M / 256) * (FF / 256)) % 256;
                    const int first = (q == OP_INPROJ) ? (L == 0 ? 0 : cv::R_SCAN) : (L == 0 ? cv::R_IN1 : cv::R_UP0), last = (q == OP_INPROJ) ? (L == 0 ? cv::R_IN0 : cv::R_IN1) : (L == 0 ? cv::R_UP0 : cv::N_REST);
                    if (G == 256 && bx >= busy) { const int w_ = MK_WAVE; convert_range(a, (LAS float*)(lds + w_ * 16384), first, last, (bx - busy) * NWAVES + w_, (G - busy) * NWAVES, MK_LANE); }
                }
            }
        }
#if MK_N_LAUNCHES == 1
        if (p + 1 < hi || rep + 1 < nrep) xcd_barrier(bar);
#endif
      }
      asm volatile("s_add_i32 %0, %0, 1" : "+s"(p) : : "scc");
    }
}

extern "C" void kernel_launch(void* const* d_in, const int* in_sizes, int n_in, void* d_out, int out_size, void* d_ws, size_t ws_size, hipStream_t stream) {
    static int grid = 0;
    if (grid == 0) {
        if (n_in != 35 || (size_t)out_size != O_END || ws_size < WS_END) { fprintf(stderr, "kernel_launch: unexpected shapes: n_in %d out %d (want %zu) ws %zu (want %zu)\n", n_in, out_size, (size_t)O_END, ws_size, (size_t)WS_END); grid = -1; return; }
        int dev = 0, cus = 0, per_cu = 0;
        hipGetDevice(&dev); hipDeviceGetAttribute(&cus, hipDeviceAttributeMultiprocessorCount, dev);
        if (hipFuncSetAttribute((const void*)mk_fwd, hipFuncAttributeMaxDynamicSharedMemorySize, LDS_BYTES) != hipSuccess) { fprintf(stderr, "kernel_launch: hipFuncSetAttribute failed\n"); grid = -1; return; }
        if (hipOccupancyMaxActiveBlocksPerMultiprocessor(&per_cu, (const void*)mk_fwd, NTHR, LDS_BYTES) != hipSuccess || per_cu < 1) { fprintf(stderr, "kernel_launch: occupancy query says %d\n", per_cu); per_cu = 1; }
        (void)hipGetLastError();
        if (cus != 256) { fprintf(stderr, "kernel_launch: built for a 256-CU device (N = 2048 GEMM schedule), got %d\n", cus); grid = -1; return; }
        grid = cus * 1;
    }
    if (grid < 0) return;
    Args a{};
    for (int i = 0; i < 35; ++i) a.in[i] = (const float*)d_in[i];
    a.out = (float*)d_out; a.ws = (unsigned char*)d_ws;
#if MK_N_LAUNCHES == 1
    hipMemsetAsync((char*)d_ws + WS_CTL, 0, 1 * MiB, stream);
    a.ph_lo = 0; a.ph_hi = N_PHASES;
    hipLaunchKernelGGL(mk_fwd, dim3(grid), dim3(NTHR), LDS_BYTES, stream, a);
#else
    for (int p = 0; p < N_PHASES; ++p) {
        a.ph_lo = p; a.ph_hi = p + 1;
        hipLaunchKernelGGL(mk_fwd, dim3(grid), dim3(NTHR), LDS_BYTES, stream, a);
    }
#endif
}
```

```cpp
#include <hip/hip_runtime.h>
#include <hip/hip_cooperative_groups.h>
#include <cstdio>
#include <cstdint>
namespace cg = cooperative_groups;

#ifndef PROBE_MASK
#define PROBE_MASK 0
#endif
#define PROBE_P (-1)
#define PROBE_SUB 0
#ifndef MK_N_LAUNCHES
#define MK_N_LAUNCHES 1
#endif

namespace pg8 {
#define PG8_LAS __attribute__((address_space(3)))
typedef unsigned short bf16_t;
typedef short bf16x8 __attribute__((ext_vector_type(8)));
typedef float f32x4 __attribute__((ext_vector_type(4)));
typedef unsigned u32x4 __attribute__((ext_vector_type(4)));
constexpr int BM = 256, BK = 64, HALF = 128, HTB = HALF * BK * 2, STAGE_BYTES = 8 * HTB, NXCD = 8, WGM = 8;

__host__ __device__ __forceinline__ int lds_byte(int r, int c) { const int st = (r >> 4) * 2 + (c >> 5), rr = r & 15, cc = c & 31, ob = rr * 64 + cc * 2; return st * 1024 + (ob ^ (((ob >> 9) & 1) << 5)); }
__host__ __device__ __forceinline__ void stage_rc(int b, int& R, int& C) { const int st = b / 1024, sb = b % 1024, swz = sb ^ (((sb >> 9) & 1) << 5); R = (st >> 1) * 16 + swz / 64; C = (st & 1) * 32 + (swz % 64) / 2; }
__host__ __device__ __forceinline__ int perm32(int rho) { const int n = rho >> 4, i = rho & 15; return 8 * (i >> 2) + 4 * n + (i & 3); }

struct Unit { int pm, pn, kt0, nkt, dst; };
struct Gemm { const bf16_t* A; const bf16_t* Bt; int M, N, K; };

struct StaticOrder {
    int nM, nN, nwg, G, c, T;
    __host__ __device__ void init(int M, int N, int K, int G_, int c_) { nM = M / BM; nN = N / BM; nwg = nM * nN; G = G_; c = c_; T = K / BK; }
    __host__ __device__ bool next(int i, Unit& u) const {
        const long L = (long)i * G + c; if (L >= nwg) return false;
        int wgid = (int)L; { const int q = nwg / NXCD, r = nwg % NXCD, xcd = wgid % NXCD, off = wgid / NXCD; wgid = (xcd < r ? xcd * (q + 1) : r * (q + 1) + (xcd - r) * q) + off; }
        const int nig = WGM * nN, gid = wgid / nig, fm = gid * WGM, gsz = (nM - fm) < WGM ? (nM - fm) : WGM;
        u.pm = fm + ((wgid % nig) % gsz); u.pn = (wgid % nig) / gsz; u.kt0 = 0; u.nkt = T; u.dst = 0; return true;
    }
    __device__ __forceinline__ void a_ready(const Unit&) const {}
    __device__ __forceinline__ void done(const Unit&) const {}
};
struct StreamK {
    int nN, T, P, ntot, c;
    __host__ __device__ void init(int M, int N, int K, int G, int c_) { nN = N / BM; T = K / BK; ntot = (M / BM) * nN * T; P = (((ntot + G - 1) / G) + 1) & ~1; c = c_; }
    __host__ __device__ bool next(int i, Unit& u) const {
        int s = c * P; const int e = (s + P < ntot) ? s + P : ntot;
        for (int k = 0; ; ++k) { if (s >= e) return false; const int tile = s / T, kt0 = s - tile * T; const int n = (T - kt0 < e - s) ? T - kt0 : e - s;
            if (k == i) { u.pm = tile / nN; u.pn = tile - u.pm * nN; u.kt0 = kt0; u.nkt = n; u.dst = kt0 ? 1 : 0; return true; }
            s += n; }
    }
    __device__ __forceinline__ void a_ready(const Unit&) const {}
    __device__ __forceinline__ void done(const Unit&) const {}
};
struct MainSplit {
    int T, c;
    __host__ __device__ void init(int K, int c_) { T = K / BK; c = c_; }
    __host__ __device__ bool next(int i, Unit& u) const {
        if (i == 0) { u.pm = c >> 3; u.pn = c & 7; u.kt0 = 0; u.nkt = T; u.dst = 0; return true; }
        if (i == 1) { const int lt = c >> 4, j = c & 15; u.pm = 32 + (lt >> 3); u.pn = lt & 7; u.nkt = T >> 4; u.kt0 = j * u.nkt; u.dst = 1 + j; return true; }
        return false;
    }
    __device__ __forceinline__ void a_ready(const Unit&) const {}
    __device__ __forceinline__ void done(const Unit&) const {}
};
__host__ __device__ __forceinline__ bool split_tile(int tile, int T, int P) { return (tile * T) / P != ((tile + 1) * T - 1) / P; }

typedef __bf16 hwbf16x2 __attribute__((ext_vector_type(2)));
typedef float hwf32x2 __attribute__((ext_vector_type(2)));
__device__ __forceinline__ unsigned cvt_pk_bf16(float lo, float hi) { return __builtin_bit_cast(unsigned, __builtin_convertvector((hwf32x2){lo, hi}, hwbf16x2)); }

__device__ __forceinline__ float pg_bflo(unsigned w) { return __builtin_bit_cast(float, w << 16); }
__device__ __forceinline__ float pg_bfhi(unsigned w) { return __builtin_bit_cast(float, w & 0xffff0000u); }
__device__ __forceinline__ void store_chunk(const f32x4 (&acc)[2][2][4][2], const Unit& u, float* C1, int ldc, int wr, int wc, int fr, int fq) {
    const int row0 = u.pm * BM + wr * 64 + fr, col0 = u.pn * BM + wc * 32 + 8 * fq; bf16_t* Cb = (bf16_t*)C1 + ((long)(u.dst - 1) * 512 - 8192) * (long)ldc;
#pragma unroll
    for (int ai = 0; ai < 2; ++ai)
#pragma unroll
        for (int m = 0; m < 4; ++m) { bf16_t* rowp = Cb + (size_t)(row0 + ai * HALF + m * 16) * ldc + col0;
#pragma unroll
            for (int bj = 0; bj < 2; ++bj) { const f32x4 v0 = acc[ai][bj][m][0], v1 = acc[ai][bj][m][1];
                u32x4 w; w.x = cvt_pk_bf16(v0[0], v0[1]); w.y = cvt_pk_bf16(v0[2], v0[3]); w.z = cvt_pk_bf16(v1[0], v1[1]); w.w = cvt_pk_bf16(v1[2], v1[3]);
                *(u32x4*)(rowp + bj * HALF) = w; } }
}
struct EpiLnStat {
    static constexpr bool PERM = true, AFTER_DRAIN = false;
    bf16_t* VB; float* ST; const bf16_t* resid; float* C1; int ldc; int mrows; float alpha;
    __device__ __forceinline__ void operator()(const f32x4 (&acc)[2][2][4][2], const Unit& u, int wr, int wc, int fr, int fq) const {
        if (u.dst) { store_chunk(acc, u, C1, ldc, wr, wc, fr, fq); return; }
        const int row0 = u.pm * BM + wr * 64 + fr, col0 = u.pn * BM + wc * 32 + 8 * fq;
        u32x4 rq[2];
#pragma unroll
        for (int bj = 0; bj < 2; ++bj) rq[bj] = *(const u32x4*)(resid + (size_t)(row0) * ldc + col0 + bj * HALF);
#pragma unroll
        for (int idx = 0; idx < 8; ++idx) { const int ai = idx >> 2, m = idx & 3; const int row = row0 + ai * HALF + m * 16; float s = 0.f, ss = 0.f;
                u32x4 rc[2] = {rq[0], rq[1]};
                if (idx + 1 < 8) { const int nrow = row0 + ((idx + 1) >> 2) * HALF + ((idx + 1) & 3) * 16;
#pragma unroll
                    for (int bj = 0; bj < 2; ++bj) rq[bj] = *(const u32x4*)(resid + (size_t)nrow * ldc + col0 + bj * HALF); }
#pragma unroll
                for (int bj = 0; bj < 2; ++bj) { const size_t off = (size_t)row * ldc + col0 + bj * HALF; const u32x4 r = rc[bj];
                    f32x4 v0 = acc[ai][bj][m][0], v1 = acc[ai][bj][m][1];
                    v0[0] += alpha * pg_bflo(r.x); v0[1] += alpha * pg_bfhi(r.x); v0[2] += alpha * pg_bflo(r.y); v0[3] += alpha * pg_bfhi(r.y);
                    v1[0] += alpha * pg_bflo(r.z); v1[1] += alpha * pg_bfhi(r.z); v1[2] += alpha * pg_bflo(r.w); v1[3] += alpha * pg_bfhi(r.w);
                    s += ((v0[0] + v0[1]) + (v0[2] + v0[3])) + ((v1[0] + v1[1]) + (v1[2] + v1[3]));
                    ss += ((v0[0] * v0[0] + v0[1] * v0[1]) + (v0[2] * v0[2] + v0[3] * v0[3])) + ((v1[0] * v1[0] + v1[1] * v1[1]) + (v1[2] * v1[2] + v1[3] * v1[3]));
                    u32x4 w; w.x = cvt_pk_bf16(v0[0], v0[1]); w.y = cvt_pk_bf16(v0[2], v0[3]); w.z = cvt_pk_bf16(v1[0], v1[1]); w.w = cvt_pk_bf16(v1[2], v1[3]);
                    *(u32x4*)(VB + off) = w; }
                s += __shfl_xor(s, 16); s += __shfl_xor(s, 32); ss += __shfl_xor(ss, 16); ss += __shfl_xor(ss, 32);
                if (fq == 0) { float* sp = ST + (((size_t)u.pn * mrows + row) * 4 + wc) * 2; sp[0] = s; sp[1] = ss; } }
    }
};
struct EpiCombine {
    static constexpr bool PERM = true, AFTER_DRAIN = false;
    const bf16_t* h2; const bf16_t* pw; bf16_t* xb; float* outf; float* C1; int ldc;
    __device__ __forceinline__ void operator()(const f32x4 (&acc)[2][2][4][2], const Unit& u, int wr, int wc, int fr, int fq) const {
        if (u.dst) { store_chunk(acc, u, C1, ldc, wr, wc, fr, fq); return; }
        const int row0 = u.pm * BM + wr * 64 + fr, col0 = u.pn * BM + wc * 32 + 8 * fq;
        u32x4 hq[2], pq[2];
#pragma unroll
        for (int bj = 0; bj < 2; ++bj) { const size_t o0 = (size_t)row0 * ldc + col0 + bj * HALF; hq[bj] = *(const u32x4*)(h2 + o0); pq[bj] = *(const u32x4*)(pw + o0); }
#pragma unroll
        for (int idx = 0; idx < 8; ++idx) { const int ai = idx >> 2, m = idx & 3; const int row = row0 + ai * HALF + m * 16;
                u32x4 hc[2] = {hq[0], hq[1]}, pc[2] = {pq[0], pq[1]};
                if (idx + 1 < 8) { const int nrow = row0 + ((idx + 1) >> 2) * HALF + ((idx + 1) & 3) * 16;
#pragma unroll
                    for (int bj = 0; bj < 2; ++bj) { const size_t on = (size_t)nrow * ldc + col0 + bj * HALF; hq[bj] = *(const u32x4*)(h2 + on); pq[bj] = *(const u32x4*)(pw + on); } }
#pragma unroll
                for (int bj = 0; bj < 2; ++bj) { const size_t off = (size_t)row * ldc + col0 + bj * HALF; const u32x4 hh = hc[bj], pp = pc[bj];
                    const f32x4 a0 = acc[ai][bj][m][0], a1 = acc[ai][bj][m][1]; f32x4 o0, o1;
                    o0[0] = pg_bflo(hh.x) + pg_bflo(pp.x) / (1.f + __expf(-a0[0])); o0[1] = pg_bfhi(hh.x) + pg_bfhi(pp.x) / (1.f + __expf(-a0[1]));
                    o0[2] = pg_bflo(hh.y) + pg_bflo(pp.y) / (1.f + __expf(-a0[2])); o0[3] = pg_bfhi(hh.y) + pg_bfhi(pp.y) / (1.f + __expf(-a0[3]));
                    o1[0] = pg_bflo(hh.z) + pg_bflo(pp.z) / (1.f + __expf(-a1[0])); o1[1] = pg_bfhi(hh.z) + pg_bfhi(pp.z) / (1.f + __expf(-a1[1]));
                    o1[2] = pg_bflo(hh.w) + pg_bflo(pp.w) / (1.f + __expf(-a1[2])); o1[3] = pg_bfhi(hh.w) + pg_bfhi(pp.w) / (1.f + __expf(-a1[3]));
                    u32x4 w; w.x = cvt_pk_bf16(o0[0], o0[1]); w.y = cvt_pk_bf16(o0[2], o0[3]); w.z = cvt_pk_bf16(o1[0], o1[1]); w.w = cvt_pk_bf16(o1[2], o1[3]);
                    *(u32x4*)(xb + off) = w;
                    if (outf) { *(f32x4*)(outf + off) = o0; *(f32x4*)(outf + off + 4) = o1; } } }
    }
};
template <int ACT> struct EpiBf16 {
    static constexpr bool PERM = true, AFTER_DRAIN = false;
    bf16_t* O; int ldc; float* gates; int gate_pn;
    __device__ __forceinline__ void operator()(const f32x4 (&acc)[2][2][4][2], const Unit& u, int wr, int wc, int fr, int fq) const {
        const int row0 = u.pm * BM + wr * 64 + fr; const int col0 = u.pn * BM + wc * 32 + 8 * fq;
        const bool gt = (gates != nullptr) && (u.pn == gate_pn) && (wc == 0) && (fq < 2);
#pragma unroll
        for (int ai = 0; ai < 2; ++ai)
#pragma unroll
            for (int m = 0; m < 4; ++m) { const int row = row0 + ai * HALF + m * 16; bf16_t* rowp = O + (size_t)row * ldc + col0;
#pragma unroll
                for (int bj = 0; bj < 2; ++bj) { f32x4 v0 = acc[ai][bj][m][0], v1 = acc[ai][bj][m][1];
                    if (ACT == 1) {
#pragma unroll
                        for (int j = 0; j < 4; ++j) { const float a = fmaxf(v0[j], 0.f), b = fmaxf(v1[j], 0.f); v0[j] = a * a; v1[j] = b * b; } }
                    u32x4 w; w.x = cvt_pk_bf16(v0[0], v0[1]); w.y = cvt_pk_bf16(v0[2], v0[3]); w.z = cvt_pk_bf16(v1[0], v1[1]); w.w = cvt_pk_bf16(v1[2], v1[3]);
                    *(u32x4*)(rowp + bj * HALF) = w; }
                if (gt) { float* gp = gates + (size_t)row * 16 + 8 * fq; *(f32x4*)gp = acc[ai][0][m][0]; *(f32x4*)(gp + 4) = acc[ai][0][m][1]; } }
    }
};

template <class Epi, class Sched, bool ALIGN_EPI = false, bool SP2 = false>
__device__ __forceinline__ void gemm_phase(PG8_LAS unsigned char* lds, const Gemm g, const Sched& S, const Epi& E, const int tid) {
    const int wid = __builtin_amdgcn_readfirstlane(tid >> 6), lane = tid & 63, wr = wid >> 2, wc = wid & 3, fr = lane & 15, fq = lane >> 4;
    const int K = g.K;
    unsigned voffA[2], voffB[2];
#pragma unroll
    for (int i = 0; i < 2; ++i) { int R, C; stage_rc(tid * 16 + i * 8192, R, C); const int Rb = Epi::PERM ? ((R & ~31) + perm32(R & 31)) : R;
        voffA[i] = (unsigned)(R * K + C) * 2u; voffB[i] = (unsigned)(Rb * K + C) * 2u; }
    const size_t kstep = (size_t)(BK * 2);
    const size_t hstep = (size_t)HALF * K * 2;
    const size_t tstep = 2 * hstep;
    const unsigned ldsw = (unsigned)wid * 1024u;
    const int aoff = lds_byte(wr * 64 + fr, fq * 8), boff = lds_byte(wc * 32 + fr, fq * 8);
#define PG8_SA(b, h) (((b) * 2 + (h)) * HTB)
#define PG8_SB(b, h) ((4 + (b) * 2 + (h)) * HTB)
#define PG8_STAGE(bufoff, gbase, voff) do { _Pragma("unroll") for (int _i = 0; _i < 2; ++_i) \
        __builtin_amdgcn_global_load_lds((const unsigned*)((const char*)(gbase) + (voff)[_i]), (PG8_LAS unsigned*)(lds + (bufoff) + ldsw + _i * 8192), 16, 0, 0); } while (0)
#define PG8_LDA(dst, b, h) do { _Pragma("unroll") for (int m = 0; m < 4; ++m) _Pragma("unroll") for (int k = 0; k < 2; ++k) dst[m][k] = *(const PG8_LAS bf16x8*)(lds + PG8_SA(b, h) + aoff + m * 2048 + k * 1024); } while (0)
#define PG8_LDB(dst, b, h) do { _Pragma("unroll") for (int n = 0; n < 2; ++n) _Pragma("unroll") for (int k = 0; k < 2; ++k) dst[n][k] = *(const PG8_LAS bf16x8*)(lds + PG8_SB(b, h) + boff + n * 2048 + k * 1024); } while (0)
#define PG8_MMA(ai, bj, At, Bt) do { __builtin_amdgcn_s_setprio(1); _Pragma("unroll") for (int m = 0; m < 4; ++m) _Pragma("unroll") for (int n = 0; n < 2; ++n) _Pragma("unroll") for (int k = 0; k < 2; ++k) \
        acc[ai][bj][m][n] = __builtin_amdgcn_mfma_f32_16x16x32_bf16(Bt[n][k], At[m][k], acc[ai][bj][m][n], 0, 0, 0); __builtin_amdgcn_s_setprio(0); } while (0)
#define PG8_WAIT_V(n) asm volatile("s_waitcnt vmcnt(" #n ")" ::: "memory")
#define PG8_WAIT_L(n) asm volatile("s_waitcnt lgkmcnt(" #n ")" ::: "memory")
#define PG8_BAR __builtin_amdgcn_s_barrier()
#define PG8_SCHED __builtin_amdgcn_sched_barrier(0)
    Unit cur, nxt; int ui = 0;
    if (!S.next(0, cur)) return;
    f32x4 acc[2][2][4][2];
#pragma unroll
    for (int a = 0; a < 2; ++a)
#pragma unroll
        for (int b = 0; b < 2; ++b)
#pragma unroll
            for (int m = 0; m < 4; ++m)
#pragma unroll
                for (int n = 0; n < 2; ++n) acc[a][b][m][n] = (f32x4){0.f, 0.f, 0.f, 0.f};
    bf16x8 At[4][2], B0[2][2], B1[2][2];
    const char* cA = (const char*)g.A + (size_t)cur.pm * tstep + (size_t)cur.kt0 * kstep; const char* cB = (const char*)g.Bt + (size_t)cur.pn * tstep + (size_t)cur.kt0 * kstep;
    S.a_ready(cur);
    if constexpr (SP2) {
        PG8_STAGE(PG8_SB(0, 0), cB, voffB); PG8_STAGE(PG8_SB(0, 1), cB + hstep, voffB); PG8_STAGE(PG8_SA(0, 0), cA, voffA); PG8_STAGE(PG8_SA(0, 1), cA + hstep, voffA);
        if (wr == 1) PG8_BAR;
        PG8_WAIT_V(2); PG8_BAR;
        PG8_STAGE(PG8_SB(1, 0), cB + kstep, voffB); PG8_STAGE(PG8_SA(1, 0), cA + kstep, voffA); PG8_STAGE(PG8_SB(1, 1), cB + hstep + kstep, voffB);
        PG8_WAIT_V(6); PG8_BAR;
    } else {
        PG8_STAGE(PG8_SB(0, 0), cB, voffB); PG8_STAGE(PG8_SA(0, 0), cA, voffA); PG8_STAGE(PG8_SB(0, 1), cB + hstep, voffB); PG8_STAGE(PG8_SA(0, 1), cA + hstep, voffA);
        if (wr == 1) PG8_BAR;
        PG8_WAIT_V(4); PG8_BAR;
        PG8_STAGE(PG8_SB(1, 0), cB + kstep, voffB); PG8_STAGE(PG8_SA(1, 0), cA + kstep, voffA); PG8_STAGE(PG8_SB(1, 1), cB + hstep + kstep, voffB);
        PG8_WAIT_V(6); PG8_BAR;
    }
    for (;;) {
        const bool has_next = S.next(ui + 1, nxt);
        const char* nA = has_next ? (const char*)g.A + (size_t)nxt.pm * tstep + (size_t)nxt.kt0 * kstep : cA; const char* nB = has_next ? (const char*)g.Bt + (size_t)nxt.pn * tstep + (size_t)nxt.kt0 * kstep : cB;
        const int nt = cur.nkt;
        for (int t = 0; t < nt; t += 2) {
            const bool last = (t == nt - 2);
            const char* a1 = cA + (size_t)(t + 1) * kstep;
            const char* a2 = last ? nA : cA + (size_t)(t + 2) * kstep; const char* b2 = last ? nB : cB + (size_t)(t + 2) * kstep;
            const char* a3 = a2 + kstep; const char* b3 = b2 + kstep;
            if (last && has_next) S.a_ready(nxt);
            if constexpr (SP2) {
            PG8_LDB(B0, 0, 0); PG8_LDB(B1, 0, 1); PG8_SCHED; PG8_LDA(At, 0, 0); PG8_STAGE(PG8_SA(1, 1), a1 + hstep, voffA);
            PG8_WAIT_V(8); PG8_WAIT_L(0); PG8_BAR; PG8_MMA(0, 0, At, B0); PG8_MMA(0, 1, At, B1); PG8_BAR; PG8_SCHED;
            PG8_LDA(At, 0, 1); PG8_STAGE(PG8_SB(0, 0), b2, voffB); PG8_STAGE(PG8_SB(0, 1), b2 + hstep, voffB); PG8_STAGE(PG8_SA(0, 0), a2, voffA);
            PG8_WAIT_V(8); PG8_WAIT_L(0); PG8_BAR; PG8_MMA(1, 0, At, B0); PG8_MMA(1, 1, At, B1); PG8_BAR; PG8_SCHED;
            PG8_LDB(B0, 1, 0); PG8_LDB(B1, 1, 1); PG8_SCHED; PG8_LDA(At, 1, 0); PG8_STAGE(PG8_SA(0, 1), a2 + hstep, voffA);
            PG8_WAIT_V(8); PG8_WAIT_L(0); PG8_BAR; PG8_MMA(0, 0, At, B0); PG8_MMA(0, 1, At, B1); PG8_BAR; PG8_SCHED;
            PG8_LDA(At, 1, 1); PG8_STAGE(PG8_SB(1, 0), b3, voffB); PG8_STAGE(PG8_SB(1, 1), b3 + hstep, voffB); PG8_STAGE(PG8_SA(1, 0), a3, voffA);
            PG8_WAIT_V(8); PG8_WAIT_L(0); PG8_BAR; PG8_MMA(1, 0, At, B0); PG8_MMA(1, 1, At, B1); PG8_BAR; PG8_SCHED;
            } else {
            PG8_LDB(B0, 0, 0); PG8_SCHED; PG8_LDA(At, 0, 0); PG8_STAGE(PG8_SA(1, 1), a1 + hstep, voffA);
            PG8_WAIT_L(8); PG8_BAR; PG8_WAIT_L(0); PG8_MMA(0, 0, At, B0); PG8_BAR; PG8_SCHED;
            PG8_LDB(B1, 0, 1); PG8_STAGE(PG8_SB(0, 0), b2, voffB);
            PG8_BAR; PG8_WAIT_L(0); PG8_MMA(0, 1, At, B1); PG8_BAR;
            PG8_LDA(At, 0, 1); PG8_STAGE(PG8_SA(0, 0), a2, voffA);
            PG8_BAR; PG8_WAIT_L(0); PG8_MMA(1, 0, At, B0); PG8_BAR; PG8_SCHED;
            PG8_STAGE(PG8_SB(0, 1), b2 + hstep, voffB);
            PG8_WAIT_V(6); PG8_BAR; PG8_MMA(1, 1, At, B1); PG8_BAR;
            PG8_LDB(B0, 1, 0); PG8_SCHED; PG8_LDA(At, 1, 0); PG8_STAGE(PG8_SA(0, 1), a2 + hstep, voffA);
            PG8_WAIT_L(8); PG8_BAR; PG8_WAIT_L(0); PG8_MMA(0, 0, At, B0); PG8_BAR; PG8_SCHED;
            PG8_LDB(B1, 1, 1); PG8_STAGE(PG8_SB(1, 0), b3, voffB);
            PG8_BAR; PG8_WAIT_L(0); PG8_MMA(0, 1, At, B1); PG8_BAR;
            PG8_LDA(At, 1, 1); PG8_STAGE(PG8_SA(1, 0), a3, voffA);
            PG8_BAR; PG8_WAIT_L(0); PG8_MMA(1, 0, At, B0); PG8_BAR; PG8_SCHED;
            PG8_STAGE(PG8_SB(1, 1), b3 + hstep, voffB);
            PG8_WAIT_V(6); PG8_BAR; PG8_MMA(1, 1, At, B1); PG8_BAR;
            }
        }
        if constexpr (ALIGN_EPI) { if (wr == 0) PG8_BAR; }
        E(acc, cur, wr, wc, fr, fq); S.done(cur);
        if (!has_next) break;
#pragma unroll
        for (int a = 0; a < 2; ++a)
#pragma unroll
            for (int b = 0; b < 2; ++b)
#pragma unroll
                for (int m = 0; m < 4; ++m)
#pragma unroll
                    for (int n = 0; n < 2; ++n) acc[a][b][m][n] = (f32x4){0.f, 0.f, 0.f, 0.f};
        cur = nxt; cA = nA; cB = nB; ++ui;
        if constexpr (ALIGN_EPI) { if (wr == 1) PG8_BAR; }
    }
    PG8_WAIT_V(0);
    if constexpr (!ALIGN_EPI) { if (wr == 0) PG8_BAR; }
    PG8_BAR;
#undef PG8_SA
#undef PG8_SB
#undef PG8_STAGE
#undef PG8_LDA
#undef PG8_LDB
#undef PG8_MMA
#undef PG8_WAIT_V
#undef PG8_WAIT_L
#undef PG8_BAR
#undef PG8_SCHED
}
}

constexpr int NWAVES = 8, NTHR = 512;
constexpr int D = 2048, FF = 8192, PLE = 256;
constexpr int TP = 2048, BP = 4, TS = 4, BS = 128;
constexpr int MP = BP * TP, MS = BS * TS, M = MP + MS;
constexpr int NPROJ = 6160, NPROJ_PAD = 6400;
constexpr int NH = 8;
constexpr float LN_EPS = 1e-5f, RMS_EPS = 1e-6f;
constexpr float DN_ALPHA = 1.41421356237f;

constexpr size_t MiB = 1u << 20;
constexpr size_t WS_CTL = 0;
constexpr size_t WS_WINE = 1 * MiB;
constexpr size_t WS_WOUTE = WS_WINE + 25 * MiB;
constexpr size_t WS_WINO = WS_WOUTE + 8 * MiB;
constexpr size_t WS_WOUTO = WS_WINO + 25 * MiB;
constexpr size_t WS_WUP = WS_WOUTO + 8 * MiB;
constexpr size_t WS_WDOWN = WS_WUP + 64 * MiB;
constexpr size_t WS_WPLE = WS_WDOWN + 64 * MiB;
constexpr size_t WS_WGATE = WS_WPLE + 2 * MiB;
constexpr size_t WS_XB = WS_WGATE + 16 * MiB;
constexpr size_t WS_MIX = WS_XB + 34 * MiB;
constexpr size_t WS_H = WS_MIX + 34 * MiB;
constexpr size_t WS_H2 = WS_H + 34 * MiB;
constexpr size_t WS_PW = WS_H2 + 34 * MiB;
constexpr size_t WS_PB = WS_PW + 34 * MiB;
constexpr size_t WS_GATES = WS_PB + 9 * MiB;
constexpr size_t WS_PROJ = WS_GATES + 1 * MiB;
constexpr size_t WS_PART0 = WS_PROJ + 136 * MiB;
constexpr size_t WS_PART1 = WS_PART0 + 68 * MiB;
constexpr size_t WS_LRUW = WS_PART1 + 68 * MiB;
constexpr size_t WS_END = WS_LRUW + 1 * MiB;
constexpr size_t WS_DG = WS_PART0;
constexpr size_t WS_DB = WS_PART0 + 32 * MiB;
constexpr size_t WS_DS = WS_PART0 + 64 * MiB;
constexpr size_t WS_DQ = WS_PART0 + 96 * MiB;
constexpr size_t WS_DO = WS_PART0 + 112 * MiB;
constexpr size_t WS_DD = WS_PART0 + 128 * MiB;
constexpr size_t WS_DF = WS_PART0 + 129 * MiB;
constexpr size_t WS_MC = WS_PART0;
constexpr size_t WS_MN = WS_PART0 + 64 * MiB;
constexpr size_t WS_MM = WS_PART0 + 65 * MiB;
constexpr size_t WS_LRU_HL = WS_H;
constexpr size_t WS_LRU_P = WS_H + 16 * MiB;
constexpr size_t WS_LRU_END = WS_H + 32 * MiB;

constexpr size_t O_Y = 0;
constexpr size_t O_CONVP = (size_t)M * D;
constexpr size_t O_DELTAP = O_CONVP + (size_t)BP * 3 * 4096;
constexpr size_t O_LRUP = O_DELTAP + (size_t)BP * 8 * 128 * 128;
constexpr size_t O_MCP = O_LRUP + (size_t)BP * 1024;
constexpr size_t O_MNP = O_MCP + (size_t)BP * 8 * 256 * 128;
constexpr size_t O_MMP = O_MNP + (size_t)BP * 8 * 128;
constexpr size_t O_CONVS = O_MMP + (size_t)BP * 8;
constexpr size_t O_DELTAS = O_CONVS + (size_t)BS * 3 * 4096;
constexpr size_t O_LRUS = O_DELTAS + (size_t)BS * 8 * 128 * 128;
constexpr size_t O_MCS = O_LRUS + (size_t)BS * 1024;
constexpr size_t O_MNS = O_MCS + (size_t)BS * 8 * 256 * 128;
constexpr size_t O_MMS = O_MNS + (size_t)BS * 8 * 128;
constexpr size_t O_END = O_MMS + (size_t)BS * 8;

constexpr int LDS_BYTES = 147456;
constexpr int LDS_CTL_OFF = 131072;

#define LAS __attribute__((address_space(3)))
typedef unsigned short bf16;
typedef unsigned v4u __attribute__((ext_vector_type(4)));
typedef unsigned v2u __attribute__((ext_vector_type(2)));
typedef float f32x4 __attribute__((ext_vector_type(4)));
#define LDS_WAIT() asm volatile("s_waitcnt lgkmcnt(0)" ::: "memory")
#define LDS_BARRIER() do { asm volatile("s_waitcnt lgkmcnt(0)" ::: "memory"); __builtin_amdgcn_s_barrier(); asm volatile("" ::: "memory"); } while (0)
__device__ __forceinline__ unsigned pk2(float lo, float hi) { return pg8::cvt_pk_bf16(lo, hi); }
__device__ __forceinline__ unsigned f2bf(float f) { return pg8::cvt_pk_bf16(f, 0.f) & 0xffffu; }
__device__ __forceinline__ float bf2f(unsigned short b) { return __builtin_bit_cast(float, ((unsigned)b) << 16); }
__device__ __forceinline__ float bflo(unsigned w) { return __builtin_bit_cast(float, w << 16); }
__device__ __forceinline__ float bfhi(unsigned w) { return __builtin_bit_cast(float, w & 0xffff0000u); }
__device__ __forceinline__ float fexp(float x) { return __builtin_amdgcn_exp2f(x * 1.4426950408889634f); }
__device__ __forceinline__ float sigm(float x) { return __builtin_amdgcn_rcpf(1.f + fexp(-x)); }
__device__ __forceinline__ float siluf(float x) { return x * sigm(x); }
__device__ __forceinline__ float softplusf(float x) { return fmaxf(x, 0.f) + log1pf(expf(-fabsf(x))); }
__device__ __forceinline__ float logsigf(float x) { return -softplusf(-x); }
__device__ __forceinline__ float neg_expm1(float y) {
    const float ser = -y * (1.f + y * (0.5f + y * (0.16666667f + y * (0.041666668f + y * (0.008333334f + y * 0.0013888889f)))));
    return (y > -0.25f) ? ser : 1.f - fexp(y);
}
__device__ __forceinline__ float gelu_tanh(float x) { const float u = 0.7978845608028654f * (x + 0.044715f * x * x * x); return x * sigm(2.f * u); }
__device__ __forceinline__ float wave_sum(float v) {
#pragma unroll
    for (int o = 1; o < 64; o <<= 1) v += __shfl_xor(v, o);
    return v;
}

__device__ __forceinline__ float wave_incl_sum(float v, int lane) {
#pragma unroll
    for (int o = 1; o < 64; o <<= 1) { const float u = __shfl_up(v, o); if (lane >= o) v += u; }
    return v;
}
__device__ __forceinline__ float wave_incl_max(float v, int lane) {
#pragma unroll
    for (int o = 1; o < 64; o <<= 1) { const float u = __shfl_up(v, o); if (lane >= o) v = fmaxf(v, u); }
    return v;
}
__device__ __forceinline__ float wave_max(float v) {
#pragma unroll
    for (int o = 1; o < 64; o <<= 1) v = fmaxf(v, __shfl_xor(v, o));
    return v;
}
#define XB_TMO      128
#define XB_XCNT(j)  (256  + 64 * (j))
#define XB_XSUB(j)  (1280 + 64 * (j))
#define XB_XGEN(j)  (2304 + 64 * (j))
#define XB_TOP      3328
#define XB_TOPGEN   3392
#define XCD_BAR_WORDS 3456
#define XB_SPIN_CAP (1u << 22)
__device__ __forceinline__ unsigned xb_ld(unsigned* p)              { return __hip_atomic_load(p, __ATOMIC_RELAXED, __HIP_MEMORY_SCOPE_AGENT); }
__device__ __forceinline__ unsigned xb_add(unsigned* p, unsigned v) { return __hip_atomic_fetch_add(p, v, __ATOMIC_RELAXED, __HIP_MEMORY_SCOPE_AGENT); }
__device__ __forceinline__ unsigned xb_xcc_id() { return (unsigned)__builtin_amdgcn_s_getreg((3 << 11) | 20) & 0xFu; }
#define XB_SPIN(cond, bar) do { unsigned _sp = 0; while (cond) { __builtin_amdgcn_s_sleep(1); \
    if ((++_sp & 255u) == 0u) { if (xb_ld(&(bar)[XB_TMO])) break; if (_sp > XB_SPIN_CAP) { atomicAdd(&(bar)[XB_TMO], 1u); break; } } } } while (0)
struct XcdBarrier { unsigned* bar; unsigned x; volatile LAS unsigned* st; };
__device__ __forceinline__ XcdBarrier xcd_barrier_post(unsigned* bar, volatile LAS unsigned* st) {
    XcdBarrier b; b.bar = bar; b.x = xb_xcc_id(); b.st = st;
    if (threadIdx.x == 0) (void)xb_add(&bar[XB_XCNT(b.x)], 1u);
    return b;
}
__device__ __forceinline__ void xcd_barrier_complete(unsigned* bar, unsigned x, unsigned& nloc, unsigned& nx) {
    const unsigned G = gridDim.x * gridDim.y * gridDim.z;
    unsigned sum, cnt, mine, sp = 0u;
    for (;;) {
        sum = 0u; cnt = 0u; mine = 0u;
#pragma unroll
        for (unsigned j = 0; j < 16; ++j) { const unsigned c = xb_ld(&bar[XB_XCNT(j)]); sum += c; cnt += (c > 0u) ? 1u : 0u; mine = (j == x) ? c : mine; }
        if (sum == G) break;
        __builtin_amdgcn_s_sleep(1);
        if ((++sp & 255u) == 0u) { if (xb_ld(&bar[XB_TMO])) break; if (sp > XB_SPIN_CAP) { atomicAdd(&bar[XB_TMO], 1u); break; } }
    }
    nloc = mine > 0u ? mine : 1u; nx = cnt > 0u ? cnt : 1u;
}
__device__ __forceinline__ void xcd_barrier(const XcdBarrier& b) {
    asm volatile("s_waitcnt vmcnt(0)" ::: "memory");
    __syncthreads();
    if (threadIdx.x == 0) {
        unsigned* bar = b.bar;
        __builtin_amdgcn_s_waitcnt(0);
        unsigned nloc = b.st[0], nx = b.st[1];
        if (nloc == 0u) { xcd_barrier_complete(bar, b.x, nloc, nx); b.st[0] = nloc; b.st[1] = nx; }
        const unsigned old = xb_add(&bar[XB_XSUB(b.x)], 1u);
        const unsigned gen = old / nloc;
        if (old + 1u == (gen + 1u) * nloc) {
            __builtin_amdgcn_fence(__ATOMIC_RELEASE, "agent");
            asm volatile("s_waitcnt vmcnt(0)" ::: "memory");
            const unsigned og = xb_add(&bar[XB_TOP], 1u);
            const unsigned tg = og / nx;
            if (og + 1u == (tg + 1u) * nx) xb_add(&bar[XB_TOPGEN], 1u);
            else XB_SPIN(xb_ld(&bar[XB_TOPGEN]) == tg, bar);
            __builtin_amdgcn_fence(__ATOMIC_ACQUIRE, "agent");
            xb_add(&bar[XB_XGEN(b.x)], 1u);
            asm volatile("s_waitcnt vmcnt(0)" ::: "memory");
        } else {
            XB_SPIN(xb_ld(&bar[XB_XGEN(b.x)]) == gen, bar);
            __builtin_amdgcn_fence(__ATOMIC_ACQUIRE, "agent");
            asm volatile("s_waitcnt vmcnt(0)" ::: "memory");
        }
    }
    __syncthreads();
}

struct Args { const float* in[35]; float* out; unsigned char* ws; int ph_lo, ph_hi; };
typedef const __attribute__((address_space(4))) Args* ArgsP;
enum { I_XP = 0, I_XS, I_PP, I_PS, I_SCONV, I_SDELTA, I_SLRU, I_SMC, I_SMN, I_SMM, I_WINE, I_WCONV, I_BCONV, I_ALOG, I_DTB, I_DNORM, I_LWR, I_LBR, I_LWI, I_LBI, I_LLAM, I_WOUTE,
       I_WINO, I_BIG, I_BFG, I_MNORM, I_WOUTO, I_LN1G, I_LN1B, I_LN2G, I_LN2B, I_WUP, I_WDOWN, I_WPLE, I_WGATE };

struct TDesc { const float* W; bf16* WT; int K, N, Npad, item; };
__device__ __forceinline__ void t_load(const TDesc& d, int lane, f32x4 (&v)[8]) {
    const int nblk = d.Npad / 32, kb = d.item / nblk, nb = d.item % nblk, k0 = 64 * kb, n0 = 32 * nb;
    const int r8 = lane >> 3, c4 = lane & 7; const bool ok = (n0 + 4 * c4) < d.N;
#pragma unroll
    for (int i = 0; i < 8; ++i) v[i] = ok ? __builtin_nontemporal_load((const f32x4*)(d.W + (size_t)(k0 + 8 * r8 + i) * d.N + n0 + 4 * c4)) : (f32x4){0.f, 0.f, 0.f, 0.f};
}
__device__ __forceinline__ void t_finish(const TDesc& d, LAS float*  , int lane, const f32x4 (&v)[8]) {
    const int nblk = d.Npad / 32, kb = d.item / nblk, nb = d.item % nblk, k0 = 64 * kb, n0 = 32 * nb;
    const int r8 = lane >> 3, c4 = lane & 7;
    bf16* o = d.WT + (size_t)(n0 + 4 * c4) * d.K + k0 + 8 * r8;
    *(v4u*)(o) = (v4u){pk2(v[0].x, v[1].x), pk2(v[2].x, v[3].x), pk2(v[4].x, v[5].x), pk2(v[6].x, v[7].x)};
    *(v4u*)(o + (size_t)d.K) = (v4u){pk2(v[0].y, v[1].y), pk2(v[2].y, v[3].y), pk2(v[4].y, v[5].y), pk2(v[6].y, v[7].y)};
    *(v4u*)(o + 2 * (size_t)d.K) = (v4u){pk2(v[0].z, v[1].z), pk2(v[2].z, v[3].z), pk2(v[4].z, v[5].z), pk2(v[6].z, v[7].z)};
    *(v4u*)(o + 3 * (size_t)d.K) = (v4u){pk2(v[0].w, v[1].w), pk2(v[2].w, v[3].w), pk2(v[4].w, v[5].w), pk2(v[6].w, v[7].w)};
}
__device__ __forceinline__ void p0_transpose_item(const float* W, int K, int N, int Npad, bf16* WT, LAS float* scr, int item, int lane) {
    const TDesc d{W, WT, K, N, Npad, item}; f32x4 v[8]; t_load(d, lane, v); t_finish(d, scr, lane, v);
}
template <int N> __device__ __forceinline__ void row_to_bf16(const float* src, bf16* dst, int lane) {
    f32x4 v[N / 256];
#pragma unroll
    for (int j = 0; j < N / 256; ++j) v[j] = __builtin_nontemporal_load((const f32x4*)(src + j * 256 + lane * 4));
#pragma unroll
    for (int j = 0; j < N / 256; ++j) { v2u o; o.x = pk2(v[j].x, v[j].y); o.y = pk2(v[j].z, v[j].w); *(v2u*)(dst + j * 256 + lane * 4) = o; }
}
namespace cv { constexpr int I_IN = (D / 64) * (NPROJ_PAD / 32), I_SQ = (D / 64) * (D / 32), I_UP = (D / 64) * (FF / 32), I_DN = (FF / 64) * (D / 32), I_PL = (PLE / 64) * (D / 32);
               constexpr int N_FIRST = I_IN + I_PL + 128, N_REST = I_IN + 2 * I_SQ + 2 * I_UP + 2 * I_DN + I_PL + 2 * I_SQ;
               constexpr int R_IN0 = 6200;
               constexpr int R_G1 = I_SQ + I_UP + I_SQ + I_IN + I_SQ + I_PL + I_SQ;
               constexpr int R_IN1 = R_G1 + I_UP;
               constexpr int R_SCAN = R_IN1 - 6200;
               constexpr int R_UP0 = R_IN1 + I_DN;
               static_assert(R_UP0 + I_DN == N_REST && R_SCAN > R_G1 && R_SCAN > R_IN0, "conversion ranges"); }
__device__ __forceinline__ void convert_first_item(ArgsP a, LAS float* scr, int r, int lane) {
    unsigned char* ws = a->ws;
    if (r < cv::I_IN) { p0_transpose_item(a->in[I_WINE], D, NPROJ, NPROJ_PAD, (bf16*)(ws + WS_WINE), scr, r, lane); return; } r -= cv::I_IN;
    if (r < cv::I_PL) { p0_transpose_item(a->in[I_WPLE], PLE, D, D, (bf16*)(ws + WS_WPLE), scr, r, lane); return; } r -= cv::I_PL;
    { const int mat = r / 64, blk = (r / 8) & 7; p0_transpose_item(a->in[mat == 0 ? I_LWR : I_LWI] + (size_t)blk * 16384, 128, 128, 128, (bf16*)(ws + WS_LRUW) + (size_t)(mat * 8 + blk) * 16384, scr, r % 8, lane); }
}
__device__ __forceinline__ TDesc decode_rest(ArgsP a, int r) {
    using namespace cv; unsigned char* ws = a->ws;
    if (r < I_SQ) return TDesc{a->in[I_WOUTE], (bf16*)(ws + WS_WOUTE), D, D, D, r}; r -= I_SQ;
    if (r < I_UP) return TDesc{a->in[I_WUP], (bf16*)(ws + WS_WUP), D, FF, FF, r}; r -= I_UP;
    if (r < I_SQ) return TDesc{a->in[I_WGATE], (bf16*)(ws + WS_WGATE), D, D, D, r}; r -= I_SQ;
    if (r < I_IN) return TDesc{a->in[I_WINO], (bf16*)(ws + WS_WINO), D, NPROJ, NPROJ_PAD, r}; r -= I_IN;
    if (r < I_SQ) return TDesc{a->in[I_WOUTO], (bf16*)(ws + WS_WOUTO), D, D, D, r}; r -= I_SQ;
    if (r < I_PL) return TDesc{a->in[I_WPLE] + (size_t)PLE * D, (bf16*)(ws + WS_WPLE) + (size_t)PLE * D, PLE, D, D, r}; r -= I_PL;
    if (r < I_SQ) return TDesc{a->in[I_WGATE] + (size_t)D * D, (bf16*)(ws + WS_WGATE) + (size_t)D * D, D, D, D, r}; r -= I_SQ;
    if (r < I_UP) return TDesc{a->in[I_WUP] + (size_t)D * FF, (bf16*)(ws + WS_WUP) + (size_t)D * FF, D, FF, FF, r}; r -= I_UP;
    if (r < I_DN) return TDesc{a->in[I_WDOWN], (bf16*)(ws + WS_WDOWN), FF, D, D, r}; r -= I_DN;
    return TDesc{a->in[I_WDOWN] + (size_t)D * FF, (bf16*)(ws + WS_WDOWN) + (size_t)D * FF, FF, D, D, r};
}
__device__ __forceinline__ void convert_range(ArgsP a, LAS float* scr, int first, int last, int widx, int nw, int lane) {
    int it = first + widx;
    TDesc dA, dB; f32x4 vA[8], vB[8];
    if (it < last) { dA = decode_rest(a, it); t_load(dA, lane, vA);
#pragma unroll 1
        for (;;) {
            const int itB = it + nw; const bool hasB = itB < last;
            if (hasB) { dB = decode_rest(a, itB); t_load(dB, lane, vB); }
            t_finish(dA, scr, lane, vA);
            if (!hasB) break;
            it = itB + nw; const bool hasA = it < last;
            if (hasA) { dA = decode_rest(a, it); t_load(dA, lane, vA); }
            t_finish(dB, scr, lane, vB);
            if (!hasA) break;
        } }
}
__device__ __forceinline__ void phase_convert(ArgsP a, LAS unsigned char* lds, int gw, int NGW, int wave, int lane) {
    unsigned char* ws = a->ws;
    LAS float* scr = (LAS float*)(lds + wave * 16384);
    for (int it = gw; it < cv::N_FIRST; it += NGW) convert_first_item(a, scr, it, lane);
    bf16* xb = (bf16*)(ws + WS_XB);
    for (int m0 = gw; m0 < M; m0 += 2 * NGW) {
        const int m1 = m0 + NGW; const bool two = m1 < M;
        const float* s0 = m0 < MP ? a->in[I_XP] + (size_t)m0 * D : a->in[I_XS] + (size_t)(m0 - MP) * D;
        const float* s1 = two ? (m1 < MP ? a->in[I_XP] + (size_t)m1 * D : a->in[I_XS] + (size_t)(m1 - MP) * D) : s0;
        f32x4 v0[8], v1[8];
#pragma unroll
        for (int j = 0; j < 8; ++j) { v0[j] = __builtin_nontemporal_load((const f32x4*)(s0 + j * 256 + lane * 4)); v1[j] = __builtin_nontemporal_load((const f32x4*)(s1 + j * 256 + lane * 4)); }
#pragma unroll
        for (int j = 0; j < 8; ++j) { v2u o; o.x = pk2(v0[j].x, v0[j].y); o.y = pk2(v0[j].z, v0[j].w); *(v2u*)(xb + (size_t)m0 * D + j * 256 + lane * 4) = o; }
        if (two) {
#pragma unroll
            for (int j = 0; j < 8; ++j) { v2u o; o.x = pk2(v1[j].x, v1[j].y); o.y = pk2(v1[j].z, v1[j].w); *(v2u*)(xb + (size_t)m1 * D + j * 256 + lane * 4) = o; } }
    }
    bf16* pb = (bf16*)(ws + WS_PB);
    for (int r0 = gw; r0 < 2 * M; r0 += 4 * NGW) {
        f32x4 v[4];
#pragma unroll
        for (int k = 0; k < 4; ++k) { const int r = r0 + k * NGW; const int rr = r < 2 * M ? r : r0; const int l = rr / M, m = rr % M;
            const float* src = m < MP ? a->in[I_PP] + ((size_t)l * MP + m) * PLE : a->in[I_PS] + ((size_t)l * MS + (m - MP)) * PLE;
            v[k] = __builtin_nontemporal_load((const f32x4*)(src + lane * 4)); }
#pragma unroll
        for (int k = 0; k < 4; ++k) { const int r = r0 + k * NGW; if (r < 2 * M) { v2u o; o.x = pk2(v[k].x, v[k].y); o.y = pk2(v[k].z, v[k].w); *(v2u*)(pb + (size_t)r * PLE + lane * 4) = o; } }
    }
}

__device__ __forceinline__ float conv_in(const bf16* proj, int row0, int tq, int ch, const float* cstate) {
    if (tq >= 0) return bf2f(proj[(size_t)(row0 + tq) * NPROJ_PAD + ch]);
    return cstate ? cstate[(3 + tq) * 4096 + ch] : 0.f;
}
__device__ __forceinline__ float conv4(const bf16* proj, int row0, int t, int ch, const float* cstate, const float* wconv, const float* bconv) {
    float acc = bconv[ch];
#pragma unroll
    for (int j = 0; j < 4; ++j) acc += wconv[j * 4096 + ch] * conv_in(proj, row0, t - 3 + j, ch, cstate);
    return acc;
}

__device__ __forceinline__ void delta_rec_item(ArgsP a, LAS unsigned char* lds, int row0, int T, int h, const float* cstate, const float* S0, float* Sout, const int tid) {
    const int lane = tid & 63, wave = tid >> 6, c = tid & 127, r = tid >> 7;
    const bf16* proj = (const bf16*)(a->ws + WS_PROJ); const float* gates = (const float*)(a->ws + WS_GATES); bf16* mix = (bf16*)(a->ws + WS_MIX);
    const float* wconv = a->in[I_WCONV]; const float* bconv = a->in[I_BCONV];
    LAS float* act = (LAS float*)lds;
    LAS float* nrm = act + 4 * 384;
    LAS float* gb = nrm + 8;
    LAS float* red = gb + 8;
    LAS float* red2 = red + 512;
    LAS float* obuf = red2 + 512;
    float s[32];
#pragma unroll
    for (int i = 0; i < 32; ++i) s[i] = S0 ? S0[(size_t)(32 * r + i) * 128 + c] : 0.f;
    const float aexp = fexp(a->in[I_ALOG][h]), dtb = a->in[I_DTB][h];
#pragma unroll 1
    for (int t0 = 0; t0 < T; t0 += 4) {
#pragma unroll
        for (int j = 0; j < 3; ++j) { const int idx = tid + 512 * j, tok = idx / 384, chl = idx % 384, part = chl >> 7, i = chl & 127;
            const int ch = part * 1024 + h * 128 + i;
            act[tok * 384 + chl] = siluf(conv4(proj, row0, t0 + tok, ch, cstate, wconv, bconv)); }
        LDS_BARRIER();
        { const int tok = wave >> 1, part = wave & 1; const float x0 = act[tok * 384 + part * 128 + lane], x1 = act[tok * 384 + part * 128 + 64 + lane];
          const float ss = wave_sum(x0 * x0 + x1 * x1); if (lane == 0) nrm[tok * 2 + part] = rsqrtf(ss + 1e-6f) * (part == 0 ? 0.08838834764831845f : 1.f); }
        if (tid < 4) { const int row = row0 + t0 + tid; const float g = -aexp * softplusf(gates[(size_t)row * 16 + h] + dtb); gb[tid * 2] = fexp(g); gb[tid * 2 + 1] = sigm(gates[(size_t)row * 16 + 8 + h]); }
        LDS_BARRIER();
#pragma unroll 1
        for (int tok = 0; tok < 4; ++tok) {
            const float eg = gb[tok * 2], beta = gb[tok * 2 + 1], nq = nrm[tok * 2], nk = nrm[tok * 2 + 1];
            const LAS float* qv = act + tok * 384 + 32 * r; const LAS float* kv = qv + 128;
            float ks = 0.f;
#pragma unroll
            for (int i = 0; i < 32; ++i) ks += kv[i] * s[i];
            red[r * 128 + c] = ks * nk;
            LDS_BARRIER();
            const float kS = red[c] + red[128 + c] + red[256 + c] + red[384 + c];
            const float vnew = beta * (act[tok * 384 + 256 + c] - eg * kS);
            float os = 0.f;
#pragma unroll
            for (int i = 0; i < 32; ++i) { s[i] = eg * s[i] + (kv[i] * nk) * vnew; os += qv[i] * s[i]; }
            red2[r * 128 + c] = os * nq;
            LDS_BARRIER();
            if (r == 0) obuf[tok * 128 + c] = red2[c] + red2[128 + c] + red2[256 + c] + red2[384 + c];
        }
        LDS_BARRIER();
        if (wave < 4) { const int tok = wave, row = row0 + t0 + tok; const float o0 = obuf[tok * 128 + lane], o1 = obuf[tok * 128 + 64 + lane];
            const float rstd = rsqrtf(wave_sum(o0 * o0 + o1 * o1) * (1.f / 128.f) + RMS_EPS);
            const float* nw = a->in[I_DNORM];
            const float z0 = bf2f(proj[(size_t)row * NPROJ_PAD + 4096 + h * 128 + lane]), z1 = bf2f(proj[(size_t)row * NPROJ_PAD + 4096 + h * 128 + 64 + lane]);
            mix[(size_t)row * D + h * 128 + lane] = (bf16)f2bf(o0 * rstd * nw[lane] * siluf(z0));
            mix[(size_t)row * D + h * 128 + 64 + lane] = (bf16)f2bf(o1 * rstd * nw[64 + lane] * siluf(z1)); }
        LDS_BARRIER();
    }
#pragma unroll
    for (int i = 0; i < 32; ++i) Sout[(size_t)(32 * r + i) * 128 + c] = s[i];
}


typedef short bf16x8 __attribute__((ext_vector_type(8)));
#define MFMA32(a_, b_, c_) __builtin_amdgcn_mfma_f32_16x16x32_bf16(a_, b_, c_, 0, 0, 0)

__device__ __forceinline__ void lru_prep_item(ArgsP a, LAS unsigned char* lds, int item, const int tid) {
    const int c = item & 31, n = (item >> 5) & 7, b = item >> 8;
    const int lane = tid & 63, w = __builtin_amdgcn_readfirstlane(tid >> 6), fr = lane & 15, fq = lane >> 4;
    unsigned char* ws = a->ws;
    const bf16* proj = (const bf16*)(ws + WS_PROJ);
    LAS bf16* xa = (LAS bf16*)lds;
    LAS float* xf = (LAS float*)(lds + 17408);
    LAS float* obH = (LAS float*)(lds + 51200);
    LAS float* obP = obH + 64 * 132;
    {
        const int t = tid >> 3, sub = tid & 7, ch0 = 3072 + n * 128 + sub * 16;
        const float* wconv = a->in[I_WCONV]; const float* bconv = a->in[I_BCONV];
        float x[16];
#pragma unroll
        for (int i = 0; i < 4; ++i) { const f32x4 bb = *(const f32x4*)(bconv + ch0 + 4 * i); x[4 * i] = bb.x; x[4 * i + 1] = bb.y; x[4 * i + 2] = bb.z; x[4 * i + 3] = bb.w; }
#pragma unroll
        for (int j = 0; j < 4; ++j) { const int tt = 64 * c + t - 3 + j;
            if (tt >= 0) { const bf16* pr = proj + (size_t)(b * TP + tt) * NPROJ_PAD + ch0; const v4u u0 = *(const v4u*)pr, u1 = *(const v4u*)(pr + 8);
                const unsigned uu[8] = {u0.x, u0.y, u0.z, u0.w, u1.x, u1.y, u1.z, u1.w};
#pragma unroll
                for (int i = 0; i < 4; ++i) { const f32x4 ww = *(const f32x4*)(wconv + j * 4096 + ch0 + 4 * i);
                    x[4 * i] += ww.x * bflo(uu[2 * i]); x[4 * i + 1] += ww.y * bfhi(uu[2 * i]); x[4 * i + 2] += ww.z * bflo(uu[2 * i + 1]); x[4 * i + 3] += ww.w * bfhi(uu[2 * i + 1]); } } }
        v4u o0, o1; o0.x = pk2(x[0], x[1]); o0.y = pk2(x[2], x[3]); o0.z = pk2(x[4], x[5]); o0.w = pk2(x[6], x[7]); o1.x = pk2(x[8], x[9]); o1.y = pk2(x[10], x[11]); o1.z = pk2(x[12], x[13]); o1.w = pk2(x[14], x[15]);
        *(LAS v4u*)(xa + t * 136 + sub * 16) = o0; *(LAS v4u*)(xa + t * 136 + sub * 16 + 8) = o1;
#pragma unroll
        for (int i = 0; i < 4; ++i) *(LAS f32x4*)(xf + t * 132 + sub * 16 + 4 * i) = (f32x4){x[4 * i], x[4 * i + 1], x[4 * i + 2], x[4 * i + 3]};
    }
    LDS_BARRIER();
    const bf16* wrT = (const bf16*)(ws + WS_LRUW) + (size_t)n * 16384; const bf16* wiT = wrT + 8 * 16384;
    bf16x8 br[4], bi[4];
#pragma unroll
    for (int ks = 0; ks < 4; ++ks) { br[ks] = *(const bf16x8*)(wrT + (16 * w + fr) * 128 + 32 * ks + 8 * fq); bi[ks] = *(const bf16x8*)(wiT + (16 * w + fr) * 128 + 32 * ks + 8 * fq); }
    f32x4 accr[4], acci[4];
#pragma unroll
    for (int tb = 0; tb < 4; ++tb) { accr[tb] = (f32x4){0.f, 0.f, 0.f, 0.f}; acci[tb] = (f32x4){0.f, 0.f, 0.f, 0.f};
#pragma unroll
        for (int ks = 0; ks < 4; ++ks) { const bf16x8 af = *(const LAS bf16x8*)(xa + (16 * tb + fr) * 136 + 32 * ks + 8 * fq); accr[tb] = MFMA32(af, br[ks], accr[tb]); acci[tb] = MFMA32(af, bi[ks], acci[tb]); } }
    const int dl = 16 * w + fr, chn = n * 128 + dl;
    const float brs = a->in[I_LBR][chn], bis = a->in[I_LBI][chn], spl = softplusf(-a->in[I_LLAM][chn]);
    float Apre = 1.f, Hpre = 0.f;
#pragma unroll
    for (int tb = 0; tb < 4; ++tb) {
        float P[4], Hh[4];
#pragma unroll
        for (int j = 0; j < 4; ++j) { const int t = 16 * tb + 4 * fq + j;
            const float log_a = -8.f * sigm(accr[tb][j] + brs) * spl; const float av = fexp(log_a);
            const float bx = sqrtf(neg_expm1(2.f * log_a)) * sigm(acci[tb][j] + bis) * xf[t * 132 + dl];
            if (j == 0) { P[0] = av; Hh[0] = bx; } else { P[j] = P[j - 1] * av; Hh[j] = av * Hh[j - 1] + bx; } }
        float Ai = P[3], Hi = Hh[3];
        { const float A2 = __shfl_up(Ai, 16), H2 = __shfl_up(Hi, 16); if (fq >= 1) { Hi = Ai * H2 + Hi; Ai = A2 * Ai; } }
        { const float A2 = __shfl_up(Ai, 32), H2 = __shfl_up(Hi, 32); if (fq >= 2) { Hi = Ai * H2 + Hi; Ai = A2 * Ai; } }
        float Aex = __shfl_up(Ai, 16), Hex = __shfl_up(Hi, 16); if (fq == 0) { Aex = 1.f; Hex = 0.f; }
        const float Atb = __shfl(Ai, 48 + fr), Htb = __shfl(Hi, 48 + fr);
        const float EA = Apre * Aex, EH = Aex * Hpre + Hex;
#pragma unroll
        for (int j = 0; j < 4; ++j) { const int t = 16 * tb + 4 * fq + j; obP[t * 132 + dl] = EA * P[j]; obH[t * 132 + dl] = P[j] * EH + Hh[j]; }
        Hpre = Atb * Hpre + Htb; Apre = Apre * Atb;
    }
    if (fq == 0) { float* e = (float*)(ws + WS_LRU_END) + (size_t)item * 256; e[dl] = Apre; e[128 + dl] = Hpre; }
    LDS_BARRIER();
    {
        const int t = tid >> 3, sub = tid & 7;
        bf16* hl = (bf16*)(ws + WS_LRU_HL) + ((size_t)item * 64 + t) * 128 + sub * 16; bf16* pp = (bf16*)(ws + WS_LRU_P) + ((size_t)item * 64 + t) * 128 + sub * 16;
        const LAS float* sh = obH + t * 132 + sub * 16; const LAS float* sp = obP + t * 132 + sub * 16;
        v4u o0, o1;
        o0.x = pk2(sh[0], sh[1]); o0.y = pk2(sh[2], sh[3]); o0.z = pk2(sh[4], sh[5]); o0.w = pk2(sh[6], sh[7]); o1.x = pk2(sh[8], sh[9]); o1.y = pk2(sh[10], sh[11]); o1.z = pk2(sh[12], sh[13]); o1.w = pk2(sh[14], sh[15]);
        *(v4u*)hl = o0; *(v4u*)(hl + 8) = o1;
        o0.x = pk2(sp[0], sp[1]); o0.y = pk2(sp[2], sp[3]); o0.z = pk2(sp[4], sp[5]); o0.w = pk2(sp[6], sp[7]); o1.x = pk2(sp[8], sp[9]); o1.y = pk2(sp[10], sp[11]); o1.z = pk2(sp[12], sp[13]); o1.w = pk2(sp[14], sp[15]);
        *(v4u*)pp = o0; *(v4u*)(pp + 8) = o1;
    }
    LDS_BARRIER();
}
__device__ __forceinline__ void lru_out_item(ArgsP a, LAS unsigned char* lds, int item, const int tid) {
    const int c = item & 31, n = (item >> 5) & 7, b = item >> 8;
    unsigned char* ws = a->ws;
    LAS float* carry = (LAS float*)lds;
    if (tid < 128) { float cr = 0.f; const float* e = (const float*)(ws + WS_LRU_END) + (size_t)(item - c) * 256;
        float pv[31], hv_[31];
#pragma unroll
        for (int k = 0; k < 31; ++k) { const bool on = k < c; pv[k] = on ? e[k * 256 + tid] : 1.f; hv_[k] = on ? e[k * 256 + 128 + tid] : 0.f; }
#pragma unroll
        for (int k = 0; k < 31; ++k) cr = hv_[k] + pv[k] * cr;
        carry[tid] = cr; }
    LDS_BARRIER();
    const int t = tid >> 3, sub = tid & 7, d0 = sub * 16, row = b * TP + 64 * c + t;
    const bf16* hl = (const bf16*)(ws + WS_LRU_HL) + ((size_t)item * 64 + t) * 128 + d0; const bf16* pp = (const bf16*)(ws + WS_LRU_P) + ((size_t)item * 64 + t) * 128 + d0;
    const bf16* gp = (const bf16*)(ws + WS_PROJ) + (size_t)row * NPROJ_PAD + 5120 + n * 128 + d0;
    const v4u h0 = *(const v4u*)hl, h1 = *(const v4u*)(hl + 8), p0 = *(const v4u*)pp, p1 = *(const v4u*)(pp + 8), g0 = *(const v4u*)gp, g1 = *(const v4u*)(gp + 8);
    const unsigned hu[8] = {h0.x, h0.y, h0.z, h0.w, h1.x, h1.y, h1.z, h1.w}, pu[8] = {p0.x, p0.y, p0.z, p0.w, p1.x, p1.y, p1.z, p1.w}, gu[8] = {g0.x, g0.y, g0.z, g0.w, g1.x, g1.y, g1.z, g1.w};
    float hv[16]; unsigned ou[8];
#pragma unroll
    for (int i = 0; i < 8; ++i) { hv[2 * i] = bflo(hu[i]) + bflo(pu[i]) * carry[d0 + 2 * i]; hv[2 * i + 1] = bfhi(hu[i]) + bfhi(pu[i]) * carry[d0 + 2 * i + 1];
        ou[i] = pk2(hv[2 * i] * gelu_tanh(bflo(gu[i])), hv[2 * i + 1] * gelu_tanh(bfhi(gu[i]))); }
    bf16* mp = (bf16*)(ws + WS_MIX) + (size_t)row * D + 1024 + n * 128 + d0;
    *(v4u*)mp = (v4u){ou[0], ou[1], ou[2], ou[3]}; *(v4u*)(mp + 8) = (v4u){ou[4], ou[5], ou[6], ou[7]};
    if (c == 31 && t == 63) { float* o = a->out + O_LRUP + (size_t)b * 1024 + n * 128 + d0;
#pragma unroll
        for (int i = 0; i < 4; ++i) *(f32x4*)(o + 4 * i) = (f32x4){hv[4 * i], hv[4 * i + 1], hv[4 * i + 2], hv[4 * i + 3]}; }
    LDS_BARRIER();
}


__device__ __forceinline__ void conv16_load(const bf16* proj, int b, int tseq, int ch0, v4u (&u)[8]) {
#pragma unroll
    for (int j = 0; j < 4; ++j) { const int tt = tseq - 3 + j;
        if (tt >= 0) { const bf16* pr = proj + (size_t)(b * TP + tt) * NPROJ_PAD + ch0; u[2 * j] = *(const v4u*)pr; u[2 * j + 1] = *(const v4u*)(pr + 8); }
        else { u[2 * j] = (v4u){0u, 0u, 0u, 0u}; u[2 * j + 1] = (v4u){0u, 0u, 0u, 0u}; } }
}
__device__ __forceinline__ void conv16_compute(const v4u (&u)[8], const float* wconv, const float* bconv, int ch0, float (&x)[16]) {
#pragma unroll
    for (int i = 0; i < 4; ++i) { const f32x4 bb = *(const f32x4*)(bconv + ch0 + 4 * i); x[4 * i] = bb.x; x[4 * i + 1] = bb.y; x[4 * i + 2] = bb.z; x[4 * i + 3] = bb.w; }
#pragma unroll
    for (int j = 0; j < 4; ++j) { const unsigned uu[8] = {u[2 * j].x, u[2 * j].y, u[2 * j].z, u[2 * j].w, u[2 * j + 1].x, u[2 * j + 1].y, u[2 * j + 1].z, u[2 * j + 1].w};
#pragma unroll
        for (int i = 0; i < 4; ++i) { const f32x4 ww = *(const f32x4*)(wconv + j * 4096 + ch0 + 4 * i);
            x[4 * i] += ww.x * bflo(uu[2 * i]); x[4 * i + 1] += ww.y * bfhi(uu[2 * i]); x[4 * i + 2] += ww.z * bflo(uu[2 * i + 1]); x[4 * i + 3] += ww.w * bfhi(uu[2 * i + 1]); } }
}
__device__ __forceinline__ void conv16_prompt(const bf16* proj, const float* wconv, const float* bconv, int b, int tseq, int ch0, float (&x)[16]) {
    v4u u[8]; conv16_load(proj, b, tseq, ch0, u); conv16_compute(u, wconv, bconv, ch0, x);
}
__device__ __forceinline__ void st16_bf16(LAS bf16* p, const float (&x)[16]) {
    v4u o0, o1; o0.x = pk2(x[0], x[1]); o0.y = pk2(x[2], x[3]); o0.z = pk2(x[4], x[5]); o0.w = pk2(x[6], x[7]); o1.x = pk2(x[8], x[9]); o1.y = pk2(x[10], x[11]); o1.z = pk2(x[12], x[13]); o1.w = pk2(x[14], x[15]);
    *(LAS v4u*)p = o0; *(LAS v4u*)(p + 8) = o1;
}
__device__ __forceinline__ v2u pack4(const f32x4 v) { v2u o; o.x = pk2(v.x, v.y); o.y = pk2(v.z, v.w); return o; }
__device__ __forceinline__ bf16x8 zero8() { return (bf16x8){0, 0, 0, 0, 0, 0, 0, 0}; }

__device__ __forceinline__ void delta_prep_item(ArgsP a, LAS unsigned char* lds, int item, const int tid) {
    const int c = item & 31, h = (item >> 5) & 7, b = item >> 8;
    const int lane = tid & 63, w = __builtin_amdgcn_readfirstlane(tid >> 6), fr = lane & 15, fq = lane >> 4;
    unsigned char* ws = a->ws;
    const bf16* proj = (const bf16*)(ws + WS_PROJ);
    LAS bf16* Kn = (LAS bf16*)lds;
    LAS bf16* Qn = (LAS bf16*)(lds + 17408);
    LAS bf16* KdT = (LAS bf16*)(lds + 34816);
    LAS bf16* RX = (LAS bf16*)(lds + 53248);
    LAS bf16* Mm = (LAS bf16*)(lds + 90112);
    LAS bf16* QKd = (LAS bf16*)(lds + 99328);
    LAS bf16* Td = (LAS bf16*)(lds + 108544);
    LAS bf16* RT = (LAS bf16*)(lds + 111616) + w * 768;
    LAS float* gl = (LAS float*)(lds + 123904);
    LAS float* gcs = gl + 64;
    LAS float* bet = gcs + 64;
    float gcv, bvv;
    {
        const float* gt = (const float*)(ws + WS_GATES) + (size_t)(b * TP + 64 * c + lane) * 16;
        const float gv = -fexp(a->in[I_ALOG][h]) * softplusf(gt[h] + a->in[I_DTB][h]); bvv = sigm(gt[8 + h]);
        gcv = wave_incl_sum(gv, lane);
        if (w == 0) { gl[lane] = gv; gcs[lane] = gcv; bet[lane] = bvv; }
    }
    {
        const int part = w >> 1;
        if (part < 3) {
            const float* wconv = a->in[I_WCONV]; const float* bconv = a->in[I_BCONV];
            const int sub = tid & 7, tg = (tid >> 3) & 15, ch0 = (part == 0 ? 0 : part == 1 ? 1024 : 2048) + h * 128 + sub * 16;
            f32x4 wv[4][4], bv4[4];
#pragma unroll
            for (int i = 0; i < 4; ++i) { bv4[i] = *(const f32x4*)(bconv + ch0 + 4 * i);
#pragma unroll
                for (int j = 0; j < 4; ++j) wv[j][i] = *(const f32x4*)(wconv + j * 4096 + ch0 + 4 * i); }
            v4u u[7][2];
#pragma unroll
            for (int r = 0; r < 7; ++r) { const int tt = 64 * c + 4 * tg - 3 + r;
                if (tt >= 0) { const bf16* pr = proj + (size_t)(b * TP + tt) * NPROJ_PAD + ch0; u[r][0] = *(const v4u*)pr; u[r][1] = *(const v4u*)(pr + 8); }
                else { u[r][0] = (v4u){0u, 0u, 0u, 0u}; u[r][1] = (v4u){0u, 0u, 0u, 0u}; } }
            const float glast = __shfl(gcv, 63);
#pragma unroll
            for (int e = 0; e < 4; ++e) { const int t = 4 * tg + e;
                float x[16];
#pragma unroll
                for (int i = 0; i < 4; ++i) { x[4 * i] = bv4[i].x; x[4 * i + 1] = bv4[i].y; x[4 * i + 2] = bv4[i].z; x[4 * i + 3] = bv4[i].w; }
#pragma unroll
                for (int j = 0; j < 4; ++j) { const unsigned uu[8] = {u[e + j][0].x, u[e + j][0].y, u[e + j][0].z, u[e + j][0].w, u[e + j][1].x, u[e + j][1].y, u[e + j][1].z, u[e + j][1].w};
#pragma unroll
                    for (int i = 0; i < 4; ++i) { x[4 * i] += wv[j][i].x * bflo(uu[2 * i]); x[4 * i + 1] += wv[j][i].y * bfhi(uu[2 * i]); x[4 * i + 2] += wv[j][i].z * bflo(uu[2 * i + 1]); x[4 * i + 3] += wv[j][i].w * bfhi(uu[2 * i + 1]); } }
                float ss = 0.f;
#pragma unroll
                for (int i = 0; i < 16; ++i) { x[i] = siluf(x[i]); ss += x[i] * x[i]; }
                const float gc = __shfl(gcv, t), beta = __shfl(bvv, t);
                if (part == 2) {
#pragma unroll
                    for (int i = 0; i < 16; ++i) x[i] *= beta;
                    st16_bf16(RX + t * 264 + sub * 16, x);
                } else {
                    ss += __shfl_xor(ss, 1); ss += __shfl_xor(ss, 2); ss += __shfl_xor(ss, 4);
                    const float rn = rsqrtf(ss + 1e-6f) * (part == 0 ? 0.08838834764831845f : 1.f);
#pragma unroll
                    for (int i = 0; i < 16; ++i) x[i] *= rn;
                    if (part == 0) st16_bf16(Qn + t * 136 + sub * 16, x);
                    else { st16_bf16(Kn + t * 136 + sub * 16, x);
                        const float ec = fexp(gc), ed = fexp(glast - gc); float y[16];
#pragma unroll
                        for (int i = 0; i < 16; ++i) { KdT[(sub * 16 + i) * 72 + t] = (bf16)f2bf(x[i] * ed); y[i] = x[i] * (beta * ec); }
                        st16_bf16(RX + t * 264 + 128 + sub * 16, y); }
                }
            }
        }
    }
    LDS_BARRIER();
    {
        const int ib = w >> 1;
#pragma unroll
        for (int jj = 0; jj < 2; ++jj) { const int jb = 2 * (w & 1) + jj;
            f32x4 ak = (f32x4){0.f, 0.f, 0.f, 0.f}, aq = (f32x4){0.f, 0.f, 0.f, 0.f};
            if (jb <= ib) {
#pragma unroll
                for (int ks = 0; ks < 4; ++ks) { const bf16x8 bfr = *(const LAS bf16x8*)(Kn + (16 * jb + fr) * 136 + 32 * ks + 8 * fq);
                    const bf16x8 afk = *(const LAS bf16x8*)(Kn + (16 * ib + fr) * 136 + 32 * ks + 8 * fq), afq = *(const LAS bf16x8*)(Qn + (16 * ib + fr) * 136 + 32 * ks + 8 * fq);
                    ak = MFMA32(afk, bfr, ak); aq = MFMA32(afq, bfr, aq); } }
            const int col = 16 * jb + fr; const float gcc = gcs[col];
#pragma unroll
            for (int j = 0; j < 4; ++j) { const int row = 16 * ib + 4 * fq + j; const float dec = (row >= col) ? fexp(gcs[row] - gcc) : 0.f;
                Mm[row * 72 + col] = (bf16)f2bf(row > col ? -bet[row] * ak[j] * dec : 0.f);
                QKd[row * 72 + col] = (bf16)f2bf(aq[j] * dec); }
        }
    }
    LDS_BARRIER();
    if (w == 0) { const int blk = lane >> 4, col = lane & 15; float xi[16];
#pragma unroll
        for (int i = 0; i < 16; ++i) { float acc = (i == col) ? 1.f : 0.f; const LAS bf16* mr = Mm + (16 * blk + i) * 72 + 16 * blk;
#pragma unroll
            for (int j = 0; j < i; ++j) acc += bf2f(mr[j]) * xi[j];
            xi[i] = acc; }
#pragma unroll
        for (int i = 0; i < 16; ++i) Td[(blk * 16 + i) * 24 + col] = (bf16)f2bf(xi[i]); }
    f32x4 rhs[2][4];
#pragma unroll
    for (int cbl = 0; cbl < 2; ++cbl)
#pragma unroll
        for (int bb = 0; bb < 4; ++bb)
#pragma unroll
            for (int j = 0; j < 4; ++j) rhs[cbl][bb][j] = bf2f(RX[(16 * bb + 4 * fq + j) * 264 + 32 * w + 16 * cbl + fr]);
    LDS_BARRIER();
#pragma unroll
    for (int cbl = 0; cbl < 2; ++cbl) { const int cb = 2 * w + cbl;
#pragma unroll
        for (int bb = 0; bb < 4; ++bb) {
            f32x4 acc = rhs[cbl][bb];
#pragma unroll
            for (int ks = 0; ks < 2; ++ks) { if (32 * ks < 16 * bb) { const bool ok = (32 * ks + 8 * fq) < 16 * bb;
                const bf16x8 af = ok ? *(const LAS bf16x8*)(Mm + (16 * bb + fr) * 72 + 32 * ks + 8 * fq) : zero8();
                const bf16x8 bf_ = ok ? *(const LAS bf16x8*)(RX + (16 * cb + fr) * 72 + 32 * ks + 8 * fq) : zero8();
                acc = MFMA32(af, bf_, acc); } }
            *(LAS v2u*)(RT + (16 * cbl + fr) * 24 + 4 * fq) = pack4(acc);
            asm volatile("s_waitcnt lgkmcnt(0)" ::: "memory");
            const bool ok2 = fq < 2;
            const bf16x8 af2 = ok2 ? *(const LAS bf16x8*)(Td + (bb * 16 + fr) * 24 + 8 * fq) : zero8();
            const bf16x8 bf2 = ok2 ? *(const LAS bf16x8*)(RT + (16 * cbl + fr) * 24 + 8 * fq) : zero8();
            const f32x4 xb4 = MFMA32(af2, bf2, ((f32x4){0.f, 0.f, 0.f, 0.f}));
            *(LAS v2u*)(RX + (16 * cb + fr) * 72 + 16 * bb + 4 * fq) = pack4(xb4);
            asm volatile("s_waitcnt lgkmcnt(0)" ::: "memory");
        }
    }
    LDS_BARRIER();
    {
        v4u* gout = (v4u*)(ws + WS_DG) + ((size_t)item * 8 + w) * 4 * 64 + lane;
        bf16x8 kb[2];
#pragma unroll
        for (int kt = 0; kt < 2; ++kt) kb[kt] = *(const LAS bf16x8*)(KdT + (16 * w + fr) * 72 + 32 * kt + 8 * fq);
#pragma unroll
        for (int ks = 0; ks < 4; ++ks) { f32x4 g0 = (f32x4){0.f, 0.f, 0.f, 0.f}, g1 = (f32x4){0.f, 0.f, 0.f, 0.f};
#pragma unroll
            for (int kt = 0; kt < 2; ++kt) { const bf16x8 a0 = *(const LAS bf16x8*)(RX + (128 + 32 * ks + fr) * 72 + 32 * kt + 8 * fq), a1 = *(const LAS bf16x8*)(RX + (128 + 32 * ks + 16 + fr) * 72 + 32 * kt + 8 * fq);
                g0 = MFMA32(a0, kb[kt], g0); g1 = MFMA32(a1, kb[kt], g1); }
            const v2u p0 = pack4(-g0), p1 = pack4(-g1); gout[ks * 64] = (v4u){p0.x, p0.y, p1.x, p1.y}; }
        v2u* bout = (v2u*)(ws + WS_DB) + ((size_t)item * 64 + w) * 64 + lane;
#pragma unroll
        for (int s2 = 0; s2 < 8; ++s2) { f32x4 bc = (f32x4){0.f, 0.f, 0.f, 0.f};
#pragma unroll
            for (int kt = 0; kt < 2; ++kt) { const bf16x8 ub = *(const LAS bf16x8*)(RX + (16 * s2 + fr) * 72 + 32 * kt + 8 * fq); bc = MFMA32(kb[kt], ub, bc); }
            bout[(size_t)s2 * 8 * 64] = pack4(bc); }
    }
    {
        const int tb = w >> 1, half = w & 1; const float ect = fexp(gcs[16 * tb + fr]);
        bf16x8 qk[2];
#pragma unroll
        for (int kt = 0; kt < 2; ++kt) qk[kt] = *(const LAS bf16x8*)(QKd + (16 * tb + fr) * 72 + 32 * kt + 8 * fq);
        v4u* qout = (v4u*)(ws + WS_DQ) + ((size_t)item * 4 + tb) * 4 * 64 + lane;
#pragma unroll
        for (int kk = 0; kk < 2; ++kk) { const int ks = 2 * half + kk; v2u pk[2];
#pragma unroll
            for (int hf = 0; hf < 2; ++hf) { const int db = 2 * ks + hf; f32x4 acc = (f32x4){0.f, 0.f, 0.f, 0.f};
#pragma unroll
                for (int kt = 0; kt < 2; ++kt) { const bf16x8 wa = *(const LAS bf16x8*)(RX + (128 + 16 * db + fr) * 72 + 32 * kt + 8 * fq); acc = MFMA32(wa, qk[kt], acc); }
                const v2u qn4 = *(const LAS v2u*)(Qn + (16 * tb + fr) * 136 + 16 * db + 4 * fq);
                f32x4 qp; qp.x = bflo(qn4.x) * ect - acc.x; qp.y = bfhi(qn4.x) * ect - acc.y; qp.z = bflo(qn4.y) * ect - acc.z; qp.w = bfhi(qn4.y) * ect - acc.w;
                pk[hf] = pack4(qp); }
            qout[ks * 64] = (v4u){pk[0].x, pk[0].y, pk[1].x, pk[1].y}; }
        v2u* oout = (v2u*)(ws + WS_DO) + ((size_t)item * 4 + tb) * 8 * 64 + lane;
#pragma unroll
        for (int ss = 0; ss < 4; ++ss) { const int s2 = 4 * half + ss; f32x4 acc = (f32x4){0.f, 0.f, 0.f, 0.f};
#pragma unroll
            for (int kt = 0; kt < 2; ++kt) { const bf16x8 ua = *(const LAS bf16x8*)(RX + (16 * s2 + fr) * 72 + 32 * kt + 8 * fq); acc = MFMA32(ua, qk[kt], acc); }
            oout[s2 * 64] = pack4(acc); }
    }
    if (tid == 0) ((float*)(ws + WS_DD))[item] = fexp(gcs[63]);
    LDS_BARRIER();
}

__device__ __forceinline__ void delta_scan_wave(ArgsP a, int chain, int s, const int lane) {
    unsigned char* ws = a->ws;
    const int fr = lane & 15, fq = lane >> 4;
    f32x4 S[8]; bf16x8 Sb[4];
#pragma unroll
    for (int i = 0; i < 8; ++i) S[i] = (f32x4){0.f, 0.f, 0.f, 0.f};
#pragma unroll
    for (int i = 0; i < 4; ++i) Sb[i] = zero8();
    const bf16x8* gbase = (const bf16x8*)(ws + WS_DG) + (size_t)chain * 32 * 2048 + lane;
    bf16x8 G[8][4];
#pragma unroll
    for (int rb = 0; rb < 8; ++rb)
#pragma unroll
        for (int ks = 0; ks < 4; ++ks) G[rb][ks] = gbase[(rb * 4 + ks) * 64];
#pragma unroll 1
    for (int c = 0; c < 32; ++c) {
        const int item = chain * 32 + c;
        const float d = ((const float*)(ws + WS_DD))[item];
        bf16x8* sout = (bf16x8*)(ws + WS_DS) + ((size_t)item * 8 + s) * 4 * 64 + lane;
#pragma unroll
        for (int ks = 0; ks < 4; ++ks) sout[ks * 64] = Sb[ks];
        const v2u* bin = (const v2u*)(ws + WS_DB) + ((size_t)item * 8 + s) * 8 * 64 + lane;
#pragma unroll
        for (int rb = 0; rb < 8; ++rb) { const v2u bc = bin[rb * 64]; S[rb].x = d * S[rb].x + bflo(bc.x); S[rb].y = d * S[rb].y + bfhi(bc.x); S[rb].z = d * S[rb].z + bflo(bc.y); S[rb].w = d * S[rb].w + bfhi(bc.y); }
        const bf16x8* gnext = gbase + (size_t)(c + 1 < 32 ? c + 1 : c) * 2048;
#pragma unroll
        for (int rb = 0; rb < 8; ++rb) {
#pragma unroll
            for (int ks = 0; ks < 4; ++ks) S[rb] = MFMA32(G[rb][ks], Sb[ks], S[rb]);
#pragma unroll
            for (int ks = 0; ks < 4; ++ks) G[rb][ks] = gnext[(rb * 4 + ks) * 64];
        }
#pragma unroll
        for (int ks = 0; ks < 4; ++ks) { const v2u lo = pack4(S[2 * ks]), hi = pack4(S[2 * ks + 1]); const v4u u = (v4u){lo.x, lo.y, hi.x, hi.y}; Sb[ks] = __builtin_bit_cast(bf16x8, u); }
    }
    f32x4* so = (f32x4*)(ws + WS_DF) + ((size_t)(chain * 8 + s) * 8) * 64 + lane;
#pragma unroll
    for (int rb = 0; rb < 8; ++rb) so[rb * 64] = S[rb];
}

__device__ __forceinline__ void delta_out_wave(ArgsP a, int item, int tb, const int lane) {
    unsigned char* ws = a->ws;
    const int c = item & 31, h = (item >> 5) & 7, b = item >> 8, fr = lane & 15, fq = lane >> 4;
    bf16x8 qf[4];
    const bf16x8* qin = (const bf16x8*)(ws + WS_DQ) + ((size_t)item * 4 + tb) * 4 * 64 + lane;
#pragma unroll
    for (int ks = 0; ks < 4; ++ks) qf[ks] = qin[ks * 64];
    const v2u* oin = (const v2u*)(ws + WS_DO) + ((size_t)item * 4 + tb) * 8 * 64 + lane;
    const bf16x8* sin = (const bf16x8*)(ws + WS_DS) + (size_t)item * 8 * 4 * 64 + lane;
    f32x4 o[8]; float ss = 0.f;
    v2u olv[8]; bf16x8 sfr[4][4];
#pragma unroll
    for (int s = 0; s < 8; ++s) olv[s] = oin[s * 64];
#pragma unroll
    for (int s = 0; s < 4; ++s)
#pragma unroll
        for (int ks = 0; ks < 4; ++ks) sfr[s][ks] = sin[(s * 4 + ks) * 64];
    const int row_ = b * TP + 64 * c + 16 * tb + fr;
    v2u zv[8];
#pragma unroll
    for (int s = 0; s < 8; ++s) zv[s] = *(const v2u*)((const bf16*)(ws + WS_PROJ) + (size_t)row_ * NPROJ_PAD + 4096 + h * 128 + 4 * fq + 16 * s);
#pragma unroll
    for (int grp = 0; grp < 2; ++grp) {
#pragma unroll
        for (int s4 = 0; s4 < 4; ++s4) { const int s = 4 * grp + s4; const v2u ol = olv[s]; o[s] = (f32x4){bflo(ol.x), bfhi(ol.x), bflo(ol.y), bfhi(ol.y)};
#pragma unroll
            for (int ks = 0; ks < 4; ++ks) o[s] = MFMA32(sfr[s4][ks], qf[ks], o[s]);
            ss += (o[s].x * o[s].x + o[s].y * o[s].y) + (o[s].z * o[s].z + o[s].w * o[s].w); }
        if (grp == 0) {
#pragma unroll
            for (int s4 = 0; s4 < 4; ++s4)
#pragma unroll
                for (int ks = 0; ks < 4; ++ks) sfr[s4][ks] = sin[((4 + s4) * 4 + ks) * 64]; }
    }
    ss += __shfl_xor(ss, 16); ss += __shfl_xor(ss, 32);
    const float rstd = rsqrtf(ss * (1.f / 128.f) + RMS_EPS);
    const int row = b * TP + 64 * c + 16 * tb + fr;
    const bf16* zp = (const bf16*)(ws + WS_PROJ) + (size_t)row * NPROJ_PAD + 4096 + h * 128 + 4 * fq;
    bf16* mp = (bf16*)(ws + WS_MIX) + (size_t)row * D + h * 128 + 4 * fq;
    const float* nw = a->in[I_DNORM] + 4 * fq;
#pragma unroll
    for (int s = 0; s < 8; ++s) { const v2u z = zv[s]; const f32x4 n4 = *(const f32x4*)(nw + 16 * s);
        f32x4 y; y.x = o[s].x * rstd * n4.x * siluf(bflo(z.x)); y.y = o[s].y * rstd * n4.y * siluf(bfhi(z.x)); y.z = o[s].z * rstd * n4.z * siluf(bflo(z.y)); y.w = o[s].w * rstd * n4.w * siluf(bfhi(z.y));
        *(v2u*)(mp + 16 * s) = pack4(y); }
}


__device__ __forceinline__ void mlstm_scan_item(ArgsP a, LAS unsigned char* lds, int chain, int vs, const int tid) {
    const int lane = tid & 63, w = __builtin_amdgcn_readfirstlane(tid >> 6), fr = lane & 15, fq = lane >> 4;
    const int b = chain >> 3, h = chain & 7, row0 = b * TP;
    unsigned char* ws = a->ws;
    const bf16* proj = (const bf16*)(ws + WS_PROJ); const float* gates = (const float*)(ws + WS_GATES);
    LAS bf16* KT = (LAS bf16*)lds;
    LAS bf16* VT = (LAS bf16*)(lds + 36864);
    LAS float* wls = (LAS float*)(lds + 46080);
    LAS float* gendA = (LAS float*)(lds + 46592);
    LAS float* blastA = gendA + 2048;
    LAS float* mxA = blastA + 32;
    const float big = a->in[I_BIG][h], bfg = a->in[I_BFG][h];
    {
        float lf4[4], ig4[4];
#pragma unroll
        for (int i = 0; i < 4; ++i) { const float* gp = gates + (size_t)(row0 + 64 * (w + 8 * i) + lane) * 16 + h; ig4[i] = gp[0] + big; lf4[i] = logsigf(gp[8] + bfg); }
#pragma unroll
        for (int i = 0; i < 4; ++i) { const float bcum = wave_incl_sum(lf4[i], lane), blast = __shfl(bcum, 63), gend = blast - bcum + ig4[i]; const float mx = wave_max(gend);
            gendA[(w + 8 * i) * 64 + lane] = gend; if (lane == 0) { blastA[w + 8 * i] = blast; mxA[w + 8 * i] = mx; } }
    }
    LDS_BARRIER();
    const bf16* kptr = proj + (size_t)(row0 + lane) * NPROJ_PAD + 1024 + h * 128 + 16 * w;
    const bf16* vptr = proj + (size_t)(row0 + lane) * NPROJ_PAD + 2048 + h * 256 + 32 * vs + 8 * (w & 3);
    f32x4 acc[2]; acc[0] = (f32x4){0.f, 0.f, 0.f, 0.f}; acc[1] = acc[0];
    float nst = 0.f, m = 0.f;
    v4u kq[2][2], vq[2];
#define ML_LOAD(set, c_) do { const size_t ro = (size_t)(c_) * 64 * NPROJ_PAD; kq[set][0] = *(const v4u*)(kptr + ro); kq[set][1] = *(const v4u*)(kptr + ro + 8); \
        if (w < 4) vq[set] = *(const v4u*)(vptr + ro); } while (0)
#define ML_STEP(set, c_) do { const int item = chain * 32 + (c_); \
        const float blast = blastA[(c_)], gend = gendA[(c_) * 64 + lane]; \
        const float mnew = fmaxf(blast + m, mxA[(c_)]), sc = fexp(blast + m - mnew), wv = fexp(gend - mnew) * 0.08838834764831845f; \
        LAS bf16* kt = KT + (set) * 9216; LAS bf16* vt = VT + (set) * 2304; \
        _Pragma("unroll") for (int i = 0; i < 2; ++i) { const unsigned uu[4] = {kq[set][i].x, kq[set][i].y, kq[set][i].z, kq[set][i].w}; const int kr = 8 * (2 * w + i); \
            _Pragma("unroll") for (int e = 0; e < 4; ++e) { kt[(kr + 2 * e) * 72 + lane] = (bf16)(uu[e] & 0xffffu); kt[(kr + 2 * e + 1) * 72 + lane] = (bf16)(uu[e] >> 16); } } \
        if (w < 4) { const unsigned uu[4] = {vq[set].x, vq[set].y, vq[set].z, vq[set].w}; \
            _Pragma("unroll") for (int e = 0; e < 4; ++e) { vt[(8 * w + 2 * e) * 72 + lane] = (bf16)f2bf(bflo(uu[e]) * wv); vt[(8 * w + 2 * e + 1) * 72 + lane] = (bf16)f2bf(bfhi(uu[e]) * wv); } } \
        if (w == 0) wls[(set) * 64 + lane] = wv; \
        if ((c_) + 2 < 32) ML_LOAD(set, (c_) + 2); \
        if (vs == 0 && tid == 0) ((float*)(ws + WS_MM))[item] = m; \
        LDS_BARRIER(); \
        _Pragma("unroll") for (int vb = 0; vb < 2; ++vb) { *(v2u*)((bf16*)(ws + WS_MC) + ((size_t)item * 256 + 32 * vs + 16 * vb + fr) * 128 + 16 * w + 4 * fq) = pack4(acc[vb]); } \
        if (vs == 0 && tid < 128) { ((float*)(ws + WS_MN))[(size_t)item * 128 + tid] = nst; float sn = 0.f; \
            _Pragma("unroll") for (int s8 = 0; s8 < 8; ++s8) { const v4u kk = *(const LAS v4u*)(kt + tid * 72 + 8 * s8); const LAS float* wl = wls + (set) * 64 + 8 * s8; \
                sn += bflo(kk.x) * wl[0] + bfhi(kk.x) * wl[1] + bflo(kk.y) * wl[2] + bfhi(kk.y) * wl[3] + bflo(kk.z) * wl[4] + bfhi(kk.z) * wl[5] + bflo(kk.w) * wl[6] + bfhi(kk.w) * wl[7]; } \
            nst = sc * nst + sn; } \
        _Pragma("unroll") for (int vb = 0; vb < 2; ++vb) { acc[vb] = acc[vb] * sc; \
            _Pragma("unroll") for (int kt2 = 0; kt2 < 2; ++kt2) { const bf16x8 af = *(const LAS bf16x8*)(kt + (16 * w + fr) * 72 + 32 * kt2 + 8 * fq), bfv = *(const LAS bf16x8*)(vt + (16 * vb + fr) * 72 + 32 * kt2 + 8 * fq); \
                acc[vb] = MFMA32(af, bfv, acc[vb]); } } \
        m = mnew; } while (0)
    ML_LOAD(0, 0); ML_LOAD(1, 1);
#pragma unroll 1
    for (int c2 = 0; c2 < 32; c2 += 2) { ML_STEP(0, c2); ML_STEP(1, c2 + 1); }
#undef ML_LOAD
#undef ML_STEP
#pragma unroll
    for (int vb = 0; vb < 2; ++vb) *(f32x4*)(a->out + O_MCP + ((size_t)chain * 256 + 32 * vs + 16 * vb + fr) * 128 + 16 * w + 4 * fq) = acc[vb];
    if (vs == 0) { if (tid < 128) a->out[O_MNP + (size_t)chain * 128 + tid] = nst; if (tid == 0) a->out[O_MMP + chain] = m; }
    LDS_BARRIER();
}

__device__ __forceinline__ void mlstm_out_item(ArgsP a, LAS unsigned char* lds, int item, const int tid) {
    const int c = item & 31, h = (item >> 5) & 7, b = item >> 8, row0 = b * TP + 64 * c;
    const int lane = tid & 63, w = __builtin_amdgcn_readfirstlane(tid >> 6), fr = lane & 15, fq = lane >> 4;
    unsigned char* ws = a->ws;
    const bf16* proj = (const bf16*)(ws + WS_PROJ); const float* gates = (const float*)(ws + WS_GATES);
    LAS bf16* VT = (LAS bf16*)lds;
    LAS float* ssq = (LAS float*)(lds + 36864);
    const int tb = w & 3, half = w >> 2, t = 16 * tb + fr;
    v4u vu[4];
#pragma unroll
    for (int i = 0; i < 4; ++i) vu[i] = *(const v4u*)(proj + (size_t)(row0 + lane) * NPROJ_PAD + 2048 + h * 256 + 8 * (w + 8 * i));
    v4u qu[4]; f32x4 nv[4][2];
#pragma unroll
    for (int ks = 0; ks < 4; ++ks) { qu[ks] = *(const v4u*)(proj + (size_t)(row0 + t) * NPROJ_PAD + h * 128 + 32 * ks + 8 * fq);
        const float* np = (const float*)(ws + WS_MN) + (size_t)item * 128 + 32 * ks + 8 * fq; nv[ks][0] = *(const f32x4*)np; nv[ks][1] = *(const f32x4*)(np + 4); }
    v4u kfr[4][4];
#pragma unroll
    for (int sb = 0; sb < 4; ++sb) if (sb <= tb) {
#pragma unroll
        for (int ks = 0; ks < 4; ++ks) kfr[sb][ks] = *(const v4u*)(proj + (size_t)(row0 + 16 * sb + fr) * NPROJ_PAD + 1024 + h * 128 + 32 * ks + 8 * fq); }
    const float mc = ((const float*)(ws + WS_MM))[item];
    float av, Mt, et, em;
    { const float ig = gates[(size_t)(row0 + lane) * 16 + h] + a->in[I_BIG][h], lf = logsigf(gates[(size_t)(row0 + lane) * 16 + 8 + h] + a->in[I_BFG][h]);
      const float bcum = wave_incl_sum(lf, lane); av = ig - bcum; Mt = fmaxf(mc, wave_incl_max(av, lane)); et = fexp(mc - Mt); em = fexp(-(bcum + Mt)); }
#pragma unroll
    for (int i = 0; i < 4; ++i) { const unsigned uu[4] = {vu[i].x, vu[i].y, vu[i].z, vu[i].w}; const int vr = 8 * (w + 8 * i);
#pragma unroll
        for (int e = 0; e < 4; ++e) { VT[(vr + 2 * e) * 72 + lane] = (bf16)(uu[e] & 0xffffu); VT[(vr + 2 * e + 1) * 72 + lane] = (bf16)(uu[e] >> 16); } }
    bf16x8 qf[4]; float qn = 0.f;
#pragma unroll
    for (int ks = 0; ks < 4; ++ks) { const v4u u = qu[ks]; qf[ks] = __builtin_bit_cast(bf16x8, u); const f32x4 n0 = nv[ks][0], n1 = nv[ks][1];
        qn += bflo(u.x) * n0.x + bfhi(u.x) * n0.y + bflo(u.y) * n0.z + bfhi(u.y) * n0.w + bflo(u.z) * n1.x + bfhi(u.z) * n1.y + bflo(u.w) * n1.z + bfhi(u.w) * n1.w; }
    qn += __shfl_xor(qn, 16); qn += __shfl_xor(qn, 32);
    const float Mtt = __shfl(Mt, t), ett = __shfl(et, t), emt = __shfl(em, t);
    const bf16* cs = (const bf16*)(ws + WS_MC) + (size_t)item * 256 * 128;
    v2u smp[4]; float rowsum = 0.f;
#pragma unroll
    for (int sb = 0; sb < 4; ++sb) { smp[sb] = (v2u){0u, 0u};
        if (sb <= tb) { f32x4 qk = (f32x4){0.f, 0.f, 0.f, 0.f};
#pragma unroll
            for (int ks = 0; ks < 4; ++ks) qk = MFMA32(__builtin_bit_cast(bf16x8, kfr[sb][ks]), qf[ks], qk);
            f32x4 sm;
#pragma unroll
            for (int j = 0; j < 4; ++j) { const int s = 16 * sb + 4 * fq + j; const float as = __shfl(av, s); sm[j] = (s <= t) ? qk[j] * 0.08838834764831845f * fexp(as - Mtt) : 0.f; rowsum += sm[j]; }
            smp[sb] = pack4(sm); } }
    rowsum += __shfl_xor(rowsum, 16); rowsum += __shfl_xor(rowsum, 32);
    const float hden = 1.f / fmaxf(fabsf(ett * qn + rowsum), emt);
    const v4u s0u = (v4u){smp[0].x, smp[0].y, smp[1].x, smp[1].y}, s1u = (v4u){smp[2].x, smp[2].y, smp[3].x, smp[3].y};
    const bf16x8 sf0 = __builtin_bit_cast(bf16x8, s0u), sf1 = __builtin_bit_cast(bf16x8, s1u);
    v4u cfr[4][4];
#pragma unroll
    for (int g4 = 0; g4 < 4; ++g4)
#pragma unroll
        for (int ks = 0; ks < 4; ++ks) cfr[g4][ks] = *(const v4u*)(cs + (size_t)(128 * half + 16 * g4 + fr) * 128 + 32 * ks + 8 * fq);
    LDS_BARRIER();
    f32x4 hv[8]; float ss = 0.f;
#pragma unroll
    for (int grp = 0; grp < 2; ++grp) {
      f32x4 accs[4];
#pragma unroll
      for (int g4 = 0; g4 < 4; ++g4) { f32x4 acc = (f32x4){0.f, 0.f, 0.f, 0.f};
#pragma unroll
          for (int ks = 0; ks < 4; ++ks) acc = MFMA32(__builtin_bit_cast(bf16x8, cfr[g4][ks]), qf[ks], acc);
          accs[g4] = acc * ett; }
      if (grp == 0) {
#pragma unroll
          for (int g4 = 0; g4 < 4; ++g4)
#pragma unroll
              for (int ks = 0; ks < 4; ++ks) cfr[g4][ks] = *(const v4u*)(cs + (size_t)(128 * half + 64 + 16 * g4 + fr) * 128 + 32 * ks + 8 * fq); }
#pragma unroll
      for (int g4 = 0; g4 < 4; ++g4) { const int vb = 4 * grp + g4, vrow = 128 * half + 16 * vb + fr; f32x4 acc = accs[g4];
        { const v2u a0 = *(const LAS v2u*)(VT + vrow * 72 + 4 * fq), a1 = *(const LAS v2u*)(VT + vrow * 72 + 16 + 4 * fq); const v4u au = (v4u){a0.x, a0.y, a1.x, a1.y}; acc = MFMA32(__builtin_bit_cast(bf16x8, au), sf0, acc); }
        { const v2u a0 = *(const LAS v2u*)(VT + vrow * 72 + 32 + 4 * fq), a1 = *(const LAS v2u*)(VT + vrow * 72 + 48 + 4 * fq); const v4u au = (v4u){a0.x, a0.y, a1.x, a1.y}; acc = MFMA32(__builtin_bit_cast(bf16x8, au), sf1, acc); }
        hv[vb] = acc * hden; ss += (hv[vb].x * hv[vb].x + hv[vb].y * hv[vb].y) + (hv[vb].z * hv[vb].z + hv[vb].w * hv[vb].w); }
    }
    ss += __shfl_xor(ss, 16); ss += __shfl_xor(ss, 32);
    if (fq == 0) ssq[half * 64 + t] = ss;
    LDS_BARRIER();
    const float rstd = rsqrtf((ssq[t] + ssq[64 + t]) * (1.f / 256.f) + RMS_EPS);
    const bf16* op = proj + (size_t)(row0 + t) * NPROJ_PAD + 4096 + h * 256 + 128 * half + 4 * fq;
    bf16* mp = (bf16*)(ws + WS_MIX) + (size_t)(row0 + t) * D + h * 256 + 128 * half + 4 * fq;
    const float* nw = a->in[I_MNORM] + h * 256 + 128 * half + 4 * fq;
    v2u opr[8];
#pragma unroll
    for (int vb = 0; vb < 8; ++vb) opr[vb] = *(const v2u*)(op + 16 * vb);
#pragma unroll
    for (int vb = 0; vb < 8; ++vb) { const v2u o = opr[vb]; const f32x4 n4 = *(const f32x4*)(nw + 16 * vb);
        f32x4 y; y.x = hv[vb].x * rstd * n4.x * sigm(bflo(o.x)); y.y = hv[vb].y * rstd * n4.y * sigm(bfhi(o.x)); y.z = hv[vb].z * rstd * n4.z * sigm(bflo(o.y)); y.w = hv[vb].w * rstd * n4.w * sigm(bfhi(o.y));
        *(v2u*)(mp + 16 * vb) = pack4(y); }
    LDS_BARRIER();
}


__device__ __forceinline__ void mlstm_sample_load(ArgsP a, int j, const int tid, f32x4 (&cst)[2][4][2]) {
    const int lane = tid & 63, w = __builtin_amdgcn_readfirstlane(tid >> 6), fr = lane & 15, fq = lane >> 4;
    const float* C0 = a->in[I_SMC] + (size_t)j * 32768;
#pragma unroll
    for (int vb = 0; vb < 2; ++vb)
#pragma unroll
        for (int ksp = 0; ksp < 4; ++ksp) { const float* cp = C0 + (size_t)(32 * w + 16 * vb + fr) * 128 + 32 * ksp + 4 * fq; cst[vb][ksp][0] = __builtin_nontemporal_load((const f32x4*)cp); cst[vb][ksp][1] = __builtin_nontemporal_load((const f32x4*)(cp + 16)); }
}
__device__ __forceinline__ void mlstm_sample_item(ArgsP a, LAS unsigned char* lds, int j, const int tid, const f32x4 (&cst)[2][4][2]) {
    const int b = j >> 3, h = j & 7, row0 = MP + b * TS;
    const int lane = tid & 63, w = __builtin_amdgcn_readfirstlane(tid >> 6), fr = lane & 15, fq = lane >> 4;
    unsigned char* ws = a->ws;
    const bf16* proj = (const bf16*)(ws + WS_PROJ); const float* gates = (const float*)(ws + WS_GATES);
    float* Cout = a->out + O_MCS + (size_t)j * 32768;
    LAS float* qs = (LAS float*)lds;
    LAS float* ks = qs + 512;
    LAS float* vs = ks + 512;
    LAS float* gs = vs + 1024;
    LAS float* qkr = gs + 8;
    LAS float* qnl = qkr + 16;
    LAS float* hbuf = qnl + 8;
#pragma unroll
    for (int tok = 0; tok < 4; ++tok) { const bf16* pr = proj + (size_t)(row0 + tok) * NPROJ_PAD;
        if (tid < 128) qs[tok * 128 + tid] = bf2f(pr[h * 128 + tid]); else if (tid < 256) ks[tok * 128 + tid - 128] = bf2f(pr[1024 + h * 128 + (tid - 128)]) * 0.08838834764831845f; else vs[tok * 256 + tid - 256] = bf2f(pr[2048 + h * 256 + (tid - 256)]); }
    if (tid < 4) { gs[tid * 2] = gates[(size_t)(row0 + tid) * 16 + h] + a->in[I_BIG][h]; gs[tid * 2 + 1] = gates[(size_t)(row0 + tid) * 16 + 8 + h] + a->in[I_BFG][h]; }
    const float n0a = a->in[I_SMN][(size_t)j * 128 + lane], n0b = a->in[I_SMN][(size_t)j * 128 + 64 + lane];
    const float m0 = a->in[I_SMM][j];
    LDS_BARRIER();
#pragma unroll
    for (int i = 0; i < 2; ++i) { const int p = 2 * w + i, t = p >> 2, sx = p & 3; const float d = wave_sum(qs[t * 128 + lane] * ks[sx * 128 + lane] + qs[t * 128 + 64 + lane] * ks[sx * 128 + 64 + lane]); if (lane == 0) qkr[p] = d; }
    if (w < 4) { const float d = wave_sum(qs[w * 128 + lane] * n0a + qs[w * 128 + 64 + lane] * n0b); if (lane == 0) qnl[w] = d; }
    float bc[4], ig[4], mt[4], m = m0, bsum = 0.f;
#pragma unroll
    for (int t = 0; t < 4; ++t) { ig[t] = gs[t * 2]; const float lf = logsigf(gs[t * 2 + 1]); bsum += lf; bc[t] = bsum; m = fmaxf(lf + m, ig[t]); mt[t] = m; }
    const float scf = fexp(bc[3] + m0 - mt[3]);
    float wsf[4], et[4];
#pragma unroll
    for (int t = 0; t < 4; ++t) { wsf[t] = fexp(bc[3] - bc[t] + ig[t] - mt[3]); et[t] = fexp(bc[t] + m0 - mt[t]); }
    LDS_BARRIER();
    float S[4][4], hden[4];
#pragma unroll
    for (int t = 0; t < 4; ++t) { float den = et[t] * qnl[t];
#pragma unroll
        for (int sx = 0; sx < 4; ++sx) { S[t][sx] = (sx <= t) ? qkr[t * 4 + sx] * fexp(bc[t] - bc[sx] + ig[sx] - mt[t]) : 0.f; den += S[t][sx]; }
        hden[t] = 1.f / fmaxf(fabsf(den), fexp(-mt[t])); }
    bf16x8 qa[4];
#pragma unroll
    for (int ksp = 0; ksp < 4; ++ksp) { v4u u = (v4u){0u, 0u, 0u, 0u};
        if (fr < 4) { const f32x4 x0 = *(const LAS f32x4*)(qs + fr * 128 + 32 * ksp + 4 * fq), x1 = *(const LAS f32x4*)(qs + fr * 128 + 32 * ksp + 16 + 4 * fq); u.x = pk2(x0.x, x0.y); u.y = pk2(x0.z, x0.w); u.z = pk2(x1.x, x1.y); u.w = pk2(x1.z, x1.w); }
        qa[ksp] = __builtin_bit_cast(bf16x8, u); }
#pragma unroll
    for (int vb = 0; vb < 2; ++vb) { const int v = 32 * w + 16 * vb + fr;
        float vw[4];
#pragma unroll
        for (int sx = 0; sx < 4; ++sx) vw[sx] = vs[sx * 256 + v] * wsf[sx];
        f32x4 dacc = (f32x4){0.f, 0.f, 0.f, 0.f};
#pragma unroll
        for (int ksp = 0; ksp < 4; ++ksp) { const f32x4 c0 = cst[vb][ksp][0], c1 = cst[vb][ksp][1];
            v4u u; u.x = pk2(c0.x, c0.y); u.y = pk2(c0.z, c0.w); u.z = pk2(c1.x, c1.y); u.w = pk2(c1.z, c1.w);
            dacc = MFMA32(qa[ksp], __builtin_bit_cast(bf16x8, u), dacc);
            f32x4 n0v = c0 * scf, n1v = c1 * scf;
#pragma unroll
            for (int sx = 0; sx < 4; ++sx) { const f32x4 k0 = *(const LAS f32x4*)(ks + sx * 128 + 32 * ksp + 4 * fq), k1 = *(const LAS f32x4*)(ks + sx * 128 + 32 * ksp + 16 + 4 * fq); n0v = n0v + k0 * vw[sx]; n1v = n1v + k1 * vw[sx]; }
            float* op = Cout + (size_t)v * 128 + 32 * ksp + 4 * fq; __builtin_nontemporal_store(n0v, (f32x4*)op); __builtin_nontemporal_store(n1v, (f32x4*)(op + 16)); }
        if (fq == 0) {
#pragma unroll
            for (int t = 0; t < 4; ++t) { float num = et[t] * dacc[t];
#pragma unroll
                for (int sx = 0; sx < 4; ++sx) num += S[t][sx] * vs[sx * 256 + v];
                hbuf[t * 256 + v] = num * hden[t]; } }
    }
    if (tid < 128) { float nn = scf * a->in[I_SMN][(size_t)j * 128 + tid];
#pragma unroll
        for (int sx = 0; sx < 4; ++sx) nn += wsf[sx] * ks[sx * 128 + tid];
        a->out[O_MNS + (size_t)j * 128 + tid] = nn; }
    if (tid == 0) a->out[O_MMS + j] = mt[3];
    LDS_BARRIER();
    if (w < 4) { const int tok = w, row = row0 + tok; float hv[4]; float ss = 0.f;
#pragma unroll
        for (int i = 0; i < 4; ++i) { hv[i] = hbuf[tok * 256 + i * 64 + lane]; ss += hv[i] * hv[i]; }
        const float rstd = rsqrtf(wave_sum(ss) * (1.f / 256.f) + RMS_EPS);
        const float* nw = a->in[I_MNORM] + h * 256; bf16* mix = (bf16*)(ws + WS_MIX);
#pragma unroll
        for (int i = 0; i < 4; ++i) { const int vi = i * 64 + lane; const float op = bf2f(proj[(size_t)row * NPROJ_PAD + 4096 + h * 256 + vi]);
            mix[(size_t)row * D + h * 256 + vi] = (bf16)f2bf(hv[i] * rstd * nw[vi] * sigm(op)); } }
    LDS_BARRIER();
}


__device__ __forceinline__ void lru_sample_loop(ArgsP a, LAS unsigned char* lds, int vcu, int G, const int tid) {
    const int d = tid & 127, part = tid >> 7, n = vcu & 7, chn = n * 128 + d;
    const bf16* proj = (const bf16*)(a->ws + WS_PROJ); bf16* mix = (bf16*)(a->ws + WS_MIX);
    const float* wconv = a->in[I_WCONV]; const float* bconv = a->in[I_BCONV];
    const float* wr = a->in[I_LWR] + (size_t)n * 16384; const float* wi = a->in[I_LWI] + (size_t)n * 16384;
    LAS float* xr = (LAS float*)lds;
    LAS float* red = xr + 512;
    float w1[32], w2[32];
#pragma unroll
    for (int cc = 0; cc < 32; ++cc) { w1[cc] = wr[(part * 32 + cc) * 128 + d]; w2[cc] = wi[(part * 32 + cc) * 128 + d]; }
    const float br = a->in[I_LBR][chn], bi = a->in[I_LBI][chn], spl = softplusf(-a->in[I_LLAM][chn]);
#pragma unroll 1
    for (int j = vcu; j < 1024; j += G) {
        const int b = j >> 3, row0 = MP + b * TS; const float* cstate = a->in[I_SCONV] + (size_t)b * 3 * 4096;
        float hst = a->in[I_SLRU][(size_t)b * 1024 + chn];
        float gt[4];
        if (part == 0) {
#pragma unroll
            for (int tok = 0; tok < 4; ++tok) gt[tok] = bf2f(proj[(size_t)(row0 + tok) * NPROJ_PAD + 5120 + chn]); }
        { const int tok = tid >> 7; xr[tok * 128 + d] = conv4(proj, row0, tok, 3072 + chn, cstate, wconv, bconv); }
        LDS_BARRIER();
        float ar[4] = {0.f, 0.f, 0.f, 0.f}, ai[4] = {0.f, 0.f, 0.f, 0.f};
#pragma unroll
        for (int cc = 0; cc < 32; ++cc) { const int c = part * 32 + cc;
#pragma unroll
            for (int tok = 0; tok < 4; ++tok) { const float x = xr[tok * 128 + c]; ar[tok] += x * w1[cc]; ai[tok] += x * w2[cc]; } }
#pragma unroll
        for (int tok = 0; tok < 4; ++tok) { red[((tok * 2 + 0) * 4 + part) * 128 + d] = ar[tok]; red[((tok * 2 + 1) * 4 + part) * 128 + d] = ai[tok]; }
        LDS_BARRIER();
        if (part == 0) {
#pragma unroll
            for (int tok = 0; tok < 4; ++tok) {
                float rp = br, ip = bi;
#pragma unroll
                for (int p = 0; p < 4; ++p) { rp += red[((tok * 2 + 0) * 4 + p) * 128 + d]; ip += red[((tok * 2 + 1) * 4 + p) * 128 + d]; }
                const float log_a = -8.f * sigm(rp) * spl;
                const float av = fexp(log_a);
                const float bx = sqrtf(neg_expm1(2.f * log_a)) * sigm(ip) * xr[tok * 128 + d];
                hst = av * hst + bx;
                mix[(size_t)(row0 + tok) * D + 1024 + chn] = (bf16)f2bf(hst * gelu_tanh(gt[tok]));
            }
            a->out[O_LRUS + (size_t)b * 1024 + chn] = hst;
        }
        LDS_BARRIER();
    }
}

__device__ __forceinline__ void phase_mixer_even(ArgsP a, LAS unsigned char* lds, int vcu, int G, const int tid) {
#pragma unroll 1
    for (int r = 0; r < 1 + (PROBE_SUB & 1); ++r)
#pragma unroll 1
    for (int it = vcu; it < 1024; it += G) { int tq = tid; asm volatile("" : "+v"(tq)); delta_prep_item(a, lds, it, tq); }
#pragma unroll 1
    for (int r = 0; r < 1 + ((PROBE_SUB >> 1) & 1); ++r)
#pragma unroll 1
    for (int it = vcu; it < 1024; it += G) lru_prep_item(a, lds, it, tid);
#pragma unroll 1
    for (int r = 0; r < 1 + ((PROBE_SUB >> 2) & 1); ++r)
#pragma unroll 1
    for (int j = vcu; j < 1024; j += G) { const int b = j >> 3, hn = j & 7; delta_rec_item(a, lds, MP + b * TS, TS, hn, a->in[I_SCONV] + (size_t)b * 3 * 4096, a->in[I_SDELTA] + (size_t)j * 16384, a->out + O_DELTAS + (size_t)j * 16384, tid); }
#pragma unroll 1
    for (int r = 0; r < 1 + ((PROBE_SUB >> 3) & 1); ++r)
    lru_sample_loop(a, lds, vcu, G, tid);
    const bf16* proj = (const bf16*)(a->ws + WS_PROJ);
    const int npieces = (BP + BS) * 3 * 512;
    for (int i = vcu * NTHR + tid; i < npieces; i += G * NTHR) {
        const int c8 = i & 511, rj = i >> 9, j = rj % 3, b = rj / 3;
        const bf16* src; float* dst;
        if (b < BP) { src = proj + (size_t)(b * TP + TP - 3 + j) * NPROJ_PAD + 8 * c8; dst = a->out + O_CONVP + (size_t)(b * 3 + j) * 4096 + 8 * c8; }
        else { const int bs = b - BP; src = proj + (size_t)(MP + bs * TS + 1 + j) * NPROJ_PAD + 8 * c8; dst = a->out + O_CONVS + (size_t)(bs * 3 + j) * 4096 + 8 * c8; }
        const v4u u = *(const v4u*)src;
        *(f32x4*)dst = (f32x4){bflo(u.x), bfhi(u.x), bflo(u.y), bfhi(u.y)}; *(f32x4*)(dst + 4) = (f32x4){bflo(u.z), bfhi(u.z), bflo(u.w), bfhi(u.w)};
    }
}
__device__ __forceinline__ void phase_mixer_even_b(ArgsP a, LAS unsigned char* lds, int vcu, int G, const int tid) {
    const int w = __builtin_amdgcn_readfirstlane(tid >> 6);
    if (w == 0) { for (int it = vcu; it < 256; it += G) delta_scan_wave(a, it >> 3, it & 7, tid & 63); }
    else { LAS float* scr = (LAS float*)(lds + w * 16384);
        convert_range(a, scr, cv::R_IN0, cv::R_SCAN, vcu * 7 + (w - 1), G * 7, tid & 63); }
}
__device__ __forceinline__ void phase_mixer_even_c(ArgsP a, LAS unsigned char* lds, int vcu, int G, const int tid) {
    const int w = tid >> 6;
#pragma unroll 1
    for (int it = vcu; it < 512; it += G) delta_out_wave(a, 2 * it + (w >> 2), w & 3, tid & 63);
#pragma unroll 1
    for (int it = vcu; it < 1024; it += G) lru_out_item(a, lds, it, tid);
    for (int chain = vcu; chain < 32; chain += G) {
        const f32x4* src = (const f32x4*)(a->ws + WS_DF) + (size_t)chain * 4096; float* dst = a->out + O_DELTAP + (size_t)chain * 16384;
        f32x4 v[8];
#pragma unroll
        for (int i = 0; i < 8; ++i) v[i] = src[tid + 512 * i];
#pragma unroll
        for (int i = 0; i < 8; ++i) { const int idx = tid + 512 * i, ln = idx & 63, rb = (idx >> 6) & 7, s8 = idx >> 9; const int dk0 = 16 * rb + 4 * (ln >> 4), dv = 16 * s8 + (ln & 15);
            dst[(size_t)(dk0 + 0) * 128 + dv] = v[i].x; dst[(size_t)(dk0 + 1) * 128 + dv] = v[i].y; dst[(size_t)(dk0 + 2) * 128 + dv] = v[i].z; dst[(size_t)(dk0 + 3) * 128 + dv] = v[i].w; }
    }
}
__device__ __forceinline__ void phase_mixer_odd(ArgsP a, LAS unsigned char* lds, int vcu, int G, const int tid) {
#pragma unroll 1
    for (int r = 0; r < 1 + ((PROBE_SUB >> 4) & 1); ++r)
#pragma unroll 1
    for (int it = vcu; it < 256; it += G) mlstm_scan_item(a, lds, it >> 3, it & 7, tid);
#pragma unroll 1
    for (int r = 0; r < 1 + ((PROBE_SUB >> 5) & 1); ++r)
    {
        f32x4 cA[2][4][2], cB[2][4][2]; int j = vcu;
        if (j < 1024) { mlstm_sample_load(a, j, tid, cA);
#pragma unroll 1
            for (;;) {
                const int jB = j + G; const bool hasB = jB < 1024;
                if (hasB) mlstm_sample_load(a, jB, tid, cB);
                mlstm_sample_item(a, lds, j, tid, cA);
                if (!hasB) break;
                j = jB + G; const bool hasA = j < 1024;
                if (hasA) mlstm_sample_load(a, j, tid, cA);
                mlstm_sample_item(a, lds, jB, tid, cB);
                if (!hasA) break;
            } }
    }
}
__device__ __forceinline__ void phase_mixer_odd_b(ArgsP a, LAS unsigned char* lds, int vcu, int G, const int tid) {
#pragma unroll 1
    for (int it = vcu; it < 1024; it += G) mlstm_out_item(a, lds, it, tid);
}

__device__ __forceinline__ void phase_ln(const bf16* VB, const float* ST, const float* p1, const bf16* resid, const float* g, const float* bta, bf16* dst, LAS unsigned char* lds, int vcu, int G, const int tid) {
    const int lane = tid & 63, w = __builtin_amdgcn_readfirstlane(tid >> 6), gw = vcu * NWAVES + w, NGW = G * NWAVES;
    {
        LAS float* red = (LAS float*)lds;
        for (int r0 = 2 * vcu; r0 < MS; r0 += 2 * G) {
            const int r = r0 + (w >> 2), q = w & 3, col = 512 * q + 8 * lane; const size_t off = (size_t)(MP + r) * D + col;
            const bf16* q1 = (const bf16*)p1 + (size_t)r * D + col;
            f32x4 x0 = (f32x4){0.f, 0.f, 0.f, 0.f}, x1 = x0; v4u cq[16];
#pragma unroll
            for (int ch = 0; ch < 16; ++ch) cq[ch] = *(const v4u*)(q1 + (size_t)ch * 512 * D);
#pragma unroll
            for (int ch = 0; ch < 16; ++ch) { x0.x += bflo(cq[ch].x); x0.y += bfhi(cq[ch].x); x0.z += bflo(cq[ch].y); x0.w += bfhi(cq[ch].y); x1.x += bflo(cq[ch].z); x1.y += bfhi(cq[ch].z); x1.z += bflo(cq[ch].w); x1.w += bfhi(cq[ch].w); }
            const v4u rr = *(const v4u*)(resid + off);
            float v[8] = {x0.x + DN_ALPHA * bflo(rr.x), x0.y + DN_ALPHA * bfhi(rr.x), x0.z + DN_ALPHA * bflo(rr.y), x0.w + DN_ALPHA * bfhi(rr.y),
                          x1.x + DN_ALPHA * bflo(rr.z), x1.y + DN_ALPHA * bfhi(rr.z), x1.z + DN_ALPHA * bflo(rr.w), x1.w + DN_ALPHA * bfhi(rr.w)};
            float s = 0.f, ss = 0.f;
#pragma unroll
            for (int i = 0; i < 8; ++i) { s += v[i]; ss += v[i] * v[i]; }
            s = wave_sum(s); ss = wave_sum(ss);
            if (lane == 0) { red[w * 2] = s; red[w * 2 + 1] = ss; }
            LDS_BARRIER();
            const int wb = (w >> 2) * 4; s = (red[wb * 2] + red[wb * 2 + 2]) + (red[wb * 2 + 4] + red[wb * 2 + 6]); ss = (red[wb * 2 + 1] + red[wb * 2 + 3]) + (red[wb * 2 + 5] + red[wb * 2 + 7]);
            const float mean = s * (1.f / D), rstd = rsqrtf(fmaxf(ss * (1.f / D) - mean * mean, 0.f) + LN_EPS);
            const f32x4 g0 = *(const f32x4*)(g + col), g1 = *(const f32x4*)(g + col + 4), b0 = *(const f32x4*)(bta + col), b1 = *(const f32x4*)(bta + col + 4);
            v4u o; o.x = pk2((v[0] - mean) * rstd * g0.x + b0.x, (v[1] - mean) * rstd * g0.y + b0.y); o.y = pk2((v[2] - mean) * rstd * g0.z + b0.z, (v[3] - mean) * rstd * g0.w + b0.w);
            o.z = pk2((v[4] - mean) * rstd * g1.x + b1.x, (v[5] - mean) * rstd * g1.y + b1.y); o.w = pk2((v[6] - mean) * rstd * g1.z + b1.z, (v[7] - mean) * rstd * g1.w + b1.w);
            *(v4u*)(dst + off) = o;
            LDS_BARRIER();
        }
    }
    for (int m0 = gw; m0 < MP; m0 += 4 * NGW) {
        v4u vv[4][4]; float s[4], ss[4];
#pragma unroll
        for (int i = 0; i < 4; ++i) { const int m = m0 + i * NGW; s[i] = 0.f; ss[i] = 0.f;
            if (m < MP) { if (lane < 32) { const float* sp = ST + (((size_t)(lane >> 2) * M + m) * 4 + (lane & 3)) * 2; s[i] = sp[0]; ss[i] = sp[1]; }
#pragma unroll
                for (int j = 0; j < 4; ++j) vv[i][j] = *(const v4u*)(VB + (size_t)m * D + j * 512 + lane * 8); } }
#pragma unroll
        for (int i = 0; i < 4; ++i) { const int m = m0 + i * NGW;
            if (m < MP) { const float st = wave_sum(s[i]), sst = wave_sum(ss[i]);
                const float mean = st * (1.f / D), rstd = rsqrtf(fmaxf(sst * (1.f / D) - mean * mean, 0.f) + LN_EPS);
#pragma unroll
                for (int j = 0; j < 4; ++j) { const int col = j * 512 + lane * 8; const v4u v = vv[i][j];
                    const f32x4 g0 = *(const f32x4*)(g + col), g1 = *(const f32x4*)(g + col + 4), b0 = *(const f32x4*)(bta + col), b1 = *(const f32x4*)(bta + col + 4);
                    v4u o; o.x = pk2((bflo(v.x) - mean) * rstd * g0.x + b0.x, (bfhi(v.x) - mean) * rstd * g0.y + b0.y); o.y = pk2((bflo(v.y) - mean) * rstd * g0.z + b0.z, (bfhi(v.y) - mean) * rstd * g0.w + b0.w);
                    o.z = pk2((bflo(v.z) - mean) * rstd * g1.x + b1.x, (bfhi(v.z) - mean) * rstd * g1.y + b1.y); o.w = pk2((bflo(v.w) - mean) * rstd * g1.z + b1.z, (bfhi(v.w) - mean) * rstd * g1.w + b1.w);
                    *(v4u*)(dst + (size_t)m * D + col) = o; } } }
    }
}
__device__ __forceinline__ void phase_combine(const float* p1, const bf16* h2, const bf16* pw, bf16* xb, float* outf, int vcu, int G, const int tid) {
    const int lane = tid & 63, w = tid >> 6;
    for (int r0 = 2 * vcu; r0 < MS; r0 += 2 * G) {
        const int r = r0 + (w >> 2), q = w & 3, col = 512 * q + 8 * lane; const size_t off = (size_t)(MP + r) * D + col;
        const bf16* q1 = (const bf16*)p1 + (size_t)r * D + col;
        f32x4 x0 = (f32x4){0.f, 0.f, 0.f, 0.f}, x1 = x0; v4u cq[16];
#pragma unroll
        for (int ch = 0; ch < 16; ++ch) cq[ch] = *(const v4u*)(q1 + (size_t)ch * 512 * D);
#pragma unroll
        for (int ch = 0; ch < 16; ++ch) { x0.x += bflo(cq[ch].x); x0.y += bfhi(cq[ch].x); x0.z += bflo(cq[ch].y); x0.w += bfhi(cq[ch].y); x1.x += bflo(cq[ch].z); x1.y += bfhi(cq[ch].z); x1.z += bflo(cq[ch].w); x1.w += bfhi(cq[ch].w); }
        const v4u hh = *(const v4u*)(h2 + off), pp = *(const v4u*)(pw + off);
        f32x4 o0, o1;
        o0.x = bflo(hh.x) + sigm(x0.x) * bflo(pp.x); o0.y = bfhi(hh.x) + sigm(x0.y) * bfhi(pp.x); o0.z = bflo(hh.y) + sigm(x0.z) * bflo(pp.y); o0.w = bfhi(hh.y) + sigm(x0.w) * bfhi(pp.y);
        o1.x = bflo(hh.z) + sigm(x1.x) * bflo(pp.z); o1.y = bfhi(hh.z) + sigm(x1.y) * bfhi(pp.z); o1.z = bflo(hh.w) + sigm(x1.z) * bflo(pp.w); o1.w = bfhi(hh.w) + sigm(x1.w) * bfhi(pp.w);
        v4u ob; ob.x = pk2(o0.x, o0.y); ob.y = pk2(o0.z, o0.w); ob.z = pk2(o1.x, o1.y); ob.w = pk2(o1.z, o1.w); *(v4u*)(xb + off) = ob;
        if (outf) { *(f32x4*)(outf + off) = o0; *(f32x4*)(outf + off + 4) = o1; }
    }
}

constexpr int N_PHASES = 22;
enum { OP_INPROJ = 0, OP_MIXA, OP_MIXB, OP_MIXC, OP_OUTPROJ, OP_LN1, OP_UP, OP_DOWN, OP_LN2, OP_GATE, OP_COMBINE };
enum { GK_LN = 0, GK_BF16 = 1, GK_SQRELU = 2, GK_COMB = 3 };
__global__ void __launch_bounds__(NTHR, 2) mk_fwd(Args a_in) {
    extern __shared__ __attribute__((aligned(16))) unsigned char lds_raw[];
    LAS unsigned char* lds = (LAS unsigned char*)lds_raw;
    ArgsP kp = (ArgsP)__builtin_amdgcn_kernarg_segment_ptr();
    const int lo = a_in.ph_lo, hi = a_in.ph_hi;
    int wv0; { const int wtmp = (int)threadIdx.x >> 6; asm volatile("s_nop 4\n\tv_readfirstlane_b32 %0, %1\n\ts_nop 4" : "=s"(wv0) : "v"(wtmp)); }
#if MK_N_LAUNCHES == 1
    volatile LAS unsigned* xst = (volatile LAS unsigned*)(lds + LDS_CTL_OFF);
    if (threadIdx.x < 2) xst[threadIdx.x] = 0u;
    __syncthreads();
    XcdBarrier bar = xcd_barrier_post((unsigned*)(a_in.ws + WS_CTL) + 4096, xst);
#endif
    int p = lo; asm volatile("" : "+s"(p));
#pragma unroll 1
    for (; p < hi; ) {
      int nrep = 1;
      if (PROBE_MASK) { const int L_ = p <= 11 ? 0 : 1; const int q_ = p == 0 ? -1 : (L_ == 0 ? p - 1 : (p - 12 < 3 ? p - 12 : p - 11));
        int grp; if (p == 0) grp = 0; else if (q_ == OP_INPROJ || q_ == OP_UP) grp = 1; else if (q_ == OP_OUTPROJ || q_ == OP_DOWN || q_ == OP_GATE) grp = 2; else if (q_ == OP_LN1 || q_ == OP_LN2 || q_ == OP_COMBINE) grp = 3; else grp = (L_ == 0) ? 4 : 5;
        if ((PROBE_MASK >> grp) & 1) nrep = 2; }
      if (p == PROBE_P) nrep = 2;
#pragma unroll 1
      for (int rep = 0; rep < nrep; ++rep) {
        int pp = p; asm volatile("" : "+s"(pp));
        int wvs = wv0; asm volatile("" : "+s"(wvs));
        unsigned ones = ~0u; asm volatile("" : "+s"(ones));
        int tid = (wvs << 6) | (int)__builtin_amdgcn_mbcnt_hi(ones, __builtin_amdgcn_mbcnt_lo(ones, 0u)); asm volatile("" : "+v"(tid));
        int bx = blockIdx.x; asm volatile("" : "+s"(bx));
        int G = gridDim.x; asm volatile("" : "+s"(G));
        ArgsP a = kp; asm volatile("" : "+s"(a));
#define MK_VCU ((G % 8 == 0) ? (bx % 8) * (G / 8) + bx / 8 : bx)
#define MK_WAVE (__builtin_amdgcn_readfirstlane(tid >> 6))
#define MK_GW (MK_VCU * NWAVES + MK_WAVE)
#define MK_NGW (G * NWAVES)
#define MK_LANE (tid & 63)
        unsigned char* ws = a->ws;
        if (pp == 0) {
phase_convert(a, lds, MK_GW, MK_NGW, MK_WAVE, MK_LANE); }
        else {
            const int L = pp <= 11 ? 0 : 1; const int q = L == 0 ? pp - 1 : (pp - 12 < 3 ? pp - 12 : pp - 11);
            bf16* xb = (bf16*)(ws + WS_XB); bf16* mixb = (bf16*)(ws + WS_MIX); bf16* hb = (bf16*)(ws + WS_H); bf16* h2b = (bf16*)(ws + WS_H2); bf16* pwb = (bf16*)(ws + WS_PW);
            bf16* projb = (bf16*)(ws + WS_PROJ); bf16* upb = (bf16*)(ws + WS_PROJ);
            bf16* vbb = (bf16*)(ws + WS_PART0); float* stb = (float*)(ws + WS_PART0 + 34 * MiB); float* part1 = (float*)(ws + WS_PART1); float* gatesb = (float*)(ws + WS_GATES);
            if (q == OP_MIXA) { if (L == 0) phase_mixer_even(a, lds, MK_VCU, G, tid); else phase_mixer_odd(a, lds, MK_VCU, G, tid); }
            else if (q == OP_MIXB) { if (L == 0) phase_mixer_even_b(a, lds, MK_VCU, G, tid); else phase_mixer_odd_b(a, lds, MK_VCU, G, tid); }
            else if (q == OP_MIXC) { phase_mixer_even_c(a, lds, MK_VCU, G, tid); }
            else if (q == OP_LN1) phase_ln(vbb, stb, part1, xb, a->in[I_LN1G] + L * D, a->in[I_LN1B] + L * D, hb, lds, MK_VCU, G, tid);
            else if (q == OP_LN2) phase_ln(vbb, stb, part1, hb, a->in[I_LN2G] + L * D, a->in[I_LN2B] + L * D, h2b, lds, MK_VCU, G, tid);
            else if (q == OP_COMBINE) phase_combine(part1, h2b, pwb, xb, L == 1 ? a->out + O_Y : nullptr, MK_VCU, G, tid);
            else {
                for (int sub = 0; sub < (q == OP_INPROJ ? 2 : 1); ++sub) {
                    const bf16* A; const bf16* Bt; int N, K, kind; void* out = nullptr; float* gp = nullptr; const bf16* resid = nullptr; int corder = bx, gorder = G;
                    const int busy_in = ((M / 256) * (NPROJ_PAD / 256)) % 256;
                    if (q == OP_INPROJ && sub == 0) { A = xb; Bt = (const bf16*)(ws + (L == 0 ? WS_WINE : WS_WINO)); N = NPROJ_PAD; K = D; kind = GK_BF16; out = projb; gp = gatesb; }
                    else if (q == OP_INPROJ) { A = (const bf16*)(ws + WS_PB) + (size_t)L * M * PLE; Bt = (const bf16*)(ws + WS_WPLE) + (size_t)L * PLE * D; N = D; K = PLE; kind = GK_BF16; out = pwb;
                        gorder = G - busy_in; corder = (bx >= busy_in) ? bx - busy_in : 1 << 20; }
                    else if (q == OP_OUTPROJ) { A = mixb; Bt = (const bf16*)(ws + (L == 0 ? WS_WOUTE : WS_WOUTO)); N = D; K = D; kind = GK_LN; resid = xb; }
                    else if (q == OP_UP) { A = hb; Bt = (const bf16*)(ws + WS_WUP) + (size_t)L * D * FF; N = FF; K = D; kind = GK_SQRELU; out = upb; }
                    else if (q == OP_DOWN) { A = upb; Bt = (const bf16*)(ws + WS_WDOWN) + (size_t)L * D * FF; N = D; K = FF; kind = GK_LN; resid = hb; }
                    else { A = h2b; Bt = (const bf16*)(ws + WS_WGATE) + (size_t)L * D * D; N = D; K = D; kind = GK_COMB; }
                    pg8::Gemm g{A, Bt, M, N, K};
                    if (kind == GK_LN) { pg8::MainSplit SK; SK.init(K, MK_VCU); pg8::EpiLnStat E{vbb, stb, resid, part1, N, M, DN_ALPHA}; pg8::gemm_phase<pg8::EpiLnStat, pg8::MainSplit, true, true>(lds, g, SK, E, tid); }
                    else if (kind == GK_COMB) { pg8::MainSplit SK; SK.init(K, MK_VCU); pg8::EpiCombine E{h2b, pwb, xb, L == 1 ? a->out + O_Y : nullptr, part1, N}; pg8::gemm_phase<pg8::EpiCombine, pg8::MainSplit, true, true>(lds, g, SK, E, tid); }
                    else if (kind == GK_BF16) { pg8::StaticOrder S; S.init(M, N, K, gorder, corder); pg8::EpiBf16<0> E{(bf16*)out, N, gp, 24}; pg8::gemm_phase<pg8::EpiBf16<0>, pg8::StaticOrder, true, true>(lds, g, S, E, tid);}
                    else { pg8::StaticOrder S; S.init(M, N, K, G, corder); pg8::EpiBf16<1> E{(bf16*)out, N, nullptr, -1}; pg8::gemm_phase<pg8::EpiBf16<1>, pg8::StaticOrder, true, true>(lds, g, S, E, tid);}
                }
                if (q == OP_INPROJ || q == OP_UP) {
                    const int busy = (q == OP_INPROJ) ? ((M / 256) * (NPROJ_PAD / 256)) % 256 : ((M / 256) * (FF / 256)) % 256;
                    const int first = (q == OP_INPROJ) ? (L == 0 ? 0 : cv::R_SCAN) : (L == 0 ? cv::R_IN1 : cv::R_UP0), last = (q == OP_INPROJ) ? (L == 0 ? cv::R_IN0 : cv::R_IN1) : (L == 0 ? cv::R_UP0 : cv::N_REST);
                    if (G == 256 && bx >= busy) { const int w_ = MK_WAVE; convert_range(a, (LAS float*)(lds + w_ * 16384), first, last, (bx - busy) * NWAVES + w_, (G - busy) * NWAVES, MK_LANE); }
                }
            }
        }
#if MK_N_LAUNCHES == 1
        if (p + 1 < hi || rep + 1 < nrep) xcd_barrier(bar);
#endif
      }
      asm volatile("s_add_i32 %0, %0, 1" : "+s"(p) : : "scc");
    }
}

extern "C" void kernel_launch(void* const* d_in, const int* in_sizes, int n_in, void* d_out, int out_size, void* d_ws, size_t ws_size, hipStream_t stream) {
    static int grid = 0;
    if (grid == 0) {
        if (n_in != 35 || (size_t)out_size != O_END || ws_size < WS_END) { fprintf(stderr, "kernel_launch: unexpected shapes: n_in %d out %d (want %zu) ws %zu (want %zu)\n", n_in, out_size, (size_t)O_END, ws_size, (size_t)WS_END); grid = -1; return; }
        int dev = 0, cus = 0, per_cu = 0;
        hipGetDevice(&dev); hipDeviceGetAttribute(&cus, hipDeviceAttributeMultiprocessorCount, dev);
        if (hipFuncSetAttribute((const void*)mk_fwd, hipFuncAttributeMaxDynamicSharedMemorySize, LDS_BYTES) != hipSuccess) { fprintf(stderr, "kernel_launch: hipFuncSetAttribute failed\n"); grid = -1; return; }
        if (hipOccupancyMaxActiveBlocksPerMultiprocessor(&per_cu, (const void*)mk_fwd, NTHR, LDS_BYTES) != hipSuccess || per_cu < 1) { fprintf(stderr, "kernel_launch: occupancy query says %d\n", per_cu); per_cu = 1; }
        (void)hipGetLastError();
        if (cus != 256) { fprintf(stderr, "kernel_launch: built for a 256-CU device (N = 2048 GEMM schedule), got %d\n", cus); grid = -1; return; }
        grid = cus * 1;
    }
    if (grid < 0) return;
    Args a{};
    for (int i = 0; i < 35; ++i) a.in[i] = (const float*)d_in[i];
    a.out = (float*)d_out; a.ws = (unsigned char*)d_ws;
#if MK_N_LAUNCHES == 1
    hipMemsetAsync((char*)d_ws + WS_CTL, 0, 1 * MiB, stream);
    a.ph_lo = 0; a.ph_hi = N_PHASES;
    hipLaunchKernelGGL(mk_fwd, dim3(grid), dim3(NTHR), LDS_BYTES, stream, a);
#else
    for (int p = 0; p < N_PHASES; ++p) {
        a.ph_lo = p; a.ph_hi = p + 1;
        hipLaunchKernelGGL(mk_fwd, dim3(grid), dim3(NTHR), LDS_BYTES, stream, a);
    }
#endif
}
```

```cpp
#include <hip/hip_runtime.h>
#include <hip/hip_cooperative_groups.h>
#include <cstdio>
#include <cstdint>
namespace cg = cooperative_groups;

#ifndef PROBE_MASK
#define PROBE_MASK 0
#endif
#define PROBE_P (-1)
#define PROBE_SUB 0
#ifndef MK_N_LAUNCHES
#define MK_N_LAUNCHES 1
#endif

namespace pg8 {
#define PG8_LAS __attribute__((address_space(3)))
typedef unsigned short bf16_t;
typedef short bf16x8 __attribute__((ext_vector_type(8)));
typedef float f32x4 __attribute__((ext_vector_type(4)));
typedef unsigned u32x4 __attribute__((ext_vector_type(4)));
constexpr int BM = 256, BK = 64, HALF = 128, HTB = HALF * BK * 2, STAGE_BYTES = 8 * HTB, NXCD = 8, WGM = 8;

__host__ __device__ __forceinline__ int lds_byte(int r, int c) { const int st = (r >> 4) * 2 + (c >> 5), rr = r & 15, cc = c & 31, ob = rr * 64 + cc * 2; return st * 1024 + (ob ^ (((ob >> 9) & 1) << 5)); }
__host__ __device__ __forceinline__ void stage_rc(int b, int& R, int& C) { const int st = b / 1024, sb = b % 1024, swz = sb ^ (((sb >> 9) & 1) << 5); R = (st >> 1) * 16 + swz / 64; C = (st & 1) * 32 + (swz % 64) / 2; }
__host__ __device__ __forceinline__ int perm32(int rho) { const int n = rho >> 4, i = rho & 15; return 8 * (i >> 2) + 4 * n + (i & 3); }

struct Unit { int pm, pn, kt0, nkt, dst; };
struct Gemm { const bf16_t* A; const bf16_t* Bt; int M, N, K; };

__device__ __forceinline__ void wait_rows_ready(unsigned* rdy, unsigned need) {
    unsigned sp = 0u;
    while (__hip_atomic_load(rdy, __ATOMIC_RELAXED, __HIP_MEMORY_SCOPE_AGENT) < need) { __builtin_amdgcn_s_sleep(1); if (++sp > (1u << 22)) break; }
    asm volatile("" ::: "memory");
}
struct StaticOrder {
    int nM, nN, nwg, G, c, T; unsigned* rdy = nullptr; unsigned need = 0u; unsigned* sig = nullptr;
    __host__ __device__ void init(int M, int N, int K, int G_, int c_) { nM = M / BM; nN = N / BM; nwg = nM * nN; G = G_; c = c_; T = K / BK; }
    __host__ __device__ bool next(int i, Unit& u) const {
        const long L = (long)i * G + c; if (L >= nwg) return false;
        int wgid = (int)L; { const int q = nwg / NXCD, r = nwg % NXCD, xcd = wgid % NXCD, off = wgid / NXCD; wgid = (xcd < r ? xcd * (q + 1) : r * (q + 1) + (xcd - r) * q) + off; }
        const int nig = WGM * nN, gid = wgid / nig, fm = gid * WGM, gsz = (nM - fm) < WGM ? (nM - fm) : WGM;
        u.pm = fm + ((wgid % nig) % gsz); u.pn = (wgid % nig) / gsz; u.kt0 = 0; u.nkt = T; u.dst = 0; return true;
    }
    __device__ __forceinline__ void a_ready(const Unit& u) const { if (rdy != nullptr && u.pm >= 32) wait_rows_ready(rdy, need); }
    __device__ __forceinline__ void done(const Unit&) const {}
    __device__ __forceinline__ void started(int tid) const { if (sig != nullptr && tid == 0) (void)__hip_atomic_fetch_add(sig, 1u, __ATOMIC_RELAXED, __HIP_MEMORY_SCOPE_AGENT); }
};
struct StreamK {
    int nN, T, P, ntot, c;
    __host__ __device__ void init(int M, int N, int K, int G, int c_) { nN = N / BM; T = K / BK; ntot = (M / BM) * nN * T; P = (((ntot + G - 1) / G) + 1) & ~1; c = c_; }
    __host__ __device__ bool next(int i, Unit& u) const {
        int s = c * P; const int e = (s + P < ntot) ? s + P : ntot;
        for (int k = 0; ; ++k) { if (s >= e) return false; const int tile = s / T, kt0 = s - tile * T; const int n = (T - kt0 < e - s) ? T - kt0 : e - s;
            if (k == i) { u.pm = tile / nN; u.pn = tile - u.pm * nN; u.kt0 = kt0; u.nkt = n; u.dst = kt0 ? 1 : 0; return true; }
            s += n; }
    }
    __device__ __forceinline__ void a_ready(const Unit&) const {}
    __device__ __forceinline__ void done(const Unit&) const {}
    __device__ __forceinline__ void started(int) const {}
};
struct MainSplit {
    int T, c; unsigned* rdy = nullptr; unsigned need = 0u; unsigned* sig = nullptr;
    __host__ __device__ void init(int K, int c_) { T = K / BK; c = c_; }
    __host__ __device__ bool next(int i, Unit& u) const {
        if (i == 0) { u.pm = c >> 3; u.pn = c & 7; u.kt0 = 0; u.nkt = T; u.dst = 0; return true; }
        if (i == 1) { const int lt = c >> 4, j = c & 15; u.pm = 32 + (lt >> 3); u.pn = lt & 7; u.nkt = T >> 4; u.kt0 = j * u.nkt; u.dst = 1 + j; return true; }
        return false;
    }
    __device__ __forceinline__ void a_ready(const Unit& u) const { if (rdy != nullptr && u.pm >= 32) wait_rows_ready(rdy, need); }
    __device__ __forceinline__ void done(const Unit&) const {}
    __device__ __forceinline__ void started(int tid) const { if (sig != nullptr && tid == 0) (void)__hip_atomic_fetch_add(sig, 1u, __ATOMIC_RELAXED, __HIP_MEMORY_SCOPE_AGENT); }
};
__host__ __device__ __forceinline__ bool split_tile(int tile, int T, int P) { return (tile * T) / P != ((tile + 1) * T - 1) / P; }

typedef __bf16 hwbf16x2 __attribute__((ext_vector_type(2)));
typedef float hwf32x2 __attribute__((ext_vector_type(2)));
__device__ __forceinline__ unsigned cvt_pk_bf16(float lo, float hi) { return __builtin_bit_cast(unsigned, __builtin_convertvector((hwf32x2){lo, hi}, hwbf16x2)); }

__device__ __forceinline__ float pg_bflo(unsigned w) { return __builtin_bit_cast(float, w << 16); }
__device__ __forceinline__ float pg_bfhi(unsigned w) { return __builtin_bit_cast(float, w & 0xffff0000u); }
__device__ __forceinline__ void store_chunk(const f32x4 (&acc)[2][2][4][2], const Unit& u, float* C1, int ldc, int wr, int wc, int fr, int fq) {
    const int row0 = u.pm * BM + wr * 64 + fr, col0 = u.pn * BM + wc * 32 + 8 * fq; bf16_t* Cb = (bf16_t*)C1 + ((long)(u.dst - 1) * 512 - 8192) * (long)ldc;
#pragma unroll
    for (int ai = 0; ai < 2; ++ai)
#pragma unroll
        for (int m = 0; m < 4; ++m) { bf16_t* rowp = Cb + (size_t)(row0 + ai * HALF + m * 16) * ldc + col0;
#pragma unroll
            for (int bj = 0; bj < 2; ++bj) { const f32x4 v0 = acc[ai][bj][m][0], v1 = acc[ai][bj][m][1];
                u32x4 w; w.x = cvt_pk_bf16(v0[0], v0[1]); w.y = cvt_pk_bf16(v0[2], v0[3]); w.z = cvt_pk_bf16(v1[0], v1[1]); w.w = cvt_pk_bf16(v1[2], v1[3]);
                *(u32x4*)(rowp + bj * HALF) = w; } }
}
template <bool LNRES> struct EpiLnStat {
    static constexpr bool PERM = true, AFTER_DRAIN = false;
    bf16_t* VB; float* ST; const bf16_t* resid; float* C1; int ldc; int mrows; float alpha; const float* stf; const float* g; const float* b;
    __device__ __forceinline__ void operator()(const f32x4 (&acc)[2][2][4][2], const Unit& u, int wr, int wc, int fr, int fq) const {
        if (u.dst) { store_chunk(acc, u, C1, ldc, wr, wc, fr, fq); return; }
        const int row0 = u.pm * BM + wr * 64 + fr, col0 = u.pn * BM + wc * 32 + 8 * fq;
        f32x4 gv[2][2], bv[2][2];
        if (LNRES) {
#pragma unroll
            for (int bj = 0; bj < 2; ++bj) { gv[bj][0] = *(const f32x4*)(g + col0 + bj * HALF); gv[bj][1] = *(const f32x4*)(g + col0 + bj * HALF + 4); bv[bj][0] = *(const f32x4*)(b + col0 + bj * HALF); bv[bj][1] = *(const f32x4*)(b + col0 + bj * HALF + 4); } }
        u32x4 rq[2]; hwf32x2 sq = (hwf32x2){0.f, 1.f};
#pragma unroll
        for (int bj = 0; bj < 2; ++bj) rq[bj] = *(const u32x4*)(resid + (size_t)(row0) * ldc + col0 + bj * HALF);
        if (LNRES) sq = *(const hwf32x2*)(stf + 2 * (size_t)row0);
#pragma unroll
        for (int idx = 0; idx < 8; ++idx) { const int ai = idx >> 2, m = idx & 3; const int row = row0 + ai * HALF + m * 16; float s = 0.f, ss = 0.f;
                u32x4 rc[2] = {rq[0], rq[1]}; const hwf32x2 sc = sq;
                if (idx + 1 < 8) { const int nrow = row0 + ((idx + 1) >> 2) * HALF + ((idx + 1) & 3) * 16;
#pragma unroll
                    for (int bj = 0; bj < 2; ++bj) rq[bj] = *(const u32x4*)(resid + (size_t)nrow * ldc + col0 + bj * HALF);
                    if (LNRES) sq = *(const hwf32x2*)(stf + 2 * (size_t)nrow); }
#pragma unroll
                for (int bj = 0; bj < 2; ++bj) { const size_t off = (size_t)row * ldc + col0 + bj * HALF; const u32x4 r = rc[bj];
                    f32x4 v0 = acc[ai][bj][m][0], v1 = acc[ai][bj][m][1];
                    float rr[8] = {pg_bflo(r.x), pg_bfhi(r.x), pg_bflo(r.y), pg_bfhi(r.y), pg_bflo(r.z), pg_bfhi(r.z), pg_bflo(r.w), pg_bfhi(r.w)};
                    if (LNRES) {
#pragma unroll
                        for (int j = 0; j < 8; ++j) rr[j] = (rr[j] - sc[0]) * sc[1] * gv[bj][j >> 2][j & 3] + bv[bj][j >> 2][j & 3]; }
#pragma unroll
                    for (int j = 0; j < 4; ++j) { v0[j] += alpha * rr[j]; v1[j] += alpha * rr[4 + j]; }
                    s += ((v0[0] + v0[1]) + (v0[2] + v0[3])) + ((v1[0] + v1[1]) + (v1[2] + v1[3]));
                    ss += ((v0[0] * v0[0] + v0[1] * v0[1]) + (v0[2] * v0[2] + v0[3] * v0[3])) + ((v1[0] * v1[0] + v1[1] * v1[1]) + (v1[2] * v1[2] + v1[3] * v1[3]));
                    u32x4 w; w.x = cvt_pk_bf16(v0[0], v0[1]); w.y = cvt_pk_bf16(v0[2], v0[3]); w.z = cvt_pk_bf16(v1[0], v1[1]); w.w = cvt_pk_bf16(v1[2], v1[3]);
                    *(u32x4*)(VB + off) = w; }
                s += __shfl_xor(s, 16); s += __shfl_xor(s, 32); ss += __shfl_xor(ss, 16); ss += __shfl_xor(ss, 32);
                if (fq == 0) { float* sp = ST + (((size_t)u.pn * mrows + row) * 4 + wc) * 2; sp[0] = s; sp[1] = ss; } }
    }
    __device__ __forceinline__ void first() const {}
};
struct EpiCombineLn {
    static constexpr bool PERM = true, AFTER_DRAIN = false;
    const bf16_t* vb; const bf16_t* pw; bf16_t* xb; float* outf; float* C1; int ldc; const float* stf; const float* c1; const float* c2; const float* g; const float* b; unsigned* rdy; unsigned need;
    __device__ __forceinline__ void first() const { wait_rows_ready(rdy, need); }
    __device__ __forceinline__ void operator()(const f32x4 (&acc)[2][2][4][2], const Unit& u, int wr, int wc, int fr, int fq) const {
        if (u.dst) { store_chunk(acc, u, C1, ldc, wr, wc, fr, fq); return; }
        const int row0 = u.pm * BM + wr * 64 + fr, col0 = u.pn * BM + wc * 32 + 8 * fq;
        hwf32x2 st[8];
#pragma unroll
        for (int idx = 0; idx < 8; ++idx) st[idx] = *(const hwf32x2*)(stf + 2 * (size_t)(row0 + (idx >> 2) * HALF + (idx & 3) * 16));
#pragma unroll
        for (int bj = 0; bj < 2; ++bj) { const int cb = col0 + bj * HALF;
            const f32x4 c1v[2] = {*(const f32x4*)(c1 + cb), *(const f32x4*)(c1 + cb + 4)}, c2v[2] = {*(const f32x4*)(c2 + cb), *(const f32x4*)(c2 + cb + 4)};
            const f32x4 gv[2] = {*(const f32x4*)(g + cb), *(const f32x4*)(g + cb + 4)}, bv[2] = {*(const f32x4*)(b + cb), *(const f32x4*)(b + cb + 4)};
            u32x4 hq = *(const u32x4*)(vb + (size_t)row0 * ldc + cb), pq = *(const u32x4*)(pw + (size_t)row0 * ldc + cb);
#pragma unroll
            for (int idx = 0; idx < 8; ++idx) { const int ai = idx >> 2, m = idx & 3; const int row = row0 + ai * HALF + m * 16;
                const u32x4 hh = hq, pp = pq; const float mean = st[idx][0], rstd = st[idx][1];
                if (idx + 1 < 8) { const size_t on = (size_t)(row0 + ((idx + 1) >> 2) * HALF + ((idx + 1) & 3) * 16) * ldc + cb; hq = *(const u32x4*)(vb + on); pq = *(const u32x4*)(pw + on); }
                const size_t off = (size_t)row * ldc + cb;
                const float hv[8] = {pg_bflo(hh.x), pg_bfhi(hh.x), pg_bflo(hh.y), pg_bfhi(hh.y), pg_bflo(hh.z), pg_bfhi(hh.z), pg_bflo(hh.w), pg_bfhi(hh.w)};
                const float pv[8] = {pg_bflo(pp.x), pg_bfhi(pp.x), pg_bflo(pp.y), pg_bfhi(pp.y), pg_bflo(pp.z), pg_bfhi(pp.z), pg_bflo(pp.w), pg_bfhi(pp.w)};
                f32x4 o[2];
#pragma unroll
                for (int h = 0; h < 2; ++h)
#pragma unroll
                    for (int j = 0; j < 4; ++j) { const float gt = rstd * (acc[ai][bj][m][h][j] - mean * c1v[h][j]) + c2v[h][j]; const float h2 = (hv[4 * h + j] - mean) * rstd * gv[h][j] + bv[h][j];
                        o[h][j] = h2 + pv[4 * h + j] / (1.f + __expf(-gt)); }
                u32x4 w; w.x = cvt_pk_bf16(o[0][0], o[0][1]); w.y = cvt_pk_bf16(o[0][2], o[0][3]); w.z = cvt_pk_bf16(o[1][0], o[1][1]); w.w = cvt_pk_bf16(o[1][2], o[1][3]);
                *(u32x4*)(xb + off) = w;
                if (outf) { *(f32x4*)(outf + off) = o[0]; *(f32x4*)(outf + off + 4) = o[1]; } } }
    }
};
struct EpiUpLn {
    static constexpr bool PERM = true, AFTER_DRAIN = false;
    bf16_t* O; int ldc; const float* stf; const float* c1; const float* c2; unsigned* rdy; unsigned need;
    __device__ __forceinline__ void first() const { wait_rows_ready(rdy, need); }
    __device__ __forceinline__ void operator()(const f32x4 (&acc)[2][2][4][2], const Unit& u, int wr, int wc, int fr, int fq) const {
        const int row0 = u.pm * BM + wr * 64 + fr; const int col0 = u.pn * BM + wc * 32 + 8 * fq;
        hwf32x2 st[8]; f32x4 c1v[2][2], c2v[2][2];
#pragma unroll
        for (int idx = 0; idx < 8; ++idx) st[idx] = *(const hwf32x2*)(stf + 2 * (size_t)(row0 + (idx >> 2) * HALF + (idx & 3) * 16));
#pragma unroll
        for (int bj = 0; bj < 2; ++bj) { c1v[bj][0] = *(const f32x4*)(c1 + col0 + bj * HALF); c1v[bj][1] = *(const f32x4*)(c1 + col0 + bj * HALF + 4); c2v[bj][0] = *(const f32x4*)(c2 + col0 + bj * HALF); c2v[bj][1] = *(const f32x4*)(c2 + col0 + bj * HALF + 4); }
#pragma unroll
        for (int ai = 0; ai < 2; ++ai)
#pragma unroll
            for (int m = 0; m < 4; ++m) { const int row = row0 + ai * HALF + m * 16; bf16_t* rowp = O + (size_t)row * ldc + col0; const float mean = st[ai * 4 + m][0], rstd = st[ai * 4 + m][1];
#pragma unroll
                for (int bj = 0; bj < 2; ++bj) { f32x4 v0 = acc[ai][bj][m][0], v1 = acc[ai][bj][m][1];
#pragma unroll
                    for (int j = 0; j < 4; ++j) { const float x0 = fmaxf(rstd * (v0[j] - mean * c1v[bj][0][j]) + c2v[bj][0][j], 0.f), x1 = fmaxf(rstd * (v1[j] - mean * c1v[bj][1][j]) + c2v[bj][1][j], 0.f); v0[j] = x0 * x0; v1[j] = x1 * x1; }
                    u32x4 w; w.x = cvt_pk_bf16(v0[0], v0[1]); w.y = cvt_pk_bf16(v0[2], v0[3]); w.z = cvt_pk_bf16(v1[0], v1[1]); w.w = cvt_pk_bf16(v1[2], v1[3]);
                    *(u32x4*)(rowp + bj * HALF) = w; } }
    }
};
template <int ACT> struct EpiBf16 {
    static constexpr bool PERM = true, AFTER_DRAIN = false;
    bf16_t* O; int ldc; float* gates; int gate_pn;
    __device__ __forceinline__ void operator()(const f32x4 (&acc)[2][2][4][2], const Unit& u, int wr, int wc, int fr, int fq) const {
        const int row0 = u.pm * BM + wr * 64 + fr; const int col0 = u.pn * BM + wc * 32 + 8 * fq;
        const bool gt = (gates != nullptr) && (u.pn == gate_pn) && (wc == 0) && (fq < 2);
#pragma unroll
        for (int ai = 0; ai < 2; ++ai)
#pragma unroll
            for (int m = 0; m < 4; ++m) { const int row = row0 + ai * HALF + m * 16; bf16_t* rowp = O + (size_t)row * ldc + col0;
#pragma unroll
                for (int bj = 0; bj < 2; ++bj) { f32x4 v0 = acc[ai][bj][m][0], v1 = acc[ai][bj][m][1];
                    if (ACT == 1) {
#pragma unroll
                        for (int j = 0; j < 4; ++j) { const float a = fmaxf(v0[j], 0.f), b = fmaxf(v1[j], 0.f); v0[j] = a * a; v1[j] = b * b; } }
                    u32x4 w; w.x = cvt_pk_bf16(v0[0], v0[1]); w.y = cvt_pk_bf16(v0[2], v0[3]); w.z = cvt_pk_bf16(v1[0], v1[1]); w.w = cvt_pk_bf16(v1[2], v1[3]);
                    *(u32x4*)(rowp + bj * HALF) = w; }
                if (gt) { float* gp = gates + (size_t)row * 16 + 8 * fq; *(f32x4*)gp = acc[ai][0][m][0]; *(f32x4*)(gp + 4) = acc[ai][0][m][1]; } }
    }
    __device__ __forceinline__ void first() const {}
};

template <class Epi, class Sched, bool ALIGN_EPI = false, bool SP2 = false>
__device__ __forceinline__ void gemm_phase(PG8_LAS unsigned char* lds, const Gemm g, const Sched& S, const Epi& E, const int tid_in) {
    int tid = tid_in; asm volatile("" : "+v"(tid));
    const int wid = __builtin_amdgcn_readfirstlane(tid >> 6), lane = tid & 63, wr = wid >> 2, wc = wid & 3, fr = lane & 15, fq = lane >> 4;
    const int K = g.K;
    unsigned voffA[2], voffB[2];
#pragma unroll
    for (int i = 0; i < 2; ++i) { int R, C; stage_rc(tid * 16 + i * 8192, R, C); const int Rb = Epi::PERM ? ((R & ~31) + perm32(R & 31)) : R;
        voffA[i] = (unsigned)(R * K + C) * 2u; voffB[i] = (unsigned)(Rb * K + C) * 2u; }
    const size_t kstep = (size_t)(BK * 2);
    const size_t hstep = (size_t)HALF * K * 2;
    const size_t tstep = 2 * hstep;
    const unsigned ldsw = (unsigned)wid * 1024u;
    const int aoff = lds_byte(wr * 64 + fr, fq * 8), boff = lds_byte(wc * 32 + fr, fq * 8);
#define PG8_SA(b, h) (((b) * 2 + (h)) * HTB)
#define PG8_SB(b, h) ((4 + (b) * 2 + (h)) * HTB)
#define PG8_STAGE(bufoff, gbase, voff) do { _Pragma("unroll") for (int _i = 0; _i < 2; ++_i) \
        __builtin_amdgcn_global_load_lds((const unsigned*)((const char*)(gbase) + (voff)[_i]), (PG8_LAS unsigned*)(lds + (bufoff) + ldsw + _i * 8192), 16, 0, 0); } while (0)
#define PG8_LDA(dst, b, h) do { _Pragma("unroll") for (int m = 0; m < 4; ++m) _Pragma("unroll") for (int k = 0; k < 2; ++k) dst[m][k] = *(const PG8_LAS bf16x8*)(lds + PG8_SA(b, h) + aoff + m * 2048 + k * 1024); } while (0)
#define PG8_LDB(dst, b, h) do { _Pragma("unroll") for (int n = 0; n < 2; ++n) _Pragma("unroll") for (int k = 0; k < 2; ++k) dst[n][k] = *(const PG8_LAS bf16x8*)(lds + PG8_SB(b, h) + boff + n * 2048 + k * 1024); } while (0)
#define PG8_MMA(ai, bj, At, Bt) do { __builtin_amdgcn_s_setprio(1); _Pragma("unroll") for (int m = 0; m < 4; ++m) _Pragma("unroll") for (int n = 0; n < 2; ++n) _Pragma("unroll") for (int k = 0; k < 2; ++k) \
        acc[ai][bj][m][n] = __builtin_amdgcn_mfma_f32_16x16x32_bf16(Bt[n][k], At[m][k], acc[ai][bj][m][n], 0, 0, 0); __builtin_amdgcn_s_setprio(0); } while (0)
#define PG8_WAIT_V(n) asm volatile("s_waitcnt vmcnt(" #n ")" ::: "memory")
#define PG8_WAIT_L(n) asm volatile("s_waitcnt lgkmcnt(" #n ")" ::: "memory")
#define PG8_BAR __builtin_amdgcn_s_barrier()
#define PG8_SCHED __builtin_amdgcn_sched_barrier(0)
    Unit cur, nxt; int ui = 0;
    if (!S.next(0, cur)) { asm volatile("s_waitcnt vmcnt(0)" ::: "memory"); __syncthreads(); S.started(tid); return; }
    f32x4 acc[2][2][4][2];
#pragma unroll
    for (int a = 0; a < 2; ++a)
#pragma unroll
        for (int b = 0; b < 2; ++b)
#pragma unroll
            for (int m = 0; m < 4; ++m)
#pragma unroll
                for (int n = 0; n < 2; ++n) acc[a][b][m][n] = (f32x4){0.f, 0.f, 0.f, 0.f};
    bf16x8 At[4][2], B0[2][2], B1[2][2];
    const char* cA = (const char*)g.A + (size_t)cur.pm * tstep + (size_t)cur.kt0 * kstep; const char* cB = (const char*)g.Bt + (size_t)cur.pn * tstep + (size_t)cur.kt0 * kstep;
    S.a_ready(cur);
    if constexpr (SP2) {
        PG8_STAGE(PG8_SB(0, 0), cB, voffB); PG8_STAGE(PG8_SB(0, 1), cB + hstep, voffB); PG8_STAGE(PG8_SA(0, 0), cA, voffA); PG8_STAGE(PG8_SA(0, 1), cA + hstep, voffA);
        if (wr == 1) PG8_BAR;
        PG8_WAIT_V(2); PG8_BAR;
        PG8_STAGE(PG8_SB(1, 0), cB + kstep, voffB); PG8_STAGE(PG8_SA(1, 0), cA + kstep, voffA); PG8_STAGE(PG8_SB(1, 1), cB + hstep + kstep, voffB);
        PG8_WAIT_V(6); PG8_BAR;
        S.started(tid);
    } else {
        PG8_STAGE(PG8_SB(0, 0), cB, voffB); PG8_STAGE(PG8_SA(0, 0), cA, voffA); PG8_STAGE(PG8_SB(0, 1), cB + hstep, voffB); PG8_STAGE(PG8_SA(0, 1), cA + hstep, voffA);
        if (wr == 1) PG8_BAR;
        PG8_WAIT_V(4); PG8_BAR;
        PG8_STAGE(PG8_SB(1, 0), cB + kstep, voffB); PG8_STAGE(PG8_SA(1, 0), cA + kstep, voffA); PG8_STAGE(PG8_SB(1, 1), cB + hstep + kstep, voffB);
        PG8_WAIT_V(6); PG8_BAR;
        S.started(tid);
    }
    for (;;) {
        const bool has_next = S.next(ui + 1, nxt);
        const char* nA = has_next ? (const char*)g.A + (size_t)nxt.pm * tstep + (size_t)nxt.kt0 * kstep : cA; const char* nB = has_next ? (const char*)g.Bt + (size_t)nxt.pn * tstep + (size_t)nxt.kt0 * kstep : cB;
        const int nt = cur.nkt;
        for (int t = 0; t < nt; t += 2) {
            const bool last = (t == nt - 2);
            const char* a1 = cA + (size_t)(t + 1) * kstep;
            const char* a2 = last ? nA : cA + (size_t)(t + 2) * kstep; const char* b2 = last ? nB : cB + (size_t)(t + 2) * kstep;
            const char* a3 = a2 + kstep; const char* b3 = b2 + kstep;
            if (last && has_next) S.a_ready(nxt);
            if constexpr (SP2) {
            PG8_LDB(B0, 0, 0); PG8_LDB(B1, 0, 1); PG8_SCHED; PG8_LDA(At, 0, 0); PG8_STAGE(PG8_SA(1, 1), a1 + hstep, voffA);
            PG8_WAIT_V(8); PG8_WAIT_L(0); PG8_BAR; PG8_MMA(0, 0, At, B0); PG8_MMA(0, 1, At, B1); PG8_BAR; PG8_SCHED;
            PG8_LDA(At, 0, 1); PG8_STAGE(PG8_SB(0, 0), b2, voffB); PG8_STAGE(PG8_SB(0, 1), b2 + hstep, voffB); PG8_STAGE(PG8_SA(0, 0), a2, voffA);
            PG8_WAIT_V(8); PG8_WAIT_L(0); PG8_BAR; PG8_MMA(1, 0, At, B0); PG8_MMA(1, 1, At, B1); PG8_BAR; PG8_SCHED;
            PG8_LDB(B0, 1, 0); PG8_LDB(B1, 1, 1); PG8_SCHED; PG8_LDA(At, 1, 0); PG8_STAGE(PG8_SA(0, 1), a2 + hstep, voffA);
            PG8_WAIT_V(8); PG8_WAIT_L(0); PG8_BAR; PG8_MMA(0, 0, At, B0); PG8_MMA(0, 1, At, B1); PG8_BAR; PG8_SCHED;
            PG8_LDA(At, 1, 1); PG8_STAGE(PG8_SB(1, 0), b3, voffB); PG8_STAGE(PG8_SB(1, 1), b3 + hstep, voffB); PG8_STAGE(PG8_SA(1, 0), a3, voffA);
            PG8_WAIT_V(8); PG8_WAIT_L(0); PG8_BAR; PG8_MMA(1, 0, At, B0); PG8_MMA(1, 1, At, B1); PG8_BAR; PG8_SCHED;
            } else {
            PG8_LDB(B0, 0, 0); PG8_SCHED; PG8_LDA(At, 0, 0); PG8_STAGE(PG8_SA(1, 1), a1 + hstep, voffA);
            PG8_WAIT_L(8); PG8_BAR; PG8_WAIT_L(0); PG8_MMA(0, 0, At, B0); PG8_BAR; PG8_SCHED;
            PG8_LDB(B1, 0, 1); PG8_STAGE(PG8_SB(0, 0), b2, voffB);
            PG8_BAR; PG8_WAIT_L(0); PG8_MMA(0, 1, At, B1); PG8_BAR;
            PG8_LDA(At, 0, 1); PG8_STAGE(PG8_SA(0, 0), a2, voffA);
            PG8_BAR; PG8_WAIT_L(0); PG8_MMA(1, 0, At, B0); PG8_BAR; PG8_SCHED;
            PG8_STAGE(PG8_SB(0, 1), b2 + hstep, voffB);
            PG8_WAIT_V(6); PG8_BAR; PG8_MMA(1, 1, At, B1); PG8_BAR;
            PG8_LDB(B0, 1, 0); PG8_SCHED; PG8_LDA(At, 1, 0); PG8_STAGE(PG8_SA(0, 1), a2 + hstep, voffA);
            PG8_WAIT_L(8); PG8_BAR; PG8_WAIT_L(0); PG8_MMA(0, 0, At, B0); PG8_BAR; PG8_SCHED;
            PG8_LDB(B1, 1, 1); PG8_STAGE(PG8_SB(1, 0), b3, voffB);
            PG8_BAR; PG8_WAIT_L(0); PG8_MMA(0, 1, At, B1); PG8_BAR;
            PG8_LDA(At, 1, 1); PG8_STAGE(PG8_SA(1, 0), a3, voffA);
            PG8_BAR; PG8_WAIT_L(0); PG8_MMA(1, 0, At, B0); PG8_BAR; PG8_SCHED;
            PG8_STAGE(PG8_SB(1, 1), b3 + hstep, voffB);
            PG8_WAIT_V(6); PG8_BAR; PG8_MMA(1, 1, At, B1); PG8_BAR;
            }
        }
        if constexpr (ALIGN_EPI) { if (wr == 0) PG8_BAR; }
        if (ui == 0) E.first();
        E(acc, cur, wr, wc, fr, fq); S.done(cur);
        if (!has_next) break;
#pragma unroll
        for (int a = 0; a < 2; ++a)
#pragma unroll
            for (int b = 0; b < 2; ++b)
#pragma unroll
                for (int m = 0; m < 4; ++m)
#pragma unroll
                    for (int n = 0; n < 2; ++n) acc[a][b][m][n] = (f32x4){0.f, 0.f, 0.f, 0.f};
        cur = nxt; cA = nA; cB = nB; ++ui;
        if constexpr (ALIGN_EPI) { if (wr == 1) PG8_BAR; }
    }
    PG8_WAIT_V(0);
    if constexpr (!ALIGN_EPI) { if (wr == 0) PG8_BAR; }
    PG8_BAR;
#undef PG8_SA
#undef PG8_SB
#undef PG8_STAGE
#undef PG8_LDA
#undef PG8_LDB
#undef PG8_MMA
#undef PG8_WAIT_V
#undef PG8_WAIT_L
#undef PG8_BAR
#undef PG8_SCHED
}
}

constexpr int NWAVES = 8, NTHR = 512;
constexpr int D = 2048, FF = 8192, PLE = 256;
constexpr int TP = 2048, BP = 4, TS = 4, BS = 128;
constexpr int MP = BP * TP, MS = BS * TS, M = MP + MS;
constexpr int NPROJ = 6160, NPROJ_PAD = 6400;
constexpr int NH = 8;
constexpr float LN_EPS = 1e-5f, RMS_EPS = 1e-6f;
constexpr float DN_ALPHA = 1.41421356237f;

constexpr size_t MiB = 1u << 20;
constexpr size_t WS_CTL = 0;
constexpr size_t WS_WINE = 1 * MiB;
constexpr size_t WS_WOUTE = WS_WINE + 25 * MiB;
constexpr size_t WS_WINO = WS_WOUTE + 8 * MiB;
constexpr size_t WS_WOUTO = WS_WINO + 25 * MiB;
constexpr size_t WS_WUP = WS_WOUTO + 8 * MiB;
constexpr size_t WS_WDOWN = WS_WUP + 64 * MiB;
constexpr size_t WS_WPLE = WS_WDOWN + 64 * MiB;
constexpr size_t WS_WGATE = WS_WPLE + 2 * MiB;
constexpr size_t WS_XB = WS_WGATE + 16 * MiB;
constexpr size_t WS_MIX = WS_XB + 34 * MiB;
constexpr size_t WS_H = WS_MIX + 34 * MiB;
constexpr size_t WS_H2 = WS_H + 34 * MiB;
constexpr size_t WS_PW = WS_H2 + 34 * MiB;
constexpr size_t WS_PB = WS_PW + 34 * MiB;
constexpr size_t WS_GATES = WS_PB + 9 * MiB;
constexpr size_t WS_PROJ = WS_GATES + 1 * MiB;
constexpr size_t WS_PART0 = WS_PROJ + 136 * MiB;
constexpr size_t WS_PART1 = WS_PART0 + 68 * MiB;
constexpr size_t WS_LRUW = WS_PART1 + 68 * MiB;
constexpr size_t WS_STF = WS_LRUW + 1 * MiB;
constexpr size_t WS_CFIN = WS_STF + 1 * MiB;
constexpr size_t WS_CPART = WS_CFIN + 1 * MiB;
constexpr size_t WS_END = WS_CPART + 6 * MiB;
constexpr int CTL_RDY = 32768;
constexpr size_t WS_DG = WS_PART0;
constexpr size_t WS_DB = WS_PART0 + 32 * MiB;
constexpr size_t WS_DS = WS_PART0 + 64 * MiB;
constexpr size_t WS_DQ = WS_PART0 + 96 * MiB;
constexpr size_t WS_DO = WS_PART0 + 112 * MiB;
constexpr size_t WS_DD = WS_PART0 + 128 * MiB;
constexpr size_t WS_DF = WS_PART0 + 129 * MiB;
constexpr size_t WS_MC = WS_PART0;
constexpr size_t WS_MN = WS_PART0 + 64 * MiB;
constexpr size_t WS_MM = WS_PART0 + 65 * MiB;
constexpr size_t WS_LRU_HL = WS_H;
constexpr size_t WS_LRU_P = WS_H + 16 * MiB;
constexpr size_t WS_LRU_END = WS_H + 32 * MiB;

constexpr size_t O_Y = 0;
constexpr size_t O_CONVP = (size_t)M * D;
constexpr size_t O_DELTAP = O_CONVP + (size_t)BP * 3 * 4096;
constexpr size_t O_LRUP = O_DELTAP + (size_t)BP * 8 * 128 * 128;
constexpr size_t O_MCP = O_LRUP + (size_t)BP * 1024;
constexpr size_t O_MNP = O_MCP + (size_t)BP * 8 * 256 * 128;
constexpr size_t O_MMP = O_MNP + (size_t)BP * 8 * 128;
constexpr size_t O_CONVS = O_MMP + (size_t)BP * 8;
constexpr size_t O_DELTAS = O_CONVS + (size_t)BS * 3 * 4096;
constexpr size_t O_LRUS = O_DELTAS + (size_t)BS * 8 * 128 * 128;
constexpr size_t O_MCS = O_LRUS + (size_t)BS * 1024;
constexpr size_t O_MNS = O_MCS + (size_t)BS * 8 * 256 * 128;
constexpr size_t O_MMS = O_MNS + (size_t)BS * 8 * 128;
constexpr size_t O_END = O_MMS + (size_t)BS * 8;

constexpr int LDS_BYTES = 147456;
constexpr int LDS_CTL_OFF = 131072;

#define LAS __attribute__((address_space(3)))
typedef unsigned short bf16;
typedef unsigned v4u __attribute__((ext_vector_type(4)));
typedef unsigned v2u __attribute__((ext_vector_type(2)));
typedef float f32x4 __attribute__((ext_vector_type(4)));
#define LDS_WAIT() asm volatile("s_waitcnt lgkmcnt(0)" ::: "memory")
#define LDS_BARRIER() do { asm volatile("s_waitcnt lgkmcnt(0)" ::: "memory"); __builtin_amdgcn_s_barrier(); asm volatile("" ::: "memory"); } while (0)
__device__ __forceinline__ unsigned pk2(float lo, float hi) { return pg8::cvt_pk_bf16(lo, hi); }
__device__ __forceinline__ unsigned f2bf(float f) { return pg8::cvt_pk_bf16(f, 0.f) & 0xffffu; }
__device__ __forceinline__ float bf2f(unsigned short b) { return __builtin_bit_cast(float, ((unsigned)b) << 16); }
__device__ __forceinline__ float bflo(unsigned w) { return __builtin_bit_cast(float, w << 16); }
__device__ __forceinline__ float bfhi(unsigned w) { return __builtin_bit_cast(float, w & 0xffff0000u); }
__device__ __forceinline__ float fexp(float x) { return __builtin_amdgcn_exp2f(x * 1.4426950408889634f); }
__device__ __forceinline__ float sigm(float x) { return __builtin_amdgcn_rcpf(1.f + fexp(-x)); }
__device__ __forceinline__ float siluf(float x) { return x * sigm(x); }
__device__ __forceinline__ float softplusf(float x) { return fmaxf(x, 0.f) + log1pf(expf(-fabsf(x))); }
__device__ __forceinline__ float logsigf(float x) { return -softplusf(-x); }
__device__ __forceinline__ float neg_expm1(float y) {
    const float ser = -y * (1.f + y * (0.5f + y * (0.16666667f + y * (0.041666668f + y * (0.008333334f + y * 0.0013888889f)))));
    return (y > -0.25f) ? ser : 1.f - fexp(y);
}
__device__ __forceinline__ float gelu_tanh(float x) { const float u = 0.7978845608028654f * (x + 0.044715f * x * x * x); return x * sigm(2.f * u); }
__device__ __forceinline__ float wave_sum(float v) {
#pragma unroll
    for (int o = 1; o < 64; o <<= 1) v += __shfl_xor(v, o);
    return v;
}

__device__ __forceinline__ float wave_incl_sum(float v, int lane) {
#pragma unroll
    for (int o = 1; o < 64; o <<= 1) { const float u = __shfl_up(v, o); if (lane >= o) v += u; }
    return v;
}
__device__ __forceinline__ float wave_incl_max(float v, int lane) {
#pragma unroll
    for (int o = 1; o < 64; o <<= 1) { const float u = __shfl_up(v, o); if (lane >= o) v = fmaxf(v, u); }
    return v;
}
__device__ __forceinline__ float wave_max(float v) {
#pragma unroll
    for (int o = 1; o < 64; o <<= 1) v = fmaxf(v, __shfl_xor(v, o));
    return v;
}
#define XB_TMO      128
#define XB_XCNT(j)  (256  + 64 * (j))
#define XB_XSUB(j)  (1280 + 64 * (j))
#define XB_XGEN(j)  (2304 + 64 * (j))
#define XB_TOP      3328
#define XB_TOPGEN   3392
#define XCD_BAR_WORDS 3456
#define XB_SPIN_CAP (1u << 22)
__device__ __forceinline__ unsigned xb_ld(unsigned* p)              { return __hip_atomic_load(p, __ATOMIC_RELAXED, __HIP_MEMORY_SCOPE_AGENT); }
__device__ __forceinline__ unsigned xb_add(unsigned* p, unsigned v) { return __hip_atomic_fetch_add(p, v, __ATOMIC_RELAXED, __HIP_MEMORY_SCOPE_AGENT); }
__device__ __forceinline__ unsigned xb_xcc_id() { return (unsigned)__builtin_amdgcn_s_getreg((3 << 11) | 20) & 0xFu; }
#define XB_SPIN(cond, bar) do { unsigned _sp = 0; while (cond) { __builtin_amdgcn_s_sleep(1); \
    if ((++_sp & 255u) == 0u) { if (xb_ld(&(bar)[XB_TMO])) break; if (_sp > XB_SPIN_CAP) { atomicAdd(&(bar)[XB_TMO], 1u); break; } } } } while (0)
struct XcdBarrier { unsigned* bar; unsigned x; volatile LAS unsigned* st; };
__device__ __forceinline__ XcdBarrier xcd_barrier_post(unsigned* bar, volatile LAS unsigned* st) {
    XcdBarrier b; b.bar = bar; b.x = xb_xcc_id(); b.st = st;
    if (threadIdx.x == 0) (void)xb_add(&bar[XB_XCNT(b.x)], 1u);
    return b;
}
__device__ __forceinline__ void xcd_barrier_complete(unsigned* bar, unsigned x, unsigned& nloc, unsigned& nx) {
    const unsigned G = gridDim.x * gridDim.y * gridDim.z;
    unsigned sum, cnt, mine, sp = 0u;
    for (;;) {
        sum = 0u; cnt = 0u; mine = 0u;
#pragma unroll
        for (unsigned j = 0; j < 16; ++j) { const unsigned c = xb_ld(&bar[XB_XCNT(j)]); sum += c; cnt += (c > 0u) ? 1u : 0u; mine = (j == x) ? c : mine; }
        if (sum == G) break;
        __builtin_amdgcn_s_sleep(1);
        if ((++sp & 255u) == 0u) { if (xb_ld(&bar[XB_TMO])) break; if (sp > XB_SPIN_CAP) { atomicAdd(&bar[XB_TMO], 1u); break; } }
    }
    nloc = mine > 0u ? mine : 1u; nx = cnt > 0u ? cnt : 1u;
}
__device__ __forceinline__ void xcd_barrier(const XcdBarrier& b) {
    asm volatile("s_waitcnt vmcnt(0)" ::: "memory");
    __syncthreads();
    if (threadIdx.x == 0) {
        unsigned* bar = b.bar;
        __builtin_amdgcn_s_waitcnt(0);
        unsigned nloc = b.st[0], nx = b.st[1];
        if (nloc == 0u) { xcd_barrier_complete(bar, b.x, nloc, nx); b.st[0] = nloc; b.st[1] = nx; }
        __builtin_amdgcn_fence(__ATOMIC_ACQUIRE, "agent");
        const unsigned old = xb_add(&bar[XB_XSUB(b.x)], 1u);
        const unsigned gen = old / nloc;
        if (old + 1u == (gen + 1u) * nloc) {
            __builtin_amdgcn_fence(__ATOMIC_RELEASE, "agent");
            asm volatile("s_waitcnt vmcnt(0)" ::: "memory");
            const unsigned og = xb_add(&bar[XB_TOP], 1u);
            const unsigned tg = og / nx;
            if (og + 1u == (tg + 1u) * nx) {
#pragma unroll
                for (unsigned j = 0; j < 16; ++j) xb_add(&bar[XB_XGEN(j)], 1u);
            } else XB_SPIN(xb_ld(&bar[XB_XGEN(b.x)]) == gen, bar);
        } else {
            XB_SPIN(xb_ld(&bar[XB_XGEN(b.x)]) == gen, bar);
        }
    }
    __syncthreads();
}

struct Args { const float* in[35]; float* out; unsigned char* ws; int ph_lo, ph_hi; };
typedef const __attribute__((address_space(4))) Args* ArgsP;
enum { I_XP = 0, I_XS, I_PP, I_PS, I_SCONV, I_SDELTA, I_SLRU, I_SMC, I_SMN, I_SMM, I_WINE, I_WCONV, I_BCONV, I_ALOG, I_DTB, I_DNORM, I_LWR, I_LBR, I_LWI, I_LBI, I_LLAM, I_WOUTE,
       I_WINO, I_BIG, I_BFG, I_MNORM, I_WOUTO, I_LN1G, I_LN1B, I_LN2G, I_LN2B, I_WUP, I_WDOWN, I_WPLE, I_WGATE };

struct TDesc { const float* W; bf16* WT; int K, N, Npad, item; const float* gv; const float* bv; float* cp; int remap; };
__device__ __forceinline__ void t_decode(const TDesc& d, int& kb, int& nb) {
    const int nblk = d.Npad / 32;
    if (d.remap && (d.K & 511) == 0) { const int sup = d.item >> 3, sub = d.item & 7; kb = (sup / nblk) * 8 + sub; nb = sup % nblk; }
    else { kb = d.item / nblk; nb = d.item % nblk; }
}
__device__ __forceinline__ void t_load(const TDesc& d, int lane, f32x4 (&v)[8], f32x4 (&gb)[4]) {
    int kb, nb; t_decode(d, kb, nb); const int k0 = 64 * kb, n0 = 32 * nb;
    const int r8 = lane >> 3, c4 = lane & 7; const bool ok = (n0 + 4 * c4) < d.N;
#pragma unroll
    for (int i = 0; i < 8; ++i) v[i] = ok ? __builtin_nontemporal_load((const f32x4*)(d.W + (size_t)(k0 + 8 * r8 + i) * d.N + n0 + 4 * c4)) : (f32x4){0.f, 0.f, 0.f, 0.f};
    if (d.gv != nullptr) { gb[0] = *(const f32x4*)(d.gv + k0 + 8 * r8); gb[1] = *(const f32x4*)(d.gv + k0 + 8 * r8 + 4); gb[2] = *(const f32x4*)(d.bv + k0 + 8 * r8); gb[3] = *(const f32x4*)(d.bv + k0 + 8 * r8 + 4); }
}
__device__ __forceinline__ void t_finish(const TDesc& d, LAS float*  , int lane, const f32x4 (&v)[8], const f32x4 (&gb)[4]) {
    int kb, nb; t_decode(d, kb, nb); const int k0 = 64 * kb, n0 = 32 * nb;
    const int r8 = lane >> 3, c4 = lane & 7;
    bf16* o = d.WT + (size_t)(n0 + 4 * c4) * d.K + k0 + 8 * r8;
    if (d.gv == nullptr) {
        *(v4u*)(o) = (v4u){pk2(v[0].x, v[1].x), pk2(v[2].x, v[3].x), pk2(v[4].x, v[5].x), pk2(v[6].x, v[7].x)};
        *(v4u*)(o + (size_t)d.K) = (v4u){pk2(v[0].y, v[1].y), pk2(v[2].y, v[3].y), pk2(v[4].y, v[5].y), pk2(v[6].y, v[7].y)};
        *(v4u*)(o + 2 * (size_t)d.K) = (v4u){pk2(v[0].z, v[1].z), pk2(v[2].z, v[3].z), pk2(v[4].z, v[5].z), pk2(v[6].z, v[7].z)};
        *(v4u*)(o + 3 * (size_t)d.K) = (v4u){pk2(v[0].w, v[1].w), pk2(v[2].w, v[3].w), pk2(v[4].w, v[5].w), pk2(v[6].w, v[7].w)};
    } else {
        const float g8[8] = {gb[0].x, gb[0].y, gb[0].z, gb[0].w, gb[1].x, gb[1].y, gb[1].z, gb[1].w}, b8[8] = {gb[2].x, gb[2].y, gb[2].z, gb[2].w, gb[3].x, gb[3].y, gb[3].z, gb[3].w};
        f32x4 c1 = (f32x4){0.f, 0.f, 0.f, 0.f}, c2 = c1, s[8];
#pragma unroll
        for (int i = 0; i < 8; ++i) { c2 = c2 + v[i] * b8[i]; s[i] = v[i] * g8[i]; }
        const v4u w0 = (v4u){pk2(s[0].x, s[1].x), pk2(s[2].x, s[3].x), pk2(s[4].x, s[5].x), pk2(s[6].x, s[7].x)}, w1 = (v4u){pk2(s[0].y, s[1].y), pk2(s[2].y, s[3].y), pk2(s[4].y, s[5].y), pk2(s[6].y, s[7].y)};
        const v4u w2 = (v4u){pk2(s[0].z, s[1].z), pk2(s[2].z, s[3].z), pk2(s[4].z, s[5].z), pk2(s[6].z, s[7].z)}, w3 = (v4u){pk2(s[0].w, s[1].w), pk2(s[2].w, s[3].w), pk2(s[4].w, s[5].w), pk2(s[6].w, s[7].w)};
        *(v4u*)(o) = w0; *(v4u*)(o + (size_t)d.K) = w1; *(v4u*)(o + 2 * (size_t)d.K) = w2; *(v4u*)(o + 3 * (size_t)d.K) = w3;
        c1.x = ((bflo(w0.x) + bfhi(w0.x)) + (bflo(w0.y) + bfhi(w0.y))) + ((bflo(w0.z) + bfhi(w0.z)) + (bflo(w0.w) + bfhi(w0.w)));
        c1.y = ((bflo(w1.x) + bfhi(w1.x)) + (bflo(w1.y) + bfhi(w1.y))) + ((bflo(w1.z) + bfhi(w1.z)) + (bflo(w1.w) + bfhi(w1.w)));
        c1.z = ((bflo(w2.x) + bfhi(w2.x)) + (bflo(w2.y) + bfhi(w2.y))) + ((bflo(w2.z) + bfhi(w2.z)) + (bflo(w2.w) + bfhi(w2.w)));
        c1.w = ((bflo(w3.x) + bfhi(w3.x)) + (bflo(w3.y) + bfhi(w3.y))) + ((bflo(w3.z) + bfhi(w3.z)) + (bflo(w3.w) + bfhi(w3.w)));
#pragma unroll
        for (int o_ = 8; o_ < 64; o_ <<= 1) {
            c1.x += __shfl_xor(c1.x, o_); c1.y += __shfl_xor(c1.y, o_); c1.z += __shfl_xor(c1.z, o_); c1.w += __shfl_xor(c1.w, o_);
            c2.x += __shfl_xor(c2.x, o_); c2.y += __shfl_xor(c2.y, o_); c2.z += __shfl_xor(c2.z, o_); c2.w += __shfl_xor(c2.w, o_); }
        if (r8 == 0) { float* cq = d.cp + (size_t)kb * d.Npad + n0 + 4 * c4; *(f32x4*)cq = c1; *(f32x4*)(cq + (size_t)(d.K / 64) * d.Npad) = c2; }
    }
}
__device__ __forceinline__ void p0_transpose_item(const float* W, int K, int N, int Npad, bf16* WT, LAS float* scr, int item, int lane) {
    const TDesc d{W, WT, K, N, Npad, item, nullptr, nullptr, nullptr, 0}; f32x4 v[8], gb[4]; t_load(d, lane, v, gb); t_finish(d, scr, lane, v, gb);
}
template <int N> __device__ __forceinline__ void row_to_bf16(const float* src, bf16* dst, int lane) {
    f32x4 v[N / 256];
#pragma unroll
    for (int j = 0; j < N / 256; ++j) v[j] = __builtin_nontemporal_load((const f32x4*)(src + j * 256 + lane * 4));
#pragma unroll
    for (int j = 0; j < N / 256; ++j) { v2u o; o.x = pk2(v[j].x, v[j].y); o.y = pk2(v[j].z, v[j].w); *(v2u*)(dst + j * 256 + lane * 4) = o; }
}
namespace cv { constexpr int I_IN = (D / 64) * (NPROJ_PAD / 32), I_SQ = (D / 64) * (D / 32), I_UP = (D / 64) * (FF / 32), I_DN = (FF / 64) * (D / 32), I_PL = (PLE / 64) * (D / 32);
               constexpr int N_FIRST = I_IN + I_PL + 128, N_REST = I_IN + 2 * I_SQ + 2 * I_UP + 2 * I_DN + I_PL + 2 * I_SQ;
               constexpr int R_IN0 = 6144;
               constexpr int R_G1 = I_SQ + I_UP + I_SQ + I_IN + I_SQ + I_PL + I_SQ;
               constexpr int R_IN1 = R_G1 + I_UP;
               constexpr int R_SCAN = R_IN1 - 6144;
               constexpr int R_UP0 = R_IN1 + I_DN;
               static_assert(R_UP0 + I_DN == N_REST && R_SCAN > R_G1 && R_SCAN > R_IN0 && (R_IN0 - I_SQ) % 2048 == 0 && (R_SCAN - R_G1) % 2048 == 0, "conversion ranges (the scan-phase range splits w_up at a multiple of 8 k blocks: its item order is a permutation within such groups)"); }
__device__ __forceinline__ void convert_first_item(ArgsP a, LAS float* scr, int r, int lane) {
    unsigned char* ws = a->ws;
    if (r < cv::I_IN) { p0_transpose_item(a->in[I_WINE], D, NPROJ, NPROJ_PAD, (bf16*)(ws + WS_WINE), scr, r, lane); return; } r -= cv::I_IN;
    if (r < cv::I_PL) { p0_transpose_item(a->in[I_WPLE], PLE, D, D, (bf16*)(ws + WS_WPLE), scr, r, lane); return; } r -= cv::I_PL;
    { const int mat = r / 64, blk = (r / 8) & 7; p0_transpose_item(a->in[mat == 0 ? I_LWR : I_LWI] + (size_t)blk * 16384, 128, 128, 128, (bf16*)(ws + WS_LRUW) + (size_t)(mat * 8 + blk) * 16384, scr, r % 8, lane); }
}
__device__ __forceinline__ TDesc decode_rest(ArgsP a, int r) {
    using namespace cv; unsigned char* ws = a->ws; const int rm = (r >= R_IN0 && r < R_SCAN) ? 1 : 0;
    if (r < I_SQ) return TDesc{a->in[I_WOUTE], (bf16*)(ws + WS_WOUTE), D, D, D, r, nullptr, nullptr, nullptr, rm}; r -= I_SQ;
    if (r < I_UP) return TDesc{a->in[I_WUP], (bf16*)(ws + WS_WUP), D, FF, FF, r, a->in[I_LN1G], a->in[I_LN1B], (float*)(ws + WS_CPART), rm}; r -= I_UP;
    if (r < I_SQ) return TDesc{a->in[I_WGATE], (bf16*)(ws + WS_WGATE), D, D, D, r, a->in[I_LN2G], a->in[I_LN2B], (float*)(ws + WS_CPART + 2 * MiB), rm}; r -= I_SQ;
    if (r < I_IN) return TDesc{a->in[I_WINO], (bf16*)(ws + WS_WINO), D, NPROJ, NPROJ_PAD, r, nullptr, nullptr, nullptr, rm}; r -= I_IN;
    if (r < I_SQ) return TDesc{a->in[I_WOUTO], (bf16*)(ws + WS_WOUTO), D, D, D, r, nullptr, nullptr, nullptr, rm}; r -= I_SQ;
    if (r < I_PL) return TDesc{a->in[I_WPLE] + (size_t)PLE * D, (bf16*)(ws + WS_WPLE) + (size_t)PLE * D, PLE, D, D, r, nullptr, nullptr, nullptr, rm}; r -= I_PL;
    if (r < I_SQ) return TDesc{a->in[I_WGATE] + (size_t)D * D, (bf16*)(ws + WS_WGATE) + (size_t)D * D, D, D, D, r, a->in[I_LN2G] + D, a->in[I_LN2B] + D, (float*)(ws + WS_CPART + 5 * MiB), rm}; r -= I_SQ;
    if (r < I_UP) return TDesc{a->in[I_WUP] + (size_t)D * FF, (bf16*)(ws + WS_WUP) + (size_t)D * FF, D, FF, FF, r, a->in[I_LN1G] + D, a->in[I_LN1B] + D, (float*)(ws + WS_CPART + 3 * MiB), rm}; r -= I_UP;
    if (r < I_DN) return TDesc{a->in[I_WDOWN], (bf16*)(ws + WS_WDOWN), FF, D, D, r, nullptr, nullptr, nullptr, rm}; r -= I_DN;
    return TDesc{a->in[I_WDOWN] + (size_t)D * FF, (bf16*)(ws + WS_WDOWN) + (size_t)D * FF, FF, D, D, r, nullptr, nullptr, nullptr, rm};
}
template <int BLK = 1> __device__ __forceinline__ void convert_range(ArgsP a, LAS float* scr, int first, int last, int widx, int nw, int lane) {
#define CV_IDX(j) (first + (((j) / BLK) * nw + widx) * BLK + ((j) % BLK))
    int j = 0, it = CV_IDX(0);
    TDesc dA, dB; f32x4 vA[8], vB[8], gA[4], gB[4];
    if (it < last) { dA = decode_rest(a, it); t_load(dA, lane, vA, gA);
#pragma unroll 1
        for (;;) {
            const int itB = CV_IDX(j + 1); const bool hasB = itB < last;
            if (hasB) { dB = decode_rest(a, itB); t_load(dB, lane, vB, gB); }
            t_finish(dA, scr, lane, vA, gA);
            if (!hasB) break;
            j += 2; it = CV_IDX(j); const bool hasA = it < last;
            if (hasA) { dA = decode_rest(a, it); t_load(dA, lane, vA, gA); }
            t_finish(dB, scr, lane, vB, gB);
            if (!hasA) break;
        } }
#undef CV_IDX
}
__device__ __forceinline__ void phase_convert(ArgsP a, LAS unsigned char* lds, int gw, int NGW, int wave, int lane) {
    unsigned char* ws = a->ws;
    LAS float* scr = (LAS float*)(lds + wave * 16384);
    for (int it = gw; it < cv::N_FIRST; it += NGW) convert_first_item(a, scr, it, lane);
    bf16* xb = (bf16*)(ws + WS_XB);
    for (int m0 = gw; m0 < M; m0 += 2 * NGW) {
        const int m1 = m0 + NGW; const bool two = m1 < M;
        const float* s0 = m0 < MP ? a->in[I_XP] + (size_t)m0 * D : a->in[I_XS] + (size_t)(m0 - MP) * D;
        const float* s1 = two ? (m1 < MP ? a->in[I_XP] + (size_t)m1 * D : a->in[I_XS] + (size_t)(m1 - MP) * D) : s0;
        f32x4 v0[8], v1[8];
#pragma unroll
        for (int j = 0; j < 8; ++j) { v0[j] = __builtin_nontemporal_load((const f32x4*)(s0 + j * 256 + lane * 4)); v1[j] = __builtin_nontemporal_load((const f32x4*)(s1 + j * 256 + lane * 4)); }
#pragma unroll
        for (int j = 0; j < 8; ++j) { v2u o; o.x = pk2(v0[j].x, v0[j].y); o.y = pk2(v0[j].z, v0[j].w); *(v2u*)(xb + (size_t)m0 * D + j * 256 + lane * 4) = o; }
        if (two) {
#pragma unroll
            for (int j = 0; j < 8; ++j) { v2u o; o.x = pk2(v1[j].x, v1[j].y); o.y = pk2(v1[j].z, v1[j].w); *(v2u*)(xb + (size_t)m1 * D + j * 256 + lane * 4) = o; } }
    }
    bf16* pb = (bf16*)(ws + WS_PB);
    for (int r0 = gw; r0 < 2 * M; r0 += 4 * NGW) {
        f32x4 v[4];
#pragma unroll
        for (int k = 0; k < 4; ++k) { const int r = r0 + k * NGW; const int rr = r < 2 * M ? r : r0; const int l = rr / M, m = rr % M;
            const float* src = m < MP ? a->in[I_PP] + ((size_t)l * MP + m) * PLE : a->in[I_PS] + ((size_t)l * MS + (m - MP)) * PLE;
            v[k] = __builtin_nontemporal_load((const f32x4*)(src + lane * 4)); }
#pragma unroll
        for (int k = 0; k < 4; ++k) { const int r = r0 + k * NGW; if (r < 2 * M) { v2u o; o.x = pk2(v[k].x, v[k].y); o.y = pk2(v[k].z, v[k].w); *(v2u*)(pb + (size_t)r * PLE + lane * 4) = o; } }
    }
}

__device__ __forceinline__ float conv_in(const bf16* proj, int row0, int tq, int ch, const float* cstate) {
    if (tq >= 0) return bf2f(proj[(size_t)(row0 + tq) * NPROJ_PAD + ch]);
    return cstate ? cstate[(3 + tq) * 4096 + ch] : 0.f;
}
__device__ __forceinline__ float conv4(const bf16* proj, int row0, int t, int ch, const float* cstate, const float* wconv, const float* bconv) {
    float acc = bconv[ch];
#pragma unroll
    for (int j = 0; j < 4; ++j) acc += wconv[j * 4096 + ch] * conv_in(proj, row0, t - 3 + j, ch, cstate);
    return acc;
}

__device__ __forceinline__ void delta_rec_item(ArgsP a, LAS unsigned char* lds, int row0, int T, int h, const float* cstate, const float* S0, float* Sout, const int tid) {
    const int lane = tid & 63, wave = tid >> 6, c = tid & 127, r = tid >> 7;
    const bf16* proj = (const bf16*)(a->ws + WS_PROJ); const float* gates = (const float*)(a->ws + WS_GATES); bf16* mix = (bf16*)(a->ws + WS_MIX);
    const float* wconv = a->in[I_WCONV]; const float* bconv = a->in[I_BCONV];
    LAS float* act = (LAS float*)lds;
    LAS float* nrm = act + 4 * 384;
    LAS float* gb = nrm + 8;
    LAS float* red = gb + 8;
    LAS float* red2 = red + 512;
    LAS float* obuf = red2 + 512;
    float s[32];
#pragma unroll
    for (int i = 0; i < 32; ++i) s[i] = S0 ? S0[(size_t)(32 * r + i) * 128 + c] : 0.f;
    const float aexp = fexp(a->in[I_ALOG][h]), dtb = a->in[I_DTB][h];
#pragma unroll 1
    for (int t0 = 0; t0 < T; t0 += 4) {
#pragma unroll
        for (int j = 0; j < 3; ++j) { const int idx = tid + 512 * j, tok = idx / 384, chl = idx % 384, part = chl >> 7, i = chl & 127;
            const int ch = part * 1024 + h * 128 + i;
            act[tok * 384 + chl] = siluf(conv4(proj, row0, t0 + tok, ch, cstate, wconv, bconv)); }
        LDS_BARRIER();
        { const int tok = wave >> 1, part = wave & 1; const float x0 = act[tok * 384 + part * 128 + lane], x1 = act[tok * 384 + part * 128 + 64 + lane];
          const float ss = wave_sum(x0 * x0 + x1 * x1); if (lane == 0) nrm[tok * 2 + part] = rsqrtf(ss + 1e-6f) * (part == 0 ? 0.08838834764831845f : 1.f); }
        if (tid < 4) { const int row = row0 + t0 + tid; const float g = -aexp * softplusf(gates[(size_t)row * 16 + h] + dtb); gb[tid * 2] = fexp(g); gb[tid * 2 + 1] = sigm(gates[(size_t)row * 16 + 8 + h]); }
        LDS_BARRIER();
#pragma unroll 1
        for (int tok = 0; tok < 4; ++tok) {
            const float eg = gb[tok * 2], beta = gb[tok * 2 + 1], nq = nrm[tok * 2], nk = nrm[tok * 2 + 1];
            const LAS float* qv = act + tok * 384 + 32 * r; const LAS float* kv = qv + 128;
            float ks = 0.f;
#pragma unroll
            for (int i = 0; i < 32; ++i) ks += kv[i] * s[i];
            red[r * 128 + c] = ks * nk;
            LDS_BARRIER();
            const float kS = red[c] + red[128 + c] + red[256 + c] + red[384 + c];
            const float vnew = beta * (act[tok * 384 + 256 + c] - eg * kS);
            float os = 0.f;
#pragma unroll
            for (int i = 0; i < 32; ++i) { s[i] = eg * s[i] + (kv[i] * nk) * vnew; os += qv[i] * s[i]; }
            red2[r * 128 + c] = os * nq;
            LDS_BARRIER();
            if (r == 0) obuf[tok * 128 + c] = red2[c] + red2[128 + c] + red2[256 + c] + red2[384 + c];
        }
        LDS_BARRIER();
        if (wave < 4) { const int tok = wave, row = row0 + t0 + tok; const float o0 = obuf[tok * 128 + lane], o1 = obuf[tok * 128 + 64 + lane];
            const float rstd = rsqrtf(wave_sum(o0 * o0 + o1 * o1) * (1.f / 128.f) + RMS_EPS);
            const float* nw = a->in[I_DNORM];
            const float z0 = bf2f(proj[(size_t)row * NPROJ_PAD + 4096 + h * 128 + lane]), z1 = bf2f(proj[(size_t)row * NPROJ_PAD + 4096 + h * 128 + 64 + lane]);
            mix[(size_t)row * D + h * 128 + lane] = (bf16)f2bf(o0 * rstd * nw[lane] * siluf(z0));
            mix[(size_t)row * D + h * 128 + 64 + lane] = (bf16)f2bf(o1 * rstd * nw[64 + lane] * siluf(z1)); }
        LDS_BARRIER();
    }
#pragma unroll
    for (int i = 0; i < 32; ++i) Sout[(size_t)(32 * r + i) * 128 + c] = s[i];
}


typedef short bf16x8 __attribute__((ext_vector_type(8)));
#define MFMA32(a_, b_, c_) __builtin_amdgcn_mfma_f32_16x16x32_bf16(a_, b_, c_, 0, 0, 0)

__device__ __forceinline__ void lru_prep_item(ArgsP a, LAS unsigned char* lds, int item, const int tid) {
    const int c = item & 31, n = (item >> 5) & 7, b = item >> 8;
    const int lane = tid & 63, w = __builtin_amdgcn_readfirstlane(tid >> 6), fr = lane & 15, fq = lane >> 4;
    unsigned char* ws = a->ws;
    const bf16* proj = (const bf16*)(ws + WS_PROJ);
    LAS bf16* xa = (LAS bf16*)lds;
    LAS float* xf = (LAS float*)(lds + 17408);
    LAS float* obH = (LAS float*)(lds + 51200);
    LAS float* obP = obH + 64 * 132;
    {
        const int t = tid >> 3, sub = tid & 7, ch0 = 3072 + n * 128 + sub * 16;
        const float* wconv = a->in[I_WCONV]; const float* bconv = a->in[I_BCONV];
        float x[16];
#pragma unroll
        for (int i = 0; i < 4; ++i) { const f32x4 bb = *(const f32x4*)(bconv + ch0 + 4 * i); x[4 * i] = bb.x; x[4 * i + 1] = bb.y; x[4 * i + 2] = bb.z; x[4 * i + 3] = bb.w; }
#pragma unroll
        for (int j = 0; j < 4; ++j) { const int tt = 64 * c + t - 3 + j;
            if (tt >= 0) { const bf16* pr = proj + (size_t)(b * TP + tt) * NPROJ_PAD + ch0; const v4u u0 = *(const v4u*)pr, u1 = *(const v4u*)(pr + 8);
                const unsigned uu[8] = {u0.x, u0.y, u0.z, u0.w, u1.x, u1.y, u1.z, u1.w};
#pragma unroll
                for (int i = 0; i < 4; ++i) { const f32x4 ww = *(const f32x4*)(wconv + j * 4096 + ch0 + 4 * i);
                    x[4 * i] += ww.x * bflo(uu[2 * i]); x[4 * i + 1] += ww.y * bfhi(uu[2 * i]); x[4 * i + 2] += ww.z * bflo(uu[2 * i + 1]); x[4 * i + 3] += ww.w * bfhi(uu[2 * i + 1]); } } }
        v4u o0, o1; o0.x = pk2(x[0], x[1]); o0.y = pk2(x[2], x[3]); o0.z = pk2(x[4], x[5]); o0.w = pk2(x[6], x[7]); o1.x = pk2(x[8], x[9]); o1.y = pk2(x[10], x[11]); o1.z = pk2(x[12], x[13]); o1.w = pk2(x[14], x[15]);
        *(LAS v4u*)(xa + t * 136 + sub * 16) = o0; *(LAS v4u*)(xa + t * 136 + sub * 16 + 8) = o1;
#pragma unroll
        for (int i = 0; i < 4; ++i) *(LAS f32x4*)(xf + t * 132 + sub * 16 + 4 * i) = (f32x4){x[4 * i], x[4 * i + 1], x[4 * i + 2], x[4 * i + 3]};
    }
    LDS_BARRIER();
    const bf16* wrT = (const bf16*)(ws + WS_LRUW) + (size_t)n * 16384; const bf16* wiT = wrT + 8 * 16384;
    bf16x8 br[4], bi[4];
#pragma unroll
    for (int ks = 0; ks < 4; ++ks) { br[ks] = *(const bf16x8*)(wrT + (16 * w + fr) * 128 + 32 * ks + 8 * fq); bi[ks] = *(const bf16x8*)(wiT + (16 * w + fr) * 128 + 32 * ks + 8 * fq); }
    f32x4 accr[4], acci[4];
#pragma unroll
    for (int tb = 0; tb < 4; ++tb) { accr[tb] = (f32x4){0.f, 0.f, 0.f, 0.f}; acci[tb] = (f32x4){0.f, 0.f, 0.f, 0.f};
#pragma unroll
        for (int ks = 0; ks < 4; ++ks) { const bf16x8 af = *(const LAS bf16x8*)(xa + (16 * tb + fr) * 136 + 32 * ks + 8 * fq); accr[tb] = MFMA32(af, br[ks], accr[tb]); acci[tb] = MFMA32(af, bi[ks], acci[tb]); } }
    const int dl = 16 * w + fr, chn = n * 128 + dl;
    const float brs = a->in[I_LBR][chn], bis = a->in[I_LBI][chn], spl = softplusf(-a->in[I_LLAM][chn]);
    float Apre = 1.f, Hpre = 0.f;
#pragma unroll
    for (int tb = 0; tb < 4; ++tb) {
        float P[4], Hh[4];
#pragma unroll
        for (int j = 0; j < 4; ++j) { const int t = 16 * tb + 4 * fq + j;
            const float log_a = -8.f * sigm(accr[tb][j] + brs) * spl; const float av = fexp(log_a);
            const float bx = sqrtf(neg_expm1(2.f * log_a)) * sigm(acci[tb][j] + bis) * xf[t * 132 + dl];
            if (j == 0) { P[0] = av; Hh[0] = bx; } else { P[j] = P[j - 1] * av; Hh[j] = av * Hh[j - 1] + bx; } }
        float Ai = P[3], Hi = Hh[3];
        { const float A2 = __shfl_up(Ai, 16), H2 = __shfl_up(Hi, 16); if (fq >= 1) { Hi = Ai * H2 + Hi; Ai = A2 * Ai; } }
        { const float A2 = __shfl_up(Ai, 32), H2 = __shfl_up(Hi, 32); if (fq >= 2) { Hi = Ai * H2 + Hi; Ai = A2 * Ai; } }
        float Aex = __shfl_up(Ai, 16), Hex = __shfl_up(Hi, 16); if (fq == 0) { Aex = 1.f; Hex = 0.f; }
        const float Atb = __shfl(Ai, 48 + fr), Htb = __shfl(Hi, 48 + fr);
        const float EA = Apre * Aex, EH = Aex * Hpre + Hex;
#pragma unroll
        for (int j = 0; j < 4; ++j) { const int t = 16 * tb + 4 * fq + j; obP[t * 132 + dl] = EA * P[j]; obH[t * 132 + dl] = P[j] * EH + Hh[j]; }
        Hpre = Atb * Hpre + Htb; Apre = Apre * Atb;
    }
    if (fq == 0) { float* e = (float*)(ws + WS_LRU_END) + (size_t)item * 256; e[dl] = Apre; e[128 + dl] = Hpre; }
    LDS_BARRIER();
    {
        const int t = tid >> 3, sub = tid & 7;
        bf16* hl = (bf16*)(ws + WS_LRU_HL) + ((size_t)item * 64 + t) * 128 + sub * 16; bf16* pp = (bf16*)(ws + WS_LRU_P) + ((size_t)item * 64 + t) * 128 + sub * 16;
        const LAS float* sh = obH + t * 132 + sub * 16; const LAS float* sp = obP + t * 132 + sub * 16;
        v4u o0, o1;
        o0.x = pk2(sh[0], sh[1]); o0.y = pk2(sh[2], sh[3]); o0.z = pk2(sh[4], sh[5]); o0.w = pk2(sh[6], sh[7]); o1.x = pk2(sh[8], sh[9]); o1.y = pk2(sh[10], sh[11]); o1.z = pk2(sh[12], sh[13]); o1.w = pk2(sh[14], sh[15]);
        *(v4u*)hl = o0; *(v4u*)(hl + 8) = o1;
        o0.x = pk2(sp[0], sp[1]); o0.y = pk2(sp[2], sp[3]); o0.z = pk2(sp[4], sp[5]); o0.w = pk2(sp[6], sp[7]); o1.x = pk2(sp[8], sp[9]); o1.y = pk2(sp[10], sp[11]); o1.z = pk2(sp[12], sp[13]); o1.w = pk2(sp[14], sp[15]);
        *(v4u*)pp = o0; *(v4u*)(pp + 8) = o1;
    }
    LDS_BARRIER();
}
struct LruOutRegs { float pv[31], hv[31]; v4u h0, h1, p0, p1, g0, g1; };
__device__ __forceinline__ void lru_out_load(ArgsP a, int item, const int tid, LruOutRegs& R) {
    const int c = item & 31, n = (item >> 5) & 7, b = item >> 8;
    unsigned char* ws = a->ws;
    if (tid < 128) { const float* e = (const float*)(ws + WS_LRU_END) + (size_t)(item - c) * 256;
#pragma unroll
        for (int k = 0; k < 31; ++k) { const bool on = k < c; R.pv[k] = on ? e[k * 256 + tid] : 1.f; R.hv[k] = on ? e[k * 256 + 128 + tid] : 0.f; } }
    const int t = tid >> 3, sub = tid & 7, d0 = sub * 16, row = b * TP + 64 * c + t;
    const bf16* hl = (const bf16*)(ws + WS_LRU_HL) + ((size_t)item * 64 + t) * 128 + d0; const bf16* pp = (const bf16*)(ws + WS_LRU_P) + ((size_t)item * 64 + t) * 128 + d0;
    const bf16* gp = (const bf16*)(ws + WS_PROJ) + (size_t)row * NPROJ_PAD + 5120 + n * 128 + d0;
    R.h0 = *(const v4u*)hl; R.h1 = *(const v4u*)(hl + 8); R.p0 = *(const v4u*)pp; R.p1 = *(const v4u*)(pp + 8); R.g0 = *(const v4u*)gp; R.g1 = *(const v4u*)(gp + 8);
}
__device__ __forceinline__ void lru_out_compute(ArgsP a, LAS unsigned char* lds, int item, const int tid, const LruOutRegs& R) {
    const int c = item & 31, n = (item >> 5) & 7, b = item >> 8;
    unsigned char* ws = a->ws;
    LAS float* carry = (LAS float*)lds;
    if (tid < 128) { float cr = 0.f;
#pragma unroll
        for (int k = 0; k < 31; ++k) cr = R.hv[k] + R.pv[k] * cr;
        carry[tid] = cr; }
    LDS_BARRIER();
    const int t = tid >> 3, sub = tid & 7, d0 = sub * 16, row = b * TP + 64 * c + t;
    const unsigned hu[8] = {R.h0.x, R.h0.y, R.h0.z, R.h0.w, R.h1.x, R.h1.y, R.h1.z, R.h1.w}, pu[8] = {R.p0.x, R.p0.y, R.p0.z, R.p0.w, R.p1.x, R.p1.y, R.p1.z, R.p1.w}, gu[8] = {R.g0.x, R.g0.y, R.g0.z, R.g0.w, R.g1.x, R.g1.y, R.g1.z, R.g1.w};
    float hv[16]; unsigned ou[8];
#pragma unroll
    for (int i = 0; i < 8; ++i) { hv[2 * i] = bflo(hu[i]) + bflo(pu[i]) * carry[d0 + 2 * i]; hv[2 * i + 1] = bfhi(hu[i]) + bfhi(pu[i]) * carry[d0 + 2 * i + 1];
        ou[i] = pk2(hv[2 * i] * gelu_tanh(bflo(gu[i])), hv[2 * i + 1] * gelu_tanh(bfhi(gu[i]))); }
    bf16* mp = (bf16*)(ws + WS_MIX) + (size_t)row * D + 1024 + n * 128 + d0;
    *(v4u*)mp = (v4u){ou[0], ou[1], ou[2], ou[3]}; *(v4u*)(mp + 8) = (v4u){ou[4], ou[5], ou[6], ou[7]};
    if (c == 31 && t == 63) { float* o = a->out + O_LRUP + (size_t)b * 1024 + n * 128 + d0;
#pragma unroll
        for (int i = 0; i < 4; ++i) *(f32x4*)(o + 4 * i) = (f32x4){hv[4 * i], hv[4 * i + 1], hv[4 * i + 2], hv[4 * i + 3]}; }
    LDS_BARRIER();
}
__device__ __forceinline__ void lru_out_loop(ArgsP a, LAS unsigned char* lds, int first, int step, const int tid) {
    LruOutRegs RA, RB;
#pragma unroll
    for (int k = 0; k < 31; ++k) { RA.pv[k] = 1.f; RA.hv[k] = 0.f; RB.pv[k] = 1.f; RB.hv[k] = 0.f; }
    RA.h0 = RA.h1 = RA.p0 = RA.p1 = RA.g0 = RA.g1 = (v4u){0u, 0u, 0u, 0u}; RB.h0 = RB.h1 = RB.p0 = RB.p1 = RB.g0 = RB.g1 = (v4u){0u, 0u, 0u, 0u};
    int it = first;
    if (it < 1024) { lru_out_load(a, it, tid, RA);
#pragma unroll 1
        for (;;) {
            const int itB = it + step; const bool hasB = itB < 1024;
            if (hasB) lru_out_load(a, itB, tid, RB);
            lru_out_compute(a, lds, it, tid, RA);
            if (!hasB) break;
            it = itB + step; const bool hasA = it < 1024;
            if (hasA) lru_out_load(a, it, tid, RA);
            lru_out_compute(a, lds, itB, tid, RB);
            if (!hasA) break;
        } }
}

__device__ __forceinline__ void conv16_load(const bf16* proj, int b, int tseq, int ch0, v4u (&u)[8]) {
#pragma unroll
    for (int j = 0; j < 4; ++j) { const int tt = tseq - 3 + j;
        if (tt >= 0) { const bf16* pr = proj + (size_t)(b * TP + tt) * NPROJ_PAD + ch0; u[2 * j] = *(const v4u*)pr; u[2 * j + 1] = *(const v4u*)(pr + 8); }
        else { u[2 * j] = (v4u){0u, 0u, 0u, 0u}; u[2 * j + 1] = (v4u){0u, 0u, 0u, 0u}; } }
}
__device__ __forceinline__ void conv16_compute(const v4u (&u)[8], const float* wconv, const float* bconv, int ch0, float (&x)[16]) {
#pragma unroll
    for (int i = 0; i < 4; ++i) { const f32x4 bb = *(const f32x4*)(bconv + ch0 + 4 * i); x[4 * i] = bb.x; x[4 * i + 1] = bb.y; x[4 * i + 2] = bb.z; x[4 * i + 3] = bb.w; }
#pragma unroll
    for (int j = 0; j < 4; ++j) { const unsigned uu[8] = {u[2 * j].x, u[2 * j].y, u[2 * j].z, u[2 * j].w, u[2 * j + 1].x, u[2 * j + 1].y, u[2 * j + 1].z, u[2 * j + 1].w};
#pragma unroll
        for (int i = 0; i < 4; ++i) { const f32x4 ww = *(const f32x4*)(wconv + j * 4096 + ch0 + 4 * i);
            x[4 * i] += ww.x * bflo(uu[2 * i]); x[4 * i + 1] += ww.y * bfhi(uu[2 * i]); x[4 * i + 2] += ww.z * bflo(uu[2 * i + 1]); x[4 * i + 3] += ww.w * bfhi(uu[2 * i + 1]); } }
}
__device__ __forceinline__ void conv16_prompt(const bf16* proj, const float* wconv, const float* bconv, int b, int tseq, int ch0, float (&x)[16]) {
    v4u u[8]; conv16_load(proj, b, tseq, ch0, u); conv16_compute(u, wconv, bconv, ch0, x);
}
__device__ __forceinline__ void st16_bf16(LAS bf16* p, const float (&x)[16]) {
    v4u o0, o1; o0.x = pk2(x[0], x[1]); o0.y = pk2(x[2], x[3]); o0.z = pk2(x[4], x[5]); o0.w = pk2(x[6], x[7]); o1.x = pk2(x[8], x[9]); o1.y = pk2(x[10], x[11]); o1.z = pk2(x[12], x[13]); o1.w = pk2(x[14], x[15]);
    *(LAS v4u*)p = o0; *(LAS v4u*)(p + 8) = o1;
}
__device__ __forceinline__ v2u pack4(const f32x4 v) { v2u o; o.x = pk2(v.x, v.y); o.y = pk2(v.z, v.w); return o; }
__device__ __forceinline__ bf16x8 zero8() { return (bf16x8){0, 0, 0, 0, 0, 0, 0, 0}; }

__device__ __forceinline__ void delta_prep_item(ArgsP a, LAS unsigned char* lds, int item, const int tid) {
    const int c = item & 31, h = (item >> 5) & 7, b = item >> 8;
    const int lane = tid & 63, w = __builtin_amdgcn_readfirstlane(tid >> 6), fr = lane & 15, fq = lane >> 4;
    unsigned char* ws = a->ws;
    const bf16* proj = (const bf16*)(ws + WS_PROJ);
    LAS bf16* Kn = (LAS bf16*)lds;
    LAS bf16* Qn = (LAS bf16*)(lds + 17408);
    LAS bf16* KdT = (LAS bf16*)(lds + 34816);
    LAS bf16* RX = (LAS bf16*)(lds + 53248);
    LAS bf16* Mm = (LAS bf16*)(lds + 90112);
    LAS bf16* QKd = (LAS bf16*)(lds + 99328);
    LAS bf16* Td = (LAS bf16*)(lds + 108544);
    LAS bf16* RT = (LAS bf16*)(lds + 111616) + w * 768;
    LAS float* gl = (LAS float*)(lds + 123904);
    LAS float* gcs = gl + 64;
    LAS float* bet = gcs + 64;
    float gcv, bvv;
    {
        const float* gt = (const float*)(ws + WS_GATES) + (size_t)(b * TP + 64 * c + lane) * 16;
        const float gv = -fexp(a->in[I_ALOG][h]) * softplusf(gt[h] + a->in[I_DTB][h]); bvv = sigm(gt[8 + h]);
        gcv = wave_incl_sum(gv, lane);
        if (w == 0) { gl[lane] = gv; gcs[lane] = gcv; bet[lane] = bvv; }
    }
    {
        const int part = w >> 1;
        if (part < 3) {
            const float* wconv = a->in[I_WCONV]; const float* bconv = a->in[I_BCONV];
            const int sub = tid & 7, tg = (tid >> 3) & 15, ch0 = (part == 0 ? 0 : part == 1 ? 1024 : 2048) + h * 128 + sub * 16;
            f32x4 wv[4][4], bv4[4];
#pragma unroll
            for (int i = 0; i < 4; ++i) { bv4[i] = *(const f32x4*)(bconv + ch0 + 4 * i);
#pragma unroll
                for (int j = 0; j < 4; ++j) wv[j][i] = *(const f32x4*)(wconv + j * 4096 + ch0 + 4 * i); }
            v4u u[7][2];
#pragma unroll
            for (int r = 0; r < 7; ++r) { const int tt = 64 * c + 4 * tg - 3 + r;
                if (tt >= 0) { const bf16* pr = proj + (size_t)(b * TP + tt) * NPROJ_PAD + ch0; u[r][0] = *(const v4u*)pr; u[r][1] = *(const v4u*)(pr + 8); }
                else { u[r][0] = (v4u){0u, 0u, 0u, 0u}; u[r][1] = (v4u){0u, 0u, 0u, 0u}; } }
            const float glast = __shfl(gcv, 63);
#pragma unroll
            for (int e = 0; e < 4; ++e) { const int t = 4 * tg + e;
                float x[16];
#pragma unroll
                for (int i = 0; i < 4; ++i) { x[4 * i] = bv4[i].x; x[4 * i + 1] = bv4[i].y; x[4 * i + 2] = bv4[i].z; x[4 * i + 3] = bv4[i].w; }
#pragma unroll
                for (int j = 0; j < 4; ++j) { const unsigned uu[8] = {u[e + j][0].x, u[e + j][0].y, u[e + j][0].z, u[e + j][0].w, u[e + j][1].x, u[e + j][1].y, u[e + j][1].z, u[e + j][1].w};
#pragma unroll
                    for (int i = 0; i < 4; ++i) { x[4 * i] += wv[j][i].x * bflo(uu[2 * i]); x[4 * i + 1] += wv[j][i].y * bfhi(uu[2 * i]); x[4 * i + 2] += wv[j][i].z * bflo(uu[2 * i + 1]); x[4 * i + 3] += wv[j][i].w * bfhi(uu[2 * i + 1]); } }
                float ss = 0.f;
#pragma unroll
                for (int i = 0; i < 16; ++i) { x[i] = siluf(x[i]); ss += x[i] * x[i]; }
                const float gc = __shfl(gcv, t), beta = __shfl(bvv, t);
                if (part == 2) {
#pragma unroll
                    for (int i = 0; i < 16; ++i) x[i] *= beta;
                    st16_bf16(RX + t * 264 + sub * 16, x);
                } else {
                    ss += __shfl_xor(ss, 1); ss += __shfl_xor(ss, 2); ss += __shfl_xor(ss, 4);
                    const float rn = rsqrtf(ss + 1e-6f) * (part == 0 ? 0.08838834764831845f : 1.f);
#pragma unroll
                    for (int i = 0; i < 16; ++i) x[i] *= rn;
                    if (part == 0) st16_bf16(Qn + t * 136 + sub * 16, x);
                    else { st16_bf16(Kn + t * 136 + sub * 16, x);
                        const float ec = fexp(gc), ed = fexp(glast - gc); float y[16];
#pragma unroll
                        for (int i = 0; i < 16; ++i) { KdT[(sub * 16 + i) * 72 + t] = (bf16)f2bf(x[i] * ed); y[i] = x[i] * (beta * ec); }
                        st16_bf16(RX + t * 264 + 128 + sub * 16, y); }
                }
            }
        }
    }
    LDS_BARRIER();
    {
        const int ib = w >> 1;
#pragma unroll
        for (int jj = 0; jj < 2; ++jj) { const int jb = 2 * (w & 1) + jj;
            f32x4 ak = (f32x4){0.f, 0.f, 0.f, 0.f}, aq = (f32x4){0.f, 0.f, 0.f, 0.f};
            if (jb <= ib) {
#pragma unroll
                for (int ks = 0; ks < 4; ++ks) { const bf16x8 bfr = *(const LAS bf16x8*)(Kn + (16 * jb + fr) * 136 + 32 * ks + 8 * fq);
                    const bf16x8 afk = *(const LAS bf16x8*)(Kn + (16 * ib + fr) * 136 + 32 * ks + 8 * fq), afq = *(const LAS bf16x8*)(Qn + (16 * ib + fr) * 136 + 32 * ks + 8 * fq);
                    ak = MFMA32(afk, bfr, ak); aq = MFMA32(afq, bfr, aq); } }
            const int col = 16 * jb + fr; const float gcc = gcs[col];
#pragma unroll
            for (int j = 0; j < 4; ++j) { const int row = 16 * ib + 4 * fq + j; const float dec = (row >= col) ? fexp(gcs[row] - gcc) : 0.f;
                Mm[row * 72 + col] = (bf16)f2bf(row > col ? -bet[row] * ak[j] * dec : 0.f);
                QKd[row * 72 + col] = (bf16)f2bf(aq[j] * dec); }
        }
    }
    LDS_BARRIER();
    if (w == 0) { const int blk = lane >> 4, col = lane & 15; float xi[16];
#pragma unroll
        for (int i = 0; i < 16; ++i) { float acc = (i == col) ? 1.f : 0.f; const LAS bf16* mr = Mm + (16 * blk + i) * 72 + 16 * blk;
#pragma unroll
            for (int j = 0; j < i; ++j) acc += bf2f(mr[j]) * xi[j];
            xi[i] = acc; }
#pragma unroll
        for (int i = 0; i < 16; ++i) Td[(blk * 16 + i) * 24 + col] = (bf16)f2bf(xi[i]); }
    f32x4 rhs[2][4];
#pragma unroll
    for (int cbl = 0; cbl < 2; ++cbl)
#pragma unroll
        for (int bb = 0; bb < 4; ++bb)
#pragma unroll
            for (int j = 0; j < 4; ++j) rhs[cbl][bb][j] = bf2f(RX[(16 * bb + 4 * fq + j) * 264 + 32 * w + 16 * cbl + fr]);
    LDS_BARRIER();
#pragma unroll
    for (int cbl = 0; cbl < 2; ++cbl) { const int cb = 2 * w + cbl;
#pragma unroll
        for (int bb = 0; bb < 4; ++bb) {
            f32x4 acc = rhs[cbl][bb];
#pragma unroll
            for (int ks = 0; ks < 2; ++ks) { if (32 * ks < 16 * bb) { const bool ok = (32 * ks + 8 * fq) < 16 * bb;
                const bf16x8 af = ok ? *(const LAS bf16x8*)(Mm + (16 * bb + fr) * 72 + 32 * ks + 8 * fq) : zero8();
                const bf16x8 bf_ = ok ? *(const LAS bf16x8*)(RX + (16 * cb + fr) * 72 + 32 * ks + 8 * fq) : zero8();
                acc = MFMA32(af, bf_, acc); } }
            *(LAS v2u*)(RT + (16 * cbl + fr) * 24 + 4 * fq) = pack4(acc);
            asm volatile("s_waitcnt lgkmcnt(0)" ::: "memory");
            const bool ok2 = fq < 2;
            const bf16x8 af2 = ok2 ? *(const LAS bf16x8*)(Td + (bb * 16 + fr) * 24 + 8 * fq) : zero8();
            const bf16x8 bf2 = ok2 ? *(const LAS bf16x8*)(RT + (16 * cbl + fr) * 24 + 8 * fq) : zero8();
            const f32x4 xb4 = MFMA32(af2, bf2, ((f32x4){0.f, 0.f, 0.f, 0.f}));
            *(LAS v2u*)(RX + (16 * cb + fr) * 72 + 16 * bb + 4 * fq) = pack4(xb4);
            asm volatile("s_waitcnt lgkmcnt(0)" ::: "memory");
        }
    }
    LDS_BARRIER();
    {
        v4u* gout = (v4u*)(ws + WS_DG) + ((size_t)item * 8 + w) * 4 * 64 + lane;
        bf16x8 kb[2];
#pragma unroll
        for (int kt = 0; kt < 2; ++kt) kb[kt] = *(const LAS bf16x8*)(KdT + (16 * w + fr) * 72 + 32 * kt + 8 * fq);
#pragma unroll
        for (int ks = 0; ks < 4; ++ks) { f32x4 g0 = (f32x4){0.f, 0.f, 0.f, 0.f}, g1 = (f32x4){0.f, 0.f, 0.f, 0.f};
#pragma unroll
            for (int kt = 0; kt < 2; ++kt) { const bf16x8 a0 = *(const LAS bf16x8*)(RX + (128 + 32 * ks + fr) * 72 + 32 * kt + 8 * fq), a1 = *(const LAS bf16x8*)(RX + (128 + 32 * ks + 16 + fr) * 72 + 32 * kt + 8 * fq);
                g0 = MFMA32(a0, kb[kt], g0); g1 = MFMA32(a1, kb[kt], g1); }
            const v2u p0 = pack4(-g0), p1 = pack4(-g1); gout[ks * 64] = (v4u){p0.x, p0.y, p1.x, p1.y}; }
        v2u* bout = (v2u*)(ws + WS_DB) + ((size_t)item * 64 + w) * 64 + lane;
#pragma unroll
        for (int s2 = 0; s2 < 8; ++s2) { f32x4 bc = (f32x4){0.f, 0.f, 0.f, 0.f};
#pragma unroll
            for (int kt = 0; kt < 2; ++kt) { const bf16x8 ub = *(const LAS bf16x8*)(RX + (16 * s2 + fr) * 72 + 32 * kt + 8 * fq); bc = MFMA32(kb[kt], ub, bc); }
            bout[(size_t)s2 * 8 * 64] = pack4(bc); }
    }
    {
        const int tb = w >> 1, half = w & 1; const float ect = fexp(gcs[16 * tb + fr]);
        bf16x8 qk[2];
#pragma unroll
        for (int kt = 0; kt < 2; ++kt) qk[kt] = *(const LAS bf16x8*)(QKd + (16 * tb + fr) * 72 + 32 * kt + 8 * fq);
        v4u* qout = (v4u*)(ws + WS_DQ) + ((size_t)item * 4 + tb) * 4 * 64 + lane;
#pragma unroll
        for (int kk = 0; kk < 2; ++kk) { const int ks = 2 * half + kk; v2u pk[2];
#pragma unroll
            for (int hf = 0; hf < 2; ++hf) { const int db = 2 * ks + hf; f32x4 acc = (f32x4){0.f, 0.f, 0.f, 0.f};
#pragma unroll
                for (int kt = 0; kt < 2; ++kt) { const bf16x8 wa = *(const LAS bf16x8*)(RX + (128 + 16 * db + fr) * 72 + 32 * kt + 8 * fq); acc = MFMA32(wa, qk[kt], acc); }
                const v2u qn4 = *(const LAS v2u*)(Qn + (16 * tb + fr) * 136 + 16 * db + 4 * fq);
                f32x4 qp; qp.x = bflo(qn4.x) * ect - acc.x; qp.y = bfhi(qn4.x) * ect - acc.y; qp.z = bflo(qn4.y) * ect - acc.z; qp.w = bfhi(qn4.y) * ect - acc.w;
                pk[hf] = pack4(qp); }
            qout[ks * 64] = (v4u){pk[0].x, pk[0].y, pk[1].x, pk[1].y}; }
        v2u* oout = (v2u*)(ws + WS_DO) + ((size_t)item * 4 + tb) * 8 * 64 + lane;
#pragma unroll
        for (int ss = 0; ss < 4; ++ss) { const int s2 = 4 * half + ss; f32x4 acc = (f32x4){0.f, 0.f, 0.f, 0.f};
#pragma unroll
            for (int kt = 0; kt < 2; ++kt) { const bf16x8 ua = *(const LAS bf16x8*)(RX + (16 * s2 + fr) * 72 + 32 * kt + 8 * fq); acc = MFMA32(ua, qk[kt], acc); }
            oout[s2 * 64] = pack4(acc); }
    }
    if (tid == 0) ((float*)(ws + WS_DD))[item] = fexp(gcs[63]);
    LDS_BARRIER();
}

__device__ __forceinline__ void delta_scan_wave(ArgsP a, int chain, int s, const int lane) {
    unsigned char* ws = a->ws;
    const int fr = lane & 15, fq = lane >> 4;
    f32x4 S[8]; bf16x8 Sb[4];
#pragma unroll
    for (int i = 0; i < 8; ++i) S[i] = (f32x4){0.f, 0.f, 0.f, 0.f};
#pragma unroll
    for (int i = 0; i < 4; ++i) Sb[i] = zero8();
    const bf16x8* gbase = (const bf16x8*)(ws + WS_DG) + (size_t)chain * 32 * 2048 + lane;
    bf16x8 G[8][4];
#pragma unroll
    for (int rb = 0; rb < 8; ++rb)
#pragma unroll
        for (int ks = 0; ks < 4; ++ks) G[rb][ks] = gbase[(rb * 4 + ks) * 64];
#pragma unroll 1
    for (int c = 0; c < 32; ++c) {
        const int item = chain * 32 + c;
        const float d = ((const float*)(ws + WS_DD))[item];
        bf16x8* sout = (bf16x8*)(ws + WS_DS) + ((size_t)item * 8 + s) * 4 * 64 + lane;
#pragma unroll
        for (int ks = 0; ks < 4; ++ks) sout[ks * 64] = Sb[ks];
        const v2u* bin = (const v2u*)(ws + WS_DB) + ((size_t)item * 8 + s) * 8 * 64 + lane;
#pragma unroll
        for (int rb = 0; rb < 8; ++rb) { const v2u bc = bin[rb * 64]; S[rb].x = d * S[rb].x + bflo(bc.x); S[rb].y = d * S[rb].y + bfhi(bc.x); S[rb].z = d * S[rb].z + bflo(bc.y); S[rb].w = d * S[rb].w + bfhi(bc.y); }
        const bf16x8* gnext = gbase + (size_t)(c + 1 < 32 ? c + 1 : c) * 2048;
#pragma unroll
        for (int rb = 0; rb < 8; ++rb) {
#pragma unroll
            for (int ks = 0; ks < 4; ++ks) S[rb] = MFMA32(G[rb][ks], Sb[ks], S[rb]);
#pragma unroll
            for (int ks = 0; ks < 4; ++ks) G[rb][ks] = gnext[(rb * 4 + ks) * 64];
        }
#pragma unroll
        for (int ks = 0; ks < 4; ++ks) { const v2u lo = pack4(S[2 * ks]), hi = pack4(S[2 * ks + 1]); const v4u u = (v4u){lo.x, lo.y, hi.x, hi.y}; Sb[ks] = __builtin_bit_cast(bf16x8, u); }
    }
    f32x4* so = (f32x4*)(ws + WS_DF) + ((size_t)(chain * 8 + s) * 8) * 64 + lane;
#pragma unroll
    for (int rb = 0; rb < 8; ++rb) so[rb * 64] = S[rb];
}

__device__ __forceinline__ void delta_out_wave(ArgsP a, int item, int tb, const int lane) {
    unsigned char* ws = a->ws;
    const int c = item & 31, h = (item >> 5) & 7, b = item >> 8, fr = lane & 15, fq = lane >> 4;
    bf16x8 qf[4];
    const bf16x8* qin = (const bf16x8*)(ws + WS_DQ) + ((size_t)item * 4 + tb) * 4 * 64 + lane;
#pragma unroll
    for (int ks = 0; ks < 4; ++ks) qf[ks] = qin[ks * 64];
    const v2u* oin = (const v2u*)(ws + WS_DO) + ((size_t)item * 4 + tb) * 8 * 64 + lane;
    const bf16x8* sin = (const bf16x8*)(ws + WS_DS) + (size_t)item * 8 * 4 * 64 + lane;
    f32x4 o[8]; float ss = 0.f;
    v2u olv[8]; bf16x8 sfr[4][4];
#pragma unroll
    for (int s = 0; s < 8; ++s) olv[s] = oin[s * 64];
#pragma unroll
    for (int s = 0; s < 4; ++s)
#pragma unroll
        for (int ks = 0; ks < 4; ++ks) sfr[s][ks] = sin[(s * 4 + ks) * 64];
    const int row_ = b * TP + 64 * c + 16 * tb + fr;
    v2u zv[8];
#pragma unroll
    for (int s = 0; s < 8; ++s) zv[s] = *(const v2u*)((const bf16*)(ws + WS_PROJ) + (size_t)row_ * NPROJ_PAD + 4096 + h * 128 + 4 * fq + 16 * s);
#pragma unroll
    for (int grp = 0; grp < 2; ++grp) {
#pragma unroll
        for (int s4 = 0; s4 < 4; ++s4) { const int s = 4 * grp + s4; const v2u ol = olv[s]; o[s] = (f32x4){bflo(ol.x), bfhi(ol.x), bflo(ol.y), bfhi(ol.y)};
#pragma unroll
            for (int ks = 0; ks < 4; ++ks) o[s] = MFMA32(sfr[s4][ks], qf[ks], o[s]);
            ss += (o[s].x * o[s].x + o[s].y * o[s].y) + (o[s].z * o[s].z + o[s].w * o[s].w); }
        if (grp == 0) {
#pragma unroll
            for (int s4 = 0; s4 < 4; ++s4)
#pragma unroll
                for (int ks = 0; ks < 4; ++ks) sfr[s4][ks] = sin[((4 + s4) * 4 + ks) * 64]; }
    }
    ss += __shfl_xor(ss, 16); ss += __shfl_xor(ss, 32);
    const float rstd = rsqrtf(ss * (1.f / 128.f) + RMS_EPS);
    const int row = b * TP + 64 * c + 16 * tb + fr;
    const bf16* zp = (const bf16*)(ws + WS_PROJ) + (size_t)row * NPROJ_PAD + 4096 + h * 128 + 4 * fq;
    bf16* mp = (bf16*)(ws + WS_MIX) + (size_t)row * D + h * 128 + 4 * fq;
    const float* nw = a->in[I_DNORM] + 4 * fq;
#pragma unroll
    for (int s = 0; s < 8; ++s) { const v2u z = zv[s]; const f32x4 n4 = *(const f32x4*)(nw + 16 * s);
        f32x4 y; y.x = o[s].x * rstd * n4.x * siluf(bflo(z.x)); y.y = o[s].y * rstd * n4.y * siluf(bfhi(z.x)); y.z = o[s].z * rstd * n4.z * siluf(bflo(z.y)); y.w = o[s].w * rstd * n4.w * siluf(bfhi(z.y));
        *(v2u*)(mp + 16 * s) = pack4(y); }
}


__device__ __forceinline__ void mlstm_scan_item(ArgsP a, LAS unsigned char* lds, int chain, int vs, const int tid) {
    const int lane = tid & 63, w = __builtin_amdgcn_readfirstlane(tid >> 6), fr = lane & 15, fq = lane >> 4;
    const int b = chain >> 3, h = chain & 7, row0 = b * TP;
    unsigned char* ws = a->ws;
    const bf16* proj = (const bf16*)(ws + WS_PROJ); const float* gates = (const float*)(ws + WS_GATES);
    LAS bf16* KT = (LAS bf16*)lds;
    LAS bf16* VT = (LAS bf16*)(lds + 36864);
    LAS float* wls = (LAS float*)(lds + 46080);
    LAS float* gendA = (LAS float*)(lds + 46592);
    LAS float* blastA = gendA + 2048;
    LAS float* mxA = blastA + 32;
    const float big = a->in[I_BIG][h], bfg = a->in[I_BFG][h];
    {
        float lf4[4], ig4[4];
#pragma unroll
        for (int i = 0; i < 4; ++i) { const float* gp = gates + (size_t)(row0 + 64 * (w + 8 * i) + lane) * 16 + h; ig4[i] = gp[0] + big; lf4[i] = logsigf(gp[8] + bfg); }
#pragma unroll
        for (int i = 0; i < 4; ++i) { const float bcum = wave_incl_sum(lf4[i], lane), blast = __shfl(bcum, 63), gend = blast - bcum + ig4[i]; const float mx = wave_max(gend);
            gendA[(w + 8 * i) * 64 + lane] = gend; if (lane == 0) { blastA[w + 8 * i] = blast; mxA[w + 8 * i] = mx; } }
    }
    LDS_BARRIER();
    const bf16* kptr = proj + (size_t)(row0 + lane) * NPROJ_PAD + 1024 + h * 128 + 16 * w;
    const bf16* vptr = proj + (size_t)(row0 + lane) * NPROJ_PAD + 2048 + h * 256 + 32 * vs + 8 * (w & 3);
    f32x4 acc[2]; acc[0] = (f32x4){0.f, 0.f, 0.f, 0.f}; acc[1] = acc[0];
    float nst = 0.f, m = 0.f;
    v4u kq[2][2], vq[2];
    const unsigned psel = (lane & 1) ? 0x03020706u : 0x05040100u;
#define ML_LOAD(set, c_) do { const size_t ro = (size_t)(c_) * 64 * NPROJ_PAD; kq[set][0] = *(const v4u*)(kptr + ro); kq[set][1] = *(const v4u*)(kptr + ro + 8); \
        if (w < 4) vq[set] = *(const v4u*)(vptr + ro); } while (0)
#define ML_STEP(set, c_) do { const int item = chain * 32 + (c_); \
        const float blast = blastA[(c_)], gend = gendA[(c_) * 64 + lane]; \
        const float mnew = fmaxf(blast + m, mxA[(c_)]), sc = fexp(blast + m - mnew), wv = fexp(gend - mnew) * 0.08838834764831845f; \
        LAS bf16* kt = KT + (set) * 9216; LAS bf16* vt = VT + (set) * 2304; \
          \
          \
        _Pragma("unroll") for (int i = 0; i < 2; ++i) { const unsigned uu[4] = {kq[set][i].x, kq[set][i].y, kq[set][i].z, kq[set][i].w}; const int kr = 8 * (2 * w + i); \
            _Pragma("unroll") for (int e = 0; e < 4; ++e) { const unsigned pu = (unsigned)__builtin_amdgcn_mov_dpp((int)uu[e], 0xB1, 0xF, 0xF, true); \
                *(LAS unsigned*)(kt + (kr + 2 * e + (lane & 1)) * 72 + (lane & ~1)) = __builtin_amdgcn_perm(pu, uu[e], psel); } } \
        if (w < 4) { const unsigned uu[4] = {vq[set].x, vq[set].y, vq[set].z, vq[set].w}; \
            _Pragma("unroll") for (int e = 0; e < 4; ++e) { const unsigned yy = pk2(bflo(uu[e]) * wv, bfhi(uu[e]) * wv); const unsigned pu = (unsigned)__builtin_amdgcn_mov_dpp((int)yy, 0xB1, 0xF, 0xF, true); \
                *(LAS unsigned*)(vt + (8 * w + 2 * e + (lane & 1)) * 72 + (lane & ~1)) = __builtin_amdgcn_perm(pu, yy, psel); } } \
        if (w == 0) wls[(set) * 64 + lane] = wv; \
        if ((c_) + 2 < 32) ML_LOAD(set, (c_) + 2); \
        if (vs == 0 && tid == 0) ((float*)(ws + WS_MM))[item] = m; \
        LDS_BARRIER(); \
        _Pragma("unroll") for (int vb = 0; vb < 2; ++vb) { *(v2u*)((bf16*)(ws + WS_MC) + ((size_t)item * 256 + 32 * vs + 16 * vb + fr) * 128 + 16 * w + 4 * fq) = pack4(acc[vb]); } \
        if (vs == 0) {   \
            if (fq == 0) ((float*)(ws + WS_MN))[(size_t)item * 128 + 16 * w + fr] = nst; float sn = 0.f; \
            _Pragma("unroll") for (int s2 = 0; s2 < 2; ++s2) { const v4u kk = *(const LAS v4u*)(kt + (16 * w + fr) * 72 + 16 * fq + 8 * s2); const LAS float* wl = wls + (set) * 64 + 16 * fq + 8 * s2; \
                const f32x4 w0 = *(const LAS f32x4*)wl, w1 = *(const LAS f32x4*)(wl + 4); \
                sn += bflo(kk.x) * w0.x + bfhi(kk.x) * w0.y + bflo(kk.y) * w0.z + bfhi(kk.y) * w0.w + bflo(kk.z) * w1.x + bfhi(kk.z) * w1.y + bflo(kk.w) * w1.z + bfhi(kk.w) * w1.w; } \
            sn += __shfl_xor(sn, 16); sn += __shfl_xor(sn, 32); \
            nst = sc * nst + sn; } \
        _Pragma("unroll") for (int vb = 0; vb < 2; ++vb) { acc[vb] = acc[vb] * sc; \
            _Pragma("unroll") for (int kt2 = 0; kt2 < 2; ++kt2) { const bf16x8 af = *(const LAS bf16x8*)(kt + (16 * w + fr) * 72 + 32 * kt2 + 8 * fq), bfv = *(const LAS bf16x8*)(vt + (16 * vb + fr) * 72 + 32 * kt2 + 8 * fq); \
                acc[vb] = MFMA32(af, bfv, acc[vb]); } } \
        m = mnew; } while (0)
    ML_LOAD(0, 0); ML_LOAD(1, 1);
#pragma unroll 1
    for (int c2 = 0; c2 < 32; c2 += 2) { ML_STEP(0, c2); ML_STEP(1, c2 + 1); }
#undef ML_LOAD
#undef ML_STEP
#pragma unroll
    for (int vb = 0; vb < 2; ++vb) *(f32x4*)(a->out + O_MCP + ((size_t)chain * 256 + 32 * vs + 16 * vb + fr) * 128 + 16 * w + 4 * fq) = acc[vb];
    if (vs == 0) { if (fq == 0) a->out[O_MNP + (size_t)chain * 128 + 16 * w + fr] = nst; if (tid == 0) a->out[O_MMP + chain] = m; }
    LDS_BARRIER();
}

__device__ __forceinline__ void mlstm_out_item(ArgsP a, LAS unsigned char* lds, int item, const int tid) {
    const int c = item & 31, h = (item >> 5) & 7, b = item >> 8, row0 = b * TP + 64 * c;
    const int lane = tid & 63, w = __builtin_amdgcn_readfirstlane(tid >> 6), fr = lane & 15, fq = lane >> 4;
    unsigned char* ws = a->ws;
    const bf16* proj = (const bf16*)(ws + WS_PROJ); const float* gates = (const float*)(ws + WS_GATES);
    LAS bf16* VT = (LAS bf16*)lds;
    LAS float* ssq = (LAS float*)(lds + 36864);
    const int tb = w & 3, half = w >> 2, t = 16 * tb + fr;
    v4u vu[4];
#pragma unroll
    for (int i = 0; i < 4; ++i) vu[i] = *(const v4u*)(proj + (size_t)(row0 + lane) * NPROJ_PAD + 2048 + h * 256 + 8 * (w + 8 * i));
    v4u qu[4]; f32x4 nv[4][2];
#pragma unroll
    for (int ks = 0; ks < 4; ++ks) { qu[ks] = *(const v4u*)(proj + (size_t)(row0 + t) * NPROJ_PAD + h * 128 + 32 * ks + 8 * fq);
        const float* np = (const float*)(ws + WS_MN) + (size_t)item * 128 + 32 * ks + 8 * fq; nv[ks][0] = *(const f32x4*)np; nv[ks][1] = *(const f32x4*)(np + 4); }
    v4u kfr[4][4];
#pragma unroll
    for (int sb = 0; sb < 4; ++sb) if (sb <= tb) {
#pragma unroll
        for (int ks = 0; ks < 4; ++ks) kfr[sb][ks] = *(const v4u*)(proj + (size_t)(row0 + 16 * sb + fr) * NPROJ_PAD + 1024 + h * 128 + 32 * ks + 8 * fq); }
    const float mc = ((const float*)(ws + WS_MM))[item];
    float av, Mt, et, em;
    { const float ig = gates[(size_t)(row0 + lane) * 16 + h] + a->in[I_BIG][h], lf = logsigf(gates[(size_t)(row0 + lane) * 16 + 8 + h] + a->in[I_BFG][h]);
      const float bcum = wave_incl_sum(lf, lane); av = ig - bcum; Mt = fmaxf(mc, wave_incl_max(av, lane)); et = fexp(mc - Mt); em = fexp(-(bcum + Mt)); }
    const unsigned psel = (lane & 1) ? 0x03020706u : 0x05040100u;
#pragma unroll
    for (int i = 0; i < 4; ++i) { const unsigned uu[4] = {vu[i].x, vu[i].y, vu[i].z, vu[i].w}; const int vr = 8 * (w + 8 * i);
#pragma unroll
        for (int e = 0; e < 4; ++e) { const unsigned pu = (unsigned)__builtin_amdgcn_mov_dpp((int)uu[e], 0xB1, 0xF, 0xF, true);
            *(LAS unsigned*)(VT + (vr + 2 * e + (lane & 1)) * 72 + (lane & ~1)) = __builtin_amdgcn_perm(pu, uu[e], psel); } }
    bf16x8 qf[4]; float qn = 0.f;
#pragma unroll
    for (int ks = 0; ks < 4; ++ks) { const v4u u = qu[ks]; qf[ks] = __builtin_bit_cast(bf16x8, u); const f32x4 n0 = nv[ks][0], n1 = nv[ks][1];
        qn += bflo(u.x) * n0.x + bfhi(u.x) * n0.y + bflo(u.y) * n0.z + bfhi(u.y) * n0.w + bflo(u.z) * n1.x + bfhi(u.z) * n1.y + bflo(u.w) * n1.z + bfhi(u.w) * n1.w; }
    qn += __shfl_xor(qn, 16); qn += __shfl_xor(qn, 32);
    const float Mtt = __shfl(Mt, t), ett = __shfl(et, t), emt = __shfl(em, t);
    const bf16* cs = (const bf16*)(ws + WS_MC) + (size_t)item * 256 * 128;
    v2u smp[4]; float rowsum = 0.f;
#pragma unroll
    for (int sb = 0; sb < 4; ++sb) { smp[sb] = (v2u){0u, 0u};
        if (sb <= tb) { f32x4 qk = (f32x4){0.f, 0.f, 0.f, 0.f};
#pragma unroll
            for (int ks = 0; ks < 4; ++ks) qk = MFMA32(__builtin_bit_cast(bf16x8, kfr[sb][ks]), qf[ks], qk);
            f32x4 sm;
#pragma unroll
            for (int j = 0; j < 4; ++j) { const int s = 16 * sb + 4 * fq + j; const float as = __shfl(av, s); sm[j] = (s <= t) ? qk[j] * 0.08838834764831845f * fexp(as - Mtt) : 0.f; rowsum += sm[j]; }
            smp[sb] = pack4(sm); } }
    rowsum += __shfl_xor(rowsum, 16); rowsum += __shfl_xor(rowsum, 32);
    const float hden = 1.f / fmaxf(fabsf(ett * qn + rowsum), emt);
    const v4u s0u = (v4u){smp[0].x, smp[0].y, smp[1].x, smp[1].y}, s1u = (v4u){smp[2].x, smp[2].y, smp[3].x, smp[3].y};
    const bf16x8 sf0 = __builtin_bit_cast(bf16x8, s0u), sf1 = __builtin_bit_cast(bf16x8, s1u);
    v4u cfr[4][4];
#pragma unroll
    for (int g4 = 0; g4 < 4; ++g4)
#pragma unroll
        for (int ks = 0; ks < 4; ++ks) cfr[g4][ks] = *(const v4u*)(cs + (size_t)(128 * half + 16 * g4 + fr) * 128 + 32 * ks + 8 * fq);
    LDS_BARRIER();
    f32x4 hv[8]; float ss = 0.f;
#pragma unroll
    for (int grp = 0; grp < 2; ++grp) {
      f32x4 accs[4];
#pragma unroll
      for (int g4 = 0; g4 < 4; ++g4) { f32x4 acc = (f32x4){0.f, 0.f, 0.f, 0.f};
#pragma unroll
          for (int ks = 0; ks < 4; ++ks) acc = MFMA32(__builtin_bit_cast(bf16x8, cfr[g4][ks]), qf[ks], acc);
          accs[g4] = acc * ett; }
      if (grp == 0) {
#pragma unroll
          for (int g4 = 0; g4 < 4; ++g4)
#pragma unroll
              for (int ks = 0; ks < 4; ++ks) cfr[g4][ks] = *(const v4u*)(cs + (size_t)(128 * half + 64 + 16 * g4 + fr) * 128 + 32 * ks + 8 * fq); }
#pragma unroll
      for (int g4 = 0; g4 < 4; ++g4) { const int vb = 4 * grp + g4, vrow = 128 * half + 16 * vb + fr; f32x4 acc = accs[g4];
        { const v2u a0 = *(const LAS v2u*)(VT + vrow * 72 + 4 * fq), a1 = *(const LAS v2u*)(VT + vrow * 72 + 16 + 4 * fq); const v4u au = (v4u){a0.x, a0.y, a1.x, a1.y}; acc = MFMA32(__builtin_bit_cast(bf16x8, au), sf0, acc); }
        { const v2u a0 = *(const LAS v2u*)(VT + vrow * 72 + 32 + 4 * fq), a1 = *(const LAS v2u*)(VT + vrow * 72 + 48 + 4 * fq); const v4u au = (v4u){a0.x, a0.y, a1.x, a1.y}; acc = MFMA32(__builtin_bit_cast(bf16x8, au), sf1, acc); }
        hv[vb] = acc * hden; ss += (hv[vb].x * hv[vb].x + hv[vb].y * hv[vb].y) + (hv[vb].z * hv[vb].z + hv[vb].w * hv[vb].w); }
    }
    ss += __shfl_xor(ss, 16); ss += __shfl_xor(ss, 32);
    if (fq == 0) ssq[half * 64 + t] = ss;
    LDS_BARRIER();
    const float rstd = rsqrtf((ssq[t] + ssq[64 + t]) * (1.f / 256.f) + RMS_EPS);
    const bf16* op = proj + (size_t)(row0 + t) * NPROJ_PAD + 4096 + h * 256 + 128 * half + 4 * fq;
    bf16* mp = (bf16*)(ws + WS_MIX) + (size_t)(row0 + t) * D + h * 256 + 128 * half + 4 * fq;
    const float* nw = a->in[I_MNORM] + h * 256 + 128 * half + 4 * fq;
    v2u opr[8];
#pragma unroll
    for (int vb = 0; vb < 8; ++vb) opr[vb] = *(const v2u*)(op + 16 * vb);
#pragma unroll
    for (int vb = 0; vb < 8; ++vb) { const v2u o = opr[vb]; const f32x4 n4 = *(const f32x4*)(nw + 16 * vb);
        f32x4 y; y.x = hv[vb].x * rstd * n4.x * sigm(bflo(o.x)); y.y = hv[vb].y * rstd * n4.y * sigm(bfhi(o.x)); y.z = hv[vb].z * rstd * n4.z * sigm(bflo(o.y)); y.w = hv[vb].w * rstd * n4.w * sigm(bfhi(o.y));
        *(v2u*)(mp + 16 * vb) = pack4(y); }
    LDS_BARRIER();
}


__device__ __forceinline__ void mlstm_sample_load(ArgsP a, int j, const int tid, f32x4 (&cst)[2][4][2]) {
    const int lane = tid & 63, w = __builtin_amdgcn_readfirstlane(tid >> 6), fr = lane & 15, fq = lane >> 4;
    const float* C0 = a->in[I_SMC] + (size_t)j * 32768;
#pragma unroll
    for (int vb = 0; vb < 2; ++vb)
#pragma unroll
        for (int ksp = 0; ksp < 4; ++ksp) { const float* cp = C0 + (size_t)(32 * w + 16 * vb + fr) * 128 + 32 * ksp + 4 * fq; cst[vb][ksp][0] = __builtin_nontemporal_load((const f32x4*)cp); cst[vb][ksp][1] = __builtin_nontemporal_load((const f32x4*)(cp + 16)); }
}
__device__ __forceinline__ void mlstm_sample_item(ArgsP a, LAS unsigned char* lds, int j, const int tid, const f32x4 (&cst)[2][4][2]) {
    const int b = j >> 3, h = j & 7, row0 = MP + b * TS;
    const int lane = tid & 63, w = __builtin_amdgcn_readfirstlane(tid >> 6), fr = lane & 15, fq = lane >> 4;
    unsigned char* ws = a->ws;
    const bf16* proj = (const bf16*)(ws + WS_PROJ); const float* gates = (const float*)(ws + WS_GATES);
    float* Cout = a->out + O_MCS + (size_t)j * 32768;
    LAS float* qs = (LAS float*)lds;
    LAS float* ks = qs + 512;
    LAS float* vs = ks + 512;
    LAS float* gs = vs + 1024;
    LAS float* qkr = gs + 8;
    LAS float* qnl = qkr + 16;
    LAS float* hbuf = qnl + 8;
#pragma unroll
    for (int tok = 0; tok < 4; ++tok) { const bf16* pr = proj + (size_t)(row0 + tok) * NPROJ_PAD;
        if (tid < 128) qs[tok * 128 + tid] = bf2f(pr[h * 128 + tid]); else if (tid < 256) ks[tok * 128 + tid - 128] = bf2f(pr[1024 + h * 128 + (tid - 128)]) * 0.08838834764831845f; else vs[tok * 256 + tid - 256] = bf2f(pr[2048 + h * 256 + (tid - 256)]); }
    if (tid < 4) { gs[tid * 2] = gates[(size_t)(row0 + tid) * 16 + h] + a->in[I_BIG][h]; gs[tid * 2 + 1] = gates[(size_t)(row0 + tid) * 16 + 8 + h] + a->in[I_BFG][h]; }
    const float n0a = a->in[I_SMN][(size_t)j * 128 + lane], n0b = a->in[I_SMN][(size_t)j * 128 + 64 + lane];
    const float m0 = a->in[I_SMM][j];
    LDS_BARRIER();
#pragma unroll
    for (int i = 0; i < 2; ++i) { const int p = 2 * w + i, t = p >> 2, sx = p & 3; const float d = wave_sum(qs[t * 128 + lane] * ks[sx * 128 + lane] + qs[t * 128 + 64 + lane] * ks[sx * 128 + 64 + lane]); if (lane == 0) qkr[p] = d; }
    if (w < 4) { const float d = wave_sum(qs[w * 128 + lane] * n0a + qs[w * 128 + 64 + lane] * n0b); if (lane == 0) qnl[w] = d; }
    float bc[4], ig[4], mt[4], m = m0, bsum = 0.f;
#pragma unroll
    for (int t = 0; t < 4; ++t) { ig[t] = gs[t * 2]; const float lf = logsigf(gs[t * 2 + 1]); bsum += lf; bc[t] = bsum; m = fmaxf(lf + m, ig[t]); mt[t] = m; }
    const float scf = fexp(bc[3] + m0 - mt[3]);
    float wsf[4], et[4];
#pragma unroll
    for (int t = 0; t < 4; ++t) { wsf[t] = fexp(bc[3] - bc[t] + ig[t] - mt[3]); et[t] = fexp(bc[t] + m0 - mt[t]); }
    LDS_BARRIER();
    float S[4][4], hden[4];
#pragma unroll
    for (int t = 0; t < 4; ++t) { float den = et[t] * qnl[t];
#pragma unroll
        for (int sx = 0; sx < 4; ++sx) { S[t][sx] = (sx <= t) ? qkr[t * 4 + sx] * fexp(bc[t] - bc[sx] + ig[sx] - mt[t]) : 0.f; den += S[t][sx]; }
        hden[t] = 1.f / fmaxf(fabsf(den), fexp(-mt[t])); }
    bf16x8 qa[4];
#pragma unroll
    for (int ksp = 0; ksp < 4; ++ksp) { v4u u = (v4u){0u, 0u, 0u, 0u};
        if (fr < 4) { const f32x4 x0 = *(const LAS f32x4*)(qs + fr * 128 + 32 * ksp + 4 * fq), x1 = *(const LAS f32x4*)(qs + fr * 128 + 32 * ksp + 16 + 4 * fq); u.x = pk2(x0.x, x0.y); u.y = pk2(x0.z, x0.w); u.z = pk2(x1.x, x1.y); u.w = pk2(x1.z, x1.w); }
        qa[ksp] = __builtin_bit_cast(bf16x8, u); }
#pragma unroll
    for (int vb = 0; vb < 2; ++vb) { const int v = 32 * w + 16 * vb + fr;
        float vw[4];
#pragma unroll
        for (int sx = 0; sx < 4; ++sx) vw[sx] = vs[sx * 256 + v] * wsf[sx];
        f32x4 dacc = (f32x4){0.f, 0.f, 0.f, 0.f};
#pragma unroll
        for (int ksp = 0; ksp < 4; ++ksp) { const f32x4 c0 = cst[vb][ksp][0], c1 = cst[vb][ksp][1];
            v4u u; u.x = pk2(c0.x, c0.y); u.y = pk2(c0.z, c0.w); u.z = pk2(c1.x, c1.y); u.w = pk2(c1.z, c1.w);
            dacc = MFMA32(qa[ksp], __builtin_bit_cast(bf16x8, u), dacc);
            f32x4 n0v = c0 * scf, n1v = c1 * scf;
#pragma unroll
            for (int sx = 0; sx < 4; ++sx) { const f32x4 k0 = *(const LAS f32x4*)(ks + sx * 128 + 32 * ksp + 4 * fq), k1 = *(const LAS f32x4*)(ks + sx * 128 + 32 * ksp + 16 + 4 * fq); n0v = n0v + k0 * vw[sx]; n1v = n1v + k1 * vw[sx]; }
            float* op = Cout + (size_t)v * 128 + 32 * ksp + 4 * fq; __builtin_nontemporal_store(n0v, (f32x4*)op); __builtin_nontemporal_store(n1v, (f32x4*)(op + 16)); }
        if (fq == 0) {
#pragma unroll
            for (int t = 0; t < 4; ++t) { float num = et[t] * dacc[t];
#pragma unroll
                for (int sx = 0; sx < 4; ++sx) num += S[t][sx] * vs[sx * 256 + v];
                hbuf[t * 256 + v] = num * hden[t]; } }
    }
    if (tid < 128) { float nn = scf * a->in[I_SMN][(size_t)j * 128 + tid];
#pragma unroll
        for (int sx = 0; sx < 4; ++sx) nn += wsf[sx] * ks[sx * 128 + tid];
        a->out[O_MNS + (size_t)j * 128 + tid] = nn; }
    if (tid == 0) a->out[O_MMS + j] = mt[3];
    LDS_BARRIER();
    if (w < 4) { const int tok = w, row = row0 + tok; float hv[4]; float ss = 0.f;
#pragma unroll
        for (int i = 0; i < 4; ++i) { hv[i] = hbuf[tok * 256 + i * 64 + lane]; ss += hv[i] * hv[i]; }
        const float rstd = rsqrtf(wave_sum(ss) * (1.f / 256.f) + RMS_EPS);
        const float* nw = a->in[I_MNORM] + h * 256; bf16* mix = (bf16*)(ws + WS_MIX);
#pragma unroll
        for (int i = 0; i < 4; ++i) { const int vi = i * 64 + lane; const float op = bf2f(proj[(size_t)row * NPROJ_PAD + 4096 + h * 256 + vi]);
            mix[(size_t)row * D + h * 256 + vi] = (bf16)f2bf(hv[i] * rstd * nw[vi] * sigm(op)); } }
    LDS_BARRIER();
}


__device__ __forceinline__ void lru_sample_loop(ArgsP a, LAS unsigned char* lds, int vcu, int G, const int tid) {
    const int d = tid & 127, part = tid >> 7, n = vcu & 7, chn = n * 128 + d;
    const bf16* proj = (const bf16*)(a->ws + WS_PROJ); bf16* mix = (bf16*)(a->ws + WS_MIX);
    const float* wconv = a->in[I_WCONV]; const float* bconv = a->in[I_BCONV];
    const float* wr = a->in[I_LWR] + (size_t)n * 16384; const float* wi = a->in[I_LWI] + (size_t)n * 16384;
    LAS float* xr = (LAS float*)lds;
    LAS float* red = xr + 512;
    float w1[32], w2[32];
#pragma unroll
    for (int cc = 0; cc < 32; ++cc) { w1[cc] = wr[(part * 32 + cc) * 128 + d]; w2[cc] = wi[(part * 32 + cc) * 128 + d]; }
    const float br = a->in[I_LBR][chn], bi = a->in[I_LBI][chn], spl = softplusf(-a->in[I_LLAM][chn]);
#pragma unroll 1
    for (int j = vcu; j < 1024; j += G) {
        const int b = j >> 3, row0 = MP + b * TS; const float* cstate = a->in[I_SCONV] + (size_t)b * 3 * 4096;
        float hst = a->in[I_SLRU][(size_t)b * 1024 + chn];
        float gt[4];
        if (part == 0) {
#pragma unroll
            for (int tok = 0; tok < 4; ++tok) gt[tok] = bf2f(proj[(size_t)(row0 + tok) * NPROJ_PAD + 5120 + chn]); }
        { const int tok = tid >> 7; xr[tok * 128 + d] = conv4(proj, row0, tok, 3072 + chn, cstate, wconv, bconv); }
        LDS_BARRIER();
        float ar[4] = {0.f, 0.f, 0.f, 0.f}, ai[4] = {0.f, 0.f, 0.f, 0.f};
#pragma unroll
        for (int cc = 0; cc < 32; ++cc) { const int c = part * 32 + cc;
#pragma unroll
            for (int tok = 0; tok < 4; ++tok) { const float x = xr[tok * 128 + c]; ar[tok] += x * w1[cc]; ai[tok] += x * w2[cc]; } }
#pragma unroll
        for (int tok = 0; tok < 4; ++tok) { red[((tok * 2 + 0) * 4 + part) * 128 + d] = ar[tok]; red[((tok * 2 + 1) * 4 + part) * 128 + d] = ai[tok]; }
        LDS_BARRIER();
        if (part == 0) {
#pragma unroll
            for (int tok = 0; tok < 4; ++tok) {
                float rp = br, ip = bi;
#pragma unroll
                for (int p = 0; p < 4; ++p) { rp += red[((tok * 2 + 0) * 4 + p) * 128 + d]; ip += red[((tok * 2 + 1) * 4 + p) * 128 + d]; }
                const float log_a = -8.f * sigm(rp) * spl;
                const float av = fexp(log_a);
                const float bx = sqrtf(neg_expm1(2.f * log_a)) * sigm(ip) * xr[tok * 128 + d];
                hst = av * hst + bx;
                mix[(size_t)(row0 + tok) * D + 1024 + chn] = (bf16)f2bf(hst * gelu_tanh(gt[tok]));
            }
            a->out[O_LRUS + (size_t)b * 1024 + chn] = hst;
        }
        LDS_BARRIER();
    }
}

__device__ __forceinline__ void phase_mixer_even(ArgsP a, LAS unsigned char* lds, int vcu, int G, const int tid) {
#pragma unroll 1
    for (int r = 0; r < 1 + (PROBE_SUB & 1); ++r)
#pragma unroll 1
    for (int it = vcu; it < 1024; it += G) { int tq = tid; asm volatile("" : "+v"(tq)); delta_prep_item(a, lds, it, tq); }
#pragma unroll 1
    for (int r = 0; r < 1 + ((PROBE_SUB >> 1) & 1); ++r)
#pragma unroll 1
    for (int it = vcu; it < 1024; it += G) lru_prep_item(a, lds, it, tid);
#pragma unroll 1
    for (int r = 0; r < 1 + ((PROBE_SUB >> 2) & 1); ++r)
#pragma unroll 1
    for (int j = vcu; j < 1024; j += G) { const int b = j >> 3, hn = j & 7; delta_rec_item(a, lds, MP + b * TS, TS, hn, a->in[I_SCONV] + (size_t)b * 3 * 4096, a->in[I_SDELTA] + (size_t)j * 16384, a->out + O_DELTAS + (size_t)j * 16384, tid); }
#pragma unroll 1
    for (int r = 0; r < 1 + ((PROBE_SUB >> 3) & 1); ++r)
    lru_sample_loop(a, lds, vcu, G, tid);
    const bf16* proj = (const bf16*)(a->ws + WS_PROJ);
    const int npieces = (BP + BS) * 3 * 512;
    for (int i = vcu * NTHR + tid; i < npieces; i += G * NTHR) {
        const int c8 = i & 511, rj = i >> 9, j = rj % 3, b = rj / 3;
        const bf16* src; float* dst;
        if (b < BP) { src = proj + (size_t)(b * TP + TP - 3 + j) * NPROJ_PAD + 8 * c8; dst = a->out + O_CONVP + (size_t)(b * 3 + j) * 4096 + 8 * c8; }
        else { const int bs = b - BP; src = proj + (size_t)(MP + bs * TS + 1 + j) * NPROJ_PAD + 8 * c8; dst = a->out + O_CONVS + (size_t)(bs * 3 + j) * 4096 + 8 * c8; }
        const v4u u = *(const v4u*)src;
        *(f32x4*)dst = (f32x4){bflo(u.x), bfhi(u.x), bflo(u.y), bfhi(u.y)}; *(f32x4*)(dst + 4) = (f32x4){bflo(u.z), bfhi(u.z), bflo(u.w), bfhi(u.w)};
    }
}
__device__ __forceinline__ void phase_mixer_even_b(ArgsP a, LAS unsigned char* lds, int vcu, int G, const int tid, int rep = 0) {
    const int w = __builtin_amdgcn_readfirstlane(tid >> 6);
    if (vcu & 1) { if (w < 2) { const int it = (vcu >> 1) * 2 + w; if (it < 256) delta_scan_wave(a, it >> 3, it & 7, tid & 63); } }
    else { LAS float* scr = (LAS float*)(lds + w * 16384);
        convert_range<8>(a, scr, cv::R_IN0, cv::R_SCAN, (vcu >> 1) * 8 + w, (G >> 1) * 8, tid & 63); }
}
__device__ __forceinline__ void phase_mixer_even_c(ArgsP a, LAS unsigned char* lds, int vcu, int G, const int tid) {
    const int w = tid >> 6;
#pragma unroll 1
    for (int it = vcu; it < 512; it += G) delta_out_wave(a, 2 * it + (w >> 2), w & 3, tid & 63);
    lru_out_loop(a, lds, vcu, G, tid);
    for (int chain = vcu; chain < 32; chain += G) {
        const f32x4* src = (const f32x4*)(a->ws + WS_DF) + (size_t)chain * 4096; float* dst = a->out + O_DELTAP + (size_t)chain * 16384;
        f32x4 v[8];
#pragma unroll
        for (int i = 0; i < 8; ++i) v[i] = src[tid + 512 * i];
#pragma unroll
        for (int i = 0; i < 8; ++i) { const int idx = tid + 512 * i, ln = idx & 63, rb = (idx >> 6) & 7, s8 = idx >> 9; const int dk0 = 16 * rb + 4 * (ln >> 4), dv = 16 * s8 + (ln & 15);
            dst[(size_t)(dk0 + 0) * 128 + dv] = v[i].x; dst[(size_t)(dk0 + 1) * 128 + dv] = v[i].y; dst[(size_t)(dk0 + 2) * 128 + dv] = v[i].z; dst[(size_t)(dk0 + 3) * 128 + dv] = v[i].w; }
    }
}
__device__ __forceinline__ void phase_mixer_odd(ArgsP a, LAS unsigned char* lds, int vcu, int G, const int tid) {
#pragma unroll 1
    for (int r = 0; r < 1 + ((PROBE_SUB >> 4) & 1); ++r)
#pragma unroll 1
    for (int it = vcu; it < 256; it += G) mlstm_scan_item(a, lds, it >> 3, it & 7, tid);
#pragma unroll 1
    for (int r = 0; r < 1 + ((PROBE_SUB >> 5) & 1); ++r)
    {
        f32x4 cA[2][4][2], cB[2][4][2]; int j = vcu;
        if (j < 1024) { mlstm_sample_load(a, j, tid, cA);
#pragma unroll 1
            for (;;) {
                const int jB = j + G; const bool hasB = jB < 1024;
                if (hasB) mlstm_sample_load(a, jB, tid, cB);
                mlstm_sample_item(a, lds, j, tid, cA);
                if (!hasB) break;
                j = jB + G; const bool hasA = j < 1024;
                if (hasA) mlstm_sample_load(a, j, tid, cA);
                mlstm_sample_item(a, lds, jB, tid, cB);
                if (!hasA) break;
            } }
    }
}
__device__ __forceinline__ void phase_mixer_odd_b(ArgsP a, LAS unsigned char* lds, int vcu, int G, const int tid) {
#pragma unroll 1
    for (int it = vcu; it < 1024; it += G) mlstm_out_item(a, lds, it, tid);
}

__device__ __forceinline__ void st_wt16(void* p, v4u v) { asm volatile("global_store_dwordx4 %0, %1, off sc0 sc1\n\ts_nop 1" : : "v"(p), "v"(v) : "memory"); }
__device__ __forceinline__ void st_wt8(void* p, v2u v) { asm volatile("global_store_dwordx2 %0, %1, off sc0 sc1\n\ts_nop 1" : : "v"(p), "v"(v) : "memory"); }
__device__ __forceinline__ void cfin_finalize(ArgsP a, int L, int vcu, int G, const int tid) {
    const float* cp = (const float*)(a->ws + WS_CPART + (size_t)L * 3 * MiB); float* cf = (float*)(a->ws + WS_CFIN + (size_t)L * 256 * 1024);
    for (int idx = vcu * NTHR + tid; idx < 2 * FF + 2 * D; idx += G * NTHR) {
        const float* src; int stride;
        if (idx < 2 * FF) { src = cp + (size_t)(idx >> 13) * (32 * FF) + (idx & (FF - 1)); stride = FF; }
        else { const int j = idx - 2 * FF; src = cp + (size_t)2 * 32 * FF + (size_t)(j >> 11) * (32 * D) + (j & (D - 1)); stride = D; }
        float sacc = 0.f;
#pragma unroll 8
        for (int kb = 0; kb < 32; ++kb) sacc += src[(size_t)kb * stride];
        cf[idx] = sacc;
    }
}
template <int MODE> __device__ __forceinline__ void sample_rows(ArgsP a, LAS unsigned char* lds, int L, float* outf, int vcu, int G, const int tid) {
    const int lane = tid & 63, w = __builtin_amdgcn_readfirstlane(tid >> 6);
    float alpha = DN_ALPHA; asm volatile("" : "+s"(alpha));
    unsigned char* ws = a->ws;
    bf16* VB = (bf16*)(ws + WS_PART0); bf16* VB2 = (bf16*)(ws + WS_H); const bf16* p1 = (const bf16*)(ws + WS_PART1); bf16* xb = (bf16*)(ws + WS_XB); const bf16* pw = (const bf16*)(ws + WS_PW);
    float* stf1 = (float*)(ws + WS_STF); float* stf2 = (float*)(ws + WS_STF + 512 * 1024); const float* cf = (const float*)(ws + WS_CFIN + (size_t)L * 256 * 1024);
    LAS float* red = (LAS float*)(lds + LDS_CTL_OFF + 128);
    f32x4 pst = (f32x4){0.f, 0.f, 0.f, 0.f}; const int prow = 32 * vcu + (tid >> 4);
    if (MODE != 2 && prow < MP) pst = *(const f32x4*)((const float*)(ws + WS_PART0 + 34 * MiB) + (((size_t)((tid & 15) >> 1) * M + prow) * 4 + 2 * (tid & 1)) * 2);
    for (int r0 = 2 * vcu; r0 < MS; r0 += 2 * G) {
        const int r = r0 + (w >> 2), q = w & 3, col = 512 * q + 8 * lane; const size_t off = (size_t)(MP + r) * D + col;
        const bf16* q1 = p1 + (size_t)r * D + col;
        v4u cq[16];
#pragma unroll
        for (int ch = 0; ch < 16; ++ch) cq[ch] = *(const v4u*)(q1 + (size_t)ch * 512 * D);
        float x[8] = {0.f, 0.f, 0.f, 0.f, 0.f, 0.f, 0.f, 0.f};
        v4u rr, pq; float mean_in = 0.f, rstd_in = 1.f; f32x4 g0, g1, b0, b1, c10, c11, c20, c21;
        if (MODE == 0) rr = *(const v4u*)(xb + off); else rr = *(const v4u*)((MODE == 1 ? VB : VB2) + off);
        if (MODE == 1) { mean_in = stf1[2 * (MP + r)]; rstd_in = stf1[2 * (MP + r) + 1]; const float* g = a->in[I_LN1G] + L * D + col; const float* b = a->in[I_LN1B] + L * D + col;
            g0 = *(const f32x4*)g; g1 = *(const f32x4*)(g + 4); b0 = *(const f32x4*)b; b1 = *(const f32x4*)(b + 4); }
        if (MODE == 2) { mean_in = stf2[2 * (MP + r)]; rstd_in = stf2[2 * (MP + r) + 1]; const float* g = a->in[I_LN2G] + L * D + col; const float* b = a->in[I_LN2B] + L * D + col;
            g0 = *(const f32x4*)g; g1 = *(const f32x4*)(g + 4); b0 = *(const f32x4*)b; b1 = *(const f32x4*)(b + 4); pq = *(const v4u*)(pw + off);
            c10 = *(const f32x4*)(cf + 2 * FF + col); c11 = *(const f32x4*)(cf + 2 * FF + col + 4); c20 = *(const f32x4*)(cf + 2 * FF + D + col); c21 = *(const f32x4*)(cf + 2 * FF + D + col + 4); }
#pragma unroll
        for (int ch = 0; ch < 16; ++ch) { x[0] += bflo(cq[ch].x); x[1] += bfhi(cq[ch].x); x[2] += bflo(cq[ch].y); x[3] += bfhi(cq[ch].y); x[4] += bflo(cq[ch].z); x[5] += bfhi(cq[ch].z); x[6] += bflo(cq[ch].w); x[7] += bfhi(cq[ch].w); }
        float rv[8] = {bflo(rr.x), bfhi(rr.x), bflo(rr.y), bfhi(rr.y), bflo(rr.z), bfhi(rr.z), bflo(rr.w), bfhi(rr.w)};
        if (MODE != 0) {
            const float gg[8] = {g0.x, g0.y, g0.z, g0.w, g1.x, g1.y, g1.z, g1.w}, bb[8] = {b0.x, b0.y, b0.z, b0.w, b1.x, b1.y, b1.z, b1.w};
#pragma unroll
            for (int i = 0; i < 8; ++i) rv[i] = (rv[i] - mean_in) * rstd_in * gg[i] + bb[i]; }
        if (MODE == 2) {
            const float c1[8] = {c10.x, c10.y, c10.z, c10.w, c11.x, c11.y, c11.z, c11.w}, c2[8] = {c20.x, c20.y, c20.z, c20.w, c21.x, c21.y, c21.z, c21.w};
            const float pv[8] = {bflo(pq.x), bfhi(pq.x), bflo(pq.y), bfhi(pq.y), bflo(pq.z), bfhi(pq.z), bflo(pq.w), bfhi(pq.w)};
            float o[8];
#pragma unroll
            for (int i = 0; i < 8; ++i) { const float gt = rstd_in * (x[i] - mean_in * c1[i]) + c2[i]; o[i] = rv[i] + pv[i] / (1.f + __expf(-gt)); }
            v4u ob; ob.x = pk2(o[0], o[1]); ob.y = pk2(o[2], o[3]); ob.z = pk2(o[4], o[5]); ob.w = pk2(o[6], o[7]); st_wt16(xb + off, ob);
            if (outf) { *(f32x4*)(outf + off) = (f32x4){o[0], o[1], o[2], o[3]}; *(f32x4*)(outf + off + 4) = (f32x4){o[4], o[5], o[6], o[7]}; }
        } else {
            float v[8], s = 0.f, ss = 0.f;
#pragma unroll
            for (int i = 0; i < 8; ++i) { v[i] = x[i] + alpha * rv[i]; s += v[i]; ss += v[i] * v[i]; }
            v4u ob; ob.x = pk2(v[0], v[1]); ob.y = pk2(v[2], v[3]); ob.z = pk2(v[4], v[5]); ob.w = pk2(v[6], v[7]); st_wt16((MODE == 0 ? VB : VB2) + off, ob);
            s = wave_sum(s); ss = wave_sum(ss);
            if (lane == 0) { red[w * 2] = s; red[w * 2 + 1] = ss; }
            LDS_BARRIER();
            const int wb = (w >> 2) * 4; s = (red[wb * 2] + red[wb * 2 + 2]) + (red[wb * 2 + 4] + red[wb * 2 + 6]); ss = (red[wb * 2 + 1] + red[wb * 2 + 3]) + (red[wb * 2 + 5] + red[wb * 2 + 7]);
            const float mean = s * (1.f / D), rstd = rsqrtf(fmaxf(ss * (1.f / D) - mean * mean, 0.f) + LN_EPS);
            if (q == 0 && lane == 0) { v2u sv; sv.x = __builtin_bit_cast(unsigned, mean); sv.y = __builtin_bit_cast(unsigned, rstd); st_wt8((MODE == 0 ? stf1 : stf2) + 2 * (MP + r), sv); }
            LDS_BARRIER();
        }
    }
    if (MODE != 2) {
        float sm = pst.x + pst.z, sq = pst.y + pst.w;
#pragma unroll
        for (int o = 1; o < 16; o <<= 1) { sm += __shfl_xor(sm, o); sq += __shfl_xor(sq, o); }
        const float mean = sm * (1.f / D), rstd = rsqrtf(fmaxf(sq * (1.f / D) - mean * mean, 0.f) + LN_EPS);
        if ((tid & 15) == 0 && prow < MP) { v2u sv; sv.x = __builtin_bit_cast(unsigned, mean); sv.y = __builtin_bit_cast(unsigned, rstd); st_wt8((MODE == 0 ? stf1 : stf2) + 2 * (size_t)prow, sv); }
    }
}

constexpr int N_PHASES = 17;
enum { OP_INPROJ = 0, OP_MIXA, OP_MIXB, OP_MIXC, OP_OUTPROJ, OP_UP, OP_DOWN, OP_GATE, OP_COMBINE };
enum { GK_LN = 0, GK_BF16 = 1, GK_SQRELU = 2, GK_COMB = 3 };
__global__ void __launch_bounds__(NTHR, 2) mk_fwd(Args a_in) {
    extern __shared__ __attribute__((aligned(16))) unsigned char lds_raw[];
    LAS unsigned char* lds = (LAS unsigned char*)lds_raw;
    ArgsP kp = (ArgsP)__builtin_amdgcn_kernarg_segment_ptr();
    const int lo = a_in.ph_lo, hi = a_in.ph_hi;
    int wv0; { const int wtmp = (int)threadIdx.x >> 6; asm volatile("s_nop 4\n\tv_readfirstlane_b32 %0, %1\n\ts_nop 4" : "=s"(wv0) : "v"(wtmp)); }
#if MK_N_LAUNCHES == 1
    volatile LAS unsigned* xst = (volatile LAS unsigned*)(lds + LDS_CTL_OFF);
    if (threadIdx.x < 2) xst[threadIdx.x] = 0u;
    __syncthreads();
    XcdBarrier bar = xcd_barrier_post((unsigned*)(a_in.ws + WS_CTL) + 4096, xst);
#endif
    int p = lo; asm volatile("" : "+s"(p));
#pragma unroll 1
    for (; p < hi; ) {
      int nrep = 1;
      if (p == PROBE_P) nrep = 2;
#pragma unroll 1
      for (int rep = 0; rep < nrep; ++rep) {
        int pp = p; asm volatile("" : "+s"(pp));
        int wvs = wv0; asm volatile("" : "+s"(wvs));
        unsigned ones = ~0u; asm volatile("" : "+s"(ones));
        int tid = (wvs << 6) | (int)__builtin_amdgcn_mbcnt_hi(ones, __builtin_amdgcn_mbcnt_lo(ones, 0u)); asm volatile("" : "+v"(tid));
        int bx = blockIdx.x; asm volatile("" : "+s"(bx));
        int G = gridDim.x; asm volatile("" : "+s"(G));
        ArgsP a = kp; asm volatile("" : "+s"(a));
#define MK_VCU ((G % 8 == 0) ? (bx % 8) * (G / 8) + bx / 8 : bx)
#define MK_WAVE (__builtin_amdgcn_readfirstlane(tid >> 6))
#define MK_GW (MK_VCU * NWAVES + MK_WAVE)
#define MK_NGW (G * NWAVES)
#define MK_LANE (tid & 63)
        unsigned char* ws = a->ws;
        if (pp == 0) {
phase_convert(a, lds, MK_GW, MK_NGW, MK_WAVE, MK_LANE); }
        else {
            const int L = pp <= 8 ? 0 : 1; const int q = L == 0 ? pp - 1 : (pp - 9 < 3 ? pp - 9 : pp - 8);
            bf16* xb = (bf16*)(ws + WS_XB); bf16* mixb = (bf16*)(ws + WS_MIX); bf16* pwb = (bf16*)(ws + WS_PW);
            bf16* projb = (bf16*)(ws + WS_PROJ); bf16* upb = (bf16*)(ws + WS_PROJ);
            bf16* vbb = (bf16*)(ws + WS_PART0); bf16* vb2 = (bf16*)(ws + WS_H); float* stb = (float*)(ws + WS_PART0 + 34 * MiB); float* part1 = (float*)(ws + WS_PART1); float* gatesb = (float*)(ws + WS_GATES);
            float* stf1 = (float*)(ws + WS_STF); float* stf2 = (float*)(ws + WS_STF + 512 * 1024); const float* cfin = (const float*)(ws + WS_CFIN + (size_t)L * 256 * 1024);
            unsigned* ctl = (unsigned*)(ws + WS_CTL);
            if (q == OP_MIXA) { if (L == 0) phase_mixer_even(a, lds, MK_VCU, G, tid); else { cfin_finalize(a, 1, MK_VCU, G, tid); phase_mixer_odd(a, lds, MK_VCU, G, tid); } }
            else if (q == OP_MIXB) { if (L == 0) phase_mixer_even_b(a, lds, MK_VCU, G, tid, rep); else phase_mixer_odd_b(a, lds, MK_VCU, G, tid); }
            else if (q == OP_MIXC) { cfin_finalize(a, 0, MK_VCU, G, tid); phase_mixer_even_c(a, lds, MK_VCU, G, tid); }
            else if (q == OP_COMBINE) sample_rows<2>(a, lds, L, a->out + O_Y, MK_VCU, G, tid);
            else {
                unsigned* rdy = nullptr;
                if (q == OP_INPROJ && L == 1) { rdy = ctl + CTL_RDY + 64 * 2; sample_rows<2>(a, lds, 0, nullptr, MK_VCU, G, tid); }
                else if (q == OP_UP) { rdy = ctl + CTL_RDY + 64 * (3 * L); sample_rows<0>(a, lds, L, nullptr, MK_VCU, G, tid); }
                else if (q == OP_GATE) { rdy = ctl + CTL_RDY + 64 * (3 * L + 1); if (rep == 0) sample_rows<1>(a, lds, L, nullptr, MK_VCU, G, tid); }
                for (int sub = 0; sub < (q == OP_INPROJ ? 2 : 1); ++sub) {
                    const bf16* A; const bf16* Bt; int N, K, kind; void* out = nullptr; float* gp = nullptr; int corder = bx, gorder = G;
                    const int busy_in = ((M / 256) * (NPROJ_PAD / 256)) % 256;
                    if (q == OP_INPROJ && sub == 0) { A = xb; Bt = (const bf16*)(ws + (L == 0 ? WS_WINE : WS_WINO)); N = NPROJ_PAD; K = D; kind = GK_BF16; out = projb; gp = gatesb; }
                    else if (q == OP_INPROJ) { A = (const bf16*)(ws + WS_PB) + (size_t)L * M * PLE; Bt = (const bf16*)(ws + WS_WPLE) + (size_t)L * PLE * D; N = D; K = PLE; kind = GK_BF16; out = pwb;
                        gorder = G - busy_in; corder = (bx >= busy_in) ? bx - busy_in : 1 << 20; }
                    else if (q == OP_OUTPROJ) { A = mixb; Bt = (const bf16*)(ws + (L == 0 ? WS_WOUTE : WS_WOUTO)); N = D; K = D; kind = GK_LN; }
                    else if (q == OP_UP) { A = vbb; Bt = (const bf16*)(ws + WS_WUP) + (size_t)L * D * FF; N = FF; K = D; kind = GK_SQRELU; out = upb; }
                    else if (q == OP_DOWN) { A = upb; Bt = (const bf16*)(ws + WS_WDOWN) + (size_t)L * D * FF; N = D; K = FF; kind = GK_LN; }
                    else { A = vb2; Bt = (const bf16*)(ws + WS_WGATE) + (size_t)L * D * D; N = D; K = D; kind = GK_COMB; }
                    pg8::Gemm g{A, Bt, M, N, K};
                    if (kind == GK_LN) { pg8::MainSplit SK; SK.init(K, MK_VCU);
                        if (q == OP_OUTPROJ) { pg8::EpiLnStat<false> E{vbb, stb, xb, part1, N, M, DN_ALPHA, nullptr, nullptr, nullptr}; pg8::gemm_phase<pg8::EpiLnStat<false>, pg8::MainSplit, true, true>(lds, g, SK, E, tid); }
                        else { pg8::EpiLnStat<true> E{vb2, stb, vbb, part1, N, M, DN_ALPHA, stf1, a->in[I_LN1G] + L * D, a->in[I_LN1B] + L * D}; pg8::gemm_phase<pg8::EpiLnStat<true>, pg8::MainSplit, true, true>(lds, g, SK, E, tid); }
                    }
                    else if (kind == GK_COMB) { pg8::MainSplit SK; SK.init(K, MK_VCU); SK.rdy = rdy; SK.need = (unsigned)G; SK.sig = rdy;
                        pg8::EpiCombineLn E{vb2, pwb, xb, L == 1 ? a->out + O_Y : nullptr, part1, N, stf2, cfin + 2 * FF, cfin + 2 * FF + D, a->in[I_LN2G] + L * D, a->in[I_LN2B] + L * D, rdy, (unsigned)G}; pg8::gemm_phase<pg8::EpiCombineLn, pg8::MainSplit, true, true>(lds, g, SK, E, tid); }
                    else if (kind == GK_BF16) { pg8::StaticOrder S; S.init(M, N, K, gorder, corder); S.rdy = rdy; S.need = (unsigned)G; if (sub == 0) S.sig = rdy; pg8::EpiBf16<0> E{(bf16*)out, N, gp, 24}; pg8::gemm_phase<pg8::EpiBf16<0>, pg8::StaticOrder, true, true>(lds, g, S, E, tid);}
                    else { pg8::StaticOrder S; S.init(M, N, K, G, corder); S.rdy = rdy; S.need = (unsigned)G; S.sig = rdy; pg8::EpiUpLn E{(bf16*)out, N, stf1, cfin, cfin + FF, rdy, (unsigned)G}; pg8::gemm_phase<pg8::EpiUpLn, pg8::StaticOrder, true, true>(lds, g, S, E, tid);}
                }
                if (q == OP_INPROJ || q == OP_UP) {
                    const int busy = (q == OP_INPROJ) ? ((M / 256) * (NPROJ_PAD / 256)) % 256 : ((M / 256) * (FF / 256)) % 256;
                    const int first = (q == OP_INPROJ) ? (L == 0 ? 0 : cv::R_SCAN) : (L == 0 ? cv::R_IN1 : cv::R_UP0), last = (q == OP_INPROJ) ? (L == 0 ? cv::R_IN0 : cv::R_IN1) : (L == 0 ? cv::R_UP0 : cv::N_REST);
                    if (G == 256 && bx >= busy) { const int w_ = MK_WAVE; convert_range(a, (LAS float*)(lds + w_ * 16384), first, last, (bx - busy) * NWAVES + w_, (G - busy) * NWAVES, MK_LANE); }
                }
            }
        }
#if MK_N_LAUNCHES == 1
        if (p + 1 < hi || rep + 1 < nrep) xcd_barrier(bar);
#endif
      }
      asm volatile("s_add_i32 %0, %0, 1" : "+s"(p) : : "scc");
    }
}

extern "C" void kernel_launch(void* const* d_in, const int* in_sizes, int n_in, void* d_out, int out_size, void* d_ws, size_t ws_size, hipStream_t stream) {
    static int grid = 0;
    if (grid == 0) {
        if (n_in != 35 || (size_t)out_size != O_END || ws_size < WS_END) { fprintf(stderr, "kernel_launch: unexpected shapes: n_in %d out %d (want %zu) ws %zu (want %zu)\n", n_in, out_size, (size_t)O_END, ws_size, (size_t)WS_END); grid = -1; return; }
        int dev = 0, cus = 0, per_cu = 0;
        hipGetDevice(&dev); hipDeviceGetAttribute(&cus, hipDeviceAttributeMultiprocessorCount, dev);
        if (hipFuncSetAttribute((const void*)mk_fwd, hipFuncAttributeMaxDynamicSharedMemorySize, LDS_BYTES) != hipSuccess) { fprintf(stderr, "kernel_launch: hipFuncSetAttribute failed\n"); grid = -1; return; }
        if (hipOccupancyMaxActiveBlocksPerMultiprocessor(&per_cu, (const void*)mk_fwd, NTHR, LDS_BYTES) != hipSuccess || per_cu < 1) { fprintf(stderr, "kernel_launch: occupancy query says %d\n", per_cu); per_cu = 1; }
        (void)hipGetLastError();
        if (cus != 256) { fprintf(stderr, "kernel_launch: built for a 256-CU device (N = 2048 GEMM schedule), got %d\n", cus); grid = -1; return; }
        grid = cus * 1;
    }
    if (grid < 0) return;
    Args a{};
    for (int i = 0; i < 35; ++i) a.in[i] = (const float*)d_in[i];
    a.out = (float*)d_out; a.ws = (unsigned char*)d_ws;
#if MK_N_LAUNCHES == 1
    hipMemsetAsync((char*)d_ws + WS_CTL, 0, 1 * MiB, stream);
    a.ph_lo = 0; a.ph_hi = N_PHASES;
    hipLaunchKernelGGL(mk_fwd, dim3(grid), dim3(NTHR), LDS_BYTES, stream, a);
#else
    for (int p = 0; p < N_PHASES; ++p) {
        a.ph_lo = p; a.ph_hi = p + 1;
        hipLaunchKernelGGL(mk_fwd, dim3(grid), dim3(NTHR), LDS_BYTES, stream, a);
    }
#endif
}
```
